# Optimizing an MI355X kernel written in HIP

```python
import jax, jax.numpy as jnp
from jax import lax

D_MODEL = 1024
BATCH = 16
SEQ = 2048
DEPTH = 1

CHUNK = 64
SB_HEADS = 8
SB_HEAD_DIM = 64
SB_WIDTH = SB_HEADS * SB_HEAD_DIM
HG_HEADS = 4
HG_HEAD_DIM = 128
HG_WIDTH = HG_HEADS * HG_HEAD_DIM
MIX_WIDTH = SB_WIDTH + HG_WIDTH
IN_PROJ_WIDTH = 3 * SB_WIDTH + 4 * HG_WIDTH
Q_BLOCK = 128
RECUR_BLOCK = CHUNK // 2
N_EXPERTS = 32
TOP_K = 4
D_EXPERT = D_MODEL
SWIGLU_LIMIT = 7.0
SWIGLU_ALPHA = 1.702
EXPERT_BLOCK = 128
EPS = 1e-6

kernel_name = "hybrid_stickbreak_hgrn2_moe"


def rms_norm(x, g):
    xf = x.astype(jnp.float32)
    y = xf * lax.rsqrt(jnp.mean(xf * xf, axis=-1, keepdims=True) + EPS)
    return (y * g.astype(jnp.float32)).astype(x.dtype)


def stick_breaking_attention(q, k, v):
    seq = q.shape[2]
    scale = SB_HEAD_DIM ** -0.5
    outs = []
    for blk in range(seq // Q_BLOCK):
        lo, hi = blk * Q_BLOCK, (blk + 1) * Q_BLOCK
        z = jnp.einsum("bhqd,bhkd->bhqk", q[:, :, lo:hi], k[:, :, :hi]).astype(jnp.float32) * scale
        t_idx = lo + jnp.arange(Q_BLOCK)[:, None]
        s_idx = jnp.arange(hi)[None, :]
        strict = s_idx < t_idx
        log_1mb = jnp.where(strict, jax.nn.log_sigmoid(-z), 0.0)
        after = lax.cumsum(log_1mb, axis=3, reverse=True) - log_1mb
        w = jnp.where(strict, jnp.exp(jax.nn.log_sigmoid(z) + after), 0.0)
        outs.append(jnp.einsum("bhqk,bhkd->bhqd", w.astype(v.dtype), v[:, :, :hi]))
    return jnp.concatenate(outs, axis=2)


def hgrn2_recurrence(q, f_pre, i, lb):
    bsz, seq, nh, dk = q.shape
    nb = seq // RECUR_BLOCK
    qf = q.astype(jnp.float32)
    ff = f_pre.astype(jnp.float32)
    vf = i.astype(jnp.float32)
    lbf = lb.astype(jnp.float32)
    log_f = jnp.log(lbf + (1.0 - lbf) * jax.nn.sigmoid(ff))
    kf = (1.0 - lbf) * jax.nn.sigmoid(-ff)

    def to_blocks(a):
        return a.reshape(bsz, nb, RECUR_BLOCK, nh, a.shape[-1]).transpose(1, 0, 3, 2, 4)

    causal = jnp.tril(jnp.ones((RECUR_BLOCK, RECUR_BLOCK), jnp.float32))

    def step(state, inp):
        qc, kc, vc, gc = inp
        b = jnp.cumsum(gc, axis=2)
        q_e = qc * jnp.exp(b)
        k_e = kc * jnp.exp(-b)
        attn = jnp.einsum("bhtd,bhsd->bhts", q_e, k_e) * causal
        o = jnp.einsum("bhts,bhse->bhte", attn, vc) + jnp.einsum("bhtd,bhde->bhte", q_e, state)
        b_last = b[:, :, -1:, :]
        state = jnp.exp(b_last[:, :, 0, :])[..., None] * state + jnp.einsum(
            "bhsd,bhse->bhde", kc * jnp.exp(b_last - b), vc)
        return state, o

    s0 = jnp.zeros((bsz, nh, dk, vf.shape[-1]), jnp.float32)
    _, o = lax.scan(step, s0, (to_blocks(qf), to_blocks(kf), to_blocks(vf), to_blocks(log_f)))
    o = o.transpose(1, 0, 3, 2, 4).reshape(bsz, seq, nh, vf.shape[-1])
    return o.astype(q.dtype)


def moe_ffn(h, w_router, b_router, w_gate_up, b_gate_up, w_down, b_down):
    n_tok, d = h.shape
    logits = (h @ w_router + b_router).astype(jnp.float32)
    top_val, top_idx = lax.top_k(logits, TOP_K)
    gate = jax.nn.softmax(top_val, axis=-1)
    n_assign = n_tok * TOP_K
    flat_e = top_idx.reshape(-1).astype(jnp.int32)
    flat_tok = jnp.arange(n_assign, dtype=jnp.int32) // TOP_K
    flat_g = gate.reshape(-1)
    order = jnp.argsort(flat_e)
    e_sorted = flat_e[order]
    counts = jnp.zeros((N_EXPERTS,), jnp.int32).at[flat_e].add(1)
    starts = jnp.cumsum(counts) - counts
    padded = (counts + EXPERT_BLOCK - 1) // EXPERT_BLOCK * EXPERT_BLOCK
    pad_ends = jnp.cumsum(padded)
    pad_starts = pad_ends - padded
    dest = pad_starts[e_sorted] + (jnp.arange(n_assign, dtype=jnp.int32) - starts[e_sorted])
    n_blocks = (n_assign + EXPERT_BLOCK - 1) // EXPERT_BLOCK + N_EXPERTS
    n_rows = n_blocks * EXPERT_BLOCK
    row_tok = jnp.full((n_rows,), n_tok, jnp.int32).at[dest].set(flat_tok[order])
    row_g = jnp.zeros((n_rows,), jnp.float32).at[dest].set(flat_g[order])
    block_start = jnp.arange(n_blocks, dtype=jnp.int32) * EXPERT_BLOCK
    block_e = jnp.minimum(jnp.searchsorted(pad_ends, block_start, side="right"), N_EXPERTS - 1)
    h_pad = jnp.concatenate([h, jnp.zeros((1, d), h.dtype)], axis=0)
    xb = h_pad[row_tok].reshape(n_blocks, EXPERT_BLOCK, d)

    def expert_block(args):
        xblk, e = args
        gu = xblk @ w_gate_up[e] + b_gate_up[e]
        g_lin = jnp.minimum(gu[:, :D_EXPERT], SWIGLU_LIMIT)
        u_lin = jnp.clip(gu[:, D_EXPERT:], -SWIGLU_LIMIT, SWIGLU_LIMIT)
        act = g_lin * jax.nn.sigmoid(SWIGLU_ALPHA * g_lin) * (u_lin + 1.0)
        return act @ w_down[e] + b_down[e]

    yb = lax.map(expert_block, (xb, block_e)).reshape(n_rows, d)
    y = jnp.zeros((n_tok + 1, d), h.dtype).at[row_tok].add(yb * row_g[:, None].astype(h.dtype))
    return y[:n_tok]


def setup_inputs(seed: int = 0) -> dict:
    key = jax.random.key(seed)
    ks = jax.random.split(key, 16)
    nrm = jax.random.normal
    f32 = jnp.float32
    return {
        "x": nrm(ks[0], (BATCH, SEQ, D_MODEL), f32),
        "norm1_g": 1.0 + 0.02 * nrm(ks[1], (DEPTH, D_MODEL), f32),
        "w_in": nrm(ks[2], (DEPTH, D_MODEL, IN_PROJ_WIDTH), f32) * D_MODEL ** -0.5,
        "sb_q_norm_g": 1.0 + 0.02 * nrm(ks[3], (DEPTH, SB_HEAD_DIM), f32),
        "sb_k_norm_g": 1.0 + 0.02 * nrm(ks[4], (DEPTH, SB_HEAD_DIM), f32),
        "sb_out_norm_g": 1.0 + 0.02 * nrm(ks[5], (DEPTH, SB_WIDTH), f32),
        "hg_lb_logits": 0.1 * nrm(ks[6], (DEPTH + 1, HG_WIDTH), f32),
        "hg_out_norm_g": 1.0 + 0.02 * nrm(ks[7], (DEPTH, HG_WIDTH), f32),
        "w_out": nrm(ks[8], (DEPTH, MIX_WIDTH, D_MODEL), f32) * MIX_WIDTH ** -0.5,
        "norm2_g": 1.0 + 0.02 * nrm(ks[9], (DEPTH, D_MODEL), f32),
        "w_router": nrm(ks[10], (DEPTH, D_MODEL, N_EXPERTS), f32) * D_MODEL ** -0.5,
        "b_router": 0.01 * nrm(ks[11], (DEPTH, N_EXPERTS), f32),
        "w_gate_up": nrm(ks[12], (DEPTH, N_EXPERTS, D_MODEL, 2 * D_EXPERT), f32) * D_MODEL ** -0.5,
        "b_gate_up": 0.02 * nrm(ks[13], (DEPTH, N_EXPERTS, 2 * D_EXPERT), f32),
        "w_down": nrm(ks[14], (DEPTH, N_EXPERTS, D_EXPERT, D_MODEL), f32) * D_EXPERT ** -0.5,
        "b_down": 0.02 * nrm(ks[15], (DEPTH, N_EXPERTS, D_MODEL), f32),
    }


def reference(x, norm1_g, w_in, sb_q_norm_g, sb_k_norm_g, sb_out_norm_g, hg_lb_logits,
              hg_out_norm_g, w_out, norm2_g, w_router, b_router, w_gate_up, b_gate_up,
              w_down, b_down):
    bsz, seq, d = x.shape
    lb_all = jnp.cumsum(jax.nn.softmax(hg_lb_logits.astype(jnp.float32), axis=0), axis=0)
    for l in range(DEPTH):
        h = rms_norm(x, norm1_g[l])
        p = h @ w_in[l]
        sb_q, sb_k, sb_v, hg_q, hg_f, hg_i, hg_g = jnp.split(
            p, [SB_WIDTH, 2 * SB_WIDTH, 3 * SB_WIDTH, 3 * SB_WIDTH + HG_WIDTH,
                3 * SB_WIDTH + 2 * HG_WIDTH, 3 * SB_WIDTH + 3 * HG_WIDTH], axis=-1)
        heads = lambda a: a.reshape(bsz, seq, SB_HEADS, SB_HEAD_DIM).transpose(0, 2, 1, 3)
        q = rms_norm(heads(sb_q), sb_q_norm_g[l])
        k = rms_norm(heads(sb_k), sb_k_norm_g[l])
        a = stick_breaking_attention(q, k, heads(sb_v)).transpose(0, 2, 1, 3)
        a = rms_norm(a, sb_out_norm_g[l].reshape(SB_HEADS, SB_HEAD_DIM)).reshape(bsz, seq, SB_WIDTH)
        hh = lambda t: t.reshape(bsz, seq, HG_HEADS, HG_HEAD_DIM)
        lb = lb_all[l].reshape(HG_HEADS, HG_HEAD_DIM)
        r = hgrn2_recurrence(hh(hg_q), hh(hg_f), hh(hg_i), lb)
        r = rms_norm(r, hg_out_norm_g[l].reshape(HG_HEADS, HG_HEAD_DIM)).reshape(bsz, seq, HG_WIDTH)
        r = r * jax.nn.silu(hg_g)
        x = x + jnp.concatenate([a, r], axis=-1) @ w_out[l]
        h2 = rms_norm(x, norm2_g[l]).reshape(bsz * seq, d)
        x = x + moe_ffn(h2, w_router[l], b_router[l], w_gate_up[l], b_gate_up[l],
                        w_down[l], b_down[l]).reshape(bsz, seq, d)
    return x
```

```cpp
#include <hip/hip_runtime.h>
#include <cstdio>
#include <cstdint>
namespace pg8 {
#define PG8_LAS __attribute__((address_space(3)))
typedef unsigned short bf16_t;
typedef short bf16x8 __attribute__((ext_vector_type(8)));
typedef float f32x4 __attribute__((ext_vector_type(4)));
typedef unsigned u32x4 __attribute__((ext_vector_type(4)));
constexpr int BM = 256, BK = 64, HALF = 128, HTB = HALF * BK * 2  , STAGE_BYTES = 8 * HTB, NXCD = 8, WGM = 8;

__host__ __device__ __forceinline__ int lds_byte(int r, int c) { const int st = (r >> 4) * 2 + (c >> 5), rr = r & 15, cc = c & 31, ob = rr * 64 + cc * 2; return st * 1024 + (ob ^ (((ob >> 9) & 1) << 5)); }
__host__ __device__ __forceinline__ void stage_rc(int b, int& R, int& C) { const int st = b / 1024, sb = b % 1024, swz = sb ^ (((sb >> 9) & 1) << 5); R = (st >> 1) * 16 + swz / 64; C = (st & 1) * 32 + (swz % 64) / 2; }
__host__ __device__ __forceinline__ int perm32(int rho) { const int n = rho >> 4, i = rho & 15; return 8 * (i >> 2) + 4 * n + (i & 3); }

struct Unit { int pm, pn; };
struct Gemm { const bf16_t* A; const bf16_t* Bt; int M, N, K; };

struct StaticOrder {
    int nM, nN, nwg, G, c;
    __host__ __device__ void init(int M, int N, int G_, int c_) { nM = M / BM; nN = N / BM; nwg = nM * nN; G = G_; c = c_; }
    __host__ __device__ bool next(int i, Unit& u) const {
        const long L = (long)i * G + c; if (L >= nwg) return false;
        int wgid = (int)L; { const int q = nwg / NXCD, r = nwg % NXCD, xcd = wgid % NXCD, off = wgid / NXCD; wgid = (xcd < r ? xcd * (q + 1) : r * (q + 1) + (xcd - r) * q) + off; }
        const int nig = WGM * nN, gid = wgid / nig, fm = gid * WGM, gsz = (nM - fm) < WGM ? (nM - fm) : WGM;
        u.pm = fm + ((wgid % nig) % gsz); u.pn = (wgid % nig) / gsz; return true;
    }
    __device__ __forceinline__ void a_ready(const Unit&) const {}
    __device__ __forceinline__ void done(const Unit&) const {}
};

__device__ __forceinline__ unsigned cvt_pk_bf16(float lo, float hi) { unsigned r; asm volatile("v_cvt_pk_bf16_f32 %0, %1, %2" : "=v"(r) : "v"(lo), "v"(hi)); return r; }
typedef float f32x2 __attribute__((ext_vector_type(2)));
__device__ __forceinline__ f32x2 gelu_pk(f32x2 v) {
    const f32x2 av = __builtin_elementwise_abs(v), d = av * 0.2316418882f + 1.0f;
    f32x2 t; t.x = __builtin_amdgcn_rcpf(d.x); t.y = __builtin_amdgcn_rcpf(d.y);
    f32x2 q = t * 0.5307027145f + (-0.7265760135f); q = q * t + 0.7107068705f; q = q * t + (-0.142248368f); q = q * t + 0.127414796f; q = q * t;
    const f32x2 s = (v * v) * (-0.72134752044f);
    f32x2 e; e.x = __builtin_amdgcn_exp2f(s.x); e.y = __builtin_amdgcn_exp2f(s.y);
    const f32x2 m = v * (q * e), r = v - m;
    f32x2 o; o.x = v.x < 0.f ? m.x : r.x; o.y = v.y < 0.f ? m.y : r.y; return o;
}

template <int ACT  > struct EpiBf16 {
    static constexpr bool PERM = true, AFTER_DRAIN = false; static_assert(ACT == 0 || ACT == 1, "EpiBf16: ACT is 0 (none) or 1 (gelu_pk)");
    bf16_t* O; int ldc; const float* bias; int split_cols; size_t split_stride; float scale0;
    __device__ __forceinline__ void operator()(const f32x4 (&acc)[2][2][4][2], const Unit& u, int wr, int wc, int fr, int fq) const {
        const int row0 = u.pm * BM + wr * 64 + fr; int colt = u.pn * BM; bf16_t* base = O;
        float sc = 1.f; if (split_cols) { const int t = colt / split_cols; base += (size_t)t * split_stride; colt -= t * split_cols; if (t == 0) sc = scale0; }
        const int col0 = colt + wc * 32 + 8 * fq, bcol0 = u.pn * BM + wc * 32 + 8 * fq;
        f32x4 bv[2][2];
#pragma unroll
        for (int bj = 0; bj < 2; ++bj)
#pragma unroll
            for (int n = 0; n < 2; ++n) bv[bj][n] = bias ? *(const f32x4*)(bias + bcol0 + bj * HALF + 4 * n) : (f32x4){0.f, 0.f, 0.f, 0.f};
#pragma unroll
        for (int ai = 0; ai < 2; ++ai)
#pragma unroll
            for (int m = 0; m < 4; ++m) { bf16_t* rowp = base + (size_t)(row0 + ai * HALF + m * 16) * ldc + col0;
#pragma unroll
                for (int bj = 0; bj < 2; ++bj) { f32x4 v0 = acc[ai][bj][m][0] + bv[bj][0], v1 = acc[ai][bj][m][1] + bv[bj][1];
                    if (ACT == 1) { f32x2 a = gelu_pk((f32x2){v0[0], v0[1]}), b = gelu_pk((f32x2){v0[2], v0[3]}), c = gelu_pk((f32x2){v1[0], v1[1]}), d = gelu_pk((f32x2){v1[2], v1[3]});
                        v0 = (f32x4){a.x, a.y, b.x, b.y}; v1 = (f32x4){c.x, c.y, d.x, d.y}; }
                    v0 = v0 * sc; v1 = v1 * sc; u32x4 w; w.x = cvt_pk_bf16(v0[0], v0[1]); w.y = cvt_pk_bf16(v0[2], v0[3]); w.z = cvt_pk_bf16(v1[0], v1[1]); w.w = cvt_pk_bf16(v1[2], v1[3]);
                    *(u32x4*)(rowp + bj * HALF) = w; } }
    }
};

struct EpiRes {
    static constexpr bool PERM = false, AFTER_DRAIN = false;
    const float* X; float* C; int ldc;
    __device__ __forceinline__ void operator()(const f32x4 (&acc)[2][2][4][2], const Unit& u, int wr, int wc, int fr, int fq) const {
        const int row0 = u.pm * BM + wr * 64 + fr, col0 = u.pn * BM + wc * 32 + 4 * fq;
#pragma unroll
        for (int ai = 0; ai < 2; ++ai)
#pragma unroll
            for (int m = 0; m < 4; ++m) { const size_t off = (size_t)(row0 + ai * HALF + m * 16) * ldc + col0;
#pragma unroll
                for (int bj = 0; bj < 2; ++bj)
#pragma unroll
                    for (int n = 0; n < 2; ++n) { const size_t o2 = off + bj * HALF + n * 16; *(f32x4*)(C + o2) = *(const f32x4*)(X + o2) + acc[ai][bj][m][n]; } }
    }
};
struct MoeOrder {
    const PG8_LAS int* tile_e; int ntn, nunits, G, c;
    __device__ __forceinline__ bool next(int i, Unit& u) const {
        const int L = i * G + c; if (L >= nunits) return false;
        const int pm = L / ntn, pl = L - pm * ntn; u.pm = pm; u.pn = tile_e[pm] * ntn + pl; return true;
    }
    __device__ __forceinline__ void a_ready(const Unit&) const {}
    __device__ __forceinline__ void done(const Unit&) const {}
};
struct EpiAct {
    static constexpr bool PERM = true, AFTER_DRAIN = false;
    bf16_t* ACT; const float* bgu;
    __device__ __forceinline__ void operator()(const f32x4 (&acc)[2][2][4][2], const Unit& u, int wr, int wc, int fr, int fq) const {
        const int e = u.pn >> 3, pl = u.pn & 7; const int row0 = u.pm * BM + wr * 64 + fr, acol0 = pl * 128 + wc * 32 + 8 * fq;
        f32x4 bg[2], bu[2];
#pragma unroll
        for (int n = 0; n < 2; ++n) { bg[n] = *(const f32x4*)(bgu + (size_t)e * 2048 + acol0 + 4 * n); bu[n] = *(const f32x4*)(bgu + (size_t)e * 2048 + 1024 + acol0 + 4 * n); }
#pragma unroll
        for (int ai = 0; ai < 2; ++ai)
#pragma unroll
            for (int m = 0; m < 4; ++m) { bf16_t* rowp = ACT + (size_t)(row0 + ai * HALF + m * 16) * 1024 + acol0; float a[8];
#pragma unroll
                for (int n = 0; n < 2; ++n) { const f32x4 g4 = acc[ai][0][m][n] + bg[n], u4 = acc[ai][1][m][n] + bu[n];
#pragma unroll
                    for (int j = 0; j < 4; ++j) { const float gl = fminf(g4[j], 7.0f), ul = fminf(fmaxf(u4[j], -7.0f), 7.0f);
                        const float sg = __builtin_amdgcn_rcpf(1.0f + __builtin_amdgcn_exp2f(gl * (-1.702f * 1.44269504089f))); a[4 * n + j] = gl * sg * (ul + 1.0f); } }
                u32x4 w; w.x = cvt_pk_bf16(a[0], a[1]); w.y = cvt_pk_bf16(a[2], a[3]); w.z = cvt_pk_bf16(a[4], a[5]); w.w = cvt_pk_bf16(a[6], a[7]);
                *(u32x4*)rowp = w; }
    }
};
struct EpiDown {
    static constexpr bool PERM = true, AFTER_DRAIN = false;
    bf16_t* YK; const float* bd; const int* rowtok; const float* rowg;
    __device__ __forceinline__ void operator()(const f32x4 (&acc)[2][2][4][2], const Unit& u, int wr, int wc, int fr, int fq) const {
        const int e = u.pn >> 2, pl = u.pn & 3; const int row0 = u.pm * BM + wr * 64 + fr, col0 = pl * BM + wc * 32 + 8 * fq;
        f32x4 bv[2][2];
#pragma unroll
        for (int bj = 0; bj < 2; ++bj)
#pragma unroll
            for (int n = 0; n < 2; ++n) bv[bj][n] = *(const f32x4*)(bd + (size_t)e * 1024 + col0 + bj * HALF + 4 * n);
#pragma unroll
        for (int ai = 0; ai < 2; ++ai)
#pragma unroll
            for (int m = 0; m < 4; ++m) { const int row = row0 + ai * HALF + m * 16; const int tk = rowtok[row]; const float gt = rowg[row];
                if (tk >= 0) { bf16_t* rowp = YK + (size_t)tk * 1024 + col0;
#pragma unroll
                    for (int bj = 0; bj < 2; ++bj) { const f32x4 v0 = (acc[ai][bj][m][0] + bv[bj][0]) * gt, v1 = (acc[ai][bj][m][1] + bv[bj][1]) * gt;
                        u32x4 w; w.x = cvt_pk_bf16(v0[0], v0[1]); w.y = cvt_pk_bf16(v0[2], v0[3]); w.z = cvt_pk_bf16(v1[0], v1[1]); w.w = cvt_pk_bf16(v1[2], v1[3]);
                        *(u32x4*)(rowp + bj * HALF) = w; } } }
    }
};

template <class Epi, class Sched, bool ALIGN_EPI = false, bool SP2 = false>
__device__ __forceinline__ void gemm_phase(PG8_LAS unsigned char* lds, const Gemm g, const Sched& S, const Epi& E) {
    const int tid = threadIdx.x, wid = __builtin_amdgcn_readfirstlane(tid >> 6), lane = tid & 63, wr = wid >> 2, wc = wid & 3, fr = lane & 15, fq = lane >> 4;
    const int K = g.K, nt = K / BK;
    unsigned voffA[2], voffB[2];
#pragma unroll
    for (int i = 0; i < 2; ++i) { int R, C; stage_rc(tid * 16 + i * 8192, R, C); const int Rb = Epi::PERM ? ((R & ~31) + perm32(R & 31)) : R;
        voffA[i] = (unsigned)(R * K + C) * 2u; voffB[i] = (unsigned)(Rb * K + C) * 2u; }
    const size_t kstep = (size_t)(BK * 2);
    const size_t hstep = (size_t)HALF * K * 2;
    const size_t tstep = 2 * hstep;
    const unsigned ldsw = (unsigned)wid * 1024u;
    const int aoff = lds_byte(wr * 64 + fr, fq * 8), boff = lds_byte(wc * 32 + fr, fq * 8);
#define PG8_SA(b, h) (((b) * 2 + (h)) * HTB)
#define PG8_SB(b, h) ((4 + (b) * 2 + (h)) * HTB)
#define PG8_STAGE(bufoff, gbase, voff) do { _Pragma("unroll") for (int _i = 0; _i < 2; ++_i) \
        __builtin_amdgcn_global_load_lds((const unsigned*)((const char*)(gbase) + (voff)[_i]), (PG8_LAS unsigned*)(lds + (bufoff) + ldsw + _i * 8192), 16, 0, 0); } while (0)
#define PG8_LDA(dst, b, h) do { _Pragma("unroll") for (int m = 0; m < 4; ++m) _Pragma("unroll") for (int k = 0; k < 2; ++k) dst[m][k] = *(const PG8_LAS bf16x8*)(lds + PG8_SA(b, h) + aoff + m * 2048 + k * 1024); } while (0)
#define PG8_LDB(dst, b, h) do { _Pragma("unroll") for (int n = 0; n < 2; ++n) _Pragma("unroll") for (int k = 0; k < 2; ++k) dst[n][k] = *(const PG8_LAS bf16x8*)(lds + PG8_SB(b, h) + boff + n * 2048 + k * 1024); } while (0)
#define PG8_MMA(ai, bj, At, Bt) do { __builtin_amdgcn_s_setprio(1); _Pragma("unroll") for (int m = 0; m < 4; ++m) _Pragma("unroll") for (int n = 0; n < 2; ++n) _Pragma("unroll") for (int k = 0; k < 2; ++k) \
        acc[ai][bj][m][n] = __builtin_amdgcn_mfma_f32_16x16x32_bf16(Bt[n][k], At[m][k], acc[ai][bj][m][n], 0, 0, 0); __builtin_amdgcn_s_setprio(0); } while (0)
#define PG8_WAIT_V(n) asm volatile("s_waitcnt vmcnt(" #n ")" ::: "memory")
#define PG8_WAIT_L(n) asm volatile("s_waitcnt lgkmcnt(" #n ")" ::: "memory")
#define PG8_BAR __builtin_amdgcn_s_barrier()
#define PG8_SCHED __builtin_amdgcn_sched_barrier(0)
    Unit cur, nxt; int ui = 0;
    if (!S.next(0, cur)) return;
    f32x4 acc[2][2][4][2];
#pragma unroll
    for (int a = 0; a < 2; ++a)
#pragma unroll
        for (int b = 0; b < 2; ++b)
#pragma unroll
            for (int m = 0; m < 4; ++m)
#pragma unroll
                for (int n = 0; n < 2; ++n) acc[a][b][m][n] = (f32x4){0.f, 0.f, 0.f, 0.f};
    bf16x8 At[4][2], B0[2][2], B1[2][2];
    const char* cA = (const char*)g.A + (size_t)cur.pm * tstep; const char* cB = (const char*)g.Bt + (size_t)cur.pn * tstep;
    S.a_ready(cur);
    if constexpr (SP2) {
        PG8_STAGE(PG8_SB(0, 0), cB, voffB); PG8_STAGE(PG8_SB(0, 1), cB + hstep, voffB); PG8_STAGE(PG8_SA(0, 0), cA, voffA); PG8_STAGE(PG8_SA(0, 1), cA + hstep, voffA);
        if (wr == 1) PG8_BAR;
        PG8_WAIT_V(2); PG8_BAR;
        PG8_STAGE(PG8_SB(1, 0), cB + kstep, voffB); PG8_STAGE(PG8_SA(1, 0), cA + kstep, voffA); PG8_STAGE(PG8_SB(1, 1), cB + hstep + kstep, voffB);
        PG8_WAIT_V(6); PG8_BAR;
    } else {
        PG8_STAGE(PG8_SB(0, 0), cB, voffB); PG8_STAGE(PG8_SA(0, 0), cA, voffA); PG8_STAGE(PG8_SB(0, 1), cB + hstep, voffB); PG8_STAGE(PG8_SA(0, 1), cA + hstep, voffA);
        if (wr == 1) PG8_BAR;
        PG8_WAIT_V(4); PG8_BAR;
        PG8_STAGE(PG8_SB(1, 0), cB + kstep, voffB); PG8_STAGE(PG8_SA(1, 0), cA + kstep, voffA); PG8_STAGE(PG8_SB(1, 1), cB + hstep + kstep, voffB);
        PG8_WAIT_V(6); PG8_BAR;
    }
    for (;;) {
        const bool has_next = S.next(ui + 1, nxt);
        const char* nA = has_next ? (const char*)g.A + (size_t)nxt.pm * tstep : cA; const char* nB = has_next ? (const char*)g.Bt + (size_t)nxt.pn * tstep : cB;
        for (int t = 0; t < nt; t += 2) {
            const bool last = (t == nt - 2);
            const char* a1 = cA + (size_t)(t + 1) * kstep;
            const char* a2 = last ? nA : cA + (size_t)(t + 2) * kstep; const char* b2 = last ? nB : cB + (size_t)(t + 2) * kstep;
            const char* a3 = a2 + kstep; const char* b3 = b2 + kstep;
            if (last && has_next) S.a_ready(nxt);
            if constexpr (SP2) {
            PG8_LDB(B0, 0, 0); PG8_LDB(B1, 0, 1); PG8_SCHED; PG8_LDA(At, 0, 0); PG8_STAGE(PG8_SA(1, 1), a1 + hstep, voffA);
            PG8_WAIT_V(8); PG8_WAIT_L(0); PG8_BAR; PG8_MMA(0, 0, At, B0); PG8_MMA(0, 1, At, B1); PG8_BAR; PG8_SCHED;
            PG8_LDA(At, 0, 1); PG8_STAGE(PG8_SB(0, 0), b2, voffB); PG8_STAGE(PG8_SB(0, 1), b2 + hstep, voffB); PG8_STAGE(PG8_SA(0, 0), a2, voffA);
            PG8_WAIT_V(8); PG8_WAIT_L(0); PG8_BAR; PG8_MMA(1, 0, At, B0); PG8_MMA(1, 1, At, B1); PG8_BAR; PG8_SCHED;
            PG8_LDB(B0, 1, 0); PG8_LDB(B1, 1, 1); PG8_SCHED; PG8_LDA(At, 1, 0); PG8_STAGE(PG8_SA(0, 1), a2 + hstep, voffA);
            PG8_WAIT_V(8); PG8_WAIT_L(0); PG8_BAR; PG8_MMA(0, 0, At, B0); PG8_MMA(0, 1, At, B1); PG8_BAR; PG8_SCHED;
            PG8_LDA(At, 1, 1); PG8_STAGE(PG8_SB(1, 0), b3, voffB); PG8_STAGE(PG8_SB(1, 1), b3 + hstep, voffB); PG8_STAGE(PG8_SA(1, 0), a3, voffA);
            PG8_WAIT_V(8); PG8_WAIT_L(0); PG8_BAR; PG8_MMA(1, 0, At, B0); PG8_MMA(1, 1, At, B1); PG8_BAR; PG8_SCHED;
            } else {
            PG8_LDB(B0, 0, 0); PG8_SCHED; PG8_LDA(At, 0, 0); PG8_STAGE(PG8_SA(1, 1), a1 + hstep, voffA);
            PG8_WAIT_L(8); PG8_BAR; PG8_WAIT_L(0); PG8_MMA(0, 0, At, B0); PG8_BAR; PG8_SCHED;
            PG8_LDB(B1, 0, 1); PG8_STAGE(PG8_SB(0, 0), b2, voffB);
            PG8_BAR; PG8_WAIT_L(0); PG8_MMA(0, 1, At, B1); PG8_BAR;
            PG8_LDA(At, 0, 1); PG8_STAGE(PG8_SA(0, 0), a2, voffA);
            PG8_BAR; PG8_WAIT_L(0); PG8_MMA(1, 0, At, B0); PG8_BAR; PG8_SCHED;
            PG8_STAGE(PG8_SB(0, 1), b2 + hstep, voffB);
            PG8_WAIT_V(6); PG8_BAR; PG8_MMA(1, 1, At, B1); PG8_BAR;
            PG8_LDB(B0, 1, 0); PG8_SCHED; PG8_LDA(At, 1, 0); PG8_STAGE(PG8_SA(0, 1), a2 + hstep, voffA);
            PG8_WAIT_L(8); PG8_BAR; PG8_WAIT_L(0); PG8_MMA(0, 0, At, B0); PG8_BAR; PG8_SCHED;
            PG8_LDB(B1, 1, 1); PG8_STAGE(PG8_SB(1, 0), b3, voffB);
            PG8_BAR; PG8_WAIT_L(0); PG8_MMA(0, 1, At, B1); PG8_BAR;
            PG8_LDA(At, 1, 1); PG8_STAGE(PG8_SA(1, 0), a3, voffA);
            PG8_BAR; PG8_WAIT_L(0); PG8_MMA(1, 0, At, B0); PG8_BAR; PG8_SCHED;
            PG8_STAGE(PG8_SB(1, 1), b3 + hstep, voffB);
            PG8_WAIT_V(6); PG8_BAR; PG8_MMA(1, 1, At, B1); PG8_BAR;
            }
        }
        if constexpr (ALIGN_EPI) { if (wr == 0) PG8_BAR; }
        if constexpr (!Epi::AFTER_DRAIN) { E(acc, cur, wr, wc, fr, fq); S.done(cur); }
        if (!has_next) break;
#pragma unroll
        for (int a = 0; a < 2; ++a)
#pragma unroll
            for (int b = 0; b < 2; ++b)
#pragma unroll
                for (int m = 0; m < 4; ++m)
#pragma unroll
                    for (int n = 0; n < 2; ++n) acc[a][b][m][n] = (f32x4){0.f, 0.f, 0.f, 0.f};
        cur = nxt; cA = nA; cB = nB; ++ui;
        if constexpr (ALIGN_EPI) { if (wr == 1) PG8_BAR; }
    }
    PG8_WAIT_V(0);
    if constexpr (!ALIGN_EPI) { if (wr == 0) PG8_BAR; }
    PG8_BAR;
    if constexpr (Epi::AFTER_DRAIN) { E.fused(acc, cur, wr, wc, fr, fq, lds, wid, lane); S.done(cur); }
#undef PG8_SA
#undef PG8_SB
#undef PG8_STAGE
#undef PG8_LDA
#undef PG8_LDB
#undef PG8_MMA
#undef PG8_WAIT_V
#undef PG8_WAIT_L
#undef PG8_BAR
#undef PG8_SCHED
}
}

#ifndef PG8_SP2
#define PG8_SP2 true
#endif
#ifndef PG8_ALIGN
#define PG8_ALIGN true
#endif
#define GAS __attribute__((address_space(1)))
#define LAS __attribute__((address_space(3)))
typedef unsigned short bf16;
typedef unsigned v4u __attribute__((ext_vector_type(4)));
typedef float f32x4 __attribute__((ext_vector_type(4)));
typedef short bf16x8 __attribute__((ext_vector_type(8)));
typedef GAS unsigned gu32;
typedef GAS unsigned long long gu64;
#define RLX_AGENT __ATOMIC_RELAXED, __HIP_MEMORY_SCOPE_AGENT
#define LDS_WAIT() asm volatile("s_waitcnt lgkmcnt(0)" ::: "memory")
#define VM_WAIT() asm volatile("s_waitcnt vmcnt(0)" ::: "memory")
__device__ __forceinline__ unsigned long long rt() { return __builtin_amdgcn_s_memrealtime(); }
__device__ __forceinline__ unsigned f2bf(float f) { unsigned u = __builtin_bit_cast(unsigned, f); return (u + 0x7fffu + ((u >> 16) & 1u)) >> 16; }
__device__ __forceinline__ unsigned pk2(float lo, float hi) { return f2bf(lo) | (f2bf(hi) << 16); }

#define XB_TMO      128
#define XB_XCNT(j)  (256  + 64 * (j))
#define XB_XSUB(j)  (1280 + 64 * (j))
#define XB_XGEN(j)  (2304 + 64 * (j))
#define XB_TOP      3328
#define XB_TOPGEN   3392
#define XCD_BAR_WORDS 3456
#define XB_SPIN_CAP (1u << 18)

__device__ __forceinline__ unsigned xb_ld(unsigned* p)              { return __hip_atomic_load(p, __ATOMIC_RELAXED, __HIP_MEMORY_SCOPE_AGENT); }
__device__ __forceinline__ unsigned xb_add(unsigned* p, unsigned v) { return __hip_atomic_fetch_add(p, v, __ATOMIC_RELAXED, __HIP_MEMORY_SCOPE_AGENT); }
__device__ __forceinline__ unsigned xb_xcc_id() { return (unsigned)__builtin_amdgcn_s_getreg((3 << 11) | 20) & 0xFu; }
#define XB_SPIN(cond, bar) do { unsigned _sp = 0; while (cond) { __builtin_amdgcn_s_sleep(1); \
    if ((++_sp & 255u) == 0u) { if (xb_ld(&(bar)[XB_TMO])) break; if (_sp > XB_SPIN_CAP) { atomicAdd(&(bar)[XB_TMO], 1u); break; } } } } while (0)

struct XcdBarrier {
    unsigned* bar; unsigned x;
    volatile LAS unsigned* st;
};

__device__ __forceinline__ XcdBarrier xcd_barrier_post(unsigned* bar, volatile LAS unsigned* st) {
    XcdBarrier b; b.bar = bar; b.x = xb_xcc_id(); b.st = st;
    if (threadIdx.x == 0) (void)xb_add(&bar[XB_XCNT(b.x)], 1u);
    return b;
}
__device__ __forceinline__ void xcd_barrier_complete(unsigned* bar, unsigned x, unsigned& nloc, unsigned& nx) {
    const unsigned G = gridDim.x * gridDim.y * gridDim.z;
    unsigned sum, cnt, mine, sp = 0u;
    for (;;) {
        sum = 0u; cnt = 0u; mine = 0u;
#pragma unroll
        for (unsigned j = 0; j < 16; ++j) { const unsigned c = xb_ld(&bar[XB_XCNT(j)]); sum += c; cnt += (c > 0u) ? 1u : 0u; mine = (j == x) ? c : mine; }
        if (sum == G) break;
        __builtin_amdgcn_s_sleep(1);
        if ((++sp & 255u) == 0u) { if (xb_ld(&bar[XB_TMO])) break; if (sp > XB_SPIN_CAP) { atomicAdd(&bar[XB_TMO], 1u); break; } }
    }
    nloc = mine > 0u ? mine : 1u; nx = cnt > 0u ? cnt : 1u;
}

__device__ __forceinline__ void xcd_barrier(const XcdBarrier& b) {
    asm volatile("s_waitcnt vmcnt(0)" ::: "memory");
    __syncthreads();
    if (threadIdx.x == 0) {
        unsigned* bar = b.bar;
        __builtin_amdgcn_s_waitcnt(0);
        unsigned nloc = b.st[0], nx = b.st[1];
        if (nloc == 0u) { xcd_barrier_complete(bar, b.x, nloc, nx); b.st[0] = nloc; b.st[1] = nx; }
        const unsigned old = xb_add(&bar[XB_XSUB(b.x)], 1u);
        const unsigned gen = old / nloc;
        if (old + 1u == (gen + 1u) * nloc) {
            __builtin_amdgcn_fence(__ATOMIC_RELEASE, "agent");
            asm volatile("s_waitcnt vmcnt(0)" ::: "memory");
            const unsigned og = xb_add(&bar[XB_TOP], 1u);
            const unsigned tg = og / nx;
            if (og + 1u == (tg + 1u) * nx) xb_add(&bar[XB_TOPGEN], 1u);
            else XB_SPIN(xb_ld(&bar[XB_TOPGEN]) == tg, bar);
            __builtin_amdgcn_fence(__ATOMIC_ACQUIRE, "agent");
            xb_add(&bar[XB_XGEN(b.x)], 1u);
            asm volatile("s_waitcnt vmcnt(0)" ::: "memory");
        } else {
            XB_SPIN(xb_ld(&bar[XB_XGEN(b.x)]) == gen, bar);
            __builtin_amdgcn_fence(__ATOMIC_ACQUIRE, "agent");
            asm volatile("s_waitcnt vmcnt(0)" ::: "memory");
        }
    }
    __syncthreads();
}

constexpr int NWAVES = 8;
#ifndef MK_ONE_LAUNCH
#define MK_ONE_LAUNCH 0
#endif

constexpr int BATCH = 16, SEQ = 2048, D = 1024, T = BATCH * SEQ;
constexpr int NIN = 3584;
constexpr int OFF_SQ = 0, OFF_SK = 512, OFF_SV = 1024, OFF_HQ = 1536, OFF_HF = 2048, OFF_HI = 2560, OFF_HG = 3072;
constexpr int NE = 32, TOPK = 4, NASSIGN = T * TOPK;
constexpr int MAXTILES = NASSIGN / 256 + NE;
constexpr int MAXROWS = MAXTILES * 256;
constexpr float EPS = 1e-6f;

constexpr size_t MiB = 1u << 20;
constexpr size_t WS_CTL = 0, CTL_ZERO_BYTES = 1 * MiB;
constexpr size_t WS_WIN = 2 * MiB;
constexpr size_t WS_WOUT = 10 * MiB;
constexpr size_t WS_TAB = 12 * MiB;
constexpr size_t WS_WGU = 16 * MiB;
constexpr size_t WS_WD = 144 * MiB;
constexpr size_t WS_XN = 208 * MiB;
constexpr size_t WS_P = 272 * MiB;
constexpr size_t WS_MIX = 496 * MiB;
constexpr size_t WS_ACT = 272 * MiB;
constexpr size_t WS_XB = 560 * MiB;
constexpr size_t WS_HGO = 560 * MiB;
constexpr size_t WS_YK = 560 * MiB;
constexpr size_t WS_END = 832 * MiB;
constexpr size_t TB_ASG = WS_TAB;
constexpr size_t TB_TOPG = WS_TAB + 1 * MiB;
constexpr size_t TB_ROWTOK = WS_TAB + 2 * MiB;
constexpr size_t TB_ROWG = WS_TAB + 3 * MiB;
constexpr size_t TB_TILE = WS_TAB + 3 * MiB + 768 * 1024;
static_assert(TB_ROWTOK + (size_t)MAXROWS * 4 <= TB_ROWG && TB_ROWG + (size_t)MAXROWS * 4 <= TB_TILE && TB_TILE + 4096 <= WS_WGU, "table map");
static_assert(WS_ACT + (size_t)MAXROWS * 2048 <= WS_XB && WS_XB + (size_t)MAXROWS * 2048 <= WS_END && WS_MIX + (size_t)T * 2048 <= WS_XB, "d_ws map");
constexpr int CW_TMO = 0, CW_CODE = 1;
constexpr int CW_CNT = 64;
constexpr int CW_BAR = 4096;

constexpr int RING_OFF = 0, RING_BYTES = 131072;
constexpr int LDSCTL_OFF = RING_BYTES, MISC_OFF = LDSCTL_OFF + 320;
constexpr int LTAB_OFF = LDSCTL_OFF + 512;
constexpr int LDS_BYTES = 147456;
static_assert(MISC_OFF + 128 <= LTAB_OFF && LTAB_OFF + (1 + MAXTILES) * 4 <= LDS_BYTES, "LDS map");

struct Frame {
    LAS unsigned char* lds;
    volatile LAS unsigned* MISC;
    gu32* ctl;
    int tid, lane, wave, gw, ngw;
    int vcu, G;
    const float *x, *norm1_g, *w_in, *sb_q_g, *sb_k_g, *sb_out_g, *hg_lb, *hg_out_g, *w_out, *norm2_g, *w_router, *b_router, *w_gu, *b_gu, *w_d, *b_d;
    float* out;
    unsigned char* ws;
};
__device__ __forceinline__ float bf2f(unsigned short b) { return __builtin_bit_cast(float, (unsigned)b << 16); }
__device__ __forceinline__ float bflo(unsigned w) { return __builtin_bit_cast(float, w << 16); }
__device__ __forceinline__ float bfhi(unsigned w) { return __builtin_bit_cast(float, w & 0xffff0000u); }
__device__ __forceinline__ int vzero() { int z; asm volatile("v_mov_b32 %0, 0" : "=v"(z)); return z; }
__device__ __forceinline__ float wave_sum(float v) {
#pragma unroll
    for (int o = 1; o < 64; o <<= 1) v += __shfl_xor(v, o);
    return v;
}

__device__ __forceinline__ void p0_transpose_item(const float* W, int K, int N, bf16* WT, int k0, int n0, int drow0, LAS float* scr, int lane) {
#pragma unroll 8
    for (int i = 0; i < 32; ++i) { const int kk = 2 * i + (lane >> 5); scr[kk * 33 + (lane & 31)] = W[(size_t)(k0 + kk) * N + n0 + (lane & 31)]; }
    LDS_WAIT(); asm volatile("" ::: "memory");
    const int c = lane & 7;
#pragma unroll
    for (int j = 0; j < 4; ++j) { const int n = (lane >> 3) + 8 * j; const LAS float* s = scr + (8 * c) * 33 + n;
        v4u o; o.x = pk2(s[0 * 33], s[1 * 33]); o.y = pk2(s[2 * 33], s[3 * 33]); o.z = pk2(s[4 * 33], s[5 * 33]); o.w = pk2(s[6 * 33], s[7 * 33]);
        *(GAS v4u*)(WT + (size_t)(drow0 + n) * K + k0 + 8 * c) = o; }
    LDS_WAIT(); asm volatile("" ::: "memory");
}
__device__ __forceinline__ void rms_row_to_bf16(const float* xrow, const float* g, bf16* orow, int lane) {
    const GAS f32x4* xr = (const GAS f32x4*)xrow + lane; const f32x4* gr = (const f32x4*)g + lane;
    f32x4 v[4]; float s = 0.f;
#pragma unroll
    for (int j = 0; j < 4; ++j) { v[j] = xr[64 * j]; s += (v[j].x * v[j].x + v[j].y * v[j].y) + (v[j].z * v[j].z + v[j].w * v[j].w); }
    const float rstd = 1.f / sqrtf(wave_sum(s) * (1.f / D) + EPS);
    GAS unsigned long long* o8 = (GAS unsigned long long*)orow + lane;
#pragma unroll
    for (int j = 0; j < 4; ++j) { const f32x4 gg = gr[64 * j];
        o8[64 * j] = (unsigned long long)pk2(v[j].x * rstd * gg.x, v[j].y * rstd * gg.y) | ((unsigned long long)pk2(v[j].z * rstd * gg.z, v[j].w * rstd * gg.w) << 32); }
}
__device__ __forceinline__ void p0_prologue(Frame& F) {
    LAS float* scr = (LAS float*)(F.lds + RING_OFF + F.wave * 16384);
    constexpr int I_IN = 16 * (NIN / 32), I_OUT = 16 * 32, I_GU = NE * 16 * 64, I_D = NE * 16 * 32;
    constexpr int NITEMS = I_IN + I_OUT + I_GU + I_D;
    for (int it = F.gw; it < NITEMS; it += F.ngw) {
        int r = it;
        if (r < I_IN) { const int nb = NIN / 32, kb = r / nb, nn = r % nb; p0_transpose_item(F.w_in, D, NIN, (bf16*)(F.ws + WS_WIN), 64 * kb, 32 * nn, 32 * nn, scr, F.lane); continue; } r -= I_IN;
        if (r < I_OUT) { const int kb = r / 32, nn = r % 32; p0_transpose_item(F.w_out, D, D, (bf16*)(F.ws + WS_WOUT), 64 * kb, 32 * nn, 32 * nn, scr, F.lane); continue; } r -= I_OUT;
        if (r < I_GU) { const int e = r / 1024, q = r % 1024, kb = q / 64, nn = q % 64;
            const int isup = nn >> 5, a = (nn & 31) * 32;
            const int drow = 256 * (a >> 7) + 128 * isup + (a & 127);
            p0_transpose_item(F.w_gu + (size_t)e * D * 2048, D, 2048, (bf16*)(F.ws + WS_WGU) + (size_t)e * 2048 * D, 64 * kb, 32 * nn, drow, scr, F.lane); continue; } r -= I_GU;
        { const int e = r / 512, q = r % 512, kb = q / 32, nn = q % 32;
            p0_transpose_item(F.w_d + (size_t)e * D * D, D, D, (bf16*)(F.ws + WS_WD) + (size_t)e * D * D, 64 * kb, 32 * nn, 32 * nn, scr, F.lane); }
    }
    for (int m = F.gw; m < T; m += F.ngw) rms_row_to_bf16(F.x + (size_t)m * D, F.norm1_g, (bf16*)(F.ws + WS_XN) + (size_t)m * D, F.lane);
    { int* rt = (int*)(F.ws + TB_ROWTOK); for (int i = F.gw * 64 + F.lane; i < MAXROWS; i += F.ngw * 64) rt[i] = -1; }
}

__device__ __forceinline__ void qknorm_phase(Frame& F) {
    bf16* P = (bf16*)(F.ws + WS_P);
    for (int t = F.gw; t < T; t += F.ngw) {
#pragma unroll
        for (int which = 0; which < 2; ++which) {
            GAS v4u* p = (GAS v4u*)(P + (size_t)t * NIN + (which ? OFF_SK : OFF_SQ)) + F.lane;
            const v4u raw = *p; float v[8];
            v[0] = bflo(raw.x); v[1] = bfhi(raw.x); v[2] = bflo(raw.y); v[3] = bfhi(raw.y); v[4] = bflo(raw.z); v[5] = bfhi(raw.z); v[6] = bflo(raw.w); v[7] = bfhi(raw.w);
            float s = 0.f;
#pragma unroll
            for (int j = 0; j < 8; ++j) s += v[j] * v[j];
            s += __shfl_xor(s, 1); s += __shfl_xor(s, 2); s += __shfl_xor(s, 4);
            const float r = (1.f / sqrtf(s * (1.f / 64.f) + EPS)) * (which ? 1.0f : 0.125f);
            const float* g = (which ? F.sb_k_g : F.sb_q_g) + (F.lane & 7) * 8;
            v4u o; o.x = pk2(v[0] * r * g[0], v[1] * r * g[1]); o.y = pk2(v[2] * r * g[2], v[3] * r * g[3]); o.z = pk2(v[4] * r * g[4], v[5] * r * g[5]); o.w = pk2(v[6] * r * g[6], v[7] * r * g[7]);
            *p = o;
        }
    }
}

__device__ __forceinline__ void attn_naive_item(Frame& F, int bh, int qb) {
    const int b = bh >> 3, h = bh & 7, t = qb * 64 + F.lane;
    const bf16* Pb = (const bf16*)(F.ws + WS_P) + (size_t)b * SEQ * NIN;
    float q[64], o[64];
    { const GAS v4u* qp = (const GAS v4u*)(Pb + (size_t)t * NIN + OFF_SQ + h * 64);
#pragma unroll
        for (int c = 0; c < 8; ++c) { const v4u r = qp[c]; q[8 * c + 0] = bflo(r.x); q[8 * c + 1] = bfhi(r.x); q[8 * c + 2] = bflo(r.y); q[8 * c + 3] = bfhi(r.y); q[8 * c + 4] = bflo(r.z); q[8 * c + 5] = bfhi(r.z); q[8 * c + 6] = bflo(r.w); q[8 * c + 7] = bfhi(r.w); } }
#pragma unroll
    for (int d = 0; d < 64; ++d) o[d] = 0.f;
    float C = 0.f; const int vz = vzero();
    for (int s = qb * 64 + 62; s >= 0; --s) {
        const GAS v4u* kp = (const GAS v4u*)(Pb + (size_t)s * NIN + OFF_SK + h * 64) + vz;
        const GAS v4u* vp = (const GAS v4u*)(Pb + (size_t)s * NIN + OFF_SV + h * 64) + vz;
        float z = 0.f;
#pragma unroll
        for (int c = 0; c < 8; ++c) { const v4u r = kp[c];
            z += q[8 * c + 0] * bflo(r.x) + q[8 * c + 1] * bfhi(r.x) + q[8 * c + 2] * bflo(r.y) + q[8 * c + 3] * bfhi(r.y) + q[8 * c + 4] * bflo(r.z) + q[8 * c + 5] * bfhi(r.z) + q[8 * c + 6] * bflo(r.w) + q[8 * c + 7] * bfhi(r.w); }
        const float sp = fmaxf(z, 0.f) + __logf(1.f + __expf(-fabsf(z)));
        const bool act = s < t;
        const float w = act ? __expf(z - sp - C) : 0.f;
        C += act ? sp : 0.f;
#pragma unroll
        for (int c = 0; c < 8; ++c) { const v4u r = vp[c];
            o[8 * c + 0] += w * bflo(r.x); o[8 * c + 1] += w * bfhi(r.x); o[8 * c + 2] += w * bflo(r.y); o[8 * c + 3] += w * bfhi(r.y); o[8 * c + 4] += w * bflo(r.z); o[8 * c + 5] += w * bfhi(r.z); o[8 * c + 6] += w * bflo(r.w); o[8 * c + 7] += w * bfhi(r.w); }
    }
    float ss = 0.f;
#pragma unroll
    for (int d = 0; d < 64; ++d) ss += o[d] * o[d];
    const float r = 1.f / sqrtf(ss * (1.f / 64.f) + EPS);
    const float* g = F.sb_out_g + h * 64;
    GAS v4u* op = (GAS v4u*)((bf16*)(F.ws + WS_MIX) + ((size_t)b * SEQ + t) * D + h * 64);
#pragma unroll
    for (int c = 0; c < 8; ++c) { v4u w4; w4.x = pk2(o[8 * c + 0] * r * g[8 * c + 0], o[8 * c + 1] * r * g[8 * c + 1]); w4.y = pk2(o[8 * c + 2] * r * g[8 * c + 2], o[8 * c + 3] * r * g[8 * c + 3]);
        w4.z = pk2(o[8 * c + 4] * r * g[8 * c + 4], o[8 * c + 5] * r * g[8 * c + 5]); w4.w = pk2(o[8 * c + 6] * r * g[8 * c + 6], o[8 * c + 7] * r * g[8 * c + 7]); op[c] = w4; }
}
__device__ __forceinline__ void attn_naive_phase(Frame& F) {
    for (int it = F.gw; it < 2048; it += F.ngw) { const int bh = it & 127, j = it >> 7;
        attn_naive_item(F, bh, 31 - j); attn_naive_item(F, bh, j); }
}

__device__ __forceinline__ void hgrn_naive_phase(Frame& F) {
    LAS float* sc = (LAS float*)(F.lds + RING_OFF + F.wave * 16384);
    const bf16* P = (const bf16*)(F.ws + WS_P); float* HGO = (float*)(F.ws + WS_HGO);
    for (int it = F.gw; it < 128; it += F.ngw) {
        const int bh = it >> 1, half = it & 1, b = bh >> 2, h = bh & 3;
        float S[128];
#pragma unroll
        for (int d = 0; d < 128; ++d) S[d] = 0.f;
        float lb[2];
#pragma unroll
        for (int j = 0; j < 2; ++j) { const int c = h * 128 + F.lane + 64 * j; lb[j] = 1.f / (1.f + __expf(F.hg_lb[512 + c] - F.hg_lb[c])); }
        for (int t = 0; t < SEQ; ++t) {
            const bf16* row = P + ((size_t)b * SEQ + t) * NIN;
#pragma unroll
            for (int j = 0; j < 2; ++j) { const int d = F.lane + 64 * j; const float ff = bf2f(row[OFF_HF + h * 128 + d]); const float sg = 1.f / (1.f + __expf(-ff));
                sc[d] = lb[j] + (1.f - lb[j]) * sg; sc[128 + d] = (1.f - lb[j]) * (1.f - sg); sc[256 + d] = bf2f(row[OFF_HQ + h * 128 + d]); }
            const float v = bf2f(row[OFF_HI + h * 128 + half * 64 + F.lane]);
            LDS_WAIT(); asm volatile("" ::: "memory");
            float o = 0.f;
#pragma unroll
            for (int d4 = 0; d4 < 32; ++d4) { const f32x4 f4 = *(const LAS f32x4*)(sc + 4 * d4), k4 = *(const LAS f32x4*)(sc + 128 + 4 * d4), q4 = *(const LAS f32x4*)(sc + 256 + 4 * d4);
#pragma unroll
                for (int j = 0; j < 4; ++j) { S[4 * d4 + j] = f4[j] * S[4 * d4 + j] + k4[j] * v; o += q4[j] * S[4 * d4 + j]; } }
            HGO[((size_t)b * SEQ + t) * 512 + h * 128 + half * 64 + F.lane] = o;
            LDS_WAIT(); asm volatile("" ::: "memory");
        }
    }
}
__device__ __forceinline__ void hgnorm_phase(Frame& F) {
    const bf16* P = (const bf16*)(F.ws + WS_P); const float* HGO = (const float*)(F.ws + WS_HGO); bf16* MIX = (bf16*)(F.ws + WS_MIX);
    for (int t = F.gw; t < T; t += F.ngw) {
        const GAS f32x4* op = (const GAS f32x4*)(HGO + (size_t)t * 512) + 2 * F.lane; const f32x4 a = op[0], b2 = op[1];
        float v[8] = {a.x, a.y, a.z, a.w, b2.x, b2.y, b2.z, b2.w}; float s = 0.f;
#pragma unroll
        for (int j = 0; j < 8; ++j) s += v[j] * v[j];
        s += __shfl_xor(s, 1); s += __shfl_xor(s, 2); s += __shfl_xor(s, 4); s += __shfl_xor(s, 8);
        const float r = 1.f / sqrtf(s * (1.f / 128.f) + EPS);
        const v4u graw = *((const GAS v4u*)(P + (size_t)t * NIN + OFF_HG) + F.lane);
        float gt[8] = {bflo(graw.x), bfhi(graw.x), bflo(graw.y), bfhi(graw.y), bflo(graw.z), bfhi(graw.z), bflo(graw.w), bfhi(graw.w)};
        const float* g = F.hg_out_g + 8 * F.lane; float y[8];
#pragma unroll
        for (int j = 0; j < 8; ++j) { const float si = gt[j] / (1.f + __expf(-gt[j])); y[j] = v[j] * r * g[j] * si; }
        v4u o; o.x = pk2(y[0], y[1]); o.y = pk2(y[2], y[3]); o.z = pk2(y[4], y[5]); o.w = pk2(y[6], y[7]);
        *((GAS v4u*)(MIX + (size_t)t * D + 512) + F.lane) = o;
    }
}

__device__ __forceinline__ void router_phase(Frame& F) {
    LAS float* hs = (LAS float*)(F.lds + RING_OFF + F.wave * 16384);
    const float* X1 = F.out; bf16* H2 = (bf16*)(F.ws + WS_XN);
    int* ASG = (int*)(F.ws + TB_ASG); float* TOPG = (float*)(F.ws + TB_TOPG); unsigned* cnt = (unsigned*)(F.ctl + CW_CNT);
    const int e = F.lane & 31, kh = F.lane >> 5;
    for (int t = F.gw; t < T; t += F.ngw) {
        const GAS f32x4* xr = (const GAS f32x4*)(X1 + (size_t)t * D) + F.lane; const f32x4* gr = (const f32x4*)F.norm2_g + F.lane;
        f32x4 v[4]; float s = 0.f;
#pragma unroll
        for (int j = 0; j < 4; ++j) { v[j] = xr[64 * j]; s += (v[j].x * v[j].x + v[j].y * v[j].y) + (v[j].z * v[j].z + v[j].w * v[j].w); }
        const float rstd = 1.f / sqrtf(wave_sum(s) * (1.f / D) + EPS);
        GAS unsigned long long* o8 = (GAS unsigned long long*)(H2 + (size_t)t * D) + F.lane;
#pragma unroll
        for (int j = 0; j < 4; ++j) { const f32x4 gg = gr[64 * j]; const f32x4 hv = (f32x4){v[j].x * rstd * gg.x, v[j].y * rstd * gg.y, v[j].z * rstd * gg.z, v[j].w * rstd * gg.w};
            o8[64 * j] = (unsigned long long)pk2(hv.x, hv.y) | ((unsigned long long)pk2(hv.z, hv.w) << 32);
            *(LAS f32x4*)(hs + 4 * (F.lane + 64 * j)) = hv; }
        LDS_WAIT(); asm volatile("" ::: "memory");
        float acc = 0.f; const float* wr = F.w_router + (size_t)(512 * kh) * NE + e; const LAS float* hp = hs + 512 * kh;
#pragma unroll 8
        for (int k4 = 0; k4 < 128; ++k4) { const f32x4 h4 = *(const LAS f32x4*)(hp + 4 * k4);
            acc += h4.x * wr[(4 * k4 + 0) * NE]; acc += h4.y * wr[(4 * k4 + 1) * NE]; acc += h4.z * wr[(4 * k4 + 2) * NE]; acc += h4.w * wr[(4 * k4 + 3) * NE]; }
        acc += __shfl_xor(acc, 32);
        float val = acc + F.b_router[e];
        float sv[4]; int se[4];
#pragma unroll
        for (int r = 0; r < 4; ++r) { float bv = val; int bi = e;
#pragma unroll
            for (int off = 1; off < 32; off <<= 1) { const float ov = __shfl_xor(bv, off); const int oi = __shfl_xor(bi, off); if (ov > bv || (ov == bv && oi < bi)) { bv = ov; bi = oi; } }
            sv[r] = bv; se[r] = bi; if (e == bi) val = -__builtin_inff(); }
        const float e1 = __expf(sv[1] - sv[0]), e2 = __expf(sv[2] - sv[0]), e3 = __expf(sv[3] - sv[0]); const float inv = 1.f / (1.f + e1 + e2 + e3);
        if (F.lane < 4) { const int my_e = F.lane == 0 ? se[0] : F.lane == 1 ? se[1] : F.lane == 2 ? se[2] : se[3];
            const float my_g = (F.lane == 0 ? 1.f : F.lane == 1 ? e1 : F.lane == 2 ? e2 : e3) * inv;
            const unsigned pos = __hip_atomic_fetch_add(cnt + my_e, 1u, __ATOMIC_RELAXED, __HIP_MEMORY_SCOPE_AGENT);
            ASG[((size_t)t * 4 + F.lane) * 2] = my_e; ASG[((size_t)t * 4 + F.lane) * 2 + 1] = (int)pos; TOPG[(size_t)t * 4 + F.lane] = my_g; }
        LDS_WAIT(); asm volatile("" ::: "memory");
    }
}
__device__ __forceinline__ int expert_starts(Frame& F, int& my_cnt, int& total_tiles) {
    const int e = F.lane & 31; const int c = (int)__hip_atomic_load((unsigned*)(F.ctl + CW_CNT) + e, __ATOMIC_RELAXED, __HIP_MEMORY_SCOPE_AGENT);
    const int tl = (c + 255) >> 8; int inc = tl;
#pragma unroll
    for (int off = 1; off < 32; off <<= 1) { const int o = __shfl_up(inc, off, 32); if (e >= off) inc += o; }
    total_tiles = __shfl(inc, 31, 32); my_cnt = c; return (inc - tl) * 256;
}
__device__ __forceinline__ void gather_phase(Frame& F) {
    const bf16* H2 = (const bf16*)(F.ws + WS_XN); bf16* XB = (bf16*)(F.ws + WS_XB);
    const int* ASG = (const int*)(F.ws + TB_ASG); const float* TOPG = (const float*)(F.ws + TB_TOPG);
    int* ROWTOK = (int*)(F.ws + TB_ROWTOK); float* ROWG = (float*)(F.ws + TB_ROWG); int* TILE = (int*)(F.ws + TB_TILE);
    int my_cnt, ntiles; const int my_start = expert_starts(F, my_cnt, ntiles);
    if (F.gw == 0) {
        if (F.lane == 0) TILE[0] = ntiles;
        if (F.lane < 32) { const int t0 = my_start >> 8, nt = (my_cnt + 255) >> 8; for (int i = 0; i < nt; ++i) TILE[1 + t0 + i] = F.lane; }
    }
    const int vz = vzero();
    for (int t = F.gw; t < T; t += F.ngw) {
        const GAS v4u* src = (const GAS v4u*)(H2 + (size_t)t * D) + 2 * F.lane; const v4u a = src[0], b2 = src[1];
#pragma unroll
        for (int k = 0; k < 4; ++k) { const int e = ASG[((size_t)t * 4 + k) * 2 + vz], pos = ASG[((size_t)t * 4 + k) * 2 + 1 + vz]; const float g = TOPG[(size_t)t * 4 + k + vz];
            const int dest = __shfl(my_start, e, 64) + pos;
            GAS v4u* dst = (GAS v4u*)(XB + (size_t)dest * D) + 2 * F.lane; dst[0] = a; dst[1] = b2;
            if (F.lane == 0) { ROWTOK[dest] = t * 4 + k; ROWG[dest] = g; } }
    }
}
__device__ __forceinline__ int load_tile_table(Frame& F) {
    const int* TILE = (const int*)(F.ws + TB_TILE); LAS int* lt = (LAS int*)(F.lds + LTAB_OFF);
    for (int i = F.tid; i < 1 + MAXTILES; i += NWAVES * 64) lt[i] = TILE[i];
    __syncthreads();
    int nt = lt[0]; nt = nt < 0 ? 0 : (nt > MAXTILES ? MAXTILES : nt); return __builtin_amdgcn_readfirstlane(nt);
}
__device__ __forceinline__ void combine_phase(Frame& F) {
    const bf16* YK = (const bf16*)(F.ws + WS_YK);
    for (int t = F.gw; t < T; t += F.ngw) {
        GAS f32x4* xr = (GAS f32x4*)(F.out + (size_t)t * D) + F.lane;
#pragma unroll
        for (int j = 0; j < 4; ++j) { f32x4 v = xr[64 * j];
#pragma unroll
            for (int k = 0; k < 4; ++k) { const unsigned long long y = *((const GAS unsigned long long*)(YK + ((size_t)t * 4 + k) * D) + F.lane + 64 * j);
                const unsigned lo = (unsigned)y, hi = (unsigned)(y >> 32); v.x += bflo(lo); v.y += bfhi(lo); v.z += bflo(hi); v.w += bfhi(hi); }
            xr[64 * j] = v; }
    }
}

constexpr int NPH = 12;
struct Args { const float* in[16]; float* out; unsigned char* ws; int ph_lo, ph_hi; };
__global__ void __launch_bounds__(NWAVES * 64, 2) fwd(Args args) {
    extern __shared__ __attribute__((aligned(16))) unsigned char lds[];
    Frame F;
    F.lds = (LAS unsigned char*)lds;
    F.MISC = (volatile LAS unsigned*)(F.lds + MISC_OFF);
    F.tid = threadIdx.x; F.lane = F.tid & 63; F.wave = __builtin_amdgcn_readfirstlane(F.tid >> 6);
    F.G = gridDim.x; { const int bx = blockIdx.x; F.vcu = (F.G % 8 == 0) ? (bx % 8) * (F.G / 8) + bx / 8 : bx; }
    F.gw = blockIdx.x * NWAVES + F.wave; F.ngw = F.G * NWAVES;
    F.ws = args.ws; F.ctl = (gu32*)(args.ws + WS_CTL); F.out = args.out;
    F.x = args.in[0]; F.norm1_g = args.in[1]; F.w_in = args.in[2]; F.sb_q_g = args.in[3]; F.sb_k_g = args.in[4]; F.sb_out_g = args.in[5]; F.hg_lb = args.in[6]; F.hg_out_g = args.in[7];
    F.w_out = args.in[8]; F.norm2_g = args.in[9]; F.w_router = args.in[10]; F.b_router = args.in[11]; F.w_gu = args.in[12]; F.b_gu = args.in[13]; F.w_d = args.in[14]; F.b_d = args.in[15];
    for (int u = F.tid; u < (LDS_BYTES - LDSCTL_OFF) / 4; u += NWAVES * 64) ((LAS unsigned*)(F.lds + LDSCTL_OFF))[u] = 0u;
    __syncthreads();
    XcdBarrier bar; bar.bar = (unsigned*)(F.ctl + CW_BAR); bar.x = 0; bar.st = nullptr;
    if (MK_ONE_LAUNCH) bar = xcd_barrier_post((unsigned*)(F.ctl + CW_BAR), F.MISC + 8);
    const int lo = args.ph_lo, hi = args.ph_hi;
#define IN(k) (lo <= (k) && (k) < hi)
#define SEAM(k) do { if (IN(k) && IN((k) + 1)) xcd_barrier(bar); } while (0)

    if (IN(0)) { p0_prologue(F); } SEAM(0);
    if (IN(1)) {
        pg8::Gemm g{(const bf16*)(F.ws + WS_XN), (const bf16*)(F.ws + WS_WIN), T, NIN, D}; pg8::StaticOrder S; S.init(T, NIN, F.G, (int)blockIdx.x);
        pg8::EpiBf16<0> E{(bf16*)(F.ws + WS_P), NIN, nullptr, 0, 0, 1.f};
        pg8::gemm_phase<pg8::EpiBf16<0>, pg8::StaticOrder, PG8_ALIGN, PG8_SP2>(F.lds + RING_OFF, g, S, E);
    } SEAM(1);
    if (IN(2)) { qknorm_phase(F); } SEAM(2);
    if (IN(3)) { attn_naive_phase(F); } SEAM(3);
    if (IN(4)) { hgrn_naive_phase(F); } SEAM(4);
    if (IN(5)) { hgnorm_phase(F); } SEAM(5);
    if (IN(6)) {
        pg8::Gemm g{(const bf16*)(F.ws + WS_MIX), (const bf16*)(F.ws + WS_WOUT), T, D, D}; pg8::StaticOrder S; S.init(T, D, F.G, (int)blockIdx.x);
        pg8::EpiRes E{F.x, F.out, D};
        pg8::gemm_phase<pg8::EpiRes, pg8::StaticOrder, PG8_ALIGN, PG8_SP2>(F.lds + RING_OFF, g, S, E);
    } SEAM(6);
    if (IN(7)) { router_phase(F); } SEAM(7);
    if (IN(8)) { gather_phase(F); } SEAM(8);
    if (IN(9)) {
        const int nt = load_tile_table(F);
        pg8::Gemm g{(const bf16*)(F.ws + WS_XB), (const bf16*)(F.ws + WS_WGU), MAXROWS, NE * 2048, D};
        pg8::MoeOrder S{(const LAS int*)(F.lds + LTAB_OFF) + 1, 8, nt * 8, F.G, F.vcu};
        pg8::EpiAct E{(bf16*)(F.ws + WS_ACT), F.b_gu};
        pg8::gemm_phase<pg8::EpiAct, pg8::MoeOrder, PG8_ALIGN, PG8_SP2>(F.lds + RING_OFF, g, S, E);
    } SEAM(9);
    if (IN(10)) {
        const int nt = load_tile_table(F);
        pg8::Gemm g{(const bf16*)(F.ws + WS_ACT), (const bf16*)(F.ws + WS_WD), MAXROWS, NE * 1024, D};
        pg8::MoeOrder S{(const LAS int*)(F.lds + LTAB_OFF) + 1, 4, nt * 4, F.G, F.vcu};
        pg8::EpiDown E{(bf16*)(F.ws + WS_YK), F.b_d, (const int*)(F.ws + TB_ROWTOK), (const float*)(F.ws + TB_ROWG)};
        pg8::gemm_phase<pg8::EpiDown, pg8::MoeOrder, PG8_ALIGN, PG8_SP2>(F.lds + RING_OFF, g, S, E);
    } SEAM(10);
    if (IN(11)) { combine_phase(F); }
#undef IN
#undef SEAM
}

extern "C" void kernel_launch(void* const* d_in, const int* in_sizes, int n_in, void* d_out, int out_size, void* d_ws, size_t ws_size, hipStream_t stream) {
    static int grid = 0;
    if (grid == 0) {
        if (n_in != 16 || in_sizes[0] != T * D || out_size != T * D || ws_size < WS_END) { fprintf(stderr, "kernel_launch: shape/workspace mismatch (n_in %d, ws %zu, need %zu); nothing launched\n", n_in, ws_size, (size_t)WS_END); grid = -1; return; }
        int dev = 0, cus = 0, per_cu = 0;
        if (hipGetDevice(&dev) != hipSuccess || hipDeviceGetAttribute(&cus, hipDeviceAttributeMultiprocessorCount, dev) != hipSuccess) { grid = -1; return; }
        if (hipFuncSetAttribute((const void*)fwd, hipFuncAttributeMaxDynamicSharedMemorySize, LDS_BYTES) != hipSuccess) { grid = -1; return; }
        if (hipOccupancyMaxActiveBlocksPerMultiprocessor(&per_cu, (const void*)fwd, NWAVES * 64, LDS_BYTES) != hipSuccess || per_cu < 1) { fprintf(stderr, "kernel_launch: occupancy query says %d\n", per_cu); }
        (void)hipGetLastError();
        grid = cus;
    }
    if (grid < 0) return;
    if (hipMemsetAsync((char*)d_ws + WS_CTL, 0, CTL_ZERO_BYTES, stream) != hipSuccess) return;
    Args a{};
    for (int i = 0; i < 16; ++i) a.in[i] = (const float*)d_in[i];
    a.out = (float*)d_out; a.ws = (unsigned char*)d_ws;
#if MK_ONE_LAUNCH
    a.ph_lo = 0; a.ph_hi = NPH;
    hipLaunchKernelGGL(fwd, dim3(grid), dim3(NWAVES * 64), LDS_BYTES, stream, a);
#else
    for (int p = 0; p < NPH; ++p) { a.ph_lo = p; a.ph_hi = p + 1; hipLaunchKernelGGL(fwd, dim3(grid), dim3(NWAVES * 64), LDS_BYTES, stream, a); }
#endif
}
```

```cpp
#include <hip/hip_runtime.h>
#include <cstdio>
#include <cstdint>
namespace pg8 {
#define PG8_LAS __attribute__((address_space(3)))
typedef unsigned short bf16_t;
typedef short bf16x8 __attribute__((ext_vector_type(8)));
typedef float f32x4 __attribute__((ext_vector_type(4)));
typedef unsigned u32x4 __attribute__((ext_vector_type(4)));
constexpr int BM = 256, BK = 64, HALF = 128, HTB = HALF * BK * 2  , STAGE_BYTES = 8 * HTB, NXCD = 8, WGM = 8;

__host__ __device__ __forceinline__ int lds_byte(int r, int c) { const int st = (r >> 4) * 2 + (c >> 5), rr = r & 15, cc = c & 31, ob = rr * 64 + cc * 2; return st * 1024 + (ob ^ (((ob >> 9) & 1) << 5)); }
__host__ __device__ __forceinline__ void stage_rc(int b, int& R, int& C) { const int st = b / 1024, sb = b % 1024, swz = sb ^ (((sb >> 9) & 1) << 5); R = (st >> 1) * 16 + swz / 64; C = (st & 1) * 32 + (swz % 64) / 2; }
__host__ __device__ __forceinline__ int perm32(int rho) { const int n = rho >> 4, i = rho & 15; return 8 * (i >> 2) + 4 * n + (i & 3); }

struct Unit { int pm, pn; };
struct Gemm { const bf16_t* A; const bf16_t* Bt; int M, N, K; };

struct StaticOrder {
    int nM, nN, nwg, G, c;
    __host__ __device__ void init(int M, int N, int G_, int c_) { nM = M / BM; nN = N / BM; nwg = nM * nN; G = G_; c = c_; }
    __host__ __device__ bool next(int i, Unit& u) const {
        const long L = (long)i * G + c; if (L >= nwg) return false;
        int wgid = (int)L; { const int q = nwg / NXCD, r = nwg % NXCD, xcd = wgid % NXCD, off = wgid / NXCD; wgid = (xcd < r ? xcd * (q + 1) : r * (q + 1) + (xcd - r) * q) + off; }
        const int nig = WGM * nN, gid = wgid / nig, fm = gid * WGM, gsz = (nM - fm) < WGM ? (nM - fm) : WGM;
        u.pm = fm + ((wgid % nig) % gsz); u.pn = (wgid % nig) / gsz; return true;
    }
    __device__ __forceinline__ void a_ready(const Unit&) const {}
    __device__ __forceinline__ void done(const Unit&) const {}
};

__device__ __forceinline__ unsigned cvt_pk_bf16(float lo, float hi) { unsigned r; asm volatile("v_cvt_pk_bf16_f32 %0, %1, %2" : "=v"(r) : "v"(lo), "v"(hi)); return r; }
typedef float f32x2 __attribute__((ext_vector_type(2)));
__device__ __forceinline__ f32x2 gelu_pk(f32x2 v) {
    const f32x2 av = __builtin_elementwise_abs(v), d = av * 0.2316418882f + 1.0f;
    f32x2 t; t.x = __builtin_amdgcn_rcpf(d.x); t.y = __builtin_amdgcn_rcpf(d.y);
    f32x2 q = t * 0.5307027145f + (-0.7265760135f); q = q * t + 0.7107068705f; q = q * t + (-0.142248368f); q = q * t + 0.127414796f; q = q * t;
    const f32x2 s = (v * v) * (-0.72134752044f);
    f32x2 e; e.x = __builtin_amdgcn_exp2f(s.x); e.y = __builtin_amdgcn_exp2f(s.y);
    const f32x2 m = v * (q * e), r = v - m;
    f32x2 o; o.x = v.x < 0.f ? m.x : r.x; o.y = v.y < 0.f ? m.y : r.y; return o;
}

template <int ACT  > struct EpiBf16 {
    static constexpr bool PERM = true, AFTER_DRAIN = false; static_assert(ACT == 0 || ACT == 1, "EpiBf16: ACT is 0 (none) or 1 (gelu_pk)");
    bf16_t* O; int ldc; const float* bias; int split_cols; size_t split_stride; float scale0;
    __device__ __forceinline__ void operator()(const f32x4 (&acc)[2][2][4][2], const Unit& u, int wr, int wc, int fr, int fq) const {
        const int row0 = u.pm * BM + wr * 64 + fr; int colt = u.pn * BM; bf16_t* base = O;
        float sc = 1.f; if (split_cols) { const int t = colt / split_cols; base += (size_t)t * split_stride; colt -= t * split_cols; if (t == 0) sc = scale0; }
        const int col0 = colt + wc * 32 + 8 * fq, bcol0 = u.pn * BM + wc * 32 + 8 * fq;
        f32x4 bv[2][2];
#pragma unroll
        for (int bj = 0; bj < 2; ++bj)
#pragma unroll
            for (int n = 0; n < 2; ++n) bv[bj][n] = bias ? *(const f32x4*)(bias + bcol0 + bj * HALF + 4 * n) : (f32x4){0.f, 0.f, 0.f, 0.f};
#pragma unroll
        for (int ai = 0; ai < 2; ++ai)
#pragma unroll
            for (int m = 0; m < 4; ++m) { bf16_t* rowp = base + (size_t)(row0 + ai * HALF + m * 16) * ldc + col0;
#pragma unroll
                for (int bj = 0; bj < 2; ++bj) { f32x4 v0 = acc[ai][bj][m][0] + bv[bj][0], v1 = acc[ai][bj][m][1] + bv[bj][1];
                    if (ACT == 1) { f32x2 a = gelu_pk((f32x2){v0[0], v0[1]}), b = gelu_pk((f32x2){v0[2], v0[3]}), c = gelu_pk((f32x2){v1[0], v1[1]}), d = gelu_pk((f32x2){v1[2], v1[3]});
                        v0 = (f32x4){a.x, a.y, b.x, b.y}; v1 = (f32x4){c.x, c.y, d.x, d.y}; }
                    v0 = v0 * sc; v1 = v1 * sc; u32x4 w; w.x = cvt_pk_bf16(v0[0], v0[1]); w.y = cvt_pk_bf16(v0[2], v0[3]); w.z = cvt_pk_bf16(v1[0], v1[1]); w.w = cvt_pk_bf16(v1[2], v1[3]);
                    *(u32x4*)(rowp + bj * HALF) = w; } }
    }
};

struct EpiRes {
    static constexpr bool PERM = false, AFTER_DRAIN = false;
    const float* X; float* C; int ldc;
    __device__ __forceinline__ void operator()(const f32x4 (&acc)[2][2][4][2], const Unit& u, int wr, int wc, int fr, int fq) const {
        const int row0 = u.pm * BM + wr * 64 + fr, col0 = u.pn * BM + wc * 32 + 4 * fq;
#pragma unroll
        for (int ai = 0; ai < 2; ++ai)
#pragma unroll
            for (int m = 0; m < 4; ++m) { const size_t off = (size_t)(row0 + ai * HALF + m * 16) * ldc + col0;
#pragma unroll
                for (int bj = 0; bj < 2; ++bj)
#pragma unroll
                    for (int n = 0; n < 2; ++n) { const size_t o2 = off + bj * HALF + n * 16; *(f32x4*)(C + o2) = *(const f32x4*)(X + o2) + acc[ai][bj][m][n]; } }
    }
};
struct MoeOrder {
    const PG8_LAS int* tile_e; int ntn, nunits, G, c;
    __device__ __forceinline__ bool next(int i, Unit& u) const {
        const int L = i * G + c; if (L >= nunits) return false;
        const int pm = L / ntn, pl = L - pm * ntn; u.pm = pm; u.pn = tile_e[pm] * ntn + pl; return true;
    }
    __device__ __forceinline__ void a_ready(const Unit&) const {}
    __device__ __forceinline__ void done(const Unit&) const {}
};
struct EpiAct {
    static constexpr bool PERM = true, AFTER_DRAIN = false;
    bf16_t* ACT; const float* bgu;
    __device__ __forceinline__ void operator()(const f32x4 (&acc)[2][2][4][2], const Unit& u, int wr, int wc, int fr, int fq) const {
        const int e = u.pn >> 3, pl = u.pn & 7; const int row0 = u.pm * BM + wr * 64 + fr, acol0 = pl * 128 + wc * 32 + 8 * fq;
        f32x4 bg[2], bu[2];
#pragma unroll
        for (int n = 0; n < 2; ++n) { bg[n] = *(const f32x4*)(bgu + (size_t)e * 2048 + acol0 + 4 * n); bu[n] = *(const f32x4*)(bgu + (size_t)e * 2048 + 1024 + acol0 + 4 * n); }
#pragma unroll
        for (int ai = 0; ai < 2; ++ai)
#pragma unroll
            for (int m = 0; m < 4; ++m) { bf16_t* rowp = ACT + (size_t)(row0 + ai * HALF + m * 16) * 1024 + acol0; float a[8];
#pragma unroll
                for (int n = 0; n < 2; ++n) { const f32x4 g4 = acc[ai][0][m][n] + bg[n], u4 = acc[ai][1][m][n] + bu[n];
#pragma unroll
                    for (int j = 0; j < 4; ++j) { const float gl = fminf(g4[j], 7.0f), ul = fminf(fmaxf(u4[j], -7.0f), 7.0f);
                        const float sg = __builtin_amdgcn_rcpf(1.0f + __builtin_amdgcn_exp2f(gl * (-1.702f * 1.44269504089f))); a[4 * n + j] = gl * sg * (ul + 1.0f); } }
                u32x4 w; w.x = cvt_pk_bf16(a[0], a[1]); w.y = cvt_pk_bf16(a[2], a[3]); w.z = cvt_pk_bf16(a[4], a[5]); w.w = cvt_pk_bf16(a[6], a[7]);
                *(u32x4*)rowp = w; }
    }
};
struct EpiDown {
    static constexpr bool PERM = true, AFTER_DRAIN = false;
    bf16_t* YK; const float* bd; const int* rowtok; const float* rowg;
    __device__ __forceinline__ void operator()(const f32x4 (&acc)[2][2][4][2], const Unit& u, int wr, int wc, int fr, int fq) const {
        const int e = u.pn >> 2, pl = u.pn & 3; const int row0 = u.pm * BM + wr * 64 + fr, col0 = pl * BM + wc * 32 + 8 * fq;
        f32x4 bv[2][2];
#pragma unroll
        for (int bj = 0; bj < 2; ++bj)
#pragma unroll
            for (int n = 0; n < 2; ++n) bv[bj][n] = *(const f32x4*)(bd + (size_t)e * 1024 + col0 + bj * HALF + 4 * n);
#pragma unroll
        for (int ai = 0; ai < 2; ++ai)
#pragma unroll
            for (int m = 0; m < 4; ++m) { const int row = row0 + ai * HALF + m * 16; const int tk = rowtok[row]; const float gt = rowg[row];
                if (tk >= 0) { bf16_t* rowp = YK + (size_t)tk * 1024 + col0;
#pragma unroll
                    for (int bj = 0; bj < 2; ++bj) { const f32x4 v0 = (acc[ai][bj][m][0] + bv[bj][0]) * gt, v1 = (acc[ai][bj][m][1] + bv[bj][1]) * gt;
                        u32x4 w; w.x = cvt_pk_bf16(v0[0], v0[1]); w.y = cvt_pk_bf16(v0[2], v0[3]); w.z = cvt_pk_bf16(v1[0], v1[1]); w.w = cvt_pk_bf16(v1[2], v1[3]);
                        *(u32x4*)(rowp + bj * HALF) = w; } } }
    }
};

template <class Epi, class Sched, bool ALIGN_EPI = false, bool SP2 = false>
__device__ __forceinline__ void gemm_phase(PG8_LAS unsigned char* lds, const Gemm g, const Sched& S, const Epi& E) {
    const int tid = threadIdx.x, wid = __builtin_amdgcn_readfirstlane(tid >> 6), lane = tid & 63, wr = wid >> 2, wc = wid & 3, fr = lane & 15, fq = lane >> 4;
    const int K = g.K, nt = K / BK;
    unsigned voffA[2], voffB[2];
#pragma unroll
    for (int i = 0; i < 2; ++i) { int R, C; stage_rc(tid * 16 + i * 8192, R, C); const int Rb = Epi::PERM ? ((R & ~31) + perm32(R & 31)) : R;
        voffA[i] = (unsigned)(R * K + C) * 2u; voffB[i] = (unsigned)(Rb * K + C) * 2u; }
    const size_t kstep = (size_t)(BK * 2);
    const size_t hstep = (size_t)HALF * K * 2;
    const size_t tstep = 2 * hstep;
    const unsigned ldsw = (unsigned)wid * 1024u;
    const int aoff = lds_byte(wr * 64 + fr, fq * 8), boff = lds_byte(wc * 32 + fr, fq * 8);
#define PG8_SA(b, h) (((b) * 2 + (h)) * HTB)
#define PG8_SB(b, h) ((4 + (b) * 2 + (h)) * HTB)
#define PG8_STAGE(bufoff, gbase, voff) do { _Pragma("unroll") for (int _i = 0; _i < 2; ++_i) \
        __builtin_amdgcn_global_load_lds((const unsigned*)((const char*)(gbase) + (voff)[_i]), (PG8_LAS unsigned*)(lds + (bufoff) + ldsw + _i * 8192), 16, 0, 0); } while (0)
#define PG8_LDA(dst, b, h) do { _Pragma("unroll") for (int m = 0; m < 4; ++m) _Pragma("unroll") for (int k = 0; k < 2; ++k) dst[m][k] = *(const PG8_LAS bf16x8*)(lds + PG8_SA(b, h) + aoff + m * 2048 + k * 1024); } while (0)
#define PG8_LDB(dst, b, h) do { _Pragma("unroll") for (int n = 0; n < 2; ++n) _Pragma("unroll") for (int k = 0; k < 2; ++k) dst[n][k] = *(const PG8_LAS bf16x8*)(lds + PG8_SB(b, h) + boff + n * 2048 + k * 1024); } while (0)
#define PG8_MMA(ai, bj, At, Bt) do { __builtin_amdgcn_s_setprio(1); _Pragma("unroll") for (int m = 0; m < 4; ++m) _Pragma("unroll") for (int n = 0; n < 2; ++n) _Pragma("unroll") for (int k = 0; k < 2; ++k) \
        acc[ai][bj][m][n] = __builtin_amdgcn_mfma_f32_16x16x32_bf16(Bt[n][k], At[m][k], acc[ai][bj][m][n], 0, 0, 0); __builtin_amdgcn_s_setprio(0); } while (0)
#define PG8_WAIT_V(n) asm volatile("s_waitcnt vmcnt(" #n ")" ::: "memory")
#define PG8_WAIT_L(n) asm volatile("s_waitcnt lgkmcnt(" #n ")" ::: "memory")
#define PG8_BAR __builtin_amdgcn_s_barrier()
#define PG8_SCHED __builtin_amdgcn_sched_barrier(0)
    Unit cur, nxt; int ui = 0;
    if (!S.next(0, cur)) return;
    f32x4 acc[2][2][4][2];
#pragma unroll
    for (int a = 0; a < 2; ++a)
#pragma unroll
        for (int b = 0; b < 2; ++b)
#pragma unroll
            for (int m = 0; m < 4; ++m)
#pragma unroll
                for (int n = 0; n < 2; ++n) acc[a][b][m][n] = (f32x4){0.f, 0.f, 0.f, 0.f};
    bf16x8 At[4][2], B0[2][2], B1[2][2];
    const char* cA = (const char*)g.A + (size_t)cur.pm * tstep; const char* cB = (const char*)g.Bt + (size_t)cur.pn * tstep;
    S.a_ready(cur);
    if constexpr (SP2) {
        PG8_STAGE(PG8_SB(0, 0), cB, voffB); PG8_STAGE(PG8_SB(0, 1), cB + hstep, voffB); PG8_STAGE(PG8_SA(0, 0), cA, voffA); PG8_STAGE(PG8_SA(0, 1), cA + hstep, voffA);
        if (wr == 1) PG8_BAR;
        PG8_WAIT_V(2); PG8_BAR;
        PG8_STAGE(PG8_SB(1, 0), cB + kstep, voffB); PG8_STAGE(PG8_SA(1, 0), cA + kstep, voffA); PG8_STAGE(PG8_SB(1, 1), cB + hstep + kstep, voffB);
        PG8_WAIT_V(6); PG8_BAR;
    } else {
        PG8_STAGE(PG8_SB(0, 0), cB, voffB); PG8_STAGE(PG8_SA(0, 0), cA, voffA); PG8_STAGE(PG8_SB(0, 1), cB + hstep, voffB); PG8_STAGE(PG8_SA(0, 1), cA + hstep, voffA);
        if (wr == 1) PG8_BAR;
        PG8_WAIT_V(4); PG8_BAR;
        PG8_STAGE(PG8_SB(1, 0), cB + kstep, voffB); PG8_STAGE(PG8_SA(1, 0), cA + kstep, voffA); PG8_STAGE(PG8_SB(1, 1), cB + hstep + kstep, voffB);
        PG8_WAIT_V(6); PG8_BAR;
    }
    for (;;) {
        const bool has_next = S.next(ui + 1, nxt);
        const char* nA = has_next ? (const char*)g.A + (size_t)nxt.pm * tstep : cA; const char* nB = has_next ? (const char*)g.Bt + (size_t)nxt.pn * tstep : cB;
        for (int t = 0; t < nt; t += 2) {
            const bool last = (t == nt - 2);
            const char* a1 = cA + (size_t)(t + 1) * kstep;
            const char* a2 = last ? nA : cA + (size_t)(t + 2) * kstep; const char* b2 = last ? nB : cB + (size_t)(t + 2) * kstep;
            const char* a3 = a2 + kstep; const char* b3 = b2 + kstep;
            if (last && has_next) S.a_ready(nxt);
            if constexpr (SP2) {
            PG8_LDB(B0, 0, 0); PG8_LDB(B1, 0, 1); PG8_SCHED; PG8_LDA(At, 0, 0); PG8_STAGE(PG8_SA(1, 1), a1 + hstep, voffA);
            PG8_WAIT_V(8); PG8_WAIT_L(0); PG8_BAR; PG8_MMA(0, 0, At, B0); PG8_MMA(0, 1, At, B1); PG8_BAR; PG8_SCHED;
            PG8_LDA(At, 0, 1); PG8_STAGE(PG8_SB(0, 0), b2, voffB); PG8_STAGE(PG8_SB(0, 1), b2 + hstep, voffB); PG8_STAGE(PG8_SA(0, 0), a2, voffA);
            PG8_WAIT_V(8); PG8_WAIT_L(0); PG8_BAR; PG8_MMA(1, 0, At, B0); PG8_MMA(1, 1, At, B1); PG8_BAR; PG8_SCHED;
            PG8_LDB(B0, 1, 0); PG8_LDB(B1, 1, 1); PG8_SCHED; PG8_LDA(At, 1, 0); PG8_STAGE(PG8_SA(0, 1), a2 + hstep, voffA);
            PG8_WAIT_V(8); PG8_WAIT_L(0); PG8_BAR; PG8_MMA(0, 0, At, B0); PG8_MMA(0, 1, At, B1); PG8_BAR; PG8_SCHED;
            PG8_LDA(At, 1, 1); PG8_STAGE(PG8_SB(1, 0), b3, voffB); PG8_STAGE(PG8_SB(1, 1), b3 + hstep, voffB); PG8_STAGE(PG8_SA(1, 0), a3, voffA);
            PG8_WAIT_V(8); PG8_WAIT_L(0); PG8_BAR; PG8_MMA(1, 0, At, B0); PG8_MMA(1, 1, At, B1); PG8_BAR; PG8_SCHED;
            } else {
            PG8_LDB(B0, 0, 0); PG8_SCHED; PG8_LDA(At, 0, 0); PG8_STAGE(PG8_SA(1, 1), a1 + hstep, voffA);
            PG8_WAIT_L(8); PG8_BAR; PG8_WAIT_L(0); PG8_MMA(0, 0, At, B0); PG8_BAR; PG8_SCHED;
            PG8_LDB(B1, 0, 1); PG8_STAGE(PG8_SB(0, 0), b2, voffB);
            PG8_BAR; PG8_WAIT_L(0); PG8_MMA(0, 1, At, B1); PG8_BAR;
            PG8_LDA(At, 0, 1); PG8_STAGE(PG8_SA(0, 0), a2, voffA);
            PG8_BAR; PG8_WAIT_L(0); PG8_MMA(1, 0, At, B0); PG8_BAR; PG8_SCHED;
            PG8_STAGE(PG8_SB(0, 1), b2 + hstep, voffB);
            PG8_WAIT_V(6); PG8_BAR; PG8_MMA(1, 1, At, B1); PG8_BAR;
            PG8_LDB(B0, 1, 0); PG8_SCHED; PG8_LDA(At, 1, 0); PG8_STAGE(PG8_SA(0, 1), a2 + hstep, voffA);
            PG8_WAIT_L(8); PG8_BAR; PG8_WAIT_L(0); PG8_MMA(0, 0, At, B0); PG8_BAR; PG8_SCHED;
            PG8_LDB(B1, 1, 1); PG8_STAGE(PG8_SB(1, 0), b3, voffB);
            PG8_BAR; PG8_WAIT_L(0); PG8_MMA(0, 1, At, B1); PG8_BAR;
            PG8_LDA(At, 1, 1); PG8_STAGE(PG8_SA(1, 0), a3, voffA);
            PG8_BAR; PG8_WAIT_L(0); PG8_MMA(1, 0, At, B0); PG8_BAR; PG8_SCHED;
            PG8_STAGE(PG8_SB(1, 1), b3 + hstep, voffB);
            PG8_WAIT_V(6); PG8_BAR; PG8_MMA(1, 1, At, B1); PG8_BAR;
            }
        }
        if constexpr (ALIGN_EPI) { if (wr == 0) PG8_BAR; }
        if constexpr (!Epi::AFTER_DRAIN) { E(acc, cur, wr, wc, fr, fq); S.done(cur); }
        if (!has_next) break;
#pragma unroll
        for (int a = 0; a < 2; ++a)
#pragma unroll
            for (int b = 0; b < 2; ++b)
#pragma unroll
                for (int m = 0; m < 4; ++m)
#pragma unroll
                    for (int n = 0; n < 2; ++n) acc[a][b][m][n] = (f32x4){0.f, 0.f, 0.f, 0.f};
        cur = nxt; cA = nA; cB = nB; ++ui;
        if constexpr (ALIGN_EPI) { if (wr == 1) PG8_BAR; }
    }
    PG8_WAIT_V(0);
    if constexpr (!ALIGN_EPI) { if (wr == 0) PG8_BAR; }
    PG8_BAR;
    if constexpr (Epi::AFTER_DRAIN) { E.fused(acc, cur, wr, wc, fr, fq, lds, wid, lane); S.done(cur); }
#undef PG8_SA
#undef PG8_SB
#undef PG8_STAGE
#undef PG8_LDA
#undef PG8_LDB
#undef PG8_MMA
#undef PG8_WAIT_V
#undef PG8_WAIT_L
#undef PG8_BAR
#undef PG8_SCHED
}
}

#ifndef PG8_SP2
#define PG8_SP2 true
#endif
#ifndef PG8_ALIGN
#define PG8_ALIGN true
#endif
#define GAS __attribute__((address_space(1)))
#define LAS __attribute__((address_space(3)))
typedef unsigned short bf16;
typedef unsigned v4u __attribute__((ext_vector_type(4)));
typedef float f32x4 __attribute__((ext_vector_type(4)));
typedef short bf16x8 __attribute__((ext_vector_type(8)));
typedef GAS unsigned gu32;
typedef GAS unsigned long long gu64;
#define RLX_AGENT __ATOMIC_RELAXED, __HIP_MEMORY_SCOPE_AGENT
#define LDS_WAIT() asm volatile("s_waitcnt lgkmcnt(0)" ::: "memory")
#define VM_WAIT() asm volatile("s_waitcnt vmcnt(0)" ::: "memory")
__device__ __forceinline__ unsigned long long rt() { return __builtin_amdgcn_s_memrealtime(); }
__device__ __forceinline__ unsigned f2bf(float f) { unsigned u = __builtin_bit_cast(unsigned, f); return (u + 0x7fffu + ((u >> 16) & 1u)) >> 16; }
__device__ __forceinline__ unsigned pk2(float lo, float hi) { return f2bf(lo) | (f2bf(hi) << 16); }

#define XB_TMO      128
#define XB_XCNT(j)  (256  + 64 * (j))
#define XB_XSUB(j)  (1280 + 64 * (j))
#define XB_XGEN(j)  (2304 + 64 * (j))
#define XB_TOP      3328
#define XB_TOPGEN   3392
#define XCD_BAR_WORDS 3456
#define XB_SPIN_CAP (1u << 18)

__device__ __forceinline__ unsigned xb_ld(unsigned* p)              { return __hip_atomic_load(p, __ATOMIC_RELAXED, __HIP_MEMORY_SCOPE_AGENT); }
__device__ __forceinline__ unsigned xb_add(unsigned* p, unsigned v) { return __hip_atomic_fetch_add(p, v, __ATOMIC_RELAXED, __HIP_MEMORY_SCOPE_AGENT); }
__device__ __forceinline__ unsigned xb_xcc_id() { return (unsigned)__builtin_amdgcn_s_getreg((3 << 11) | 20) & 0xFu; }
#define XB_SPIN(cond, bar) do { unsigned _sp = 0; while (cond) { __builtin_amdgcn_s_sleep(1); \
    if ((++_sp & 255u) == 0u) { if (xb_ld(&(bar)[XB_TMO])) break; if (_sp > XB_SPIN_CAP) { atomicAdd(&(bar)[XB_TMO], 1u); break; } } } } while (0)

struct XcdBarrier {
    unsigned* bar; unsigned x;
    volatile LAS unsigned* st;
};

__device__ __forceinline__ XcdBarrier xcd_barrier_post(unsigned* bar, volatile LAS unsigned* st) {
    XcdBarrier b; b.bar = bar; b.x = xb_xcc_id(); b.st = st;
    if (threadIdx.x == 0) (void)xb_add(&bar[XB_XCNT(b.x)], 1u);
    return b;
}
__device__ __forceinline__ void xcd_barrier_complete(unsigned* bar, unsigned x, unsigned& nloc, unsigned& nx) {
    const unsigned G = gridDim.x * gridDim.y * gridDim.z;
    unsigned sum, cnt, mine, sp = 0u;
    for (;;) {
        sum = 0u; cnt = 0u; mine = 0u;
#pragma unroll
        for (unsigned j = 0; j < 16; ++j) { const unsigned c = xb_ld(&bar[XB_XCNT(j)]); sum += c; cnt += (c > 0u) ? 1u : 0u; mine = (j == x) ? c : mine; }
        if (sum == G) break;
        __builtin_amdgcn_s_sleep(1);
        if ((++sp & 255u) == 0u) { if (xb_ld(&bar[XB_TMO])) break; if (sp > XB_SPIN_CAP) { atomicAdd(&bar[XB_TMO], 1u); break; } }
    }
    nloc = mine > 0u ? mine : 1u; nx = cnt > 0u ? cnt : 1u;
}

__device__ __forceinline__ void xcd_barrier(const XcdBarrier& b) {
    asm volatile("s_waitcnt vmcnt(0)" ::: "memory");
    __syncthreads();
    if (threadIdx.x == 0) {
        unsigned* bar = b.bar;
        __builtin_amdgcn_s_waitcnt(0);
        unsigned nloc = b.st[0], nx = b.st[1];
        if (nloc == 0u) { xcd_barrier_complete(bar, b.x, nloc, nx); b.st[0] = nloc; b.st[1] = nx; }
        const unsigned old = xb_add(&bar[XB_XSUB(b.x)], 1u);
        const unsigned gen = old / nloc;
        if (old + 1u == (gen + 1u) * nloc) {
            __builtin_amdgcn_fence(__ATOMIC_RELEASE, "agent");
            asm volatile("s_waitcnt vmcnt(0)" ::: "memory");
            const unsigned og = xb_add(&bar[XB_TOP], 1u);
            const unsigned tg = og / nx;
            if (og + 1u == (tg + 1u) * nx) xb_add(&bar[XB_TOPGEN], 1u);
            else XB_SPIN(xb_ld(&bar[XB_TOPGEN]) == tg, bar);
            __builtin_amdgcn_fence(__ATOMIC_ACQUIRE, "agent");
            xb_add(&bar[XB_XGEN(b.x)], 1u);
            asm volatile("s_waitcnt vmcnt(0)" ::: "memory");
        } else {
            XB_SPIN(xb_ld(&bar[XB_XGEN(b.x)]) == gen, bar);
            __builtin_amdgcn_fence(__ATOMIC_ACQUIRE, "agent");
            asm volatile("s_waitcnt vmcnt(0)" ::: "memory");
        }
    }
    __syncthreads();
}

constexpr int NWAVES = 8;
#ifndef MK_ONE_LAUNCH
#define MK_ONE_LAUNCH 1
#endif

constexpr int BATCH = 16, SEQ = 2048, D = 1024, T = BATCH * SEQ;
constexpr int NIN = 3584;
constexpr int OFF_SQ = 0, OFF_SK = 512, OFF_SV = 1024, OFF_HQ = 1536, OFF_HF = 2048, OFF_HI = 2560, OFF_HG = 3072;
constexpr int NE = 32, TOPK = 4, NASSIGN = T * TOPK;
constexpr int MAXTILES = NASSIGN / 256 + NE;
constexpr int MAXROWS = MAXTILES * 256;
constexpr float EPS = 1e-6f;

constexpr size_t MiB = 1u << 20;
constexpr size_t WS_CTL = 0, CTL_ZERO_BYTES = 1 * MiB;
constexpr size_t WS_WIN = 2 * MiB;
constexpr size_t WS_WOUT = 10 * MiB;
constexpr size_t WS_TAB = 12 * MiB;
constexpr size_t WS_WGU = 16 * MiB;
constexpr size_t WS_WD = 144 * MiB;
constexpr size_t WS_XN = 208 * MiB;
constexpr size_t WS_P = 272 * MiB;
constexpr size_t WS_MIX = 496 * MiB;
constexpr size_t WS_ACT = 272 * MiB;
constexpr size_t WS_XB = 560 * MiB;
constexpr size_t WS_HGO = 560 * MiB;
constexpr size_t WS_YK = 560 * MiB;
constexpr size_t WS_END = 832 * MiB;
constexpr size_t TB_ASG = WS_TAB;
constexpr size_t TB_TOPG = WS_TAB + 1 * MiB;
constexpr size_t TB_ROWTOK = WS_TAB + 2 * MiB;
constexpr size_t TB_ROWG = WS_TAB + 3 * MiB;
constexpr size_t TB_TILE = WS_TAB + 3 * MiB + 768 * 1024;
static_assert(TB_ROWTOK + (size_t)MAXROWS * 4 <= TB_ROWG && TB_ROWG + (size_t)MAXROWS * 4 <= TB_TILE && TB_TILE + 4096 <= WS_WGU, "table map");
static_assert(WS_ACT + (size_t)MAXROWS * 2048 <= WS_XB && WS_XB + (size_t)MAXROWS * 2048 <= WS_END && WS_MIX + (size_t)T * 2048 <= WS_XB, "d_ws map");
constexpr int CW_TMO = 0, CW_CODE = 1;
constexpr int CW_CNT = 64;
constexpr int CW_BAR = 4096;

constexpr int RING_OFF = 0, RING_BYTES = 131072;
constexpr int LDSCTL_OFF = RING_BYTES, MISC_OFF = LDSCTL_OFF + 320;
constexpr int LTAB_OFF = LDSCTL_OFF + 512;
constexpr int LDS_BYTES = 147456;
static_assert(MISC_OFF + 128 <= LTAB_OFF && LTAB_OFF + (1 + MAXTILES) * 4 <= LDS_BYTES, "LDS map");

struct Frame {
    LAS unsigned char* lds;
    volatile LAS unsigned* MISC;
    gu32* ctl;
    int tid, lane, wave, gw, ngw;
    int vcu, G;
    const float *x, *norm1_g, *w_in, *sb_q_g, *sb_k_g, *sb_out_g, *hg_lb, *hg_out_g, *w_out, *norm2_g, *w_router, *b_router, *w_gu, *b_gu, *w_d, *b_d;
    float* out;
    unsigned char* ws;
};
__device__ __forceinline__ float bf2f(unsigned short b) { return __builtin_bit_cast(float, (unsigned)b << 16); }
__device__ __forceinline__ float bflo(unsigned w) { return __builtin_bit_cast(float, w << 16); }
__device__ __forceinline__ float bfhi(unsigned w) { return __builtin_bit_cast(float, w & 0xffff0000u); }
__device__ __forceinline__ int vzero() { int z; asm volatile("v_mov_b32 %0, 0" : "=v"(z)); return z; }
__device__ __forceinline__ float wave_sum(float v) {
#pragma unroll
    for (int o = 1; o < 64; o <<= 1) v += __shfl_xor(v, o);
    return v;
}

__device__ __forceinline__ void p0_transpose_item(const float* W, int K, int N, bf16* WT, int k0, int n0, int drow0, LAS float* scr, int lane) {
#pragma unroll 8
    for (int i = 0; i < 32; ++i) { const int kk = 2 * i + (lane >> 5); scr[kk * 33 + (lane & 31)] = W[(size_t)(k0 + kk) * N + n0 + (lane & 31)]; }
    LDS_WAIT(); asm volatile("" ::: "memory");
    const int c = lane & 7;
#pragma unroll
    for (int j = 0; j < 4; ++j) { const int n = (lane >> 3) + 8 * j; const LAS float* s = scr + (8 * c) * 33 + n;
        v4u o; o.x = pk2(s[0 * 33], s[1 * 33]); o.y = pk2(s[2 * 33], s[3 * 33]); o.z = pk2(s[4 * 33], s[5 * 33]); o.w = pk2(s[6 * 33], s[7 * 33]);
        *(GAS v4u*)(WT + (size_t)(drow0 + n) * K + k0 + 8 * c) = o; }
    LDS_WAIT(); asm volatile("" ::: "memory");
}
__device__ __forceinline__ void rms_row_to_bf16(const float* xrow, const float* g, bf16* orow, int lane) {
    const GAS f32x4* xr = (const GAS f32x4*)xrow + lane; const f32x4* gr = (const f32x4*)g + lane;
    f32x4 v[4]; float s = 0.f;
#pragma unroll
    for (int j = 0; j < 4; ++j) { v[j] = xr[64 * j]; s += (v[j].x * v[j].x + v[j].y * v[j].y) + (v[j].z * v[j].z + v[j].w * v[j].w); }
    const float rstd = 1.f / sqrtf(wave_sum(s) * (1.f / D) + EPS);
    GAS unsigned long long* o8 = (GAS unsigned long long*)orow + lane;
#pragma unroll
    for (int j = 0; j < 4; ++j) { const f32x4 gg = gr[64 * j];
        o8[64 * j] = (unsigned long long)pk2(v[j].x * rstd * gg.x, v[j].y * rstd * gg.y) | ((unsigned long long)pk2(v[j].z * rstd * gg.z, v[j].w * rstd * gg.w) << 32); }
}
__device__ __forceinline__ void p0_prologue(Frame& F) {
    LAS float* scr = (LAS float*)(F.lds + RING_OFF + F.wave * 16384);
    constexpr int I_IN = 16 * (NIN / 32), I_OUT = 16 * 32, I_GU = NE * 16 * 64, I_D = NE * 16 * 32;
    constexpr int NITEMS = I_IN + I_OUT + I_GU + I_D;
    for (int it = F.gw; it < NITEMS; it += F.ngw) {
        int r = it;
        if (r < I_IN) { const int nb = NIN / 32, kb = r / nb, nn = r % nb; p0_transpose_item(F.w_in, D, NIN, (bf16*)(F.ws + WS_WIN), 64 * kb, 32 * nn, 32 * nn, scr, F.lane); continue; } r -= I_IN;
        if (r < I_OUT) { const int kb = r / 32, nn = r % 32; p0_transpose_item(F.w_out, D, D, (bf16*)(F.ws + WS_WOUT), 64 * kb, 32 * nn, 32 * nn, scr, F.lane); continue; } r -= I_OUT;
        if (r < I_GU) { const int e = r / 1024, q = r % 1024, kb = q / 64, nn = q % 64;
            const int isup = nn >> 5, a = (nn & 31) * 32;
            const int drow = 256 * (a >> 7) + 128 * isup + (a & 127);
            p0_transpose_item(F.w_gu + (size_t)e * D * 2048, D, 2048, (bf16*)(F.ws + WS_WGU) + (size_t)e * 2048 * D, 64 * kb, 32 * nn, drow, scr, F.lane); continue; } r -= I_GU;
        { const int e = r / 512, q = r % 512, kb = q / 32, nn = q % 32;
            p0_transpose_item(F.w_d + (size_t)e * D * D, D, D, (bf16*)(F.ws + WS_WD) + (size_t)e * D * D, 64 * kb, 32 * nn, 32 * nn, scr, F.lane); }
    }
    for (int m = F.gw; m < T; m += F.ngw) rms_row_to_bf16(F.x + (size_t)m * D, F.norm1_g, (bf16*)(F.ws + WS_XN) + (size_t)m * D, F.lane);
    { int* rt = (int*)(F.ws + TB_ROWTOK); for (int i = F.gw * 64 + F.lane; i < MAXROWS; i += F.ngw * 64) rt[i] = -1; }
}

__device__ __forceinline__ void qknorm_phase(Frame& F) {
    bf16* P = (bf16*)(F.ws + WS_P);
    for (int t = F.gw; t < T; t += F.ngw) {
#pragma unroll
        for (int which = 0; which < 2; ++which) {
            GAS v4u* p = (GAS v4u*)(P + (size_t)t * NIN + (which ? OFF_SK : OFF_SQ)) + F.lane;
            const v4u raw = *p; float v[8];
            v[0] = bflo(raw.x); v[1] = bfhi(raw.x); v[2] = bflo(raw.y); v[3] = bfhi(raw.y); v[4] = bflo(raw.z); v[5] = bfhi(raw.z); v[6] = bflo(raw.w); v[7] = bfhi(raw.w);
            float s = 0.f;
#pragma unroll
            for (int j = 0; j < 8; ++j) s += v[j] * v[j];
            s += __shfl_xor(s, 1); s += __shfl_xor(s, 2); s += __shfl_xor(s, 4);
            const float r = (1.f / sqrtf(s * (1.f / 64.f) + EPS)) * (which ? 1.0f : 0.125f);
            const float* g = (which ? F.sb_k_g : F.sb_q_g) + (F.lane & 7) * 8;
            v4u o; o.x = pk2(v[0] * r * g[0], v[1] * r * g[1]); o.y = pk2(v[2] * r * g[2], v[3] * r * g[3]); o.z = pk2(v[4] * r * g[4], v[5] * r * g[5]); o.w = pk2(v[6] * r * g[6], v[7] * r * g[7]);
            *p = o;
        }
    }
}

__device__ __forceinline__ void attn_naive_item(Frame& F, int bh, int qb) {
    const int b = bh >> 3, h = bh & 7, t = qb * 64 + F.lane;
    const bf16* Pb = (const bf16*)(F.ws + WS_P) + (size_t)b * SEQ * NIN;
    float q[64], o[64];
    { const GAS v4u* qp = (const GAS v4u*)(Pb + (size_t)t * NIN + OFF_SQ + h * 64);
#pragma unroll
        for (int c = 0; c < 8; ++c) { const v4u r = qp[c]; q[8 * c + 0] = bflo(r.x); q[8 * c + 1] = bfhi(r.x); q[8 * c + 2] = bflo(r.y); q[8 * c + 3] = bfhi(r.y); q[8 * c + 4] = bflo(r.z); q[8 * c + 5] = bfhi(r.z); q[8 * c + 6] = bflo(r.w); q[8 * c + 7] = bfhi(r.w); } }
#pragma unroll
    for (int d = 0; d < 64; ++d) o[d] = 0.f;
    float C = 0.f; const int vz = vzero();
    for (int s = qb * 64 + 62; s >= 0; --s) {
        const GAS v4u* kp = (const GAS v4u*)(Pb + (size_t)s * NIN + OFF_SK + h * 64) + vz;
        const GAS v4u* vp = (const GAS v4u*)(Pb + (size_t)s * NIN + OFF_SV + h * 64) + vz;
        float z = 0.f;
#pragma unroll
        for (int c = 0; c < 8; ++c) { const v4u r = kp[c];
            z += q[8 * c + 0] * bflo(r.x) + q[8 * c + 1] * bfhi(r.x) + q[8 * c + 2] * bflo(r.y) + q[8 * c + 3] * bfhi(r.y) + q[8 * c + 4] * bflo(r.z) + q[8 * c + 5] * bfhi(r.z) + q[8 * c + 6] * bflo(r.w) + q[8 * c + 7] * bfhi(r.w); }
        const float sp = fmaxf(z, 0.f) + __logf(1.f + __expf(-fabsf(z)));
        const bool act = s < t;
        const float w = act ? __expf(z - sp - C) : 0.f;
        C += act ? sp : 0.f;
#pragma unroll
        for (int c = 0; c < 8; ++c) { const v4u r = vp[c];
            o[8 * c + 0] += w * bflo(r.x); o[8 * c + 1] += w * bfhi(r.x); o[8 * c + 2] += w * bflo(r.y); o[8 * c + 3] += w * bfhi(r.y); o[8 * c + 4] += w * bflo(r.z); o[8 * c + 5] += w * bfhi(r.z); o[8 * c + 6] += w * bflo(r.w); o[8 * c + 7] += w * bfhi(r.w); }
    }
    float ss = 0.f;
#pragma unroll
    for (int d = 0; d < 64; ++d) ss += o[d] * o[d];
    const float r = 1.f / sqrtf(ss * (1.f / 64.f) + EPS);
    const float* g = F.sb_out_g + h * 64;
    GAS v4u* op = (GAS v4u*)((bf16*)(F.ws + WS_MIX) + ((size_t)b * SEQ + t) * D + h * 64);
#pragma unroll
    for (int c = 0; c < 8; ++c) { v4u w4; w4.x = pk2(o[8 * c + 0] * r * g[8 * c + 0], o[8 * c + 1] * r * g[8 * c + 1]); w4.y = pk2(o[8 * c + 2] * r * g[8 * c + 2], o[8 * c + 3] * r * g[8 * c + 3]);
        w4.z = pk2(o[8 * c + 4] * r * g[8 * c + 4], o[8 * c + 5] * r * g[8 * c + 5]); w4.w = pk2(o[8 * c + 6] * r * g[8 * c + 6], o[8 * c + 7] * r * g[8 * c + 7]); op[c] = w4; }
}
__device__ __forceinline__ void attn_naive_phase(Frame& F) {
    for (int it = F.gw; it < 2048; it += F.ngw) { const int bh = it & 127, j = it >> 7;
        attn_naive_item(F, bh, 31 - j); attn_naive_item(F, bh, j); }
}

__device__ __forceinline__ void hgrn_naive_phase(Frame& F) {
    LAS float* sc = (LAS float*)(F.lds + RING_OFF + F.wave * 16384);
    const bf16* P = (const bf16*)(F.ws + WS_P); float* HGO = (float*)(F.ws + WS_HGO);
    for (int it = F.gw; it < 128; it += F.ngw) {
        const int bh = it >> 1, half = it & 1, b = bh >> 2, h = bh & 3;
        float S[128];
#pragma unroll
        for (int d = 0; d < 128; ++d) S[d] = 0.f;
        float lb[2];
#pragma unroll
        for (int j = 0; j < 2; ++j) { const int c = h * 128 + F.lane + 64 * j; lb[j] = 1.f / (1.f + __expf(F.hg_lb[512 + c] - F.hg_lb[c])); }
        for (int t = 0; t < SEQ; ++t) {
            const bf16* row = P + ((size_t)b * SEQ + t) * NIN;
#pragma unroll
            for (int j = 0; j < 2; ++j) { const int d = F.lane + 64 * j; const float ff = bf2f(row[OFF_HF + h * 128 + d]); const float sg = 1.f / (1.f + __expf(-ff));
                sc[d] = lb[j] + (1.f - lb[j]) * sg; sc[128 + d] = (1.f - lb[j]) * (1.f - sg); sc[256 + d] = bf2f(row[OFF_HQ + h * 128 + d]); }
            const float v = bf2f(row[OFF_HI + h * 128 + half * 64 + F.lane]);
            LDS_WAIT(); asm volatile("" ::: "memory");
            float o = 0.f;
#pragma unroll
            for (int d4 = 0; d4 < 32; ++d4) { const f32x4 f4 = *(const LAS f32x4*)(sc + 4 * d4), k4 = *(const LAS f32x4*)(sc + 128 + 4 * d4), q4 = *(const LAS f32x4*)(sc + 256 + 4 * d4);
#pragma unroll
                for (int j = 0; j < 4; ++j) { S[4 * d4 + j] = f4[j] * S[4 * d4 + j] + k4[j] * v; o += q4[j] * S[4 * d4 + j]; } }
            HGO[((size_t)b * SEQ + t) * 512 + h * 128 + half * 64 + F.lane] = o;
            LDS_WAIT(); asm volatile("" ::: "memory");
        }
    }
}
__device__ __forceinline__ void hgnorm_phase(Frame& F) {
    const bf16* P = (const bf16*)(F.ws + WS_P); const float* HGO = (const float*)(F.ws + WS_HGO); bf16* MIX = (bf16*)(F.ws + WS_MIX);
    for (int t = F.gw; t < T; t += F.ngw) {
        const GAS f32x4* op = (const GAS f32x4*)(HGO + (size_t)t * 512) + 2 * F.lane; const f32x4 a = op[0], b2 = op[1];
        float v[8] = {a.x, a.y, a.z, a.w, b2.x, b2.y, b2.z, b2.w}; float s = 0.f;
#pragma unroll
        for (int j = 0; j < 8; ++j) s += v[j] * v[j];
        s += __shfl_xor(s, 1); s += __shfl_xor(s, 2); s += __shfl_xor(s, 4); s += __shfl_xor(s, 8);
        const float r = 1.f / sqrtf(s * (1.f / 128.f) + EPS);
        const v4u graw = *((const GAS v4u*)(P + (size_t)t * NIN + OFF_HG) + F.lane);
        float gt[8] = {bflo(graw.x), bfhi(graw.x), bflo(graw.y), bfhi(graw.y), bflo(graw.z), bfhi(graw.z), bflo(graw.w), bfhi(graw.w)};
        const float* g = F.hg_out_g + 8 * F.lane; float y[8];
#pragma unroll
        for (int j = 0; j < 8; ++j) { const float si = gt[j] / (1.f + __expf(-gt[j])); y[j] = v[j] * r * g[j] * si; }
        v4u o; o.x = pk2(y[0], y[1]); o.y = pk2(y[2], y[3]); o.z = pk2(y[4], y[5]); o.w = pk2(y[6], y[7]);
        *((GAS v4u*)(MIX + (size_t)t * D + 512) + F.lane) = o;
    }
}

__device__ __forceinline__ void router_phase(Frame& F) {
    LAS float* hs = (LAS float*)(F.lds + RING_OFF + F.wave * 16384);
    const float* X1 = F.out; bf16* H2 = (bf16*)(F.ws + WS_XN);
    int* ASG = (int*)(F.ws + TB_ASG); float* TOPG = (float*)(F.ws + TB_TOPG); unsigned* cnt = (unsigned*)(F.ctl + CW_CNT);
    const int e = F.lane & 31, kh = F.lane >> 5;
    for (int t = F.gw; t < T; t += F.ngw) {
        const GAS f32x4* xr = (const GAS f32x4*)(X1 + (size_t)t * D) + F.lane; const f32x4* gr = (const f32x4*)F.norm2_g + F.lane;
        f32x4 v[4]; float s = 0.f;
#pragma unroll
        for (int j = 0; j < 4; ++j) { v[j] = xr[64 * j]; s += (v[j].x * v[j].x + v[j].y * v[j].y) + (v[j].z * v[j].z + v[j].w * v[j].w); }
        const float rstd = 1.f / sqrtf(wave_sum(s) * (1.f / D) + EPS);
        GAS unsigned long long* o8 = (GAS unsigned long long*)(H2 + (size_t)t * D) + F.lane;
#pragma unroll
        for (int j = 0; j < 4; ++j) { const f32x4 gg = gr[64 * j]; const f32x4 hv = (f32x4){v[j].x * rstd * gg.x, v[j].y * rstd * gg.y, v[j].z * rstd * gg.z, v[j].w * rstd * gg.w};
            o8[64 * j] = (unsigned long long)pk2(hv.x, hv.y) | ((unsigned long long)pk2(hv.z, hv.w) << 32);
            *(LAS f32x4*)(hs + 4 * (F.lane + 64 * j)) = hv; }
        LDS_WAIT(); asm volatile("" ::: "memory");
        float acc = 0.f; const float* wr = F.w_router + (size_t)(512 * kh) * NE + e; const LAS float* hp = hs + 512 * kh;
#pragma unroll 8
        for (int k4 = 0; k4 < 128; ++k4) { const f32x4 h4 = *(const LAS f32x4*)(hp + 4 * k4);
            acc += h4.x * wr[(4 * k4 + 0) * NE]; acc += h4.y * wr[(4 * k4 + 1) * NE]; acc += h4.z * wr[(4 * k4 + 2) * NE]; acc += h4.w * wr[(4 * k4 + 3) * NE]; }
        acc += __shfl_xor(acc, 32);
        float val = acc + F.b_router[e];
        float sv[4]; int se[4];
#pragma unroll
        for (int r = 0; r < 4; ++r) { float bv = val; int bi = e;
#pragma unroll
            for (int off = 1; off < 32; off <<= 1) { const float ov = __shfl_xor(bv, off); const int oi = __shfl_xor(bi, off); if (ov > bv || (ov == bv && oi < bi)) { bv = ov; bi = oi; } }
            sv[r] = bv; se[r] = bi; if (e == bi) val = -__builtin_inff(); }
        const float e1 = __expf(sv[1] - sv[0]), e2 = __expf(sv[2] - sv[0]), e3 = __expf(sv[3] - sv[0]); const float inv = 1.f / (1.f + e1 + e2 + e3);
        if (F.lane < 4) { const int my_e = F.lane == 0 ? se[0] : F.lane == 1 ? se[1] : F.lane == 2 ? se[2] : se[3];
            const float my_g = (F.lane == 0 ? 1.f : F.lane == 1 ? e1 : F.lane == 2 ? e2 : e3) * inv;
            const unsigned pos = __hip_atomic_fetch_add(cnt + my_e, 1u, __ATOMIC_RELAXED, __HIP_MEMORY_SCOPE_AGENT);
            ASG[((size_t)t * 4 + F.lane) * 2] = my_e; ASG[((size_t)t * 4 + F.lane) * 2 + 1] = (int)pos; TOPG[(size_t)t * 4 + F.lane] = my_g; }
        LDS_WAIT(); asm volatile("" ::: "memory");
    }
}
__device__ __forceinline__ int expert_starts(Frame& F, int& my_cnt, int& total_tiles) {
    const int e = F.lane & 31; const int c = (int)__hip_atomic_load((unsigned*)(F.ctl + CW_CNT) + e, __ATOMIC_RELAXED, __HIP_MEMORY_SCOPE_AGENT);
    const int tl = (c + 255) >> 8; int inc = tl;
#pragma unroll
    for (int off = 1; off < 32; off <<= 1) { const int o = __shfl_up(inc, off, 32); if (e >= off) inc += o; }
    total_tiles = __shfl(inc, 31, 32); my_cnt = c; return (inc - tl) * 256;
}
__device__ __forceinline__ void gather_phase(Frame& F) {
    const bf16* H2 = (const bf16*)(F.ws + WS_XN); bf16* XB = (bf16*)(F.ws + WS_XB);
    const int* ASG = (const int*)(F.ws + TB_ASG); const float* TOPG = (const float*)(F.ws + TB_TOPG);
    int* ROWTOK = (int*)(F.ws + TB_ROWTOK); float* ROWG = (float*)(F.ws + TB_ROWG); int* TILE = (int*)(F.ws + TB_TILE);
    int my_cnt, ntiles; const int my_start = expert_starts(F, my_cnt, ntiles);
    if (F.gw == 0) {
        if (F.lane == 0) TILE[0] = ntiles;
        if (F.lane < 32) { const int t0 = my_start >> 8, nt = (my_cnt + 255) >> 8; for (int i = 0; i < nt; ++i) TILE[1 + t0 + i] = F.lane; }
    }
    const int vz = vzero();
    for (int t = F.gw; t < T; t += F.ngw) {
        const GAS v4u* src = (const GAS v4u*)(H2 + (size_t)t * D) + 2 * F.lane; const v4u a = src[0], b2 = src[1];
#pragma unroll
        for (int k = 0; k < 4; ++k) { const int e = ASG[((size_t)t * 4 + k) * 2 + vz], pos = ASG[((size_t)t * 4 + k) * 2 + 1 + vz]; const float g = TOPG[(size_t)t * 4 + k + vz];
            const int dest = __shfl(my_start, e, 64) + pos;
            GAS v4u* dst = (GAS v4u*)(XB + (size_t)dest * D) + 2 * F.lane; dst[0] = a; dst[1] = b2;
            if (F.lane == 0) { ROWTOK[dest] = t * 4 + k; ROWG[dest] = g; } }
    }
}
__device__ __forceinline__ int load_tile_table(Frame& F) {
    const int* TILE = (const int*)(F.ws + TB_TILE); LAS int* lt = (LAS int*)(F.lds + LTAB_OFF);
    for (int i = F.tid; i < 1 + MAXTILES; i += NWAVES * 64) lt[i] = TILE[i];
    __syncthreads();
    int nt = lt[0]; nt = nt < 0 ? 0 : (nt > MAXTILES ? MAXTILES : nt); return __builtin_amdgcn_readfirstlane(nt);
}
__device__ __forceinline__ void combine_phase(Frame& F) {
    const bf16* YK = (const bf16*)(F.ws + WS_YK);
    for (int t = F.gw; t < T; t += F.ngw) {
        GAS f32x4* xr = (GAS f32x4*)(F.out + (size_t)t * D) + F.lane;
#pragma unroll
        for (int j = 0; j < 4; ++j) { f32x4 v = xr[64 * j];
#pragma unroll
            for (int k = 0; k < 4; ++k) { const unsigned long long y = *((const GAS unsigned long long*)(YK + ((size_t)t * 4 + k) * D) + F.lane + 64 * j);
                const unsigned lo = (unsigned)y, hi = (unsigned)(y >> 32); v.x += bflo(lo); v.y += bfhi(lo); v.z += bflo(hi); v.w += bfhi(hi); }
            xr[64 * j] = v; }
    }
}

constexpr int NPH = 12;
struct Args { const float* in[16]; float* out; unsigned char* ws; int ph_lo, ph_hi; };
__global__ void __launch_bounds__(NWAVES * 64, 2) fwd(Args args) {
    extern __shared__ __attribute__((aligned(16))) unsigned char lds[];
    Frame F;
    F.lds = (LAS unsigned char*)lds;
    F.MISC = (volatile LAS unsigned*)(F.lds + MISC_OFF);
    F.tid = threadIdx.x; F.lane = F.tid & 63; F.wave = __builtin_amdgcn_readfirstlane(F.tid >> 6);
    F.G = gridDim.x; { const int bx = blockIdx.x; F.vcu = (F.G % 8 == 0) ? (bx % 8) * (F.G / 8) + bx / 8 : bx; }
    F.gw = blockIdx.x * NWAVES + F.wave; F.ngw = F.G * NWAVES;
    F.ws = args.ws; F.ctl = (gu32*)(args.ws + WS_CTL); F.out = args.out;
    F.x = args.in[0]; F.norm1_g = args.in[1]; F.w_in = args.in[2]; F.sb_q_g = args.in[3]; F.sb_k_g = args.in[4]; F.sb_out_g = args.in[5]; F.hg_lb = args.in[6]; F.hg_out_g = args.in[7];
    F.w_out = args.in[8]; F.norm2_g = args.in[9]; F.w_router = args.in[10]; F.b_router = args.in[11]; F.w_gu = args.in[12]; F.b_gu = args.in[13]; F.w_d = args.in[14]; F.b_d = args.in[15];
    for (int u = F.tid; u < (LDS_BYTES - LDSCTL_OFF) / 4; u += NWAVES * 64) ((LAS unsigned*)(F.lds + LDSCTL_OFF))[u] = 0u;
    __syncthreads();
    XcdBarrier bar; bar.bar = (unsigned*)(F.ctl + CW_BAR); bar.x = 0; bar.st = nullptr;
    if (MK_ONE_LAUNCH) bar = xcd_barrier_post((unsigned*)(F.ctl + CW_BAR), F.MISC + 8);
    const int lo = args.ph_lo, hi = args.ph_hi;
#define IN(k) (lo <= (k) && (k) < hi)
#define SEAM(k) do { if (IN(k) && IN((k) + 1)) xcd_barrier(bar); } while (0)

    if (IN(0)) { p0_prologue(F); } SEAM(0);
    if (IN(1)) {
        pg8::Gemm g{(const bf16*)(F.ws + WS_XN), (const bf16*)(F.ws + WS_WIN), T, NIN, D}; pg8::StaticOrder S; S.init(T, NIN, F.G, (int)blockIdx.x);
        pg8::EpiBf16<0> E{(bf16*)(F.ws + WS_P), NIN, nullptr, 0, 0, 1.f};
        pg8::gemm_phase<pg8::EpiBf16<0>, pg8::StaticOrder, PG8_ALIGN, PG8_SP2>(F.lds + RING_OFF, g, S, E);
    } SEAM(1);
    if (IN(2)) { qknorm_phase(F); } SEAM(2);
    if (IN(3)) { attn_naive_phase(F); } SEAM(3);
    if (IN(4)) { hgrn_naive_phase(F); } SEAM(4);
    if (IN(5)) { hgnorm_phase(F); } SEAM(5);
    if (IN(6)) {
        pg8::Gemm g{(const bf16*)(F.ws + WS_MIX), (const bf16*)(F.ws + WS_WOUT), T, D, D}; pg8::StaticOrder S; S.init(T, D, F.G, (int)blockIdx.x);
        pg8::EpiRes E{F.x, F.out, D};
        pg8::gemm_phase<pg8::EpiRes, pg8::StaticOrder, PG8_ALIGN, PG8_SP2>(F.lds + RING_OFF, g, S, E);
    } SEAM(6);
    if (IN(7)) { router_phase(F); } SEAM(7);
    if (IN(8)) { gather_phase(F); } SEAM(8);
    if (IN(9)) {
        const int nt = load_tile_table(F);
        pg8::Gemm g{(const bf16*)(F.ws + WS_XB), (const bf16*)(F.ws + WS_WGU), MAXROWS, NE * 2048, D};
        pg8::MoeOrder S{(const LAS int*)(F.lds + LTAB_OFF) + 1, 8, nt * 8, F.G, F.vcu};
        pg8::EpiAct E{(bf16*)(F.ws + WS_ACT), F.b_gu};
        pg8::gemm_phase<pg8::EpiAct, pg8::MoeOrder, PG8_ALIGN, PG8_SP2>(F.lds + RING_OFF, g, S, E);
    } SEAM(9);
    if (IN(10)) {
        const int nt = load_tile_table(F);
        pg8::Gemm g{(const bf16*)(F.ws + WS_ACT), (const bf16*)(F.ws + WS_WD), MAXROWS, NE * 1024, D};
        pg8::MoeOrder S{(const LAS int*)(F.lds + LTAB_OFF) + 1, 4, nt * 4, F.G, F.vcu};
        pg8::EpiDown E{(bf16*)(F.ws + WS_YK), F.b_d, (const int*)(F.ws + TB_ROWTOK), (const float*)(F.ws + TB_ROWG)};
        pg8::gemm_phase<pg8::EpiDown, pg8::MoeOrder, PG8_ALIGN, PG8_SP2>(F.lds + RING_OFF, g, S, E);
    } SEAM(10);
    if (IN(11)) { combine_phase(F); }
#undef IN
#undef SEAM
}

extern "C" void kernel_launch(void* const* d_in, const int* in_sizes, int n_in, void* d_out, int out_size, void* d_ws, size_t ws_size, hipStream_t stream) {
    static int grid = 0;
    if (grid == 0) {
        if (n_in != 16 || in_sizes[0] != T * D || out_size != T * D || ws_size < WS_END) { fprintf(stderr, "kernel_launch: shape/workspace mismatch (n_in %d, ws %zu, need %zu); nothing launched\n", n_in, ws_size, (size_t)WS_END); grid = -1; return; }
        int dev = 0, cus = 0, per_cu = 0;
        if (hipGetDevice(&dev) != hipSuccess || hipDeviceGetAttribute(&cus, hipDeviceAttributeMultiprocessorCount, dev) != hipSuccess) { grid = -1; return; }
        if (hipFuncSetAttribute((const void*)fwd, hipFuncAttributeMaxDynamicSharedMemorySize, LDS_BYTES) != hipSuccess) { grid = -1; return; }
        if (hipOccupancyMaxActiveBlocksPerMultiprocessor(&per_cu, (const void*)fwd, NWAVES * 64, LDS_BYTES) != hipSuccess || per_cu < 1) { fprintf(stderr, "kernel_launch: occupancy query says %d\n", per_cu); }
        (void)hipGetLastError();
        grid = cus;
    }
    if (grid < 0) return;
    if (hipMemsetAsync((char*)d_ws + WS_CTL, 0, CTL_ZERO_BYTES, stream) != hipSuccess) return;
    Args a{};
    for (int i = 0; i < 16; ++i) a.in[i] = (const float*)d_in[i];
    a.out = (float*)d_out; a.ws = (unsigned char*)d_ws;
#if MK_ONE_LAUNCH
    a.ph_lo = 0; a.ph_hi = NPH;
    hipLaunchKernelGGL(fwd, dim3(grid), dim3(NWAVES * 64), LDS_BYTES, stream, a);
#else
    for (int p = 0; p < NPH; ++p) { a.ph_lo = p; a.ph_hi = p + 1; hipLaunchKernelGGL(fwd, dim3(grid), dim3(NWAVES * 64), LDS_BYTES, stream, a); }
#endif
}
```

```cpp
#include <hip/hip_runtime.h>
#include <cstdio>
#include <cstdint>
namespace pg8 {
#define PG8_LAS __attribute__((address_space(3)))
typedef unsigned short bf16_t;
typedef short bf16x8 __attribute__((ext_vector_type(8)));
typedef float f32x4 __attribute__((ext_vector_type(4)));
typedef unsigned u32x4 __attribute__((ext_vector_type(4)));
constexpr int BM = 256, BK = 64, HALF = 128, HTB = HALF * BK * 2  , STAGE_BYTES = 8 * HTB, NXCD = 8, WGM = 8;

__host__ __device__ __forceinline__ int lds_byte(int r, int c) { const int st = (r >> 4) * 2 + (c >> 5), rr = r & 15, cc = c & 31, ob = rr * 64 + cc * 2; return st * 1024 + (ob ^ (((ob >> 9) & 1) << 5)); }
__host__ __device__ __forceinline__ void stage_rc(int b, int& R, int& C) { const int st = b / 1024, sb = b % 1024, swz = sb ^ (((sb >> 9) & 1) << 5); R = (st >> 1) * 16 + swz / 64; C = (st & 1) * 32 + (swz % 64) / 2; }
__host__ __device__ __forceinline__ int perm32(int rho) { const int n = rho >> 4, i = rho & 15; return 8 * (i >> 2) + 4 * n + (i & 3); }

struct Unit { int pm, pn; };
struct Gemm { const bf16_t* A; const bf16_t* Bt; int M, N, K; };

struct StaticOrder {
    int nM, nN, nwg, G, c;
    __host__ __device__ void init(int M, int N, int G_, int c_) { nM = M / BM; nN = N / BM; nwg = nM * nN; G = G_; c = c_; }
    __host__ __device__ bool next(int i, Unit& u) const {
        const long L = (long)i * G + c; if (L >= nwg) return false;
        int wgid = (int)L; { const int q = nwg / NXCD, r = nwg % NXCD, xcd = wgid % NXCD, off = wgid / NXCD; wgid = (xcd < r ? xcd * (q + 1) : r * (q + 1) + (xcd - r) * q) + off; }
        const int nig = WGM * nN, gid = wgid / nig, fm = gid * WGM, gsz = (nM - fm) < WGM ? (nM - fm) : WGM;
        u.pm = fm + ((wgid % nig) % gsz); u.pn = (wgid % nig) / gsz; return true;
    }
    __device__ __forceinline__ void a_ready(const Unit&) const {}
    __device__ __forceinline__ void done(const Unit&) const {}
};

__device__ __forceinline__ unsigned cvt_pk_bf16(float lo, float hi) { unsigned r; asm volatile("v_cvt_pk_bf16_f32 %0, %1, %2" : "=v"(r) : "v"(lo), "v"(hi)); return r; }
typedef float f32x2 __attribute__((ext_vector_type(2)));
__device__ __forceinline__ f32x2 gelu_pk(f32x2 v) {
    const f32x2 av = __builtin_elementwise_abs(v), d = av * 0.2316418882f + 1.0f;
    f32x2 t; t.x = __builtin_amdgcn_rcpf(d.x); t.y = __builtin_amdgcn_rcpf(d.y);
    f32x2 q = t * 0.5307027145f + (-0.7265760135f); q = q * t + 0.7107068705f; q = q * t + (-0.142248368f); q = q * t + 0.127414796f; q = q * t;
    const f32x2 s = (v * v) * (-0.72134752044f);
    f32x2 e; e.x = __builtin_amdgcn_exp2f(s.x); e.y = __builtin_amdgcn_exp2f(s.y);
    const f32x2 m = v * (q * e), r = v - m;
    f32x2 o; o.x = v.x < 0.f ? m.x : r.x; o.y = v.y < 0.f ? m.y : r.y; return o;
}

template <int ACT  > struct EpiBf16 {
    static constexpr bool PERM = true, AFTER_DRAIN = false; static_assert(ACT == 0 || ACT == 1, "EpiBf16: ACT is 0 (none) or 1 (gelu_pk)");
    bf16_t* O; int ldc; const float* bias; int split_cols; size_t split_stride; float scale0;
    __device__ __forceinline__ void operator()(const f32x4 (&acc)[2][2][4][2], const Unit& u, int wr, int wc, int fr, int fq) const {
        const int row0 = u.pm * BM + wr * 64 + fr; int colt = u.pn * BM; bf16_t* base = O;
        float sc = 1.f; if (split_cols) { const int t = colt / split_cols; base += (size_t)t * split_stride; colt -= t * split_cols; if (t == 0) sc = scale0; }
        const int col0 = colt + wc * 32 + 8 * fq, bcol0 = u.pn * BM + wc * 32 + 8 * fq;
        f32x4 bv[2][2];
#pragma unroll
        for (int bj = 0; bj < 2; ++bj)
#pragma unroll
            for (int n = 0; n < 2; ++n) bv[bj][n] = bias ? *(const f32x4*)(bias + bcol0 + bj * HALF + 4 * n) : (f32x4){0.f, 0.f, 0.f, 0.f};
#pragma unroll
        for (int ai = 0; ai < 2; ++ai)
#pragma unroll
            for (int m = 0; m < 4; ++m) { bf16_t* rowp = base + (size_t)(row0 + ai * HALF + m * 16) * ldc + col0;
#pragma unroll
                for (int bj = 0; bj < 2; ++bj) { f32x4 v0 = acc[ai][bj][m][0] + bv[bj][0], v1 = acc[ai][bj][m][1] + bv[bj][1];
                    if (ACT == 1) { f32x2 a = gelu_pk((f32x2){v0[0], v0[1]}), b = gelu_pk((f32x2){v0[2], v0[3]}), c = gelu_pk((f32x2){v1[0], v1[1]}), d = gelu_pk((f32x2){v1[2], v1[3]});
                        v0 = (f32x4){a.x, a.y, b.x, b.y}; v1 = (f32x4){c.x, c.y, d.x, d.y}; }
                    v0 = v0 * sc; v1 = v1 * sc; u32x4 w; w.x = cvt_pk_bf16(v0[0], v0[1]); w.y = cvt_pk_bf16(v0[2], v0[3]); w.z = cvt_pk_bf16(v1[0], v1[1]); w.w = cvt_pk_bf16(v1[2], v1[3]);
                    *(u32x4*)(rowp + bj * HALF) = w; } }
    }
};

struct EpiRes {
    static constexpr bool PERM = false, AFTER_DRAIN = false;
    const float* X; float* C; int ldc;
    __device__ __forceinline__ void operator()(const f32x4 (&acc)[2][2][4][2], const Unit& u, int wr, int wc, int fr, int fq) const {
        const int row0 = u.pm * BM + wr * 64 + fr, col0 = u.pn * BM + wc * 32 + 4 * fq;
#pragma unroll
        for (int ai = 0; ai < 2; ++ai)
#pragma unroll
            for (int m = 0; m < 4; ++m) { const size_t off = (size_t)(row0 + ai * HALF + m * 16) * ldc + col0;
#pragma unroll
                for (int bj = 0; bj < 2; ++bj)
#pragma unroll
                    for (int n = 0; n < 2; ++n) { const size_t o2 = off + bj * HALF + n * 16; *(f32x4*)(C + o2) = *(const f32x4*)(X + o2) + acc[ai][bj][m][n]; } }
    }
};
struct MoeOrder {
    const PG8_LAS int* tile_e; int ntn, nunits, G, c;
    __device__ __forceinline__ bool next(int i, Unit& u) const {
        const int L = i * G + c; if (L >= nunits) return false;
        const int pm = L / ntn, pl = L - pm * ntn; u.pm = pm; u.pn = tile_e[pm] * ntn + pl; return true;
    }
    __device__ __forceinline__ void a_ready(const Unit&) const {}
    __device__ __forceinline__ void done(const Unit&) const {}
};
struct EpiAct {
    static constexpr bool PERM = true, AFTER_DRAIN = false;
    bf16_t* ACT; const float* bgu;
    __device__ __forceinline__ void operator()(const f32x4 (&acc)[2][2][4][2], const Unit& u, int wr, int wc, int fr, int fq) const {
        const int e = u.pn >> 3, pl = u.pn & 7; const int row0 = u.pm * BM + wr * 64 + fr, acol0 = pl * 128 + wc * 32 + 8 * fq;
        f32x4 bg[2], bu[2];
#pragma unroll
        for (int n = 0; n < 2; ++n) { bg[n] = *(const f32x4*)(bgu + (size_t)e * 2048 + acol0 + 4 * n); bu[n] = *(const f32x4*)(bgu + (size_t)e * 2048 + 1024 + acol0 + 4 * n); }
#pragma unroll
        for (int ai = 0; ai < 2; ++ai)
#pragma unroll
            for (int m = 0; m < 4; ++m) { bf16_t* rowp = ACT + (size_t)(row0 + ai * HALF + m * 16) * 1024 + acol0; float a[8];
#pragma unroll
                for (int n = 0; n < 2; ++n) { const f32x4 g4 = acc[ai][0][m][n] + bg[n], u4 = acc[ai][1][m][n] + bu[n];
#pragma unroll
                    for (int j = 0; j < 4; ++j) { const float gl = fminf(g4[j], 7.0f), ul = fminf(fmaxf(u4[j], -7.0f), 7.0f);
                        const float sg = __builtin_amdgcn_rcpf(1.0f + __builtin_amdgcn_exp2f(gl * (-1.702f * 1.44269504089f))); a[4 * n + j] = gl * sg * (ul + 1.0f); } }
                u32x4 w; w.x = cvt_pk_bf16(a[0], a[1]); w.y = cvt_pk_bf16(a[2], a[3]); w.z = cvt_pk_bf16(a[4], a[5]); w.w = cvt_pk_bf16(a[6], a[7]);
                *(u32x4*)rowp = w; }
    }
};
struct EpiDown {
    static constexpr bool PERM = true, AFTER_DRAIN = false;
    bf16_t* YK; const float* bd; const int* rowtok; const float* rowg;
    __device__ __forceinline__ void operator()(const f32x4 (&acc)[2][2][4][2], const Unit& u, int wr, int wc, int fr, int fq) const {
        const int e = u.pn >> 2, pl = u.pn & 3; const int row0 = u.pm * BM + wr * 64 + fr, col0 = pl * BM + wc * 32 + 8 * fq;
        f32x4 bv[2][2];
#pragma unroll
        for (int bj = 0; bj < 2; ++bj)
#pragma unroll
            for (int n = 0; n < 2; ++n) bv[bj][n] = *(const f32x4*)(bd + (size_t)e * 1024 + col0 + bj * HALF + 4 * n);
#pragma unroll
        for (int ai = 0; ai < 2; ++ai)
#pragma unroll
            for (int m = 0; m < 4; ++m) { const int row = row0 + ai * HALF + m * 16; const int tk = rowtok[row]; const float gt = rowg[row];
                if (tk >= 0) { bf16_t* rowp = YK + (size_t)tk * 1024 + col0;
#pragma unroll
                    for (int bj = 0; bj < 2; ++bj) { const f32x4 v0 = (acc[ai][bj][m][0] + bv[bj][0]) * gt, v1 = (acc[ai][bj][m][1] + bv[bj][1]) * gt;
                        u32x4 w; w.x = cvt_pk_bf16(v0[0], v0[1]); w.y = cvt_pk_bf16(v0[2], v0[3]); w.z = cvt_pk_bf16(v1[0], v1[1]); w.w = cvt_pk_bf16(v1[2], v1[3]);
                        *(u32x4*)(rowp + bj * HALF) = w; } } }
    }
};

template <class Epi, class Sched, bool ALIGN_EPI = false, bool SP2 = false>
__device__ __forceinline__ void gemm_phase(PG8_LAS unsigned char* lds, const Gemm g, const Sched& S, const Epi& E) {
    const int tid = threadIdx.x, wid = __builtin_amdgcn_readfirstlane(tid >> 6), lane = tid & 63, wr = wid >> 2, wc = wid & 3, fr = lane & 15, fq = lane >> 4;
    const int K = g.K, nt = K / BK;
    unsigned voffA[2], voffB[2];
#pragma unroll
    for (int i = 0; i < 2; ++i) { int R, C; stage_rc(tid * 16 + i * 8192, R, C); const int Rb = Epi::PERM ? ((R & ~31) + perm32(R & 31)) : R;
        voffA[i] = (unsigned)(R * K + C) * 2u; voffB[i] = (unsigned)(Rb * K + C) * 2u; }
    const size_t kstep = (size_t)(BK * 2);
    const size_t hstep = (size_t)HALF * K * 2;
    const size_t tstep = 2 * hstep;
    const unsigned ldsw = (unsigned)wid * 1024u;
    const int aoff = lds_byte(wr * 64 + fr, fq * 8), boff = lds_byte(wc * 32 + fr, fq * 8);
#define PG8_SA(b, h) (((b) * 2 + (h)) * HTB)
#define PG8_SB(b, h) ((4 + (b) * 2 + (h)) * HTB)
#define PG8_STAGE(bufoff, gbase, voff) do { _Pragma("unroll") for (int _i = 0; _i < 2; ++_i) \
        __builtin_amdgcn_global_load_lds((const unsigned*)((const char*)(gbase) + (voff)[_i]), (PG8_LAS unsigned*)(lds + (bufoff) + ldsw + _i * 8192), 16, 0, 0); } while (0)
#define PG8_LDA(dst, b, h) do { _Pragma("unroll") for (int m = 0; m < 4; ++m) _Pragma("unroll") for (int k = 0; k < 2; ++k) dst[m][k] = *(const PG8_LAS bf16x8*)(lds + PG8_SA(b, h) + aoff + m * 2048 + k * 1024); } while (0)
#define PG8_LDB(dst, b, h) do { _Pragma("unroll") for (int n = 0; n < 2; ++n) _Pragma("unroll") for (int k = 0; k < 2; ++k) dst[n][k] = *(const PG8_LAS bf16x8*)(lds + PG8_SB(b, h) + boff + n * 2048 + k * 1024); } while (0)
#define PG8_MMA(ai, bj, At, Bt) do { __builtin_amdgcn_s_setprio(1); _Pragma("unroll") for (int m = 0; m < 4; ++m) _Pragma("unroll") for (int n = 0; n < 2; ++n) _Pragma("unroll") for (int k = 0; k < 2; ++k) \
        acc[ai][bj][m][n] = __builtin_amdgcn_mfma_f32_16x16x32_bf16(Bt[n][k], At[m][k], acc[ai][bj][m][n], 0, 0, 0); __builtin_amdgcn_s_setprio(0); } while (0)
#define PG8_WAIT_V(n) asm volatile("s_waitcnt vmcnt(" #n ")" ::: "memory")
#define PG8_WAIT_L(n) asm volatile("s_waitcnt lgkmcnt(" #n ")" ::: "memory")
#define PG8_BAR __builtin_amdgcn_s_barrier()
#define PG8_SCHED __builtin_amdgcn_sched_barrier(0)
    Unit cur, nxt; int ui = 0;
    if (!S.next(0, cur)) return;
    f32x4 acc[2][2][4][2];
#pragma unroll
    for (int a = 0; a < 2; ++a)
#pragma unroll
        for (int b = 0; b < 2; ++b)
#pragma unroll
            for (int m = 0; m < 4; ++m)
#pragma unroll
                for (int n = 0; n < 2; ++n) acc[a][b][m][n] = (f32x4){0.f, 0.f, 0.f, 0.f};
    bf16x8 At[4][2], B0[2][2], B1[2][2];
    const char* cA = (const char*)g.A + (size_t)cur.pm * tstep; const char* cB = (const char*)g.Bt + (size_t)cur.pn * tstep;
    S.a_ready(cur);
    if constexpr (SP2) {
        PG8_STAGE(PG8_SB(0, 0), cB, voffB); PG8_STAGE(PG8_SB(0, 1), cB + hstep, voffB); PG8_STAGE(PG8_SA(0, 0), cA, voffA); PG8_STAGE(PG8_SA(0, 1), cA + hstep, voffA);
        if (wr == 1) PG8_BAR;
        PG8_WAIT_V(2); PG8_BAR;
        PG8_STAGE(PG8_SB(1, 0), cB + kstep, voffB); PG8_STAGE(PG8_SA(1, 0), cA + kstep, voffA); PG8_STAGE(PG8_SB(1, 1), cB + hstep + kstep, voffB);
        PG8_WAIT_V(6); PG8_BAR;
    } else {
        PG8_STAGE(PG8_SB(0, 0), cB, voffB); PG8_STAGE(PG8_SA(0, 0), cA, voffA); PG8_STAGE(PG8_SB(0, 1), cB + hstep, voffB); PG8_STAGE(PG8_SA(0, 1), cA + hstep, voffA);
        if (wr == 1) PG8_BAR;
        PG8_WAIT_V(4); PG8_BAR;
        PG8_STAGE(PG8_SB(1, 0), cB + kstep, voffB); PG8_STAGE(PG8_SA(1, 0), cA + kstep, voffA); PG8_STAGE(PG8_SB(1, 1), cB + hstep + kstep, voffB);
        PG8_WAIT_V(6); PG8_BAR;
    }
    for (;;) {
        const bool has_next = S.next(ui + 1, nxt);
        const char* nA = has_next ? (const char*)g.A + (size_t)nxt.pm * tstep : cA; const char* nB = has_next ? (const char*)g.Bt + (size_t)nxt.pn * tstep : cB;
        for (int t = 0; t < nt; t += 2) {
            const bool last = (t == nt - 2);
            const char* a1 = cA + (size_t)(t + 1) * kstep;
            const char* a2 = last ? nA : cA + (size_t)(t + 2) * kstep; const char* b2 = last ? nB : cB + (size_t)(t + 2) * kstep;
            const char* a3 = a2 + kstep; const char* b3 = b2 + kstep;
            if (last && has_next) S.a_ready(nxt);
            if constexpr (SP2) {
            PG8_LDB(B0, 0, 0); PG8_LDB(B1, 0, 1); PG8_SCHED; PG8_LDA(At, 0, 0); PG8_STAGE(PG8_SA(1, 1), a1 + hstep, voffA);
            PG8_WAIT_V(8); PG8_WAIT_L(0); PG8_BAR; PG8_MMA(0, 0, At, B0); PG8_MMA(0, 1, At, B1); PG8_BAR; PG8_SCHED;
            PG8_LDA(At, 0, 1); PG8_STAGE(PG8_SB(0, 0), b2, voffB); PG8_STAGE(PG8_SB(0, 1), b2 + hstep, voffB); PG8_STAGE(PG8_SA(0, 0), a2, voffA);
            PG8_WAIT_V(8); PG8_WAIT_L(0); PG8_BAR; PG8_MMA(1, 0, At, B0); PG8_MMA(1, 1, At, B1); PG8_BAR; PG8_SCHED;
            PG8_LDB(B0, 1, 0); PG8_LDB(B1, 1, 1); PG8_SCHED; PG8_LDA(At, 1, 0); PG8_STAGE(PG8_SA(0, 1), a2 + hstep, voffA);
            PG8_WAIT_V(8); PG8_WAIT_L(0); PG8_BAR; PG8_MMA(0, 0, At, B0); PG8_MMA(0, 1, At, B1); PG8_BAR; PG8_SCHED;
            PG8_LDA(At, 1, 1); PG8_STAGE(PG8_SB(1, 0), b3, voffB); PG8_STAGE(PG8_SB(1, 1), b3 + hstep, voffB); PG8_STAGE(PG8_SA(1, 0), a3, voffA);
            PG8_WAIT_V(8); PG8_WAIT_L(0); PG8_BAR; PG8_MMA(1, 0, At, B0); PG8_MMA(1, 1, At, B1); PG8_BAR; PG8_SCHED;
            } else {
            PG8_LDB(B0, 0, 0); PG8_SCHED; PG8_LDA(At, 0, 0); PG8_STAGE(PG8_SA(1, 1), a1 + hstep, voffA);
            PG8_WAIT_L(8); PG8_BAR; PG8_WAIT_L(0); PG8_MMA(0, 0, At, B0); PG8_BAR; PG8_SCHED;
            PG8_LDB(B1, 0, 1); PG8_STAGE(PG8_SB(0, 0), b2, voffB);
            PG8_BAR; PG8_WAIT_L(0); PG8_MMA(0, 1, At, B1); PG8_BAR;
            PG8_LDA(At, 0, 1); PG8_STAGE(PG8_SA(0, 0), a2, voffA);
            PG8_BAR; PG8_WAIT_L(0); PG8_MMA(1, 0, At, B0); PG8_BAR; PG8_SCHED;
            PG8_STAGE(PG8_SB(0, 1), b2 + hstep, voffB);
            PG8_WAIT_V(6); PG8_BAR; PG8_MMA(1, 1, At, B1); PG8_BAR;
            PG8_LDB(B0, 1, 0); PG8_SCHED; PG8_LDA(At, 1, 0); PG8_STAGE(PG8_SA(0, 1), a2 + hstep, voffA);
            PG8_WAIT_L(8); PG8_BAR; PG8_WAIT_L(0); PG8_MMA(0, 0, At, B0); PG8_BAR; PG8_SCHED;
            PG8_LDB(B1, 1, 1); PG8_STAGE(PG8_SB(1, 0), b3, voffB);
            PG8_BAR; PG8_WAIT_L(0); PG8_MMA(0, 1, At, B1); PG8_BAR;
            PG8_LDA(At, 1, 1); PG8_STAGE(PG8_SA(1, 0), a3, voffA);
            PG8_BAR; PG8_WAIT_L(0); PG8_MMA(1, 0, At, B0); PG8_BAR; PG8_SCHED;
            PG8_STAGE(PG8_SB(1, 1), b3 + hstep, voffB);
            PG8_WAIT_V(6); PG8_BAR; PG8_MMA(1, 1, At, B1); PG8_BAR;
            }
        }
        if constexpr (ALIGN_EPI) { if (wr == 0) PG8_BAR; }
        if constexpr (!Epi::AFTER_DRAIN) { E(acc, cur, wr, wc, fr, fq); S.done(cur); }
        if (!has_next) break;
#pragma unroll
        for (int a = 0; a < 2; ++a)
#pragma unroll
            for (int b = 0; b < 2; ++b)
#pragma unroll
                for (int m = 0; m < 4; ++m)
#pragma unroll
                    for (int n = 0; n < 2; ++n) acc[a][b][m][n] = (f32x4){0.f, 0.f, 0.f, 0.f};
        cur = nxt; cA = nA; cB = nB; ++ui;
        if constexpr (ALIGN_EPI) { if (wr == 1) PG8_BAR; }
    }
    PG8_WAIT_V(0);
    if constexpr (!ALIGN_EPI) { if (wr == 0) PG8_BAR; }
    PG8_BAR;
    if constexpr (Epi::AFTER_DRAIN) { E.fused(acc, cur, wr, wc, fr, fq, lds, wid, lane); S.done(cur); }
#undef PG8_SA
#undef PG8_SB
#undef PG8_STAGE
#undef PG8_LDA
#undef PG8_LDB
#undef PG8_MMA
#undef PG8_WAIT_V
#undef PG8_WAIT_L
#undef PG8_BAR
#undef PG8_SCHED
}
}

#ifndef PG8_SP2
#define PG8_SP2 true
#endif
#ifndef PG8_ALIGN
#define PG8_ALIGN true
#endif
#define GAS __attribute__((address_space(1)))
#define LAS __attribute__((address_space(3)))
typedef unsigned short bf16;
typedef unsigned v4u __attribute__((ext_vector_type(4)));
typedef float f32x4 __attribute__((ext_vector_type(4)));
typedef short bf16x8 __attribute__((ext_vector_type(8)));
typedef GAS unsigned gu32;
typedef GAS unsigned long long gu64;
#define RLX_AGENT __ATOMIC_RELAXED, __HIP_MEMORY_SCOPE_AGENT
#define LDS_WAIT() asm volatile("s_waitcnt lgkmcnt(0)" ::: "memory")
#define VM_WAIT() asm volatile("s_waitcnt vmcnt(0)" ::: "memory")
__device__ __forceinline__ unsigned long long rt() { return __builtin_amdgcn_s_memrealtime(); }
__device__ __forceinline__ unsigned f2bf(float f) { unsigned u = __builtin_bit_cast(unsigned, f); return (u + 0x7fffu + ((u >> 16) & 1u)) >> 16; }
__device__ __forceinline__ unsigned pk2(float lo, float hi) { return f2bf(lo) | (f2bf(hi) << 16); }

#define XB_TMO      128
#define XB_XCNT(j)  (256  + 64 * (j))
#define XB_XSUB(j)  (1280 + 64 * (j))
#define XB_XGEN(j)  (2304 + 64 * (j))
#define XB_TOP      3328
#define XB_TOPGEN   3392
#define XCD_BAR_WORDS 3456
#define XB_SPIN_CAP (1u << 18)

__device__ __forceinline__ unsigned xb_ld(unsigned* p)              { return __hip_atomic_load(p, __ATOMIC_RELAXED, __HIP_MEMORY_SCOPE_AGENT); }
__device__ __forceinline__ unsigned xb_add(unsigned* p, unsigned v) { return __hip_atomic_fetch_add(p, v, __ATOMIC_RELAXED, __HIP_MEMORY_SCOPE_AGENT); }
__device__ __forceinline__ unsigned xb_xcc_id() { return (unsigned)__builtin_amdgcn_s_getreg((3 << 11) | 20) & 0xFu; }
#define XB_SPIN(cond, bar) do { unsigned _sp = 0; while (cond) { __builtin_amdgcn_s_sleep(1); \
    if ((++_sp & 255u) == 0u) { if (xb_ld(&(bar)[XB_TMO])) break; if (_sp > XB_SPIN_CAP) { atomicAdd(&(bar)[XB_TMO], 1u); break; } } } } while (0)

struct XcdBarrier {
    unsigned* bar; unsigned x;
    volatile LAS unsigned* st;
};

__device__ __forceinline__ XcdBarrier xcd_barrier_post(unsigned* bar, volatile LAS unsigned* st) {
    XcdBarrier b; b.bar = bar; b.x = xb_xcc_id(); b.st = st;
    if (threadIdx.x == 0) (void)xb_add(&bar[XB_XCNT(b.x)], 1u);
    return b;
}
__device__ __forceinline__ void xcd_barrier_complete(unsigned* bar, unsigned x, unsigned& nloc, unsigned& nx) {
    const unsigned G = gridDim.x * gridDim.y * gridDim.z;
    unsigned sum, cnt, mine, sp = 0u;
    for (;;) {
        sum = 0u; cnt = 0u; mine = 0u;
#pragma unroll
        for (unsigned j = 0; j < 16; ++j) { const unsigned c = xb_ld(&bar[XB_XCNT(j)]); sum += c; cnt += (c > 0u) ? 1u : 0u; mine = (j == x) ? c : mine; }
        if (sum == G) break;
        __builtin_amdgcn_s_sleep(1);
        if ((++sp & 255u) == 0u) { if (xb_ld(&bar[XB_TMO])) break; if (sp > XB_SPIN_CAP) { atomicAdd(&bar[XB_TMO], 1u); break; } }
    }
    nloc = mine > 0u ? mine : 1u; nx = cnt > 0u ? cnt : 1u;
}

__device__ __forceinline__ void xcd_barrier(const XcdBarrier& b) {
    asm volatile("s_waitcnt vmcnt(0)" ::: "memory");
    __syncthreads();
    if (threadIdx.x == 0) {
        unsigned* bar = b.bar;
        __builtin_amdgcn_s_waitcnt(0);
        unsigned nloc = b.st[0], nx = b.st[1];
        if (nloc == 0u) { xcd_barrier_complete(bar, b.x, nloc, nx); b.st[0] = nloc; b.st[1] = nx; }
        const unsigned old = xb_add(&bar[XB_XSUB(b.x)], 1u);
        const unsigned gen = old / nloc;
        if (old + 1u == (gen + 1u) * nloc) {
            __builtin_amdgcn_fence(__ATOMIC_RELEASE, "agent");
            asm volatile("s_waitcnt vmcnt(0)" ::: "memory");
            const unsigned og = xb_add(&bar[XB_TOP], 1u);
            const unsigned tg = og / nx;
            if (og + 1u == (tg + 1u) * nx) xb_add(&bar[XB_TOPGEN], 1u);
            else XB_SPIN(xb_ld(&bar[XB_TOPGEN]) == tg, bar);
            __builtin_amdgcn_fence(__ATOMIC_ACQUIRE, "agent");
            xb_add(&bar[XB_XGEN(b.x)], 1u);
            asm volatile("s_waitcnt vmcnt(0)" ::: "memory");
        } else {
            XB_SPIN(xb_ld(&bar[XB_XGEN(b.x)]) == gen, bar);
            __builtin_amdgcn_fence(__ATOMIC_ACQUIRE, "agent");
            asm volatile("s_waitcnt vmcnt(0)" ::: "memory");
        }
    }
    __syncthreads();
}

constexpr int NWAVES = 8;
#ifndef MK_ONE_LAUNCH
#define MK_ONE_LAUNCH 1
#endif

constexpr int BATCH = 16, SEQ = 2048, D = 1024, T = BATCH * SEQ;
constexpr int NIN = 3584;
constexpr int OFF_SQ = 0, OFF_SK = 512, OFF_SV = 1024, OFF_HQ = 1536, OFF_HF = 2048, OFF_HI = 2560, OFF_HG = 3072;
constexpr int NE = 32, TOPK = 4, NASSIGN = T * TOPK;
constexpr int MAXTILES = NASSIGN / 256 + NE;
constexpr int MAXROWS = MAXTILES * 256;
constexpr float EPS = 1e-6f;

constexpr size_t MiB = 1u << 20;
constexpr size_t WS_CTL = 0, CTL_ZERO_BYTES = 1 * MiB;
constexpr size_t WS_WIN = 2 * MiB;
constexpr size_t WS_WOUT = 10 * MiB;
constexpr size_t WS_TAB = 12 * MiB;
constexpr size_t WS_WGU = 16 * MiB;
constexpr size_t WS_WD = 144 * MiB;
constexpr size_t WS_XN = 208 * MiB;
constexpr size_t WS_P = 272 * MiB;
constexpr size_t WS_MIX = 496 * MiB;
constexpr size_t WS_ACT = 272 * MiB;
constexpr size_t WS_XB = 560 * MiB;
constexpr size_t WS_HGO = 560 * MiB;
constexpr size_t WS_YK = 560 * MiB;
constexpr size_t WS_QN = 624 * MiB;
constexpr size_t WS_KN = 656 * MiB;
constexpr size_t WS_VT = 688 * MiB;
constexpr size_t WS_KVS = 720 * MiB;
constexpr size_t WS_DEC = 784 * MiB;
constexpr size_t WS_END = 832 * MiB;
constexpr size_t TB_ASG = WS_TAB;
constexpr size_t TB_TOPG = WS_TAB + 1 * MiB;
constexpr size_t TB_ROWTOK = WS_TAB + 2 * MiB;
constexpr size_t TB_ROWG = WS_TAB + 3 * MiB;
constexpr size_t TB_TILE = WS_TAB + 3 * MiB + 768 * 1024;
static_assert(TB_ROWTOK + (size_t)MAXROWS * 4 <= TB_ROWG && TB_ROWG + (size_t)MAXROWS * 4 <= TB_TILE && TB_TILE + 4096 <= WS_WGU, "table map");
static_assert(WS_ACT + (size_t)MAXROWS * 2048 <= WS_XB && WS_XB + (size_t)MAXROWS * 2048 <= WS_END && WS_MIX + (size_t)T * 2048 <= WS_XB, "d_ws map");
constexpr int CW_TMO = 0, CW_CODE = 1;
constexpr int CW_CNT = 64;
constexpr int CW_BAR = 4096;

constexpr int RING_OFF = 0, RING_BYTES = 131072;
constexpr int LDSCTL_OFF = RING_BYTES, MISC_OFF = LDSCTL_OFF + 320;
constexpr int LTAB_OFF = LDSCTL_OFF + 512;
constexpr int LDS_BYTES = 147456;
static_assert(MISC_OFF + 128 <= LTAB_OFF && LTAB_OFF + (1 + MAXTILES) * 4 <= LDS_BYTES, "LDS map");

struct Frame {
    LAS unsigned char* lds;
    volatile LAS unsigned* MISC;
    gu32* ctl;
    int tid, lane, wave, gw, ngw;
    int vcu, G;
    const float *x, *norm1_g, *w_in, *sb_q_g, *sb_k_g, *sb_out_g, *hg_lb, *hg_out_g, *w_out, *norm2_g, *w_router, *b_router, *w_gu, *b_gu, *w_d, *b_d;
    float* out;
    unsigned char* ws;
};
__device__ __forceinline__ float bf2f(unsigned short b) { return __builtin_bit_cast(float, (unsigned)b << 16); }
__device__ __forceinline__ float bflo(unsigned w) { return __builtin_bit_cast(float, w << 16); }
__device__ __forceinline__ float bfhi(unsigned w) { return __builtin_bit_cast(float, w & 0xffff0000u); }
__device__ __forceinline__ int vzero() { int z; asm volatile("v_mov_b32 %0, 0" : "=v"(z)); return z; }
__device__ __forceinline__ float wave_sum(float v) {
#pragma unroll
    for (int o = 1; o < 64; o <<= 1) v += __shfl_xor(v, o);
    return v;
}

__device__ __forceinline__ void p0_transpose_item(const float* W, int K, int N, bf16* WT, int k0, int n0, int drow0, LAS float* scr, int lane) {
#pragma unroll 8
    for (int i = 0; i < 32; ++i) { const int kk = 2 * i + (lane >> 5); scr[kk * 33 + (lane & 31)] = W[(size_t)(k0 + kk) * N + n0 + (lane & 31)]; }
    LDS_WAIT(); asm volatile("" ::: "memory");
    const int c = lane & 7;
#pragma unroll
    for (int j = 0; j < 4; ++j) { const int n = (lane >> 3) + 8 * j; const LAS float* s = scr + (8 * c) * 33 + n;
        v4u o; o.x = pk2(s[0 * 33], s[1 * 33]); o.y = pk2(s[2 * 33], s[3 * 33]); o.z = pk2(s[4 * 33], s[5 * 33]); o.w = pk2(s[6 * 33], s[7 * 33]);
        *(GAS v4u*)(WT + (size_t)(drow0 + n) * K + k0 + 8 * c) = o; }
    LDS_WAIT(); asm volatile("" ::: "memory");
}
__device__ __forceinline__ void rms_row_to_bf16(const float* xrow, const float* g, bf16* orow, int lane) {
    const GAS f32x4* xr = (const GAS f32x4*)xrow + lane; const f32x4* gr = (const f32x4*)g + lane;
    f32x4 v[4]; float s = 0.f;
#pragma unroll
    for (int j = 0; j < 4; ++j) { v[j] = xr[64 * j]; s += (v[j].x * v[j].x + v[j].y * v[j].y) + (v[j].z * v[j].z + v[j].w * v[j].w); }
    const float rstd = 1.f / sqrtf(wave_sum(s) * (1.f / D) + EPS);
    GAS unsigned long long* o8 = (GAS unsigned long long*)orow + lane;
#pragma unroll
    for (int j = 0; j < 4; ++j) { const f32x4 gg = gr[64 * j];
        o8[64 * j] = (unsigned long long)pk2(v[j].x * rstd * gg.x, v[j].y * rstd * gg.y) | ((unsigned long long)pk2(v[j].z * rstd * gg.z, v[j].w * rstd * gg.w) << 32); }
}
__device__ __forceinline__ void p0_prologue(Frame& F) {
    LAS float* scr = (LAS float*)(F.lds + RING_OFF + F.wave * 16384);
    constexpr int I_IN = 16 * (NIN / 32), I_OUT = 16 * 32, I_GU = NE * 16 * 64, I_D = NE * 16 * 32;
    constexpr int NITEMS = I_IN + I_OUT + I_GU + I_D;
    for (int it = F.gw; it < NITEMS; it += F.ngw) {
        int r = it;
        if (r < I_IN) { const int nb = NIN / 32, kb = r / nb, nn = r % nb; p0_transpose_item(F.w_in, D, NIN, (bf16*)(F.ws + WS_WIN), 64 * kb, 32 * nn, 32 * nn, scr, F.lane); continue; } r -= I_IN;
        if (r < I_OUT) { const int kb = r / 32, nn = r % 32; p0_transpose_item(F.w_out, D, D, (bf16*)(F.ws + WS_WOUT), 64 * kb, 32 * nn, 32 * nn, scr, F.lane); continue; } r -= I_OUT;
        if (r < I_GU) { const int e = r / 1024, q = r % 1024, kb = q / 64, nn = q % 64;
            const int isup = nn >> 5, a = (nn & 31) * 32;
            const int drow = 256 * (a >> 7) + 128 * isup + (a & 127);
            p0_transpose_item(F.w_gu + (size_t)e * D * 2048, D, 2048, (bf16*)(F.ws + WS_WGU) + (size_t)e * 2048 * D, 64 * kb, 32 * nn, drow, scr, F.lane); continue; } r -= I_GU;
        { const int e = r / 512, q = r % 512, kb = q / 32, nn = q % 32;
            p0_transpose_item(F.w_d + (size_t)e * D * D, D, D, (bf16*)(F.ws + WS_WD) + (size_t)e * D * D, 64 * kb, 32 * nn, 32 * nn, scr, F.lane); }
    }
    for (int m = F.gw; m < T; m += F.ngw) rms_row_to_bf16(F.x + (size_t)m * D, F.norm1_g, (bf16*)(F.ws + WS_XN) + (size_t)m * D, F.lane);
    { int* rt = (int*)(F.ws + TB_ROWTOK); for (int i = F.gw * 64 + F.lane; i < MAXROWS; i += F.ngw * 64) rt[i] = -1; }
}

typedef float f32x16 __attribute__((ext_vector_type(16)));
typedef __bf16 bf16x2n __attribute__((ext_vector_type(2)));
typedef float f32x2n __attribute__((ext_vector_type(2)));
#define MFMA32(a, b, c) __builtin_amdgcn_mfma_f32_32x32x16_bf16((a), (b), (c), 0, 0, 0)
__device__ __forceinline__ unsigned pkbf(float a, float b) { const bf16x2n v = __builtin_convertvector((f32x2n){a, b}, bf16x2n); return __builtin_bit_cast(unsigned, v); }
__device__ __forceinline__ bf16x8 pack8(float a0, float a1, float a2, float a3, float a4, float a5, float a6, float a7) { const v4u p = {pkbf(a0, a1), pkbf(a2, a3), pkbf(a4, a5), pkbf(a6, a7)}; return __builtin_bit_cast(bf16x8, p); }
constexpr float QSCALE = 0.125f * 1.44269504089f;
__device__ __forceinline__ void prep_phase(Frame& F) {
    LAS unsigned* tl = (LAS unsigned*)(F.lds + RING_OFF + F.wave * 16384);
    const bf16* P = (const bf16*)(F.ws + WS_P); bf16* Qn = (bf16*)(F.ws + WS_QN); bf16* Kn = (bf16*)(F.ws + WS_KN); bf16* VT = (bf16*)(F.ws + WS_VT);
    for (int it = F.gw; it < 4096; it += F.ngw) {
        const int bh = it & 127, blk = it >> 7, b = bh >> 3, h = bh & 7, s = blk * 64 + F.lane;
        const bf16* row = P + ((size_t)b * SEQ + s) * NIN;
#pragma unroll
        for (int which = 0; which < 2; ++which) {
            const GAS v4u* p = (const GAS v4u*)(row + (which ? OFF_SK : OFF_SQ) + h * 64); float v[64]; float ss = 0.f;
#pragma unroll
            for (int c = 0; c < 8; ++c) { const v4u r4 = p[c]; v[8 * c + 0] = bflo(r4.x); v[8 * c + 1] = bfhi(r4.x); v[8 * c + 2] = bflo(r4.y); v[8 * c + 3] = bfhi(r4.y); v[8 * c + 4] = bflo(r4.z); v[8 * c + 5] = bfhi(r4.z); v[8 * c + 6] = bflo(r4.w); v[8 * c + 7] = bfhi(r4.w); }
#pragma unroll
            for (int d = 0; d < 64; ++d) ss += v[d] * v[d];
            const float rs = (1.f / sqrtf(ss * (1.f / 64.f) + EPS)) * (which ? 1.0f : QSCALE);
            const float* g = which ? F.sb_k_g : F.sb_q_g;
            GAS v4u* o = (GAS v4u*)((which ? Kn : Qn) + ((size_t)bh * SEQ + s) * 64);
#pragma unroll
            for (int c = 0; c < 8; ++c) { v4u w4; w4.x = pkbf(v[8 * c + 0] * rs * g[8 * c + 0], v[8 * c + 1] * rs * g[8 * c + 1]); w4.y = pkbf(v[8 * c + 2] * rs * g[8 * c + 2], v[8 * c + 3] * rs * g[8 * c + 3]);
                w4.z = pkbf(v[8 * c + 4] * rs * g[8 * c + 4], v[8 * c + 5] * rs * g[8 * c + 5]); w4.w = pkbf(v[8 * c + 6] * rs * g[8 * c + 6], v[8 * c + 7] * rs * g[8 * c + 7]); o[c] = w4; }
        }
        {
            const GAS v4u* p = (const GAS v4u*)(row + OFF_SV + h * 64);
#pragma unroll
            for (int c = 0; c < 8; ++c) { const v4u r4 = p[c]; tl[F.lane * 33 + 4 * c + 0] = r4.x; tl[F.lane * 33 + 4 * c + 1] = r4.y; tl[F.lane * 33 + 4 * c + 2] = r4.z; tl[F.lane * 33 + 4 * c + 3] = r4.w; }
            LDS_WAIT(); asm volatile("" ::: "memory");
            const LAS unsigned short* t16 = (const LAS unsigned short*)tl; unsigned val[64];
#pragma unroll
            for (int k = 0; k < 64; ++k) val[k] = t16[k * 66 + F.lane];
            GAS v4u* o = (GAS v4u*)(VT + ((size_t)bh * 64 + F.lane) * SEQ + blk * 64);
#define KAP(pos) (((pos) & ~12) | (((pos) & 4) << 1) | (((pos) & 8) >> 1))
#pragma unroll
            for (int c = 0; c < 8; ++c) { v4u w4;
                w4.x = val[KAP(8 * c + 0)] | (val[KAP(8 * c + 1)] << 16); w4.y = val[KAP(8 * c + 2)] | (val[KAP(8 * c + 3)] << 16);
                w4.z = val[KAP(8 * c + 4)] | (val[KAP(8 * c + 5)] << 16); w4.w = val[KAP(8 * c + 6)] | (val[KAP(8 * c + 7)] << 16); o[c] = w4; }
#undef KAP
            LDS_WAIT(); asm volatile("" ::: "memory");
        }
    }
}

__device__ __forceinline__ int crow16(int i, int hh) { return (i & 3) + 8 * (i >> 2) + 4 * hh; }
__device__ __forceinline__ void attn_item(Frame& F, int bh, int qb, float thr, const bf16x8 (&Lt)[2]) {
    const int r = F.lane & 31, hh = F.lane >> 5, b = bh >> 3, h = bh & 7, q0 = qb * 32;
    const bf16* Qn = (const bf16*)(F.ws + WS_QN); const bf16* Kn = (const bf16*)(F.ws + WS_KN); const bf16* VT = (const bf16*)(F.ws + WS_VT);
    bf16x8 qf[4];
#pragma unroll
    for (int s = 0; s < 4; ++s) qf[s] = *(const GAS bf16x8*)(Qn + ((size_t)bh * SEQ + q0 + r) * 64 + 16 * s + 8 * hh);
    f32x16 O0, O1;
#pragma unroll
    for (int i = 0; i < 16; ++i) { O0[i] = 0.f; O1[i] = 0.f; }
    float carry = 0.f;
    for (int kb = qb; kb >= 0; --kb) {
        const bool diag = (kb == qb);
        bf16x8 kf[4], vf[2][2];
#pragma unroll
        for (int s = 0; s < 4; ++s) kf[s] = *(const GAS bf16x8*)(Kn + ((size_t)bh * SEQ + kb * 32 + r) * 64 + 16 * s + 8 * hh);
#pragma unroll
        for (int db = 0; db < 2; ++db)
#pragma unroll
            for (int ks = 0; ks < 2; ++ks) vf[db][ks] = *(const GAS bf16x8*)(VT + ((size_t)bh * 64 + db * 32 + r) * SEQ + kb * 32 + 16 * ks + 8 * hh);
        f32x16 z;
#pragma unroll
        for (int i = 0; i < 16; ++i) z[i] = 0.f;
#pragma unroll
        for (int s = 0; s < 4; ++s) z = MFMA32(kf[s], qf[s], z);
        float sp[16];
#pragma unroll
        for (int i = 0; i < 16; ++i) { const float zz = z[i]; float v = fmaxf(zz, 0.f) + __builtin_amdgcn_logf(1.f + __builtin_amdgcn_exp2f(-fabsf(zz)));
            if (diag && !(crow16(i, hh) < r)) v = 0.f; sp[i] = v; }
        const bf16x8 sb0 = pack8(sp[0], sp[1], sp[2], sp[3], sp[4], sp[5], sp[6], sp[7]), sb1 = pack8(sp[8], sp[9], sp[10], sp[11], sp[12], sp[13], sp[14], sp[15]);
        f32x16 Cc;
#pragma unroll
        for (int i = 0; i < 16; ++i) Cc[i] = carry;
        Cc = MFMA32(Lt[0], sb0, Cc); Cc = MFMA32(Lt[1], sb1, Cc);
        float w[16];
#pragma unroll
        for (int i = 0; i < 16; ++i) { float v = __builtin_amdgcn_exp2f(z[i] - Cc[i]); if (diag && !(crow16(i, hh) < r)) v = 0.f; w[i] = v; }
        const bf16x8 wb0 = pack8(w[0], w[1], w[2], w[3], w[4], w[5], w[6], w[7]), wb1 = pack8(w[8], w[9], w[10], w[11], w[12], w[13], w[14], w[15]);
        O0 = MFMA32(vf[0][0], wb0, O0); O0 = MFMA32(vf[0][1], wb1, O0);
        O1 = MFMA32(vf[1][0], wb0, O1); O1 = MFMA32(vf[1][1], wb1, O1);
        carry = __shfl(Cc[0], r);
        if (__all(carry > thr)) break;
    }
    float ss = 0.f;
#pragma unroll
    for (int i = 0; i < 16; ++i) ss += O0[i] * O0[i] + O1[i] * O1[i];
    ss += __shfl_xor(ss, 32);
    const float rs = 1.f / sqrtf(ss * (1.f / 64.f) + EPS);
    bf16* orow = (bf16*)(F.ws + WS_MIX) + ((size_t)b * SEQ + q0 + r) * D + h * 64; const float* g = F.sb_out_g + h * 64;
#pragma unroll
    for (int db = 0; db < 2; ++db)
#pragma unroll
        for (int gq = 0; gq < 4; ++gq) { const int d = 32 * db + 8 * gq + 4 * hh; const f32x4 gg = *(const f32x4*)(g + d);
            const float a0 = (db ? O1[4 * gq + 0] : O0[4 * gq + 0]) * rs * gg.x, a1 = (db ? O1[4 * gq + 1] : O0[4 * gq + 1]) * rs * gg.y, a2 = (db ? O1[4 * gq + 2] : O0[4 * gq + 2]) * rs * gg.z, a3 = (db ? O1[4 * gq + 3] : O0[4 * gq + 3]) * rs * gg.w;
            *(GAS unsigned long long*)(orow + d) = (unsigned long long)pkbf(a0, a1) | ((unsigned long long)pkbf(a2, a3) << 32); }
}
__device__ __forceinline__ void attn_phase(Frame& F) {
    const int r = F.lane & 31, hh = F.lane >> 5;
    float mq = fabsf(F.sb_q_g[F.lane]), mk = fabsf(F.sb_k_g[F.lane]);
#pragma unroll
    for (int o = 1; o < 64; o <<= 1) { mq = fmaxf(mq, __shfl_xor(mq, o)); mk = fmaxf(mk, __shfl_xor(mk, o)); }
    const float thr = 64.f * QSCALE * mq * mk * 1.02f + 170.f;
    bf16x8 Lt[2];
#pragma unroll
    for (int ks = 0; ks < 2; ++ks) { float e[8];
#pragma unroll
        for (int jj = 0; jj < 8; ++jj) e[jj] = (16 * ks + 8 * (jj >> 2) + 4 * hh + (jj & 3) >= r) ? 1.f : 0.f;
        Lt[ks] = pack8(e[0], e[1], e[2], e[3], e[4], e[5], e[6], e[7]); }
    for (int it = F.gw; it < 2048; it += F.ngw) { const int bh = it & 127, j = it >> 7;
        attn_item(F, bh, 63 - j, thr, Lt); attn_item(F, bh, j, thr, Lt); attn_item(F, bh, 47 - j, thr, Lt); attn_item(F, bh, 16 + j, thr, Lt); }
}

__device__ __forceinline__ void hgrn_naive_phase(Frame& F) {
    LAS float* sc = (LAS float*)(F.lds + RING_OFF + F.wave * 16384);
    const bf16* P = (const bf16*)(F.ws + WS_P); float* HGO = (float*)(F.ws + WS_HGO);
    for (int it = F.gw; it < 128; it += F.ngw) {
        const int bh = it >> 1, half = it & 1, b = bh >> 2, h = bh & 3;
        float S[128];
#pragma unroll
        for (int d = 0; d < 128; ++d) S[d] = 0.f;
        float lb[2];
#pragma unroll
        for (int j = 0; j < 2; ++j) { const int c = h * 128 + F.lane + 64 * j; lb[j] = 1.f / (1.f + __expf(F.hg_lb[512 + c] - F.hg_lb[c])); }
        for (int t = 0; t < SEQ; ++t) {
            const bf16* row = P + ((size_t)b * SEQ + t) * NIN;
#pragma unroll
            for (int j = 0; j < 2; ++j) { const int d = F.lane + 64 * j; const float ff = bf2f(row[OFF_HF + h * 128 + d]); const float sg = 1.f / (1.f + __expf(-ff));
                sc[d] = lb[j] + (1.f - lb[j]) * sg; sc[128 + d] = (1.f - lb[j]) * (1.f - sg); sc[256 + d] = bf2f(row[OFF_HQ + h * 128 + d]); }
            const float v = bf2f(row[OFF_HI + h * 128 + half * 64 + F.lane]);
            LDS_WAIT(); asm volatile("" ::: "memory");
            float o = 0.f;
#pragma unroll
            for (int d4 = 0; d4 < 32; ++d4) { const f32x4 f4 = *(const LAS f32x4*)(sc + 4 * d4), k4 = *(const LAS f32x4*)(sc + 128 + 4 * d4), q4 = *(const LAS f32x4*)(sc + 256 + 4 * d4);
#pragma unroll
                for (int j = 0; j < 4; ++j) { S[4 * d4 + j] = f4[j] * S[4 * d4 + j] + k4[j] * v; o += q4[j] * S[4 * d4 + j]; } }
            HGO[((size_t)b * SEQ + t) * 512 + h * 128 + half * 64 + F.lane] = o;
            LDS_WAIT(); asm volatile("" ::: "memory");
        }
    }
}
__device__ __forceinline__ void hgnorm_phase(Frame& F) {
    const bf16* P = (const bf16*)(F.ws + WS_P); const float* HGO = (const float*)(F.ws + WS_HGO); bf16* MIX = (bf16*)(F.ws + WS_MIX);
    for (int t = F.gw; t < T; t += F.ngw) {
        const GAS f32x4* op = (const GAS f32x4*)(HGO + (size_t)t * 512) + 2 * F.lane; const f32x4 a = op[0], b2 = op[1];
        float v[8] = {a.x, a.y, a.z, a.w, b2.x, b2.y, b2.z, b2.w}; float s = 0.f;
#pragma unroll
        for (int j = 0; j < 8; ++j) s += v[j] * v[j];
        s += __shfl_xor(s, 1); s += __shfl_xor(s, 2); s += __shfl_xor(s, 4); s += __shfl_xor(s, 8);
        const float r = 1.f / sqrtf(s * (1.f / 128.f) + EPS);
        const v4u graw = *((const GAS v4u*)(P + (size_t)t * NIN + OFF_HG) + F.lane);
        float gt[8] = {bflo(graw.x), bfhi(graw.x), bflo(graw.y), bfhi(graw.y), bflo(graw.z), bfhi(graw.z), bflo(graw.w), bfhi(graw.w)};
        const float* g = F.hg_out_g + 8 * F.lane; float y[8];
#pragma unroll
        for (int j = 0; j < 8; ++j) { const float si = gt[j] / (1.f + __expf(-gt[j])); y[j] = v[j] * r * g[j] * si; }
        v4u o; o.x = pk2(y[0], y[1]); o.y = pk2(y[2], y[3]); o.z = pk2(y[4], y[5]); o.w = pk2(y[6], y[7]);
        *((GAS v4u*)(MIX + (size_t)t * D + 512) + F.lane) = o;
    }
}

__device__ __forceinline__ void router_phase(Frame& F) {
    LAS float* hs = (LAS float*)(F.lds + RING_OFF + F.wave * 16384);
    const float* X1 = F.out; bf16* H2 = (bf16*)(F.ws + WS_XN);
    int* ASG = (int*)(F.ws + TB_ASG); float* TOPG = (float*)(F.ws + TB_TOPG); unsigned* cnt = (unsigned*)(F.ctl + CW_CNT);
    const int e = F.lane & 31, kh = F.lane >> 5;
    for (int t = F.gw; t < T; t += F.ngw) {
        const GAS f32x4* xr = (const GAS f32x4*)(X1 + (size_t)t * D) + F.lane; const f32x4* gr = (const f32x4*)F.norm2_g + F.lane;
        f32x4 v[4]; float s = 0.f;
#pragma unroll
        for (int j = 0; j < 4; ++j) { v[j] = xr[64 * j]; s += (v[j].x * v[j].x + v[j].y * v[j].y) + (v[j].z * v[j].z + v[j].w * v[j].w); }
        const float rstd = 1.f / sqrtf(wave_sum(s) * (1.f / D) + EPS);
        GAS unsigned long long* o8 = (GAS unsigned long long*)(H2 + (size_t)t * D) + F.lane;
#pragma unroll
        for (int j = 0; j < 4; ++j) { const f32x4 gg = gr[64 * j]; const f32x4 hv = (f32x4){v[j].x * rstd * gg.x, v[j].y * rstd * gg.y, v[j].z * rstd * gg.z, v[j].w * rstd * gg.w};
            o8[64 * j] = (unsigned long long)pk2(hv.x, hv.y) | ((unsigned long long)pk2(hv.z, hv.w) << 32);
            *(LAS f32x4*)(hs + 4 * (F.lane + 64 * j)) = hv; }
        LDS_WAIT(); asm volatile("" ::: "memory");
        float acc = 0.f; const float* wr = F.w_router + (size_t)(512 * kh) * NE + e; const LAS float* hp = hs + 512 * kh;
#pragma unroll 8
        for (int k4 = 0; k4 < 128; ++k4) { const f32x4 h4 = *(const LAS f32x4*)(hp + 4 * k4);
            acc += h4.x * wr[(4 * k4 + 0) * NE]; acc += h4.y * wr[(4 * k4 + 1) * NE]; acc += h4.z * wr[(4 * k4 + 2) * NE]; acc += h4.w * wr[(4 * k4 + 3) * NE]; }
        acc += __shfl_xor(acc, 32);
        float val = acc + F.b_router[e];
        float sv[4]; int se[4];
#pragma unroll
        for (int r = 0; r < 4; ++r) { float bv = val; int bi = e;
#pragma unroll
            for (int off = 1; off < 32; off <<= 1) { const float ov = __shfl_xor(bv, off); const int oi = __shfl_xor(bi, off); if (ov > bv || (ov == bv && oi < bi)) { bv = ov; bi = oi; } }
            sv[r] = bv; se[r] = bi; if (e == bi) val = -__builtin_inff(); }
        const float e1 = __expf(sv[1] - sv[0]), e2 = __expf(sv[2] - sv[0]), e3 = __expf(sv[3] - sv[0]); const float inv = 1.f / (1.f + e1 + e2 + e3);
        if (F.lane < 4) { const int my_e = F.lane == 0 ? se[0] : F.lane == 1 ? se[1] : F.lane == 2 ? se[2] : se[3];
            const float my_g = (F.lane == 0 ? 1.f : F.lane == 1 ? e1 : F.lane == 2 ? e2 : e3) * inv;
            const unsigned pos = __hip_atomic_fetch_add(cnt + my_e, 1u, __ATOMIC_RELAXED, __HIP_MEMORY_SCOPE_AGENT);
            ASG[((size_t)t * 4 + F.lane) * 2] = my_e; ASG[((size_t)t * 4 + F.lane) * 2 + 1] = (int)pos; TOPG[(size_t)t * 4 + F.lane] = my_g; }
        LDS_WAIT(); asm volatile("" ::: "memory");
    }
}
__device__ __forceinline__ int expert_starts(Frame& F, int& my_cnt, int& total_tiles) {
    const int e = F.lane & 31; const int c = (int)__hip_atomic_load((unsigned*)(F.ctl + CW_CNT) + e, __ATOMIC_RELAXED, __HIP_MEMORY_SCOPE_AGENT);
    const int tl = (c + 255) >> 8; int inc = tl;
#pragma unroll
    for (int off = 1; off < 32; off <<= 1) { const int o = __shfl_up(inc, off, 32); if (e >= off) inc += o; }
    total_tiles = __shfl(inc, 31, 32); my_cnt = c; return (inc - tl) * 256;
}
__device__ __forceinline__ void gather_phase(Frame& F) {
    const bf16* H2 = (const bf16*)(F.ws + WS_XN); bf16* XB = (bf16*)(F.ws + WS_XB);
    const int* ASG = (const int*)(F.ws + TB_ASG); const float* TOPG = (const float*)(F.ws + TB_TOPG);
    int* ROWTOK = (int*)(F.ws + TB_ROWTOK); float* ROWG = (float*)(F.ws + TB_ROWG); int* TILE = (int*)(F.ws + TB_TILE);
    int my_cnt, ntiles; const int my_start = expert_starts(F, my_cnt, ntiles);
    if (F.gw == 0) {
        if (F.lane == 0) TILE[0] = ntiles;
        if (F.lane < 32) { const int t0 = my_start >> 8, nt = (my_cnt + 255) >> 8; for (int i = 0; i < nt; ++i) TILE[1 + t0 + i] = F.lane; }
    }
    const int vz = vzero();
    for (int t = F.gw; t < T; t += F.ngw) {
        const GAS v4u* src = (const GAS v4u*)(H2 + (size_t)t * D) + 2 * F.lane; const v4u a = src[0], b2 = src[1];
#pragma unroll
        for (int k = 0; k < 4; ++k) { const int e = ASG[((size_t)t * 4 + k) * 2 + vz], pos = ASG[((size_t)t * 4 + k) * 2 + 1 + vz]; const float g = TOPG[(size_t)t * 4 + k + vz];
            const int dest = __shfl(my_start, e, 64) + pos;
            GAS v4u* dst = (GAS v4u*)(XB + (size_t)dest * D) + 2 * F.lane; dst[0] = a; dst[1] = b2;
            if (F.lane == 0) { ROWTOK[dest] = t * 4 + k; ROWG[dest] = g; } }
    }
}
__device__ __forceinline__ int load_tile_table(Frame& F) {
    const int* TILE = (const int*)(F.ws + TB_TILE); LAS int* lt = (LAS int*)(F.lds + LTAB_OFF);
    for (int i = F.tid; i < 1 + MAXTILES; i += NWAVES * 64) lt[i] = TILE[i];
    __syncthreads();
    int nt = lt[0]; nt = nt < 0 ? 0 : (nt > MAXTILES ? MAXTILES : nt); return __builtin_amdgcn_readfirstlane(nt);
}
__device__ __forceinline__ void combine_phase(Frame& F) {
    const bf16* YK = (const bf16*)(F.ws + WS_YK);
    for (int t = F.gw; t < T; t += F.ngw) {
        GAS f32x4* xr = (GAS f32x4*)(F.out + (size_t)t * D) + F.lane;
#pragma unroll
        for (int j = 0; j < 4; ++j) { f32x4 v = xr[64 * j];
#pragma unroll
            for (int k = 0; k < 4; ++k) { const unsigned long long y = *((const GAS unsigned long long*)(YK + ((size_t)t * 4 + k) * D) + F.lane + 64 * j);
                const unsigned lo = (unsigned)y, hi = (unsigned)(y >> 32); v.x += bflo(lo); v.y += bfhi(lo); v.z += bflo(hi); v.w += bfhi(hi); }
            xr[64 * j] = v; }
    }
}

constexpr int NPH = 12;
struct Args { const float* in[16]; float* out; unsigned char* ws; int ph_lo, ph_hi; };
__global__ void __launch_bounds__(NWAVES * 64, 2) fwd(Args args) {
    extern __shared__ __attribute__((aligned(16))) unsigned char lds[];
    Frame F;
    F.lds = (LAS unsigned char*)lds;
    F.MISC = (volatile LAS unsigned*)(F.lds + MISC_OFF);
    F.tid = threadIdx.x; F.lane = F.tid & 63; F.wave = __builtin_amdgcn_readfirstlane(F.tid >> 6);
    F.G = gridDim.x; { const int bx = blockIdx.x; F.vcu = (F.G % 8 == 0) ? (bx % 8) * (F.G / 8) + bx / 8 : bx; }
    F.gw = blockIdx.x * NWAVES + F.wave; F.ngw = F.G * NWAVES;
    F.ws = args.ws; F.ctl = (gu32*)(args.ws + WS_CTL); F.out = args.out;
    F.x = args.in[0]; F.norm1_g = args.in[1]; F.w_in = args.in[2]; F.sb_q_g = args.in[3]; F.sb_k_g = args.in[4]; F.sb_out_g = args.in[5]; F.hg_lb = args.in[6]; F.hg_out_g = args.in[7];
    F.w_out = args.in[8]; F.norm2_g = args.in[9]; F.w_router = args.in[10]; F.b_router = args.in[11]; F.w_gu = args.in[12]; F.b_gu = args.in[13]; F.w_d = args.in[14]; F.b_d = args.in[15];
    for (int u = F.tid; u < (LDS_BYTES - LDSCTL_OFF) / 4; u += NWAVES * 64) ((LAS unsigned*)(F.lds + LDSCTL_OFF))[u] = 0u;
    __syncthreads();
    XcdBarrier bar; bar.bar = (unsigned*)(F.ctl + CW_BAR); bar.x = 0; bar.st = nullptr;
    if (MK_ONE_LAUNCH) bar = xcd_barrier_post((unsigned*)(F.ctl + CW_BAR), F.MISC + 8);
    const int lo = args.ph_lo, hi = args.ph_hi;
#define IN(k) (lo <= (k) && (k) < hi)
#define SEAM(k) do { if (IN(k) && IN((k) + 1)) xcd_barrier(bar); } while (0)

    if (IN(0)) { p0_prologue(F); } SEAM(0);
    if (IN(1)) {
        pg8::Gemm g{(const bf16*)(F.ws + WS_XN), (const bf16*)(F.ws + WS_WIN), T, NIN, D}; pg8::StaticOrder S; S.init(T, NIN, F.G, (int)blockIdx.x);
        pg8::EpiBf16<0> E{(bf16*)(F.ws + WS_P), NIN, nullptr, 0, 0, 1.f};
        pg8::gemm_phase<pg8::EpiBf16<0>, pg8::StaticOrder, PG8_ALIGN, PG8_SP2>(F.lds + RING_OFF, g, S, E);
    } SEAM(1);
    if (IN(2)) { prep_phase(F); } SEAM(2);
    if (IN(3)) { attn_phase(F); } SEAM(3);
    if (IN(4)) { hgrn_naive_phase(F); } SEAM(4);
    if (IN(5)) { hgnorm_phase(F); } SEAM(5);
    if (IN(6)) {
        pg8::Gemm g{(const bf16*)(F.ws + WS_MIX), (const bf16*)(F.ws + WS_WOUT), T, D, D}; pg8::StaticOrder S; S.init(T, D, F.G, (int)blockIdx.x);
        pg8::EpiRes E{F.x, F.out, D};
        pg8::gemm_phase<pg8::EpiRes, pg8::StaticOrder, PG8_ALIGN, PG8_SP2>(F.lds + RING_OFF, g, S, E);
    } SEAM(6);
    if (IN(7)) { router_phase(F); } SEAM(7);
    if (IN(8)) { gather_phase(F); } SEAM(8);
    if (IN(9)) {
        const int nt = load_tile_table(F);
        pg8::Gemm g{(const bf16*)(F.ws + WS_XB), (const bf16*)(F.ws + WS_WGU), MAXROWS, NE * 2048, D};
        pg8::MoeOrder S{(const LAS int*)(F.lds + LTAB_OFF) + 1, 8, nt * 8, F.G, F.vcu};
        pg8::EpiAct E{(bf16*)(F.ws + WS_ACT), F.b_gu};
        pg8::gemm_phase<pg8::EpiAct, pg8::MoeOrder, PG8_ALIGN, PG8_SP2>(F.lds + RING_OFF, g, S, E);
    } SEAM(9);
    if (IN(10)) {
        const int nt = load_tile_table(F);
        pg8::Gemm g{(const bf16*)(F.ws + WS_ACT), (const bf16*)(F.ws + WS_WD), MAXROWS, NE * 1024, D};
        pg8::MoeOrder S{(const LAS int*)(F.lds + LTAB_OFF) + 1, 4, nt * 4, F.G, F.vcu};
        pg8::EpiDown E{(bf16*)(F.ws + WS_YK), F.b_d, (const int*)(F.ws + TB_ROWTOK), (const float*)(F.ws + TB_ROWG)};
        pg8::gemm_phase<pg8::EpiDown, pg8::MoeOrder, PG8_ALIGN, PG8_SP2>(F.lds + RING_OFF, g, S, E);
    } SEAM(10);
    if (IN(11)) { combine_phase(F); }
#undef IN
#undef SEAM
}

extern "C" void kernel_launch(void* const* d_in, const int* in_sizes, int n_in, void* d_out, int out_size, void* d_ws, size_t ws_size, hipStream_t stream) {
    static int grid = 0;
    if (grid == 0) {
        if (n_in != 16 || in_sizes[0] != T * D || out_size != T * D || ws_size < WS_END) { fprintf(stderr, "kernel_launch: shape/workspace mismatch (n_in %d, ws %zu, need %zu); nothing launched\n", n_in, ws_size, (size_t)WS_END); grid = -1; return; }
        int dev = 0, cus = 0, per_cu = 0;
        if (hipGetDevice(&dev) != hipSuccess || hipDeviceGetAttribute(&cus, hipDeviceAttributeMultiprocessorCount, dev) != hipSuccess) { grid = -1; return; }
        if (hipFuncSetAttribute((const void*)fwd, hipFuncAttributeMaxDynamicSharedMemorySize, LDS_BYTES) != hipSuccess) { grid = -1; return; }
        if (hipOccupancyMaxActiveBlocksPerMultiprocessor(&per_cu, (const void*)fwd, NWAVES * 64, LDS_BYTES) != hipSuccess || per_cu < 1) { fprintf(stderr, "kernel_launch: occupancy query says %d\n", per_cu); }
        (void)hipGetLastError();
        grid = cus;
    }
    if (grid < 0) return;
    if (hipMemsetAsync((char*)d_ws + WS_CTL, 0, CTL_ZERO_BYTES, stream) != hipSuccess) return;
    Args a{};
    for (int i = 0; i < 16; ++i) a.in[i] = (const float*)d_in[i];
    a.out = (float*)d_out; a.ws = (unsigned char*)d_ws;
#if MK_ONE_LAUNCH
    a.ph_lo = 0; a.ph_hi = NPH;
    hipLaunchKernelGGL(fwd, dim3(grid), dim3(NWAVES * 64), LDS_BYTES, stream, a);
#else
    for (int p = 0; p < NPH; ++p) { a.ph_lo = p; a.ph_hi = p + 1; hipLaunchKernelGGL(fwd, dim3(grid), dim3(NWAVES * 64), LDS_BYTES, stream, a); }
#endif
}
```

```cpp
#include <hip/hip_runtime.h>
#include <cstdio>
#include <cstdint>
namespace pg8 {
#define PG8_LAS __attribute__((address_space(3)))
typedef unsigned short bf16_t;
typedef short bf16x8 __attribute__((ext_vector_type(8)));
typedef float f32x4 __attribute__((ext_vector_type(4)));
typedef unsigned u32x4 __attribute__((ext_vector_type(4)));
constexpr int BM = 256, BK = 64, HALF = 128, HTB = HALF * BK * 2  , STAGE_BYTES = 8 * HTB, NXCD = 8, WGM = 8;

__host__ __device__ __forceinline__ int lds_byte(int r, int c) { const int st = (r >> 4) * 2 + (c >> 5), rr = r & 15, cc = c & 31, ob = rr * 64 + cc * 2; return st * 1024 + (ob ^ (((ob >> 9) & 1) << 5)); }
__host__ __device__ __forceinline__ void stage_rc(int b, int& R, int& C) { const int st = b / 1024, sb = b % 1024, swz = sb ^ (((sb >> 9) & 1) << 5); R = (st >> 1) * 16 + swz / 64; C = (st & 1) * 32 + (swz % 64) / 2; }
__host__ __device__ __forceinline__ int perm32(int rho) { const int n = rho >> 4, i = rho & 15; return 8 * (i >> 2) + 4 * n + (i & 3); }

struct Unit { int pm, pn; };
struct Gemm { const bf16_t* A; const bf16_t* Bt; int M, N, K; };

struct StaticOrder {
    int nM, nN, nwg, G, c;
    __host__ __device__ void init(int M, int N, int G_, int c_) { nM = M / BM; nN = N / BM; nwg = nM * nN; G = G_; c = c_; }
    __host__ __device__ bool next(int i, Unit& u) const {
        const long L = (long)i * G + c; if (L >= nwg) return false;
        int wgid = (int)L; { const int q = nwg / NXCD, r = nwg % NXCD, xcd = wgid % NXCD, off = wgid / NXCD; wgid = (xcd < r ? xcd * (q + 1) : r * (q + 1) + (xcd - r) * q) + off; }
        const int nig = WGM * nN, gid = wgid / nig, fm = gid * WGM, gsz = (nM - fm) < WGM ? (nM - fm) : WGM;
        u.pm = fm + ((wgid % nig) % gsz); u.pn = (wgid % nig) / gsz; return true;
    }
    __device__ __forceinline__ void a_ready(const Unit&) const {}
    __device__ __forceinline__ void done(const Unit&) const {}
};

__device__ __forceinline__ unsigned cvt_pk_bf16(float lo, float hi) { unsigned r; asm volatile("v_cvt_pk_bf16_f32 %0, %1, %2" : "=v"(r) : "v"(lo), "v"(hi)); return r; }
typedef float f32x2 __attribute__((ext_vector_type(2)));
__device__ __forceinline__ f32x2 gelu_pk(f32x2 v) {
    const f32x2 av = __builtin_elementwise_abs(v), d = av * 0.2316418882f + 1.0f;
    f32x2 t; t.x = __builtin_amdgcn_rcpf(d.x); t.y = __builtin_amdgcn_rcpf(d.y);
    f32x2 q = t * 0.5307027145f + (-0.7265760135f); q = q * t + 0.7107068705f; q = q * t + (-0.142248368f); q = q * t + 0.127414796f; q = q * t;
    const f32x2 s = (v * v) * (-0.72134752044f);
    f32x2 e; e.x = __builtin_amdgcn_exp2f(s.x); e.y = __builtin_amdgcn_exp2f(s.y);
    const f32x2 m = v * (q * e), r = v - m;
    f32x2 o; o.x = v.x < 0.f ? m.x : r.x; o.y = v.y < 0.f ? m.y : r.y; return o;
}

template <int ACT  > struct EpiBf16 {
    static constexpr bool PERM = true, AFTER_DRAIN = false; static_assert(ACT == 0 || ACT == 1, "EpiBf16: ACT is 0 (none) or 1 (gelu_pk)");
    bf16_t* O; int ldc; const float* bias; int split_cols; size_t split_stride; float scale0;
    __device__ __forceinline__ void operator()(const f32x4 (&acc)[2][2][4][2], const Unit& u, int wr, int wc, int fr, int fq) const {
        const int row0 = u.pm * BM + wr * 64 + fr; int colt = u.pn * BM; bf16_t* base = O;
        float sc = 1.f; if (split_cols) { const int t = colt / split_cols; base += (size_t)t * split_stride; colt -= t * split_cols; if (t == 0) sc = scale0; }
        const int col0 = colt + wc * 32 + 8 * fq, bcol0 = u.pn * BM + wc * 32 + 8 * fq;
        f32x4 bv[2][2];
#pragma unroll
        for (int bj = 0; bj < 2; ++bj)
#pragma unroll
            for (int n = 0; n < 2; ++n) bv[bj][n] = bias ? *(const f32x4*)(bias + bcol0 + bj * HALF + 4 * n) : (f32x4){0.f, 0.f, 0.f, 0.f};
#pragma unroll
        for (int ai = 0; ai < 2; ++ai)
#pragma unroll
            for (int m = 0; m < 4; ++m) { bf16_t* rowp = base + (size_t)(row0 + ai * HALF + m * 16) * ldc + col0;
#pragma unroll
                for (int bj = 0; bj < 2; ++bj) { f32x4 v0 = acc[ai][bj][m][0] + bv[bj][0], v1 = acc[ai][bj][m][1] + bv[bj][1];
                    if (ACT == 1) { f32x2 a = gelu_pk((f32x2){v0[0], v0[1]}), b = gelu_pk((f32x2){v0[2], v0[3]}), c = gelu_pk((f32x2){v1[0], v1[1]}), d = gelu_pk((f32x2){v1[2], v1[3]});
                        v0 = (f32x4){a.x, a.y, b.x, b.y}; v1 = (f32x4){c.x, c.y, d.x, d.y}; }
                    v0 = v0 * sc; v1 = v1 * sc; u32x4 w; w.x = cvt_pk_bf16(v0[0], v0[1]); w.y = cvt_pk_bf16(v0[2], v0[3]); w.z = cvt_pk_bf16(v1[0], v1[1]); w.w = cvt_pk_bf16(v1[2], v1[3]);
                    *(u32x4*)(rowp + bj * HALF) = w; } }
    }
};

struct EpiRes {
    static constexpr bool PERM = false, AFTER_DRAIN = false;
    const float* X; float* C; int ldc;
    __device__ __forceinline__ void operator()(const f32x4 (&acc)[2][2][4][2], const Unit& u, int wr, int wc, int fr, int fq) const {
        const int row0 = u.pm * BM + wr * 64 + fr, col0 = u.pn * BM + wc * 32 + 4 * fq;
#pragma unroll
        for (int ai = 0; ai < 2; ++ai)
#pragma unroll
            for (int m = 0; m < 4; ++m) { const size_t off = (size_t)(row0 + ai * HALF + m * 16) * ldc + col0;
#pragma unroll
                for (int bj = 0; bj < 2; ++bj)
#pragma unroll
                    for (int n = 0; n < 2; ++n) { const size_t o2 = off + bj * HALF + n * 16; *(f32x4*)(C + o2) = *(const f32x4*)(X + o2) + acc[ai][bj][m][n]; } }
    }
};
struct MoeOrder {
    const PG8_LAS int* tile_e; int ntn, nunits, G, c;
    __device__ __forceinline__ bool next(int i, Unit& u) const {
        const int L = i * G + c; if (L >= nunits) return false;
        const int pm = L / ntn, pl = L - pm * ntn; u.pm = pm; u.pn = tile_e[pm] * ntn + pl; return true;
    }
    __device__ __forceinline__ void a_ready(const Unit&) const {}
    __device__ __forceinline__ void done(const Unit&) const {}
};
struct EpiAct {
    static constexpr bool PERM = true, AFTER_DRAIN = false;
    bf16_t* ACT; const float* bgu;
    __device__ __forceinline__ void operator()(const f32x4 (&acc)[2][2][4][2], const Unit& u, int wr, int wc, int fr, int fq) const {
        const int e = u.pn >> 3, pl = u.pn & 7; const int row0 = u.pm * BM + wr * 64 + fr, acol0 = pl * 128 + wc * 32 + 8 * fq;
        f32x4 bg[2], bu[2];
#pragma unroll
        for (int n = 0; n < 2; ++n) { bg[n] = *(const f32x4*)(bgu + (size_t)e * 2048 + acol0 + 4 * n); bu[n] = *(const f32x4*)(bgu + (size_t)e * 2048 + 1024 + acol0 + 4 * n); }
#pragma unroll
        for (int ai = 0; ai < 2; ++ai)
#pragma unroll
            for (int m = 0; m < 4; ++m) { bf16_t* rowp = ACT + (size_t)(row0 + ai * HALF + m * 16) * 1024 + acol0; float a[8];
#pragma unroll
                for (int n = 0; n < 2; ++n) { const f32x4 g4 = acc[ai][0][m][n] + bg[n], u4 = acc[ai][1][m][n] + bu[n];
#pragma unroll
                    for (int j = 0; j < 4; ++j) { const float gl = fminf(g4[j], 7.0f), ul = fminf(fmaxf(u4[j], -7.0f), 7.0f);
                        const float sg = __builtin_amdgcn_rcpf(1.0f + __builtin_amdgcn_exp2f(gl * (-1.702f * 1.44269504089f))); a[4 * n + j] = gl * sg * (ul + 1.0f); } }
                u32x4 w; w.x = cvt_pk_bf16(a[0], a[1]); w.y = cvt_pk_bf16(a[2], a[3]); w.z = cvt_pk_bf16(a[4], a[5]); w.w = cvt_pk_bf16(a[6], a[7]);
                *(u32x4*)rowp = w; }
    }
};
struct EpiDown {
    static constexpr bool PERM = true, AFTER_DRAIN = false;
    bf16_t* YK; const float* bd; const int* rowtok; const float* rowg;
    __device__ __forceinline__ void operator()(const f32x4 (&acc)[2][2][4][2], const Unit& u, int wr, int wc, int fr, int fq) const {
        const int e = u.pn >> 2, pl = u.pn & 3; const int row0 = u.pm * BM + wr * 64 + fr, col0 = pl * BM + wc * 32 + 8 * fq;
        f32x4 bv[2][2];
#pragma unroll
        for (int bj = 0; bj < 2; ++bj)
#pragma unroll
            for (int n = 0; n < 2; ++n) bv[bj][n] = *(const f32x4*)(bd + (size_t)e * 1024 + col0 + bj * HALF + 4 * n);
#pragma unroll
        for (int ai = 0; ai < 2; ++ai)
#pragma unroll
            for (int m = 0; m < 4; ++m) { const int row = row0 + ai * HALF + m * 16; const int tk = rowtok[row]; const float gt = rowg[row];
                if (tk >= 0) { bf16_t* rowp = YK + (size_t)tk * 1024 + col0;
#pragma unroll
                    for (int bj = 0; bj < 2; ++bj) { const f32x4 v0 = (acc[ai][bj][m][0] + bv[bj][0]) * gt, v1 = (acc[ai][bj][m][1] + bv[bj][1]) * gt;
                        u32x4 w; w.x = cvt_pk_bf16(v0[0], v0[1]); w.y = cvt_pk_bf16(v0[2], v0[3]); w.z = cvt_pk_bf16(v1[0], v1[1]); w.w = cvt_pk_bf16(v1[2], v1[3]);
                        *(u32x4*)(rowp + bj * HALF) = w; } } }
    }
};

template <class Epi, class Sched, bool ALIGN_EPI = false, bool SP2 = false>
__device__ __forceinline__ void gemm_phase(PG8_LAS unsigned char* lds, const Gemm g, const Sched& S, const Epi& E) {
    const int tid = threadIdx.x, wid = __builtin_amdgcn_readfirstlane(tid >> 6), lane = tid & 63, wr = wid >> 2, wc = wid & 3, fr = lane & 15, fq = lane >> 4;
    const int K = g.K, nt = K / BK;
    unsigned voffA[2], voffB[2];
#pragma unroll
    for (int i = 0; i < 2; ++i) { int R, C; stage_rc(tid * 16 + i * 8192, R, C); const int Rb = Epi::PERM ? ((R & ~31) + perm32(R & 31)) : R;
        voffA[i] = (unsigned)(R * K + C) * 2u; voffB[i] = (unsigned)(Rb * K + C) * 2u; }
    const size_t kstep = (size_t)(BK * 2);
    const size_t hstep = (size_t)HALF * K * 2;
    const size_t tstep = 2 * hstep;
    const unsigned ldsw = (unsigned)wid * 1024u;
    const int aoff = lds_byte(wr * 64 + fr, fq * 8), boff = lds_byte(wc * 32 + fr, fq * 8);
#define PG8_SA(b, h) (((b) * 2 + (h)) * HTB)
#define PG8_SB(b, h) ((4 + (b) * 2 + (h)) * HTB)
#define PG8_STAGE(bufoff, gbase, voff) do { _Pragma("unroll") for (int _i = 0; _i < 2; ++_i) \
        __builtin_amdgcn_global_load_lds((const unsigned*)((const char*)(gbase) + (voff)[_i]), (PG8_LAS unsigned*)(lds + (bufoff) + ldsw + _i * 8192), 16, 0, 0); } while (0)
#define PG8_LDA(dst, b, h) do { _Pragma("unroll") for (int m = 0; m < 4; ++m) _Pragma("unroll") for (int k = 0; k < 2; ++k) dst[m][k] = *(const PG8_LAS bf16x8*)(lds + PG8_SA(b, h) + aoff + m * 2048 + k * 1024); } while (0)
#define PG8_LDB(dst, b, h) do { _Pragma("unroll") for (int n = 0; n < 2; ++n) _Pragma("unroll") for (int k = 0; k < 2; ++k) dst[n][k] = *(const PG8_LAS bf16x8*)(lds + PG8_SB(b, h) + boff + n * 2048 + k * 1024); } while (0)
#define PG8_MMA(ai, bj, At, Bt) do { __builtin_amdgcn_s_setprio(1); _Pragma("unroll") for (int m = 0; m < 4; ++m) _Pragma("unroll") for (int n = 0; n < 2; ++n) _Pragma("unroll") for (int k = 0; k < 2; ++k) \
        acc[ai][bj][m][n] = __builtin_amdgcn_mfma_f32_16x16x32_bf16(Bt[n][k], At[m][k], acc[ai][bj][m][n], 0, 0, 0); __builtin_amdgcn_s_setprio(0); } while (0)
#define PG8_WAIT_V(n) asm volatile("s_waitcnt vmcnt(" #n ")" ::: "memory")
#define PG8_WAIT_L(n) asm volatile("s_waitcnt lgkmcnt(" #n ")" ::: "memory")
#define PG8_BAR __builtin_amdgcn_s_barrier()
#define PG8_SCHED __builtin_amdgcn_sched_barrier(0)
    Unit cur, nxt; int ui = 0;
    if (!S.next(0, cur)) return;
    f32x4 acc[2][2][4][2];
#pragma unroll
    for (int a = 0; a < 2; ++a)
#pragma unroll
        for (int b = 0; b < 2; ++b)
#pragma unroll
            for (int m = 0; m < 4; ++m)
#pragma unroll
                for (int n = 0; n < 2; ++n) acc[a][b][m][n] = (f32x4){0.f, 0.f, 0.f, 0.f};
    bf16x8 At[4][2], B0[2][2], B1[2][2];
    const char* cA = (const char*)g.A + (size_t)cur.pm * tstep; const char* cB = (const char*)g.Bt + (size_t)cur.pn * tstep;
    S.a_ready(cur);
    if constexpr (SP2) {
        PG8_STAGE(PG8_SB(0, 0), cB, voffB); PG8_STAGE(PG8_SB(0, 1), cB + hstep, voffB); PG8_STAGE(PG8_SA(0, 0), cA, voffA); PG8_STAGE(PG8_SA(0, 1), cA + hstep, voffA);
        if (wr == 1) PG8_BAR;
        PG8_WAIT_V(2); PG8_BAR;
        PG8_STAGE(PG8_SB(1, 0), cB + kstep, voffB); PG8_STAGE(PG8_SA(1, 0), cA + kstep, voffA); PG8_STAGE(PG8_SB(1, 1), cB + hstep + kstep, voffB);
        PG8_WAIT_V(6); PG8_BAR;
    } else {
        PG8_STAGE(PG8_SB(0, 0), cB, voffB); PG8_STAGE(PG8_SA(0, 0), cA, voffA); PG8_STAGE(PG8_SB(0, 1), cB + hstep, voffB); PG8_STAGE(PG8_SA(0, 1), cA + hstep, voffA);
        if (wr == 1) PG8_BAR;
        PG8_WAIT_V(4); PG8_BAR;
        PG8_STAGE(PG8_SB(1, 0), cB + kstep, voffB); PG8_STAGE(PG8_SA(1, 0), cA + kstep, voffA); PG8_STAGE(PG8_SB(1, 1), cB + hstep + kstep, voffB);
        PG8_WAIT_V(6); PG8_BAR;
    }
    for (;;) {
        const bool has_next = S.next(ui + 1, nxt);
        const char* nA = has_next ? (const char*)g.A + (size_t)nxt.pm * tstep : cA; const char* nB = has_next ? (const char*)g.Bt + (size_t)nxt.pn * tstep : cB;
        for (int t = 0; t < nt; t += 2) {
            const bool last = (t == nt - 2);
            const char* a1 = cA + (size_t)(t + 1) * kstep;
            const char* a2 = last ? nA : cA + (size_t)(t + 2) * kstep; const char* b2 = last ? nB : cB + (size_t)(t + 2) * kstep;
            const char* a3 = a2 + kstep; const char* b3 = b2 + kstep;
            if (last && has_next) S.a_ready(nxt);
            if constexpr (SP2) {
            PG8_LDB(B0, 0, 0); PG8_LDB(B1, 0, 1); PG8_SCHED; PG8_LDA(At, 0, 0); PG8_STAGE(PG8_SA(1, 1), a1 + hstep, voffA);
            PG8_WAIT_V(8); PG8_WAIT_L(0); PG8_BAR; PG8_MMA(0, 0, At, B0); PG8_MMA(0, 1, At, B1); PG8_BAR; PG8_SCHED;
            PG8_LDA(At, 0, 1); PG8_STAGE(PG8_SB(0, 0), b2, voffB); PG8_STAGE(PG8_SB(0, 1), b2 + hstep, voffB); PG8_STAGE(PG8_SA(0, 0), a2, voffA);
            PG8_WAIT_V(8); PG8_WAIT_L(0); PG8_BAR; PG8_MMA(1, 0, At, B0); PG8_MMA(1, 1, At, B1); PG8_BAR; PG8_SCHED;
            PG8_LDB(B0, 1, 0); PG8_LDB(B1, 1, 1); PG8_SCHED; PG8_LDA(At, 1, 0); PG8_STAGE(PG8_SA(0, 1), a2 + hstep, voffA);
            PG8_WAIT_V(8); PG8_WAIT_L(0); PG8_BAR; PG8_MMA(0, 0, At, B0); PG8_MMA(0, 1, At, B1); PG8_BAR; PG8_SCHED;
            PG8_LDA(At, 1, 1); PG8_STAGE(PG8_SB(1, 0), b3, voffB); PG8_STAGE(PG8_SB(1, 1), b3 + hstep, voffB); PG8_STAGE(PG8_SA(1, 0), a3, voffA);
            PG8_WAIT_V(8); PG8_WAIT_L(0); PG8_BAR; PG8_MMA(1, 0, At, B0); PG8_MMA(1, 1, At, B1); PG8_BAR; PG8_SCHED;
            } else {
            PG8_LDB(B0, 0, 0); PG8_SCHED; PG8_LDA(At, 0, 0); PG8_STAGE(PG8_SA(1, 1), a1 + hstep, voffA);
            PG8_WAIT_L(8); PG8_BAR; PG8_WAIT_L(0); PG8_MMA(0, 0, At, B0); PG8_BAR; PG8_SCHED;
            PG8_LDB(B1, 0, 1); PG8_STAGE(PG8_SB(0, 0), b2, voffB);
            PG8_BAR; PG8_WAIT_L(0); PG8_MMA(0, 1, At, B1); PG8_BAR;
            PG8_LDA(At, 0, 1); PG8_STAGE(PG8_SA(0, 0), a2, voffA);
            PG8_BAR; PG8_WAIT_L(0); PG8_MMA(1, 0, At, B0); PG8_BAR; PG8_SCHED;
            PG8_STAGE(PG8_SB(0, 1), b2 + hstep, voffB);
            PG8_WAIT_V(6); PG8_BAR; PG8_MMA(1, 1, At, B1); PG8_BAR;
            PG8_LDB(B0, 1, 0); PG8_SCHED; PG8_LDA(At, 1, 0); PG8_STAGE(PG8_SA(0, 1), a2 + hstep, voffA);
            PG8_WAIT_L(8); PG8_BAR; PG8_WAIT_L(0); PG8_MMA(0, 0, At, B0); PG8_BAR; PG8_SCHED;
            PG8_LDB(B1, 1, 1); PG8_STAGE(PG8_SB(1, 0), b3, voffB);
            PG8_BAR; PG8_WAIT_L(0); PG8_MMA(0, 1, At, B1); PG8_BAR;
            PG8_LDA(At, 1, 1); PG8_STAGE(PG8_SA(1, 0), a3, voffA);
            PG8_BAR; PG8_WAIT_L(0); PG8_MMA(1, 0, At, B0); PG8_BAR; PG8_SCHED;
            PG8_STAGE(PG8_SB(1, 1), b3 + hstep, voffB);
            PG8_WAIT_V(6); PG8_BAR; PG8_MMA(1, 1, At, B1); PG8_BAR;
            }
        }
        if constexpr (ALIGN_EPI) { if (wr == 0) PG8_BAR; }
        if constexpr (!Epi::AFTER_DRAIN) { E(acc, cur, wr, wc, fr, fq); S.done(cur); }
        if (!has_next) break;
#pragma unroll
        for (int a = 0; a < 2; ++a)
#pragma unroll
            for (int b = 0; b < 2; ++b)
#pragma unroll
                for (int m = 0; m < 4; ++m)
#pragma unroll
                    for (int n = 0; n < 2; ++n) acc[a][b][m][n] = (f32x4){0.f, 0.f, 0.f, 0.f};
        cur = nxt; cA = nA; cB = nB; ++ui;
        if constexpr (ALIGN_EPI) { if (wr == 1) PG8_BAR; }
    }
    PG8_WAIT_V(0);
    if constexpr (!ALIGN_EPI) { if (wr == 0) PG8_BAR; }
    PG8_BAR;
    if constexpr (Epi::AFTER_DRAIN) { E.fused(acc, cur, wr, wc, fr, fq, lds, wid, lane); S.done(cur); }
#undef PG8_SA
#undef PG8_SB
#undef PG8_STAGE
#undef PG8_LDA
#undef PG8_LDB
#undef PG8_MMA
#undef PG8_WAIT_V
#undef PG8_WAIT_L
#undef PG8_BAR
#undef PG8_SCHED
}
}

#ifndef PG8_SP2
#define PG8_SP2 true
#endif
#ifndef PG8_ALIGN
#define PG8_ALIGN true
#endif
#define GAS __attribute__((address_space(1)))
#define LAS __attribute__((address_space(3)))
typedef unsigned short bf16;
typedef unsigned v4u __attribute__((ext_vector_type(4)));
typedef float f32x4 __attribute__((ext_vector_type(4)));
typedef short bf16x8 __attribute__((ext_vector_type(8)));
typedef GAS unsigned gu32;
typedef GAS unsigned long long gu64;
#define RLX_AGENT __ATOMIC_RELAXED, __HIP_MEMORY_SCOPE_AGENT
#define LDS_WAIT() asm volatile("s_waitcnt lgkmcnt(0)" ::: "memory")
#define VM_WAIT() asm volatile("s_waitcnt vmcnt(0)" ::: "memory")
__device__ __forceinline__ unsigned long long rt() { return __builtin_amdgcn_s_memrealtime(); }
__device__ __forceinline__ unsigned f2bf(float f) { unsigned u = __builtin_bit_cast(unsigned, f); return (u + 0x7fffu + ((u >> 16) & 1u)) >> 16; }
__device__ __forceinline__ unsigned pk2(float lo, float hi) { return f2bf(lo) | (f2bf(hi) << 16); }

#define XB_TMO      128
#define XB_XCNT(j)  (256  + 64 * (j))
#define XB_XSUB(j)  (1280 + 64 * (j))
#define XB_XGEN(j)  (2304 + 64 * (j))
#define XB_TOP      3328
#define XB_TOPGEN   3392
#define XCD_BAR_WORDS 3456
#define XB_SPIN_CAP (1u << 18)

__device__ __forceinline__ unsigned xb_ld(unsigned* p)              { return __hip_atomic_load(p, __ATOMIC_RELAXED, __HIP_MEMORY_SCOPE_AGENT); }
__device__ __forceinline__ unsigned xb_add(unsigned* p, unsigned v) { return __hip_atomic_fetch_add(p, v, __ATOMIC_RELAXED, __HIP_MEMORY_SCOPE_AGENT); }
__device__ __forceinline__ unsigned xb_xcc_id() { return (unsigned)__builtin_amdgcn_s_getreg((3 << 11) | 20) & 0xFu; }
#define XB_SPIN(cond, bar) do { unsigned _sp = 0; while (cond) { __builtin_amdgcn_s_sleep(1); \
    if ((++_sp & 255u) == 0u) { if (xb_ld(&(bar)[XB_TMO])) break; if (_sp > XB_SPIN_CAP) { atomicAdd(&(bar)[XB_TMO], 1u); break; } } } } while (0)

struct XcdBarrier {
    unsigned* bar; unsigned x;
    volatile LAS unsigned* st;
};

__device__ __forceinline__ XcdBarrier xcd_barrier_post(unsigned* bar, volatile LAS unsigned* st) {
    XcdBarrier b; b.bar = bar; b.x = xb_xcc_id(); b.st = st;
    if (threadIdx.x == 0) (void)xb_add(&bar[XB_XCNT(b.x)], 1u);
    return b;
}
__device__ __forceinline__ void xcd_barrier_complete(unsigned* bar, unsigned x, unsigned& nloc, unsigned& nx) {
    const unsigned G = gridDim.x * gridDim.y * gridDim.z;
    unsigned sum, cnt, mine, sp = 0u;
    for (;;) {
        sum = 0u; cnt = 0u; mine = 0u;
#pragma unroll
        for (unsigned j = 0; j < 16; ++j) { const unsigned c = xb_ld(&bar[XB_XCNT(j)]); sum += c; cnt += (c > 0u) ? 1u : 0u; mine = (j == x) ? c : mine; }
        if (sum == G) break;
        __builtin_amdgcn_s_sleep(1);
        if ((++sp & 255u) == 0u) { if (xb_ld(&bar[XB_TMO])) break; if (sp > XB_SPIN_CAP) { atomicAdd(&bar[XB_TMO], 1u); break; } }
    }
    nloc = mine > 0u ? mine : 1u; nx = cnt > 0u ? cnt : 1u;
}

__device__ __forceinline__ void xcd_barrier(const XcdBarrier& b) {
    asm volatile("s_waitcnt vmcnt(0)" ::: "memory");
    __syncthreads();
    if (threadIdx.x == 0) {
        unsigned* bar = b.bar;
        __builtin_amdgcn_s_waitcnt(0);
        unsigned nloc = b.st[0], nx = b.st[1];
        if (nloc == 0u) { xcd_barrier_complete(bar, b.x, nloc, nx); b.st[0] = nloc; b.st[1] = nx; }
        const unsigned old = xb_add(&bar[XB_XSUB(b.x)], 1u);
        const unsigned gen = old / nloc;
        if (old + 1u == (gen + 1u) * nloc) {
            __builtin_amdgcn_fence(__ATOMIC_RELEASE, "agent");
            asm volatile("s_waitcnt vmcnt(0)" ::: "memory");
            const unsigned og = xb_add(&bar[XB_TOP], 1u);
            const unsigned tg = og / nx;
            if (og + 1u == (tg + 1u) * nx) xb_add(&bar[XB_TOPGEN], 1u);
            else XB_SPIN(xb_ld(&bar[XB_TOPGEN]) == tg, bar);
            __builtin_amdgcn_fence(__ATOMIC_ACQUIRE, "agent");
            xb_add(&bar[XB_XGEN(b.x)], 1u);
            asm volatile("s_waitcnt vmcnt(0)" ::: "memory");
        } else {
            XB_SPIN(xb_ld(&bar[XB_XGEN(b.x)]) == gen, bar);
            __builtin_amdgcn_fence(__ATOMIC_ACQUIRE, "agent");
            asm volatile("s_waitcnt vmcnt(0)" ::: "memory");
        }
    }
    __syncthreads();
}

constexpr int NWAVES = 8;
#ifndef MK_ONE_LAUNCH
#define MK_ONE_LAUNCH 1
#endif

constexpr int BATCH = 16, SEQ = 2048, D = 1024, T = BATCH * SEQ;
constexpr int NIN = 3584;
constexpr int OFF_SQ = 0, OFF_SK = 512, OFF_SV = 1024, OFF_HQ = 1536, OFF_HF = 2048, OFF_HI = 2560, OFF_HG = 3072;
constexpr int NE = 32, TOPK = 4, NASSIGN = T * TOPK;
constexpr int MAXTILES = NASSIGN / 256 + NE;
constexpr int MAXROWS = MAXTILES * 256;
constexpr float EPS = 1e-6f;

constexpr size_t MiB = 1u << 20;
constexpr size_t WS_CTL = 0, CTL_ZERO_BYTES = 1 * MiB;
constexpr size_t WS_WIN = 2 * MiB;
constexpr size_t WS_WOUT = 10 * MiB;
constexpr size_t WS_TAB = 12 * MiB;
constexpr size_t WS_WGU = 16 * MiB;
constexpr size_t WS_WD = 144 * MiB;
constexpr size_t WS_XN = 208 * MiB;
constexpr size_t WS_P = 272 * MiB;
constexpr size_t WS_MIX = 496 * MiB;
constexpr size_t WS_ACT = 272 * MiB;
constexpr size_t WS_XB = 560 * MiB;
constexpr size_t WS_HGO = 560 * MiB;
constexpr size_t WS_YK = 560 * MiB;
constexpr size_t WS_QN = 624 * MiB;
constexpr size_t WS_KN = 656 * MiB;
constexpr size_t WS_VT = 688 * MiB;
constexpr size_t WS_KVS = 720 * MiB;
constexpr size_t WS_DEC = 784 * MiB;
constexpr size_t WS_END = 832 * MiB;
constexpr size_t TB_ASG = WS_TAB;
constexpr size_t TB_TOPG = WS_TAB + 1 * MiB;
constexpr size_t TB_ROWTOK = WS_TAB + 2 * MiB;
constexpr size_t TB_ROWG = WS_TAB + 3 * MiB;
constexpr size_t TB_TILE = WS_TAB + 3 * MiB + 768 * 1024;
static_assert(TB_ROWTOK + (size_t)MAXROWS * 4 <= TB_ROWG && TB_ROWG + (size_t)MAXROWS * 4 <= TB_TILE && TB_TILE + 4096 <= WS_WGU, "table map");
static_assert(WS_ACT + (size_t)MAXROWS * 2048 <= WS_XB && WS_XB + (size_t)MAXROWS * 2048 <= WS_END && WS_MIX + (size_t)T * 2048 <= WS_XB, "d_ws map");
constexpr int CW_TMO = 0, CW_CODE = 1;
constexpr int CW_CNT = 64;
constexpr int CW_BAR = 4096;

constexpr int RING_OFF = 0, RING_BYTES = 131072;
constexpr int LDSCTL_OFF = RING_BYTES, MISC_OFF = LDSCTL_OFF + 320;
constexpr int LTAB_OFF = LDSCTL_OFF + 512;
constexpr int LDS_BYTES = 147456;
static_assert(MISC_OFF + 128 <= LTAB_OFF && LTAB_OFF + (1 + MAXTILES) * 4 <= LDS_BYTES, "LDS map");

struct Frame {
    LAS unsigned char* lds;
    volatile LAS unsigned* MISC;
    gu32* ctl;
    int tid, lane, wave, gw, ngw;
    int vcu, G;
    const float *x, *norm1_g, *w_in, *sb_q_g, *sb_k_g, *sb_out_g, *hg_lb, *hg_out_g, *w_out, *norm2_g, *w_router, *b_router, *w_gu, *b_gu, *w_d, *b_d;
    float* out;
    unsigned char* ws;
};
__device__ __forceinline__ float bf2f(unsigned short b) { return __builtin_bit_cast(float, (unsigned)b << 16); }
__device__ __forceinline__ float bflo(unsigned w) { return __builtin_bit_cast(float, w << 16); }
__device__ __forceinline__ float bfhi(unsigned w) { return __builtin_bit_cast(float, w & 0xffff0000u); }
__device__ __forceinline__ int vzero() { int z; asm volatile("v_mov_b32 %0, 0" : "=v"(z)); return z; }
__device__ __forceinline__ float wave_sum(float v) {
#pragma unroll
    for (int o = 1; o < 64; o <<= 1) v += __shfl_xor(v, o);
    return v;
}

__device__ __forceinline__ void p0_transpose_item(const float* W, int K, int N, bf16* WT, int k0, int n0, int drow0, LAS float* scr, int lane) {
#pragma unroll 8
    for (int i = 0; i < 32; ++i) { const int kk = 2 * i + (lane >> 5); scr[kk * 33 + (lane & 31)] = W[(size_t)(k0 + kk) * N + n0 + (lane & 31)]; }
    LDS_WAIT(); asm volatile("" ::: "memory");
    const int c = lane & 7;
#pragma unroll
    for (int j = 0; j < 4; ++j) { const int n = (lane >> 3) + 8 * j; const LAS float* s = scr + (8 * c) * 33 + n;
        v4u o; o.x = pk2(s[0 * 33], s[1 * 33]); o.y = pk2(s[2 * 33], s[3 * 33]); o.z = pk2(s[4 * 33], s[5 * 33]); o.w = pk2(s[6 * 33], s[7 * 33]);
        *(GAS v4u*)(WT + (size_t)(drow0 + n) * K + k0 + 8 * c) = o; }
    LDS_WAIT(); asm volatile("" ::: "memory");
}
__device__ __forceinline__ void rms_row_to_bf16(const float* xrow, const float* g, bf16* orow, int lane) {
    const GAS f32x4* xr = (const GAS f32x4*)xrow + lane; const f32x4* gr = (const f32x4*)g + lane;
    f32x4 v[4]; float s = 0.f;
#pragma unroll
    for (int j = 0; j < 4; ++j) { v[j] = xr[64 * j]; s += (v[j].x * v[j].x + v[j].y * v[j].y) + (v[j].z * v[j].z + v[j].w * v[j].w); }
    const float rstd = 1.f / sqrtf(wave_sum(s) * (1.f / D) + EPS);
    GAS unsigned long long* o8 = (GAS unsigned long long*)orow + lane;
#pragma unroll
    for (int j = 0; j < 4; ++j) { const f32x4 gg = gr[64 * j];
        o8[64 * j] = (unsigned long long)pk2(v[j].x * rstd * gg.x, v[j].y * rstd * gg.y) | ((unsigned long long)pk2(v[j].z * rstd * gg.z, v[j].w * rstd * gg.w) << 32); }
}
__device__ __forceinline__ void p0_prologue(Frame& F) {
    LAS float* scr = (LAS float*)(F.lds + RING_OFF + F.wave * 16384);
    constexpr int I_IN = 16 * (NIN / 32), I_OUT = 16 * 32, I_GU = NE * 16 * 64, I_D = NE * 16 * 32;
    constexpr int NITEMS = I_IN + I_OUT + I_GU + I_D;
    for (int it = F.gw; it < NITEMS; it += F.ngw) {
        int r = it;
        if (r < I_IN) { const int nb = NIN / 32, kb = r / nb, nn = r % nb; p0_transpose_item(F.w_in, D, NIN, (bf16*)(F.ws + WS_WIN), 64 * kb, 32 * nn, 32 * nn, scr, F.lane); continue; } r -= I_IN;
        if (r < I_OUT) { const int kb = r / 32, nn = r % 32; p0_transpose_item(F.w_out, D, D, (bf16*)(F.ws + WS_WOUT), 64 * kb, 32 * nn, 32 * nn, scr, F.lane); continue; } r -= I_OUT;
        if (r < I_GU) { const int e = r / 1024, q = r % 1024, kb = q / 64, nn = q % 64;
            const int isup = nn >> 5, a = (nn & 31) * 32;
            const int drow = 256 * (a >> 7) + 128 * isup + (a & 127);
            p0_transpose_item(F.w_gu + (size_t)e * D * 2048, D, 2048, (bf16*)(F.ws + WS_WGU) + (size_t)e * 2048 * D, 64 * kb, 32 * nn, drow, scr, F.lane); continue; } r -= I_GU;
        { const int e = r / 512, q = r % 512, kb = q / 32, nn = q % 32;
            p0_transpose_item(F.w_d + (size_t)e * D * D, D, D, (bf16*)(F.ws + WS_WD) + (size_t)e * D * D, 64 * kb, 32 * nn, 32 * nn, scr, F.lane); }
    }
    for (int m = F.gw; m < T; m += F.ngw) rms_row_to_bf16(F.x + (size_t)m * D, F.norm1_g, (bf16*)(F.ws + WS_XN) + (size_t)m * D, F.lane);
    { int* rt = (int*)(F.ws + TB_ROWTOK); for (int i = F.gw * 64 + F.lane; i < MAXROWS; i += F.ngw * 64) rt[i] = -1; }
}

typedef float f32x16 __attribute__((ext_vector_type(16)));
typedef __bf16 bf16x2n __attribute__((ext_vector_type(2)));
typedef float f32x2n __attribute__((ext_vector_type(2)));
#define MFMA32(a, b, c) __builtin_amdgcn_mfma_f32_32x32x16_bf16((a), (b), (c), 0, 0, 0)
__device__ __forceinline__ unsigned pkbf(float a, float b) { const bf16x2n v = __builtin_convertvector((f32x2n){a, b}, bf16x2n); return __builtin_bit_cast(unsigned, v); }
__device__ __forceinline__ bf16x8 pack8(float a0, float a1, float a2, float a3, float a4, float a5, float a6, float a7) { const v4u p = {pkbf(a0, a1), pkbf(a2, a3), pkbf(a4, a5), pkbf(a6, a7)}; return __builtin_bit_cast(bf16x8, p); }
constexpr float QSCALE = 0.125f * 1.44269504089f;
__device__ __forceinline__ void prep_phase(Frame& F) {
    LAS unsigned* tl = (LAS unsigned*)(F.lds + RING_OFF + F.wave * 16384);
    const bf16* P = (const bf16*)(F.ws + WS_P); bf16* Qn = (bf16*)(F.ws + WS_QN); bf16* Kn = (bf16*)(F.ws + WS_KN); bf16* VT = (bf16*)(F.ws + WS_VT);
    for (int it = F.gw; it < 4096; it += F.ngw) {
        const int bh = it & 127, blk = it >> 7, b = bh >> 3, h = bh & 7, s = blk * 64 + F.lane;
        const bf16* row = P + ((size_t)b * SEQ + s) * NIN;
#pragma unroll
        for (int which = 0; which < 2; ++which) {
            const GAS v4u* p = (const GAS v4u*)(row + (which ? OFF_SK : OFF_SQ) + h * 64); float v[64]; float ss = 0.f;
#pragma unroll
            for (int c = 0; c < 8; ++c) { const v4u r4 = p[c]; v[8 * c + 0] = bflo(r4.x); v[8 * c + 1] = bfhi(r4.x); v[8 * c + 2] = bflo(r4.y); v[8 * c + 3] = bfhi(r4.y); v[8 * c + 4] = bflo(r4.z); v[8 * c + 5] = bfhi(r4.z); v[8 * c + 6] = bflo(r4.w); v[8 * c + 7] = bfhi(r4.w); }
#pragma unroll
            for (int d = 0; d < 64; ++d) ss += v[d] * v[d];
            const float rs = (1.f / sqrtf(ss * (1.f / 64.f) + EPS)) * (which ? 1.0f : QSCALE);
            const float* g = which ? F.sb_k_g : F.sb_q_g;
            GAS v4u* o = (GAS v4u*)((which ? Kn : Qn) + ((size_t)bh * SEQ + s) * 64);
#pragma unroll
            for (int c = 0; c < 8; ++c) { v4u w4; w4.x = pkbf(v[8 * c + 0] * rs * g[8 * c + 0], v[8 * c + 1] * rs * g[8 * c + 1]); w4.y = pkbf(v[8 * c + 2] * rs * g[8 * c + 2], v[8 * c + 3] * rs * g[8 * c + 3]);
                w4.z = pkbf(v[8 * c + 4] * rs * g[8 * c + 4], v[8 * c + 5] * rs * g[8 * c + 5]); w4.w = pkbf(v[8 * c + 6] * rs * g[8 * c + 6], v[8 * c + 7] * rs * g[8 * c + 7]); o[c] = w4; }
        }
        {
            const GAS v4u* p = (const GAS v4u*)(row + OFF_SV + h * 64);
#pragma unroll
            for (int c = 0; c < 8; ++c) { const v4u r4 = p[c]; tl[F.lane * 33 + 4 * c + 0] = r4.x; tl[F.lane * 33 + 4 * c + 1] = r4.y; tl[F.lane * 33 + 4 * c + 2] = r4.z; tl[F.lane * 33 + 4 * c + 3] = r4.w; }
            LDS_WAIT(); asm volatile("" ::: "memory");
            const LAS unsigned short* t16 = (const LAS unsigned short*)tl; unsigned val[64];
#pragma unroll
            for (int k = 0; k < 64; ++k) val[k] = t16[k * 66 + F.lane];
            GAS v4u* o = (GAS v4u*)(VT + ((size_t)bh * 64 + F.lane) * SEQ + blk * 64);
#define KAP(pos) (((pos) & ~12) | (((pos) & 4) << 1) | (((pos) & 8) >> 1))
#pragma unroll
            for (int c = 0; c < 8; ++c) { v4u w4;
                w4.x = val[KAP(8 * c + 0)] | (val[KAP(8 * c + 1)] << 16); w4.y = val[KAP(8 * c + 2)] | (val[KAP(8 * c + 3)] << 16);
                w4.z = val[KAP(8 * c + 4)] | (val[KAP(8 * c + 5)] << 16); w4.w = val[KAP(8 * c + 6)] | (val[KAP(8 * c + 7)] << 16); o[c] = w4; }
#undef KAP
            LDS_WAIT(); asm volatile("" ::: "memory");
        }
    }
}

__device__ __forceinline__ int crow16(int i, int hh) { return (i & 3) + 8 * (i >> 2) + 4 * hh; }
__device__ __forceinline__ void attn_item(Frame& F, int bh, int qb, float thr, const bf16x8 (&Lt)[2]) {
    const int r = F.lane & 31, hh = F.lane >> 5, b = bh >> 3, h = bh & 7, q0 = qb * 32;
    const bf16* Qn = (const bf16*)(F.ws + WS_QN); const bf16* Kn = (const bf16*)(F.ws + WS_KN); const bf16* VT = (const bf16*)(F.ws + WS_VT);
    bf16x8 qf[4];
#pragma unroll
    for (int s = 0; s < 4; ++s) qf[s] = *(const GAS bf16x8*)(Qn + ((size_t)bh * SEQ + q0 + r) * 64 + 16 * s + 8 * hh);
    f32x16 O0, O1;
#pragma unroll
    for (int i = 0; i < 16; ++i) { O0[i] = 0.f; O1[i] = 0.f; }
    float carry = 0.f;
    for (int kb = qb; kb >= 0; --kb) {
        const bool diag = (kb == qb);
        bf16x8 kf[4], vf[2][2];
#pragma unroll
        for (int s = 0; s < 4; ++s) kf[s] = *(const GAS bf16x8*)(Kn + ((size_t)bh * SEQ + kb * 32 + r) * 64 + 16 * s + 8 * hh);
#pragma unroll
        for (int db = 0; db < 2; ++db)
#pragma unroll
            for (int ks = 0; ks < 2; ++ks) vf[db][ks] = *(const GAS bf16x8*)(VT + ((size_t)bh * 64 + db * 32 + r) * SEQ + kb * 32 + 16 * ks + 8 * hh);
        f32x16 z;
#pragma unroll
        for (int i = 0; i < 16; ++i) z[i] = 0.f;
#pragma unroll
        for (int s = 0; s < 4; ++s) z = MFMA32(kf[s], qf[s], z);
        float sp[16];
#pragma unroll
        for (int i = 0; i < 16; ++i) { const float zz = z[i]; float v = fmaxf(zz, 0.f) + __builtin_amdgcn_logf(1.f + __builtin_amdgcn_exp2f(-fabsf(zz)));
            if (diag && !(crow16(i, hh) < r)) v = 0.f; sp[i] = v; }
        const bf16x8 sb0 = pack8(sp[0], sp[1], sp[2], sp[3], sp[4], sp[5], sp[6], sp[7]), sb1 = pack8(sp[8], sp[9], sp[10], sp[11], sp[12], sp[13], sp[14], sp[15]);
        f32x16 Cc;
#pragma unroll
        for (int i = 0; i < 16; ++i) Cc[i] = carry;
        Cc = MFMA32(Lt[0], sb0, Cc); Cc = MFMA32(Lt[1], sb1, Cc);
        float w[16];
#pragma unroll
        for (int i = 0; i < 16; ++i) { float v = __builtin_amdgcn_exp2f(z[i] - Cc[i]); if (diag && !(crow16(i, hh) < r)) v = 0.f; w[i] = v; }
        const bf16x8 wb0 = pack8(w[0], w[1], w[2], w[3], w[4], w[5], w[6], w[7]), wb1 = pack8(w[8], w[9], w[10], w[11], w[12], w[13], w[14], w[15]);
        O0 = MFMA32(vf[0][0], wb0, O0); O0 = MFMA32(vf[0][1], wb1, O0);
        O1 = MFMA32(vf[1][0], wb0, O1); O1 = MFMA32(vf[1][1], wb1, O1);
        carry = __shfl(Cc[0], r);
        if (__all(carry > thr)) break;
    }
    float ss = 0.f;
#pragma unroll
    for (int i = 0; i < 16; ++i) ss += O0[i] * O0[i] + O1[i] * O1[i];
    ss += __shfl_xor(ss, 32);
    const float rs = 1.f / sqrtf(ss * (1.f / 64.f) + EPS);
    bf16* orow = (bf16*)(F.ws + WS_MIX) + ((size_t)b * SEQ + q0 + r) * D + h * 64; const float* g = F.sb_out_g + h * 64;
#pragma unroll
    for (int db = 0; db < 2; ++db)
#pragma unroll
        for (int gq = 0; gq < 4; ++gq) { const int d = 32 * db + 8 * gq + 4 * hh; const f32x4 gg = *(const f32x4*)(g + d);
            const float a0 = (db ? O1[4 * gq + 0] : O0[4 * gq + 0]) * rs * gg.x, a1 = (db ? O1[4 * gq + 1] : O0[4 * gq + 1]) * rs * gg.y, a2 = (db ? O1[4 * gq + 2] : O0[4 * gq + 2]) * rs * gg.z, a3 = (db ? O1[4 * gq + 3] : O0[4 * gq + 3]) * rs * gg.w;
            *(GAS unsigned long long*)(orow + d) = (unsigned long long)pkbf(a0, a1) | ((unsigned long long)pkbf(a2, a3) << 32); }
}
__device__ __forceinline__ void attn_phase(Frame& F) {
    const int r = F.lane & 31, hh = F.lane >> 5;
    float mq = fabsf(F.sb_q_g[F.lane]), mk = fabsf(F.sb_k_g[F.lane]);
#pragma unroll
    for (int o = 1; o < 64; o <<= 1) { mq = fmaxf(mq, __shfl_xor(mq, o)); mk = fmaxf(mk, __shfl_xor(mk, o)); }
    const float thr = 64.f * QSCALE * mq * mk * 1.02f + 170.f;
    bf16x8 Lt[2];
#pragma unroll
    for (int ks = 0; ks < 2; ++ks) { float e[8];
#pragma unroll
        for (int jj = 0; jj < 8; ++jj) e[jj] = (16 * ks + 8 * (jj >> 2) + 4 * hh + (jj & 3) >= r) ? 1.f : 0.f;
        Lt[ks] = pack8(e[0], e[1], e[2], e[3], e[4], e[5], e[6], e[7]); }
    for (int it = F.gw; it < 2048; it += F.ngw) { const int bh = it & 127, j = it >> 7;
        attn_item(F, bh, 63 - j, thr, Lt); attn_item(F, bh, j, thr, Lt); attn_item(F, bh, 47 - j, thr, Lt); attn_item(F, bh, 16 + j, thr, Lt); }
}

constexpr int HG_PART = 0, HG_SSQ = 2048, HG_QE = 4096, HG_KE = HG_QE + 64 * 272, HG_VT = HG_KE + 64 * 272, HG_KST = HG_VT + 128 * 144, HG_ST = HG_KST + 128 * 144, HG_END = HG_ST + 128 * 272;
static_assert(HG_END <= RING_BYTES, "HGRN2 LDS map");
__device__ __forceinline__ void hg_gates(Frame& F, const bf16* Pc, int h, int d, int tq, float (&bb)[16], float (&kk)[16], float& total) {
    const int c = h * 128 + d; const float lb = 1.f / (1.f + __expf(F.hg_lb[512 + c] - F.hg_lb[c]));
    float run = 0.f;
#pragma unroll
    for (int i = 0; i < 16; ++i) { const float ff = bf2f(Pc[(size_t)(16 * tq + i) * NIN + OFF_HF + c]); const float sg = 1.f / (1.f + __expf(-ff));
        const float f = lb + (1.f - lb) * sg; kk[i] = (1.f - lb) * (1.f - sg); run += __logf(f); bb[i] = run; }
    LAS float* part = (LAS float*)(F.lds + RING_OFF + HG_PART);
    part[tq * 128 + d] = run;
    __syncthreads();
    const float p0 = part[d], p1 = part[128 + d], p2 = part[256 + d], p3 = part[384 + d];
    const float off = (tq > 0 ? p0 : 0.f) + (tq > 1 ? p1 : 0.f) + (tq > 2 ? p2 : 0.f);
    total = (p0 + p1) + (p2 + p3);
#pragma unroll
    for (int i = 0; i < 16; ++i) bb[i] += off;
}
template <bool PERMUTE> __device__ __forceinline__ void st16(LAS unsigned char* dst, const float (&v)[16]) {
    v4u a, b2;
    if (!PERMUTE) { a.x = pkbf(v[0], v[1]); a.y = pkbf(v[2], v[3]); a.z = pkbf(v[4], v[5]); a.w = pkbf(v[6], v[7]); b2.x = pkbf(v[8], v[9]); b2.y = pkbf(v[10], v[11]); b2.z = pkbf(v[12], v[13]); b2.w = pkbf(v[14], v[15]); }
    else { a.x = pkbf(v[0], v[1]); a.y = pkbf(v[2], v[3]); a.z = pkbf(v[8], v[9]); a.w = pkbf(v[10], v[11]); b2.x = pkbf(v[4], v[5]); b2.y = pkbf(v[6], v[7]); b2.z = pkbf(v[12], v[13]); b2.w = pkbf(v[14], v[15]); }
    *(LAS v4u*)dst = a; *(LAS v4u*)(dst + 16) = b2;
}
__device__ __forceinline__ void hgA_phase(Frame& F) {
    const int d = F.tid & 127, tq = F.tid >> 7, r = F.lane & 31, hh = F.lane >> 5;
    const bf16* P = (const bf16*)(F.ws + WS_P); bf16* KVS = (bf16*)(F.ws + WS_KVS); float* DEC = (float*)(F.ws + WS_DEC);
    LAS unsigned char* L = F.lds + RING_OFF;
    for (int item = blockIdx.x; item < 2048; item += F.G) {
        const int bh = item >> 5, c = item & 31, b = bh >> 2, h = bh & 3;
        const bf16* Pc = P + ((size_t)b * SEQ + c * 64) * NIN;
        float bb[16], kk[16], total; hg_gates(F, Pc, h, d, tq, bb, kk, total);
        float ks[16], vv[16];
#pragma unroll
        for (int i = 0; i < 16; ++i) { ks[i] = kk[i] * __expf(total - bb[i]); vv[i] = bf2f(Pc[(size_t)(16 * tq + i) * NIN + OFF_HI + h * 128 + d]); }
        st16<false>(L + HG_KST + d * 144 + tq * 32, ks); st16<false>(L + HG_VT + d * 144 + tq * 32, vv);
        if (tq == 0) DEC[(size_t)item * 128 + d] = __expf(total);
        __syncthreads();
        const int db = F.wave & 3, eb0 = 2 * (F.wave >> 2);
        f32x16 acc0, acc1;
#pragma unroll
        for (int i = 0; i < 16; ++i) { acc0[i] = 0.f; acc1[i] = 0.f; }
#pragma unroll
        for (int s = 0; s < 4; ++s) { const bf16x8 af = *(const LAS bf16x8*)(L + HG_KST + (db * 32 + r) * 144 + 32 * s + 16 * hh);
            const bf16x8 b0 = *(const LAS bf16x8*)(L + HG_VT + (eb0 * 32 + r) * 144 + 32 * s + 16 * hh), b1 = *(const LAS bf16x8*)(L + HG_VT + ((eb0 + 1) * 32 + r) * 144 + 32 * s + 16 * hh);
            acc0 = MFMA32(af, b0, acc0); acc1 = MFMA32(af, b1, acc1); }
#pragma unroll
        for (int j = 0; j < 2; ++j) { bf16* dst = KVS + ((size_t)item * 128 + (eb0 + j) * 32 + r) * 128 + db * 32 + 4 * hh;
#pragma unroll
            for (int g = 0; g < 4; ++g) { const float a0 = j ? acc1[4 * g + 0] : acc0[4 * g + 0], a1 = j ? acc1[4 * g + 1] : acc0[4 * g + 1], a2 = j ? acc1[4 * g + 2] : acc0[4 * g + 2], a3 = j ? acc1[4 * g + 3] : acc0[4 * g + 3];
                *(GAS unsigned long long*)(dst + 8 * g) = (unsigned long long)pkbf(a0, a1) | ((unsigned long long)pkbf(a2, a3) << 32); } }
        __syncthreads();
    }
}
__device__ __forceinline__ void hg_scan_phase(Frame& F) {
    bf16* KVS = (bf16*)(F.ws + WS_KVS); const float* DEC = (const float*)(F.ws + WS_DEC);
    for (int g = blockIdx.x * (NWAVES * 64) + F.tid; g < 64 * 128 * 32; g += F.G * NWAVES * 64) {
        const int bh = g >> 12, e = (g >> 5) & 127, d4 = (g & 31) * 4;
        float s0 = 0.f, s1 = 0.f, s2 = 0.f, s3 = 0.f;
#pragma unroll 8
        for (int c = 0; c < 32; ++c) { GAS unsigned long long* p = (GAS unsigned long long*)(KVS + (((size_t)bh * 32 + c) * 128 + e) * 128 + d4);
            const unsigned long long kv = *p; const f32x4 dc = *(const GAS f32x4*)(DEC + ((size_t)bh * 32 + c) * 128 + d4);
            *p = (unsigned long long)pkbf(s0, s1) | ((unsigned long long)pkbf(s2, s3) << 32);
            const unsigned lo = (unsigned)kv, hi = (unsigned)(kv >> 32);
            s0 = dc.x * s0 + bflo(lo); s1 = dc.y * s1 + bfhi(lo); s2 = dc.z * s2 + bflo(hi); s3 = dc.w * s3 + bfhi(hi); }
    }
}
__device__ __forceinline__ void hgC_phase(Frame& F) {
    const int d = F.tid & 127, tq = F.tid >> 7, r = F.lane & 31, hh = F.lane >> 5;
    const bf16* P = (const bf16*)(F.ws + WS_P); const bf16* KVS = (const bf16*)(F.ws + WS_KVS); bf16* MIX = (bf16*)(F.ws + WS_MIX);
    LAS unsigned char* L = F.lds + RING_OFF;
    for (int item = blockIdx.x; item < 2048; item += F.G) {
        const int bh = item >> 5, c = item & 31, b = bh >> 2, h = bh & 3;
        const bf16* Pc = P + ((size_t)b * SEQ + c * 64) * NIN;
        float bb[16], kk[16], total; hg_gates(F, Pc, h, d, tq, bb, kk, total);
        float vv[16];
#pragma unroll
        for (int i = 0; i < 16; ++i) { const int t = 16 * tq + i; const float q = bf2f(Pc[(size_t)t * NIN + OFF_HQ + h * 128 + d]);
            *(LAS unsigned short*)(L + HG_QE + t * 272 + 2 * d) = (unsigned short)pkbf(q * __expf(bb[i]), 0.f);
            *(LAS unsigned short*)(L + HG_KE + t * 272 + 2 * d) = (unsigned short)pkbf(kk[i] * __expf(-bb[i]), 0.f);
            vv[i] = bf2f(Pc[(size_t)t * NIN + OFF_HI + h * 128 + d]); }
        st16<true>(L + HG_VT + d * 144 + tq * 32, vv);
        {
            const int e = F.tid >> 2, qd = F.tid & 3; const GAS v4u* src = (const GAS v4u*)(KVS + ((size_t)item * 128 + e) * 128 + qd * 32);
#pragma unroll
            for (int j = 0; j < 4; ++j) *(LAS v4u*)(L + HG_ST + e * 272 + qd * 64 + 16 * j) = src[j];
        }
        __syncthreads();
        const int tb = F.wave & 1, eb = F.wave >> 1;
        f32x16 acc;
#pragma unroll
        for (int i = 0; i < 16; ++i) acc[i] = 0.f;
        bf16x8 qf[8];
#pragma unroll
        for (int s = 0; s < 8; ++s) qf[s] = *(const LAS bf16x8*)(L + HG_QE + (tb * 32 + r) * 272 + 32 * s + 16 * hh);
#pragma unroll
        for (int s = 0; s < 8; ++s) acc = MFMA32(*(const LAS bf16x8*)(L + HG_ST + (eb * 32 + r) * 272 + 32 * s + 16 * hh), qf[s], acc);
        for (int sb = 0; sb <= tb; ++sb) {
            f32x16 at;
#pragma unroll
            for (int i = 0; i < 16; ++i) at[i] = 0.f;
#pragma unroll
            for (int s = 0; s < 8; ++s) at = MFMA32(*(const LAS bf16x8*)(L + HG_KE + (sb * 32 + r) * 272 + 32 * s + 16 * hh), qf[s], at);
            float a[16];
#pragma unroll
            for (int i = 0; i < 16; ++i) a[i] = (sb < tb || crow16(i, hh) <= r) ? at[i] : 0.f;
            const bf16x8 ab0 = pack8(a[0], a[1], a[2], a[3], a[4], a[5], a[6], a[7]), ab1 = pack8(a[8], a[9], a[10], a[11], a[12], a[13], a[14], a[15]);
            acc = MFMA32(*(const LAS bf16x8*)(L + HG_VT + (eb * 32 + r) * 144 + sb * 64 + 0 + 16 * hh), ab0, acc);
            acc = MFMA32(*(const LAS bf16x8*)(L + HG_VT + (eb * 32 + r) * 144 + sb * 64 + 32 + 16 * hh), ab1, acc);
        }
        float ss = 0.f;
#pragma unroll
        for (int i = 0; i < 16; ++i) ss += acc[i] * acc[i];
        ss += __shfl_xor(ss, 32);
        LAS float* ssq = (LAS float*)(L + HG_SSQ);
        if (hh == 0) ssq[eb * 64 + tb * 32 + r] = ss;
        __syncthreads();
        const int tl = tb * 32 + r; const float tot = (ssq[tl] + ssq[64 + tl]) + (ssq[128 + tl] + ssq[192 + tl]);
        const float rs = 1.f / sqrtf(tot * (1.f / 128.f) + EPS);
        const bf16* grow = Pc + (size_t)tl * NIN + OFF_HG + h * 128; bf16* orow = MIX + ((size_t)b * SEQ + c * 64 + tl) * D + 512 + h * 128; const float* gn = F.hg_out_g + h * 128;
#pragma unroll
        for (int g = 0; g < 4; ++g) { const int e = eb * 32 + 8 * g + 4 * hh; const unsigned long long gr = *(const GAS unsigned long long*)(grow + e); const f32x4 gg = *(const f32x4*)(gn + e);
            const float g0 = bflo((unsigned)gr), g1 = bfhi((unsigned)gr), g2 = bflo((unsigned)(gr >> 32)), g3 = bfhi((unsigned)(gr >> 32));
            const float y0 = acc[4 * g + 0] * rs * gg.x * (g0 / (1.f + __expf(-g0))), y1 = acc[4 * g + 1] * rs * gg.y * (g1 / (1.f + __expf(-g1)));
            const float y2 = acc[4 * g + 2] * rs * gg.z * (g2 / (1.f + __expf(-g2))), y3 = acc[4 * g + 3] * rs * gg.w * (g3 / (1.f + __expf(-g3)));
            *(GAS unsigned long long*)(orow + e) = (unsigned long long)pkbf(y0, y1) | ((unsigned long long)pkbf(y2, y3) << 32); }
        __syncthreads();
    }
}

__device__ __forceinline__ void router_phase(Frame& F) {
    LAS float* hs = (LAS float*)(F.lds + RING_OFF + F.wave * 16384);
    const float* X1 = F.out; bf16* H2 = (bf16*)(F.ws + WS_XN);
    int* ASG = (int*)(F.ws + TB_ASG); float* TOPG = (float*)(F.ws + TB_TOPG); unsigned* cnt = (unsigned*)(F.ctl + CW_CNT);
    const int e = F.lane & 31, kh = F.lane >> 5;
    for (int t = F.gw; t < T; t += F.ngw) {
        const GAS f32x4* xr = (const GAS f32x4*)(X1 + (size_t)t * D) + F.lane; const f32x4* gr = (const f32x4*)F.norm2_g + F.lane;
        f32x4 v[4]; float s = 0.f;
#pragma unroll
        for (int j = 0; j < 4; ++j) { v[j] = xr[64 * j]; s += (v[j].x * v[j].x + v[j].y * v[j].y) + (v[j].z * v[j].z + v[j].w * v[j].w); }
        const float rstd = 1.f / sqrtf(wave_sum(s) * (1.f / D) + EPS);
        GAS unsigned long long* o8 = (GAS unsigned long long*)(H2 + (size_t)t * D) + F.lane;
#pragma unroll
        for (int j = 0; j < 4; ++j) { const f32x4 gg = gr[64 * j]; const f32x4 hv = (f32x4){v[j].x * rstd * gg.x, v[j].y * rstd * gg.y, v[j].z * rstd * gg.z, v[j].w * rstd * gg.w};
            o8[64 * j] = (unsigned long long)pk2(hv.x, hv.y) | ((unsigned long long)pk2(hv.z, hv.w) << 32);
            *(LAS f32x4*)(hs + 4 * (F.lane + 64 * j)) = hv; }
        LDS_WAIT(); asm volatile("" ::: "memory");
        float acc = 0.f; const float* wr = F.w_router + (size_t)(512 * kh) * NE + e; const LAS float* hp = hs + 512 * kh;
#pragma unroll 8
        for (int k4 = 0; k4 < 128; ++k4) { const f32x4 h4 = *(const LAS f32x4*)(hp + 4 * k4);
            acc += h4.x * wr[(4 * k4 + 0) * NE]; acc += h4.y * wr[(4 * k4 + 1) * NE]; acc += h4.z * wr[(4 * k4 + 2) * NE]; acc += h4.w * wr[(4 * k4 + 3) * NE]; }
        acc += __shfl_xor(acc, 32);
        float val = acc + F.b_router[e];
        float sv[4]; int se[4];
#pragma unroll
        for (int r = 0; r < 4; ++r) { float bv = val; int bi = e;
#pragma unroll
            for (int off = 1; off < 32; off <<= 1) { const float ov = __shfl_xor(bv, off); const int oi = __shfl_xor(bi, off); if (ov > bv || (ov == bv && oi < bi)) { bv = ov; bi = oi; } }
            sv[r] = bv; se[r] = bi; if (e == bi) val = -__builtin_inff(); }
        const float e1 = __expf(sv[1] - sv[0]), e2 = __expf(sv[2] - sv[0]), e3 = __expf(sv[3] - sv[0]); const float inv = 1.f / (1.f + e1 + e2 + e3);
        if (F.lane < 4) { const int my_e = F.lane == 0 ? se[0] : F.lane == 1 ? se[1] : F.lane == 2 ? se[2] : se[3];
            const float my_g = (F.lane == 0 ? 1.f : F.lane == 1 ? e1 : F.lane == 2 ? e2 : e3) * inv;
            const unsigned pos = __hip_atomic_fetch_add(cnt + my_e, 1u, __ATOMIC_RELAXED, __HIP_MEMORY_SCOPE_AGENT);
            ASG[((size_t)t * 4 + F.lane) * 2] = my_e; ASG[((size_t)t * 4 + F.lane) * 2 + 1] = (int)pos; TOPG[(size_t)t * 4 + F.lane] = my_g; }
        LDS_WAIT(); asm volatile("" ::: "memory");
    }
}
__device__ __forceinline__ int expert_starts(Frame& F, int& my_cnt, int& total_tiles) {
    const int e = F.lane & 31; const int c = (int)__hip_atomic_load((unsigned*)(F.ctl + CW_CNT) + e, __ATOMIC_RELAXED, __HIP_MEMORY_SCOPE_AGENT);
    const int tl = (c + 255) >> 8; int inc = tl;
#pragma unroll
    for (int off = 1; off < 32; off <<= 1) { const int o = __shfl_up(inc, off, 32); if (e >= off) inc += o; }
    total_tiles = __shfl(inc, 31, 32); my_cnt = c; return (inc - tl) * 256;
}
__device__ __forceinline__ void gather_phase(Frame& F) {
    const bf16* H2 = (const bf16*)(F.ws + WS_XN); bf16* XB = (bf16*)(F.ws + WS_XB);
    const int* ASG = (const int*)(F.ws + TB_ASG); const float* TOPG = (const float*)(F.ws + TB_TOPG);
    int* ROWTOK = (int*)(F.ws + TB_ROWTOK); float* ROWG = (float*)(F.ws + TB_ROWG); int* TILE = (int*)(F.ws + TB_TILE);
    int my_cnt, ntiles; const int my_start = expert_starts(F, my_cnt, ntiles);
    if (F.gw == 0) {
        if (F.lane == 0) TILE[0] = ntiles;
        if (F.lane < 32) { const int t0 = my_start >> 8, nt = (my_cnt + 255) >> 8; for (int i = 0; i < nt; ++i) TILE[1 + t0 + i] = F.lane; }
    }
    const int vz = vzero();
    for (int t = F.gw; t < T; t += F.ngw) {
        const GAS v4u* src = (const GAS v4u*)(H2 + (size_t)t * D) + 2 * F.lane; const v4u a = src[0], b2 = src[1];
#pragma unroll
        for (int k = 0; k < 4; ++k) { const int e = ASG[((size_t)t * 4 + k) * 2 + vz], pos = ASG[((size_t)t * 4 + k) * 2 + 1 + vz]; const float g = TOPG[(size_t)t * 4 + k + vz];
            const int dest = __shfl(my_start, e, 64) + pos;
            GAS v4u* dst = (GAS v4u*)(XB + (size_t)dest * D) + 2 * F.lane; dst[0] = a; dst[1] = b2;
            if (F.lane == 0) { ROWTOK[dest] = t * 4 + k; ROWG[dest] = g; } }
    }
}
__device__ __forceinline__ int load_tile_table(Frame& F) {
    const int* TILE = (const int*)(F.ws + TB_TILE); LAS int* lt = (LAS int*)(F.lds + LTAB_OFF);
    for (int i = F.tid; i < 1 + MAXTILES; i += NWAVES * 64) lt[i] = TILE[i];
    __syncthreads();
    int nt = lt[0]; nt = nt < 0 ? 0 : (nt > MAXTILES ? MAXTILES : nt); return __builtin_amdgcn_readfirstlane(nt);
}
__device__ __forceinline__ void combine_phase(Frame& F) {
    const bf16* YK = (const bf16*)(F.ws + WS_YK);
    for (int t = F.gw; t < T; t += F.ngw) {
        GAS f32x4* xr = (GAS f32x4*)(F.out + (size_t)t * D) + F.lane;
#pragma unroll
        for (int j = 0; j < 4; ++j) { f32x4 v = xr[64 * j];
#pragma unroll
            for (int k = 0; k < 4; ++k) { const unsigned long long y = *((const GAS unsigned long long*)(YK + ((size_t)t * 4 + k) * D) + F.lane + 64 * j);
                const unsigned lo = (unsigned)y, hi = (unsigned)(y >> 32); v.x += bflo(lo); v.y += bfhi(lo); v.z += bflo(hi); v.w += bfhi(hi); }
            xr[64 * j] = v; }
    }
}

constexpr int NPH = 11;
struct Args { const float* in[16]; float* out; unsigned char* ws; int ph_lo, ph_hi; };
__global__ void __launch_bounds__(NWAVES * 64, 2) fwd(Args args) {
    extern __shared__ __attribute__((aligned(16))) unsigned char lds[];
    Frame F;
    F.lds = (LAS unsigned char*)lds;
    F.MISC = (volatile LAS unsigned*)(F.lds + MISC_OFF);
    F.tid = threadIdx.x; F.lane = F.tid & 63; F.wave = __builtin_amdgcn_readfirstlane(F.tid >> 6);
    F.G = gridDim.x; { const int bx = blockIdx.x; F.vcu = (F.G % 8 == 0) ? (bx % 8) * (F.G / 8) + bx / 8 : bx; }
    F.gw = blockIdx.x * NWAVES + F.wave; F.ngw = F.G * NWAVES;
    F.ws = args.ws; F.ctl = (gu32*)(args.ws + WS_CTL); F.out = args.out;
    F.x = args.in[0]; F.norm1_g = args.in[1]; F.w_in = args.in[2]; F.sb_q_g = args.in[3]; F.sb_k_g = args.in[4]; F.sb_out_g = args.in[5]; F.hg_lb = args.in[6]; F.hg_out_g = args.in[7];
    F.w_out = args.in[8]; F.norm2_g = args.in[9]; F.w_router = args.in[10]; F.b_router = args.in[11]; F.w_gu = args.in[12]; F.b_gu = args.in[13]; F.w_d = args.in[14]; F.b_d = args.in[15];
    for (int u = F.tid; u < (LDS_BYTES - LDSCTL_OFF) / 4; u += NWAVES * 64) ((LAS unsigned*)(F.lds + LDSCTL_OFF))[u] = 0u;
    __syncthreads();
    XcdBarrier bar; bar.bar = (unsigned*)(F.ctl + CW_BAR); bar.x = 0; bar.st = nullptr;
    if (MK_ONE_LAUNCH) bar = xcd_barrier_post((unsigned*)(F.ctl + CW_BAR), F.MISC + 8);
    const int lo = args.ph_lo, hi = args.ph_hi;
#define IN(k) (lo <= (k) && (k) < hi)
#define SEAM(k) do { if (IN(k) && IN((k) + 1)) xcd_barrier(bar); } while (0)

    if (IN(0)) { p0_prologue(F); } SEAM(0);
    if (IN(1)) {
        pg8::Gemm g{(const bf16*)(F.ws + WS_XN), (const bf16*)(F.ws + WS_WIN), T, NIN, D}; pg8::StaticOrder S; S.init(T, NIN, F.G, (int)blockIdx.x);
        pg8::EpiBf16<0> E{(bf16*)(F.ws + WS_P), NIN, nullptr, 0, 0, 1.f};
        pg8::gemm_phase<pg8::EpiBf16<0>, pg8::StaticOrder, PG8_ALIGN, PG8_SP2>(F.lds + RING_OFF, g, S, E);
    } SEAM(1);
    if (IN(2)) { prep_phase(F); __syncthreads(); hgA_phase(F); } SEAM(2);
    if (IN(3)) { attn_phase(F); hg_scan_phase(F); } SEAM(3);
    if (IN(4)) { hgC_phase(F); } SEAM(4);
    if (IN(5)) {
        pg8::Gemm g{(const bf16*)(F.ws + WS_MIX), (const bf16*)(F.ws + WS_WOUT), T, D, D}; pg8::StaticOrder S; S.init(T, D, F.G, (int)blockIdx.x);
        pg8::EpiRes E{F.x, F.out, D};
        pg8::gemm_phase<pg8::EpiRes, pg8::StaticOrder, PG8_ALIGN, PG8_SP2>(F.lds + RING_OFF, g, S, E);
    } SEAM(5);
    if (IN(6)) { router_phase(F); } SEAM(6);
    if (IN(7)) { gather_phase(F); } SEAM(7);
    if (IN(8)) {
        const int nt = load_tile_table(F);
        pg8::Gemm g{(const bf16*)(F.ws + WS_XB), (const bf16*)(F.ws + WS_WGU), MAXROWS, NE * 2048, D};
        pg8::MoeOrder S{(const LAS int*)(F.lds + LTAB_OFF) + 1, 8, nt * 8, F.G, F.vcu};
        pg8::EpiAct E{(bf16*)(F.ws + WS_ACT), F.b_gu};
        pg8::gemm_phase<pg8::EpiAct, pg8::MoeOrder, PG8_ALIGN, PG8_SP2>(F.lds + RING_OFF, g, S, E);
    } SEAM(8);
    if (IN(9)) {
        const int nt = load_tile_table(F);
        pg8::Gemm g{(const bf16*)(F.ws + WS_ACT), (const bf16*)(F.ws + WS_WD), MAXROWS, NE * 1024, D};
        pg8::MoeOrder S{(const LAS int*)(F.lds + LTAB_OFF) + 1, 4, nt * 4, F.G, F.vcu};
        pg8::EpiDown E{(bf16*)(F.ws + WS_YK), F.b_d, (const int*)(F.ws + TB_ROWTOK), (const float*)(F.ws + TB_ROWG)};
        pg8::gemm_phase<pg8::EpiDown, pg8::MoeOrder, PG8_ALIGN, PG8_SP2>(F.lds + RING_OFF, g, S, E);
    } SEAM(9);
    if (IN(10)) { combine_phase(F); }
#undef IN
#undef SEAM
}

extern "C" void kernel_launch(void* const* d_in, const int* in_sizes, int n_in, void* d_out, int out_size, void* d_ws, size_t ws_size, hipStream_t stream) {
    static int grid = 0;
    if (grid == 0) {
        if (n_in != 16 || in_sizes[0] != T * D || out_size != T * D || ws_size < WS_END) { fprintf(stderr, "kernel_launch: shape/workspace mismatch (n_in %d, ws %zu, need %zu); nothing launched\n", n_in, ws_size, (size_t)WS_END); grid = -1; return; }
        int dev = 0, cus = 0, per_cu = 0;
        if (hipGetDevice(&dev) != hipSuccess || hipDeviceGetAttribute(&cus, hipDeviceAttributeMultiprocessorCount, dev) != hipSuccess) { grid = -1; return; }
        if (hipFuncSetAttribute((const void*)fwd, hipFuncAttributeMaxDynamicSharedMemorySize, LDS_BYTES) != hipSuccess) { grid = -1; return; }
        if (hipOccupancyMaxActiveBlocksPerMultiprocessor(&per_cu, (const void*)fwd, NWAVES * 64, LDS_BYTES) != hipSuccess || per_cu < 1) { fprintf(stderr, "kernel_launch: occupancy query says %d\n", per_cu); }
        (void)hipGetLastError();
        grid = cus;
    }
    if (grid < 0) return;
    if (hipMemsetAsync((char*)d_ws + WS_CTL, 0, CTL_ZERO_BYTES, stream) != hipSuccess) return;
    Args a{};
    for (int i = 0; i < 16; ++i) a.in[i] = (const float*)d_in[i];
    a.out = (float*)d_out; a.ws = (unsigned char*)d_ws;
#if MK_ONE_LAUNCH
    a.ph_lo = 0; a.ph_hi = NPH;
    hipLaunchKernelGGL(fwd, dim3(grid), dim3(NWAVES * 64), LDS_BYTES, stream, a);
#else
    for (int p = 0; p < NPH; ++p) { a.ph_lo = p; a.ph_hi = p + 1; hipLaunchKernelGGL(fwd, dim3(grid), dim3(NWAVES * 64), LDS_BYTES, stream, a); }
#endif
}
```

```cpp
#include <hip/hip_runtime.h>
#include <cstdio>
#include <cstdint>
namespace pg8 {
#define PG8_LAS __attribute__((address_space(3)))
typedef unsigned short bf16_t;
typedef short bf16x8 __attribute__((ext_vector_type(8)));
typedef float f32x4 __attribute__((ext_vector_type(4)));
typedef unsigned u32x4 __attribute__((ext_vector_type(4)));
typedef int i32x4_t __attribute__((ext_vector_type(4)));
typedef int i32x8_t __attribute__((ext_vector_type(8)));
constexpr int BM = 256, BK = 64, HALF = 128, HTB = HALF * BK * 2  , STAGE_BYTES = 8 * HTB, NXCD = 8, WGM = 8;

__host__ __device__ __forceinline__ int lds_byte(int r, int c) { const int st = (r >> 4) * 2 + (c >> 5), rr = r & 15, cc = c & 31, ob = rr * 64 + cc * 2; return st * 1024 + (ob ^ (((ob >> 9) & 1) << 5)); }
__host__ __device__ __forceinline__ void stage_rc(int b, int& R, int& C) { const int st = b / 1024, sb = b % 1024, swz = sb ^ (((sb >> 9) & 1) << 5); R = (st >> 1) * 16 + swz / 64; C = (st & 1) * 32 + (swz % 64) / 2; }
__host__ __device__ __forceinline__ int perm32(int rho) { const int n = rho >> 4, i = rho & 15; return 8 * (i >> 2) + 4 * n + (i & 3); }

struct Unit { int pm, pn, slot; };
struct Gemm { const bf16_t* A; const bf16_t* Bt; int M, N, K; };

struct StaticOrder {
    int nM, nN, nwg, G, c;
    __host__ __device__ void init(int M, int N, int G_, int c_) { nM = M / BM; nN = N / BM; nwg = nM * nN; G = G_; c = c_; }
    __host__ __device__ bool next(int i, Unit& u) const {
        const long L = (long)i * G + c; if (L >= nwg) return false;
        int wgid = (int)L; { const int q = nwg / NXCD, r = nwg % NXCD, xcd = wgid % NXCD, off = wgid / NXCD; wgid = (xcd < r ? xcd * (q + 1) : r * (q + 1) + (xcd - r) * q) + off; }
        const int nig = WGM * nN, gid = wgid / nig, fm = gid * WGM, gsz = (nM - fm) < WGM ? (nM - fm) : WGM;
        u.pm = fm + ((wgid % nig) % gsz); u.pn = (wgid % nig) / gsz; return true;
    }
    __device__ __forceinline__ void a_ready(const Unit&) const {}
    __device__ __forceinline__ void done(const Unit&) const {}
};

__device__ __forceinline__ unsigned cvt_pk_bf16(float lo, float hi) { unsigned r; asm volatile("v_cvt_pk_bf16_f32 %0, %1, %2" : "=v"(r) : "v"(lo), "v"(hi)); return r; }
typedef float f32x2 __attribute__((ext_vector_type(2)));
__device__ __forceinline__ f32x2 gelu_pk(f32x2 v) {
    const f32x2 av = __builtin_elementwise_abs(v), d = av * 0.2316418882f + 1.0f;
    f32x2 t; t.x = __builtin_amdgcn_rcpf(d.x); t.y = __builtin_amdgcn_rcpf(d.y);
    f32x2 q = t * 0.5307027145f + (-0.7265760135f); q = q * t + 0.7107068705f; q = q * t + (-0.142248368f); q = q * t + 0.127414796f; q = q * t;
    const f32x2 s = (v * v) * (-0.72134752044f);
    f32x2 e; e.x = __builtin_amdgcn_exp2f(s.x); e.y = __builtin_amdgcn_exp2f(s.y);
    const f32x2 m = v * (q * e), r = v - m;
    f32x2 o; o.x = v.x < 0.f ? m.x : r.x; o.y = v.y < 0.f ? m.y : r.y; return o;
}

template <int ACT  > struct EpiBf16 {
    static constexpr bool PERM = true, AFTER_DRAIN = false, HAS_INIT = false; static_assert(ACT == 0 || ACT == 1, "EpiBf16: ACT is 0 (none) or 1 (gelu_pk)");
    bf16_t* O; int ldc; const float* bias; int split_cols; size_t split_stride; float scale0;
    __device__ __forceinline__ void operator()(const f32x4 (&acc)[2][2][4][2], const Unit& u, int wr, int wc, int fr, int fq) const {
        const int row0 = u.pm * BM + wr * 64 + fr; int colt = u.pn * BM; bf16_t* base = O;
        float sc = 1.f; if (split_cols) { const int t = colt / split_cols; base += (size_t)t * split_stride; colt -= t * split_cols; if (t == 0) sc = scale0; }
        const int col0 = colt + wc * 32 + 8 * fq, bcol0 = u.pn * BM + wc * 32 + 8 * fq;
        f32x4 bv[2][2];
#pragma unroll
        for (int bj = 0; bj < 2; ++bj)
#pragma unroll
            for (int n = 0; n < 2; ++n) bv[bj][n] = bias ? *(const f32x4*)(bias + bcol0 + bj * HALF + 4 * n) : (f32x4){0.f, 0.f, 0.f, 0.f};
#pragma unroll
        for (int ai = 0; ai < 2; ++ai)
#pragma unroll
            for (int m = 0; m < 4; ++m) { bf16_t* rowp = base + (size_t)(row0 + ai * HALF + m * 16) * ldc + col0;
#pragma unroll
                for (int bj = 0; bj < 2; ++bj) { f32x4 v0 = acc[ai][bj][m][0] + bv[bj][0], v1 = acc[ai][bj][m][1] + bv[bj][1];
                    if (ACT == 1) { f32x2 a = gelu_pk((f32x2){v0[0], v0[1]}), b = gelu_pk((f32x2){v0[2], v0[3]}), c = gelu_pk((f32x2){v1[0], v1[1]}), d = gelu_pk((f32x2){v1[2], v1[3]});
                        v0 = (f32x4){a.x, a.y, b.x, b.y}; v1 = (f32x4){c.x, c.y, d.x, d.y}; }
                    v0 = v0 * sc; v1 = v1 * sc; u32x4 w; w.x = cvt_pk_bf16(v0[0], v0[1]); w.y = cvt_pk_bf16(v0[2], v0[3]); w.z = cvt_pk_bf16(v1[0], v1[1]); w.w = cvt_pk_bf16(v1[2], v1[3]);
                    *(u32x4*)(rowp + bj * HALF) = w; } }
    }
};

__device__ __forceinline__ unsigned pk4_fp8(float a, float b, float c, float d) {
    a = fminf(fmaxf(a, -448.f), 448.f); b = fminf(fmaxf(b, -448.f), 448.f); c = fminf(fmaxf(c, -448.f), 448.f); d = fminf(fmaxf(d, -448.f), 448.f);
    int p = 0; p = __builtin_amdgcn_cvt_pk_fp8_f32(a, b, p, false); p = __builtin_amdgcn_cvt_pk_fp8_f32(c, d, p, true); return (unsigned)p;
}
struct EpiRes {
    static constexpr bool PERM = false, AFTER_DRAIN = false, HAS_INIT = false;
    const float* __restrict__ X; bf16_t* __restrict__ XH; int ldc;
    __device__ __forceinline__ void operator()(const f32x4 (&acc)[2][2][4][2], const Unit& u, int wr, int wc, int fr, int fq) const {
        const int row0 = u.pm * BM + wr * 64 + fr, col0 = u.pn * BM + wc * 32 + 4 * fq;
#pragma unroll
        for (int ai = 0; ai < 2; ++ai)
#pragma unroll
            for (int mp = 0; mp < 2; ++mp) { f32x4 xv[2][2][2];
#pragma unroll
                for (int mm = 0; mm < 2; ++mm) { const size_t off = (size_t)(row0 + ai * HALF + (2 * mp + mm) * 16) * ldc + col0;
#pragma unroll
                    for (int bj = 0; bj < 2; ++bj)
#pragma unroll
                        for (int n = 0; n < 2; ++n) xv[mm][bj][n] = __builtin_nontemporal_load((const f32x4*)(X + off + bj * HALF + n * 16)); }
#pragma unroll
                for (int mm = 0; mm < 2; ++mm) { const size_t off = (size_t)(row0 + ai * HALF + (2 * mp + mm) * 16) * ldc + col0;
#pragma unroll
                    for (int bj = 0; bj < 2; ++bj)
#pragma unroll
                        for (int n = 0; n < 2; ++n) { const size_t o2 = off + bj * HALF + n * 16; const f32x4 v = xv[mm][bj][n] + acc[ai][bj][2 * mp + mm][n];
                            *(unsigned long long*)(XH + o2) = (unsigned long long)cvt_pk_bf16(v[0], v[1]) | ((unsigned long long)cvt_pk_bf16(v[2], v[3]) << 32); } } }
    }
};
struct EpiInproj {
    static constexpr bool PERM = true, AFTER_DRAIN = false, HAS_INIT = false;
    bf16_t* PA; bf16_t* PH;
    __device__ __forceinline__ void operator()(const f32x4 (&acc)[2][2][4][2], const Unit& u, int wr, int wc, int fr, int fq) const {
#pragma unroll
        for (int bj = 0; bj < 2; ++bj) { const int col = u.pn * BM + bj * HALF + wc * 32 + 8 * fq;
            bf16_t* base; int rowlen;
            if (col < 1536) { const int arr = col >> 9, hd = (col & 511) >> 6, dd = col & 63; base = PA + ((size_t)(arr * 16) * 8 + hd) * 2048 * 64 + dd; rowlen = 64; }
            else { const int c2 = col - 1536, arr = c2 >> 9, hd = (c2 & 511) >> 7, dd = c2 & 127; base = PH + ((size_t)(arr * 16) * 4 + hd) * 2048 * 128 + dd; rowlen = 128; }
            const size_t bstride = (size_t)(rowlen == 64 ? 8 : 4) * 2048 * rowlen;
#pragma unroll
            for (int ai = 0; ai < 2; ++ai)
#pragma unroll
                for (int m = 0; m < 4; ++m) { const int row = u.pm * BM + ai * HALF + wr * 64 + m * 16 + fr, b = row >> 11, s = row & 2047;
                    const f32x4 v0 = acc[ai][bj][m][0], v1 = acc[ai][bj][m][1];
                    u32x4 w; w.x = cvt_pk_bf16(v0[0], v0[1]); w.y = cvt_pk_bf16(v0[2], v0[3]); w.z = cvt_pk_bf16(v1[0], v1[1]); w.w = cvt_pk_bf16(v1[2], v1[3]);
                    *(u32x4*)(base + (size_t)b * bstride + (size_t)s * rowlen) = w; } }
    }
};
struct MoeOrder {
    const PG8_LAS int* tile_e; const PG8_LAS unsigned short* rowtab; int ntn, nunits, G, c; unsigned rowbytes; int rev;
    __device__ __forceinline__ bool next(int i, Unit& u) const {
        const int L = i * G + c; if (L >= nunits) return false;
        const int pm0 = L / ntn, pl = L - pm0 * ntn, pm = rev ? rev - 1 - pm0 : pm0; u.pm = pm; u.pn = tile_e[pm] * ntn + pl; u.slot = i; return true;
    }
    __device__ __forceinline__ unsigned rowoff(const Unit& u, int r) const { return (rowtab ? (unsigned)rowtab[u.slot * 256 + r] : (unsigned)(u.pm * 256 + r)) * rowbytes; }
    __device__ __forceinline__ void a_ready(const Unit&) const {}
    __device__ __forceinline__ void done(const Unit&) const {}
};
template <bool OUT8> struct EpiAct {
    static constexpr bool PERM = true, AFTER_DRAIN = false, HAS_INIT = true;
    unsigned char* ACT; const PG8_LAS float* biastab; float oscale;
    __device__ __forceinline__ void init(f32x4 (&acc)[2][2][4][2], const Unit& u, int wc, int fq) const {
#pragma unroll
        for (int n = 0; n < 2; ++n) { const f32x4 bg = *(const PG8_LAS f32x4*)(biastab + u.slot * 256 + wc * 32 + 8 * fq + 4 * n), bu = *(const PG8_LAS f32x4*)(biastab + u.slot * 256 + 128 + wc * 32 + 8 * fq + 4 * n);
#pragma unroll
            for (int ai = 0; ai < 2; ++ai)
#pragma unroll
                for (int m = 0; m < 4; ++m) { acc[ai][0][m][n] = bg; acc[ai][1][m][n] = bu; } }
    }
    __device__ __forceinline__ void operator()(const f32x4 (&acc)[2][2][4][2], const Unit& u, int wr, int wc, int fr, int fq) const {
        const int pl = u.pn & 7; const int row0 = u.pm * BM + wr * 64 + fr, acol0 = pl * 128 + wc * 32 + 8 * fq;
#pragma unroll
        for (int ai = 0; ai < 2; ++ai)
#pragma unroll
            for (int m = 0; m < 4; ++m) { unsigned char* rowp = ACT + (size_t)(row0 + ai * HALF + m * 16) * 1024 + acol0; f32x4 a4[2];
#pragma unroll
                for (int n = 0; n < 2; ++n) { const f32x4 g4 = acc[ai][0][m][n], u4 = acc[ai][1][m][n]; f32x4 gl, ul, ex;
#pragma unroll
                    for (int j = 0; j < 4; ++j) { gl[j] = fminf(g4[j], 7.0f); ul[j] = __builtin_amdgcn_fmed3f(u4[j], -7.0f, 7.0f); }
                    const f32x4 t4 = gl * (-1.702f * 1.44269504089f);
#pragma unroll
                    for (int j = 0; j < 4; ++j) ex[j] = __builtin_amdgcn_exp2f(t4[j]);
                    const f32x4 d4 = ex + 1.0f; f32x4 s4;
#pragma unroll
                    for (int j = 0; j < 4; ++j) s4[j] = __builtin_amdgcn_rcpf(d4[j]);
                    a4[n] = (gl * s4) * (ul * oscale + oscale); }
                if constexpr (OUT8) { int p0 = 0, p1 = 0; p0 = __builtin_amdgcn_cvt_pk_fp8_f32(a4[0][0], a4[0][1], p0, false); p0 = __builtin_amdgcn_cvt_pk_fp8_f32(a4[0][2], a4[0][3], p0, true);
                    p1 = __builtin_amdgcn_cvt_pk_fp8_f32(a4[1][0], a4[1][1], p1, false); p1 = __builtin_amdgcn_cvt_pk_fp8_f32(a4[1][2], a4[1][3], p1, true);
                    *(unsigned long long*)rowp = (unsigned long long)(unsigned)p0 | ((unsigned long long)(unsigned)p1 << 32); }
                else { u32x4 w; w.x = cvt_pk_bf16(a4[0][0], a4[0][1]); w.y = cvt_pk_bf16(a4[0][2], a4[0][3]); w.z = cvt_pk_bf16(a4[1][0], a4[1][1]); w.w = cvt_pk_bf16(a4[1][2], a4[1][3]); *(u32x4*)(rowp + (size_t)(row0 + ai * HALF + m * 16) * 1024 + acol0) = w; } }
    }
};
struct EpiDown {
    static constexpr bool PERM = true, AFTER_DRAIN = false, HAS_INIT = true;
    unsigned char* YK; const PG8_LAS int* tktab; const PG8_LAS float* biastab; float oscale;
    __device__ __forceinline__ void init(f32x4 (&acc)[2][2][4][2], const Unit& u, int wc, int fq) const {
#pragma unroll
        for (int bj = 0; bj < 2; ++bj)
#pragma unroll
            for (int n = 0; n < 2; ++n) { const f32x4 bv = *(const PG8_LAS f32x4*)(biastab + u.slot * 256 + bj * HALF + wc * 32 + 8 * fq + 4 * n) * oscale;
#pragma unroll
                for (int ai = 0; ai < 2; ++ai)
#pragma unroll
                    for (int m = 0; m < 4; ++m) acc[ai][bj][m][n] = bv; }
    }
    __device__ __forceinline__ void operator()(const f32x4 (&acc)[2][2][4][2], const Unit& u, int wr, int wc, int fr, int fq) const {
        const int pl = u.pn & 3; const int col0 = pl * BM + wc * 32 + 8 * fq;
#pragma unroll
        for (int ai = 0; ai < 2; ++ai)
#pragma unroll
            for (int m = 0; m < 4; ++m) { const int tk = tktab[u.slot * 256 + ai * HALF + wr * 64 + m * 16 + fr];
                if (tk >= 0) { unsigned char* rowp = YK + (size_t)tk * 1024 + col0;
#pragma unroll
                    for (int bj = 0; bj < 2; ++bj) { f32x4 v0 = acc[ai][bj][m][0], v1 = acc[ai][bj][m][1];
#pragma unroll
                        for (int j = 0; j < 4; ++j) { v0[j] = __builtin_amdgcn_fmed3f(v0[j], -448.f, 448.f); v1[j] = __builtin_amdgcn_fmed3f(v1[j], -448.f, 448.f); }
                        int p0 = 0, p1 = 0; p0 = __builtin_amdgcn_cvt_pk_fp8_f32(v0[0], v0[1], p0, false); p0 = __builtin_amdgcn_cvt_pk_fp8_f32(v0[2], v0[3], p0, true);
                        p1 = __builtin_amdgcn_cvt_pk_fp8_f32(v1[0], v1[1], p1, false); p1 = __builtin_amdgcn_cvt_pk_fp8_f32(v1[2], v1[3], p1, true);
                        *(unsigned long long*)(rowp + bj * HALF) = (unsigned long long)(unsigned)p0 | ((unsigned long long)(unsigned)p1 << 32); } } }
    }
};


template <class Epi, class Sched, bool ALIGN_EPI = false, bool SP2 = false, bool GATHER = false, int SCW = 0, int SCX = 0>
__device__ __forceinline__ void gemm_phase(PG8_LAS unsigned char* lds, const Gemm g, const Sched& S, const Epi& E, const int tid) {
    const int wid = __builtin_amdgcn_readfirstlane(tid >> 6), lane = tid & 63, wr = wid >> 2, wc = wid & 3, fr = lane & 15, fq = lane >> 4;
    const int K = g.K, nt = K / BK;
    unsigned voffA[2], voffB[2]; int RA[2]; unsigned CA2[2]; unsigned va0[2] = {0u, 0u}, va1[2] = {0u, 0u};
#pragma unroll
    for (int i = 0; i < 2; ++i) { int R, C; stage_rc(tid * 16 + i * 8192, R, C); const int Rb = Epi::PERM ? ((R & ~31) + perm32(R & 31)) : R;
        voffA[i] = (unsigned)(R * K + C) * 2u; voffB[i] = (unsigned)(Rb * K + C) * 2u; RA[i] = R; CA2[i] = (unsigned)C * 2u; }
    static_assert(!GATHER || SP2, "the gathered-A form exists for the SP2 loop only");
    const char* const gA0 = (const char*)g.A;
#define PG8_VA(u) do { int l_; asm volatile("v_mbcnt_lo_u32_b32 %0, -1, 0\n\tv_mbcnt_hi_u32_b32 %0, -1, %0" : "=v"(l_)); const int t_ = wid * 64 + l_;     \
        _Pragma("unroll") for (int _i = 0; _i < 2; ++_i) { int R_, C_; stage_rc(t_ * 16 + _i * 8192, R_, C_); va0[_i] = S.rowoff((u), R_) + (unsigned)C_ * 2u; va1[_i] = S.rowoff((u), HALF + R_) + (unsigned)C_ * 2u; } } while (0)
#define PG8_STA(bufoff, base_ng, base_g, h) do { if constexpr (GATHER) { if (h) PG8_STAGE(bufoff, base_g, va1); else PG8_STAGE(bufoff, base_g, va0); } else PG8_STAGE(bufoff, base_ng, voffA); } while (0)
    const size_t kstep = (size_t)(BK * 2);
    const size_t hstep = (size_t)HALF * K * 2;
    const size_t tstep = 2 * hstep;
    const unsigned ldsw = (unsigned)wid * 1024u;
    const int aoff = lds_byte(wr * 64 + fr, fq * 8), boff = lds_byte(wc * 32 + fr, fq * 8);
#define PG8_SA(b, h) (((b) * 2 + (h)) * HTB)
#define PG8_SB(b, h) ((4 + (b) * 2 + (h)) * HTB)
#define PG8_STAGE(bufoff, gbase, voff) do { _Pragma("unroll") for (int _i = 0; _i < 2; ++_i) \
        __builtin_amdgcn_global_load_lds((const unsigned*)((const char*)(gbase) + (voff)[_i]), (PG8_LAS unsigned*)(lds + (bufoff) + ldsw + _i * 8192), 16, 0, 0); } while (0)
#define PG8_LDA(dst, b, h) do { if constexpr (SCW != 0) { _Pragma("unroll") for (int m = 0; m < 4; ++m) dst##8[m] = PG8_CAT8(*(const PG8_LAS bf16x8*)(lds + PG8_SA(b, h) + aoff + m * 2048), *(const PG8_LAS bf16x8*)(lds + PG8_SA(b, h) + aoff + m * 2048 + 1024)); } \
        else { _Pragma("unroll") for (int m = 0; m < 4; ++m) _Pragma("unroll") for (int k = 0; k < 2; ++k) dst[m][k] = *(const PG8_LAS bf16x8*)(lds + PG8_SA(b, h) + aoff + m * 2048 + k * 1024); } } while (0)
#define PG8_LDB(dst, b, h) do { if constexpr (SCW != 0) { _Pragma("unroll") for (int n = 0; n < 2; ++n) dst##8[n] = PG8_CAT8(*(const PG8_LAS bf16x8*)(lds + PG8_SB(b, h) + boff + n * 2048), *(const PG8_LAS bf16x8*)(lds + PG8_SB(b, h) + boff + n * 2048 + 1024)); } \
        else { _Pragma("unroll") for (int n = 0; n < 2; ++n) _Pragma("unroll") for (int k = 0; k < 2; ++k) dst[n][k] = *(const PG8_LAS bf16x8*)(lds + PG8_SB(b, h) + boff + n * 2048 + k * 1024); } } while (0)
#define PG8_CAT8(lo, hi) __builtin_shufflevector(__builtin_bit_cast(i32x4_t, (lo)), __builtin_bit_cast(i32x4_t, (hi)), 0, 1, 2, 3, 4, 5, 6, 7)
#define PG8_MMA(ai, bj, At, Bt) do { __builtin_amdgcn_s_setprio(1); _Pragma("unroll") for (int m = 0; m < 4; ++m) _Pragma("unroll") for (int n = 0; n < 2; ++n) { \
        if constexpr (SCW != 0) acc[ai][bj][m][n] = __builtin_amdgcn_mfma_scale_f32_16x16x128_f8f6f4(Bt##8[n], At##8[m], acc[ai][bj][m][n], 0, 0, 0, SCW, 0, SCX); \
        else { _Pragma("unroll") for (int k = 0; k < 2; ++k) acc[ai][bj][m][n] = __builtin_amdgcn_mfma_f32_16x16x32_bf16(Bt[n][k], At[m][k], acc[ai][bj][m][n], 0, 0, 0); } } __builtin_amdgcn_s_setprio(0); } while (0)
#define PG8_WAIT_V(n) asm volatile("s_waitcnt vmcnt(" #n ")" ::: "memory")
#define PG8_WAIT_L(n) asm volatile("s_waitcnt lgkmcnt(" #n ")" ::: "memory")
#define PG8_BAR __builtin_amdgcn_s_barrier()
#define PG8_SCHED __builtin_amdgcn_sched_barrier(0)
    Unit cur, nxt; int ui = 0;
    if (!S.next(0, cur)) return;
    f32x4 acc[2][2][4][2];
    if constexpr (Epi::HAS_INIT) E.init(acc, cur, wc, fq);
    else {
#pragma unroll
    for (int a = 0; a < 2; ++a)
#pragma unroll
        for (int b = 0; b < 2; ++b)
#pragma unroll
            for (int m = 0; m < 4; ++m)
#pragma unroll
                for (int n = 0; n < 2; ++n) acc[a][b][m][n] = (f32x4){0.f, 0.f, 0.f, 0.f};
    }
    bf16x8 At[4][2], B0[2][2], B1[2][2]; i32x8_t At8[4], B08[2], B18[2];
    const char* cA = (const char*)g.A + (size_t)cur.pm * tstep; const char* cB = (const char*)g.Bt + (size_t)cur.pn * tstep;
    S.a_ready(cur);
    if constexpr (SP2) {
        if constexpr (GATHER) PG8_VA(cur);
        PG8_STAGE(PG8_SB(0, 0), cB, voffB); PG8_STAGE(PG8_SB(0, 1), cB + hstep, voffB); PG8_STA(PG8_SA(0, 0), cA, gA0, 0); PG8_STA(PG8_SA(0, 1), cA + hstep, gA0, 1);
        if (wr == 1) PG8_BAR;
        PG8_WAIT_V(2); PG8_BAR;
        PG8_STAGE(PG8_SB(1, 0), cB + kstep, voffB); PG8_STA(PG8_SA(1, 0), cA + kstep, gA0 + kstep, 0); PG8_STAGE(PG8_SB(1, 1), cB + hstep + kstep, voffB);
        PG8_WAIT_V(6); PG8_BAR;
    } else {
        PG8_STAGE(PG8_SB(0, 0), cB, voffB); PG8_STAGE(PG8_SA(0, 0), cA, voffA); PG8_STAGE(PG8_SB(0, 1), cB + hstep, voffB); PG8_STAGE(PG8_SA(0, 1), cA + hstep, voffA);
        if (wr == 1) PG8_BAR;
        PG8_WAIT_V(4); PG8_BAR;
        PG8_STAGE(PG8_SB(1, 0), cB + kstep, voffB); PG8_STAGE(PG8_SA(1, 0), cA + kstep, voffA); PG8_STAGE(PG8_SB(1, 1), cB + hstep + kstep, voffB);
        PG8_WAIT_V(6); PG8_BAR;
    }
    for (;;) {
        const bool has_next = S.next(ui + 1, nxt);
        const char* nA = has_next ? (const char*)g.A + (size_t)nxt.pm * tstep : cA; const char* nB = has_next ? (const char*)g.Bt + (size_t)nxt.pn * tstep : cB;
        _Pragma("nounroll") for (int t = 0; t < nt; t += 2) {
            const bool last = (t == nt - 2);
            const char* a1 = cA + (size_t)(t + 1) * kstep;
            const char* a2 = last ? nA : cA + (size_t)(t + 2) * kstep; const char* b2 = last ? nB : cB + (size_t)(t + 2) * kstep;
            const char* a3 = a2 + kstep; const char* b3 = b2 + kstep;
            if (last && has_next) S.a_ready(nxt);
            const char* const g1 = gA0 + (size_t)(t + 1) * kstep; const char* const g2 = last ? gA0 : gA0 + (size_t)(t + 2) * kstep; const char* const g3 = g2 + kstep;
            if constexpr (SP2) {
            PG8_LDB(B0, 0, 0); PG8_LDB(B1, 0, 1); PG8_SCHED; PG8_LDA(At, 0, 0); PG8_STA(PG8_SA(1, 1), a1 + hstep, g1, 1);
            PG8_WAIT_V(8); PG8_WAIT_L(0); PG8_BAR; PG8_MMA(0, 0, At, B0); PG8_MMA(0, 1, At, B1); PG8_BAR; PG8_SCHED;
            if constexpr (GATHER) { if (last && has_next) PG8_VA(nxt); }
            PG8_LDA(At, 0, 1); PG8_STAGE(PG8_SB(0, 0), b2, voffB); PG8_STAGE(PG8_SB(0, 1), b2 + hstep, voffB); PG8_STA(PG8_SA(0, 0), a2, g2, 0);
            PG8_WAIT_V(8); PG8_WAIT_L(0); PG8_BAR; PG8_MMA(1, 0, At, B0); PG8_MMA(1, 1, At, B1); PG8_BAR; PG8_SCHED;
            PG8_LDB(B0, 1, 0); PG8_LDB(B1, 1, 1); PG8_SCHED; PG8_LDA(At, 1, 0); PG8_STA(PG8_SA(0, 1), a2 + hstep, g2, 1);
            PG8_WAIT_V(8); PG8_WAIT_L(0); PG8_BAR; PG8_MMA(0, 0, At, B0); PG8_MMA(0, 1, At, B1); PG8_BAR; PG8_SCHED;
            PG8_LDA(At, 1, 1); PG8_STAGE(PG8_SB(1, 0), b3, voffB); PG8_STAGE(PG8_SB(1, 1), b3 + hstep, voffB); PG8_STA(PG8_SA(1, 0), a3, g3, 0);
            PG8_WAIT_V(8); PG8_WAIT_L(0); PG8_BAR; PG8_MMA(1, 0, At, B0); PG8_MMA(1, 1, At, B1); PG8_BAR; PG8_SCHED;
            } else {
            PG8_LDB(B0, 0, 0); PG8_SCHED; PG8_LDA(At, 0, 0); PG8_STAGE(PG8_SA(1, 1), a1 + hstep, voffA);
            PG8_WAIT_L(8); PG8_BAR; PG8_WAIT_L(0); PG8_MMA(0, 0, At, B0); PG8_BAR; PG8_SCHED;
            PG8_LDB(B1, 0, 1); PG8_STAGE(PG8_SB(0, 0), b2, voffB);
            PG8_BAR; PG8_WAIT_L(0); PG8_MMA(0, 1, At, B1); PG8_BAR;
            PG8_LDA(At, 0, 1); PG8_STAGE(PG8_SA(0, 0), a2, voffA);
            PG8_BAR; PG8_WAIT_L(0); PG8_MMA(1, 0, At, B0); PG8_BAR; PG8_SCHED;
            PG8_STAGE(PG8_SB(0, 1), b2 + hstep, voffB);
            PG8_WAIT_V(6); PG8_BAR; PG8_MMA(1, 1, At, B1); PG8_BAR;
            PG8_LDB(B0, 1, 0); PG8_SCHED; PG8_LDA(At, 1, 0); PG8_STAGE(PG8_SA(0, 1), a2 + hstep, voffA);
            PG8_WAIT_L(8); PG8_BAR; PG8_WAIT_L(0); PG8_MMA(0, 0, At, B0); PG8_BAR; PG8_SCHED;
            PG8_LDB(B1, 1, 1); PG8_STAGE(PG8_SB(1, 0), b3, voffB);
            PG8_BAR; PG8_WAIT_L(0); PG8_MMA(0, 1, At, B1); PG8_BAR;
            PG8_LDA(At, 1, 1); PG8_STAGE(PG8_SA(1, 0), a3, voffA);
            PG8_BAR; PG8_WAIT_L(0); PG8_MMA(1, 0, At, B0); PG8_BAR; PG8_SCHED;
            PG8_STAGE(PG8_SB(1, 1), b3 + hstep, voffB);
            PG8_WAIT_V(6); PG8_BAR; PG8_MMA(1, 1, At, B1); PG8_BAR;
            }
        }
        if constexpr (ALIGN_EPI) { if (wr == 0) PG8_BAR; }
        if constexpr (!Epi::AFTER_DRAIN) { int fr_ = fr, fq_ = fq; asm volatile("" : "+v"(fr_), "+v"(fq_));
            E(acc, cur, wr, wc, fr_, fq_); S.done(cur); }
        if (!has_next) break;
        if constexpr (Epi::HAS_INIT) { int fq_ = fq; asm volatile("" : "+v"(fq_)); E.init(acc, nxt, wc, fq_); }
        else {
#pragma unroll
        for (int a = 0; a < 2; ++a)
#pragma unroll
            for (int b = 0; b < 2; ++b)
#pragma unroll
                for (int m = 0; m < 4; ++m)
#pragma unroll
                    for (int n = 0; n < 2; ++n) acc[a][b][m][n] = (f32x4){0.f, 0.f, 0.f, 0.f};
        }
        cur = nxt; cA = nA; cB = nB; ++ui;
        if constexpr (ALIGN_EPI) { if (wr == 1) PG8_BAR; }
    }
    PG8_WAIT_V(0);
    if constexpr (!ALIGN_EPI) { if (wr == 0) PG8_BAR; }
    PG8_BAR;
    if constexpr (Epi::AFTER_DRAIN) { E.fused(acc, cur, wr, wc, fr, fq, lds, wid, lane); S.done(cur); }
#undef PG8_SA
#undef PG8_CAT8
#undef PG8_VA
#undef PG8_STA
#undef PG8_SB
#undef PG8_STAGE
#undef PG8_LDA
#undef PG8_LDB
#undef PG8_MMA
#undef PG8_WAIT_V
#undef PG8_WAIT_L
#undef PG8_BAR
#undef PG8_SCHED
}
}

#ifndef PG8_SP2
#define PG8_SP2 true
#endif
#ifndef PG8_ALIGN
#define PG8_ALIGN true
#endif
#define GAS __attribute__((address_space(1)))
#define LAS __attribute__((address_space(3)))
typedef unsigned short bf16;
typedef unsigned v4u __attribute__((ext_vector_type(4)));
typedef float f32x4 __attribute__((ext_vector_type(4)));
typedef short bf16x8 __attribute__((ext_vector_type(8)));
typedef GAS unsigned gu32;
typedef GAS unsigned long long gu64;
#define RLX_AGENT __ATOMIC_RELAXED, __HIP_MEMORY_SCOPE_AGENT
#define LDS_WAIT() asm volatile("s_waitcnt lgkmcnt(0)" ::: "memory")
#define VM_WAIT() asm volatile("s_waitcnt vmcnt(0)" ::: "memory")
__device__ __forceinline__ unsigned long long rt() { return __builtin_amdgcn_s_memrealtime(); }
__device__ __forceinline__ unsigned f2bf(float f) { unsigned u = __builtin_bit_cast(unsigned, f); return (u + 0x7fffu + ((u >> 16) & 1u)) >> 16; }
__device__ __forceinline__ unsigned pk2(float lo, float hi) { return f2bf(lo) | (f2bf(hi) << 16); }

#define XB_TMO      128
#define XB_XCNT(j)  (256  + 64 * (j))
#define XB_XSUB(j)  (1280 + 64 * (j))
#define XB_XGEN(j)  (2304 + 64 * (j))
#define XB_TOP      3328
#define XB_TOPGEN   3392
#define XCD_BAR_WORDS 3456
#define XB_SPIN_CAP (1u << 18)

__device__ __forceinline__ unsigned xb_ld(unsigned* p)              { return __hip_atomic_load(p, __ATOMIC_RELAXED, __HIP_MEMORY_SCOPE_AGENT); }
__device__ __forceinline__ unsigned xb_add(unsigned* p, unsigned v) { return __hip_atomic_fetch_add(p, v, __ATOMIC_RELAXED, __HIP_MEMORY_SCOPE_AGENT); }
__device__ __forceinline__ unsigned xb_xcc_id() { return (unsigned)__builtin_amdgcn_s_getreg((3 << 11) | 20) & 0xFu; }
#define XB_SPIN(cond, bar) do { unsigned _sp = 0; while (cond) { __builtin_amdgcn_s_sleep(1); \
    if ((++_sp & 255u) == 0u) { if (xb_ld(&(bar)[XB_TMO])) break; if (_sp > XB_SPIN_CAP) { atomicAdd(&(bar)[XB_TMO], 1u); break; } } } } while (0)

struct XcdBarrier {
    unsigned* bar; unsigned x;
    volatile LAS unsigned* st;
};

__device__ __forceinline__ XcdBarrier xcd_barrier_post(unsigned* bar, volatile LAS unsigned* st) {
    XcdBarrier b; b.bar = bar; b.x = xb_xcc_id(); b.st = st;
    if (threadIdx.x == 0) (void)xb_add(&bar[XB_XCNT(b.x)], 1u);
    return b;
}
__device__ __forceinline__ void xcd_barrier_complete(unsigned* bar, unsigned x, unsigned& nloc, unsigned& nx) {
    const unsigned G = gridDim.x * gridDim.y * gridDim.z;
    unsigned sum, cnt, mine, sp = 0u;
    for (;;) {
        sum = 0u; cnt = 0u; mine = 0u;
#pragma unroll
        for (unsigned j = 0; j < 16; ++j) { const unsigned c = xb_ld(&bar[XB_XCNT(j)]); sum += c; cnt += (c > 0u) ? 1u : 0u; mine = (j == x) ? c : mine; }
        if (sum == G) break;
        __builtin_amdgcn_s_sleep(1);
        if ((++sp & 255u) == 0u) { if (xb_ld(&bar[XB_TMO])) break; if (sp > XB_SPIN_CAP) { atomicAdd(&bar[XB_TMO], 1u); break; } }
    }
    nloc = mine > 0u ? mine : 1u; nx = cnt > 0u ? cnt : 1u;
}

__device__ __forceinline__ void xcd_barrier(const XcdBarrier& b) {
    asm volatile("s_waitcnt vmcnt(0)" ::: "memory");
    __syncthreads();
    if (threadIdx.x == 0) {
        unsigned* bar = b.bar;
        __builtin_amdgcn_s_waitcnt(0);
        unsigned nloc = b.st[0], nx = b.st[1];
        if (nloc == 0u) { xcd_barrier_complete(bar, b.x, nloc, nx); b.st[0] = nloc; b.st[1] = nx; }
        const unsigned old = xb_add(&bar[XB_XSUB(b.x)], 1u);
        const unsigned gen = old / nloc;
        if (old + 1u == (gen + 1u) * nloc) {
            __builtin_amdgcn_fence(__ATOMIC_RELEASE, "agent");
            asm volatile("s_waitcnt vmcnt(0)" ::: "memory");
            const unsigned og = xb_add(&bar[XB_TOP], 1u);
            const unsigned tg = og / nx;
            if (og + 1u == (tg + 1u) * nx) xb_add(&bar[XB_TOPGEN], 1u);
            else XB_SPIN(xb_ld(&bar[XB_TOPGEN]) == tg, bar);
            __builtin_amdgcn_fence(__ATOMIC_ACQUIRE, "agent");
            xb_add(&bar[XB_XGEN(b.x)], 1u);
            asm volatile("s_waitcnt vmcnt(0)" ::: "memory");
        } else {
            XB_SPIN(xb_ld(&bar[XB_XGEN(b.x)]) == gen, bar);
            __builtin_amdgcn_fence(__ATOMIC_ACQUIRE, "agent");
            asm volatile("s_waitcnt vmcnt(0)" ::: "memory");
        }
    }
    __syncthreads();
}

constexpr int NWAVES = 8;
#ifndef MK_ONE_LAUNCH
#define MK_ONE_LAUNCH 1
#endif

constexpr int BATCH = 16, SEQ = 2048, D = 1024, T = BATCH * SEQ;
constexpr int NIN = 3584;
constexpr int OFF_SQ = 0, OFF_SK = 512, OFF_SV = 1024, OFF_HQ = 1536, OFF_HF = 2048, OFF_HI = 2560, OFF_HG = 3072;
constexpr int NE = 32, TOPK = 4, NASSIGN = T * TOPK;
constexpr int MAXTILES = NASSIGN / 256 + NE;
constexpr int MAXROWS = MAXTILES * 256;
constexpr float EPS = 1e-6f;

constexpr size_t MiB = 1u << 20;
constexpr size_t WS_CTL = 0, CTL_ZERO_BYTES = 1 * MiB;
constexpr size_t WS_WIN = 2 * MiB;
constexpr size_t WS_WOUT = 10 * MiB;
constexpr size_t WS_WGU = 16 * MiB;
constexpr size_t WS_WD = 144 * MiB;
constexpr size_t WS_XN = 208 * MiB;
constexpr size_t WS_P = 272 * MiB;
constexpr size_t WS_PH = WS_P + 96 * MiB;
constexpr size_t WS_MIX = 496 * MiB;
constexpr size_t WS_ACT = 272 * MiB;
constexpr size_t WS_YK = 560 * MiB;
constexpr size_t WS_QN = 624 * MiB;
constexpr size_t WS_KN = 656 * MiB;
constexpr size_t WS_VT = 688 * MiB;
constexpr size_t WS_KVS = 720 * MiB;
constexpr size_t WS_DEC = 784 * MiB;
constexpr size_t WS_SSEG = 786 * MiB;
constexpr size_t WS_DSEG = 802 * MiB;
constexpr size_t WS_LIST = 816 * MiB;
constexpr size_t WS_TOPG = 825 * MiB;
constexpr size_t WS_X8 = 560 * MiB;
constexpr size_t WS_END = 832 * MiB;
static_assert(WS_ACT + (size_t)MAXROWS * 2048 <= WS_YK && WS_YK + (size_t)T * 4 * 2048 <= WS_LIST && WS_MIX + (size_t)T * 2048 <= WS_YK, "d_ws map");
constexpr int CW_TMO = 0, CW_CODE = 1;
constexpr int CW_CNT = 64;
constexpr int CW_BAR = 4096;

constexpr int RING_OFF = 0, RING_BYTES = 131072;
constexpr int RT_ROW = 2064, RT_WL = 32 * RT_ROW, RT_END = 64 * RT_ROW;
constexpr int LDSCTL_OFF = 133120, MISC_OFF = LDSCTL_OFF + 320;
constexpr int LTAB_OFF = LDSCTL_OFF + 512;
constexpr int LT_TS = MAXTILES, LT_CNT = MAXTILES + 32, LT_MISC = MAXTILES + 64, LT_WORDS = MAXTILES + 192;
constexpr int ROWTAB_OFF = LTAB_OFF + LT_WORDS * 4;
constexpr int MAXSLOT = 17;
constexpr int ROWTAB2_OFF = ROWTAB_OFF + MAXSLOT * 1024;
constexpr int LDS_BYTES = ROWTAB2_OFF + MAXSLOT * 512;
static_assert(RT_END <= LDSCTL_OFF && MISC_OFF + 128 <= LTAB_OFF && LDS_BYTES <= 160 * 1024 && (MAXTILES * 8 + 255) / 256 <= MAXSLOT && 2 * ((MAXTILES * 4 + 255) / 256) * 1024 <= MAXSLOT * 1536 && ROWTAB_OFF % 16 == 0, "LDS map");

struct Frame {
    LAS unsigned char* lds;
    volatile LAS unsigned* MISC;
    gu32* ctl;
    int tid, lane, wave, gw, ngw;
    int vcu, G;
    const float *x, *norm1_g, *w_in, *sb_q_g, *sb_k_g, *sb_out_g, *hg_lb, *hg_out_g, *w_out, *norm2_g, *w_router, *b_router, *w_gu, *b_gu, *w_d, *b_d;
    float* out;
    unsigned char* ws;
};
__device__ __forceinline__ float bf2f(unsigned short b) { return __builtin_bit_cast(float, (unsigned)b << 16); }
__device__ __forceinline__ float bflo(unsigned w) { return __builtin_bit_cast(float, w << 16); }
__device__ __forceinline__ float bfhi(unsigned w) { return __builtin_bit_cast(float, w & 0xffff0000u); }
typedef __bf16 bf16x2n_ __attribute__((ext_vector_type(2)));
typedef float f32x2n_ __attribute__((ext_vector_type(2)));
__device__ __forceinline__ unsigned pkbf(float a, float b) { const bf16x2n_ v = __builtin_convertvector((f32x2n_){a, b}, bf16x2n_); return __builtin_bit_cast(unsigned, v); }
__device__ __forceinline__ int lane_id() { int l; asm volatile("v_mbcnt_lo_u32_b32 %0, -1, 0\n\tv_mbcnt_hi_u32_b32 %0, -1, %0" : "=v"(l)); return l; }
__device__ __forceinline__ int vzero() { int z; asm volatile("v_mov_b32 %0, 0" : "=v"(z)); return z; }
__device__ __forceinline__ float wave_sum(float v) {
#pragma unroll
    for (int o = 1; o < 64; o <<= 1) v += __shfl_xor(v, o);
    return v;
}

constexpr float W8_SCALE = 256.f, A8_SCALE = 4.f, Y8_SCALE = 32.f; static_assert(Y8_SCALE == 32.f, "SC_W8Y below is 2^-8 * 32");
constexpr int SC_ONE = 0x7f7f7f7f, SC_W8 = 0x77777777, SC_A8 = 0x7d7d7d7d, SC_W8Y = 0x7c7c7c7c;
struct P0Item { const float* W; bf16* WT; const float* rowscale; int N, k0, n0, drow0, fp8; };
__device__ __forceinline__ void p0_load(const P0Item& it, f32x4 (&v)[16], int lane) {
    const int kr = lane >> 4, nc = 4 * (lane & 15);
#pragma unroll
    for (int i = 0; i < 16; ++i) v[i] = __builtin_nontemporal_load((const f32x4*)(it.W + (size_t)(it.k0 + 4 * i + kr) * it.N + it.n0 + nc));
}
__device__ __forceinline__ void p0_store(const P0Item& it, const f32x4 (&v)[16], LAS unsigned char* scr, int lane) {
    const int kr = lane >> 4, nc = 4 * (lane & 15);
#pragma unroll
    for (int i = 0; i < 16; ++i) { const float sc = it.rowscale ? it.rowscale[it.k0 + 4 * i + kr] : 1.f;
        *(LAS unsigned long long*)(scr + (4 * i + kr) * 136 + 2 * nc) = (unsigned long long)pkbf(v[i].x * sc, v[i].y * sc) | ((unsigned long long)pkbf(v[i].z * sc, v[i].w * sc) << 32); }
    LDS_WAIT(); asm volatile("" ::: "memory");
    unsigned val[64];
#pragma unroll
    for (int k = 0; k < 64; ++k) val[k] = *(const LAS unsigned short*)(scr + k * 136 + 2 * lane);
    if (it.fp8) { GAS v4u* o = (GAS v4u*)((unsigned char*)it.WT + (size_t)(it.drow0 + lane) * D + it.k0);
#pragma unroll
        for (int c = 0; c < 4; ++c) { v4u w4;
            w4.x = pg8::pk4_fp8(bflo(val[16 * c + 0]) * W8_SCALE, bflo(val[16 * c + 1]) * W8_SCALE, bflo(val[16 * c + 2]) * W8_SCALE, bflo(val[16 * c + 3]) * W8_SCALE);
            w4.y = pg8::pk4_fp8(bflo(val[16 * c + 4]) * W8_SCALE, bflo(val[16 * c + 5]) * W8_SCALE, bflo(val[16 * c + 6]) * W8_SCALE, bflo(val[16 * c + 7]) * W8_SCALE);
            w4.z = pg8::pk4_fp8(bflo(val[16 * c + 8]) * W8_SCALE, bflo(val[16 * c + 9]) * W8_SCALE, bflo(val[16 * c + 10]) * W8_SCALE, bflo(val[16 * c + 11]) * W8_SCALE);
            w4.w = pg8::pk4_fp8(bflo(val[16 * c + 12]) * W8_SCALE, bflo(val[16 * c + 13]) * W8_SCALE, bflo(val[16 * c + 14]) * W8_SCALE, bflo(val[16 * c + 15]) * W8_SCALE); o[c] = w4; }
    } else { GAS v4u* o = (GAS v4u*)(it.WT + (size_t)(it.drow0 + lane) * D + it.k0);
#pragma unroll
        for (int c = 0; c < 8; ++c) { v4u w4; w4.x = val[8 * c + 0] | (val[8 * c + 1] << 16); w4.y = val[8 * c + 2] | (val[8 * c + 3] << 16); w4.z = val[8 * c + 4] | (val[8 * c + 5] << 16); w4.w = val[8 * c + 6] | (val[8 * c + 7] << 16); o[c] = w4; } }
    LDS_WAIT(); asm volatile("" ::: "memory");
}
__device__ __forceinline__ void rms_rows2_to_bf16(const float* xa, const float* xb, bool hasb, const float* g, bf16* oa, bf16* ob, int lane) {
    const GAS f32x4* pa = (const GAS f32x4*)xa + lane; const GAS f32x4* pb = (const GAS f32x4*)(hasb ? xb : xa) + lane; const f32x4* gr = (const f32x4*)g + lane;
    f32x4 va[4], vb[4], gg[4]; float sa = 0.f, sb = 0.f;
#pragma unroll
    for (int j = 0; j < 4; ++j) { va[j] = __builtin_nontemporal_load(pa + 64 * j); vb[j] = __builtin_nontemporal_load(pb + 64 * j); gg[j] = gr[64 * j]; }
#pragma unroll
    for (int j = 0; j < 4; ++j) { sa += (va[j].x * va[j].x + va[j].y * va[j].y) + (va[j].z * va[j].z + va[j].w * va[j].w); sb += (vb[j].x * vb[j].x + vb[j].y * vb[j].y) + (vb[j].z * vb[j].z + vb[j].w * vb[j].w); }
    const float ra = 1.f / sqrtf(wave_sum(sa) * (1.f / D) + EPS), rb = 1.f / sqrtf(wave_sum(sb) * (1.f / D) + EPS);
    GAS unsigned long long* o8a = (GAS unsigned long long*)oa + lane; GAS unsigned long long* o8b = (GAS unsigned long long*)ob + lane;
#pragma unroll
    for (int j = 0; j < 4; ++j) o8a[64 * j] = (unsigned long long)pkbf(va[j].x * ra * gg[j].x, va[j].y * ra * gg[j].y) | ((unsigned long long)pkbf(va[j].z * ra * gg[j].z, va[j].w * ra * gg[j].w) << 32);
    if (hasb) {
#pragma unroll
        for (int j = 0; j < 4; ++j) o8b[64 * j] = (unsigned long long)pkbf(vb[j].x * rb * gg[j].x, vb[j].y * rb * gg[j].y) | ((unsigned long long)pkbf(vb[j].z * rb * gg[j].z, vb[j].w * rb * gg[j].w) << 32); }
}
__device__ __forceinline__ P0Item p0_item(Frame& F, int r) {
    constexpr int I_IN = 16 * (NIN / 64), I_OUT = 16 * 16, I_GU = NE * 16 * 32;
    P0Item it;
    if (r < I_IN) { const int nb = NIN / 64, kb = r / nb, nn = r % nb; it = P0Item{F.w_in, (bf16*)(F.ws + WS_WIN), nullptr, NIN, 64 * kb, 64 * nn, 64 * nn, 0}; return it; } r -= I_IN;
    if (r < I_OUT) { const int kb = r / 16, nn = r % 16; it = P0Item{F.w_out, (bf16*)(F.ws + WS_WOUT), nullptr, D, 64 * kb, 64 * nn, 64 * nn, 0}; return it; } r -= I_OUT;
    if (r < I_GU) { const int e = r / 512, q = r % 512, kb = q / 32, nn = q % 32;
        const int isup = nn >> 4, a = (nn & 15) * 64;
        it = P0Item{F.w_gu + (size_t)e * D * 2048, (bf16*)(F.ws + WS_WGU + (size_t)e * 2048 * D), F.norm2_g, 2048, 64 * kb, 64 * nn, 256 * (a >> 7) + 128 * isup + (a & 127), 1}; return it; } r -= I_GU;
    { const int e = r / 256, q = r % 256, kb = q / 16, nn = q % 16;
        it = P0Item{F.w_d + (size_t)e * D * D, (bf16*)(F.ws + WS_WD + (size_t)e * D * D), nullptr, D, 64 * kb, 64 * nn, 64 * nn, 1}; return it; }
}
__device__ __forceinline__ void p0_prologue(Frame& F) {
    LAS unsigned char* scr = F.lds + RING_OFF + F.wave * 16384;
    constexpr int NITEMS = 16 * (NIN / 64) + 16 * 16 + NE * 16 * 32 + NE * 16 * 16;
    {
        f32x4 va[16], vb[16]; int it = F.gw;
        if (it < NITEMS) { P0Item A = p0_item(F, it); p0_load(A, va, F.lane);
            for (;;) {
                const int itb = it + F.ngw; const bool hb = itb < NITEMS; const P0Item B = p0_item(F, hb ? itb : it); p0_load(B, vb, F.lane); __builtin_amdgcn_sched_barrier(0);
                p0_store(A, va, scr, F.lane);
                if (!hb) break;
                it = itb + F.ngw; const bool ha = it < NITEMS; A = p0_item(F, ha ? it : itb); p0_load(A, va, F.lane); __builtin_amdgcn_sched_barrier(0);
                p0_store(B, vb, scr, F.lane);
                if (!ha) break;
            }
        }
    }
    for (int m = F.gw; m < T; m += 2 * F.ngw) rms_rows2_to_bf16(F.x + (size_t)m * D, F.x + (size_t)(m + F.ngw) * D, m + F.ngw < T, F.norm1_g, (bf16*)(F.ws + WS_XN) + (size_t)m * D, (bf16*)(F.ws + WS_XN) + (size_t)(m + F.ngw) * D, F.lane);
}

typedef float f32x16 __attribute__((ext_vector_type(16)));
typedef __bf16 bf16x2n __attribute__((ext_vector_type(2)));
typedef float f32x2n __attribute__((ext_vector_type(2)));
#define MFMA32(a, b, c) __builtin_amdgcn_mfma_f32_32x32x16_bf16((a), (b), (c), 0, 0, 0)
__device__ __forceinline__ bf16x8 pack8(float a0, float a1, float a2, float a3, float a4, float a5, float a6, float a7) { const v4u p = {pkbf(a0, a1), pkbf(a2, a3), pkbf(a4, a5), pkbf(a6, a7)}; return __builtin_bit_cast(bf16x8, p); }
constexpr float QSCALE = 0.125f * 1.44269504089f;
__device__ __forceinline__ void prep_phase(Frame& F) {
    LAS unsigned* tl = (LAS unsigned*)(F.lds + RING_OFF + F.wave * 16384);
    const bf16* P = (const bf16*)(F.ws + WS_P); bf16* Qn = (bf16*)(F.ws + WS_QN); bf16* Kn = (bf16*)(F.ws + WS_KN); bf16* VT = (bf16*)(F.ws + WS_VT);
    const int tr = F.lane >> 3, c8 = F.lane & 7;
    float gq[8], gk[8];
#pragma unroll
    for (int j = 0; j < 8; ++j) { gq[j] = F.sb_q_g[8 * c8 + j] * QSCALE; gk[j] = F.sb_k_g[8 * c8 + j]; }
    for (int it = F.gw; it < 4096; it += F.ngw) {
        const int bh = it & 127, blk = it >> 7, b = bh >> 3, h = bh & 7;
        const bf16* base = P + ((size_t)b * 8 + h) * SEQ * 64 + (size_t)(blk * 64 + tr) * 64 + 8 * c8;
        v4u rq[8], rk[8], rv[8];
#pragma unroll
        for (int i = 0; i < 8; ++i) { const bf16* row = base + (size_t)(8 * i) * 64; rq[i] = *(const GAS v4u*)row; rk[i] = *(const GAS v4u*)(row + (size_t)16 * 8 * SEQ * 64); rv[i] = *(const GAS v4u*)(row + (size_t)2 * 16 * 8 * SEQ * 64); }
#pragma unroll
        for (int which = 0; which < 2; ++which) {
            bf16* const obase = (which ? Kn : Qn) + ((size_t)bh * 64 + blk * 2) * 2048 + (c8 >> 1) * 512 + (c8 & 1) * 256 + tr * 8;
#pragma unroll
            for (int i = 0; i < 8; ++i) { const v4u r4 = which ? rk[i] : rq[i]; float v[8] = {bflo(r4.x), bfhi(r4.x), bflo(r4.y), bfhi(r4.y), bflo(r4.z), bfhi(r4.z), bflo(r4.w), bfhi(r4.w)};
                float ss = 0.f;
#pragma unroll
                for (int j = 0; j < 8; ++j) ss += v[j] * v[j];
                ss += __shfl_xor(ss, 1); ss += __shfl_xor(ss, 2); ss += __shfl_xor(ss, 4);
                const float rs = 1.f / sqrtf(ss * (1.f / 64.f) + EPS);
                v4u w4;
                if (which) { w4.x = pkbf(v[0] * rs * gk[0], v[1] * rs * gk[1]); w4.y = pkbf(v[2] * rs * gk[2], v[3] * rs * gk[3]); w4.z = pkbf(v[4] * rs * gk[4], v[5] * rs * gk[5]); w4.w = pkbf(v[6] * rs * gk[6], v[7] * rs * gk[7]); }
                else { w4.x = pkbf(v[0] * rs * gq[0], v[1] * rs * gq[1]); w4.y = pkbf(v[2] * rs * gq[2], v[3] * rs * gq[3]); w4.z = pkbf(v[4] * rs * gq[4], v[5] * rs * gq[5]); w4.w = pkbf(v[6] * rs * gq[6], v[7] * rs * gq[7]); }
                *(GAS v4u*)(obase + (i >> 2) * 2048 + (i & 3) * 64) = w4; }
        }
        {
#pragma unroll
            for (int i = 0; i < 8; ++i) { LAS unsigned* q = tl + (8 * i + tr) * 33 + 4 * c8; q[0] = rv[i].x; q[1] = rv[i].y; q[2] = rv[i].z; q[3] = rv[i].w; }
            LDS_WAIT(); asm volatile("" ::: "memory");
            const LAS unsigned short* t16 = (const LAS unsigned short*)tl; const int dr = tr;
#define KAP(pos) (((pos) & ~12) | (((pos) & 4) << 1) | (((pos) & 8) >> 1))
            bf16* const obase = VT + ((size_t)bh * 64 + blk * 2 + (c8 >> 2)) * 2048 + ((c8 >> 1) & 1) * 512 + (c8 & 1) * 256;
#pragma unroll
            for (int j = 0; j < 8; ++j) { unsigned val[8];
#pragma unroll
                for (int p = 0; p < 8; ++p) { const int pos = 8 * c8 + p; val[p] = t16[KAP(pos) * 66 + 8 * j + dr]; }
                v4u w4; w4.x = val[0] | (val[1] << 16); w4.y = val[2] | (val[3] << 16); w4.z = val[4] | (val[5] << 16); w4.w = val[6] | (val[7] << 16);
                *(GAS v4u*)(obase + (j >> 2) * 1024 + ((8 * j + dr) & 31) * 8) = w4; }
#undef KAP
            LDS_WAIT(); asm volatile("" ::: "memory");
        }
    }
}

__device__ __forceinline__ int crow16(int i, int hh) { return (i & 3) + 8 * (i >> 2) + 4 * hh; }
__device__ __forceinline__ void attn_item(Frame& F, int bh, int qb, float thr, const bf16x8 (&Lt)[2]) {
    const int r = F.lane & 31, hh = F.lane >> 5, b = bh >> 3, h = bh & 7, q0 = qb * 32;
    const bf16* Qn = (const bf16*)(F.ws + WS_QN); const bf16* Kn = (const bf16*)(F.ws + WS_KN); const bf16* VT = (const bf16*)(F.ws + WS_VT);
    bf16x8 qf[4];
#pragma unroll
    for (int s = 0; s < 4; ++s) qf[s] = *(const GAS bf16x8*)(Qn + ((size_t)bh * 64 + qb) * 2048 + s * 512 + F.lane * 8);
    f32x4 gout[2][4];
#pragma unroll
    for (int db = 0; db < 2; ++db)
#pragma unroll
        for (int gq = 0; gq < 4; ++gq) gout[db][gq] = *(const f32x4*)(F.sb_out_g + h * 64 + 32 * db + 8 * gq + 4 * hh);
    f32x16 O0, O1;
#pragma unroll
    for (int i = 0; i < 16; ++i) { O0[i] = 0.f; O1[i] = 0.f; }
    float carry = 0.f;
    const bf16* kbase = Kn + (size_t)bh * 64 * 2048 + F.lane * 8; const bf16* vbase = VT + (size_t)bh * 64 * 2048 + F.lane * 8;
#define ATT_LOAD(KF, VF, kb_) do { _Pragma("unroll") for (int s_ = 0; s_ < 4; ++s_) KF[s_] = *(const GAS bf16x8*)(kbase + (size_t)(kb_) * 2048 + 512 * s_); \
        _Pragma("unroll") for (int db_ = 0; db_ < 2; ++db_) _Pragma("unroll") for (int ks_ = 0; ks_ < 2; ++ks_) VF[db_][ks_] = *(const GAS bf16x8*)(vbase + (size_t)(kb_) * 2048 + 1024 * db_ + 512 * ks_); } while (0)
#define ATT_BLOCK(KF, VF, kb_) do { const bool diag = ((kb_) == qb); \
        f32x16 z; _Pragma("unroll") for (int i = 0; i < 16; ++i) z[i] = 0.f; \
        _Pragma("unroll") for (int s_ = 0; s_ < 4; ++s_) z = MFMA32(KF[s_], qf[s_], z); \
        float sp[16]; \
        _Pragma("unroll") for (int i = 0; i < 16; ++i) { const float zz = z[i]; float v = fmaxf(zz, 0.f) + __builtin_amdgcn_logf(1.f + __builtin_amdgcn_exp2f(-fabsf(zz))); if (diag && !(crow16(i, hh) < r)) v = 0.f; sp[i] = v; } \
        const bf16x8 sb0 = pack8(sp[0], sp[1], sp[2], sp[3], sp[4], sp[5], sp[6], sp[7]), sb1 = pack8(sp[8], sp[9], sp[10], sp[11], sp[12], sp[13], sp[14], sp[15]); \
        f32x16 Cc; _Pragma("unroll") for (int i = 0; i < 16; ++i) Cc[i] = carry; \
        Cc = MFMA32(Lt[0], sb0, Cc); Cc = MFMA32(Lt[1], sb1, Cc); \
        float w[16]; \
        _Pragma("unroll") for (int i = 0; i < 16; ++i) { float v = __builtin_amdgcn_exp2f(z[i] - Cc[i]); if (diag && !(crow16(i, hh) < r)) v = 0.f; w[i] = v; } \
        const bf16x8 wb0 = pack8(w[0], w[1], w[2], w[3], w[4], w[5], w[6], w[7]), wb1 = pack8(w[8], w[9], w[10], w[11], w[12], w[13], w[14], w[15]); \
        O0 = MFMA32(VF[0][0], wb0, O0); O0 = MFMA32(VF[0][1], wb1, O0); O1 = MFMA32(VF[1][0], wb0, O1); O1 = MFMA32(VF[1][1], wb1, O1); \
        carry = __shfl(Cc[0], r); } while (0)
    bf16x8 kfA[4], vfA[2][2], kfB[4], vfB[2][2];
    ATT_LOAD(kfA, vfA, qb);
    for (int kb = qb; kb >= 0; kb -= 2) {
        ATT_LOAD(kfB, vfB, kb > 0 ? kb - 1 : 0); __builtin_amdgcn_sched_barrier(0);
        ATT_BLOCK(kfA, vfA, kb);
        if (kb == 0 || __all(carry > thr)) break;
        ATT_LOAD(kfA, vfA, kb > 1 ? kb - 2 : 0); __builtin_amdgcn_sched_barrier(0);
        ATT_BLOCK(kfB, vfB, kb - 1);
        if (__all(carry > thr)) break;
    }
#undef ATT_LOAD
#undef ATT_BLOCK
    float ss = 0.f;
#pragma unroll
    for (int i = 0; i < 16; ++i) ss += O0[i] * O0[i] + O1[i] * O1[i];
    ss += __shfl_xor(ss, 32);
    const float rs = 1.f / sqrtf(ss * (1.f / 64.f) + EPS);
    bf16* orow = (bf16*)(F.ws + WS_MIX) + ((size_t)b * SEQ + q0 + r) * D + h * 64;
#pragma unroll
    for (int db = 0; db < 2; ++db)
#pragma unroll
        for (int gq = 0; gq < 4; ++gq) { const int d = 32 * db + 8 * gq + 4 * hh; const f32x4 gg = gout[db][gq];
            const float a0 = (db ? O1[4 * gq + 0] : O0[4 * gq + 0]) * rs * gg.x, a1 = (db ? O1[4 * gq + 1] : O0[4 * gq + 1]) * rs * gg.y, a2 = (db ? O1[4 * gq + 2] : O0[4 * gq + 2]) * rs * gg.z, a3 = (db ? O1[4 * gq + 3] : O0[4 * gq + 3]) * rs * gg.w;
            *(GAS unsigned long long*)(orow + d) = (unsigned long long)pkbf(a0, a1) | ((unsigned long long)pkbf(a2, a3) << 32); }
}
__device__ __forceinline__ void attn_phase(Frame& F) {
    const int r = F.lane & 31, hh = F.lane >> 5;
    float mq = fabsf(F.sb_q_g[F.lane]), mk = fabsf(F.sb_k_g[F.lane]);
#pragma unroll
    for (int o = 1; o < 64; o <<= 1) { mq = fmaxf(mq, __shfl_xor(mq, o)); mk = fmaxf(mk, __shfl_xor(mk, o)); }
    const float thr = 64.f * QSCALE * mq * mk * 1.02f + 170.f;
    bf16x8 Lt[2];
#pragma unroll
    for (int ks = 0; ks < 2; ++ks) { float e[8];
#pragma unroll
        for (int jj = 0; jj < 8; ++jj) e[jj] = (16 * ks + 8 * (jj >> 2) + 4 * hh + (jj & 3) >= r) ? 1.f : 0.f;
        Lt[ks] = pack8(e[0], e[1], e[2], e[3], e[4], e[5], e[6], e[7]); }
    for (int it = F.gw; it < 2048; it += F.ngw) { const int bh = it & 127, j = it >> 7;
        attn_item(F, bh, 63 - j, thr, Lt); attn_item(F, bh, j, thr, Lt); attn_item(F, bh, 47 - j, thr, Lt); attn_item(F, bh, 16 + j, thr, Lt); }
}

constexpr int HG_PART = 0, HG_SSQ = 2048, HG_QE = 4096, HG_KE = HG_QE + 64 * 272, HG_VT = HG_KE + 64 * 272, HG_KST = HG_VT + 128 * 144, HG_ST = HG_KST + 128 * 144, HG_END = HG_ST + 128 * 272;
static_assert(HG_END <= RING_BYTES, "HGRN2 LDS map");
__device__ __forceinline__ float hg_lbound(Frame& F, int h, int d) { const int c = h * 128 + d; return 1.f / (1.f + __expf(F.hg_lb[512 + c] - F.hg_lb[c])); }
__device__ __forceinline__ void hg_gates(Frame& F, const unsigned short (&ffr)[16], float lb, int d, int tq, float (&bb)[16], float (&kk)[16], float& total) {
    float run = 0.f;
#pragma unroll
    for (int i = 0; i < 16; ++i) { const float ff = bf2f(ffr[i]); const float sg = __builtin_amdgcn_rcpf(1.f + __expf(-ff));
        const float f = lb + (1.f - lb) * sg; kk[i] = (1.f - lb) * (1.f - sg); run += __logf(f); bb[i] = run; }
    LAS float* part = (LAS float*)(F.lds + RING_OFF + HG_PART);
    part[tq * 128 + d] = run;
    __syncthreads();
    const float p0 = part[d], p1 = part[128 + d], p2 = part[256 + d], p3 = part[384 + d];
    const float off = (tq > 0 ? p0 : 0.f) + (tq > 1 ? p1 : 0.f) + (tq > 2 ? p2 : 0.f);
    total = (p0 + p1) + (p2 + p3);
#pragma unroll
    for (int i = 0; i < 16; ++i) bb[i] += off;
}
#define HG_HV() const bf16* const PHp = (const bf16*)(F.ws + WS_PH); \
    const __amdgpu_buffer_rsrc_t rsrcP = __builtin_amdgcn_make_buffer_rsrc((void*)PHp, 0, (int)((size_t)4 * T * 512 * 2), 0x00020000)
#define HG_SOFF(item_, arr_) ((unsigned)((((arr_) * 16 + (((item_) >> 5) >> 2)) * 4 + (((item_) >> 5) & 3)) * SEQ + ((item_) & 31) * 64) * 256u)
#define HG_ARR(col_) ((col_) == OFF_HQ ? 0 : (col_) == OFF_HF ? 1 : (col_) == OFF_HI ? 2 : 3)
#define HG_LOADT(dst2, item_, arr_) do { const unsigned so_ = (unsigned)__builtin_amdgcn_readfirstlane((int)HG_SOFF(item_, arr_)); _Pragma("unroll") for (int j_ = 0; j_ < 2; ++j_) \
        (dst2)[j_] = __builtin_bit_cast(v4u, __builtin_amdgcn_raw_buffer_load_b128(rsrcP, (unsigned)F.tid * 16u + 8192u * j_, so_, 0)); } while (0)
#define HG_PUT(src2, raw_) do { _Pragma("unroll") for (int j_ = 0; j_ < 2; ++j_) *(LAS v4u*)((raw_) + ((F.tid >> 4) + 32 * j_) * 272 + (F.tid & 15) * 16) = (src2)[j_]; } while (0)
#define HG_COL(dst, raw_) do { _Pragma("unroll") for (int i_ = 0; i_ < 16; ++i_) dst[i_] = *(const LAS unsigned short*)((raw_) + (16 * tq + i_) * 272 + 2 * d); } while (0)
template <bool PERMUTE> __device__ __forceinline__ void st16(LAS unsigned char* dst, const float (&v)[16]) {
    v4u a, b2;
    if (!PERMUTE) { a.x = pkbf(v[0], v[1]); a.y = pkbf(v[2], v[3]); a.z = pkbf(v[4], v[5]); a.w = pkbf(v[6], v[7]); b2.x = pkbf(v[8], v[9]); b2.y = pkbf(v[10], v[11]); b2.z = pkbf(v[12], v[13]); b2.w = pkbf(v[14], v[15]); }
    else { a.x = pkbf(v[0], v[1]); a.y = pkbf(v[2], v[3]); a.z = pkbf(v[8], v[9]); a.w = pkbf(v[10], v[11]); b2.x = pkbf(v[4], v[5]); b2.y = pkbf(v[6], v[7]); b2.z = pkbf(v[12], v[13]); b2.w = pkbf(v[14], v[15]); }
    *(LAS v4u*)dst = a; *(LAS v4u*)(dst + 16) = b2;
}
__device__ __forceinline__ void hgA_phase(Frame& F) {
    const int d = F.tid & 127, tq = F.tid >> 7, r = F.lane & 31, hh = F.lane >> 5;
    const bf16* P = (const bf16*)(F.ws + WS_P); bf16* KVS = (bf16*)(F.ws + WS_KVS); float* DEC = (float*)(F.ws + WS_DEC); float* SSEG = (float*)(F.ws + WS_SSEG); float* DSEG = (float*)(F.ws + WS_DSEG);
    LAS unsigned char* L = F.lds + RING_OFF; LAS float* decl = (LAS float*)(L + HG_SSQ);
    HG_HV();
    v4u rf[2], rv[2];
    LAS unsigned char* const RAWF = F.lds + ROWTAB_OFF; LAS unsigned char* const RAWV = L + HG_ST;
    for (int wg = blockIdx.x; wg < 256; wg += F.G) {
        const int bh = wg >> 2, seg = wg & 3, item0 = bh * 32 + seg * 8, h = bh & 3;
        HG_LOADT(rf, item0, 1); HG_LOADT(rv, item0, 2);
        const float lbv = hg_lbound(F, h, d); float totrun = 0.f;
        const int db = F.wave & 3, eb0 = 2 * (F.wave >> 2);
        f32x16 run0, run1;
#pragma unroll
        for (int i = 0; i < 16; ++i) { run0[i] = 0.f; run1[i] = 0.f; }
      for (int k = 0; k < 8; ++k) {
        const int item = item0 + k;
        HG_PUT(rf, RAWF); HG_PUT(rv, RAWV);
        __syncthreads();
        { const int nit = k < 7 ? item + 1 : item; HG_LOADT(rf, nit, 1); HG_LOADT(rv, nit, 2); __builtin_amdgcn_sched_barrier(0); }
        unsigned short ffr[16], vr[16]; HG_COL(ffr, RAWF); HG_COL(vr, RAWV);
        float bb[16], kk[16], total; hg_gates(F, ffr, lbv, d, tq, bb, kk, total);
        float ks[16], vv[16];
#pragma unroll
        for (int i = 0; i < 16; ++i) { ks[i] = kk[i] * __expf(total - bb[i]); vv[i] = bf2f(vr[i]); }
        st16<false>(L + HG_KST + d * 144 + tq * 32, ks); st16<false>(L + HG_VT + d * 144 + tq * 32, vv);
        const float dc = __expf(total); totrun += total;
        if (tq == 0) { DEC[(size_t)item * 128 + d] = dc; decl[d] = dc; }
        __syncthreads();
        f32x16 acc0, acc1;
#pragma unroll
        for (int i = 0; i < 16; ++i) { acc0[i] = 0.f; acc1[i] = 0.f; }
#pragma unroll
        for (int s = 0; s < 4; ++s) { const bf16x8 af = *(const LAS bf16x8*)(L + HG_KST + (db * 32 + r) * 144 + 32 * s + 16 * hh);
            const bf16x8 b0 = *(const LAS bf16x8*)(L + HG_VT + (eb0 * 32 + r) * 144 + 32 * s + 16 * hh), b1 = *(const LAS bf16x8*)(L + HG_VT + ((eb0 + 1) * 32 + r) * 144 + 32 * s + 16 * hh);
            acc0 = MFMA32(af, b0, acc0); acc1 = MFMA32(af, b1, acc1); }
#pragma unroll
        for (int g = 0; g < 4; ++g) { const f32x4 dl = *(const LAS f32x4*)(decl + db * 32 + 8 * g + 4 * hh);
#pragma unroll
            for (int ii = 0; ii < 4; ++ii) { run0[4 * g + ii] = dl[ii] * run0[4 * g + ii] + acc0[4 * g + ii]; run1[4 * g + ii] = dl[ii] * run1[4 * g + ii] + acc1[4 * g + ii]; } }
#pragma unroll
        for (int j = 0; j < 2; ++j) { bf16* dst = KVS + ((size_t)item * 128 + (eb0 + j) * 32 + r) * 128 + db * 32 + 4 * hh;
#pragma unroll
            for (int g = 0; g < 4; ++g) { const float a0 = j ? acc1[4 * g + 0] : acc0[4 * g + 0], a1 = j ? acc1[4 * g + 1] : acc0[4 * g + 1], a2 = j ? acc1[4 * g + 2] : acc0[4 * g + 2], a3 = j ? acc1[4 * g + 3] : acc0[4 * g + 3];
                *(GAS unsigned long long*)(dst + 8 * g) = (unsigned long long)pkbf(a0, a1) | ((unsigned long long)pkbf(a2, a3) << 32); } }
        __syncthreads();
      }
#pragma unroll
        for (int j = 0; j < 2; ++j) { float* dst = SSEG + ((size_t)wg * 128 + (eb0 + j) * 32 + r) * 128 + db * 32 + 4 * hh;
#pragma unroll
            for (int g = 0; g < 4; ++g) *(GAS f32x4*)(dst + 8 * g) = j ? (f32x4){run1[4 * g + 0], run1[4 * g + 1], run1[4 * g + 2], run1[4 * g + 3]} : (f32x4){run0[4 * g + 0], run0[4 * g + 1], run0[4 * g + 2], run0[4 * g + 3]}; }
        if (tq == 0) DSEG[(size_t)wg * 128 + d] = __expf(totrun);
    }
}
constexpr int HG_DECS = HG_END;
static_assert(HG_DECS + 4096 + 64 * 272 <= LDSCTL_OFF && HG_KST + 64 * 272 <= HG_ST && 64 * 272 <= MAXSLOT * 1536, "HGRN2 LDS map (decays, raw tiles)");
__device__ __forceinline__ void hgC_phase(Frame& F) {
    const int d = F.tid & 127, tq = F.tid >> 7, r = F.lane & 31, hh = F.lane >> 5;
    const bf16* P = (const bf16*)(F.ws + WS_P); const bf16* KVS = (const bf16*)(F.ws + WS_KVS); bf16* MIX = (bf16*)(F.ws + WS_MIX); const float* DEC = (const float*)(F.ws + WS_DEC);
    HG_HV();
    LAS unsigned char* L = F.lds + RING_OFF; const LAS float* decs = (const LAS float*)(L + HG_DECS);
    const int se = F.tid >> 2, sq = F.tid & 3;
    v4u rf[2], rq[2], rv[2], st[4];
    LAS unsigned char* const RAWF = L + HG_KST; LAS unsigned char* const RAWQ = F.lds + ROWTAB_OFF; LAS unsigned char* const RAWV = L + HG_DECS + 4096;
    const __amdgpu_buffer_rsrc_t rsrcG = __builtin_amdgcn_make_buffer_rsrc((void*)F.hg_out_g, 0, 512 * 4, 0x00020000), rsrcSS = __builtin_amdgcn_make_buffer_rsrc((void*)(F.ws + WS_SSEG), 0, 256 * 128 * 128 * 4, 0x00020000), rsrcDS = __builtin_amdgcn_make_buffer_rsrc((void*)(F.ws + WS_DSEG), 0, 256 * 128 * 4, 0x00020000);
    const __amdgpu_buffer_rsrc_t rsrcD = __builtin_amdgcn_make_buffer_rsrc((void*)DEC, 0, 64 * 32 * 128 * 4, 0x00020000), rsrcM = __builtin_amdgcn_make_buffer_rsrc((void*)MIX, 0, (int)((size_t)T * D * 2), 0x00020000);
    const __amdgpu_buffer_rsrc_t rsrcK = __builtin_amdgcn_make_buffer_rsrc((void*)KVS, 0, 64 * 32 * 128 * 128 * 2, 0x00020000); const unsigned kvo = (unsigned)((se * 128 + sq * 32) * 2);
#define HG_LOADKV(dst_, item_) do { const unsigned so_ = (unsigned)__builtin_amdgcn_readfirstlane((int)((item_) * (128 * 128 * 2))); _Pragma("unroll") for (int j_ = 0; j_ < 4; ++j_) (dst_)[j_] = __builtin_bit_cast(v4u, __builtin_amdgcn_raw_buffer_load_b128(rsrcK, kvo + 16u * j_, so_, 0)); } while (0)
#define HG_LOADST(item_) HG_LOADKV(st, item_)
#define HG_FOLD(kv_, c_) do { _Pragma("unroll") for (int j_ = 0; j_ < 4; ++j_) { const f32x4 d0_ = *(const LAS f32x4*)(decs + (c_) * 128 + sq * 32 + 8 * j_), d1_ = *(const LAS f32x4*)(decs + (c_) * 128 + sq * 32 + 8 * j_ + 4); const v4u k_ = (kv_)[j_]; \
        S[8 * j_ + 0] = d0_.x * S[8 * j_ + 0] + bflo(k_.x); S[8 * j_ + 1] = d0_.y * S[8 * j_ + 1] + bfhi(k_.x); S[8 * j_ + 2] = d0_.z * S[8 * j_ + 2] + bflo(k_.y); S[8 * j_ + 3] = d0_.w * S[8 * j_ + 3] + bfhi(k_.y); \
        S[8 * j_ + 4] = d1_.x * S[8 * j_ + 4] + bflo(k_.z); S[8 * j_ + 5] = d1_.y * S[8 * j_ + 5] + bfhi(k_.z); S[8 * j_ + 6] = d1_.z * S[8 * j_ + 6] + bflo(k_.w); S[8 * j_ + 7] = d1_.w * S[8 * j_ + 7] + bfhi(k_.w); } } while (0)
    for (int wg = blockIdx.x; wg < 256; wg += F.G) {
        const int bh = wg >> 2, seg = wg & 3, item0 = bh * 32 + seg * 8, b = bh >> 2, h = bh & 3;
        if (F.tid < 256) { const unsigned so = (unsigned)__builtin_amdgcn_readfirstlane((bh * 32 + seg * 8) * 128 * 4);
            *((LAS f32x4*)(L + HG_DECS) + F.tid) = __builtin_bit_cast(f32x4, __builtin_amdgcn_raw_buffer_load_b128(rsrcD, (unsigned)F.tid * 16u, so, 0)); }
        __syncthreads();
        const float lbv = hg_lbound(F, h, d);
        float S[32];
#pragma unroll
        for (int j = 0; j < 32; ++j) S[j] = 0.f;
        for (int sp = 0; sp < seg; ++sp) {
            const unsigned sso = (unsigned)__builtin_amdgcn_readfirstlane((bh * 4 + sp) * 128 * 128 * 4), dso = (unsigned)__builtin_amdgcn_readfirstlane((bh * 4 + sp) * 128 * 4);
#pragma unroll
            for (int j0 = 0; j0 < 8; j0 += 4) { f32x4 sv[4], dv[4];
#pragma unroll
                for (int j = 0; j < 4; ++j) { sv[j] = __builtin_bit_cast(f32x4, __builtin_amdgcn_raw_buffer_load_b128(rsrcSS, (unsigned)((se * 128 + sq * 32) * 4) + 16u * (j0 + j), sso, 0));
                    dv[j] = __builtin_bit_cast(f32x4, __builtin_amdgcn_raw_buffer_load_b128(rsrcDS, (unsigned)(sq * 32 * 4) + 16u * (j0 + j), dso, 0)); }
#pragma unroll
                for (int j = 0; j < 4; ++j) { const int q = 4 * (j0 + j); S[q + 0] = dv[j].x * S[q + 0] + sv[j].x; S[q + 1] = dv[j].y * S[q + 1] + sv[j].y; S[q + 2] = dv[j].z * S[q + 2] + sv[j].z; S[q + 3] = dv[j].w * S[q + 3] + sv[j].w; } }
        }
        HG_LOADT(rf, item0, 1); HG_LOADT(rq, item0, 0); HG_LOADT(rv, item0, 2); HG_LOADST(item0);
      for (int k = 0; k < 8; ++k) {
        const int item = item0 + k, c = seg * 8 + k;
        const int tb = F.wave & 1, eb = F.wave >> 1;
        const int nit = k < 7 ? item + 1 : item;
        HG_PUT(rf, RAWF); HG_PUT(rq, RAWQ); HG_PUT(rv, RAWV);
        __syncthreads();
        HG_LOADT(rf, nit, 1); HG_LOADT(rq, nit, 0); HG_LOADT(rv, nit, 2); __builtin_amdgcn_sched_barrier(0);
        unsigned short ffr[16], qr[16], vr[16]; HG_COL(ffr, RAWF); HG_COL(qr, RAWQ); HG_COL(vr, RAWV);
        float bb[16], kk[16], total; hg_gates(F, ffr, lbv, d, tq, bb, kk, total);
        float vv[16];
#pragma unroll
        for (int i = 0; i < 16; ++i) { const int t = 16 * tq + i; const float q = bf2f(qr[i]);
            *(LAS unsigned short*)(L + HG_QE + t * 272 + 2 * d) = (unsigned short)pkbf(q * __expf(bb[i]), 0.f);
            *(LAS unsigned short*)(L + HG_KE + t * 272 + 2 * d) = (unsigned short)pkbf(kk[i] * __expf(-bb[i]), 0.f);
            vv[i] = bf2f(vr[i]); }
        st16<true>(L + HG_VT + d * 144 + tq * 32, vv);
#pragma unroll
        for (int j = 0; j < 4; ++j) { v4u w4; w4.x = pkbf(S[8 * j + 0], S[8 * j + 1]); w4.y = pkbf(S[8 * j + 2], S[8 * j + 3]); w4.z = pkbf(S[8 * j + 4], S[8 * j + 5]); w4.w = pkbf(S[8 * j + 6], S[8 * j + 7]);
            *(LAS v4u*)(L + HG_ST + se * 272 + sq * 64 + 16 * j) = w4; }
        HG_FOLD(st, k);
        unsigned long long grv[4];
        { const bf16* grow_ = PHp + (((size_t)(3 * 16 + b) * 4 + h) * SEQ + c * 64 + tb * 32 + r) * 128;
#pragma unroll
            for (int g = 0; g < 4; ++g) grv[g] = *(const GAS unsigned long long*)(grow_ + eb * 32 + 8 * g + 4 * hh); }
        HG_LOADST(nit); __builtin_amdgcn_sched_barrier(0);
        __syncthreads();
        f32x16 acc;
#pragma unroll
        for (int i = 0; i < 16; ++i) acc[i] = 0.f;
#define HG_QF(s_) (*(const LAS bf16x8*)(L + HG_QE + (tb * 32 + r) * 272 + 32 * (s_) + 16 * hh))
#pragma unroll
        for (int s = 0; s < 8; ++s) acc = MFMA32(*(const LAS bf16x8*)(L + HG_ST + (eb * 32 + r) * 272 + 32 * s + 16 * hh), HG_QF(s), acc);
        for (int sb = 0; sb <= tb; ++sb) {
            f32x16 at;
#pragma unroll
            for (int i = 0; i < 16; ++i) at[i] = 0.f;
#pragma unroll
            for (int s = 0; s < 8; ++s) at = MFMA32(*(const LAS bf16x8*)(L + HG_KE + (sb * 32 + r) * 272 + 32 * s + 16 * hh), HG_QF(s), at);
            float a[16];
#pragma unroll
            for (int i = 0; i < 16; ++i) a[i] = (sb < tb || crow16(i, hh) <= r) ? at[i] : 0.f;
            const bf16x8 ab0 = pack8(a[0], a[1], a[2], a[3], a[4], a[5], a[6], a[7]), ab1 = pack8(a[8], a[9], a[10], a[11], a[12], a[13], a[14], a[15]);
            acc = MFMA32(*(const LAS bf16x8*)(L + HG_VT + (eb * 32 + r) * 144 + sb * 64 + 0 + 16 * hh), ab0, acc);
            acc = MFMA32(*(const LAS bf16x8*)(L + HG_VT + (eb * 32 + r) * 144 + sb * 64 + 32 + 16 * hh), ab1, acc);
        }
        float ss = 0.f;
#pragma unroll
        for (int i = 0; i < 16; ++i) ss += acc[i] * acc[i];
        ss += __shfl_xor(ss, 32);
        LAS float* ssq = (LAS float*)(L + HG_SSQ);
        if (hh == 0) ssq[eb * 64 + tb * 32 + r] = ss;
        f32x4 ggv[4];
        { const unsigned so = (unsigned)__builtin_amdgcn_readfirstlane(h * 512);
#pragma unroll
            for (int g = 0; g < 4; ++g) ggv[g] = __builtin_bit_cast(f32x4, __builtin_amdgcn_raw_buffer_load_b128(rsrcG, (unsigned)((eb * 32 + 8 * g + 4 * hh) * 4), so, 0)); }
        __syncthreads();
        const int tl = tb * 32 + r; const float tot = (ssq[tl] + ssq[64 + tl]) + (ssq[128 + tl] + ssq[192 + tl]);
        const float rs = 1.f / sqrtf(tot * (1.f / 128.f) + EPS);
        const unsigned mso = (unsigned)__builtin_amdgcn_readfirstlane((int)((((unsigned)b * SEQ + c * 64) * D + 512 + h * 128) * 2)), mvo = (unsigned)((tl * D + eb * 32 + 4 * hh) * 2);
#pragma unroll
        for (int g = 0; g < 4; ++g) { const int e = eb * 32 + 8 * g + 4 * hh; const unsigned long long gr = grv[g]; const f32x4 gg = ggv[g];
            const float g0 = bflo((unsigned)gr), g1 = bfhi((unsigned)gr), g2 = bflo((unsigned)(gr >> 32)), g3 = bfhi((unsigned)(gr >> 32));
            const float y0 = acc[4 * g + 0] * rs * gg.x * (g0 * __builtin_amdgcn_rcpf(1.f + __expf(-g0))), y1 = acc[4 * g + 1] * rs * gg.y * (g1 * __builtin_amdgcn_rcpf(1.f + __expf(-g1)));
            const float y2 = acc[4 * g + 2] * rs * gg.z * (g2 * __builtin_amdgcn_rcpf(1.f + __expf(-g2))), y3 = acc[4 * g + 3] * rs * gg.w * (g3 * __builtin_amdgcn_rcpf(1.f + __expf(-g3)));
            typedef unsigned u32x2_t __attribute__((ext_vector_type(2))); __builtin_amdgcn_raw_buffer_store_b64((u32x2_t){pkbf(y0, y1), pkbf(y2, y3)}, rsrcM, mvo + 16u * g, mso, 0); }
        __syncthreads();
      }
    }
#undef HG_LOADST
#undef HG_LOADKV
#undef HG_FOLD
#undef HG_QF
}
#undef HG_LOADT
#undef HG_PUT
#undef HG_COL
#undef HG_ARR
#undef HG_SOFF
#undef HG_HV

__device__ __forceinline__ void router_phase(Frame& F) {
    LAS unsigned char* L = F.lds; const int r = F.lane & 31, hh = F.lane >> 5;
    LAS unsigned* lcnt = (LAS unsigned*)(F.lds + LTAB_OFF) + LT_MISC; LAS unsigned* lbase = lcnt + 32; LAS float* lrstd = (LAS float*)(F.lds + ROWTAB_OFF);
    float* TOPG = (float*)(F.ws + WS_TOPG);
    for (int idx = F.tid; idx < 32768; idx += NWAVES * 64) { const int k = idx >> 5, e = idx & 31; const float w = F.w_router[idx] * F.norm2_g[k];
        const unsigned hi = pkbf(w, 0.f) & 0xffffu; const unsigned lo = pkbf(w - bflo(hi), 0.f) & 0xffffu;
        *(LAS unsigned short*)(L + e * RT_ROW + 2 * k) = (unsigned short)hi; *(LAS unsigned short*)(L + RT_WL + e * RT_ROW + 2 * k) = (unsigned short)lo; }
    const bf16* XH = (const bf16*)(F.ws + WS_XN); int* LIST = (int*)(F.ws + WS_LIST); unsigned* cnt = (unsigned*)(F.ctl + CW_CNT);
    for (int base = blockIdx.x * 4; base < T / 32; base += F.G * 4) {
        const int grp = base + F.wave; const bool active = F.wave < 4 && grp < T / 32;
        if (F.tid < 32) lcnt[F.tid] = 0u;
        __syncthreads();
        float sv[4] = {0.f, 0.f, 0.f, 0.f}; int se[4] = {0, 0, 0, 0}; unsigned lp0 = 0u, lp1 = 0u; float rstd = 0.f; const int tok = grp * 32 + r;
        if (active) {
            const bf16* hrow = XH + (size_t)tok * D + 8 * hh;
            f32x16 acc;
#pragma unroll
            for (int i = 0; i < 16; ++i) acc[i] = 0.f;
            float ssq = 0.f;
#pragma unroll 16
            for (int s = 0; s < 64; ++s) {
                const v4u hu = *(const GAS v4u*)(hrow + 16 * s); const bf16x8 hi = __builtin_bit_cast(bf16x8, hu);
                { const float a0 = bflo(hu.x), a1 = bfhi(hu.x), a2 = bflo(hu.y), a3 = bfhi(hu.y), a4 = bflo(hu.z), a5 = bfhi(hu.z), a6 = bflo(hu.w), a7 = bfhi(hu.w);
                    ssq += (a0 * a0 + a1 * a1) + (a2 * a2 + a3 * a3) + (a4 * a4 + a5 * a5) + (a6 * a6 + a7 * a7); }
                const bf16x8 wh = *(const LAS bf16x8*)(L + r * RT_ROW + 32 * s + 16 * hh), wl = *(const LAS bf16x8*)(L + RT_WL + r * RT_ROW + 32 * s + 16 * hh);
                acc = MFMA32(wh, hi, acc); acc = MFMA32(wl, hi, acc);
            }
            ssq += __shfl_xor(ssq, 32);
            rstd = 1.f / sqrtf(ssq * (1.f / D) + EPS);
            float l[16];
#pragma unroll
            for (int i = 0; i < 16; ++i) l[i] = acc[i] * rstd + F.b_router[crow16(i, hh)];
            float cv[8]; int ce[8];
#pragma unroll
            for (int rnd = 0; rnd < 4; ++rnd) { float bv = l[0]; int bi = 0;
#pragma unroll
                for (int i = 1; i < 16; ++i) if (l[i] > bv) { bv = l[i]; bi = i; }
                cv[rnd] = bv; ce[rnd] = crow16(bi, hh);
#pragma unroll
                for (int i = 0; i < 16; ++i) if (i == bi) l[i] = -__builtin_inff(); }
#pragma unroll
            for (int j = 0; j < 4; ++j) { cv[4 + j] = __shfl_xor(cv[j], 32); ce[4 + j] = __shfl_xor(ce[j], 32); }
#pragma unroll
            for (int rnd = 0; rnd < 4; ++rnd) { float bv = cv[0]; int be = ce[0]; int bj = 0;
#pragma unroll
                for (int j = 1; j < 8; ++j) if (cv[j] > bv || (cv[j] == bv && ce[j] < be)) { bv = cv[j]; be = ce[j]; bj = j; }
                sv[rnd] = bv; se[rnd] = be;
#pragma unroll
                for (int j = 0; j < 8; ++j) if (j == bj) { cv[j] = -__builtin_inff(); ce[j] = 64; } }
            lp0 = __hip_atomic_fetch_add(lcnt + (hh ? se[2] : se[0]), 1u, __ATOMIC_RELAXED, __HIP_MEMORY_SCOPE_WORKGROUP);
            lp1 = __hip_atomic_fetch_add(lcnt + (hh ? se[3] : se[1]), 1u, __ATOMIC_RELAXED, __HIP_MEMORY_SCOPE_WORKGROUP);
        }
        __syncthreads();
        if (F.tid < 32) lbase[F.tid] = __hip_atomic_fetch_add(cnt + F.tid, lcnt[F.tid], __ATOMIC_RELAXED, __HIP_MEMORY_SCOPE_AGENT);
        __syncthreads();
        if (active) {
            const float e1 = __expf(sv[1] - sv[0]), e2 = __expf(sv[2] - sv[0]), e3 = __expf(sv[3] - sv[0]); const float inv = 1.f / (1.f + e1 + e2 + e3);
            const int ea = hh ? se[2] : se[0], eb = hh ? se[3] : se[1]; const float ga = (hh ? e2 : 1.f) * inv, gb = (hh ? e3 : e1) * inv;
            const size_t ia = (size_t)ea * 32768 + lbase[ea] + lp0, ib = (size_t)eb * 32768 + lbase[eb] + lp1;
            LIST[ia] = tok * 4 + 2 * hh; LIST[ib] = tok * 4 + 2 * hh + 1; TOPG[tok * 4 + 2 * hh] = ga; TOPG[tok * 4 + 2 * hh + 1] = gb;
            if (hh == 0) lrstd[F.wave * 32 + r] = rstd;
        }
        __syncthreads();
        {
            unsigned char* X8 = F.ws + WS_X8; const int t0 = base * 32;
#pragma unroll
            for (int q0 = 0; q0 < 16; q0 += 4) { v4u a[4][2];
#pragma unroll
                for (int q = 0; q < 4; ++q) { const int tt = t0 + F.wave * 16 + q0 + q; const GAS v4u* p = (const GAS v4u*)(XH + (size_t)(tt < T ? tt : 0) * D) + 2 * F.lane; a[q][0] = p[0]; a[q][1] = p[1]; }
#pragma unroll
                for (int q = 0; q < 4; ++q) { const int tl = F.wave * 16 + q0 + q, tt = t0 + tl; if (tt < T) { const float rs = lrstd[tl]; v4u o;
                    o.x = pg8::pk4_fp8(bflo(a[q][0].x) * rs, bfhi(a[q][0].x) * rs, bflo(a[q][0].y) * rs, bfhi(a[q][0].y) * rs); o.y = pg8::pk4_fp8(bflo(a[q][0].z) * rs, bfhi(a[q][0].z) * rs, bflo(a[q][0].w) * rs, bfhi(a[q][0].w) * rs);
                    o.z = pg8::pk4_fp8(bflo(a[q][1].x) * rs, bfhi(a[q][1].x) * rs, bflo(a[q][1].y) * rs, bfhi(a[q][1].y) * rs); o.w = pg8::pk4_fp8(bflo(a[q][1].z) * rs, bfhi(a[q][1].z) * rs, bflo(a[q][1].w) * rs, bfhi(a[q][1].w) * rs);
                    *((GAS v4u*)(X8 + (size_t)tt * D) + F.lane) = o; } } }
        }
        __syncthreads();
    }
}
__device__ __forceinline__ int build_moe_tables(Frame& F, int ntn, int mode) {
    LAS int* lt = (LAS int*)(F.lds + LTAB_OFF);
    if (F.wave == 0) {
        const int e = F.lane & 31; const int c = (int)__hip_atomic_load((unsigned*)(F.ctl + CW_CNT) + e, __ATOMIC_RELAXED, __HIP_MEMORY_SCOPE_AGENT);
        const int tl = (c + 255) >> 8; int inc = tl;
#pragma unroll
        for (int off = 1; off < 32; off <<= 1) { const int o = __shfl_up(inc, off, 32); if (e >= off) inc += o; }
        const int tot = __shfl(inc, 31, 32), t0 = inc - tl;
        if (F.lane < 32) { lt[LT_TS + e] = t0; lt[LT_CNT + e] = c; for (int i = 0; i < tl; ++i) lt[t0 + i] = e; }
        if (F.lane == 0) lt[LT_MISC + 64] = tot;
    }
    __syncthreads();
    int nt = lt[LT_MISC + 64]; nt = nt < 0 ? 0 : (nt > MAXTILES ? MAXTILES : nt); nt = __builtin_amdgcn_readfirstlane(nt);
    const int* LIST = (const int*)(F.ws + WS_LIST);
    const int nslot = mode == 1 ? MAXSLOT : (MAXTILES * 4 + 255) / 256;
    for (int q = F.tid; q < nslot * 256; q += NWAVES * 64) { const int i = q >> 8, rr = q & 255; const int Lu = i * F.G + F.vcu;
        int li = -1; float bias = 0.f;
        if (Lu < nt * ntn) { const int pm0 = Lu / ntn, pl = Lu - pm0 * ntn, pm = mode == 2 ? nt - 1 - pm0 : pm0, e = lt[pm], idx = (pm - lt[LT_TS + e]) * 256 + rr; if (idx < lt[LT_CNT + e]) li = LIST[(size_t)e * 32768 + idx];
            bias = mode == 1 ? F.b_gu[(size_t)e * 2048 + (rr >> 7) * 1024 + pl * 128 + (rr & 127)] : F.b_d[(size_t)e * 1024 + pl * 256 + rr]; }
        ((LAS float*)(F.lds + ROWTAB_OFF))[q] = bias;
        if (mode == 1) ((LAS unsigned short*)(F.lds + ROWTAB2_OFF))[q] = (unsigned short)(li < 0 ? 0 : (li >> 2));
        else ((LAS int*)(F.lds + ROWTAB_OFF) + nslot * 256)[q] = li; }
    __syncthreads();
    return nt;
}
__device__ __forceinline__ void combine_phase(Frame& F) {
    const unsigned char* YK = F.ws + WS_YK; const bf16* XH = (const bf16*)(F.ws + WS_XN); const float* TOPG = (const float*)(F.ws + WS_TOPG);
    for (int t = F.gw; t < T; t += F.ngw) {
        GAS f32x4* xr = (GAS f32x4*)(F.out + (size_t)t * D) + F.lane; f32x4 v[4]; unsigned y[4][4]; const f32x4 gt = *((const GAS f32x4*)TOPG + t + vzero()) * (1.0f / Y8_SCALE);
#pragma unroll
        for (int j = 0; j < 4; ++j) { const unsigned long long xh = __builtin_nontemporal_load((const GAS unsigned long long*)(XH + (size_t)t * D) + F.lane + 64 * j);
            v[j] = (f32x4){bflo((unsigned)xh), bfhi((unsigned)xh), bflo((unsigned)(xh >> 32)), bfhi((unsigned)(xh >> 32))};
#pragma unroll
            for (int k = 0; k < 4; ++k) y[j][k] = __builtin_nontemporal_load((const GAS unsigned*)(YK + ((size_t)t * 4 + k) * D) + F.lane + 64 * j); }
#pragma unroll
        for (int j = 0; j < 4; ++j) { f32x4 s4 = {0.f, 0.f, 0.f, 0.f};
#pragma unroll
            for (int k = 0; k < 4; ++k) { const f32x2n_ lo = __builtin_amdgcn_cvt_pk_f32_fp8((int)y[j][k], false), hi = __builtin_amdgcn_cvt_pk_f32_fp8((int)y[j][k], true); const float g = gt[k]; s4.x += g * lo.x; s4.y += g * lo.y; s4.z += g * hi.x; s4.w += g * hi.y; }
            v[j] = v[j] + s4;
            __builtin_nontemporal_store(v[j], xr + 64 * j); }
    }
}

constexpr int NPH = 9;
struct Args { const float* in[16]; float* out; unsigned char* ws; int ph_lo, ph_hi; };
__global__ void __launch_bounds__(NWAVES * 64, 2) fwd(Args args) {
    extern __shared__ __attribute__((aligned(16))) unsigned char lds[];
    Frame F;
    F.lds = (LAS unsigned char*)lds;
    F.MISC = (volatile LAS unsigned*)(F.lds + MISC_OFF);
    F.tid = threadIdx.x; F.lane = F.tid & 63; F.wave = __builtin_amdgcn_readfirstlane(F.tid >> 6);
    F.G = gridDim.x; { const int bx = blockIdx.x; F.vcu = (F.G % 8 == 0) ? (bx % 8) * (F.G / 8) + bx / 8 : bx; }
    F.gw = blockIdx.x * NWAVES + F.wave; F.ngw = F.G * NWAVES;
    F.ws = args.ws; F.ctl = (gu32*)(args.ws + WS_CTL); F.out = args.out;
    F.x = args.in[0]; F.norm1_g = args.in[1]; F.w_in = args.in[2]; F.sb_q_g = args.in[3]; F.sb_k_g = args.in[4]; F.sb_out_g = args.in[5]; F.hg_lb = args.in[6]; F.hg_out_g = args.in[7];
    F.w_out = args.in[8]; F.norm2_g = args.in[9]; F.w_router = args.in[10]; F.b_router = args.in[11]; F.w_gu = args.in[12]; F.b_gu = args.in[13]; F.w_d = args.in[14]; F.b_d = args.in[15];
    for (int u = F.tid; u < (LDS_BYTES - LDSCTL_OFF) / 4; u += NWAVES * 64) ((LAS unsigned*)(F.lds + LDSCTL_OFF))[u] = 0u;
    __syncthreads();
    XcdBarrier bar; bar.bar = (unsigned*)(F.ctl + CW_BAR); bar.x = 0; bar.st = nullptr;
    if (MK_ONE_LAUNCH) bar = xcd_barrier_post((unsigned*)(F.ctl + CW_BAR), F.MISC + 8);
    const int lo = args.ph_lo, hi = args.ph_hi;
#define IN(k) (lo <= (k) && (k) < hi && ((F.lane = lane_id()), (F.tid = F.wave * 64 + F.lane), true))
#define SEAM(k) do { if (IN(k) && IN((k) + 1)) xcd_barrier(bar); } while (0)

    if (IN(0)) { p0_prologue(F); } SEAM(0);
    if (IN(1)) {
        pg8::Gemm g{(const bf16*)(F.ws + WS_XN), (const bf16*)(F.ws + WS_WIN), T, NIN, D}; pg8::StaticOrder S; S.init(T, NIN, F.G, (int)blockIdx.x);
        pg8::EpiInproj E{(bf16*)(F.ws + WS_P), (bf16*)(F.ws + WS_PH)};
        pg8::gemm_phase<pg8::EpiInproj, pg8::StaticOrder, PG8_ALIGN, PG8_SP2>(F.lds + RING_OFF, g, S, E, F.tid);
    } SEAM(1);
    if (IN(2)) { prep_phase(F); __syncthreads(); hgA_phase(F); } SEAM(2);
    if (IN(3)) { attn_phase(F); hgC_phase(F); } SEAM(3);
    if (IN(4)) {
        pg8::Gemm g{(const bf16*)(F.ws + WS_MIX), (const bf16*)(F.ws + WS_WOUT), T, D, D}; pg8::StaticOrder S; S.init(T, D, F.G, (int)blockIdx.x);
        pg8::EpiRes E{F.x, (bf16*)(F.ws + WS_XN), D};
        pg8::gemm_phase<pg8::EpiRes, pg8::StaticOrder, PG8_ALIGN, PG8_SP2>(F.lds + RING_OFF, g, S, E, F.tid);
    } SEAM(4);
    if (IN(5)) { router_phase(F); } SEAM(5);
    if (IN(6)) {
        const int nt = build_moe_tables(F, 8, 1); const LAS int* lt = (const LAS int*)(F.lds + LTAB_OFF);
        pg8::Gemm g{(const bf16*)(F.ws + WS_X8), (const bf16*)(F.ws + WS_WGU), MAXROWS, NE * 2048, D / 2};
        pg8::MoeOrder S{lt, (const LAS unsigned short*)(F.lds + ROWTAB2_OFF), 8, nt * 8, F.G, F.vcu, 1024u, 0};
        pg8::EpiAct<true> E{F.ws + WS_ACT, (const LAS float*)(F.lds + ROWTAB_OFF), A8_SCALE};
        pg8::gemm_phase<pg8::EpiAct<true>, pg8::MoeOrder, PG8_ALIGN, PG8_SP2, true, SC_W8, SC_ONE>(F.lds + RING_OFF, g, S, E, F.tid);
    } SEAM(6);
    if (IN(7)) {
        const int nt = build_moe_tables(F, 4, 2); const LAS int* lt = (const LAS int*)(F.lds + LTAB_OFF);
        pg8::Gemm g{(const bf16*)(F.ws + WS_ACT), (const bf16*)(F.ws + WS_WD), MAXROWS, NE * 1024, D / 2};
        pg8::MoeOrder S{lt, nullptr, 4, nt * 4, F.G, F.vcu, 1024u, nt};
        pg8::EpiDown E{F.ws + WS_YK, (const LAS int*)(F.lds + ROWTAB_OFF) + ((MAXTILES * 4 + 255) / 256) * 256, (const LAS float*)(F.lds + ROWTAB_OFF), Y8_SCALE};
        pg8::gemm_phase<pg8::EpiDown, pg8::MoeOrder, PG8_ALIGN, PG8_SP2, true, SC_W8Y, SC_A8>(F.lds + RING_OFF, g, S, E, F.tid);
    } SEAM(7);
    if (IN(8)) { combine_phase(F); }
#undef IN
#undef SEAM
}

extern "C" void kernel_launch(void* const* d_in, const int* in_sizes, int n_in, void* d_out, int out_size, void* d_ws, size_t ws_size, hipStream_t stream) {
    static int grid = 0;
    if (grid == 0) {
        if (n_in != 16 || in_sizes[0] != T * D || out_size != T * D || ws_size < WS_END) { fprintf(stderr, "kernel_launch: shape/workspace mismatch (n_in %d, ws %zu, need %zu); nothing launched\n", n_in, ws_size, (size_t)WS_END); grid = -1; return; }
        int dev = 0, cus = 0, per_cu = 0;
        if (hipGetDevice(&dev) != hipSuccess || hipDeviceGetAttribute(&cus, hipDeviceAttributeMultiprocessorCount, dev) != hipSuccess) { grid = -1; return; }
        if (hipFuncSetAttribute((const void*)fwd, hipFuncAttributeMaxDynamicSharedMemorySize, LDS_BYTES) != hipSuccess) { grid = -1; return; }
        if (hipOccupancyMaxActiveBlocksPerMultiprocessor(&per_cu, (const void*)fwd, NWAVES * 64, LDS_BYTES) != hipSuccess || per_cu < 1) { fprintf(stderr, "kernel_launch: occupancy query says %d\n", per_cu); }
        (void)hipGetLastError();
        if ((MAXTILES * 8 + cus - 1) / cus > MAXSLOT || cus < 1) { fprintf(stderr, "kernel_launch: %d CUs: the per-workgroup unit tables are sized for 256\n", cus); grid = -1; return; }
        grid = cus;
    }
    if (grid < 0) return;
    if (hipMemsetAsync((char*)d_ws + WS_CTL, 0, CTL_ZERO_BYTES, stream) != hipSuccess) return;
    Args a{};
    for (int i = 0; i < 16; ++i) a.in[i] = (const float*)d_in[i];
    a.out = (float*)d_out; a.ws = (unsigned char*)d_ws;
#if MK_ONE_LAUNCH
    a.ph_lo = 0; a.ph_hi = NPH;
    hipLaunchKernelGGL(fwd, dim3(grid), dim3(NWAVES * 64), LDS_BYTES, stream, a);
#else
    for (int p = 0; p < NPH; ++p) { a.ph_lo = p; a.ph_hi = p + 1; hipLaunchKernelGGL(fwd, dim3(grid), dim3(NWAVES * 64), LDS_BYTES, stream, a); }
#endif
}
```

```cpp
#include <hip/hip_runtime.h>
#include <cstdio>
#include <cstdint>
namespace pg8 {
#define PG8_LAS __attribute__((address_space(3)))
typedef unsigned short bf16_t;
typedef short bf16x8 __attribute__((ext_vector_type(8)));
typedef float f32x4 __attribute__((ext_vector_type(4)));
typedef unsigned u32x4 __attribute__((ext_vector_type(4)));
typedef int i32x4_t __attribute__((ext_vector_type(4)));
typedef int i32x8_t __attribute__((ext_vector_type(8)));
constexpr int BM = 256, BK = 64, HALF = 128, HTB = HALF * BK * 2  , STAGE_BYTES = 8 * HTB, NXCD = 8, WGM = 8;

__host__ __device__ __forceinline__ int lds_byte(int r, int c) { const int st = (r >> 4) * 2 + (c >> 5), rr = r & 15, cc = c & 31, ob = rr * 64 + cc * 2; return st * 1024 + (ob ^ (((ob >> 9) & 1) << 5)); }
__host__ __device__ __forceinline__ void stage_rc(int b, int& R, int& C) { const int st = b / 1024, sb = b % 1024, swz = sb ^ (((sb >> 9) & 1) << 5); R = (st >> 1) * 16 + swz / 64; C = (st & 1) * 32 + (swz % 64) / 2; }
__host__ __device__ __forceinline__ int perm32(int rho) { const int n = rho >> 4, i = rho & 15; return 8 * (i >> 2) + 4 * n + (i & 3); }

struct Unit { int pm, pn, slot; };
struct Gemm { const bf16_t* A; const bf16_t* Bt; int M, N, K; };

struct StaticOrder {
    int nM, nN, nwg, G, c;
    __host__ __device__ void init(int M, int N, int G_, int c_) { nM = M / BM; nN = N / BM; nwg = nM * nN; G = G_; c = c_; }
    __host__ __device__ bool next(int i, Unit& u) const {
        const long L = (long)i * G + c; if (L >= nwg) return false;
        int wgid = (int)L; { const int q = nwg / NXCD, r = nwg % NXCD, xcd = wgid % NXCD, off = wgid / NXCD; wgid = (xcd < r ? xcd * (q + 1) : r * (q + 1) + (xcd - r) * q) + off; }
        const int nig = WGM * nN, gid = wgid / nig, fm = gid * WGM, gsz = (nM - fm) < WGM ? (nM - fm) : WGM;
        u.pm = fm + ((wgid % nig) % gsz); u.pn = (wgid % nig) / gsz; return true;
    }
    __device__ __forceinline__ void a_ready(const Unit&) const {}
    __device__ __forceinline__ void done(const Unit&) const {}
};

__device__ __forceinline__ unsigned cvt_pk_bf16(float lo, float hi) { unsigned r; asm volatile("v_cvt_pk_bf16_f32 %0, %1, %2" : "=v"(r) : "v"(lo), "v"(hi)); return r; }
typedef float f32x2 __attribute__((ext_vector_type(2)));
__device__ __forceinline__ f32x2 gelu_pk(f32x2 v) {
    const f32x2 av = __builtin_elementwise_abs(v), d = av * 0.2316418882f + 1.0f;
    f32x2 t; t.x = __builtin_amdgcn_rcpf(d.x); t.y = __builtin_amdgcn_rcpf(d.y);
    f32x2 q = t * 0.5307027145f + (-0.7265760135f); q = q * t + 0.7107068705f; q = q * t + (-0.142248368f); q = q * t + 0.127414796f; q = q * t;
    const f32x2 s = (v * v) * (-0.72134752044f);
    f32x2 e; e.x = __builtin_amdgcn_exp2f(s.x); e.y = __builtin_amdgcn_exp2f(s.y);
    const f32x2 m = v * (q * e), r = v - m;
    f32x2 o; o.x = v.x < 0.f ? m.x : r.x; o.y = v.y < 0.f ? m.y : r.y; return o;
}

template <int ACT  > struct EpiBf16 {
    static constexpr bool PERM = true, AFTER_DRAIN = false, HAS_INIT = false; static_assert(ACT == 0 || ACT == 1, "EpiBf16: ACT is 0 (none) or 1 (gelu_pk)");
    bf16_t* O; int ldc; const float* bias; int split_cols; size_t split_stride; float scale0;
    __device__ __forceinline__ void operator()(const f32x4 (&acc)[2][2][4][2], const Unit& u, int wr, int wc, int fr, int fq) const {
        const int row0 = u.pm * BM + wr * 64 + fr; int colt = u.pn * BM; bf16_t* base = O;
        float sc = 1.f; if (split_cols) { const int t = colt / split_cols; base += (size_t)t * split_stride; colt -= t * split_cols; if (t == 0) sc = scale0; }
        const int col0 = colt + wc * 32 + 8 * fq, bcol0 = u.pn * BM + wc * 32 + 8 * fq;
        f32x4 bv[2][2];
#pragma unroll
        for (int bj = 0; bj < 2; ++bj)
#pragma unroll
            for (int n = 0; n < 2; ++n) bv[bj][n] = bias ? *(const f32x4*)(bias + bcol0 + bj * HALF + 4 * n) : (f32x4){0.f, 0.f, 0.f, 0.f};
#pragma unroll
        for (int ai = 0; ai < 2; ++ai)
#pragma unroll
            for (int m = 0; m < 4; ++m) { bf16_t* rowp = base + (size_t)(row0 + ai * HALF + m * 16) * ldc + col0;
#pragma unroll
                for (int bj = 0; bj < 2; ++bj) { f32x4 v0 = acc[ai][bj][m][0] + bv[bj][0], v1 = acc[ai][bj][m][1] + bv[bj][1];
                    if (ACT == 1) { f32x2 a = gelu_pk((f32x2){v0[0], v0[1]}), b = gelu_pk((f32x2){v0[2], v0[3]}), c = gelu_pk((f32x2){v1[0], v1[1]}), d = gelu_pk((f32x2){v1[2], v1[3]});
                        v0 = (f32x4){a.x, a.y, b.x, b.y}; v1 = (f32x4){c.x, c.y, d.x, d.y}; }
                    v0 = v0 * sc; v1 = v1 * sc; u32x4 w; w.x = cvt_pk_bf16(v0[0], v0[1]); w.y = cvt_pk_bf16(v0[2], v0[3]); w.z = cvt_pk_bf16(v1[0], v1[1]); w.w = cvt_pk_bf16(v1[2], v1[3]);
                    *(u32x4*)(rowp + bj * HALF) = w; } }
    }
};

__device__ __forceinline__ unsigned pk4_fp8(float a, float b, float c, float d) {
    a = fminf(fmaxf(a, -448.f), 448.f); b = fminf(fmaxf(b, -448.f), 448.f); c = fminf(fmaxf(c, -448.f), 448.f); d = fminf(fmaxf(d, -448.f), 448.f);
    int p = 0; p = __builtin_amdgcn_cvt_pk_fp8_f32(a, b, p, false); p = __builtin_amdgcn_cvt_pk_fp8_f32(c, d, p, true); return (unsigned)p;
}
struct EpiRes {
    static constexpr bool PERM = false, AFTER_DRAIN = false, HAS_INIT = false;
    const float* __restrict__ X; bf16_t* __restrict__ XH; int ldc;
    __device__ __forceinline__ void operator()(const f32x4 (&acc)[2][2][4][2], const Unit& u, int wr, int wc, int fr, int fq) const {
        const int row0 = u.pm * BM + wr * 64 + fr, col0 = u.pn * BM + wc * 32 + 4 * fq;
#pragma unroll
        for (int ai = 0; ai < 2; ++ai)
#pragma unroll
            for (int mp = 0; mp < 2; ++mp) { f32x4 xv[2][2][2];
#pragma unroll
                for (int mm = 0; mm < 2; ++mm) { const size_t off = (size_t)(row0 + ai * HALF + (2 * mp + mm) * 16) * ldc + col0;
#pragma unroll
                    for (int bj = 0; bj < 2; ++bj)
#pragma unroll
                        for (int n = 0; n < 2; ++n) xv[mm][bj][n] = __builtin_nontemporal_load((const f32x4*)(X + off + bj * HALF + n * 16)); }
#pragma unroll
                for (int mm = 0; mm < 2; ++mm) { const size_t off = (size_t)(row0 + ai * HALF + (2 * mp + mm) * 16) * ldc + col0;
#pragma unroll
                    for (int bj = 0; bj < 2; ++bj)
#pragma unroll
                        for (int n = 0; n < 2; ++n) { const size_t o2 = off + bj * HALF + n * 16; const f32x4 v = xv[mm][bj][n] + acc[ai][bj][2 * mp + mm][n];
                            *(unsigned long long*)(XH + o2) = (unsigned long long)cvt_pk_bf16(v[0], v[1]) | ((unsigned long long)cvt_pk_bf16(v[2], v[3]) << 32); } } }
    }
};
struct EpiInproj {
    static constexpr bool PERM = true, AFTER_DRAIN = false, HAS_INIT = false;
    bf16_t* PA; bf16_t* PH; bf16_t* QN; bf16_t* KN; const float* gq; const float* gk; float qscale, eps;
    __device__ __forceinline__ void operator()(const f32x4 (&acc)[2][2][4][2], const Unit& u, int wr, int wc, int fr, int fq) const {
        if (u.pn < 4) {
            const int arr = u.pn >> 1, hd = (u.pn & 1) * 4 + wc; const float* g = arr ? gk : gq; const float gs = arr ? 1.f : qscale; bf16_t* dst = arr ? KN : QN;
            f32x4 gv[2][2];
#pragma unroll
            for (int bj = 0; bj < 2; ++bj)
#pragma unroll
                for (int n = 0; n < 2; ++n) gv[bj][n] = *(const f32x4*)(g + 32 * bj + 8 * fq + 4 * n) * gs;
#pragma unroll
            for (int ai = 0; ai < 2; ++ai)
#pragma unroll
                for (int m = 0; m < 4; ++m) { float ss = 0.f;
#pragma unroll
                    for (int bj = 0; bj < 2; ++bj)
#pragma unroll
                        for (int n = 0; n < 2; ++n) { const f32x4 a = acc[ai][bj][m][n]; ss += (a[0] * a[0] + a[1] * a[1]) + (a[2] * a[2] + a[3] * a[3]); }
                    ss += __shfl_xor(ss, 16); ss += __shfl_xor(ss, 32);
                    const float rs = 1.f / sqrtf(ss * (1.f / 64.f) + eps);
                    const int row = u.pm * BM + ai * HALF + wr * 64 + m * 16 + fr, b = row >> 11, s = row & 2047;
                    bf16_t* rp = dst + ((size_t)((b * 8 + hd) * 64 + (s >> 5))) * 2048 + (s & 31) * 8;
#pragma unroll
                    for (int bj = 0; bj < 2; ++bj) { const int c8 = 4 * bj + fq; const f32x4 v0 = acc[ai][bj][m][0] * rs * gv[bj][0], v1 = acc[ai][bj][m][1] * rs * gv[bj][1];
                        u32x4 w; w.x = cvt_pk_bf16(v0[0], v0[1]); w.y = cvt_pk_bf16(v0[2], v0[3]); w.z = cvt_pk_bf16(v1[0], v1[1]); w.w = cvt_pk_bf16(v1[2], v1[3]);
                        *(u32x4*)(rp + (c8 >> 1) * 512 + (c8 & 1) * 256) = w; } }
            return;
        }
#pragma unroll
        for (int bj = 0; bj < 2; ++bj) { const int col = u.pn * BM + bj * HALF + wc * 32 + 8 * fq;
            bf16_t* base; int rowlen;
            if (col < 1536) { const int arr = col >> 9, hd = (col & 511) >> 6, dd = col & 63; base = PA + ((size_t)(arr * 16) * 8 + hd) * 2048 * 64 + dd; rowlen = 64; }
            else { const int c2 = col - 1536, arr = c2 >> 9, hd = (c2 & 511) >> 7, dd = c2 & 127; base = PH + ((size_t)(arr * 16) * 4 + hd) * 2048 * 128 + dd; rowlen = 128; }
            const size_t bstride = (size_t)(rowlen == 64 ? 8 : 4) * 2048 * rowlen;
#pragma unroll
            for (int ai = 0; ai < 2; ++ai)
#pragma unroll
                for (int m = 0; m < 4; ++m) { const int row = u.pm * BM + ai * HALF + wr * 64 + m * 16 + fr, b = row >> 11, s = row & 2047;
                    const f32x4 v0 = acc[ai][bj][m][0], v1 = acc[ai][bj][m][1];
                    u32x4 w; w.x = cvt_pk_bf16(v0[0], v0[1]); w.y = cvt_pk_bf16(v0[2], v0[3]); w.z = cvt_pk_bf16(v1[0], v1[1]); w.w = cvt_pk_bf16(v1[2], v1[3]);
                    *(u32x4*)(base + (size_t)b * bstride + (size_t)s * rowlen) = w; } }
    }
};
struct MoeOrder {
    const PG8_LAS int* tile_e; const PG8_LAS unsigned short* rowtab; int ntn, nunits, G, c; unsigned rowbytes; int rev;
    __device__ __forceinline__ bool next(int i, Unit& u) const {
        const int L = i * G + c; if (L >= nunits) return false;
        const int pm0 = L / ntn, pl = L - pm0 * ntn, pm = rev ? rev - 1 - pm0 : pm0; u.pm = pm; u.pn = tile_e[pm] * ntn + pl; u.slot = i; return true;
    }
    __device__ __forceinline__ unsigned rowoff(const Unit& u, int r) const { return (rowtab ? (unsigned)rowtab[u.slot * 256 + r] : (unsigned)(u.pm * 256 + r)) * rowbytes; }
    __device__ __forceinline__ void a_ready(const Unit&) const {}
    __device__ __forceinline__ void done(const Unit&) const {}
};
template <bool OUT8> struct EpiAct {
    static constexpr bool PERM = true, AFTER_DRAIN = false, HAS_INIT = true;
    unsigned char* ACT; const PG8_LAS float* biastab; float oscale;
    __device__ __forceinline__ void init(f32x4 (&acc)[2][2][4][2], const Unit& u, int wc, int fq) const {
#pragma unroll
        for (int n = 0; n < 2; ++n) { const f32x4 bg = *(const PG8_LAS f32x4*)(biastab + u.slot * 256 + wc * 32 + 8 * fq + 4 * n), bu = *(const PG8_LAS f32x4*)(biastab + u.slot * 256 + 128 + wc * 32 + 8 * fq + 4 * n);
#pragma unroll
            for (int ai = 0; ai < 2; ++ai)
#pragma unroll
                for (int m = 0; m < 4; ++m) { acc[ai][0][m][n] = bg; acc[ai][1][m][n] = bu; } }
    }
    __device__ __forceinline__ void operator()(const f32x4 (&acc)[2][2][4][2], const Unit& u, int wr, int wc, int fr, int fq) const {
        const int pl = u.pn & 7; const int row0 = u.pm * BM + wr * 64 + fr, acol0 = pl * 128 + wc * 32 + 8 * fq;
#pragma unroll
        for (int ai = 0; ai < 2; ++ai)
#pragma unroll
            for (int m = 0; m < 4; ++m) { unsigned char* rowp = ACT + (size_t)(row0 + ai * HALF + m * 16) * 1024 + acol0; f32x4 a4[2];
#pragma unroll
                for (int n = 0; n < 2; ++n) { const f32x4 g4 = acc[ai][0][m][n], u4 = acc[ai][1][m][n]; f32x4 gl, ul, ex;
#pragma unroll
                    for (int j = 0; j < 4; ++j) { gl[j] = fminf(g4[j], 7.0f); ul[j] = __builtin_amdgcn_fmed3f(u4[j], -7.0f, 7.0f); }
                    const f32x4 t4 = gl * (-1.702f * 1.44269504089f);
#pragma unroll
                    for (int j = 0; j < 4; ++j) ex[j] = __builtin_amdgcn_exp2f(t4[j]);
                    const f32x4 d4 = ex + 1.0f; f32x4 s4;
#pragma unroll
                    for (int j = 0; j < 4; ++j) s4[j] = __builtin_amdgcn_rcpf(d4[j]);
                    a4[n] = (gl * s4) * (ul * oscale + oscale); }
                if constexpr (OUT8) { int p0 = 0, p1 = 0; p0 = __builtin_amdgcn_cvt_pk_fp8_f32(a4[0][0], a4[0][1], p0, false); p0 = __builtin_amdgcn_cvt_pk_fp8_f32(a4[0][2], a4[0][3], p0, true);
                    p1 = __builtin_amdgcn_cvt_pk_fp8_f32(a4[1][0], a4[1][1], p1, false); p1 = __builtin_amdgcn_cvt_pk_fp8_f32(a4[1][2], a4[1][3], p1, true);
                    *(unsigned long long*)rowp = (unsigned long long)(unsigned)p0 | ((unsigned long long)(unsigned)p1 << 32); }
                else { u32x4 w; w.x = cvt_pk_bf16(a4[0][0], a4[0][1]); w.y = cvt_pk_bf16(a4[0][2], a4[0][3]); w.z = cvt_pk_bf16(a4[1][0], a4[1][1]); w.w = cvt_pk_bf16(a4[1][2], a4[1][3]); *(u32x4*)(rowp + (size_t)(row0 + ai * HALF + m * 16) * 1024 + acol0) = w; } }
    }
};
struct EpiDown {
    static constexpr bool PERM = true, AFTER_DRAIN = false, HAS_INIT = true;
    unsigned char* YK; const PG8_LAS int* tktab; const PG8_LAS float* biastab; float oscale;
    __device__ __forceinline__ void init(f32x4 (&acc)[2][2][4][2], const Unit& u, int wc, int fq) const {
#pragma unroll
        for (int bj = 0; bj < 2; ++bj)
#pragma unroll
            for (int n = 0; n < 2; ++n) { const f32x4 bv = *(const PG8_LAS f32x4*)(biastab + u.slot * 256 + bj * HALF + wc * 32 + 8 * fq + 4 * n) * oscale;
#pragma unroll
                for (int ai = 0; ai < 2; ++ai)
#pragma unroll
                    for (int m = 0; m < 4; ++m) acc[ai][bj][m][n] = bv; }
    }
    __device__ __forceinline__ void operator()(const f32x4 (&acc)[2][2][4][2], const Unit& u, int wr, int wc, int fr, int fq) const {
        const int pl = u.pn & 3; const int col0 = pl * BM + wc * 32 + 8 * fq;
#pragma unroll
        for (int ai = 0; ai < 2; ++ai)
#pragma unroll
            for (int m = 0; m < 4; ++m) { const int tk = tktab[u.slot * 256 + ai * HALF + wr * 64 + m * 16 + fr];
                if (tk >= 0) { unsigned char* rowp = YK + (size_t)tk * 1024 + col0;
#pragma unroll
                    for (int bj = 0; bj < 2; ++bj) { f32x4 v0 = acc[ai][bj][m][0], v1 = acc[ai][bj][m][1];
#pragma unroll
                        for (int j = 0; j < 4; ++j) { v0[j] = __builtin_amdgcn_fmed3f(v0[j], -448.f, 448.f); v1[j] = __builtin_amdgcn_fmed3f(v1[j], -448.f, 448.f); }
                        int p0 = 0, p1 = 0; p0 = __builtin_amdgcn_cvt_pk_fp8_f32(v0[0], v0[1], p0, false); p0 = __builtin_amdgcn_cvt_pk_fp8_f32(v0[2], v0[3], p0, true);
                        p1 = __builtin_amdgcn_cvt_pk_fp8_f32(v1[0], v1[1], p1, false); p1 = __builtin_amdgcn_cvt_pk_fp8_f32(v1[2], v1[3], p1, true);
                        *(unsigned long long*)(rowp + bj * HALF) = (unsigned long long)(unsigned)p0 | ((unsigned long long)(unsigned)p1 << 32); } } }
    }
};


template <class Epi, class Sched, bool ALIGN_EPI = false, bool SP2 = false, bool GATHER = false, int SCW = 0, int SCX = 0>
__device__ __forceinline__ void gemm_phase(PG8_LAS unsigned char* lds, const Gemm g, const Sched& S, const Epi& E, const int tid) {
    const int wid = __builtin_amdgcn_readfirstlane(tid >> 6), lane = tid & 63, wr = wid >> 2, wc = wid & 3, fr = lane & 15, fq = lane >> 4;
    const int K = g.K, nt = K / BK;
    unsigned voffA[2], voffB[2]; int RA[2]; unsigned CA2[2]; unsigned va0[2] = {0u, 0u}, va1[2] = {0u, 0u};
#pragma unroll
    for (int i = 0; i < 2; ++i) { int R, C; stage_rc(tid * 16 + i * 8192, R, C); const int Rb = Epi::PERM ? ((R & ~31) + perm32(R & 31)) : R;
        voffA[i] = (unsigned)(R * K + C) * 2u; voffB[i] = (unsigned)(Rb * K + C) * 2u; RA[i] = R; CA2[i] = (unsigned)C * 2u; }
    static_assert(!GATHER || SP2, "the gathered-A form exists for the SP2 loop only");
    const char* const gA0 = (const char*)g.A;
#define PG8_VA(u) do { int l_; asm volatile("v_mbcnt_lo_u32_b32 %0, -1, 0\n\tv_mbcnt_hi_u32_b32 %0, -1, %0" : "=v"(l_)); const int t_ = wid * 64 + l_;     \
        _Pragma("unroll") for (int _i = 0; _i < 2; ++_i) { int R_, C_; stage_rc(t_ * 16 + _i * 8192, R_, C_); va0[_i] = S.rowoff((u), R_) + (unsigned)C_ * 2u; va1[_i] = S.rowoff((u), HALF + R_) + (unsigned)C_ * 2u; } } while (0)
#define PG8_STA(bufoff, base_ng, base_g, h) do { if constexpr (GATHER) { if (h) PG8_STAGE(bufoff, base_g, va1); else PG8_STAGE(bufoff, base_g, va0); } else PG8_STAGE(bufoff, base_ng, voffA); } while (0)
    const size_t kstep = (size_t)(BK * 2);
    const size_t hstep = (size_t)HALF * K * 2;
    const size_t tstep = 2 * hstep;
    const unsigned ldsw = (unsigned)wid * 1024u;
    const int aoff = lds_byte(wr * 64 + fr, fq * 8), boff = lds_byte(wc * 32 + fr, fq * 8);
#define PG8_SA(b, h) (((b) * 2 + (h)) * HTB)
#define PG8_SB(b, h) ((4 + (b) * 2 + (h)) * HTB)
#define PG8_STAGE(bufoff, gbase, voff) do { _Pragma("unroll") for (int _i = 0; _i < 2; ++_i) \
        __builtin_amdgcn_global_load_lds((const unsigned*)((const char*)(gbase) + (voff)[_i]), (PG8_LAS unsigned*)(lds + (bufoff) + ldsw + _i * 8192), 16, 0, 0); } while (0)
#define PG8_LDA(dst, b, h) do { if constexpr (SCW != 0) { _Pragma("unroll") for (int m = 0; m < 4; ++m) dst##8[m] = PG8_CAT8(*(const PG8_LAS bf16x8*)(lds + PG8_SA(b, h) + aoff + m * 2048), *(const PG8_LAS bf16x8*)(lds + PG8_SA(b, h) + aoff + m * 2048 + 1024)); } \
        else { _Pragma("unroll") for (int m = 0; m < 4; ++m) _Pragma("unroll") for (int k = 0; k < 2; ++k) dst[m][k] = *(const PG8_LAS bf16x8*)(lds + PG8_SA(b, h) + aoff + m * 2048 + k * 1024); } } while (0)
#define PG8_LDB(dst, b, h) do { if constexpr (SCW != 0) { _Pragma("unroll") for (int n = 0; n < 2; ++n) dst##8[n] = PG8_CAT8(*(const PG8_LAS bf16x8*)(lds + PG8_SB(b, h) + boff + n * 2048), *(const PG8_LAS bf16x8*)(lds + PG8_SB(b, h) + boff + n * 2048 + 1024)); } \
        else { _Pragma("unroll") for (int n = 0; n < 2; ++n) _Pragma("unroll") for (int k = 0; k < 2; ++k) dst[n][k] = *(const PG8_LAS bf16x8*)(lds + PG8_SB(b, h) + boff + n * 2048 + k * 1024); } } while (0)
#define PG8_CAT8(lo, hi) __builtin_shufflevector(__builtin_bit_cast(i32x4_t, (lo)), __builtin_bit_cast(i32x4_t, (hi)), 0, 1, 2, 3, 4, 5, 6, 7)
#define PG8_MMA(ai, bj, At, Bt) do { __builtin_amdgcn_s_setprio(1); _Pragma("unroll") for (int m = 0; m < 4; ++m) _Pragma("unroll") for (int n = 0; n < 2; ++n) { \
        if constexpr (SCW != 0) acc[ai][bj][m][n] = __builtin_amdgcn_mfma_scale_f32_16x16x128_f8f6f4(Bt##8[n], At##8[m], acc[ai][bj][m][n], 0, 0, 0, SCW, 0, SCX); \
        else { _Pragma("unroll") for (int k = 0; k < 2; ++k) acc[ai][bj][m][n] = __builtin_amdgcn_mfma_f32_16x16x32_bf16(Bt[n][k], At[m][k], acc[ai][bj][m][n], 0, 0, 0); } } __builtin_amdgcn_s_setprio(0); } while (0)
#define PG8_WAIT_V(n) asm volatile("s_waitcnt vmcnt(" #n ")" ::: "memory")
#define PG8_WAIT_L(n) asm volatile("s_waitcnt lgkmcnt(" #n ")" ::: "memory")
#define PG8_BAR __builtin_amdgcn_s_barrier()
#define PG8_SCHED __builtin_amdgcn_sched_barrier(0)
    Unit cur, nxt; int ui = 0;
    if (!S.next(0, cur)) return;
    f32x4 acc[2][2][4][2];
    if constexpr (Epi::HAS_INIT) E.init(acc, cur, wc, fq);
    else {
#pragma unroll
    for (int a = 0; a < 2; ++a)
#pragma unroll
        for (int b = 0; b < 2; ++b)
#pragma unroll
            for (int m = 0; m < 4; ++m)
#pragma unroll
                for (int n = 0; n < 2; ++n) acc[a][b][m][n] = (f32x4){0.f, 0.f, 0.f, 0.f};
    }
    bf16x8 At[4][2], B0[2][2], B1[2][2]; i32x8_t At8[4], B08[2], B18[2];
    const char* cA = (const char*)g.A + (size_t)cur.pm * tstep; const char* cB = (const char*)g.Bt + (size_t)cur.pn * tstep;
    S.a_ready(cur);
    if constexpr (SP2) {
        if constexpr (GATHER) PG8_VA(cur);
        PG8_STAGE(PG8_SB(0, 0), cB, voffB); PG8_STAGE(PG8_SB(0, 1), cB + hstep, voffB); PG8_STA(PG8_SA(0, 0), cA, gA0, 0); PG8_STA(PG8_SA(0, 1), cA + hstep, gA0, 1);
        if (wr == 1) PG8_BAR;
        PG8_WAIT_V(2); PG8_BAR;
        PG8_STAGE(PG8_SB(1, 0), cB + kstep, voffB); PG8_STA(PG8_SA(1, 0), cA + kstep, gA0 + kstep, 0); PG8_STAGE(PG8_SB(1, 1), cB + hstep + kstep, voffB);
        PG8_WAIT_V(6); PG8_BAR;
    } else {
        PG8_STAGE(PG8_SB(0, 0), cB, voffB); PG8_STAGE(PG8_SA(0, 0), cA, voffA); PG8_STAGE(PG8_SB(0, 1), cB + hstep, voffB); PG8_STAGE(PG8_SA(0, 1), cA + hstep, voffA);
        if (wr == 1) PG8_BAR;
        PG8_WAIT_V(4); PG8_BAR;
        PG8_STAGE(PG8_SB(1, 0), cB + kstep, voffB); PG8_STAGE(PG8_SA(1, 0), cA + kstep, voffA); PG8_STAGE(PG8_SB(1, 1), cB + hstep + kstep, voffB);
        PG8_WAIT_V(6); PG8_BAR;
    }
    for (;;) {
        const bool has_next = S.next(ui + 1, nxt);
        const char* nA = has_next ? (const char*)g.A + (size_t)nxt.pm * tstep : cA; const char* nB = has_next ? (const char*)g.Bt + (size_t)nxt.pn * tstep : cB;
        _Pragma("nounroll") for (int t = 0; t < nt; t += 2) {
            const bool last = (t == nt - 2);
            const char* a1 = cA + (size_t)(t + 1) * kstep;
            const char* a2 = last ? nA : cA + (size_t)(t + 2) * kstep; const char* b2 = last ? nB : cB + (size_t)(t + 2) * kstep;
            const char* a3 = a2 + kstep; const char* b3 = b2 + kstep;
            if (last && has_next) S.a_ready(nxt);
            const char* const g1 = gA0 + (size_t)(t + 1) * kstep; const char* const g2 = last ? gA0 : gA0 + (size_t)(t + 2) * kstep; const char* const g3 = g2 + kstep;
            if constexpr (SP2) {
            PG8_LDB(B0, 0, 0); PG8_LDB(B1, 0, 1); PG8_SCHED; PG8_LDA(At, 0, 0); PG8_STA(PG8_SA(1, 1), a1 + hstep, g1, 1);
            PG8_WAIT_V(8); PG8_WAIT_L(0); PG8_BAR; PG8_MMA(0, 0, At, B0); PG8_MMA(0, 1, At, B1); PG8_BAR; PG8_SCHED;
            if constexpr (GATHER) { if (last && has_next) PG8_VA(nxt); }
            PG8_LDA(At, 0, 1); PG8_STAGE(PG8_SB(0, 0), b2, voffB); PG8_STAGE(PG8_SB(0, 1), b2 + hstep, voffB); PG8_STA(PG8_SA(0, 0), a2, g2, 0);
            PG8_WAIT_V(8); PG8_WAIT_L(0); PG8_BAR; PG8_MMA(1, 0, At, B0); PG8_MMA(1, 1, At, B1); PG8_BAR; PG8_SCHED;
            PG8_LDB(B0, 1, 0); PG8_LDB(B1, 1, 1); PG8_SCHED; PG8_LDA(At, 1, 0); PG8_STA(PG8_SA(0, 1), a2 + hstep, g2, 1);
            PG8_WAIT_V(8); PG8_WAIT_L(0); PG8_BAR; PG8_MMA(0, 0, At, B0); PG8_MMA(0, 1, At, B1); PG8_BAR; PG8_SCHED;
            PG8_LDA(At, 1, 1); PG8_STAGE(PG8_SB(1, 0), b3, voffB); PG8_STAGE(PG8_SB(1, 1), b3 + hstep, voffB); PG8_STA(PG8_SA(1, 0), a3, g3, 0);
            PG8_WAIT_V(8); PG8_WAIT_L(0); PG8_BAR; PG8_MMA(1, 0, At, B0); PG8_MMA(1, 1, At, B1); PG8_BAR; PG8_SCHED;
            } else {
            PG8_LDB(B0, 0, 0); PG8_SCHED; PG8_LDA(At, 0, 0); PG8_STAGE(PG8_SA(1, 1), a1 + hstep, voffA);
            PG8_WAIT_L(8); PG8_BAR; PG8_WAIT_L(0); PG8_MMA(0, 0, At, B0); PG8_BAR; PG8_SCHED;
            PG8_LDB(B1, 0, 1); PG8_STAGE(PG8_SB(0, 0), b2, voffB);
            PG8_BAR; PG8_WAIT_L(0); PG8_MMA(0, 1, At, B1); PG8_BAR;
            PG8_LDA(At, 0, 1); PG8_STAGE(PG8_SA(0, 0), a2, voffA);
            PG8_BAR; PG8_WAIT_L(0); PG8_MMA(1, 0, At, B0); PG8_BAR; PG8_SCHED;
            PG8_STAGE(PG8_SB(0, 1), b2 + hstep, voffB);
            PG8_WAIT_V(6); PG8_BAR; PG8_MMA(1, 1, At, B1); PG8_BAR;
            PG8_LDB(B0, 1, 0); PG8_SCHED; PG8_LDA(At, 1, 0); PG8_STAGE(PG8_SA(0, 1), a2 + hstep, voffA);
            PG8_WAIT_L(8); PG8_BAR; PG8_WAIT_L(0); PG8_MMA(0, 0, At, B0); PG8_BAR; PG8_SCHED;
            PG8_LDB(B1, 1, 1); PG8_STAGE(PG8_SB(1, 0), b3, voffB);
            PG8_BAR; PG8_WAIT_L(0); PG8_MMA(0, 1, At, B1); PG8_BAR;
            PG8_LDA(At, 1, 1); PG8_STAGE(PG8_SA(1, 0), a3, voffA);
            PG8_BAR; PG8_WAIT_L(0); PG8_MMA(1, 0, At, B0); PG8_BAR; PG8_SCHED;
            PG8_STAGE(PG8_SB(1, 1), b3 + hstep, voffB);
            PG8_WAIT_V(6); PG8_BAR; PG8_MMA(1, 1, At, B1); PG8_BAR;
            }
        }
        if constexpr (ALIGN_EPI) { if (wr == 0) PG8_BAR; }
        if constexpr (!Epi::AFTER_DRAIN) { int fr_ = fr, fq_ = fq; asm volatile("" : "+v"(fr_), "+v"(fq_));
            E(acc, cur, wr, wc, fr_, fq_); S.done(cur); }
        if (!has_next) break;
        if constexpr (Epi::HAS_INIT) { int fq_ = fq; asm volatile("" : "+v"(fq_)); E.init(acc, nxt, wc, fq_); }
        else {
#pragma unroll
        for (int a = 0; a < 2; ++a)
#pragma unroll
            for (int b = 0; b < 2; ++b)
#pragma unroll
                for (int m = 0; m < 4; ++m)
#pragma unroll
                    for (int n = 0; n < 2; ++n) acc[a][b][m][n] = (f32x4){0.f, 0.f, 0.f, 0.f};
        }
        cur = nxt; cA = nA; cB = nB; ++ui;
        if constexpr (ALIGN_EPI) { if (wr == 1) PG8_BAR; }
    }
    PG8_WAIT_V(0);
    if constexpr (!ALIGN_EPI) { if (wr == 0) PG8_BAR; }
    PG8_BAR;
    if constexpr (Epi::AFTER_DRAIN) { E.fused(acc, cur, wr, wc, fr, fq, lds, wid, lane); S.done(cur); }
#undef PG8_SA
#undef PG8_CAT8
#undef PG8_VA
#undef PG8_STA
#undef PG8_SB
#undef PG8_STAGE
#undef PG8_LDA
#undef PG8_LDB
#undef PG8_MMA
#undef PG8_WAIT_V
#undef PG8_WAIT_L
#undef PG8_BAR
#undef PG8_SCHED
}
}

#ifndef PG8_SP2
#define PG8_SP2 true
#endif
#ifndef PG8_ALIGN
#define PG8_ALIGN true
#endif
#define GAS __attribute__((address_space(1)))
#define LAS __attribute__((address_space(3)))
typedef unsigned short bf16;
typedef unsigned v4u __attribute__((ext_vector_type(4)));
typedef float f32x4 __attribute__((ext_vector_type(4)));
typedef short bf16x8 __attribute__((ext_vector_type(8)));
typedef GAS unsigned gu32;
typedef GAS unsigned long long gu64;
#define RLX_AGENT __ATOMIC_RELAXED, __HIP_MEMORY_SCOPE_AGENT
#define LDS_WAIT() asm volatile("s_waitcnt lgkmcnt(0)" ::: "memory")
#define VM_WAIT() asm volatile("s_waitcnt vmcnt(0)" ::: "memory")
__device__ __forceinline__ unsigned long long rt() { return __builtin_amdgcn_s_memrealtime(); }
__device__ __forceinline__ unsigned f2bf(float f) { unsigned u = __builtin_bit_cast(unsigned, f); return (u + 0x7fffu + ((u >> 16) & 1u)) >> 16; }
__device__ __forceinline__ unsigned pk2(float lo, float hi) { return f2bf(lo) | (f2bf(hi) << 16); }

#define XB_TMO      128
#define XB_XCNT(j)  (256  + 64 * (j))
#define XB_XSUB(j)  (1280 + 64 * (j))
#define XB_XGEN(j)  (2304 + 64 * (j))
#define XB_TOP      3328
#define XB_TOPGEN   3392
#define XCD_BAR_WORDS 3456
#define XB_SPIN_CAP (1u << 18)

__device__ __forceinline__ unsigned xb_ld(unsigned* p)              { return __hip_atomic_load(p, __ATOMIC_RELAXED, __HIP_MEMORY_SCOPE_AGENT); }
__device__ __forceinline__ unsigned xb_add(unsigned* p, unsigned v) { return __hip_atomic_fetch_add(p, v, __ATOMIC_RELAXED, __HIP_MEMORY_SCOPE_AGENT); }
__device__ __forceinline__ unsigned xb_xcc_id() { return (unsigned)__builtin_amdgcn_s_getreg((3 << 11) | 20) & 0xFu; }
#define XB_SPIN(cond, bar) do { unsigned _sp = 0; while (cond) { __builtin_amdgcn_s_sleep(1); \
    if ((++_sp & 255u) == 0u) { if (xb_ld(&(bar)[XB_TMO])) break; if (_sp > XB_SPIN_CAP) { atomicAdd(&(bar)[XB_TMO], 1u); break; } } } } while (0)

struct XcdBarrier {
    unsigned* bar; unsigned x;
    volatile LAS unsigned* st;
};

__device__ __forceinline__ XcdBarrier xcd_barrier_post(unsigned* bar, volatile LAS unsigned* st) {
    XcdBarrier b; b.bar = bar; b.x = xb_xcc_id(); b.st = st;
    if (threadIdx.x == 0) (void)xb_add(&bar[XB_XCNT(b.x)], 1u);
    return b;
}
__device__ __forceinline__ void xcd_barrier_complete(unsigned* bar, unsigned x, unsigned& nloc, unsigned& nx) {
    const unsigned G = gridDim.x * gridDim.y * gridDim.z;
    unsigned sum, cnt, mine, sp = 0u;
    for (;;) {
        sum = 0u; cnt = 0u; mine = 0u;
#pragma unroll
        for (unsigned j = 0; j < 16; ++j) { const unsigned c = xb_ld(&bar[XB_XCNT(j)]); sum += c; cnt += (c > 0u) ? 1u : 0u; mine = (j == x) ? c : mine; }
        if (sum == G) break;
        __builtin_amdgcn_s_sleep(1);
        if ((++sp & 255u) == 0u) { if (xb_ld(&bar[XB_TMO])) break; if (sp > XB_SPIN_CAP) { atomicAdd(&bar[XB_TMO], 1u); break; } }
    }
    nloc = mine > 0u ? mine : 1u; nx = cnt > 0u ? cnt : 1u;
}

__device__ __forceinline__ void xcd_barrier(const XcdBarrier& b) {
    asm volatile("s_waitcnt vmcnt(0)" ::: "memory");
    __syncthreads();
    if (threadIdx.x == 0) {
        unsigned* bar = b.bar;
        __builtin_amdgcn_s_waitcnt(0);
        unsigned nloc = b.st[0], nx = b.st[1];
        if (nloc == 0u) { xcd_barrier_complete(bar, b.x, nloc, nx); b.st[0] = nloc; b.st[1] = nx; }
        const unsigned old = xb_add(&bar[XB_XSUB(b.x)], 1u);
        const unsigned gen = old / nloc;
        if (old + 1u == (gen + 1u) * nloc) {
            __builtin_amdgcn_fence(__ATOMIC_RELEASE, "agent");
            asm volatile("s_waitcnt vmcnt(0)" ::: "memory");
            const unsigned og = xb_add(&bar[XB_TOP], 1u);
            const unsigned tg = og / nx;
            if (og + 1u == (tg + 1u) * nx) xb_add(&bar[XB_TOPGEN], 1u);
            else XB_SPIN(xb_ld(&bar[XB_TOPGEN]) == tg, bar);
            __builtin_amdgcn_fence(__ATOMIC_ACQUIRE, "agent");
            xb_add(&bar[XB_XGEN(b.x)], 1u);
            asm volatile("s_waitcnt vmcnt(0)" ::: "memory");
        } else {
            XB_SPIN(xb_ld(&bar[XB_XGEN(b.x)]) == gen, bar);
            __builtin_amdgcn_fence(__ATOMIC_ACQUIRE, "agent");
            asm volatile("s_waitcnt vmcnt(0)" ::: "memory");
        }
    }
    __syncthreads();
}

constexpr int NWAVES = 8;
#ifndef MK_ONE_LAUNCH
#define MK_ONE_LAUNCH 1
#endif

constexpr int BATCH = 16, SEQ = 2048, D = 1024, T = BATCH * SEQ;
constexpr int NIN = 3584;
constexpr int OFF_SQ = 0, OFF_SK = 512, OFF_SV = 1024, OFF_HQ = 1536, OFF_HF = 2048, OFF_HI = 2560, OFF_HG = 3072;
constexpr int NE = 32, TOPK = 4, NASSIGN = T * TOPK;
constexpr int MAXTILES = NASSIGN / 256 + NE;
constexpr int MAXROWS = MAXTILES * 256;
constexpr float EPS = 1e-6f;

constexpr size_t MiB = 1u << 20;
constexpr size_t WS_CTL = 0, CTL_ZERO_BYTES = 1 * MiB;
constexpr size_t WS_WIN = 2 * MiB;
constexpr size_t WS_WOUT = 10 * MiB;
constexpr size_t WS_WGU = 16 * MiB;
constexpr size_t WS_WD = 144 * MiB;
constexpr size_t WS_XN = 208 * MiB;
constexpr size_t WS_P = 272 * MiB;
constexpr size_t WS_PH = WS_P + 96 * MiB;
constexpr size_t WS_MIX = 496 * MiB;
constexpr size_t WS_ACT = 272 * MiB;
constexpr size_t WS_YK = 560 * MiB;
constexpr size_t WS_QN = 624 * MiB;
constexpr size_t WS_KN = 656 * MiB;
constexpr size_t WS_VT = 688 * MiB;
constexpr size_t WS_KVS = 720 * MiB;
constexpr size_t WS_DEC = 784 * MiB;
constexpr size_t WS_SSEG = 786 * MiB;
constexpr size_t WS_DSEG = 802 * MiB;
constexpr size_t WS_LIST = 816 * MiB;
constexpr size_t WS_TOPG = 825 * MiB;
constexpr size_t WS_X8 = 560 * MiB;
constexpr size_t WS_END = 832 * MiB;
static_assert(WS_ACT + (size_t)MAXROWS * 2048 <= WS_YK && WS_YK + (size_t)T * 4 * 2048 <= WS_LIST && WS_MIX + (size_t)T * 2048 <= WS_YK, "d_ws map");
constexpr int CW_TMO = 0, CW_CODE = 1;
constexpr int CW_CNT = 64;
constexpr int CW_BAR = 4096;

constexpr int RING_OFF = 0, RING_BYTES = 131072;
constexpr int RT_ROW = 2064, RT_WL = 32 * RT_ROW, RT_END = 64 * RT_ROW;
constexpr int LDSCTL_OFF = 133120, MISC_OFF = LDSCTL_OFF + 320;
constexpr int LTAB_OFF = LDSCTL_OFF + 512;
constexpr int LT_TS = MAXTILES, LT_CNT = MAXTILES + 32, LT_MISC = MAXTILES + 64, LT_WORDS = MAXTILES + 192;
constexpr int ROWTAB_OFF = LTAB_OFF + LT_WORDS * 4;
constexpr int MAXSLOT = 17;
constexpr int ROWTAB2_OFF = ROWTAB_OFF + MAXSLOT * 1024;
constexpr int LDS_BYTES = ROWTAB2_OFF + MAXSLOT * 512;
static_assert(RT_END <= LDSCTL_OFF && MISC_OFF + 128 <= LTAB_OFF && LDS_BYTES <= 160 * 1024 && (MAXTILES * 8 + 255) / 256 <= MAXSLOT && 2 * ((MAXTILES * 4 + 255) / 256) * 1024 <= MAXSLOT * 1536 && ROWTAB_OFF % 16 == 0, "LDS map");

struct Frame {
    LAS unsigned char* lds;
    volatile LAS unsigned* MISC;
    gu32* ctl;
    int tid, lane, wave, gw, ngw;
    int vcu, G;
    const float *x, *norm1_g, *w_in, *sb_q_g, *sb_k_g, *sb_out_g, *hg_lb, *hg_out_g, *w_out, *norm2_g, *w_router, *b_router, *w_gu, *b_gu, *w_d, *b_d;
    float* out;
    unsigned char* ws;
};
__device__ __forceinline__ float bf2f(unsigned short b) { return __builtin_bit_cast(float, (unsigned)b << 16); }
__device__ __forceinline__ float bflo(unsigned w) { return __builtin_bit_cast(float, w << 16); }
__device__ __forceinline__ float bfhi(unsigned w) { return __builtin_bit_cast(float, w & 0xffff0000u); }
typedef __bf16 bf16x2n_ __attribute__((ext_vector_type(2)));
typedef float f32x2n_ __attribute__((ext_vector_type(2)));
__device__ __forceinline__ unsigned pkbf(float a, float b) { const bf16x2n_ v = __builtin_convertvector((f32x2n_){a, b}, bf16x2n_); return __builtin_bit_cast(unsigned, v); }
__device__ __forceinline__ int lane_id() { int l; asm volatile("v_mbcnt_lo_u32_b32 %0, -1, 0\n\tv_mbcnt_hi_u32_b32 %0, -1, %0" : "=v"(l)); return l; }
__device__ __forceinline__ int vzero() { int z; asm volatile("v_mov_b32 %0, 0" : "=v"(z)); return z; }
__device__ __forceinline__ float wave_sum(float v) {
#pragma unroll
    for (int o = 1; o < 64; o <<= 1) v += __shfl_xor(v, o);
    return v;
}

constexpr float W8_SCALE = 256.f, A8_SCALE = 4.f, Y8_SCALE = 32.f; static_assert(Y8_SCALE == 32.f, "SC_W8Y below is 2^-8 * 32");
constexpr int SC_ONE = 0x7f7f7f7f, SC_W8 = 0x77777777, SC_A8 = 0x7d7d7d7d, SC_W8Y = 0x7c7c7c7c;
struct P0Item { const float* W; bf16* WT; const float* rowscale; int N, k0, n0, drow0, fp8, perm; };
__device__ __forceinline__ void p0_load(const P0Item& it, f32x4 (&v)[16], int lane) {
    const int kr = lane >> 4, nc = 4 * (lane & 15);
#pragma unroll
    for (int i = 0; i < 16; ++i) v[i] = __builtin_nontemporal_load((const f32x4*)(it.W + (size_t)(it.k0 + 4 * i + kr) * it.N + it.n0 + nc));
}
__device__ __forceinline__ void p0_store(const P0Item& it, const f32x4 (&v)[16], LAS unsigned char* scr, int lane) {
    const int kr = lane >> 4, nc = 4 * (lane & 15);
#pragma unroll
    for (int i = 0; i < 16; ++i) { const float sc = it.rowscale ? it.rowscale[it.k0 + 4 * i + kr] : 1.f;
        *(LAS unsigned long long*)(scr + (4 * i + kr) * 136 + 2 * nc) = (unsigned long long)pkbf(v[i].x * sc, v[i].y * sc) | ((unsigned long long)pkbf(v[i].z * sc, v[i].w * sc) << 32); }
    LDS_WAIT(); asm volatile("" ::: "memory");
    unsigned val[64];
#pragma unroll
    for (int k = 0; k < 64; ++k) val[k] = *(const LAS unsigned short*)(scr + k * 136 + 2 * lane);
    if (it.fp8) { GAS v4u* o = (GAS v4u*)((unsigned char*)it.WT + (size_t)(it.drow0 + lane) * D + it.k0);
#pragma unroll
        for (int c = 0; c < 4; ++c) { v4u w4;
            w4.x = pg8::pk4_fp8(bflo(val[16 * c + 0]) * W8_SCALE, bflo(val[16 * c + 1]) * W8_SCALE, bflo(val[16 * c + 2]) * W8_SCALE, bflo(val[16 * c + 3]) * W8_SCALE);
            w4.y = pg8::pk4_fp8(bflo(val[16 * c + 4]) * W8_SCALE, bflo(val[16 * c + 5]) * W8_SCALE, bflo(val[16 * c + 6]) * W8_SCALE, bflo(val[16 * c + 7]) * W8_SCALE);
            w4.z = pg8::pk4_fp8(bflo(val[16 * c + 8]) * W8_SCALE, bflo(val[16 * c + 9]) * W8_SCALE, bflo(val[16 * c + 10]) * W8_SCALE, bflo(val[16 * c + 11]) * W8_SCALE);
            w4.w = pg8::pk4_fp8(bflo(val[16 * c + 12]) * W8_SCALE, bflo(val[16 * c + 13]) * W8_SCALE, bflo(val[16 * c + 14]) * W8_SCALE, bflo(val[16 * c + 15]) * W8_SCALE); o[c] = w4; }
    } else { GAS v4u* o = (GAS v4u*)(it.WT + (size_t)(it.drow0 + (it.perm ? 128 * (lane >> 5) + (lane & 31) : lane)) * D + it.k0);
#pragma unroll
        for (int c = 0; c < 8; ++c) { v4u w4; w4.x = val[8 * c + 0] | (val[8 * c + 1] << 16); w4.y = val[8 * c + 2] | (val[8 * c + 3] << 16); w4.z = val[8 * c + 4] | (val[8 * c + 5] << 16); w4.w = val[8 * c + 6] | (val[8 * c + 7] << 16); o[c] = w4; } }
    LDS_WAIT(); asm volatile("" ::: "memory");
}
__device__ __forceinline__ void rms_rows2_to_bf16(const float* xa, const float* xb, bool hasb, const float* g, bf16* oa, bf16* ob, int lane) {
    const GAS f32x4* pa = (const GAS f32x4*)xa + lane; const GAS f32x4* pb = (const GAS f32x4*)(hasb ? xb : xa) + lane; const f32x4* gr = (const f32x4*)g + lane;
    f32x4 va[4], vb[4], gg[4]; float sa = 0.f, sb = 0.f;
#pragma unroll
    for (int j = 0; j < 4; ++j) { va[j] = __builtin_nontemporal_load(pa + 64 * j); vb[j] = __builtin_nontemporal_load(pb + 64 * j); gg[j] = gr[64 * j]; }
#pragma unroll
    for (int j = 0; j < 4; ++j) { sa += (va[j].x * va[j].x + va[j].y * va[j].y) + (va[j].z * va[j].z + va[j].w * va[j].w); sb += (vb[j].x * vb[j].x + vb[j].y * vb[j].y) + (vb[j].z * vb[j].z + vb[j].w * vb[j].w); }
    const float ra = 1.f / sqrtf(wave_sum(sa) * (1.f / D) + EPS), rb = 1.f / sqrtf(wave_sum(sb) * (1.f / D) + EPS);
    GAS unsigned long long* o8a = (GAS unsigned long long*)oa + lane; GAS unsigned long long* o8b = (GAS unsigned long long*)ob + lane;
#pragma unroll
    for (int j = 0; j < 4; ++j) o8a[64 * j] = (unsigned long long)pkbf(va[j].x * ra * gg[j].x, va[j].y * ra * gg[j].y) | ((unsigned long long)pkbf(va[j].z * ra * gg[j].z, va[j].w * ra * gg[j].w) << 32);
    if (hasb) {
#pragma unroll
        for (int j = 0; j < 4; ++j) o8b[64 * j] = (unsigned long long)pkbf(vb[j].x * rb * gg[j].x, vb[j].y * rb * gg[j].y) | ((unsigned long long)pkbf(vb[j].z * rb * gg[j].z, vb[j].w * rb * gg[j].w) << 32); }
}
__device__ __forceinline__ P0Item p0_item(Frame& F, int r) {
    constexpr int I_IN = 16 * (NIN / 64), I_OUT = 16 * 16, I_GU = NE * 16 * 32;
    P0Item it;
    if (r < I_IN) { const int nb = NIN / 64, kb = r / nb, nn = r % nb; const int pq = nn < 16; it = P0Item{F.w_in, (bf16*)(F.ws + WS_WIN), nullptr, NIN, 64 * kb, 64 * nn, pq ? 256 * (nn >> 2) + 32 * (nn & 3) : 64 * nn, 0, pq}; return it; } r -= I_IN;
    if (r < I_OUT) { const int kb = r / 16, nn = r % 16; it = P0Item{F.w_out, (bf16*)(F.ws + WS_WOUT), nullptr, D, 64 * kb, 64 * nn, 64 * nn, 0, 0}; return it; } r -= I_OUT;
    if (r < I_GU) { const int e = r / 512, q = r % 512, kb = q / 32, nn = q % 32;
        const int isup = nn >> 4, a = (nn & 15) * 64;
        it = P0Item{F.w_gu + (size_t)e * D * 2048, (bf16*)(F.ws + WS_WGU + (size_t)e * 2048 * D), F.norm2_g, 2048, 64 * kb, 64 * nn, 256 * (a >> 7) + 128 * isup + (a & 127), 1, 0}; return it; } r -= I_GU;
    { const int e = r / 256, q = r % 256, kb = q / 16, nn = q % 16;
        it = P0Item{F.w_d + (size_t)e * D * D, (bf16*)(F.ws + WS_WD + (size_t)e * D * D), nullptr, D, 64 * kb, 64 * nn, 64 * nn, 1, 0}; return it; }
}
__device__ __forceinline__ void p0_prologue(Frame& F) {
    LAS unsigned char* scr = F.lds + RING_OFF + F.wave * 16384;
    constexpr int NITEMS = 16 * (NIN / 64) + 16 * 16 + NE * 16 * 32 + NE * 16 * 16;
    {
        f32x4 va[16], vb[16]; int it = F.gw;
        if (it < NITEMS) { P0Item A = p0_item(F, it); p0_load(A, va, F.lane);
            for (;;) {
                const int itb = it + F.ngw; const bool hb = itb < NITEMS; const P0Item B = p0_item(F, hb ? itb : it); p0_load(B, vb, F.lane); __builtin_amdgcn_sched_barrier(0);
                p0_store(A, va, scr, F.lane);
                if (!hb) break;
                it = itb + F.ngw; const bool ha = it < NITEMS; A = p0_item(F, ha ? it : itb); p0_load(A, va, F.lane); __builtin_amdgcn_sched_barrier(0);
                p0_store(B, vb, scr, F.lane);
                if (!ha) break;
            }
        }
    }
    for (int m = F.gw; m < T; m += 2 * F.ngw) rms_rows2_to_bf16(F.x + (size_t)m * D, F.x + (size_t)(m + F.ngw) * D, m + F.ngw < T, F.norm1_g, (bf16*)(F.ws + WS_XN) + (size_t)m * D, (bf16*)(F.ws + WS_XN) + (size_t)(m + F.ngw) * D, F.lane);
}

typedef float f32x16 __attribute__((ext_vector_type(16)));
typedef __bf16 bf16x2n __attribute__((ext_vector_type(2)));
typedef float f32x2n __attribute__((ext_vector_type(2)));
#define MFMA32(a, b, c) __builtin_amdgcn_mfma_f32_32x32x16_bf16((a), (b), (c), 0, 0, 0)
__device__ __forceinline__ bf16x8 pack8(float a0, float a1, float a2, float a3, float a4, float a5, float a6, float a7) { const v4u p = {pkbf(a0, a1), pkbf(a2, a3), pkbf(a4, a5), pkbf(a6, a7)}; return __builtin_bit_cast(bf16x8, p); }
constexpr float QSCALE = 0.125f * 1.44269504089f;
__device__ __forceinline__ void prep_phase(Frame& F) {
    LAS unsigned* tl = (LAS unsigned*)(F.lds + RING_OFF + F.wave * 16384);
    const bf16* P = (const bf16*)(F.ws + WS_P); bf16* Qn = (bf16*)(F.ws + WS_QN); bf16* Kn = (bf16*)(F.ws + WS_KN); bf16* VT = (bf16*)(F.ws + WS_VT);
    const int tr = F.lane >> 3, c8 = F.lane & 7;
    for (int it = F.gw; it < 4096; it += F.ngw) {
        const int bh = it & 127, blk = it >> 7, b = bh >> 3, h = bh & 7;
        const bf16* base = P + ((size_t)b * 8 + h) * SEQ * 64 + (size_t)(blk * 64 + tr) * 64 + 8 * c8;
        v4u rv[8];
#pragma unroll
        for (int i = 0; i < 8; ++i) { const bf16* row = base + (size_t)(8 * i) * 64; rv[i] = *(const GAS v4u*)(row + (size_t)2 * 16 * 8 * SEQ * 64); }
        {
#pragma unroll
            for (int i = 0; i < 8; ++i) { LAS unsigned* q = tl + (8 * i + tr) * 33 + 4 * c8; q[0] = rv[i].x; q[1] = rv[i].y; q[2] = rv[i].z; q[3] = rv[i].w; }
            LDS_WAIT(); asm volatile("" ::: "memory");
            const LAS unsigned short* t16 = (const LAS unsigned short*)tl; const int dr = tr;
#define KAP(pos) (((pos) & ~12) | (((pos) & 4) << 1) | (((pos) & 8) >> 1))
            bf16* const obase = VT + ((size_t)bh * 64 + blk * 2 + (c8 >> 2)) * 2048 + ((c8 >> 1) & 1) * 512 + (c8 & 1) * 256;
#pragma unroll
            for (int j = 0; j < 8; ++j) { unsigned val[8];
#pragma unroll
                for (int p = 0; p < 8; ++p) { const int pos = 8 * c8 + p; val[p] = t16[KAP(pos) * 66 + 8 * j + dr]; }
                v4u w4; w4.x = val[0] | (val[1] << 16); w4.y = val[2] | (val[3] << 16); w4.z = val[4] | (val[5] << 16); w4.w = val[6] | (val[7] << 16);
                *(GAS v4u*)(obase + (j >> 2) * 1024 + ((8 * j + dr) & 31) * 8) = w4; }
#undef KAP
            LDS_WAIT(); asm volatile("" ::: "memory");
        }
    }
}

__device__ __forceinline__ int crow16(int i, int hh) { return (i & 3) + 8 * (i >> 2) + 4 * hh; }
__device__ __forceinline__ void attn_item(Frame& F, int bh, int qb, float thr, const bf16x8 (&Lt)[2]) {
    const int r = F.lane & 31, hh = F.lane >> 5, b = bh >> 3, h = bh & 7, q0 = qb * 32;
    const bf16* Qn = (const bf16*)(F.ws + WS_QN); const bf16* Kn = (const bf16*)(F.ws + WS_KN); const bf16* VT = (const bf16*)(F.ws + WS_VT);
    bf16x8 qf[4];
#pragma unroll
    for (int s = 0; s < 4; ++s) qf[s] = *(const GAS bf16x8*)(Qn + ((size_t)bh * 64 + qb) * 2048 + s * 512 + F.lane * 8);
    f32x4 gout[2][4];
#pragma unroll
    for (int db = 0; db < 2; ++db)
#pragma unroll
        for (int gq = 0; gq < 4; ++gq) gout[db][gq] = *(const f32x4*)(F.sb_out_g + h * 64 + 32 * db + 8 * gq + 4 * hh);
    f32x16 O0, O1;
#pragma unroll
    for (int i = 0; i < 16; ++i) { O0[i] = 0.f; O1[i] = 0.f; }
    float carry = 0.f;
    const bf16* kbase = Kn + (size_t)bh * 64 * 2048 + F.lane * 8; const bf16* vbase = VT + (size_t)bh * 64 * 2048 + F.lane * 8;
#define ATT_LOAD(KF, VF, kb_) do { _Pragma("unroll") for (int s_ = 0; s_ < 4; ++s_) KF[s_] = *(const GAS bf16x8*)(kbase + (size_t)(kb_) * 2048 + 512 * s_); \
        _Pragma("unroll") for (int db_ = 0; db_ < 2; ++db_) _Pragma("unroll") for (int ks_ = 0; ks_ < 2; ++ks_) VF[db_][ks_] = *(const GAS bf16x8*)(vbase + (size_t)(kb_) * 2048 + 1024 * db_ + 512 * ks_); } while (0)
#define ATT_BLOCK(KF, VF, kb_) do { const bool diag = ((kb_) == qb); \
        f32x16 z; _Pragma("unroll") for (int i = 0; i < 16; ++i) z[i] = 0.f; \
        _Pragma("unroll") for (int s_ = 0; s_ < 4; ++s_) z = MFMA32(KF[s_], qf[s_], z); \
        float sp[16]; \
        _Pragma("unroll") for (int i = 0; i < 16; ++i) { const float zz = z[i]; float v = fmaxf(zz, 0.f) + __builtin_amdgcn_logf(1.f + __builtin_amdgcn_exp2f(-fabsf(zz))); if (diag && !(crow16(i, hh) < r)) v = 0.f; sp[i] = v; } \
        const bf16x8 sb0 = pack8(sp[0], sp[1], sp[2], sp[3], sp[4], sp[5], sp[6], sp[7]), sb1 = pack8(sp[8], sp[9], sp[10], sp[11], sp[12], sp[13], sp[14], sp[15]); \
        f32x16 Cc; _Pragma("unroll") for (int i = 0; i < 16; ++i) Cc[i] = carry; \
        Cc = MFMA32(Lt[0], sb0, Cc); Cc = MFMA32(Lt[1], sb1, Cc); \
        float w[16]; \
        _Pragma("unroll") for (int i = 0; i < 16; ++i) { float v = __builtin_amdgcn_exp2f(z[i] - Cc[i]); if (diag && !(crow16(i, hh) < r)) v = 0.f; w[i] = v; } \
        const bf16x8 wb0 = pack8(w[0], w[1], w[2], w[3], w[4], w[5], w[6], w[7]), wb1 = pack8(w[8], w[9], w[10], w[11], w[12], w[13], w[14], w[15]); \
        O0 = MFMA32(VF[0][0], wb0, O0); O0 = MFMA32(VF[0][1], wb1, O0); O1 = MFMA32(VF[1][0], wb0, O1); O1 = MFMA32(VF[1][1], wb1, O1); \
        carry = __shfl(Cc[0], r); } while (0)
    bf16x8 kfA[4], vfA[2][2], kfB[4], vfB[2][2];
    ATT_LOAD(kfA, vfA, qb);
    for (int kb = qb; kb >= 0; kb -= 2) {
        ATT_LOAD(kfB, vfB, kb > 0 ? kb - 1 : 0); __builtin_amdgcn_sched_barrier(0);
        ATT_BLOCK(kfA, vfA, kb);
        if (kb == 0 || __all(carry > thr)) break;
        ATT_LOAD(kfA, vfA, kb > 1 ? kb - 2 : 0); __builtin_amdgcn_sched_barrier(0);
        ATT_BLOCK(kfB, vfB, kb - 1);
        if (__all(carry > thr)) break;
    }
#undef ATT_LOAD
#undef ATT_BLOCK
    float ss = 0.f;
#pragma unroll
    for (int i = 0; i < 16; ++i) ss += O0[i] * O0[i] + O1[i] * O1[i];
    ss += __shfl_xor(ss, 32);
    const float rs = 1.f / sqrtf(ss * (1.f / 64.f) + EPS);
    bf16* orow = (bf16*)(F.ws + WS_MIX) + ((size_t)b * SEQ + q0 + r) * D + h * 64;
#pragma unroll
    for (int db = 0; db < 2; ++db)
#pragma unroll
        for (int gq = 0; gq < 4; ++gq) { const int d = 32 * db + 8 * gq + 4 * hh; const f32x4 gg = gout[db][gq];
            const float a0 = (db ? O1[4 * gq + 0] : O0[4 * gq + 0]) * rs * gg.x, a1 = (db ? O1[4 * gq + 1] : O0[4 * gq + 1]) * rs * gg.y, a2 = (db ? O1[4 * gq + 2] : O0[4 * gq + 2]) * rs * gg.z, a3 = (db ? O1[4 * gq + 3] : O0[4 * gq + 3]) * rs * gg.w;
            *(GAS unsigned long long*)(orow + d) = (unsigned long long)pkbf(a0, a1) | ((unsigned long long)pkbf(a2, a3) << 32); }
}
__device__ __forceinline__ void attn_phase(Frame& F) {
    const int r = F.lane & 31, hh = F.lane >> 5;
    float mq = fabsf(F.sb_q_g[F.lane]), mk = fabsf(F.sb_k_g[F.lane]);
#pragma unroll
    for (int o = 1; o < 64; o <<= 1) { mq = fmaxf(mq, __shfl_xor(mq, o)); mk = fmaxf(mk, __shfl_xor(mk, o)); }
    const float thr = 64.f * QSCALE * mq * mk * 1.02f + 170.f;
    bf16x8 Lt[2];
#pragma unroll
    for (int ks = 0; ks < 2; ++ks) { float e[8];
#pragma unroll
        for (int jj = 0; jj < 8; ++jj) e[jj] = (16 * ks + 8 * (jj >> 2) + 4 * hh + (jj & 3) >= r) ? 1.f : 0.f;
        Lt[ks] = pack8(e[0], e[1], e[2], e[3], e[4], e[5], e[6], e[7]); }
    for (int it = F.gw; it < 2048; it += F.ngw) { const int bh = it & 127, j = it >> 7;
        attn_item(F, bh, 63 - j, thr, Lt); attn_item(F, bh, j, thr, Lt); attn_item(F, bh, 47 - j, thr, Lt); attn_item(F, bh, 16 + j, thr, Lt); }
}

constexpr int HG_PART = 0, HG_SSQ = 2048, HG_QE = 4096, HG_KE = HG_QE + 64 * 272, HG_VT = HG_KE + 64 * 272, HG_KST = HG_VT + 128 * 144, HG_ST = HG_KST + 128 * 144, HG_END = HG_ST + 128 * 272;
static_assert(HG_END <= RING_BYTES, "HGRN2 LDS map");
__device__ __forceinline__ float hg_lbound(Frame& F, int h, int d) { const int c = h * 128 + d; return 1.f / (1.f + __expf(F.hg_lb[512 + c] - F.hg_lb[c])); }
__device__ __forceinline__ void hg_gates(Frame& F, const unsigned short (&ffr)[16], float lb, int d, int tq, float (&bb)[16], float (&kk)[16], float& total) {
    float run = 0.f;
#pragma unroll
    for (int i = 0; i < 16; ++i) { const float ff = bf2f(ffr[i]); const float sg = __builtin_amdgcn_rcpf(1.f + __expf(-ff));
        const float f = lb + (1.f - lb) * sg; kk[i] = (1.f - lb) * (1.f - sg); run += __logf(f); bb[i] = run; }
    LAS float* part = (LAS float*)(F.lds + RING_OFF + HG_PART);
    part[tq * 128 + d] = run;
    __syncthreads();
    const float p0 = part[d], p1 = part[128 + d], p2 = part[256 + d], p3 = part[384 + d];
    const float off = (tq > 0 ? p0 : 0.f) + (tq > 1 ? p1 : 0.f) + (tq > 2 ? p2 : 0.f);
    total = (p0 + p1) + (p2 + p3);
#pragma unroll
    for (int i = 0; i < 16; ++i) bb[i] += off;
}
#define HG_HV() const bf16* const PHp = (const bf16*)(F.ws + WS_PH); \
    const __amdgpu_buffer_rsrc_t rsrcP = __builtin_amdgcn_make_buffer_rsrc((void*)PHp, 0, (int)((size_t)4 * T * 512 * 2), 0x00020000)
#define HG_SOFF(item_, arr_) ((unsigned)((((arr_) * 16 + (((item_) >> 5) >> 2)) * 4 + (((item_) >> 5) & 3)) * SEQ + ((item_) & 31) * 64) * 256u)
#define HG_ARR(col_) ((col_) == OFF_HQ ? 0 : (col_) == OFF_HF ? 1 : (col_) == OFF_HI ? 2 : 3)
#define HG_LOADT(dst2, item_, arr_) do { const unsigned so_ = (unsigned)__builtin_amdgcn_readfirstlane((int)HG_SOFF(item_, arr_)); _Pragma("unroll") for (int j_ = 0; j_ < 2; ++j_) \
        (dst2)[j_] = __builtin_bit_cast(v4u, __builtin_amdgcn_raw_buffer_load_b128(rsrcP, (unsigned)F.tid * 16u + 8192u * j_, so_, 0)); } while (0)
#define HG_PUT(src2, raw_) do { _Pragma("unroll") for (int j_ = 0; j_ < 2; ++j_) *(LAS v4u*)((raw_) + ((F.tid >> 4) + 32 * j_) * 272 + (F.tid & 15) * 16) = (src2)[j_]; } while (0)
#define HG_COL(dst, raw_) do { _Pragma("unroll") for (int i_ = 0; i_ < 16; ++i_) dst[i_] = *(const LAS unsigned short*)((raw_) + (16 * tq + i_) * 272 + 2 * d); } while (0)
template <bool PERMUTE> __device__ __forceinline__ void st16(LAS unsigned char* dst, const float (&v)[16]) {
    v4u a, b2;
    if (!PERMUTE) { a.x = pkbf(v[0], v[1]); a.y = pkbf(v[2], v[3]); a.z = pkbf(v[4], v[5]); a.w = pkbf(v[6], v[7]); b2.x = pkbf(v[8], v[9]); b2.y = pkbf(v[10], v[11]); b2.z = pkbf(v[12], v[13]); b2.w = pkbf(v[14], v[15]); }
    else { a.x = pkbf(v[0], v[1]); a.y = pkbf(v[2], v[3]); a.z = pkbf(v[8], v[9]); a.w = pkbf(v[10], v[11]); b2.x = pkbf(v[4], v[5]); b2.y = pkbf(v[6], v[7]); b2.z = pkbf(v[12], v[13]); b2.w = pkbf(v[14], v[15]); }
    *(LAS v4u*)dst = a; *(LAS v4u*)(dst + 16) = b2;
}
__device__ __forceinline__ void hgA_phase(Frame& F) {
    const int d = F.tid & 127, tq = F.tid >> 7, r = F.lane & 31, hh = F.lane >> 5;
    const bf16* P = (const bf16*)(F.ws + WS_P); bf16* KVS = (bf16*)(F.ws + WS_KVS); float* DEC = (float*)(F.ws + WS_DEC); float* SSEG = (float*)(F.ws + WS_SSEG); float* DSEG = (float*)(F.ws + WS_DSEG);
    LAS unsigned char* L = F.lds + RING_OFF; LAS float* decl = (LAS float*)(L + HG_SSQ);
    HG_HV();
    v4u rf[2], rv[2];
    LAS unsigned char* const RAWF = F.lds + ROWTAB_OFF; LAS unsigned char* const RAWV = L + HG_ST;
    for (int wg = blockIdx.x; wg < 256; wg += F.G) {
        const int bh = wg >> 2, seg = wg & 3, item0 = bh * 32 + seg * 8, h = bh & 3;
        HG_LOADT(rf, item0, 1); HG_LOADT(rv, item0, 2);
        const float lbv = hg_lbound(F, h, d); float totrun = 0.f;
        const int db = F.wave & 3, eb0 = 2 * (F.wave >> 2);
        f32x16 run0, run1;
#pragma unroll
        for (int i = 0; i < 16; ++i) { run0[i] = 0.f; run1[i] = 0.f; }
      for (int k = 0; k < 8; ++k) {
        const int item = item0 + k;
        HG_PUT(rf, RAWF); HG_PUT(rv, RAWV);
        __syncthreads();
        { const int nit = k < 7 ? item + 1 : item; HG_LOADT(rf, nit, 1); HG_LOADT(rv, nit, 2); __builtin_amdgcn_sched_barrier(0); }
        unsigned short ffr[16], vr[16]; HG_COL(ffr, RAWF); HG_COL(vr, RAWV);
        float bb[16], kk[16], total; hg_gates(F, ffr, lbv, d, tq, bb, kk, total);
        float ks[16], vv[16];
#pragma unroll
        for (int i = 0; i < 16; ++i) { ks[i] = kk[i] * __expf(total - bb[i]); vv[i] = bf2f(vr[i]); }
        st16<false>(L + HG_KST + d * 144 + tq * 32, ks); st16<false>(L + HG_VT + d * 144 + tq * 32, vv);
        const float dc = __expf(total); totrun += total;
        if (tq == 0) { DEC[(size_t)item * 128 + d] = dc; decl[d] = dc; }
        __syncthreads();
        f32x16 acc0, acc1;
#pragma unroll
        for (int i = 0; i < 16; ++i) { acc0[i] = 0.f; acc1[i] = 0.f; }
#pragma unroll
        for (int s = 0; s < 4; ++s) { const bf16x8 af = *(const LAS bf16x8*)(L + HG_KST + (db * 32 + r) * 144 + 32 * s + 16 * hh);
            const bf16x8 b0 = *(const LAS bf16x8*)(L + HG_VT + (eb0 * 32 + r) * 144 + 32 * s + 16 * hh), b1 = *(const LAS bf16x8*)(L + HG_VT + ((eb0 + 1) * 32 + r) * 144 + 32 * s + 16 * hh);
            acc0 = MFMA32(af, b0, acc0); acc1 = MFMA32(af, b1, acc1); }
#pragma unroll
        for (int g = 0; g < 4; ++g) { const f32x4 dl = *(const LAS f32x4*)(decl + db * 32 + 8 * g + 4 * hh);
#pragma unroll
            for (int ii = 0; ii < 4; ++ii) { run0[4 * g + ii] = dl[ii] * run0[4 * g + ii] + acc0[4 * g + ii]; run1[4 * g + ii] = dl[ii] * run1[4 * g + ii] + acc1[4 * g + ii]; } }
#pragma unroll
        for (int j = 0; j < 2; ++j) { bf16* dst = KVS + ((size_t)item * 128 + (eb0 + j) * 32 + r) * 128 + db * 32 + 4 * hh;
#pragma unroll
            for (int g = 0; g < 4; ++g) { const float a0 = j ? acc1[4 * g + 0] : acc0[4 * g + 0], a1 = j ? acc1[4 * g + 1] : acc0[4 * g + 1], a2 = j ? acc1[4 * g + 2] : acc0[4 * g + 2], a3 = j ? acc1[4 * g + 3] : acc0[4 * g + 3];
                *(GAS unsigned long long*)(dst + 8 * g) = (unsigned long long)pkbf(a0, a1) | ((unsigned long long)pkbf(a2, a3) << 32); } }
        __syncthreads();
      }
#pragma unroll
        for (int j = 0; j < 2; ++j) { float* dst = SSEG + ((size_t)wg * 128 + (eb0 + j) * 32 + r) * 128 + db * 32 + 4 * hh;
#pragma unroll
            for (int g = 0; g < 4; ++g) *(GAS f32x4*)(dst + 8 * g) = j ? (f32x4){run1[4 * g + 0], run1[4 * g + 1], run1[4 * g + 2], run1[4 * g + 3]} : (f32x4){run0[4 * g + 0], run0[4 * g + 1], run0[4 * g + 2], run0[4 * g + 3]}; }
        if (tq == 0) DSEG[(size_t)wg * 128 + d] = __expf(totrun);
    }
}
constexpr int HG_DECS = HG_END;
static_assert(HG_DECS + 4096 + 64 * 272 <= LDSCTL_OFF && HG_KST + 64 * 272 <= HG_ST && 64 * 272 <= MAXSLOT * 1536, "HGRN2 LDS map (decays, raw tiles)");
__device__ __forceinline__ void hgC_phase(Frame& F) {
    const int d = F.tid & 127, tq = F.tid >> 7, r = F.lane & 31, hh = F.lane >> 5;
    const bf16* P = (const bf16*)(F.ws + WS_P); const bf16* KVS = (const bf16*)(F.ws + WS_KVS); bf16* MIX = (bf16*)(F.ws + WS_MIX); const float* DEC = (const float*)(F.ws + WS_DEC);
    HG_HV();
    LAS unsigned char* L = F.lds + RING_OFF; const LAS float* decs = (const LAS float*)(L + HG_DECS);
    const int se = F.tid >> 2, sq = F.tid & 3;
    v4u rf[2], rq[2], rv[2], st[4];
    LAS unsigned char* const RAWF = L + HG_KST; LAS unsigned char* const RAWQ = F.lds + ROWTAB_OFF; LAS unsigned char* const RAWV = L + HG_DECS + 4096;
    const __amdgpu_buffer_rsrc_t rsrcG = __builtin_amdgcn_make_buffer_rsrc((void*)F.hg_out_g, 0, 512 * 4, 0x00020000), rsrcSS = __builtin_amdgcn_make_buffer_rsrc((void*)(F.ws + WS_SSEG), 0, 256 * 128 * 128 * 4, 0x00020000), rsrcDS = __builtin_amdgcn_make_buffer_rsrc((void*)(F.ws + WS_DSEG), 0, 256 * 128 * 4, 0x00020000);
    const __amdgpu_buffer_rsrc_t rsrcD = __builtin_amdgcn_make_buffer_rsrc((void*)DEC, 0, 64 * 32 * 128 * 4, 0x00020000), rsrcM = __builtin_amdgcn_make_buffer_rsrc((void*)MIX, 0, (int)((size_t)T * D * 2), 0x00020000);
    const __amdgpu_buffer_rsrc_t rsrcK = __builtin_amdgcn_make_buffer_rsrc((void*)KVS, 0, 64 * 32 * 128 * 128 * 2, 0x00020000); const unsigned kvo = (unsigned)((se * 128 + sq * 32) * 2);
#define HG_LOADKV(dst_, item_) do { const unsigned so_ = (unsigned)__builtin_amdgcn_readfirstlane((int)((item_) * (128 * 128 * 2))); _Pragma("unroll") for (int j_ = 0; j_ < 4; ++j_) (dst_)[j_] = __builtin_bit_cast(v4u, __builtin_amdgcn_raw_buffer_load_b128(rsrcK, kvo + 16u * j_, so_, 0)); } while (0)
#define HG_LOADST(item_) HG_LOADKV(st, item_)
#define HG_FOLD(kv_, c_) do { _Pragma("unroll") for (int j_ = 0; j_ < 4; ++j_) { const f32x4 d0_ = *(const LAS f32x4*)(decs + (c_) * 128 + sq * 32 + 8 * j_), d1_ = *(const LAS f32x4*)(decs + (c_) * 128 + sq * 32 + 8 * j_ + 4); const v4u k_ = (kv_)[j_]; \
        S[8 * j_ + 0] = d0_.x * S[8 * j_ + 0] + bflo(k_.x); S[8 * j_ + 1] = d0_.y * S[8 * j_ + 1] + bfhi(k_.x); S[8 * j_ + 2] = d0_.z * S[8 * j_ + 2] + bflo(k_.y); S[8 * j_ + 3] = d0_.w * S[8 * j_ + 3] + bfhi(k_.y); \
        S[8 * j_ + 4] = d1_.x * S[8 * j_ + 4] + bflo(k_.z); S[8 * j_ + 5] = d1_.y * S[8 * j_ + 5] + bfhi(k_.z); S[8 * j_ + 6] = d1_.z * S[8 * j_ + 6] + bflo(k_.w); S[8 * j_ + 7] = d1_.w * S[8 * j_ + 7] + bfhi(k_.w); } } while (0)
    for (int wg = blockIdx.x; wg < 256; wg += F.G) {
        const int bh = wg >> 2, seg = wg & 3, item0 = bh * 32 + seg * 8, b = bh >> 2, h = bh & 3;
        if (F.tid < 256) { const unsigned so = (unsigned)__builtin_amdgcn_readfirstlane((bh * 32 + seg * 8) * 128 * 4);
            *((LAS f32x4*)(L + HG_DECS) + F.tid) = __builtin_bit_cast(f32x4, __builtin_amdgcn_raw_buffer_load_b128(rsrcD, (unsigned)F.tid * 16u, so, 0)); }
        __syncthreads();
        const float lbv = hg_lbound(F, h, d);
        float S[32];
#pragma unroll
        for (int j = 0; j < 32; ++j) S[j] = 0.f;
        for (int sp = 0; sp < seg; ++sp) {
            const unsigned sso = (unsigned)__builtin_amdgcn_readfirstlane((bh * 4 + sp) * 128 * 128 * 4), dso = (unsigned)__builtin_amdgcn_readfirstlane((bh * 4 + sp) * 128 * 4);
#pragma unroll
            for (int j0 = 0; j0 < 8; j0 += 4) { f32x4 sv[4], dv[4];
#pragma unroll
                for (int j = 0; j < 4; ++j) { sv[j] = __builtin_bit_cast(f32x4, __builtin_amdgcn_raw_buffer_load_b128(rsrcSS, (unsigned)((se * 128 + sq * 32) * 4) + 16u * (j0 + j), sso, 0));
                    dv[j] = __builtin_bit_cast(f32x4, __builtin_amdgcn_raw_buffer_load_b128(rsrcDS, (unsigned)(sq * 32 * 4) + 16u * (j0 + j), dso, 0)); }
#pragma unroll
                for (int j = 0; j < 4; ++j) { const int q = 4 * (j0 + j); S[q + 0] = dv[j].x * S[q + 0] + sv[j].x; S[q + 1] = dv[j].y * S[q + 1] + sv[j].y; S[q + 2] = dv[j].z * S[q + 2] + sv[j].z; S[q + 3] = dv[j].w * S[q + 3] + sv[j].w; } }
        }
        HG_LOADT(rf, item0, 1); HG_LOADT(rq, item0, 0); HG_LOADT(rv, item0, 2); HG_LOADST(item0);
      for (int k = 0; k < 8; ++k) {
        const int item = item0 + k, c = seg * 8 + k;
        const int tb = F.wave & 1, eb = F.wave >> 1;
        const int nit = k < 7 ? item + 1 : item;
        HG_PUT(rf, RAWF); HG_PUT(rq, RAWQ); HG_PUT(rv, RAWV);
        __syncthreads();
        HG_LOADT(rf, nit, 1); HG_LOADT(rq, nit, 0); HG_LOADT(rv, nit, 2); __builtin_amdgcn_sched_barrier(0);
        unsigned short ffr[16], qr[16], vr[16]; HG_COL(ffr, RAWF); HG_COL(qr, RAWQ); HG_COL(vr, RAWV);
        float bb[16], kk[16], total; hg_gates(F, ffr, lbv, d, tq, bb, kk, total);
        float vv[16];
#pragma unroll
        for (int i = 0; i < 16; ++i) { const int t = 16 * tq + i; const float q = bf2f(qr[i]);
            *(LAS unsigned short*)(L + HG_QE + t * 272 + 2 * d) = (unsigned short)pkbf(q * __expf(bb[i]), 0.f);
            *(LAS unsigned short*)(L + HG_KE + t * 272 + 2 * d) = (unsigned short)pkbf(kk[i] * __expf(-bb[i]), 0.f);
            vv[i] = bf2f(vr[i]); }
        st16<true>(L + HG_VT + d * 144 + tq * 32, vv);
#pragma unroll
        for (int j = 0; j < 4; ++j) { v4u w4; w4.x = pkbf(S[8 * j + 0], S[8 * j + 1]); w4.y = pkbf(S[8 * j + 2], S[8 * j + 3]); w4.z = pkbf(S[8 * j + 4], S[8 * j + 5]); w4.w = pkbf(S[8 * j + 6], S[8 * j + 7]);
            *(LAS v4u*)(L + HG_ST + se * 272 + sq * 64 + 16 * j) = w4; }
        HG_FOLD(st, k);
        unsigned long long grv[4];
        { const bf16* grow_ = PHp + (((size_t)(3 * 16 + b) * 4 + h) * SEQ + c * 64 + tb * 32 + r) * 128;
#pragma unroll
            for (int g = 0; g < 4; ++g) grv[g] = *(const GAS unsigned long long*)(grow_ + eb * 32 + 8 * g + 4 * hh); }
        HG_LOADST(nit); __builtin_amdgcn_sched_barrier(0);
        __syncthreads();
        f32x16 acc;
#pragma unroll
        for (int i = 0; i < 16; ++i) acc[i] = 0.f;
#define HG_QF(s_) (*(const LAS bf16x8*)(L + HG_QE + (tb * 32 + r) * 272 + 32 * (s_) + 16 * hh))
#pragma unroll
        for (int s = 0; s < 8; ++s) acc = MFMA32(*(const LAS bf16x8*)(L + HG_ST + (eb * 32 + r) * 272 + 32 * s + 16 * hh), HG_QF(s), acc);
        for (int sb = 0; sb <= tb; ++sb) {
            f32x16 at;
#pragma unroll
            for (int i = 0; i < 16; ++i) at[i] = 0.f;
#pragma unroll
            for (int s = 0; s < 8; ++s) at = MFMA32(*(const LAS bf16x8*)(L + HG_KE + (sb * 32 + r) * 272 + 32 * s + 16 * hh), HG_QF(s), at);
            float a[16];
#pragma unroll
            for (int i = 0; i < 16; ++i) a[i] = (sb < tb || crow16(i, hh) <= r) ? at[i] : 0.f;
            const bf16x8 ab0 = pack8(a[0], a[1], a[2], a[3], a[4], a[5], a[6], a[7]), ab1 = pack8(a[8], a[9], a[10], a[11], a[12], a[13], a[14], a[15]);
            acc = MFMA32(*(const LAS bf16x8*)(L + HG_VT + (eb * 32 + r) * 144 + sb * 64 + 0 + 16 * hh), ab0, acc);
            acc = MFMA32(*(const LAS bf16x8*)(L + HG_VT + (eb * 32 + r) * 144 + sb * 64 + 32 + 16 * hh), ab1, acc);
        }
        float ss = 0.f;
#pragma unroll
        for (int i = 0; i < 16; ++i) ss += acc[i] * acc[i];
        ss += __shfl_xor(ss, 32);
        LAS float* ssq = (LAS float*)(L + HG_SSQ);
        if (hh == 0) ssq[eb * 64 + tb * 32 + r] = ss;
        f32x4 ggv[4];
        { const unsigned so = (unsigned)__builtin_amdgcn_readfirstlane(h * 512);
#pragma unroll
            for (int g = 0; g < 4; ++g) ggv[g] = __builtin_bit_cast(f32x4, __builtin_amdgcn_raw_buffer_load_b128(rsrcG, (unsigned)((eb * 32 + 8 * g + 4 * hh) * 4), so, 0)); }
        __syncthreads();
        const int tl = tb * 32 + r; const float tot = (ssq[tl] + ssq[64 + tl]) + (ssq[128 + tl] + ssq[192 + tl]);
        const float rs = 1.f / sqrtf(tot * (1.f / 128.f) + EPS);
        const unsigned mso = (unsigned)__builtin_amdgcn_readfirstlane((int)((((unsigned)b * SEQ + c * 64) * D + 512 + h * 128) * 2)), mvo = (unsigned)((tl * D + eb * 32 + 4 * hh) * 2);
#pragma unroll
        for (int g = 0; g < 4; ++g) { const int e = eb * 32 + 8 * g + 4 * hh; const unsigned long long gr = grv[g]; const f32x4 gg = ggv[g];
            const float g0 = bflo((unsigned)gr), g1 = bfhi((unsigned)gr), g2 = bflo((unsigned)(gr >> 32)), g3 = bfhi((unsigned)(gr >> 32));
            const float y0 = acc[4 * g + 0] * rs * gg.x * (g0 * __builtin_amdgcn_rcpf(1.f + __expf(-g0))), y1 = acc[4 * g + 1] * rs * gg.y * (g1 * __builtin_amdgcn_rcpf(1.f + __expf(-g1)));
            const float y2 = acc[4 * g + 2] * rs * gg.z * (g2 * __builtin_amdgcn_rcpf(1.f + __expf(-g2))), y3 = acc[4 * g + 3] * rs * gg.w * (g3 * __builtin_amdgcn_rcpf(1.f + __expf(-g3)));
            typedef unsigned u32x2_t __attribute__((ext_vector_type(2))); __builtin_amdgcn_raw_buffer_store_b64((u32x2_t){pkbf(y0, y1), pkbf(y2, y3)}, rsrcM, mvo + 16u * g, mso, 0); }
        __syncthreads();
      }
    }
#undef HG_LOADST
#undef HG_LOADKV
#undef HG_FOLD
#undef HG_QF
}
#undef HG_LOADT
#undef HG_PUT
#undef HG_COL
#undef HG_ARR
#undef HG_SOFF
#undef HG_HV

__device__ __forceinline__ void router_phase(Frame& F) {
    LAS unsigned char* L = F.lds; const int r = F.lane & 31, hh = F.lane >> 5;
    LAS unsigned* lcnt = (LAS unsigned*)(F.lds + LTAB_OFF) + LT_MISC; LAS unsigned* lbase = lcnt + 32; LAS float* lrstd = (LAS float*)(F.lds + ROWTAB_OFF);
    float* TOPG = (float*)(F.ws + WS_TOPG);
    for (int idx = F.tid; idx < 32768; idx += NWAVES * 64) { const int k = idx >> 5, e = idx & 31; const float w = F.w_router[idx] * F.norm2_g[k];
        const unsigned hi = pkbf(w, 0.f) & 0xffffu; const unsigned lo = pkbf(w - bflo(hi), 0.f) & 0xffffu;
        *(LAS unsigned short*)(L + e * RT_ROW + 2 * k) = (unsigned short)hi; *(LAS unsigned short*)(L + RT_WL + e * RT_ROW + 2 * k) = (unsigned short)lo; }
    const bf16* XH = (const bf16*)(F.ws + WS_XN); int* LIST = (int*)(F.ws + WS_LIST); unsigned* cnt = (unsigned*)(F.ctl + CW_CNT);
    for (int base = blockIdx.x * 4; base < T / 32; base += F.G * 4) {
        const int grp = base + F.wave; const bool active = F.wave < 4 && grp < T / 32;
        if (F.tid < 32) lcnt[F.tid] = 0u;
        __syncthreads();
        float sv[4] = {0.f, 0.f, 0.f, 0.f}; int se[4] = {0, 0, 0, 0}; unsigned lp0 = 0u, lp1 = 0u; float rstd = 0.f; const int tok = grp * 32 + r;
        if (active) {
            const bf16* hrow = XH + (size_t)tok * D + 8 * hh;
            f32x16 acc;
#pragma unroll
            for (int i = 0; i < 16; ++i) acc[i] = 0.f;
            float ssq = 0.f;
#pragma unroll 16
            for (int s = 0; s < 64; ++s) {
                const v4u hu = *(const GAS v4u*)(hrow + 16 * s); const bf16x8 hi = __builtin_bit_cast(bf16x8, hu);
                { const float a0 = bflo(hu.x), a1 = bfhi(hu.x), a2 = bflo(hu.y), a3 = bfhi(hu.y), a4 = bflo(hu.z), a5 = bfhi(hu.z), a6 = bflo(hu.w), a7 = bfhi(hu.w);
                    ssq += (a0 * a0 + a1 * a1) + (a2 * a2 + a3 * a3) + (a4 * a4 + a5 * a5) + (a6 * a6 + a7 * a7); }
                const bf16x8 wh = *(const LAS bf16x8*)(L + r * RT_ROW + 32 * s + 16 * hh), wl = *(const LAS bf16x8*)(L + RT_WL + r * RT_ROW + 32 * s + 16 * hh);
                acc = MFMA32(wh, hi, acc); acc = MFMA32(wl, hi, acc);
            }
            ssq += __shfl_xor(ssq, 32);
            rstd = 1.f / sqrtf(ssq * (1.f / D) + EPS);
            float l[16];
#pragma unroll
            for (int i = 0; i < 16; ++i) l[i] = acc[i] * rstd + F.b_router[crow16(i, hh)];
            float cv[8]; int ce[8];
#pragma unroll
            for (int rnd = 0; rnd < 4; ++rnd) { float bv = l[0]; int bi = 0;
#pragma unroll
                for (int i = 1; i < 16; ++i) if (l[i] > bv) { bv = l[i]; bi = i; }
                cv[rnd] = bv; ce[rnd] = crow16(bi, hh);
#pragma unroll
                for (int i = 0; i < 16; ++i) if (i == bi) l[i] = -__builtin_inff(); }
#pragma unroll
            for (int j = 0; j < 4; ++j) { cv[4 + j] = __shfl_xor(cv[j], 32); ce[4 + j] = __shfl_xor(ce[j], 32); }
#pragma unroll
            for (int rnd = 0; rnd < 4; ++rnd) { float bv = cv[0]; int be = ce[0]; int bj = 0;
#pragma unroll
                for (int j = 1; j < 8; ++j) if (cv[j] > bv || (cv[j] == bv && ce[j] < be)) { bv = cv[j]; be = ce[j]; bj = j; }
                sv[rnd] = bv; se[rnd] = be;
#pragma unroll
                for (int j = 0; j < 8; ++j) if (j == bj) { cv[j] = -__builtin_inff(); ce[j] = 64; } }
            lp0 = __hip_atomic_fetch_add(lcnt + (hh ? se[2] : se[0]), 1u, __ATOMIC_RELAXED, __HIP_MEMORY_SCOPE_WORKGROUP);
            lp1 = __hip_atomic_fetch_add(lcnt + (hh ? se[3] : se[1]), 1u, __ATOMIC_RELAXED, __HIP_MEMORY_SCOPE_WORKGROUP);
        }
        __syncthreads();
        if (F.tid < 32) lbase[F.tid] = __hip_atomic_fetch_add(cnt + F.tid, lcnt[F.tid], __ATOMIC_RELAXED, __HIP_MEMORY_SCOPE_AGENT);
        __syncthreads();
        if (active) {
            const float e1 = __expf(sv[1] - sv[0]), e2 = __expf(sv[2] - sv[0]), e3 = __expf(sv[3] - sv[0]); const float inv = 1.f / (1.f + e1 + e2 + e3);
            const int ea = hh ? se[2] : se[0], eb = hh ? se[3] : se[1]; const float ga = (hh ? e2 : 1.f) * inv, gb = (hh ? e3 : e1) * inv;
            const size_t ia = (size_t)ea * 32768 + lbase[ea] + lp0, ib = (size_t)eb * 32768 + lbase[eb] + lp1;
            LIST[ia] = tok * 4 + 2 * hh; LIST[ib] = tok * 4 + 2 * hh + 1; TOPG[tok * 4 + 2 * hh] = ga; TOPG[tok * 4 + 2 * hh + 1] = gb;
            if (hh == 0) lrstd[F.wave * 32 + r] = rstd;
        }
        __syncthreads();
        {
            unsigned char* X8 = F.ws + WS_X8; const int t0 = base * 32;
#pragma unroll
            for (int q0 = 0; q0 < 16; q0 += 4) { v4u a[4][2];
#pragma unroll
                for (int q = 0; q < 4; ++q) { const int tt = t0 + F.wave * 16 + q0 + q; const GAS v4u* p = (const GAS v4u*)(XH + (size_t)(tt < T ? tt : 0) * D) + 2 * F.lane; a[q][0] = p[0]; a[q][1] = p[1]; }
#pragma unroll
                for (int q = 0; q < 4; ++q) { const int tl = F.wave * 16 + q0 + q, tt = t0 + tl; if (tt < T) { const float rs = lrstd[tl]; v4u o;
                    o.x = pg8::pk4_fp8(bflo(a[q][0].x) * rs, bfhi(a[q][0].x) * rs, bflo(a[q][0].y) * rs, bfhi(a[q][0].y) * rs); o.y = pg8::pk4_fp8(bflo(a[q][0].z) * rs, bfhi(a[q][0].z) * rs, bflo(a[q][0].w) * rs, bfhi(a[q][0].w) * rs);
                    o.z = pg8::pk4_fp8(bflo(a[q][1].x) * rs, bfhi(a[q][1].x) * rs, bflo(a[q][1].y) * rs, bfhi(a[q][1].y) * rs); o.w = pg8::pk4_fp8(bflo(a[q][1].z) * rs, bfhi(a[q][1].z) * rs, bflo(a[q][1].w) * rs, bfhi(a[q][1].w) * rs);
                    *((GAS v4u*)(X8 + (size_t)tt * D) + F.lane) = o; } } }
        }
        __syncthreads();
    }
}
__device__ __forceinline__ int build_moe_tables(Frame& F, int ntn, int mode) {
    LAS int* lt = (LAS int*)(F.lds + LTAB_OFF);
    if (F.wave == 0) {
        const int e = F.lane & 31; const int c = (int)__hip_atomic_load((unsigned*)(F.ctl + CW_CNT) + e, __ATOMIC_RELAXED, __HIP_MEMORY_SCOPE_AGENT);
        const int tl = (c + 255) >> 8; int inc = tl;
#pragma unroll
        for (int off = 1; off < 32; off <<= 1) { const int o = __shfl_up(inc, off, 32); if (e >= off) inc += o; }
        const int tot = __shfl(inc, 31, 32), t0 = inc - tl;
        if (F.lane < 32) { lt[LT_TS + e] = t0; lt[LT_CNT + e] = c; for (int i = 0; i < tl; ++i) lt[t0 + i] = e; }
        if (F.lane == 0) lt[LT_MISC + 64] = tot;
    }
    __syncthreads();
    int nt = lt[LT_MISC + 64]; nt = nt < 0 ? 0 : (nt > MAXTILES ? MAXTILES : nt); nt = __builtin_amdgcn_readfirstlane(nt);
    const int* LIST = (const int*)(F.ws + WS_LIST);
    const int nslot = mode == 1 ? MAXSLOT : (MAXTILES * 4 + 255) / 256;
    for (int q = F.tid; q < nslot * 256; q += NWAVES * 64) { const int i = q >> 8, rr = q & 255; const int Lu = i * F.G + F.vcu;
        int li = -1; float bias = 0.f;
        if (Lu < nt * ntn) { const int pm0 = Lu / ntn, pl = Lu - pm0 * ntn, pm = mode == 2 ? nt - 1 - pm0 : pm0, e = lt[pm], idx = (pm - lt[LT_TS + e]) * 256 + rr; if (idx < lt[LT_CNT + e]) li = LIST[(size_t)e * 32768 + idx];
            bias = mode == 1 ? F.b_gu[(size_t)e * 2048 + (rr >> 7) * 1024 + pl * 128 + (rr & 127)] : F.b_d[(size_t)e * 1024 + pl * 256 + rr]; }
        ((LAS float*)(F.lds + ROWTAB_OFF))[q] = bias;
        if (mode == 1) ((LAS unsigned short*)(F.lds + ROWTAB2_OFF))[q] = (unsigned short)(li < 0 ? 0 : (li >> 2));
        else ((LAS int*)(F.lds + ROWTAB_OFF) + nslot * 256)[q] = li; }
    __syncthreads();
    return nt;
}
__device__ __forceinline__ void combine_phase(Frame& F) {
    const unsigned char* YK = F.ws + WS_YK; const bf16* XH = (const bf16*)(F.ws + WS_XN); const float* TOPG = (const float*)(F.ws + WS_TOPG);
    for (int t = F.gw; t < T; t += F.ngw) {
        GAS f32x4* xr = (GAS f32x4*)(F.out + (size_t)t * D) + F.lane; f32x4 v[4]; unsigned y[4][4]; const f32x4 gt = *((const GAS f32x4*)TOPG + t + vzero()) * (1.0f / Y8_SCALE);
#pragma unroll
        for (int j = 0; j < 4; ++j) { const unsigned long long xh = __builtin_nontemporal_load((const GAS unsigned long long*)(XH + (size_t)t * D) + F.lane + 64 * j);
            v[j] = (f32x4){bflo((unsigned)xh), bfhi((unsigned)xh), bflo((unsigned)(xh >> 32)), bfhi((unsigned)(xh >> 32))};
#pragma unroll
            for (int k = 0; k < 4; ++k) y[j][k] = __builtin_nontemporal_load((const GAS unsigned*)(YK + ((size_t)t * 4 + k) * D) + F.lane + 64 * j); }
#pragma unroll
        for (int j = 0; j < 4; ++j) { f32x4 s4 = {0.f, 0.f, 0.f, 0.f};
#pragma unroll
            for (int k = 0; k < 4; ++k) { const f32x2n_ lo = __builtin_amdgcn_cvt_pk_f32_fp8((int)y[j][k], false), hi = __builtin_amdgcn_cvt_pk_f32_fp8((int)y[j][k], true); const float g = gt[k]; s4.x += g * lo.x; s4.y += g * lo.y; s4.z += g * hi.x; s4.w += g * hi.y; }
            v[j] = v[j] + s4;
            __builtin_nontemporal_store(v[j], xr + 64 * j); }
    }
}

constexpr int NPH = 9;
struct Args { const float* in[16]; float* out; unsigned char* ws; int ph_lo, ph_hi; };
__global__ void __launch_bounds__(NWAVES * 64, 2) fwd(Args args) {
    extern __shared__ __attribute__((aligned(16))) unsigned char lds[];
    Frame F;
    F.lds = (LAS unsigned char*)lds;
    F.MISC = (volatile LAS unsigned*)(F.lds + MISC_OFF);
    F.tid = threadIdx.x; F.lane = F.tid & 63; F.wave = __builtin_amdgcn_readfirstlane(F.tid >> 6);
    F.G = gridDim.x; { const int bx = blockIdx.x; F.vcu = (F.G % 8 == 0) ? (bx % 8) * (F.G / 8) + bx / 8 : bx; }
    F.gw = blockIdx.x * NWAVES + F.wave; F.ngw = F.G * NWAVES;
    F.ws = args.ws; F.ctl = (gu32*)(args.ws + WS_CTL); F.out = args.out;
    F.x = args.in[0]; F.norm1_g = args.in[1]; F.w_in = args.in[2]; F.sb_q_g = args.in[3]; F.sb_k_g = args.in[4]; F.sb_out_g = args.in[5]; F.hg_lb = args.in[6]; F.hg_out_g = args.in[7];
    F.w_out = args.in[8]; F.norm2_g = args.in[9]; F.w_router = args.in[10]; F.b_router = args.in[11]; F.w_gu = args.in[12]; F.b_gu = args.in[13]; F.w_d = args.in[14]; F.b_d = args.in[15];
    for (int u = F.tid; u < (LDS_BYTES - LDSCTL_OFF) / 4; u += NWAVES * 64) ((LAS unsigned*)(F.lds + LDSCTL_OFF))[u] = 0u;
    __syncthreads();
    XcdBarrier bar; bar.bar = (unsigned*)(F.ctl + CW_BAR); bar.x = 0; bar.st = nullptr;
    if (MK_ONE_LAUNCH) bar = xcd_barrier_post((unsigned*)(F.ctl + CW_BAR), F.MISC + 8);
    const int lo = args.ph_lo, hi = args.ph_hi;
#define IN(k) (lo <= (k) && (k) < hi && ((F.lane = lane_id()), (F.tid = F.wave * 64 + F.lane), true))
#define SEAM(k) do { if (IN(k) && IN((k) + 1)) xcd_barrier(bar); } while (0)

    if (IN(0)) { p0_prologue(F); } SEAM(0);
    if (IN(1)) {
        pg8::Gemm g{(const bf16*)(F.ws + WS_XN), (const bf16*)(F.ws + WS_WIN), T, NIN, D}; pg8::StaticOrder S; S.init(T, NIN, F.G, (int)blockIdx.x);
        pg8::EpiInproj E{(bf16*)(F.ws + WS_P), (bf16*)(F.ws + WS_PH), (bf16*)(F.ws + WS_QN), (bf16*)(F.ws + WS_KN), F.sb_q_g, F.sb_k_g, QSCALE, EPS};
        pg8::gemm_phase<pg8::EpiInproj, pg8::StaticOrder, PG8_ALIGN, PG8_SP2>(F.lds + RING_OFF, g, S, E, F.tid);
    } SEAM(1);
    if (IN(2)) { prep_phase(F); __syncthreads(); hgA_phase(F); } SEAM(2);
    if (IN(3)) { attn_phase(F); hgC_phase(F); } SEAM(3);
    if (IN(4)) {
        pg8::Gemm g{(const bf16*)(F.ws + WS_MIX), (const bf16*)(F.ws + WS_WOUT), T, D, D}; pg8::StaticOrder S; S.init(T, D, F.G, (int)blockIdx.x);
        pg8::EpiRes E{F.x, (bf16*)(F.ws + WS_XN), D};
        pg8::gemm_phase<pg8::EpiRes, pg8::StaticOrder, PG8_ALIGN, PG8_SP2>(F.lds + RING_OFF, g, S, E, F.tid);
    } SEAM(4);
    if (IN(5)) { router_phase(F); } SEAM(5);
    if (IN(6)) {
        const int nt = build_moe_tables(F, 8, 1); const LAS int* lt = (const LAS int*)(F.lds + LTAB_OFF);
        pg8::Gemm g{(const bf16*)(F.ws + WS_X8), (const bf16*)(F.ws + WS_WGU), MAXROWS, NE * 2048, D / 2};
        pg8::MoeOrder S{lt, (const LAS unsigned short*)(F.lds + ROWTAB2_OFF), 8, nt * 8, F.G, F.vcu, 1024u, 0};
        pg8::EpiAct<true> E{F.ws + WS_ACT, (const LAS float*)(F.lds + ROWTAB_OFF), A8_SCALE};
        pg8::gemm_phase<pg8::EpiAct<true>, pg8::MoeOrder, PG8_ALIGN, PG8_SP2, true, SC_W8, SC_ONE>(F.lds + RING_OFF, g, S, E, F.tid);
    } SEAM(6);
    if (IN(7)) {
        const int nt = build_moe_tables(F, 4, 2); const LAS int* lt = (const LAS int*)(F.lds + LTAB_OFF);
        pg8::Gemm g{(const bf16*)(F.ws + WS_ACT), (const bf16*)(F.ws + WS_WD), MAXROWS, NE * 1024, D / 2};
        pg8::MoeOrder S{lt, nullptr, 4, nt * 4, F.G, F.vcu, 1024u, nt};
        pg8::EpiDown E{F.ws + WS_YK, (const LAS int*)(F.lds + ROWTAB_OFF) + ((MAXTILES * 4 + 255) / 256) * 256, (const LAS float*)(F.lds + ROWTAB_OFF), Y8_SCALE};
        pg8::gemm_phase<pg8::EpiDown, pg8::MoeOrder, PG8_ALIGN, PG8_SP2, true, SC_W8Y, SC_A8>(F.lds + RING_OFF, g, S, E, F.tid);
    } SEAM(7);
    if (IN(8)) { combine_phase(F); }
#undef IN
#undef SEAM
}

extern "C" void kernel_launch(void* const* d_in, const int* in_sizes, int n_in, void* d_out, int out_size, void* d_ws, size_t ws_size, hipStream_t stream) {
    static int grid = 0;
    if (grid == 0) {
        if (n_in != 16 || in_sizes[0] != T * D || out_size != T * D || ws_size < WS_END) { fprintf(stderr, "kernel_launch: shape/workspace mismatch (n_in %d, ws %zu, need %zu); nothing launched\n", n_in, ws_size, (size_t)WS_END); grid = -1; return; }
        int dev = 0, cus = 0, per_cu = 0;
        if (hipGetDevice(&dev) != hipSuccess || hipDeviceGetAttribute(&cus, hipDeviceAttributeMultiprocessorCount, dev) != hipSuccess) { grid = -1; return; }
        if (hipFuncSetAttribute((const void*)fwd, hipFuncAttributeMaxDynamicSharedMemorySize, LDS_BYTES) != hipSuccess) { grid = -1; return; }
        if (hipOccupancyMaxActiveBlocksPerMultiprocessor(&per_cu, (const void*)fwd, NWAVES * 64, LDS_BYTES) != hipSuccess || per_cu < 1) { fprintf(stderr, "kernel_launch: occupancy query says %d\n", per_cu); }
        (void)hipGetLastError();
        if ((MAXTILES * 8 + cus - 1) / cus > MAXSLOT || cus < 1) { fprintf(stderr, "kernel_launch: %d CUs: the per-workgroup unit tables are sized for 256\n", cus); grid = -1; return; }
        grid = cus;
    }
    if (grid < 0) return;
    if (hipMemsetAsync((char*)d_ws + WS_CTL, 0, CTL_ZERO_BYTES, stream) != hipSuccess) return;
    Args a{};
    for (int i = 0; i < 16; ++i) a.in[i] = (const float*)d_in[i];
    a.out = (float*)d_out; a.ws = (unsigned char*)d_ws;
#if MK_ONE_LAUNCH
    a.ph_lo = 0; a.ph_hi = NPH;
    hipLaunchKernelGGL(fwd, dim3(grid), dim3(NWAVES * 64), LDS_BYTES, stream, a);
#else
    for (int p = 0; p < NPH; ++p) { a.ph_lo = p; a.ph_hi = p + 1; hipLaunchKernelGGL(fwd, dim3(grid), dim3(NWAVES * 64), LDS_BYTES, stream, a); }
#endif
}
```

```cpp
#include <hip/hip_runtime.h>
#include <cstdio>
#include <cstdint>
namespace pg8 {
#define PG8_LAS __attribute__((address_space(3)))
typedef unsigned short bf16_t;
typedef short bf16x8 __attribute__((ext_vector_type(8)));
typedef float f32x4 __attribute__((ext_vector_type(4)));
typedef unsigned u32x4 __attribute__((ext_vector_type(4)));
typedef int i32x4_t __attribute__((ext_vector_type(4)));
typedef int i32x8_t __attribute__((ext_vector_type(8)));
constexpr int BM = 256, BK = 64, HALF = 128, HTB = HALF * BK * 2  , STAGE_BYTES = 8 * HTB, NXCD = 8, WGM = 8;

__host__ __device__ __forceinline__ int lds_byte(int r, int c) { const int st = (r >> 4) * 2 + (c >> 5), rr = r & 15, cc = c & 31, ob = rr * 64 + cc * 2; return st * 1024 + (ob ^ (((ob >> 9) & 1) << 5)); }
__host__ __device__ __forceinline__ void stage_rc(int b, int& R, int& C) { const int st = b / 1024, sb = b % 1024, swz = sb ^ (((sb >> 9) & 1) << 5); R = (st >> 1) * 16 + swz / 64; C = (st & 1) * 32 + (swz % 64) / 2; }
__host__ __device__ __forceinline__ int perm32(int rho) { const int n = rho >> 4, i = rho & 15; return 8 * (i >> 2) + 4 * n + (i & 3); }

struct Unit { int pm, pn, slot; };
struct Gemm { const bf16_t* A; const bf16_t* Bt; int M, N, K; };

struct StaticOrder {
    int nM, nN, nwg, G, c;
    __host__ __device__ void init(int M, int N, int G_, int c_) { nM = M / BM; nN = N / BM; nwg = nM * nN; G = G_; c = c_; }
    __host__ __device__ bool next(int i, Unit& u) const {
        const long L = (long)i * G + c; if (L >= nwg) return false;
        int wgid = (int)L; { const int q = nwg / NXCD, r = nwg % NXCD, xcd = wgid % NXCD, off = wgid / NXCD; wgid = (xcd < r ? xcd * (q + 1) : r * (q + 1) + (xcd - r) * q) + off; }
        const int nig = WGM * nN, gid = wgid / nig, fm = gid * WGM, gsz = (nM - fm) < WGM ? (nM - fm) : WGM;
        u.pm = fm + ((wgid % nig) % gsz); u.pn = (wgid % nig) / gsz; return true;
    }
    __device__ __forceinline__ void a_ready(const Unit&) const {}
    __device__ __forceinline__ void done(const Unit&) const {}
};

__device__ __forceinline__ unsigned cvt_pk_bf16(float lo, float hi) { unsigned r; asm volatile("v_cvt_pk_bf16_f32 %0, %1, %2" : "=v"(r) : "v"(lo), "v"(hi)); return r; }
typedef float f32x2 __attribute__((ext_vector_type(2)));
__device__ __forceinline__ f32x2 gelu_pk(f32x2 v) {
    const f32x2 av = __builtin_elementwise_abs(v), d = av * 0.2316418882f + 1.0f;
    f32x2 t; t.x = __builtin_amdgcn_rcpf(d.x); t.y = __builtin_amdgcn_rcpf(d.y);
    f32x2 q = t * 0.5307027145f + (-0.7265760135f); q = q * t + 0.7107068705f; q = q * t + (-0.142248368f); q = q * t + 0.127414796f; q = q * t;
    const f32x2 s = (v * v) * (-0.72134752044f);
    f32x2 e; e.x = __builtin_amdgcn_exp2f(s.x); e.y = __builtin_amdgcn_exp2f(s.y);
    const f32x2 m = v * (q * e), r = v - m;
    f32x2 o; o.x = v.x < 0.f ? m.x : r.x; o.y = v.y < 0.f ? m.y : r.y; return o;
}

template <int ACT  > struct EpiBf16 {
    static constexpr bool PERM = true, AFTER_DRAIN = false, HAS_INIT = false; static_assert(ACT == 0 || ACT == 1, "EpiBf16: ACT is 0 (none) or 1 (gelu_pk)");
    bf16_t* O; int ldc; const float* bias; int split_cols; size_t split_stride; float scale0;
    __device__ __forceinline__ void operator()(const f32x4 (&acc)[2][2][4][2], const Unit& u, int wr, int wc, int fr, int fq) const {
        const int row0 = u.pm * BM + wr * 64 + fr; int colt = u.pn * BM; bf16_t* base = O;
        float sc = 1.f; if (split_cols) { const int t = colt / split_cols; base += (size_t)t * split_stride; colt -= t * split_cols; if (t == 0) sc = scale0; }
        const int col0 = colt + wc * 32 + 8 * fq, bcol0 = u.pn * BM + wc * 32 + 8 * fq;
        f32x4 bv[2][2];
#pragma unroll
        for (int bj = 0; bj < 2; ++bj)
#pragma unroll
            for (int n = 0; n < 2; ++n) bv[bj][n] = bias ? *(const f32x4*)(bias + bcol0 + bj * HALF + 4 * n) : (f32x4){0.f, 0.f, 0.f, 0.f};
#pragma unroll
        for (int ai = 0; ai < 2; ++ai)
#pragma unroll
            for (int m = 0; m < 4; ++m) { bf16_t* rowp = base + (size_t)(row0 + ai * HALF + m * 16) * ldc + col0;
#pragma unroll
                for (int bj = 0; bj < 2; ++bj) { f32x4 v0 = acc[ai][bj][m][0] + bv[bj][0], v1 = acc[ai][bj][m][1] + bv[bj][1];
                    if (ACT == 1) { f32x2 a = gelu_pk((f32x2){v0[0], v0[1]}), b = gelu_pk((f32x2){v0[2], v0[3]}), c = gelu_pk((f32x2){v1[0], v1[1]}), d = gelu_pk((f32x2){v1[2], v1[3]});
                        v0 = (f32x4){a.x, a.y, b.x, b.y}; v1 = (f32x4){c.x, c.y, d.x, d.y}; }
                    v0 = v0 * sc; v1 = v1 * sc; u32x4 w; w.x = cvt_pk_bf16(v0[0], v0[1]); w.y = cvt_pk_bf16(v0[2], v0[3]); w.z = cvt_pk_bf16(v1[0], v1[1]); w.w = cvt_pk_bf16(v1[2], v1[3]);
                    *(u32x4*)(rowp + bj * HALF) = w; } }
    }
};

__device__ __forceinline__ unsigned pk4_fp8(float a, float b, float c, float d) {
    a = fminf(fmaxf(a, -448.f), 448.f); b = fminf(fmaxf(b, -448.f), 448.f); c = fminf(fmaxf(c, -448.f), 448.f); d = fminf(fmaxf(d, -448.f), 448.f);
    int p = 0; p = __builtin_amdgcn_cvt_pk_fp8_f32(a, b, p, false); p = __builtin_amdgcn_cvt_pk_fp8_f32(c, d, p, true); return (unsigned)p;
}
struct EpiRes {
    static constexpr bool PERM = false, AFTER_DRAIN = false, HAS_INIT = false;
    const float* __restrict__ X; bf16_t* __restrict__ XH; int ldc;
    __device__ __forceinline__ void operator()(const f32x4 (&acc)[2][2][4][2], const Unit& u, int wr, int wc, int fr, int fq) const {
        const int row0 = u.pm * BM + wr * 64 + fr, col0 = u.pn * BM + wc * 32 + 4 * fq;
#pragma unroll
        for (int ai = 0; ai < 2; ++ai)
#pragma unroll
            for (int mp = 0; mp < 2; ++mp) { f32x4 xv[2][2][2];
#pragma unroll
                for (int mm = 0; mm < 2; ++mm) { const size_t off = (size_t)(row0 + ai * HALF + (2 * mp + mm) * 16) * ldc + col0;
#pragma unroll
                    for (int bj = 0; bj < 2; ++bj)
#pragma unroll
                        for (int n = 0; n < 2; ++n) xv[mm][bj][n] = __builtin_nontemporal_load((const f32x4*)(X + off + bj * HALF + n * 16)); }
#pragma unroll
                for (int mm = 0; mm < 2; ++mm) { const size_t off = (size_t)(row0 + ai * HALF + (2 * mp + mm) * 16) * ldc + col0;
#pragma unroll
                    for (int bj = 0; bj < 2; ++bj)
#pragma unroll
                        for (int n = 0; n < 2; ++n) { const size_t o2 = off + bj * HALF + n * 16; const f32x4 v = xv[mm][bj][n] + acc[ai][bj][2 * mp + mm][n];
                            *(unsigned long long*)(XH + o2) = (unsigned long long)cvt_pk_bf16(v[0], v[1]) | ((unsigned long long)cvt_pk_bf16(v[2], v[3]) << 32); } } }
    }
};
struct EpiInproj {
    static constexpr bool PERM = true, AFTER_DRAIN = false, HAS_INIT = false;
    bf16_t* PA; bf16_t* PH; bf16_t* QN; bf16_t* KN; const float* gq; const float* gk; float qscale, eps;
    __device__ __forceinline__ void operator()(const f32x4 (&acc)[2][2][4][2], const Unit& u, int wr, int wc, int fr, int fq) const {
        if (u.pn < 4) {
            const int arr = u.pn >> 1, hd = (u.pn & 1) * 4 + wc; const float* g = arr ? gk : gq; const float gs = arr ? 1.f : qscale; bf16_t* dst = arr ? KN : QN;
            f32x4 gv[2][2];
#pragma unroll
            for (int bj = 0; bj < 2; ++bj)
#pragma unroll
                for (int n = 0; n < 2; ++n) gv[bj][n] = *(const f32x4*)(g + 32 * bj + 8 * fq + 4 * n) * gs;
#pragma unroll
            for (int ai = 0; ai < 2; ++ai)
#pragma unroll
                for (int m = 0; m < 4; ++m) { float ss = 0.f;
#pragma unroll
                    for (int bj = 0; bj < 2; ++bj)
#pragma unroll
                        for (int n = 0; n < 2; ++n) { const f32x4 a = acc[ai][bj][m][n]; ss += (a[0] * a[0] + a[1] * a[1]) + (a[2] * a[2] + a[3] * a[3]); }
                    ss += __shfl_xor(ss, 16); ss += __shfl_xor(ss, 32);
                    const float rs = 1.f / sqrtf(ss * (1.f / 64.f) + eps);
                    const int row = u.pm * BM + ai * HALF + wr * 64 + m * 16 + fr, b = row >> 11, s = row & 2047;
                    bf16_t* rp = dst + ((size_t)((b * 8 + hd) * 64 + (s >> 5))) * 2048 + (s & 31) * 8;
#pragma unroll
                    for (int bj = 0; bj < 2; ++bj) { const int c8 = 4 * bj + fq; const f32x4 v0 = acc[ai][bj][m][0] * rs * gv[bj][0], v1 = acc[ai][bj][m][1] * rs * gv[bj][1];
                        u32x4 w; w.x = cvt_pk_bf16(v0[0], v0[1]); w.y = cvt_pk_bf16(v0[2], v0[3]); w.z = cvt_pk_bf16(v1[0], v1[1]); w.w = cvt_pk_bf16(v1[2], v1[3]);
                        *(u32x4*)(rp + (c8 >> 1) * 512 + (c8 & 1) * 256) = w; } }
            return;
        }
#pragma unroll
        for (int bj = 0; bj < 2; ++bj) { const int col = u.pn * BM + bj * HALF + wc * 32 + 8 * fq;
            bf16_t* base; int rowlen;
            if (col < 1536) { const int arr = col >> 9, hd = (col & 511) >> 6, dd = col & 63; base = PA + ((size_t)(arr * 16) * 8 + hd) * 2048 * 64 + dd; rowlen = 64; }
            else { const int c2 = col - 1536, arr = c2 >> 9, hd = (c2 & 511) >> 7, dd = c2 & 127; base = PH + ((size_t)(arr * 16) * 4 + hd) * 2048 * 128 + dd; rowlen = 128; }
            const size_t bstride = (size_t)(rowlen == 64 ? 8 : 4) * 2048 * rowlen;
#pragma unroll
            for (int ai = 0; ai < 2; ++ai)
#pragma unroll
                for (int m = 0; m < 4; ++m) { const int row = u.pm * BM + ai * HALF + wr * 64 + m * 16 + fr, b = row >> 11, s = row & 2047;
                    const f32x4 v0 = acc[ai][bj][m][0], v1 = acc[ai][bj][m][1];
                    u32x4 w; w.x = cvt_pk_bf16(v0[0], v0[1]); w.y = cvt_pk_bf16(v0[2], v0[3]); w.z = cvt_pk_bf16(v1[0], v1[1]); w.w = cvt_pk_bf16(v1[2], v1[3]);
                    *(u32x4*)(base + (size_t)b * bstride + (size_t)s * rowlen) = w; } }
    }
};
struct MoeOrder {
    const PG8_LAS int* tile_e; const PG8_LAS unsigned short* rowtab; int ntn, nunits, G, c; unsigned rowbytes; int rev;
    __device__ __forceinline__ bool next(int i, Unit& u) const {
        const int L = i * G + c; if (L >= nunits) return false;
        const int pm0 = L / ntn, pl = L - pm0 * ntn, pm = rev ? rev - 1 - pm0 : pm0; u.pm = pm; u.pn = tile_e[pm] * ntn + pl; u.slot = i; return true;
    }
    __device__ __forceinline__ unsigned rowoff(const Unit& u, int r) const { return (rowtab ? (unsigned)rowtab[u.slot * 256 + r] : (unsigned)(u.pm * 256 + r)) * rowbytes; }
    __device__ __forceinline__ void a_ready(const Unit&) const {}
    __device__ __forceinline__ void done(const Unit&) const {}
};
template <bool OUT8> struct EpiAct {
    static constexpr bool PERM = true, AFTER_DRAIN = false, HAS_INIT = true;
    unsigned char* ACT; const PG8_LAS float* biastab; float oscale;
    __device__ __forceinline__ void init(f32x4 (&acc)[2][2][4][2], const Unit& u, int wc, int fq) const {
#pragma unroll
        for (int n = 0; n < 2; ++n) { const f32x4 bg = *(const PG8_LAS f32x4*)(biastab + u.slot * 256 + wc * 32 + 8 * fq + 4 * n), bu = *(const PG8_LAS f32x4*)(biastab + u.slot * 256 + 128 + wc * 32 + 8 * fq + 4 * n);
#pragma unroll
            for (int ai = 0; ai < 2; ++ai)
#pragma unroll
                for (int m = 0; m < 4; ++m) { acc[ai][0][m][n] = bg; acc[ai][1][m][n] = bu; } }
    }
    __device__ __forceinline__ void operator()(const f32x4 (&acc)[2][2][4][2], const Unit& u, int wr, int wc, int fr, int fq) const {
        const int pl = u.pn & 7; const int row0 = u.pm * BM + wr * 64 + fr, acol0 = pl * 128 + wc * 32 + 8 * fq;
#pragma unroll
        for (int ai = 0; ai < 2; ++ai)
#pragma unroll
            for (int m = 0; m < 4; ++m) { unsigned char* rowp = ACT + (size_t)(row0 + ai * HALF + m * 16) * 1024 + acol0; f32x4 a4[2];
#pragma unroll
                for (int n = 0; n < 2; ++n) { const f32x4 g4 = acc[ai][0][m][n], u4 = acc[ai][1][m][n]; f32x4 gl, ul, ex;
#pragma unroll
                    for (int j = 0; j < 4; ++j) { gl[j] = fminf(g4[j], 7.0f); ul[j] = __builtin_amdgcn_fmed3f(u4[j], -7.0f, 7.0f); }
                    const f32x4 t4 = gl * (-1.702f * 1.44269504089f);
#pragma unroll
                    for (int j = 0; j < 4; ++j) ex[j] = __builtin_amdgcn_exp2f(t4[j]);
                    const f32x4 d4 = ex + 1.0f; f32x4 s4;
#pragma unroll
                    for (int j = 0; j < 4; ++j) s4[j] = __builtin_amdgcn_rcpf(d4[j]);
                    a4[n] = (gl * s4) * (ul * oscale + oscale); }
                if constexpr (OUT8) { int p0 = 0, p1 = 0; p0 = __builtin_amdgcn_cvt_pk_fp8_f32(a4[0][0], a4[0][1], p0, false); p0 = __builtin_amdgcn_cvt_pk_fp8_f32(a4[0][2], a4[0][3], p0, true);
                    p1 = __builtin_amdgcn_cvt_pk_fp8_f32(a4[1][0], a4[1][1], p1, false); p1 = __builtin_amdgcn_cvt_pk_fp8_f32(a4[1][2], a4[1][3], p1, true);
                    *(unsigned long long*)rowp = (unsigned long long)(unsigned)p0 | ((unsigned long long)(unsigned)p1 << 32); }
                else { u32x4 w; w.x = cvt_pk_bf16(a4[0][0], a4[0][1]); w.y = cvt_pk_bf16(a4[0][2], a4[0][3]); w.z = cvt_pk_bf16(a4[1][0], a4[1][1]); w.w = cvt_pk_bf16(a4[1][2], a4[1][3]); *(u32x4*)(rowp + (size_t)(row0 + ai * HALF + m * 16) * 1024 + acol0) = w; } }
    }
};
struct EpiDown {
    static constexpr bool PERM = true, AFTER_DRAIN = false, HAS_INIT = true;
    unsigned char* YK; const PG8_LAS int* tktab; const PG8_LAS float* biastab; float oscale;
    __device__ __forceinline__ void init(f32x4 (&acc)[2][2][4][2], const Unit& u, int wc, int fq) const {
#pragma unroll
        for (int bj = 0; bj < 2; ++bj)
#pragma unroll
            for (int n = 0; n < 2; ++n) { const f32x4 bv = *(const PG8_LAS f32x4*)(biastab + u.slot * 256 + bj * HALF + wc * 32 + 8 * fq + 4 * n) * oscale;
#pragma unroll
                for (int ai = 0; ai < 2; ++ai)
#pragma unroll
                    for (int m = 0; m < 4; ++m) acc[ai][bj][m][n] = bv; }
    }
    __device__ __forceinline__ void operator()(const f32x4 (&acc)[2][2][4][2], const Unit& u, int wr, int wc, int fr, int fq) const {
        const int pl = u.pn & 3; const int col0 = pl * BM + wc * 32 + 8 * fq;
#pragma unroll
        for (int ai = 0; ai < 2; ++ai)
#pragma unroll
            for (int m = 0; m < 4; ++m) { const int tk = tktab[u.slot * 256 + ai * HALF + wr * 64 + m * 16 + fr];
                if (tk >= 0) { unsigned char* rowp = YK + (size_t)tk * 1024 + col0;
#pragma unroll
                    for (int bj = 0; bj < 2; ++bj) { f32x4 v0 = acc[ai][bj][m][0], v1 = acc[ai][bj][m][1];
#pragma unroll
                        for (int j = 0; j < 4; ++j) { v0[j] = __builtin_amdgcn_fmed3f(v0[j], -448.f, 448.f); v1[j] = __builtin_amdgcn_fmed3f(v1[j], -448.f, 448.f); }
                        int p0 = 0, p1 = 0; p0 = __builtin_amdgcn_cvt_pk_fp8_f32(v0[0], v0[1], p0, false); p0 = __builtin_amdgcn_cvt_pk_fp8_f32(v0[2], v0[3], p0, true);
                        p1 = __builtin_amdgcn_cvt_pk_fp8_f32(v1[0], v1[1], p1, false); p1 = __builtin_amdgcn_cvt_pk_fp8_f32(v1[2], v1[3], p1, true);
                        *(unsigned long long*)(rowp + bj * HALF) = (unsigned long long)(unsigned)p0 | ((unsigned long long)(unsigned)p1 << 32); } } }
    }
};


template <class Epi, class Sched, bool ALIGN_EPI = false, bool SP2 = false, bool GATHER = false, int SCW = 0, int SCX = 0>
__device__ __forceinline__ void gemm_phase(PG8_LAS unsigned char* lds, const Gemm g, const Sched& S, const Epi& E, const int tid) {
    const int wid = __builtin_amdgcn_readfirstlane(tid >> 6), lane = tid & 63, wr = wid >> 2, wc = wid & 3, fr = lane & 15, fq = lane >> 4;
    const int K = g.K, nt = K / BK;
    unsigned voffA[2], voffB[2]; int RA[2]; unsigned CA2[2]; unsigned va0[2] = {0u, 0u}, va1[2] = {0u, 0u};
#pragma unroll
    for (int i = 0; i < 2; ++i) { int R, C; stage_rc(tid * 16 + i * 8192, R, C); const int Rb = Epi::PERM ? ((R & ~31) + perm32(R & 31)) : R;
        voffA[i] = (unsigned)(R * K + C) * 2u; voffB[i] = (unsigned)(Rb * K + C) * 2u; RA[i] = R; CA2[i] = (unsigned)C * 2u; }
    static_assert(!GATHER || SP2, "the gathered-A form exists for the SP2 loop only");
    const char* const gA0 = (const char*)g.A;
#define PG8_VA(u) do { int l_; asm volatile("v_mbcnt_lo_u32_b32 %0, -1, 0\n\tv_mbcnt_hi_u32_b32 %0, -1, %0" : "=v"(l_)); const int t_ = wid * 64 + l_;     \
        _Pragma("unroll") for (int _i = 0; _i < 2; ++_i) { int R_, C_; stage_rc(t_ * 16 + _i * 8192, R_, C_); va0[_i] = S.rowoff((u), R_) + (unsigned)C_ * 2u; va1[_i] = S.rowoff((u), HALF + R_) + (unsigned)C_ * 2u; } } while (0)
#define PG8_STA(bufoff, base_ng, base_g, h) do { if constexpr (GATHER) { if (h) PG8_STAGE(bufoff, base_g, va1); else PG8_STAGE(bufoff, base_g, va0); } else PG8_STAGE(bufoff, base_ng, voffA); } while (0)
    const size_t kstep = (size_t)(BK * 2);
    const size_t hstep = (size_t)HALF * K * 2;
    const size_t tstep = 2 * hstep;
    const unsigned ldsw = (unsigned)wid * 1024u;
    const int aoff = lds_byte(wr * 64 + fr, fq * 8), boff = lds_byte(wc * 32 + fr, fq * 8);
#define PG8_SA(b, h) (((b) * 2 + (h)) * HTB)
#define PG8_SB(b, h) ((4 + (b) * 2 + (h)) * HTB)
#define PG8_STAGE(bufoff, gbase, voff) do { _Pragma("unroll") for (int _i = 0; _i < 2; ++_i) \
        __builtin_amdgcn_global_load_lds((const unsigned*)((const char*)(gbase) + (voff)[_i]), (PG8_LAS unsigned*)(lds + (bufoff) + ldsw + _i * 8192), 16, 0, 0); } while (0)
#define PG8_LDA(dst, b, h) do { if constexpr (SCW != 0) { _Pragma("unroll") for (int m = 0; m < 4; ++m) dst##8[m] = PG8_CAT8(*(const PG8_LAS bf16x8*)(lds + PG8_SA(b, h) + aoff + m * 2048), *(const PG8_LAS bf16x8*)(lds + PG8_SA(b, h) + aoff + m * 2048 + 1024)); } \
        else { _Pragma("unroll") for (int m = 0; m < 4; ++m) _Pragma("unroll") for (int k = 0; k < 2; ++k) dst[m][k] = *(const PG8_LAS bf16x8*)(lds + PG8_SA(b, h) + aoff + m * 2048 + k * 1024); } } while (0)
#define PG8_LDB(dst, b, h) do { if constexpr (SCW != 0) { _Pragma("unroll") for (int n = 0; n < 2; ++n) dst##8[n] = PG8_CAT8(*(const PG8_LAS bf16x8*)(lds + PG8_SB(b, h) + boff + n * 2048), *(const PG8_LAS bf16x8*)(lds + PG8_SB(b, h) + boff + n * 2048 + 1024)); } \
        else { _Pragma("unroll") for (int n = 0; n < 2; ++n) _Pragma("unroll") for (int k = 0; k < 2; ++k) dst[n][k] = *(const PG8_LAS bf16x8*)(lds + PG8_SB(b, h) + boff + n * 2048 + k * 1024); } } while (0)
#define PG8_CAT8(lo, hi) __builtin_shufflevector(__builtin_bit_cast(i32x4_t, (lo)), __builtin_bit_cast(i32x4_t, (hi)), 0, 1, 2, 3, 4, 5, 6, 7)
#define PG8_MMA(ai, bj, At, Bt) do { __builtin_amdgcn_s_setprio(1); _Pragma("unroll") for (int m = 0; m < 4; ++m) _Pragma("unroll") for (int n = 0; n < 2; ++n) { \
        if constexpr (SCW != 0) acc[ai][bj][m][n] = __builtin_amdgcn_mfma_scale_f32_16x16x128_f8f6f4(Bt##8[n], At##8[m], acc[ai][bj][m][n], 0, 0, 0, SCW, 0, SCX); \
        else { _Pragma("unroll") for (int k = 0; k < 2; ++k) acc[ai][bj][m][n] = __builtin_amdgcn_mfma_f32_16x16x32_bf16(Bt[n][k], At[m][k], acc[ai][bj][m][n], 0, 0, 0); } } __builtin_amdgcn_s_setprio(0); } while (0)
#define PG8_WAIT_V(n) asm volatile("s_waitcnt vmcnt(" #n ")" ::: "memory")
#define PG8_WAIT_L(n) asm volatile("s_waitcnt lgkmcnt(" #n ")" ::: "memory")
#define PG8_BAR __builtin_amdgcn_s_barrier()
#define PG8_SCHED __builtin_amdgcn_sched_barrier(0)
    Unit cur, nxt; int ui = 0;
    if (!S.next(0, cur)) return;
    f32x4 acc[2][2][4][2];
    if constexpr (Epi::HAS_INIT) E.init(acc, cur, wc, fq);
    else {
#pragma unroll
    for (int a = 0; a < 2; ++a)
#pragma unroll
        for (int b = 0; b < 2; ++b)
#pragma unroll
            for (int m = 0; m < 4; ++m)
#pragma unroll
                for (int n = 0; n < 2; ++n) acc[a][b][m][n] = (f32x4){0.f, 0.f, 0.f, 0.f};
    }
    bf16x8 At[4][2], B0[2][2], B1[2][2]; i32x8_t At8[4], B08[2], B18[2];
    const char* cA = (const char*)g.A + (size_t)cur.pm * tstep; const char* cB = (const char*)g.Bt + (size_t)cur.pn * tstep;
    S.a_ready(cur);
    if constexpr (SP2) {
        if constexpr (GATHER) PG8_VA(cur);
        PG8_STAGE(PG8_SB(0, 0), cB, voffB); PG8_STAGE(PG8_SB(0, 1), cB + hstep, voffB); PG8_STA(PG8_SA(0, 0), cA, gA0, 0); PG8_STA(PG8_SA(0, 1), cA + hstep, gA0, 1);
        if (wr == 1) PG8_BAR;
        PG8_WAIT_V(2); PG8_BAR;
        PG8_STAGE(PG8_SB(1, 0), cB + kstep, voffB); PG8_STA(PG8_SA(1, 0), cA + kstep, gA0 + kstep, 0); PG8_STAGE(PG8_SB(1, 1), cB + hstep + kstep, voffB);
        PG8_WAIT_V(6); PG8_BAR;
    } else {
        PG8_STAGE(PG8_SB(0, 0), cB, voffB); PG8_STAGE(PG8_SA(0, 0), cA, voffA); PG8_STAGE(PG8_SB(0, 1), cB + hstep, voffB); PG8_STAGE(PG8_SA(0, 1), cA + hstep, voffA);
        if (wr == 1) PG8_BAR;
        PG8_WAIT_V(4); PG8_BAR;
        PG8_STAGE(PG8_SB(1, 0), cB + kstep, voffB); PG8_STAGE(PG8_SA(1, 0), cA + kstep, voffA); PG8_STAGE(PG8_SB(1, 1), cB + hstep + kstep, voffB);
        PG8_WAIT_V(6); PG8_BAR;
    }
    for (;;) {
        const bool has_next = S.next(ui + 1, nxt);
        const char* nA = has_next ? (const char*)g.A + (size_t)nxt.pm * tstep : cA; const char* nB = has_next ? (const char*)g.Bt + (size_t)nxt.pn * tstep : cB;
        _Pragma("nounroll") for (int t = 0; t < nt; t += 2) {
            const bool last = (t == nt - 2);
            const char* a1 = cA + (size_t)(t + 1) * kstep;
            const char* a2 = last ? nA : cA + (size_t)(t + 2) * kstep; const char* b2 = last ? nB : cB + (size_t)(t + 2) * kstep;
            const char* a3 = a2 + kstep; const char* b3 = b2 + kstep;
            if (last && has_next) S.a_ready(nxt);
            const char* const g1 = gA0 + (size_t)(t + 1) * kstep; const char* const g2 = last ? gA0 : gA0 + (size_t)(t + 2) * kstep; const char* const g3 = g2 + kstep;
            if constexpr (SP2) {
            PG8_LDB(B0, 0, 0); PG8_LDB(B1, 0, 1); PG8_SCHED; PG8_LDA(At, 0, 0); PG8_STA(PG8_SA(1, 1), a1 + hstep, g1, 1);
            PG8_WAIT_V(8); PG8_WAIT_L(0); PG8_BAR; PG8_MMA(0, 0, At, B0); PG8_MMA(0, 1, At, B1); PG8_BAR; PG8_SCHED;
            if constexpr (GATHER) { if (last && has_next) PG8_VA(nxt); }
            PG8_LDA(At, 0, 1); PG8_STAGE(PG8_SB(0, 0), b2, voffB); PG8_STAGE(PG8_SB(0, 1), b2 + hstep, voffB); PG8_STA(PG8_SA(0, 0), a2, g2, 0);
            PG8_WAIT_V(8); PG8_WAIT_L(0); PG8_BAR; PG8_MMA(1, 0, At, B0); PG8_MMA(1, 1, At, B1); PG8_BAR; PG8_SCHED;
            PG8_LDB(B0, 1, 0); PG8_LDB(B1, 1, 1); PG8_SCHED; PG8_LDA(At, 1, 0); PG8_STA(PG8_SA(0, 1), a2 + hstep, g2, 1);
            PG8_WAIT_V(8); PG8_WAIT_L(0); PG8_BAR; PG8_MMA(0, 0, At, B0); PG8_MMA(0, 1, At, B1); PG8_BAR; PG8_SCHED;
            PG8_LDA(At, 1, 1); PG8_STAGE(PG8_SB(1, 0), b3, voffB); PG8_STAGE(PG8_SB(1, 1), b3 + hstep, voffB); PG8_STA(PG8_SA(1, 0), a3, g3, 0);
            PG8_WAIT_V(8); PG8_WAIT_L(0); PG8_BAR; PG8_MMA(1, 0, At, B0); PG8_MMA(1, 1, At, B1); PG8_BAR; PG8_SCHED;
            } else {
            PG8_LDB(B0, 0, 0); PG8_SCHED; PG8_LDA(At, 0, 0); PG8_STAGE(PG8_SA(1, 1), a1 + hstep, voffA);
            PG8_WAIT_L(8); PG8_BAR; PG8_WAIT_L(0); PG8_MMA(0, 0, At, B0); PG8_BAR; PG8_SCHED;
            PG8_LDB(B1, 0, 1); PG8_STAGE(PG8_SB(0, 0), b2, voffB);
            PG8_BAR; PG8_WAIT_L(0); PG8_MMA(0, 1, At, B1); PG8_BAR;
            PG8_LDA(At, 0, 1); PG8_STAGE(PG8_SA(0, 0), a2, voffA);
            PG8_BAR; PG8_WAIT_L(0); PG8_MMA(1, 0, At, B0); PG8_BAR; PG8_SCHED;
            PG8_STAGE(PG8_SB(0, 1), b2 + hstep, voffB);
            PG8_WAIT_V(6); PG8_BAR; PG8_MMA(1, 1, At, B1); PG8_BAR;
            PG8_LDB(B0, 1, 0); PG8_SCHED; PG8_LDA(At, 1, 0); PG8_STAGE(PG8_SA(0, 1), a2 + hstep, voffA);
            PG8_WAIT_L(8); PG8_BAR; PG8_WAIT_L(0); PG8_MMA(0, 0, At, B0); PG8_BAR; PG8_SCHED;
            PG8_LDB(B1, 1, 1); PG8_STAGE(PG8_SB(1, 0), b3, voffB);
            PG8_BAR; PG8_WAIT_L(0); PG8_MMA(0, 1, At, B1); PG8_BAR;
            PG8_LDA(At, 1, 1); PG8_STAGE(PG8_SA(1, 0), a3, voffA);
            PG8_BAR; PG8_WAIT_L(0); PG8_MMA(1, 0, At, B0); PG8_BAR; PG8_SCHED;
            PG8_STAGE(PG8_SB(1, 1), b3 + hstep, voffB);
            PG8_WAIT_V(6); PG8_BAR; PG8_MMA(1, 1, At, B1); PG8_BAR;
            }
        }
        if constexpr (ALIGN_EPI) { if (wr == 0) PG8_BAR; }
        if constexpr (!Epi::AFTER_DRAIN) { int fr_ = fr, fq_ = fq; asm volatile("" : "+v"(fr_), "+v"(fq_));
            E(acc, cur, wr, wc, fr_, fq_); S.done(cur); }
        if (!has_next) break;
        if constexpr (Epi::HAS_INIT) { int fq_ = fq; asm volatile("" : "+v"(fq_)); E.init(acc, nxt, wc, fq_); }
        else {
#pragma unroll
        for (int a = 0; a < 2; ++a)
#pragma unroll
            for (int b = 0; b < 2; ++b)
#pragma unroll
                for (int m = 0; m < 4; ++m)
#pragma unroll
                    for (int n = 0; n < 2; ++n) acc[a][b][m][n] = (f32x4){0.f, 0.f, 0.f, 0.f};
        }
        cur = nxt; cA = nA; cB = nB; ++ui;
        if constexpr (ALIGN_EPI) { if (wr == 1) PG8_BAR; }
    }
    PG8_WAIT_V(0);
    if constexpr (!ALIGN_EPI) { if (wr == 0) PG8_BAR; }
    PG8_BAR;
    if constexpr (Epi::AFTER_DRAIN) { E.fused(acc, cur, wr, wc, fr, fq, lds, wid, lane); S.done(cur); }
#undef PG8_SA
#undef PG8_CAT8
#undef PG8_VA
#undef PG8_STA
#undef PG8_SB
#undef PG8_STAGE
#undef PG8_LDA
#undef PG8_LDB
#undef PG8_MMA
#undef PG8_WAIT_V
#undef PG8_WAIT_L
#undef PG8_BAR
#undef PG8_SCHED
}
}

#ifndef PG8_SP2
#define PG8_SP2 true
#endif
#ifndef PG8_ALIGN
#define PG8_ALIGN true
#endif
#define GAS __attribute__((address_space(1)))
#define LAS __attribute__((address_space(3)))
typedef unsigned short bf16;
typedef unsigned v4u __attribute__((ext_vector_type(4)));
typedef float f32x4 __attribute__((ext_vector_type(4)));
typedef short bf16x8 __attribute__((ext_vector_type(8)));
typedef GAS unsigned gu32;
typedef GAS unsigned long long gu64;
#define RLX_AGENT __ATOMIC_RELAXED, __HIP_MEMORY_SCOPE_AGENT
#define LDS_WAIT() asm volatile("s_waitcnt lgkmcnt(0)" ::: "memory")
#define VM_WAIT() asm volatile("s_waitcnt vmcnt(0)" ::: "memory")
__device__ __forceinline__ unsigned long long rt() { return __builtin_amdgcn_s_memrealtime(); }
__device__ __forceinline__ unsigned f2bf(float f) { unsigned u = __builtin_bit_cast(unsigned, f); return (u + 0x7fffu + ((u >> 16) & 1u)) >> 16; }
__device__ __forceinline__ unsigned pk2(float lo, float hi) { return f2bf(lo) | (f2bf(hi) << 16); }

#define XB_TMO      128
#define XB_XCNT(j)  (256  + 64 * (j))
#define XB_XSUB(j)  (1280 + 64 * (j))
#define XB_XGEN(j)  (2304 + 64 * (j))
#define XB_TOP      3328
#define XB_TOPGEN   3392
#define XCD_BAR_WORDS 3456
#define XB_SPIN_CAP (1u << 18)

__device__ __forceinline__ unsigned xb_ld(unsigned* p)              { return __hip_atomic_load(p, __ATOMIC_RELAXED, __HIP_MEMORY_SCOPE_AGENT); }
__device__ __forceinline__ unsigned xb_add(unsigned* p, unsigned v) { return __hip_atomic_fetch_add(p, v, __ATOMIC_RELAXED, __HIP_MEMORY_SCOPE_AGENT); }
__device__ __forceinline__ unsigned xb_xcc_id() { return (unsigned)__builtin_amdgcn_s_getreg((3 << 11) | 20) & 0xFu; }
#define XB_SPIN(cond, bar) do { unsigned _sp = 0; while (cond) { __builtin_amdgcn_s_sleep(1); \
    if ((++_sp & 255u) == 0u) { if (xb_ld(&(bar)[XB_TMO])) break; if (_sp > XB_SPIN_CAP) { atomicAdd(&(bar)[XB_TMO], 1u); break; } } } } while (0)

struct XcdBarrier {
    unsigned* bar; unsigned x;
    volatile LAS unsigned* st;
};

__device__ __forceinline__ XcdBarrier xcd_barrier_post(unsigned* bar, volatile LAS unsigned* st) {
    XcdBarrier b; b.bar = bar; b.x = xb_xcc_id(); b.st = st;
    if (threadIdx.x == 0) (void)xb_add(&bar[XB_XCNT(b.x)], 1u);
    return b;
}
__device__ __forceinline__ void xcd_barrier_complete(unsigned* bar, unsigned x, unsigned& nloc, unsigned& nx) {
    const unsigned G = gridDim.x * gridDim.y * gridDim.z;
    unsigned sum, cnt, mine, sp = 0u;
    for (;;) {
        sum = 0u; cnt = 0u; mine = 0u;
#pragma unroll
        for (unsigned j = 0; j < 16; ++j) { const unsigned c = xb_ld(&bar[XB_XCNT(j)]); sum += c; cnt += (c > 0u) ? 1u : 0u; mine = (j == x) ? c : mine; }
        if (sum == G) break;
        __builtin_amdgcn_s_sleep(1);
        if ((++sp & 255u) == 0u) { if (xb_ld(&bar[XB_TMO])) break; if (sp > XB_SPIN_CAP) { atomicAdd(&bar[XB_TMO], 1u); break; } }
    }
    nloc = mine > 0u ? mine : 1u; nx = cnt > 0u ? cnt : 1u;
}

__device__ __forceinline__ void xcd_barrier(const XcdBarrier& b) {
    asm volatile("s_waitcnt vmcnt(0)" ::: "memory");
    __syncthreads();
    if (threadIdx.x == 0) {
        unsigned* bar = b.bar;
        __builtin_amdgcn_s_waitcnt(0);
        unsigned nloc = b.st[0], nx = b.st[1];
        if (nloc == 0u) { xcd_barrier_complete(bar, b.x, nloc, nx); b.st[0] = nloc; b.st[1] = nx; }
        const unsigned old = xb_add(&bar[XB_XSUB(b.x)], 1u);
        const unsigned gen = old / nloc;
        if (old + 1u == (gen + 1u) * nloc) {
            __builtin_amdgcn_fence(__ATOMIC_RELEASE, "agent");
            asm volatile("s_waitcnt vmcnt(0)" ::: "memory");
            const unsigned og = xb_add(&bar[XB_TOP], 1u);
            const unsigned tg = og / nx;
            if (og + 1u == (tg + 1u) * nx) xb_add(&bar[XB_TOPGEN], 1u);
            else XB_SPIN(xb_ld(&bar[XB_TOPGEN]) == tg, bar);
            __builtin_amdgcn_fence(__ATOMIC_ACQUIRE, "agent");
            xb_add(&bar[XB_XGEN(b.x)], 1u);
            asm volatile("s_waitcnt vmcnt(0)" ::: "memory");
        } else {
            XB_SPIN(xb_ld(&bar[XB_XGEN(b.x)]) == gen, bar);
            __builtin_amdgcn_fence(__ATOMIC_ACQUIRE, "agent");
            asm volatile("s_waitcnt vmcnt(0)" ::: "memory");
        }
    }
    __syncthreads();
}

constexpr int NWAVES = 8;
#ifndef MK_ONE_LAUNCH
#define MK_ONE_LAUNCH 1
#endif

constexpr int BATCH = 16, SEQ = 2048, D = 1024, T = BATCH * SEQ;
constexpr int NIN = 3584;
constexpr int OFF_SQ = 0, OFF_SK = 512, OFF_SV = 1024, OFF_HQ = 1536, OFF_HF = 2048, OFF_HI = 2560, OFF_HG = 3072;
constexpr int NE = 32, TOPK = 4, NASSIGN = T * TOPK;
constexpr int MAXTILES = NASSIGN / 256 + NE;
constexpr int MAXROWS = MAXTILES * 256;
constexpr float EPS = 1e-6f;

constexpr size_t MiB = 1u << 20;
constexpr size_t WS_CTL = 0, CTL_ZERO_BYTES = 1 * MiB;
constexpr size_t WS_WIN = 2 * MiB;
constexpr size_t WS_WOUT = 10 * MiB;
constexpr size_t WS_RT = 12 * MiB;
constexpr size_t WS_WGU = 16 * MiB;
constexpr size_t WS_WD = 144 * MiB;
constexpr size_t WS_XN = 208 * MiB;
constexpr size_t WS_P = 272 * MiB;
constexpr size_t WS_PH = WS_P + 96 * MiB;
constexpr size_t WS_MIX = 496 * MiB;
constexpr size_t WS_ACT = 272 * MiB;
constexpr size_t WS_YK = 560 * MiB;
constexpr size_t WS_QN = 624 * MiB;
constexpr size_t WS_KN = 656 * MiB;
constexpr size_t WS_VT = 688 * MiB;
constexpr size_t WS_KVS = 720 * MiB;
constexpr size_t WS_DEC = 784 * MiB;
constexpr size_t WS_SSEG = 786 * MiB;
constexpr size_t WS_DSEG = 802 * MiB;
constexpr size_t WS_LIST = 816 * MiB;
constexpr size_t WS_TOPG = 825 * MiB;
constexpr size_t WS_X8 = 560 * MiB;
constexpr size_t WS_END = 832 * MiB;
static_assert(WS_ACT + (size_t)MAXROWS * 2048 <= WS_YK && WS_YK + (size_t)T * 4 * 2048 <= WS_LIST && WS_MIX + (size_t)T * 2048 <= WS_YK, "d_ws map");
constexpr int CW_TMO = 0, CW_CODE = 1;
constexpr int CW_CNT = 64;
constexpr int CW_BAR = 4096;

constexpr int RING_OFF = 0, RING_BYTES = 131072;
constexpr int RT_ROW = 2064, RT_WL = 32 * RT_ROW, RT_END = 64 * RT_ROW;
constexpr int LDSCTL_OFF = 133120, MISC_OFF = LDSCTL_OFF + 320;
constexpr int LTAB_OFF = LDSCTL_OFF + 512;
constexpr int LT_TS = MAXTILES, LT_CNT = MAXTILES + 32, LT_MISC = MAXTILES + 64, LT_WORDS = MAXTILES + 192;
constexpr int ROWTAB_OFF = LTAB_OFF + LT_WORDS * 4;
constexpr int MAXSLOT = 17;
constexpr int ROWTAB2_OFF = ROWTAB_OFF + MAXSLOT * 1024;
constexpr int LDS_BYTES = ROWTAB2_OFF + MAXSLOT * 512;
static_assert(RT_END <= LDSCTL_OFF && MISC_OFF + 128 <= LTAB_OFF && LDS_BYTES <= 160 * 1024 && (MAXTILES * 8 + 255) / 256 <= MAXSLOT && 2 * ((MAXTILES * 4 + 255) / 256) * 1024 <= MAXSLOT * 1536 && ROWTAB_OFF % 16 == 0, "LDS map");

struct Frame {
    LAS unsigned char* lds;
    volatile LAS unsigned* MISC;
    gu32* ctl;
    int tid, lane, wave, gw, ngw;
    int vcu, G;
    const float *x, *norm1_g, *w_in, *sb_q_g, *sb_k_g, *sb_out_g, *hg_lb, *hg_out_g, *w_out, *norm2_g, *w_router, *b_router, *w_gu, *b_gu, *w_d, *b_d;
    float* out;
    unsigned char* ws;
};
__device__ __forceinline__ float bf2f(unsigned short b) { return __builtin_bit_cast(float, (unsigned)b << 16); }
__device__ __forceinline__ float bflo(unsigned w) { return __builtin_bit_cast(float, w << 16); }
__device__ __forceinline__ float bfhi(unsigned w) { return __builtin_bit_cast(float, w & 0xffff0000u); }
typedef __bf16 bf16x2n_ __attribute__((ext_vector_type(2)));
typedef float f32x2n_ __attribute__((ext_vector_type(2)));
__device__ __forceinline__ unsigned pkbf(float a, float b) { const bf16x2n_ v = __builtin_convertvector((f32x2n_){a, b}, bf16x2n_); return __builtin_bit_cast(unsigned, v); }
__device__ __forceinline__ int lane_id() { int l; asm volatile("v_mbcnt_lo_u32_b32 %0, -1, 0\n\tv_mbcnt_hi_u32_b32 %0, -1, %0" : "=v"(l)); return l; }
__device__ __forceinline__ int vzero() { int z; asm volatile("v_mov_b32 %0, 0" : "=v"(z)); return z; }
__device__ __forceinline__ float wave_sum(float v) {
#pragma unroll
    for (int o = 1; o < 64; o <<= 1) v += __shfl_xor(v, o);
    return v;
}

constexpr float W8_SCALE = 256.f, A8_SCALE = 4.f, Y8_SCALE = 32.f; static_assert(Y8_SCALE == 32.f, "SC_W8Y below is 2^-8 * 32");
constexpr int SC_ONE = 0x7f7f7f7f, SC_W8 = 0x77777777, SC_A8 = 0x7d7d7d7d, SC_W8Y = 0x7c7c7c7c;
struct P0Item { const float* W; bf16* WT; const float* rowscale; int N, k0, n0, drow0, fp8, perm; };
__device__ __forceinline__ void p0_load(const P0Item& it, f32x4 (&v)[16], int lane) {
    const int kr = lane >> 4, nc = 4 * (lane & 15);
#pragma unroll
    for (int i = 0; i < 16; ++i) v[i] = __builtin_nontemporal_load((const f32x4*)(it.W + (size_t)(it.k0 + 4 * i + kr) * it.N + it.n0 + nc));
}
__device__ __forceinline__ void p0_store(const P0Item& it, const f32x4 (&v)[16], LAS unsigned char* scr, int lane) {
    const int kr = lane >> 4, nc = 4 * (lane & 15);
#pragma unroll
    for (int i = 0; i < 16; ++i) { const float sc = it.rowscale ? it.rowscale[it.k0 + 4 * i + kr] : 1.f;
        *(LAS unsigned long long*)(scr + (4 * i + kr) * 136 + 2 * nc) = (unsigned long long)pkbf(v[i].x * sc, v[i].y * sc) | ((unsigned long long)pkbf(v[i].z * sc, v[i].w * sc) << 32); }
    LDS_WAIT(); asm volatile("" ::: "memory");
    unsigned val[64];
#pragma unroll
    for (int k = 0; k < 64; ++k) val[k] = *(const LAS unsigned short*)(scr + k * 136 + 2 * lane);
    if (it.fp8) { GAS v4u* o = (GAS v4u*)((unsigned char*)it.WT + (size_t)(it.drow0 + lane) * D + it.k0);
#pragma unroll
        for (int c = 0; c < 4; ++c) { v4u w4;
            w4.x = pg8::pk4_fp8(bflo(val[16 * c + 0]) * W8_SCALE, bflo(val[16 * c + 1]) * W8_SCALE, bflo(val[16 * c + 2]) * W8_SCALE, bflo(val[16 * c + 3]) * W8_SCALE);
            w4.y = pg8::pk4_fp8(bflo(val[16 * c + 4]) * W8_SCALE, bflo(val[16 * c + 5]) * W8_SCALE, bflo(val[16 * c + 6]) * W8_SCALE, bflo(val[16 * c + 7]) * W8_SCALE);
            w4.z = pg8::pk4_fp8(bflo(val[16 * c + 8]) * W8_SCALE, bflo(val[16 * c + 9]) * W8_SCALE, bflo(val[16 * c + 10]) * W8_SCALE, bflo(val[16 * c + 11]) * W8_SCALE);
            w4.w = pg8::pk4_fp8(bflo(val[16 * c + 12]) * W8_SCALE, bflo(val[16 * c + 13]) * W8_SCALE, bflo(val[16 * c + 14]) * W8_SCALE, bflo(val[16 * c + 15]) * W8_SCALE); o[c] = w4; }
    } else { GAS v4u* o = (GAS v4u*)(it.WT + (size_t)(it.drow0 + (it.perm ? 128 * (lane >> 5) + (lane & 31) : lane)) * D + it.k0);
#pragma unroll
        for (int c = 0; c < 8; ++c) { v4u w4; w4.x = val[8 * c + 0] | (val[8 * c + 1] << 16); w4.y = val[8 * c + 2] | (val[8 * c + 3] << 16); w4.z = val[8 * c + 4] | (val[8 * c + 5] << 16); w4.w = val[8 * c + 6] | (val[8 * c + 7] << 16); o[c] = w4; } }
    LDS_WAIT(); asm volatile("" ::: "memory");
}
__device__ __forceinline__ void rms_rows2_to_bf16(const float* xa, const float* xb, bool hasb, const float* g, bf16* oa, bf16* ob, int lane) {
    const GAS f32x4* pa = (const GAS f32x4*)xa + lane; const GAS f32x4* pb = (const GAS f32x4*)(hasb ? xb : xa) + lane; const f32x4* gr = (const f32x4*)g + lane;
    f32x4 va[4], vb[4], gg[4]; float sa = 0.f, sb = 0.f;
#pragma unroll
    for (int j = 0; j < 4; ++j) { va[j] = __builtin_nontemporal_load(pa + 64 * j); vb[j] = __builtin_nontemporal_load(pb + 64 * j); gg[j] = gr[64 * j]; }
#pragma unroll
    for (int j = 0; j < 4; ++j) { sa += (va[j].x * va[j].x + va[j].y * va[j].y) + (va[j].z * va[j].z + va[j].w * va[j].w); sb += (vb[j].x * vb[j].x + vb[j].y * vb[j].y) + (vb[j].z * vb[j].z + vb[j].w * vb[j].w); }
    const float ra = 1.f / sqrtf(wave_sum(sa) * (1.f / D) + EPS), rb = 1.f / sqrtf(wave_sum(sb) * (1.f / D) + EPS);
    GAS unsigned long long* o8a = (GAS unsigned long long*)oa + lane; GAS unsigned long long* o8b = (GAS unsigned long long*)ob + lane;
#pragma unroll
    for (int j = 0; j < 4; ++j) o8a[64 * j] = (unsigned long long)pkbf(va[j].x * ra * gg[j].x, va[j].y * ra * gg[j].y) | ((unsigned long long)pkbf(va[j].z * ra * gg[j].z, va[j].w * ra * gg[j].w) << 32);
    if (hasb) {
#pragma unroll
        for (int j = 0; j < 4; ++j) o8b[64 * j] = (unsigned long long)pkbf(vb[j].x * rb * gg[j].x, vb[j].y * rb * gg[j].y) | ((unsigned long long)pkbf(vb[j].z * rb * gg[j].z, vb[j].w * rb * gg[j].w) << 32); }
}
__device__ __forceinline__ P0Item p0_item(Frame& F, int r) {
    constexpr int I_IN = 16 * (NIN / 64), I_OUT = 16 * 16, I_GU = NE * 16 * 32;
    P0Item it;
    if (r < I_IN) { const int nb = NIN / 64, kb = r / nb, nn = r % nb; const int pq = nn < 16; it = P0Item{F.w_in, (bf16*)(F.ws + WS_WIN), nullptr, NIN, 64 * kb, 64 * nn, pq ? 256 * (nn >> 2) + 32 * (nn & 3) : 64 * nn, 0, pq}; return it; } r -= I_IN;
    if (r < I_OUT) { const int kb = r / 16, nn = r % 16; it = P0Item{F.w_out, (bf16*)(F.ws + WS_WOUT), nullptr, D, 64 * kb, 64 * nn, 64 * nn, 0, 0}; return it; } r -= I_OUT;
    if (r < I_GU) { const int e = r / 512, q = r % 512, kb = q / 32, nn = q % 32;
        const int isup = nn >> 4, a = (nn & 15) * 64;
        it = P0Item{F.w_gu + (size_t)e * D * 2048, (bf16*)(F.ws + WS_WGU + (size_t)e * 2048 * D), F.norm2_g, 2048, 64 * kb, 64 * nn, 256 * (a >> 7) + 128 * isup + (a & 127), 1, 0}; return it; } r -= I_GU;
    { const int e = r / 256, q = r % 256, kb = q / 16, nn = q % 16;
        it = P0Item{F.w_d + (size_t)e * D * D, (bf16*)(F.ws + WS_WD + (size_t)e * D * D), nullptr, D, 64 * kb, 64 * nn, 64 * nn, 1, 0}; return it; }
}
__device__ __forceinline__ void p0_prologue(Frame& F) {
    LAS unsigned char* scr = F.lds + RING_OFF + F.wave * 16384;
    constexpr int NITEMS = 16 * (NIN / 64) + 16 * 16 + NE * 16 * 32 + NE * 16 * 16;
    {
        f32x4 va[16], vb[16]; int it = F.gw;
        if (it < NITEMS) { P0Item A = p0_item(F, it); p0_load(A, va, F.lane);
            for (;;) {
                const int itb = it + F.ngw; const bool hb = itb < NITEMS; const P0Item B = p0_item(F, hb ? itb : it); p0_load(B, vb, F.lane); __builtin_amdgcn_sched_barrier(0);
                p0_store(A, va, scr, F.lane);
                if (!hb) break;
                it = itb + F.ngw; const bool ha = it < NITEMS; A = p0_item(F, ha ? it : itb); p0_load(A, va, F.lane); __builtin_amdgcn_sched_barrier(0);
                p0_store(B, vb, scr, F.lane);
                if (!ha) break;
            }
        }
    }
    for (int q = blockIdx.x * (NWAVES * 64) + F.tid; q < 4096; q += F.G * NWAVES * 64) {
        const int e = q & 31, k0 = (q >> 5) * 8; unsigned hi[8], lo[8];
#pragma unroll
        for (int j = 0; j < 8; ++j) { const float w = F.w_router[(k0 + j) * 32 + e] * F.norm2_g[k0 + j]; hi[j] = pkbf(w, 0.f) & 0xffffu; lo[j] = pkbf(w - bflo(hi[j]), 0.f) & 0xffffu; }
        const v4u h4 = {hi[0] | (hi[1] << 16), hi[2] | (hi[3] << 16), hi[4] | (hi[5] << 16), hi[6] | (hi[7] << 16)}, l4 = {lo[0] | (lo[1] << 16), lo[2] | (lo[3] << 16), lo[4] | (lo[5] << 16), lo[6] | (lo[7] << 16)};
        *(GAS v4u*)(F.ws + WS_RT + e * RT_ROW + 2 * k0) = h4; *(GAS v4u*)(F.ws + WS_RT + RT_WL + e * RT_ROW + 2 * k0) = l4; }
    for (int m = F.gw; m < T; m += 2 * F.ngw) rms_rows2_to_bf16(F.x + (size_t)m * D, F.x + (size_t)(m + F.ngw) * D, m + F.ngw < T, F.norm1_g, (bf16*)(F.ws + WS_XN) + (size_t)m * D, (bf16*)(F.ws + WS_XN) + (size_t)(m + F.ngw) * D, F.lane);
}

typedef float f32x16 __attribute__((ext_vector_type(16)));
typedef __bf16 bf16x2n __attribute__((ext_vector_type(2)));
typedef float f32x2n __attribute__((ext_vector_type(2)));
#define MFMA32(a, b, c) __builtin_amdgcn_mfma_f32_32x32x16_bf16((a), (b), (c), 0, 0, 0)
__device__ __forceinline__ bf16x8 pack8(float a0, float a1, float a2, float a3, float a4, float a5, float a6, float a7) { const v4u p = {pkbf(a0, a1), pkbf(a2, a3), pkbf(a4, a5), pkbf(a6, a7)}; return __builtin_bit_cast(bf16x8, p); }
constexpr float QSCALE = 0.125f * 1.44269504089f;
__device__ __forceinline__ void prep_phase(Frame& F) {
    LAS unsigned* tl = (LAS unsigned*)(F.lds + RING_OFF + F.wave * 16384);
    const bf16* P = (const bf16*)(F.ws + WS_P); bf16* Qn = (bf16*)(F.ws + WS_QN); bf16* Kn = (bf16*)(F.ws + WS_KN); bf16* VT = (bf16*)(F.ws + WS_VT);
    const int tr = F.lane >> 3, c8 = F.lane & 7;
    for (int it = F.gw; it < 4096; it += F.ngw) {
        const int bh = it & 127, blk = it >> 7, b = bh >> 3, h = bh & 7;
        const bf16* base = P + ((size_t)b * 8 + h) * SEQ * 64 + (size_t)(blk * 64 + tr) * 64 + 8 * c8;
        v4u rv[8];
#pragma unroll
        for (int i = 0; i < 8; ++i) { const bf16* row = base + (size_t)(8 * i) * 64; rv[i] = *(const GAS v4u*)(row + (size_t)2 * 16 * 8 * SEQ * 64); }
        {
#pragma unroll
            for (int i = 0; i < 8; ++i) { LAS unsigned* q = tl + (8 * i + tr) * 33 + 4 * c8; q[0] = rv[i].x; q[1] = rv[i].y; q[2] = rv[i].z; q[3] = rv[i].w; }
            LDS_WAIT(); asm volatile("" ::: "memory");
            const LAS unsigned short* t16 = (const LAS unsigned short*)tl; const int dr = tr;
#define KAP(pos) (((pos) & ~12) | (((pos) & 4) << 1) | (((pos) & 8) >> 1))
            bf16* const obase = VT + ((size_t)bh * 64 + blk * 2 + (c8 >> 2)) * 2048 + ((c8 >> 1) & 1) * 512 + (c8 & 1) * 256;
#pragma unroll
            for (int j = 0; j < 8; ++j) { unsigned val[8];
#pragma unroll
                for (int p = 0; p < 8; ++p) { const int pos = 8 * c8 + p; val[p] = t16[KAP(pos) * 66 + 8 * j + dr]; }
                v4u w4; w4.x = val[0] | (val[1] << 16); w4.y = val[2] | (val[3] << 16); w4.z = val[4] | (val[5] << 16); w4.w = val[6] | (val[7] << 16);
                *(GAS v4u*)(obase + (j >> 2) * 1024 + ((8 * j + dr) & 31) * 8) = w4; }
#undef KAP
            LDS_WAIT(); asm volatile("" ::: "memory");
        }
    }
}

__device__ __forceinline__ int crow16(int i, int hh) { return (i & 3) + 8 * (i >> 2) + 4 * hh; }
__device__ __forceinline__ void attn_item(Frame& F, int bh, int qb, float thr, const bf16x8 (&Lt)[2]) {
    const int r = F.lane & 31, hh = F.lane >> 5, b = bh >> 3, h = bh & 7, q0 = qb * 32;
    const bf16* Qn = (const bf16*)(F.ws + WS_QN); const bf16* Kn = (const bf16*)(F.ws + WS_KN); const bf16* VT = (const bf16*)(F.ws + WS_VT);
    bf16x8 qf[4];
#pragma unroll
    for (int s = 0; s < 4; ++s) qf[s] = *(const GAS bf16x8*)(Qn + ((size_t)bh * 64 + qb) * 2048 + s * 512 + F.lane * 8);
    f32x4 gout[2][4];
#pragma unroll
    for (int db = 0; db < 2; ++db)
#pragma unroll
        for (int gq = 0; gq < 4; ++gq) gout[db][gq] = *(const f32x4*)(F.sb_out_g + h * 64 + 32 * db + 8 * gq + 4 * hh);
    f32x16 O0, O1;
#pragma unroll
    for (int i = 0; i < 16; ++i) { O0[i] = 0.f; O1[i] = 0.f; }
    float carry = 0.f;
    const bf16* kbase = Kn + (size_t)bh * 64 * 2048 + F.lane * 8; const bf16* vbase = VT + (size_t)bh * 64 * 2048 + F.lane * 8;
#define ATT_LOAD(KF, VF, kb_) do { _Pragma("unroll") for (int s_ = 0; s_ < 4; ++s_) KF[s_] = *(const GAS bf16x8*)(kbase + (size_t)(kb_) * 2048 + 512 * s_); \
        _Pragma("unroll") for (int db_ = 0; db_ < 2; ++db_) _Pragma("unroll") for (int ks_ = 0; ks_ < 2; ++ks_) VF[db_][ks_] = *(const GAS bf16x8*)(vbase + (size_t)(kb_) * 2048 + 1024 * db_ + 512 * ks_); } while (0)
#define ATT_BLOCK(KF, VF, kb_) do { const bool diag = ((kb_) == qb); \
        f32x16 z; _Pragma("unroll") for (int i = 0; i < 16; ++i) z[i] = 0.f; \
        _Pragma("unroll") for (int s_ = 0; s_ < 4; ++s_) z = MFMA32(KF[s_], qf[s_], z); \
        float sp[16]; \
        _Pragma("unroll") for (int i = 0; i < 16; ++i) { const float zz = z[i]; float v = fmaxf(zz, 0.f) + __builtin_amdgcn_logf(1.f + __builtin_amdgcn_exp2f(-fabsf(zz))); if (diag && !(crow16(i, hh) < r)) v = 0.f; sp[i] = v; } \
        const bf16x8 sb0 = pack8(sp[0], sp[1], sp[2], sp[3], sp[4], sp[5], sp[6], sp[7]), sb1 = pack8(sp[8], sp[9], sp[10], sp[11], sp[12], sp[13], sp[14], sp[15]); \
        f32x16 Cc; _Pragma("unroll") for (int i = 0; i < 16; ++i) Cc[i] = carry; \
        Cc = MFMA32(Lt[0], sb0, Cc); Cc = MFMA32(Lt[1], sb1, Cc); \
        float w[16]; \
        _Pragma("unroll") for (int i = 0; i < 16; ++i) { float v = __builtin_amdgcn_exp2f(z[i] - Cc[i]); if (diag && !(crow16(i, hh) < r)) v = 0.f; w[i] = v; } \
        const bf16x8 wb0 = pack8(w[0], w[1], w[2], w[3], w[4], w[5], w[6], w[7]), wb1 = pack8(w[8], w[9], w[10], w[11], w[12], w[13], w[14], w[15]); \
        O0 = MFMA32(VF[0][0], wb0, O0); O0 = MFMA32(VF[0][1], wb1, O0); O1 = MFMA32(VF[1][0], wb0, O1); O1 = MFMA32(VF[1][1], wb1, O1); \
        carry = __shfl(Cc[0], r); } while (0)
    bf16x8 kfA[4], vfA[2][2], kfB[4], vfB[2][2];
    ATT_LOAD(kfA, vfA, qb);
    for (int kb = qb; kb >= 0; kb -= 2) {
        ATT_LOAD(kfB, vfB, kb > 0 ? kb - 1 : 0); __builtin_amdgcn_sched_barrier(0);
        ATT_BLOCK(kfA, vfA, kb);
        if (kb == 0 || __all(carry > thr)) break;
        ATT_LOAD(kfA, vfA, kb > 1 ? kb - 2 : 0); __builtin_amdgcn_sched_barrier(0);
        ATT_BLOCK(kfB, vfB, kb - 1);
        if (__all(carry > thr)) break;
    }
#undef ATT_LOAD
#undef ATT_BLOCK
    float ss = 0.f;
#pragma unroll
    for (int i = 0; i < 16; ++i) ss += O0[i] * O0[i] + O1[i] * O1[i];
    ss += __shfl_xor(ss, 32);
    const float rs = 1.f / sqrtf(ss * (1.f / 64.f) + EPS);
    bf16* orow = (bf16*)(F.ws + WS_MIX) + ((size_t)b * SEQ + q0 + r) * D + h * 64;
#pragma unroll
    for (int db = 0; db < 2; ++db)
#pragma unroll
        for (int gq = 0; gq < 4; ++gq) { const int d = 32 * db + 8 * gq + 4 * hh; const f32x4 gg = gout[db][gq];
            const float a0 = (db ? O1[4 * gq + 0] : O0[4 * gq + 0]) * rs * gg.x, a1 = (db ? O1[4 * gq + 1] : O0[4 * gq + 1]) * rs * gg.y, a2 = (db ? O1[4 * gq + 2] : O0[4 * gq + 2]) * rs * gg.z, a3 = (db ? O1[4 * gq + 3] : O0[4 * gq + 3]) * rs * gg.w;
            *(GAS unsigned long long*)(orow + d) = (unsigned long long)pkbf(a0, a1) | ((unsigned long long)pkbf(a2, a3) << 32); }
}
__device__ __forceinline__ void attn_phase(Frame& F) {
    const int r = F.lane & 31, hh = F.lane >> 5;
    float mq = fabsf(F.sb_q_g[F.lane]), mk = fabsf(F.sb_k_g[F.lane]);
#pragma unroll
    for (int o = 1; o < 64; o <<= 1) { mq = fmaxf(mq, __shfl_xor(mq, o)); mk = fmaxf(mk, __shfl_xor(mk, o)); }
    const float thr = 64.f * QSCALE * mq * mk * 1.02f + 170.f;
    bf16x8 Lt[2];
#pragma unroll
    for (int ks = 0; ks < 2; ++ks) { float e[8];
#pragma unroll
        for (int jj = 0; jj < 8; ++jj) e[jj] = (16 * ks + 8 * (jj >> 2) + 4 * hh + (jj & 3) >= r) ? 1.f : 0.f;
        Lt[ks] = pack8(e[0], e[1], e[2], e[3], e[4], e[5], e[6], e[7]); }
    for (int it = F.gw; it < 2048; it += F.ngw) { const int bh = it & 127, j = it >> 7;
        attn_item(F, bh, 63 - j, thr, Lt); attn_item(F, bh, j, thr, Lt); attn_item(F, bh, 47 - j, thr, Lt); attn_item(F, bh, 16 + j, thr, Lt); }
}

constexpr int HG_PART = 0, HG_SSQ = 2048, HG_QE = 4096, HG_KE = HG_QE + 64 * 272, HG_VT = HG_KE + 64 * 272, HG_KST = HG_VT + 128 * 144, HG_ST = HG_KST + 128 * 144, HG_END = HG_ST + 128 * 272;
static_assert(HG_END <= RING_BYTES, "HGRN2 LDS map");
__device__ __forceinline__ float hg_lbound(Frame& F, int h, int d) { const int c = h * 128 + d; return 1.f / (1.f + __expf(F.hg_lb[512 + c] - F.hg_lb[c])); }
__device__ __forceinline__ void hg_gates(Frame& F, const unsigned short (&ffr)[16], float lb, int d, int tq, float (&bb)[16], float (&kk)[16], float& total) {
    float run = 0.f;
#pragma unroll
    for (int i = 0; i < 16; ++i) { const float ff = bf2f(ffr[i]); const float sg = __builtin_amdgcn_rcpf(1.f + __expf(-ff));
        const float f = lb + (1.f - lb) * sg; kk[i] = (1.f - lb) * (1.f - sg); run += __logf(f); bb[i] = run; }
    LAS float* part = (LAS float*)(F.lds + RING_OFF + HG_PART);
    part[tq * 128 + d] = run;
    __syncthreads();
    const float p0 = part[d], p1 = part[128 + d], p2 = part[256 + d], p3 = part[384 + d];
    const float off = (tq > 0 ? p0 : 0.f) + (tq > 1 ? p1 : 0.f) + (tq > 2 ? p2 : 0.f);
    total = (p0 + p1) + (p2 + p3);
#pragma unroll
    for (int i = 0; i < 16; ++i) bb[i] += off;
}
#define HG_HV() const bf16* const PHp = (const bf16*)(F.ws + WS_PH); \
    const __amdgpu_buffer_rsrc_t rsrcP = __builtin_amdgcn_make_buffer_rsrc((void*)PHp, 0, (int)((size_t)4 * T * 512 * 2), 0x00020000)
#define HG_SOFF(item_, arr_) ((unsigned)((((arr_) * 16 + (((item_) >> 5) >> 2)) * 4 + (((item_) >> 5) & 3)) * SEQ + ((item_) & 31) * 64) * 256u)
#define HG_ARR(col_) ((col_) == OFF_HQ ? 0 : (col_) == OFF_HF ? 1 : (col_) == OFF_HI ? 2 : 3)
#define HG_LOADT(dst2, item_, arr_) do { const unsigned so_ = (unsigned)__builtin_amdgcn_readfirstlane((int)HG_SOFF(item_, arr_)); _Pragma("unroll") for (int j_ = 0; j_ < 2; ++j_) \
        (dst2)[j_] = __builtin_bit_cast(v4u, __builtin_amdgcn_raw_buffer_load_b128(rsrcP, (unsigned)F.tid * 16u + 8192u * j_, so_, 0)); } while (0)
#define HG_PUT(src2, raw_) do { _Pragma("unroll") for (int j_ = 0; j_ < 2; ++j_) *(LAS v4u*)((raw_) + ((F.tid >> 4) + 32 * j_) * 272 + (F.tid & 15) * 16) = (src2)[j_]; } while (0)
#define HG_COL(dst, raw_) do { _Pragma("unroll") for (int i_ = 0; i_ < 16; ++i_) dst[i_] = *(const LAS unsigned short*)((raw_) + (16 * tq + i_) * 272 + 2 * d); } while (0)
template <bool PERMUTE> __device__ __forceinline__ void st16(LAS unsigned char* dst, const float (&v)[16]) {
    v4u a, b2;
    if (!PERMUTE) { a.x = pkbf(v[0], v[1]); a.y = pkbf(v[2], v[3]); a.z = pkbf(v[4], v[5]); a.w = pkbf(v[6], v[7]); b2.x = pkbf(v[8], v[9]); b2.y = pkbf(v[10], v[11]); b2.z = pkbf(v[12], v[13]); b2.w = pkbf(v[14], v[15]); }
    else { a.x = pkbf(v[0], v[1]); a.y = pkbf(v[2], v[3]); a.z = pkbf(v[8], v[9]); a.w = pkbf(v[10], v[11]); b2.x = pkbf(v[4], v[5]); b2.y = pkbf(v[6], v[7]); b2.z = pkbf(v[12], v[13]); b2.w = pkbf(v[14], v[15]); }
    *(LAS v4u*)dst = a; *(LAS v4u*)(dst + 16) = b2;
}
__device__ __forceinline__ void hgA_phase(Frame& F) {
    const int d = F.tid & 127, tq = F.tid >> 7, r = F.lane & 31, hh = F.lane >> 5;
    const bf16* P = (const bf16*)(F.ws + WS_P); bf16* KVS = (bf16*)(F.ws + WS_KVS); float* DEC = (float*)(F.ws + WS_DEC); float* SSEG = (float*)(F.ws + WS_SSEG); float* DSEG = (float*)(F.ws + WS_DSEG);
    LAS unsigned char* L = F.lds + RING_OFF; LAS float* decl = (LAS float*)(L + HG_SSQ);
    HG_HV();
    v4u rf[2], rv[2];
    LAS unsigned char* const RAWF = F.lds + ROWTAB_OFF; LAS unsigned char* const RAWV = L + HG_ST;
    for (int wg = blockIdx.x; wg < 256; wg += F.G) {
        const int bh = wg >> 2, seg = wg & 3, item0 = bh * 32 + seg * 8, h = bh & 3;
        HG_LOADT(rf, item0, 1); HG_LOADT(rv, item0, 2);
        const float lbv = hg_lbound(F, h, d); float totrun = 0.f;
        const int db = F.wave & 3, eb0 = 2 * (F.wave >> 2);
        f32x16 run0, run1;
#pragma unroll
        for (int i = 0; i < 16; ++i) { run0[i] = 0.f; run1[i] = 0.f; }
      for (int k = 0; k < 8; ++k) {
        const int item = item0 + k;
        HG_PUT(rf, RAWF); HG_PUT(rv, RAWV);
        __syncthreads();
        { const int nit = k < 7 ? item + 1 : item; HG_LOADT(rf, nit, 1); HG_LOADT(rv, nit, 2); __builtin_amdgcn_sched_barrier(0); }
        unsigned short ffr[16], vr[16]; HG_COL(ffr, RAWF); HG_COL(vr, RAWV);
        float bb[16], kk[16], total; hg_gates(F, ffr, lbv, d, tq, bb, kk, total);
        float ks[16], vv[16];
#pragma unroll
        for (int i = 0; i < 16; ++i) { ks[i] = kk[i] * __expf(total - bb[i]); vv[i] = bf2f(vr[i]); }
        st16<false>(L + HG_KST + d * 144 + tq * 32, ks); st16<false>(L + HG_VT + d * 144 + tq * 32, vv);
        const float dc = __expf(total); totrun += total;
        if (tq == 0) { DEC[(size_t)item * 128 + d] = dc; decl[d] = dc; }
        __syncthreads();
        f32x16 acc0, acc1;
#pragma unroll
        for (int i = 0; i < 16; ++i) { acc0[i] = 0.f; acc1[i] = 0.f; }
#pragma unroll
        for (int s = 0; s < 4; ++s) { const bf16x8 af = *(const LAS bf16x8*)(L + HG_KST + (db * 32 + r) * 144 + 32 * s + 16 * hh);
            const bf16x8 b0 = *(const LAS bf16x8*)(L + HG_VT + (eb0 * 32 + r) * 144 + 32 * s + 16 * hh), b1 = *(const LAS bf16x8*)(L + HG_VT + ((eb0 + 1) * 32 + r) * 144 + 32 * s + 16 * hh);
            acc0 = MFMA32(af, b0, acc0); acc1 = MFMA32(af, b1, acc1); }
#pragma unroll
        for (int g = 0; g < 4; ++g) { const f32x4 dl = *(const LAS f32x4*)(decl + db * 32 + 8 * g + 4 * hh);
#pragma unroll
            for (int ii = 0; ii < 4; ++ii) { run0[4 * g + ii] = dl[ii] * run0[4 * g + ii] + acc0[4 * g + ii]; run1[4 * g + ii] = dl[ii] * run1[4 * g + ii] + acc1[4 * g + ii]; } }
#pragma unroll
        for (int j = 0; j < 2; ++j) { bf16* dst = KVS + ((size_t)item * 128 + (eb0 + j) * 32 + r) * 128 + db * 32 + 4 * hh;
#pragma unroll
            for (int g = 0; g < 4; ++g) { const float a0 = j ? acc1[4 * g + 0] : acc0[4 * g + 0], a1 = j ? acc1[4 * g + 1] : acc0[4 * g + 1], a2 = j ? acc1[4 * g + 2] : acc0[4 * g + 2], a3 = j ? acc1[4 * g + 3] : acc0[4 * g + 3];
                *(GAS unsigned long long*)(dst + 8 * g) = (unsigned long long)pkbf(a0, a1) | ((unsigned long long)pkbf(a2, a3) << 32); } }
        __syncthreads();
      }
#pragma unroll
        for (int j = 0; j < 2; ++j) { float* dst = SSEG + ((size_t)wg * 128 + (eb0 + j) * 32 + r) * 128 + db * 32 + 4 * hh;
#pragma unroll
            for (int g = 0; g < 4; ++g) *(GAS f32x4*)(dst + 8 * g) = j ? (f32x4){run1[4 * g + 0], run1[4 * g + 1], run1[4 * g + 2], run1[4 * g + 3]} : (f32x4){run0[4 * g + 0], run0[4 * g + 1], run0[4 * g + 2], run0[4 * g + 3]}; }
        if (tq == 0) DSEG[(size_t)wg * 128 + d] = __expf(totrun);
    }
}
constexpr int HG_DECS = HG_END;
static_assert(HG_DECS + 4096 + 64 * 272 <= LDSCTL_OFF && HG_KST + 64 * 272 <= HG_ST && 64 * 272 <= MAXSLOT * 1536, "HGRN2 LDS map (decays, raw tiles)");
__device__ __forceinline__ void hgC_phase(Frame& F) {
    const int d = F.tid & 127, tq = F.tid >> 7, r = F.lane & 31, hh = F.lane >> 5;
    const bf16* P = (const bf16*)(F.ws + WS_P); const bf16* KVS = (const bf16*)(F.ws + WS_KVS); bf16* MIX = (bf16*)(F.ws + WS_MIX); const float* DEC = (const float*)(F.ws + WS_DEC);
    HG_HV();
    LAS unsigned char* L = F.lds + RING_OFF; const LAS float* decs = (const LAS float*)(L + HG_DECS);
    const int se = F.tid >> 2, sq = F.tid & 3;
    v4u rf[2], rq[2], rv[2], st[4];
    LAS unsigned char* const RAWF = L + HG_KST; LAS unsigned char* const RAWQ = F.lds + ROWTAB_OFF; LAS unsigned char* const RAWV = L + HG_DECS + 4096;
    const __amdgpu_buffer_rsrc_t rsrcG = __builtin_amdgcn_make_buffer_rsrc((void*)F.hg_out_g, 0, 512 * 4, 0x00020000), rsrcSS = __builtin_amdgcn_make_buffer_rsrc((void*)(F.ws + WS_SSEG), 0, 256 * 128 * 128 * 4, 0x00020000), rsrcDS = __builtin_amdgcn_make_buffer_rsrc((void*)(F.ws + WS_DSEG), 0, 256 * 128 * 4, 0x00020000);
    const __amdgpu_buffer_rsrc_t rsrcD = __builtin_amdgcn_make_buffer_rsrc((void*)DEC, 0, 64 * 32 * 128 * 4, 0x00020000), rsrcM = __builtin_amdgcn_make_buffer_rsrc((void*)MIX, 0, (int)((size_t)T * D * 2), 0x00020000);
    const __amdgpu_buffer_rsrc_t rsrcK = __builtin_amdgcn_make_buffer_rsrc((void*)KVS, 0, 64 * 32 * 128 * 128 * 2, 0x00020000); const unsigned kvo = (unsigned)((se * 128 + sq * 32) * 2);
#define HG_LOADKV(dst_, item_) do { const unsigned so_ = (unsigned)__builtin_amdgcn_readfirstlane((int)((item_) * (128 * 128 * 2))); _Pragma("unroll") for (int j_ = 0; j_ < 4; ++j_) (dst_)[j_] = __builtin_bit_cast(v4u, __builtin_amdgcn_raw_buffer_load_b128(rsrcK, kvo + 16u * j_, so_, 0)); } while (0)
#define HG_LOADST(item_) HG_LOADKV(st, item_)
#define HG_FOLD(kv_, c_) do { _Pragma("unroll") for (int j_ = 0; j_ < 4; ++j_) { const f32x4 d0_ = *(const LAS f32x4*)(decs + (c_) * 128 + sq * 32 + 8 * j_), d1_ = *(const LAS f32x4*)(decs + (c_) * 128 + sq * 32 + 8 * j_ + 4); const v4u k_ = (kv_)[j_]; \
        S[8 * j_ + 0] = d0_.x * S[8 * j_ + 0] + bflo(k_.x); S[8 * j_ + 1] = d0_.y * S[8 * j_ + 1] + bfhi(k_.x); S[8 * j_ + 2] = d0_.z * S[8 * j_ + 2] + bflo(k_.y); S[8 * j_ + 3] = d0_.w * S[8 * j_ + 3] + bfhi(k_.y); \
        S[8 * j_ + 4] = d1_.x * S[8 * j_ + 4] + bflo(k_.z); S[8 * j_ + 5] = d1_.y * S[8 * j_ + 5] + bfhi(k_.z); S[8 * j_ + 6] = d1_.z * S[8 * j_ + 6] + bflo(k_.w); S[8 * j_ + 7] = d1_.w * S[8 * j_ + 7] + bfhi(k_.w); } } while (0)
    for (int wg = blockIdx.x; wg < 256; wg += F.G) {
        const int bh = wg >> 2, seg = wg & 3, item0 = bh * 32 + seg * 8, b = bh >> 2, h = bh & 3;
        if (F.tid < 256) { const unsigned so = (unsigned)__builtin_amdgcn_readfirstlane((bh * 32 + seg * 8) * 128 * 4);
            *((LAS f32x4*)(L + HG_DECS) + F.tid) = __builtin_bit_cast(f32x4, __builtin_amdgcn_raw_buffer_load_b128(rsrcD, (unsigned)F.tid * 16u, so, 0)); }
        __syncthreads();
        const float lbv = hg_lbound(F, h, d);
        float S[32];
#pragma unroll
        for (int j = 0; j < 32; ++j) S[j] = 0.f;
        for (int sp = 0; sp < seg; ++sp) {
            const unsigned sso = (unsigned)__builtin_amdgcn_readfirstlane((bh * 4 + sp) * 128 * 128 * 4), dso = (unsigned)__builtin_amdgcn_readfirstlane((bh * 4 + sp) * 128 * 4);
#pragma unroll
            for (int j0 = 0; j0 < 8; j0 += 4) { f32x4 sv[4], dv[4];
#pragma unroll
                for (int j = 0; j < 4; ++j) { sv[j] = __builtin_bit_cast(f32x4, __builtin_amdgcn_raw_buffer_load_b128(rsrcSS, (unsigned)((se * 128 + sq * 32) * 4) + 16u * (j0 + j), sso, 0));
                    dv[j] = __builtin_bit_cast(f32x4, __builtin_amdgcn_raw_buffer_load_b128(rsrcDS, (unsigned)(sq * 32 * 4) + 16u * (j0 + j), dso, 0)); }
#pragma unroll
                for (int j = 0; j < 4; ++j) { const int q = 4 * (j0 + j); S[q + 0] = dv[j].x * S[q + 0] + sv[j].x; S[q + 1] = dv[j].y * S[q + 1] + sv[j].y; S[q + 2] = dv[j].z * S[q + 2] + sv[j].z; S[q + 3] = dv[j].w * S[q + 3] + sv[j].w; } }
        }
        HG_LOADT(rf, item0, 1); HG_LOADT(rq, item0, 0); HG_LOADT(rv, item0, 2); HG_LOADST(item0);
      for (int k = 0; k < 8; ++k) {
        const int item = item0 + k, c = seg * 8 + k;
        const int tb = F.wave & 1, eb = F.wave >> 1;
        const int nit = k < 7 ? item + 1 : item;
        HG_PUT(rf, RAWF); HG_PUT(rq, RAWQ); HG_PUT(rv, RAWV);
        __syncthreads();
        HG_LOADT(rf, nit, 1); HG_LOADT(rq, nit, 0); HG_LOADT(rv, nit, 2); __builtin_amdgcn_sched_barrier(0);
        unsigned short ffr[16], qr[16], vr[16]; HG_COL(ffr, RAWF); HG_COL(qr, RAWQ); HG_COL(vr, RAWV);
        float bb[16], kk[16], total; hg_gates(F, ffr, lbv, d, tq, bb, kk, total);
        float vv[16];
#pragma unroll
        for (int i = 0; i < 16; ++i) { const int t = 16 * tq + i; const float q = bf2f(qr[i]);
            *(LAS unsigned short*)(L + HG_QE + t * 272 + 2 * d) = (unsigned short)pkbf(q * __expf(bb[i]), 0.f);
            *(LAS unsigned short*)(L + HG_KE + t * 272 + 2 * d) = (unsigned short)pkbf(kk[i] * __expf(-bb[i]), 0.f);
            vv[i] = bf2f(vr[i]); }
        st16<true>(L + HG_VT + d * 144 + tq * 32, vv);
#pragma unroll
        for (int j = 0; j < 4; ++j) { v4u w4; w4.x = pkbf(S[8 * j + 0], S[8 * j + 1]); w4.y = pkbf(S[8 * j + 2], S[8 * j + 3]); w4.z = pkbf(S[8 * j + 4], S[8 * j + 5]); w4.w = pkbf(S[8 * j + 6], S[8 * j + 7]);
            *(LAS v4u*)(L + HG_ST + se * 272 + sq * 64 + 16 * j) = w4; }
        HG_FOLD(st, k);
        unsigned long long grv[4];
        { const bf16* grow_ = PHp + (((size_t)(3 * 16 + b) * 4 + h) * SEQ + c * 64 + tb * 32 + r) * 128;
#pragma unroll
            for (int g = 0; g < 4; ++g) grv[g] = *(const GAS unsigned long long*)(grow_ + eb * 32 + 8 * g + 4 * hh); }
        HG_LOADST(nit); __builtin_amdgcn_sched_barrier(0);
        __syncthreads();
        f32x16 acc;
#pragma unroll
        for (int i = 0; i < 16; ++i) acc[i] = 0.f;
#define HG_QF(s_) (*(const LAS bf16x8*)(L + HG_QE + (tb * 32 + r) * 272 + 32 * (s_) + 16 * hh))
#pragma unroll
        for (int s = 0; s < 8; ++s) acc = MFMA32(*(const LAS bf16x8*)(L + HG_ST + (eb * 32 + r) * 272 + 32 * s + 16 * hh), HG_QF(s), acc);
        for (int sb = 0; sb <= tb; ++sb) {
            f32x16 at;
#pragma unroll
            for (int i = 0; i < 16; ++i) at[i] = 0.f;
#pragma unroll
            for (int s = 0; s < 8; ++s) at = MFMA32(*(const LAS bf16x8*)(L + HG_KE + (sb * 32 + r) * 272 + 32 * s + 16 * hh), HG_QF(s), at);
            float a[16];
#pragma unroll
            for (int i = 0; i < 16; ++i) a[i] = (sb < tb || crow16(i, hh) <= r) ? at[i] : 0.f;
            const bf16x8 ab0 = pack8(a[0], a[1], a[2], a[3], a[4], a[5], a[6], a[7]), ab1 = pack8(a[8], a[9], a[10], a[11], a[12], a[13], a[14], a[15]);
            acc = MFMA32(*(const LAS bf16x8*)(L + HG_VT + (eb * 32 + r) * 144 + sb * 64 + 0 + 16 * hh), ab0, acc);
            acc = MFMA32(*(const LAS bf16x8*)(L + HG_VT + (eb * 32 + r) * 144 + sb * 64 + 32 + 16 * hh), ab1, acc);
        }
        float ss = 0.f;
#pragma unroll
        for (int i = 0; i < 16; ++i) ss += acc[i] * acc[i];
        ss += __shfl_xor(ss, 32);
        LAS float* ssq = (LAS float*)(L + HG_SSQ);
        if (hh == 0) ssq[eb * 64 + tb * 32 + r] = ss;
        f32x4 ggv[4];
        { const unsigned so = (unsigned)__builtin_amdgcn_readfirstlane(h * 512);
#pragma unroll
            for (int g = 0; g < 4; ++g) ggv[g] = __builtin_bit_cast(f32x4, __builtin_amdgcn_raw_buffer_load_b128(rsrcG, (unsigned)((eb * 32 + 8 * g + 4 * hh) * 4), so, 0)); }
        __syncthreads();
        const int tl = tb * 32 + r; const float tot = (ssq[tl] + ssq[64 + tl]) + (ssq[128 + tl] + ssq[192 + tl]);
        const float rs = 1.f / sqrtf(tot * (1.f / 128.f) + EPS);
        const unsigned mso = (unsigned)__builtin_amdgcn_readfirstlane((int)((((unsigned)b * SEQ + c * 64) * D + 512 + h * 128) * 2)), mvo = (unsigned)((tl * D + eb * 32 + 4 * hh) * 2);
#pragma unroll
        for (int g = 0; g < 4; ++g) { const int e = eb * 32 + 8 * g + 4 * hh; const unsigned long long gr = grv[g]; const f32x4 gg = ggv[g];
            const float g0 = bflo((unsigned)gr), g1 = bfhi((unsigned)gr), g2 = bflo((unsigned)(gr >> 32)), g3 = bfhi((unsigned)(gr >> 32));
            const float y0 = acc[4 * g + 0] * rs * gg.x * (g0 * __builtin_amdgcn_rcpf(1.f + __expf(-g0))), y1 = acc[4 * g + 1] * rs * gg.y * (g1 * __builtin_amdgcn_rcpf(1.f + __expf(-g1)));
            const float y2 = acc[4 * g + 2] * rs * gg.z * (g2 * __builtin_amdgcn_rcpf(1.f + __expf(-g2))), y3 = acc[4 * g + 3] * rs * gg.w * (g3 * __builtin_amdgcn_rcpf(1.f + __expf(-g3)));
            typedef unsigned u32x2_t __attribute__((ext_vector_type(2))); __builtin_amdgcn_raw_buffer_store_b64((u32x2_t){pkbf(y0, y1), pkbf(y2, y3)}, rsrcM, mvo + 16u * g, mso, 0); }
        __syncthreads();
      }
    }
#undef HG_LOADST
#undef HG_LOADKV
#undef HG_FOLD
#undef HG_QF
}
#undef HG_LOADT
#undef HG_PUT
#undef HG_COL
#undef HG_ARR
#undef HG_SOFF
#undef HG_HV

__device__ __forceinline__ void router_phase(Frame& F) {
    LAS unsigned char* L = F.lds; const int r = F.lane & 31, hh = F.lane >> 5;
    LAS unsigned* lcnt = (LAS unsigned*)(F.lds + LTAB_OFF) + LT_MISC; LAS unsigned* lbase = lcnt + 32; LAS float* lrstd = (LAS float*)(F.lds + ROWTAB_OFF);
    float* TOPG = (float*)(F.ws + WS_TOPG);
    {
        const GAS v4u* img = (const GAS v4u*)(F.ws + WS_RT) + vzero();
        for (int q0 = F.tid; q0 < RT_END / 16; q0 += 4 * NWAVES * 64) { v4u t4[4];
#pragma unroll
            for (int j = 0; j < 4; ++j) { const int q = q0 + j * NWAVES * 64; t4[j] = img[q < RT_END / 16 ? q : 0]; }
#pragma unroll
            for (int j = 0; j < 4; ++j) { const int q = q0 + j * NWAVES * 64; if (q < RT_END / 16) *(LAS v4u*)(L + 16 * q) = t4[j]; } }
    }
    const bf16* XH = (const bf16*)(F.ws + WS_XN); int* LIST = (int*)(F.ws + WS_LIST); unsigned* cnt = (unsigned*)(F.ctl + CW_CNT);
    for (int base = blockIdx.x * 4; base < T / 32; base += F.G * 4) {
        const int grp = base + F.wave; const bool active = F.wave < 4 && grp < T / 32;
        if (F.tid < 32) lcnt[F.tid] = 0u;
        __syncthreads();
        float sv[4] = {0.f, 0.f, 0.f, 0.f}; int se[4] = {0, 0, 0, 0}; unsigned lp0 = 0u, lp1 = 0u; float rstd = 0.f; const int tok = grp * 32 + r;
        if (active) {
            const bf16* hrow = XH + (size_t)tok * D + 8 * hh;
            f32x16 acc;
#pragma unroll
            for (int i = 0; i < 16; ++i) acc[i] = 0.f;
            float ssq = 0.f;
#pragma unroll 16
            for (int s = 0; s < 64; ++s) {
                const v4u hu = *(const GAS v4u*)(hrow + 16 * s); const bf16x8 hi = __builtin_bit_cast(bf16x8, hu);
                { const float a0 = bflo(hu.x), a1 = bfhi(hu.x), a2 = bflo(hu.y), a3 = bfhi(hu.y), a4 = bflo(hu.z), a5 = bfhi(hu.z), a6 = bflo(hu.w), a7 = bfhi(hu.w);
                    ssq += (a0 * a0 + a1 * a1) + (a2 * a2 + a3 * a3) + (a4 * a4 + a5 * a5) + (a6 * a6 + a7 * a7); }
                const bf16x8 wh = *(const LAS bf16x8*)(L + r * RT_ROW + 32 * s + 16 * hh), wl = *(const LAS bf16x8*)(L + RT_WL + r * RT_ROW + 32 * s + 16 * hh);
                acc = MFMA32(wh, hi, acc); acc = MFMA32(wl, hi, acc);
            }
            ssq += __shfl_xor(ssq, 32);
            rstd = 1.f / sqrtf(ssq * (1.f / D) + EPS);
            float l[16];
#pragma unroll
            for (int i = 0; i < 16; ++i) l[i] = acc[i] * rstd + F.b_router[crow16(i, hh)];
            float cv[8]; int ce[8];
#pragma unroll
            for (int rnd = 0; rnd < 4; ++rnd) { float bv = l[0]; int bi = 0;
#pragma unroll
                for (int i = 1; i < 16; ++i) if (l[i] > bv) { bv = l[i]; bi = i; }
                cv[rnd] = bv; ce[rnd] = crow16(bi, hh);
#pragma unroll
                for (int i = 0; i < 16; ++i) if (i == bi) l[i] = -__builtin_inff(); }
#pragma unroll
            for (int j = 0; j < 4; ++j) { cv[4 + j] = __shfl_xor(cv[j], 32); ce[4 + j] = __shfl_xor(ce[j], 32); }
#pragma unroll
            for (int rnd = 0; rnd < 4; ++rnd) { float bv = cv[0]; int be = ce[0]; int bj = 0;
#pragma unroll
                for (int j = 1; j < 8; ++j) if (cv[j] > bv || (cv[j] == bv && ce[j] < be)) { bv = cv[j]; be = ce[j]; bj = j; }
                sv[rnd] = bv; se[rnd] = be;
#pragma unroll
                for (int j = 0; j < 8; ++j) if (j == bj) { cv[j] = -__builtin_inff(); ce[j] = 64; } }
            lp0 = __hip_atomic_fetch_add(lcnt + (hh ? se[2] : se[0]), 1u, __ATOMIC_RELAXED, __HIP_MEMORY_SCOPE_WORKGROUP);
            lp1 = __hip_atomic_fetch_add(lcnt + (hh ? se[3] : se[1]), 1u, __ATOMIC_RELAXED, __HIP_MEMORY_SCOPE_WORKGROUP);
        }
        __syncthreads();
        if (F.tid < 32) lbase[F.tid] = __hip_atomic_fetch_add(cnt + F.tid, lcnt[F.tid], __ATOMIC_RELAXED, __HIP_MEMORY_SCOPE_AGENT);
        __syncthreads();
        if (active) {
            const float e1 = __expf(sv[1] - sv[0]), e2 = __expf(sv[2] - sv[0]), e3 = __expf(sv[3] - sv[0]); const float inv = 1.f / (1.f + e1 + e2 + e3);
            const int ea = hh ? se[2] : se[0], eb = hh ? se[3] : se[1]; const float ga = (hh ? e2 : 1.f) * inv, gb = (hh ? e3 : e1) * inv;
            const size_t ia = (size_t)ea * 32768 + lbase[ea] + lp0, ib = (size_t)eb * 32768 + lbase[eb] + lp1;
            LIST[ia] = tok * 4 + 2 * hh; LIST[ib] = tok * 4 + 2 * hh + 1; TOPG[tok * 4 + 2 * hh] = ga; TOPG[tok * 4 + 2 * hh + 1] = gb;
            if (hh == 0) lrstd[F.wave * 32 + r] = rstd;
        }
        __syncthreads();
        {
            unsigned char* X8 = F.ws + WS_X8; const int t0 = base * 32;
#pragma unroll
            for (int q0 = 0; q0 < 16; q0 += 4) { v4u a[4][2];
#pragma unroll
                for (int q = 0; q < 4; ++q) { const int tt = t0 + F.wave * 16 + q0 + q; const GAS v4u* p = (const GAS v4u*)(XH + (size_t)(tt < T ? tt : 0) * D) + 2 * F.lane; a[q][0] = p[0]; a[q][1] = p[1]; }
#pragma unroll
                for (int q = 0; q < 4; ++q) { const int tl = F.wave * 16 + q0 + q, tt = t0 + tl; if (tt < T) { const float rs = lrstd[tl]; v4u o;
                    o.x = pg8::pk4_fp8(bflo(a[q][0].x) * rs, bfhi(a[q][0].x) * rs, bflo(a[q][0].y) * rs, bfhi(a[q][0].y) * rs); o.y = pg8::pk4_fp8(bflo(a[q][0].z) * rs, bfhi(a[q][0].z) * rs, bflo(a[q][0].w) * rs, bfhi(a[q][0].w) * rs);
                    o.z = pg8::pk4_fp8(bflo(a[q][1].x) * rs, bfhi(a[q][1].x) * rs, bflo(a[q][1].y) * rs, bfhi(a[q][1].y) * rs); o.w = pg8::pk4_fp8(bflo(a[q][1].z) * rs, bfhi(a[q][1].z) * rs, bflo(a[q][1].w) * rs, bfhi(a[q][1].w) * rs);
                    *((GAS v4u*)(X8 + (size_t)tt * D) + F.lane) = o; } } }
        }
        __syncthreads();
    }
}
__device__ __forceinline__ int build_moe_tables(Frame& F, int ntn, int mode) {
    LAS int* lt = (LAS int*)(F.lds + LTAB_OFF);
    if (F.wave == 0) {
        const int e = F.lane & 31; const int c = (int)__hip_atomic_load((unsigned*)(F.ctl + CW_CNT) + e, __ATOMIC_RELAXED, __HIP_MEMORY_SCOPE_AGENT);
        const int tl = (c + 255) >> 8; int inc = tl;
#pragma unroll
        for (int off = 1; off < 32; off <<= 1) { const int o = __shfl_up(inc, off, 32); if (e >= off) inc += o; }
        const int tot = __shfl(inc, 31, 32), t0 = inc - tl;
        if (F.lane < 32) { lt[LT_TS + e] = t0; lt[LT_CNT + e] = c; for (int i = 0; i < tl; ++i) lt[t0 + i] = e; }
        if (F.lane == 0) lt[LT_MISC + 64] = tot;
    }
    __syncthreads();
    int nt = lt[LT_MISC + 64]; nt = nt < 0 ? 0 : (nt > MAXTILES ? MAXTILES : nt); nt = __builtin_amdgcn_readfirstlane(nt);
    const int* LIST = (const int*)(F.ws + WS_LIST);
    const int nslot = mode == 1 ? MAXSLOT : (MAXTILES * 4 + 255) / 256;
    for (int q = F.tid; q < nslot * 256; q += NWAVES * 64) { const int i = q >> 8, rr = q & 255; const int Lu = i * F.G + F.vcu;
        int li = -1; float bias = 0.f;
        if (Lu < nt * ntn) { const int pm0 = Lu / ntn, pl = Lu - pm0 * ntn, pm = mode == 2 ? nt - 1 - pm0 : pm0, e = lt[pm], idx = (pm - lt[LT_TS + e]) * 256 + rr; if (idx < lt[LT_CNT + e]) li = LIST[(size_t)e * 32768 + idx];
            bias = mode == 1 ? F.b_gu[(size_t)e * 2048 + (rr >> 7) * 1024 + pl * 128 + (rr & 127)] : F.b_d[(size_t)e * 1024 + pl * 256 + rr]; }
        ((LAS float*)(F.lds + ROWTAB_OFF))[q] = bias;
        if (mode == 1) ((LAS unsigned short*)(F.lds + ROWTAB2_OFF))[q] = (unsigned short)(li < 0 ? 0 : (li >> 2));
        else ((LAS int*)(F.lds + ROWTAB_OFF) + nslot * 256)[q] = li; }
    __syncthreads();
    return nt;
}
__device__ __forceinline__ void combine_phase(Frame& F) {
    const unsigned char* YK = F.ws + WS_YK; const bf16* XH = (const bf16*)(F.ws + WS_XN); const float* TOPG = (const float*)(F.ws + WS_TOPG);
    for (int t = F.gw; t < T; t += F.ngw) {
        GAS f32x4* xr = (GAS f32x4*)(F.out + (size_t)t * D) + F.lane; f32x4 v[4]; unsigned y[4][4]; const f32x4 gt = *((const GAS f32x4*)TOPG + t + vzero()) * (1.0f / Y8_SCALE);
#pragma unroll
        for (int j = 0; j < 4; ++j) { const unsigned long long xh = __builtin_nontemporal_load((const GAS unsigned long long*)(XH + (size_t)t * D) + F.lane + 64 * j);
            v[j] = (f32x4){bflo((unsigned)xh), bfhi((unsigned)xh), bflo((unsigned)(xh >> 32)), bfhi((unsigned)(xh >> 32))};
#pragma unroll
            for (int k = 0; k < 4; ++k) y[j][k] = __builtin_nontemporal_load((const GAS unsigned*)(YK + ((size_t)t * 4 + k) * D) + F.lane + 64 * j); }
#pragma unroll
        for (int j = 0; j < 4; ++j) { f32x4 s4 = {0.f, 0.f, 0.f, 0.f};
#pragma unroll
            for (int k = 0; k < 4; ++k) { const f32x2n_ lo = __builtin_amdgcn_cvt_pk_f32_fp8((int)y[j][k], false), hi = __builtin_amdgcn_cvt_pk_f32_fp8((int)y[j][k], true); const float g = gt[k]; s4.x += g * lo.x; s4.y += g * lo.y; s4.z += g * hi.x; s4.w += g * hi.y; }
            v[j] = v[j] + s4;
            __builtin_nontemporal_store(v[j], xr + 64 * j); }
    }
}

constexpr int NPH = 9;
struct Args { const float* in[16]; float* out; unsigned char* ws; int ph_lo, ph_hi; };
__global__ void __launch_bounds__(NWAVES * 64, 2) fwd(Args args) {
    extern __shared__ __attribute__((aligned(16))) unsigned char lds[];
    Frame F;
    F.lds = (LAS unsigned char*)lds;
    F.MISC = (volatile LAS unsigned*)(F.lds + MISC_OFF);
    F.tid = threadIdx.x; F.lane = F.tid & 63; F.wave = __builtin_amdgcn_readfirstlane(F.tid >> 6);
    F.G = gridDim.x; { const int bx = blockIdx.x; F.vcu = (F.G % 8 == 0) ? (bx % 8) * (F.G / 8) + bx / 8 : bx; }
    F.gw = blockIdx.x * NWAVES + F.wave; F.ngw = F.G * NWAVES;
    F.ws = args.ws; F.ctl = (gu32*)(args.ws + WS_CTL); F.out = args.out;
    F.x = args.in[0]; F.norm1_g = args.in[1]; F.w_in = args.in[2]; F.sb_q_g = args.in[3]; F.sb_k_g = args.in[4]; F.sb_out_g = args.in[5]; F.hg_lb = args.in[6]; F.hg_out_g = args.in[7];
    F.w_out = args.in[8]; F.norm2_g = args.in[9]; F.w_router = args.in[10]; F.b_router = args.in[11]; F.w_gu = args.in[12]; F.b_gu = args.in[13]; F.w_d = args.in[14]; F.b_d = args.in[15];
    for (int u = F.tid; u < (LDS_BYTES - LDSCTL_OFF) / 4; u += NWAVES * 64) ((LAS unsigned*)(F.lds + LDSCTL_OFF))[u] = 0u;
    __syncthreads();
    XcdBarrier bar; bar.bar = (unsigned*)(F.ctl + CW_BAR); bar.x = 0; bar.st = nullptr;
    if (MK_ONE_LAUNCH) bar = xcd_barrier_post((unsigned*)(F.ctl + CW_BAR), F.MISC + 8);
    const int lo = args.ph_lo, hi = args.ph_hi;
#define IN(k) (lo <= (k) && (k) < hi && ((F.lane = lane_id()), (F.tid = F.wave * 64 + F.lane), true))
#define SEAM(k) do { if (IN(k) && IN((k) + 1)) xcd_barrier(bar); } while (0)

    if (IN(0)) { p0_prologue(F); } SEAM(0);
    if (IN(1)) {
        pg8::Gemm g{(const bf16*)(F.ws + WS_XN), (const bf16*)(F.ws + WS_WIN), T, NIN, D}; pg8::StaticOrder S; S.init(T, NIN, F.G, (int)blockIdx.x);
        pg8::EpiInproj E{(bf16*)(F.ws + WS_P), (bf16*)(F.ws + WS_PH), (bf16*)(F.ws + WS_QN), (bf16*)(F.ws + WS_KN), F.sb_q_g, F.sb_k_g, QSCALE, EPS};
        pg8::gemm_phase<pg8::EpiInproj, pg8::StaticOrder, PG8_ALIGN, PG8_SP2>(F.lds + RING_OFF, g, S, E, F.tid);
    } SEAM(1);
    if (IN(2)) { prep_phase(F); __syncthreads(); hgA_phase(F); } SEAM(2);
    if (IN(3)) { attn_phase(F); hgC_phase(F); } SEAM(3);
    if (IN(4)) {
        pg8::Gemm g{(const bf16*)(F.ws + WS_MIX), (const bf16*)(F.ws + WS_WOUT), T, D, D}; pg8::StaticOrder S; S.init(T, D, F.G, (int)blockIdx.x);
        pg8::EpiRes E{F.x, (bf16*)(F.ws + WS_XN), D};
        pg8::gemm_phase<pg8::EpiRes, pg8::StaticOrder, PG8_ALIGN, PG8_SP2>(F.lds + RING_OFF, g, S, E, F.tid);
    } SEAM(4);
    if (IN(5)) { router_phase(F); } SEAM(5);
    if (IN(6)) {
        const int nt = build_moe_tables(F, 8, 1); const LAS int* lt = (const LAS int*)(F.lds + LTAB_OFF);
        pg8::Gemm g{(const bf16*)(F.ws + WS_X8), (const bf16*)(F.ws + WS_WGU), MAXROWS, NE * 2048, D / 2};
        pg8::MoeOrder S{lt, (const LAS unsigned short*)(F.lds + ROWTAB2_OFF), 8, nt * 8, F.G, F.vcu, 1024u, 0};
        pg8::EpiAct<true> E{F.ws + WS_ACT, (const LAS float*)(F.lds + ROWTAB_OFF), A8_SCALE};
        pg8::gemm_phase<pg8::EpiAct<true>, pg8::MoeOrder, PG8_ALIGN, PG8_SP2, true, SC_W8, SC_ONE>(F.lds + RING_OFF, g, S, E, F.tid);
    } SEAM(6);
    if (IN(7)) {
        const int nt = build_moe_tables(F, 4, 2); const LAS int* lt = (const LAS int*)(F.lds + LTAB_OFF);
        pg8::Gemm g{(const bf16*)(F.ws + WS_ACT), (const bf16*)(F.ws + WS_WD), MAXROWS, NE * 1024, D / 2};
        pg8::MoeOrder S{lt, nullptr, 4, nt * 4, F.G, F.vcu, 1024u, nt};
        pg8::EpiDown E{F.ws + WS_YK, (const LAS int*)(F.lds + ROWTAB_OFF) + ((MAXTILES * 4 + 255) / 256) * 256, (const LAS float*)(F.lds + ROWTAB_OFF), Y8_SCALE};
        pg8::gemm_phase<pg8::EpiDown, pg8::MoeOrder, PG8_ALIGN, PG8_SP2, true, SC_W8Y, SC_A8>(F.lds + RING_OFF, g, S, E, F.tid);
    } SEAM(7);
    if (IN(8)) { combine_phase(F); }
#undef IN
#undef SEAM
}

extern "C" void kernel_launch(void* const* d_in, const int* in_sizes, int n_in, void* d_out, int out_size, void* d_ws, size_t ws_size, hipStream_t stream) {
    static int grid = 0;
    if (grid == 0) {
        if (n_in != 16 || in_sizes[0] != T * D || out_size != T * D || ws_size < WS_END) { fprintf(stderr, "kernel_launch: shape/workspace mismatch (n_in %d, ws %zu, need %zu); nothing launched\n", n_in, ws_size, (size_t)WS_END); grid = -1; return; }
        int dev = 0, cus = 0, per_cu = 0;
        if (hipGetDevice(&dev) != hipSuccess || hipDeviceGetAttribute(&cus, hipDeviceAttributeMultiprocessorCount, dev) != hipSuccess) { grid = -1; return; }
        if (hipFuncSetAttribute((const void*)fwd, hipFuncAttributeMaxDynamicSharedMemorySize, LDS_BYTES) != hipSuccess) { grid = -1; return; }
        if (hipOccupancyMaxActiveBlocksPerMultiprocessor(&per_cu, (const void*)fwd, NWAVES * 64, LDS_BYTES) != hipSuccess || per_cu < 1) { fprintf(stderr, "kernel_launch: occupancy query says %d\n", per_cu); }
        (void)hipGetLastError();
        if ((MAXTILES * 8 + cus - 1) / cus > MAXSLOT || cus < 1) { fprintf(stderr, "kernel_launch: %d CUs: the per-workgroup unit tables are sized for 256\n", cus); grid = -1; return; }
        grid = cus;
    }
    if (grid < 0) return;
    if (hipMemsetAsync((char*)d_ws + WS_CTL, 0, CTL_ZERO_BYTES, stream) != hipSuccess) return;
    Args a{};
    for (int i = 0; i < 16; ++i) a.in[i] = (const float*)d_in[i];
    a.out = (float*)d_out; a.ws = (unsigned char*)d_ws;
#if MK_ONE_LAUNCH
    a.ph_lo = 0; a.ph_hi = NPH;
    hipLaunchKernelGGL(fwd, dim3(grid), dim3(NWAVES * 64), LDS_BYTES, stream, a);
#else
    for (int p = 0; p < NPH; ++p) { a.ph_lo = p; a.ph_hi = p + 1; hipLaunchKernelGGL(fwd, dim3(grid), dim3(NWAVES * 64), LDS_BYTES, stream, a); }
#endif
}
```

```cpp
#include <hip/hip_runtime.h>
#include <cstdio>
#include <cstdint>
namespace pg8 {
#define PG8_LAS __attribute__((address_space(3)))
typedef unsigned short bf16_t;
typedef short bf16x8 __attribute__((ext_vector_type(8)));
typedef float f32x4 __attribute__((ext_vector_type(4)));
typedef unsigned u32x4 __attribute__((ext_vector_type(4)));
typedef int i32x4_t __attribute__((ext_vector_type(4)));
typedef int i32x8_t __attribute__((ext_vector_type(8)));
constexpr int BM = 256, BK = 64, HALF = 128, HTB = HALF * BK * 2  , STAGE_BYTES = 8 * HTB, NXCD = 8, WGM = 8;

__host__ __device__ __forceinline__ int lds_byte(int r, int c) { const int st = (r >> 4) * 2 + (c >> 5), rr = r & 15, cc = c & 31, ob = rr * 64 + cc * 2; return st * 1024 + (ob ^ (((ob >> 9) & 1) << 5)); }
__host__ __device__ __forceinline__ void stage_rc(int b, int& R, int& C) { const int st = b / 1024, sb = b % 1024, swz = sb ^ (((sb >> 9) & 1) << 5); R = (st >> 1) * 16 + swz / 64; C = (st & 1) * 32 + (swz % 64) / 2; }
__host__ __device__ __forceinline__ int perm32(int rho) { const int n = rho >> 4, i = rho & 15; return 8 * (i >> 2) + 4 * n + (i & 3); }

struct Unit { int pm, pn, slot; };
struct Gemm { const bf16_t* A; const bf16_t* Bt; int M, N, K; };

struct StaticOrder {
    int nM, nN, nwg, G, c;
    __host__ __device__ void init(int M, int N, int G_, int c_) { nM = M / BM; nN = N / BM; nwg = nM * nN; G = G_; c = c_; }
    __host__ __device__ bool next(int i, Unit& u) const {
        const long L = (long)i * G + c; if (L >= nwg) return false;
        int wgid = (int)L; { const int q = nwg / NXCD, r = nwg % NXCD, xcd = wgid % NXCD, off = wgid / NXCD; wgid = (xcd < r ? xcd * (q + 1) : r * (q + 1) + (xcd - r) * q) + off; }
        const int nig = WGM * nN, gid = wgid / nig, fm = gid * WGM, gsz = (nM - fm) < WGM ? (nM - fm) : WGM;
        u.pm = fm + ((wgid % nig) % gsz); u.pn = (wgid % nig) / gsz; return true;
    }
    __device__ __forceinline__ void a_ready(const Unit&) const {}
    __device__ __forceinline__ void done(const Unit&) const {}
};

__device__ __forceinline__ unsigned cvt_pk_bf16(float lo, float hi) { unsigned r; asm volatile("v_cvt_pk_bf16_f32 %0, %1, %2" : "=v"(r) : "v"(lo), "v"(hi)); return r; }
typedef float f32x2 __attribute__((ext_vector_type(2)));
__device__ __forceinline__ f32x2 gelu_pk(f32x2 v) {
    const f32x2 av = __builtin_elementwise_abs(v), d = av * 0.2316418882f + 1.0f;
    f32x2 t; t.x = __builtin_amdgcn_rcpf(d.x); t.y = __builtin_amdgcn_rcpf(d.y);
    f32x2 q = t * 0.5307027145f + (-0.7265760135f); q = q * t + 0.7107068705f; q = q * t + (-0.142248368f); q = q * t + 0.127414796f; q = q * t;
    const f32x2 s = (v * v) * (-0.72134752044f);
    f32x2 e; e.x = __builtin_amdgcn_exp2f(s.x); e.y = __builtin_amdgcn_exp2f(s.y);
    const f32x2 m = v * (q * e), r = v - m;
    f32x2 o; o.x = v.x < 0.f ? m.x : r.x; o.y = v.y < 0.f ? m.y : r.y; return o;
}

template <int ACT  > struct EpiBf16 {
    static constexpr bool PERM = true, AFTER_DRAIN = false, HAS_INIT = false; static_assert(ACT == 0 || ACT == 1, "EpiBf16: ACT is 0 (none) or 1 (gelu_pk)");
    bf16_t* O; int ldc; const float* bias; int split_cols; size_t split_stride; float scale0;
    __device__ __forceinline__ void operator()(const f32x4 (&acc)[2][2][4][2], const Unit& u, int wr, int wc, int fr, int fq) const {
        const int row0 = u.pm * BM + wr * 64 + fr; int colt = u.pn * BM; bf16_t* base = O;
        float sc = 1.f; if (split_cols) { const int t = colt / split_cols; base += (size_t)t * split_stride; colt -= t * split_cols; if (t == 0) sc = scale0; }
        const int col0 = colt + wc * 32 + 8 * fq, bcol0 = u.pn * BM + wc * 32 + 8 * fq;
        f32x4 bv[2][2];
#pragma unroll
        for (int bj = 0; bj < 2; ++bj)
#pragma unroll
            for (int n = 0; n < 2; ++n) bv[bj][n] = bias ? *(const f32x4*)(bias + bcol0 + bj * HALF + 4 * n) : (f32x4){0.f, 0.f, 0.f, 0.f};
#pragma unroll
        for (int ai = 0; ai < 2; ++ai)
#pragma unroll
            for (int m = 0; m < 4; ++m) { bf16_t* rowp = base + (size_t)(row0 + ai * HALF + m * 16) * ldc + col0;
#pragma unroll
                for (int bj = 0; bj < 2; ++bj) { f32x4 v0 = acc[ai][bj][m][0] + bv[bj][0], v1 = acc[ai][bj][m][1] + bv[bj][1];
                    if (ACT == 1) { f32x2 a = gelu_pk((f32x2){v0[0], v0[1]}), b = gelu_pk((f32x2){v0[2], v0[3]}), c = gelu_pk((f32x2){v1[0], v1[1]}), d = gelu_pk((f32x2){v1[2], v1[3]});
                        v0 = (f32x4){a.x, a.y, b.x, b.y}; v1 = (f32x4){c.x, c.y, d.x, d.y}; }
                    v0 = v0 * sc; v1 = v1 * sc; u32x4 w; w.x = cvt_pk_bf16(v0[0], v0[1]); w.y = cvt_pk_bf16(v0[2], v0[3]); w.z = cvt_pk_bf16(v1[0], v1[1]); w.w = cvt_pk_bf16(v1[2], v1[3]);
                    *(u32x4*)(rowp + bj * HALF) = w; } }
    }
};

__device__ __forceinline__ unsigned pk4_fp8(float a, float b, float c, float d) {
    a = fminf(fmaxf(a, -448.f), 448.f); b = fminf(fmaxf(b, -448.f), 448.f); c = fminf(fmaxf(c, -448.f), 448.f); d = fminf(fmaxf(d, -448.f), 448.f);
    int p = 0; p = __builtin_amdgcn_cvt_pk_fp8_f32(a, b, p, false); p = __builtin_amdgcn_cvt_pk_fp8_f32(c, d, p, true); return (unsigned)p;
}
struct EpiRes {
    static constexpr bool PERM = false, AFTER_DRAIN = false, HAS_INIT = false;
    const float* __restrict__ X; bf16_t* __restrict__ XH; int ldc;
    __device__ __forceinline__ void operator()(const f32x4 (&acc)[2][2][4][2], const Unit& u, int wr, int wc, int fr, int fq) const {
        const int row0 = u.pm * BM + wr * 64 + fr, col0 = u.pn * BM + wc * 32 + 4 * fq;
#pragma unroll
        for (int ai = 0; ai < 2; ++ai)
#pragma unroll
            for (int mp = 0; mp < 2; ++mp) { f32x4 xv[2][2][2];
#pragma unroll
                for (int mm = 0; mm < 2; ++mm) { const size_t off = (size_t)(row0 + ai * HALF + (2 * mp + mm) * 16) * ldc + col0;
#pragma unroll
                    for (int bj = 0; bj < 2; ++bj)
#pragma unroll
                        for (int n = 0; n < 2; ++n) xv[mm][bj][n] = __builtin_nontemporal_load((const f32x4*)(X + off + bj * HALF + n * 16)); }
#pragma unroll
                for (int mm = 0; mm < 2; ++mm) { const size_t off = (size_t)(row0 + ai * HALF + (2 * mp + mm) * 16) * ldc + col0;
#pragma unroll
                    for (int bj = 0; bj < 2; ++bj)
#pragma unroll
                        for (int n = 0; n < 2; ++n) { const size_t o2 = off + bj * HALF + n * 16; const f32x4 v = xv[mm][bj][n] + acc[ai][bj][2 * mp + mm][n];
                            *(unsigned long long*)(XH + o2) = (unsigned long long)cvt_pk_bf16(v[0], v[1]) | ((unsigned long long)cvt_pk_bf16(v[2], v[3]) << 32); } } }
    }
};
struct EpiInproj {
    static constexpr bool PERM = true, AFTER_DRAIN = false, HAS_INIT = false;
    bf16_t* PA; bf16_t* PH; bf16_t* QN; bf16_t* KN; const float* gq; const float* gk; float qscale, eps;
    __device__ __forceinline__ void operator()(const f32x4 (&acc)[2][2][4][2], const Unit& u, int wr, int wc, int fr, int fq) const {
        if (u.pn < 4) {
            const int arr = u.pn >> 1, hd = (u.pn & 1) * 4 + wc; const float* g = arr ? gk : gq; const float gs = arr ? 1.f : qscale; bf16_t* dst = arr ? KN : QN;
            f32x4 gv[2][2];
#pragma unroll
            for (int bj = 0; bj < 2; ++bj)
#pragma unroll
                for (int n = 0; n < 2; ++n) gv[bj][n] = *(const f32x4*)(g + 32 * bj + 8 * fq + 4 * n) * gs;
#pragma unroll
            for (int ai = 0; ai < 2; ++ai)
#pragma unroll
                for (int m = 0; m < 4; ++m) { float ss = 0.f;
#pragma unroll
                    for (int bj = 0; bj < 2; ++bj)
#pragma unroll
                        for (int n = 0; n < 2; ++n) { const f32x4 a = acc[ai][bj][m][n]; ss += (a[0] * a[0] + a[1] * a[1]) + (a[2] * a[2] + a[3] * a[3]); }
                    ss += __shfl_xor(ss, 16); ss += __shfl_xor(ss, 32);
                    const float rs = 1.f / sqrtf(ss * (1.f / 64.f) + eps);
                    const int row = u.pm * BM + ai * HALF + wr * 64 + m * 16 + fr, b = row >> 11, s = row & 2047;
                    bf16_t* rp = dst + ((size_t)((b * 8 + hd) * 64 + (s >> 5))) * 2048 + (s & 31) * 8;
#pragma unroll
                    for (int bj = 0; bj < 2; ++bj) { const int c8 = 4 * bj + fq; const f32x4 v0 = acc[ai][bj][m][0] * rs * gv[bj][0], v1 = acc[ai][bj][m][1] * rs * gv[bj][1];
                        u32x4 w; w.x = cvt_pk_bf16(v0[0], v0[1]); w.y = cvt_pk_bf16(v0[2], v0[3]); w.z = cvt_pk_bf16(v1[0], v1[1]); w.w = cvt_pk_bf16(v1[2], v1[3]);
                        *(u32x4*)(rp + (c8 >> 1) * 512 + (c8 & 1) * 256) = w; } }
            return;
        }
#pragma unroll
        for (int bj = 0; bj < 2; ++bj) { const int col = u.pn * BM + bj * HALF + wc * 32 + 8 * fq;
            bf16_t* base; int rowlen;
            if (col < 1536) { const int arr = col >> 9, hd = (col & 511) >> 6, dd = col & 63; base = PA + ((size_t)(arr * 16) * 8 + hd) * 2048 * 64 + dd; rowlen = 64; }
            else { const int c2 = col - 1536, arr = c2 >> 9, hd = (c2 & 511) >> 7, dd = c2 & 127; base = PH + ((size_t)(arr * 16) * 4 + hd) * 2048 * 128 + dd; rowlen = 128; }
            const size_t bstride = (size_t)(rowlen == 64 ? 8 : 4) * 2048 * rowlen;
#pragma unroll
            for (int ai = 0; ai < 2; ++ai)
#pragma unroll
                for (int m = 0; m < 4; ++m) { const int row = u.pm * BM + ai * HALF + wr * 64 + m * 16 + fr, b = row >> 11, s = row & 2047;
                    const f32x4 v0 = acc[ai][bj][m][0], v1 = acc[ai][bj][m][1];
                    u32x4 w; w.x = cvt_pk_bf16(v0[0], v0[1]); w.y = cvt_pk_bf16(v0[2], v0[3]); w.z = cvt_pk_bf16(v1[0], v1[1]); w.w = cvt_pk_bf16(v1[2], v1[3]);
                    *(u32x4*)(base + (size_t)b * bstride + (size_t)s * rowlen) = w; } }
    }
};
struct MoeOrder {
    const PG8_LAS int* tile_e; const PG8_LAS unsigned short* rowtab; int ntn, nunits, G, c; unsigned rowbytes; int rev;
    __device__ __forceinline__ bool next(int i, Unit& u) const {
        const int L = i * G + c; if (L >= nunits) return false;
        const int pm0 = L / ntn, pl = L - pm0 * ntn, pm = rev ? rev - 1 - pm0 : pm0; u.pm = pm; u.pn = tile_e[pm] * ntn + pl; u.slot = i; return true;
    }
    __device__ __forceinline__ unsigned rowoff(const Unit& u, int r) const { return (rowtab ? (unsigned)rowtab[u.slot * 256 + r] : (unsigned)(u.pm * 256 + r)) * rowbytes; }
    __device__ __forceinline__ void a_ready(const Unit&) const {}
    __device__ __forceinline__ void done(const Unit&) const {}
};
template <bool OUT8> struct EpiAct {
    static constexpr bool PERM = true, AFTER_DRAIN = false, HAS_INIT = true;
    unsigned char* ACT; const PG8_LAS float* biastab; float oscale;
    __device__ __forceinline__ void init(f32x4 (&acc)[2][2][4][2], const Unit& u, int wc, int fq) const {
#pragma unroll
        for (int n = 0; n < 2; ++n) { const f32x4 bg = *(const PG8_LAS f32x4*)(biastab + u.slot * 256 + wc * 32 + 8 * fq + 4 * n), bu = *(const PG8_LAS f32x4*)(biastab + u.slot * 256 + 128 + wc * 32 + 8 * fq + 4 * n);
#pragma unroll
            for (int ai = 0; ai < 2; ++ai)
#pragma unroll
                for (int m = 0; m < 4; ++m) { acc[ai][0][m][n] = bg; acc[ai][1][m][n] = bu; } }
    }
    __device__ __forceinline__ void operator()(const f32x4 (&acc)[2][2][4][2], const Unit& u, int wr, int wc, int fr, int fq) const {
        const int pl = u.pn & 7; const int row0 = u.pm * BM + wr * 64 + fr, acol0 = pl * 128 + wc * 32 + 8 * fq;
#pragma unroll
        for (int ai = 0; ai < 2; ++ai)
#pragma unroll
            for (int m = 0; m < 4; ++m) { unsigned char* rowp = ACT + (size_t)(row0 + ai * HALF + m * 16) * 1024 + acol0; f32x4 a4[2];
#pragma unroll
                for (int n = 0; n < 2; ++n) { const f32x4 g4 = acc[ai][0][m][n], u4 = acc[ai][1][m][n]; f32x4 gl, ul, ex;
#pragma unroll
                    for (int j = 0; j < 4; ++j) { gl[j] = fminf(g4[j], 7.0f); ul[j] = __builtin_amdgcn_fmed3f(u4[j], -7.0f, 7.0f); }
                    const f32x4 t4 = gl * (-1.702f * 1.44269504089f);
#pragma unroll
                    for (int j = 0; j < 4; ++j) ex[j] = __builtin_amdgcn_exp2f(t4[j]);
                    const f32x4 d4 = ex + 1.0f; f32x4 s4;
#pragma unroll
                    for (int j = 0; j < 4; ++j) s4[j] = __builtin_amdgcn_rcpf(d4[j]);
                    a4[n] = (gl * s4) * (ul * oscale + oscale); }
                if constexpr (OUT8) { int p0 = 0, p1 = 0; p0 = __builtin_amdgcn_cvt_pk_fp8_f32(a4[0][0], a4[0][1], p0, false); p0 = __builtin_amdgcn_cvt_pk_fp8_f32(a4[0][2], a4[0][3], p0, true);
                    p1 = __builtin_amdgcn_cvt_pk_fp8_f32(a4[1][0], a4[1][1], p1, false); p1 = __builtin_amdgcn_cvt_pk_fp8_f32(a4[1][2], a4[1][3], p1, true);
                    *(unsigned long long*)rowp = (unsigned long long)(unsigned)p0 | ((unsigned long long)(unsigned)p1 << 32); }
                else { u32x4 w; w.x = cvt_pk_bf16(a4[0][0], a4[0][1]); w.y = cvt_pk_bf16(a4[0][2], a4[0][3]); w.z = cvt_pk_bf16(a4[1][0], a4[1][1]); w.w = cvt_pk_bf16(a4[1][2], a4[1][3]); *(u32x4*)(rowp + (size_t)(row0 + ai * HALF + m * 16) * 1024 + acol0) = w; } }
    }
};
struct EpiDown {
    static constexpr bool PERM = true, AFTER_DRAIN = false, HAS_INIT = true;
    unsigned char* YK; const PG8_LAS int* tktab; const PG8_LAS float* biastab; float oscale;
    __device__ __forceinline__ void init(f32x4 (&acc)[2][2][4][2], const Unit& u, int wc, int fq) const {
#pragma unroll
        for (int bj = 0; bj < 2; ++bj)
#pragma unroll
            for (int n = 0; n < 2; ++n) { const f32x4 bv = *(const PG8_LAS f32x4*)(biastab + u.slot * 256 + bj * HALF + wc * 32 + 8 * fq + 4 * n) * oscale;
#pragma unroll
                for (int ai = 0; ai < 2; ++ai)
#pragma unroll
                    for (int m = 0; m < 4; ++m) acc[ai][bj][m][n] = bv; }
    }
    __device__ __forceinline__ void operator()(const f32x4 (&acc)[2][2][4][2], const Unit& u, int wr, int wc, int fr, int fq) const {
        const int pl = u.pn & 3; const int col0 = pl * BM + wc * 32 + 8 * fq;
#pragma unroll
        for (int ai = 0; ai < 2; ++ai)
#pragma unroll
            for (int m = 0; m < 4; ++m) { const int tk = tktab[u.slot * 256 + ai * HALF + wr * 64 + m * 16 + fr];
                if (tk >= 0) { unsigned char* rowp = YK + (size_t)tk * 1024 + col0;
#pragma unroll
                    for (int bj = 0; bj < 2; ++bj) { f32x4 v0 = acc[ai][bj][m][0], v1 = acc[ai][bj][m][1];
#pragma unroll
                        for (int j = 0; j < 4; ++j) { v0[j] = __builtin_amdgcn_fmed3f(v0[j], -448.f, 448.f); v1[j] = __builtin_amdgcn_fmed3f(v1[j], -448.f, 448.f); }
                        int p0 = 0, p1 = 0; p0 = __builtin_amdgcn_cvt_pk_fp8_f32(v0[0], v0[1], p0, false); p0 = __builtin_amdgcn_cvt_pk_fp8_f32(v0[2], v0[3], p0, true);
                        p1 = __builtin_amdgcn_cvt_pk_fp8_f32(v1[0], v1[1], p1, false); p1 = __builtin_amdgcn_cvt_pk_fp8_f32(v1[2], v1[3], p1, true);
                        *(unsigned long long*)(rowp + bj * HALF) = (unsigned long long)(unsigned)p0 | ((unsigned long long)(unsigned)p1 << 32); } } }
    }
};


template <class Epi, class Sched, bool ALIGN_EPI = false, bool SP2 = false, bool GATHER = false, int SCW = 0, int SCX = 0>
__device__ __forceinline__ void gemm_phase(PG8_LAS unsigned char* lds, const Gemm g, const Sched& S, const Epi& E, const int tid) {
    const int wid = __builtin_amdgcn_readfirstlane(tid >> 6), lane = tid & 63, wr = wid >> 2, wc = wid & 3, fr = lane & 15, fq = lane >> 4;
    const int K = g.K, nt = K / BK;
    unsigned voffA[2], voffB[2]; int RA[2]; unsigned CA2[2]; unsigned va0[2] = {0u, 0u}, va1[2] = {0u, 0u};
#pragma unroll
    for (int i = 0; i < 2; ++i) { int R, C; stage_rc(tid * 16 + i * 8192, R, C); const int Rb = Epi::PERM ? ((R & ~31) + perm32(R & 31)) : R;
        voffA[i] = (unsigned)(R * K + C) * 2u; voffB[i] = (unsigned)(Rb * K + C) * 2u; RA[i] = R; CA2[i] = (unsigned)C * 2u; }
    static_assert(!GATHER || SP2, "the gathered-A form exists for the SP2 loop only");
    const char* const gA0 = (const char*)g.A;
#define PG8_VA(u) do { int l_; asm volatile("v_mbcnt_lo_u32_b32 %0, -1, 0\n\tv_mbcnt_hi_u32_b32 %0, -1, %0" : "=v"(l_)); const int t_ = wid * 64 + l_;     \
        _Pragma("unroll") for (int _i = 0; _i < 2; ++_i) { int R_, C_; stage_rc(t_ * 16 + _i * 8192, R_, C_); va0[_i] = S.rowoff((u), R_) + (unsigned)C_ * 2u; va1[_i] = S.rowoff((u), HALF + R_) + (unsigned)C_ * 2u; } } while (0)
#define PG8_STA(bufoff, base_ng, base_g, h) do { if constexpr (GATHER) { if (h) PG8_STAGE(bufoff, base_g, va1); else PG8_STAGE(bufoff, base_g, va0); } else PG8_STAGE(bufoff, base_ng, voffA); } while (0)
    const size_t kstep = (size_t)(BK * 2);
    const size_t hstep = (size_t)HALF * K * 2;
    const size_t tstep = 2 * hstep;
    const unsigned ldsw = (unsigned)wid * 1024u;
    const int aoff = lds_byte(wr * 64 + fr, fq * 8), boff = lds_byte(wc * 32 + fr, fq * 8);
#define PG8_SA(b, h) (((b) * 2 + (h)) * HTB)
#define PG8_SB(b, h) ((4 + (b) * 2 + (h)) * HTB)
#define PG8_STAGE(bufoff, gbase, voff) do { _Pragma("unroll") for (int _i = 0; _i < 2; ++_i) \
        __builtin_amdgcn_global_load_lds((const unsigned*)((const char*)(gbase) + (voff)[_i]), (PG8_LAS unsigned*)(lds + (bufoff) + ldsw + _i * 8192), 16, 0, 0); } while (0)
#define PG8_LDA(dst, b, h) do { if constexpr (SCW != 0) { _Pragma("unroll") for (int m = 0; m < 4; ++m) dst##8[m] = PG8_CAT8(*(const PG8_LAS bf16x8*)(lds + PG8_SA(b, h) + aoff + m * 2048), *(const PG8_LAS bf16x8*)(lds + PG8_SA(b, h) + aoff + m * 2048 + 1024)); } \
        else { _Pragma("unroll") for (int m = 0; m < 4; ++m) _Pragma("unroll") for (int k = 0; k < 2; ++k) dst[m][k] = *(const PG8_LAS bf16x8*)(lds + PG8_SA(b, h) + aoff + m * 2048 + k * 1024); } } while (0)
#define PG8_LDB(dst, b, h) do { if constexpr (SCW != 0) { _Pragma("unroll") for (int n = 0; n < 2; ++n) dst##8[n] = PG8_CAT8(*(const PG8_LAS bf16x8*)(lds + PG8_SB(b, h) + boff + n * 2048), *(const PG8_LAS bf16x8*)(lds + PG8_SB(b, h) + boff + n * 2048 + 1024)); } \
        else { _Pragma("unroll") for (int n = 0; n < 2; ++n) _Pragma("unroll") for (int k = 0; k < 2; ++k) dst[n][k] = *(const PG8_LAS bf16x8*)(lds + PG8_SB(b, h) + boff + n * 2048 + k * 1024); } } while (0)
#define PG8_CAT8(lo, hi) __builtin_shufflevector(__builtin_bit_cast(i32x4_t, (lo)), __builtin_bit_cast(i32x4_t, (hi)), 0, 1, 2, 3, 4, 5, 6, 7)
#define PG8_MMA(ai, bj, At, Bt) do { __builtin_amdgcn_s_setprio(1); _Pragma("unroll") for (int m = 0; m < 4; ++m) _Pragma("unroll") for (int n = 0; n < 2; ++n) { \
        if constexpr (SCW != 0) acc[ai][bj][m][n] = __builtin_amdgcn_mfma_scale_f32_16x16x128_f8f6f4(Bt##8[n], At##8[m], acc[ai][bj][m][n], 0, 0, 0, SCW, 0, SCX); \
        else { _Pragma("unroll") for (int k = 0; k < 2; ++k) acc[ai][bj][m][n] = __builtin_amdgcn_mfma_f32_16x16x32_bf16(Bt[n][k], At[m][k], acc[ai][bj][m][n], 0, 0, 0); } } __builtin_amdgcn_s_setprio(0); } while (0)
#define PG8_WAIT_V(n) asm volatile("s_waitcnt vmcnt(" #n ")" ::: "memory")
#define PG8_WAIT_L(n) asm volatile("s_waitcnt lgkmcnt(" #n ")" ::: "memory")
#define PG8_BAR __builtin_amdgcn_s_barrier()
#define PG8_SCHED __builtin_amdgcn_sched_barrier(0)
    Unit cur, nxt; int ui = 0;
    if (!S.next(0, cur)) return;
    f32x4 acc[2][2][4][2];
    if constexpr (Epi::HAS_INIT) E.init(acc, cur, wc, fq);
    else {
#pragma unroll
    for (int a = 0; a < 2; ++a)
#pragma unroll
        for (int b = 0; b < 2; ++b)
#pragma unroll
            for (int m = 0; m < 4; ++m)
#pragma unroll
                for (int n = 0; n < 2; ++n) acc[a][b][m][n] = (f32x4){0.f, 0.f, 0.f, 0.f};
    }
    bf16x8 At[4][2], B0[2][2], B1[2][2]; i32x8_t At8[4], B08[2], B18[2];
    const char* cA = (const char*)g.A + (size_t)cur.pm * tstep; const char* cB = (const char*)g.Bt + (size_t)cur.pn * tstep;
    S.a_ready(cur);
    if constexpr (SP2) {
        if constexpr (GATHER) PG8_VA(cur);
        PG8_STAGE(PG8_SB(0, 0), cB, voffB); PG8_STAGE(PG8_SB(0, 1), cB + hstep, voffB); PG8_STA(PG8_SA(0, 0), cA, gA0, 0); PG8_STA(PG8_SA(0, 1), cA + hstep, gA0, 1);
        if (wr == 1) PG8_BAR;
        PG8_WAIT_V(2); PG8_BAR;
        PG8_STAGE(PG8_SB(1, 0), cB + kstep, voffB); PG8_STA(PG8_SA(1, 0), cA + kstep, gA0 + kstep, 0); PG8_STAGE(PG8_SB(1, 1), cB + hstep + kstep, voffB);
        PG8_WAIT_V(6); PG8_BAR;
    } else {
        PG8_STAGE(PG8_SB(0, 0), cB, voffB); PG8_STAGE(PG8_SA(0, 0), cA, voffA); PG8_STAGE(PG8_SB(0, 1), cB + hstep, voffB); PG8_STAGE(PG8_SA(0, 1), cA + hstep, voffA);
        if (wr == 1) PG8_BAR;
        PG8_WAIT_V(4); PG8_BAR;
        PG8_STAGE(PG8_SB(1, 0), cB + kstep, voffB); PG8_STAGE(PG8_SA(1, 0), cA + kstep, voffA); PG8_STAGE(PG8_SB(1, 1), cB + hstep + kstep, voffB);
        PG8_WAIT_V(6); PG8_BAR;
    }
    for (;;) {
        const bool has_next = S.next(ui + 1, nxt);
        const char* nA = has_next ? (const char*)g.A + (size_t)nxt.pm * tstep : cA; const char* nB = has_next ? (const char*)g.Bt + (size_t)nxt.pn * tstep : cB;
        _Pragma("nounroll") for (int t = 0; t < nt; t += 2) {
            const bool last = (t == nt - 2);
            const char* a1 = cA + (size_t)(t + 1) * kstep;
            const char* a2 = last ? nA : cA + (size_t)(t + 2) * kstep; const char* b2 = last ? nB : cB + (size_t)(t + 2) * kstep;
            const char* a3 = a2 + kstep; const char* b3 = b2 + kstep;
            if (last && has_next) S.a_ready(nxt);
            const char* const g1 = gA0 + (size_t)(t + 1) * kstep; const char* const g2 = last ? gA0 : gA0 + (size_t)(t + 2) * kstep; const char* const g3 = g2 + kstep;
            if constexpr (SP2) {
            PG8_LDB(B0, 0, 0); PG8_LDB(B1, 0, 1); PG8_SCHED; PG8_LDA(At, 0, 0); PG8_STA(PG8_SA(1, 1), a1 + hstep, g1, 1);
            PG8_WAIT_V(8); PG8_WAIT_L(0); PG8_BAR; PG8_MMA(0, 0, At, B0); PG8_MMA(0, 1, At, B1); PG8_BAR; PG8_SCHED;
            if constexpr (GATHER) { if (last && has_next) PG8_VA(nxt); }
            PG8_LDA(At, 0, 1); PG8_STAGE(PG8_SB(0, 0), b2, voffB); PG8_STAGE(PG8_SB(0, 1), b2 + hstep, voffB); PG8_STA(PG8_SA(0, 0), a2, g2, 0);
            PG8_WAIT_V(8); PG8_WAIT_L(0); PG8_BAR; PG8_MMA(1, 0, At, B0); PG8_MMA(1, 1, At, B1); PG8_BAR; PG8_SCHED;
            PG8_LDB(B0, 1, 0); PG8_LDB(B1, 1, 1); PG8_SCHED; PG8_LDA(At, 1, 0); PG8_STA(PG8_SA(0, 1), a2 + hstep, g2, 1);
            PG8_WAIT_V(8); PG8_WAIT_L(0); PG8_BAR; PG8_MMA(0, 0, At, B0); PG8_MMA(0, 1, At, B1); PG8_BAR; PG8_SCHED;
            PG8_LDA(At, 1, 1); PG8_STAGE(PG8_SB(1, 0), b3, voffB); PG8_STAGE(PG8_SB(1, 1), b3 + hstep, voffB); PG8_STA(PG8_SA(1, 0), a3, g3, 0);
            PG8_WAIT_V(8); PG8_WAIT_L(0); PG8_BAR; PG8_MMA(1, 0, At, B0); PG8_MMA(1, 1, At, B1); PG8_BAR; PG8_SCHED;
            } else {
            PG8_LDB(B0, 0, 0); PG8_SCHED; PG8_LDA(At, 0, 0); PG8_STAGE(PG8_SA(1, 1), a1 + hstep, voffA);
            PG8_WAIT_L(8); PG8_BAR; PG8_WAIT_L(0); PG8_MMA(0, 0, At, B0); PG8_BAR; PG8_SCHED;
            PG8_LDB(B1, 0, 1); PG8_STAGE(PG8_SB(0, 0), b2, voffB);
            PG8_BAR; PG8_WAIT_L(0); PG8_MMA(0, 1, At, B1); PG8_BAR;
            PG8_LDA(At, 0, 1); PG8_STAGE(PG8_SA(0, 0), a2, voffA);
            PG8_BAR; PG8_WAIT_L(0); PG8_MMA(1, 0, At, B0); PG8_BAR; PG8_SCHED;
            PG8_STAGE(PG8_SB(0, 1), b2 + hstep, voffB);
            PG8_WAIT_V(6); PG8_BAR; PG8_MMA(1, 1, At, B1); PG8_BAR;
            PG8_LDB(B0, 1, 0); PG8_SCHED; PG8_LDA(At, 1, 0); PG8_STAGE(PG8_SA(0, 1), a2 + hstep, voffA);
            PG8_WAIT_L(8); PG8_BAR; PG8_WAIT_L(0); PG8_MMA(0, 0, At, B0); PG8_BAR; PG8_SCHED;
            PG8_LDB(B1, 1, 1); PG8_STAGE(PG8_SB(1, 0), b3, voffB);
            PG8_BAR; PG8_WAIT_L(0); PG8_MMA(0, 1, At, B1); PG8_BAR;
            PG8_LDA(At, 1, 1); PG8_STAGE(PG8_SA(1, 0), a3, voffA);
            PG8_BAR; PG8_WAIT_L(0); PG8_MMA(1, 0, At, B0); PG8_BAR; PG8_SCHED;
            PG8_STAGE(PG8_SB(1, 1), b3 + hstep, voffB);
            PG8_WAIT_V(6); PG8_BAR; PG8_MMA(1, 1, At, B1); PG8_BAR;
            }
        }
        if constexpr (ALIGN_EPI) { if (wr == 0) PG8_BAR; }
        if constexpr (!Epi::AFTER_DRAIN) { int fr_ = fr, fq_ = fq; asm volatile("" : "+v"(fr_), "+v"(fq_));
            E(acc, cur, wr, wc, fr_, fq_); S.done(cur); }
        if (!has_next) break;
        if constexpr (Epi::HAS_INIT) { int fq_ = fq; asm volatile("" : "+v"(fq_)); E.init(acc, nxt, wc, fq_); }
        else {
#pragma unroll
        for (int a = 0; a < 2; ++a)
#pragma unroll
            for (int b = 0; b < 2; ++b)
#pragma unroll
                for (int m = 0; m < 4; ++m)
#pragma unroll
                    for (int n = 0; n < 2; ++n) acc[a][b][m][n] = (f32x4){0.f, 0.f, 0.f, 0.f};
        }
        cur = nxt; cA = nA; cB = nB; ++ui;
        if constexpr (ALIGN_EPI) { if (wr == 1) PG8_BAR; }
    }
    PG8_WAIT_V(0);
    if constexpr (!ALIGN_EPI) { if (wr == 0) PG8_BAR; }
    PG8_BAR;
    if constexpr (Epi::AFTER_DRAIN) { E.fused(acc, cur, wr, wc, fr, fq, lds, wid, lane); S.done(cur); }
#undef PG8_SA
#undef PG8_CAT8
#undef PG8_VA
#undef PG8_STA
#undef PG8_SB
#undef PG8_STAGE
#undef PG8_LDA
#undef PG8_LDB
#undef PG8_MMA
#undef PG8_WAIT_V
#undef PG8_WAIT_L
#undef PG8_BAR
#undef PG8_SCHED
}
}

#ifndef PG8_SP2
#define PG8_SP2 true
#endif
#ifndef PG8_ALIGN
#define PG8_ALIGN true
#endif
#define GAS __attribute__((address_space(1)))
#define LAS __attribute__((address_space(3)))
typedef unsigned short bf16;
typedef unsigned v4u __attribute__((ext_vector_type(4)));
typedef float f32x4 __attribute__((ext_vector_type(4)));
typedef short bf16x8 __attribute__((ext_vector_type(8)));
typedef GAS unsigned gu32;
typedef GAS unsigned long long gu64;
#define RLX_AGENT __ATOMIC_RELAXED, __HIP_MEMORY_SCOPE_AGENT
#define LDS_WAIT() asm volatile("s_waitcnt lgkmcnt(0)" ::: "memory")
#define VM_WAIT() asm volatile("s_waitcnt vmcnt(0)" ::: "memory")
__device__ __forceinline__ unsigned long long rt() { return __builtin_amdgcn_s_memrealtime(); }
__device__ __forceinline__ unsigned f2bf(float f) { unsigned u = __builtin_bit_cast(unsigned, f); return (u + 0x7fffu + ((u >> 16) & 1u)) >> 16; }
__device__ __forceinline__ unsigned pk2(float lo, float hi) { return f2bf(lo) | (f2bf(hi) << 16); }

#define XB_TMO      128
#define XB_XCNT(j)  (256  + 64 * (j))
#define XB_XSUB(j)  (1280 + 64 * (j))
#define XB_XGEN(j)  (2304 + 64 * (j))
#define XB_TOP      3328
#define XB_TOPGEN   3392
#define XCD_BAR_WORDS 3456
#define XB_SPIN_CAP (1u << 18)

__device__ __forceinline__ unsigned xb_ld(unsigned* p)              { return __hip_atomic_load(p, __ATOMIC_RELAXED, __HIP_MEMORY_SCOPE_AGENT); }
__device__ __forceinline__ unsigned xb_add(unsigned* p, unsigned v) { return __hip_atomic_fetch_add(p, v, __ATOMIC_RELAXED, __HIP_MEMORY_SCOPE_AGENT); }
__device__ __forceinline__ unsigned xb_xcc_id() { return (unsigned)__builtin_amdgcn_s_getreg((3 << 11) | 20) & 0xFu; }
#define XB_SPIN(cond, bar) do { unsigned _sp = 0; while (cond) { __builtin_amdgcn_s_sleep(1); \
    if ((++_sp & 255u) == 0u) { if (xb_ld(&(bar)[XB_TMO])) break; if (_sp > XB_SPIN_CAP) { atomicAdd(&(bar)[XB_TMO], 1u); break; } } } } while (0)

struct XcdBarrier {
    unsigned* bar; unsigned x;
    volatile LAS unsigned* st;
};

__device__ __forceinline__ XcdBarrier xcd_barrier_post(unsigned* bar, volatile LAS unsigned* st) {
    XcdBarrier b; b.bar = bar; b.x = xb_xcc_id(); b.st = st;
    if (threadIdx.x == 0) (void)xb_add(&bar[XB_XCNT(b.x)], 1u);
    return b;
}
__device__ __forceinline__ void xcd_barrier_complete(unsigned* bar, unsigned x, unsigned& nloc, unsigned& nx) {
    const unsigned G = gridDim.x * gridDim.y * gridDim.z;
    unsigned sum, cnt, mine, sp = 0u;
    for (;;) {
        sum = 0u; cnt = 0u; mine = 0u;
#pragma unroll
        for (unsigned j = 0; j < 16; ++j) { const unsigned c = xb_ld(&bar[XB_XCNT(j)]); sum += c; cnt += (c > 0u) ? 1u : 0u; mine = (j == x) ? c : mine; }
        if (sum == G) break;
        __builtin_amdgcn_s_sleep(1);
        if ((++sp & 255u) == 0u) { if (xb_ld(&bar[XB_TMO])) break; if (sp > XB_SPIN_CAP) { atomicAdd(&bar[XB_TMO], 1u); break; } }
    }
    nloc = mine > 0u ? mine : 1u; nx = cnt > 0u ? cnt : 1u;
}

__device__ __forceinline__ void xcd_barrier(const XcdBarrier& b) {
    asm volatile("s_waitcnt vmcnt(0)" ::: "memory");
    __syncthreads();
    if (threadIdx.x == 0) {
        unsigned* bar = b.bar;
        __builtin_amdgcn_s_waitcnt(0);
        unsigned nloc = b.st[0], nx = b.st[1];
        if (nloc == 0u) { xcd_barrier_complete(bar, b.x, nloc, nx); b.st[0] = nloc; b.st[1] = nx; }
        const unsigned old = xb_add(&bar[XB_XSUB(b.x)], 1u);
        const unsigned gen = old / nloc;
        if (old + 1u == (gen + 1u) * nloc) {
            __builtin_amdgcn_fence(__ATOMIC_RELEASE, "agent");
            asm volatile("s_waitcnt vmcnt(0)" ::: "memory");
            const unsigned og = xb_add(&bar[XB_TOP], 1u);
            const unsigned tg = og / nx;
            if (og + 1u == (tg + 1u) * nx) xb_add(&bar[XB_TOPGEN], 1u);
            else XB_SPIN(xb_ld(&bar[XB_TOPGEN]) == tg, bar);
            __builtin_amdgcn_fence(__ATOMIC_ACQUIRE, "agent");
            xb_add(&bar[XB_XGEN(b.x)], 1u);
            asm volatile("s_waitcnt vmcnt(0)" ::: "memory");
        } else {
            XB_SPIN(xb_ld(&bar[XB_XGEN(b.x)]) == gen, bar);
            __builtin_amdgcn_fence(__ATOMIC_ACQUIRE, "agent");
            asm volatile("s_waitcnt vmcnt(0)" ::: "memory");
        }
    }
    __syncthreads();
}

constexpr int NWAVES = 8;
#ifndef MK_ONE_LAUNCH
#define MK_ONE_LAUNCH 1
#endif

constexpr int BATCH = 16, SEQ = 2048, D = 1024, T = BATCH * SEQ;
constexpr int NIN = 3584;
constexpr int OFF_SQ = 0, OFF_SK = 512, OFF_SV = 1024, OFF_HQ = 1536, OFF_HF = 2048, OFF_HI = 2560, OFF_HG = 3072;
constexpr int NE = 32, TOPK = 4, NASSIGN = T * TOPK;
constexpr int MAXTILES = NASSIGN / 256 + NE;
constexpr int MAXROWS = MAXTILES * 256;
constexpr float EPS = 1e-6f;

constexpr size_t MiB = 1u << 20;
constexpr size_t WS_CTL = 0, CTL_ZERO_BYTES = 1 * MiB;
constexpr size_t WS_WIN = 2 * MiB;
constexpr size_t WS_WOUT = 10 * MiB;
constexpr size_t WS_RT = 12 * MiB;
constexpr size_t WS_WGU = 16 * MiB;
constexpr size_t WS_WD = 144 * MiB;
constexpr size_t WS_XN = 208 * MiB;
constexpr size_t WS_P = 272 * MiB;
constexpr size_t WS_PH = WS_P + 96 * MiB;
constexpr size_t WS_MIX = 496 * MiB;
constexpr size_t WS_ACT = 272 * MiB;
constexpr size_t WS_YK = 560 * MiB;
constexpr size_t WS_QN = 624 * MiB;
constexpr size_t WS_KN = 656 * MiB;
constexpr size_t WS_VT = 688 * MiB;
constexpr size_t WS_KVS = 720 * MiB;
constexpr size_t WS_DEC = 784 * MiB;
constexpr size_t WS_SSEG = 786 * MiB;
constexpr size_t WS_DSEG = 802 * MiB;
constexpr size_t WS_LIST = 816 * MiB;
constexpr size_t WS_TOPG = 825 * MiB;
constexpr size_t WS_X8 = 560 * MiB;
constexpr size_t WS_END = 832 * MiB;
static_assert(WS_ACT + (size_t)MAXROWS * 2048 <= WS_YK && WS_YK + (size_t)T * 4 * 2048 <= WS_LIST && WS_MIX + (size_t)T * 2048 <= WS_YK, "d_ws map");
constexpr int CW_TMO = 0, CW_CODE = 1;
constexpr int CW_CNT = 64;
constexpr int CW_BAR = 4096;

constexpr int RING_OFF = 0, RING_BYTES = 131072;
constexpr int RT_ROW = 2064, RT_WL = 32 * RT_ROW, RT_END = 64 * RT_ROW;
constexpr int LDSCTL_OFF = 133120, MISC_OFF = LDSCTL_OFF + 320;
constexpr int LTAB_OFF = LDSCTL_OFF + 512;
constexpr int LT_TS = MAXTILES, LT_CNT = MAXTILES + 32, LT_MISC = MAXTILES + 64, LT_WORDS = MAXTILES + 192;
constexpr int ROWTAB_OFF = LTAB_OFF + LT_WORDS * 4;
constexpr int MAXSLOT = 17;
constexpr int ROWTAB2_OFF = ROWTAB_OFF + MAXSLOT * 1024;
constexpr int LDS_BYTES = ROWTAB2_OFF + MAXSLOT * 512;
static_assert(RT_END <= LDSCTL_OFF && MISC_OFF + 128 <= LTAB_OFF && LDS_BYTES <= 160 * 1024 && (MAXTILES * 8 + 255) / 256 <= MAXSLOT && 2 * ((MAXTILES * 4 + 255) / 256) * 1024 <= MAXSLOT * 1536 && ROWTAB_OFF % 16 == 0, "LDS map");

struct Frame {
    LAS unsigned char* lds;
    volatile LAS unsigned* MISC;
    gu32* ctl;
    int tid, lane, wave, gw, ngw;
    int vcu, G;
    const float *x, *norm1_g, *w_in, *sb_q_g, *sb_k_g, *sb_out_g, *hg_lb, *hg_out_g, *w_out, *norm2_g, *w_router, *b_router, *w_gu, *b_gu, *w_d, *b_d;
    float* out;
    unsigned char* ws;
};
__device__ __forceinline__ float bf2f(unsigned short b) { return __builtin_bit_cast(float, (unsigned)b << 16); }
__device__ __forceinline__ float bflo(unsigned w) { return __builtin_bit_cast(float, w << 16); }
__device__ __forceinline__ float bfhi(unsigned w) { return __builtin_bit_cast(float, w & 0xffff0000u); }
typedef __bf16 bf16x2n_ __attribute__((ext_vector_type(2)));
typedef float f32x2n_ __attribute__((ext_vector_type(2)));
__device__ __forceinline__ unsigned pkbf(float a, float b) { const bf16x2n_ v = __builtin_convertvector((f32x2n_){a, b}, bf16x2n_); return __builtin_bit_cast(unsigned, v); }
__device__ __forceinline__ int lane_id() { int l; asm volatile("v_mbcnt_lo_u32_b32 %0, -1, 0\n\tv_mbcnt_hi_u32_b32 %0, -1, %0" : "=v"(l)); return l; }
__device__ __forceinline__ int vzero() { int z; asm volatile("v_mov_b32 %0, 0" : "=v"(z)); return z; }
__device__ __forceinline__ float wave_sum(float v) {
#pragma unroll
    for (int o = 1; o < 64; o <<= 1) v += __shfl_xor(v, o);
    return v;
}

constexpr float W8_SCALE = 256.f, A8_SCALE = 4.f, Y8_SCALE = 32.f; static_assert(Y8_SCALE == 32.f, "SC_W8Y below is 2^-8 * 32");
constexpr int SC_ONE = 0x7f7f7f7f, SC_W8 = 0x77777777, SC_A8 = 0x7d7d7d7d, SC_W8Y = 0x7c7c7c7c;
struct P0Item { const float* W; bf16* WT; const float* rowscale; int N, k0, n0, drow0, fp8, perm; };
__device__ __forceinline__ void p0_load(const P0Item& it, f32x4 (&v)[16], int lane) {
    const int kr = lane >> 4, nc = 4 * (lane & 15);
#pragma unroll
    for (int i = 0; i < 16; ++i) v[i] = __builtin_nontemporal_load((const f32x4*)(it.W + (size_t)(it.k0 + 4 * i + kr) * it.N + it.n0 + nc));
}
__device__ __forceinline__ void p0_store(const P0Item& it, const f32x4 (&v)[16], LAS unsigned char* scr, int lane) {
    const int kr = lane >> 4, nc = 4 * (lane & 15);
#pragma unroll
    for (int i = 0; i < 16; ++i) { const float sc = it.rowscale ? it.rowscale[it.k0 + 4 * i + kr] : 1.f;
        *(LAS unsigned long long*)(scr + (4 * i + kr) * 136 + 2 * nc) = (unsigned long long)pkbf(v[i].x * sc, v[i].y * sc) | ((unsigned long long)pkbf(v[i].z * sc, v[i].w * sc) << 32); }
    LDS_WAIT(); asm volatile("" ::: "memory");
    const LAS unsigned short* s16 = (const LAS unsigned short*)scr;
    if (it.fp8) { const int p = lane & 3, nr = lane >> 2;
#pragma unroll
        for (int c = 0; c < 4; ++c) { const int n = 16 * c + nr; unsigned val[16];
#pragma unroll
            for (int kk = 0; kk < 16; ++kk) val[kk] = s16[(16 * p + kk) * 68 + n];
            v4u w4;
            w4.x = pg8::pk4_fp8(bflo(val[0]) * W8_SCALE, bflo(val[1]) * W8_SCALE, bflo(val[2]) * W8_SCALE, bflo(val[3]) * W8_SCALE);
            w4.y = pg8::pk4_fp8(bflo(val[4]) * W8_SCALE, bflo(val[5]) * W8_SCALE, bflo(val[6]) * W8_SCALE, bflo(val[7]) * W8_SCALE);
            w4.z = pg8::pk4_fp8(bflo(val[8]) * W8_SCALE, bflo(val[9]) * W8_SCALE, bflo(val[10]) * W8_SCALE, bflo(val[11]) * W8_SCALE);
            w4.w = pg8::pk4_fp8(bflo(val[12]) * W8_SCALE, bflo(val[13]) * W8_SCALE, bflo(val[14]) * W8_SCALE, bflo(val[15]) * W8_SCALE);
            *(GAS v4u*)((unsigned char*)it.WT + (size_t)(it.drow0 + n) * D + it.k0 + 16 * p) = w4; }
    } else { const int p = lane & 7, nr = lane >> 3;
#pragma unroll
        for (int c = 0; c < 8; ++c) { const int n = 8 * c + nr; unsigned val[8];
#pragma unroll
            for (int kk = 0; kk < 8; ++kk) val[kk] = s16[(8 * p + kk) * 68 + n];
            v4u w4; w4.x = val[0] | (val[1] << 16); w4.y = val[2] | (val[3] << 16); w4.z = val[4] | (val[5] << 16); w4.w = val[6] | (val[7] << 16);
            *(GAS v4u*)(it.WT + (size_t)(it.drow0 + (it.perm ? 128 * (n >> 5) + (n & 31) : n)) * D + it.k0 + 8 * p) = w4; } }
    LDS_WAIT(); asm volatile("" ::: "memory");
}
__device__ __forceinline__ void rms_rows2_to_bf16(const float* xa, const float* xb, bool hasb, const float* g, bf16* oa, bf16* ob, int lane) {
    const GAS f32x4* pa = (const GAS f32x4*)xa + lane; const GAS f32x4* pb = (const GAS f32x4*)(hasb ? xb : xa) + lane; const f32x4* gr = (const f32x4*)g + lane;
    f32x4 va[4], vb[4], gg[4]; float sa = 0.f, sb = 0.f;
#pragma unroll
    for (int j = 0; j < 4; ++j) { va[j] = __builtin_nontemporal_load(pa + 64 * j); vb[j] = __builtin_nontemporal_load(pb + 64 * j); gg[j] = gr[64 * j]; }
#pragma unroll
    for (int j = 0; j < 4; ++j) { sa += (va[j].x * va[j].x + va[j].y * va[j].y) + (va[j].z * va[j].z + va[j].w * va[j].w); sb += (vb[j].x * vb[j].x + vb[j].y * vb[j].y) + (vb[j].z * vb[j].z + vb[j].w * vb[j].w); }
    const float ra = 1.f / sqrtf(wave_sum(sa) * (1.f / D) + EPS), rb = 1.f / sqrtf(wave_sum(sb) * (1.f / D) + EPS);
    GAS unsigned long long* o8a = (GAS unsigned long long*)oa + lane; GAS unsigned long long* o8b = (GAS unsigned long long*)ob + lane;
#pragma unroll
    for (int j = 0; j < 4; ++j) o8a[64 * j] = (unsigned long long)pkbf(va[j].x * ra * gg[j].x, va[j].y * ra * gg[j].y) | ((unsigned long long)pkbf(va[j].z * ra * gg[j].z, va[j].w * ra * gg[j].w) << 32);
    if (hasb) {
#pragma unroll
        for (int j = 0; j < 4; ++j) o8b[64 * j] = (unsigned long long)pkbf(vb[j].x * rb * gg[j].x, vb[j].y * rb * gg[j].y) | ((unsigned long long)pkbf(vb[j].z * rb * gg[j].z, vb[j].w * rb * gg[j].w) << 32); }
}
__device__ __forceinline__ P0Item p0_item(Frame& F, int r) {
    constexpr int I_IN = 16 * (NIN / 64), I_OUT = 16 * 16, I_GU = NE * 16 * 32;
    P0Item it;
    if (r < I_IN) { const int nb = NIN / 64, kb = r / nb, nn = r % nb; const int pq = nn < 16; it = P0Item{F.w_in, (bf16*)(F.ws + WS_WIN), nullptr, NIN, 64 * kb, 64 * nn, pq ? 256 * (nn >> 2) + 32 * (nn & 3) : 64 * nn, 0, pq}; return it; } r -= I_IN;
    if (r < I_OUT) { const int kb = r / 16, nn = r % 16; it = P0Item{F.w_out, (bf16*)(F.ws + WS_WOUT), nullptr, D, 64 * kb, 64 * nn, 64 * nn, 0, 0}; return it; } r -= I_OUT;
    if (r < I_GU) { const int e = r / 512, q = r % 512, kb = q / 32, nn = q % 32;
        const int isup = nn >> 4, a = (nn & 15) * 64;
        it = P0Item{F.w_gu + (size_t)e * D * 2048, (bf16*)(F.ws + WS_WGU + (size_t)e * 2048 * D), F.norm2_g, 2048, 64 * kb, 64 * nn, 256 * (a >> 7) + 128 * isup + (a & 127), 1, 0}; return it; } r -= I_GU;
    { const int e = r / 256, q = r % 256, kb = q / 16, nn = q % 16;
        it = P0Item{F.w_d + (size_t)e * D * D, (bf16*)(F.ws + WS_WD + (size_t)e * D * D), nullptr, D, 64 * kb, 64 * nn, 64 * nn, 1, 0}; return it; }
}
__device__ __forceinline__ void p0_prologue(Frame& F) {
    LAS unsigned char* scr = F.lds + RING_OFF + F.wave * 16384;
    constexpr int NITEMS = 16 * (NIN / 64) + 16 * 16 + NE * 16 * 32 + NE * 16 * 16;
    {
        f32x4 va[16], vb[16]; int it = F.gw;
        if (it < NITEMS) { P0Item A = p0_item(F, it); p0_load(A, va, F.lane);
            for (;;) {
                const int itb = it + F.ngw; const bool hb = itb < NITEMS; const P0Item B = p0_item(F, hb ? itb : it); p0_load(B, vb, F.lane); __builtin_amdgcn_sched_barrier(0);
                p0_store(A, va, scr, F.lane);
                if (!hb) break;
                it = itb + F.ngw; const bool ha = it < NITEMS; A = p0_item(F, ha ? it : itb); p0_load(A, va, F.lane); __builtin_amdgcn_sched_barrier(0);
                p0_store(B, vb, scr, F.lane);
                if (!ha) break;
            }
        }
    }
    for (int q = blockIdx.x * (NWAVES * 64) + F.tid; q < 4096; q += F.G * NWAVES * 64) {
        const int e = q & 31, k0 = (q >> 5) * 8; unsigned hi[8], lo[8];
#pragma unroll
        for (int j = 0; j < 8; ++j) { const float w = F.w_router[(k0 + j) * 32 + e] * F.norm2_g[k0 + j]; hi[j] = pkbf(w, 0.f) & 0xffffu; lo[j] = pkbf(w - bflo(hi[j]), 0.f) & 0xffffu; }
        const v4u h4 = {hi[0] | (hi[1] << 16), hi[2] | (hi[3] << 16), hi[4] | (hi[5] << 16), hi[6] | (hi[7] << 16)}, l4 = {lo[0] | (lo[1] << 16), lo[2] | (lo[3] << 16), lo[4] | (lo[5] << 16), lo[6] | (lo[7] << 16)};
        *(GAS v4u*)(F.ws + WS_RT + e * RT_ROW + 2 * k0) = h4; *(GAS v4u*)(F.ws + WS_RT + RT_WL + e * RT_ROW + 2 * k0) = l4; }
    for (int m = F.gw; m < T; m += 2 * F.ngw) rms_rows2_to_bf16(F.x + (size_t)m * D, F.x + (size_t)(m + F.ngw) * D, m + F.ngw < T, F.norm1_g, (bf16*)(F.ws + WS_XN) + (size_t)m * D, (bf16*)(F.ws + WS_XN) + (size_t)(m + F.ngw) * D, F.lane);
}

typedef float f32x16 __attribute__((ext_vector_type(16)));
typedef __bf16 bf16x2n __attribute__((ext_vector_type(2)));
typedef float f32x2n __attribute__((ext_vector_type(2)));
#define MFMA32(a, b, c) __builtin_amdgcn_mfma_f32_32x32x16_bf16((a), (b), (c), 0, 0, 0)
__device__ __forceinline__ bf16x8 pack8(float a0, float a1, float a2, float a3, float a4, float a5, float a6, float a7) { const v4u p = {pkbf(a0, a1), pkbf(a2, a3), pkbf(a4, a5), pkbf(a6, a7)}; return __builtin_bit_cast(bf16x8, p); }
constexpr float QSCALE = 0.125f * 1.44269504089f;
__device__ __forceinline__ void prep_phase(Frame& F) {
    LAS unsigned* tl = (LAS unsigned*)(F.lds + RING_OFF + F.wave * 16384);
    const bf16* P = (const bf16*)(F.ws + WS_P); bf16* Qn = (bf16*)(F.ws + WS_QN); bf16* Kn = (bf16*)(F.ws + WS_KN); bf16* VT = (bf16*)(F.ws + WS_VT);
    const int tr = F.lane >> 3, c8 = F.lane & 7;
    for (int it = F.gw; it < 4096; it += F.ngw) {
        const int bh = it & 127, blk = it >> 7, b = bh >> 3, h = bh & 7;
        const bf16* base = P + ((size_t)b * 8 + h) * SEQ * 64 + (size_t)(blk * 64 + tr) * 64 + 8 * c8;
        v4u rv[8];
#pragma unroll
        for (int i = 0; i < 8; ++i) { const bf16* row = base + (size_t)(8 * i) * 64; rv[i] = *(const GAS v4u*)(row + (size_t)2 * 16 * 8 * SEQ * 64); }
        {
#pragma unroll
            for (int i = 0; i < 8; ++i) { LAS unsigned* q = tl + (8 * i + tr) * 33 + 4 * c8; q[0] = rv[i].x; q[1] = rv[i].y; q[2] = rv[i].z; q[3] = rv[i].w; }
            LDS_WAIT(); asm volatile("" ::: "memory");
            const LAS unsigned short* t16 = (const LAS unsigned short*)tl; const int dr = tr;
#define KAP(pos) (((pos) & ~12) | (((pos) & 4) << 1) | (((pos) & 8) >> 1))
            bf16* const obase = VT + ((size_t)bh * 64 + blk * 2 + (c8 >> 2)) * 2048 + ((c8 >> 1) & 1) * 512 + (c8 & 1) * 256;
#pragma unroll
            for (int j = 0; j < 8; ++j) { unsigned val[8];
#pragma unroll
                for (int p = 0; p < 8; ++p) { const int pos = 8 * c8 + p; val[p] = t16[KAP(pos) * 66 + 8 * j + dr]; }
                v4u w4; w4.x = val[0] | (val[1] << 16); w4.y = val[2] | (val[3] << 16); w4.z = val[4] | (val[5] << 16); w4.w = val[6] | (val[7] << 16);
                *(GAS v4u*)(obase + (j >> 2) * 1024 + ((8 * j + dr) & 31) * 8) = w4; }
#undef KAP
            LDS_WAIT(); asm volatile("" ::: "memory");
        }
    }
}

__device__ __forceinline__ int crow16(int i, int hh) { return (i & 3) + 8 * (i >> 2) + 4 * hh; }
__device__ __forceinline__ void attn_item(Frame& F, int bh, int qb, float thr, const bf16x8 (&Lt)[2]) {
    const int r = F.lane & 31, hh = F.lane >> 5, b = bh >> 3, h = bh & 7, q0 = qb * 32;
    const bf16* Qn = (const bf16*)(F.ws + WS_QN); const bf16* Kn = (const bf16*)(F.ws + WS_KN); const bf16* VT = (const bf16*)(F.ws + WS_VT);
    bf16x8 qf[4];
#pragma unroll
    for (int s = 0; s < 4; ++s) qf[s] = *(const GAS bf16x8*)(Qn + ((size_t)bh * 64 + qb) * 2048 + s * 512 + F.lane * 8);
    f32x4 gout[2][4];
#pragma unroll
    for (int db = 0; db < 2; ++db)
#pragma unroll
        for (int gq = 0; gq < 4; ++gq) gout[db][gq] = *(const f32x4*)(F.sb_out_g + h * 64 + 32 * db + 8 * gq + 4 * hh);
    f32x16 O0, O1;
#pragma unroll
    for (int i = 0; i < 16; ++i) { O0[i] = 0.f; O1[i] = 0.f; }
    float carry = 0.f;
    const bf16* kbase = Kn + (size_t)bh * 64 * 2048 + F.lane * 8; const bf16* vbase = VT + (size_t)bh * 64 * 2048 + F.lane * 8;
#define ATT_LOAD(KF, VF, kb_) do { _Pragma("unroll") for (int s_ = 0; s_ < 4; ++s_) KF[s_] = *(const GAS bf16x8*)(kbase + (size_t)(kb_) * 2048 + 512 * s_); \
        _Pragma("unroll") for (int db_ = 0; db_ < 2; ++db_) _Pragma("unroll") for (int ks_ = 0; ks_ < 2; ++ks_) VF[db_][ks_] = *(const GAS bf16x8*)(vbase + (size_t)(kb_) * 2048 + 1024 * db_ + 512 * ks_); } while (0)
#define ATT_BLOCK(KF, VF, kb_) do { const bool diag = ((kb_) == qb); \
        f32x16 z; _Pragma("unroll") for (int i = 0; i < 16; ++i) z[i] = 0.f; \
        _Pragma("unroll") for (int s_ = 0; s_ < 4; ++s_) z = MFMA32(KF[s_], qf[s_], z); \
        float sp[16]; \
        _Pragma("unroll") for (int i = 0; i < 16; ++i) { const float zz = z[i]; float v = fmaxf(zz, 0.f) + __builtin_amdgcn_logf(1.f + __builtin_amdgcn_exp2f(-fabsf(zz))); if (diag && !(crow16(i, hh) < r)) v = 0.f; sp[i] = v; } \
        const bf16x8 sb0 = pack8(sp[0], sp[1], sp[2], sp[3], sp[4], sp[5], sp[6], sp[7]), sb1 = pack8(sp[8], sp[9], sp[10], sp[11], sp[12], sp[13], sp[14], sp[15]); \
        f32x16 Cc; _Pragma("unroll") for (int i = 0; i < 16; ++i) Cc[i] = carry; \
        Cc = MFMA32(Lt[0], sb0, Cc); Cc = MFMA32(Lt[1], sb1, Cc); \
        float w[16]; \
        _Pragma("unroll") for (int i = 0; i < 16; ++i) { float v = __builtin_amdgcn_exp2f(z[i] - Cc[i]); if (diag && !(crow16(i, hh) < r)) v = 0.f; w[i] = v; } \
        const bf16x8 wb0 = pack8(w[0], w[1], w[2], w[3], w[4], w[5], w[6], w[7]), wb1 = pack8(w[8], w[9], w[10], w[11], w[12], w[13], w[14], w[15]); \
        O0 = MFMA32(VF[0][0], wb0, O0); O0 = MFMA32(VF[0][1], wb1, O0); O1 = MFMA32(VF[1][0], wb0, O1); O1 = MFMA32(VF[1][1], wb1, O1); \
        carry = __shfl(Cc[0], r); } while (0)
    bf16x8 kfA[4], vfA[2][2], kfB[4], vfB[2][2];
    ATT_LOAD(kfA, vfA, qb);
    for (int kb = qb; kb >= 0; kb -= 2) {
        ATT_LOAD(kfB, vfB, kb > 0 ? kb - 1 : 0); __builtin_amdgcn_sched_barrier(0);
        ATT_BLOCK(kfA, vfA, kb);
        if (kb == 0 || __all(carry > thr)) break;
        ATT_LOAD(kfA, vfA, kb > 1 ? kb - 2 : 0); __builtin_amdgcn_sched_barrier(0);
        ATT_BLOCK(kfB, vfB, kb - 1);
        if (__all(carry > thr)) break;
    }
#undef ATT_LOAD
#undef ATT_BLOCK
    float ss = 0.f;
#pragma unroll
    for (int i = 0; i < 16; ++i) ss += O0[i] * O0[i] + O1[i] * O1[i];
    ss += __shfl_xor(ss, 32);
    const float rs = 1.f / sqrtf(ss * (1.f / 64.f) + EPS);
    bf16* orow = (bf16*)(F.ws + WS_MIX) + ((size_t)b * SEQ + q0 + r) * D + h * 64;
#pragma unroll
    for (int db = 0; db < 2; ++db)
#pragma unroll
        for (int gq = 0; gq < 4; ++gq) { const int d = 32 * db + 8 * gq + 4 * hh; const f32x4 gg = gout[db][gq];
            const float a0 = (db ? O1[4 * gq + 0] : O0[4 * gq + 0]) * rs * gg.x, a1 = (db ? O1[4 * gq + 1] : O0[4 * gq + 1]) * rs * gg.y, a2 = (db ? O1[4 * gq + 2] : O0[4 * gq + 2]) * rs * gg.z, a3 = (db ? O1[4 * gq + 3] : O0[4 * gq + 3]) * rs * gg.w;
            *(GAS unsigned long long*)(orow + d) = (unsigned long long)pkbf(a0, a1) | ((unsigned long long)pkbf(a2, a3) << 32); }
}
__device__ __forceinline__ void attn_phase(Frame& F) {
    const int r = F.lane & 31, hh = F.lane >> 5;
    float mq = fabsf(F.sb_q_g[F.lane]), mk = fabsf(F.sb_k_g[F.lane]);
#pragma unroll
    for (int o = 1; o < 64; o <<= 1) { mq = fmaxf(mq, __shfl_xor(mq, o)); mk = fmaxf(mk, __shfl_xor(mk, o)); }
    const float thr = 64.f * QSCALE * mq * mk * 1.02f + 170.f;
    bf16x8 Lt[2];
#pragma unroll
    for (int ks = 0; ks < 2; ++ks) { float e[8];
#pragma unroll
        for (int jj = 0; jj < 8; ++jj) e[jj] = (16 * ks + 8 * (jj >> 2) + 4 * hh + (jj & 3) >= r) ? 1.f : 0.f;
        Lt[ks] = pack8(e[0], e[1], e[2], e[3], e[4], e[5], e[6], e[7]); }
    for (int it = F.gw; it < 2048; it += F.ngw) { const int bh = it & 127, j = it >> 7;
        attn_item(F, bh, 63 - j, thr, Lt); attn_item(F, bh, j, thr, Lt); attn_item(F, bh, 47 - j, thr, Lt); attn_item(F, bh, 16 + j, thr, Lt); }
}

constexpr int HG_PART = 0, HG_SSQ = 2048, HG_QE = 4096, HG_KE = HG_QE + 64 * 272, HG_VT = HG_KE + 64 * 272, HG_KST = HG_VT + 128 * 144, HG_ST = HG_KST + 128 * 144, HG_END = HG_ST + 128 * 272;
static_assert(HG_END <= RING_BYTES, "HGRN2 LDS map");
__device__ __forceinline__ float hg_lbound(Frame& F, int h, int d) { const int c = h * 128 + d; return 1.f / (1.f + __expf(F.hg_lb[512 + c] - F.hg_lb[c])); }
__device__ __forceinline__ void hg_gates(Frame& F, const unsigned short (&ffr)[16], float lb, int d, int tq, float (&bb)[16], float (&kk)[16], float& total) {
    float run = 0.f;
#pragma unroll
    for (int i = 0; i < 16; ++i) { const float ff = bf2f(ffr[i]); const float sg = __builtin_amdgcn_rcpf(1.f + __expf(-ff));
        const float f = lb + (1.f - lb) * sg; kk[i] = (1.f - lb) * (1.f - sg); run += __logf(f); bb[i] = run; }
    LAS float* part = (LAS float*)(F.lds + RING_OFF + HG_PART);
    part[tq * 128 + d] = run;
    __syncthreads();
    const float p0 = part[d], p1 = part[128 + d], p2 = part[256 + d], p3 = part[384 + d];
    const float off = (tq > 0 ? p0 : 0.f) + (tq > 1 ? p1 : 0.f) + (tq > 2 ? p2 : 0.f);
    total = (p0 + p1) + (p2 + p3);
#pragma unroll
    for (int i = 0; i < 16; ++i) bb[i] += off;
}
#define HG_HV() const bf16* const PHp = (const bf16*)(F.ws + WS_PH); \
    const __amdgpu_buffer_rsrc_t rsrcP = __builtin_amdgcn_make_buffer_rsrc((void*)PHp, 0, (int)((size_t)4 * T * 512 * 2), 0x00020000)
#define HG_SOFF(item_, arr_) ((unsigned)((((arr_) * 16 + (((item_) >> 5) >> 2)) * 4 + (((item_) >> 5) & 3)) * SEQ + ((item_) & 31) * 64) * 256u)
#define HG_ARR(col_) ((col_) == OFF_HQ ? 0 : (col_) == OFF_HF ? 1 : (col_) == OFF_HI ? 2 : 3)
#define HG_LOADT(dst2, item_, arr_) do { const unsigned so_ = (unsigned)__builtin_amdgcn_readfirstlane((int)HG_SOFF(item_, arr_)); _Pragma("unroll") for (int j_ = 0; j_ < 2; ++j_) \
        (dst2)[j_] = __builtin_bit_cast(v4u, __builtin_amdgcn_raw_buffer_load_b128(rsrcP, (unsigned)F.tid * 16u + 8192u * j_, so_, 0)); } while (0)
#define HG_PUT(src2, raw_) do { _Pragma("unroll") for (int j_ = 0; j_ < 2; ++j_) *(LAS v4u*)((raw_) + ((F.tid >> 4) + 32 * j_) * 272 + (F.tid & 15) * 16) = (src2)[j_]; } while (0)
#define HG_COL(dst, raw_) do { _Pragma("unroll") for (int i_ = 0; i_ < 16; ++i_) dst[i_] = *(const LAS unsigned short*)((raw_) + (16 * tq + i_) * 272 + 2 * d); } while (0)
template <bool PERMUTE> __device__ __forceinline__ void st16(LAS unsigned char* dst, const float (&v)[16]) {
    v4u a, b2;
    if (!PERMUTE) { a.x = pkbf(v[0], v[1]); a.y = pkbf(v[2], v[3]); a.z = pkbf(v[4], v[5]); a.w = pkbf(v[6], v[7]); b2.x = pkbf(v[8], v[9]); b2.y = pkbf(v[10], v[11]); b2.z = pkbf(v[12], v[13]); b2.w = pkbf(v[14], v[15]); }
    else { a.x = pkbf(v[0], v[1]); a.y = pkbf(v[2], v[3]); a.z = pkbf(v[8], v[9]); a.w = pkbf(v[10], v[11]); b2.x = pkbf(v[4], v[5]); b2.y = pkbf(v[6], v[7]); b2.z = pkbf(v[12], v[13]); b2.w = pkbf(v[14], v[15]); }
    *(LAS v4u*)dst = a; *(LAS v4u*)(dst + 16) = b2;
}
__device__ __forceinline__ void hgA_phase(Frame& F) {
    const int d = F.tid & 127, tq = F.tid >> 7, r = F.lane & 31, hh = F.lane >> 5;
    const bf16* P = (const bf16*)(F.ws + WS_P); bf16* KVS = (bf16*)(F.ws + WS_KVS); float* DEC = (float*)(F.ws + WS_DEC); float* SSEG = (float*)(F.ws + WS_SSEG); float* DSEG = (float*)(F.ws + WS_DSEG);
    LAS unsigned char* L = F.lds + RING_OFF; LAS float* decl = (LAS float*)(L + HG_SSQ);
    HG_HV();
    v4u rf[2], rv[2];
    LAS unsigned char* const RAWF = F.lds + ROWTAB_OFF; LAS unsigned char* const RAWV = L + HG_ST;
    for (int wg = blockIdx.x; wg < 256; wg += F.G) {
        const int bh = wg >> 2, seg = wg & 3, item0 = bh * 32 + seg * 8, h = bh & 3;
        HG_LOADT(rf, item0, 1); HG_LOADT(rv, item0, 2);
        const float lbv = hg_lbound(F, h, d); float totrun = 0.f;
        const int db = F.wave & 3, eb0 = 2 * (F.wave >> 2);
        f32x16 run0, run1;
#pragma unroll
        for (int i = 0; i < 16; ++i) { run0[i] = 0.f; run1[i] = 0.f; }
      for (int k = 0; k < 8; ++k) {
        const int item = item0 + k;
        HG_PUT(rf, RAWF); HG_PUT(rv, RAWV);
        __syncthreads();
        { const int nit = k < 7 ? item + 1 : item; HG_LOADT(rf, nit, 1); HG_LOADT(rv, nit, 2); __builtin_amdgcn_sched_barrier(0); }
        unsigned short ffr[16], vr[16]; HG_COL(ffr, RAWF); HG_COL(vr, RAWV);
        float bb[16], kk[16], total; hg_gates(F, ffr, lbv, d, tq, bb, kk, total);
        float ks[16], vv[16];
#pragma unroll
        for (int i = 0; i < 16; ++i) { ks[i] = kk[i] * __expf(total - bb[i]); vv[i] = bf2f(vr[i]); }
        st16<false>(L + HG_KST + d * 144 + tq * 32, ks); st16<false>(L + HG_VT + d * 144 + tq * 32, vv);
        const float dc = __expf(total); totrun += total;
        if (tq == 0) { DEC[(size_t)item * 128 + d] = dc; decl[d] = dc; }
        __syncthreads();
        f32x16 acc0, acc1;
#pragma unroll
        for (int i = 0; i < 16; ++i) { acc0[i] = 0.f; acc1[i] = 0.f; }
#pragma unroll
        for (int s = 0; s < 4; ++s) { const bf16x8 af = *(const LAS bf16x8*)(L + HG_KST + (db * 32 + r) * 144 + 32 * s + 16 * hh);
            const bf16x8 b0 = *(const LAS bf16x8*)(L + HG_VT + (eb0 * 32 + r) * 144 + 32 * s + 16 * hh), b1 = *(const LAS bf16x8*)(L + HG_VT + ((eb0 + 1) * 32 + r) * 144 + 32 * s + 16 * hh);
            acc0 = MFMA32(af, b0, acc0); acc1 = MFMA32(af, b1, acc1); }
#pragma unroll
        for (int g = 0; g < 4; ++g) { const f32x4 dl = *(const LAS f32x4*)(decl + db * 32 + 8 * g + 4 * hh);
#pragma unroll
            for (int ii = 0; ii < 4; ++ii) { run0[4 * g + ii] = dl[ii] * run0[4 * g + ii] + acc0[4 * g + ii]; run1[4 * g + ii] = dl[ii] * run1[4 * g + ii] + acc1[4 * g + ii]; } }
#pragma unroll
        for (int j = 0; j < 2; ++j) { bf16* dst = KVS + ((size_t)item * 128 + (eb0 + j) * 32 + r) * 128 + db * 32 + 4 * hh;
#pragma unroll
            for (int g = 0; g < 4; ++g) { const float a0 = j ? acc1[4 * g + 0] : acc0[4 * g + 0], a1 = j ? acc1[4 * g + 1] : acc0[4 * g + 1], a2 = j ? acc1[4 * g + 2] : acc0[4 * g + 2], a3 = j ? acc1[4 * g + 3] : acc0[4 * g + 3];
                *(GAS unsigned long long*)(dst + 8 * g) = (unsigned long long)pkbf(a0, a1) | ((unsigned long long)pkbf(a2, a3) << 32); } }
        __syncthreads();
      }
#pragma unroll
        for (int j = 0; j < 2; ++j) { float* dst = SSEG + ((size_t)wg * 128 + (eb0 + j) * 32 + r) * 128 + db * 32 + 4 * hh;
#pragma unroll
            for (int g = 0; g < 4; ++g) *(GAS f32x4*)(dst + 8 * g) = j ? (f32x4){run1[4 * g + 0], run1[4 * g + 1], run1[4 * g + 2], run1[4 * g + 3]} : (f32x4){run0[4 * g + 0], run0[4 * g + 1], run0[4 * g + 2], run0[4 * g + 3]}; }
        if (tq == 0) DSEG[(size_t)wg * 128 + d] = __expf(totrun);
    }
}
constexpr int HG_DECS = HG_END;
static_assert(HG_DECS + 4096 + 64 * 272 <= LDSCTL_OFF && HG_KST + 64 * 272 <= HG_ST && 64 * 272 <= MAXSLOT * 1536, "HGRN2 LDS map (decays, raw tiles)");
__device__ __forceinline__ void hgC_phase(Frame& F) {
    const int d = F.tid & 127, tq = F.tid >> 7, r = F.lane & 31, hh = F.lane >> 5;
    const bf16* P = (const bf16*)(F.ws + WS_P); const bf16* KVS = (const bf16*)(F.ws + WS_KVS); bf16* MIX = (bf16*)(F.ws + WS_MIX); const float* DEC = (const float*)(F.ws + WS_DEC);
    HG_HV();
    LAS unsigned char* L = F.lds + RING_OFF; const LAS float* decs = (const LAS float*)(L + HG_DECS);
    const int se = F.tid >> 2, sq = F.tid & 3;
    v4u rf[2], rq[2], rv[2], st[4];
    LAS unsigned char* const RAWF = L + HG_KST; LAS unsigned char* const RAWQ = F.lds + ROWTAB_OFF; LAS unsigned char* const RAWV = L + HG_DECS + 4096;
    const __amdgpu_buffer_rsrc_t rsrcG = __builtin_amdgcn_make_buffer_rsrc((void*)F.hg_out_g, 0, 512 * 4, 0x00020000), rsrcSS = __builtin_amdgcn_make_buffer_rsrc((void*)(F.ws + WS_SSEG), 0, 256 * 128 * 128 * 4, 0x00020000), rsrcDS = __builtin_amdgcn_make_buffer_rsrc((void*)(F.ws + WS_DSEG), 0, 256 * 128 * 4, 0x00020000);
    const __amdgpu_buffer_rsrc_t rsrcD = __builtin_amdgcn_make_buffer_rsrc((void*)DEC, 0, 64 * 32 * 128 * 4, 0x00020000), rsrcM = __builtin_amdgcn_make_buffer_rsrc((void*)MIX, 0, (int)((size_t)T * D * 2), 0x00020000);
    const __amdgpu_buffer_rsrc_t rsrcK = __builtin_amdgcn_make_buffer_rsrc((void*)KVS, 0, 64 * 32 * 128 * 128 * 2, 0x00020000); const unsigned kvo = (unsigned)((se * 128 + sq * 32) * 2);
#define HG_LOADKV(dst_, item_) do { const unsigned so_ = (unsigned)__builtin_amdgcn_readfirstlane((int)((item_) * (128 * 128 * 2))); _Pragma("unroll") for (int j_ = 0; j_ < 4; ++j_) (dst_)[j_] = __builtin_bit_cast(v4u, __builtin_amdgcn_raw_buffer_load_b128(rsrcK, kvo + 16u * j_, so_, 0)); } while (0)
#define HG_LOADST(item_) HG_LOADKV(st, item_)
#define HG_FOLD(kv_, c_) do { _Pragma("unroll") for (int j_ = 0; j_ < 4; ++j_) { const f32x4 d0_ = *(const LAS f32x4*)(decs + (c_) * 128 + sq * 32 + 8 * j_), d1_ = *(const LAS f32x4*)(decs + (c_) * 128 + sq * 32 + 8 * j_ + 4); const v4u k_ = (kv_)[j_]; \
        S[8 * j_ + 0] = d0_.x * S[8 * j_ + 0] + bflo(k_.x); S[8 * j_ + 1] = d0_.y * S[8 * j_ + 1] + bfhi(k_.x); S[8 * j_ + 2] = d0_.z * S[8 * j_ + 2] + bflo(k_.y); S[8 * j_ + 3] = d0_.w * S[8 * j_ + 3] + bfhi(k_.y); \
        S[8 * j_ + 4] = d1_.x * S[8 * j_ + 4] + bflo(k_.z); S[8 * j_ + 5] = d1_.y * S[8 * j_ + 5] + bfhi(k_.z); S[8 * j_ + 6] = d1_.z * S[8 * j_ + 6] + bflo(k_.w); S[8 * j_ + 7] = d1_.w * S[8 * j_ + 7] + bfhi(k_.w); } } while (0)
    for (int wg = blockIdx.x; wg < 256; wg += F.G) {
        const int bh = wg >> 2, seg = wg & 3, item0 = bh * 32 + seg * 8, b = bh >> 2, h = bh & 3;
        HG_LOADT(rf, item0, 1); HG_LOADT(rq, item0, 0); HG_LOADT(rv, item0, 2); HG_LOADST(item0);
        const unsigned dso0 = (unsigned)__builtin_amdgcn_readfirstlane((bh * 32 + seg * 8) * 128 * 4);
        const f32x4 decv = __builtin_bit_cast(f32x4, __builtin_amdgcn_raw_buffer_load_b128(rsrcD, (unsigned)(F.tid & 255) * 16u, dso0, 0));
        const float lbv = hg_lbound(F, h, d);
        __builtin_amdgcn_sched_barrier(0);
        float S[32];
#pragma unroll
        for (int j = 0; j < 32; ++j) S[j] = 0.f;
        for (int sp = 0; sp < seg; ++sp) {
            const unsigned sso = (unsigned)__builtin_amdgcn_readfirstlane((bh * 4 + sp) * 128 * 128 * 4), dso = (unsigned)__builtin_amdgcn_readfirstlane((bh * 4 + sp) * 128 * 4);
#pragma unroll
            for (int j0 = 0; j0 < 8; j0 += 8) { f32x4 sv[8], dv[8];
#pragma unroll
                for (int j = 0; j < 8; ++j) { sv[j] = __builtin_bit_cast(f32x4, __builtin_amdgcn_raw_buffer_load_b128(rsrcSS, (unsigned)((se * 128 + sq * 32) * 4) + 16u * (j0 + j), sso, 0));
                    dv[j] = __builtin_bit_cast(f32x4, __builtin_amdgcn_raw_buffer_load_b128(rsrcDS, (unsigned)(sq * 32 * 4) + 16u * (j0 + j), dso, 0)); }
#pragma unroll
                for (int j = 0; j < 8; ++j) { const int q = 4 * (j0 + j); S[q + 0] = dv[j].x * S[q + 0] + sv[j].x; S[q + 1] = dv[j].y * S[q + 1] + sv[j].y; S[q + 2] = dv[j].z * S[q + 2] + sv[j].z; S[q + 3] = dv[j].w * S[q + 3] + sv[j].w; } }
        }
        if (F.tid < 256) *((LAS f32x4*)(L + HG_DECS) + F.tid) = decv;
        __syncthreads();
      for (int k = 0; k < 8; ++k) {
        const int item = item0 + k, c = seg * 8 + k;
        const int tb = F.wave & 1, eb = F.wave >> 1;
        const int nit = k < 7 ? item + 1 : item;
        HG_PUT(rf, RAWF); HG_PUT(rq, RAWQ); HG_PUT(rv, RAWV);
        __syncthreads();
        HG_LOADT(rf, nit, 1); HG_LOADT(rq, nit, 0); HG_LOADT(rv, nit, 2); __builtin_amdgcn_sched_barrier(0);
        unsigned short ffr[16], qr[16], vr[16]; HG_COL(ffr, RAWF); HG_COL(qr, RAWQ); HG_COL(vr, RAWV);
        float bb[16], kk[16], total; hg_gates(F, ffr, lbv, d, tq, bb, kk, total);
        float vv[16];
#pragma unroll
        for (int i = 0; i < 16; ++i) { const int t = 16 * tq + i; const float q = bf2f(qr[i]);
            *(LAS unsigned short*)(L + HG_QE + t * 272 + 2 * d) = (unsigned short)pkbf(q * __expf(bb[i]), 0.f);
            *(LAS unsigned short*)(L + HG_KE + t * 272 + 2 * d) = (unsigned short)pkbf(kk[i] * __expf(-bb[i]), 0.f);
            vv[i] = bf2f(vr[i]); }
        st16<true>(L + HG_VT + d * 144 + tq * 32, vv);
#pragma unroll
        for (int j = 0; j < 4; ++j) { v4u w4; w4.x = pkbf(S[8 * j + 0], S[8 * j + 1]); w4.y = pkbf(S[8 * j + 2], S[8 * j + 3]); w4.z = pkbf(S[8 * j + 4], S[8 * j + 5]); w4.w = pkbf(S[8 * j + 6], S[8 * j + 7]);
            *(LAS v4u*)(L + HG_ST + se * 272 + sq * 64 + 16 * j) = w4; }
        HG_FOLD(st, k);
        unsigned long long grv[4];
        { const bf16* grow_ = PHp + (((size_t)(3 * 16 + b) * 4 + h) * SEQ + c * 64 + tb * 32 + r) * 128;
#pragma unroll
            for (int g = 0; g < 4; ++g) grv[g] = *(const GAS unsigned long long*)(grow_ + eb * 32 + 8 * g + 4 * hh); }
        HG_LOADST(nit); __builtin_amdgcn_sched_barrier(0);
        __syncthreads();
        f32x16 acc;
#pragma unroll
        for (int i = 0; i < 16; ++i) acc[i] = 0.f;
#define HG_QF(s_) (*(const LAS bf16x8*)(L + HG_QE + (tb * 32 + r) * 272 + 32 * (s_) + 16 * hh))
#pragma unroll
        for (int s = 0; s < 8; ++s) acc = MFMA32(*(const LAS bf16x8*)(L + HG_ST + (eb * 32 + r) * 272 + 32 * s + 16 * hh), HG_QF(s), acc);
        for (int sb = 0; sb <= tb; ++sb) {
            f32x16 at;
#pragma unroll
            for (int i = 0; i < 16; ++i) at[i] = 0.f;
#pragma unroll
            for (int s = 0; s < 8; ++s) at = MFMA32(*(const LAS bf16x8*)(L + HG_KE + (sb * 32 + r) * 272 + 32 * s + 16 * hh), HG_QF(s), at);
            float a[16];
#pragma unroll
            for (int i = 0; i < 16; ++i) a[i] = (sb < tb || crow16(i, hh) <= r) ? at[i] : 0.f;
            const bf16x8 ab0 = pack8(a[0], a[1], a[2], a[3], a[4], a[5], a[6], a[7]), ab1 = pack8(a[8], a[9], a[10], a[11], a[12], a[13], a[14], a[15]);
            acc = MFMA32(*(const LAS bf16x8*)(L + HG_VT + (eb * 32 + r) * 144 + sb * 64 + 0 + 16 * hh), ab0, acc);
            acc = MFMA32(*(const LAS bf16x8*)(L + HG_VT + (eb * 32 + r) * 144 + sb * 64 + 32 + 16 * hh), ab1, acc);
        }
        float ss = 0.f;
#pragma unroll
        for (int i = 0; i < 16; ++i) ss += acc[i] * acc[i];
        ss += __shfl_xor(ss, 32);
        LAS float* ssq = (LAS float*)(L + HG_SSQ);
        if (hh == 0) ssq[eb * 64 + tb * 32 + r] = ss;
        f32x4 ggv[4];
        { const unsigned so = (unsigned)__builtin_amdgcn_readfirstlane(h * 512);
#pragma unroll
            for (int g = 0; g < 4; ++g) ggv[g] = __builtin_bit_cast(f32x4, __builtin_amdgcn_raw_buffer_load_b128(rsrcG, (unsigned)((eb * 32 + 8 * g + 4 * hh) * 4), so, 0)); }
        __syncthreads();
        const int tl = tb * 32 + r; const float tot = (ssq[tl] + ssq[64 + tl]) + (ssq[128 + tl] + ssq[192 + tl]);
        const float rs = 1.f / sqrtf(tot * (1.f / 128.f) + EPS);
        const unsigned mso = (unsigned)__builtin_amdgcn_readfirstlane((int)((((unsigned)b * SEQ + c * 64) * D + 512 + h * 128) * 2)), mvo = (unsigned)((tl * D + eb * 32 + 4 * hh) * 2);
#pragma unroll
        for (int g = 0; g < 4; ++g) { const int e = eb * 32 + 8 * g + 4 * hh; const unsigned long long gr = grv[g]; const f32x4 gg = ggv[g];
            const float g0 = bflo((unsigned)gr), g1 = bfhi((unsigned)gr), g2 = bflo((unsigned)(gr >> 32)), g3 = bfhi((unsigned)(gr >> 32));
            const float y0 = acc[4 * g + 0] * rs * gg.x * (g0 * __builtin_amdgcn_rcpf(1.f + __expf(-g0))), y1 = acc[4 * g + 1] * rs * gg.y * (g1 * __builtin_amdgcn_rcpf(1.f + __expf(-g1)));
            const float y2 = acc[4 * g + 2] * rs * gg.z * (g2 * __builtin_amdgcn_rcpf(1.f + __expf(-g2))), y3 = acc[4 * g + 3] * rs * gg.w * (g3 * __builtin_amdgcn_rcpf(1.f + __expf(-g3)));
            typedef unsigned u32x2_t __attribute__((ext_vector_type(2))); __builtin_amdgcn_raw_buffer_store_b64((u32x2_t){pkbf(y0, y1), pkbf(y2, y3)}, rsrcM, mvo + 16u * g, mso, 0); }
        __syncthreads();
      }
    }
#undef HG_LOADST
#undef HG_LOADKV
#undef HG_FOLD
#undef HG_QF
}
#undef HG_LOADT
#undef HG_PUT
#undef HG_COL
#undef HG_ARR
#undef HG_SOFF
#undef HG_HV

__device__ __forceinline__ void router_phase(Frame& F) {
    LAS unsigned char* L = F.lds; const int r = F.lane & 31, hh = F.lane >> 5;
    LAS unsigned* lcnt = (LAS unsigned*)(F.lds + LTAB_OFF) + LT_MISC; LAS unsigned* lbase = lcnt + 32; LAS float* lrstd = (LAS float*)(F.lds + ROWTAB_OFF);
    float* TOPG = (float*)(F.ws + WS_TOPG);
    {
        const GAS v4u* img = (const GAS v4u*)(F.ws + WS_RT) + vzero();
        for (int q0 = F.tid; q0 < RT_END / 16; q0 += 4 * NWAVES * 64) { v4u t4[4];
#pragma unroll
            for (int j = 0; j < 4; ++j) { const int q = q0 + j * NWAVES * 64; t4[j] = img[q < RT_END / 16 ? q : 0]; }
#pragma unroll
            for (int j = 0; j < 4; ++j) { const int q = q0 + j * NWAVES * 64; if (q < RT_END / 16) *(LAS v4u*)(L + 16 * q) = t4[j]; } }
    }
    const bf16* XH = (const bf16*)(F.ws + WS_XN); int* LIST = (int*)(F.ws + WS_LIST); unsigned* cnt = (unsigned*)(F.ctl + CW_CNT);
    for (int base = blockIdx.x * 4; base < T / 32; base += F.G * 4) {
        const int grp = base + F.wave; const bool active = F.wave < 4 && grp < T / 32;
        if (F.tid < 32) lcnt[F.tid] = 0u;
        __syncthreads();
        float sv[4] = {0.f, 0.f, 0.f, 0.f}; int se[4] = {0, 0, 0, 0}; unsigned lp0 = 0u, lp1 = 0u; float rstd = 0.f; const int tok = grp * 32 + r;
        if (active) {
            const bf16* hrow = XH + (size_t)tok * D + 8 * hh;
            f32x16 acc;
#pragma unroll
            for (int i = 0; i < 16; ++i) acc[i] = 0.f;
            float ssq = 0.f;
#pragma unroll 16
            for (int s = 0; s < 64; ++s) {
                const v4u hu = *(const GAS v4u*)(hrow + 16 * s); const bf16x8 hi = __builtin_bit_cast(bf16x8, hu);
                { const float a0 = bflo(hu.x), a1 = bfhi(hu.x), a2 = bflo(hu.y), a3 = bfhi(hu.y), a4 = bflo(hu.z), a5 = bfhi(hu.z), a6 = bflo(hu.w), a7 = bfhi(hu.w);
                    ssq += (a0 * a0 + a1 * a1) + (a2 * a2 + a3 * a3) + (a4 * a4 + a5 * a5) + (a6 * a6 + a7 * a7); }
                const bf16x8 wh = *(const LAS bf16x8*)(L + r * RT_ROW + 32 * s + 16 * hh), wl = *(const LAS bf16x8*)(L + RT_WL + r * RT_ROW + 32 * s + 16 * hh);
                acc = MFMA32(wh, hi, acc); acc = MFMA32(wl, hi, acc);
            }
            ssq += __shfl_xor(ssq, 32);
            rstd = 1.f / sqrtf(ssq * (1.f / D) + EPS);
            float l[16];
#pragma unroll
            for (int i = 0; i < 16; ++i) l[i] = acc[i] * rstd + F.b_router[crow16(i, hh)];
            float cv[8]; int ce[8];
#pragma unroll
            for (int rnd = 0; rnd < 4; ++rnd) { float bv = l[0]; int bi = 0;
#pragma unroll
                for (int i = 1; i < 16; ++i) if (l[i] > bv) { bv = l[i]; bi = i; }
                cv[rnd] = bv; ce[rnd] = crow16(bi, hh);
#pragma unroll
                for (int i = 0; i < 16; ++i) if (i == bi) l[i] = -__builtin_inff(); }
#pragma unroll
            for (int j = 0; j < 4; ++j) { cv[4 + j] = __shfl_xor(cv[j], 32); ce[4 + j] = __shfl_xor(ce[j], 32); }
#pragma unroll
            for (int rnd = 0; rnd < 4; ++rnd) { float bv = cv[0]; int be = ce[0]; int bj = 0;
#pragma unroll
                for (int j = 1; j < 8; ++j) if (cv[j] > bv || (cv[j] == bv && ce[j] < be)) { bv = cv[j]; be = ce[j]; bj = j; }
                sv[rnd] = bv; se[rnd] = be;
#pragma unroll
                for (int j = 0; j < 8; ++j) if (j == bj) { cv[j] = -__builtin_inff(); ce[j] = 64; } }
            lp0 = __hip_atomic_fetch_add(lcnt + (hh ? se[2] : se[0]), 1u, __ATOMIC_RELAXED, __HIP_MEMORY_SCOPE_WORKGROUP);
            lp1 = __hip_atomic_fetch_add(lcnt + (hh ? se[3] : se[1]), 1u, __ATOMIC_RELAXED, __HIP_MEMORY_SCOPE_WORKGROUP);
        }
        __syncthreads();
        if (F.tid < 32) lbase[F.tid] = __hip_atomic_fetch_add(cnt + F.tid, lcnt[F.tid], __ATOMIC_RELAXED, __HIP_MEMORY_SCOPE_AGENT);
        __syncthreads();
        if (active) {
            const float e1 = __expf(sv[1] - sv[0]), e2 = __expf(sv[2] - sv[0]), e3 = __expf(sv[3] - sv[0]); const float inv = 1.f / (1.f + e1 + e2 + e3);
            const int ea = hh ? se[2] : se[0], eb = hh ? se[3] : se[1]; const float ga = (hh ? e2 : 1.f) * inv, gb = (hh ? e3 : e1) * inv;
            const size_t ia = (size_t)ea * 32768 + lbase[ea] + lp0, ib = (size_t)eb * 32768 + lbase[eb] + lp1;
            LIST[ia] = tok * 4 + 2 * hh; LIST[ib] = tok * 4 + 2 * hh + 1; TOPG[tok * 4 + 2 * hh] = ga; TOPG[tok * 4 + 2 * hh + 1] = gb;
            if (hh == 0) lrstd[F.wave * 32 + r] = rstd;
        }
        __syncthreads();
        {
            unsigned char* X8 = F.ws + WS_X8; const int t0 = base * 32;
#pragma unroll
            for (int q0 = 0; q0 < 16; q0 += 4) { v4u a[4][2];
#pragma unroll
                for (int q = 0; q < 4; ++q) { const int tt = t0 + F.wave * 16 + q0 + q; const GAS v4u* p = (const GAS v4u*)(XH + (size_t)(tt < T ? tt : 0) * D) + 2 * F.lane; a[q][0] = p[0]; a[q][1] = p[1]; }
#pragma unroll
                for (int q = 0; q < 4; ++q) { const int tl = F.wave * 16 + q0 + q, tt = t0 + tl; if (tt < T) { const float rs = lrstd[tl]; v4u o;
                    o.x = pg8::pk4_fp8(bflo(a[q][0].x) * rs, bfhi(a[q][0].x) * rs, bflo(a[q][0].y) * rs, bfhi(a[q][0].y) * rs); o.y = pg8::pk4_fp8(bflo(a[q][0].z) * rs, bfhi(a[q][0].z) * rs, bflo(a[q][0].w) * rs, bfhi(a[q][0].w) * rs);
                    o.z = pg8::pk4_fp8(bflo(a[q][1].x) * rs, bfhi(a[q][1].x) * rs, bflo(a[q][1].y) * rs, bfhi(a[q][1].y) * rs); o.w = pg8::pk4_fp8(bflo(a[q][1].z) * rs, bfhi(a[q][1].z) * rs, bflo(a[q][1].w) * rs, bfhi(a[q][1].w) * rs);
                    *((GAS v4u*)(X8 + (size_t)tt * D) + F.lane) = o; } } }
        }
        __syncthreads();
    }
}
__device__ __forceinline__ int build_moe_tables(Frame& F, int ntn, int mode) {
    LAS int* lt = (LAS int*)(F.lds + LTAB_OFF);
    if (F.wave == 0) {
        const int e = F.lane & 31; const int c = (int)__hip_atomic_load((unsigned*)(F.ctl + CW_CNT) + e, __ATOMIC_RELAXED, __HIP_MEMORY_SCOPE_AGENT);
        const int tl = (c + 255) >> 8; int inc = tl;
#pragma unroll
        for (int off = 1; off < 32; off <<= 1) { const int o = __shfl_up(inc, off, 32); if (e >= off) inc += o; }
        const int tot = __shfl(inc, 31, 32), t0 = inc - tl;
        if (F.lane < 32) { lt[LT_TS + e] = t0; lt[LT_CNT + e] = c; for (int i = 0; i < tl; ++i) lt[t0 + i] = e; }
        if (F.lane == 0) lt[LT_MISC + 64] = tot;
    }
    __syncthreads();
    int nt = lt[LT_MISC + 64]; nt = nt < 0 ? 0 : (nt > MAXTILES ? MAXTILES : nt); nt = __builtin_amdgcn_readfirstlane(nt);
    const int* LIST = (const int*)(F.ws + WS_LIST);
    const int nslot = mode == 1 ? MAXSLOT : (MAXTILES * 4 + 255) / 256;
    for (int q = F.tid; q < nslot * 256; q += NWAVES * 64) { const int i = q >> 8, rr = q & 255; const int Lu = i * F.G + F.vcu;
        int li = -1; float bias = 0.f;
        if (Lu < nt * ntn) { const int pm0 = Lu / ntn, pl = Lu - pm0 * ntn, pm = mode == 2 ? nt - 1 - pm0 : pm0, e = lt[pm], idx = (pm - lt[LT_TS + e]) * 256 + rr; if (idx < lt[LT_CNT + e]) li = LIST[(size_t)e * 32768 + idx];
            bias = mode == 1 ? F.b_gu[(size_t)e * 2048 + (rr >> 7) * 1024 + pl * 128 + (rr & 127)] : F.b_d[(size_t)e * 1024 + pl * 256 + rr]; }
        ((LAS float*)(F.lds + ROWTAB_OFF))[q] = bias;
        if (mode == 1) ((LAS unsigned short*)(F.lds + ROWTAB2_OFF))[q] = (unsigned short)(li < 0 ? 0 : (li >> 2));
        else ((LAS int*)(F.lds + ROWTAB_OFF) + nslot * 256)[q] = li; }
    __syncthreads();
    return nt;
}
__device__ __forceinline__ void combine_phase(Frame& F) {
    const unsigned char* YK = F.ws + WS_YK; const bf16* XH = (const bf16*)(F.ws + WS_XN); const float* TOPG = (const float*)(F.ws + WS_TOPG);
    for (int t = F.gw; t < T; t += F.ngw) {
        GAS f32x4* xr = (GAS f32x4*)(F.out + (size_t)t * D) + F.lane; f32x4 v[4]; unsigned y[4][4]; const f32x4 gt = *((const GAS f32x4*)TOPG + t + vzero()) * (1.0f / Y8_SCALE);
#pragma unroll
        for (int j = 0; j < 4; ++j) { const unsigned long long xh = __builtin_nontemporal_load((const GAS unsigned long long*)(XH + (size_t)t * D) + F.lane + 64 * j);
            v[j] = (f32x4){bflo((unsigned)xh), bfhi((unsigned)xh), bflo((unsigned)(xh >> 32)), bfhi((unsigned)(xh >> 32))};
#pragma unroll
            for (int k = 0; k < 4; ++k) y[j][k] = __builtin_nontemporal_load((const GAS unsigned*)(YK + ((size_t)t * 4 + k) * D) + F.lane + 64 * j); }
#pragma unroll
        for (int j = 0; j < 4; ++j) { f32x4 s4 = {0.f, 0.f, 0.f, 0.f};
#pragma unroll
            for (int k = 0; k < 4; ++k) { const f32x2n_ lo = __builtin_amdgcn_cvt_pk_f32_fp8((int)y[j][k], false), hi = __builtin_amdgcn_cvt_pk_f32_fp8((int)y[j][k], true); const float g = gt[k]; s4.x += g * lo.x; s4.y += g * lo.y; s4.z += g * hi.x; s4.w += g * hi.y; }
            v[j] = v[j] + s4;
            __builtin_nontemporal_store(v[j], xr + 64 * j); }
    }
}

constexpr int NPH = 9;
struct Args { const float* in[16]; float* out; unsigned char* ws; int ph_lo, ph_hi; };
__global__ void __launch_bounds__(NWAVES * 64, 2) fwd(Args args) {
    extern __shared__ __attribute__((aligned(16))) unsigned char lds[];
    Frame F;
    F.lds = (LAS unsigned char*)lds;
    F.MISC = (volatile LAS unsigned*)(F.lds + MISC_OFF);
    F.tid = threadIdx.x; F.lane = F.tid & 63; F.wave = __builtin_amdgcn_readfirstlane(F.tid >> 6);
    F.G = gridDim.x; { const int bx = blockIdx.x; F.vcu = (F.G % 8 == 0) ? (bx % 8) * (F.G / 8) + bx / 8 : bx; }
    F.gw = blockIdx.x * NWAVES + F.wave; F.ngw = F.G * NWAVES;
    F.ws = args.ws; F.ctl = (gu32*)(args.ws + WS_CTL); F.out = args.out;
    F.x = args.in[0]; F.norm1_g = args.in[1]; F.w_in = args.in[2]; F.sb_q_g = args.in[3]; F.sb_k_g = args.in[4]; F.sb_out_g = args.in[5]; F.hg_lb = args.in[6]; F.hg_out_g = args.in[7];
    F.w_out = args.in[8]; F.norm2_g = args.in[9]; F.w_router = args.in[10]; F.b_router = args.in[11]; F.w_gu = args.in[12]; F.b_gu = args.in[13]; F.w_d = args.in[14]; F.b_d = args.in[15];
    for (int u = F.tid; u < (LDS_BYTES - LDSCTL_OFF) / 4; u += NWAVES * 64) ((LAS unsigned*)(F.lds + LDSCTL_OFF))[u] = 0u;
    __syncthreads();
    XcdBarrier bar; bar.bar = (unsigned*)(F.ctl + CW_BAR); bar.x = 0; bar.st = nullptr;
    if (MK_ONE_LAUNCH) bar = xcd_barrier_post((unsigned*)(F.ctl + CW_BAR), F.MISC + 8);
    const int lo = args.ph_lo, hi = args.ph_hi;
#define IN(k) (lo <= (k) && (k) < hi && ((F.lane = lane_id()), (F.tid = F.wave * 64 + F.lane), true))
#define SEAM(k) do { if (IN(k) && IN((k) + 1)) xcd_barrier(bar); } while (0)

    if (IN(0)) { p0_prologue(F); } SEAM(0);
    if (IN(1)) {
        pg8::Gemm g{(const bf16*)(F.ws + WS_XN), (const bf16*)(F.ws + WS_WIN), T, NIN, D}; pg8::StaticOrder S; S.init(T, NIN, F.G, (int)blockIdx.x);
        pg8::EpiInproj E{(bf16*)(F.ws + WS_P), (bf16*)(F.ws + WS_PH), (bf16*)(F.ws + WS_QN), (bf16*)(F.ws + WS_KN), F.sb_q_g, F.sb_k_g, QSCALE, EPS};
        pg8::gemm_phase<pg8::EpiInproj, pg8::StaticOrder, PG8_ALIGN, PG8_SP2>(F.lds + RING_OFF, g, S, E, F.tid);
    } SEAM(1);
    if (IN(2)) { prep_phase(F); __syncthreads(); hgA_phase(F); } SEAM(2);
    if (IN(3)) { attn_phase(F); hgC_phase(F); } SEAM(3);
    if (IN(4)) {
        pg8::Gemm g{(const bf16*)(F.ws + WS_MIX), (const bf16*)(F.ws + WS_WOUT), T, D, D}; pg8::StaticOrder S; S.init(T, D, F.G, (int)blockIdx.x);
        pg8::EpiRes E{F.x, (bf16*)(F.ws + WS_XN), D};
        pg8::gemm_phase<pg8::EpiRes, pg8::StaticOrder, PG8_ALIGN, PG8_SP2>(F.lds + RING_OFF, g, S, E, F.tid);
    } SEAM(4);
    if (IN(5)) { router_phase(F); } SEAM(5);
    if (IN(6)) {
        const int nt = build_moe_tables(F, 8, 1); const LAS int* lt = (const LAS int*)(F.lds + LTAB_OFF);
        pg8::Gemm g{(const bf16*)(F.ws + WS_X8), (const bf16*)(F.ws + WS_WGU), MAXROWS, NE * 2048, D / 2};
        pg8::MoeOrder S{lt, (const LAS unsigned short*)(F.lds + ROWTAB2_OFF), 8, nt * 8, F.G, F.vcu, 1024u, 0};
        pg8::EpiAct<true> E{F.ws + WS_ACT, (const LAS float*)(F.lds + ROWTAB_OFF), A8_SCALE};
        pg8::gemm_phase<pg8::EpiAct<true>, pg8::MoeOrder, PG8_ALIGN, PG8_SP2, true, SC_W8, SC_ONE>(F.lds + RING_OFF, g, S, E, F.tid);
    } SEAM(6);
    if (IN(7)) {
        const int nt = build_moe_tables(F, 4, 2); const LAS int* lt = (const LAS int*)(F.lds + LTAB_OFF);
        pg8::Gemm g{(const bf16*)(F.ws + WS_ACT), (const bf16*)(F.ws + WS_WD), MAXROWS, NE * 1024, D / 2};
        pg8::MoeOrder S{lt, nullptr, 4, nt * 4, F.G, F.vcu, 1024u, nt};
        pg8::EpiDown E{F.ws + WS_YK, (const LAS int*)(F.lds + ROWTAB_OFF) + ((MAXTILES * 4 + 255) / 256) * 256, (const LAS float*)(F.lds + ROWTAB_OFF), Y8_SCALE};
        pg8::gemm_phase<pg8::EpiDown, pg8::MoeOrder, PG8_ALIGN, PG8_SP2, true, SC_W8Y, SC_A8>(F.lds + RING_OFF, g, S, E, F.tid);
    } SEAM(7);
    if (IN(8)) { combine_phase(F); }
#undef IN
#undef SEAM
}

extern "C" void kernel_launch(void* const* d_in, const int* in_sizes, int n_in, void* d_out, int out_size, void* d_ws, size_t ws_size, hipStream_t stream) {
    static int grid = 0;
    if (grid == 0) {
        if (n_in != 16 || in_sizes[0] != T * D || out_size != T * D || ws_size < WS_END) { fprintf(stderr, "kernel_launch: shape/workspace mismatch (n_in %d, ws %zu, need %zu); nothing launched\n", n_in, ws_size, (size_t)WS_END); grid = -1; return; }
        int dev = 0, cus = 0, per_cu = 0;
        if (hipGetDevice(&dev) != hipSuccess || hipDeviceGetAttribute(&cus, hipDeviceAttributeMultiprocessorCount, dev) != hipSuccess) { grid = -1; return; }
        if (hipFuncSetAttribute((const void*)fwd, hipFuncAttributeMaxDynamicSharedMemorySize, LDS_BYTES) != hipSuccess) { grid = -1; return; }
        if (hipOccupancyMaxActiveBlocksPerMultiprocessor(&per_cu, (const void*)fwd, NWAVES * 64, LDS_BYTES) != hipSuccess || per_cu < 1) { fprintf(stderr, "kernel_launch: occupancy query says %d\n", per_cu); }
        (void)hipGetLastError();
        if ((MAXTILES * 8 + cus - 1) / cus > MAXSLOT || cus < 1) { fprintf(stderr, "kernel_launch: %d CUs: the per-workgroup unit tables are sized for 256\n", cus); grid = -1; return; }
        grid = cus;
    }
    if (grid < 0) return;
    if (hipMemsetAsync((char*)d_ws + WS_CTL, 0, CTL_ZERO_BYTES, stream) != hipSuccess) return;
    Args a{};
    for (int i = 0; i < 16; ++i) a.in[i] = (const float*)d_in[i];
    a.out = (float*)d_out; a.ws = (unsigned char*)d_ws;
#if MK_ONE_LAUNCH
    a.ph_lo = 0; a.ph_hi = NPH;
    hipLaunchKernelGGL(fwd, dim3(grid), dim3(NWAVES * 64), LDS_BYTES, stream, a);
#else
    for (int p = 0; p < NPH; ++p) { a.ph_lo = p; a.ph_hi = p + 1; hipLaunchKernelGGL(fwd, dim3(grid), dim3(NWAVES * 64), LDS_BYTES, stream, a); }
#endif
}
```

```cpp
#include <hip/hip_runtime.h>
#include <cstdio>
#include <cstdint>
namespace pg8 {
#define PG8_LAS __attribute__((address_space(3)))
typedef unsigned short bf16_t;
typedef short bf16x8 __attribute__((ext_vector_type(8)));
typedef float f32x4 __attribute__((ext_vector_type(4)));
typedef unsigned u32x4 __attribute__((ext_vector_type(4)));
typedef int i32x4_t __attribute__((ext_vector_type(4)));
typedef int i32x8_t __attribute__((ext_vector_type(8)));
constexpr int BM = 256, BK = 64, HALF = 128, HTB = HALF * BK * 2  , STAGE_BYTES = 8 * HTB, NXCD = 8, WGM = 8;

__host__ __device__ __forceinline__ int lds_byte(int r, int c) { const int st = (r >> 4) * 2 + (c >> 5), rr = r & 15, cc = c & 31, ob = rr * 64 + cc * 2; return st * 1024 + (ob ^ (((ob >> 9) & 1) << 5)); }
__host__ __device__ __forceinline__ void stage_rc(int b, int& R, int& C) { const int st = b / 1024, sb = b % 1024, swz = sb ^ (((sb >> 9) & 1) << 5); R = (st >> 1) * 16 + swz / 64; C = (st & 1) * 32 + (swz % 64) / 2; }
__host__ __device__ __forceinline__ int perm32(int rho) { const int n = rho >> 4, i = rho & 15; return 8 * (i >> 2) + 4 * n + (i & 3); }

struct Unit { int pm, pn, slot; };
struct Gemm { const bf16_t* A; const bf16_t* Bt; int M, N, K; };

struct StaticOrder {
    int nM, nN, nwg, G, c;
    __host__ __device__ void init(int M, int N, int G_, int c_) { nM = M / BM; nN = N / BM; nwg = nM * nN; G = G_; c = c_; }
    __host__ __device__ bool next(int i, Unit& u) const {
        const long L = (long)i * G + c; if (L >= nwg) return false;
        int wgid = (int)L; { const int q = nwg / NXCD, r = nwg % NXCD, xcd = wgid % NXCD, off = wgid / NXCD; wgid = (xcd < r ? xcd * (q + 1) : r * (q + 1) + (xcd - r) * q) + off; }
        const int nig = WGM * nN, gid = wgid / nig, fm = gid * WGM, gsz = (nM - fm) < WGM ? (nM - fm) : WGM;
        u.pm = fm + ((wgid % nig) % gsz); u.pn = (wgid % nig) / gsz; return true;
    }
    __device__ __forceinline__ void a_ready(const Unit&) const {}
    __device__ __forceinline__ void done(const Unit&) const {}
};

__device__ __forceinline__ unsigned cvt_pk_bf16(float lo, float hi) { unsigned r; asm volatile("v_cvt_pk_bf16_f32 %0, %1, %2" : "=v"(r) : "v"(lo), "v"(hi)); return r; }
typedef float f32x2 __attribute__((ext_vector_type(2)));
__device__ __forceinline__ f32x2 gelu_pk(f32x2 v) {
    const f32x2 av = __builtin_elementwise_abs(v), d = av * 0.2316418882f + 1.0f;
    f32x2 t; t.x = __builtin_amdgcn_rcpf(d.x); t.y = __builtin_amdgcn_rcpf(d.y);
    f32x2 q = t * 0.5307027145f + (-0.7265760135f); q = q * t + 0.7107068705f; q = q * t + (-0.142248368f); q = q * t + 0.127414796f; q = q * t;
    const f32x2 s = (v * v) * (-0.72134752044f);
    f32x2 e; e.x = __builtin_amdgcn_exp2f(s.x); e.y = __builtin_amdgcn_exp2f(s.y);
    const f32x2 m = v * (q * e), r = v - m;
    f32x2 o; o.x = v.x < 0.f ? m.x : r.x; o.y = v.y < 0.f ? m.y : r.y; return o;
}

template <int ACT  > struct EpiBf16 {
    static constexpr bool PERM = true, AFTER_DRAIN = false, HAS_INIT = false; static_assert(ACT == 0 || ACT == 1, "EpiBf16: ACT is 0 (none) or 1 (gelu_pk)");
    bf16_t* O; int ldc; const float* bias; int split_cols; size_t split_stride; float scale0;
    __device__ __forceinline__ void operator()(const f32x4 (&acc)[2][2][4][2], const Unit& u, int wr, int wc, int fr, int fq) const {
        const int row0 = u.pm * BM + wr * 64 + fr; int colt = u.pn * BM; bf16_t* base = O;
        float sc = 1.f; if (split_cols) { const int t = colt / split_cols; base += (size_t)t * split_stride; colt -= t * split_cols; if (t == 0) sc = scale0; }
        const int col0 = colt + wc * 32 + 8 * fq, bcol0 = u.pn * BM + wc * 32 + 8 * fq;
        f32x4 bv[2][2];
#pragma unroll
        for (int bj = 0; bj < 2; ++bj)
#pragma unroll
            for (int n = 0; n < 2; ++n) bv[bj][n] = bias ? *(const f32x4*)(bias + bcol0 + bj * HALF + 4 * n) : (f32x4){0.f, 0.f, 0.f, 0.f};
#pragma unroll
        for (int ai = 0; ai < 2; ++ai)
#pragma unroll
            for (int m = 0; m < 4; ++m) { bf16_t* rowp = base + (size_t)(row0 + ai * HALF + m * 16) * ldc + col0;
#pragma unroll
                for (int bj = 0; bj < 2; ++bj) { f32x4 v0 = acc[ai][bj][m][0] + bv[bj][0], v1 = acc[ai][bj][m][1] + bv[bj][1];
                    if (ACT == 1) { f32x2 a = gelu_pk((f32x2){v0[0], v0[1]}), b = gelu_pk((f32x2){v0[2], v0[3]}), c = gelu_pk((f32x2){v1[0], v1[1]}), d = gelu_pk((f32x2){v1[2], v1[3]});
                        v0 = (f32x4){a.x, a.y, b.x, b.y}; v1 = (f32x4){c.x, c.y, d.x, d.y}; }
                    v0 = v0 * sc; v1 = v1 * sc; u32x4 w; w.x = cvt_pk_bf16(v0[0], v0[1]); w.y = cvt_pk_bf16(v0[2], v0[3]); w.z = cvt_pk_bf16(v1[0], v1[1]); w.w = cvt_pk_bf16(v1[2], v1[3]);
                    *(u32x4*)(rowp + bj * HALF) = w; } }
    }
};

__device__ __forceinline__ unsigned pk4_fp8(float a, float b, float c, float d) {
    a = fminf(fmaxf(a, -448.f), 448.f); b = fminf(fmaxf(b, -448.f), 448.f); c = fminf(fmaxf(c, -448.f), 448.f); d = fminf(fmaxf(d, -448.f), 448.f);
    int p = 0; p = __builtin_amdgcn_cvt_pk_fp8_f32(a, b, p, false); p = __builtin_amdgcn_cvt_pk_fp8_f32(c, d, p, true); return (unsigned)p;
}
struct EpiRes {
    static constexpr bool PERM = false, AFTER_DRAIN = false, HAS_INIT = false;
    const float* __restrict__ X; bf16_t* __restrict__ XH; int ldc;
    __device__ __forceinline__ void operator()(const f32x4 (&acc)[2][2][4][2], const Unit& u, int wr, int wc, int fr, int fq) const {
        const int row0 = u.pm * BM + wr * 64 + fr, col0 = u.pn * BM + wc * 32 + 4 * fq;
#pragma unroll
        for (int ai = 0; ai < 2; ++ai)
#pragma unroll
            for (int mp = 0; mp < 2; ++mp) { f32x4 xv[2][2][2];
#pragma unroll
                for (int mm = 0; mm < 2; ++mm) { const size_t off = (size_t)(row0 + ai * HALF + (2 * mp + mm) * 16) * ldc + col0;
#pragma unroll
                    for (int bj = 0; bj < 2; ++bj)
#pragma unroll
                        for (int n = 0; n < 2; ++n) xv[mm][bj][n] = __builtin_nontemporal_load((const f32x4*)(X + off + bj * HALF + n * 16)); }
#pragma unroll
                for (int mm = 0; mm < 2; ++mm) { const size_t off = (size_t)(row0 + ai * HALF + (2 * mp + mm) * 16) * ldc + col0;
#pragma unroll
                    for (int bj = 0; bj < 2; ++bj)
#pragma unroll
                        for (int n = 0; n < 2; ++n) { const size_t o2 = off + bj * HALF + n * 16; const f32x4 v = xv[mm][bj][n] + acc[ai][bj][2 * mp + mm][n];
                            *(unsigned long long*)(XH + o2) = (unsigned long long)cvt_pk_bf16(v[0], v[1]) | ((unsigned long long)cvt_pk_bf16(v[2], v[3]) << 32); } } }
    }
};
struct EpiInproj {
    static constexpr bool PERM = true, AFTER_DRAIN = false, HAS_INIT = false;
    bf16_t* PA; bf16_t* PH; bf16_t* QN; bf16_t* KN; const float* gq; const float* gk; float qscale, eps;
    __device__ __forceinline__ void operator()(const f32x4 (&acc)[2][2][4][2], const Unit& u, int wr, int wc, int fr, int fq) const {
        if (u.pn < 4) {
            const int arr = u.pn >> 1, hd = (u.pn & 1) * 4 + wc; const float* g = arr ? gk : gq; const float gs = arr ? 1.f : qscale; bf16_t* dst = arr ? KN : QN;
            f32x4 gv[2][2];
#pragma unroll
            for (int bj = 0; bj < 2; ++bj)
#pragma unroll
                for (int n = 0; n < 2; ++n) gv[bj][n] = *(const f32x4*)(g + 32 * bj + 8 * fq + 4 * n) * gs;
#pragma unroll
            for (int ai = 0; ai < 2; ++ai)
#pragma unroll
                for (int m = 0; m < 4; ++m) { float ss = 0.f;
#pragma unroll
                    for (int bj = 0; bj < 2; ++bj)
#pragma unroll
                        for (int n = 0; n < 2; ++n) { const f32x4 a = acc[ai][bj][m][n]; ss += (a[0] * a[0] + a[1] * a[1]) + (a[2] * a[2] + a[3] * a[3]); }
                    ss += __shfl_xor(ss, 16); ss += __shfl_xor(ss, 32);
                    const float rs = 1.f / sqrtf(ss * (1.f / 64.f) + eps);
                    const int row = u.pm * BM + ai * HALF + wr * 64 + m * 16 + fr, b = row >> 11, s = row & 2047;
                    bf16_t* rp = dst + ((size_t)((b * 8 + hd) * 64 + (s >> 5))) * 2048 + (s & 31) * 8;
#pragma unroll
                    for (int bj = 0; bj < 2; ++bj) { const int c8 = 4 * bj + fq; const f32x4 v0 = acc[ai][bj][m][0] * rs * gv[bj][0], v1 = acc[ai][bj][m][1] * rs * gv[bj][1];
                        u32x4 w; w.x = cvt_pk_bf16(v0[0], v0[1]); w.y = cvt_pk_bf16(v0[2], v0[3]); w.z = cvt_pk_bf16(v1[0], v1[1]); w.w = cvt_pk_bf16(v1[2], v1[3]);
                        *(u32x4*)(rp + (c8 >> 1) * 512 + (c8 & 1) * 256) = w; } }
            return;
        }
#pragma unroll
        for (int bj = 0; bj < 2; ++bj) { const int col = u.pn * BM + bj * HALF + wc * 32 + 8 * fq;
            bf16_t* base; int rowlen;
            if (col < 1536) { const int arr = col >> 9, hd = (col & 511) >> 6, dd = col & 63; base = PA + ((size_t)(arr * 16) * 8 + hd) * 2048 * 64 + dd; rowlen = 64; }
            else { const int c2 = col - 1536, arr = c2 >> 9, hd = (c2 & 511) >> 7, dd = c2 & 127; base = PH + ((size_t)(arr * 16) * 4 + hd) * 2048 * 128 + dd; rowlen = 128; }
            const size_t bstride = (size_t)(rowlen == 64 ? 8 : 4) * 2048 * rowlen;
#pragma unroll
            for (int ai = 0; ai < 2; ++ai)
#pragma unroll
                for (int m = 0; m < 4; ++m) { const int row = u.pm * BM + ai * HALF + wr * 64 + m * 16 + fr, b = row >> 11, s = row & 2047;
                    const f32x4 v0 = acc[ai][bj][m][0], v1 = acc[ai][bj][m][1];
                    u32x4 w; w.x = cvt_pk_bf16(v0[0], v0[1]); w.y = cvt_pk_bf16(v0[2], v0[3]); w.z = cvt_pk_bf16(v1[0], v1[1]); w.w = cvt_pk_bf16(v1[2], v1[3]);
                    *(u32x4*)(base + (size_t)b * bstride + (size_t)s * rowlen) = w; } }
    }
};
struct MoeOrder {
    const PG8_LAS int* tile_e; const PG8_LAS unsigned short* rowtab; int ntn, nunits, G, c; unsigned rowbytes; int rev;
    __device__ __forceinline__ bool next(int i, Unit& u) const {
        const int L = i * G + c; if (L >= nunits) return false;
        const int pm0 = L / ntn, pl = L - pm0 * ntn, pm = rev ? rev - 1 - pm0 : pm0; u.pm = pm; u.pn = tile_e[pm] * ntn + pl; u.slot = i; return true;
    }
    __device__ __forceinline__ unsigned rowoff(const Unit& u, int r) const { return (rowtab ? (unsigned)rowtab[u.slot * 256 + r] : (unsigned)(u.pm * 256 + r)) * rowbytes; }
    __device__ __forceinline__ void a_ready(const Unit&) const {}
    __device__ __forceinline__ void done(const Unit&) const {}
};
template <bool OUT8> struct EpiAct {
    static constexpr bool PERM = true, AFTER_DRAIN = false, HAS_INIT = true;
    unsigned char* ACT; const PG8_LAS float* biastab; float oscale;
    __device__ __forceinline__ void init(f32x4 (&acc)[2][2][4][2], const Unit& u, int wc, int fq) const {
#pragma unroll
        for (int n = 0; n < 2; ++n) { const f32x4 bg = *(const PG8_LAS f32x4*)(biastab + u.slot * 256 + wc * 32 + 8 * fq + 4 * n), bu = *(const PG8_LAS f32x4*)(biastab + u.slot * 256 + 128 + wc * 32 + 8 * fq + 4 * n);
#pragma unroll
            for (int ai = 0; ai < 2; ++ai)
#pragma unroll
                for (int m = 0; m < 4; ++m) { acc[ai][0][m][n] = bg; acc[ai][1][m][n] = bu; } }
    }
    __device__ __forceinline__ void operator()(const f32x4 (&acc)[2][2][4][2], const Unit& u, int wr, int wc, int fr, int fq) const {
        const int pl = u.pn & 7; const int row0 = u.pm * BM + wr * 64 + fr, acol0 = pl * 128 + wc * 32 + 8 * fq;
#pragma unroll
        for (int ai = 0; ai < 2; ++ai)
#pragma unroll
            for (int m = 0; m < 4; ++m) { unsigned char* rowp = ACT + (size_t)(row0 + ai * HALF + m * 16) * 1024 + acol0; f32x4 a4[2];
#pragma unroll
                for (int n = 0; n < 2; ++n) { const f32x4 g4 = acc[ai][0][m][n], u4 = acc[ai][1][m][n]; f32x4 gl, ul, ex;
#pragma unroll
                    for (int j = 0; j < 4; ++j) { gl[j] = fminf(g4[j], 7.0f); ul[j] = __builtin_amdgcn_fmed3f(u4[j], -7.0f, 7.0f); }
                    const f32x4 t4 = gl * (-1.702f * 1.44269504089f);
#pragma unroll
                    for (int j = 0; j < 4; ++j) ex[j] = __builtin_amdgcn_exp2f(t4[j]);
                    const f32x4 d4 = ex + 1.0f; f32x4 s4;
#pragma unroll
                    for (int j = 0; j < 4; ++j) s4[j] = __builtin_amdgcn_rcpf(d4[j]);
                    a4[n] = (gl * s4) * (ul * oscale + oscale); }
                if constexpr (OUT8) { int p0 = 0, p1 = 0; p0 = __builtin_amdgcn_cvt_pk_fp8_f32(a4[0][0], a4[0][1], p0, false); p0 = __builtin_amdgcn_cvt_pk_fp8_f32(a4[0][2], a4[0][3], p0, true);
                    p1 = __builtin_amdgcn_cvt_pk_fp8_f32(a4[1][0], a4[1][1], p1, false); p1 = __builtin_amdgcn_cvt_pk_fp8_f32(a4[1][2], a4[1][3], p1, true);
                    *(unsigned long long*)rowp = (unsigned long long)(unsigned)p0 | ((unsigned long long)(unsigned)p1 << 32); }
                else { u32x4 w; w.x = cvt_pk_bf16(a4[0][0], a4[0][1]); w.y = cvt_pk_bf16(a4[0][2], a4[0][3]); w.z = cvt_pk_bf16(a4[1][0], a4[1][1]); w.w = cvt_pk_bf16(a4[1][2], a4[1][3]); *(u32x4*)(rowp + (size_t)(row0 + ai * HALF + m * 16) * 1024 + acol0) = w; } }
    }
};
struct EpiDown {
    static constexpr bool PERM = true, AFTER_DRAIN = false, HAS_INIT = true;
    unsigned char* YK; const PG8_LAS int* tktab; const PG8_LAS float* biastab; float oscale;
    __device__ __forceinline__ void init(f32x4 (&acc)[2][2][4][2], const Unit& u, int wc, int fq) const {
#pragma unroll
        for (int bj = 0; bj < 2; ++bj)
#pragma unroll
            for (int n = 0; n < 2; ++n) { const f32x4 bv = *(const PG8_LAS f32x4*)(biastab + u.slot * 256 + bj * HALF + wc * 32 + 8 * fq + 4 * n) * oscale;
#pragma unroll
                for (int ai = 0; ai < 2; ++ai)
#pragma unroll
                    for (int m = 0; m < 4; ++m) acc[ai][bj][m][n] = bv; }
    }
    __device__ __forceinline__ void operator()(const f32x4 (&acc)[2][2][4][2], const Unit& u, int wr, int wc, int fr, int fq) const {
        const int pl = u.pn & 3; const int col0 = pl * BM + wc * 32 + 8 * fq;
#pragma unroll
        for (int ai = 0; ai < 2; ++ai)
#pragma unroll
            for (int m = 0; m < 4; ++m) { const int tk = tktab[u.slot * 256 + ai * HALF + wr * 64 + m * 16 + fr];
                if (tk >= 0) { unsigned char* rowp = YK + (size_t)tk * 1024 + col0;
#pragma unroll
                    for (int bj = 0; bj < 2; ++bj) { f32x4 v0 = acc[ai][bj][m][0], v1 = acc[ai][bj][m][1];
#pragma unroll
                        for (int j = 0; j < 4; ++j) { v0[j] = __builtin_amdgcn_fmed3f(v0[j], -448.f, 448.f); v1[j] = __builtin_amdgcn_fmed3f(v1[j], -448.f, 448.f); }
                        int p0 = 0, p1 = 0; p0 = __builtin_amdgcn_cvt_pk_fp8_f32(v0[0], v0[1], p0, false); p0 = __builtin_amdgcn_cvt_pk_fp8_f32(v0[2], v0[3], p0, true);
                        p1 = __builtin_amdgcn_cvt_pk_fp8_f32(v1[0], v1[1], p1, false); p1 = __builtin_amdgcn_cvt_pk_fp8_f32(v1[2], v1[3], p1, true);
                        *(unsigned long long*)(rowp + bj * HALF) = (unsigned long long)(unsigned)p0 | ((unsigned long long)(unsigned)p1 << 32); } } }
    }
};


template <class Epi, class Sched, bool ALIGN_EPI = false, bool SP2 = false, bool GATHER = false, int SCW = 0, int SCX = 0>
__device__ __forceinline__ void gemm_phase(PG8_LAS unsigned char* lds, const Gemm g, const Sched& S, const Epi& E, const int tid) {
    const int wid = __builtin_amdgcn_readfirstlane(tid >> 6), lane = tid & 63, wr = wid >> 2, wc = wid & 3, fr = lane & 15, fq = lane >> 4;
    const int K = g.K, nt = K / BK;
    unsigned voffA[2], voffB[2]; int RA[2]; unsigned CA2[2]; unsigned va0[2] = {0u, 0u}, va1[2] = {0u, 0u};
#pragma unroll
    for (int i = 0; i < 2; ++i) { int R, C; stage_rc(tid * 16 + i * 8192, R, C); const int Rb = Epi::PERM ? ((R & ~31) + perm32(R & 31)) : R;
        voffA[i] = (unsigned)(R * K + C) * 2u; voffB[i] = (unsigned)(Rb * K + C) * 2u; RA[i] = R; CA2[i] = (unsigned)C * 2u; }
    static_assert(!GATHER || SP2, "the gathered-A form exists for the SP2 loop only");
    const char* const gA0 = (const char*)g.A;
#define PG8_VA(u) do { int l_; asm volatile("v_mbcnt_lo_u32_b32 %0, -1, 0\n\tv_mbcnt_hi_u32_b32 %0, -1, %0" : "=v"(l_)); const int t_ = wid * 64 + l_;     \
        _Pragma("unroll") for (int _i = 0; _i < 2; ++_i) { int R_, C_; stage_rc(t_ * 16 + _i * 8192, R_, C_); va0[_i] = S.rowoff((u), R_) + (unsigned)C_ * 2u; va1[_i] = S.rowoff((u), HALF + R_) + (unsigned)C_ * 2u; } } while (0)
#define PG8_STA(bufoff, base_ng, base_g, h) do { if constexpr (GATHER) { if (h) PG8_STAGE(bufoff, base_g, va1); else PG8_STAGE(bufoff, base_g, va0); } else PG8_STAGE(bufoff, base_ng, voffA); } while (0)
    const size_t kstep = (size_t)(BK * 2);
    const size_t hstep = (size_t)HALF * K * 2;
    const size_t tstep = 2 * hstep;
    const unsigned ldsw = (unsigned)wid * 1024u;
    const int aoff = lds_byte(wr * 64 + fr, fq * 8), boff = lds_byte(wc * 32 + fr, fq * 8);
#define PG8_SA(b, h) (((b) * 2 + (h)) * HTB)
#define PG8_SB(b, h) ((4 + (b) * 2 + (h)) * HTB)
#define PG8_STAGE(bufoff, gbase, voff) do { _Pragma("unroll") for (int _i = 0; _i < 2; ++_i) \
        __builtin_amdgcn_global_load_lds((const unsigned*)((const char*)(gbase) + (voff)[_i]), (PG8_LAS unsigned*)(lds + (bufoff) + ldsw + _i * 8192), 16, 0, 0); } while (0)
#define PG8_LDA(dst, b, h) do { if constexpr (SCW != 0) { _Pragma("unroll") for (int m = 0; m < 4; ++m) dst##8[m] = PG8_CAT8(*(const PG8_LAS bf16x8*)(lds + PG8_SA(b, h) + aoff + m * 2048), *(const PG8_LAS bf16x8*)(lds + PG8_SA(b, h) + aoff + m * 2048 + 1024)); } \
        else { _Pragma("unroll") for (int m = 0; m < 4; ++m) _Pragma("unroll") for (int k = 0; k < 2; ++k) dst[m][k] = *(const PG8_LAS bf16x8*)(lds + PG8_SA(b, h) + aoff + m * 2048 + k * 1024); } } while (0)
#define PG8_LDB(dst, b, h) do { if constexpr (SCW != 0) { _Pragma("unroll") for (int n = 0; n < 2; ++n) dst##8[n] = PG8_CAT8(*(const PG8_LAS bf16x8*)(lds + PG8_SB(b, h) + boff + n * 2048), *(const PG8_LAS bf16x8*)(lds + PG8_SB(b, h) + boff + n * 2048 + 1024)); } \
        else { _Pragma("unroll") for (int n = 0; n < 2; ++n) _Pragma("unroll") for (int k = 0; k < 2; ++k) dst[n][k] = *(const PG8_LAS bf16x8*)(lds + PG8_SB(b, h) + boff + n * 2048 + k * 1024); } } while (0)
#define PG8_CAT8(lo, hi) __builtin_shufflevector(__builtin_bit_cast(i32x4_t, (lo)), __builtin_bit_cast(i32x4_t, (hi)), 0, 1, 2, 3, 4, 5, 6, 7)
#define PG8_MMA(ai, bj, At, Bt) do { __builtin_amdgcn_s_setprio(1); _Pragma("unroll") for (int m = 0; m < 4; ++m) _Pragma("unroll") for (int n = 0; n < 2; ++n) { \
        if constexpr (SCW != 0) acc[ai][bj][m][n] = __builtin_amdgcn_mfma_scale_f32_16x16x128_f8f6f4(Bt##8[n], At##8[m], acc[ai][bj][m][n], 0, 0, 0, SCW, 0, SCX); \
        else { _Pragma("unroll") for (int k = 0; k < 2; ++k) acc[ai][bj][m][n] = __builtin_amdgcn_mfma_f32_16x16x32_bf16(Bt[n][k], At[m][k], acc[ai][bj][m][n], 0, 0, 0); } } __builtin_amdgcn_s_setprio(0); } while (0)
#define PG8_WAIT_V(n) asm volatile("s_waitcnt vmcnt(" #n ")" ::: "memory")
#define PG8_WAIT_L(n) asm volatile("s_waitcnt lgkmcnt(" #n ")" ::: "memory")
#define PG8_BAR __builtin_amdgcn_s_barrier()
#define PG8_SCHED __builtin_amdgcn_sched_barrier(0)
    Unit cur, nxt; int ui = 0;
    if (!S.next(0, cur)) return;
    f32x4 acc[2][2][4][2];
    if constexpr (Epi::HAS_INIT) E.init(acc, cur, wc, fq);
    else {
#pragma unroll
    for (int a = 0; a < 2; ++a)
#pragma unroll
        for (int b = 0; b < 2; ++b)
#pragma unroll
            for (int m = 0; m < 4; ++m)
#pragma unroll
                for (int n = 0; n < 2; ++n) acc[a][b][m][n] = (f32x4){0.f, 0.f, 0.f, 0.f};
    }
    bf16x8 At[4][2], B0[2][2], B1[2][2]; i32x8_t At8[4], B08[2], B18[2];
    const char* cA = (const char*)g.A + (size_t)cur.pm * tstep; const char* cB = (const char*)g.Bt + (size_t)cur.pn * tstep;
    S.a_ready(cur);
    if constexpr (SP2) {
        if constexpr (GATHER) PG8_VA(cur);
        PG8_STAGE(PG8_SB(0, 0), cB, voffB); PG8_STAGE(PG8_SB(0, 1), cB + hstep, voffB); PG8_STA(PG8_SA(0, 0), cA, gA0, 0); PG8_STA(PG8_SA(0, 1), cA + hstep, gA0, 1);
        if (wr == 1) PG8_BAR;
        PG8_WAIT_V(2); PG8_BAR;
        PG8_STAGE(PG8_SB(1, 0), cB + kstep, voffB); PG8_STA(PG8_SA(1, 0), cA + kstep, gA0 + kstep, 0); PG8_STAGE(PG8_SB(1, 1), cB + hstep + kstep, voffB);
        PG8_WAIT_V(6); PG8_BAR;
    } else {
        PG8_STAGE(PG8_SB(0, 0), cB, voffB); PG8_STAGE(PG8_SA(0, 0), cA, voffA); PG8_STAGE(PG8_SB(0, 1), cB + hstep, voffB); PG8_STAGE(PG8_SA(0, 1), cA + hstep, voffA);
        if (wr == 1) PG8_BAR;
        PG8_WAIT_V(4); PG8_BAR;
        PG8_STAGE(PG8_SB(1, 0), cB + kstep, voffB); PG8_STAGE(PG8_SA(1, 0), cA + kstep, voffA); PG8_STAGE(PG8_SB(1, 1), cB + hstep + kstep, voffB);
        PG8_WAIT_V(6); PG8_BAR;
    }
    for (;;) {
        const bool has_next = S.next(ui + 1, nxt);
        const char* nA = has_next ? (const char*)g.A + (size_t)nxt.pm * tstep : cA; const char* nB = has_next ? (const char*)g.Bt + (size_t)nxt.pn * tstep : cB;
        _Pragma("nounroll") for (int t = 0; t < nt; t += 2) {
            const bool last = (t == nt - 2);
            const char* a1 = cA + (size_t)(t + 1) * kstep;
            const char* a2 = last ? nA : cA + (size_t)(t + 2) * kstep; const char* b2 = last ? nB : cB + (size_t)(t + 2) * kstep;
            const char* a3 = a2 + kstep; const char* b3 = b2 + kstep;
            if (last && has_next) S.a_ready(nxt);
            const char* const g1 = gA0 + (size_t)(t + 1) * kstep; const char* const g2 = last ? gA0 : gA0 + (size_t)(t + 2) * kstep; const char* const g3 = g2 + kstep;
            if constexpr (SP2) {
            PG8_LDB(B0, 0, 0); PG8_LDB(B1, 0, 1); PG8_SCHED; PG8_LDA(At, 0, 0); PG8_STA(PG8_SA(1, 1), a1 + hstep, g1, 1);
            PG8_WAIT_V(8); PG8_WAIT_L(0); PG8_BAR; PG8_MMA(0, 0, At, B0); PG8_MMA(0, 1, At, B1); PG8_BAR; PG8_SCHED;
            if constexpr (GATHER) { if (last && has_next) PG8_VA(nxt); }
            PG8_LDA(At, 0, 1); PG8_STAGE(PG8_SB(0, 0), b2, voffB); PG8_STAGE(PG8_SB(0, 1), b2 + hstep, voffB); PG8_STA(PG8_SA(0, 0), a2, g2, 0);
            PG8_WAIT_V(8); PG8_WAIT_L(0); PG8_BAR; PG8_MMA(1, 0, At, B0); PG8_MMA(1, 1, At, B1); PG8_BAR; PG8_SCHED;
            PG8_LDB(B0, 1, 0); PG8_LDB(B1, 1, 1); PG8_SCHED; PG8_LDA(At, 1, 0); PG8_STA(PG8_SA(0, 1), a2 + hstep, g2, 1);
            PG8_WAIT_V(8); PG8_WAIT_L(0); PG8_BAR; PG8_MMA(0, 0, At, B0); PG8_MMA(0, 1, At, B1); PG8_BAR; PG8_SCHED;
            PG8_LDA(At, 1, 1); PG8_STAGE(PG8_SB(1, 0), b3, voffB); PG8_STAGE(PG8_SB(1, 1), b3 + hstep, voffB); PG8_STA(PG8_SA(1, 0), a3, g3, 0);
            PG8_WAIT_V(8); PG8_WAIT_L(0); PG8_BAR; PG8_MMA(1, 0, At, B0); PG8_MMA(1, 1, At, B1); PG8_BAR; PG8_SCHED;
            } else {
            PG8_LDB(B0, 0, 0); PG8_SCHED; PG8_LDA(At, 0, 0); PG8_STAGE(PG8_SA(1, 1), a1 + hstep, voffA);
            PG8_WAIT_L(8); PG8_BAR; PG8_WAIT_L(0); PG8_MMA(0, 0, At, B0); PG8_BAR; PG8_SCHED;
            PG8_LDB(B1, 0, 1); PG8_STAGE(PG8_SB(0, 0), b2, voffB);
            PG8_BAR; PG8_WAIT_L(0); PG8_MMA(0, 1, At, B1); PG8_BAR;
            PG8_LDA(At, 0, 1); PG8_STAGE(PG8_SA(0, 0), a2, voffA);
            PG8_BAR; PG8_WAIT_L(0); PG8_MMA(1, 0, At, B0); PG8_BAR; PG8_SCHED;
            PG8_STAGE(PG8_SB(0, 1), b2 + hstep, voffB);
            PG8_WAIT_V(6); PG8_BAR; PG8_MMA(1, 1, At, B1); PG8_BAR;
            PG8_LDB(B0, 1, 0); PG8_SCHED; PG8_LDA(At, 1, 0); PG8_STAGE(PG8_SA(0, 1), a2 + hstep, voffA);
            PG8_WAIT_L(8); PG8_BAR; PG8_WAIT_L(0); PG8_MMA(0, 0, At, B0); PG8_BAR; PG8_SCHED;
            PG8_LDB(B1, 1, 1); PG8_STAGE(PG8_SB(1, 0), b3, voffB);
            PG8_BAR; PG8_WAIT_L(0); PG8_MMA(0, 1, At, B1); PG8_BAR;
            PG8_LDA(At, 1, 1); PG8_STAGE(PG8_SA(1, 0), a3, voffA);
            PG8_BAR; PG8_WAIT_L(0); PG8_MMA(1, 0, At, B0); PG8_BAR; PG8_SCHED;
            PG8_STAGE(PG8_SB(1, 1), b3 + hstep, voffB);
            PG8_WAIT_V(6); PG8_BAR; PG8_MMA(1, 1, At, B1); PG8_BAR;
            }
        }
        if constexpr (ALIGN_EPI) { if (wr == 0) PG8_BAR; }
        if constexpr (!Epi::AFTER_DRAIN) { int fr_ = fr, fq_ = fq; asm volatile("" : "+v"(fr_), "+v"(fq_));
            E(acc, cur, wr, wc, fr_, fq_); S.done(cur); }
        if (!has_next) break;
        if constexpr (Epi::HAS_INIT) { int fq_ = fq; asm volatile("" : "+v"(fq_)); E.init(acc, nxt, wc, fq_); }
        else {
#pragma unroll
        for (int a = 0; a < 2; ++a)
#pragma unroll
            for (int b = 0; b < 2; ++b)
#pragma unroll
                for (int m = 0; m < 4; ++m)
#pragma unroll
                    for (int n = 0; n < 2; ++n) acc[a][b][m][n] = (f32x4){0.f, 0.f, 0.f, 0.f};
        }
        cur = nxt; cA = nA; cB = nB; ++ui;
        if constexpr (ALIGN_EPI) { if (wr == 1) PG8_BAR; }
    }
    PG8_WAIT_V(0);
    if constexpr (!ALIGN_EPI) { if (wr == 0) PG8_BAR; }
    PG8_BAR;
    if constexpr (Epi::AFTER_DRAIN) { E.fused(acc, cur, wr, wc, fr, fq, lds, wid, lane); S.done(cur); }
#undef PG8_SA
#undef PG8_CAT8
#undef PG8_VA
#undef PG8_STA
#undef PG8_SB
#undef PG8_STAGE
#undef PG8_LDA
#undef PG8_LDB
#undef PG8_MMA
#undef PG8_WAIT_V
#undef PG8_WAIT_L
#undef PG8_BAR
#undef PG8_SCHED
}
}

#ifndef PG8_SP2
#define PG8_SP2 true
#endif
#ifndef PG8_ALIGN
#define PG8_ALIGN true
#endif
#define GAS __attribute__((address_space(1)))
#define LAS __attribute__((address_space(3)))
typedef unsigned short bf16;
typedef unsigned v4u __attribute__((ext_vector_type(4)));
typedef float f32x4 __attribute__((ext_vector_type(4)));
typedef short bf16x8 __attribute__((ext_vector_type(8)));
typedef GAS unsigned gu32;
typedef GAS unsigned long long gu64;
#define RLX_AGENT __ATOMIC_RELAXED, __HIP_MEMORY_SCOPE_AGENT
#define LDS_WAIT() asm volatile("s_waitcnt lgkmcnt(0)" ::: "memory")
#define VM_WAIT() asm volatile("s_waitcnt vmcnt(0)" ::: "memory")
__device__ __forceinline__ unsigned long long rt() { return __builtin_amdgcn_s_memrealtime(); }
__device__ __forceinline__ unsigned f2bf(float f) { unsigned u = __builtin_bit_cast(unsigned, f); return (u + 0x7fffu + ((u >> 16) & 1u)) >> 16; }
__device__ __forceinline__ unsigned pk2(float lo, float hi) { return f2bf(lo) | (f2bf(hi) << 16); }

#define XB_TMO      128
#define XB_XCNT(j)  (256  + 64 * (j))
#define XB_XSUB(j)  (1280 + 64 * (j))
#define XB_XGEN(j)  (2304 + 64 * (j))
#define XB_TOP      3328
#define XB_TOPGEN   3392
#define XCD_BAR_WORDS 3456
#define XB_SPIN_CAP (1u << 18)

__device__ __forceinline__ unsigned xb_ld(unsigned* p)              { return __hip_atomic_load(p, __ATOMIC_RELAXED, __HIP_MEMORY_SCOPE_AGENT); }
__device__ __forceinline__ unsigned xb_add(unsigned* p, unsigned v) { return __hip_atomic_fetch_add(p, v, __ATOMIC_RELAXED, __HIP_MEMORY_SCOPE_AGENT); }
__device__ __forceinline__ unsigned xb_xcc_id() { return (unsigned)__builtin_amdgcn_s_getreg((3 << 11) | 20) & 0xFu; }
#define XB_SPIN(cond, bar) do { unsigned _sp = 0; while (cond) { __builtin_amdgcn_s_sleep(1); \
    if ((++_sp & 255u) == 0u) { if (xb_ld(&(bar)[XB_TMO])) break; if (_sp > XB_SPIN_CAP) { atomicAdd(&(bar)[XB_TMO], 1u); break; } } } } while (0)

struct XcdBarrier {
    unsigned* bar; unsigned x;
    volatile LAS unsigned* st;
};

__device__ __forceinline__ XcdBarrier xcd_barrier_post(unsigned* bar, volatile LAS unsigned* st) {
    XcdBarrier b; b.bar = bar; b.x = xb_xcc_id(); b.st = st;
    if (threadIdx.x == 0) (void)xb_add(&bar[XB_XCNT(b.x)], 1u);
    return b;
}
__device__ __forceinline__ void xcd_barrier_complete(unsigned* bar, unsigned x, unsigned& nloc, unsigned& nx) {
    const unsigned G = gridDim.x * gridDim.y * gridDim.z;
    unsigned sum, cnt, mine, sp = 0u;
    for (;;) {
        sum = 0u; cnt = 0u; mine = 0u;
#pragma unroll
        for (unsigned j = 0; j < 16; ++j) { const unsigned c = xb_ld(&bar[XB_XCNT(j)]); sum += c; cnt += (c > 0u) ? 1u : 0u; mine = (j == x) ? c : mine; }
        if (sum == G) break;
        __builtin_amdgcn_s_sleep(1);
        if ((++sp & 255u) == 0u) { if (xb_ld(&bar[XB_TMO])) break; if (sp > XB_SPIN_CAP) { atomicAdd(&bar[XB_TMO], 1u); break; } }
    }
    nloc = mine > 0u ? mine : 1u; nx = cnt > 0u ? cnt : 1u;
}

__device__ __forceinline__ void xcd_barrier(const XcdBarrier& b) {
    asm volatile("s_waitcnt vmcnt(0)" ::: "memory");
    __syncthreads();
    if (threadIdx.x == 0) {
        unsigned* bar = b.bar;
        __builtin_amdgcn_s_waitcnt(0);
        unsigned nloc = b.st[0], nx = b.st[1];
        if (nloc == 0u) { xcd_barrier_complete(bar, b.x, nloc, nx); b.st[0] = nloc; b.st[1] = nx; }
        const unsigned old = xb_add(&bar[XB_XSUB(b.x)], 1u);
        const unsigned gen = old / nloc;
        if (old + 1u == (gen + 1u) * nloc) {
            __builtin_amdgcn_fence(__ATOMIC_RELEASE, "agent");
            asm volatile("s_waitcnt vmcnt(0)" ::: "memory");
            const unsigned og = xb_add(&bar[XB_TOP], 1u);
            const unsigned tg = og / nx;
            if (og + 1u == (tg + 1u) * nx) xb_add(&bar[XB_TOPGEN], 1u);
            else XB_SPIN(xb_ld(&bar[XB_TOPGEN]) == tg, bar);
            __builtin_amdgcn_fence(__ATOMIC_ACQUIRE, "agent");
            xb_add(&bar[XB_XGEN(b.x)], 1u);
            asm volatile("s_waitcnt vmcnt(0)" ::: "memory");
        } else {
            XB_SPIN(xb_ld(&bar[XB_XGEN(b.x)]) == gen, bar);
            __builtin_amdgcn_fence(__ATOMIC_ACQUIRE, "agent");
            asm volatile("s_waitcnt vmcnt(0)" ::: "memory");
        }
    }
    __syncthreads();
}

constexpr int NWAVES = 8;
#ifndef MK_ONE_LAUNCH
#define MK_ONE_LAUNCH 1
#endif

constexpr int BATCH = 16, SEQ = 2048, D = 1024, T = BATCH * SEQ;
constexpr int NIN = 3584;
constexpr int OFF_SQ = 0, OFF_SK = 512, OFF_SV = 1024, OFF_HQ = 1536, OFF_HF = 2048, OFF_HI = 2560, OFF_HG = 3072;
constexpr int NE = 32, TOPK = 4, NASSIGN = T * TOPK;
constexpr int MAXTILES = NASSIGN / 256 + NE;
constexpr int MAXROWS = MAXTILES * 256;
constexpr float EPS = 1e-6f;

constexpr size_t MiB = 1u << 20;
constexpr size_t WS_CTL = 0, CTL_ZERO_BYTES = 1 * MiB;
constexpr size_t WS_WIN = 2 * MiB;
constexpr size_t WS_WOUT = 10 * MiB;
constexpr size_t WS_RT = 12 * MiB;
constexpr size_t WS_WGU = 16 * MiB;
constexpr size_t WS_WD = 144 * MiB;
constexpr size_t WS_XN = 208 * MiB;
constexpr size_t WS_P = 272 * MiB;
constexpr size_t WS_PH = WS_P + 96 * MiB;
constexpr size_t WS_MIX = 496 * MiB;
constexpr size_t WS_ACT = 272 * MiB;
constexpr size_t WS_YK = 560 * MiB;
constexpr size_t WS_QN = 624 * MiB;
constexpr size_t WS_KN = 656 * MiB;
constexpr size_t WS_VT = 688 * MiB;
constexpr size_t WS_KVS = 720 * MiB;
constexpr size_t WS_DEC = 784 * MiB;
constexpr size_t WS_SSEG = 786 * MiB;
constexpr size_t WS_DSEG = 802 * MiB;
constexpr size_t WS_LIST = 816 * MiB;
constexpr size_t WS_TOPG = 825 * MiB;
constexpr size_t WS_X8 = 560 * MiB;
constexpr size_t WS_END = 832 * MiB;
static_assert(WS_ACT + (size_t)MAXROWS * 2048 <= WS_YK && WS_YK + (size_t)T * 4 * 2048 <= WS_LIST && WS_MIX + (size_t)T * 2048 <= WS_YK, "d_ws map");
constexpr int CW_TMO = 0, CW_CODE = 1;
constexpr int CW_CNT = 64;
constexpr int CW_BAR = 4096;

constexpr int RING_OFF = 0, RING_BYTES = 131072;
constexpr int RT_ROW = 2064, RT_WL = 32 * RT_ROW, RT_END = 64 * RT_ROW;
constexpr int LDSCTL_OFF = 133120, MISC_OFF = LDSCTL_OFF + 320;
constexpr int LTAB_OFF = LDSCTL_OFF + 512;
constexpr int LT_TS = MAXTILES, LT_CNT = MAXTILES + 32, LT_MISC = MAXTILES + 64, LT_WORDS = MAXTILES + 192;
constexpr int ROWTAB_OFF = LTAB_OFF + LT_WORDS * 4;
constexpr int MAXSLOT = 17;
constexpr int ROWTAB2_OFF = ROWTAB_OFF + MAXSLOT * 1024;
constexpr int LDS_BYTES = ROWTAB2_OFF + MAXSLOT * 512;
static_assert(RT_END <= LDSCTL_OFF && MISC_OFF + 128 <= LTAB_OFF && LDS_BYTES <= 160 * 1024 && (MAXTILES * 8 + 255) / 256 <= MAXSLOT && 2 * ((MAXTILES * 4 + 255) / 256) * 1024 <= MAXSLOT * 1536 && ROWTAB_OFF % 16 == 0, "LDS map");

struct Frame {
    LAS unsigned char* lds;
    volatile LAS unsigned* MISC;
    gu32* ctl;
    int tid, lane, wave, gw, ngw;
    int vcu, G;
    const float *x, *norm1_g, *w_in, *sb_q_g, *sb_k_g, *sb_out_g, *hg_lb, *hg_out_g, *w_out, *norm2_g, *w_router, *b_router, *w_gu, *b_gu, *w_d, *b_d;
    float* out;
    unsigned char* ws;
};
__device__ __forceinline__ float bf2f(unsigned short b) { return __builtin_bit_cast(float, (unsigned)b << 16); }
__device__ __forceinline__ float bflo(unsigned w) { return __builtin_bit_cast(float, w << 16); }
__device__ __forceinline__ float bfhi(unsigned w) { return __builtin_bit_cast(float, w & 0xffff0000u); }
typedef __bf16 bf16x2n_ __attribute__((ext_vector_type(2)));
typedef float f32x2n_ __attribute__((ext_vector_type(2)));
__device__ __forceinline__ unsigned pkbf(float a, float b) { const bf16x2n_ v = __builtin_convertvector((f32x2n_){a, b}, bf16x2n_); return __builtin_bit_cast(unsigned, v); }
__device__ __forceinline__ int lane_id() { int l; asm volatile("v_mbcnt_lo_u32_b32 %0, -1, 0\n\tv_mbcnt_hi_u32_b32 %0, -1, %0" : "=v"(l)); return l; }
__device__ __forceinline__ int vzero() { int z; asm volatile("v_mov_b32 %0, 0" : "=v"(z)); return z; }
__device__ __forceinline__ float wave_sum(float v) {
#pragma unroll
    for (int o = 1; o < 64; o <<= 1) v += __shfl_xor(v, o);
    return v;
}

constexpr float W8_SCALE = 256.f, A8_SCALE = 4.f, Y8_SCALE = 32.f; static_assert(Y8_SCALE == 32.f, "SC_W8Y below is 2^-8 * 32");
constexpr int SC_ONE = 0x7f7f7f7f, SC_W8 = 0x77777777, SC_A8 = 0x7d7d7d7d, SC_W8Y = 0x7c7c7c7c;
struct P0Item { const float* W; bf16* WT; const float* rowscale; int N, k0, n0, drow0, fp8, perm; };
__device__ __forceinline__ void p0_load(const P0Item& it, f32x4 (&v)[16], int lane) {
    const int kr = lane >> 4, nc = 4 * (lane & 15);
#pragma unroll
    for (int i = 0; i < 16; ++i) v[i] = __builtin_nontemporal_load((const f32x4*)(it.W + (size_t)(it.k0 + 4 * i + kr) * it.N + it.n0 + nc));
}
__device__ __forceinline__ void p0_store(const P0Item& it, const f32x4 (&v)[16], LAS unsigned char* scr, int lane) {
    const int kr = lane >> 4, nc = 4 * (lane & 15);
#pragma unroll
    for (int i = 0; i < 16; ++i) { const float sc = it.rowscale ? it.rowscale[it.k0 + 4 * i + kr] : 1.f;
        *(LAS unsigned long long*)(scr + (4 * i + kr) * 136 + 2 * nc) = (unsigned long long)pkbf(v[i].x * sc, v[i].y * sc) | ((unsigned long long)pkbf(v[i].z * sc, v[i].w * sc) << 32); }
    LDS_WAIT(); asm volatile("" ::: "memory");
    const LAS unsigned short* s16 = (const LAS unsigned short*)scr;
    if (it.fp8) { const int p = lane & 3, nr = lane >> 2;
#pragma unroll
        for (int c = 0; c < 4; ++c) { const int n = 16 * c + nr; unsigned val[16];
#pragma unroll
            for (int kk = 0; kk < 16; ++kk) val[kk] = s16[(16 * p + kk) * 68 + n];
            v4u w4;
            w4.x = pg8::pk4_fp8(bflo(val[0]) * W8_SCALE, bflo(val[1]) * W8_SCALE, bflo(val[2]) * W8_SCALE, bflo(val[3]) * W8_SCALE);
            w4.y = pg8::pk4_fp8(bflo(val[4]) * W8_SCALE, bflo(val[5]) * W8_SCALE, bflo(val[6]) * W8_SCALE, bflo(val[7]) * W8_SCALE);
            w4.z = pg8::pk4_fp8(bflo(val[8]) * W8_SCALE, bflo(val[9]) * W8_SCALE, bflo(val[10]) * W8_SCALE, bflo(val[11]) * W8_SCALE);
            w4.w = pg8::pk4_fp8(bflo(val[12]) * W8_SCALE, bflo(val[13]) * W8_SCALE, bflo(val[14]) * W8_SCALE, bflo(val[15]) * W8_SCALE);
            *(GAS v4u*)((unsigned char*)it.WT + (size_t)(it.drow0 + n) * D + it.k0 + 16 * p) = w4; }
    } else { const int p = lane & 7, nr = lane >> 3;
#pragma unroll
        for (int c = 0; c < 8; ++c) { const int n = 8 * c + nr; unsigned val[8];
#pragma unroll
            for (int kk = 0; kk < 8; ++kk) val[kk] = s16[(8 * p + kk) * 68 + n];
            v4u w4; w4.x = val[0] | (val[1] << 16); w4.y = val[2] | (val[3] << 16); w4.z = val[4] | (val[5] << 16); w4.w = val[6] | (val[7] << 16);
            *(GAS v4u*)(it.WT + (size_t)(it.drow0 + (it.perm ? 128 * (n >> 5) + (n & 31) : n)) * D + it.k0 + 8 * p) = w4; } }
    LDS_WAIT(); asm volatile("" ::: "memory");
}
__device__ __forceinline__ void rms_rows2_to_bf16(const float* xa, const float* xb, bool hasb, const float* g, bf16* oa, bf16* ob, int lane) {
    const GAS f32x4* pa = (const GAS f32x4*)xa + lane; const GAS f32x4* pb = (const GAS f32x4*)(hasb ? xb : xa) + lane; const f32x4* gr = (const f32x4*)g + lane;
    f32x4 va[4], vb[4], gg[4]; float sa = 0.f, sb = 0.f;
#pragma unroll
    for (int j = 0; j < 4; ++j) { va[j] = __builtin_nontemporal_load(pa + 64 * j); vb[j] = __builtin_nontemporal_load(pb + 64 * j); gg[j] = gr[64 * j]; }
#pragma unroll
    for (int j = 0; j < 4; ++j) { sa += (va[j].x * va[j].x + va[j].y * va[j].y) + (va[j].z * va[j].z + va[j].w * va[j].w); sb += (vb[j].x * vb[j].x + vb[j].y * vb[j].y) + (vb[j].z * vb[j].z + vb[j].w * vb[j].w); }
    const float ra = 1.f / sqrtf(wave_sum(sa) * (1.f / D) + EPS), rb = 1.f / sqrtf(wave_sum(sb) * (1.f / D) + EPS);
    GAS unsigned long long* o8a = (GAS unsigned long long*)oa + lane; GAS unsigned long long* o8b = (GAS unsigned long long*)ob + lane;
#pragma unroll
    for (int j = 0; j < 4; ++j) o8a[64 * j] = (unsigned long long)pkbf(va[j].x * ra * gg[j].x, va[j].y * ra * gg[j].y) | ((unsigned long long)pkbf(va[j].z * ra * gg[j].z, va[j].w * ra * gg[j].w) << 32);
    if (hasb) {
#pragma unroll
        for (int j = 0; j < 4; ++j) o8b[64 * j] = (unsigned long long)pkbf(vb[j].x * rb * gg[j].x, vb[j].y * rb * gg[j].y) | ((unsigned long long)pkbf(vb[j].z * rb * gg[j].z, vb[j].w * rb * gg[j].w) << 32); }
}
__device__ __forceinline__ P0Item p0_item(Frame& F, int r) {
    constexpr int I_IN = 16 * (NIN / 64), I_OUT = 16 * 16, I_GU = NE * 16 * 32;
    P0Item it;
    if (r < I_IN) { const int nb = NIN / 64, kb = r / nb, nn = r % nb; const int pq = nn < 16; it = P0Item{F.w_in, (bf16*)(F.ws + WS_WIN), nullptr, NIN, 64 * kb, 64 * nn, pq ? 256 * (nn >> 2) + 32 * (nn & 3) : 64 * nn, 0, pq}; return it; } r -= I_IN;
    if (r < I_OUT) { const int kb = r / 16, nn = r % 16; it = P0Item{F.w_out, (bf16*)(F.ws + WS_WOUT), nullptr, D, 64 * kb, 64 * nn, 64 * nn, 0, 0}; return it; } r -= I_OUT;
    if (r < I_GU) { const int e = r / 512, q = r % 512, kb = q / 32, nn = q % 32;
        const int isup = nn >> 4, a = (nn & 15) * 64;
        it = P0Item{F.w_gu + (size_t)e * D * 2048, (bf16*)(F.ws + WS_WGU + (size_t)e * 2048 * D), F.norm2_g, 2048, 64 * kb, 64 * nn, 256 * (a >> 7) + 128 * isup + (a & 127), 1, 0}; return it; } r -= I_GU;
    { const int e = r / 256, q = r % 256, kb = q / 16, nn = q % 16;
        it = P0Item{F.w_d + (size_t)e * D * D, (bf16*)(F.ws + WS_WD + (size_t)e * D * D), nullptr, D, 64 * kb, 64 * nn, 64 * nn, 1, 0}; return it; }
}
constexpr int P0_NITEMS = 16 * (NIN / 64) + 16 * 16 + NE * 16 * 32 + NE * 16 * 16;
constexpr int P0_NLATE = 1024;
__device__ __forceinline__ void p0_items(Frame& F, int lo, int hi, int w, int nw) {
    LAS unsigned char* scr = F.lds + RING_OFF + F.wave * 16384;
    f32x4 va[16], vb[16]; int it = lo + w;
    if (it < hi) { P0Item A = p0_item(F, it); p0_load(A, va, F.lane);
        for (;;) {
            const int itb = it + nw; const bool hb = itb < hi; const P0Item B = p0_item(F, hb ? itb : it); p0_load(B, vb, F.lane); __builtin_amdgcn_sched_barrier(0);
            p0_store(A, va, scr, F.lane);
            if (!hb) break;
            it = itb + nw; const bool ha = it < hi; A = p0_item(F, ha ? it : itb); p0_load(A, va, F.lane); __builtin_amdgcn_sched_barrier(0);
            p0_store(B, vb, scr, F.lane);
            if (!ha) break;
        }
    }
}
__device__ __forceinline__ void p0_prologue(Frame& F) {
    p0_items(F, 0, P0_NITEMS - P0_NLATE, F.gw, F.ngw);
    for (int q = blockIdx.x * (NWAVES * 64) + F.tid; q < 4096; q += F.G * NWAVES * 64) {
        const int e = q & 31, k0 = (q >> 5) * 8; unsigned hi[8], lo[8];
#pragma unroll
        for (int j = 0; j < 8; ++j) { const float w = F.w_router[(k0 + j) * 32 + e] * F.norm2_g[k0 + j]; hi[j] = pkbf(w, 0.f) & 0xffffu; lo[j] = pkbf(w - bflo(hi[j]), 0.f) & 0xffffu; }
        const v4u h4 = {hi[0] | (hi[1] << 16), hi[2] | (hi[3] << 16), hi[4] | (hi[5] << 16), hi[6] | (hi[7] << 16)}, l4 = {lo[0] | (lo[1] << 16), lo[2] | (lo[3] << 16), lo[4] | (lo[5] << 16), lo[6] | (lo[7] << 16)};
        *(GAS v4u*)(F.ws + WS_RT + e * RT_ROW + 2 * k0) = h4; *(GAS v4u*)(F.ws + WS_RT + RT_WL + e * RT_ROW + 2 * k0) = l4; }
    for (int m = F.gw; m < T; m += 2 * F.ngw) rms_rows2_to_bf16(F.x + (size_t)m * D, F.x + (size_t)(m + F.ngw) * D, m + F.ngw < T, F.norm1_g, (bf16*)(F.ws + WS_XN) + (size_t)m * D, (bf16*)(F.ws + WS_XN) + (size_t)(m + F.ngw) * D, F.lane);
}

typedef float f32x16 __attribute__((ext_vector_type(16)));
typedef __bf16 bf16x2n __attribute__((ext_vector_type(2)));
typedef float f32x2n __attribute__((ext_vector_type(2)));
#define MFMA32(a, b, c) __builtin_amdgcn_mfma_f32_32x32x16_bf16((a), (b), (c), 0, 0, 0)
__device__ __forceinline__ bf16x8 pack8(float a0, float a1, float a2, float a3, float a4, float a5, float a6, float a7) { const v4u p = {pkbf(a0, a1), pkbf(a2, a3), pkbf(a4, a5), pkbf(a6, a7)}; return __builtin_bit_cast(bf16x8, p); }
constexpr float QSCALE = 0.125f * 1.44269504089f;
__device__ __forceinline__ void prep_phase(Frame& F) {
    LAS unsigned* tl = (LAS unsigned*)(F.lds + RING_OFF + F.wave * 16384);
    const bf16* P = (const bf16*)(F.ws + WS_P); bf16* Qn = (bf16*)(F.ws + WS_QN); bf16* Kn = (bf16*)(F.ws + WS_KN); bf16* VT = (bf16*)(F.ws + WS_VT);
    const int tr = F.lane >> 3, c8 = F.lane & 7;
    for (int it = F.gw; it < 4096; it += F.ngw) {
        const int bh = it & 127, blk = it >> 7, b = bh >> 3, h = bh & 7;
        const bf16* base = P + ((size_t)b * 8 + h) * SEQ * 64 + (size_t)(blk * 64 + tr) * 64 + 8 * c8;
        v4u rv[8];
#pragma unroll
        for (int i = 0; i < 8; ++i) { const bf16* row = base + (size_t)(8 * i) * 64; rv[i] = *(const GAS v4u*)(row + (size_t)2 * 16 * 8 * SEQ * 64); }
        {
#pragma unroll
            for (int i = 0; i < 8; ++i) { LAS unsigned* q = tl + (8 * i + tr) * 33 + 4 * c8; q[0] = rv[i].x; q[1] = rv[i].y; q[2] = rv[i].z; q[3] = rv[i].w; }
            LDS_WAIT(); asm volatile("" ::: "memory");
            const LAS unsigned short* t16 = (const LAS unsigned short*)tl; const int dr = tr;
#define KAP(pos) (((pos) & ~12) | (((pos) & 4) << 1) | (((pos) & 8) >> 1))
            bf16* const obase = VT + ((size_t)bh * 64 + blk * 2 + (c8 >> 2)) * 2048 + ((c8 >> 1) & 1) * 512 + (c8 & 1) * 256;
#pragma unroll
            for (int j = 0; j < 8; ++j) { unsigned val[8];
#pragma unroll
                for (int p = 0; p < 8; ++p) { const int pos = 8 * c8 + p; val[p] = t16[KAP(pos) * 66 + 8 * j + dr]; }
                v4u w4; w4.x = val[0] | (val[1] << 16); w4.y = val[2] | (val[3] << 16); w4.z = val[4] | (val[5] << 16); w4.w = val[6] | (val[7] << 16);
                *(GAS v4u*)(obase + (j >> 2) * 1024 + ((8 * j + dr) & 31) * 8) = w4; }
#undef KAP
            LDS_WAIT(); asm volatile("" ::: "memory");
        }
    }
}

__device__ __forceinline__ int crow16(int i, int hh) { return (i & 3) + 8 * (i >> 2) + 4 * hh; }
__device__ __forceinline__ void attn_item(Frame& F, int bh, int qb, float thr, const bf16x8 (&Lt)[2]) {
    const int r = F.lane & 31, hh = F.lane >> 5, b = bh >> 3, h = bh & 7, q0 = qb * 32;
    const bf16* Qn = (const bf16*)(F.ws + WS_QN); const bf16* Kn = (const bf16*)(F.ws + WS_KN); const bf16* VT = (const bf16*)(F.ws + WS_VT);
    bf16x8 qf[4];
#pragma unroll
    for (int s = 0; s < 4; ++s) qf[s] = *(const GAS bf16x8*)(Qn + ((size_t)bh * 64 + qb) * 2048 + s * 512 + F.lane * 8);
    f32x4 gout[2][4];
#pragma unroll
    for (int db = 0; db < 2; ++db)
#pragma unroll
        for (int gq = 0; gq < 4; ++gq) gout[db][gq] = *(const f32x4*)(F.sb_out_g + h * 64 + 32 * db + 8 * gq + 4 * hh);
    f32x16 O0, O1;
#pragma unroll
    for (int i = 0; i < 16; ++i) { O0[i] = 0.f; O1[i] = 0.f; }
    float carry = 0.f;
    const bf16* kbase = Kn + (size_t)bh * 64 * 2048 + F.lane * 8; const bf16* vbase = VT + (size_t)bh * 64 * 2048 + F.lane * 8;
#define ATT_LOAD(KF, VF, kb_) do { _Pragma("unroll") for (int s_ = 0; s_ < 4; ++s_) KF[s_] = *(const GAS bf16x8*)(kbase + (size_t)(kb_) * 2048 + 512 * s_); \
        _Pragma("unroll") for (int db_ = 0; db_ < 2; ++db_) _Pragma("unroll") for (int ks_ = 0; ks_ < 2; ++ks_) VF[db_][ks_] = *(const GAS bf16x8*)(vbase + (size_t)(kb_) * 2048 + 1024 * db_ + 512 * ks_); } while (0)
#define ATT_BLOCK(KF, VF, kb_) do { const bool diag = ((kb_) == qb); \
        f32x16 z; _Pragma("unroll") for (int i = 0; i < 16; ++i) z[i] = 0.f; \
        _Pragma("unroll") for (int s_ = 0; s_ < 4; ++s_) z = MFMA32(KF[s_], qf[s_], z); \
        float sp[16]; \
        _Pragma("unroll") for (int i = 0; i < 16; ++i) { const float zz = z[i]; float v = fmaxf(zz, 0.f) + __builtin_amdgcn_logf(1.f + __builtin_amdgcn_exp2f(-fabsf(zz))); if (diag && !(crow16(i, hh) < r)) v = 0.f; sp[i] = v; } \
        const bf16x8 sb0 = pack8(sp[0], sp[1], sp[2], sp[3], sp[4], sp[5], sp[6], sp[7]), sb1 = pack8(sp[8], sp[9], sp[10], sp[11], sp[12], sp[13], sp[14], sp[15]); \
        f32x16 Cc; _Pragma("unroll") for (int i = 0; i < 16; ++i) Cc[i] = carry; \
        Cc = MFMA32(Lt[0], sb0, Cc); Cc = MFMA32(Lt[1], sb1, Cc); \
        float w[16]; \
        _Pragma("unroll") for (int i = 0; i < 16; ++i) { float v = __builtin_amdgcn_exp2f(z[i] - Cc[i]); if (diag && !(crow16(i, hh) < r)) v = 0.f; w[i] = v; } \
        const bf16x8 wb0 = pack8(w[0], w[1], w[2], w[3], w[4], w[5], w[6], w[7]), wb1 = pack8(w[8], w[9], w[10], w[11], w[12], w[13], w[14], w[15]); \
        O0 = MFMA32(VF[0][0], wb0, O0); O0 = MFMA32(VF[0][1], wb1, O0); O1 = MFMA32(VF[1][0], wb0, O1); O1 = MFMA32(VF[1][1], wb1, O1); \
        carry = __shfl(Cc[0], r); } while (0)
    bf16x8 kfA[4], vfA[2][2], kfB[4], vfB[2][2];
    ATT_LOAD(kfA, vfA, qb);
    for (int kb = qb; kb >= 0; kb -= 2) {
        ATT_LOAD(kfB, vfB, kb > 0 ? kb - 1 : 0); __builtin_amdgcn_sched_barrier(0);
        ATT_BLOCK(kfA, vfA, kb);
        if (kb == 0 || __all(carry > thr)) break;
        ATT_LOAD(kfA, vfA, kb > 1 ? kb - 2 : 0); __builtin_amdgcn_sched_barrier(0);
        ATT_BLOCK(kfB, vfB, kb - 1);
        if (__all(carry > thr)) break;
    }
#undef ATT_LOAD
#undef ATT_BLOCK
    float ss = 0.f;
#pragma unroll
    for (int i = 0; i < 16; ++i) ss += O0[i] * O0[i] + O1[i] * O1[i];
    ss += __shfl_xor(ss, 32);
    const float rs = 1.f / sqrtf(ss * (1.f / 64.f) + EPS);
    bf16* orow = (bf16*)(F.ws + WS_MIX) + ((size_t)b * SEQ + q0 + r) * D + h * 64;
#pragma unroll
    for (int db = 0; db < 2; ++db)
#pragma unroll
        for (int gq = 0; gq < 4; ++gq) { const int d = 32 * db + 8 * gq + 4 * hh; const f32x4 gg = gout[db][gq];
            const float a0 = (db ? O1[4 * gq + 0] : O0[4 * gq + 0]) * rs * gg.x, a1 = (db ? O1[4 * gq + 1] : O0[4 * gq + 1]) * rs * gg.y, a2 = (db ? O1[4 * gq + 2] : O0[4 * gq + 2]) * rs * gg.z, a3 = (db ? O1[4 * gq + 3] : O0[4 * gq + 3]) * rs * gg.w;
            *(GAS unsigned long long*)(orow + d) = (unsigned long long)pkbf(a0, a1) | ((unsigned long long)pkbf(a2, a3) << 32); }
}
__device__ __forceinline__ void attn_phase(Frame& F) {
    const int r = F.lane & 31, hh = F.lane >> 5;
    float mq = fabsf(F.sb_q_g[F.lane]), mk = fabsf(F.sb_k_g[F.lane]);
#pragma unroll
    for (int o = 1; o < 64; o <<= 1) { mq = fmaxf(mq, __shfl_xor(mq, o)); mk = fmaxf(mk, __shfl_xor(mk, o)); }
    const float thr = 64.f * QSCALE * mq * mk * 1.02f + 170.f;
    bf16x8 Lt[2];
#pragma unroll
    for (int ks = 0; ks < 2; ++ks) { float e[8];
#pragma unroll
        for (int jj = 0; jj < 8; ++jj) e[jj] = (16 * ks + 8 * (jj >> 2) + 4 * hh + (jj & 3) >= r) ? 1.f : 0.f;
        Lt[ks] = pack8(e[0], e[1], e[2], e[3], e[4], e[5], e[6], e[7]); }
    for (int it = F.gw; it < 2048; it += F.ngw) { const int bh = it & 127, j = it >> 7;
        attn_item(F, bh, 63 - j, thr, Lt); attn_item(F, bh, j, thr, Lt); attn_item(F, bh, 47 - j, thr, Lt); attn_item(F, bh, 16 + j, thr, Lt); }
}

constexpr int HG_PART = 0, HG_SSQ = 2048, HG_QE = 4096, HG_KE = HG_QE + 64 * 272, HG_VT = HG_KE + 64 * 272, HG_KST = HG_VT + 128 * 144, HG_ST = HG_KST + 128 * 144, HG_END = HG_ST + 128 * 272;
static_assert(HG_END <= RING_BYTES, "HGRN2 LDS map");
__device__ __forceinline__ float hg_lbound(Frame& F, int h, int d) { const int c = h * 128 + d; return 1.f / (1.f + __expf(F.hg_lb[512 + c] - F.hg_lb[c])); }
__device__ __forceinline__ void hg_gates(Frame& F, const unsigned short (&ffr)[16], float lb, int d, int tq, float (&bb)[16], float (&kk)[16], float& total) {
    float run = 0.f;
#pragma unroll
    for (int i = 0; i < 16; ++i) { const float ff = bf2f(ffr[i]); const float sg = __builtin_amdgcn_rcpf(1.f + __expf(-ff));
        const float f = lb + (1.f - lb) * sg; kk[i] = (1.f - lb) * (1.f - sg); run += __logf(f); bb[i] = run; }
    LAS float* part = (LAS float*)(F.lds + RING_OFF + HG_PART);
    part[tq * 128 + d] = run;
    __syncthreads();
    const float p0 = part[d], p1 = part[128 + d], p2 = part[256 + d], p3 = part[384 + d];
    const float off = (tq > 0 ? p0 : 0.f) + (tq > 1 ? p1 : 0.f) + (tq > 2 ? p2 : 0.f);
    total = (p0 + p1) + (p2 + p3);
#pragma unroll
    for (int i = 0; i < 16; ++i) bb[i] += off;
}
#define HG_HV() const bf16* const PHp = (const bf16*)(F.ws + WS_PH); \
    const __amdgpu_buffer_rsrc_t rsrcP = __builtin_amdgcn_make_buffer_rsrc((void*)PHp, 0, (int)((size_t)4 * T * 512 * 2), 0x00020000)
#define HG_SOFF(item_, arr_) ((unsigned)((((arr_) * 16 + (((item_) >> 5) >> 2)) * 4 + (((item_) >> 5) & 3)) * SEQ + ((item_) & 31) * 64) * 256u)
#define HG_ARR(col_) ((col_) == OFF_HQ ? 0 : (col_) == OFF_HF ? 1 : (col_) == OFF_HI ? 2 : 3)
#define HG_LOADT(dst2, item_, arr_) do { const unsigned so_ = (unsigned)__builtin_amdgcn_readfirstlane((int)HG_SOFF(item_, arr_)); _Pragma("unroll") for (int j_ = 0; j_ < 2; ++j_) \
        (dst2)[j_] = __builtin_bit_cast(v4u, __builtin_amdgcn_raw_buffer_load_b128(rsrcP, (unsigned)F.tid * 16u + 8192u * j_, so_, 0)); } while (0)
#define HG_PUT(src2, raw_) do { _Pragma("unroll") for (int j_ = 0; j_ < 2; ++j_) *(LAS v4u*)((raw_) + ((F.tid >> 4) + 32 * j_) * 272 + (F.tid & 15) * 16) = (src2)[j_]; } while (0)
#define HG_COL(dst, raw_) do { _Pragma("unroll") for (int i_ = 0; i_ < 16; ++i_) dst[i_] = *(const LAS unsigned short*)((raw_) + (16 * tq + i_) * 272 + 2 * d); } while (0)
template <bool PERMUTE> __device__ __forceinline__ void st16(LAS unsigned char* dst, const float (&v)[16]) {
    v4u a, b2;
    if (!PERMUTE) { a.x = pkbf(v[0], v[1]); a.y = pkbf(v[2], v[3]); a.z = pkbf(v[4], v[5]); a.w = pkbf(v[6], v[7]); b2.x = pkbf(v[8], v[9]); b2.y = pkbf(v[10], v[11]); b2.z = pkbf(v[12], v[13]); b2.w = pkbf(v[14], v[15]); }
    else { a.x = pkbf(v[0], v[1]); a.y = pkbf(v[2], v[3]); a.z = pkbf(v[8], v[9]); a.w = pkbf(v[10], v[11]); b2.x = pkbf(v[4], v[5]); b2.y = pkbf(v[6], v[7]); b2.z = pkbf(v[12], v[13]); b2.w = pkbf(v[14], v[15]); }
    *(LAS v4u*)dst = a; *(LAS v4u*)(dst + 16) = b2;
}
__device__ __forceinline__ void hgA_phase(Frame& F) {
    const int d = F.tid & 127, tq = F.tid >> 7, r = F.lane & 31, hh = F.lane >> 5;
    const bf16* P = (const bf16*)(F.ws + WS_P); bf16* KVS = (bf16*)(F.ws + WS_KVS); float* DEC = (float*)(F.ws + WS_DEC); float* SSEG = (float*)(F.ws + WS_SSEG); float* DSEG = (float*)(F.ws + WS_DSEG);
    LAS unsigned char* L = F.lds + RING_OFF; LAS float* decl = (LAS float*)(L + HG_SSQ);
    HG_HV();
    v4u rf[2], rv[2];
    LAS unsigned char* const RAWF = F.lds + ROWTAB_OFF; LAS unsigned char* const RAWV = L + HG_ST;
    for (int wg = blockIdx.x; wg < 256; wg += F.G) {
        const int bh = wg >> 2, seg = wg & 3, item0 = bh * 32 + seg * 8, h = bh & 3;
        HG_LOADT(rf, item0, 1); HG_LOADT(rv, item0, 2);
        const float lbv = hg_lbound(F, h, d); float totrun = 0.f;
        const int db = F.wave & 3, eb0 = 2 * (F.wave >> 2);
        f32x16 run0, run1;
#pragma unroll
        for (int i = 0; i < 16; ++i) { run0[i] = 0.f; run1[i] = 0.f; }
      for (int k = 0; k < 8; ++k) {
        const int item = item0 + k;
        HG_PUT(rf, RAWF); HG_PUT(rv, RAWV);
        __syncthreads();
        { const int nit = k < 7 ? item + 1 : item; HG_LOADT(rf, nit, 1); HG_LOADT(rv, nit, 2); __builtin_amdgcn_sched_barrier(0); }
        unsigned short ffr[16], vr[16]; HG_COL(ffr, RAWF); HG_COL(vr, RAWV);
        float bb[16], kk[16], total; hg_gates(F, ffr, lbv, d, tq, bb, kk, total);
        float ks[16], vv[16];
#pragma unroll
        for (int i = 0; i < 16; ++i) { ks[i] = kk[i] * __expf(total - bb[i]); vv[i] = bf2f(vr[i]); }
        st16<false>(L + HG_KST + d * 144 + tq * 32, ks); st16<false>(L + HG_VT + d * 144 + tq * 32, vv);
        const float dc = __expf(total); totrun += total;
        if (tq == 0) { DEC[(size_t)item * 128 + d] = dc; decl[d] = dc; }
        __syncthreads();
        f32x16 acc0, acc1;
#pragma unroll
        for (int i = 0; i < 16; ++i) { acc0[i] = 0.f; acc1[i] = 0.f; }
#pragma unroll
        for (int s = 0; s < 4; ++s) { const bf16x8 af = *(const LAS bf16x8*)(L + HG_KST + (db * 32 + r) * 144 + 32 * s + 16 * hh);
            const bf16x8 b0 = *(const LAS bf16x8*)(L + HG_VT + (eb0 * 32 + r) * 144 + 32 * s + 16 * hh), b1 = *(const LAS bf16x8*)(L + HG_VT + ((eb0 + 1) * 32 + r) * 144 + 32 * s + 16 * hh);
            acc0 = MFMA32(af, b0, acc0); acc1 = MFMA32(af, b1, acc1); }
#pragma unroll
        for (int g = 0; g < 4; ++g) { const f32x4 dl = *(const LAS f32x4*)(decl + db * 32 + 8 * g + 4 * hh);
#pragma unroll
            for (int ii = 0; ii < 4; ++ii) { run0[4 * g + ii] = dl[ii] * run0[4 * g + ii] + acc0[4 * g + ii]; run1[4 * g + ii] = dl[ii] * run1[4 * g + ii] + acc1[4 * g + ii]; } }
#pragma unroll
        for (int j = 0; j < 2; ++j) { bf16* dst = KVS + ((size_t)item * 128 + (eb0 + j) * 32 + r) * 128 + db * 32 + 4 * hh;
#pragma unroll
            for (int g = 0; g < 4; ++g) { const float a0 = j ? acc1[4 * g + 0] : acc0[4 * g + 0], a1 = j ? acc1[4 * g + 1] : acc0[4 * g + 1], a2 = j ? acc1[4 * g + 2] : acc0[4 * g + 2], a3 = j ? acc1[4 * g + 3] : acc0[4 * g + 3];
                *(GAS unsigned long long*)(dst + 8 * g) = (unsigned long long)pkbf(a0, a1) | ((unsigned long long)pkbf(a2, a3) << 32); } }
        __syncthreads();
      }
#pragma unroll
        for (int j = 0; j < 2; ++j) { float* dst = SSEG + ((size_t)wg * 128 + (eb0 + j) * 32 + r) * 128 + db * 32 + 4 * hh;
#pragma unroll
            for (int g = 0; g < 4; ++g) *(GAS f32x4*)(dst + 8 * g) = j ? (f32x4){run1[4 * g + 0], run1[4 * g + 1], run1[4 * g + 2], run1[4 * g + 3]} : (f32x4){run0[4 * g + 0], run0[4 * g + 1], run0[4 * g + 2], run0[4 * g + 3]}; }
        if (tq == 0) DSEG[(size_t)wg * 128 + d] = __expf(totrun);
    }
}
constexpr int HG_DECS = HG_END;
static_assert(HG_DECS + 4096 + 64 * 272 <= LDSCTL_OFF && HG_KST + 64 * 272 <= HG_ST && 64 * 272 <= MAXSLOT * 1536, "HGRN2 LDS map (decays, raw tiles)");
__device__ __forceinline__ void hgC_phase(Frame& F) {
    const int d = F.tid & 127, tq = F.tid >> 7, r = F.lane & 31, hh = F.lane >> 5;
    const bf16* P = (const bf16*)(F.ws + WS_P); const bf16* KVS = (const bf16*)(F.ws + WS_KVS); bf16* MIX = (bf16*)(F.ws + WS_MIX); const float* DEC = (const float*)(F.ws + WS_DEC);
    HG_HV();
    LAS unsigned char* L = F.lds + RING_OFF; const LAS float* decs = (const LAS float*)(L + HG_DECS);
    const int se = F.tid >> 2, sq = F.tid & 3;
    v4u rf[2], rq[2], rv[2], st[4];
    LAS unsigned char* const RAWF = L + HG_KST; LAS unsigned char* const RAWQ = F.lds + ROWTAB_OFF; LAS unsigned char* const RAWV = L + HG_DECS + 4096;
    const __amdgpu_buffer_rsrc_t rsrcG = __builtin_amdgcn_make_buffer_rsrc((void*)F.hg_out_g, 0, 512 * 4, 0x00020000), rsrcSS = __builtin_amdgcn_make_buffer_rsrc((void*)(F.ws + WS_SSEG), 0, 256 * 128 * 128 * 4, 0x00020000), rsrcDS = __builtin_amdgcn_make_buffer_rsrc((void*)(F.ws + WS_DSEG), 0, 256 * 128 * 4, 0x00020000);
    const __amdgpu_buffer_rsrc_t rsrcD = __builtin_amdgcn_make_buffer_rsrc((void*)DEC, 0, 64 * 32 * 128 * 4, 0x00020000), rsrcM = __builtin_amdgcn_make_buffer_rsrc((void*)MIX, 0, (int)((size_t)T * D * 2), 0x00020000);
    const __amdgpu_buffer_rsrc_t rsrcK = __builtin_amdgcn_make_buffer_rsrc((void*)KVS, 0, 64 * 32 * 128 * 128 * 2, 0x00020000); const unsigned kvo = (unsigned)((se * 128 + sq * 32) * 2);
#define HG_LOADKV(dst_, item_) do { const unsigned so_ = (unsigned)__builtin_amdgcn_readfirstlane((int)((item_) * (128 * 128 * 2))); _Pragma("unroll") for (int j_ = 0; j_ < 4; ++j_) (dst_)[j_] = __builtin_bit_cast(v4u, __builtin_amdgcn_raw_buffer_load_b128(rsrcK, kvo + 16u * j_, so_, 0)); } while (0)
#define HG_LOADST(item_) HG_LOADKV(st, item_)
#define HG_FOLD(kv_, c_) do { _Pragma("unroll") for (int j_ = 0; j_ < 4; ++j_) { const f32x4 d0_ = *(const LAS f32x4*)(decs + (c_) * 128 + sq * 32 + 8 * j_), d1_ = *(const LAS f32x4*)(decs + (c_) * 128 + sq * 32 + 8 * j_ + 4); const v4u k_ = (kv_)[j_]; \
        S[8 * j_ + 0] = d0_.x * S[8 * j_ + 0] + bflo(k_.x); S[8 * j_ + 1] = d0_.y * S[8 * j_ + 1] + bfhi(k_.x); S[8 * j_ + 2] = d0_.z * S[8 * j_ + 2] + bflo(k_.y); S[8 * j_ + 3] = d0_.w * S[8 * j_ + 3] + bfhi(k_.y); \
        S[8 * j_ + 4] = d1_.x * S[8 * j_ + 4] + bflo(k_.z); S[8 * j_ + 5] = d1_.y * S[8 * j_ + 5] + bfhi(k_.z); S[8 * j_ + 6] = d1_.z * S[8 * j_ + 6] + bflo(k_.w); S[8 * j_ + 7] = d1_.w * S[8 * j_ + 7] + bfhi(k_.w); } } while (0)
    for (int wg = blockIdx.x; wg < 256; wg += F.G) {
        const int bh = wg >> 2, seg = wg & 3, item0 = bh * 32 + seg * 8, b = bh >> 2, h = bh & 3;
        HG_LOADT(rf, item0, 1); HG_LOADT(rq, item0, 0); HG_LOADT(rv, item0, 2); HG_LOADST(item0);
        const unsigned dso0 = (unsigned)__builtin_amdgcn_readfirstlane((bh * 32 + seg * 8) * 128 * 4);
        const f32x4 decv = __builtin_bit_cast(f32x4, __builtin_amdgcn_raw_buffer_load_b128(rsrcD, (unsigned)(F.tid & 255) * 16u, dso0, 0));
        const float lbv = hg_lbound(F, h, d);
        __builtin_amdgcn_sched_barrier(0);
        float S[32];
#pragma unroll
        for (int j = 0; j < 32; ++j) S[j] = 0.f;
        for (int sp = 0; sp < seg; ++sp) {
            const unsigned sso = (unsigned)__builtin_amdgcn_readfirstlane((bh * 4 + sp) * 128 * 128 * 4), dso = (unsigned)__builtin_amdgcn_readfirstlane((bh * 4 + sp) * 128 * 4);
#pragma unroll
            for (int j0 = 0; j0 < 8; j0 += 8) { f32x4 sv[8], dv[8];
#pragma unroll
                for (int j = 0; j < 8; ++j) { sv[j] = __builtin_bit_cast(f32x4, __builtin_amdgcn_raw_buffer_load_b128(rsrcSS, (unsigned)((se * 128 + sq * 32) * 4) + 16u * (j0 + j), sso, 0));
                    dv[j] = __builtin_bit_cast(f32x4, __builtin_amdgcn_raw_buffer_load_b128(rsrcDS, (unsigned)(sq * 32 * 4) + 16u * (j0 + j), dso, 0)); }
#pragma unroll
                for (int j = 0; j < 8; ++j) { const int q = 4 * (j0 + j); S[q + 0] = dv[j].x * S[q + 0] + sv[j].x; S[q + 1] = dv[j].y * S[q + 1] + sv[j].y; S[q + 2] = dv[j].z * S[q + 2] + sv[j].z; S[q + 3] = dv[j].w * S[q + 3] + sv[j].w; } }
        }
        if (F.tid < 256) *((LAS f32x4*)(L + HG_DECS) + F.tid) = decv;
        __syncthreads();
      for (int k = 0; k < 8; ++k) {
        const int item = item0 + k, c = seg * 8 + k;
        const int tb = F.wave & 1, eb = F.wave >> 1;
        const int nit = k < 7 ? item + 1 : item;
        HG_PUT(rf, RAWF); HG_PUT(rq, RAWQ); HG_PUT(rv, RAWV);
        __syncthreads();
        HG_LOADT(rf, nit, 1); HG_LOADT(rq, nit, 0); HG_LOADT(rv, nit, 2); __builtin_amdgcn_sched_barrier(0);
        unsigned short ffr[16], qr[16], vr[16]; HG_COL(ffr, RAWF); HG_COL(qr, RAWQ); HG_COL(vr, RAWV);
        float bb[16], kk[16], total; hg_gates(F, ffr, lbv, d, tq, bb, kk, total);
        float vv[16];
#pragma unroll
        for (int i = 0; i < 16; ++i) { const int t = 16 * tq + i; const float q = bf2f(qr[i]);
            *(LAS unsigned short*)(L + HG_QE + t * 272 + 2 * d) = (unsigned short)pkbf(q * __expf(bb[i]), 0.f);
            *(LAS unsigned short*)(L + HG_KE + t * 272 + 2 * d) = (unsigned short)pkbf(kk[i] * __expf(-bb[i]), 0.f);
            vv[i] = bf2f(vr[i]); }
        st16<true>(L + HG_VT + d * 144 + tq * 32, vv);
#pragma unroll
        for (int j = 0; j < 4; ++j) { v4u w4; w4.x = pkbf(S[8 * j + 0], S[8 * j + 1]); w4.y = pkbf(S[8 * j + 2], S[8 * j + 3]); w4.z = pkbf(S[8 * j + 4], S[8 * j + 5]); w4.w = pkbf(S[8 * j + 6], S[8 * j + 7]);
            *(LAS v4u*)(L + HG_ST + se * 272 + sq * 64 + 16 * j) = w4; }
        HG_FOLD(st, k);
        unsigned long long grv[4];
        { const bf16* grow_ = PHp + (((size_t)(3 * 16 + b) * 4 + h) * SEQ + c * 64 + tb * 32 + r) * 128;
#pragma unroll
            for (int g = 0; g < 4; ++g) grv[g] = *(const GAS unsigned long long*)(grow_ + eb * 32 + 8 * g + 4 * hh); }
        HG_LOADST(nit); __builtin_amdgcn_sched_barrier(0);
        __syncthreads();
        f32x16 acc;
#pragma unroll
        for (int i = 0; i < 16; ++i) acc[i] = 0.f;
#define HG_QF(s_) (*(const LAS bf16x8*)(L + HG_QE + (tb * 32 + r) * 272 + 32 * (s_) + 16 * hh))
#pragma unroll
        for (int s = 0; s < 8; ++s) acc = MFMA32(*(const LAS bf16x8*)(L + HG_ST + (eb * 32 + r) * 272 + 32 * s + 16 * hh), HG_QF(s), acc);
        for (int sb = 0; sb <= tb; ++sb) {
            f32x16 at;
#pragma unroll
            for (int i = 0; i < 16; ++i) at[i] = 0.f;
#pragma unroll
            for (int s = 0; s < 8; ++s) at = MFMA32(*(const LAS bf16x8*)(L + HG_KE + (sb * 32 + r) * 272 + 32 * s + 16 * hh), HG_QF(s), at);
            float a[16];
#pragma unroll
            for (int i = 0; i < 16; ++i) a[i] = (sb < tb || crow16(i, hh) <= r) ? at[i] : 0.f;
            const bf16x8 ab0 = pack8(a[0], a[1], a[2], a[3], a[4], a[5], a[6], a[7]), ab1 = pack8(a[8], a[9], a[10], a[11], a[12], a[13], a[14], a[15]);
            acc = MFMA32(*(const LAS bf16x8*)(L + HG_VT + (eb * 32 + r) * 144 + sb * 64 + 0 + 16 * hh), ab0, acc);
            acc = MFMA32(*(const LAS bf16x8*)(L + HG_VT + (eb * 32 + r) * 144 + sb * 64 + 32 + 16 * hh), ab1, acc);
        }
        float ss = 0.f;
#pragma unroll
        for (int i = 0; i < 16; ++i) ss += acc[i] * acc[i];
        ss += __shfl_xor(ss, 32);
        LAS float* ssq = (LAS float*)(L + HG_SSQ);
        if (hh == 0) ssq[eb * 64 + tb * 32 + r] = ss;
        f32x4 ggv[4];
        { const unsigned so = (unsigned)__builtin_amdgcn_readfirstlane(h * 512);
#pragma unroll
            for (int g = 0; g < 4; ++g) ggv[g] = __builtin_bit_cast(f32x4, __builtin_amdgcn_raw_buffer_load_b128(rsrcG, (unsigned)((eb * 32 + 8 * g + 4 * hh) * 4), so, 0)); }
        __syncthreads();
        const int tl = tb * 32 + r; const float tot = (ssq[tl] + ssq[64 + tl]) + (ssq[128 + tl] + ssq[192 + tl]);
        const float rs = 1.f / sqrtf(tot * (1.f / 128.f) + EPS);
        const unsigned mso = (unsigned)__builtin_amdgcn_readfirstlane((int)((((unsigned)b * SEQ + c * 64) * D + 512 + h * 128) * 2)), mvo = (unsigned)((tl * D + eb * 32 + 4 * hh) * 2);
#pragma unroll
        for (int g = 0; g < 4; ++g) { const int e = eb * 32 + 8 * g + 4 * hh; const unsigned long long gr = grv[g]; const f32x4 gg = ggv[g];
            const float g0 = bflo((unsigned)gr), g1 = bfhi((unsigned)gr), g2 = bflo((unsigned)(gr >> 32)), g3 = bfhi((unsigned)(gr >> 32));
            const float y0 = acc[4 * g + 0] * rs * gg.x * (g0 * __builtin_amdgcn_rcpf(1.f + __expf(-g0))), y1 = acc[4 * g + 1] * rs * gg.y * (g1 * __builtin_amdgcn_rcpf(1.f + __expf(-g1)));
            const float y2 = acc[4 * g + 2] * rs * gg.z * (g2 * __builtin_amdgcn_rcpf(1.f + __expf(-g2))), y3 = acc[4 * g + 3] * rs * gg.w * (g3 * __builtin_amdgcn_rcpf(1.f + __expf(-g3)));
            typedef unsigned u32x2_t __attribute__((ext_vector_type(2))); __builtin_amdgcn_raw_buffer_store_b64((u32x2_t){pkbf(y0, y1), pkbf(y2, y3)}, rsrcM, mvo + 16u * g, mso, 0); }
        __syncthreads();
      }
    }
#undef HG_LOADST
#undef HG_LOADKV
#undef HG_FOLD
#undef HG_QF
}
#undef HG_LOADT
#undef HG_PUT
#undef HG_COL
#undef HG_ARR
#undef HG_SOFF
#undef HG_HV

__device__ __forceinline__ void router_phase(Frame& F) {
    LAS unsigned char* L = F.lds; const int r = F.lane & 31, hh = F.lane >> 5;
    LAS unsigned* lcnt = (LAS unsigned*)(F.lds + LTAB_OFF) + LT_MISC; LAS unsigned* lbase = lcnt + 32; LAS float* lrstd = (LAS float*)(F.lds + ROWTAB_OFF);
    float* TOPG = (float*)(F.ws + WS_TOPG);
    {
        const GAS v4u* img = (const GAS v4u*)(F.ws + WS_RT) + vzero();
        constexpr int NB = (RT_END / 16 + NWAVES * 64 - 1) / (NWAVES * 64);
        v4u t4[NB];
#pragma unroll
        for (int j = 0; j < NB; ++j) { const int q = F.tid + j * NWAVES * 64; t4[j] = img[q < RT_END / 16 ? q : 0]; }
#pragma unroll
        for (int j = 0; j < NB; ++j) { const int q = F.tid + j * NWAVES * 64; if (q < RT_END / 16) *(LAS v4u*)(L + 16 * q) = t4[j]; }
    }
    const bf16* XH = (const bf16*)(F.ws + WS_XN); int* LIST = (int*)(F.ws + WS_LIST); unsigned* cnt = (unsigned*)(F.ctl + CW_CNT);
    for (int base = blockIdx.x * 4; base < T / 32; base += F.G * 4) {
        const int grp = base + F.wave; const bool active = F.wave < 4 && grp < T / 32;
        if (F.tid < 32) lcnt[F.tid] = 0u;
        __syncthreads();
        float sv[4] = {0.f, 0.f, 0.f, 0.f}; int se[4] = {0, 0, 0, 0}; unsigned lp0 = 0u, lp1 = 0u; float rstd = 0.f; const int tok = grp * 32 + r;
        if (active) {
            const bf16* hrow = XH + (size_t)tok * D + 8 * hh;
            f32x16 acc;
#pragma unroll
            for (int i = 0; i < 16; ++i) acc[i] = 0.f;
            float ssq = 0.f;
#pragma unroll 16
            for (int s = 0; s < 64; ++s) {
                const v4u hu = *(const GAS v4u*)(hrow + 16 * s); const bf16x8 hi = __builtin_bit_cast(bf16x8, hu);
                { const float a0 = bflo(hu.x), a1 = bfhi(hu.x), a2 = bflo(hu.y), a3 = bfhi(hu.y), a4 = bflo(hu.z), a5 = bfhi(hu.z), a6 = bflo(hu.w), a7 = bfhi(hu.w);
                    ssq += (a0 * a0 + a1 * a1) + (a2 * a2 + a3 * a3) + (a4 * a4 + a5 * a5) + (a6 * a6 + a7 * a7); }
                const bf16x8 wh = *(const LAS bf16x8*)(L + r * RT_ROW + 32 * s + 16 * hh), wl = *(const LAS bf16x8*)(L + RT_WL + r * RT_ROW + 32 * s + 16 * hh);
                acc = MFMA32(wh, hi, acc); acc = MFMA32(wl, hi, acc);
            }
            ssq += __shfl_xor(ssq, 32);
            rstd = 1.f / sqrtf(ssq * (1.f / D) + EPS);
            float l[16];
#pragma unroll
            for (int i = 0; i < 16; ++i) l[i] = acc[i] * rstd + F.b_router[crow16(i, hh)];
            float cv[8]; int ce[8];
#pragma unroll
            for (int rnd = 0; rnd < 4; ++rnd) { float bv = l[0]; int bi = 0;
#pragma unroll
                for (int i = 1; i < 16; ++i) if (l[i] > bv) { bv = l[i]; bi = i; }
                cv[rnd] = bv; ce[rnd] = crow16(bi, hh);
#pragma unroll
                for (int i = 0; i < 16; ++i) if (i == bi) l[i] = -__builtin_inff(); }
#pragma unroll
            for (int j = 0; j < 4; ++j) { cv[4 + j] = __shfl_xor(cv[j], 32); ce[4 + j] = __shfl_xor(ce[j], 32); }
#pragma unroll
            for (int rnd = 0; rnd < 4; ++rnd) { float bv = cv[0]; int be = ce[0]; int bj = 0;
#pragma unroll
                for (int j = 1; j < 8; ++j) if (cv[j] > bv || (cv[j] == bv && ce[j] < be)) { bv = cv[j]; be = ce[j]; bj = j; }
                sv[rnd] = bv; se[rnd] = be;
#pragma unroll
                for (int j = 0; j < 8; ++j) if (j == bj) { cv[j] = -__builtin_inff(); ce[j] = 64; } }
            lp0 = __hip_atomic_fetch_add(lcnt + (hh ? se[2] : se[0]), 1u, __ATOMIC_RELAXED, __HIP_MEMORY_SCOPE_WORKGROUP);
            lp1 = __hip_atomic_fetch_add(lcnt + (hh ? se[3] : se[1]), 1u, __ATOMIC_RELAXED, __HIP_MEMORY_SCOPE_WORKGROUP);
        }
        __syncthreads();
        if (F.tid < 32) lbase[F.tid] = __hip_atomic_fetch_add(cnt + F.tid, lcnt[F.tid], __ATOMIC_RELAXED, __HIP_MEMORY_SCOPE_AGENT);
        __syncthreads();
        if (active) {
            const float e1 = __expf(sv[1] - sv[0]), e2 = __expf(sv[2] - sv[0]), e3 = __expf(sv[3] - sv[0]); const float inv = 1.f / (1.f + e1 + e2 + e3);
            const int ea = hh ? se[2] : se[0], eb = hh ? se[3] : se[1]; const float ga = (hh ? e2 : 1.f) * inv, gb = (hh ? e3 : e1) * inv;
            const size_t ia = (size_t)ea * 32768 + lbase[ea] + lp0, ib = (size_t)eb * 32768 + lbase[eb] + lp1;
            LIST[ia] = tok * 4 + 2 * hh; LIST[ib] = tok * 4 + 2 * hh + 1; TOPG[tok * 4 + 2 * hh] = ga; TOPG[tok * 4 + 2 * hh + 1] = gb;
            if (hh == 0) lrstd[F.wave * 32 + r] = rstd;
        }
        __syncthreads();
        {
            unsigned char* X8 = F.ws + WS_X8; const int t0 = base * 32;
#pragma unroll
            for (int q0 = 0; q0 < 16; q0 += 4) { v4u a[4][2];
#pragma unroll
                for (int q = 0; q < 4; ++q) { const int tt = t0 + F.wave * 16 + q0 + q; const GAS v4u* p = (const GAS v4u*)(XH + (size_t)(tt < T ? tt : 0) * D) + 2 * F.lane; a[q][0] = p[0]; a[q][1] = p[1]; }
#pragma unroll
                for (int q = 0; q < 4; ++q) { const int tl = F.wave * 16 + q0 + q, tt = t0 + tl; if (tt < T) { const float rs = lrstd[tl]; v4u o;
                    o.x = pg8::pk4_fp8(bflo(a[q][0].x) * rs, bfhi(a[q][0].x) * rs, bflo(a[q][0].y) * rs, bfhi(a[q][0].y) * rs); o.y = pg8::pk4_fp8(bflo(a[q][0].z) * rs, bfhi(a[q][0].z) * rs, bflo(a[q][0].w) * rs, bfhi(a[q][0].w) * rs);
                    o.z = pg8::pk4_fp8(bflo(a[q][1].x) * rs, bfhi(a[q][1].x) * rs, bflo(a[q][1].y) * rs, bfhi(a[q][1].y) * rs); o.w = pg8::pk4_fp8(bflo(a[q][1].z) * rs, bfhi(a[q][1].z) * rs, bflo(a[q][1].w) * rs, bfhi(a[q][1].w) * rs);
                    *((GAS v4u*)(X8 + (size_t)tt * D) + F.lane) = o; } } }
        }
        __syncthreads();
    }
}
__device__ __forceinline__ int build_moe_tables(Frame& F, int ntn, int mode) {
    LAS int* lt = (LAS int*)(F.lds + LTAB_OFF);
    if (F.wave == 0) {
        const int e = F.lane & 31; const int c = (int)__hip_atomic_load((unsigned*)(F.ctl + CW_CNT) + e, __ATOMIC_RELAXED, __HIP_MEMORY_SCOPE_AGENT);
        const int tl = (c + 255) >> 8; int inc = tl;
#pragma unroll
        for (int off = 1; off < 32; off <<= 1) { const int o = __shfl_up(inc, off, 32); if (e >= off) inc += o; }
        const int tot = __shfl(inc, 31, 32), t0 = inc - tl;
        if (F.lane < 32) { lt[LT_TS + e] = t0; lt[LT_CNT + e] = c; for (int i = 0; i < tl; ++i) lt[t0 + i] = e; }
        if (F.lane == 0) lt[LT_MISC + 64] = tot;
    }
    __syncthreads();
    int nt = lt[LT_MISC + 64]; nt = nt < 0 ? 0 : (nt > MAXTILES ? MAXTILES : nt); nt = __builtin_amdgcn_readfirstlane(nt);
    const int* LIST = (const int*)(F.ws + WS_LIST);
    const int nslot = mode == 1 ? MAXSLOT : (MAXTILES * 4 + 255) / 256;
    for (int q = F.tid; q < nslot * 256; q += NWAVES * 64) { const int i = q >> 8, rr = q & 255; const int Lu = i * F.G + F.vcu;
        int li = -1; float bias = 0.f;
        if (Lu < nt * ntn) { const int pm0 = Lu / ntn, pl = Lu - pm0 * ntn, pm = mode == 2 ? nt - 1 - pm0 : pm0, e = lt[pm], idx = (pm - lt[LT_TS + e]) * 256 + rr; if (idx < lt[LT_CNT + e]) li = LIST[(size_t)e * 32768 + idx];
            bias = mode == 1 ? F.b_gu[(size_t)e * 2048 + (rr >> 7) * 1024 + pl * 128 + (rr & 127)] : F.b_d[(size_t)e * 1024 + pl * 256 + rr]; }
        ((LAS float*)(F.lds + ROWTAB_OFF))[q] = bias;
        if (mode == 1) ((LAS unsigned short*)(F.lds + ROWTAB2_OFF))[q] = (unsigned short)(li < 0 ? 0 : (li >> 2));
        else ((LAS int*)(F.lds + ROWTAB_OFF) + nslot * 256)[q] = li; }
    __syncthreads();
    return nt;
}
__device__ __forceinline__ void combine_phase(Frame& F) {
    const unsigned char* YK = F.ws + WS_YK; const bf16* XH = (const bf16*)(F.ws + WS_XN); const float* TOPG = (const float*)(F.ws + WS_TOPG);
    for (int t = F.gw; t < T; t += F.ngw) {
        GAS f32x4* xr = (GAS f32x4*)(F.out + (size_t)t * D) + F.lane; f32x4 v[4]; unsigned y[4][4]; const f32x4 gt = *((const GAS f32x4*)TOPG + t + vzero()) * (1.0f / Y8_SCALE);
#pragma unroll
        for (int j = 0; j < 4; ++j) { const unsigned long long xh = __builtin_nontemporal_load((const GAS unsigned long long*)(XH + (size_t)t * D) + F.lane + 64 * j);
            v[j] = (f32x4){bflo((unsigned)xh), bfhi((unsigned)xh), bflo((unsigned)(xh >> 32)), bfhi((unsigned)(xh >> 32))};
#pragma unroll
            for (int k = 0; k < 4; ++k) y[j][k] = __builtin_nontemporal_load((const GAS unsigned*)(YK + ((size_t)t * 4 + k) * D) + F.lane + 64 * j); }
#pragma unroll
        for (int j = 0; j < 4; ++j) { f32x4 s4 = {0.f, 0.f, 0.f, 0.f};
#pragma unroll
            for (int k = 0; k < 4; ++k) { const f32x2n_ lo = __builtin_amdgcn_cvt_pk_f32_fp8((int)y[j][k], false), hi = __builtin_amdgcn_cvt_pk_f32_fp8((int)y[j][k], true); const float g = gt[k]; s4.x += g * lo.x; s4.y += g * lo.y; s4.z += g * hi.x; s4.w += g * hi.y; }
            v[j] = v[j] + s4;
            __builtin_nontemporal_store(v[j], xr + 64 * j); }
    }
}

constexpr int NPH = 9;
struct Args { const float* in[16]; float* out; unsigned char* ws; int ph_lo, ph_hi; };
__global__ void __launch_bounds__(NWAVES * 64, 2) fwd(Args args) {
    extern __shared__ __attribute__((aligned(16))) unsigned char lds[];
    Frame F;
    F.lds = (LAS unsigned char*)lds;
    F.MISC = (volatile LAS unsigned*)(F.lds + MISC_OFF);
    F.tid = threadIdx.x; F.lane = F.tid & 63; F.wave = __builtin_amdgcn_readfirstlane(F.tid >> 6);
    F.G = gridDim.x; { const int bx = blockIdx.x; F.vcu = (F.G % 8 == 0) ? (bx % 8) * (F.G / 8) + bx / 8 : bx; }
    F.gw = blockIdx.x * NWAVES + F.wave; F.ngw = F.G * NWAVES;
    F.ws = args.ws; F.ctl = (gu32*)(args.ws + WS_CTL); F.out = args.out;
    F.x = args.in[0]; F.norm1_g = args.in[1]; F.w_in = args.in[2]; F.sb_q_g = args.in[3]; F.sb_k_g = args.in[4]; F.sb_out_g = args.in[5]; F.hg_lb = args.in[6]; F.hg_out_g = args.in[7];
    F.w_out = args.in[8]; F.norm2_g = args.in[9]; F.w_router = args.in[10]; F.b_router = args.in[11]; F.w_gu = args.in[12]; F.b_gu = args.in[13]; F.w_d = args.in[14]; F.b_d = args.in[15];
    for (int u = F.tid; u < (LDS_BYTES - LDSCTL_OFF) / 4; u += NWAVES * 64) ((LAS unsigned*)(F.lds + LDSCTL_OFF))[u] = 0u;
    __syncthreads();
    XcdBarrier bar; bar.bar = (unsigned*)(F.ctl + CW_BAR); bar.x = 0; bar.st = nullptr;
    if (MK_ONE_LAUNCH) bar = xcd_barrier_post((unsigned*)(F.ctl + CW_BAR), F.MISC + 8);
    const int lo = args.ph_lo, hi = args.ph_hi;
#define IN(k) (lo <= (k) && (k) < hi && ((F.lane = lane_id()), (F.tid = F.wave * 64 + F.lane), true))
#define SEAM(k) do { if (IN(k) && IN((k) + 1)) xcd_barrier(bar); } while (0)

    if (IN(0)) { p0_prologue(F); } SEAM(0);
    if (IN(1)) {
        pg8::Gemm g{(const bf16*)(F.ws + WS_XN), (const bf16*)(F.ws + WS_WIN), T, NIN, D}; pg8::StaticOrder S; S.init(T, NIN, F.G, (int)blockIdx.x);
        pg8::EpiInproj E{(bf16*)(F.ws + WS_P), (bf16*)(F.ws + WS_PH), (bf16*)(F.ws + WS_QN), (bf16*)(F.ws + WS_KN), F.sb_q_g, F.sb_k_g, QSCALE, EPS};
        pg8::gemm_phase<pg8::EpiInproj, pg8::StaticOrder, PG8_ALIGN, PG8_SP2>(F.lds + RING_OFF, g, S, E, F.tid);
    } SEAM(1);
    if (IN(2)) { prep_phase(F); __syncthreads(); hgA_phase(F); } SEAM(2);
    if (IN(3)) { attn_phase(F); hgC_phase(F); } SEAM(3);
    if (IN(4)) {
        pg8::Gemm g{(const bf16*)(F.ws + WS_MIX), (const bf16*)(F.ws + WS_WOUT), T, D, D}; pg8::StaticOrder S; S.init(T, D, F.G, (int)blockIdx.x);
        pg8::EpiRes E{F.x, (bf16*)(F.ws + WS_XN), D};
        pg8::gemm_phase<pg8::EpiRes, pg8::StaticOrder, PG8_ALIGN, PG8_SP2>(F.lds + RING_OFF, g, S, E, F.tid);
    } SEAM(4);
    if (IN(5)) { router_phase(F); } SEAM(5);
    if (IN(6)) {
        const int nt = build_moe_tables(F, 8, 1); const LAS int* lt = (const LAS int*)(F.lds + LTAB_OFF);
        pg8::Gemm g{(const bf16*)(F.ws + WS_X8), (const bf16*)(F.ws + WS_WGU), MAXROWS, NE * 2048, D / 2};
        pg8::MoeOrder S{lt, (const LAS unsigned short*)(F.lds + ROWTAB2_OFF), 8, nt * 8, F.G, F.vcu, 1024u, 0};
        pg8::EpiAct<true> E{F.ws + WS_ACT, (const LAS float*)(F.lds + ROWTAB_OFF), A8_SCALE};
        pg8::gemm_phase<pg8::EpiAct<true>, pg8::MoeOrder, PG8_ALIGN, PG8_SP2, true, SC_W8, SC_ONE>(F.lds + RING_OFF, g, S, E, F.tid);
        {
            const int rem = (nt * 8) % F.G, nidle = F.G - rem; const bool few = rem == 0 || nidle < F.G / 4;
            __syncthreads();
            if (few) p0_items(F, P0_NITEMS - P0_NLATE, P0_NITEMS, F.vcu * NWAVES + F.wave, F.G * NWAVES);
            else if (F.vcu >= rem) p0_items(F, P0_NITEMS - P0_NLATE, P0_NITEMS, (F.vcu - rem) * NWAVES + F.wave, nidle * NWAVES);
        }
    } SEAM(6);
    if (IN(7)) {
        const int nt = build_moe_tables(F, 4, 2); const LAS int* lt = (const LAS int*)(F.lds + LTAB_OFF);
        pg8::Gemm g{(const bf16*)(F.ws + WS_ACT), (const bf16*)(F.ws + WS_WD), MAXROWS, NE * 1024, D / 2};
        pg8::MoeOrder S{lt, nullptr, 4, nt * 4, F.G, F.vcu, 1024u, nt};
        pg8::EpiDown E{F.ws + WS_YK, (const LAS int*)(F.lds + ROWTAB_OFF) + ((MAXTILES * 4 + 255) / 256) * 256, (const LAS float*)(F.lds + ROWTAB_OFF), Y8_SCALE};
        pg8::gemm_phase<pg8::EpiDown, pg8::MoeOrder, PG8_ALIGN, PG8_SP2, true, SC_W8Y, SC_A8>(F.lds + RING_OFF, g, S, E, F.tid);
    } SEAM(7);
    if (IN(8)) { combine_phase(F); }
#undef IN
#undef SEAM
}

extern "C" void kernel_launch(void* const* d_in, const int* in_sizes, int n_in, void* d_out, int out_size, void* d_ws, size_t ws_size, hipStream_t stream) {
    static int grid = 0;
    if (grid == 0) {
        if (n_in != 16 || in_sizes[0] != T * D || out_size != T * D || ws_size < WS_END) { fprintf(stderr, "kernel_launch: shape/workspace mismatch (n_in %d, ws %zu, need %zu); nothing launched\n", n_in, ws_size, (size_t)WS_END); grid = -1; return; }
        int dev = 0, cus = 0, per_cu = 0;
        if (hipGetDevice(&dev) != hipSuccess || hipDeviceGetAttribute(&cus, hipDeviceAttributeMultiprocessorCount, dev) != hipSuccess) { grid = -1; return; }
        if (hipFuncSetAttribute((const void*)fwd, hipFuncAttributeMaxDynamicSharedMemorySize, LDS_BYTES) != hipSuccess) { grid = -1; return; }
        if (hipOccupancyMaxActiveBlocksPerMultiprocessor(&per_cu, (const void*)fwd, NWAVES * 64, LDS_BYTES) != hipSuccess || per_cu < 1) { fprintf(stderr, "kernel_launch: occupancy query says %d\n", per_cu); }
        (void)hipGetLastError();
        if ((MAXTILES * 8 + cus - 1) / cus > MAXSLOT || cus < 1) { fprintf(stderr, "kernel_launch: %d CUs: the per-workgroup unit tables are sized for 256\n", cus); grid = -1; return; }
        grid = cus;
    }
    if (grid < 0) return;
    if (hipMemsetAsync((char*)d_ws + WS_CTL, 0, CTL_ZERO_BYTES, stream) != hipSuccess) return;
    Args a{};
    for (int i = 0; i < 16; ++i) a.in[i] = (const float*)d_in[i];
    a.out = (float*)d_out; a.ws = (unsigned char*)d_ws;
#if MK_ONE_LAUNCH
    a.ph_lo = 0; a.ph_hi = NPH;
    hipLaunchKernelGGL(fwd, dim3(grid), dim3(NWAVES * 64), LDS_BYTES, stream, a);
#else
    for (int p = 0; p < NPH; ++p) { a.ph_lo = p; a.ph_hi = p + 1; hipLaunchKernelGGL(fwd, dim3(grid), dim3(NWAVES * 64), LDS_BYTES, stream, a); }
#endif
}
```

```cpp
#include <hip/hip_runtime.h>
#include <cstdio>
#include <cstdint>
namespace pg8 {
#define PG8_LAS __attribute__((address_space(3)))
typedef unsigned short bf16_t;
typedef short bf16x8 __attribute__((ext_vector_type(8)));
typedef float f32x4 __attribute__((ext_vector_type(4)));
typedef unsigned u32x4 __attribute__((ext_vector_type(4)));
typedef int i32x4_t __attribute__((ext_vector_type(4)));
typedef int i32x8_t __attribute__((ext_vector_type(8)));
constexpr int BM = 256, BK = 64, HALF = 128, HTB = HALF * BK * 2  , STAGE_BYTES = 8 * HTB, NXCD = 8, WGM = 8;

__host__ __device__ __forceinline__ int lds_byte(int r, int c) { const int st = (r >> 4) * 2 + (c >> 5), rr = r & 15, cc = c & 31, ob = rr * 64 + cc * 2; return st * 1024 + (ob ^ (((ob >> 9) & 1) << 5)); }
__host__ __device__ __forceinline__ void stage_rc(int b, int& R, int& C) { const int st = b / 1024, sb = b % 1024, swz = sb ^ (((sb >> 9) & 1) << 5); R = (st >> 1) * 16 + swz / 64; C = (st & 1) * 32 + (swz % 64) / 2; }
__host__ __device__ __forceinline__ int perm32(int rho) { const int n = rho >> 4, i = rho & 15; return 8 * (i >> 2) + 4 * n + (i & 3); }

struct Unit { int pm, pn, slot; };
struct Gemm { const bf16_t* A; const bf16_t* Bt; int M, N, K; };

struct StaticOrder {
    int nM, nN, nwg, G, c;
    __host__ __device__ void init(int M, int N, int G_, int c_) { nM = M / BM; nN = N / BM; nwg = nM * nN; G = G_; c = c_; }
    __host__ __device__ bool next(int i, Unit& u) const {
        const long L = (long)i * G + c; if (L >= nwg) return false;
        int wgid = (int)L; { const int q = nwg / NXCD, r = nwg % NXCD, xcd = wgid % NXCD, off = wgid / NXCD; wgid = (xcd < r ? xcd * (q + 1) : r * (q + 1) + (xcd - r) * q) + off; }
        const int nig = WGM * nN, gid = wgid / nig, fm = gid * WGM, gsz = (nM - fm) < WGM ? (nM - fm) : WGM;
        u.pm = fm + ((wgid % nig) % gsz); u.pn = (wgid % nig) / gsz; return true;
    }
    __device__ __forceinline__ void a_ready(const Unit&) const {}
    __device__ __forceinline__ void done(const Unit&) const {}
};

__device__ __forceinline__ unsigned cvt_pk_bf16(float lo, float hi) { unsigned r; asm volatile("v_cvt_pk_bf16_f32 %0, %1, %2" : "=v"(r) : "v"(lo), "v"(hi)); return r; }
typedef float f32x2 __attribute__((ext_vector_type(2)));
__device__ __forceinline__ f32x2 gelu_pk(f32x2 v) {
    const f32x2 av = __builtin_elementwise_abs(v), d = av * 0.2316418882f + 1.0f;
    f32x2 t; t.x = __builtin_amdgcn_rcpf(d.x); t.y = __builtin_amdgcn_rcpf(d.y);
    f32x2 q = t * 0.5307027145f + (-0.7265760135f); q = q * t + 0.7107068705f; q = q * t + (-0.142248368f); q = q * t + 0.127414796f; q = q * t;
    const f32x2 s = (v * v) * (-0.72134752044f);
    f32x2 e; e.x = __builtin_amdgcn_exp2f(s.x); e.y = __builtin_amdgcn_exp2f(s.y);
    const f32x2 m = v * (q * e), r = v - m;
    f32x2 o; o.x = v.x < 0.f ? m.x : r.x; o.y = v.y < 0.f ? m.y : r.y; return o;
}

template <int ACT  > struct EpiBf16 {
    static constexpr bool PERM = true, AFTER_DRAIN = false, HAS_INIT = false; static_assert(ACT == 0 || ACT == 1, "EpiBf16: ACT is 0 (none) or 1 (gelu_pk)");
    bf16_t* O; int ldc; const float* bias; int split_cols; size_t split_stride; float scale0;
    __device__ __forceinline__ void operator()(const f32x4 (&acc)[2][2][4][2], const Unit& u, int wr, int wc, int fr, int fq) const {
        const int row0 = u.pm * BM + wr * 64 + fr; int colt = u.pn * BM; bf16_t* base = O;
        float sc = 1.f; if (split_cols) { const int t = colt / split_cols; base += (size_t)t * split_stride; colt -= t * split_cols; if (t == 0) sc = scale0; }
        const int col0 = colt + wc * 32 + 8 * fq, bcol0 = u.pn * BM + wc * 32 + 8 * fq;
        f32x4 bv[2][2];
#pragma unroll
        for (int bj = 0; bj < 2; ++bj)
#pragma unroll
            for (int n = 0; n < 2; ++n) bv[bj][n] = bias ? *(const f32x4*)(bias + bcol0 + bj * HALF + 4 * n) : (f32x4){0.f, 0.f, 0.f, 0.f};
#pragma unroll
        for (int ai = 0; ai < 2; ++ai)
#pragma unroll
            for (int m = 0; m < 4; ++m) { bf16_t* rowp = base + (size_t)(row0 + ai * HALF + m * 16) * ldc + col0;
#pragma unroll
                for (int bj = 0; bj < 2; ++bj) { f32x4 v0 = acc[ai][bj][m][0] + bv[bj][0], v1 = acc[ai][bj][m][1] + bv[bj][1];
                    if (ACT == 1) { f32x2 a = gelu_pk((f32x2){v0[0], v0[1]}), b = gelu_pk((f32x2){v0[2], v0[3]}), c = gelu_pk((f32x2){v1[0], v1[1]}), d = gelu_pk((f32x2){v1[2], v1[3]});
                        v0 = (f32x4){a.x, a.y, b.x, b.y}; v1 = (f32x4){c.x, c.y, d.x, d.y}; }
                    v0 = v0 * sc; v1 = v1 * sc; u32x4 w; w.x = cvt_pk_bf16(v0[0], v0[1]); w.y = cvt_pk_bf16(v0[2], v0[3]); w.z = cvt_pk_bf16(v1[0], v1[1]); w.w = cvt_pk_bf16(v1[2], v1[3]);
                    *(u32x4*)(rowp + bj * HALF) = w; } }
    }
};

__device__ __forceinline__ unsigned pk4_fp8(float a, float b, float c, float d) {
    a = fminf(fmaxf(a, -448.f), 448.f); b = fminf(fmaxf(b, -448.f), 448.f); c = fminf(fmaxf(c, -448.f), 448.f); d = fminf(fmaxf(d, -448.f), 448.f);
    int p = 0; p = __builtin_amdgcn_cvt_pk_fp8_f32(a, b, p, false); p = __builtin_amdgcn_cvt_pk_fp8_f32(c, d, p, true); return (unsigned)p;
}
struct EpiRes {
    static constexpr bool PERM = false, AFTER_DRAIN = false, HAS_INIT = false;
    const float* __restrict__ X; bf16_t* __restrict__ XH; int ldc;
    __device__ __forceinline__ void operator()(const f32x4 (&acc)[2][2][4][2], const Unit& u, int wr, int wc, int fr, int fq) const {
        const int row0 = u.pm * BM + wr * 64 + fr, col0 = u.pn * BM + wc * 32 + 4 * fq;
#pragma unroll
        for (int ai = 0; ai < 2; ++ai)
#pragma unroll
            for (int mp = 0; mp < 2; ++mp) { f32x4 xv[2][2][2];
#pragma unroll
                for (int mm = 0; mm < 2; ++mm) { const size_t off = (size_t)(row0 + ai * HALF + (2 * mp + mm) * 16) * ldc + col0;
#pragma unroll
                    for (int bj = 0; bj < 2; ++bj)
#pragma unroll
                        for (int n = 0; n < 2; ++n) xv[mm][bj][n] = __builtin_nontemporal_load((const f32x4*)(X + off + bj * HALF + n * 16)); }
#pragma unroll
                for (int mm = 0; mm < 2; ++mm) { const size_t off = (size_t)(row0 + ai * HALF + (2 * mp + mm) * 16) * ldc + col0;
#pragma unroll
                    for (int bj = 0; bj < 2; ++bj)
#pragma unroll
                        for (int n = 0; n < 2; ++n) { const size_t o2 = off + bj * HALF + n * 16; const f32x4 v = xv[mm][bj][n] + acc[ai][bj][2 * mp + mm][n];
                            *(unsigned long long*)(XH + o2) = (unsigned long long)cvt_pk_bf16(v[0], v[1]) | ((unsigned long long)cvt_pk_bf16(v[2], v[3]) << 32); } } }
    }
};
struct EpiInproj {
    static constexpr bool PERM = true, AFTER_DRAIN = false, HAS_INIT = false;
    bf16_t* PA; bf16_t* PH; bf16_t* QN; bf16_t* KN; const float* gq; const float* gk; float qscale, eps;
    __device__ __forceinline__ void operator()(const f32x4 (&acc)[2][2][4][2], const Unit& u, int wr, int wc, int fr, int fq) const {
        if (u.pn < 4) {
            const int arr = u.pn >> 1, hd = (u.pn & 1) * 4 + wc; const float* g = arr ? gk : gq; const float gs = arr ? 1.f : qscale; bf16_t* dst = arr ? KN : QN;
            f32x4 gv[2][2];
#pragma unroll
            for (int bj = 0; bj < 2; ++bj)
#pragma unroll
                for (int n = 0; n < 2; ++n) gv[bj][n] = *(const f32x4*)(g + 32 * bj + 8 * fq + 4 * n) * gs;
#pragma unroll
            for (int ai = 0; ai < 2; ++ai)
#pragma unroll
                for (int m = 0; m < 4; ++m) { float ss = 0.f;
#pragma unroll
                    for (int bj = 0; bj < 2; ++bj)
#pragma unroll
                        for (int n = 0; n < 2; ++n) { const f32x4 a = acc[ai][bj][m][n]; ss += (a[0] * a[0] + a[1] * a[1]) + (a[2] * a[2] + a[3] * a[3]); }
                    ss += __shfl_xor(ss, 16); ss += __shfl_xor(ss, 32);
                    const float rs = 1.f / sqrtf(ss * (1.f / 64.f) + eps);
                    const int row = u.pm * BM + ai * HALF + wr * 64 + m * 16 + fr, b = row >> 11, s = row & 2047;
                    bf16_t* rp = dst + ((size_t)((b * 8 + hd) * 64 + (s >> 5))) * 2048 + (s & 31) * 8;
#pragma unroll
                    for (int bj = 0; bj < 2; ++bj) { const int c8 = 4 * bj + fq; const f32x4 v0 = acc[ai][bj][m][0] * rs * gv[bj][0], v1 = acc[ai][bj][m][1] * rs * gv[bj][1];
                        u32x4 w; w.x = cvt_pk_bf16(v0[0], v0[1]); w.y = cvt_pk_bf16(v0[2], v0[3]); w.z = cvt_pk_bf16(v1[0], v1[1]); w.w = cvt_pk_bf16(v1[2], v1[3]);
                        *(u32x4*)(rp + (c8 >> 1) * 512 + (c8 & 1) * 256) = w; } }
            return;
        }
#pragma unroll
        for (int bj = 0; bj < 2; ++bj) { const int col = u.pn * BM + bj * HALF + wc * 32 + 8 * fq;
            bf16_t* base; int rowlen;
            if (col < 1536) { const int arr = col >> 9, hd = (col & 511) >> 6, dd = col & 63; base = PA + ((size_t)(arr * 16) * 8 + hd) * 2048 * 64 + dd; rowlen = 64; }
            else { const int c2 = col - 1536, arr = c2 >> 9, hd = (c2 & 511) >> 7, dd = c2 & 127; base = PH + ((size_t)(arr * 16) * 4 + hd) * 2048 * 128 + dd; rowlen = 128; }
            const size_t bstride = (size_t)(rowlen == 64 ? 8 : 4) * 2048 * rowlen;
#pragma unroll
            for (int ai = 0; ai < 2; ++ai)
#pragma unroll
                for (int m = 0; m < 4; ++m) { const int row = u.pm * BM + ai * HALF + wr * 64 + m * 16 + fr, b = row >> 11, s = row & 2047;
                    const f32x4 v0 = acc[ai][bj][m][0], v1 = acc[ai][bj][m][1];
                    u32x4 w; w.x = cvt_pk_bf16(v0[0], v0[1]); w.y = cvt_pk_bf16(v0[2], v0[3]); w.z = cvt_pk_bf16(v1[0], v1[1]); w.w = cvt_pk_bf16(v1[2], v1[3]);
                    *(u32x4*)(base + (size_t)b * bstride + (size_t)s * rowlen) = w; } }
    }
};
struct MoeOrder {
    const PG8_LAS int* tile_e; const PG8_LAS unsigned short* rowtab; int ntn, nunits, G, c; unsigned rowbytes; int rev;
    __device__ __forceinline__ bool next(int i, Unit& u) const {
        const int L = i * G + c; if (L >= nunits) return false;
        const int pm0 = L / ntn, pl = L - pm0 * ntn, pm = rev ? rev - 1 - pm0 : pm0; u.pm = pm; u.pn = tile_e[pm] * ntn + pl; u.slot = i; return true;
    }
    __device__ __forceinline__ unsigned rowoff(const Unit& u, int r) const { return (rowtab ? (unsigned)rowtab[u.slot * 256 + r] : (unsigned)(u.pm * 256 + r)) * rowbytes; }
    __device__ __forceinline__ void a_ready(const Unit&) const {}
    __device__ __forceinline__ void done(const Unit&) const {}
};
template <bool OUT8> struct EpiAct {
    static constexpr bool PERM = true, AFTER_DRAIN = false, HAS_INIT = true;
    unsigned char* ACT; const PG8_LAS float* biastab; float oscale;
    __device__ __forceinline__ void init(f32x4 (&acc)[2][2][4][2], const Unit& u, int wc, int fq) const {
#pragma unroll
        for (int n = 0; n < 2; ++n) { const f32x4 bg = *(const PG8_LAS f32x4*)(biastab + u.slot * 256 + wc * 32 + 8 * fq + 4 * n), bu = *(const PG8_LAS f32x4*)(biastab + u.slot * 256 + 128 + wc * 32 + 8 * fq + 4 * n);
#pragma unroll
            for (int ai = 0; ai < 2; ++ai)
#pragma unroll
                for (int m = 0; m < 4; ++m) { acc[ai][0][m][n] = bg; acc[ai][1][m][n] = bu; } }
    }
    __device__ __forceinline__ void operator()(const f32x4 (&acc)[2][2][4][2], const Unit& u, int wr, int wc, int fr, int fq) const {
        const int pl = u.pn & 7; const int row0 = u.pm * BM + wr * 64 + fr, acol0 = pl * 128 + wc * 32 + 8 * fq;
#pragma unroll
        for (int ai = 0; ai < 2; ++ai)
#pragma unroll
            for (int m = 0; m < 4; ++m) { unsigned char* rowp = ACT + (size_t)(row0 + ai * HALF + m * 16) * 1024 + acol0; f32x4 a4[2];
#pragma unroll
                for (int n = 0; n < 2; ++n) { const f32x4 g4 = acc[ai][0][m][n], u4 = acc[ai][1][m][n]; f32x4 gl, ul, ex;
#pragma unroll
                    for (int j = 0; j < 4; ++j) { gl[j] = fminf(g4[j], 7.0f); ul[j] = __builtin_amdgcn_fmed3f(u4[j], -7.0f, 7.0f); }
                    const f32x4 t4 = gl * (-1.702f * 1.44269504089f);
#pragma unroll
                    for (int j = 0; j < 4; ++j) ex[j] = __builtin_amdgcn_exp2f(t4[j]);
                    const f32x4 d4 = ex + 1.0f; f32x4 s4;
#pragma unroll
                    for (int j = 0; j < 4; ++j) s4[j] = __builtin_amdgcn_rcpf(d4[j]);
                    a4[n] = (gl * s4) * (ul * oscale + oscale); }
                if constexpr (OUT8) { int p0 = 0, p1 = 0; p0 = __builtin_amdgcn_cvt_pk_fp8_f32(a4[0][0], a4[0][1], p0, false); p0 = __builtin_amdgcn_cvt_pk_fp8_f32(a4[0][2], a4[0][3], p0, true);
                    p1 = __builtin_amdgcn_cvt_pk_fp8_f32(a4[1][0], a4[1][1], p1, false); p1 = __builtin_amdgcn_cvt_pk_fp8_f32(a4[1][2], a4[1][3], p1, true);
                    *(unsigned long long*)rowp = (unsigned long long)(unsigned)p0 | ((unsigned long long)(unsigned)p1 << 32); }
                else { u32x4 w; w.x = cvt_pk_bf16(a4[0][0], a4[0][1]); w.y = cvt_pk_bf16(a4[0][2], a4[0][3]); w.z = cvt_pk_bf16(a4[1][0], a4[1][1]); w.w = cvt_pk_bf16(a4[1][2], a4[1][3]); *(u32x4*)(rowp + (size_t)(row0 + ai * HALF + m * 16) * 1024 + acol0) = w; } }
    }
};
struct EpiDown {
    static constexpr bool PERM = true, AFTER_DRAIN = false, HAS_INIT = true;
    unsigned char* YK; const PG8_LAS int* tktab; const PG8_LAS float* biastab; float oscale;
    __device__ __forceinline__ void init(f32x4 (&acc)[2][2][4][2], const Unit& u, int wc, int fq) const {
#pragma unroll
        for (int bj = 0; bj < 2; ++bj)
#pragma unroll
            for (int n = 0; n < 2; ++n) { const f32x4 bv = *(const PG8_LAS f32x4*)(biastab + u.slot * 256 + bj * HALF + wc * 32 + 8 * fq + 4 * n) * oscale;
#pragma unroll
                for (int ai = 0; ai < 2; ++ai)
#pragma unroll
                    for (int m = 0; m < 4; ++m) acc[ai][bj][m][n] = bv; }
    }
    __device__ __forceinline__ void operator()(const f32x4 (&acc)[2][2][4][2], const Unit& u, int wr, int wc, int fr, int fq) const {
        const int pl = u.pn & 3; const int col0 = pl * BM + wc * 32 + 8 * fq;
#pragma unroll
        for (int ai = 0; ai < 2; ++ai)
#pragma unroll
            for (int m = 0; m < 4; ++m) { const int tk = tktab[u.slot * 256 + ai * HALF + wr * 64 + m * 16 + fr];
                if (tk >= 0) { unsigned char* rowp = YK + (size_t)tk * 1024 + col0;
#pragma unroll
                    for (int bj = 0; bj < 2; ++bj) { f32x4 v0 = acc[ai][bj][m][0], v1 = acc[ai][bj][m][1];
#pragma unroll
                        for (int j = 0; j < 4; ++j) { v0[j] = __builtin_amdgcn_fmed3f(v0[j], -448.f, 448.f); v1[j] = __builtin_amdgcn_fmed3f(v1[j], -448.f, 448.f); }
                        int p0 = 0, p1 = 0; p0 = __builtin_amdgcn_cvt_pk_fp8_f32(v0[0], v0[1], p0, false); p0 = __builtin_amdgcn_cvt_pk_fp8_f32(v0[2], v0[3], p0, true);
                        p1 = __builtin_amdgcn_cvt_pk_fp8_f32(v1[0], v1[1], p1, false); p1 = __builtin_amdgcn_cvt_pk_fp8_f32(v1[2], v1[3], p1, true);
                        *(unsigned long long*)(rowp + bj * HALF) = (unsigned long long)(unsigned)p0 | ((unsigned long long)(unsigned)p1 << 32); } } }
    }
};


template <class Epi, class Sched, bool ALIGN_EPI = false, bool SP2 = false, bool GATHER = false, int SCW = 0, int SCX = 0>
__device__ __forceinline__ void gemm_phase(PG8_LAS unsigned char* lds, const Gemm g, const Sched& S, const Epi& E, const int tid) {
    const int wid = __builtin_amdgcn_readfirstlane(tid >> 6), lane = tid & 63, wr = wid >> 2, wc = wid & 3, fr = lane & 15, fq = lane >> 4;
    const int K = g.K, nt = K / BK;
    unsigned voffA[2], voffB[2]; int RA[2]; unsigned CA2[2]; unsigned va0[2] = {0u, 0u}, va1[2] = {0u, 0u};
#pragma unroll
    for (int i = 0; i < 2; ++i) { int R, C; stage_rc(tid * 16 + i * 8192, R, C); const int Rb = Epi::PERM ? ((R & ~31) + perm32(R & 31)) : R;
        voffA[i] = (unsigned)(R * K + C) * 2u; voffB[i] = (unsigned)(Rb * K + C) * 2u; RA[i] = R; CA2[i] = (unsigned)C * 2u; }
    static_assert(!GATHER || SP2, "the gathered-A form exists for the SP2 loop only");
    const char* const gA0 = (const char*)g.A;
#define PG8_VA(u) do { int l_; asm volatile("v_mbcnt_lo_u32_b32 %0, -1, 0\n\tv_mbcnt_hi_u32_b32 %0, -1, %0" : "=v"(l_)); const int t_ = wid * 64 + l_;     \
        _Pragma("unroll") for (int _i = 0; _i < 2; ++_i) { int R_, C_; stage_rc(t_ * 16 + _i * 8192, R_, C_); va0[_i] = S.rowoff((u), R_) + (unsigned)C_ * 2u; va1[_i] = S.rowoff((u), HALF + R_) + (unsigned)C_ * 2u; } } while (0)
#define PG8_STA(bufoff, base_ng, base_g, h) do { if constexpr (GATHER) { if (h) PG8_STAGE(bufoff, base_g, va1); else PG8_STAGE(bufoff, base_g, va0); } else PG8_STAGE(bufoff, base_ng, voffA); } while (0)
    const size_t kstep = (size_t)(BK * 2);
    const size_t hstep = (size_t)HALF * K * 2;
    const size_t tstep = 2 * hstep;
    const unsigned ldsw = (unsigned)wid * 1024u;
    const int aoff = lds_byte(wr * 64 + fr, fq * 8), boff = lds_byte(wc * 32 + fr, fq * 8);
#define PG8_SA(b, h) (((b) * 2 + (h)) * HTB)
#define PG8_SB(b, h) ((4 + (b) * 2 + (h)) * HTB)
#define PG8_STAGE(bufoff, gbase, voff) do { _Pragma("unroll") for (int _i = 0; _i < 2; ++_i) \
        __builtin_amdgcn_global_load_lds((const unsigned*)((const char*)(gbase) + (voff)[_i]), (PG8_LAS unsigned*)(lds + (bufoff) + ldsw + _i * 8192), 16, 0, 0); } while (0)
#define PG8_LDA(dst, b, h) do { if constexpr (SCW != 0) { _Pragma("unroll") for (int m = 0; m < 4; ++m) dst##8[m] = PG8_CAT8(*(const PG8_LAS bf16x8*)(lds + PG8_SA(b, h) + aoff + m * 2048), *(const PG8_LAS bf16x8*)(lds + PG8_SA(b, h) + aoff + m * 2048 + 1024)); } \
        else { _Pragma("unroll") for (int m = 0; m < 4; ++m) _Pragma("unroll") for (int k = 0; k < 2; ++k) dst[m][k] = *(const PG8_LAS bf16x8*)(lds + PG8_SA(b, h) + aoff + m * 2048 + k * 1024); } } while (0)
#define PG8_LDB(dst, b, h) do { if constexpr (SCW != 0) { _Pragma("unroll") for (int n = 0; n < 2; ++n) dst##8[n] = PG8_CAT8(*(const PG8_LAS bf16x8*)(lds + PG8_SB(b, h) + boff + n * 2048), *(const PG8_LAS bf16x8*)(lds + PG8_SB(b, h) + boff + n * 2048 + 1024)); } \
        else { _Pragma("unroll") for (int n = 0; n < 2; ++n) _Pragma("unroll") for (int k = 0; k < 2; ++k) dst[n][k] = *(const PG8_LAS bf16x8*)(lds + PG8_SB(b, h) + boff + n * 2048 + k * 1024); } } while (0)
#define PG8_CAT8(lo, hi) __builtin_shufflevector(__builtin_bit_cast(i32x4_t, (lo)), __builtin_bit_cast(i32x4_t, (hi)), 0, 1, 2, 3, 4, 5, 6, 7)
#define PG8_MMA(ai, bj, At, Bt) do { __builtin_amdgcn_s_setprio(1); _Pragma("unroll") for (int m = 0; m < 4; ++m) _Pragma("unroll") for (int n = 0; n < 2; ++n) { \
        if constexpr (SCW != 0) acc[ai][bj][m][n] = __builtin_amdgcn_mfma_scale_f32_16x16x128_f8f6f4(Bt##8[n], At##8[m], acc[ai][bj][m][n], 0, 0, 0, SCW, 0, SCX); \
        else { _Pragma("unroll") for (int k = 0; k < 2; ++k) acc[ai][bj][m][n] = __builtin_amdgcn_mfma_f32_16x16x32_bf16(Bt[n][k], At[m][k], acc[ai][bj][m][n], 0, 0, 0); } } __builtin_amdgcn_s_setprio(0); } while (0)
#define PG8_WAIT_V(n) asm volatile("s_waitcnt vmcnt(" #n ")" ::: "memory")
#define PG8_WAIT_L(n) asm volatile("s_waitcnt lgkmcnt(" #n ")" ::: "memory")
#define PG8_BAR __builtin_amdgcn_s_barrier()
#define PG8_SCHED __builtin_amdgcn_sched_barrier(0)
    Unit cur, nxt; int ui = 0;
    if (!S.next(0, cur)) return;
    f32x4 acc[2][2][4][2];
    if constexpr (Epi::HAS_INIT) E.init(acc, cur, wc, fq);
    else {
#pragma unroll
    for (int a = 0; a < 2; ++a)
#pragma unroll
        for (int b = 0; b < 2; ++b)
#pragma unroll
            for (int m = 0; m < 4; ++m)
#pragma unroll
                for (int n = 0; n < 2; ++n) acc[a][b][m][n] = (f32x4){0.f, 0.f, 0.f, 0.f};
    }
    bf16x8 At[4][2], B0[2][2], B1[2][2]; i32x8_t At8[4], B08[2], B18[2];
    const char* cA = (const char*)g.A + (size_t)cur.pm * tstep; const char* cB = (const char*)g.Bt + (size_t)cur.pn * tstep;
    S.a_ready(cur);
    if constexpr (SP2) {
        if constexpr (GATHER) PG8_VA(cur);
        PG8_STAGE(PG8_SB(0, 0), cB, voffB); PG8_STAGE(PG8_SB(0, 1), cB + hstep, voffB); PG8_STA(PG8_SA(0, 0), cA, gA0, 0); PG8_STA(PG8_SA(0, 1), cA + hstep, gA0, 1);
        if (wr == 1) PG8_BAR;
        PG8_WAIT_V(2); PG8_BAR;
        PG8_STAGE(PG8_SB(1, 0), cB + kstep, voffB); PG8_STA(PG8_SA(1, 0), cA + kstep, gA0 + kstep, 0); PG8_STAGE(PG8_SB(1, 1), cB + hstep + kstep, voffB);
        PG8_WAIT_V(6); PG8_BAR;
    } else {
        PG8_STAGE(PG8_SB(0, 0), cB, voffB); PG8_STAGE(PG8_SA(0, 0), cA, voffA); PG8_STAGE(PG8_SB(0, 1), cB + hstep, voffB); PG8_STAGE(PG8_SA(0, 1), cA + hstep, voffA);
        if (wr == 1) PG8_BAR;
        PG8_WAIT_V(4); PG8_BAR;
        PG8_STAGE(PG8_SB(1, 0), cB + kstep, voffB); PG8_STAGE(PG8_SA(1, 0), cA + kstep, voffA); PG8_STAGE(PG8_SB(1, 1), cB + hstep + kstep, voffB);
        PG8_WAIT_V(6); PG8_BAR;
    }
    for (;;) {
        const bool has_next = S.next(ui + 1, nxt);
        const char* nA = has_next ? (const char*)g.A + (size_t)nxt.pm * tstep : cA; const char* nB = has_next ? (const char*)g.Bt + (size_t)nxt.pn * tstep : cB;
        _Pragma("nounroll") for (int t = 0; t < nt; t += 2) {
            const bool last = (t == nt - 2);
            const char* a1 = cA + (size_t)(t + 1) * kstep;
            const char* a2 = last ? nA : cA + (size_t)(t + 2) * kstep; const char* b2 = last ? nB : cB + (size_t)(t + 2) * kstep;
            const char* a3 = a2 + kstep; const char* b3 = b2 + kstep;
            if (last && has_next) S.a_ready(nxt);
            const char* const g1 = gA0 + (size_t)(t + 1) * kstep; const char* const g2 = last ? gA0 : gA0 + (size_t)(t + 2) * kstep; const char* const g3 = g2 + kstep;
            if constexpr (SP2) {
            PG8_LDB(B0, 0, 0); PG8_LDB(B1, 0, 1); PG8_SCHED; PG8_LDA(At, 0, 0); PG8_STA(PG8_SA(1, 1), a1 + hstep, g1, 1);
            PG8_WAIT_V(8); PG8_WAIT_L(0); PG8_BAR; PG8_MMA(0, 0, At, B0); PG8_MMA(0, 1, At, B1); PG8_BAR; PG8_SCHED;
            if constexpr (GATHER) { if (last && has_next) PG8_VA(nxt); }
            PG8_LDA(At, 0, 1); PG8_STAGE(PG8_SB(0, 0), b2, voffB); PG8_STAGE(PG8_SB(0, 1), b2 + hstep, voffB); PG8_STA(PG8_SA(0, 0), a2, g2, 0);
            PG8_WAIT_V(8); PG8_WAIT_L(0); PG8_BAR; PG8_MMA(1, 0, At, B0); PG8_MMA(1, 1, At, B1); PG8_BAR; PG8_SCHED;
            PG8_LDB(B0, 1, 0); PG8_LDB(B1, 1, 1); PG8_SCHED; PG8_LDA(At, 1, 0); PG8_STA(PG8_SA(0, 1), a2 + hstep, g2, 1);
            PG8_WAIT_V(8); PG8_WAIT_L(0); PG8_BAR; PG8_MMA(0, 0, At, B0); PG8_MMA(0, 1, At, B1); PG8_BAR; PG8_SCHED;
            PG8_LDA(At, 1, 1); PG8_STAGE(PG8_SB(1, 0), b3, voffB); PG8_STAGE(PG8_SB(1, 1), b3 + hstep, voffB); PG8_STA(PG8_SA(1, 0), a3, g3, 0);
            PG8_WAIT_V(8); PG8_WAIT_L(0); PG8_BAR; PG8_MMA(1, 0, At, B0); PG8_MMA(1, 1, At, B1); PG8_BAR; PG8_SCHED;
            } else {
            PG8_LDB(B0, 0, 0); PG8_SCHED; PG8_LDA(At, 0, 0); PG8_STAGE(PG8_SA(1, 1), a1 + hstep, voffA);
            PG8_WAIT_L(8); PG8_BAR; PG8_WAIT_L(0); PG8_MMA(0, 0, At, B0); PG8_BAR; PG8_SCHED;
            PG8_LDB(B1, 0, 1); PG8_STAGE(PG8_SB(0, 0), b2, voffB);
            PG8_BAR; PG8_WAIT_L(0); PG8_MMA(0, 1, At, B1); PG8_BAR;
            PG8_LDA(At, 0, 1); PG8_STAGE(PG8_SA(0, 0), a2, voffA);
            PG8_BAR; PG8_WAIT_L(0); PG8_MMA(1, 0, At, B0); PG8_BAR; PG8_SCHED;
            PG8_STAGE(PG8_SB(0, 1), b2 + hstep, voffB);
            PG8_WAIT_V(6); PG8_BAR; PG8_MMA(1, 1, At, B1); PG8_BAR;
            PG8_LDB(B0, 1, 0); PG8_SCHED; PG8_LDA(At, 1, 0); PG8_STAGE(PG8_SA(0, 1), a2 + hstep, voffA);
            PG8_WAIT_L(8); PG8_BAR; PG8_WAIT_L(0); PG8_MMA(0, 0, At, B0); PG8_BAR; PG8_SCHED;
            PG8_LDB(B1, 1, 1); PG8_STAGE(PG8_SB(1, 0), b3, voffB);
            PG8_BAR; PG8_WAIT_L(0); PG8_MMA(0, 1, At, B1); PG8_BAR;
            PG8_LDA(At, 1, 1); PG8_STAGE(PG8_SA(1, 0), a3, voffA);
            PG8_BAR; PG8_WAIT_L(0); PG8_MMA(1, 0, At, B0); PG8_BAR; PG8_SCHED;
            PG8_STAGE(PG8_SB(1, 1), b3 + hstep, voffB);
            PG8_WAIT_V(6); PG8_BAR; PG8_MMA(1, 1, At, B1); PG8_BAR;
            }
        }
        if constexpr (ALIGN_EPI) { if (wr == 0) PG8_BAR; }
        if constexpr (!Epi::AFTER_DRAIN) { int fr_ = fr, fq_ = fq; asm volatile("" : "+v"(fr_), "+v"(fq_));
            E(acc, cur, wr, wc, fr_, fq_); S.done(cur); }
        if (!has_next) break;
        if constexpr (Epi::HAS_INIT) { int fq_ = fq; asm volatile("" : "+v"(fq_)); E.init(acc, nxt, wc, fq_); }
        else {
#pragma unroll
        for (int a = 0; a < 2; ++a)
#pragma unroll
            for (int b = 0; b < 2; ++b)
#pragma unroll
                for (int m = 0; m < 4; ++m)
#pragma unroll
                    for (int n = 0; n < 2; ++n) acc[a][b][m][n] = (f32x4){0.f, 0.f, 0.f, 0.f};
        }
        cur = nxt; cA = nA; cB = nB; ++ui;
        if constexpr (ALIGN_EPI) { if (wr == 1) PG8_BAR; }
    }
    PG8_WAIT_V(0);
    if constexpr (!ALIGN_EPI) { if (wr == 0) PG8_BAR; }
    PG8_BAR;
    if constexpr (Epi::AFTER_DRAIN) { E.fused(acc, cur, wr, wc, fr, fq, lds, wid, lane); S.done(cur); }
#undef PG8_SA
#undef PG8_CAT8
#undef PG8_VA
#undef PG8_STA
#undef PG8_SB
#undef PG8_STAGE
#undef PG8_LDA
#undef PG8_LDB
#undef PG8_MMA
#undef PG8_WAIT_V
#undef PG8_WAIT_L
#undef PG8_BAR
#undef PG8_SCHED
}
}

#ifndef PG8_SP2
#define PG8_SP2 true
#endif
#ifndef PG8_ALIGN
#define PG8_ALIGN true
#endif
#define GAS __attribute__((address_space(1)))
#define LAS __attribute__((address_space(3)))
typedef unsigned short bf16;
typedef unsigned v4u __attribute__((ext_vector_type(4)));
typedef float f32x4 __attribute__((ext_vector_type(4)));
typedef short bf16x8 __attribute__((ext_vector_type(8)));
typedef GAS unsigned gu32;
typedef GAS unsigned long long gu64;
#define RLX_AGENT __ATOMIC_RELAXED, __HIP_MEMORY_SCOPE_AGENT
#define LDS_WAIT() asm volatile("s_waitcnt lgkmcnt(0)" ::: "memory")
#define VM_WAIT() asm volatile("s_waitcnt vmcnt(0)" ::: "memory")
__device__ __forceinline__ unsigned long long rt() { return __builtin_amdgcn_s_memrealtime(); }
__device__ __forceinline__ unsigned f2bf(float f) { unsigned u = __builtin_bit_cast(unsigned, f); return (u + 0x7fffu + ((u >> 16) & 1u)) >> 16; }
__device__ __forceinline__ unsigned pk2(float lo, float hi) { return f2bf(lo) | (f2bf(hi) << 16); }

#define XB_TMO      128
#define XB_XCNT(j)  (256  + 64 * (j))
#define XB_XSUB(j)  (1280 + 64 * (j))
#define XB_XGEN(j)  (2304 + 64 * (j))
#define XB_TOP      3328
#define XB_TOPGEN   3392
#define XCD_BAR_WORDS 3456
#define XB_SPIN_CAP (1u << 18)

__device__ __forceinline__ unsigned xb_ld(unsigned* p)              { return __hip_atomic_load(p, __ATOMIC_RELAXED, __HIP_MEMORY_SCOPE_AGENT); }
__device__ __forceinline__ unsigned xb_add(unsigned* p, unsigned v) { return __hip_atomic_fetch_add(p, v, __ATOMIC_RELAXED, __HIP_MEMORY_SCOPE_AGENT); }
__device__ __forceinline__ unsigned xb_xcc_id() { return (unsigned)__builtin_amdgcn_s_getreg((3 << 11) | 20) & 0xFu; }
#define XB_SPIN(cond, bar) do { unsigned _sp = 0; while (cond) { __builtin_amdgcn_s_sleep(1); \
    if ((++_sp & 255u) == 0u) { if (xb_ld(&(bar)[XB_TMO])) break; if (_sp > XB_SPIN_CAP) { atomicAdd(&(bar)[XB_TMO], 1u); break; } } } } while (0)

struct XcdBarrier {
    unsigned* bar; unsigned x;
    volatile LAS unsigned* st;
};

__device__ __forceinline__ XcdBarrier xcd_barrier_post(unsigned* bar, volatile LAS unsigned* st) {
    XcdBarrier b; b.bar = bar; b.x = xb_xcc_id(); b.st = st;
    if (threadIdx.x == 0) (void)xb_add(&bar[XB_XCNT(b.x)], 1u);
    return b;
}
__device__ __forceinline__ void xcd_barrier_complete(unsigned* bar, unsigned x, unsigned& nloc, unsigned& nx) {
    const unsigned G = gridDim.x * gridDim.y * gridDim.z;
    unsigned sum, cnt, mine, sp = 0u;
    for (;;) {
        sum = 0u; cnt = 0u; mine = 0u;
#pragma unroll
        for (unsigned j = 0; j < 16; ++j) { const unsigned c = xb_ld(&bar[XB_XCNT(j)]); sum += c; cnt += (c > 0u) ? 1u : 0u; mine = (j == x) ? c : mine; }
        if (sum == G) break;
        __builtin_amdgcn_s_sleep(1);
        if ((++sp & 255u) == 0u) { if (xb_ld(&bar[XB_TMO])) break; if (sp > XB_SPIN_CAP) { atomicAdd(&bar[XB_TMO], 1u); break; } }
    }
    nloc = mine > 0u ? mine : 1u; nx = cnt > 0u ? cnt : 1u;
}

__device__ __forceinline__ void xcd_barrier(const XcdBarrier& b) {
    asm volatile("s_waitcnt vmcnt(0)" ::: "memory");
    __syncthreads();
    if (threadIdx.x == 0) {
        unsigned* bar = b.bar;
        __builtin_amdgcn_s_waitcnt(0);
        unsigned nloc = b.st[0], nx = b.st[1];
        if (nloc == 0u) { xcd_barrier_complete(bar, b.x, nloc, nx); b.st[0] = nloc; b.st[1] = nx; }
        const unsigned old = xb_add(&bar[XB_XSUB(b.x)], 1u);
        const unsigned gen = old / nloc;
        if (old + 1u == (gen + 1u) * nloc) {
            __builtin_amdgcn_fence(__ATOMIC_RELEASE, "agent");
            asm volatile("s_waitcnt vmcnt(0)" ::: "memory");
            const unsigned og = xb_add(&bar[XB_TOP], 1u);
            const unsigned tg = og / nx;
            if (og + 1u == (tg + 1u) * nx) xb_add(&bar[XB_TOPGEN], 1u);
            else XB_SPIN(xb_ld(&bar[XB_TOPGEN]) == tg, bar);
            __builtin_amdgcn_fence(__ATOMIC_ACQUIRE, "agent");
            xb_add(&bar[XB_XGEN(b.x)], 1u);
            asm volatile("s_waitcnt vmcnt(0)" ::: "memory");
        } else {
            XB_SPIN(xb_ld(&bar[XB_XGEN(b.x)]) == gen, bar);
            __builtin_amdgcn_fence(__ATOMIC_ACQUIRE, "agent");
            asm volatile("s_waitcnt vmcnt(0)" ::: "memory");
        }
    }
    __syncthreads();
}

constexpr int NWAVES = 8;
#ifndef MK_ONE_LAUNCH
#define MK_ONE_LAUNCH 1
#endif

constexpr int BATCH = 16, SEQ = 2048, D = 1024, T = BATCH * SEQ;
constexpr int NIN = 3584;
constexpr int OFF_SQ = 0, OFF_SK = 512, OFF_SV = 1024, OFF_HQ = 1536, OFF_HF = 2048, OFF_HI = 2560, OFF_HG = 3072;
constexpr int NE = 32, TOPK = 4, NASSIGN = T * TOPK;
constexpr int MAXTILES = NASSIGN / 256 + NE;
constexpr int MAXROWS = MAXTILES * 256;
constexpr float EPS = 1e-6f;

constexpr size_t MiB = 1u << 20;
constexpr size_t WS_CTL = 0, CTL_ZERO_BYTES = 1 * MiB;
constexpr size_t WS_WIN = 2 * MiB;
constexpr size_t WS_WOUT = 10 * MiB;
constexpr size_t WS_RT = 12 * MiB;
constexpr size_t WS_WGU = 16 * MiB;
constexpr size_t WS_WD = 144 * MiB;
constexpr size_t WS_XN = 208 * MiB;
constexpr size_t WS_P = 272 * MiB;
constexpr size_t WS_PH = WS_P + 96 * MiB;
constexpr size_t WS_MIX = 496 * MiB;
constexpr size_t WS_ACT = 272 * MiB;
constexpr size_t WS_YK = 560 * MiB;
constexpr size_t WS_QN = 624 * MiB;
constexpr size_t WS_KN = 656 * MiB;
constexpr size_t WS_VT = 688 * MiB;
constexpr size_t WS_KVS = 720 * MiB;
constexpr size_t WS_DEC = 784 * MiB;
constexpr size_t WS_SSEG = 786 * MiB;
constexpr size_t WS_DSEG = 802 * MiB;
constexpr size_t WS_LIST = 816 * MiB;
constexpr size_t WS_TOPG = 825 * MiB;
constexpr size_t WS_X8 = 560 * MiB;
constexpr size_t WS_END = 832 * MiB;
static_assert(WS_ACT + (size_t)MAXROWS * 2048 <= WS_YK && WS_YK + (size_t)T * 4 * 2048 <= WS_LIST && WS_MIX + (size_t)T * 2048 <= WS_YK, "d_ws map");
constexpr int CW_TMO = 0, CW_CODE = 1;
constexpr int CW_CNT = 64;
constexpr int CW_BAR = 4096;

constexpr int RING_OFF = 0, RING_BYTES = 131072;
constexpr int RT_ROW = 2064, RT_WL = 32 * RT_ROW, RT_END = 64 * RT_ROW;
constexpr int LDSCTL_OFF = 133120, MISC_OFF = LDSCTL_OFF + 320;
constexpr int LTAB_OFF = LDSCTL_OFF + 512;
constexpr int LT_TS = MAXTILES, LT_CNT = MAXTILES + 32, LT_MISC = MAXTILES + 64, LT_WORDS = MAXTILES + 192;
constexpr int ROWTAB_OFF = LTAB_OFF + LT_WORDS * 4;
constexpr int MAXSLOT = 17;
constexpr int ROWTAB2_OFF = ROWTAB_OFF + MAXSLOT * 1024;
constexpr int LDS_BYTES = ROWTAB2_OFF + MAXSLOT * 512;
static_assert(RT_END <= LDSCTL_OFF && MISC_OFF + 128 <= LTAB_OFF && LDS_BYTES <= 160 * 1024 && (MAXTILES * 8 + 255) / 256 <= MAXSLOT && 2 * ((MAXTILES * 4 + 255) / 256) * 1024 <= MAXSLOT * 1536 && ROWTAB_OFF % 16 == 0, "LDS map");

struct Frame {
    LAS unsigned char* lds;
    volatile LAS unsigned* MISC;
    gu32* ctl;
    int tid, lane, wave, gw, ngw;
    int vcu, G;
    const float *x, *norm1_g, *w_in, *sb_q_g, *sb_k_g, *sb_out_g, *hg_lb, *hg_out_g, *w_out, *norm2_g, *w_router, *b_router, *w_gu, *b_gu, *w_d, *b_d;
    float* out;
    unsigned char* ws;
};
__device__ __forceinline__ float bf2f(unsigned short b) { return __builtin_bit_cast(float, (unsigned)b << 16); }
__device__ __forceinline__ float bflo(unsigned w) { return __builtin_bit_cast(float, w << 16); }
__device__ __forceinline__ float bfhi(unsigned w) { return __builtin_bit_cast(float, w & 0xffff0000u); }
typedef __bf16 bf16x2n_ __attribute__((ext_vector_type(2)));
typedef float f32x2n_ __attribute__((ext_vector_type(2)));
__device__ __forceinline__ unsigned pkbf(float a, float b) { const bf16x2n_ v = __builtin_convertvector((f32x2n_){a, b}, bf16x2n_); return __builtin_bit_cast(unsigned, v); }
__device__ __forceinline__ int lane_id() { int l; asm volatile("v_mbcnt_lo_u32_b32 %0, -1, 0\n\tv_mbcnt_hi_u32_b32 %0, -1, %0" : "=v"(l)); return l; }
__device__ __forceinline__ int vzero() { int z; asm volatile("v_mov_b32 %0, 0" : "=v"(z)); return z; }
__device__ __forceinline__ float wave_sum(float v) {
#pragma unroll
    for (int o = 1; o < 64; o <<= 1) v += __shfl_xor(v, o);
    return v;
}

constexpr float W8_SCALE = 256.f, A8_SCALE = 4.f, Y8_SCALE = 32.f; static_assert(Y8_SCALE == 32.f, "SC_W8Y below is 2^-8 * 32");
constexpr int SC_ONE = 0x7f7f7f7f, SC_W8 = 0x77777777, SC_A8 = 0x7d7d7d7d, SC_W8Y = 0x7c7c7c7c;
struct P0Item { const float* W; bf16* WT; const float* rowscale; int N, k0, n0, drow0, fp8, perm; };
__device__ __forceinline__ void p0_load(const P0Item& it, f32x4 (&v)[16], int lane) {
    const int kr = lane >> 4, nc = 4 * (lane & 15);
#pragma unroll
    for (int i = 0; i < 16; ++i) v[i] = __builtin_nontemporal_load((const f32x4*)(it.W + (size_t)(it.k0 + 4 * i + kr) * it.N + it.n0 + nc));
}
__device__ __forceinline__ void p0_store(const P0Item& it, const f32x4 (&v)[16], LAS unsigned char* scr, int lane) {
    const int kr = lane >> 4, nc = 4 * (lane & 15);
#pragma unroll
    for (int i = 0; i < 16; ++i) { const float sc = it.rowscale ? it.rowscale[it.k0 + 4 * i + kr] : 1.f;
        *(LAS unsigned long long*)(scr + (4 * i + kr) * 136 + 2 * nc) = (unsigned long long)pkbf(v[i].x * sc, v[i].y * sc) | ((unsigned long long)pkbf(v[i].z * sc, v[i].w * sc) << 32); }
    LDS_WAIT(); asm volatile("" ::: "memory");
    const LAS unsigned short* s16 = (const LAS unsigned short*)scr;
    if (it.fp8) { const int p = lane & 3, nr = lane >> 2;
#pragma unroll
        for (int c = 0; c < 4; ++c) { const int n = 16 * c + nr; unsigned val[16];
#pragma unroll
            for (int kk = 0; kk < 16; ++kk) val[kk] = s16[(16 * p + kk) * 68 + n];
            v4u w4;
            w4.x = pg8::pk4_fp8(bflo(val[0]) * W8_SCALE, bflo(val[1]) * W8_SCALE, bflo(val[2]) * W8_SCALE, bflo(val[3]) * W8_SCALE);
            w4.y = pg8::pk4_fp8(bflo(val[4]) * W8_SCALE, bflo(val[5]) * W8_SCALE, bflo(val[6]) * W8_SCALE, bflo(val[7]) * W8_SCALE);
            w4.z = pg8::pk4_fp8(bflo(val[8]) * W8_SCALE, bflo(val[9]) * W8_SCALE, bflo(val[10]) * W8_SCALE, bflo(val[11]) * W8_SCALE);
            w4.w = pg8::pk4_fp8(bflo(val[12]) * W8_SCALE, bflo(val[13]) * W8_SCALE, bflo(val[14]) * W8_SCALE, bflo(val[15]) * W8_SCALE);
            *(GAS v4u*)((unsigned char*)it.WT + (size_t)(it.drow0 + n) * D + it.k0 + 16 * p) = w4; }
    } else { const int p = lane & 7, nr = lane >> 3;
#pragma unroll
        for (int c = 0; c < 8; ++c) { const int n = 8 * c + nr; unsigned val[8];
#pragma unroll
            for (int kk = 0; kk < 8; ++kk) val[kk] = s16[(8 * p + kk) * 68 + n];
            v4u w4; w4.x = val[0] | (val[1] << 16); w4.y = val[2] | (val[3] << 16); w4.z = val[4] | (val[5] << 16); w4.w = val[6] | (val[7] << 16);
            *(GAS v4u*)(it.WT + (size_t)(it.drow0 + (it.perm ? 128 * (n >> 5) + (n & 31) : n)) * D + it.k0 + 8 * p) = w4; } }
    LDS_WAIT(); asm volatile("" ::: "memory");
}
__device__ __forceinline__ void rms_rows2_to_bf16(const float* xa, const float* xb, bool hasb, const float* g, bf16* oa, bf16* ob, int lane) {
    const GAS f32x4* pa = (const GAS f32x4*)xa + lane; const GAS f32x4* pb = (const GAS f32x4*)(hasb ? xb : xa) + lane; const f32x4* gr = (const f32x4*)g + lane;
    f32x4 va[4], vb[4], gg[4]; float sa = 0.f, sb = 0.f;
#pragma unroll
    for (int j = 0; j < 4; ++j) { va[j] = __builtin_nontemporal_load(pa + 64 * j); vb[j] = __builtin_nontemporal_load(pb + 64 * j); gg[j] = gr[64 * j]; }
#pragma unroll
    for (int j = 0; j < 4; ++j) { sa += (va[j].x * va[j].x + va[j].y * va[j].y) + (va[j].z * va[j].z + va[j].w * va[j].w); sb += (vb[j].x * vb[j].x + vb[j].y * vb[j].y) + (vb[j].z * vb[j].z + vb[j].w * vb[j].w); }
    const float ra = 1.f / sqrtf(wave_sum(sa) * (1.f / D) + EPS), rb = 1.f / sqrtf(wave_sum(sb) * (1.f / D) + EPS);
    GAS unsigned long long* o8a = (GAS unsigned long long*)oa + lane; GAS unsigned long long* o8b = (GAS unsigned long long*)ob + lane;
#pragma unroll
    for (int j = 0; j < 4; ++j) o8a[64 * j] = (unsigned long long)pkbf(va[j].x * ra * gg[j].x, va[j].y * ra * gg[j].y) | ((unsigned long long)pkbf(va[j].z * ra * gg[j].z, va[j].w * ra * gg[j].w) << 32);
    if (hasb) {
#pragma unroll
        for (int j = 0; j < 4; ++j) o8b[64 * j] = (unsigned long long)pkbf(vb[j].x * rb * gg[j].x, vb[j].y * rb * gg[j].y) | ((unsigned long long)pkbf(vb[j].z * rb * gg[j].z, vb[j].w * rb * gg[j].w) << 32); }
}
__device__ __forceinline__ P0Item p0_item(Frame& F, int r) {
    constexpr int I_IN = 16 * (NIN / 64), I_OUT = 16 * 16, I_GU = NE * 16 * 32;
    P0Item it;
    if (r < I_IN) { const int nb = NIN / 64, kb = r / nb, nn = r % nb; const int pq = nn < 16; it = P0Item{F.w_in, (bf16*)(F.ws + WS_WIN), nullptr, NIN, 64 * kb, 64 * nn, pq ? 256 * (nn >> 2) + 32 * (nn & 3) : 64 * nn, 0, pq}; return it; } r -= I_IN;
    if (r < I_OUT) { const int kb = r / 16, nn = r % 16; it = P0Item{F.w_out, (bf16*)(F.ws + WS_WOUT), nullptr, D, 64 * kb, 64 * nn, 64 * nn, 0, 0}; return it; } r -= I_OUT;
    if (r < I_GU) { const int e = r / 512, q = r % 512, kb = q / 32, nn = q % 32;
        const int isup = nn >> 4, a = (nn & 15) * 64;
        it = P0Item{F.w_gu + (size_t)e * D * 2048, (bf16*)(F.ws + WS_WGU + (size_t)e * 2048 * D), F.norm2_g, 2048, 64 * kb, 64 * nn, 256 * (a >> 7) + 128 * isup + (a & 127), 1, 0}; return it; } r -= I_GU;
    { const int e = r / 256, q = r % 256, kb = q / 16, nn = q % 16;
        it = P0Item{F.w_d + (size_t)e * D * D, (bf16*)(F.ws + WS_WD + (size_t)e * D * D), nullptr, D, 64 * kb, 64 * nn, 64 * nn, 1, 0}; return it; }
}
constexpr int P0_NITEMS = 16 * (NIN / 64) + 16 * 16 + NE * 16 * 32 + NE * 16 * 16;
constexpr int P0_NLATE = 1024;
__device__ __forceinline__ void p0_items(Frame& F, int lo, int hi, int w, int nw) {
    LAS unsigned char* scr = F.lds + RING_OFF + F.wave * 16384;
    f32x4 va[16], vb[16]; int it = lo + w;
    if (it < hi) { P0Item A = p0_item(F, it); p0_load(A, va, F.lane);
        for (;;) {
            const int itb = it + nw; const bool hb = itb < hi; const P0Item B = p0_item(F, hb ? itb : it); p0_load(B, vb, F.lane); __builtin_amdgcn_sched_barrier(0);
            p0_store(A, va, scr, F.lane);
            if (!hb) break;
            it = itb + nw; const bool ha = it < hi; A = p0_item(F, ha ? it : itb); p0_load(A, va, F.lane); __builtin_amdgcn_sched_barrier(0);
            p0_store(B, vb, scr, F.lane);
            if (!ha) break;
        }
    }
}
__device__ __forceinline__ void p0_prologue(Frame& F) {
    p0_items(F, 0, P0_NITEMS - P0_NLATE, F.gw, F.ngw);
    for (int q = blockIdx.x * (NWAVES * 64) + F.tid; q < 4096; q += F.G * NWAVES * 64) {
        const int e = q & 31, k0 = (q >> 5) * 8; unsigned hi[8], lo[8];
#pragma unroll
        for (int j = 0; j < 8; ++j) { const float w = F.w_router[(k0 + j) * 32 + e] * F.norm2_g[k0 + j]; hi[j] = pkbf(w, 0.f) & 0xffffu; lo[j] = pkbf(w - bflo(hi[j]), 0.f) & 0xffffu; }
        const v4u h4 = {hi[0] | (hi[1] << 16), hi[2] | (hi[3] << 16), hi[4] | (hi[5] << 16), hi[6] | (hi[7] << 16)}, l4 = {lo[0] | (lo[1] << 16), lo[2] | (lo[3] << 16), lo[4] | (lo[5] << 16), lo[6] | (lo[7] << 16)};
        *(GAS v4u*)(F.ws + WS_RT + e * RT_ROW + 2 * k0) = h4; *(GAS v4u*)(F.ws + WS_RT + RT_WL + e * RT_ROW + 2 * k0) = l4; }
    for (int m = F.gw; m < T; m += 2 * F.ngw) rms_rows2_to_bf16(F.x + (size_t)m * D, F.x + (size_t)(m + F.ngw) * D, m + F.ngw < T, F.norm1_g, (bf16*)(F.ws + WS_XN) + (size_t)m * D, (bf16*)(F.ws + WS_XN) + (size_t)(m + F.ngw) * D, F.lane);
}

typedef float f32x16 __attribute__((ext_vector_type(16)));
typedef __bf16 bf16x2n __attribute__((ext_vector_type(2)));
typedef float f32x2n __attribute__((ext_vector_type(2)));
#define MFMA32(a, b, c) __builtin_amdgcn_mfma_f32_32x32x16_bf16((a), (b), (c), 0, 0, 0)
__device__ __forceinline__ bf16x8 pack8(float a0, float a1, float a2, float a3, float a4, float a5, float a6, float a7) { const v4u p = {pkbf(a0, a1), pkbf(a2, a3), pkbf(a4, a5), pkbf(a6, a7)}; return __builtin_bit_cast(bf16x8, p); }
constexpr float QSCALE = 0.125f * 1.44269504089f;
__device__ __forceinline__ void prep_phase(Frame& F) {
    LAS unsigned* tl = (LAS unsigned*)(F.lds + RING_OFF + F.wave * 16384);
    const bf16* P = (const bf16*)(F.ws + WS_P); bf16* Qn = (bf16*)(F.ws + WS_QN); bf16* Kn = (bf16*)(F.ws + WS_KN); bf16* VT = (bf16*)(F.ws + WS_VT);
    const int tr = F.lane >> 3, c8 = F.lane & 7;
    for (int it = F.gw; it < 4096; it += F.ngw) {
        const int bh = it & 127, blk = it >> 7, b = bh >> 3, h = bh & 7;
        const bf16* base = P + ((size_t)b * 8 + h) * SEQ * 64 + (size_t)(blk * 64 + tr) * 64 + 8 * c8;
        v4u rv[8];
#pragma unroll
        for (int i = 0; i < 8; ++i) { const bf16* row = base + (size_t)(8 * i) * 64; rv[i] = *(const GAS v4u*)(row + (size_t)2 * 16 * 8 * SEQ * 64); }
        {
#pragma unroll
            for (int i = 0; i < 8; ++i) { LAS unsigned* q = tl + (8 * i + tr) * 33 + 4 * c8; q[0] = rv[i].x; q[1] = rv[i].y; q[2] = rv[i].z; q[3] = rv[i].w; }
            LDS_WAIT(); asm volatile("" ::: "memory");
            const LAS unsigned short* t16 = (const LAS unsigned short*)tl; const int dr = tr;
#define KAP(pos) (((pos) & ~12) | (((pos) & 4) << 1) | (((pos) & 8) >> 1))
            bf16* const obase = VT + ((size_t)bh * 64 + blk * 2 + (c8 >> 2)) * 2048 + ((c8 >> 1) & 1) * 512 + (c8 & 1) * 256;
#pragma unroll
            for (int j = 0; j < 8; ++j) { unsigned val[8];
#pragma unroll
                for (int p = 0; p < 8; ++p) { const int pos = 8 * c8 + p; val[p] = t16[KAP(pos) * 66 + 8 * j + dr]; }
                v4u w4; w4.x = val[0] | (val[1] << 16); w4.y = val[2] | (val[3] << 16); w4.z = val[4] | (val[5] << 16); w4.w = val[6] | (val[7] << 16);
                *(GAS v4u*)(obase + (j >> 2) * 1024 + ((8 * j + dr) & 31) * 8) = w4; }
#undef KAP
            LDS_WAIT(); asm volatile("" ::: "memory");
        }
    }
}

__device__ __forceinline__ int crow16(int i, int hh) { return (i & 3) + 8 * (i >> 2) + 4 * hh; }
__device__ __forceinline__ void attn_item(Frame& F, int bh, int qb, float thr, const bf16x8 (&Lt)[2]) {
    const int r = F.lane & 31, hh = F.lane >> 5, b = bh >> 3, h = bh & 7, q0 = qb * 32;
    const bf16* Qn = (const bf16*)(F.ws + WS_QN); const bf16* Kn = (const bf16*)(F.ws + WS_KN); const bf16* VT = (const bf16*)(F.ws + WS_VT);
    bf16x8 qf[4];
#pragma unroll
    for (int s = 0; s < 4; ++s) qf[s] = *(const GAS bf16x8*)(Qn + ((size_t)bh * 64 + qb) * 2048 + s * 512 + F.lane * 8);
    f32x4 gout[2][4];
#pragma unroll
    for (int db = 0; db < 2; ++db)
#pragma unroll
        for (int gq = 0; gq < 4; ++gq) gout[db][gq] = *(const f32x4*)(F.sb_out_g + h * 64 + 32 * db + 8 * gq + 4 * hh);
    f32x16 O0, O1;
#pragma unroll
    for (int i = 0; i < 16; ++i) { O0[i] = 0.f; O1[i] = 0.f; }
    float carry = 0.f;
    const bf16* kbase = Kn + (size_t)bh * 64 * 2048 + F.lane * 8; const bf16* vbase = VT + (size_t)bh * 64 * 2048 + F.lane * 8;
#define ATT_LOAD(KF, VF, kb_) do { _Pragma("unroll") for (int s_ = 0; s_ < 4; ++s_) KF[s_] = *(const GAS bf16x8*)(kbase + (size_t)(kb_) * 2048 + 512 * s_); \
        _Pragma("unroll") for (int db_ = 0; db_ < 2; ++db_) _Pragma("unroll") for (int ks_ = 0; ks_ < 2; ++ks_) VF[db_][ks_] = *(const GAS bf16x8*)(vbase + (size_t)(kb_) * 2048 + 1024 * db_ + 512 * ks_); } while (0)
#define ATT_BLOCK(KF, VF, kb_) do { const bool diag = ((kb_) == qb); \
        f32x16 z; _Pragma("unroll") for (int i = 0; i < 16; ++i) z[i] = 0.f; \
        _Pragma("unroll") for (int s_ = 0; s_ < 4; ++s_) z = MFMA32(KF[s_], qf[s_], z); \
        float sp[16]; \
        _Pragma("unroll") for (int i = 0; i < 16; ++i) { const float zz = z[i]; float v = fmaxf(zz, 0.f) + __builtin_amdgcn_logf(1.f + __builtin_amdgcn_exp2f(-fabsf(zz))); if (diag && !(crow16(i, hh) < r)) v = 0.f; sp[i] = v; } \
        const bf16x8 sb0 = pack8(sp[0], sp[1], sp[2], sp[3], sp[4], sp[5], sp[6], sp[7]), sb1 = pack8(sp[8], sp[9], sp[10], sp[11], sp[12], sp[13], sp[14], sp[15]); \
        f32x16 Cc; _Pragma("unroll") for (int i = 0; i < 16; ++i) Cc[i] = carry; \
        Cc = MFMA32(Lt[0], sb0, Cc); Cc = MFMA32(Lt[1], sb1, Cc); \
        float w[16]; \
        _Pragma("unroll") for (int i = 0; i < 16; ++i) { float v = __builtin_amdgcn_exp2f(z[i] - Cc[i]); if (diag && !(crow16(i, hh) < r)) v = 0.f; w[i] = v; } \
        const bf16x8 wb0 = pack8(w[0], w[1], w[2], w[3], w[4], w[5], w[6], w[7]), wb1 = pack8(w[8], w[9], w[10], w[11], w[12], w[13], w[14], w[15]); \
        O0 = MFMA32(VF[0][0], wb0, O0); O0 = MFMA32(VF[0][1], wb1, O0); O1 = MFMA32(VF[1][0], wb0, O1); O1 = MFMA32(VF[1][1], wb1, O1); \
        carry = __shfl(Cc[0], r); } while (0)
    bf16x8 kfA[4], vfA[2][2], kfB[4], vfB[2][2];
    ATT_LOAD(kfA, vfA, qb);
    for (int kb = qb; kb >= 0; kb -= 2) {
        ATT_LOAD(kfB, vfB, kb > 0 ? kb - 1 : 0); __builtin_amdgcn_sched_barrier(0);
        ATT_BLOCK(kfA, vfA, kb);
        if (kb == 0 || __all(carry > thr)) break;
        ATT_LOAD(kfA, vfA, kb > 1 ? kb - 2 : 0); __builtin_amdgcn_sched_barrier(0);
        ATT_BLOCK(kfB, vfB, kb - 1);
        if (__all(carry > thr)) break;
    }
#undef ATT_LOAD
#undef ATT_BLOCK
    float ss = 0.f;
#pragma unroll
    for (int i = 0; i < 16; ++i) ss += O0[i] * O0[i] + O1[i] * O1[i];
    ss += __shfl_xor(ss, 32);
    const float rs = 1.f / sqrtf(ss * (1.f / 64.f) + EPS);
    bf16* orow = (bf16*)(F.ws + WS_MIX) + ((size_t)b * SEQ + q0 + r) * D + h * 64;
#pragma unroll
    for (int db = 0; db < 2; ++db)
#pragma unroll
        for (int gq = 0; gq < 4; ++gq) { const int d = 32 * db + 8 * gq + 4 * hh; const f32x4 gg = gout[db][gq];
            const float a0 = (db ? O1[4 * gq + 0] : O0[4 * gq + 0]) * rs * gg.x, a1 = (db ? O1[4 * gq + 1] : O0[4 * gq + 1]) * rs * gg.y, a2 = (db ? O1[4 * gq + 2] : O0[4 * gq + 2]) * rs * gg.z, a3 = (db ? O1[4 * gq + 3] : O0[4 * gq + 3]) * rs * gg.w;
            *(GAS unsigned long long*)(orow + d) = (unsigned long long)pkbf(a0, a1) | ((unsigned long long)pkbf(a2, a3) << 32); }
}
__device__ __forceinline__ void attn_phase(Frame& F) {
    const int r = F.lane & 31, hh = F.lane >> 5;
    float mq = fabsf(F.sb_q_g[F.lane]), mk = fabsf(F.sb_k_g[F.lane]);
#pragma unroll
    for (int o = 1; o < 64; o <<= 1) { mq = fmaxf(mq, __shfl_xor(mq, o)); mk = fmaxf(mk, __shfl_xor(mk, o)); }
    const float thr = 64.f * QSCALE * mq * mk * 1.02f + 170.f;
    bf16x8 Lt[2];
#pragma unroll
    for (int ks = 0; ks < 2; ++ks) { float e[8];
#pragma unroll
        for (int jj = 0; jj < 8; ++jj) e[jj] = (16 * ks + 8 * (jj >> 2) + 4 * hh + (jj & 3) >= r) ? 1.f : 0.f;
        Lt[ks] = pack8(e[0], e[1], e[2], e[3], e[4], e[5], e[6], e[7]); }
    for (int it = F.gw; it < 2048; it += F.ngw) { const int bh = it & 127, j = it >> 7;
        attn_item(F, bh, 63 - j, thr, Lt); attn_item(F, bh, j, thr, Lt); attn_item(F, bh, 47 - j, thr, Lt); attn_item(F, bh, 16 + j, thr, Lt); }
}

constexpr int HG_PART = 0, HG_SSQ = 2048, HG_QE = 4096, HG_KE = HG_QE + 64 * 272, HG_VT = HG_KE + 64 * 272, HG_KST = HG_VT + 128 * 144, HG_ST = HG_KST + 128 * 144, HG_END = HG_ST + 128 * 272;
static_assert(HG_END <= RING_BYTES, "HGRN2 LDS map");
__device__ __forceinline__ float hg_lbound(Frame& F, int h, int d) { const int c = h * 128 + d; return 1.f / (1.f + __expf(F.hg_lb[512 + c] - F.hg_lb[c])); }
__device__ __forceinline__ void hg_gates(Frame& F, const unsigned short (&ffr)[16], float lb, int d, int tq, float (&bb)[16], float (&kk)[16], float& total) {
    float run = 1.f;
#pragma unroll
    for (int i = 0; i < 16; ++i) { const float ff = bf2f(ffr[i]); const float sg = __builtin_amdgcn_rcpf(1.f + __expf(-ff));
        const float f = lb + (1.f - lb) * sg; kk[i] = (1.f - lb) * (1.f - sg); run *= f; bb[i] = run; }
    LAS float* part = (LAS float*)(F.lds + RING_OFF + HG_PART);
    part[tq * 128 + d] = run;
    __syncthreads();
    const float p0 = part[d], p1 = part[128 + d], p2 = part[256 + d], p3 = part[384 + d];
    const float off = (tq > 0 ? p0 : 1.f) * (tq > 1 ? p1 : 1.f) * (tq > 2 ? p2 : 1.f);
    total = (p0 * p1) * (p2 * p3);
#pragma unroll
    for (int i = 0; i < 16; ++i) bb[i] *= off;
}
#define HG_HV() const bf16* const PHp = (const bf16*)(F.ws + WS_PH); \
    const __amdgpu_buffer_rsrc_t rsrcP = __builtin_amdgcn_make_buffer_rsrc((void*)PHp, 0, (int)((size_t)4 * T * 512 * 2), 0x00020000)
#define HG_SOFF(item_, arr_) ((unsigned)((((arr_) * 16 + (((item_) >> 5) >> 2)) * 4 + (((item_) >> 5) & 3)) * SEQ + ((item_) & 31) * 64) * 256u)
#define HG_ARR(col_) ((col_) == OFF_HQ ? 0 : (col_) == OFF_HF ? 1 : (col_) == OFF_HI ? 2 : 3)
#define HG_LOADT(dst2, item_, arr_) do { const unsigned so_ = (unsigned)__builtin_amdgcn_readfirstlane((int)HG_SOFF(item_, arr_)); _Pragma("unroll") for (int j_ = 0; j_ < 2; ++j_) \
        (dst2)[j_] = __builtin_bit_cast(v4u, __builtin_amdgcn_raw_buffer_load_b128(rsrcP, (unsigned)F.tid * 16u + 8192u * j_, so_, 0)); } while (0)
#define HG_PUT(src2, raw_) do { _Pragma("unroll") for (int j_ = 0; j_ < 2; ++j_) *(LAS v4u*)((raw_) + ((F.tid >> 4) + 32 * j_) * 272 + (F.tid & 15) * 16) = (src2)[j_]; } while (0)
#define HG_COL(dst, raw_) do { _Pragma("unroll") for (int i_ = 0; i_ < 16; ++i_) dst[i_] = *(const LAS unsigned short*)((raw_) + (16 * tq + i_) * 272 + 2 * d); } while (0)
template <bool PERMUTE> __device__ __forceinline__ void st16(LAS unsigned char* dst, const float (&v)[16]) {
    v4u a, b2;
    if (!PERMUTE) { a.x = pkbf(v[0], v[1]); a.y = pkbf(v[2], v[3]); a.z = pkbf(v[4], v[5]); a.w = pkbf(v[6], v[7]); b2.x = pkbf(v[8], v[9]); b2.y = pkbf(v[10], v[11]); b2.z = pkbf(v[12], v[13]); b2.w = pkbf(v[14], v[15]); }
    else { a.x = pkbf(v[0], v[1]); a.y = pkbf(v[2], v[3]); a.z = pkbf(v[8], v[9]); a.w = pkbf(v[10], v[11]); b2.x = pkbf(v[4], v[5]); b2.y = pkbf(v[6], v[7]); b2.z = pkbf(v[12], v[13]); b2.w = pkbf(v[14], v[15]); }
    *(LAS v4u*)dst = a; *(LAS v4u*)(dst + 16) = b2;
}
__device__ __forceinline__ void hgA_phase(Frame& F) {
    const int d = F.tid & 127, tq = F.tid >> 7, r = F.lane & 31, hh = F.lane >> 5;
    const bf16* P = (const bf16*)(F.ws + WS_P); bf16* KVS = (bf16*)(F.ws + WS_KVS); float* DEC = (float*)(F.ws + WS_DEC); float* SSEG = (float*)(F.ws + WS_SSEG); float* DSEG = (float*)(F.ws + WS_DSEG);
    LAS unsigned char* L = F.lds + RING_OFF; LAS float* decl = (LAS float*)(L + HG_SSQ);
    HG_HV();
    v4u rf[2], rv[2];
    LAS unsigned char* const RAWF = F.lds + ROWTAB_OFF; LAS unsigned char* const RAWV = L + HG_ST;
    for (int wg = blockIdx.x; wg < 256; wg += F.G) {
        const int bh = wg >> 2, seg = wg & 3, item0 = bh * 32 + seg * 8, h = bh & 3;
        HG_LOADT(rf, item0, 1); HG_LOADT(rv, item0, 2);
        const float lbv = hg_lbound(F, h, d); float totrun = 1.f;
        const int db = F.wave & 3, eb0 = 2 * (F.wave >> 2);
        f32x16 run0, run1;
#pragma unroll
        for (int i = 0; i < 16; ++i) { run0[i] = 0.f; run1[i] = 0.f; }
      for (int k = 0; k < 8; ++k) {
        const int item = item0 + k;
        HG_PUT(rf, RAWF); HG_PUT(rv, RAWV);
        __syncthreads();
        { const int nit = k < 7 ? item + 1 : item; HG_LOADT(rf, nit, 1); HG_LOADT(rv, nit, 2); __builtin_amdgcn_sched_barrier(0); }
        unsigned short ffr[16], vr[16]; HG_COL(ffr, RAWF); HG_COL(vr, RAWV);
        float bb[16], kk[16], total; hg_gates(F, ffr, lbv, d, tq, bb, kk, total);
        float ks[16], vv[16];
#pragma unroll
        for (int i = 0; i < 16; ++i) { ks[i] = kk[i] * (total * __builtin_amdgcn_rcpf(bb[i])); vv[i] = bf2f(vr[i]); }
        st16<false>(L + HG_KST + d * 144 + tq * 32, ks); st16<false>(L + HG_VT + d * 144 + tq * 32, vv);
        const float dc = total; totrun *= total;
        if (tq == 0) { DEC[(size_t)item * 128 + d] = dc; decl[d] = dc; }
        __syncthreads();
        f32x16 acc0, acc1;
#pragma unroll
        for (int i = 0; i < 16; ++i) { acc0[i] = 0.f; acc1[i] = 0.f; }
#pragma unroll
        for (int s = 0; s < 4; ++s) { const bf16x8 af = *(const LAS bf16x8*)(L + HG_KST + (db * 32 + r) * 144 + 32 * s + 16 * hh);
            const bf16x8 b0 = *(const LAS bf16x8*)(L + HG_VT + (eb0 * 32 + r) * 144 + 32 * s + 16 * hh), b1 = *(const LAS bf16x8*)(L + HG_VT + ((eb0 + 1) * 32 + r) * 144 + 32 * s + 16 * hh);
            acc0 = MFMA32(af, b0, acc0); acc1 = MFMA32(af, b1, acc1); }
#pragma unroll
        for (int g = 0; g < 4; ++g) { const f32x4 dl = *(const LAS f32x4*)(decl + db * 32 + 8 * g + 4 * hh);
#pragma unroll
            for (int ii = 0; ii < 4; ++ii) { run0[4 * g + ii] = dl[ii] * run0[4 * g + ii] + acc0[4 * g + ii]; run1[4 * g + ii] = dl[ii] * run1[4 * g + ii] + acc1[4 * g + ii]; } }
#pragma unroll
        for (int j = 0; j < 2; ++j) { bf16* dst = KVS + ((size_t)item * 128 + (eb0 + j) * 32 + r) * 128 + db * 32 + 4 * hh;
#pragma unroll
            for (int g = 0; g < 4; ++g) { const float a0 = j ? acc1[4 * g + 0] : acc0[4 * g + 0], a1 = j ? acc1[4 * g + 1] : acc0[4 * g + 1], a2 = j ? acc1[4 * g + 2] : acc0[4 * g + 2], a3 = j ? acc1[4 * g + 3] : acc0[4 * g + 3];
                *(GAS unsigned long long*)(dst + 8 * g) = (unsigned long long)pkbf(a0, a1) | ((unsigned long long)pkbf(a2, a3) << 32); } }
        __syncthreads();
      }
#pragma unroll
        for (int j = 0; j < 2; ++j) { float* dst = SSEG + ((size_t)wg * 128 + (eb0 + j) * 32 + r) * 128 + db * 32 + 4 * hh;
#pragma unroll
            for (int g = 0; g < 4; ++g) *(GAS f32x4*)(dst + 8 * g) = j ? (f32x4){run1[4 * g + 0], run1[4 * g + 1], run1[4 * g + 2], run1[4 * g + 3]} : (f32x4){run0[4 * g + 0], run0[4 * g + 1], run0[4 * g + 2], run0[4 * g + 3]}; }
        if (tq == 0) DSEG[(size_t)wg * 128 + d] = totrun;
    }
}
constexpr int HG_DECS = HG_END;
static_assert(HG_DECS + 4096 + 64 * 272 <= LDSCTL_OFF && HG_KST + 64 * 272 <= HG_ST && 64 * 272 <= MAXSLOT * 1536, "HGRN2 LDS map (decays, raw tiles)");
__device__ __forceinline__ void hgC_phase(Frame& F) {
    const int d = F.tid & 127, tq = F.tid >> 7, r = F.lane & 31, hh = F.lane >> 5;
    const bf16* P = (const bf16*)(F.ws + WS_P); const bf16* KVS = (const bf16*)(F.ws + WS_KVS); bf16* MIX = (bf16*)(F.ws + WS_MIX); const float* DEC = (const float*)(F.ws + WS_DEC);
    HG_HV();
    LAS unsigned char* L = F.lds + RING_OFF; const LAS float* decs = (const LAS float*)(L + HG_DECS);
    const int se = F.tid >> 2, sq = F.tid & 3;
    v4u rf[2], rq[2], rv[2], st[4];
    LAS unsigned char* const RAWF = L + HG_KST; LAS unsigned char* const RAWQ = F.lds + ROWTAB_OFF; LAS unsigned char* const RAWV = L + HG_DECS + 4096;
    const __amdgpu_buffer_rsrc_t rsrcG = __builtin_amdgcn_make_buffer_rsrc((void*)F.hg_out_g, 0, 512 * 4, 0x00020000), rsrcSS = __builtin_amdgcn_make_buffer_rsrc((void*)(F.ws + WS_SSEG), 0, 256 * 128 * 128 * 4, 0x00020000), rsrcDS = __builtin_amdgcn_make_buffer_rsrc((void*)(F.ws + WS_DSEG), 0, 256 * 128 * 4, 0x00020000);
    const __amdgpu_buffer_rsrc_t rsrcD = __builtin_amdgcn_make_buffer_rsrc((void*)DEC, 0, 64 * 32 * 128 * 4, 0x00020000), rsrcM = __builtin_amdgcn_make_buffer_rsrc((void*)MIX, 0, (int)((size_t)T * D * 2), 0x00020000);
    const __amdgpu_buffer_rsrc_t rsrcK = __builtin_amdgcn_make_buffer_rsrc((void*)KVS, 0, 64 * 32 * 128 * 128 * 2, 0x00020000); const unsigned kvo = (unsigned)((se * 128 + sq * 32) * 2);
#define HG_LOADKV(dst_, item_) do { const unsigned so_ = (unsigned)__builtin_amdgcn_readfirstlane((int)((item_) * (128 * 128 * 2))); _Pragma("unroll") for (int j_ = 0; j_ < 4; ++j_) (dst_)[j_] = __builtin_bit_cast(v4u, __builtin_amdgcn_raw_buffer_load_b128(rsrcK, kvo + 16u * j_, so_, 0)); } while (0)
#define HG_LOADST(item_) HG_LOADKV(st, item_)
#define HG_FOLD(kv_, c_) do { _Pragma("unroll") for (int j_ = 0; j_ < 4; ++j_) { const f32x4 d0_ = *(const LAS f32x4*)(decs + (c_) * 128 + sq * 32 + 8 * j_), d1_ = *(const LAS f32x4*)(decs + (c_) * 128 + sq * 32 + 8 * j_ + 4); const v4u k_ = (kv_)[j_]; \
        S[8 * j_ + 0] = d0_.x * S[8 * j_ + 0] + bflo(k_.x); S[8 * j_ + 1] = d0_.y * S[8 * j_ + 1] + bfhi(k_.x); S[8 * j_ + 2] = d0_.z * S[8 * j_ + 2] + bflo(k_.y); S[8 * j_ + 3] = d0_.w * S[8 * j_ + 3] + bfhi(k_.y); \
        S[8 * j_ + 4] = d1_.x * S[8 * j_ + 4] + bflo(k_.z); S[8 * j_ + 5] = d1_.y * S[8 * j_ + 5] + bfhi(k_.z); S[8 * j_ + 6] = d1_.z * S[8 * j_ + 6] + bflo(k_.w); S[8 * j_ + 7] = d1_.w * S[8 * j_ + 7] + bfhi(k_.w); } } while (0)
    for (int wg = blockIdx.x; wg < 256; wg += F.G) {
        const int bh = wg >> 2, seg = wg & 3, item0 = bh * 32 + seg * 8, b = bh >> 2, h = bh & 3;
        HG_LOADT(rf, item0, 1); HG_LOADT(rq, item0, 0); HG_LOADT(rv, item0, 2); HG_LOADST(item0);
        const unsigned dso0 = (unsigned)__builtin_amdgcn_readfirstlane((bh * 32 + seg * 8) * 128 * 4);
        const f32x4 decv = __builtin_bit_cast(f32x4, __builtin_amdgcn_raw_buffer_load_b128(rsrcD, (unsigned)(F.tid & 255) * 16u, dso0, 0));
        const float lbv = hg_lbound(F, h, d);
        __builtin_amdgcn_sched_barrier(0);
        float S[32];
#pragma unroll
        for (int j = 0; j < 32; ++j) S[j] = 0.f;
        for (int sp = 0; sp < seg; ++sp) {
            const unsigned sso = (unsigned)__builtin_amdgcn_readfirstlane((bh * 4 + sp) * 128 * 128 * 4), dso = (unsigned)__builtin_amdgcn_readfirstlane((bh * 4 + sp) * 128 * 4);
#pragma unroll
            for (int j0 = 0; j0 < 8; j0 += 8) { f32x4 sv[8], dv[8];
#pragma unroll
                for (int j = 0; j < 8; ++j) { sv[j] = __builtin_bit_cast(f32x4, __builtin_amdgcn_raw_buffer_load_b128(rsrcSS, (unsigned)((se * 128 + sq * 32) * 4) + 16u * (j0 + j), sso, 0));
                    dv[j] = __builtin_bit_cast(f32x4, __builtin_amdgcn_raw_buffer_load_b128(rsrcDS, (unsigned)(sq * 32 * 4) + 16u * (j0 + j), dso, 0)); }
#pragma unroll
                for (int j = 0; j < 8; ++j) { const int q = 4 * (j0 + j); S[q + 0] = dv[j].x * S[q + 0] + sv[j].x; S[q + 1] = dv[j].y * S[q + 1] + sv[j].y; S[q + 2] = dv[j].z * S[q + 2] + sv[j].z; S[q + 3] = dv[j].w * S[q + 3] + sv[j].w; } }
        }
        if (F.tid < 256) *((LAS f32x4*)(L + HG_DECS) + F.tid) = decv;
        __syncthreads();
      for (int k = 0; k < 8; ++k) {
        const int item = item0 + k, c = seg * 8 + k;
        const int tb = F.wave & 1, eb = F.wave >> 1;
        const int nit = k < 7 ? item + 1 : item;
        HG_PUT(rf, RAWF); HG_PUT(rq, RAWQ); HG_PUT(rv, RAWV);
        __syncthreads();
        HG_LOADT(rf, nit, 1); HG_LOADT(rq, nit, 0); HG_LOADT(rv, nit, 2); __builtin_amdgcn_sched_barrier(0);
        unsigned short ffr[16], qr[16], vr[16]; HG_COL(ffr, RAWF); HG_COL(qr, RAWQ); HG_COL(vr, RAWV);
        float bb[16], kk[16], total; hg_gates(F, ffr, lbv, d, tq, bb, kk, total);
        float vv[16];
#pragma unroll
        for (int i = 0; i < 16; ++i) { const int t = 16 * tq + i; const float q = bf2f(qr[i]);
            *(LAS unsigned short*)(L + HG_QE + t * 272 + 2 * d) = (unsigned short)pkbf(q * bb[i], 0.f);
            *(LAS unsigned short*)(L + HG_KE + t * 272 + 2 * d) = (unsigned short)pkbf(kk[i] * __builtin_amdgcn_rcpf(bb[i]), 0.f);
            vv[i] = bf2f(vr[i]); }
        st16<true>(L + HG_VT + d * 144 + tq * 32, vv);
#pragma unroll
        for (int j = 0; j < 4; ++j) { v4u w4; w4.x = pkbf(S[8 * j + 0], S[8 * j + 1]); w4.y = pkbf(S[8 * j + 2], S[8 * j + 3]); w4.z = pkbf(S[8 * j + 4], S[8 * j + 5]); w4.w = pkbf(S[8 * j + 6], S[8 * j + 7]);
            *(LAS v4u*)(L + HG_ST + se * 272 + sq * 64 + 16 * j) = w4; }
        HG_FOLD(st, k);
        unsigned long long grv[4];
        { const bf16* grow_ = PHp + (((size_t)(3 * 16 + b) * 4 + h) * SEQ + c * 64 + tb * 32 + r) * 128;
#pragma unroll
            for (int g = 0; g < 4; ++g) grv[g] = *(const GAS unsigned long long*)(grow_ + eb * 32 + 8 * g + 4 * hh); }
        HG_LOADST(nit); __builtin_amdgcn_sched_barrier(0);
        __syncthreads();
        f32x16 acc;
#pragma unroll
        for (int i = 0; i < 16; ++i) acc[i] = 0.f;
#define HG_QF(s_) (*(const LAS bf16x8*)(L + HG_QE + (tb * 32 + r) * 272 + 32 * (s_) + 16 * hh))
#pragma unroll
        for (int s = 0; s < 8; ++s) acc = MFMA32(*(const LAS bf16x8*)(L + HG_ST + (eb * 32 + r) * 272 + 32 * s + 16 * hh), HG_QF(s), acc);
        for (int sb = 0; sb <= tb; ++sb) {
            f32x16 at;
#pragma unroll
            for (int i = 0; i < 16; ++i) at[i] = 0.f;
#pragma unroll
            for (int s = 0; s < 8; ++s) at = MFMA32(*(const LAS bf16x8*)(L + HG_KE + (sb * 32 + r) * 272 + 32 * s + 16 * hh), HG_QF(s), at);
            float a[16];
#pragma unroll
            for (int i = 0; i < 16; ++i) a[i] = (sb < tb || crow16(i, hh) <= r) ? at[i] : 0.f;
            const bf16x8 ab0 = pack8(a[0], a[1], a[2], a[3], a[4], a[5], a[6], a[7]), ab1 = pack8(a[8], a[9], a[10], a[11], a[12], a[13], a[14], a[15]);
            acc = MFMA32(*(const LAS bf16x8*)(L + HG_VT + (eb * 32 + r) * 144 + sb * 64 + 0 + 16 * hh), ab0, acc);
            acc = MFMA32(*(const LAS bf16x8*)(L + HG_VT + (eb * 32 + r) * 144 + sb * 64 + 32 + 16 * hh), ab1, acc);
        }
        float ss = 0.f;
#pragma unroll
        for (int i = 0; i < 16; ++i) ss += acc[i] * acc[i];
        ss += __shfl_xor(ss, 32);
        LAS float* ssq = (LAS float*)(L + HG_SSQ);
        if (hh == 0) ssq[eb * 64 + tb * 32 + r] = ss;
        f32x4 ggv[4];
        { const unsigned so = (unsigned)__builtin_amdgcn_readfirstlane(h * 512);
#pragma unroll
            for (int g = 0; g < 4; ++g) ggv[g] = __builtin_bit_cast(f32x4, __builtin_amdgcn_raw_buffer_load_b128(rsrcG, (unsigned)((eb * 32 + 8 * g + 4 * hh) * 4), so, 0)); }
        __syncthreads();
        const int tl = tb * 32 + r; const float tot = (ssq[tl] + ssq[64 + tl]) + (ssq[128 + tl] + ssq[192 + tl]);
        const float rs = 1.f / sqrtf(tot * (1.f / 128.f) + EPS);
        const unsigned mso = (unsigned)__builtin_amdgcn_readfirstlane((int)((((unsigned)b * SEQ + c * 64) * D + 512 + h * 128) * 2)), mvo = (unsigned)((tl * D + eb * 32 + 4 * hh) * 2);
#pragma unroll
        for (int g = 0; g < 4; ++g) { const int e = eb * 32 + 8 * g + 4 * hh; const unsigned long long gr = grv[g]; const f32x4 gg = ggv[g];
            const float g0 = bflo((unsigned)gr), g1 = bfhi((unsigned)gr), g2 = bflo((unsigned)(gr >> 32)), g3 = bfhi((unsigned)(gr >> 32));
            const float y0 = acc[4 * g + 0] * rs * gg.x * (g0 * __builtin_amdgcn_rcpf(1.f + __expf(-g0))), y1 = acc[4 * g + 1] * rs * gg.y * (g1 * __builtin_amdgcn_rcpf(1.f + __expf(-g1)));
            const float y2 = acc[4 * g + 2] * rs * gg.z * (g2 * __builtin_amdgcn_rcpf(1.f + __expf(-g2))), y3 = acc[4 * g + 3] * rs * gg.w * (g3 * __builtin_amdgcn_rcpf(1.f + __expf(-g3)));
            typedef unsigned u32x2_t __attribute__((ext_vector_type(2))); __builtin_amdgcn_raw_buffer_store_b64((u32x2_t){pkbf(y0, y1), pkbf(y2, y3)}, rsrcM, mvo + 16u * g, mso, 0); }
        __syncthreads();
      }
    }
#undef HG_LOADST
#undef HG_LOADKV
#undef HG_FOLD
#undef HG_QF
}
#undef HG_LOADT
#undef HG_PUT
#undef HG_COL
#undef HG_ARR
#undef HG_SOFF
#undef HG_HV

__device__ __forceinline__ void router_phase(Frame& F) {
    LAS unsigned char* L = F.lds; const int r = F.lane & 31, hh = F.lane >> 5;
    LAS unsigned* lcnt = (LAS unsigned*)(F.lds + LTAB_OFF) + LT_MISC; LAS unsigned* lbase = lcnt + 32; LAS float* lrstd = (LAS float*)(F.lds + ROWTAB_OFF);
    float* TOPG = (float*)(F.ws + WS_TOPG);
    {
        const GAS v4u* img = (const GAS v4u*)(F.ws + WS_RT) + vzero();
        constexpr int NB = (RT_END / 16 + NWAVES * 64 - 1) / (NWAVES * 64);
        v4u t4[NB];
#pragma unroll
        for (int j = 0; j < NB; ++j) { const int q = F.tid + j * NWAVES * 64; t4[j] = img[q < RT_END / 16 ? q : 0]; }
#pragma unroll
        for (int j = 0; j < NB; ++j) { const int q = F.tid + j * NWAVES * 64; if (q < RT_END / 16) *(LAS v4u*)(L + 16 * q) = t4[j]; }
    }
    const bf16* XH = (const bf16*)(F.ws + WS_XN); int* LIST = (int*)(F.ws + WS_LIST); unsigned* cnt = (unsigned*)(F.ctl + CW_CNT);
    for (int base = blockIdx.x * 4; base < T / 32; base += F.G * 4) {
        const int grp = base + F.wave; const bool active = F.wave < 4 && grp < T / 32;
        if (F.tid < 32) lcnt[F.tid] = 0u;
        __syncthreads();
        float sv[4] = {0.f, 0.f, 0.f, 0.f}; int se[4] = {0, 0, 0, 0}; unsigned lp0 = 0u, lp1 = 0u; float rstd = 0.f; const int tok = grp * 32 + r;
        if (active) {
            const bf16* hrow = XH + (size_t)tok * D + 8 * hh;
            f32x16 acc;
#pragma unroll
            for (int i = 0; i < 16; ++i) acc[i] = 0.f;
            float ssq = 0.f;
#pragma unroll 16
            for (int s = 0; s < 64; ++s) {
                const v4u hu = *(const GAS v4u*)(hrow + 16 * s); const bf16x8 hi = __builtin_bit_cast(bf16x8, hu);
                { const float a0 = bflo(hu.x), a1 = bfhi(hu.x), a2 = bflo(hu.y), a3 = bfhi(hu.y), a4 = bflo(hu.z), a5 = bfhi(hu.z), a6 = bflo(hu.w), a7 = bfhi(hu.w);
                    ssq += (a0 * a0 + a1 * a1) + (a2 * a2 + a3 * a3) + (a4 * a4 + a5 * a5) + (a6 * a6 + a7 * a7); }
                const bf16x8 wh = *(const LAS bf16x8*)(L + r * RT_ROW + 32 * s + 16 * hh), wl = *(const LAS bf16x8*)(L + RT_WL + r * RT_ROW + 32 * s + 16 * hh);
                acc = MFMA32(wh, hi, acc); acc = MFMA32(wl, hi, acc);
            }
            ssq += __shfl_xor(ssq, 32);
            rstd = 1.f / sqrtf(ssq * (1.f / D) + EPS);
            float l[16];
#pragma unroll
            for (int i = 0; i < 16; ++i) l[i] = acc[i] * rstd + F.b_router[crow16(i, hh)];
            float cv[8]; int ce[8];
#pragma unroll
            for (int rnd = 0; rnd < 4; ++rnd) { float bv = l[0]; int bi = 0;
#pragma unroll
                for (int i = 1; i < 16; ++i) if (l[i] > bv) { bv = l[i]; bi = i; }
                cv[rnd] = bv; ce[rnd] = crow16(bi, hh);
#pragma unroll
                for (int i = 0; i < 16; ++i) if (i == bi) l[i] = -__builtin_inff(); }
#pragma unroll
            for (int j = 0; j < 4; ++j) { cv[4 + j] = __shfl_xor(cv[j], 32); ce[4 + j] = __shfl_xor(ce[j], 32); }
#pragma unroll
            for (int rnd = 0; rnd < 4; ++rnd) { float bv = cv[0]; int be = ce[0]; int bj = 0;
#pragma unroll
                for (int j = 1; j < 8; ++j) if (cv[j] > bv || (cv[j] == bv && ce[j] < be)) { bv = cv[j]; be = ce[j]; bj = j; }
                sv[rnd] = bv; se[rnd] = be;
#pragma unroll
                for (int j = 0; j < 8; ++j) if (j == bj) { cv[j] = -__builtin_inff(); ce[j] = 64; } }
            lp0 = __hip_atomic_fetch_add(lcnt + (hh ? se[2] : se[0]), 1u, __ATOMIC_RELAXED, __HIP_MEMORY_SCOPE_WORKGROUP);
            lp1 = __hip_atomic_fetch_add(lcnt + (hh ? se[3] : se[1]), 1u, __ATOMIC_RELAXED, __HIP_MEMORY_SCOPE_WORKGROUP);
        }
        __syncthreads();
        if (F.tid < 32) lbase[F.tid] = __hip_atomic_fetch_add(cnt + F.tid, lcnt[F.tid], __ATOMIC_RELAXED, __HIP_MEMORY_SCOPE_AGENT);
        __syncthreads();
        if (active) {
            const float e1 = __expf(sv[1] - sv[0]), e2 = __expf(sv[2] - sv[0]), e3 = __expf(sv[3] - sv[0]); const float inv = 1.f / (1.f + e1 + e2 + e3);
            const int ea = hh ? se[2] : se[0], eb = hh ? se[3] : se[1]; const float ga = (hh ? e2 : 1.f) * inv, gb = (hh ? e3 : e1) * inv;
            const size_t ia = (size_t)ea * 32768 + lbase[ea] + lp0, ib = (size_t)eb * 32768 + lbase[eb] + lp1;
            LIST[ia] = tok * 4 + 2 * hh; LIST[ib] = tok * 4 + 2 * hh + 1; TOPG[tok * 4 + 2 * hh] = ga; TOPG[tok * 4 + 2 * hh + 1] = gb;
            if (hh == 0) lrstd[F.wave * 32 + r] = rstd;
        }
        __syncthreads();
        {
            unsigned char* X8 = F.ws + WS_X8; const int t0 = base * 32;
#pragma unroll
            for (int q0 = 0; q0 < 16; q0 += 4) { v4u a[4][2];
#pragma unroll
                for (int q = 0; q < 4; ++q) { const int tt = t0 + F.wave * 16 + q0 + q; const GAS v4u* p = (const GAS v4u*)(XH + (size_t)(tt < T ? tt : 0) * D) + 2 * F.lane; a[q][0] = p[0]; a[q][1] = p[1]; }
#pragma unroll
                for (int q = 0; q < 4; ++q) { const int tl = F.wave * 16 + q0 + q, tt = t0 + tl; if (tt < T) { const float rs = lrstd[tl]; v4u o;
                    o.x = pg8::pk4_fp8(bflo(a[q][0].x) * rs, bfhi(a[q][0].x) * rs, bflo(a[q][0].y) * rs, bfhi(a[q][0].y) * rs); o.y = pg8::pk4_fp8(bflo(a[q][0].z) * rs, bfhi(a[q][0].z) * rs, bflo(a[q][0].w) * rs, bfhi(a[q][0].w) * rs);
                    o.z = pg8::pk4_fp8(bflo(a[q][1].x) * rs, bfhi(a[q][1].x) * rs, bflo(a[q][1].y) * rs, bfhi(a[q][1].y) * rs); o.w = pg8::pk4_fp8(bflo(a[q][1].z) * rs, bfhi(a[q][1].z) * rs, bflo(a[q][1].w) * rs, bfhi(a[q][1].w) * rs);
                    *((GAS v4u*)(X8 + (size_t)tt * D) + F.lane) = o; } } }
        }
        __syncthreads();
    }
}
__device__ __forceinline__ int build_moe_tables(Frame& F, int ntn, int mode) {
    LAS int* lt = (LAS int*)(F.lds + LTAB_OFF);
    if (F.wave == 0) {
        const int e = F.lane & 31; const int c = (int)__hip_atomic_load((unsigned*)(F.ctl + CW_CNT) + e, __ATOMIC_RELAXED, __HIP_MEMORY_SCOPE_AGENT);
        const int tl = (c + 255) >> 8; int inc = tl;
#pragma unroll
        for (int off = 1; off < 32; off <<= 1) { const int o = __shfl_up(inc, off, 32); if (e >= off) inc += o; }
        const int tot = __shfl(inc, 31, 32), t0 = inc - tl;
        if (F.lane < 32) { lt[LT_TS + e] = t0; lt[LT_CNT + e] = c; for (int i = 0; i < tl; ++i) lt[t0 + i] = e; }
        if (F.lane == 0) lt[LT_MISC + 64] = tot;
    }
    __syncthreads();
    int nt = lt[LT_MISC + 64]; nt = nt < 0 ? 0 : (nt > MAXTILES ? MAXTILES : nt); nt = __builtin_amdgcn_readfirstlane(nt);
    const int* LIST = (const int*)(F.ws + WS_LIST);
    const int nslot = mode == 1 ? MAXSLOT : (MAXTILES * 4 + 255) / 256;
    for (int q = F.tid; q < nslot * 256; q += NWAVES * 64) { const int i = q >> 8, rr = q & 255; const int Lu = i * F.G + F.vcu;
        int li = -1; float bias = 0.f;
        if (Lu < nt * ntn) { const int pm0 = Lu / ntn, pl = Lu - pm0 * ntn, pm = mode == 2 ? nt - 1 - pm0 : pm0, e = lt[pm], idx = (pm - lt[LT_TS + e]) * 256 + rr; if (idx < lt[LT_CNT + e]) li = LIST[(size_t)e * 32768 + idx];
            bias = mode == 1 ? F.b_gu[(size_t)e * 2048 + (rr >> 7) * 1024 + pl * 128 + (rr & 127)] : F.b_d[(size_t)e * 1024 + pl * 256 + rr]; }
        ((LAS float*)(F.lds + ROWTAB_OFF))[q] = bias;
        if (mode == 1) ((LAS unsigned short*)(F.lds + ROWTAB2_OFF))[q] = (unsigned short)(li < 0 ? 0 : (li >> 2));
        else ((LAS int*)(F.lds + ROWTAB_OFF) + nslot * 256)[q] = li; }
    __syncthreads();
    return nt;
}
__device__ __forceinline__ void combine_phase(Frame& F) {
    const unsigned char* YK = F.ws + WS_YK; const bf16* XH = (const bf16*)(F.ws + WS_XN); const float* TOPG = (const float*)(F.ws + WS_TOPG);
    for (int t = F.gw; t < T; t += F.ngw) {
        GAS f32x4* xr = (GAS f32x4*)(F.out + (size_t)t * D) + F.lane; f32x4 v[4]; unsigned y[4][4]; const f32x4 gt = *((const GAS f32x4*)TOPG + t + vzero()) * (1.0f / Y8_SCALE);
#pragma unroll
        for (int j = 0; j < 4; ++j) { const unsigned long long xh = __builtin_nontemporal_load((const GAS unsigned long long*)(XH + (size_t)t * D) + F.lane + 64 * j);
            v[j] = (f32x4){bflo((unsigned)xh), bfhi((unsigned)xh), bflo((unsigned)(xh >> 32)), bfhi((unsigned)(xh >> 32))};
#pragma unroll
            for (int k = 0; k < 4; ++k) y[j][k] = __builtin_nontemporal_load((const GAS unsigned*)(YK + ((size_t)t * 4 + k) * D) + F.lane + 64 * j); }
#pragma unroll
        for (int j = 0; j < 4; ++j) { f32x4 s4 = {0.f, 0.f, 0.f, 0.f};
#pragma unroll
            for (int k = 0; k < 4; ++k) { const f32x2n_ lo = __builtin_amdgcn_cvt_pk_f32_fp8((int)y[j][k], false), hi = __builtin_amdgcn_cvt_pk_f32_fp8((int)y[j][k], true); const float g = gt[k]; s4.x += g * lo.x; s4.y += g * lo.y; s4.z += g * hi.x; s4.w += g * hi.y; }
            v[j] = v[j] + s4;
            __builtin_nontemporal_store(v[j], xr + 64 * j); }
    }
}

constexpr int NPH = 9;
struct Args { const float* in[16]; float* out; unsigned char* ws; int ph_lo, ph_hi; };
__global__ void __launch_bounds__(NWAVES * 64, 2) fwd(Args args) {
    extern __shared__ __attribute__((aligned(16))) unsigned char lds[];
    Frame F;
    F.lds = (LAS unsigned char*)lds;
    F.MISC = (volatile LAS unsigned*)(F.lds + MISC_OFF);
    F.tid = threadIdx.x; F.lane = F.tid & 63; F.wave = __builtin_amdgcn_readfirstlane(F.tid >> 6);
    F.G = gridDim.x; { const int bx = blockIdx.x; F.vcu = (F.G % 8 == 0) ? (bx % 8) * (F.G / 8) + bx / 8 : bx; }
    F.gw = blockIdx.x * NWAVES + F.wave; F.ngw = F.G * NWAVES;
    F.ws = args.ws; F.ctl = (gu32*)(args.ws + WS_CTL); F.out = args.out;
    F.x = args.in[0]; F.norm1_g = args.in[1]; F.w_in = args.in[2]; F.sb_q_g = args.in[3]; F.sb_k_g = args.in[4]; F.sb_out_g = args.in[5]; F.hg_lb = args.in[6]; F.hg_out_g = args.in[7];
    F.w_out = args.in[8]; F.norm2_g = args.in[9]; F.w_router = args.in[10]; F.b_router = args.in[11]; F.w_gu = args.in[12]; F.b_gu = args.in[13]; F.w_d = args.in[14]; F.b_d = args.in[15];
    for (int u = F.tid; u < (LDS_BYTES - LDSCTL_OFF) / 4; u += NWAVES * 64) ((LAS unsigned*)(F.lds + LDSCTL_OFF))[u] = 0u;
    __syncthreads();
    XcdBarrier bar; bar.bar = (unsigned*)(F.ctl + CW_BAR); bar.x = 0; bar.st = nullptr;
    if (MK_ONE_LAUNCH) bar = xcd_barrier_post((unsigned*)(F.ctl + CW_BAR), F.MISC + 8);
    const int lo = args.ph_lo, hi = args.ph_hi;
#define IN(k) (lo <= (k) && (k) < hi && ((F.lane = lane_id()), (F.tid = F.wave * 64 + F.lane), true))
#define SEAM(k) do { if (IN(k) && IN((k) + 1)) xcd_barrier(bar); } while (0)

    if (IN(0)) { p0_prologue(F); } SEAM(0);
    if (IN(1)) {
        pg8::Gemm g{(const bf16*)(F.ws + WS_XN), (const bf16*)(F.ws + WS_WIN), T, NIN, D}; pg8::StaticOrder S; S.init(T, NIN, F.G, (int)blockIdx.x);
        pg8::EpiInproj E{(bf16*)(F.ws + WS_P), (bf16*)(F.ws + WS_PH), (bf16*)(F.ws + WS_QN), (bf16*)(F.ws + WS_KN), F.sb_q_g, F.sb_k_g, QSCALE, EPS};
        pg8::gemm_phase<pg8::EpiInproj, pg8::StaticOrder, PG8_ALIGN, PG8_SP2>(F.lds + RING_OFF, g, S, E, F.tid);
    } SEAM(1);
    if (IN(2)) { prep_phase(F); __syncthreads(); hgA_phase(F); } SEAM(2);
    if (IN(3)) { attn_phase(F); hgC_phase(F); } SEAM(3);
    if (IN(4)) {
        pg8::Gemm g{(const bf16*)(F.ws + WS_MIX), (const bf16*)(F.ws + WS_WOUT), T, D, D}; pg8::StaticOrder S; S.init(T, D, F.G, (int)blockIdx.x);
        pg8::EpiRes E{F.x, (bf16*)(F.ws + WS_XN), D};
        pg8::gemm_phase<pg8::EpiRes, pg8::StaticOrder, PG8_ALIGN, PG8_SP2>(F.lds + RING_OFF, g, S, E, F.tid);
    } SEAM(4);
    if (IN(5)) { router_phase(F); } SEAM(5);
    if (IN(6)) {
        const int nt = build_moe_tables(F, 8, 1); const LAS int* lt = (const LAS int*)(F.lds + LTAB_OFF);
        pg8::Gemm g{(const bf16*)(F.ws + WS_X8), (const bf16*)(F.ws + WS_WGU), MAXROWS, NE * 2048, D / 2};
        pg8::MoeOrder S{lt, (const LAS unsigned short*)(F.lds + ROWTAB2_OFF), 8, nt * 8, F.G, F.vcu, 1024u, 0};
        pg8::EpiAct<true> E{F.ws + WS_ACT, (const LAS float*)(F.lds + ROWTAB_OFF), A8_SCALE};
        pg8::gemm_phase<pg8::EpiAct<true>, pg8::MoeOrder, PG8_ALIGN, PG8_SP2, true, SC_W8, SC_ONE>(F.lds + RING_OFF, g, S, E, F.tid);
        {
            const int rem = (nt * 8) % F.G, nidle = F.G - rem; const bool few = rem == 0 || nidle < F.G / 4;
            __syncthreads();
            if (few) p0_items(F, P0_NITEMS - P0_NLATE, P0_NITEMS, F.vcu * NWAVES + F.wave, F.G * NWAVES);
            else if (F.vcu >= rem) p0_items(F, P0_NITEMS - P0_NLATE, P0_NITEMS, (F.vcu - rem) * NWAVES + F.wave, nidle * NWAVES);
        }
    } SEAM(6);
    if (IN(7)) {
        const int nt = build_moe_tables(F, 4, 2); const LAS int* lt = (const LAS int*)(F.lds + LTAB_OFF);
        pg8::Gemm g{(const bf16*)(F.ws + WS_ACT), (const bf16*)(F.ws + WS_WD), MAXROWS, NE * 1024, D / 2};
        pg8::MoeOrder S{lt, nullptr, 4, nt * 4, F.G, F.vcu, 1024u, nt};
        pg8::EpiDown E{F.ws + WS_YK, (const LAS int*)(F.lds + ROWTAB_OFF) + ((MAXTILES * 4 + 255) / 256) * 256, (const LAS float*)(F.lds + ROWTAB_OFF), Y8_SCALE};
        pg8::gemm_phase<pg8::EpiDown, pg8::MoeOrder, PG8_ALIGN, PG8_SP2, true, SC_W8Y, SC_A8>(F.lds + RING_OFF, g, S, E, F.tid);
    } SEAM(7);
    if (IN(8)) { combine_phase(F); }
#undef IN
#undef SEAM
}

extern "C" void kernel_launch(void* const* d_in, const int* in_sizes, int n_in, void* d_out, int out_size, void* d_ws, size_t ws_size, hipStream_t stream) {
    static int grid = 0;
    if (grid == 0) {
        if (n_in != 16 || in_sizes[0] != T * D || out_size != T * D || ws_size < WS_END) { fprintf(stderr, "kernel_launch: shape/workspace mismatch (n_in %d, ws %zu, need %zu); nothing launched\n", n_in, ws_size, (size_t)WS_END); grid = -1; return; }
        int dev = 0, cus = 0, per_cu = 0;
        if (hipGetDevice(&dev) != hipSuccess || hipDeviceGetAttribute(&cus, hipDeviceAttributeMultiprocessorCount, dev) != hipSuccess) { grid = -1; return; }
        if (hipFuncSetAttribute((const void*)fwd, hipFuncAttributeMaxDynamicSharedMemorySize, LDS_BYTES) != hipSuccess) { grid = -1; return; }
        if (hipOccupancyMaxActiveBlocksPerMultiprocessor(&per_cu, (const void*)fwd, NWAVES * 64, LDS_BYTES) != hipSuccess || per_cu < 1) { fprintf(stderr, "kernel_launch: occupancy query says %d\n", per_cu); }
        (void)hipGetLastError();
        if ((MAXTILES * 8 + cus - 1) / cus > MAXSLOT || cus < 1) { fprintf(stderr, "kernel_launch: %d CUs: the per-workgroup unit tables are sized for 256\n", cus); grid = -1; return; }
        grid = cus;
    }
    if (grid < 0) return;
    if (hipMemsetAsync((char*)d_ws + WS_CTL, 0, CTL_ZERO_BYTES, stream) != hipSuccess) return;
    Args a{};
    for (int i = 0; i < 16; ++i) a.in[i] = (const float*)d_in[i];
    a.out = (float*)d_out; a.ws = (unsigned char*)d_ws;
#if MK_ONE_LAUNCH
    a.ph_lo = 0; a.ph_hi = NPH;
    hipLaunchKernelGGL(fwd, dim3(grid), dim3(NWAVES * 64), LDS_BYTES, stream, a);
#else
    for (int p = 0; p < NPH; ++p) { a.ph_lo = p; a.ph_hi = p + 1; hipLaunchKernelGGL(fwd, dim3(grid), dim3(NWAVES * 64), LDS_BYTES, stream, a); }
#endif
}
```

```cpp
#include <hip/hip_runtime.h>
#include <cstdio>
#include <cstdint>
namespace pg8 {
#define PG8_LAS __attribute__((address_space(3)))
typedef unsigned short bf16_t;
typedef short bf16x8 __attribute__((ext_vector_type(8)));
typedef float f32x4 __attribute__((ext_vector_type(4)));
typedef unsigned u32x4 __attribute__((ext_vector_type(4)));
typedef int i32x4_t __attribute__((ext_vector_type(4)));
typedef int i32x8_t __attribute__((ext_vector_type(8)));
constexpr int BM = 256, BK = 64, HALF = 128, HTB = HALF * BK * 2  , STAGE_BYTES = 8 * HTB, NXCD = 8, WGM = 8;

__host__ __device__ __forceinline__ int lds_byte(int r, int c) { const int st = (r >> 4) * 2 + (c >> 5), rr = r & 15, cc = c & 31, ob = rr * 64 + cc * 2; return st * 1024 + (ob ^ (((ob >> 9) & 1) << 5)); }
__host__ __device__ __forceinline__ void stage_rc(int b, int& R, int& C) { const int st = b / 1024, sb = b % 1024, swz = sb ^ (((sb >> 9) & 1) << 5); R = (st >> 1) * 16 + swz / 64; C = (st & 1) * 32 + (swz % 64) / 2; }
__host__ __device__ __forceinline__ int perm32(int rho) { const int n = rho >> 4, i = rho & 15; return 8 * (i >> 2) + 4 * n + (i & 3); }

struct Unit { int pm, pn, slot; };
struct Gemm { const bf16_t* A; const bf16_t* Bt; int M, N, K; };

struct StaticOrder {
    int nM, nN, nwg, G, c;
    __host__ __device__ void init(int M, int N, int G_, int c_) { nM = M / BM; nN = N / BM; nwg = nM * nN; G = G_; c = c_; }
    __host__ __device__ bool next(int i, Unit& u) const {
        const long L = (long)i * G + c; if (L >= nwg) return false;
        int wgid = (int)L; { const int q = nwg / NXCD, r = nwg % NXCD, xcd = wgid % NXCD, off = wgid / NXCD; wgid = (xcd < r ? xcd * (q + 1) : r * (q + 1) + (xcd - r) * q) + off; }
        const int nig = WGM * nN, gid = wgid / nig, fm = gid * WGM, gsz = (nM - fm) < WGM ? (nM - fm) : WGM;
        u.pm = fm + ((wgid % nig) % gsz); u.pn = (wgid % nig) / gsz; return true;
    }
    __device__ __forceinline__ void a_ready(const Unit&) const {}
    __device__ __forceinline__ void done(const Unit&) const {}
};

__device__ __forceinline__ unsigned cvt_pk_bf16(float lo, float hi) { unsigned r; asm volatile("v_cvt_pk_bf16_f32 %0, %1, %2" : "=v"(r) : "v"(lo), "v"(hi)); return r; }
typedef float f32x2 __attribute__((ext_vector_type(2)));
__device__ __forceinline__ f32x2 gelu_pk(f32x2 v) {
    const f32x2 av = __builtin_elementwise_abs(v), d = av * 0.2316418882f + 1.0f;
    f32x2 t; t.x = __builtin_amdgcn_rcpf(d.x); t.y = __builtin_amdgcn_rcpf(d.y);
    f32x2 q = t * 0.5307027145f + (-0.7265760135f); q = q * t + 0.7107068705f; q = q * t + (-0.142248368f); q = q * t + 0.127414796f; q = q * t;
    const f32x2 s = (v * v) * (-0.72134752044f);
    f32x2 e; e.x = __builtin_amdgcn_exp2f(s.x); e.y = __builtin_amdgcn_exp2f(s.y);
    const f32x2 m = v * (q * e), r = v - m;
    f32x2 o; o.x = v.x < 0.f ? m.x : r.x; o.y = v.y < 0.f ? m.y : r.y; return o;
}

template <int ACT  > struct EpiBf16 {
    static constexpr bool PERM = true, AFTER_DRAIN = false, HAS_INIT = false; static_assert(ACT == 0 || ACT == 1, "EpiBf16: ACT is 0 (none) or 1 (gelu_pk)");
    bf16_t* O; int ldc; const float* bias; int split_cols; size_t split_stride; float scale0;
    __device__ __forceinline__ void operator()(const f32x4 (&acc)[2][2][4][2], const Unit& u, int wr, int wc, int fr, int fq) const {
        const int row0 = u.pm * BM + wr * 64 + fr; int colt = u.pn * BM; bf16_t* base = O;
        float sc = 1.f; if (split_cols) { const int t = colt / split_cols; base += (size_t)t * split_stride; colt -= t * split_cols; if (t == 0) sc = scale0; }
        const int col0 = colt + wc * 32 + 8 * fq, bcol0 = u.pn * BM + wc * 32 + 8 * fq;
        f32x4 bv[2][2];
#pragma unroll
        for (int bj = 0; bj < 2; ++bj)
#pragma unroll
            for (int n = 0; n < 2; ++n) bv[bj][n] = bias ? *(const f32x4*)(bias + bcol0 + bj * HALF + 4 * n) : (f32x4){0.f, 0.f, 0.f, 0.f};
#pragma unroll
        for (int ai = 0; ai < 2; ++ai)
#pragma unroll
            for (int m = 0; m < 4; ++m) { bf16_t* rowp = base + (size_t)(row0 + ai * HALF + m * 16) * ldc + col0;
#pragma unroll
                for (int bj = 0; bj < 2; ++bj) { f32x4 v0 = acc[ai][bj][m][0] + bv[bj][0], v1 = acc[ai][bj][m][1] + bv[bj][1];
                    if (ACT == 1) { f32x2 a = gelu_pk((f32x2){v0[0], v0[1]}), b = gelu_pk((f32x2){v0[2], v0[3]}), c = gelu_pk((f32x2){v1[0], v1[1]}), d = gelu_pk((f32x2){v1[2], v1[3]});
                        v0 = (f32x4){a.x, a.y, b.x, b.y}; v1 = (f32x4){c.x, c.y, d.x, d.y}; }
                    v0 = v0 * sc; v1 = v1 * sc; u32x4 w; w.x = cvt_pk_bf16(v0[0], v0[1]); w.y = cvt_pk_bf16(v0[2], v0[3]); w.z = cvt_pk_bf16(v1[0], v1[1]); w.w = cvt_pk_bf16(v1[2], v1[3]);
                    *(u32x4*)(rowp + bj * HALF) = w; } }
    }
};

__device__ __forceinline__ unsigned pk4_fp8(float a, float b, float c, float d) {
    a = fminf(fmaxf(a, -448.f), 448.f); b = fminf(fmaxf(b, -448.f), 448.f); c = fminf(fmaxf(c, -448.f), 448.f); d = fminf(fmaxf(d, -448.f), 448.f);
    int p = 0; p = __builtin_amdgcn_cvt_pk_fp8_f32(a, b, p, false); p = __builtin_amdgcn_cvt_pk_fp8_f32(c, d, p, true); return (unsigned)p;
}
struct EpiRes {
    static constexpr bool PERM = false, AFTER_DRAIN = false, HAS_INIT = false;
    const float* __restrict__ X; bf16_t* __restrict__ XH; int ldc;
    __device__ __forceinline__ void operator()(const f32x4 (&acc)[2][2][4][2], const Unit& u, int wr, int wc, int fr, int fq) const {
        const int row0 = u.pm * BM + wr * 64 + fr, col0 = u.pn * BM + wc * 32 + 4 * fq;
#pragma unroll
        for (int ai = 0; ai < 2; ++ai)
#pragma unroll
            for (int mp = 0; mp < 2; ++mp) { f32x4 xv[2][2][2];
#pragma unroll
                for (int mm = 0; mm < 2; ++mm) { const size_t off = (size_t)(row0 + ai * HALF + (2 * mp + mm) * 16) * ldc + col0;
#pragma unroll
                    for (int bj = 0; bj < 2; ++bj)
#pragma unroll
                        for (int n = 0; n < 2; ++n) xv[mm][bj][n] = __builtin_nontemporal_load((const f32x4*)(X + off + bj * HALF + n * 16)); }
#pragma unroll
                for (int mm = 0; mm < 2; ++mm) { const size_t off = (size_t)(row0 + ai * HALF + (2 * mp + mm) * 16) * ldc + col0;
#pragma unroll
                    for (int bj = 0; bj < 2; ++bj)
#pragma unroll
                        for (int n = 0; n < 2; ++n) { const size_t o2 = off + bj * HALF + n * 16; const f32x4 v = xv[mm][bj][n] + acc[ai][bj][2 * mp + mm][n];
                            *(unsigned long long*)(XH + o2) = (unsigned long long)cvt_pk_bf16(v[0], v[1]) | ((unsigned long long)cvt_pk_bf16(v[2], v[3]) << 32); } } }
    }
};
struct EpiInproj {
    static constexpr bool PERM = true, AFTER_DRAIN = false, HAS_INIT = false;
    bf16_t* PA; bf16_t* PH; bf16_t* QN; bf16_t* KN; const float* gq; const float* gk; float qscale, eps;
    __device__ __forceinline__ void operator()(const f32x4 (&acc)[2][2][4][2], const Unit& u, int wr, int wc, int fr, int fq) const {
        if (u.pn < 4) {
            const int arr = u.pn >> 1, hd = (u.pn & 1) * 4 + wc; const float* g = arr ? gk : gq; const float gs = arr ? 1.f : qscale; bf16_t* dst = arr ? KN : QN;
            f32x4 gv[2][2];
#pragma unroll
            for (int bj = 0; bj < 2; ++bj)
#pragma unroll
                for (int n = 0; n < 2; ++n) gv[bj][n] = *(const f32x4*)(g + 32 * bj + 8 * fq + 4 * n) * gs;
#pragma unroll
            for (int ai = 0; ai < 2; ++ai)
#pragma unroll
                for (int m = 0; m < 4; ++m) { float ss = 0.f;
#pragma unroll
                    for (int bj = 0; bj < 2; ++bj)
#pragma unroll
                        for (int n = 0; n < 2; ++n) { const f32x4 a = acc[ai][bj][m][n]; ss += (a[0] * a[0] + a[1] * a[1]) + (a[2] * a[2] + a[3] * a[3]); }
                    ss += __shfl_xor(ss, 16); ss += __shfl_xor(ss, 32);
                    const float rs = 1.f / sqrtf(ss * (1.f / 64.f) + eps);
                    const int row = u.pm * BM + ai * HALF + wr * 64 + m * 16 + fr, b = row >> 11, s = row & 2047;
                    bf16_t* rp = dst + ((size_t)((b * 8 + hd) * 64 + (s >> 5))) * 2048 + (s & 31) * 8;
#pragma unroll
                    for (int bj = 0; bj < 2; ++bj) { const int c8 = 4 * bj + fq; const f32x4 v0 = acc[ai][bj][m][0] * rs * gv[bj][0], v1 = acc[ai][bj][m][1] * rs * gv[bj][1];
                        u32x4 w; w.x = cvt_pk_bf16(v0[0], v0[1]); w.y = cvt_pk_bf16(v0[2], v0[3]); w.z = cvt_pk_bf16(v1[0], v1[1]); w.w = cvt_pk_bf16(v1[2], v1[3]);
                        *(u32x4*)(rp + (c8 >> 1) * 512 + (c8 & 1) * 256) = w; } }
            return;
        }
#pragma unroll
        for (int bj = 0; bj < 2; ++bj) { const int col = u.pn * BM + bj * HALF + wc * 32 + 8 * fq;
            bf16_t* base; int rowlen;
            if (col < 1536) { const int arr = col >> 9, hd = (col & 511) >> 6, dd = col & 63; base = PA + ((size_t)(arr * 16) * 8 + hd) * 2048 * 64 + dd; rowlen = 64; }
            else { const int c2 = col - 1536, arr = c2 >> 9, hd = (c2 & 511) >> 7, dd = c2 & 127; base = PH + ((size_t)(arr * 16) * 4 + hd) * 2048 * 128 + dd; rowlen = 128; }
            const size_t bstride = (size_t)(rowlen == 64 ? 8 : 4) * 2048 * rowlen;
#pragma unroll
            for (int ai = 0; ai < 2; ++ai)
#pragma unroll
                for (int m = 0; m < 4; ++m) { const int row = u.pm * BM + ai * HALF + wr * 64 + m * 16 + fr, b = row >> 11, s = row & 2047;
                    const f32x4 v0 = acc[ai][bj][m][0], v1 = acc[ai][bj][m][1];
                    u32x4 w; w.x = cvt_pk_bf16(v0[0], v0[1]); w.y = cvt_pk_bf16(v0[2], v0[3]); w.z = cvt_pk_bf16(v1[0], v1[1]); w.w = cvt_pk_bf16(v1[2], v1[3]);
                    *(u32x4*)(base + (size_t)b * bstride + (size_t)s * rowlen) = w; } }
    }
};
struct MoeOrder {
    const PG8_LAS int* tile_e; const PG8_LAS unsigned short* rowtab; int ntn, nunits, G, c; unsigned rowbytes; int rev;
    __device__ __forceinline__ bool next(int i, Unit& u) const {
        const int L = i * G + c; if (L >= nunits) return false;
        const int pm0 = L / ntn, pl = L - pm0 * ntn, pm = rev ? rev - 1 - pm0 : pm0; u.pm = pm; u.pn = tile_e[pm] * ntn + pl; u.slot = i; return true;
    }
    __device__ __forceinline__ unsigned rowoff(const Unit& u, int r) const { return (rowtab ? (unsigned)rowtab[u.slot * 256 + r] : (unsigned)(u.pm * 256 + r)) * rowbytes; }
    __device__ __forceinline__ void a_ready(const Unit&) const {}
    __device__ __forceinline__ void done(const Unit&) const {}
};
template <bool OUT8> struct EpiAct {
    static constexpr bool PERM = true, AFTER_DRAIN = false, HAS_INIT = true;
    unsigned char* ACT; const PG8_LAS float* biastab; float oscale;
    __device__ __forceinline__ void init(f32x4 (&acc)[2][2][4][2], const Unit& u, int wc, int fq) const {
#pragma unroll
        for (int n = 0; n < 2; ++n) { const f32x4 bg = *(const PG8_LAS f32x4*)(biastab + u.slot * 256 + wc * 32 + 8 * fq + 4 * n), bu = *(const PG8_LAS f32x4*)(biastab + u.slot * 256 + 128 + wc * 32 + 8 * fq + 4 * n);
#pragma unroll
            for (int ai = 0; ai < 2; ++ai)
#pragma unroll
                for (int m = 0; m < 4; ++m) { acc[ai][0][m][n] = bg; acc[ai][1][m][n] = bu; } }
    }
    __device__ __forceinline__ void operator()(const f32x4 (&acc)[2][2][4][2], const Unit& u, int wr, int wc, int fr, int fq) const {
        const int pl = u.pn & 7; const int row0 = u.pm * BM + wr * 64 + fr, acol0 = pl * 128 + wc * 32 + 8 * fq;
#pragma unroll
        for (int ai = 0; ai < 2; ++ai)
#pragma unroll
            for (int m = 0; m < 4; ++m) { unsigned char* rowp = ACT + (size_t)(row0 + ai * HALF + m * 16) * 1024 + acol0; f32x4 a4[2];
#pragma unroll
                for (int n = 0; n < 2; ++n) { const f32x4 g4 = acc[ai][0][m][n], u4 = acc[ai][1][m][n]; f32x4 gl, ul, ex;
#pragma unroll
                    for (int j = 0; j < 4; ++j) { gl[j] = fminf(g4[j], 7.0f); ul[j] = __builtin_amdgcn_fmed3f(u4[j], -7.0f, 7.0f); }
                    const f32x4 t4 = gl * (-1.702f * 1.44269504089f);
#pragma unroll
                    for (int j = 0; j < 4; ++j) ex[j] = __builtin_amdgcn_exp2f(t4[j]);
                    const f32x4 d4 = ex + 1.0f; f32x4 s4;
#pragma unroll
                    for (int j = 0; j < 4; ++j) s4[j] = __builtin_amdgcn_rcpf(d4[j]);
                    a4[n] = (gl * s4) * (ul * oscale + oscale); }
                if constexpr (OUT8) { int p0 = 0, p1 = 0; p0 = __builtin_amdgcn_cvt_pk_fp8_f32(a4[0][0], a4[0][1], p0, false); p0 = __builtin_amdgcn_cvt_pk_fp8_f32(a4[0][2], a4[0][3], p0, true);
                    p1 = __builtin_amdgcn_cvt_pk_fp8_f32(a4[1][0], a4[1][1], p1, false); p1 = __builtin_amdgcn_cvt_pk_fp8_f32(a4[1][2], a4[1][3], p1, true);
                    *(unsigned long long*)rowp = (unsigned long long)(unsigned)p0 | ((unsigned long long)(unsigned)p1 << 32); }
                else { u32x4 w; w.x = cvt_pk_bf16(a4[0][0], a4[0][1]); w.y = cvt_pk_bf16(a4[0][2], a4[0][3]); w.z = cvt_pk_bf16(a4[1][0], a4[1][1]); w.w = cvt_pk_bf16(a4[1][2], a4[1][3]); *(u32x4*)(rowp + (size_t)(row0 + ai * HALF + m * 16) * 1024 + acol0) = w; } }
    }
};
struct EpiDown {
    static constexpr bool PERM = true, AFTER_DRAIN = false, HAS_INIT = true;
    unsigned char* YK; const PG8_LAS int* tktab; const PG8_LAS float* biastab; float oscale;
    __device__ __forceinline__ void init(f32x4 (&acc)[2][2][4][2], const Unit& u, int wc, int fq) const {
#pragma unroll
        for (int bj = 0; bj < 2; ++bj)
#pragma unroll
            for (int n = 0; n < 2; ++n) { const f32x4 bv = *(const PG8_LAS f32x4*)(biastab + u.slot * 256 + bj * HALF + wc * 32 + 8 * fq + 4 * n) * oscale;
#pragma unroll
                for (int ai = 0; ai < 2; ++ai)
#pragma unroll
                    for (int m = 0; m < 4; ++m) acc[ai][bj][m][n] = bv; }
    }
    __device__ __forceinline__ void operator()(const f32x4 (&acc)[2][2][4][2], const Unit& u, int wr, int wc, int fr, int fq) const {
        const int pl = u.pn & 3; const int col0 = pl * BM + wc * 32 + 8 * fq;
#pragma unroll
        for (int ai = 0; ai < 2; ++ai)
#pragma unroll
            for (int m = 0; m < 4; ++m) { const int tk = tktab[u.slot * 256 + ai * HALF + wr * 64 + m * 16 + fr];
                if (tk >= 0) { unsigned char* rowp = YK + (size_t)tk * 1024 + col0;
#pragma unroll
                    for (int bj = 0; bj < 2; ++bj) { f32x4 v0 = acc[ai][bj][m][0], v1 = acc[ai][bj][m][1];
#pragma unroll
                        for (int j = 0; j < 4; ++j) { v0[j] = __builtin_amdgcn_fmed3f(v0[j], -448.f, 448.f); v1[j] = __builtin_amdgcn_fmed3f(v1[j], -448.f, 448.f); }
                        int p0 = 0, p1 = 0; p0 = __builtin_amdgcn_cvt_pk_fp8_f32(v0[0], v0[1], p0, false); p0 = __builtin_amdgcn_cvt_pk_fp8_f32(v0[2], v0[3], p0, true);
                        p1 = __builtin_amdgcn_cvt_pk_fp8_f32(v1[0], v1[1], p1, false); p1 = __builtin_amdgcn_cvt_pk_fp8_f32(v1[2], v1[3], p1, true);
                        *(unsigned long long*)(rowp + bj * HALF) = (unsigned long long)(unsigned)p0 | ((unsigned long long)(unsigned)p1 << 32); } } }
    }
};


template <class Epi, class Sched, bool ALIGN_EPI = false, bool SP2 = false, bool GATHER = false, int SCW = 0, int SCX = 0>
__device__ __forceinline__ void gemm_phase(PG8_LAS unsigned char* lds, const Gemm g, const Sched& S, const Epi& E, const int tid) {
    const int wid = __builtin_amdgcn_readfirstlane(tid >> 6), lane = tid & 63, wr = wid >> 2, wc = wid & 3, fr = lane & 15, fq = lane >> 4;
    const int K = g.K, nt = K / BK;
    unsigned voffA[2], voffB[2]; int RA[2]; unsigned CA2[2]; unsigned va0[2] = {0u, 0u}, va1[2] = {0u, 0u};
#pragma unroll
    for (int i = 0; i < 2; ++i) { int R, C; stage_rc(tid * 16 + i * 8192, R, C); const int Rb = Epi::PERM ? ((R & ~31) + perm32(R & 31)) : R;
        voffA[i] = (unsigned)(R * K + C) * 2u; voffB[i] = (unsigned)(Rb * K + C) * 2u; RA[i] = R; CA2[i] = (unsigned)C * 2u; }
    static_assert(!GATHER || SP2, "the gathered-A form exists for the SP2 loop only");
    const char* const gA0 = (const char*)g.A;
#define PG8_VA(u) do { int l_; asm volatile("v_mbcnt_lo_u32_b32 %0, -1, 0\n\tv_mbcnt_hi_u32_b32 %0, -1, %0" : "=v"(l_)); const int t_ = wid * 64 + l_;     \
        _Pragma("unroll") for (int _i = 0; _i < 2; ++_i) { int R_, C_; stage_rc(t_ * 16 + _i * 8192, R_, C_); va0[_i] = S.rowoff((u), R_) + (unsigned)C_ * 2u; va1[_i] = S.rowoff((u), HALF + R_) + (unsigned)C_ * 2u; } } while (0)
#define PG8_STA(bufoff, base_ng, base_g, h) do { if constexpr (GATHER) { if (h) PG8_STAGE(bufoff, base_g, va1); else PG8_STAGE(bufoff, base_g, va0); } else PG8_STAGE(bufoff, base_ng, voffA); } while (0)
    const size_t kstep = (size_t)(BK * 2);
    const size_t hstep = (size_t)HALF * K * 2;
    const size_t tstep = 2 * hstep;
    const unsigned ldsw = (unsigned)wid * 1024u;
    const int aoff = lds_byte(wr * 64 + fr, fq * 8), boff = lds_byte(wc * 32 + fr, fq * 8);
#define PG8_SA(b, h) (((b) * 2 + (h)) * HTB)
#define PG8_SB(b, h) ((4 + (b) * 2 + (h)) * HTB)
#define PG8_STAGE(bufoff, gbase, voff) do { _Pragma("unroll") for (int _i = 0; _i < 2; ++_i) \
        __builtin_amdgcn_global_load_lds((const unsigned*)((const char*)(gbase) + (voff)[_i]), (PG8_LAS unsigned*)(lds + (bufoff) + ldsw + _i * 8192), 16, 0, 0); } while (0)
#define PG8_LDA(dst, b, h) do { if constexpr (SCW != 0) { _Pragma("unroll") for (int m = 0; m < 4; ++m) dst##8[m] = PG8_CAT8(*(const PG8_LAS bf16x8*)(lds + PG8_SA(b, h) + aoff + m * 2048), *(const PG8_LAS bf16x8*)(lds + PG8_SA(b, h) + aoff + m * 2048 + 1024)); } \
        else { _Pragma("unroll") for (int m = 0; m < 4; ++m) _Pragma("unroll") for (int k = 0; k < 2; ++k) dst[m][k] = *(const PG8_LAS bf16x8*)(lds + PG8_SA(b, h) + aoff + m * 2048 + k * 1024); } } while (0)
#define PG8_LDB(dst, b, h) do { if constexpr (SCW != 0) { _Pragma("unroll") for (int n = 0; n < 2; ++n) dst##8[n] = PG8_CAT8(*(const PG8_LAS bf16x8*)(lds + PG8_SB(b, h) + boff + n * 2048), *(const PG8_LAS bf16x8*)(lds + PG8_SB(b, h) + boff + n * 2048 + 1024)); } \
        else { _Pragma("unroll") for (int n = 0; n < 2; ++n) _Pragma("unroll") for (int k = 0; k < 2; ++k) dst[n][k] = *(const PG8_LAS bf16x8*)(lds + PG8_SB(b, h) + boff + n * 2048 + k * 1024); } } while (0)
#define PG8_CAT8(lo, hi) __builtin_shufflevector(__builtin_bit_cast(i32x4_t, (lo)), __builtin_bit_cast(i32x4_t, (hi)), 0, 1, 2, 3, 4, 5, 6, 7)
#define PG8_MMA(ai, bj, At, Bt) do { __builtin_amdgcn_s_setprio(1); _Pragma("unroll") for (int m = 0; m < 4; ++m) _Pragma("unroll") for (int n = 0; n < 2; ++n) { \
        if constexpr (SCW != 0) acc[ai][bj][m][n] = __builtin_amdgcn_mfma_scale_f32_16x16x128_f8f6f4(Bt##8[n], At##8[m], acc[ai][bj][m][n], 0, 0, 0, SCW, 0, SCX); \
        else { _Pragma("unroll") for (int k = 0; k < 2; ++k) acc[ai][bj][m][n] = __builtin_amdgcn_mfma_f32_16x16x32_bf16(Bt[n][k], At[m][k], acc[ai][bj][m][n], 0, 0, 0); } } __builtin_amdgcn_s_setprio(0); } while (0)
#define PG8_WAIT_V(n) asm volatile("s_waitcnt vmcnt(" #n ")" ::: "memory")
#define PG8_WAIT_L(n) asm volatile("s_waitcnt lgkmcnt(" #n ")" ::: "memory")
#define PG8_BAR __builtin_amdgcn_s_barrier()
#define PG8_SCHED __builtin_amdgcn_sched_barrier(0)
    Unit cur, nxt; int ui = 0;
    if (!S.next(0, cur)) return;
    f32x4 acc[2][2][4][2];
    if constexpr (Epi::HAS_INIT) E.init(acc, cur, wc, fq);
    else {
#pragma unroll
    for (int a = 0; a < 2; ++a)
#pragma unroll
        for (int b = 0; b < 2; ++b)
#pragma unroll
            for (int m = 0; m < 4; ++m)
#pragma unroll
                for (int n = 0; n < 2; ++n) acc[a][b][m][n] = (f32x4){0.f, 0.f, 0.f, 0.f};
    }
    bf16x8 At[4][2], B0[2][2], B1[2][2]; i32x8_t At8[4], B08[2], B18[2];
    const char* cA = (const char*)g.A + (size_t)cur.pm * tstep; const char* cB = (const char*)g.Bt + (size_t)cur.pn * tstep;
    S.a_ready(cur);
    if constexpr (SP2) {
        if constexpr (GATHER) PG8_VA(cur);
        PG8_STAGE(PG8_SB(0, 0), cB, voffB); PG8_STAGE(PG8_SB(0, 1), cB + hstep, voffB); PG8_STA(PG8_SA(0, 0), cA, gA0, 0); PG8_STA(PG8_SA(0, 1), cA + hstep, gA0, 1);
        if (wr == 1) PG8_BAR;
        PG8_WAIT_V(2); PG8_BAR;
        PG8_STAGE(PG8_SB(1, 0), cB + kstep, voffB); PG8_STA(PG8_SA(1, 0), cA + kstep, gA0 + kstep, 0); PG8_STAGE(PG8_SB(1, 1), cB + hstep + kstep, voffB);
        PG8_WAIT_V(6); PG8_BAR;
    } else {
        PG8_STAGE(PG8_SB(0, 0), cB, voffB); PG8_STAGE(PG8_SA(0, 0), cA, voffA); PG8_STAGE(PG8_SB(0, 1), cB + hstep, voffB); PG8_STAGE(PG8_SA(0, 1), cA + hstep, voffA);
        if (wr == 1) PG8_BAR;
        PG8_WAIT_V(4); PG8_BAR;
        PG8_STAGE(PG8_SB(1, 0), cB + kstep, voffB); PG8_STAGE(PG8_SA(1, 0), cA + kstep, voffA); PG8_STAGE(PG8_SB(1, 1), cB + hstep + kstep, voffB);
        PG8_WAIT_V(6); PG8_BAR;
    }
    for (;;) {
        const bool has_next = S.next(ui + 1, nxt);
        const char* nA = has_next ? (const char*)g.A + (size_t)nxt.pm * tstep : cA; const char* nB = has_next ? (const char*)g.Bt + (size_t)nxt.pn * tstep : cB;
        _Pragma("nounroll") for (int t = 0; t < nt; t += 2) {
            const bool last = (t == nt - 2);
            const char* a1 = cA + (size_t)(t + 1) * kstep;
            const char* a2 = last ? nA : cA + (size_t)(t + 2) * kstep; const char* b2 = last ? nB : cB + (size_t)(t + 2) * kstep;
            const char* a3 = a2 + kstep; const char* b3 = b2 + kstep;
            if (last && has_next) S.a_ready(nxt);
            const char* const g1 = gA0 + (size_t)(t + 1) * kstep; const char* const g2 = last ? gA0 : gA0 + (size_t)(t + 2) * kstep; const char* const g3 = g2 + kstep;
            if constexpr (SP2) {
            PG8_LDB(B0, 0, 0); PG8_LDB(B1, 0, 1); PG8_SCHED; PG8_LDA(At, 0, 0); PG8_STA(PG8_SA(1, 1), a1 + hstep, g1, 1);
            PG8_WAIT_V(8); PG8_WAIT_L(0); PG8_BAR; PG8_MMA(0, 0, At, B0); PG8_MMA(0, 1, At, B1); PG8_BAR; PG8_SCHED;
            if constexpr (GATHER) { if (last && has_next) PG8_VA(nxt); }
            PG8_LDA(At, 0, 1); PG8_STAGE(PG8_SB(0, 0), b2, voffB); PG8_STAGE(PG8_SB(0, 1), b2 + hstep, voffB); PG8_STA(PG8_SA(0, 0), a2, g2, 0);
            PG8_WAIT_V(8); PG8_WAIT_L(0); PG8_BAR; PG8_MMA(1, 0, At, B0); PG8_MMA(1, 1, At, B1); PG8_BAR; PG8_SCHED;
            PG8_LDB(B0, 1, 0); PG8_LDB(B1, 1, 1); PG8_SCHED; PG8_LDA(At, 1, 0); PG8_STA(PG8_SA(0, 1), a2 + hstep, g2, 1);
            PG8_WAIT_V(8); PG8_WAIT_L(0); PG8_BAR; PG8_MMA(0, 0, At, B0); PG8_MMA(0, 1, At, B1); PG8_BAR; PG8_SCHED;
            PG8_LDA(At, 1, 1); PG8_STAGE(PG8_SB(1, 0), b3, voffB); PG8_STAGE(PG8_SB(1, 1), b3 + hstep, voffB); PG8_STA(PG8_SA(1, 0), a3, g3, 0);
            PG8_WAIT_V(8); PG8_WAIT_L(0); PG8_BAR; PG8_MMA(1, 0, At, B0); PG8_MMA(1, 1, At, B1); PG8_BAR; PG8_SCHED;
            } else {
            PG8_LDB(B0, 0, 0); PG8_SCHED; PG8_LDA(At, 0, 0); PG8_STAGE(PG8_SA(1, 1), a1 + hstep, voffA);
            PG8_WAIT_L(8); PG8_BAR; PG8_WAIT_L(0); PG8_MMA(0, 0, At, B0); PG8_BAR; PG8_SCHED;
            PG8_LDB(B1, 0, 1); PG8_STAGE(PG8_SB(0, 0), b2, voffB);
            PG8_BAR; PG8_WAIT_L(0); PG8_MMA(0, 1, At, B1); PG8_BAR;
            PG8_LDA(At, 0, 1); PG8_STAGE(PG8_SA(0, 0), a2, voffA);
            PG8_BAR; PG8_WAIT_L(0); PG8_MMA(1, 0, At, B0); PG8_BAR; PG8_SCHED;
            PG8_STAGE(PG8_SB(0, 1), b2 + hstep, voffB);
            PG8_WAIT_V(6); PG8_BAR; PG8_MMA(1, 1, At, B1); PG8_BAR;
            PG8_LDB(B0, 1, 0); PG8_SCHED; PG8_LDA(At, 1, 0); PG8_STAGE(PG8_SA(0, 1), a2 + hstep, voffA);
            PG8_WAIT_L(8); PG8_BAR; PG8_WAIT_L(0); PG8_MMA(0, 0, At, B0); PG8_BAR; PG8_SCHED;
            PG8_LDB(B1, 1, 1); PG8_STAGE(PG8_SB(1, 0), b3, voffB);
            PG8_BAR; PG8_WAIT_L(0); PG8_MMA(0, 1, At, B1); PG8_BAR;
            PG8_LDA(At, 1, 1); PG8_STAGE(PG8_SA(1, 0), a3, voffA);
            PG8_BAR; PG8_WAIT_L(0); PG8_MMA(1, 0, At, B0); PG8_BAR; PG8_SCHED;
            PG8_STAGE(PG8_SB(1, 1), b3 + hstep, voffB);
            PG8_WAIT_V(6); PG8_BAR; PG8_MMA(1, 1, At, B1); PG8_BAR;
            }
        }
        if constexpr (ALIGN_EPI) { if (wr == 0) PG8_BAR; }
        if constexpr (!Epi::AFTER_DRAIN) { int fr_ = fr, fq_ = fq; asm volatile("" : "+v"(fr_), "+v"(fq_));
            E(acc, cur, wr, wc, fr_, fq_); S.done(cur); }
        if (!has_next) break;
        if constexpr (Epi::HAS_INIT) { int fq_ = fq; asm volatile("" : "+v"(fq_)); E.init(acc, nxt, wc, fq_); }
        else {
#pragma unroll
        for (int a = 0; a < 2; ++a)
#pragma unroll
            for (int b = 0; b < 2; ++b)
#pragma unroll
                for (int m = 0; m < 4; ++m)
#pragma unroll
                    for (int n = 0; n < 2; ++n) acc[a][b][m][n] = (f32x4){0.f, 0.f, 0.f, 0.f};
        }
        cur = nxt; cA = nA; cB = nB; ++ui;
        if constexpr (ALIGN_EPI) { if (wr == 1) PG8_BAR; }
    }
    PG8_WAIT_V(0);
    if constexpr (!ALIGN_EPI) { if (wr == 0) PG8_BAR; }
    PG8_BAR;
    if constexpr (Epi::AFTER_DRAIN) { E.fused(acc, cur, wr, wc, fr, fq, lds, wid, lane); S.done(cur); }
#undef PG8_SA
#undef PG8_CAT8
#undef PG8_VA
#undef PG8_STA
#undef PG8_SB
#undef PG8_STAGE
#undef PG8_LDA
#undef PG8_LDB
#undef PG8_MMA
#undef PG8_WAIT_V
#undef PG8_WAIT_L
#undef PG8_BAR
#undef PG8_SCHED
}
}

#ifndef PG8_SP2
#define PG8_SP2 true
#endif
#ifndef PG8_ALIGN
#define PG8_ALIGN true
#endif
#define GAS __attribute__((address_space(1)))
#define LAS __attribute__((address_space(3)))
typedef unsigned short bf16;
typedef unsigned v4u __attribute__((ext_vector_type(4)));
typedef float f32x4 __attribute__((ext_vector_type(4)));
typedef short bf16x8 __attribute__((ext_vector_type(8)));
typedef GAS unsigned gu32;
typedef GAS unsigned long long gu64;
#define RLX_AGENT __ATOMIC_RELAXED, __HIP_MEMORY_SCOPE_AGENT
#define LDS_WAIT() asm volatile("s_waitcnt lgkmcnt(0)" ::: "memory")
#define VM_WAIT() asm volatile("s_waitcnt vmcnt(0)" ::: "memory")
__device__ __forceinline__ unsigned long long rt() { return __builtin_amdgcn_s_memrealtime(); }
__device__ __forceinline__ unsigned f2bf(float f) { unsigned u = __builtin_bit_cast(unsigned, f); return (u + 0x7fffu + ((u >> 16) & 1u)) >> 16; }
__device__ __forceinline__ unsigned pk2(float lo, float hi) { return f2bf(lo) | (f2bf(hi) << 16); }

#define XB_TMO      128
#define XB_XCNT(j)  (256  + 64 * (j))
#define XB_XSUB(j)  (1280 + 64 * (j))
#define XB_XGEN(j)  (2304 + 64 * (j))
#define XB_TOP      3328
#define XB_TOPGEN   3392
#define XCD_BAR_WORDS 3456
#define XB_SPIN_CAP (1u << 18)

__device__ __forceinline__ unsigned xb_ld(unsigned* p)              { return __hip_atomic_load(p, __ATOMIC_RELAXED, __HIP_MEMORY_SCOPE_AGENT); }
__device__ __forceinline__ unsigned xb_add(unsigned* p, unsigned v) { return __hip_atomic_fetch_add(p, v, __ATOMIC_RELAXED, __HIP_MEMORY_SCOPE_AGENT); }
__device__ __forceinline__ unsigned xb_xcc_id() { return (unsigned)__builtin_amdgcn_s_getreg((3 << 11) | 20) & 0xFu; }
#define XB_SPIN(cond, bar) do { unsigned _sp = 0; while (cond) { __builtin_amdgcn_s_sleep(1); \
    if ((++_sp & 255u) == 0u) { if (xb_ld(&(bar)[XB_TMO])) break; if (_sp > XB_SPIN_CAP) { atomicAdd(&(bar)[XB_TMO], 1u); break; } } } } while (0)

struct XcdBarrier {
    unsigned* bar; unsigned x;
    volatile LAS unsigned* st;
};

__device__ __forceinline__ XcdBarrier xcd_barrier_post(unsigned* bar, volatile LAS unsigned* st) {
    XcdBarrier b; b.bar = bar; b.x = xb_xcc_id(); b.st = st;
    if (threadIdx.x == 0) (void)xb_add(&bar[XB_XCNT(b.x)], 1u);
    return b;
}
__device__ __forceinline__ void xcd_barrier_complete(unsigned* bar, unsigned x, unsigned& nloc, unsigned& nx) {
    const unsigned G = gridDim.x * gridDim.y * gridDim.z;
    unsigned sum, cnt, mine, sp = 0u;
    for (;;) {
        sum = 0u; cnt = 0u; mine = 0u;
#pragma unroll
        for (unsigned j = 0; j < 16; ++j) { const unsigned c = xb_ld(&bar[XB_XCNT(j)]); sum += c; cnt += (c > 0u) ? 1u : 0u; mine = (j == x) ? c : mine; }
        if (sum == G) break;
        __builtin_amdgcn_s_sleep(1);
        if ((++sp & 255u) == 0u) { if (xb_ld(&bar[XB_TMO])) break; if (sp > XB_SPIN_CAP) { atomicAdd(&bar[XB_TMO], 1u); break; } }
    }
    nloc = mine > 0u ? mine : 1u; nx = cnt > 0u ? cnt : 1u;
}

__device__ __forceinline__ void xcd_barrier(const XcdBarrier& b) {
    asm volatile("s_waitcnt vmcnt(0)" ::: "memory");
    __syncthreads();
    if (threadIdx.x == 0) {
        unsigned* bar = b.bar;
        __builtin_amdgcn_s_waitcnt(0);
        unsigned nloc = b.st[0], nx = b.st[1];
        if (nloc == 0u) { xcd_barrier_complete(bar, b.x, nloc, nx); b.st[0] = nloc; b.st[1] = nx; }
        const unsigned old = xb_add(&bar[XB_XSUB(b.x)], 1u);
        const unsigned gen = old / nloc;
        if (old + 1u == (gen + 1u) * nloc) {
            __builtin_amdgcn_fence(__ATOMIC_RELEASE, "agent");
            asm volatile("s_waitcnt vmcnt(0)" ::: "memory");
            const unsigned og = xb_add(&bar[XB_TOP], 1u);
            const unsigned tg = og / nx;
            if (og + 1u == (tg + 1u) * nx) xb_add(&bar[XB_TOPGEN], 1u);
            else XB_SPIN(xb_ld(&bar[XB_TOPGEN]) == tg, bar);
            __builtin_amdgcn_fence(__ATOMIC_ACQUIRE, "agent");
            xb_add(&bar[XB_XGEN(b.x)], 1u);
            asm volatile("s_waitcnt vmcnt(0)" ::: "memory");
        } else {
            XB_SPIN(xb_ld(&bar[XB_XGEN(b.x)]) == gen, bar);
            __builtin_amdgcn_fence(__ATOMIC_ACQUIRE, "agent");
            asm volatile("s_waitcnt vmcnt(0)" ::: "memory");
        }
    }
    __syncthreads();
}

constexpr int NWAVES = 8;
#ifndef MK_ONE_LAUNCH
#define MK_ONE_LAUNCH 1
#endif

constexpr int BATCH = 16, SEQ = 2048, D = 1024, T = BATCH * SEQ;
constexpr int NIN = 3584;
constexpr int OFF_SQ = 0, OFF_SK = 512, OFF_SV = 1024, OFF_HQ = 1536, OFF_HF = 2048, OFF_HI = 2560, OFF_HG = 3072;
constexpr int NE = 32, TOPK = 4, NASSIGN = T * TOPK;
constexpr int MAXTILES = NASSIGN / 256 + NE;
constexpr int MAXROWS = MAXTILES * 256;
constexpr float EPS = 1e-6f;

constexpr size_t MiB = 1u << 20;
constexpr size_t WS_CTL = 0, CTL_ZERO_BYTES = 1 * MiB;
constexpr size_t WS_WIN = 2 * MiB;
constexpr size_t WS_WOUT = 10 * MiB;
constexpr size_t WS_RT = 12 * MiB;
constexpr size_t WS_WGU = 16 * MiB;
constexpr size_t WS_WD = 144 * MiB;
constexpr size_t WS_XN = 208 * MiB;
constexpr size_t WS_P = 272 * MiB;
constexpr size_t WS_PH = WS_P + 96 * MiB;
constexpr size_t WS_MIX = 496 * MiB;
constexpr size_t WS_ACT = 272 * MiB;
constexpr size_t WS_YK = 560 * MiB;
constexpr size_t WS_QN = 624 * MiB;
constexpr size_t WS_KN = 656 * MiB;
constexpr size_t WS_VT = 688 * MiB;
constexpr size_t WS_KVS = 720 * MiB;
constexpr size_t WS_DEC = 784 * MiB;
constexpr size_t WS_SSEG = 786 * MiB;
constexpr size_t WS_DSEG = 802 * MiB;
constexpr size_t WS_LIST = 816 * MiB;
constexpr size_t WS_TOPG = 825 * MiB;
constexpr size_t WS_X8 = 560 * MiB;
constexpr size_t WS_END = 832 * MiB;
static_assert(WS_ACT + (size_t)MAXROWS * 2048 <= WS_YK && WS_YK + (size_t)T * 4 * 2048 <= WS_LIST && WS_MIX + (size_t)T * 2048 <= WS_YK, "d_ws map");
constexpr int CW_TMO = 0, CW_CODE = 1;
constexpr int CW_CNT = 64;
constexpr int CW_BAR = 4096;

constexpr int RING_OFF = 0, RING_BYTES = 131072;
constexpr int RT_ROW = 2064, RT_WL = 32 * RT_ROW, RT_END = 64 * RT_ROW;
constexpr int LDSCTL_OFF = 133120, MISC_OFF = LDSCTL_OFF + 320;
constexpr int LTAB_OFF = LDSCTL_OFF + 512;
constexpr int LT_TS = MAXTILES, LT_CNT = MAXTILES + 32, LT_MISC = MAXTILES + 64, LT_WORDS = MAXTILES + 192;
constexpr int ROWTAB_OFF = LTAB_OFF + LT_WORDS * 4;
constexpr int MAXSLOT = 17;
constexpr int ROWTAB2_OFF = ROWTAB_OFF + MAXSLOT * 1024;
constexpr int LDS_BYTES = ROWTAB2_OFF + MAXSLOT * 512;
static_assert(RT_END <= LDSCTL_OFF && MISC_OFF + 128 <= LTAB_OFF && LDS_BYTES <= 160 * 1024 && (MAXTILES * 8 + 255) / 256 <= MAXSLOT && 2 * ((MAXTILES * 4 + 255) / 256) * 1024 <= MAXSLOT * 1536 && ROWTAB_OFF % 16 == 0, "LDS map");

struct Frame {
    LAS unsigned char* lds;
    volatile LAS unsigned* MISC;
    gu32* ctl;
    int tid, lane, wave, gw, ngw;
    int vcu, G;
    const float *x, *norm1_g, *w_in, *sb_q_g, *sb_k_g, *sb_out_g, *hg_lb, *hg_out_g, *w_out, *norm2_g, *w_router, *b_router, *w_gu, *b_gu, *w_d, *b_d;
    float* out;
    unsigned char* ws;
};
__device__ __forceinline__ float bf2f(unsigned short b) { return __builtin_bit_cast(float, (unsigned)b << 16); }
__device__ __forceinline__ float bflo(unsigned w) { return __builtin_bit_cast(float, w << 16); }
__device__ __forceinline__ float bfhi(unsigned w) { return __builtin_bit_cast(float, w & 0xffff0000u); }
typedef __bf16 bf16x2n_ __attribute__((ext_vector_type(2)));
typedef float f32x2n_ __attribute__((ext_vector_type(2)));
__device__ __forceinline__ unsigned pkbf(float a, float b) { const bf16x2n_ v = __builtin_convertvector((f32x2n_){a, b}, bf16x2n_); return __builtin_bit_cast(unsigned, v); }
__device__ __forceinline__ int lane_id() { int l; asm volatile("v_mbcnt_lo_u32_b32 %0, -1, 0\n\tv_mbcnt_hi_u32_b32 %0, -1, %0" : "=v"(l)); return l; }
__device__ __forceinline__ int vzero() { int z; asm volatile("v_mov_b32 %0, 0" : "=v"(z)); return z; }
__device__ __forceinline__ float wave_sum(float v) {
#pragma unroll
    for (int o = 1; o < 64; o <<= 1) v += __shfl_xor(v, o);
    return v;
}

constexpr float W8_SCALE = 256.f, A8_SCALE = 4.f, Y8_SCALE = 32.f; static_assert(Y8_SCALE == 32.f, "SC_W8Y below is 2^-8 * 32");
constexpr int SC_ONE = 0x7f7f7f7f, SC_W8 = 0x77777777, SC_A8 = 0x7d7d7d7d, SC_W8Y = 0x7c7c7c7c;
struct P0Item { const float* W; bf16* WT; const float* rowscale; int N, k0, n0, drow0, fp8, perm; };
__device__ __forceinline__ void p0_load(const P0Item& it, f32x4 (&v)[16], int lane) {
    const int kr = lane >> 4, nc = 4 * (lane & 15);
#pragma unroll
    for (int i = 0; i < 16; ++i) v[i] = __builtin_nontemporal_load((const f32x4*)(it.W + (size_t)(it.k0 + 4 * i + kr) * it.N + it.n0 + nc));
}
__device__ __forceinline__ void p0_store(const P0Item& it, const f32x4 (&v)[16], LAS unsigned char* scr, int lane) {
    const int kr = lane >> 4, nc = 4 * (lane & 15);
#pragma unroll
    for (int i = 0; i < 16; ++i) { const float sc = it.rowscale ? it.rowscale[it.k0 + 4 * i + kr] : 1.f;
        *(LAS unsigned long long*)(scr + (4 * i + kr) * 136 + 2 * nc) = (unsigned long long)pkbf(v[i].x * sc, v[i].y * sc) | ((unsigned long long)pkbf(v[i].z * sc, v[i].w * sc) << 32); }
    LDS_WAIT(); asm volatile("" ::: "memory");
    const LAS unsigned short* s16 = (const LAS unsigned short*)scr;
    if (it.fp8) { const int p = lane & 3, nr = lane >> 2;
#pragma unroll
        for (int c = 0; c < 4; ++c) { const int n = 16 * c + nr; unsigned val[16];
#pragma unroll
            for (int kk = 0; kk < 16; ++kk) val[kk] = s16[(16 * p + kk) * 68 + n];
            v4u w4;
            w4.x = pg8::pk4_fp8(bflo(val[0]) * W8_SCALE, bflo(val[1]) * W8_SCALE, bflo(val[2]) * W8_SCALE, bflo(val[3]) * W8_SCALE);
            w4.y = pg8::pk4_fp8(bflo(val[4]) * W8_SCALE, bflo(val[5]) * W8_SCALE, bflo(val[6]) * W8_SCALE, bflo(val[7]) * W8_SCALE);
            w4.z = pg8::pk4_fp8(bflo(val[8]) * W8_SCALE, bflo(val[9]) * W8_SCALE, bflo(val[10]) * W8_SCALE, bflo(val[11]) * W8_SCALE);
            w4.w = pg8::pk4_fp8(bflo(val[12]) * W8_SCALE, bflo(val[13]) * W8_SCALE, bflo(val[14]) * W8_SCALE, bflo(val[15]) * W8_SCALE);
            *(GAS v4u*)((unsigned char*)it.WT + (size_t)(it.drow0 + n) * D + it.k0 + 16 * p) = w4; }
    } else { const int p = lane & 7, nr = lane >> 3;
#pragma unroll
        for (int c = 0; c < 8; ++c) { const int n = 8 * c + nr; unsigned val[8];
#pragma unroll
            for (int kk = 0; kk < 8; ++kk) val[kk] = s16[(8 * p + kk) * 68 + n];
            v4u w4; w4.x = val[0] | (val[1] << 16); w4.y = val[2] | (val[3] << 16); w4.z = val[4] | (val[5] << 16); w4.w = val[6] | (val[7] << 16);
            *(GAS v4u*)(it.WT + (size_t)(it.drow0 + (it.perm ? 128 * (n >> 5) + (n & 31) : n)) * D + it.k0 + 8 * p) = w4; } }
    LDS_WAIT(); asm volatile("" ::: "memory");
}
__device__ __forceinline__ void rms_rows2_to_bf16(const float* xa, const float* xb, bool hasb, const float* g, bf16* oa, bf16* ob, int lane) {
    const GAS f32x4* pa = (const GAS f32x4*)xa + lane; const GAS f32x4* pb = (const GAS f32x4*)(hasb ? xb : xa) + lane; const f32x4* gr = (const f32x4*)g + lane;
    f32x4 va[4], vb[4], gg[4]; float sa = 0.f, sb = 0.f;
#pragma unroll
    for (int j = 0; j < 4; ++j) { va[j] = __builtin_nontemporal_load(pa + 64 * j); vb[j] = __builtin_nontemporal_load(pb + 64 * j); gg[j] = gr[64 * j]; }
#pragma unroll
    for (int j = 0; j < 4; ++j) { sa += (va[j].x * va[j].x + va[j].y * va[j].y) + (va[j].z * va[j].z + va[j].w * va[j].w); sb += (vb[j].x * vb[j].x + vb[j].y * vb[j].y) + (vb[j].z * vb[j].z + vb[j].w * vb[j].w); }
    const float ra = 1.f / sqrtf(wave_sum(sa) * (1.f / D) + EPS), rb = 1.f / sqrtf(wave_sum(sb) * (1.f / D) + EPS);
    GAS unsigned long long* o8a = (GAS unsigned long long*)oa + lane; GAS unsigned long long* o8b = (GAS unsigned long long*)ob + lane;
#pragma unroll
    for (int j = 0; j < 4; ++j) o8a[64 * j] = (unsigned long long)pkbf(va[j].x * ra * gg[j].x, va[j].y * ra * gg[j].y) | ((unsigned long long)pkbf(va[j].z * ra * gg[j].z, va[j].w * ra * gg[j].w) << 32);
    if (hasb) {
#pragma unroll
        for (int j = 0; j < 4; ++j) o8b[64 * j] = (unsigned long long)pkbf(vb[j].x * rb * gg[j].x, vb[j].y * rb * gg[j].y) | ((unsigned long long)pkbf(vb[j].z * rb * gg[j].z, vb[j].w * rb * gg[j].w) << 32); }
}
__device__ __forceinline__ P0Item p0_item(Frame& F, int r) {
    constexpr int I_IN = 16 * (NIN / 64), I_OUT = 16 * 16, I_GU = NE * 16 * 32;
    P0Item it;
    if (r < I_IN) { const int nb = NIN / 64, kb = r / nb, nn = r % nb; const int pq = nn < 16; it = P0Item{F.w_in, (bf16*)(F.ws + WS_WIN), nullptr, NIN, 64 * kb, 64 * nn, pq ? 256 * (nn >> 2) + 32 * (nn & 3) : 64 * nn, 0, pq}; return it; } r -= I_IN;
    if (r < I_OUT) { const int kb = r / 16, nn = r % 16; it = P0Item{F.w_out, (bf16*)(F.ws + WS_WOUT), nullptr, D, 64 * kb, 64 * nn, 64 * nn, 0, 0}; return it; } r -= I_OUT;
    if (r < I_GU) { const int e = r / 512, q = r % 512, kb = q / 32, nn = q % 32;
        const int isup = nn >> 4, a = (nn & 15) * 64;
        it = P0Item{F.w_gu + (size_t)e * D * 2048, (bf16*)(F.ws + WS_WGU + (size_t)e * 2048 * D), F.norm2_g, 2048, 64 * kb, 64 * nn, 256 * (a >> 7) + 128 * isup + (a & 127), 1, 0}; return it; } r -= I_GU;
    { const int e = r / 256, q = r % 256, kb = q / 16, nn = q % 16;
        it = P0Item{F.w_d + (size_t)e * D * D, (bf16*)(F.ws + WS_WD + (size_t)e * D * D), nullptr, D, 64 * kb, 64 * nn, 64 * nn, 1, 0}; return it; }
}
constexpr int P0_NITEMS = 16 * (NIN / 64) + 16 * 16 + NE * 16 * 32 + NE * 16 * 16;
constexpr int P0_NLATE = 1024;
__device__ __forceinline__ void p0_items(Frame& F, int lo, int hi, int w, int nw) {
    LAS unsigned char* scr = F.lds + RING_OFF + F.wave * 16384;
    f32x4 va[16], vb[16]; int it = lo + w;
    if (it < hi) { P0Item A = p0_item(F, it); p0_load(A, va, F.lane);
        for (;;) {
            const int itb = it + nw; const bool hb = itb < hi; const P0Item B = p0_item(F, hb ? itb : it); p0_load(B, vb, F.lane); __builtin_amdgcn_sched_barrier(0);
            p0_store(A, va, scr, F.lane);
            if (!hb) break;
            it = itb + nw; const bool ha = it < hi; A = p0_item(F, ha ? it : itb); p0_load(A, va, F.lane); __builtin_amdgcn_sched_barrier(0);
            p0_store(B, vb, scr, F.lane);
            if (!ha) break;
        }
    }
}
__device__ __forceinline__ void p0_prologue(Frame& F) {
    p0_items(F, 0, P0_NITEMS - P0_NLATE, F.gw, F.ngw);
    for (int q = blockIdx.x * (NWAVES * 64) + F.tid; q < 4096; q += F.G * NWAVES * 64) {
        const int e = q & 31, k0 = (q >> 5) * 8; unsigned hi[8], lo[8];
#pragma unroll
        for (int j = 0; j < 8; ++j) { const float w = F.w_router[(k0 + j) * 32 + e] * F.norm2_g[k0 + j]; hi[j] = pkbf(w, 0.f) & 0xffffu; lo[j] = pkbf(w - bflo(hi[j]), 0.f) & 0xffffu; }
        const v4u h4 = {hi[0] | (hi[1] << 16), hi[2] | (hi[3] << 16), hi[4] | (hi[5] << 16), hi[6] | (hi[7] << 16)}, l4 = {lo[0] | (lo[1] << 16), lo[2] | (lo[3] << 16), lo[4] | (lo[5] << 16), lo[6] | (lo[7] << 16)};
        *(GAS v4u*)(F.ws + WS_RT + e * RT_ROW + 2 * k0) = h4; *(GAS v4u*)(F.ws + WS_RT + RT_WL + e * RT_ROW + 2 * k0) = l4; }
    for (int m = F.gw; m < T; m += 2 * F.ngw) rms_rows2_to_bf16(F.x + (size_t)m * D, F.x + (size_t)(m + F.ngw) * D, m + F.ngw < T, F.norm1_g, (bf16*)(F.ws + WS_XN) + (size_t)m * D, (bf16*)(F.ws + WS_XN) + (size_t)(m + F.ngw) * D, F.lane);
}

typedef float f32x16 __attribute__((ext_vector_type(16)));
typedef __bf16 bf16x2n __attribute__((ext_vector_type(2)));
typedef float f32x2n __attribute__((ext_vector_type(2)));
#define MFMA32(a, b, c) __builtin_amdgcn_mfma_f32_32x32x16_bf16((a), (b), (c), 0, 0, 0)
__device__ __forceinline__ bf16x8 pack8(float a0, float a1, float a2, float a3, float a4, float a5, float a6, float a7) { const v4u p = {pkbf(a0, a1), pkbf(a2, a3), pkbf(a4, a5), pkbf(a6, a7)}; return __builtin_bit_cast(bf16x8, p); }
constexpr float QSCALE = 0.125f * 1.44269504089f;
__device__ __forceinline__ void prep_phase(Frame& F) {
    LAS unsigned* tl = (LAS unsigned*)(F.lds + RING_OFF + F.wave * 16384);
    const bf16* P = (const bf16*)(F.ws + WS_P); bf16* Qn = (bf16*)(F.ws + WS_QN); bf16* Kn = (bf16*)(F.ws + WS_KN); bf16* VT = (bf16*)(F.ws + WS_VT);
    const int tr = F.lane >> 3, c8 = F.lane & 7;
    for (int it = F.gw; it < 4096; it += F.ngw) {
        const int bh = it & 127, blk = it >> 7, b = bh >> 3, h = bh & 7;
        const bf16* base = P + ((size_t)b * 8 + h) * SEQ * 64 + (size_t)(blk * 64 + tr) * 64 + 8 * c8;
        v4u rv[8];
#pragma unroll
        for (int i = 0; i < 8; ++i) { const bf16* row = base + (size_t)(8 * i) * 64; rv[i] = *(const GAS v4u*)(row + (size_t)2 * 16 * 8 * SEQ * 64); }
        {
#pragma unroll
            for (int i = 0; i < 8; ++i) { LAS unsigned* q = tl + (8 * i + tr) * 33 + 4 * c8; q[0] = rv[i].x; q[1] = rv[i].y; q[2] = rv[i].z; q[3] = rv[i].w; }
            LDS_WAIT(); asm volatile("" ::: "memory");
            const LAS unsigned short* t16 = (const LAS unsigned short*)tl; const int dr = tr;
#define KAP(pos) (((pos) & ~12) | (((pos) & 4) << 1) | (((pos) & 8) >> 1))
            bf16* const obase = VT + ((size_t)bh * 64 + blk * 2 + (c8 >> 2)) * 2048 + ((c8 >> 1) & 1) * 512 + (c8 & 1) * 256;
#pragma unroll
            for (int j = 0; j < 8; ++j) { unsigned val[8];
#pragma unroll
                for (int p = 0; p < 8; ++p) { const int pos = 8 * c8 + p; val[p] = t16[KAP(pos) * 66 + 8 * j + dr]; }
                v4u w4; w4.x = val[0] | (val[1] << 16); w4.y = val[2] | (val[3] << 16); w4.z = val[4] | (val[5] << 16); w4.w = val[6] | (val[7] << 16);
                *(GAS v4u*)(obase + (j >> 2) * 1024 + ((8 * j + dr) & 31) * 8) = w4; }
#undef KAP
            LDS_WAIT(); asm volatile("" ::: "memory");
        }
    }
}

__device__ __forceinline__ int crow16(int i, int hh) { return (i & 3) + 8 * (i >> 2) + 4 * hh; }
__device__ __forceinline__ void attn_item(Frame& F, int bh, int qb, float thr, const bf16x8 (&Lt)[2]) {
    const int r = F.lane & 31, hh = F.lane >> 5, b = bh >> 3, h = bh & 7, q0 = qb * 32;
    const bf16* Qn = (const bf16*)(F.ws + WS_QN); const bf16* Kn = (const bf16*)(F.ws + WS_KN); const bf16* VT = (const bf16*)(F.ws + WS_VT);
    bf16x8 qf[4];
#pragma unroll
    for (int s = 0; s < 4; ++s) qf[s] = *(const GAS bf16x8*)(Qn + ((size_t)bh * 64 + qb) * 2048 + s * 512 + F.lane * 8);
    f32x4 gout[2][4];
#pragma unroll
    for (int db = 0; db < 2; ++db)
#pragma unroll
        for (int gq = 0; gq < 4; ++gq) gout[db][gq] = *(const f32x4*)(F.sb_out_g + h * 64 + 32 * db + 8 * gq + 4 * hh);
    f32x16 O0, O1;
#pragma unroll
    for (int i = 0; i < 16; ++i) { O0[i] = 0.f; O1[i] = 0.f; }
    float carry = 0.f;
    const bf16* kbase = Kn + (size_t)bh * 64 * 2048 + F.lane * 8; const bf16* vbase = VT + (size_t)bh * 64 * 2048 + F.lane * 8;
#define ATT_LOAD(KF, VF, kb_) do { _Pragma("unroll") for (int s_ = 0; s_ < 4; ++s_) KF[s_] = *(const GAS bf16x8*)(kbase + (size_t)(kb_) * 2048 + 512 * s_); \
        _Pragma("unroll") for (int db_ = 0; db_ < 2; ++db_) _Pragma("unroll") for (int ks_ = 0; ks_ < 2; ++ks_) VF[db_][ks_] = *(const GAS bf16x8*)(vbase + (size_t)(kb_) * 2048 + 1024 * db_ + 512 * ks_); } while (0)
#define ATT_BLOCK(KF, VF, kb_) do { const bool diag = ((kb_) == qb); \
        f32x16 z; _Pragma("unroll") for (int i = 0; i < 16; ++i) z[i] = 0.f; \
        _Pragma("unroll") for (int s_ = 0; s_ < 4; ++s_) z = MFMA32(KF[s_], qf[s_], z); \
        float sp[16]; \
        _Pragma("unroll") for (int i = 0; i < 16; ++i) { const float zz = z[i]; float v = fmaxf(zz, 0.f) + __builtin_amdgcn_logf(1.f + __builtin_amdgcn_exp2f(-fabsf(zz))); if (diag && !(crow16(i, hh) < r)) v = 0.f; sp[i] = v; } \
        const bf16x8 sb0 = pack8(sp[0], sp[1], sp[2], sp[3], sp[4], sp[5], sp[6], sp[7]), sb1 = pack8(sp[8], sp[9], sp[10], sp[11], sp[12], sp[13], sp[14], sp[15]); \
        f32x16 Cc; _Pragma("unroll") for (int i = 0; i < 16; ++i) Cc[i] = carry; \
        Cc = MFMA32(Lt[0], sb0, Cc); Cc = MFMA32(Lt[1], sb1, Cc); \
        float w[16]; \
        _Pragma("unroll") for (int i = 0; i < 16; ++i) { float v = __builtin_amdgcn_exp2f(z[i] - Cc[i]); if (diag && !(crow16(i, hh) < r)) v = 0.f; w[i] = v; } \
        const bf16x8 wb0 = pack8(w[0], w[1], w[2], w[3], w[4], w[5], w[6], w[7]), wb1 = pack8(w[8], w[9], w[10], w[11], w[12], w[13], w[14], w[15]); \
        O0 = MFMA32(VF[0][0], wb0, O0); O0 = MFMA32(VF[0][1], wb1, O0); O1 = MFMA32(VF[1][0], wb0, O1); O1 = MFMA32(VF[1][1], wb1, O1); \
        carry = __shfl(Cc[0], r); } while (0)
    bf16x8 kfA[4], vfA[2][2], kfB[4], vfB[2][2];
    ATT_LOAD(kfA, vfA, qb);
    for (int kb = qb; kb >= 0; kb -= 2) {
        ATT_LOAD(kfB, vfB, kb > 0 ? kb - 1 : 0); __builtin_amdgcn_sched_barrier(0);
        ATT_BLOCK(kfA, vfA, kb);
        if (kb == 0 || __all(carry > thr)) break;
        ATT_LOAD(kfA, vfA, kb > 1 ? kb - 2 : 0); __builtin_amdgcn_sched_barrier(0);
        ATT_BLOCK(kfB, vfB, kb - 1);
        if (__all(carry > thr)) break;
    }
#undef ATT_LOAD
#undef ATT_BLOCK
    float ss = 0.f;
#pragma unroll
    for (int i = 0; i < 16; ++i) ss += O0[i] * O0[i] + O1[i] * O1[i];
    ss += __shfl_xor(ss, 32);
    const float rs = 1.f / sqrtf(ss * (1.f / 64.f) + EPS);
    bf16* orow = (bf16*)(F.ws + WS_MIX) + ((size_t)b * SEQ + q0 + r) * D + h * 64;
#pragma unroll
    for (int db = 0; db < 2; ++db)
#pragma unroll
        for (int gq = 0; gq < 4; ++gq) { const int d = 32 * db + 8 * gq + 4 * hh; const f32x4 gg = gout[db][gq];
            const float a0 = (db ? O1[4 * gq + 0] : O0[4 * gq + 0]) * rs * gg.x, a1 = (db ? O1[4 * gq + 1] : O0[4 * gq + 1]) * rs * gg.y, a2 = (db ? O1[4 * gq + 2] : O0[4 * gq + 2]) * rs * gg.z, a3 = (db ? O1[4 * gq + 3] : O0[4 * gq + 3]) * rs * gg.w;
            *(GAS unsigned long long*)(orow + d) = (unsigned long long)pkbf(a0, a1) | ((unsigned long long)pkbf(a2, a3) << 32); }
}
__device__ __forceinline__ void attn_phase(Frame& F) {
    const int r = F.lane & 31, hh = F.lane >> 5;
    float mq = fabsf(F.sb_q_g[F.lane]), mk = fabsf(F.sb_k_g[F.lane]);
#pragma unroll
    for (int o = 1; o < 64; o <<= 1) { mq = fmaxf(mq, __shfl_xor(mq, o)); mk = fmaxf(mk, __shfl_xor(mk, o)); }
    const float thr = 64.f * QSCALE * mq * mk * 1.02f + 151.f;
    bf16x8 Lt[2];
#pragma unroll
    for (int ks = 0; ks < 2; ++ks) { float e[8];
#pragma unroll
        for (int jj = 0; jj < 8; ++jj) e[jj] = (16 * ks + 8 * (jj >> 2) + 4 * hh + (jj & 3) >= r) ? 1.f : 0.f;
        Lt[ks] = pack8(e[0], e[1], e[2], e[3], e[4], e[5], e[6], e[7]); }
    for (int it = F.gw; it < 2048; it += F.ngw) { const int bh = it & 127, j = it >> 7;
        attn_item(F, bh, 63 - j, thr, Lt); attn_item(F, bh, j, thr, Lt); attn_item(F, bh, 47 - j, thr, Lt); attn_item(F, bh, 16 + j, thr, Lt); }
}

constexpr int HG_PART = 0, HG_SSQ = 2048, HG_QE = 4096, HG_KE = HG_QE + 64 * 272, HG_VT = HG_KE + 64 * 272, HG_KST = HG_VT + 128 * 144, HG_ST = HG_KST + 128 * 144, HG_END = HG_ST + 128 * 272;
static_assert(HG_END <= RING_BYTES, "HGRN2 LDS map");
__device__ __forceinline__ float hg_lbound(Frame& F, int h, int d) { const int c = h * 128 + d; return 1.f / (1.f + __expf(F.hg_lb[512 + c] - F.hg_lb[c])); }
__device__ __forceinline__ void hg_gates(Frame& F, const unsigned short (&ffr)[16], float lb, int d, int tq, float (&bb)[16], float (&kk)[16], float& total) {
    float run = 1.f;
#pragma unroll
    for (int i = 0; i < 16; ++i) { const float ff = bf2f(ffr[i]); const float sg = __builtin_amdgcn_rcpf(1.f + __expf(-ff));
        const float f = lb + (1.f - lb) * sg; kk[i] = (1.f - lb) * (1.f - sg); run *= f; bb[i] = run; }
    LAS float* part = (LAS float*)(F.lds + RING_OFF + HG_PART);
    part[tq * 128 + d] = run;
    __syncthreads();
    const float p0 = part[d], p1 = part[128 + d], p2 = part[256 + d], p3 = part[384 + d];
    const float off = (tq > 0 ? p0 : 1.f) * (tq > 1 ? p1 : 1.f) * (tq > 2 ? p2 : 1.f);
    total = (p0 * p1) * (p2 * p3);
#pragma unroll
    for (int i = 0; i < 16; ++i) bb[i] *= off;
}
#define HG_HV() const bf16* const PHp = (const bf16*)(F.ws + WS_PH); \
    const __amdgpu_buffer_rsrc_t rsrcP = __builtin_amdgcn_make_buffer_rsrc((void*)PHp, 0, (int)((size_t)4 * T * 512 * 2), 0x00020000)
#define HG_SOFF(item_, arr_) ((unsigned)((((arr_) * 16 + (((item_) >> 5) >> 2)) * 4 + (((item_) >> 5) & 3)) * SEQ + ((item_) & 31) * 64) * 256u)
#define HG_ARR(col_) ((col_) == OFF_HQ ? 0 : (col_) == OFF_HF ? 1 : (col_) == OFF_HI ? 2 : 3)
#define HG_LOADT(dst2, item_, arr_) do { const unsigned so_ = (unsigned)__builtin_amdgcn_readfirstlane((int)HG_SOFF(item_, arr_)); _Pragma("unroll") for (int j_ = 0; j_ < 2; ++j_) \
        (dst2)[j_] = __builtin_bit_cast(v4u, __builtin_amdgcn_raw_buffer_load_b128(rsrcP, (unsigned)F.tid * 16u + 8192u * j_, so_, 0)); } while (0)
#define HG_PUT(src2, raw_) do { _Pragma("unroll") for (int j_ = 0; j_ < 2; ++j_) *(LAS v4u*)((raw_) + ((F.tid >> 4) + 32 * j_) * 272 + (F.tid & 15) * 16) = (src2)[j_]; } while (0)
#define HG_COL(dst, raw_) do { _Pragma("unroll") for (int i_ = 0; i_ < 16; ++i_) dst[i_] = *(const LAS unsigned short*)((raw_) + (16 * tq + i_) * 272 + 2 * d); } while (0)
template <bool PERMUTE> __device__ __forceinline__ void st16(LAS unsigned char* dst, const float (&v)[16]) {
    v4u a, b2;
    if (!PERMUTE) { a.x = pkbf(v[0], v[1]); a.y = pkbf(v[2], v[3]); a.z = pkbf(v[4], v[5]); a.w = pkbf(v[6], v[7]); b2.x = pkbf(v[8], v[9]); b2.y = pkbf(v[10], v[11]); b2.z = pkbf(v[12], v[13]); b2.w = pkbf(v[14], v[15]); }
    else { a.x = pkbf(v[0], v[1]); a.y = pkbf(v[2], v[3]); a.z = pkbf(v[8], v[9]); a.w = pkbf(v[10], v[11]); b2.x = pkbf(v[4], v[5]); b2.y = pkbf(v[6], v[7]); b2.z = pkbf(v[12], v[13]); b2.w = pkbf(v[14], v[15]); }
    *(LAS v4u*)dst = a; *(LAS v4u*)(dst + 16) = b2;
}
__device__ __forceinline__ void hgA_phase(Frame& F) {
    const int d = F.tid & 127, tq = F.tid >> 7, r = F.lane & 31, hh = F.lane >> 5;
    const bf16* P = (const bf16*)(F.ws + WS_P); bf16* KVS = (bf16*)(F.ws + WS_KVS); float* DEC = (float*)(F.ws + WS_DEC); float* SSEG = (float*)(F.ws + WS_SSEG); float* DSEG = (float*)(F.ws + WS_DSEG);
    LAS unsigned char* L = F.lds + RING_OFF; LAS float* decl = (LAS float*)(L + HG_SSQ);
    HG_HV();
    v4u rf[2], rv[2];
    LAS unsigned char* const RAWF = F.lds + ROWTAB_OFF; LAS unsigned char* const RAWV = L + HG_ST;
    for (int wg = blockIdx.x; wg < 256; wg += F.G) {
        const int bh = wg >> 2, seg = wg & 3, item0 = bh * 32 + seg * 8, h = bh & 3;
        HG_LOADT(rf, item0, 1); HG_LOADT(rv, item0, 2);
        const float lbv = hg_lbound(F, h, d); float totrun = 1.f;
        const int db = F.wave & 3, eb0 = 2 * (F.wave >> 2);
        f32x16 run0, run1;
#pragma unroll
        for (int i = 0; i < 16; ++i) { run0[i] = 0.f; run1[i] = 0.f; }
      for (int k = 0; k < 8; ++k) {
        const int item = item0 + k;
        HG_PUT(rf, RAWF); HG_PUT(rv, RAWV);
        __syncthreads();
        { const int nit = k < 7 ? item + 1 : item; HG_LOADT(rf, nit, 1); HG_LOADT(rv, nit, 2); __builtin_amdgcn_sched_barrier(0); }
        unsigned short ffr[16], vr[16]; HG_COL(ffr, RAWF); HG_COL(vr, RAWV);
        float bb[16], kk[16], total; hg_gates(F, ffr, lbv, d, tq, bb, kk, total);
        float ks[16], vv[16];
#pragma unroll
        for (int i = 0; i < 16; ++i) { ks[i] = kk[i] * (total * __builtin_amdgcn_rcpf(bb[i])); vv[i] = bf2f(vr[i]); }
        st16<false>(L + HG_KST + d * 144 + tq * 32, ks); st16<false>(L + HG_VT + d * 144 + tq * 32, vv);
        const float dc = total; totrun *= total;
        if (tq == 0) { DEC[(size_t)item * 128 + d] = dc; decl[d] = dc; }
        __syncthreads();
        f32x16 acc0, acc1;
#pragma unroll
        for (int i = 0; i < 16; ++i) { acc0[i] = 0.f; acc1[i] = 0.f; }
#pragma unroll
        for (int s = 0; s < 4; ++s) { const bf16x8 af = *(const LAS bf16x8*)(L + HG_KST + (db * 32 + r) * 144 + 32 * s + 16 * hh);
            const bf16x8 b0 = *(const LAS bf16x8*)(L + HG_VT + (eb0 * 32 + r) * 144 + 32 * s + 16 * hh), b1 = *(const LAS bf16x8*)(L + HG_VT + ((eb0 + 1) * 32 + r) * 144 + 32 * s + 16 * hh);
            acc0 = MFMA32(af, b0, acc0); acc1 = MFMA32(af, b1, acc1); }
#pragma unroll
        for (int g = 0; g < 4; ++g) { const f32x4 dl = *(const LAS f32x4*)(decl + db * 32 + 8 * g + 4 * hh);
#pragma unroll
            for (int ii = 0; ii < 4; ++ii) { run0[4 * g + ii] = dl[ii] * run0[4 * g + ii] + acc0[4 * g + ii]; run1[4 * g + ii] = dl[ii] * run1[4 * g + ii] + acc1[4 * g + ii]; } }
#pragma unroll
        for (int j = 0; j < 2; ++j) { bf16* dst = KVS + ((size_t)item * 128 + (eb0 + j) * 32 + r) * 128 + db * 32 + 4 * hh;
#pragma unroll
            for (int g = 0; g < 4; ++g) { const float a0 = j ? acc1[4 * g + 0] : acc0[4 * g + 0], a1 = j ? acc1[4 * g + 1] : acc0[4 * g + 1], a2 = j ? acc1[4 * g + 2] : acc0[4 * g + 2], a3 = j ? acc1[4 * g + 3] : acc0[4 * g + 3];
                *(GAS unsigned long long*)(dst + 8 * g) = (unsigned long long)pkbf(a0, a1) | ((unsigned long long)pkbf(a2, a3) << 32); } }
        __syncthreads();
      }
#pragma unroll
        for (int j = 0; j < 2; ++j) { float* dst = SSEG + ((size_t)wg * 128 + (eb0 + j) * 32 + r) * 128 + db * 32 + 4 * hh;
#pragma unroll
            for (int g = 0; g < 4; ++g) *(GAS f32x4*)(dst + 8 * g) = j ? (f32x4){run1[4 * g + 0], run1[4 * g + 1], run1[4 * g + 2], run1[4 * g + 3]} : (f32x4){run0[4 * g + 0], run0[4 * g + 1], run0[4 * g + 2], run0[4 * g + 3]}; }
        if (tq == 0) DSEG[(size_t)wg * 128 + d] = totrun;
    }
}
constexpr int HG_DECS = HG_END;
static_assert(HG_DECS + 4096 + 64 * 272 <= LDSCTL_OFF && HG_KST + 64 * 272 <= HG_ST && 64 * 272 <= MAXSLOT * 1536, "HGRN2 LDS map (decays, raw tiles)");
__device__ __forceinline__ void hgC_phase(Frame& F) {
    const int d = F.tid & 127, tq = F.tid >> 7, r = F.lane & 31, hh = F.lane >> 5;
    const bf16* P = (const bf16*)(F.ws + WS_P); const bf16* KVS = (const bf16*)(F.ws + WS_KVS); bf16* MIX = (bf16*)(F.ws + WS_MIX); const float* DEC = (const float*)(F.ws + WS_DEC);
    HG_HV();
    LAS unsigned char* L = F.lds + RING_OFF; const LAS float* decs = (const LAS float*)(L + HG_DECS);
    const int se = F.tid >> 2, sq = F.tid & 3;
    v4u rf[2], rq[2], rv[2], st[4];
    LAS unsigned char* const RAWF = L + HG_KST; LAS unsigned char* const RAWQ = F.lds + ROWTAB_OFF; LAS unsigned char* const RAWV = L + HG_DECS + 4096;
    const __amdgpu_buffer_rsrc_t rsrcG = __builtin_amdgcn_make_buffer_rsrc((void*)F.hg_out_g, 0, 512 * 4, 0x00020000), rsrcSS = __builtin_amdgcn_make_buffer_rsrc((void*)(F.ws + WS_SSEG), 0, 256 * 128 * 128 * 4, 0x00020000), rsrcDS = __builtin_amdgcn_make_buffer_rsrc((void*)(F.ws + WS_DSEG), 0, 256 * 128 * 4, 0x00020000);
    const __amdgpu_buffer_rsrc_t rsrcD = __builtin_amdgcn_make_buffer_rsrc((void*)DEC, 0, 64 * 32 * 128 * 4, 0x00020000), rsrcM = __builtin_amdgcn_make_buffer_rsrc((void*)MIX, 0, (int)((size_t)T * D * 2), 0x00020000);
    const __amdgpu_buffer_rsrc_t rsrcK = __builtin_amdgcn_make_buffer_rsrc((void*)KVS, 0, 64 * 32 * 128 * 128 * 2, 0x00020000); const unsigned kvo = (unsigned)((se * 128 + sq * 32) * 2);
#define HG_LOADKV(dst_, item_) do { const unsigned so_ = (unsigned)__builtin_amdgcn_readfirstlane((int)((item_) * (128 * 128 * 2))); _Pragma("unroll") for (int j_ = 0; j_ < 4; ++j_) (dst_)[j_] = __builtin_bit_cast(v4u, __builtin_amdgcn_raw_buffer_load_b128(rsrcK, kvo + 16u * j_, so_, 0)); } while (0)
#define HG_LOADST(item_) HG_LOADKV(st, item_)
#define HG_FOLD(kv_, c_) do { _Pragma("unroll") for (int j_ = 0; j_ < 4; ++j_) { const f32x4 d0_ = *(const LAS f32x4*)(decs + (c_) * 128 + sq * 32 + 8 * j_), d1_ = *(const LAS f32x4*)(decs + (c_) * 128 + sq * 32 + 8 * j_ + 4); const v4u k_ = (kv_)[j_]; \
        S[8 * j_ + 0] = d0_.x * S[8 * j_ + 0] + bflo(k_.x); S[8 * j_ + 1] = d0_.y * S[8 * j_ + 1] + bfhi(k_.x); S[8 * j_ + 2] = d0_.z * S[8 * j_ + 2] + bflo(k_.y); S[8 * j_ + 3] = d0_.w * S[8 * j_ + 3] + bfhi(k_.y); \
        S[8 * j_ + 4] = d1_.x * S[8 * j_ + 4] + bflo(k_.z); S[8 * j_ + 5] = d1_.y * S[8 * j_ + 5] + bfhi(k_.z); S[8 * j_ + 6] = d1_.z * S[8 * j_ + 6] + bflo(k_.w); S[8 * j_ + 7] = d1_.w * S[8 * j_ + 7] + bfhi(k_.w); } } while (0)
    for (int wg = blockIdx.x; wg < 256; wg += F.G) {
        const int bh = wg >> 2, seg = wg & 3, item0 = bh * 32 + seg * 8, b = bh >> 2, h = bh & 3;
        HG_LOADT(rf, item0, 1); HG_LOADT(rq, item0, 0); HG_LOADT(rv, item0, 2); HG_LOADST(item0);
        const unsigned dso0 = (unsigned)__builtin_amdgcn_readfirstlane((bh * 32 + seg * 8) * 128 * 4);
        const f32x4 decv = __builtin_bit_cast(f32x4, __builtin_amdgcn_raw_buffer_load_b128(rsrcD, (unsigned)(F.tid & 255) * 16u, dso0, 0));
        const float lbv = hg_lbound(F, h, d);
        __builtin_amdgcn_sched_barrier(0);
        float S[32];
#pragma unroll
        for (int j = 0; j < 32; ++j) S[j] = 0.f;
        for (int sp = 0; sp < seg; ++sp) {
            const unsigned sso = (unsigned)__builtin_amdgcn_readfirstlane((bh * 4 + sp) * 128 * 128 * 4), dso = (unsigned)__builtin_amdgcn_readfirstlane((bh * 4 + sp) * 128 * 4);
#pragma unroll
            for (int j0 = 0; j0 < 8; j0 += 8) { f32x4 sv[8], dv[8];
#pragma unroll
                for (int j = 0; j < 8; ++j) { sv[j] = __builtin_bit_cast(f32x4, __builtin_amdgcn_raw_buffer_load_b128(rsrcSS, (unsigned)((se * 128 + sq * 32) * 4) + 16u * (j0 + j), sso, 0));
                    dv[j] = __builtin_bit_cast(f32x4, __builtin_amdgcn_raw_buffer_load_b128(rsrcDS, (unsigned)(sq * 32 * 4) + 16u * (j0 + j), dso, 0)); }
#pragma unroll
                for (int j = 0; j < 8; ++j) { const int q = 4 * (j0 + j); S[q + 0] = dv[j].x * S[q + 0] + sv[j].x; S[q + 1] = dv[j].y * S[q + 1] + sv[j].y; S[q + 2] = dv[j].z * S[q + 2] + sv[j].z; S[q + 3] = dv[j].w * S[q + 3] + sv[j].w; } }
        }
        if (F.tid < 256) *((LAS f32x4*)(L + HG_DECS) + F.tid) = decv;
        __syncthreads();
      for (int k = 0; k < 8; ++k) {
        const int item = item0 + k, c = seg * 8 + k;
        const int tb = F.wave & 1, eb = F.wave >> 1;
        const int nit = k < 7 ? item + 1 : item;
        HG_PUT(rf, RAWF); HG_PUT(rq, RAWQ); HG_PUT(rv, RAWV);
        __syncthreads();
        HG_LOADT(rf, nit, 1); HG_LOADT(rq, nit, 0); HG_LOADT(rv, nit, 2); __builtin_amdgcn_sched_barrier(0);
        unsigned short ffr[16], qr[16], vr[16]; HG_COL(ffr, RAWF); HG_COL(qr, RAWQ); HG_COL(vr, RAWV);
        float bb[16], kk[16], total; hg_gates(F, ffr, lbv, d, tq, bb, kk, total);
        float vv[16];
#pragma unroll
        for (int i = 0; i < 16; ++i) { const int t = 16 * tq + i; const float q = bf2f(qr[i]);
            *(LAS unsigned short*)(L + HG_QE + t * 272 + 2 * d) = (unsigned short)pkbf(q * bb[i], 0.f);
            *(LAS unsigned short*)(L + HG_KE + t * 272 + 2 * d) = (unsigned short)pkbf(kk[i] * __builtin_amdgcn_rcpf(bb[i]), 0.f);
            vv[i] = bf2f(vr[i]); }
        st16<true>(L + HG_VT + d * 144 + tq * 32, vv);
#pragma unroll
        for (int j = 0; j < 4; ++j) { v4u w4; w4.x = pkbf(S[8 * j + 0], S[8 * j + 1]); w4.y = pkbf(S[8 * j + 2], S[8 * j + 3]); w4.z = pkbf(S[8 * j + 4], S[8 * j + 5]); w4.w = pkbf(S[8 * j + 6], S[8 * j + 7]);
            *(LAS v4u*)(L + HG_ST + se * 272 + sq * 64 + 16 * j) = w4; }
        HG_FOLD(st, k);
        unsigned long long grv[4];
        { const bf16* grow_ = PHp + (((size_t)(3 * 16 + b) * 4 + h) * SEQ + c * 64 + tb * 32 + r) * 128;
#pragma unroll
            for (int g = 0; g < 4; ++g) grv[g] = *(const GAS unsigned long long*)(grow_ + eb * 32 + 8 * g + 4 * hh); }
        HG_LOADST(nit); __builtin_amdgcn_sched_barrier(0);
        __syncthreads();
        f32x16 acc;
#pragma unroll
        for (int i = 0; i < 16; ++i) acc[i] = 0.f;
#define HG_QF(s_) (*(const LAS bf16x8*)(L + HG_QE + (tb * 32 + r) * 272 + 32 * (s_) + 16 * hh))
#pragma unroll
        for (int s = 0; s < 8; ++s) acc = MFMA32(*(const LAS bf16x8*)(L + HG_ST + (eb * 32 + r) * 272 + 32 * s + 16 * hh), HG_QF(s), acc);
        for (int sb = 0; sb <= tb; ++sb) {
            f32x16 at;
#pragma unroll
            for (int i = 0; i < 16; ++i) at[i] = 0.f;
#pragma unroll
            for (int s = 0; s < 8; ++s) at = MFMA32(*(const LAS bf16x8*)(L + HG_KE + (sb * 32 + r) * 272 + 32 * s + 16 * hh), HG_QF(s), at);
            float a[16];
#pragma unroll
            for (int i = 0; i < 16; ++i) a[i] = (sb < tb || crow16(i, hh) <= r) ? at[i] : 0.f;
            const bf16x8 ab0 = pack8(a[0], a[1], a[2], a[3], a[4], a[5], a[6], a[7]), ab1 = pack8(a[8], a[9], a[10], a[11], a[12], a[13], a[14], a[15]);
            acc = MFMA32(*(const LAS bf16x8*)(L + HG_VT + (eb * 32 + r) * 144 + sb * 64 + 0 + 16 * hh), ab0, acc);
            acc = MFMA32(*(const LAS bf16x8*)(L + HG_VT + (eb * 32 + r) * 144 + sb * 64 + 32 + 16 * hh), ab1, acc);
        }
        float ss = 0.f;
#pragma unroll
        for (int i = 0; i < 16; ++i) ss += acc[i] * acc[i];
        ss += __shfl_xor(ss, 32);
        LAS float* ssq = (LAS float*)(L + HG_SSQ);
        if (hh == 0) ssq[eb * 64 + tb * 32 + r] = ss;
        f32x4 ggv[4];
        { const unsigned so = (unsigned)__builtin_amdgcn_readfirstlane(h * 512);
#pragma unroll
            for (int g = 0; g < 4; ++g) ggv[g] = __builtin_bit_cast(f32x4, __builtin_amdgcn_raw_buffer_load_b128(rsrcG, (unsigned)((eb * 32 + 8 * g + 4 * hh) * 4), so, 0)); }
        __syncthreads();
        const int tl = tb * 32 + r; const float tot = (ssq[tl] + ssq[64 + tl]) + (ssq[128 + tl] + ssq[192 + tl]);
        const float rs = 1.f / sqrtf(tot * (1.f / 128.f) + EPS);
        const unsigned mso = (unsigned)__builtin_amdgcn_readfirstlane((int)((((unsigned)b * SEQ + c * 64) * D + 512 + h * 128) * 2)), mvo = (unsigned)((tl * D + eb * 32 + 4 * hh) * 2);
#pragma unroll
        for (int g = 0; g < 4; ++g) { const int e = eb * 32 + 8 * g + 4 * hh; const unsigned long long gr = grv[g]; const f32x4 gg = ggv[g];
            const float g0 = bflo((unsigned)gr), g1 = bfhi((unsigned)gr), g2 = bflo((unsigned)(gr >> 32)), g3 = bfhi((unsigned)(gr >> 32));
            const float y0 = acc[4 * g + 0] * rs * gg.x * (g0 * __builtin_amdgcn_rcpf(1.f + __expf(-g0))), y1 = acc[4 * g + 1] * rs * gg.y * (g1 * __builtin_amdgcn_rcpf(1.f + __expf(-g1)));
            const float y2 = acc[4 * g + 2] * rs * gg.z * (g2 * __builtin_amdgcn_rcpf(1.f + __expf(-g2))), y3 = acc[4 * g + 3] * rs * gg.w * (g3 * __builtin_amdgcn_rcpf(1.f + __expf(-g3)));
            typedef unsigned u32x2_t __attribute__((ext_vector_type(2))); __builtin_amdgcn_raw_buffer_store_b64((u32x2_t){pkbf(y0, y1), pkbf(y2, y3)}, rsrcM, mvo + 16u * g, mso, 0); }
        __syncthreads();
      }
    }
#undef HG_LOADST
#undef HG_LOADKV
#undef HG_FOLD
#undef HG_QF
}
#undef HG_LOADT
#undef HG_PUT
#undef HG_COL
#undef HG_ARR
#undef HG_SOFF
#undef HG_HV

__device__ __forceinline__ void router_phase(Frame& F) {
    LAS unsigned char* L = F.lds; const int r = F.lane & 31, hh = F.lane >> 5;
    LAS unsigned* lcnt = (LAS unsigned*)(F.lds + LTAB_OFF) + LT_MISC; LAS unsigned* lbase = lcnt + 32; LAS float* lrstd = (LAS float*)(F.lds + ROWTAB_OFF);
    float* TOPG = (float*)(F.ws + WS_TOPG);
    {
        const GAS v4u* img = (const GAS v4u*)(F.ws + WS_RT) + vzero();
        constexpr int NB = (RT_END / 16 + NWAVES * 64 - 1) / (NWAVES * 64);
        v4u t4[NB];
#pragma unroll
        for (int j = 0; j < NB; ++j) { const int q = F.tid + j * NWAVES * 64; t4[j] = img[q < RT_END / 16 ? q : 0]; }
#pragma unroll
        for (int j = 0; j < NB; ++j) { const int q = F.tid + j * NWAVES * 64; if (q < RT_END / 16) *(LAS v4u*)(L + 16 * q) = t4[j]; }
    }
    const bf16* XH = (const bf16*)(F.ws + WS_XN); int* LIST = (int*)(F.ws + WS_LIST); unsigned* cnt = (unsigned*)(F.ctl + CW_CNT);
    for (int base = blockIdx.x * 4; base < T / 32; base += F.G * 4) {
        const int grp = base + F.wave; const bool active = F.wave < 4 && grp < T / 32;
        if (F.tid < 32) lcnt[F.tid] = 0u;
        __syncthreads();
        float sv[4] = {0.f, 0.f, 0.f, 0.f}; int se[4] = {0, 0, 0, 0}; unsigned lp0 = 0u, lp1 = 0u; float rstd = 0.f; const int tok = grp * 32 + r;
        if (active) {
            const bf16* hrow = XH + (size_t)tok * D + 8 * hh;
            f32x16 acc;
#pragma unroll
            for (int i = 0; i < 16; ++i) acc[i] = 0.f;
            float ssq = 0.f;
#pragma unroll 16
            for (int s = 0; s < 64; ++s) {
                const v4u hu = *(const GAS v4u*)(hrow + 16 * s); const bf16x8 hi = __builtin_bit_cast(bf16x8, hu);
                { const float a0 = bflo(hu.x), a1 = bfhi(hu.x), a2 = bflo(hu.y), a3 = bfhi(hu.y), a4 = bflo(hu.z), a5 = bfhi(hu.z), a6 = bflo(hu.w), a7 = bfhi(hu.w);
                    ssq += (a0 * a0 + a1 * a1) + (a2 * a2 + a3 * a3) + (a4 * a4 + a5 * a5) + (a6 * a6 + a7 * a7); }
                const bf16x8 wh = *(const LAS bf16x8*)(L + r * RT_ROW + 32 * s + 16 * hh), wl = *(const LAS bf16x8*)(L + RT_WL + r * RT_ROW + 32 * s + 16 * hh);
                acc = MFMA32(wh, hi, acc); acc = MFMA32(wl, hi, acc);
            }
            ssq += __shfl_xor(ssq, 32);
            rstd = 1.f / sqrtf(ssq * (1.f / D) + EPS);
            float l[16];
#pragma unroll
            for (int i = 0; i < 16; ++i) l[i] = acc[i] * rstd + F.b_router[crow16(i, hh)];
            float cv[8]; int ce[8];
#pragma unroll
            for (int rnd = 0; rnd < 4; ++rnd) { float bv = l[0]; int bi = 0;
#pragma unroll
                for (int i = 1; i < 16; ++i) if (l[i] > bv) { bv = l[i]; bi = i; }
                cv[rnd] = bv; ce[rnd] = crow16(bi, hh);
#pragma unroll
                for (int i = 0; i < 16; ++i) if (i == bi) l[i] = -__builtin_inff(); }
#pragma unroll
            for (int j = 0; j < 4; ++j) { cv[4 + j] = __shfl_xor(cv[j], 32); ce[4 + j] = __shfl_xor(ce[j], 32); }
#pragma unroll
            for (int rnd = 0; rnd < 4; ++rnd) { float bv = cv[0]; int be = ce[0]; int bj = 0;
#pragma unroll
                for (int j = 1; j < 8; ++j) if (cv[j] > bv || (cv[j] == bv && ce[j] < be)) { bv = cv[j]; be = ce[j]; bj = j; }
                sv[rnd] = bv; se[rnd] = be;
#pragma unroll
                for (int j = 0; j < 8; ++j) if (j == bj) { cv[j] = -__builtin_inff(); ce[j] = 64; } }
            lp0 = __hip_atomic_fetch_add(lcnt + (hh ? se[2] : se[0]), 1u, __ATOMIC_RELAXED, __HIP_MEMORY_SCOPE_WORKGROUP);
            lp1 = __hip_atomic_fetch_add(lcnt + (hh ? se[3] : se[1]), 1u, __ATOMIC_RELAXED, __HIP_MEMORY_SCOPE_WORKGROUP);
        }
        __syncthreads();
        if (F.tid < 32) lbase[F.tid] = __hip_atomic_fetch_add(cnt + F.tid, lcnt[F.tid], __ATOMIC_RELAXED, __HIP_MEMORY_SCOPE_AGENT);
        __syncthreads();
        if (active) {
            const float e1 = __expf(sv[1] - sv[0]), e2 = __expf(sv[2] - sv[0]), e3 = __expf(sv[3] - sv[0]); const float inv = 1.f / (1.f + e1 + e2 + e3);
            const int ea = hh ? se[2] : se[0], eb = hh ? se[3] : se[1]; const float ga = (hh ? e2 : 1.f) * inv, gb = (hh ? e3 : e1) * inv;
            const size_t ia = (size_t)ea * 32768 + lbase[ea] + lp0, ib = (size_t)eb * 32768 + lbase[eb] + lp1;
            LIST[ia] = tok * 4 + 2 * hh; LIST[ib] = tok * 4 + 2 * hh + 1; TOPG[tok * 4 + 2 * hh] = ga; TOPG[tok * 4 + 2 * hh + 1] = gb;
            if (hh == 0) lrstd[F.wave * 32 + r] = rstd;
        }
        __syncthreads();
        {
            unsigned char* X8 = F.ws + WS_X8; const int t0 = base * 32;
#pragma unroll
            for (int q0 = 0; q0 < 16; q0 += 4) { v4u a[4][2];
#pragma unroll
                for (int q = 0; q < 4; ++q) { const int tt = t0 + F.wave * 16 + q0 + q; const GAS v4u* p = (const GAS v4u*)(XH + (size_t)(tt < T ? tt : 0) * D) + 2 * F.lane; a[q][0] = p[0]; a[q][1] = p[1]; }
#pragma unroll
                for (int q = 0; q < 4; ++q) { const int tl = F.wave * 16 + q0 + q, tt = t0 + tl; if (tt < T) { const float rs = lrstd[tl]; v4u o;
                    o.x = pg8::pk4_fp8(bflo(a[q][0].x) * rs, bfhi(a[q][0].x) * rs, bflo(a[q][0].y) * rs, bfhi(a[q][0].y) * rs); o.y = pg8::pk4_fp8(bflo(a[q][0].z) * rs, bfhi(a[q][0].z) * rs, bflo(a[q][0].w) * rs, bfhi(a[q][0].w) * rs);
                    o.z = pg8::pk4_fp8(bflo(a[q][1].x) * rs, bfhi(a[q][1].x) * rs, bflo(a[q][1].y) * rs, bfhi(a[q][1].y) * rs); o.w = pg8::pk4_fp8(bflo(a[q][1].z) * rs, bfhi(a[q][1].z) * rs, bflo(a[q][1].w) * rs, bfhi(a[q][1].w) * rs);
                    *((GAS v4u*)(X8 + (size_t)tt * D) + F.lane) = o; } } }
        }
        __syncthreads();
    }
}
__device__ __forceinline__ int build_moe_tables(Frame& F, int ntn, int mode) {
    LAS int* lt = (LAS int*)(F.lds + LTAB_OFF);
    if (F.wave == 0) {
        const int e = F.lane & 31; const int c = (int)__hip_atomic_load((unsigned*)(F.ctl + CW_CNT) + e, __ATOMIC_RELAXED, __HIP_MEMORY_SCOPE_AGENT);
        const int tl = (c + 255) >> 8; int inc = tl;
#pragma unroll
        for (int off = 1; off < 32; off <<= 1) { const int o = __shfl_up(inc, off, 32); if (e >= off) inc += o; }
        const int tot = __shfl(inc, 31, 32), t0 = inc - tl;
        if (F.lane < 32) { lt[LT_TS + e] = t0; lt[LT_CNT + e] = c; for (int i = 0; i < tl; ++i) lt[t0 + i] = e; }
        if (F.lane == 0) lt[LT_MISC + 64] = tot;
    }
    __syncthreads();
    int nt = lt[LT_MISC + 64]; nt = nt < 0 ? 0 : (nt > MAXTILES ? MAXTILES : nt); nt = __builtin_amdgcn_readfirstlane(nt);
    const int* LIST = (const int*)(F.ws + WS_LIST);
    const int nslot = mode == 1 ? MAXSLOT : (MAXTILES * 4 + 255) / 256;
    for (int q = F.tid; q < nslot * 256; q += NWAVES * 64) { const int i = q >> 8, rr = q & 255; const int Lu = i * F.G + F.vcu;
        int li = -1; float bias = 0.f;
        if (Lu < nt * ntn) { const int pm0 = Lu / ntn, pl = Lu - pm0 * ntn, pm = mode == 2 ? nt - 1 - pm0 : pm0, e = lt[pm], idx = (pm - lt[LT_TS + e]) * 256 + rr; if (idx < lt[LT_CNT + e]) li = LIST[(size_t)e * 32768 + idx];
            bias = mode == 1 ? F.b_gu[(size_t)e * 2048 + (rr >> 7) * 1024 + pl * 128 + (rr & 127)] : F.b_d[(size_t)e * 1024 + pl * 256 + rr]; }
        ((LAS float*)(F.lds + ROWTAB_OFF))[q] = bias;
        if (mode == 1) ((LAS unsigned short*)(F.lds + ROWTAB2_OFF))[q] = (unsigned short)(li < 0 ? 0 : (li >> 2));
        else ((LAS int*)(F.lds + ROWTAB_OFF) + nslot * 256)[q] = li; }
    __syncthreads();
    return nt;
}
__device__ __forceinline__ void combine_phase(Frame& F) {
    const unsigned char* YK = F.ws + WS_YK; const bf16* XH = (const bf16*)(F.ws + WS_XN); const float* TOPG = (const float*)(F.ws + WS_TOPG);
    for (int t = F.gw; t < T; t += F.ngw) {
        GAS f32x4* xr = (GAS f32x4*)(F.out + (size_t)t * D) + F.lane; f32x4 v[4]; unsigned y[4][4]; const f32x4 gt = *((const GAS f32x4*)TOPG + t + vzero()) * (1.0f / Y8_SCALE);
#pragma unroll
        for (int j = 0; j < 4; ++j) { const unsigned long long xh = __builtin_nontemporal_load((const GAS unsigned long long*)(XH + (size_t)t * D) + F.lane + 64 * j);
            v[j] = (f32x4){bflo((unsigned)xh), bfhi((unsigned)xh), bflo((unsigned)(xh >> 32)), bfhi((unsigned)(xh >> 32))};
#pragma unroll
            for (int k = 0; k < 4; ++k) y[j][k] = __builtin_nontemporal_load((const GAS unsigned*)(YK + ((size_t)t * 4 + k) * D) + F.lane + 64 * j); }
#pragma unroll
        for (int j = 0; j < 4; ++j) { f32x4 s4 = {0.f, 0.f, 0.f, 0.f};
#pragma unroll
            for (int k = 0; k < 4; ++k) { const f32x2n_ lo = __builtin_amdgcn_cvt_pk_f32_fp8((int)y[j][k], false), hi = __builtin_amdgcn_cvt_pk_f32_fp8((int)y[j][k], true); const float g = gt[k]; s4.x += g * lo.x; s4.y += g * lo.y; s4.z += g * hi.x; s4.w += g * hi.y; }
            v[j] = v[j] + s4;
            __builtin_nontemporal_store(v[j], xr + 64 * j); }
    }
}

constexpr int NPH = 9;
struct Args { const float* in[16]; float* out; unsigned char* ws; int ph_lo, ph_hi; };
__global__ void __launch_bounds__(NWAVES * 64, 2) fwd(Args args) {
    extern __shared__ __attribute__((aligned(16))) unsigned char lds[];
    Frame F;
    F.lds = (LAS unsigned char*)lds;
    F.MISC = (volatile LAS unsigned*)(F.lds + MISC_OFF);
    F.tid = threadIdx.x; F.lane = F.tid & 63; F.wave = __builtin_amdgcn_readfirstlane(F.tid >> 6);
    F.G = gridDim.x; { const int bx = blockIdx.x; F.vcu = (F.G % 8 == 0) ? (bx % 8) * (F.G / 8) + bx / 8 : bx; }
    F.gw = blockIdx.x * NWAVES + F.wave; F.ngw = F.G * NWAVES;
    F.ws = args.ws; F.ctl = (gu32*)(args.ws + WS_CTL); F.out = args.out;
    F.x = args.in[0]; F.norm1_g = args.in[1]; F.w_in = args.in[2]; F.sb_q_g = args.in[3]; F.sb_k_g = args.in[4]; F.sb_out_g = args.in[5]; F.hg_lb = args.in[6]; F.hg_out_g = args.in[7];
    F.w_out = args.in[8]; F.norm2_g = args.in[9]; F.w_router = args.in[10]; F.b_router = args.in[11]; F.w_gu = args.in[12]; F.b_gu = args.in[13]; F.w_d = args.in[14]; F.b_d = args.in[15];
    for (int u = F.tid; u < (LDS_BYTES - LDSCTL_OFF) / 4; u += NWAVES * 64) ((LAS unsigned*)(F.lds + LDSCTL_OFF))[u] = 0u;
    __syncthreads();
    XcdBarrier bar; bar.bar = (unsigned*)(F.ctl + CW_BAR); bar.x = 0; bar.st = nullptr;
    if (MK_ONE_LAUNCH) bar = xcd_barrier_post((unsigned*)(F.ctl + CW_BAR), F.MISC + 8);
    const int lo = args.ph_lo, hi = args.ph_hi;
#define IN(k) (lo <= (k) && (k) < hi && ((F.lane = lane_id()), (F.tid = F.wave * 64 + F.lane), true))
#define SEAM(k) do { if (IN(k) && IN((k) + 1)) xcd_barrier(bar); } while (0)

    if (IN(0)) { p0_prologue(F); } SEAM(0);
    if (IN(1)) {
        pg8::Gemm g{(const bf16*)(F.ws + WS_XN), (const bf16*)(F.ws + WS_WIN), T, NIN, D}; pg8::StaticOrder S; S.init(T, NIN, F.G, (int)blockIdx.x);
        pg8::EpiInproj E{(bf16*)(F.ws + WS_P), (bf16*)(F.ws + WS_PH), (bf16*)(F.ws + WS_QN), (bf16*)(F.ws + WS_KN), F.sb_q_g, F.sb_k_g, QSCALE, EPS};
        pg8::gemm_phase<pg8::EpiInproj, pg8::StaticOrder, PG8_ALIGN, PG8_SP2>(F.lds + RING_OFF, g, S, E, F.tid);
    } SEAM(1);
    if (IN(2)) { prep_phase(F); __syncthreads(); hgA_phase(F); } SEAM(2);
    if (IN(3)) { attn_phase(F); hgC_phase(F); } SEAM(3);
    if (IN(4)) {
        pg8::Gemm g{(const bf16*)(F.ws + WS_MIX), (const bf16*)(F.ws + WS_WOUT), T, D, D}; pg8::StaticOrder S; S.init(T, D, F.G, (int)blockIdx.x);
        pg8::EpiRes E{F.x, (bf16*)(F.ws + WS_XN), D};
        pg8::gemm_phase<pg8::EpiRes, pg8::StaticOrder, PG8_ALIGN, PG8_SP2>(F.lds + RING_OFF, g, S, E, F.tid);
    } SEAM(4);
    if (IN(5)) { router_phase(F); } SEAM(5);
    if (IN(6)) {
        const int nt = build_moe_tables(F, 8, 1); const LAS int* lt = (const LAS int*)(F.lds + LTAB_OFF);
        pg8::Gemm g{(const bf16*)(F.ws + WS_X8), (const bf16*)(F.ws + WS_WGU), MAXROWS, NE * 2048, D / 2};
        pg8::MoeOrder S{lt, (const LAS unsigned short*)(F.lds + ROWTAB2_OFF), 8, nt * 8, F.G, F.vcu, 1024u, 0};
        pg8::EpiAct<true> E{F.ws + WS_ACT, (const LAS float*)(F.lds + ROWTAB_OFF), A8_SCALE};
        pg8::gemm_phase<pg8::EpiAct<true>, pg8::MoeOrder, PG8_ALIGN, PG8_SP2, true, SC_W8, SC_ONE>(F.lds + RING_OFF, g, S, E, F.tid);
        {
            const int rem = (nt * 8) % F.G, nidle = F.G - rem; const bool few = rem == 0 || nidle < F.G / 4;
            __syncthreads();
            if (few) p0_items(F, P0_NITEMS - P0_NLATE, P0_NITEMS, F.vcu * NWAVES + F.wave, F.G * NWAVES);
            else if (F.vcu >= rem) p0_items(F, P0_NITEMS - P0_NLATE, P0_NITEMS, (F.vcu - rem) * NWAVES + F.wave, nidle * NWAVES);
        }
    } SEAM(6);
    if (IN(7)) {
        const int nt = build_moe_tables(F, 4, 2); const LAS int* lt = (const LAS int*)(F.lds + LTAB_OFF);
        pg8::Gemm g{(const bf16*)(F.ws + WS_ACT), (const bf16*)(F.ws + WS_WD), MAXROWS, NE * 1024, D / 2};
        pg8::MoeOrder S{lt, nullptr, 4, nt * 4, F.G, F.vcu, 1024u, nt};
        pg8::EpiDown E{F.ws + WS_YK, (const LAS int*)(F.lds + ROWTAB_OFF) + ((MAXTILES * 4 + 255) / 256) * 256, (const LAS float*)(F.lds + ROWTAB_OFF), Y8_SCALE};
        pg8::gemm_phase<pg8::EpiDown, pg8::MoeOrder, PG8_ALIGN, PG8_SP2, true, SC_W8Y, SC_A8>(F.lds + RING_OFF, g, S, E, F.tid);
    } SEAM(7);
    if (IN(8)) { combine_phase(F); }
#undef IN
#undef SEAM
}

extern "C" void kernel_launch(void* const* d_in, const int* in_sizes, int n_in, void* d_out, int out_size, void* d_ws, size_t ws_size, hipStream_t stream) {
    static int grid = 0;
    if (grid == 0) {
        if (n_in != 16 || in_sizes[0] != T * D || out_size != T * D || ws_size < WS_END) { fprintf(stderr, "kernel_launch: shape/workspace mismatch (n_in %d, ws %zu, need %zu); nothing launched\n", n_in, ws_size, (size_t)WS_END); grid = -1; return; }
        int dev = 0, cus = 0, per_cu = 0;
        if (hipGetDevice(&dev) != hipSuccess || hipDeviceGetAttribute(&cus, hipDeviceAttributeMultiprocessorCount, dev) != hipSuccess) { grid = -1; return; }
        if (hipFuncSetAttribute((const void*)fwd, hipFuncAttributeMaxDynamicSharedMemorySize, LDS_BYTES) != hipSuccess) { grid = -1; return; }
        if (hipOccupancyMaxActiveBlocksPerMultiprocessor(&per_cu, (const void*)fwd, NWAVES * 64, LDS_BYTES) != hipSuccess || per_cu < 1) { fprintf(stderr, "kernel_launch: occupancy query says %d\n", per_cu); }
        (void)hipGetLastError();
        if ((MAXTILES * 8 + cus - 1) / cus > MAXSLOT || cus < 1) { fprintf(stderr, "kernel_launch: %d CUs: the per-workgroup unit tables are sized for 256\n", cus); grid = -1; return; }
        grid = cus;
    }
    if (grid < 0) return;
    if (hipMemsetAsync((char*)d_ws + WS_CTL, 0, CTL_ZERO_BYTES, stream) != hipSuccess) return;
    Args a{};
    for (int i = 0; i < 16; ++i) a.in[i] = (const float*)d_in[i];
    a.out = (float*)d_out; a.ws = (unsigned char*)d_ws;
#if MK_ONE_LAUNCH
    a.ph_lo = 0; a.ph_hi = NPH;
    hipLaunchKernelGGL(fwd, dim3(grid), dim3(NWAVES * 64), LDS_BYTES, stream, a);
#else
    for (int p = 0; p < NPH; ++p) { a.ph_lo = p; a.ph_hi = p + 1; hipLaunchKernelGGL(fwd, dim3(grid), dim3(NWAVES * 64), LDS_BYTES, stream, a); }
#endif
}
```

```cpp
#include <hip/hip_runtime.h>
#include <cstdio>
#include <cstdint>
namespace pg8 {
#define PG8_LAS __attribute__((address_space(3)))
typedef unsigned short bf16_t;
typedef short bf16x8 __attribute__((ext_vector_type(8)));
typedef float f32x4 __attribute__((ext_vector_type(4)));
typedef unsigned u32x4 __attribute__((ext_vector_type(4)));
typedef int i32x4_t __attribute__((ext_vector_type(4)));
typedef int i32x8_t __attribute__((ext_vector_type(8)));
constexpr int BM = 256, BK = 64, HALF = 128, HTB = HALF * BK * 2  , STAGE_BYTES = 8 * HTB, NXCD = 8, WGM = 8;

__host__ __device__ __forceinline__ int lds_byte(int r, int c) { const int st = (r >> 4) * 2 + (c >> 5), rr = r & 15, cc = c & 31, ob = rr * 64 + cc * 2; return st * 1024 + (ob ^ (((ob >> 9) & 1) << 5)); }
__host__ __device__ __forceinline__ void stage_rc(int b, int& R, int& C) { const int st = b / 1024, sb = b % 1024, swz = sb ^ (((sb >> 9) & 1) << 5); R = (st >> 1) * 16 + swz / 64; C = (st & 1) * 32 + (swz % 64) / 2; }
__host__ __device__ __forceinline__ int perm32(int rho) { const int n = rho >> 4, i = rho & 15; return 8 * (i >> 2) + 4 * n + (i & 3); }

struct Unit { int pm, pn, slot; };
struct Gemm { const bf16_t* A; const bf16_t* Bt; int M, N, K; };

struct StaticOrder {
    int nM, nN, nwg, G, c;
    __host__ __device__ void init(int M, int N, int G_, int c_) { nM = M / BM; nN = N / BM; nwg = nM * nN; G = G_; c = c_; }
    __host__ __device__ bool next(int i, Unit& u) const {
        const long L = (long)i * G + c; if (L >= nwg) return false;
        int wgid = (int)L; { const int q = nwg / NXCD, r = nwg % NXCD, xcd = wgid % NXCD, off = wgid / NXCD; wgid = (xcd < r ? xcd * (q + 1) : r * (q + 1) + (xcd - r) * q) + off; }
        const int nig = WGM * nN, gid = wgid / nig, fm = gid * WGM, gsz = (nM - fm) < WGM ? (nM - fm) : WGM;
        u.pm = fm + ((wgid % nig) % gsz); u.pn = (wgid % nig) / gsz; return true;
    }
    __device__ __forceinline__ void a_ready(const Unit&) const {}
    __device__ __forceinline__ void done(const Unit&) const {}
};

__device__ __forceinline__ unsigned cvt_pk_bf16(float lo, float hi) { unsigned r; asm volatile("v_cvt_pk_bf16_f32 %0, %1, %2" : "=v"(r) : "v"(lo), "v"(hi)); return r; }
typedef float f32x2 __attribute__((ext_vector_type(2)));
__device__ __forceinline__ f32x2 gelu_pk(f32x2 v) {
    const f32x2 av = __builtin_elementwise_abs(v), d = av * 0.2316418882f + 1.0f;
    f32x2 t; t.x = __builtin_amdgcn_rcpf(d.x); t.y = __builtin_amdgcn_rcpf(d.y);
    f32x2 q = t * 0.5307027145f + (-0.7265760135f); q = q * t + 0.7107068705f; q = q * t + (-0.142248368f); q = q * t + 0.127414796f; q = q * t;
    const f32x2 s = (v * v) * (-0.72134752044f);
    f32x2 e; e.x = __builtin_amdgcn_exp2f(s.x); e.y = __builtin_amdgcn_exp2f(s.y);
    const f32x2 m = v * (q * e), r = v - m;
    f32x2 o; o.x = v.x < 0.f ? m.x : r.x; o.y = v.y < 0.f ? m.y : r.y; return o;
}

template <int ACT  > struct EpiBf16 {
    static constexpr bool PERM = true, AFTER_DRAIN = false, HAS_INIT = false, INIT_LOADS = false; static_assert(ACT == 0 || ACT == 1, "EpiBf16: ACT is 0 (none) or 1 (gelu_pk)");
    bf16_t* O; int ldc; const float* bias; int split_cols; size_t split_stride; float scale0;
    __device__ __forceinline__ void operator()(const f32x4 (&acc)[2][2][4][2], const Unit& u, int wr, int wc, int fr, int fq) const {
        const int row0 = u.pm * BM + wr * 64 + fr; int colt = u.pn * BM; bf16_t* base = O;
        float sc = 1.f; if (split_cols) { const int t = colt / split_cols; base += (size_t)t * split_stride; colt -= t * split_cols; if (t == 0) sc = scale0; }
        const int col0 = colt + wc * 32 + 8 * fq, bcol0 = u.pn * BM + wc * 32 + 8 * fq;
        f32x4 bv[2][2];
#pragma unroll
        for (int bj = 0; bj < 2; ++bj)
#pragma unroll
            for (int n = 0; n < 2; ++n) bv[bj][n] = bias ? *(const f32x4*)(bias + bcol0 + bj * HALF + 4 * n) : (f32x4){0.f, 0.f, 0.f, 0.f};
#pragma unroll
        for (int ai = 0; ai < 2; ++ai)
#pragma unroll
            for (int m = 0; m < 4; ++m) { bf16_t* rowp = base + (size_t)(row0 + ai * HALF + m * 16) * ldc + col0;
#pragma unroll
                for (int bj = 0; bj < 2; ++bj) { f32x4 v0 = acc[ai][bj][m][0] + bv[bj][0], v1 = acc[ai][bj][m][1] + bv[bj][1];
                    if (ACT == 1) { f32x2 a = gelu_pk((f32x2){v0[0], v0[1]}), b = gelu_pk((f32x2){v0[2], v0[3]}), c = gelu_pk((f32x2){v1[0], v1[1]}), d = gelu_pk((f32x2){v1[2], v1[3]});
                        v0 = (f32x4){a.x, a.y, b.x, b.y}; v1 = (f32x4){c.x, c.y, d.x, d.y}; }
                    v0 = v0 * sc; v1 = v1 * sc; u32x4 w; w.x = cvt_pk_bf16(v0[0], v0[1]); w.y = cvt_pk_bf16(v0[2], v0[3]); w.z = cvt_pk_bf16(v1[0], v1[1]); w.w = cvt_pk_bf16(v1[2], v1[3]);
                    *(u32x4*)(rowp + bj * HALF) = w; } }
    }
};

__device__ __forceinline__ unsigned pk4_fp8(float a, float b, float c, float d) {
    a = fminf(fmaxf(a, -448.f), 448.f); b = fminf(fmaxf(b, -448.f), 448.f); c = fminf(fmaxf(c, -448.f), 448.f); d = fminf(fmaxf(d, -448.f), 448.f);
    int p = 0; p = __builtin_amdgcn_cvt_pk_fp8_f32(a, b, p, false); p = __builtin_amdgcn_cvt_pk_fp8_f32(c, d, p, true); return (unsigned)p;
}
struct EpiRes {
    static constexpr bool PERM = true, AFTER_DRAIN = false, HAS_INIT = true, INIT_LOADS = true;
    const float* __restrict__ X; bf16_t* __restrict__ XH; int ldc;
    __device__ __forceinline__ void init(f32x4 (&acc)[2][2][4][2], const Unit& u, int wr, int wc, int fr, int fq) const {
        const int row0 = u.pm * BM + wr * 64 + fr, col0 = u.pn * BM + wc * 32 + 8 * fq;
#pragma unroll
        for (int ai = 0; ai < 2; ++ai)
#pragma unroll
            for (int m = 0; m < 4; ++m) { const float* rp = X + (size_t)(row0 + ai * HALF + m * 16) * ldc + col0;
#pragma unroll
                for (int bj = 0; bj < 2; ++bj)
#pragma unroll
                    for (int n = 0; n < 2; ++n) acc[ai][bj][m][n] = __builtin_nontemporal_load((const f32x4*)(rp + bj * HALF + n * 4)); }
    }
    __device__ __forceinline__ void operator()(const f32x4 (&acc)[2][2][4][2], const Unit& u, int wr, int wc, int fr, int fq) const {
        const int row0 = u.pm * BM + wr * 64 + fr, col0 = u.pn * BM + wc * 32 + 8 * fq;
#pragma unroll
        for (int ai = 0; ai < 2; ++ai)
#pragma unroll
            for (int m = 0; m < 4; ++m) { bf16_t* rp = XH + (size_t)(row0 + ai * HALF + m * 16) * ldc + col0;
#pragma unroll
                for (int bj = 0; bj < 2; ++bj) { const f32x4 v0 = acc[ai][bj][m][0], v1 = acc[ai][bj][m][1];
                    u32x4 w; w.x = cvt_pk_bf16(v0[0], v0[1]); w.y = cvt_pk_bf16(v0[2], v0[3]); w.z = cvt_pk_bf16(v1[0], v1[1]); w.w = cvt_pk_bf16(v1[2], v1[3]);
                    *(u32x4*)(rp + bj * HALF) = w; } }
    }
};
struct EpiInproj {
    static constexpr bool PERM = true, AFTER_DRAIN = false, HAS_INIT = false, INIT_LOADS = false;
    bf16_t* PA; bf16_t* PH; bf16_t* QN; bf16_t* KN; const float* gq; const float* gk; float qscale, eps;
    __device__ __forceinline__ void operator()(const f32x4 (&acc)[2][2][4][2], const Unit& u, int wr, int wc, int fr, int fq) const {
        if (u.pn < 4) {
            const int arr = u.pn >> 1, hd = (u.pn & 1) * 4 + wc; const float* g = arr ? gk : gq; const float gs = arr ? 1.f : qscale; bf16_t* dst = arr ? KN : QN;
            f32x4 gv[2][2];
#pragma unroll
            for (int bj = 0; bj < 2; ++bj)
#pragma unroll
                for (int n = 0; n < 2; ++n) gv[bj][n] = *(const f32x4*)(g + 32 * bj + 8 * fq + 4 * n) * gs;
#pragma unroll
            for (int ai = 0; ai < 2; ++ai)
#pragma unroll
                for (int m = 0; m < 4; ++m) { float ss = 0.f;
#pragma unroll
                    for (int bj = 0; bj < 2; ++bj)
#pragma unroll
                        for (int n = 0; n < 2; ++n) { const f32x4 a = acc[ai][bj][m][n]; ss += (a[0] * a[0] + a[1] * a[1]) + (a[2] * a[2] + a[3] * a[3]); }
                    ss += __shfl_xor(ss, 16); ss += __shfl_xor(ss, 32);
                    const float rs = 1.f / sqrtf(ss * (1.f / 64.f) + eps);
                    const int row = u.pm * BM + ai * HALF + wr * 64 + m * 16 + fr, b = row >> 11, s = row & 2047;
                    bf16_t* rp = dst + ((size_t)((b * 8 + hd) * 64 + (s >> 5))) * 2048 + (s & 31) * 8;
#pragma unroll
                    for (int bj = 0; bj < 2; ++bj) { const int c8 = 4 * bj + fq; const f32x4 v0 = acc[ai][bj][m][0] * rs * gv[bj][0], v1 = acc[ai][bj][m][1] * rs * gv[bj][1];
                        u32x4 w; w.x = cvt_pk_bf16(v0[0], v0[1]); w.y = cvt_pk_bf16(v0[2], v0[3]); w.z = cvt_pk_bf16(v1[0], v1[1]); w.w = cvt_pk_bf16(v1[2], v1[3]);
                        *(u32x4*)(rp + (c8 >> 1) * 512 + (c8 & 1) * 256) = w; } }
            return;
        }
#pragma unroll
        for (int bj = 0; bj < 2; ++bj) { const int col = u.pn * BM + bj * HALF + wc * 32 + 8 * fq;
            bf16_t* base; int rowlen;
            if (col < 1536) { const int arr = col >> 9, hd = (col & 511) >> 6, dd = col & 63; base = PA + ((size_t)(arr * 16) * 8 + hd) * 2048 * 64 + dd; rowlen = 64; }
            else { const int c2 = col - 1536, arr = c2 >> 9, hd = (c2 & 511) >> 7, dd = c2 & 127; base = PH + ((size_t)(arr * 16) * 4 + hd) * 2048 * 128 + dd; rowlen = 128; }
            const size_t bstride = (size_t)(rowlen == 64 ? 8 : 4) * 2048 * rowlen;
#pragma unroll
            for (int ai = 0; ai < 2; ++ai)
#pragma unroll
                for (int m = 0; m < 4; ++m) { const int row = u.pm * BM + ai * HALF + wr * 64 + m * 16 + fr, b = row >> 11, s = row & 2047;
                    const f32x4 v0 = acc[ai][bj][m][0], v1 = acc[ai][bj][m][1];
                    u32x4 w; w.x = cvt_pk_bf16(v0[0], v0[1]); w.y = cvt_pk_bf16(v0[2], v0[3]); w.z = cvt_pk_bf16(v1[0], v1[1]); w.w = cvt_pk_bf16(v1[2], v1[3]);
                    *(u32x4*)(base + (size_t)b * bstride + (size_t)s * rowlen) = w; } }
    }
};
struct MoeOrder {
    const PG8_LAS int* tile_e; const PG8_LAS unsigned short* rowtab; int ntn, nunits, G, c; unsigned rowbytes; int rev;
    __device__ __forceinline__ bool next(int i, Unit& u) const {
        const int L = i * G + c; if (L >= nunits) return false;
        const int pm0 = L / ntn, pl = L - pm0 * ntn, pm = rev ? rev - 1 - pm0 : pm0; u.pm = pm; u.pn = tile_e[pm] * ntn + pl; u.slot = i; return true;
    }
    __device__ __forceinline__ unsigned rowoff(const Unit& u, int r) const { return (rowtab ? (unsigned)rowtab[u.slot * 256 + r] : (unsigned)(u.pm * 256 + r)) * rowbytes; }
    __device__ __forceinline__ void a_ready(const Unit&) const {}
    __device__ __forceinline__ void done(const Unit&) const {}
};
template <bool OUT8> struct EpiAct {
    static constexpr bool PERM = true, AFTER_DRAIN = false, HAS_INIT = true, INIT_LOADS = false;
    unsigned char* ACT; const PG8_LAS float* biastab; float oscale;
    __device__ __forceinline__ void init(f32x4 (&acc)[2][2][4][2], const Unit& u, int wr, int wc, int fr, int fq) const {
#pragma unroll
        for (int n = 0; n < 2; ++n) { const f32x4 bg = *(const PG8_LAS f32x4*)(biastab + u.slot * 256 + wc * 32 + 8 * fq + 4 * n), bu = *(const PG8_LAS f32x4*)(biastab + u.slot * 256 + 128 + wc * 32 + 8 * fq + 4 * n);
#pragma unroll
            for (int ai = 0; ai < 2; ++ai)
#pragma unroll
                for (int m = 0; m < 4; ++m) { acc[ai][0][m][n] = bg; acc[ai][1][m][n] = bu; } }
    }
    __device__ __forceinline__ void operator()(const f32x4 (&acc)[2][2][4][2], const Unit& u, int wr, int wc, int fr, int fq) const {
        const int pl = u.pn & 7; const int row0 = u.pm * BM + wr * 64 + fr, acol0 = pl * 128 + wc * 32 + 8 * fq;
#pragma unroll
        for (int ai = 0; ai < 2; ++ai)
#pragma unroll
            for (int m = 0; m < 4; ++m) { unsigned char* rowp = ACT + (size_t)(row0 + ai * HALF + m * 16) * 1024 + acol0; f32x4 a4[2];
#pragma unroll
                for (int n = 0; n < 2; ++n) { const f32x4 g4 = acc[ai][0][m][n], u4 = acc[ai][1][m][n]; f32x4 gl, ul, ex;
#pragma unroll
                    for (int j = 0; j < 4; ++j) { gl[j] = fminf(g4[j], 7.0f); ul[j] = __builtin_amdgcn_fmed3f(u4[j], -7.0f, 7.0f); }
                    const f32x4 t4 = gl * (-1.702f * 1.44269504089f);
#pragma unroll
                    for (int j = 0; j < 4; ++j) ex[j] = __builtin_amdgcn_exp2f(t4[j]);
                    const f32x4 d4 = ex + 1.0f; f32x4 s4;
#pragma unroll
                    for (int j = 0; j < 4; ++j) s4[j] = __builtin_amdgcn_rcpf(d4[j]);
                    a4[n] = (gl * s4) * (ul * oscale + oscale); }
                if constexpr (OUT8) { int p0 = 0, p1 = 0; p0 = __builtin_amdgcn_cvt_pk_fp8_f32(a4[0][0], a4[0][1], p0, false); p0 = __builtin_amdgcn_cvt_pk_fp8_f32(a4[0][2], a4[0][3], p0, true);
                    p1 = __builtin_amdgcn_cvt_pk_fp8_f32(a4[1][0], a4[1][1], p1, false); p1 = __builtin_amdgcn_cvt_pk_fp8_f32(a4[1][2], a4[1][3], p1, true);
                    *(unsigned long long*)rowp = (unsigned long long)(unsigned)p0 | ((unsigned long long)(unsigned)p1 << 32); }
                else { u32x4 w; w.x = cvt_pk_bf16(a4[0][0], a4[0][1]); w.y = cvt_pk_bf16(a4[0][2], a4[0][3]); w.z = cvt_pk_bf16(a4[1][0], a4[1][1]); w.w = cvt_pk_bf16(a4[1][2], a4[1][3]); *(u32x4*)(rowp + (size_t)(row0 + ai * HALF + m * 16) * 1024 + acol0) = w; } }
    }
};
struct EpiDown {
    static constexpr bool PERM = true, AFTER_DRAIN = false, HAS_INIT = true, INIT_LOADS = false;
    unsigned char* YK; const PG8_LAS int* tktab; const PG8_LAS float* biastab; float oscale;
    __device__ __forceinline__ void init(f32x4 (&acc)[2][2][4][2], const Unit& u, int wr, int wc, int fr, int fq) const {
#pragma unroll
        for (int bj = 0; bj < 2; ++bj)
#pragma unroll
            for (int n = 0; n < 2; ++n) { const f32x4 bv = *(const PG8_LAS f32x4*)(biastab + u.slot * 256 + bj * HALF + wc * 32 + 8 * fq + 4 * n) * oscale;
#pragma unroll
                for (int ai = 0; ai < 2; ++ai)
#pragma unroll
                    for (int m = 0; m < 4; ++m) acc[ai][bj][m][n] = bv; }
    }
    __device__ __forceinline__ void operator()(const f32x4 (&acc)[2][2][4][2], const Unit& u, int wr, int wc, int fr, int fq) const {
        const int pl = u.pn & 3; const int col0 = pl * BM + wc * 32 + 8 * fq;
#pragma unroll
        for (int ai = 0; ai < 2; ++ai)
#pragma unroll
            for (int m = 0; m < 4; ++m) { const int tk = tktab[u.slot * 256 + ai * HALF + wr * 64 + m * 16 + fr];
                if (tk >= 0) { unsigned char* rowp = YK + (size_t)tk * 1024 + col0;
#pragma unroll
                    for (int bj = 0; bj < 2; ++bj) { f32x4 v0 = acc[ai][bj][m][0], v1 = acc[ai][bj][m][1];
#pragma unroll
                        for (int j = 0; j < 4; ++j) { v0[j] = __builtin_amdgcn_fmed3f(v0[j], -448.f, 448.f); v1[j] = __builtin_amdgcn_fmed3f(v1[j], -448.f, 448.f); }
                        int p0 = 0, p1 = 0; p0 = __builtin_amdgcn_cvt_pk_fp8_f32(v0[0], v0[1], p0, false); p0 = __builtin_amdgcn_cvt_pk_fp8_f32(v0[2], v0[3], p0, true);
                        p1 = __builtin_amdgcn_cvt_pk_fp8_f32(v1[0], v1[1], p1, false); p1 = __builtin_amdgcn_cvt_pk_fp8_f32(v1[2], v1[3], p1, true);
                        *(unsigned long long*)(rowp + bj * HALF) = (unsigned long long)(unsigned)p0 | ((unsigned long long)(unsigned)p1 << 32); } } }
    }
};


template <class Epi, class Sched, bool ALIGN_EPI = false, bool SP2 = false, bool GATHER = false, int SCW = 0, int SCX = 0>
__device__ __forceinline__ void gemm_phase(PG8_LAS unsigned char* lds, const Gemm g, const Sched& S, const Epi& E, const int tid) {
    const int wid = __builtin_amdgcn_readfirstlane(tid >> 6), lane = tid & 63, wr = wid >> 2, wc = wid & 3, fr = lane & 15, fq = lane >> 4;
    const int K = g.K, nt = K / BK;
    unsigned voffA[2], voffB[2]; int RA[2]; unsigned CA2[2]; unsigned va0[2] = {0u, 0u}, va1[2] = {0u, 0u};
#pragma unroll
    for (int i = 0; i < 2; ++i) { int R, C; stage_rc(tid * 16 + i * 8192, R, C); const int Rb = Epi::PERM ? ((R & ~31) + perm32(R & 31)) : R;
        voffA[i] = (unsigned)(R * K + C) * 2u; voffB[i] = (unsigned)(Rb * K + C) * 2u; RA[i] = R; CA2[i] = (unsigned)C * 2u; }
    static_assert(!GATHER || SP2, "the gathered-A form exists for the SP2 loop only");
    const char* const gA0 = (const char*)g.A;
#define PG8_VA(u) do { int l_; asm volatile("v_mbcnt_lo_u32_b32 %0, -1, 0\n\tv_mbcnt_hi_u32_b32 %0, -1, %0" : "=v"(l_)); const int t_ = wid * 64 + l_;     \
        _Pragma("unroll") for (int _i = 0; _i < 2; ++_i) { int R_, C_; stage_rc(t_ * 16 + _i * 8192, R_, C_); va0[_i] = S.rowoff((u), R_) + (unsigned)C_ * 2u; va1[_i] = S.rowoff((u), HALF + R_) + (unsigned)C_ * 2u; } } while (0)
#define PG8_STA(bufoff, base_ng, base_g, h) do { if constexpr (GATHER) { if (h) PG8_STAGE(bufoff, base_g, va1); else PG8_STAGE(bufoff, base_g, va0); } else PG8_STAGE(bufoff, base_ng, voffA); } while (0)
    const size_t kstep = (size_t)(BK * 2);
    const size_t hstep = (size_t)HALF * K * 2;
    const size_t tstep = 2 * hstep;
    const unsigned ldsw = (unsigned)wid * 1024u;
    const int aoff = lds_byte(wr * 64 + fr, fq * 8), boff = lds_byte(wc * 32 + fr, fq * 8);
#define PG8_SA(b, h) (((b) * 2 + (h)) * HTB)
#define PG8_SB(b, h) ((4 + (b) * 2 + (h)) * HTB)
#define PG8_STAGE(bufoff, gbase, voff) do { _Pragma("unroll") for (int _i = 0; _i < 2; ++_i) \
        __builtin_amdgcn_global_load_lds((const unsigned*)((const char*)(gbase) + (voff)[_i]), (PG8_LAS unsigned*)(lds + (bufoff) + ldsw + _i * 8192), 16, 0, 0); } while (0)
#define PG8_LDA(dst, b, h) do { if constexpr (SCW != 0) { _Pragma("unroll") for (int m = 0; m < 4; ++m) dst##8[m] = PG8_CAT8(*(const PG8_LAS bf16x8*)(lds + PG8_SA(b, h) + aoff + m * 2048), *(const PG8_LAS bf16x8*)(lds + PG8_SA(b, h) + aoff + m * 2048 + 1024)); } \
        else { _Pragma("unroll") for (int m = 0; m < 4; ++m) _Pragma("unroll") for (int k = 0; k < 2; ++k) dst[m][k] = *(const PG8_LAS bf16x8*)(lds + PG8_SA(b, h) + aoff + m * 2048 + k * 1024); } } while (0)
#define PG8_LDB(dst, b, h) do { if constexpr (SCW != 0) { _Pragma("unroll") for (int n = 0; n < 2; ++n) dst##8[n] = PG8_CAT8(*(const PG8_LAS bf16x8*)(lds + PG8_SB(b, h) + boff + n * 2048), *(const PG8_LAS bf16x8*)(lds + PG8_SB(b, h) + boff + n * 2048 + 1024)); } \
        else { _Pragma("unroll") for (int n = 0; n < 2; ++n) _Pragma("unroll") for (int k = 0; k < 2; ++k) dst[n][k] = *(const PG8_LAS bf16x8*)(lds + PG8_SB(b, h) + boff + n * 2048 + k * 1024); } } while (0)
#define PG8_CAT8(lo, hi) __builtin_shufflevector(__builtin_bit_cast(i32x4_t, (lo)), __builtin_bit_cast(i32x4_t, (hi)), 0, 1, 2, 3, 4, 5, 6, 7)
#define PG8_MMA(ai, bj, At, Bt) do { __builtin_amdgcn_s_setprio(1); _Pragma("unroll") for (int m = 0; m < 4; ++m) _Pragma("unroll") for (int n = 0; n < 2; ++n) { \
        if constexpr (SCW != 0) acc[ai][bj][m][n] = __builtin_amdgcn_mfma_scale_f32_16x16x128_f8f6f4(Bt##8[n], At##8[m], acc[ai][bj][m][n], 0, 0, 0, SCW, 0, SCX); \
        else { _Pragma("unroll") for (int k = 0; k < 2; ++k) acc[ai][bj][m][n] = __builtin_amdgcn_mfma_f32_16x16x32_bf16(Bt[n][k], At[m][k], acc[ai][bj][m][n], 0, 0, 0); } } __builtin_amdgcn_s_setprio(0); } while (0)
#define PG8_WAIT_V(n) asm volatile("s_waitcnt vmcnt(" #n ")" ::: "memory")
#define PG8_WAIT_L(n) asm volatile("s_waitcnt lgkmcnt(" #n ")" ::: "memory")
#define PG8_BAR __builtin_amdgcn_s_barrier()
#define PG8_SCHED __builtin_amdgcn_sched_barrier(0)
    Unit cur, nxt; int ui = 0;
    if (!S.next(0, cur)) return;
    f32x4 acc[2][2][4][2];
    if constexpr (Epi::HAS_INIT) { E.init(acc, cur, wr, wc, fr, fq); if constexpr (Epi::INIT_LOADS) __builtin_amdgcn_s_waitcnt(0x0F70); }
    else {
#pragma unroll
    for (int a = 0; a < 2; ++a)
#pragma unroll
        for (int b = 0; b < 2; ++b)
#pragma unroll
            for (int m = 0; m < 4; ++m)
#pragma unroll
                for (int n = 0; n < 2; ++n) acc[a][b][m][n] = (f32x4){0.f, 0.f, 0.f, 0.f};
    }
    bf16x8 At[4][2], B0[2][2], B1[2][2]; i32x8_t At8[4], B08[2], B18[2];
    const char* cA = (const char*)g.A + (size_t)cur.pm * tstep; const char* cB = (const char*)g.Bt + (size_t)cur.pn * tstep;
    S.a_ready(cur);
    if constexpr (SP2) {
        if constexpr (GATHER) PG8_VA(cur);
        PG8_STAGE(PG8_SB(0, 0), cB, voffB); PG8_STAGE(PG8_SB(0, 1), cB + hstep, voffB); PG8_STA(PG8_SA(0, 0), cA, gA0, 0); PG8_STA(PG8_SA(0, 1), cA + hstep, gA0, 1);
        if (wr == 1) PG8_BAR;
        PG8_WAIT_V(2); PG8_BAR;
        PG8_STAGE(PG8_SB(1, 0), cB + kstep, voffB); PG8_STA(PG8_SA(1, 0), cA + kstep, gA0 + kstep, 0); PG8_STAGE(PG8_SB(1, 1), cB + hstep + kstep, voffB);
        PG8_WAIT_V(6); PG8_BAR;
    } else {
        PG8_STAGE(PG8_SB(0, 0), cB, voffB); PG8_STAGE(PG8_SA(0, 0), cA, voffA); PG8_STAGE(PG8_SB(0, 1), cB + hstep, voffB); PG8_STAGE(PG8_SA(0, 1), cA + hstep, voffA);
        if (wr == 1) PG8_BAR;
        PG8_WAIT_V(4); PG8_BAR;
        PG8_STAGE(PG8_SB(1, 0), cB + kstep, voffB); PG8_STAGE(PG8_SA(1, 0), cA + kstep, voffA); PG8_STAGE(PG8_SB(1, 1), cB + hstep + kstep, voffB);
        PG8_WAIT_V(6); PG8_BAR;
    }
    for (;;) {
        const bool has_next = S.next(ui + 1, nxt);
        const char* nA = has_next ? (const char*)g.A + (size_t)nxt.pm * tstep : cA; const char* nB = has_next ? (const char*)g.Bt + (size_t)nxt.pn * tstep : cB;
        _Pragma("nounroll") for (int t = 0; t < nt; t += 2) {
            const bool last = (t == nt - 2);
            const char* a1 = cA + (size_t)(t + 1) * kstep;
            const char* a2 = last ? nA : cA + (size_t)(t + 2) * kstep; const char* b2 = last ? nB : cB + (size_t)(t + 2) * kstep;
            const char* a3 = a2 + kstep; const char* b3 = b2 + kstep;
            if (last && has_next) S.a_ready(nxt);
            const char* const g1 = gA0 + (size_t)(t + 1) * kstep; const char* const g2 = last ? gA0 : gA0 + (size_t)(t + 2) * kstep; const char* const g3 = g2 + kstep;
            if constexpr (SP2) {
            PG8_LDB(B0, 0, 0); PG8_LDB(B1, 0, 1); PG8_SCHED; PG8_LDA(At, 0, 0); PG8_STA(PG8_SA(1, 1), a1 + hstep, g1, 1);
            PG8_WAIT_V(8); PG8_WAIT_L(0); PG8_BAR; PG8_MMA(0, 0, At, B0); PG8_MMA(0, 1, At, B1); PG8_BAR; PG8_SCHED;
            if constexpr (GATHER) { if (last && has_next) PG8_VA(nxt); }
            PG8_LDA(At, 0, 1); PG8_STAGE(PG8_SB(0, 0), b2, voffB); PG8_STAGE(PG8_SB(0, 1), b2 + hstep, voffB); PG8_STA(PG8_SA(0, 0), a2, g2, 0);
            PG8_WAIT_V(8); PG8_WAIT_L(0); PG8_BAR; PG8_MMA(1, 0, At, B0); PG8_MMA(1, 1, At, B1); PG8_BAR; PG8_SCHED;
            PG8_LDB(B0, 1, 0); PG8_LDB(B1, 1, 1); PG8_SCHED; PG8_LDA(At, 1, 0); PG8_STA(PG8_SA(0, 1), a2 + hstep, g2, 1);
            PG8_WAIT_V(8); PG8_WAIT_L(0); PG8_BAR; PG8_MMA(0, 0, At, B0); PG8_MMA(0, 1, At, B1); PG8_BAR; PG8_SCHED;
            PG8_LDA(At, 1, 1); PG8_STAGE(PG8_SB(1, 0), b3, voffB); PG8_STAGE(PG8_SB(1, 1), b3 + hstep, voffB); PG8_STA(PG8_SA(1, 0), a3, g3, 0);
            PG8_WAIT_V(8); PG8_WAIT_L(0); PG8_BAR; PG8_MMA(1, 0, At, B0); PG8_MMA(1, 1, At, B1); PG8_BAR; PG8_SCHED;
            } else {
            PG8_LDB(B0, 0, 0); PG8_SCHED; PG8_LDA(At, 0, 0); PG8_STAGE(PG8_SA(1, 1), a1 + hstep, voffA);
            PG8_WAIT_L(8); PG8_BAR; PG8_WAIT_L(0); PG8_MMA(0, 0, At, B0); PG8_BAR; PG8_SCHED;
            PG8_LDB(B1, 0, 1); PG8_STAGE(PG8_SB(0, 0), b2, voffB);
            PG8_BAR; PG8_WAIT_L(0); PG8_MMA(0, 1, At, B1); PG8_BAR;
            PG8_LDA(At, 0, 1); PG8_STAGE(PG8_SA(0, 0), a2, voffA);
            PG8_BAR; PG8_WAIT_L(0); PG8_MMA(1, 0, At, B0); PG8_BAR; PG8_SCHED;
            PG8_STAGE(PG8_SB(0, 1), b2 + hstep, voffB);
            PG8_WAIT_V(6); PG8_BAR; PG8_MMA(1, 1, At, B1); PG8_BAR;
            PG8_LDB(B0, 1, 0); PG8_SCHED; PG8_LDA(At, 1, 0); PG8_STAGE(PG8_SA(0, 1), a2 + hstep, voffA);
            PG8_WAIT_L(8); PG8_BAR; PG8_WAIT_L(0); PG8_MMA(0, 0, At, B0); PG8_BAR; PG8_SCHED;
            PG8_LDB(B1, 1, 1); PG8_STAGE(PG8_SB(1, 0), b3, voffB);
            PG8_BAR; PG8_WAIT_L(0); PG8_MMA(0, 1, At, B1); PG8_BAR;
            PG8_LDA(At, 1, 1); PG8_STAGE(PG8_SA(1, 0), a3, voffA);
            PG8_BAR; PG8_WAIT_L(0); PG8_MMA(1, 0, At, B0); PG8_BAR; PG8_SCHED;
            PG8_STAGE(PG8_SB(1, 1), b3 + hstep, voffB);
            PG8_WAIT_V(6); PG8_BAR; PG8_MMA(1, 1, At, B1); PG8_BAR;
            }
        }
        if constexpr (ALIGN_EPI) { if (wr == 0) PG8_BAR; }
        if constexpr (!Epi::AFTER_DRAIN) { int fr_ = fr, fq_ = fq; asm volatile("" : "+v"(fr_), "+v"(fq_));
            E(acc, cur, wr, wc, fr_, fq_); S.done(cur); }
        if (!has_next) break;
        if constexpr (Epi::HAS_INIT) { int fr_ = fr, fq_ = fq; asm volatile("" : "+v"(fr_), "+v"(fq_)); E.init(acc, nxt, wr, wc, fr_, fq_); if constexpr (Epi::INIT_LOADS) __builtin_amdgcn_s_waitcnt(0x0F70); }
        else {
#pragma unroll
        for (int a = 0; a < 2; ++a)
#pragma unroll
            for (int b = 0; b < 2; ++b)
#pragma unroll
                for (int m = 0; m < 4; ++m)
#pragma unroll
                    for (int n = 0; n < 2; ++n) acc[a][b][m][n] = (f32x4){0.f, 0.f, 0.f, 0.f};
        }
        cur = nxt; cA = nA; cB = nB; ++ui;
        if constexpr (ALIGN_EPI) { if (wr == 1) PG8_BAR; }
    }
    PG8_WAIT_V(0);
    if constexpr (!ALIGN_EPI) { if (wr == 0) PG8_BAR; }
    PG8_BAR;
    if constexpr (Epi::AFTER_DRAIN) { E.fused(acc, cur, wr, wc, fr, fq, lds, wid, lane); S.done(cur); }
#undef PG8_SA
#undef PG8_CAT8
#undef PG8_VA
#undef PG8_STA
#undef PG8_SB
#undef PG8_STAGE
#undef PG8_LDA
#undef PG8_LDB
#undef PG8_MMA
#undef PG8_WAIT_V
#undef PG8_WAIT_L
#undef PG8_BAR
#undef PG8_SCHED
}
}

#ifndef PG8_SP2
#define PG8_SP2 true
#endif
#ifndef PG8_ALIGN
#define PG8_ALIGN true
#endif
#define GAS __attribute__((address_space(1)))
#define LAS __attribute__((address_space(3)))
typedef unsigned short bf16;
typedef unsigned v4u __attribute__((ext_vector_type(4)));
typedef float f32x4 __attribute__((ext_vector_type(4)));
typedef short bf16x8 __attribute__((ext_vector_type(8)));
typedef GAS unsigned gu32;
typedef GAS unsigned long long gu64;
#define RLX_AGENT __ATOMIC_RELAXED, __HIP_MEMORY_SCOPE_AGENT
#define LDS_WAIT() asm volatile("s_waitcnt lgkmcnt(0)" ::: "memory")
#define VM_WAIT() asm volatile("s_waitcnt vmcnt(0)" ::: "memory")
__device__ __forceinline__ unsigned long long rt() { return __builtin_amdgcn_s_memrealtime(); }
__device__ __forceinline__ unsigned f2bf(float f) { unsigned u = __builtin_bit_cast(unsigned, f); return (u + 0x7fffu + ((u >> 16) & 1u)) >> 16; }
__device__ __forceinline__ unsigned pk2(float lo, float hi) { return f2bf(lo) | (f2bf(hi) << 16); }

#define XB_TMO      128
#define XB_XCNT(j)  (256  + 64 * (j))
#define XB_XSUB(j)  (1280 + 64 * (j))
#define XB_XGEN(j)  (2304 + 64 * (j))
#define XB_TOP      3328
#define XB_TOPGEN   3392
#define XCD_BAR_WORDS 3456
#define XB_SPIN_CAP (1u << 18)

__device__ __forceinline__ unsigned xb_ld(unsigned* p)              { return __hip_atomic_load(p, __ATOMIC_RELAXED, __HIP_MEMORY_SCOPE_AGENT); }
__device__ __forceinline__ unsigned xb_add(unsigned* p, unsigned v) { return __hip_atomic_fetch_add(p, v, __ATOMIC_RELAXED, __HIP_MEMORY_SCOPE_AGENT); }
__device__ __forceinline__ unsigned xb_xcc_id() { return (unsigned)__builtin_amdgcn_s_getreg((3 << 11) | 20) & 0xFu; }
#define XB_SPIN(cond, bar) do { unsigned _sp = 0; while (cond) { __builtin_amdgcn_s_sleep(1); \
    if ((++_sp & 255u) == 0u) { if (xb_ld(&(bar)[XB_TMO])) break; if (_sp > XB_SPIN_CAP) { atomicAdd(&(bar)[XB_TMO], 1u); break; } } } } while (0)

struct XcdBarrier {
    unsigned* bar; unsigned x;
    volatile LAS unsigned* st;
};

__device__ __forceinline__ XcdBarrier xcd_barrier_post(unsigned* bar, volatile LAS unsigned* st) {
    XcdBarrier b; b.bar = bar; b.x = xb_xcc_id(); b.st = st;
    if (threadIdx.x == 0) (void)xb_add(&bar[XB_XCNT(b.x)], 1u);
    return b;
}
__device__ __forceinline__ void xcd_barrier_complete(unsigned* bar, unsigned x, unsigned& nloc, unsigned& nx) {
    const unsigned G = gridDim.x * gridDim.y * gridDim.z;
    unsigned sum, cnt, mine, sp = 0u;
    for (;;) {
        sum = 0u; cnt = 0u; mine = 0u;
#pragma unroll
        for (unsigned j = 0; j < 16; ++j) { const unsigned c = xb_ld(&bar[XB_XCNT(j)]); sum += c; cnt += (c > 0u) ? 1u : 0u; mine = (j == x) ? c : mine; }
        if (sum == G) break;
        __builtin_amdgcn_s_sleep(1);
        if ((++sp & 255u) == 0u) { if (xb_ld(&bar[XB_TMO])) break; if (sp > XB_SPIN_CAP) { atomicAdd(&bar[XB_TMO], 1u); break; } }
    }
    nloc = mine > 0u ? mine : 1u; nx = cnt > 0u ? cnt : 1u;
}

__device__ __forceinline__ void xcd_barrier(const XcdBarrier& b) {
    asm volatile("s_waitcnt vmcnt(0)" ::: "memory");
    __syncthreads();
    if (threadIdx.x == 0) {
        unsigned* bar = b.bar;
        __builtin_amdgcn_s_waitcnt(0);
        unsigned nloc = b.st[0], nx = b.st[1];
        if (nloc == 0u) { xcd_barrier_complete(bar, b.x, nloc, nx); b.st[0] = nloc; b.st[1] = nx; }
        const unsigned old = xb_add(&bar[XB_XSUB(b.x)], 1u);
        const unsigned gen = old / nloc;
        if (old + 1u == (gen + 1u) * nloc) {
            __builtin_amdgcn_fence(__ATOMIC_RELEASE, "agent");
            asm volatile("s_waitcnt vmcnt(0)" ::: "memory");
            const unsigned og = xb_add(&bar[XB_TOP], 1u);
            const unsigned tg = og / nx;
            if (og + 1u == (tg + 1u) * nx) xb_add(&bar[XB_TOPGEN], 1u);
            else XB_SPIN(xb_ld(&bar[XB_TOPGEN]) == tg, bar);
            __builtin_amdgcn_fence(__ATOMIC_ACQUIRE, "agent");
            xb_add(&bar[XB_XGEN(b.x)], 1u);
            asm volatile("s_waitcnt vmcnt(0)" ::: "memory");
        } else {
            XB_SPIN(xb_ld(&bar[XB_XGEN(b.x)]) == gen, bar);
            __builtin_amdgcn_fence(__ATOMIC_ACQUIRE, "agent");
            asm volatile("s_waitcnt vmcnt(0)" ::: "memory");
        }
    }
    __syncthreads();
}

constexpr int NWAVES = 8;
#ifndef MK_ONE_LAUNCH
#define MK_ONE_LAUNCH 1
#endif

constexpr int BATCH = 16, SEQ = 2048, D = 1024, T = BATCH * SEQ;
constexpr int NIN = 3584;
constexpr int OFF_SQ = 0, OFF_SK = 512, OFF_SV = 1024, OFF_HQ = 1536, OFF_HF = 2048, OFF_HI = 2560, OFF_HG = 3072;
constexpr int NE = 32, TOPK = 4, NASSIGN = T * TOPK;
constexpr int MAXTILES = NASSIGN / 256 + NE;
constexpr int MAXROWS = MAXTILES * 256;
constexpr float EPS = 1e-6f;

constexpr size_t MiB = 1u << 20;
constexpr size_t WS_CTL = 0, CTL_ZERO_BYTES = 1 * MiB;
constexpr size_t WS_WIN = 2 * MiB;
constexpr size_t WS_WOUT = 10 * MiB;
constexpr size_t WS_RT = 12 * MiB;
constexpr size_t WS_WGU = 16 * MiB;
constexpr size_t WS_WD = 144 * MiB;
constexpr size_t WS_XN = 208 * MiB;
constexpr size_t WS_P = 272 * MiB;
constexpr size_t WS_PH = WS_P + 96 * MiB;
constexpr size_t WS_MIX = 496 * MiB;
constexpr size_t WS_ACT = 272 * MiB;
constexpr size_t WS_YK = 560 * MiB;
constexpr size_t WS_QN = 624 * MiB;
constexpr size_t WS_KN = 656 * MiB;
constexpr size_t WS_VT = 688 * MiB;
constexpr size_t WS_KVS = 720 * MiB;
constexpr size_t WS_DEC = 784 * MiB;
constexpr size_t WS_SSEG = 786 * MiB;
constexpr size_t WS_DSEG = 802 * MiB;
constexpr size_t WS_LIST = 816 * MiB;
constexpr size_t WS_TOPG = 825 * MiB;
constexpr size_t WS_X8 = 560 * MiB;
constexpr size_t WS_END = 832 * MiB;
static_assert(WS_ACT + (size_t)MAXROWS * 2048 <= WS_YK && WS_YK + (size_t)T * 4 * 2048 <= WS_LIST && WS_MIX + (size_t)T * 2048 <= WS_YK, "d_ws map");
constexpr int CW_TMO = 0, CW_CODE = 1;
constexpr int CW_CNT = 64;
constexpr int CW_BAR = 4096;

constexpr int RING_OFF = 0, RING_BYTES = 131072;
constexpr int RT_ROW = 2064, RT_WL = 32 * RT_ROW, RT_END = 64 * RT_ROW;
constexpr int LDSCTL_OFF = 133120, MISC_OFF = LDSCTL_OFF + 320;
constexpr int LTAB_OFF = LDSCTL_OFF + 512;
constexpr int LT_TS = MAXTILES, LT_CNT = MAXTILES + 32, LT_MISC = MAXTILES + 64, LT_WORDS = MAXTILES + 192;
constexpr int ROWTAB_OFF = LTAB_OFF + LT_WORDS * 4;
constexpr int MAXSLOT = 17;
constexpr int ROWTAB2_OFF = ROWTAB_OFF + MAXSLOT * 1024;
constexpr int LDS_BYTES = ROWTAB2_OFF + MAXSLOT * 512;
static_assert(RT_END <= LDSCTL_OFF && MISC_OFF + 128 <= LTAB_OFF && LDS_BYTES <= 160 * 1024 && (MAXTILES * 8 + 255) / 256 <= MAXSLOT && 2 * ((MAXTILES * 4 + 255) / 256) * 1024 <= MAXSLOT * 1536 && ROWTAB_OFF % 16 == 0, "LDS map");

struct Frame {
    LAS unsigned char* lds;
    volatile LAS unsigned* MISC;
    gu32* ctl;
    int tid, lane, wave, gw, ngw;
    int vcu, G;
    const float *x, *norm1_g, *w_in, *sb_q_g, *sb_k_g, *sb_out_g, *hg_lb, *hg_out_g, *w_out, *norm2_g, *w_router, *b_router, *w_gu, *b_gu, *w_d, *b_d;
    float* out;
    unsigned char* ws;
};
__device__ __forceinline__ float bf2f(unsigned short b) { return __builtin_bit_cast(float, (unsigned)b << 16); }
__device__ __forceinline__ float bflo(unsigned w) { return __builtin_bit_cast(float, w << 16); }
__device__ __forceinline__ float bfhi(unsigned w) { return __builtin_bit_cast(float, w & 0xffff0000u); }
typedef __bf16 bf16x2n_ __attribute__((ext_vector_type(2)));
typedef float f32x2n_ __attribute__((ext_vector_type(2)));
__device__ __forceinline__ unsigned pkbf(float a, float b) { const bf16x2n_ v = __builtin_convertvector((f32x2n_){a, b}, bf16x2n_); return __builtin_bit_cast(unsigned, v); }
__device__ __forceinline__ int lane_id() { int l; asm volatile("v_mbcnt_lo_u32_b32 %0, -1, 0\n\tv_mbcnt_hi_u32_b32 %0, -1, %0" : "=v"(l)); return l; }
__device__ __forceinline__ int vzero() { int z; asm volatile("v_mov_b32 %0, 0" : "=v"(z)); return z; }
__device__ __forceinline__ float wave_sum(float v) {
#pragma unroll
    for (int o = 1; o < 64; o <<= 1) v += __shfl_xor(v, o);
    return v;
}

constexpr float W8_SCALE = 256.f, A8_SCALE = 4.f, Y8_SCALE = 32.f; static_assert(Y8_SCALE == 32.f, "SC_W8Y below is 2^-8 * 32");
constexpr int SC_ONE = 0x7f7f7f7f, SC_W8 = 0x77777777, SC_A8 = 0x7d7d7d7d, SC_W8Y = 0x7c7c7c7c;
struct P0Item { const float* W; bf16* WT; const float* rowscale; int N, k0, n0, drow0, fp8, perm; };
__device__ __forceinline__ void p0_load(const P0Item& it, f32x4 (&v)[16], int lane) {
    const int kr = lane >> 4, nc = 4 * (lane & 15);
#pragma unroll
    for (int i = 0; i < 16; ++i) v[i] = __builtin_nontemporal_load((const f32x4*)(it.W + (size_t)(it.k0 + 4 * i + kr) * it.N + it.n0 + nc));
}
__device__ __forceinline__ void p0_store(const P0Item& it, const f32x4 (&v)[16], LAS unsigned char* scr, int lane) {
    const int kr = lane >> 4, nc = 4 * (lane & 15);
#pragma unroll
    for (int i = 0; i < 16; ++i) { const float sc = it.rowscale ? it.rowscale[it.k0 + 4 * i + kr] : 1.f;
        *(LAS unsigned long long*)(scr + (4 * i + kr) * 136 + 2 * nc) = (unsigned long long)pkbf(v[i].x * sc, v[i].y * sc) | ((unsigned long long)pkbf(v[i].z * sc, v[i].w * sc) << 32); }
    LDS_WAIT(); asm volatile("" ::: "memory");
    const LAS unsigned short* s16 = (const LAS unsigned short*)scr;
    if (it.fp8) { const int p = lane & 3, nr = lane >> 2;
#pragma unroll
        for (int c = 0; c < 4; ++c) { const int n = 16 * c + nr; unsigned val[16];
#pragma unroll
            for (int kk = 0; kk < 16; ++kk) val[kk] = s16[(16 * p + kk) * 68 + n];
            v4u w4;
            w4.x = pg8::pk4_fp8(bflo(val[0]) * W8_SCALE, bflo(val[1]) * W8_SCALE, bflo(val[2]) * W8_SCALE, bflo(val[3]) * W8_SCALE);
            w4.y = pg8::pk4_fp8(bflo(val[4]) * W8_SCALE, bflo(val[5]) * W8_SCALE, bflo(val[6]) * W8_SCALE, bflo(val[7]) * W8_SCALE);
            w4.z = pg8::pk4_fp8(bflo(val[8]) * W8_SCALE, bflo(val[9]) * W8_SCALE, bflo(val[10]) * W8_SCALE, bflo(val[11]) * W8_SCALE);
            w4.w = pg8::pk4_fp8(bflo(val[12]) * W8_SCALE, bflo(val[13]) * W8_SCALE, bflo(val[14]) * W8_SCALE, bflo(val[15]) * W8_SCALE);
            *(GAS v4u*)((unsigned char*)it.WT + (size_t)(it.drow0 + n) * D + it.k0 + 16 * p) = w4; }
    } else { const int p = lane & 7, nr = lane >> 3;
#pragma unroll
        for (int c = 0; c < 8; ++c) { const int n = 8 * c + nr; unsigned val[8];
#pragma unroll
            for (int kk = 0; kk < 8; ++kk) val[kk] = s16[(8 * p + kk) * 68 + n];
            v4u w4; w4.x = val[0] | (val[1] << 16); w4.y = val[2] | (val[3] << 16); w4.z = val[4] | (val[5] << 16); w4.w = val[6] | (val[7] << 16);
            *(GAS v4u*)(it.WT + (size_t)(it.drow0 + (it.perm ? 128 * (n >> 5) + (n & 31) : n)) * D + it.k0 + 8 * p) = w4; } }
    LDS_WAIT(); asm volatile("" ::: "memory");
}
__device__ __forceinline__ void rms_rows2_to_bf16(const float* xa, const float* xb, bool hasb, const float* g, bf16* oa, bf16* ob, int lane) {
    const GAS f32x4* pa = (const GAS f32x4*)xa + lane; const GAS f32x4* pb = (const GAS f32x4*)(hasb ? xb : xa) + lane; const f32x4* gr = (const f32x4*)g + lane;
    f32x4 va[4], vb[4], gg[4]; float sa = 0.f, sb = 0.f;
#pragma unroll
    for (int j = 0; j < 4; ++j) { va[j] = __builtin_nontemporal_load(pa + 64 * j); vb[j] = __builtin_nontemporal_load(pb + 64 * j); gg[j] = gr[64 * j]; }
#pragma unroll
    for (int j = 0; j < 4; ++j) { sa += (va[j].x * va[j].x + va[j].y * va[j].y) + (va[j].z * va[j].z + va[j].w * va[j].w); sb += (vb[j].x * vb[j].x + vb[j].y * vb[j].y) + (vb[j].z * vb[j].z + vb[j].w * vb[j].w); }
    const float ra = 1.f / sqrtf(wave_sum(sa) * (1.f / D) + EPS), rb = 1.f / sqrtf(wave_sum(sb) * (1.f / D) + EPS);
    GAS unsigned long long* o8a = (GAS unsigned long long*)oa + lane; GAS unsigned long long* o8b = (GAS unsigned long long*)ob + lane;
#pragma unroll
    for (int j = 0; j < 4; ++j) o8a[64 * j] = (unsigned long long)pkbf(va[j].x * ra * gg[j].x, va[j].y * ra * gg[j].y) | ((unsigned long long)pkbf(va[j].z * ra * gg[j].z, va[j].w * ra * gg[j].w) << 32);
    if (hasb) {
#pragma unroll
        for (int j = 0; j < 4; ++j) o8b[64 * j] = (unsigned long long)pkbf(vb[j].x * rb * gg[j].x, vb[j].y * rb * gg[j].y) | ((unsigned long long)pkbf(vb[j].z * rb * gg[j].z, vb[j].w * rb * gg[j].w) << 32); }
}
__device__ __forceinline__ P0Item p0_item(Frame& F, int r) {
    constexpr int I_IN = 16 * (NIN / 64), I_OUT = 16 * 16, I_GU = NE * 16 * 32;
    P0Item it;
    if (r < I_IN) { const int nb = NIN / 64, kb = r / nb, nn = r % nb; const int pq = nn < 16; it = P0Item{F.w_in, (bf16*)(F.ws + WS_WIN), nullptr, NIN, 64 * kb, 64 * nn, pq ? 256 * (nn >> 2) + 32 * (nn & 3) : 64 * nn, 0, pq}; return it; } r -= I_IN;
    if (r < I_OUT) { const int kb = r / 16, nn = r % 16; it = P0Item{F.w_out, (bf16*)(F.ws + WS_WOUT), nullptr, D, 64 * kb, 64 * nn, 64 * nn, 0, 0}; return it; } r -= I_OUT;
    if (r < I_GU) { const int e = r / 512, q = r % 512, kb = q / 32, nn = q % 32;
        const int isup = nn >> 4, a = (nn & 15) * 64;
        it = P0Item{F.w_gu + (size_t)e * D * 2048, (bf16*)(F.ws + WS_WGU + (size_t)e * 2048 * D), F.norm2_g, 2048, 64 * kb, 64 * nn, 256 * (a >> 7) + 128 * isup + (a & 127), 1, 0}; return it; } r -= I_GU;
    { const int e = r / 256, q = r % 256, kb = q / 16, nn = q % 16;
        it = P0Item{F.w_d + (size_t)e * D * D, (bf16*)(F.ws + WS_WD + (size_t)e * D * D), nullptr, D, 64 * kb, 64 * nn, 64 * nn, 1, 0}; return it; }
}
constexpr int P0_NITEMS = 16 * (NIN / 64) + 16 * 16 + NE * 16 * 32 + NE * 16 * 16;
constexpr int P0_NLATE = 1024;
__device__ __forceinline__ void p0_items(Frame& F, int lo, int hi, int w, int nw) {
    LAS unsigned char* scr = F.lds + RING_OFF + F.wave * 16384;
    f32x4 va[16], vb[16]; int it = lo + w;
    if (it < hi) { P0Item A = p0_item(F, it); p0_load(A, va, F.lane);
        for (;;) {
            const int itb = it + nw; const bool hb = itb < hi; const P0Item B = p0_item(F, hb ? itb : it); p0_load(B, vb, F.lane); __builtin_amdgcn_sched_barrier(0);
            p0_store(A, va, scr, F.lane);
            if (!hb) break;
            it = itb + nw; const bool ha = it < hi; A = p0_item(F, ha ? it : itb); p0_load(A, va, F.lane); __builtin_amdgcn_sched_barrier(0);
            p0_store(B, vb, scr, F.lane);
            if (!ha) break;
        }
    }
}
__device__ __forceinline__ void p0_prologue(Frame& F) {
    p0_items(F, 0, P0_NITEMS - P0_NLATE, F.gw, F.ngw);
    for (int q = blockIdx.x * (NWAVES * 64) + F.tid; q < 4096; q += F.G * NWAVES * 64) {
        const int e = q & 31, k0 = (q >> 5) * 8; unsigned hi[8], lo[8];
#pragma unroll
        for (int j = 0; j < 8; ++j) { const float w = F.w_router[(k0 + j) * 32 + e] * F.norm2_g[k0 + j]; hi[j] = pkbf(w, 0.f) & 0xffffu; lo[j] = pkbf(w - bflo(hi[j]), 0.f) & 0xffffu; }
        const v4u h4 = {hi[0] | (hi[1] << 16), hi[2] | (hi[3] << 16), hi[4] | (hi[5] << 16), hi[6] | (hi[7] << 16)}, l4 = {lo[0] | (lo[1] << 16), lo[2] | (lo[3] << 16), lo[4] | (lo[5] << 16), lo[6] | (lo[7] << 16)};
        *(GAS v4u*)(F.ws + WS_RT + e * RT_ROW + 2 * k0) = h4; *(GAS v4u*)(F.ws + WS_RT + RT_WL + e * RT_ROW + 2 * k0) = l4; }
    for (int m = F.gw; m < T; m += 2 * F.ngw) rms_rows2_to_bf16(F.x + (size_t)m * D, F.x + (size_t)(m + F.ngw) * D, m + F.ngw < T, F.norm1_g, (bf16*)(F.ws + WS_XN) + (size_t)m * D, (bf16*)(F.ws + WS_XN) + (size_t)(m + F.ngw) * D, F.lane);
}

typedef float f32x16 __attribute__((ext_vector_type(16)));
typedef __bf16 bf16x2n __attribute__((ext_vector_type(2)));
typedef float f32x2n __attribute__((ext_vector_type(2)));
#define MFMA32(a, b, c) __builtin_amdgcn_mfma_f32_32x32x16_bf16((a), (b), (c), 0, 0, 0)
__device__ __forceinline__ bf16x8 pack8(float a0, float a1, float a2, float a3, float a4, float a5, float a6, float a7) { const v4u p = {pkbf(a0, a1), pkbf(a2, a3), pkbf(a4, a5), pkbf(a6, a7)}; return __builtin_bit_cast(bf16x8, p); }
constexpr float QSCALE = 0.125f * 1.44269504089f;
__device__ __forceinline__ void prep_phase(Frame& F) {
    LAS unsigned* tl = (LAS unsigned*)(F.lds + RING_OFF + F.wave * 16384);
    const bf16* P = (const bf16*)(F.ws + WS_P); bf16* Qn = (bf16*)(F.ws + WS_QN); bf16* Kn = (bf16*)(F.ws + WS_KN); bf16* VT = (bf16*)(F.ws + WS_VT);
    const int tr = F.lane >> 3, c8 = F.lane & 7;
    for (int it = F.gw; it < 4096; it += F.ngw) {
        const int bh = it & 127, blk = it >> 7, b = bh >> 3, h = bh & 7;
        const bf16* base = P + ((size_t)b * 8 + h) * SEQ * 64 + (size_t)(blk * 64 + tr) * 64 + 8 * c8;
        v4u rv[8];
#pragma unroll
        for (int i = 0; i < 8; ++i) { const bf16* row = base + (size_t)(8 * i) * 64; rv[i] = *(const GAS v4u*)(row + (size_t)2 * 16 * 8 * SEQ * 64); }
        {
#pragma unroll
            for (int i = 0; i < 8; ++i) { LAS unsigned* q = tl + (8 * i + tr) * 33 + 4 * c8; q[0] = rv[i].x; q[1] = rv[i].y; q[2] = rv[i].z; q[3] = rv[i].w; }
            LDS_WAIT(); asm volatile("" ::: "memory");
            const LAS unsigned short* t16 = (const LAS unsigned short*)tl; const int dr = tr;
#define KAP(pos) (((pos) & ~12) | (((pos) & 4) << 1) | (((pos) & 8) >> 1))
            bf16* const obase = VT + ((size_t)bh * 64 + blk * 2 + (c8 >> 2)) * 2048 + ((c8 >> 1) & 1) * 512 + (c8 & 1) * 256;
#pragma unroll
            for (int j = 0; j < 8; ++j) { unsigned val[8];
#pragma unroll
                for (int p = 0; p < 8; ++p) { const int pos = 8 * c8 + p; val[p] = t16[KAP(pos) * 66 + 8 * j + dr]; }
                v4u w4; w4.x = val[0] | (val[1] << 16); w4.y = val[2] | (val[3] << 16); w4.z = val[4] | (val[5] << 16); w4.w = val[6] | (val[7] << 16);
                *(GAS v4u*)(obase + (j >> 2) * 1024 + ((8 * j + dr) & 31) * 8) = w4; }
#undef KAP
            LDS_WAIT(); asm volatile("" ::: "memory");
        }
    }
}

__device__ __forceinline__ int crow16(int i, int hh) { return (i & 3) + 8 * (i >> 2) + 4 * hh; }
__device__ __forceinline__ void attn_item(Frame& F, int bh, int qb, float thr, const bf16x8 (&Lt)[2]) {
    const int r = F.lane & 31, hh = F.lane >> 5, b = bh >> 3, h = bh & 7, q0 = qb * 32;
    const bf16* Qn = (const bf16*)(F.ws + WS_QN); const bf16* Kn = (const bf16*)(F.ws + WS_KN); const bf16* VT = (const bf16*)(F.ws + WS_VT);
    bf16x8 qf[4];
#pragma unroll
    for (int s = 0; s < 4; ++s) qf[s] = *(const GAS bf16x8*)(Qn + ((size_t)bh * 64 + qb) * 2048 + s * 512 + F.lane * 8);
    f32x4 gout[2][4];
#pragma unroll
    for (int db = 0; db < 2; ++db)
#pragma unroll
        for (int gq = 0; gq < 4; ++gq) gout[db][gq] = *(const f32x4*)(F.sb_out_g + h * 64 + 32 * db + 8 * gq + 4 * hh);
    f32x16 O0, O1;
#pragma unroll
    for (int i = 0; i < 16; ++i) { O0[i] = 0.f; O1[i] = 0.f; }
    float carry = 0.f;
    const bf16* kbase = Kn + (size_t)bh * 64 * 2048 + F.lane * 8; const bf16* vbase = VT + (size_t)bh * 64 * 2048 + F.lane * 8;
#define ATT_LOAD(KF, VF, kb_) do { _Pragma("unroll") for (int s_ = 0; s_ < 4; ++s_) KF[s_] = *(const GAS bf16x8*)(kbase + (size_t)(kb_) * 2048 + 512 * s_); \
        _Pragma("unroll") for (int db_ = 0; db_ < 2; ++db_) _Pragma("unroll") for (int ks_ = 0; ks_ < 2; ++ks_) VF[db_][ks_] = *(const GAS bf16x8*)(vbase + (size_t)(kb_) * 2048 + 1024 * db_ + 512 * ks_); } while (0)
#define ATT_BLOCK(KF, VF, kb_) do { const bool diag = ((kb_) == qb); \
        f32x16 z; _Pragma("unroll") for (int i = 0; i < 16; ++i) z[i] = 0.f; \
        _Pragma("unroll") for (int s_ = 0; s_ < 4; ++s_) z = MFMA32(KF[s_], qf[s_], z); \
        float sp[16]; \
        _Pragma("unroll") for (int i = 0; i < 16; ++i) { const float zz = z[i]; float v = fmaxf(zz, 0.f) + __builtin_amdgcn_logf(1.f + __builtin_amdgcn_exp2f(-fabsf(zz))); if (diag && !(crow16(i, hh) < r)) v = 0.f; sp[i] = v; } \
        const bf16x8 sb0 = pack8(sp[0], sp[1], sp[2], sp[3], sp[4], sp[5], sp[6], sp[7]), sb1 = pack8(sp[8], sp[9], sp[10], sp[11], sp[12], sp[13], sp[14], sp[15]); \
        f32x16 Cc; _Pragma("unroll") for (int i = 0; i < 16; ++i) Cc[i] = carry; \
        Cc = MFMA32(Lt[0], sb0, Cc); Cc = MFMA32(Lt[1], sb1, Cc); \
        float w[16]; \
        _Pragma("unroll") for (int i = 0; i < 16; ++i) { float v = __builtin_amdgcn_exp2f(z[i] - Cc[i]); if (diag && !(crow16(i, hh) < r)) v = 0.f; w[i] = v; } \
        const bf16x8 wb0 = pack8(w[0], w[1], w[2], w[3], w[4], w[5], w[6], w[7]), wb1 = pack8(w[8], w[9], w[10], w[11], w[12], w[13], w[14], w[15]); \
        O0 = MFMA32(VF[0][0], wb0, O0); O0 = MFMA32(VF[0][1], wb1, O0); O1 = MFMA32(VF[1][0], wb0, O1); O1 = MFMA32(VF[1][1], wb1, O1); \
        carry = __shfl(Cc[0], r); } while (0)
    bf16x8 kfA[4], vfA[2][2], kfB[4], vfB[2][2];
    ATT_LOAD(kfA, vfA, qb);
    for (int kb = qb; kb >= 0; kb -= 2) {
        ATT_LOAD(kfB, vfB, kb > 0 ? kb - 1 : 0); __builtin_amdgcn_sched_barrier(0);
        ATT_BLOCK(kfA, vfA, kb);
        if (kb == 0 || __all(carry > thr)) break;
        ATT_LOAD(kfA, vfA, kb > 1 ? kb - 2 : 0); __builtin_amdgcn_sched_barrier(0);
        ATT_BLOCK(kfB, vfB, kb - 1);
        if (__all(carry > thr)) break;
    }
#undef ATT_LOAD
#undef ATT_BLOCK
    float ss = 0.f;
#pragma unroll
    for (int i = 0; i < 16; ++i) ss += O0[i] * O0[i] + O1[i] * O1[i];
    ss += __shfl_xor(ss, 32);
    const float rs = 1.f / sqrtf(ss * (1.f / 64.f) + EPS);
    bf16* orow = (bf16*)(F.ws + WS_MIX) + ((size_t)b * SEQ + q0 + r) * D + h * 64;
#pragma unroll
    for (int db = 0; db < 2; ++db)
#pragma unroll
        for (int gq = 0; gq < 4; ++gq) { const int d = 32 * db + 8 * gq + 4 * hh; const f32x4 gg = gout[db][gq];
            const float a0 = (db ? O1[4 * gq + 0] : O0[4 * gq + 0]) * rs * gg.x, a1 = (db ? O1[4 * gq + 1] : O0[4 * gq + 1]) * rs * gg.y, a2 = (db ? O1[4 * gq + 2] : O0[4 * gq + 2]) * rs * gg.z, a3 = (db ? O1[4 * gq + 3] : O0[4 * gq + 3]) * rs * gg.w;
            *(GAS unsigned long long*)(orow + d) = (unsigned long long)pkbf(a0, a1) | ((unsigned long long)pkbf(a2, a3) << 32); }
}
__device__ __forceinline__ void attn_phase(Frame& F) {
    const int r = F.lane & 31, hh = F.lane >> 5;
    float mq = fabsf(F.sb_q_g[F.lane]), mk = fabsf(F.sb_k_g[F.lane]);
#pragma unroll
    for (int o = 1; o < 64; o <<= 1) { mq = fmaxf(mq, __shfl_xor(mq, o)); mk = fmaxf(mk, __shfl_xor(mk, o)); }
    const float thr = 64.f * QSCALE * mq * mk * 1.02f + 151.f;
    bf16x8 Lt[2];
#pragma unroll
    for (int ks = 0; ks < 2; ++ks) { float e[8];
#pragma unroll
        for (int jj = 0; jj < 8; ++jj) e[jj] = (16 * ks + 8 * (jj >> 2) + 4 * hh + (jj & 3) >= r) ? 1.f : 0.f;
        Lt[ks] = pack8(e[0], e[1], e[2], e[3], e[4], e[5], e[6], e[7]); }
    for (int it = F.gw; it < 2048; it += F.ngw) { const int bh = it & 127, j = it >> 7;
        attn_item(F, bh, 63 - j, thr, Lt); attn_item(F, bh, j, thr, Lt); attn_item(F, bh, 47 - j, thr, Lt); attn_item(F, bh, 16 + j, thr, Lt); }
}

constexpr int HG_PART = 0, HG_SSQ = 2048, HG_QE = 4096, HG_KE = HG_QE + 64 * 272, HG_VT = HG_KE + 64 * 272, HG_KST = HG_VT + 128 * 144, HG_ST = HG_KST + 128 * 144, HG_END = HG_ST + 128 * 272;
static_assert(HG_END <= RING_BYTES, "HGRN2 LDS map");
__device__ __forceinline__ float hg_lbound(Frame& F, int h, int d) { const int c = h * 128 + d; return 1.f / (1.f + __expf(F.hg_lb[512 + c] - F.hg_lb[c])); }
__device__ __forceinline__ void hg_gates(Frame& F, const unsigned short (&ffr)[16], float lb, int d, int tq, float (&bb)[16], float (&kk)[16], float& total) {
    float run = 1.f;
#pragma unroll
    for (int i = 0; i < 16; ++i) { const float ff = bf2f(ffr[i]); const float sg = __builtin_amdgcn_rcpf(1.f + __expf(-ff));
        const float f = lb + (1.f - lb) * sg; kk[i] = (1.f - lb) * (1.f - sg); run *= f; bb[i] = run; }
    LAS float* part = (LAS float*)(F.lds + RING_OFF + HG_PART);
    part[tq * 128 + d] = run;
    __syncthreads();
    const float p0 = part[d], p1 = part[128 + d], p2 = part[256 + d], p3 = part[384 + d];
    const float off = (tq > 0 ? p0 : 1.f) * (tq > 1 ? p1 : 1.f) * (tq > 2 ? p2 : 1.f);
    total = (p0 * p1) * (p2 * p3);
#pragma unroll
    for (int i = 0; i < 16; ++i) bb[i] *= off;
}
#define HG_HV() const bf16* const PHp = (const bf16*)(F.ws + WS_PH); \
    const __amdgpu_buffer_rsrc_t rsrcP = __builtin_amdgcn_make_buffer_rsrc((void*)PHp, 0, (int)((size_t)4 * T * 512 * 2), 0x00020000)
#define HG_SOFF(item_, arr_) ((unsigned)((((arr_) * 16 + (((item_) >> 5) >> 2)) * 4 + (((item_) >> 5) & 3)) * SEQ + ((item_) & 31) * 64) * 256u)
#define HG_ARR(col_) ((col_) == OFF_HQ ? 0 : (col_) == OFF_HF ? 1 : (col_) == OFF_HI ? 2 : 3)
#define HG_LOADT(dst2, item_, arr_) do { const unsigned so_ = (unsigned)__builtin_amdgcn_readfirstlane((int)HG_SOFF(item_, arr_)); _Pragma("unroll") for (int j_ = 0; j_ < 2; ++j_) \
        (dst2)[j_] = __builtin_bit_cast(v4u, __builtin_amdgcn_raw_buffer_load_b128(rsrcP, (unsigned)F.tid * 16u + 8192u * j_, so_, 0)); } while (0)
#define HG_PUT(src2, raw_) do { _Pragma("unroll") for (int j_ = 0; j_ < 2; ++j_) *(LAS v4u*)((raw_) + ((F.tid >> 4) + 32 * j_) * 272 + (F.tid & 15) * 16) = (src2)[j_]; } while (0)
#define HG_COL(dst, raw_) do { _Pragma("unroll") for (int i_ = 0; i_ < 16; ++i_) dst[i_] = *(const LAS unsigned short*)((raw_) + (16 * tq + i_) * 272 + 2 * d); } while (0)
template <bool PERMUTE> __device__ __forceinline__ void st16(LAS unsigned char* dst, const float (&v)[16]) {
    v4u a, b2;
    if (!PERMUTE) { a.x = pkbf(v[0], v[1]); a.y = pkbf(v[2], v[3]); a.z = pkbf(v[4], v[5]); a.w = pkbf(v[6], v[7]); b2.x = pkbf(v[8], v[9]); b2.y = pkbf(v[10], v[11]); b2.z = pkbf(v[12], v[13]); b2.w = pkbf(v[14], v[15]); }
    else { a.x = pkbf(v[0], v[1]); a.y = pkbf(v[2], v[3]); a.z = pkbf(v[8], v[9]); a.w = pkbf(v[10], v[11]); b2.x = pkbf(v[4], v[5]); b2.y = pkbf(v[6], v[7]); b2.z = pkbf(v[12], v[13]); b2.w = pkbf(v[14], v[15]); }
    *(LAS v4u*)dst = a; *(LAS v4u*)(dst + 16) = b2;
}
__device__ __forceinline__ void hgA_phase(Frame& F) {
    const int d = F.tid & 127, tq = F.tid >> 7, r = F.lane & 31, hh = F.lane >> 5;
    const bf16* P = (const bf16*)(F.ws + WS_P); bf16* KVS = (bf16*)(F.ws + WS_KVS); float* DEC = (float*)(F.ws + WS_DEC); float* SSEG = (float*)(F.ws + WS_SSEG); float* DSEG = (float*)(F.ws + WS_DSEG);
    LAS unsigned char* L = F.lds + RING_OFF; LAS float* decl = (LAS float*)(L + HG_SSQ);
    HG_HV();
    v4u rf[2], rv[2];
    LAS unsigned char* const RAWF = F.lds + ROWTAB_OFF; LAS unsigned char* const RAWV = L + HG_ST;
    for (int wg = blockIdx.x; wg < 256; wg += F.G) {
        const int bh = wg >> 2, seg = wg & 3, item0 = bh * 32 + seg * 8, h = bh & 3;
        HG_LOADT(rf, item0, 1); HG_LOADT(rv, item0, 2);
        const float lbv = hg_lbound(F, h, d); float totrun = 1.f;
        const int db = F.wave & 3, eb0 = 2 * (F.wave >> 2);
        f32x16 run0, run1;
#pragma unroll
        for (int i = 0; i < 16; ++i) { run0[i] = 0.f; run1[i] = 0.f; }
      for (int k = 0; k < 8; ++k) {
        const int item = item0 + k;
        HG_PUT(rf, RAWF); HG_PUT(rv, RAWV);
        __syncthreads();
        { const int nit = k < 7 ? item + 1 : item; HG_LOADT(rf, nit, 1); HG_LOADT(rv, nit, 2); __builtin_amdgcn_sched_barrier(0); }
        unsigned short ffr[16], vr[16]; HG_COL(ffr, RAWF); HG_COL(vr, RAWV);
        float bb[16], kk[16], total; hg_gates(F, ffr, lbv, d, tq, bb, kk, total);
        float ks[16], vv[16];
#pragma unroll
        for (int i = 0; i < 16; ++i) { ks[i] = kk[i] * (total * __builtin_amdgcn_rcpf(bb[i])); vv[i] = bf2f(vr[i]); }
        st16<false>(L + HG_KST + d * 144 + tq * 32, ks); st16<false>(L + HG_VT + d * 144 + tq * 32, vv);
        const float dc = total; totrun *= total;
        if (tq == 0) { DEC[(size_t)item * 128 + d] = dc; decl[d] = dc; }
        __syncthreads();
        f32x16 acc0, acc1;
#pragma unroll
        for (int i = 0; i < 16; ++i) { acc0[i] = 0.f; acc1[i] = 0.f; }
#pragma unroll
        for (int s = 0; s < 4; ++s) { const bf16x8 af = *(const LAS bf16x8*)(L + HG_KST + (db * 32 + r) * 144 + 32 * s + 16 * hh);
            const bf16x8 b0 = *(const LAS bf16x8*)(L + HG_VT + (eb0 * 32 + r) * 144 + 32 * s + 16 * hh), b1 = *(const LAS bf16x8*)(L + HG_VT + ((eb0 + 1) * 32 + r) * 144 + 32 * s + 16 * hh);
            acc0 = MFMA32(af, b0, acc0); acc1 = MFMA32(af, b1, acc1); }
#pragma unroll
        for (int g = 0; g < 4; ++g) { const f32x4 dl = *(const LAS f32x4*)(decl + db * 32 + 8 * g + 4 * hh);
#pragma unroll
            for (int ii = 0; ii < 4; ++ii) { run0[4 * g + ii] = dl[ii] * run0[4 * g + ii] + acc0[4 * g + ii]; run1[4 * g + ii] = dl[ii] * run1[4 * g + ii] + acc1[4 * g + ii]; } }
#pragma unroll
        for (int j = 0; j < 2; ++j) { bf16* dst = KVS + ((size_t)item * 128 + (eb0 + j) * 32 + r) * 128 + db * 32 + 4 * hh;
#pragma unroll
            for (int g = 0; g < 4; ++g) { const float a0 = j ? acc1[4 * g + 0] : acc0[4 * g + 0], a1 = j ? acc1[4 * g + 1] : acc0[4 * g + 1], a2 = j ? acc1[4 * g + 2] : acc0[4 * g + 2], a3 = j ? acc1[4 * g + 3] : acc0[4 * g + 3];
                *(GAS unsigned long long*)(dst + 8 * g) = (unsigned long long)pkbf(a0, a1) | ((unsigned long long)pkbf(a2, a3) << 32); } }
        __syncthreads();
      }
#pragma unroll
        for (int j = 0; j < 2; ++j) { float* dst = SSEG + ((size_t)wg * 128 + (eb0 + j) * 32 + r) * 128 + db * 32 + 4 * hh;
#pragma unroll
            for (int g = 0; g < 4; ++g) *(GAS f32x4*)(dst + 8 * g) = j ? (f32x4){run1[4 * g + 0], run1[4 * g + 1], run1[4 * g + 2], run1[4 * g + 3]} : (f32x4){run0[4 * g + 0], run0[4 * g + 1], run0[4 * g + 2], run0[4 * g + 3]}; }
        if (tq == 0) DSEG[(size_t)wg * 128 + d] = totrun;
    }
}
constexpr int HG_DECS = HG_END;
static_assert(HG_DECS + 4096 + 64 * 272 <= LDSCTL_OFF && HG_KST + 64 * 272 <= HG_ST && 64 * 272 <= MAXSLOT * 1536, "HGRN2 LDS map (decays, raw tiles)");
__device__ __forceinline__ void hgC_phase(Frame& F) {
    const int d = F.tid & 127, tq = F.tid >> 7, r = F.lane & 31, hh = F.lane >> 5;
    const bf16* P = (const bf16*)(F.ws + WS_P); const bf16* KVS = (const bf16*)(F.ws + WS_KVS); bf16* MIX = (bf16*)(F.ws + WS_MIX); const float* DEC = (const float*)(F.ws + WS_DEC);
    HG_HV();
    LAS unsigned char* L = F.lds + RING_OFF; const LAS float* decs = (const LAS float*)(L + HG_DECS);
    const int se = F.tid >> 2, sq = F.tid & 3;
    v4u rf[2], rq[2], rv[2], st[4];
    LAS unsigned char* const RAWF = L + HG_KST; LAS unsigned char* const RAWQ = F.lds + ROWTAB_OFF; LAS unsigned char* const RAWV = L + HG_DECS + 4096;
    const __amdgpu_buffer_rsrc_t rsrcG = __builtin_amdgcn_make_buffer_rsrc((void*)F.hg_out_g, 0, 512 * 4, 0x00020000), rsrcSS = __builtin_amdgcn_make_buffer_rsrc((void*)(F.ws + WS_SSEG), 0, 256 * 128 * 128 * 4, 0x00020000), rsrcDS = __builtin_amdgcn_make_buffer_rsrc((void*)(F.ws + WS_DSEG), 0, 256 * 128 * 4, 0x00020000);
    const __amdgpu_buffer_rsrc_t rsrcD = __builtin_amdgcn_make_buffer_rsrc((void*)DEC, 0, 64 * 32 * 128 * 4, 0x00020000), rsrcM = __builtin_amdgcn_make_buffer_rsrc((void*)MIX, 0, (int)((size_t)T * D * 2), 0x00020000);
    const __amdgpu_buffer_rsrc_t rsrcK = __builtin_amdgcn_make_buffer_rsrc((void*)KVS, 0, 64 * 32 * 128 * 128 * 2, 0x00020000); const unsigned kvo = (unsigned)((se * 128 + sq * 32) * 2);
#define HG_LOADKV(dst_, item_) do { const unsigned so_ = (unsigned)__builtin_amdgcn_readfirstlane((int)((item_) * (128 * 128 * 2))); _Pragma("unroll") for (int j_ = 0; j_ < 4; ++j_) (dst_)[j_] = __builtin_bit_cast(v4u, __builtin_amdgcn_raw_buffer_load_b128(rsrcK, kvo + 16u * j_, so_, 0)); } while (0)
#define HG_LOADST(item_) HG_LOADKV(st, item_)
#define HG_FOLD(kv_, c_) do { _Pragma("unroll") for (int j_ = 0; j_ < 4; ++j_) { const f32x4 d0_ = *(const LAS f32x4*)(decs + (c_) * 128 + sq * 32 + 8 * j_), d1_ = *(const LAS f32x4*)(decs + (c_) * 128 + sq * 32 + 8 * j_ + 4); const v4u k_ = (kv_)[j_]; \
        S[8 * j_ + 0] = d0_.x * S[8 * j_ + 0] + bflo(k_.x); S[8 * j_ + 1] = d0_.y * S[8 * j_ + 1] + bfhi(k_.x); S[8 * j_ + 2] = d0_.z * S[8 * j_ + 2] + bflo(k_.y); S[8 * j_ + 3] = d0_.w * S[8 * j_ + 3] + bfhi(k_.y); \
        S[8 * j_ + 4] = d1_.x * S[8 * j_ + 4] + bflo(k_.z); S[8 * j_ + 5] = d1_.y * S[8 * j_ + 5] + bfhi(k_.z); S[8 * j_ + 6] = d1_.z * S[8 * j_ + 6] + bflo(k_.w); S[8 * j_ + 7] = d1_.w * S[8 * j_ + 7] + bfhi(k_.w); } } while (0)
    for (int wg = blockIdx.x; wg < 256; wg += F.G) {
        const int bh = wg >> 2, seg = wg & 3, item0 = bh * 32 + seg * 8, b = bh >> 2, h = bh & 3;
        HG_LOADT(rf, item0, 1); HG_LOADT(rq, item0, 0); HG_LOADT(rv, item0, 2); HG_LOADST(item0);
        const unsigned dso0 = (unsigned)__builtin_amdgcn_readfirstlane((bh * 32 + seg * 8) * 128 * 4);
        const f32x4 decv = __builtin_bit_cast(f32x4, __builtin_amdgcn_raw_buffer_load_b128(rsrcD, (unsigned)(F.tid & 255) * 16u, dso0, 0));
        const float lbv = hg_lbound(F, h, d);
        __builtin_amdgcn_sched_barrier(0);
        float S[32];
#pragma unroll
        for (int j = 0; j < 32; ++j) S[j] = 0.f;
        for (int sp = 0; sp < seg; ++sp) {
            const unsigned sso = (unsigned)__builtin_amdgcn_readfirstlane((bh * 4 + sp) * 128 * 128 * 4), dso = (unsigned)__builtin_amdgcn_readfirstlane((bh * 4 + sp) * 128 * 4);
#pragma unroll
            for (int j0 = 0; j0 < 8; j0 += 8) { f32x4 sv[8], dv[8];
#pragma unroll
                for (int j = 0; j < 8; ++j) { sv[j] = __builtin_bit_cast(f32x4, __builtin_amdgcn_raw_buffer_load_b128(rsrcSS, (unsigned)((se * 128 + sq * 32) * 4) + 16u * (j0 + j), sso, 0));
                    dv[j] = __builtin_bit_cast(f32x4, __builtin_amdgcn_raw_buffer_load_b128(rsrcDS, (unsigned)(sq * 32 * 4) + 16u * (j0 + j), dso, 0)); }
#pragma unroll
                for (int j = 0; j < 8; ++j) { const int q = 4 * (j0 + j); S[q + 0] = dv[j].x * S[q + 0] + sv[j].x; S[q + 1] = dv[j].y * S[q + 1] + sv[j].y; S[q + 2] = dv[j].z * S[q + 2] + sv[j].z; S[q + 3] = dv[j].w * S[q + 3] + sv[j].w; } }
        }
        if (F.tid < 256) *((LAS f32x4*)(L + HG_DECS) + F.tid) = decv;
        __syncthreads();
      for (int k = 0; k < 8; ++k) {
        const int item = item0 + k, c = seg * 8 + k;
        const int tb = F.wave & 1, eb = F.wave >> 1;
        const int nit = k < 7 ? item + 1 : item;
        HG_PUT(rf, RAWF); HG_PUT(rq, RAWQ); HG_PUT(rv, RAWV);
        __syncthreads();
        HG_LOADT(rf, nit, 1); HG_LOADT(rq, nit, 0); HG_LOADT(rv, nit, 2); __builtin_amdgcn_sched_barrier(0);
        unsigned short ffr[16], qr[16], vr[16]; HG_COL(ffr, RAWF); HG_COL(qr, RAWQ); HG_COL(vr, RAWV);
        float bb[16], kk[16], total; hg_gates(F, ffr, lbv, d, tq, bb, kk, total);
        float vv[16];
#pragma unroll
        for (int i = 0; i < 16; ++i) { const int t = 16 * tq + i; const float q = bf2f(qr[i]);
            *(LAS unsigned short*)(L + HG_QE + t * 272 + 2 * d) = (unsigned short)pkbf(q * bb[i], 0.f);
            *(LAS unsigned short*)(L + HG_KE + t * 272 + 2 * d) = (unsigned short)pkbf(kk[i] * __builtin_amdgcn_rcpf(bb[i]), 0.f);
            vv[i] = bf2f(vr[i]); }
        st16<true>(L + HG_VT + d * 144 + tq * 32, vv);
#pragma unroll
        for (int j = 0; j < 4; ++j) { v4u w4; w4.x = pkbf(S[8 * j + 0], S[8 * j + 1]); w4.y = pkbf(S[8 * j + 2], S[8 * j + 3]); w4.z = pkbf(S[8 * j + 4], S[8 * j + 5]); w4.w = pkbf(S[8 * j + 6], S[8 * j + 7]);
            *(LAS v4u*)(L + HG_ST + se * 272 + sq * 64 + 16 * j) = w4; }
        HG_FOLD(st, k);
        unsigned long long grv[4];
        { const bf16* grow_ = PHp + (((size_t)(3 * 16 + b) * 4 + h) * SEQ + c * 64 + tb * 32 + r) * 128;
#pragma unroll
            for (int g = 0; g < 4; ++g) grv[g] = *(const GAS unsigned long long*)(grow_ + eb * 32 + 8 * g + 4 * hh); }
        HG_LOADST(nit); __builtin_amdgcn_sched_barrier(0);
        __syncthreads();
        f32x16 acc;
#pragma unroll
        for (int i = 0; i < 16; ++i) acc[i] = 0.f;
#define HG_QF(s_) (*(const LAS bf16x8*)(L + HG_QE + (tb * 32 + r) * 272 + 32 * (s_) + 16 * hh))
#pragma unroll
        for (int s = 0; s < 8; ++s) acc = MFMA32(*(const LAS bf16x8*)(L + HG_ST + (eb * 32 + r) * 272 + 32 * s + 16 * hh), HG_QF(s), acc);
        for (int sb = 0; sb <= tb; ++sb) {
            f32x16 at;
#pragma unroll
            for (int i = 0; i < 16; ++i) at[i] = 0.f;
#pragma unroll
            for (int s = 0; s < 8; ++s) at = MFMA32(*(const LAS bf16x8*)(L + HG_KE + (sb * 32 + r) * 272 + 32 * s + 16 * hh), HG_QF(s), at);
            float a[16];
#pragma unroll
            for (int i = 0; i < 16; ++i) a[i] = (sb < tb || crow16(i, hh) <= r) ? at[i] : 0.f;
            const bf16x8 ab0 = pack8(a[0], a[1], a[2], a[3], a[4], a[5], a[6], a[7]), ab1 = pack8(a[8], a[9], a[10], a[11], a[12], a[13], a[14], a[15]);
            acc = MFMA32(*(const LAS bf16x8*)(L + HG_VT + (eb * 32 + r) * 144 + sb * 64 + 0 + 16 * hh), ab0, acc);
            acc = MFMA32(*(const LAS bf16x8*)(L + HG_VT + (eb * 32 + r) * 144 + sb * 64 + 32 + 16 * hh), ab1, acc);
        }
        float ss = 0.f;
#pragma unroll
        for (int i = 0; i < 16; ++i) ss += acc[i] * acc[i];
        ss += __shfl_xor(ss, 32);
        LAS float* ssq = (LAS float*)(L + HG_SSQ);
        if (hh == 0) ssq[eb * 64 + tb * 32 + r] = ss;
        f32x4 ggv[4];
        { const unsigned so = (unsigned)__builtin_amdgcn_readfirstlane(h * 512);
#pragma unroll
            for (int g = 0; g < 4; ++g) ggv[g] = __builtin_bit_cast(f32x4, __builtin_amdgcn_raw_buffer_load_b128(rsrcG, (unsigned)((eb * 32 + 8 * g + 4 * hh) * 4), so, 0)); }
        __syncthreads();
        const int tl = tb * 32 + r; const float tot = (ssq[tl] + ssq[64 + tl]) + (ssq[128 + tl] + ssq[192 + tl]);
        const float rs = 1.f / sqrtf(tot * (1.f / 128.f) + EPS);
        const unsigned mso = (unsigned)__builtin_amdgcn_readfirstlane((int)((((unsigned)b * SEQ + c * 64) * D + 512 + h * 128) * 2)), mvo = (unsigned)((tl * D + eb * 32 + 4 * hh) * 2);
#pragma unroll
        for (int g = 0; g < 4; ++g) { const int e = eb * 32 + 8 * g + 4 * hh; const unsigned long long gr = grv[g]; const f32x4 gg = ggv[g];
            const float g0 = bflo((unsigned)gr), g1 = bfhi((unsigned)gr), g2 = bflo((unsigned)(gr >> 32)), g3 = bfhi((unsigned)(gr >> 32));
            const float y0 = acc[4 * g + 0] * rs * gg.x * (g0 * __builtin_amdgcn_rcpf(1.f + __expf(-g0))), y1 = acc[4 * g + 1] * rs * gg.y * (g1 * __builtin_amdgcn_rcpf(1.f + __expf(-g1)));
            const float y2 = acc[4 * g + 2] * rs * gg.z * (g2 * __builtin_amdgcn_rcpf(1.f + __expf(-g2))), y3 = acc[4 * g + 3] * rs * gg.w * (g3 * __builtin_amdgcn_rcpf(1.f + __expf(-g3)));
            typedef unsigned u32x2_t __attribute__((ext_vector_type(2))); __builtin_amdgcn_raw_buffer_store_b64((u32x2_t){pkbf(y0, y1), pkbf(y2, y3)}, rsrcM, mvo + 16u * g, mso, 0); }
        __syncthreads();
      }
    }
#undef HG_LOADST
#undef HG_LOADKV
#undef HG_FOLD
#undef HG_QF
}
#undef HG_LOADT
#undef HG_PUT
#undef HG_COL
#undef HG_ARR
#undef HG_SOFF
#undef HG_HV

__device__ __forceinline__ void router_phase(Frame& F) {
    LAS unsigned char* L = F.lds; const int r = F.lane & 31, hh = F.lane >> 5;
    LAS unsigned* lcnt = (LAS unsigned*)(F.lds + LTAB_OFF) + LT_MISC; LAS unsigned* lbase = lcnt + 32; LAS float* lrstd = (LAS float*)(F.lds + ROWTAB_OFF);
    float* TOPG = (float*)(F.ws + WS_TOPG);
    {
        const GAS v4u* img = (const GAS v4u*)(F.ws + WS_RT) + vzero();
        constexpr int NB = (RT_END / 16 + NWAVES * 64 - 1) / (NWAVES * 64);
        v4u t4[NB];
#pragma unroll
        for (int j = 0; j < NB; ++j) { const int q = F.tid + j * NWAVES * 64; t4[j] = img[q < RT_END / 16 ? q : 0]; }
#pragma unroll
        for (int j = 0; j < NB; ++j) { const int q = F.tid + j * NWAVES * 64; if (q < RT_END / 16) *(LAS v4u*)(L + 16 * q) = t4[j]; }
    }
    const bf16* XH = (const bf16*)(F.ws + WS_XN); int* LIST = (int*)(F.ws + WS_LIST); unsigned* cnt = (unsigned*)(F.ctl + CW_CNT);
    for (int base = blockIdx.x * 4; base < T / 32; base += F.G * 4) {
        const int grp = base + F.wave; const bool active = F.wave < 4 && grp < T / 32;
        if (F.tid < 32) lcnt[F.tid] = 0u;
        __syncthreads();
        float sv[4] = {0.f, 0.f, 0.f, 0.f}; int se[4] = {0, 0, 0, 0}; unsigned lp0 = 0u, lp1 = 0u; float rstd = 0.f; const int tok = grp * 32 + r;
        if (active) {
            const bf16* hrow = XH + (size_t)tok * D + 8 * hh;
            f32x16 acc;
#pragma unroll
            for (int i = 0; i < 16; ++i) acc[i] = 0.f;
            float ssq = 0.f;
#pragma unroll 16
            for (int s = 0; s < 64; ++s) {
                const v4u hu = *(const GAS v4u*)(hrow + 16 * s); const bf16x8 hi = __builtin_bit_cast(bf16x8, hu);
                { const float a0 = bflo(hu.x), a1 = bfhi(hu.x), a2 = bflo(hu.y), a3 = bfhi(hu.y), a4 = bflo(hu.z), a5 = bfhi(hu.z), a6 = bflo(hu.w), a7 = bfhi(hu.w);
                    ssq += (a0 * a0 + a1 * a1) + (a2 * a2 + a3 * a3) + (a4 * a4 + a5 * a5) + (a6 * a6 + a7 * a7); }
                const bf16x8 wh = *(const LAS bf16x8*)(L + r * RT_ROW + 32 * s + 16 * hh), wl = *(const LAS bf16x8*)(L + RT_WL + r * RT_ROW + 32 * s + 16 * hh);
                acc = MFMA32(wh, hi, acc); acc = MFMA32(wl, hi, acc);
            }
            ssq += __shfl_xor(ssq, 32);
            rstd = 1.f / sqrtf(ssq * (1.f / D) + EPS);
            float l[16];
#pragma unroll
            for (int i = 0; i < 16; ++i) l[i] = acc[i] * rstd + F.b_router[crow16(i, hh)];
            float cv[8]; int ce[8];
#pragma unroll
            for (int rnd = 0; rnd < 4; ++rnd) { float bv = l[0]; int bi = 0;
#pragma unroll
                for (int i = 1; i < 16; ++i) if (l[i] > bv) { bv = l[i]; bi = i; }
                cv[rnd] = bv; ce[rnd] = crow16(bi, hh);
#pragma unroll
                for (int i = 0; i < 16; ++i) if (i == bi) l[i] = -__builtin_inff(); }
#pragma unroll
            for (int j = 0; j < 4; ++j) { cv[4 + j] = __shfl_xor(cv[j], 32); ce[4 + j] = __shfl_xor(ce[j], 32); }
#pragma unroll
            for (int rnd = 0; rnd < 4; ++rnd) { float bv = cv[0]; int be = ce[0]; int bj = 0;
#pragma unroll
                for (int j = 1; j < 8; ++j) if (cv[j] > bv || (cv[j] == bv && ce[j] < be)) { bv = cv[j]; be = ce[j]; bj = j; }
                sv[rnd] = bv; se[rnd] = be;
#pragma unroll
                for (int j = 0; j < 8; ++j) if (j == bj) { cv[j] = -__builtin_inff(); ce[j] = 64; } }
            lp0 = __hip_atomic_fetch_add(lcnt + (hh ? se[2] : se[0]), 1u, __ATOMIC_RELAXED, __HIP_MEMORY_SCOPE_WORKGROUP);
            lp1 = __hip_atomic_fetch_add(lcnt + (hh ? se[3] : se[1]), 1u, __ATOMIC_RELAXED, __HIP_MEMORY_SCOPE_WORKGROUP);
        }
        __syncthreads();
        if (F.tid < 32) lbase[F.tid] = __hip_atomic_fetch_add(cnt + F.tid, lcnt[F.tid], __ATOMIC_RELAXED, __HIP_MEMORY_SCOPE_AGENT);
        __syncthreads();
        if (active) {
            const float e1 = __expf(sv[1] - sv[0]), e2 = __expf(sv[2] - sv[0]), e3 = __expf(sv[3] - sv[0]); const float inv = 1.f / (1.f + e1 + e2 + e3);
            const int ea = hh ? se[2] : se[0], eb = hh ? se[3] : se[1]; const float ga = (hh ? e2 : 1.f) * inv, gb = (hh ? e3 : e1) * inv;
            const size_t ia = (size_t)ea * 32768 + lbase[ea] + lp0, ib = (size_t)eb * 32768 + lbase[eb] + lp1;
            LIST[ia] = tok * 4 + 2 * hh; LIST[ib] = tok * 4 + 2 * hh + 1; TOPG[tok * 4 + 2 * hh] = ga; TOPG[tok * 4 + 2 * hh + 1] = gb;
            if (hh == 0) lrstd[F.wave * 32 + r] = rstd;
        }
        __syncthreads();
        {
            unsigned char* X8 = F.ws + WS_X8; const int t0 = base * 32;
#pragma unroll
            for (int q0 = 0; q0 < 16; q0 += 4) { v4u a[4][2];
#pragma unroll
                for (int q = 0; q < 4; ++q) { const int tt = t0 + F.wave * 16 + q0 + q; const GAS v4u* p = (const GAS v4u*)(XH + (size_t)(tt < T ? tt : 0) * D) + 2 * F.lane; a[q][0] = p[0]; a[q][1] = p[1]; }
#pragma unroll
                for (int q = 0; q < 4; ++q) { const int tl = F.wave * 16 + q0 + q, tt = t0 + tl; if (tt < T) { const float rs = lrstd[tl]; v4u o;
                    o.x = pg8::pk4_fp8(bflo(a[q][0].x) * rs, bfhi(a[q][0].x) * rs, bflo(a[q][0].y) * rs, bfhi(a[q][0].y) * rs); o.y = pg8::pk4_fp8(bflo(a[q][0].z) * rs, bfhi(a[q][0].z) * rs, bflo(a[q][0].w) * rs, bfhi(a[q][0].w) * rs);
                    o.z = pg8::pk4_fp8(bflo(a[q][1].x) * rs, bfhi(a[q][1].x) * rs, bflo(a[q][1].y) * rs, bfhi(a[q][1].y) * rs); o.w = pg8::pk4_fp8(bflo(a[q][1].z) * rs, bfhi(a[q][1].z) * rs, bflo(a[q][1].w) * rs, bfhi(a[q][1].w) * rs);
                    *((GAS v4u*)(X8 + (size_t)tt * D) + F.lane) = o; } } }
        }
        __syncthreads();
    }
}
__device__ __forceinline__ int build_moe_tables(Frame& F, int ntn, int mode) {
    LAS int* lt = (LAS int*)(F.lds + LTAB_OFF);
    if (F.wave == 0) {
        const int e = F.lane & 31; const int c = (int)__hip_atomic_load((unsigned*)(F.ctl + CW_CNT) + e, __ATOMIC_RELAXED, __HIP_MEMORY_SCOPE_AGENT);
        const int tl = (c + 255) >> 8; int inc = tl;
#pragma unroll
        for (int off = 1; off < 32; off <<= 1) { const int o = __shfl_up(inc, off, 32); if (e >= off) inc += o; }
        const int tot = __shfl(inc, 31, 32), t0 = inc - tl;
        if (F.lane < 32) { lt[LT_TS + e] = t0; lt[LT_CNT + e] = c; for (int i = 0; i < tl; ++i) lt[t0 + i] = e; }
        if (F.lane == 0) lt[LT_MISC + 64] = tot;
    }
    __syncthreads();
    int nt = lt[LT_MISC + 64]; nt = nt < 0 ? 0 : (nt > MAXTILES ? MAXTILES : nt); nt = __builtin_amdgcn_readfirstlane(nt);
    const int* LIST = (const int*)(F.ws + WS_LIST);
    const int nslot = mode == 1 ? MAXSLOT : (MAXTILES * 4 + 255) / 256;
    for (int q = F.tid; q < nslot * 256; q += NWAVES * 64) { const int i = q >> 8, rr = q & 255; const int Lu = i * F.G + F.vcu;
        int li = -1; float bias = 0.f;
        if (Lu < nt * ntn) { const int pm0 = Lu / ntn, pl = Lu - pm0 * ntn, pm = mode == 2 ? nt - 1 - pm0 : pm0, e = lt[pm], idx = (pm - lt[LT_TS + e]) * 256 + rr; if (idx < lt[LT_CNT + e]) li = LIST[(size_t)e * 32768 + idx];
            bias = mode == 1 ? F.b_gu[(size_t)e * 2048 + (rr >> 7) * 1024 + pl * 128 + (rr & 127)] : F.b_d[(size_t)e * 1024 + pl * 256 + rr]; }
        ((LAS float*)(F.lds + ROWTAB_OFF))[q] = bias;
        if (mode == 1) ((LAS unsigned short*)(F.lds + ROWTAB2_OFF))[q] = (unsigned short)(li < 0 ? 0 : (li >> 2));
        else ((LAS int*)(F.lds + ROWTAB_OFF) + nslot * 256)[q] = li; }
    __syncthreads();
    return nt;
}
__device__ __forceinline__ void combine_phase(Frame& F) {
    const unsigned char* YK = F.ws + WS_YK; const bf16* XH = (const bf16*)(F.ws + WS_XN); const float* TOPG = (const float*)(F.ws + WS_TOPG);
    for (int t = F.gw; t < T; t += F.ngw) {
        GAS f32x4* xr = (GAS f32x4*)(F.out + (size_t)t * D) + F.lane; f32x4 v[4]; unsigned y[4][4]; const f32x4 gt = *((const GAS f32x4*)TOPG + t + vzero()) * (1.0f / Y8_SCALE);
#pragma unroll
        for (int j = 0; j < 4; ++j) { const unsigned long long xh = __builtin_nontemporal_load((const GAS unsigned long long*)(XH + (size_t)t * D) + F.lane + 64 * j);
            v[j] = (f32x4){bflo((unsigned)xh), bfhi((unsigned)xh), bflo((unsigned)(xh >> 32)), bfhi((unsigned)(xh >> 32))};
#pragma unroll
            for (int k = 0; k < 4; ++k) y[j][k] = __builtin_nontemporal_load((const GAS unsigned*)(YK + ((size_t)t * 4 + k) * D) + F.lane + 64 * j); }
#pragma unroll
        for (int j = 0; j < 4; ++j) { f32x4 s4 = {0.f, 0.f, 0.f, 0.f};
#pragma unroll
            for (int k = 0; k < 4; ++k) { const f32x2n_ lo = __builtin_amdgcn_cvt_pk_f32_fp8((int)y[j][k], false), hi = __builtin_amdgcn_cvt_pk_f32_fp8((int)y[j][k], true); const float g = gt[k]; s4.x += g * lo.x; s4.y += g * lo.y; s4.z += g * hi.x; s4.w += g * hi.y; }
            v[j] = v[j] + s4;
            __builtin_nontemporal_store(v[j], xr + 64 * j); }
    }
}

constexpr int NPH = 9;
struct Args { const float* in[16]; float* out; unsigned char* ws; int ph_lo, ph_hi; };
__global__ void __launch_bounds__(NWAVES * 64, 2) fwd(Args args) {
    extern __shared__ __attribute__((aligned(16))) unsigned char lds[];
    Frame F;
    F.lds = (LAS unsigned char*)lds;
    F.MISC = (volatile LAS unsigned*)(F.lds + MISC_OFF);
    F.tid = threadIdx.x; F.lane = F.tid & 63; F.wave = __builtin_amdgcn_readfirstlane(F.tid >> 6);
    F.G = gridDim.x; { const int bx = blockIdx.x; F.vcu = (F.G % 8 == 0) ? (bx % 8) * (F.G / 8) + bx / 8 : bx; }
    F.gw = blockIdx.x * NWAVES + F.wave; F.ngw = F.G * NWAVES;
    F.ws = args.ws; F.ctl = (gu32*)(args.ws + WS_CTL); F.out = args.out;
    F.x = args.in[0]; F.norm1_g = args.in[1]; F.w_in = args.in[2]; F.sb_q_g = args.in[3]; F.sb_k_g = args.in[4]; F.sb_out_g = args.in[5]; F.hg_lb = args.in[6]; F.hg_out_g = args.in[7];
    F.w_out = args.in[8]; F.norm2_g = args.in[9]; F.w_router = args.in[10]; F.b_router = args.in[11]; F.w_gu = args.in[12]; F.b_gu = args.in[13]; F.w_d = args.in[14]; F.b_d = args.in[15];
    for (int u = F.tid; u < (LDS_BYTES - LDSCTL_OFF) / 4; u += NWAVES * 64) ((LAS unsigned*)(F.lds + LDSCTL_OFF))[u] = 0u;
    __syncthreads();
    XcdBarrier bar; bar.bar = (unsigned*)(F.ctl + CW_BAR); bar.x = 0; bar.st = nullptr;
    if (MK_ONE_LAUNCH) bar = xcd_barrier_post((unsigned*)(F.ctl + CW_BAR), F.MISC + 8);
    const int lo = args.ph_lo, hi = args.ph_hi;
#define IN(k) (lo <= (k) && (k) < hi && ((F.lane = lane_id()), (F.tid = F.wave * 64 + F.lane), true))
#define SEAM(k) do { if (IN(k) && IN((k) + 1)) xcd_barrier(bar); } while (0)

    if (IN(0)) { p0_prologue(F); } SEAM(0);
    if (IN(1)) {
        pg8::Gemm g{(const bf16*)(F.ws + WS_XN), (const bf16*)(F.ws + WS_WIN), T, NIN, D}; pg8::StaticOrder S; S.init(T, NIN, F.G, (int)blockIdx.x);
        pg8::EpiInproj E{(bf16*)(F.ws + WS_P), (bf16*)(F.ws + WS_PH), (bf16*)(F.ws + WS_QN), (bf16*)(F.ws + WS_KN), F.sb_q_g, F.sb_k_g, QSCALE, EPS};
        pg8::gemm_phase<pg8::EpiInproj, pg8::StaticOrder, PG8_ALIGN, PG8_SP2>(F.lds + RING_OFF, g, S, E, F.tid);
    } SEAM(1);
    if (IN(2)) { prep_phase(F); __syncthreads(); hgA_phase(F); } SEAM(2);
    if (IN(3)) { attn_phase(F); hgC_phase(F); } SEAM(3);
    if (IN(4)) {
        pg8::Gemm g{(const bf16*)(F.ws + WS_MIX), (const bf16*)(F.ws + WS_WOUT), T, D, D}; pg8::StaticOrder S; S.init(T, D, F.G, (int)blockIdx.x);
        pg8::EpiRes E{F.x, (bf16*)(F.ws + WS_XN), D};
        pg8::gemm_phase<pg8::EpiRes, pg8::StaticOrder, PG8_ALIGN, PG8_SP2>(F.lds + RING_OFF, g, S, E, F.tid);
    } SEAM(4);
    if (IN(5)) { router_phase(F); } SEAM(5);
    if (IN(6)) {
        const int nt = build_moe_tables(F, 8, 1); const LAS int* lt = (const LAS int*)(F.lds + LTAB_OFF);
        pg8::Gemm g{(const bf16*)(F.ws + WS_X8), (const bf16*)(F.ws + WS_WGU), MAXROWS, NE * 2048, D / 2};
        pg8::MoeOrder S{lt, (const LAS unsigned short*)(F.lds + ROWTAB2_OFF), 8, nt * 8, F.G, F.vcu, 1024u, 0};
        pg8::EpiAct<true> E{F.ws + WS_ACT, (const LAS float*)(F.lds + ROWTAB_OFF), A8_SCALE};
        pg8::gemm_phase<pg8::EpiAct<true>, pg8::MoeOrder, PG8_ALIGN, PG8_SP2, true, SC_W8, SC_ONE>(F.lds + RING_OFF, g, S, E, F.tid);
        {
            const int rem = (nt * 8) % F.G, nidle = F.G - rem; const bool few = rem == 0 || nidle < F.G / 4;
            __syncthreads();
            if (few) p0_items(F, P0_NITEMS - P0_NLATE, P0_NITEMS, F.vcu * NWAVES + F.wave, F.G * NWAVES);
            else if (F.vcu >= rem) p0_items(F, P0_NITEMS - P0_NLATE, P0_NITEMS, (F.vcu - rem) * NWAVES + F.wave, nidle * NWAVES);
        }
    } SEAM(6);
    if (IN(7)) {
        const int nt = build_moe_tables(F, 4, 2); const LAS int* lt = (const LAS int*)(F.lds + LTAB_OFF);
        pg8::Gemm g{(const bf16*)(F.ws + WS_ACT), (const bf16*)(F.ws + WS_WD), MAXROWS, NE * 1024, D / 2};
        pg8::MoeOrder S{lt, nullptr, 4, nt * 4, F.G, F.vcu, 1024u, nt};
        pg8::EpiDown E{F.ws + WS_YK, (const LAS int*)(F.lds + ROWTAB_OFF) + ((MAXTILES * 4 + 255) / 256) * 256, (const LAS float*)(F.lds + ROWTAB_OFF), Y8_SCALE};
        pg8::gemm_phase<pg8::EpiDown, pg8::MoeOrder, PG8_ALIGN, PG8_SP2, true, SC_W8Y, SC_A8>(F.lds + RING_OFF, g, S, E, F.tid);
    } SEAM(7);
    if (IN(8)) { combine_phase(F); }
#undef IN
#undef SEAM
}

extern "C" void kernel_launch(void* const* d_in, const int* in_sizes, int n_in, void* d_out, int out_size, void* d_ws, size_t ws_size, hipStream_t stream) {
    static int grid = 0;
    if (grid == 0) {
        if (n_in != 16 || in_sizes[0] != T * D || out_size != T * D || ws_size < WS_END) { fprintf(stderr, "kernel_launch: shape/workspace mismatch (n_in %d, ws %zu, need %zu); nothing launched\n", n_in, ws_size, (size_t)WS_END); grid = -1; return; }
        int dev = 0, cus = 0, per_cu = 0;
        if (hipGetDevice(&dev) != hipSuccess || hipDeviceGetAttribute(&cus, hipDeviceAttributeMultiprocessorCount, dev) != hipSuccess) { grid = -1; return; }
        if (hipFuncSetAttribute((const void*)fwd, hipFuncAttributeMaxDynamicSharedMemorySize, LDS_BYTES) != hipSuccess) { grid = -1; return; }
        if (hipOccupancyMaxActiveBlocksPerMultiprocessor(&per_cu, (const void*)fwd, NWAVES * 64, LDS_BYTES) != hipSuccess || per_cu < 1) { fprintf(stderr, "kernel_launch: occupancy query says %d\n", per_cu); }
        (void)hipGetLastError();
        if ((MAXTILES * 8 + cus - 1) / cus > MAXSLOT || cus < 1) { fprintf(stderr, "kernel_launch: %d CUs: the per-workgroup unit tables are sized for 256\n", cus); grid = -1; return; }
        grid = cus;
    }
    if (grid < 0) return;
    if (hipMemsetAsync((char*)d_ws + WS_CTL, 0, CTL_ZERO_BYTES, stream) != hipSuccess) return;
    Args a{};
    for (int i = 0; i < 16; ++i) a.in[i] = (const float*)d_in[i];
    a.out = (float*)d_out; a.ws = (unsigned char*)d_ws;
#if MK_ONE_LAUNCH
    a.ph_lo = 0; a.ph_hi = NPH;
    hipLaunchKernelGGL(fwd, dim3(grid), dim3(NWAVES * 64), LDS_BYTES, stream, a);
#else
    for (int p = 0; p < NPH; ++p) { a.ph_lo = p; a.ph_hi = p + 1; hipLaunchKernelGGL(fwd, dim3(grid), dim3(NWAVES * 64), LDS_BYTES, stream, a); }
#endif
}
```

```cpp
#include <hip/hip_runtime.h>
#include <cstdio>
#include <cstdint>
namespace pg8 {
#define PG8_LAS __attribute__((address_space(3)))
typedef unsigned short bf16_t;
typedef short bf16x8 __attribute__((ext_vector_type(8)));
typedef float f32x4 __attribute__((ext_vector_type(4)));
typedef unsigned u32x4 __attribute__((ext_vector_type(4)));
typedef int i32x4_t __attribute__((ext_vector_type(4)));
typedef int i32x8_t __attribute__((ext_vector_type(8)));
constexpr int BM = 256, BK = 64, HALF = 128, HTB = HALF * BK * 2  , STAGE_BYTES = 8 * HTB, NXCD = 8, WGM = 8;

__host__ __device__ __forceinline__ int lds_byte(int r, int c) { const int st = (r >> 4) * 2 + (c >> 5), rr = r & 15, cc = c & 31, ob = rr * 64 + cc * 2; return st * 1024 + (ob ^ (((ob >> 9) & 1) << 5)); }
__host__ __device__ __forceinline__ void stage_rc(int b, int& R, int& C) { const int st = b / 1024, sb = b % 1024, swz = sb ^ (((sb >> 9) & 1) << 5); R = (st >> 1) * 16 + swz / 64; C = (st & 1) * 32 + (swz % 64) / 2; }
__host__ __device__ __forceinline__ int perm32(int rho) { const int n = rho >> 4, i = rho & 15; return 8 * (i >> 2) + 4 * n + (i & 3); }

struct Unit { int pm, pn, slot; };
struct Gemm { const bf16_t* A; const bf16_t* Bt; int M, N, K; };

struct StaticOrder {
    int nM, nN, nwg, G, c;
    __host__ __device__ void init(int M, int N, int G_, int c_) { nM = M / BM; nN = N / BM; nwg = nM * nN; G = G_; c = c_; }
    __host__ __device__ bool next(int i, Unit& u) const {
        const long L = (long)i * G + c; if (L >= nwg) return false;
        int wgid = (int)L; { const int q = nwg / NXCD, r = nwg % NXCD, xcd = wgid % NXCD, off = wgid / NXCD; wgid = (xcd < r ? xcd * (q + 1) : r * (q + 1) + (xcd - r) * q) + off; }
        const int nig = WGM * nN, gid = wgid / nig, fm = gid * WGM, gsz = (nM - fm) < WGM ? (nM - fm) : WGM;
        u.pm = fm + ((wgid % nig) % gsz); u.pn = (wgid % nig) / gsz; return true;
    }
    __device__ __forceinline__ void a_ready(const Unit&) const {}
    __device__ __forceinline__ void done(const Unit&) const {}
};

__device__ __forceinline__ unsigned cvt_pk_bf16(float lo, float hi) { unsigned r; asm volatile("v_cvt_pk_bf16_f32 %0, %1, %2" : "=v"(r) : "v"(lo), "v"(hi)); return r; }
typedef float f32x2 __attribute__((ext_vector_type(2)));
__device__ __forceinline__ f32x2 gelu_pk(f32x2 v) {
    const f32x2 av = __builtin_elementwise_abs(v), d = av * 0.2316418882f + 1.0f;
    f32x2 t; t.x = __builtin_amdgcn_rcpf(d.x); t.y = __builtin_amdgcn_rcpf(d.y);
    f32x2 q = t * 0.5307027145f + (-0.7265760135f); q = q * t + 0.7107068705f; q = q * t + (-0.142248368f); q = q * t + 0.127414796f; q = q * t;
    const f32x2 s = (v * v) * (-0.72134752044f);
    f32x2 e; e.x = __builtin_amdgcn_exp2f(s.x); e.y = __builtin_amdgcn_exp2f(s.y);
    const f32x2 m = v * (q * e), r = v - m;
    f32x2 o; o.x = v.x < 0.f ? m.x : r.x; o.y = v.y < 0.f ? m.y : r.y; return o;
}

template <int ACT  > struct EpiBf16 {
    static constexpr bool PERM = true, AFTER_DRAIN = false, HAS_INIT = false, INIT_LOADS = false; static_assert(ACT == 0 || ACT == 1, "EpiBf16: ACT is 0 (none) or 1 (gelu_pk)");
    bf16_t* O; int ldc; const float* bias; int split_cols; size_t split_stride; float scale0;
    __device__ __forceinline__ void operator()(const f32x4 (&acc)[2][2][4][2], const Unit& u, int wr, int wc, int fr, int fq) const {
        const int row0 = u.pm * BM + wr * 64 + fr; int colt = u.pn * BM; bf16_t* base = O;
        float sc = 1.f; if (split_cols) { const int t = colt / split_cols; base += (size_t)t * split_stride; colt -= t * split_cols; if (t == 0) sc = scale0; }
        const int col0 = colt + wc * 32 + 8 * fq, bcol0 = u.pn * BM + wc * 32 + 8 * fq;
        f32x4 bv[2][2];
#pragma unroll
        for (int bj = 0; bj < 2; ++bj)
#pragma unroll
            for (int n = 0; n < 2; ++n) bv[bj][n] = bias ? *(const f32x4*)(bias + bcol0 + bj * HALF + 4 * n) : (f32x4){0.f, 0.f, 0.f, 0.f};
#pragma unroll
        for (int ai = 0; ai < 2; ++ai)
#pragma unroll
            for (int m = 0; m < 4; ++m) { bf16_t* rowp = base + (size_t)(row0 + ai * HALF + m * 16) * ldc + col0;
#pragma unroll
                for (int bj = 0; bj < 2; ++bj) { f32x4 v0 = acc[ai][bj][m][0] + bv[bj][0], v1 = acc[ai][bj][m][1] + bv[bj][1];
                    if (ACT == 1) { f32x2 a = gelu_pk((f32x2){v0[0], v0[1]}), b = gelu_pk((f32x2){v0[2], v0[3]}), c = gelu_pk((f32x2){v1[0], v1[1]}), d = gelu_pk((f32x2){v1[2], v1[3]});
                        v0 = (f32x4){a.x, a.y, b.x, b.y}; v1 = (f32x4){c.x, c.y, d.x, d.y}; }
                    v0 = v0 * sc; v1 = v1 * sc; u32x4 w; w.x = cvt_pk_bf16(v0[0], v0[1]); w.y = cvt_pk_bf16(v0[2], v0[3]); w.z = cvt_pk_bf16(v1[0], v1[1]); w.w = cvt_pk_bf16(v1[2], v1[3]);
                    *(u32x4*)(rowp + bj * HALF) = w; } }
    }
};

__device__ __forceinline__ unsigned pk4_fp8(float a, float b, float c, float d) {
    a = fminf(fmaxf(a, -448.f), 448.f); b = fminf(fmaxf(b, -448.f), 448.f); c = fminf(fmaxf(c, -448.f), 448.f); d = fminf(fmaxf(d, -448.f), 448.f);
    int p = 0; p = __builtin_amdgcn_cvt_pk_fp8_f32(a, b, p, false); p = __builtin_amdgcn_cvt_pk_fp8_f32(c, d, p, true); return (unsigned)p;
}
struct EpiRes {
    static constexpr bool PERM = true, AFTER_DRAIN = false, HAS_INIT = true, INIT_LOADS = true;
    const float* __restrict__ X; bf16_t* __restrict__ XH; int ldc;
    __device__ __forceinline__ void init(f32x4 (&acc)[2][2][4][2], const Unit& u, int wr, int wc, int fr, int fq) const {
        const int row0 = u.pm * BM + wr * 64 + fr, col0 = u.pn * BM + wc * 32 + 8 * fq;
#pragma unroll
        for (int ai = 0; ai < 2; ++ai)
#pragma unroll
            for (int m = 0; m < 4; ++m) { const float* rp = X + (size_t)(row0 + ai * HALF + m * 16) * ldc + col0;
#pragma unroll
                for (int bj = 0; bj < 2; ++bj)
#pragma unroll
                    for (int n = 0; n < 2; ++n) acc[ai][bj][m][n] = __builtin_nontemporal_load((const f32x4*)(rp + bj * HALF + n * 4)); }
    }
    __device__ __forceinline__ void operator()(const f32x4 (&acc)[2][2][4][2], const Unit& u, int wr, int wc, int fr, int fq) const {
        const int row0 = u.pm * BM + wr * 64 + fr, col0 = u.pn * BM + wc * 32 + 8 * fq;
#pragma unroll
        for (int ai = 0; ai < 2; ++ai)
#pragma unroll
            for (int m = 0; m < 4; ++m) { bf16_t* rp = XH + (size_t)(row0 + ai * HALF + m * 16) * ldc + col0;
#pragma unroll
                for (int bj = 0; bj < 2; ++bj) { const f32x4 v0 = acc[ai][bj][m][0], v1 = acc[ai][bj][m][1];
                    u32x4 w; w.x = cvt_pk_bf16(v0[0], v0[1]); w.y = cvt_pk_bf16(v0[2], v0[3]); w.z = cvt_pk_bf16(v1[0], v1[1]); w.w = cvt_pk_bf16(v1[2], v1[3]);
                    *(u32x4*)(rp + bj * HALF) = w; } }
    }
};
struct EpiInproj {
    static constexpr bool PERM = true, AFTER_DRAIN = false, HAS_INIT = false, INIT_LOADS = false;
    bf16_t* PA; bf16_t* PH; bf16_t* QN; bf16_t* KN; const float* gq; const float* gk; float qscale, eps;
    __device__ __forceinline__ void operator()(const f32x4 (&acc)[2][2][4][2], const Unit& u, int wr, int wc, int fr, int fq) const {
        if (u.pn < 4) {
            const int arr = u.pn >> 1, hd = (u.pn & 1) * 4 + wc; const float* g = arr ? gk : gq; const float gs = arr ? 1.f : qscale; bf16_t* dst = arr ? KN : QN;
            f32x4 gv[2][2];
#pragma unroll
            for (int bj = 0; bj < 2; ++bj)
#pragma unroll
                for (int n = 0; n < 2; ++n) gv[bj][n] = *(const f32x4*)(g + 32 * bj + 8 * fq + 4 * n) * gs;
#pragma unroll
            for (int ai = 0; ai < 2; ++ai)
#pragma unroll
                for (int m = 0; m < 4; ++m) { float ss = 0.f;
#pragma unroll
                    for (int bj = 0; bj < 2; ++bj)
#pragma unroll
                        for (int n = 0; n < 2; ++n) { const f32x4 a = acc[ai][bj][m][n]; ss += (a[0] * a[0] + a[1] * a[1]) + (a[2] * a[2] + a[3] * a[3]); }
                    ss += __shfl_xor(ss, 16); ss += __shfl_xor(ss, 32);
                    const float rs = 1.f / sqrtf(ss * (1.f / 64.f) + eps);
                    const int row = u.pm * BM + ai * HALF + wr * 64 + m * 16 + fr, b = row >> 11, s = row & 2047;
                    bf16_t* rp = dst + ((size_t)((b * 8 + hd) * 64 + (s >> 5))) * 2048 + (s & 31) * 8;
#pragma unroll
                    for (int bj = 0; bj < 2; ++bj) { const int c8 = 4 * bj + fq; const f32x4 v0 = acc[ai][bj][m][0] * rs * gv[bj][0], v1 = acc[ai][bj][m][1] * rs * gv[bj][1];
                        u32x4 w; w.x = cvt_pk_bf16(v0[0], v0[1]); w.y = cvt_pk_bf16(v0[2], v0[3]); w.z = cvt_pk_bf16(v1[0], v1[1]); w.w = cvt_pk_bf16(v1[2], v1[3]);
                        *(u32x4*)(rp + (c8 >> 1) * 512 + (c8 & 1) * 256) = w; } }
            return;
        }
#pragma unroll
        for (int bj = 0; bj < 2; ++bj) { const int col = u.pn * BM + bj * HALF + wc * 32 + 8 * fq;
            bf16_t* base; int rowlen;
            if (col < 1536) { const int arr = col >> 9, hd = (col & 511) >> 6, dd = col & 63; base = PA + ((size_t)(arr * 16) * 8 + hd) * 2048 * 64 + dd; rowlen = 64; }
            else { const int c2 = col - 1536, arr = c2 >> 9, hd = (c2 & 511) >> 7, dd = c2 & 127; base = PH + ((size_t)(arr * 16) * 4 + hd) * 2048 * 128 + dd; rowlen = 128; }
            const size_t bstride = (size_t)(rowlen == 64 ? 8 : 4) * 2048 * rowlen;
#pragma unroll
            for (int ai = 0; ai < 2; ++ai)
#pragma unroll
                for (int m = 0; m < 4; ++m) { const int row = u.pm * BM + ai * HALF + wr * 64 + m * 16 + fr, b = row >> 11, s = row & 2047;
                    const f32x4 v0 = acc[ai][bj][m][0], v1 = acc[ai][bj][m][1];
                    u32x4 w; w.x = cvt_pk_bf16(v0[0], v0[1]); w.y = cvt_pk_bf16(v0[2], v0[3]); w.z = cvt_pk_bf16(v1[0], v1[1]); w.w = cvt_pk_bf16(v1[2], v1[3]);
                    *(u32x4*)(base + (size_t)b * bstride + (size_t)s * rowlen) = w; } }
    }
};
struct MoeOrder {
    const PG8_LAS int* tile_e; const PG8_LAS unsigned short* rowtab; int ntn, nunits, G, c; unsigned rowbytes; int rev;
    __device__ __forceinline__ bool next(int i, Unit& u) const {
        const int L = i * G + c; if (L >= nunits) return false;
        const int pm0 = L / ntn, pl = L - pm0 * ntn, pm = rev ? rev - 1 - pm0 : pm0; u.pm = pm; u.pn = tile_e[pm] * ntn + pl; u.slot = i; return true;
    }
    __device__ __forceinline__ unsigned rowoff(const Unit& u, int r) const { return (rowtab ? (unsigned)rowtab[u.slot * 256 + r] : (unsigned)(u.pm * 256 + r)) * rowbytes; }
    __device__ __forceinline__ void a_ready(const Unit&) const {}
    __device__ __forceinline__ void done(const Unit&) const {}
};
template <bool OUT8> struct EpiAct {
    static constexpr bool PERM = true, AFTER_DRAIN = false, HAS_INIT = true, INIT_LOADS = false;
    unsigned char* ACT; const PG8_LAS float* biastab; float oscale;
    __device__ __forceinline__ void init(f32x4 (&acc)[2][2][4][2], const Unit& u, int wr, int wc, int fr, int fq) const {
#pragma unroll
        for (int n = 0; n < 2; ++n) { const f32x4 bg = *(const PG8_LAS f32x4*)(biastab + u.slot * 256 + wc * 32 + 8 * fq + 4 * n), bu = *(const PG8_LAS f32x4*)(biastab + u.slot * 256 + 128 + wc * 32 + 8 * fq + 4 * n);
#pragma unroll
            for (int ai = 0; ai < 2; ++ai)
#pragma unroll
                for (int m = 0; m < 4; ++m) { acc[ai][0][m][n] = bg; acc[ai][1][m][n] = bu; } }
    }
    __device__ __forceinline__ void operator()(const f32x4 (&acc)[2][2][4][2], const Unit& u, int wr, int wc, int fr, int fq) const {
        const int pl = u.pn & 7; const int row0 = u.pm * BM + wr * 64 + fr, acol0 = pl * 128 + wc * 32 + 8 * fq;
#pragma unroll
        for (int ai = 0; ai < 2; ++ai)
#pragma unroll
            for (int m = 0; m < 4; ++m) { unsigned char* rowp = ACT + (size_t)(row0 + ai * HALF + m * 16) * 1024 + acol0; f32x4 a4[2];
#pragma unroll
                for (int n = 0; n < 2; ++n) { const f32x4 g4 = acc[ai][0][m][n], u4 = acc[ai][1][m][n]; f32x4 gl, ul, ex;
#pragma unroll
                    for (int j = 0; j < 4; ++j) { gl[j] = fminf(g4[j], 7.0f); ul[j] = __builtin_amdgcn_fmed3f(u4[j], -7.0f, 7.0f); }
                    const f32x4 t4 = gl * (-1.702f * 1.44269504089f);
#pragma unroll
                    for (int j = 0; j < 4; ++j) ex[j] = __builtin_amdgcn_exp2f(t4[j]);
                    const f32x4 d4 = ex + 1.0f; f32x4 s4;
#pragma unroll
                    for (int j = 0; j < 4; ++j) s4[j] = __builtin_amdgcn_rcpf(d4[j]);
                    a4[n] = (gl * s4) * (ul * oscale + oscale); }
                if constexpr (OUT8) { int p0 = 0, p1 = 0; p0 = __builtin_amdgcn_cvt_pk_fp8_f32(a4[0][0], a4[0][1], p0, false); p0 = __builtin_amdgcn_cvt_pk_fp8_f32(a4[0][2], a4[0][3], p0, true);
                    p1 = __builtin_amdgcn_cvt_pk_fp8_f32(a4[1][0], a4[1][1], p1, false); p1 = __builtin_amdgcn_cvt_pk_fp8_f32(a4[1][2], a4[1][3], p1, true);
                    *(unsigned long long*)rowp = (unsigned long long)(unsigned)p0 | ((unsigned long long)(unsigned)p1 << 32); }
                else { u32x4 w; w.x = cvt_pk_bf16(a4[0][0], a4[0][1]); w.y = cvt_pk_bf16(a4[0][2], a4[0][3]); w.z = cvt_pk_bf16(a4[1][0], a4[1][1]); w.w = cvt_pk_bf16(a4[1][2], a4[1][3]); *(u32x4*)(rowp + (size_t)(row0 + ai * HALF + m * 16) * 1024 + acol0) = w; } }
    }
};
struct EpiDown {
    static constexpr bool PERM = true, AFTER_DRAIN = false, HAS_INIT = true, INIT_LOADS = false;
    unsigned char* YK; const PG8_LAS int* tktab; const PG8_LAS float* biastab; float oscale;
    __device__ __forceinline__ void init(f32x4 (&acc)[2][2][4][2], const Unit& u, int wr, int wc, int fr, int fq) const {
#pragma unroll
        for (int bj = 0; bj < 2; ++bj)
#pragma unroll
            for (int n = 0; n < 2; ++n) { const f32x4 bv = *(const PG8_LAS f32x4*)(biastab + u.slot * 256 + 64 * wc + 16 * fq + 8 * bj + 4 * n) * oscale;
#pragma unroll
                for (int ai = 0; ai < 2; ++ai)
#pragma unroll
                    for (int m = 0; m < 4; ++m) acc[ai][bj][m][n] = bv; }
    }
    __device__ __forceinline__ void operator()(const f32x4 (&acc)[2][2][4][2], const Unit& u, int wr, int wc, int fr, int fq) const {
        const int pl = u.pn & 3; const int col0 = pl * BM + 64 * wc + 16 * fq;
#pragma unroll
        for (int ai = 0; ai < 2; ++ai)
#pragma unroll
            for (int m = 0; m < 4; ++m) { const int tk = tktab[u.slot * 256 + ai * HALF + wr * 64 + m * 16 + fr];
                if (tk >= 0) { unsigned char* rowp = YK + (size_t)tk * 1024 + col0; int p[4];
#pragma unroll
                    for (int bj = 0; bj < 2; ++bj) { f32x4 v0 = acc[ai][bj][m][0], v1 = acc[ai][bj][m][1];
#pragma unroll
                        for (int j = 0; j < 4; ++j) { v0[j] = __builtin_amdgcn_fmed3f(v0[j], -448.f, 448.f); v1[j] = __builtin_amdgcn_fmed3f(v1[j], -448.f, 448.f); }
                        int p0 = 0, p1 = 0; p0 = __builtin_amdgcn_cvt_pk_fp8_f32(v0[0], v0[1], p0, false); p0 = __builtin_amdgcn_cvt_pk_fp8_f32(v0[2], v0[3], p0, true);
                        p1 = __builtin_amdgcn_cvt_pk_fp8_f32(v1[0], v1[1], p1, false); p1 = __builtin_amdgcn_cvt_pk_fp8_f32(v1[2], v1[3], p1, true);
                        p[2 * bj] = p0; p[2 * bj + 1] = p1; }
                    u32x4 w; w.x = (unsigned)p[0]; w.y = (unsigned)p[1]; w.z = (unsigned)p[2]; w.w = (unsigned)p[3];
                    *(u32x4*)rowp = w; } }
    }
};

template <class Epi, class Sched, bool ALIGN_EPI = false, bool SP2 = false, bool GATHER = false, int SCW = 0, int SCX = 0>
__device__ __forceinline__ void gemm_phase(PG8_LAS unsigned char* lds, const Gemm g, const Sched& S, const Epi& E, const int tid) {
    const int wid = __builtin_amdgcn_readfirstlane(tid >> 6), lane = tid & 63, wr = wid >> 2, wc = wid & 3, fr = lane & 15, fq = lane >> 4;
    const int K = g.K, nt = K / BK;
    unsigned voffA[2], voffB[2]; int RA[2]; unsigned CA2[2]; unsigned va0[2] = {0u, 0u}, va1[2] = {0u, 0u};
#pragma unroll
    for (int i = 0; i < 2; ++i) { int R, C; stage_rc(tid * 16 + i * 8192, R, C); const int Rb = Epi::PERM ? ((R & ~31) + perm32(R & 31)) : R;
        voffA[i] = (unsigned)(R * K + C) * 2u; voffB[i] = (unsigned)(Rb * K + C) * 2u; RA[i] = R; CA2[i] = (unsigned)C * 2u; }
    static_assert(!GATHER || SP2, "the gathered-A form exists for the SP2 loop only");
    const char* const gA0 = (const char*)g.A;
#define PG8_VA(u) do { int l_; asm volatile("v_mbcnt_lo_u32_b32 %0, -1, 0\n\tv_mbcnt_hi_u32_b32 %0, -1, %0" : "=v"(l_)); const int t_ = wid * 64 + l_;     \
        _Pragma("unroll") for (int _i = 0; _i < 2; ++_i) { int R_, C_; stage_rc(t_ * 16 + _i * 8192, R_, C_); va0[_i] = S.rowoff((u), R_) + (unsigned)C_ * 2u; va1[_i] = S.rowoff((u), HALF + R_) + (unsigned)C_ * 2u; } } while (0)
#define PG8_STA(bufoff, base_ng, base_g, h) do { if constexpr (GATHER) { if (h) PG8_STAGE(bufoff, base_g, va1); else PG8_STAGE(bufoff, base_g, va0); } else PG8_STAGE(bufoff, base_ng, voffA); } while (0)
    const size_t kstep = (size_t)(BK * 2);
    const size_t hstep = (size_t)HALF * K * 2;
    const size_t tstep = 2 * hstep;
    const unsigned ldsw = (unsigned)wid * 1024u;
    const int aoff = lds_byte(wr * 64 + fr, fq * 8), boff = lds_byte(wc * 32 + fr, fq * 8);
#define PG8_SA(b, h) (((b) * 2 + (h)) * HTB)
#define PG8_SB(b, h) ((4 + (b) * 2 + (h)) * HTB)
#define PG8_STAGE(bufoff, gbase, voff) do { _Pragma("unroll") for (int _i = 0; _i < 2; ++_i) \
        __builtin_amdgcn_global_load_lds((const unsigned*)((const char*)(gbase) + (voff)[_i]), (PG8_LAS unsigned*)(lds + (bufoff) + ldsw + _i * 8192), 16, 0, 0); } while (0)
#define PG8_LDA(dst, b, h) do { if constexpr (SCW != 0) { _Pragma("unroll") for (int m = 0; m < 4; ++m) dst##8[m] = PG8_CAT8(*(const PG8_LAS bf16x8*)(lds + PG8_SA(b, h) + aoff + m * 2048), *(const PG8_LAS bf16x8*)(lds + PG8_SA(b, h) + aoff + m * 2048 + 1024)); } \
        else { _Pragma("unroll") for (int m = 0; m < 4; ++m) _Pragma("unroll") for (int k = 0; k < 2; ++k) dst[m][k] = *(const PG8_LAS bf16x8*)(lds + PG8_SA(b, h) + aoff + m * 2048 + k * 1024); } } while (0)
#define PG8_LDB(dst, b, h) do { if constexpr (SCW != 0) { _Pragma("unroll") for (int n = 0; n < 2; ++n) dst##8[n] = PG8_CAT8(*(const PG8_LAS bf16x8*)(lds + PG8_SB(b, h) + boff + n * 2048), *(const PG8_LAS bf16x8*)(lds + PG8_SB(b, h) + boff + n * 2048 + 1024)); } \
        else { _Pragma("unroll") for (int n = 0; n < 2; ++n) _Pragma("unroll") for (int k = 0; k < 2; ++k) dst[n][k] = *(const PG8_LAS bf16x8*)(lds + PG8_SB(b, h) + boff + n * 2048 + k * 1024); } } while (0)
#define PG8_CAT8(lo, hi) __builtin_shufflevector(__builtin_bit_cast(i32x4_t, (lo)), __builtin_bit_cast(i32x4_t, (hi)), 0, 1, 2, 3, 4, 5, 6, 7)
#define PG8_MMA(ai, bj, At, Bt) do { __builtin_amdgcn_s_setprio(1); _Pragma("unroll") for (int m = 0; m < 4; ++m) _Pragma("unroll") for (int n = 0; n < 2; ++n) { \
        if constexpr (SCW != 0) acc[ai][bj][m][n] = __builtin_amdgcn_mfma_scale_f32_16x16x128_f8f6f4(Bt##8[n], At##8[m], acc[ai][bj][m][n], 0, 0, 0, SCW, 0, SCX); \
        else { _Pragma("unroll") for (int k = 0; k < 2; ++k) acc[ai][bj][m][n] = __builtin_amdgcn_mfma_f32_16x16x32_bf16(Bt[n][k], At[m][k], acc[ai][bj][m][n], 0, 0, 0); } } __builtin_amdgcn_s_setprio(0); } while (0)
#define PG8_WAIT_V(n) asm volatile("s_waitcnt vmcnt(" #n ")" ::: "memory")
#define PG8_WAIT_L(n) asm volatile("s_waitcnt lgkmcnt(" #n ")" ::: "memory")
#define PG8_BAR __builtin_amdgcn_s_barrier()
#define PG8_SCHED __builtin_amdgcn_sched_barrier(0)
    Unit cur, nxt; int ui = 0;
    if (!S.next(0, cur)) return;
    f32x4 acc[2][2][4][2];
    if constexpr (Epi::HAS_INIT) { E.init(acc, cur, wr, wc, fr, fq); if constexpr (Epi::INIT_LOADS) __builtin_amdgcn_s_waitcnt(0x0F70); }
    else {
#pragma unroll
    for (int a = 0; a < 2; ++a)
#pragma unroll
        for (int b = 0; b < 2; ++b)
#pragma unroll
            for (int m = 0; m < 4; ++m)
#pragma unroll
                for (int n = 0; n < 2; ++n) acc[a][b][m][n] = (f32x4){0.f, 0.f, 0.f, 0.f};
    }
    bf16x8 At[4][2], B0[2][2], B1[2][2]; i32x8_t At8[4], B08[2], B18[2];
    const char* cA = (const char*)g.A + (size_t)cur.pm * tstep; const char* cB = (const char*)g.Bt + (size_t)cur.pn * tstep;
    S.a_ready(cur);
    if constexpr (SP2) {
        if constexpr (GATHER) PG8_VA(cur);
        PG8_STAGE(PG8_SB(0, 0), cB, voffB); PG8_STAGE(PG8_SB(0, 1), cB + hstep, voffB); PG8_STA(PG8_SA(0, 0), cA, gA0, 0); PG8_STA(PG8_SA(0, 1), cA + hstep, gA0, 1);
        if (wr == 1) PG8_BAR;
        PG8_WAIT_V(2); PG8_BAR;
        PG8_STAGE(PG8_SB(1, 0), cB + kstep, voffB); PG8_STA(PG8_SA(1, 0), cA + kstep, gA0 + kstep, 0); PG8_STAGE(PG8_SB(1, 1), cB + hstep + kstep, voffB);
        PG8_WAIT_V(6); PG8_BAR;
    } else {
        PG8_STAGE(PG8_SB(0, 0), cB, voffB); PG8_STAGE(PG8_SA(0, 0), cA, voffA); PG8_STAGE(PG8_SB(0, 1), cB + hstep, voffB); PG8_STAGE(PG8_SA(0, 1), cA + hstep, voffA);
        if (wr == 1) PG8_BAR;
        PG8_WAIT_V(4); PG8_BAR;
        PG8_STAGE(PG8_SB(1, 0), cB + kstep, voffB); PG8_STAGE(PG8_SA(1, 0), cA + kstep, voffA); PG8_STAGE(PG8_SB(1, 1), cB + hstep + kstep, voffB);
        PG8_WAIT_V(6); PG8_BAR;
    }
    for (;;) {
        const bool has_next = S.next(ui + 1, nxt);
        const char* nA = has_next ? (const char*)g.A + (size_t)nxt.pm * tstep : cA; const char* nB = has_next ? (const char*)g.Bt + (size_t)nxt.pn * tstep : cB;
        _Pragma("nounroll") for (int t = 0; t < nt; t += 2) {
            const bool last = (t == nt - 2);
            const char* a1 = cA + (size_t)(t + 1) * kstep;
            const char* a2 = last ? nA : cA + (size_t)(t + 2) * kstep; const char* b2 = last ? nB : cB + (size_t)(t + 2) * kstep;
            const char* a3 = a2 + kstep; const char* b3 = b2 + kstep;
            if (last && has_next) S.a_ready(nxt);
            const char* const g1 = gA0 + (size_t)(t + 1) * kstep; const char* const g2 = last ? gA0 : gA0 + (size_t)(t + 2) * kstep; const char* const g3 = g2 + kstep;
            if constexpr (SP2) {
            PG8_LDB(B0, 0, 0); PG8_LDB(B1, 0, 1); PG8_SCHED; PG8_LDA(At, 0, 0); PG8_STA(PG8_SA(1, 1), a1 + hstep, g1, 1);
            PG8_WAIT_V(8); PG8_WAIT_L(0); PG8_BAR; PG8_MMA(0, 0, At, B0); PG8_MMA(0, 1, At, B1); PG8_BAR; PG8_SCHED;
            if constexpr (GATHER) { if (last && has_next) PG8_VA(nxt); }
            PG8_LDA(At, 0, 1); PG8_STAGE(PG8_SB(0, 0), b2, voffB); PG8_STAGE(PG8_SB(0, 1), b2 + hstep, voffB); PG8_STA(PG8_SA(0, 0), a2, g2, 0);
            PG8_WAIT_V(8); PG8_WAIT_L(0); PG8_BAR; PG8_MMA(1, 0, At, B0); PG8_MMA(1, 1, At, B1); PG8_BAR; PG8_SCHED;
            PG8_LDB(B0, 1, 0); PG8_LDB(B1, 1, 1); PG8_SCHED; PG8_LDA(At, 1, 0); PG8_STA(PG8_SA(0, 1), a2 + hstep, g2, 1);
            PG8_WAIT_V(8); PG8_WAIT_L(0); PG8_BAR; PG8_MMA(0, 0, At, B0); PG8_MMA(0, 1, At, B1); PG8_BAR; PG8_SCHED;
            PG8_LDA(At, 1, 1); PG8_STAGE(PG8_SB(1, 0), b3, voffB); PG8_STAGE(PG8_SB(1, 1), b3 + hstep, voffB); PG8_STA(PG8_SA(1, 0), a3, g3, 0);
            PG8_WAIT_V(8); PG8_WAIT_L(0); PG8_BAR; PG8_MMA(1, 0, At, B0); PG8_MMA(1, 1, At, B1); PG8_BAR; PG8_SCHED;
            } else {
            PG8_LDB(B0, 0, 0); PG8_SCHED; PG8_LDA(At, 0, 0); PG8_STAGE(PG8_SA(1, 1), a1 + hstep, voffA);
            PG8_WAIT_L(8); PG8_BAR; PG8_WAIT_L(0); PG8_MMA(0, 0, At, B0); PG8_BAR; PG8_SCHED;
            PG8_LDB(B1, 0, 1); PG8_STAGE(PG8_SB(0, 0), b2, voffB);
            PG8_BAR; PG8_WAIT_L(0); PG8_MMA(0, 1, At, B1); PG8_BAR;
            PG8_LDA(At, 0, 1); PG8_STAGE(PG8_SA(0, 0), a2, voffA);
            PG8_BAR; PG8_WAIT_L(0); PG8_MMA(1, 0, At, B0); PG8_BAR; PG8_SCHED;
            PG8_STAGE(PG8_SB(0, 1), b2 + hstep, voffB);
            PG8_WAIT_V(6); PG8_BAR; PG8_MMA(1, 1, At, B1); PG8_BAR;
            PG8_LDB(B0, 1, 0); PG8_SCHED; PG8_LDA(At, 1, 0); PG8_STAGE(PG8_SA(0, 1), a2 + hstep, voffA);
            PG8_WAIT_L(8); PG8_BAR; PG8_WAIT_L(0); PG8_MMA(0, 0, At, B0); PG8_BAR; PG8_SCHED;
            PG8_LDB(B1, 1, 1); PG8_STAGE(PG8_SB(1, 0), b3, voffB);
            PG8_BAR; PG8_WAIT_L(0); PG8_MMA(0, 1, At, B1); PG8_BAR;
            PG8_LDA(At, 1, 1); PG8_STAGE(PG8_SA(1, 0), a3, voffA);
            PG8_BAR; PG8_WAIT_L(0); PG8_MMA(1, 0, At, B0); PG8_BAR; PG8_SCHED;
            PG8_STAGE(PG8_SB(1, 1), b3 + hstep, voffB);
            PG8_WAIT_V(6); PG8_BAR; PG8_MMA(1, 1, At, B1); PG8_BAR;
            }
        }
        if constexpr (ALIGN_EPI) { if (wr == 0) PG8_BAR; }
        if constexpr (!Epi::AFTER_DRAIN) { int fr_ = fr, fq_ = fq; asm volatile("" : "+v"(fr_), "+v"(fq_));
            E(acc, cur, wr, wc, fr_, fq_); S.done(cur); }
        if (!has_next) break;
        if constexpr (Epi::HAS_INIT) { int fr_ = fr, fq_ = fq; asm volatile("" : "+v"(fr_), "+v"(fq_)); E.init(acc, nxt, wr, wc, fr_, fq_); if constexpr (Epi::INIT_LOADS) __builtin_amdgcn_s_waitcnt(0x0F70); }
        else {
#pragma unroll
        for (int a = 0; a < 2; ++a)
#pragma unroll
            for (int b = 0; b < 2; ++b)
#pragma unroll
                for (int m = 0; m < 4; ++m)
#pragma unroll
                    for (int n = 0; n < 2; ++n) acc[a][b][m][n] = (f32x4){0.f, 0.f, 0.f, 0.f};
        }
        cur = nxt; cA = nA; cB = nB; ++ui;
        if constexpr (ALIGN_EPI) { if (wr == 1) PG8_BAR; }
    }
    PG8_WAIT_V(0);
    if constexpr (!ALIGN_EPI) { if (wr == 0) PG8_BAR; }
    PG8_BAR;
    if constexpr (Epi::AFTER_DRAIN) { E.fused(acc, cur, wr, wc, fr, fq, lds, wid, lane); S.done(cur); }
#undef PG8_SA
#undef PG8_CAT8
#undef PG8_VA
#undef PG8_STA
#undef PG8_SB
#undef PG8_STAGE
#undef PG8_LDA
#undef PG8_LDB
#undef PG8_MMA
#undef PG8_WAIT_V
#undef PG8_WAIT_L
#undef PG8_BAR
#undef PG8_SCHED
}
}

#ifndef PG8_SP2
#define PG8_SP2 true
#endif
#ifndef PG8_ALIGN
#define PG8_ALIGN true
#endif
#define GAS __attribute__((address_space(1)))
#define LAS __attribute__((address_space(3)))
typedef unsigned short bf16;
typedef unsigned v4u __attribute__((ext_vector_type(4)));
typedef float f32x4 __attribute__((ext_vector_type(4)));
typedef short bf16x8 __attribute__((ext_vector_type(8)));
typedef GAS unsigned gu32;
typedef GAS unsigned long long gu64;
#define RLX_AGENT __ATOMIC_RELAXED, __HIP_MEMORY_SCOPE_AGENT
#define LDS_WAIT() asm volatile("s_waitcnt lgkmcnt(0)" ::: "memory")
#define VM_WAIT() asm volatile("s_waitcnt vmcnt(0)" ::: "memory")
__device__ __forceinline__ unsigned long long rt() { return __builtin_amdgcn_s_memrealtime(); }
__device__ __forceinline__ unsigned f2bf(float f) { unsigned u = __builtin_bit_cast(unsigned, f); return (u + 0x7fffu + ((u >> 16) & 1u)) >> 16; }
__device__ __forceinline__ unsigned pk2(float lo, float hi) { return f2bf(lo) | (f2bf(hi) << 16); }

#define XB_TMO      128
#define XB_XCNT(j)  (256  + 64 * (j))
#define XB_XSUB(j)  (1280 + 64 * (j))
#define XB_XGEN(j)  (2304 + 64 * (j))
#define XB_TOP      3328
#define XB_TOPGEN   3392
#define XCD_BAR_WORDS 3456
#define XB_SPIN_CAP (1u << 18)

__device__ __forceinline__ unsigned xb_ld(unsigned* p)              { return __hip_atomic_load(p, __ATOMIC_RELAXED, __HIP_MEMORY_SCOPE_AGENT); }
__device__ __forceinline__ unsigned xb_add(unsigned* p, unsigned v) { return __hip_atomic_fetch_add(p, v, __ATOMIC_RELAXED, __HIP_MEMORY_SCOPE_AGENT); }
__device__ __forceinline__ unsigned xb_xcc_id() { return (unsigned)__builtin_amdgcn_s_getreg((3 << 11) | 20) & 0xFu; }
#define XB_SPIN(cond, bar) do { unsigned _sp = 0; while (cond) { __builtin_amdgcn_s_sleep(1); \
    if ((++_sp & 255u) == 0u) { if (xb_ld(&(bar)[XB_TMO])) break; if (_sp > XB_SPIN_CAP) { atomicAdd(&(bar)[XB_TMO], 1u); break; } } } } while (0)

struct XcdBarrier {
    unsigned* bar; unsigned x;
    volatile LAS unsigned* st;
};

__device__ __forceinline__ XcdBarrier xcd_barrier_post(unsigned* bar, volatile LAS unsigned* st) {
    XcdBarrier b; b.bar = bar; b.x = xb_xcc_id(); b.st = st;
    if (threadIdx.x == 0) (void)xb_add(&bar[XB_XCNT(b.x)], 1u);
    return b;
}
__device__ __forceinline__ void xcd_barrier_complete(unsigned* bar, unsigned x, unsigned& nloc, unsigned& nx) {
    const unsigned G = gridDim.x * gridDim.y * gridDim.z;
    unsigned sum, cnt, mine, sp = 0u;
    for (;;) {
        sum = 0u; cnt = 0u; mine = 0u;
#pragma unroll
        for (unsigned j = 0; j < 16; ++j) { const unsigned c = xb_ld(&bar[XB_XCNT(j)]); sum += c; cnt += (c > 0u) ? 1u : 0u; mine = (j == x) ? c : mine; }
        if (sum == G) break;
        __builtin_amdgcn_s_sleep(1);
        if ((++sp & 255u) == 0u) { if (xb_ld(&bar[XB_TMO])) break; if (sp > XB_SPIN_CAP) { atomicAdd(&bar[XB_TMO], 1u); break; } }
    }
    nloc = mine > 0u ? mine : 1u; nx = cnt > 0u ? cnt : 1u;
}

__device__ __forceinline__ void xcd_barrier(const XcdBarrier& b) {
    asm volatile("s_waitcnt vmcnt(0)" ::: "memory");
    __syncthreads();
    if (threadIdx.x == 0) {
        unsigned* bar = b.bar;
        __builtin_amdgcn_s_waitcnt(0);
        unsigned nloc = b.st[0], nx = b.st[1];
        if (nloc == 0u) { xcd_barrier_complete(bar, b.x, nloc, nx); b.st[0] = nloc; b.st[1] = nx; }
        const unsigned old = xb_add(&bar[XB_XSUB(b.x)], 1u);
        const unsigned gen = old / nloc;
        if (old + 1u == (gen + 1u) * nloc) {
            __builtin_amdgcn_fence(__ATOMIC_RELEASE, "agent");
            asm volatile("s_waitcnt vmcnt(0)" ::: "memory");
            const unsigned og = xb_add(&bar[XB_TOP], 1u);
            const unsigned tg = og / nx;
            if (og + 1u == (tg + 1u) * nx) xb_add(&bar[XB_TOPGEN], 1u);
            else XB_SPIN(xb_ld(&bar[XB_TOPGEN]) == tg, bar);
            __builtin_amdgcn_fence(__ATOMIC_ACQUIRE, "agent");
            xb_add(&bar[XB_XGEN(b.x)], 1u);
            asm volatile("s_waitcnt vmcnt(0)" ::: "memory");
        } else {
            XB_SPIN(xb_ld(&bar[XB_XGEN(b.x)]) == gen, bar);
            __builtin_amdgcn_fence(__ATOMIC_ACQUIRE, "agent");
            asm volatile("s_waitcnt vmcnt(0)" ::: "memory");
        }
    }
    __syncthreads();
}

constexpr int NWAVES = 8;
#ifndef MK_ONE_LAUNCH
#define MK_ONE_LAUNCH 1
#endif

constexpr int BATCH = 16, SEQ = 2048, D = 1024, T = BATCH * SEQ;
constexpr int NIN = 3584;
constexpr int OFF_SQ = 0, OFF_SK = 512, OFF_SV = 1024, OFF_HQ = 1536, OFF_HF = 2048, OFF_HI = 2560, OFF_HG = 3072;
constexpr int NE = 32, TOPK = 4, NASSIGN = T * TOPK;
constexpr int MAXTILES = NASSIGN / 256 + NE;
constexpr int MAXROWS = MAXTILES * 256;
constexpr float EPS = 1e-6f;

constexpr size_t MiB = 1u << 20;
constexpr size_t WS_CTL = 0, CTL_ZERO_BYTES = 1 * MiB;
constexpr size_t WS_WIN = 2 * MiB;
constexpr size_t WS_WOUT = 10 * MiB;
constexpr size_t WS_RT = 12 * MiB;
constexpr size_t WS_WGU = 16 * MiB;
constexpr size_t WS_WD = 144 * MiB;
constexpr size_t WS_XN = 208 * MiB;
constexpr size_t WS_P = 272 * MiB;
constexpr size_t WS_PH = WS_P + 96 * MiB;
constexpr size_t WS_MIX = 496 * MiB;
constexpr size_t WS_ACT = 272 * MiB;
constexpr size_t WS_YK = 560 * MiB;
constexpr size_t WS_QN = 624 * MiB;
constexpr size_t WS_KN = 656 * MiB;
constexpr size_t WS_VT = 688 * MiB;
constexpr size_t WS_KVS = 720 * MiB;
constexpr size_t WS_DEC = 784 * MiB;
constexpr size_t WS_SSEG = 786 * MiB;
constexpr size_t WS_DSEG = 802 * MiB;
constexpr size_t WS_LIST = 816 * MiB;
constexpr size_t WS_TOPG = 825 * MiB;
constexpr size_t WS_X8 = 560 * MiB;
constexpr size_t WS_END = 832 * MiB;
static_assert(WS_ACT + (size_t)MAXROWS * 2048 <= WS_YK && WS_YK + (size_t)T * 4 * 2048 <= WS_LIST && WS_MIX + (size_t)T * 2048 <= WS_YK, "d_ws map");
constexpr int CW_TMO = 0, CW_CODE = 1;
constexpr int CW_CNT = 64;
constexpr int CW_BAR = 4096;

constexpr int RING_OFF = 0, RING_BYTES = 131072;
constexpr int RT_ROW = 2064, RT_WL = 32 * RT_ROW, RT_END = 64 * RT_ROW;
constexpr int LDSCTL_OFF = 133120, MISC_OFF = LDSCTL_OFF + 320;
constexpr int LTAB_OFF = LDSCTL_OFF + 512;
constexpr int LT_TS = MAXTILES, LT_CNT = MAXTILES + 32, LT_MISC = MAXTILES + 64, LT_WORDS = MAXTILES + 192;
constexpr int ROWTAB_OFF = LTAB_OFF + LT_WORDS * 4;
constexpr int MAXSLOT = 17;
constexpr int ROWTAB2_OFF = ROWTAB_OFF + MAXSLOT * 1024;
constexpr int LDS_BYTES = ROWTAB2_OFF + MAXSLOT * 512;
static_assert(RT_END <= LDSCTL_OFF && MISC_OFF + 128 <= LTAB_OFF && LDS_BYTES <= 160 * 1024 && (MAXTILES * 8 + 255) / 256 <= MAXSLOT && 2 * ((MAXTILES * 4 + 255) / 256) * 1024 <= MAXSLOT * 1536 && ROWTAB_OFF % 16 == 0, "LDS map");

struct Frame {
    LAS unsigned char* lds;
    volatile LAS unsigned* MISC;
    gu32* ctl;
    int tid, lane, wave, gw, ngw;
    int vcu, G;
    const float *x, *norm1_g, *w_in, *sb_q_g, *sb_k_g, *sb_out_g, *hg_lb, *hg_out_g, *w_out, *norm2_g, *w_router, *b_router, *w_gu, *b_gu, *w_d, *b_d;
    float* out;
    unsigned char* ws;
};
__device__ __forceinline__ float bf2f(unsigned short b) { return __builtin_bit_cast(float, (unsigned)b << 16); }
__device__ __forceinline__ float bflo(unsigned w) { return __builtin_bit_cast(float, w << 16); }
__device__ __forceinline__ float bfhi(unsigned w) { return __builtin_bit_cast(float, w & 0xffff0000u); }
typedef __bf16 bf16x2n_ __attribute__((ext_vector_type(2)));
typedef float f32x2n_ __attribute__((ext_vector_type(2)));
__device__ __forceinline__ unsigned pkbf(float a, float b) { const bf16x2n_ v = __builtin_convertvector((f32x2n_){a, b}, bf16x2n_); return __builtin_bit_cast(unsigned, v); }
__device__ __forceinline__ int lane_id() { int l; asm volatile("v_mbcnt_lo_u32_b32 %0, -1, 0\n\tv_mbcnt_hi_u32_b32 %0, -1, %0" : "=v"(l)); return l; }
__device__ __forceinline__ int vzero() { int z; asm volatile("v_mov_b32 %0, 0" : "=v"(z)); return z; }
__device__ __forceinline__ float wave_sum(float v) {
#pragma unroll
    for (int o = 1; o < 64; o <<= 1) v += __shfl_xor(v, o);
    return v;
}

constexpr float W8_SCALE = 256.f, A8_SCALE = 4.f, Y8_SCALE = 32.f; static_assert(Y8_SCALE == 32.f, "SC_W8Y below is 2^-8 * 32");
constexpr int SC_ONE = 0x7f7f7f7f, SC_W8 = 0x77777777, SC_A8 = 0x7d7d7d7d, SC_W8Y = 0x7c7c7c7c;
struct P0Item { const float* W; bf16* WT; const float* rowscale; int N, k0, n0, drow0, fp8, perm; };
__device__ __forceinline__ void p0_load(const P0Item& it, f32x4 (&v)[16], int lane) {
    const int kr = lane >> 4, nc = 4 * (lane & 15);
#pragma unroll
    for (int i = 0; i < 16; ++i) v[i] = __builtin_nontemporal_load((const f32x4*)(it.W + (size_t)(it.k0 + 4 * i + kr) * it.N + it.n0 + nc));
}
__device__ __forceinline__ void p0_store(const P0Item& it, const f32x4 (&v)[16], LAS unsigned char* scr, int lane) {
    const int kr = lane >> 4, nc = 4 * (lane & 15);
#pragma unroll
    for (int i = 0; i < 16; ++i) { const float sc = it.rowscale ? it.rowscale[it.k0 + 4 * i + kr] : 1.f;
        *(LAS unsigned long long*)(scr + (4 * i + kr) * 136 + 2 * nc) = (unsigned long long)pkbf(v[i].x * sc, v[i].y * sc) | ((unsigned long long)pkbf(v[i].z * sc, v[i].w * sc) << 32); }
    LDS_WAIT(); asm volatile("" ::: "memory");
    const LAS unsigned short* s16 = (const LAS unsigned short*)scr;
    if (it.fp8) { const int p = lane & 3, nr = lane >> 2;
#pragma unroll
        for (int c = 0; c < 4; ++c) { const int n = 16 * c + nr; unsigned val[16];
#pragma unroll
            for (int kk = 0; kk < 16; ++kk) val[kk] = s16[(16 * p + kk) * 68 + n];
            v4u w4;
            w4.x = pg8::pk4_fp8(bflo(val[0]) * W8_SCALE, bflo(val[1]) * W8_SCALE, bflo(val[2]) * W8_SCALE, bflo(val[3]) * W8_SCALE);
            w4.y = pg8::pk4_fp8(bflo(val[4]) * W8_SCALE, bflo(val[5]) * W8_SCALE, bflo(val[6]) * W8_SCALE, bflo(val[7]) * W8_SCALE);
            w4.z = pg8::pk4_fp8(bflo(val[8]) * W8_SCALE, bflo(val[9]) * W8_SCALE, bflo(val[10]) * W8_SCALE, bflo(val[11]) * W8_SCALE);
            w4.w = pg8::pk4_fp8(bflo(val[12]) * W8_SCALE, bflo(val[13]) * W8_SCALE, bflo(val[14]) * W8_SCALE, bflo(val[15]) * W8_SCALE);
            *(GAS v4u*)((unsigned char*)it.WT + (size_t)(it.drow0 + (it.perm == 2 ? 128 * ((n >> 3) & 1) + 8 * (n >> 4) + (n & 7) : n)) * D + it.k0 + 16 * p) = w4; }
    } else { const int p = lane & 7, nr = lane >> 3;
#pragma unroll
        for (int c = 0; c < 8; ++c) { const int n = 8 * c + nr; unsigned val[8];
#pragma unroll
            for (int kk = 0; kk < 8; ++kk) val[kk] = s16[(8 * p + kk) * 68 + n];
            v4u w4; w4.x = val[0] | (val[1] << 16); w4.y = val[2] | (val[3] << 16); w4.z = val[4] | (val[5] << 16); w4.w = val[6] | (val[7] << 16);
            *(GAS v4u*)(it.WT + (size_t)(it.drow0 + (it.perm ? 128 * (n >> 5) + (n & 31) : n)) * D + it.k0 + 8 * p) = w4; } }
    LDS_WAIT(); asm volatile("" ::: "memory");
}
__device__ __forceinline__ void rms_rows2_to_bf16(const float* xa, const float* xb, bool hasb, const float* g, bf16* oa, bf16* ob, int lane) {
    const GAS f32x4* pa = (const GAS f32x4*)xa + lane; const GAS f32x4* pb = (const GAS f32x4*)(hasb ? xb : xa) + lane; const f32x4* gr = (const f32x4*)g + lane;
    f32x4 va[4], vb[4], gg[4]; float sa = 0.f, sb = 0.f;
#pragma unroll
    for (int j = 0; j < 4; ++j) { va[j] = __builtin_nontemporal_load(pa + 64 * j); vb[j] = __builtin_nontemporal_load(pb + 64 * j); gg[j] = gr[64 * j]; }
#pragma unroll
    for (int j = 0; j < 4; ++j) { sa += (va[j].x * va[j].x + va[j].y * va[j].y) + (va[j].z * va[j].z + va[j].w * va[j].w); sb += (vb[j].x * vb[j].x + vb[j].y * vb[j].y) + (vb[j].z * vb[j].z + vb[j].w * vb[j].w); }
    const float ra = 1.f / sqrtf(wave_sum(sa) * (1.f / D) + EPS), rb = 1.f / sqrtf(wave_sum(sb) * (1.f / D) + EPS);
    GAS unsigned long long* o8a = (GAS unsigned long long*)oa + lane; GAS unsigned long long* o8b = (GAS unsigned long long*)ob + lane;
#pragma unroll
    for (int j = 0; j < 4; ++j) o8a[64 * j] = (unsigned long long)pkbf(va[j].x * ra * gg[j].x, va[j].y * ra * gg[j].y) | ((unsigned long long)pkbf(va[j].z * ra * gg[j].z, va[j].w * ra * gg[j].w) << 32);
    if (hasb) {
#pragma unroll
        for (int j = 0; j < 4; ++j) o8b[64 * j] = (unsigned long long)pkbf(vb[j].x * rb * gg[j].x, vb[j].y * rb * gg[j].y) | ((unsigned long long)pkbf(vb[j].z * rb * gg[j].z, vb[j].w * rb * gg[j].w) << 32); }
}
__device__ __forceinline__ P0Item p0_item(Frame& F, int r) {
    constexpr int I_IN = 16 * (NIN / 64), I_OUT = 16 * 16, I_GU = NE * 16 * 32;
    P0Item it;
    if (r < I_IN) { const int nb = NIN / 64, kb = r / nb, nn = r % nb; const int pq = nn < 16; it = P0Item{F.w_in, (bf16*)(F.ws + WS_WIN), nullptr, NIN, 64 * kb, 64 * nn, pq ? 256 * (nn >> 2) + 32 * (nn & 3) : 64 * nn, 0, pq}; return it; } r -= I_IN;
    if (r < I_OUT) { const int kb = r / 16, nn = r % 16; it = P0Item{F.w_out, (bf16*)(F.ws + WS_WOUT), nullptr, D, 64 * kb, 64 * nn, 64 * nn, 0, 0}; return it; } r -= I_OUT;
    if (r < I_GU) { const int e = r / 512, q = r % 512, kb = q / 32, nn = q % 32;
        const int isup = nn >> 4, a = (nn & 15) * 64;
        it = P0Item{F.w_gu + (size_t)e * D * 2048, (bf16*)(F.ws + WS_WGU + (size_t)e * 2048 * D), F.norm2_g, 2048, 64 * kb, 64 * nn, 256 * (a >> 7) + 128 * isup + (a & 127), 1, 0}; return it; } r -= I_GU;
    { const int e = r / 256, q = r % 256, kb = q / 16, nn = q % 16;
        it = P0Item{F.w_d + (size_t)e * D * D, (bf16*)(F.ws + WS_WD + (size_t)e * D * D), nullptr, D, 64 * kb, 64 * nn, 256 * (nn >> 2) + 32 * (nn & 3), 1, 2}; return it; }
}
constexpr int P0_NITEMS = 16 * (NIN / 64) + 16 * 16 + NE * 16 * 32 + NE * 16 * 16;
constexpr int P0_NLATE = 1024;
__device__ __forceinline__ void p0_items(Frame& F, int lo, int hi, int w, int nw) {
    LAS unsigned char* scr = F.lds + RING_OFF + F.wave * 16384;
    f32x4 va[16], vb[16]; int it = lo + w;
    if (it < hi) { P0Item A = p0_item(F, it); p0_load(A, va, F.lane);
        for (;;) {
            const int itb = it + nw; const bool hb = itb < hi; const P0Item B = p0_item(F, hb ? itb : it); p0_load(B, vb, F.lane); __builtin_amdgcn_sched_barrier(0);
            p0_store(A, va, scr, F.lane);
            if (!hb) break;
            it = itb + nw; const bool ha = it < hi; A = p0_item(F, ha ? it : itb); p0_load(A, va, F.lane); __builtin_amdgcn_sched_barrier(0);
            p0_store(B, vb, scr, F.lane);
            if (!ha) break;
        }
    }
}
__device__ __forceinline__ void p0_prologue(Frame& F) {
    p0_items(F, 0, P0_NITEMS - P0_NLATE, F.gw, F.ngw);
    for (int q = blockIdx.x * (NWAVES * 64) + F.tid; q < 4096; q += F.G * NWAVES * 64) {
        const int e = q & 31, k0 = (q >> 5) * 8; unsigned hi[8], lo[8];
#pragma unroll
        for (int j = 0; j < 8; ++j) { const float w = F.w_router[(k0 + j) * 32 + e] * F.norm2_g[k0 + j]; hi[j] = pkbf(w, 0.f) & 0xffffu; lo[j] = pkbf(w - bflo(hi[j]), 0.f) & 0xffffu; }
        const v4u h4 = {hi[0] | (hi[1] << 16), hi[2] | (hi[3] << 16), hi[4] | (hi[5] << 16), hi[6] | (hi[7] << 16)}, l4 = {lo[0] | (lo[1] << 16), lo[2] | (lo[3] << 16), lo[4] | (lo[5] << 16), lo[6] | (lo[7] << 16)};
        *(GAS v4u*)(F.ws + WS_RT + e * RT_ROW + 2 * k0) = h4; *(GAS v4u*)(F.ws + WS_RT + RT_WL + e * RT_ROW + 2 * k0) = l4; }
    for (int m = F.gw; m < T; m += 2 * F.ngw) rms_rows2_to_bf16(F.x + (size_t)m * D, F.x + (size_t)(m + F.ngw) * D, m + F.ngw < T, F.norm1_g, (bf16*)(F.ws + WS_XN) + (size_t)m * D, (bf16*)(F.ws + WS_XN) + (size_t)(m + F.ngw) * D, F.lane);
}

typedef float f32x16 __attribute__((ext_vector_type(16)));
typedef __bf16 bf16x2n __attribute__((ext_vector_type(2)));
typedef float f32x2n __attribute__((ext_vector_type(2)));
#define MFMA32(a, b, c) __builtin_amdgcn_mfma_f32_32x32x16_bf16((a), (b), (c), 0, 0, 0)
__device__ __forceinline__ bf16x8 pack8(float a0, float a1, float a2, float a3, float a4, float a5, float a6, float a7) { const v4u p = {pkbf(a0, a1), pkbf(a2, a3), pkbf(a4, a5), pkbf(a6, a7)}; return __builtin_bit_cast(bf16x8, p); }
constexpr float QSCALE = 0.125f * 1.44269504089f;
__device__ __forceinline__ void prep_phase(Frame& F) {
    LAS unsigned* tl = (LAS unsigned*)(F.lds + RING_OFF + F.wave * 16384);
    const bf16* P = (const bf16*)(F.ws + WS_P); bf16* Qn = (bf16*)(F.ws + WS_QN); bf16* Kn = (bf16*)(F.ws + WS_KN); bf16* VT = (bf16*)(F.ws + WS_VT);
    const int tr = F.lane >> 3, c8 = F.lane & 7;
    for (int it = F.gw; it < 4096; it += F.ngw) {
        const int bh = it & 127, blk = it >> 7, b = bh >> 3, h = bh & 7;
        const bf16* base = P + ((size_t)b * 8 + h) * SEQ * 64 + (size_t)(blk * 64 + tr) * 64 + 8 * c8;
        v4u rv[8];
#pragma unroll
        for (int i = 0; i < 8; ++i) { const bf16* row = base + (size_t)(8 * i) * 64; rv[i] = *(const GAS v4u*)(row + (size_t)2 * 16 * 8 * SEQ * 64); }
        {
#pragma unroll
            for (int i = 0; i < 8; ++i) { LAS unsigned* q = tl + (8 * i + tr) * 33 + 4 * c8; q[0] = rv[i].x; q[1] = rv[i].y; q[2] = rv[i].z; q[3] = rv[i].w; }
            LDS_WAIT(); asm volatile("" ::: "memory");
            const LAS unsigned short* t16 = (const LAS unsigned short*)tl; const int dr = tr;
#define KAP(pos) (((pos) & ~12) | (((pos) & 4) << 1) | (((pos) & 8) >> 1))
            bf16* const obase = VT + ((size_t)bh * 64 + blk * 2 + (c8 >> 2)) * 2048 + ((c8 >> 1) & 1) * 512 + (c8 & 1) * 256;
#pragma unroll
            for (int j = 0; j < 8; ++j) { unsigned val[8];
#pragma unroll
                for (int p = 0; p < 8; ++p) { const int pos = 8 * c8 + p; val[p] = t16[KAP(pos) * 66 + 8 * j + dr]; }
                v4u w4; w4.x = val[0] | (val[1] << 16); w4.y = val[2] | (val[3] << 16); w4.z = val[4] | (val[5] << 16); w4.w = val[6] | (val[7] << 16);
                *(GAS v4u*)(obase + (j >> 2) * 1024 + ((8 * j + dr) & 31) * 8) = w4; }
#undef KAP
            LDS_WAIT(); asm volatile("" ::: "memory");
        }
    }
}

__device__ __forceinline__ int crow16(int i, int hh) { return (i & 3) + 8 * (i >> 2) + 4 * hh; }
__device__ __forceinline__ void attn_item(Frame& F, int bh, int qb, float thr, const bf16x8 (&Lt)[2]) {
    const int r = F.lane & 31, hh = F.lane >> 5, b = bh >> 3, h = bh & 7, q0 = qb * 32;
    const bf16* Qn = (const bf16*)(F.ws + WS_QN); const bf16* Kn = (const bf16*)(F.ws + WS_KN); const bf16* VT = (const bf16*)(F.ws + WS_VT);
    bf16x8 qf[4];
#pragma unroll
    for (int s = 0; s < 4; ++s) qf[s] = *(const GAS bf16x8*)(Qn + ((size_t)bh * 64 + qb) * 2048 + s * 512 + F.lane * 8);
    f32x4 gout[2][4];
#pragma unroll
    for (int db = 0; db < 2; ++db)
#pragma unroll
        for (int gq = 0; gq < 4; ++gq) gout[db][gq] = *(const f32x4*)(F.sb_out_g + h * 64 + 32 * db + 8 * gq + 4 * hh);
    f32x16 O0, O1;
#pragma unroll
    for (int i = 0; i < 16; ++i) { O0[i] = 0.f; O1[i] = 0.f; }
    float carry = 0.f;
    const bf16* kbase = Kn + (size_t)bh * 64 * 2048 + F.lane * 8; const bf16* vbase = VT + (size_t)bh * 64 * 2048 + F.lane * 8;
#define ATT_LOAD(KF, VF, kb_) do { _Pragma("unroll") for (int s_ = 0; s_ < 4; ++s_) KF[s_] = *(const GAS bf16x8*)(kbase + (size_t)(kb_) * 2048 + 512 * s_); \
        _Pragma("unroll") for (int db_ = 0; db_ < 2; ++db_) _Pragma("unroll") for (int ks_ = 0; ks_ < 2; ++ks_) VF[db_][ks_] = *(const GAS bf16x8*)(vbase + (size_t)(kb_) * 2048 + 1024 * db_ + 512 * ks_); } while (0)
#define ATT_BLOCK(KF, VF, kb_) do { const bool diag = ((kb_) == qb); \
        f32x16 z; _Pragma("unroll") for (int i = 0; i < 16; ++i) z[i] = 0.f; \
        _Pragma("unroll") for (int s_ = 0; s_ < 4; ++s_) z = MFMA32(KF[s_], qf[s_], z); \
        float sp[16]; \
        _Pragma("unroll") for (int i = 0; i < 16; ++i) { const float zz = z[i]; float v = fmaxf(zz, 0.f) + __builtin_amdgcn_logf(1.f + __builtin_amdgcn_exp2f(-fabsf(zz))); if (diag && !(crow16(i, hh) < r)) v = 0.f; sp[i] = v; } \
        const bf16x8 sb0 = pack8(sp[0], sp[1], sp[2], sp[3], sp[4], sp[5], sp[6], sp[7]), sb1 = pack8(sp[8], sp[9], sp[10], sp[11], sp[12], sp[13], sp[14], sp[15]); \
        f32x16 Cc; _Pragma("unroll") for (int i = 0; i < 16; ++i) Cc[i] = carry; \
        Cc = MFMA32(Lt[0], sb0, Cc); Cc = MFMA32(Lt[1], sb1, Cc); \
        float w[16]; \
        _Pragma("unroll") for (int i = 0; i < 16; ++i) { float v = __builtin_amdgcn_exp2f(z[i] - Cc[i]); if (diag && !(crow16(i, hh) < r)) v = 0.f; w[i] = v; } \
        const bf16x8 wb0 = pack8(w[0], w[1], w[2], w[3], w[4], w[5], w[6], w[7]), wb1 = pack8(w[8], w[9], w[10], w[11], w[12], w[13], w[14], w[15]); \
        O0 = MFMA32(VF[0][0], wb0, O0); O0 = MFMA32(VF[0][1], wb1, O0); O1 = MFMA32(VF[1][0], wb0, O1); O1 = MFMA32(VF[1][1], wb1, O1); \
        carry = __shfl(Cc[0], r); } while (0)
    bf16x8 kfA[4], vfA[2][2], kfB[4], vfB[2][2];
    ATT_LOAD(kfA, vfA, qb);
    for (int kb = qb; kb >= 0; kb -= 2) {
        ATT_LOAD(kfB, vfB, kb > 0 ? kb - 1 : 0); __builtin_amdgcn_sched_barrier(0);
        ATT_BLOCK(kfA, vfA, kb);
        if (kb == 0 || __all(carry > thr)) break;
        ATT_LOAD(kfA, vfA, kb > 1 ? kb - 2 : 0); __builtin_amdgcn_sched_barrier(0);
        ATT_BLOCK(kfB, vfB, kb - 1);
        if (__all(carry > thr)) break;
    }
#undef ATT_LOAD
#undef ATT_BLOCK
    float ss = 0.f;
#pragma unroll
    for (int i = 0; i < 16; ++i) ss += O0[i] * O0[i] + O1[i] * O1[i];
    ss += __shfl_xor(ss, 32);
    const float rs = 1.f / sqrtf(ss * (1.f / 64.f) + EPS);
    bf16* orow = (bf16*)(F.ws + WS_MIX) + ((size_t)b * SEQ + q0 + r) * D + h * 64;
#pragma unroll
    for (int db = 0; db < 2; ++db)
#pragma unroll
        for (int gq = 0; gq < 4; ++gq) { const int d = 32 * db + 8 * gq + 4 * hh; const f32x4 gg = gout[db][gq];
            const float a0 = (db ? O1[4 * gq + 0] : O0[4 * gq + 0]) * rs * gg.x, a1 = (db ? O1[4 * gq + 1] : O0[4 * gq + 1]) * rs * gg.y, a2 = (db ? O1[4 * gq + 2] : O0[4 * gq + 2]) * rs * gg.z, a3 = (db ? O1[4 * gq + 3] : O0[4 * gq + 3]) * rs * gg.w;
            *(GAS unsigned long long*)(orow + d) = (unsigned long long)pkbf(a0, a1) | ((unsigned long long)pkbf(a2, a3) << 32); }
}
__device__ __forceinline__ void attn_phase(Frame& F) {
    const int r = F.lane & 31, hh = F.lane >> 5;
    float mq = fabsf(F.sb_q_g[F.lane]), mk = fabsf(F.sb_k_g[F.lane]);
#pragma unroll
    for (int o = 1; o < 64; o <<= 1) { mq = fmaxf(mq, __shfl_xor(mq, o)); mk = fmaxf(mk, __shfl_xor(mk, o)); }
    const float thr = 64.f * QSCALE * mq * mk * 1.02f + 151.f;
    bf16x8 Lt[2];
#pragma unroll
    for (int ks = 0; ks < 2; ++ks) { float e[8];
#pragma unroll
        for (int jj = 0; jj < 8; ++jj) e[jj] = (16 * ks + 8 * (jj >> 2) + 4 * hh + (jj & 3) >= r) ? 1.f : 0.f;
        Lt[ks] = pack8(e[0], e[1], e[2], e[3], e[4], e[5], e[6], e[7]); }
    for (int it = F.gw; it < 2048; it += F.ngw) { const int bh = it & 127, j = it >> 7;
        attn_item(F, bh, 63 - j, thr, Lt); attn_item(F, bh, j, thr, Lt); attn_item(F, bh, 47 - j, thr, Lt); attn_item(F, bh, 16 + j, thr, Lt); }
}

constexpr int HG_PART = 0, HG_SSQ = 2048, HG_QE = 4096, HG_KE = HG_QE + 64 * 272, HG_VT = HG_KE + 64 * 272, HG_KST = HG_VT + 128 * 144, HG_ST = HG_KST + 128 * 144, HG_END = HG_ST + 128 * 272;
static_assert(HG_END <= RING_BYTES, "HGRN2 LDS map");
__device__ __forceinline__ float hg_lbound(Frame& F, int h, int d) { const int c = h * 128 + d; return 1.f / (1.f + __expf(F.hg_lb[512 + c] - F.hg_lb[c])); }
__device__ __forceinline__ void hg_gates(Frame& F, const unsigned short (&ffr)[16], float lb, int d, int tq, float (&bb)[16], float (&kk)[16], float& total) {
    float run = 1.f;
#pragma unroll
    for (int i = 0; i < 16; ++i) { const float ff = bf2f(ffr[i]); const float sg = __builtin_amdgcn_rcpf(1.f + __expf(-ff));
        const float f = lb + (1.f - lb) * sg; kk[i] = (1.f - lb) * (1.f - sg); run *= f; bb[i] = run; }
    LAS float* part = (LAS float*)(F.lds + RING_OFF + HG_PART);
    part[tq * 128 + d] = run;
    __syncthreads();
    const float p0 = part[d], p1 = part[128 + d], p2 = part[256 + d], p3 = part[384 + d];
    const float off = (tq > 0 ? p0 : 1.f) * (tq > 1 ? p1 : 1.f) * (tq > 2 ? p2 : 1.f);
    total = (p0 * p1) * (p2 * p3);
#pragma unroll
    for (int i = 0; i < 16; ++i) bb[i] *= off;
}
#define HG_HV() const bf16* const PHp = (const bf16*)(F.ws + WS_PH); \
    const __amdgpu_buffer_rsrc_t rsrcP = __builtin_amdgcn_make_buffer_rsrc((void*)PHp, 0, (int)((size_t)4 * T * 512 * 2), 0x00020000)
#define HG_SOFF(item_, arr_) ((unsigned)((((arr_) * 16 + (((item_) >> 5) >> 2)) * 4 + (((item_) >> 5) & 3)) * SEQ + ((item_) & 31) * 64) * 256u)
#define HG_ARR(col_) ((col_) == OFF_HQ ? 0 : (col_) == OFF_HF ? 1 : (col_) == OFF_HI ? 2 : 3)
#define HG_LOADT(dst2, item_, arr_) do { const unsigned so_ = (unsigned)__builtin_amdgcn_readfirstlane((int)HG_SOFF(item_, arr_)); _Pragma("unroll") for (int j_ = 0; j_ < 2; ++j_) \
        (dst2)[j_] = __builtin_bit_cast(v4u, __builtin_amdgcn_raw_buffer_load_b128(rsrcP, (unsigned)F.tid * 16u + 8192u * j_, so_, 0)); } while (0)
#define HG_PUT(src2, raw_) do { _Pragma("unroll") for (int j_ = 0; j_ < 2; ++j_) *(LAS v4u*)((raw_) + ((F.tid >> 4) + 32 * j_) * 272 + (F.tid & 15) * 16) = (src2)[j_]; } while (0)
#define HG_COL(dst, raw_) do { _Pragma("unroll") for (int i_ = 0; i_ < 16; ++i_) dst[i_] = *(const LAS unsigned short*)((raw_) + (16 * tq + i_) * 272 + 2 * d); } while (0)
template <bool PERMUTE> __device__ __forceinline__ void st16(LAS unsigned char* dst, const float (&v)[16]) {
    v4u a, b2;
    if (!PERMUTE) { a.x = pkbf(v[0], v[1]); a.y = pkbf(v[2], v[3]); a.z = pkbf(v[4], v[5]); a.w = pkbf(v[6], v[7]); b2.x = pkbf(v[8], v[9]); b2.y = pkbf(v[10], v[11]); b2.z = pkbf(v[12], v[13]); b2.w = pkbf(v[14], v[15]); }
    else { a.x = pkbf(v[0], v[1]); a.y = pkbf(v[2], v[3]); a.z = pkbf(v[8], v[9]); a.w = pkbf(v[10], v[11]); b2.x = pkbf(v[4], v[5]); b2.y = pkbf(v[6], v[7]); b2.z = pkbf(v[12], v[13]); b2.w = pkbf(v[14], v[15]); }
    *(LAS v4u*)dst = a; *(LAS v4u*)(dst + 16) = b2;
}
__device__ __forceinline__ void hgA_phase(Frame& F) {
    const int d = F.tid & 127, tq = F.tid >> 7, r = F.lane & 31, hh = F.lane >> 5;
    const bf16* P = (const bf16*)(F.ws + WS_P); bf16* KVS = (bf16*)(F.ws + WS_KVS); float* DEC = (float*)(F.ws + WS_DEC); float* SSEG = (float*)(F.ws + WS_SSEG); float* DSEG = (float*)(F.ws + WS_DSEG);
    LAS unsigned char* L = F.lds + RING_OFF; LAS float* decl = (LAS float*)(L + HG_SSQ);
    HG_HV();
    v4u rf[2], rv[2];
    LAS unsigned char* const RAWF = F.lds + ROWTAB_OFF; LAS unsigned char* const RAWV = L + HG_ST;
    for (int wg = blockIdx.x; wg < 256; wg += F.G) {
        const int bh = wg >> 2, seg = wg & 3, item0 = bh * 32 + seg * 8, h = bh & 3;
        HG_LOADT(rf, item0, 1); HG_LOADT(rv, item0, 2);
        const float lbv = hg_lbound(F, h, d); float totrun = 1.f;
        const int db = F.wave & 3, eb0 = 2 * (F.wave >> 2);
        f32x16 run0, run1;
#pragma unroll
        for (int i = 0; i < 16; ++i) { run0[i] = 0.f; run1[i] = 0.f; }
      for (int k = 0; k < 8; ++k) {
        const int item = item0 + k;
        HG_PUT(rf, RAWF); HG_PUT(rv, RAWV);
        __syncthreads();
        { const int nit = k < 7 ? item + 1 : item; HG_LOADT(rf, nit, 1); HG_LOADT(rv, nit, 2); __builtin_amdgcn_sched_barrier(0); }
        unsigned short ffr[16], vr[16]; HG_COL(ffr, RAWF); HG_COL(vr, RAWV);
        float bb[16], kk[16], total; hg_gates(F, ffr, lbv, d, tq, bb, kk, total);
        float ks[16], vv[16];
#pragma unroll
        for (int i = 0; i < 16; ++i) { ks[i] = kk[i] * (total * __builtin_amdgcn_rcpf(bb[i])); vv[i] = bf2f(vr[i]); }
        st16<false>(L + HG_KST + d * 144 + tq * 32, ks); st16<false>(L + HG_VT + d * 144 + tq * 32, vv);
        const float dc = total; totrun *= total;
        if (tq == 0) { DEC[(size_t)item * 128 + d] = dc; decl[d] = dc; }
        __syncthreads();
        f32x16 acc0, acc1;
#pragma unroll
        for (int i = 0; i < 16; ++i) { acc0[i] = 0.f; acc1[i] = 0.f; }
#pragma unroll
        for (int s = 0; s < 4; ++s) { const bf16x8 af = *(const LAS bf16x8*)(L + HG_KST + (db * 32 + r) * 144 + 32 * s + 16 * hh);
            const bf16x8 b0 = *(const LAS bf16x8*)(L + HG_VT + (eb0 * 32 + r) * 144 + 32 * s + 16 * hh), b1 = *(const LAS bf16x8*)(L + HG_VT + ((eb0 + 1) * 32 + r) * 144 + 32 * s + 16 * hh);
            acc0 = MFMA32(af, b0, acc0); acc1 = MFMA32(af, b1, acc1); }
#pragma unroll
        for (int g = 0; g < 4; ++g) { const f32x4 dl = *(const LAS f32x4*)(decl + db * 32 + 8 * g + 4 * hh);
#pragma unroll
            for (int ii = 0; ii < 4; ++ii) { run0[4 * g + ii] = dl[ii] * run0[4 * g + ii] + acc0[4 * g + ii]; run1[4 * g + ii] = dl[ii] * run1[4 * g + ii] + acc1[4 * g + ii]; } }
#pragma unroll
        for (int j = 0; j < 2; ++j) { bf16* dst = KVS + ((size_t)item * 128 + (eb0 + j) * 32 + r) * 128 + db * 32 + 4 * hh;
#pragma unroll
            for (int g = 0; g < 4; ++g) { const float a0 = j ? acc1[4 * g + 0] : acc0[4 * g + 0], a1 = j ? acc1[4 * g + 1] : acc0[4 * g + 1], a2 = j ? acc1[4 * g + 2] : acc0[4 * g + 2], a3 = j ? acc1[4 * g + 3] : acc0[4 * g + 3];
                *(GAS unsigned long long*)(dst + 8 * g) = (unsigned long long)pkbf(a0, a1) | ((unsigned long long)pkbf(a2, a3) << 32); } }
        __syncthreads();
      }
#pragma unroll
        for (int j = 0; j < 2; ++j) { float* dst = SSEG + ((size_t)wg * 128 + (eb0 + j) * 32 + r) * 128 + db * 32 + 4 * hh;
#pragma unroll
            for (int g = 0; g < 4; ++g) *(GAS f32x4*)(dst + 8 * g) = j ? (f32x4){run1[4 * g + 0], run1[4 * g + 1], run1[4 * g + 2], run1[4 * g + 3]} : (f32x4){run0[4 * g + 0], run0[4 * g + 1], run0[4 * g + 2], run0[4 * g + 3]}; }
        if (tq == 0) DSEG[(size_t)wg * 128 + d] = totrun;
    }
}
constexpr int HG_DECS = HG_END;
static_assert(HG_DECS + 4096 + 64 * 272 <= LDSCTL_OFF && HG_KST + 64 * 272 <= HG_ST && 64 * 272 <= MAXSLOT * 1536, "HGRN2 LDS map (decays, raw tiles)");
__device__ __forceinline__ void hgC_phase(Frame& F) {
    const int d = F.tid & 127, tq = F.tid >> 7, r = F.lane & 31, hh = F.lane >> 5;
    const bf16* P = (const bf16*)(F.ws + WS_P); const bf16* KVS = (const bf16*)(F.ws + WS_KVS); bf16* MIX = (bf16*)(F.ws + WS_MIX); const float* DEC = (const float*)(F.ws + WS_DEC);
    HG_HV();
    LAS unsigned char* L = F.lds + RING_OFF; const LAS float* decs = (const LAS float*)(L + HG_DECS);
    const int se = F.tid >> 2, sq = F.tid & 3;
    v4u rf[2], rq[2], rv[2], st[4];
    LAS unsigned char* const RAWF = L + HG_KST; LAS unsigned char* const RAWQ = F.lds + ROWTAB_OFF; LAS unsigned char* const RAWV = L + HG_DECS + 4096;
    const __amdgpu_buffer_rsrc_t rsrcG = __builtin_amdgcn_make_buffer_rsrc((void*)F.hg_out_g, 0, 512 * 4, 0x00020000), rsrcSS = __builtin_amdgcn_make_buffer_rsrc((void*)(F.ws + WS_SSEG), 0, 256 * 128 * 128 * 4, 0x00020000), rsrcDS = __builtin_amdgcn_make_buffer_rsrc((void*)(F.ws + WS_DSEG), 0, 256 * 128 * 4, 0x00020000);
    const __amdgpu_buffer_rsrc_t rsrcD = __builtin_amdgcn_make_buffer_rsrc((void*)DEC, 0, 64 * 32 * 128 * 4, 0x00020000), rsrcM = __builtin_amdgcn_make_buffer_rsrc((void*)MIX, 0, (int)((size_t)T * D * 2), 0x00020000);
    const __amdgpu_buffer_rsrc_t rsrcK = __builtin_amdgcn_make_buffer_rsrc((void*)KVS, 0, 64 * 32 * 128 * 128 * 2, 0x00020000); const unsigned kvo = (unsigned)((se * 128 + sq * 32) * 2);
#define HG_LOADKV(dst_, item_) do { const unsigned so_ = (unsigned)__builtin_amdgcn_readfirstlane((int)((item_) * (128 * 128 * 2))); _Pragma("unroll") for (int j_ = 0; j_ < 4; ++j_) (dst_)[j_] = __builtin_bit_cast(v4u, __builtin_amdgcn_raw_buffer_load_b128(rsrcK, kvo + 16u * j_, so_, 0)); } while (0)
#define HG_LOADST(item_) HG_LOADKV(st, item_)
#define HG_FOLD(kv_, c_) do { _Pragma("unroll") for (int j_ = 0; j_ < 4; ++j_) { const f32x4 d0_ = *(const LAS f32x4*)(decs + (c_) * 128 + sq * 32 + 8 * j_), d1_ = *(const LAS f32x4*)(decs + (c_) * 128 + sq * 32 + 8 * j_ + 4); const v4u k_ = (kv_)[j_]; \
        S[8 * j_ + 0] = d0_.x * S[8 * j_ + 0] + bflo(k_.x); S[8 * j_ + 1] = d0_.y * S[8 * j_ + 1] + bfhi(k_.x); S[8 * j_ + 2] = d0_.z * S[8 * j_ + 2] + bflo(k_.y); S[8 * j_ + 3] = d0_.w * S[8 * j_ + 3] + bfhi(k_.y); \
        S[8 * j_ + 4] = d1_.x * S[8 * j_ + 4] + bflo(k_.z); S[8 * j_ + 5] = d1_.y * S[8 * j_ + 5] + bfhi(k_.z); S[8 * j_ + 6] = d1_.z * S[8 * j_ + 6] + bflo(k_.w); S[8 * j_ + 7] = d1_.w * S[8 * j_ + 7] + bfhi(k_.w); } } while (0)
    for (int wg = blockIdx.x; wg < 256; wg += F.G) {
        const int bh = wg >> 2, seg = wg & 3, item0 = bh * 32 + seg * 8, b = bh >> 2, h = bh & 3;
        HG_LOADT(rf, item0, 1); HG_LOADT(rq, item0, 0); HG_LOADT(rv, item0, 2); HG_LOADST(item0);
        const unsigned dso0 = (unsigned)__builtin_amdgcn_readfirstlane((bh * 32 + seg * 8) * 128 * 4);
        const f32x4 decv = __builtin_bit_cast(f32x4, __builtin_amdgcn_raw_buffer_load_b128(rsrcD, (unsigned)(F.tid & 255) * 16u, dso0, 0));
        const float lbv = hg_lbound(F, h, d);
        __builtin_amdgcn_sched_barrier(0);
        float S[32];
#pragma unroll
        for (int j = 0; j < 32; ++j) S[j] = 0.f;
        for (int sp = 0; sp < seg; ++sp) {
            const unsigned sso = (unsigned)__builtin_amdgcn_readfirstlane((bh * 4 + sp) * 128 * 128 * 4), dso = (unsigned)__builtin_amdgcn_readfirstlane((bh * 4 + sp) * 128 * 4);
#pragma unroll
            for (int j0 = 0; j0 < 8; j0 += 8) { f32x4 sv[8], dv[8];
#pragma unroll
                for (int j = 0; j < 8; ++j) { sv[j] = __builtin_bit_cast(f32x4, __builtin_amdgcn_raw_buffer_load_b128(rsrcSS, (unsigned)((se * 128 + sq * 32) * 4) + 16u * (j0 + j), sso, 0));
                    dv[j] = __builtin_bit_cast(f32x4, __builtin_amdgcn_raw_buffer_load_b128(rsrcDS, (unsigned)(sq * 32 * 4) + 16u * (j0 + j), dso, 0)); }
#pragma unroll
                for (int j = 0; j < 8; ++j) { const int q = 4 * (j0 + j); S[q + 0] = dv[j].x * S[q + 0] + sv[j].x; S[q + 1] = dv[j].y * S[q + 1] + sv[j].y; S[q + 2] = dv[j].z * S[q + 2] + sv[j].z; S[q + 3] = dv[j].w * S[q + 3] + sv[j].w; } }
        }
        if (F.tid < 256) *((LAS f32x4*)(L + HG_DECS) + F.tid) = decv;
        __syncthreads();
      for (int k = 0; k < 8; ++k) {
        const int item = item0 + k, c = seg * 8 + k;
        const int tb = F.wave & 1, eb = F.wave >> 1;
        const int nit = k < 7 ? item + 1 : item;
        HG_PUT(rf, RAWF); HG_PUT(rq, RAWQ); HG_PUT(rv, RAWV);
        __syncthreads();
        HG_LOADT(rf, nit, 1); HG_LOADT(rq, nit, 0); HG_LOADT(rv, nit, 2); __builtin_amdgcn_sched_barrier(0);
        unsigned short ffr[16], qr[16], vr[16]; HG_COL(ffr, RAWF); HG_COL(qr, RAWQ); HG_COL(vr, RAWV);
        float bb[16], kk[16], total; hg_gates(F, ffr, lbv, d, tq, bb, kk, total);
        float vv[16];
#pragma unroll
        for (int i = 0; i < 16; ++i) { const int t = 16 * tq + i; const float q = bf2f(qr[i]);
            *(LAS unsigned short*)(L + HG_QE + t * 272 + 2 * d) = (unsigned short)pkbf(q * bb[i], 0.f);
            *(LAS unsigned short*)(L + HG_KE + t * 272 + 2 * d) = (unsigned short)pkbf(kk[i] * __builtin_amdgcn_rcpf(bb[i]), 0.f);
            vv[i] = bf2f(vr[i]); }
        st16<true>(L + HG_VT + d * 144 + tq * 32, vv);
#pragma unroll
        for (int j = 0; j < 4; ++j) { v4u w4; w4.x = pkbf(S[8 * j + 0], S[8 * j + 1]); w4.y = pkbf(S[8 * j + 2], S[8 * j + 3]); w4.z = pkbf(S[8 * j + 4], S[8 * j + 5]); w4.w = pkbf(S[8 * j + 6], S[8 * j + 7]);
            *(LAS v4u*)(L + HG_ST + se * 272 + sq * 64 + 16 * j) = w4; }
        HG_FOLD(st, k);
        unsigned long long grv[4];
        { const bf16* grow_ = PHp + (((size_t)(3 * 16 + b) * 4 + h) * SEQ + c * 64 + tb * 32 + r) * 128;
#pragma unroll
            for (int g = 0; g < 4; ++g) grv[g] = *(const GAS unsigned long long*)(grow_ + eb * 32 + 8 * g + 4 * hh); }
        HG_LOADST(nit); __builtin_amdgcn_sched_barrier(0);
        __syncthreads();
        f32x16 acc;
#pragma unroll
        for (int i = 0; i < 16; ++i) acc[i] = 0.f;
#define HG_QF(s_) (*(const LAS bf16x8*)(L + HG_QE + (tb * 32 + r) * 272 + 32 * (s_) + 16 * hh))
#pragma unroll
        for (int s = 0; s < 8; ++s) acc = MFMA32(*(const LAS bf16x8*)(L + HG_ST + (eb * 32 + r) * 272 + 32 * s + 16 * hh), HG_QF(s), acc);
        for (int sb = 0; sb <= tb; ++sb) {
            f32x16 at;
#pragma unroll
            for (int i = 0; i < 16; ++i) at[i] = 0.f;
#pragma unroll
            for (int s = 0; s < 8; ++s) at = MFMA32(*(const LAS bf16x8*)(L + HG_KE + (sb * 32 + r) * 272 + 32 * s + 16 * hh), HG_QF(s), at);
            float a[16];
#pragma unroll
            for (int i = 0; i < 16; ++i) a[i] = (sb < tb || crow16(i, hh) <= r) ? at[i] : 0.f;
            const bf16x8 ab0 = pack8(a[0], a[1], a[2], a[3], a[4], a[5], a[6], a[7]), ab1 = pack8(a[8], a[9], a[10], a[11], a[12], a[13], a[14], a[15]);
            acc = MFMA32(*(const LAS bf16x8*)(L + HG_VT + (eb * 32 + r) * 144 + sb * 64 + 0 + 16 * hh), ab0, acc);
            acc = MFMA32(*(const LAS bf16x8*)(L + HG_VT + (eb * 32 + r) * 144 + sb * 64 + 32 + 16 * hh), ab1, acc);
        }
        float ss = 0.f;
#pragma unroll
        for (int i = 0; i < 16; ++i) ss += acc[i] * acc[i];
        ss += __shfl_xor(ss, 32);
        LAS float* ssq = (LAS float*)(L + HG_SSQ);
        if (hh == 0) ssq[eb * 64 + tb * 32 + r] = ss;
        f32x4 ggv[4];
        { const unsigned so = (unsigned)__builtin_amdgcn_readfirstlane(h * 512);
#pragma unroll
            for (int g = 0; g < 4; ++g) ggv[g] = __builtin_bit_cast(f32x4, __builtin_amdgcn_raw_buffer_load_b128(rsrcG, (unsigned)((eb * 32 + 8 * g + 4 * hh) * 4), so, 0)); }
        __syncthreads();
        const int tl = tb * 32 + r; const float tot = (ssq[tl] + ssq[64 + tl]) + (ssq[128 + tl] + ssq[192 + tl]);
        const float rs = 1.f / sqrtf(tot * (1.f / 128.f) + EPS);
        const unsigned mso = (unsigned)__builtin_amdgcn_readfirstlane((int)((((unsigned)b * SEQ + c * 64) * D + 512 + h * 128) * 2)), mvo = (unsigned)((tl * D + eb * 32 + 4 * hh) * 2);
#pragma unroll
        for (int g = 0; g < 4; ++g) { const int e = eb * 32 + 8 * g + 4 * hh; const unsigned long long gr = grv[g]; const f32x4 gg = ggv[g];
            const float g0 = bflo((unsigned)gr), g1 = bfhi((unsigned)gr), g2 = bflo((unsigned)(gr >> 32)), g3 = bfhi((unsigned)(gr >> 32));
            const float y0 = acc[4 * g + 0] * rs * gg.x * (g0 * __builtin_amdgcn_rcpf(1.f + __expf(-g0))), y1 = acc[4 * g + 1] * rs * gg.y * (g1 * __builtin_amdgcn_rcpf(1.f + __expf(-g1)));
            const float y2 = acc[4 * g + 2] * rs * gg.z * (g2 * __builtin_amdgcn_rcpf(1.f + __expf(-g2))), y3 = acc[4 * g + 3] * rs * gg.w * (g3 * __builtin_amdgcn_rcpf(1.f + __expf(-g3)));
            typedef unsigned u32x2_t __attribute__((ext_vector_type(2))); __builtin_amdgcn_raw_buffer_store_b64((u32x2_t){pkbf(y0, y1), pkbf(y2, y3)}, rsrcM, mvo + 16u * g, mso, 0); }
        __syncthreads();
      }
    }
#undef HG_LOADST
#undef HG_LOADKV
#undef HG_FOLD
#undef HG_QF
}
#undef HG_LOADT
#undef HG_PUT
#undef HG_COL
#undef HG_ARR
#undef HG_SOFF
#undef HG_HV

__device__ __forceinline__ void router_phase(Frame& F) {
    LAS unsigned char* L = F.lds; const int r = F.lane & 31, hh = F.lane >> 5;
    LAS unsigned* lcnt = (LAS unsigned*)(F.lds + LTAB_OFF) + LT_MISC; LAS unsigned* lbase = lcnt + 32; LAS float* lrstd = (LAS float*)(F.lds + ROWTAB_OFF);
    float* TOPG = (float*)(F.ws + WS_TOPG);
    {
        const GAS v4u* img = (const GAS v4u*)(F.ws + WS_RT) + vzero();
        constexpr int NB = (RT_END / 16 + NWAVES * 64 - 1) / (NWAVES * 64);
        v4u t4[NB];
#pragma unroll
        for (int j = 0; j < NB; ++j) { const int q = F.tid + j * NWAVES * 64; t4[j] = img[q < RT_END / 16 ? q : 0]; }
#pragma unroll
        for (int j = 0; j < NB; ++j) { const int q = F.tid + j * NWAVES * 64; if (q < RT_END / 16) *(LAS v4u*)(L + 16 * q) = t4[j]; }
    }
    const bf16* XH = (const bf16*)(F.ws + WS_XN); int* LIST = (int*)(F.ws + WS_LIST); unsigned* cnt = (unsigned*)(F.ctl + CW_CNT);
    for (int base = blockIdx.x * 4; base < T / 32; base += F.G * 4) {
        const int grp = base + F.wave; const bool active = F.wave < 4 && grp < T / 32;
        if (F.tid < 32) lcnt[F.tid] = 0u;
        __syncthreads();
        float sv[4] = {0.f, 0.f, 0.f, 0.f}; int se[4] = {0, 0, 0, 0}; unsigned lp0 = 0u, lp1 = 0u; float rstd = 0.f; const int tok = grp * 32 + r;
        if (active) {
            const bf16* hrow = XH + (size_t)tok * D + 8 * hh;
            f32x16 acc;
#pragma unroll
            for (int i = 0; i < 16; ++i) acc[i] = 0.f;
            float ssq = 0.f;
#pragma unroll 16
            for (int s = 0; s < 64; ++s) {
                const v4u hu = *(const GAS v4u*)(hrow + 16 * s); const bf16x8 hi = __builtin_bit_cast(bf16x8, hu);
                { const float a0 = bflo(hu.x), a1 = bfhi(hu.x), a2 = bflo(hu.y), a3 = bfhi(hu.y), a4 = bflo(hu.z), a5 = bfhi(hu.z), a6 = bflo(hu.w), a7 = bfhi(hu.w);
                    ssq += (a0 * a0 + a1 * a1) + (a2 * a2 + a3 * a3) + (a4 * a4 + a5 * a5) + (a6 * a6 + a7 * a7); }
                const bf16x8 wh = *(const LAS bf16x8*)(L + r * RT_ROW + 32 * s + 16 * hh), wl = *(const LAS bf16x8*)(L + RT_WL + r * RT_ROW + 32 * s + 16 * hh);
                acc = MFMA32(wh, hi, acc); acc = MFMA32(wl, hi, acc);
            }
            ssq += __shfl_xor(ssq, 32);
            rstd = 1.f / sqrtf(ssq * (1.f / D) + EPS);
            float l[16];
#pragma unroll
            for (int i = 0; i < 16; ++i) l[i] = acc[i] * rstd + F.b_router[crow16(i, hh)];
            float cv[8]; int ce[8];
#pragma unroll
            for (int rnd = 0; rnd < 4; ++rnd) { float bv = l[0]; int bi = 0;
#pragma unroll
                for (int i = 1; i < 16; ++i) if (l[i] > bv) { bv = l[i]; bi = i; }
                cv[rnd] = bv; ce[rnd] = crow16(bi, hh);
#pragma unroll
                for (int i = 0; i < 16; ++i) if (i == bi) l[i] = -__builtin_inff(); }
#pragma unroll
            for (int j = 0; j < 4; ++j) { cv[4 + j] = __shfl_xor(cv[j], 32); ce[4 + j] = __shfl_xor(ce[j], 32); }
#pragma unroll
            for (int rnd = 0; rnd < 4; ++rnd) { float bv = cv[0]; int be = ce[0]; int bj = 0;
#pragma unroll
                for (int j = 1; j < 8; ++j) if (cv[j] > bv || (cv[j] == bv && ce[j] < be)) { bv = cv[j]; be = ce[j]; bj = j; }
                sv[rnd] = bv; se[rnd] = be;
#pragma unroll
                for (int j = 0; j < 8; ++j) if (j == bj) { cv[j] = -__builtin_inff(); ce[j] = 64; } }
            lp0 = __hip_atomic_fetch_add(lcnt + (hh ? se[2] : se[0]), 1u, __ATOMIC_RELAXED, __HIP_MEMORY_SCOPE_WORKGROUP);
            lp1 = __hip_atomic_fetch_add(lcnt + (hh ? se[3] : se[1]), 1u, __ATOMIC_RELAXED, __HIP_MEMORY_SCOPE_WORKGROUP);
        }
        __syncthreads();
        if (F.tid < 32) lbase[F.tid] = __hip_atomic_fetch_add(cnt + F.tid, lcnt[F.tid], __ATOMIC_RELAXED, __HIP_MEMORY_SCOPE_AGENT);
        __syncthreads();
        if (active) {
            const float e1 = __expf(sv[1] - sv[0]), e2 = __expf(sv[2] - sv[0]), e3 = __expf(sv[3] - sv[0]); const float inv = 1.f / (1.f + e1 + e2 + e3);
            const int ea = hh ? se[2] : se[0], eb = hh ? se[3] : se[1]; const float ga = (hh ? e2 : 1.f) * inv, gb = (hh ? e3 : e1) * inv;
            const size_t ia = (size_t)ea * 32768 + lbase[ea] + lp0, ib = (size_t)eb * 32768 + lbase[eb] + lp1;
            LIST[ia] = tok * 4 + 2 * hh; LIST[ib] = tok * 4 + 2 * hh + 1; TOPG[tok * 4 + 2 * hh] = ga; TOPG[tok * 4 + 2 * hh + 1] = gb;
            if (hh == 0) lrstd[F.wave * 32 + r] = rstd;
        }
        __syncthreads();
        {
            unsigned char* X8 = F.ws + WS_X8; const int t0 = base * 32;
#pragma unroll
            for (int q0 = 0; q0 < 16; q0 += 4) { v4u a[4][2];
#pragma unroll
                for (int q = 0; q < 4; ++q) { const int tt = t0 + F.wave * 16 + q0 + q; const GAS v4u* p = (const GAS v4u*)(XH + (size_t)(tt < T ? tt : 0) * D) + 2 * F.lane; a[q][0] = p[0]; a[q][1] = p[1]; }
#pragma unroll
                for (int q = 0; q < 4; ++q) { const int tl = F.wave * 16 + q0 + q, tt = t0 + tl; if (tt < T) { const float rs = lrstd[tl]; v4u o;
                    o.x = pg8::pk4_fp8(bflo(a[q][0].x) * rs, bfhi(a[q][0].x) * rs, bflo(a[q][0].y) * rs, bfhi(a[q][0].y) * rs); o.y = pg8::pk4_fp8(bflo(a[q][0].z) * rs, bfhi(a[q][0].z) * rs, bflo(a[q][0].w) * rs, bfhi(a[q][0].w) * rs);
                    o.z = pg8::pk4_fp8(bflo(a[q][1].x) * rs, bfhi(a[q][1].x) * rs, bflo(a[q][1].y) * rs, bfhi(a[q][1].y) * rs); o.w = pg8::pk4_fp8(bflo(a[q][1].z) * rs, bfhi(a[q][1].z) * rs, bflo(a[q][1].w) * rs, bfhi(a[q][1].w) * rs);
                    *((GAS v4u*)(X8 + (size_t)tt * D) + F.lane) = o; } } }
        }
        __syncthreads();
    }
}
__device__ __forceinline__ int build_moe_tables(Frame& F, int ntn, int mode) {
    LAS int* lt = (LAS int*)(F.lds + LTAB_OFF);
    if (F.wave == 0) {
        const int e = F.lane & 31; const int c = (int)__hip_atomic_load((unsigned*)(F.ctl + CW_CNT) + e, __ATOMIC_RELAXED, __HIP_MEMORY_SCOPE_AGENT);
        const int tl = (c + 255) >> 8; int inc = tl;
#pragma unroll
        for (int off = 1; off < 32; off <<= 1) { const int o = __shfl_up(inc, off, 32); if (e >= off) inc += o; }
        const int tot = __shfl(inc, 31, 32), t0 = inc - tl;
        if (F.lane < 32) { lt[LT_TS + e] = t0; lt[LT_CNT + e] = c; for (int i = 0; i < tl; ++i) lt[t0 + i] = e; }
        if (F.lane == 0) lt[LT_MISC + 64] = tot;
    }
    __syncthreads();
    int nt = lt[LT_MISC + 64]; nt = nt < 0 ? 0 : (nt > MAXTILES ? MAXTILES : nt); nt = __builtin_amdgcn_readfirstlane(nt);
    const int* LIST = (const int*)(F.ws + WS_LIST);
    const int nslot = mode == 1 ? MAXSLOT : (MAXTILES * 4 + 255) / 256;
    for (int q = F.tid; q < nslot * 256; q += NWAVES * 64) { const int i = q >> 8, rr = q & 255; const int Lu = i * F.G + F.vcu;
        int li = -1; float bias = 0.f;
        if (Lu < nt * ntn) { const int pm0 = Lu / ntn, pl = Lu - pm0 * ntn, pm = mode == 2 ? nt - 1 - pm0 : pm0, e = lt[pm], idx = (pm - lt[LT_TS + e]) * 256 + rr; if (idx < lt[LT_CNT + e]) li = LIST[(size_t)e * 32768 + idx];
            bias = mode == 1 ? F.b_gu[(size_t)e * 2048 + (rr >> 7) * 1024 + pl * 128 + (rr & 127)] : F.b_d[(size_t)e * 1024 + pl * 256 + rr]; }
        ((LAS float*)(F.lds + ROWTAB_OFF))[q] = bias;
        if (mode == 1) ((LAS unsigned short*)(F.lds + ROWTAB2_OFF))[q] = (unsigned short)(li < 0 ? 0 : (li >> 2));
        else ((LAS int*)(F.lds + ROWTAB_OFF) + nslot * 256)[q] = li; }
    __syncthreads();
    return nt;
}
__device__ __forceinline__ void combine_phase(Frame& F) {
    const unsigned char* YK = F.ws + WS_YK; const bf16* XH = (const bf16*)(F.ws + WS_XN); const float* TOPG = (const float*)(F.ws + WS_TOPG);
    for (int t = F.gw; t < T; t += F.ngw) {
        GAS f32x4* xr = (GAS f32x4*)(F.out + (size_t)t * D) + F.lane; f32x4 v[4]; unsigned y[4][4]; const f32x4 gt = *((const GAS f32x4*)TOPG + t + vzero()) * (1.0f / Y8_SCALE);
#pragma unroll
        for (int j = 0; j < 4; ++j) { const unsigned long long xh = __builtin_nontemporal_load((const GAS unsigned long long*)(XH + (size_t)t * D) + F.lane + 64 * j);
            v[j] = (f32x4){bflo((unsigned)xh), bfhi((unsigned)xh), bflo((unsigned)(xh >> 32)), bfhi((unsigned)(xh >> 32))};
#pragma unroll
            for (int k = 0; k < 4; ++k) y[j][k] = __builtin_nontemporal_load((const GAS unsigned*)(YK + ((size_t)t * 4 + k) * D) + F.lane + 64 * j); }
#pragma unroll
        for (int j = 0; j < 4; ++j) { f32x4 s4 = {0.f, 0.f, 0.f, 0.f};
#pragma unroll
            for (int k = 0; k < 4; ++k) { const f32x2n_ lo = __builtin_amdgcn_cvt_pk_f32_fp8((int)y[j][k], false), hi = __builtin_amdgcn_cvt_pk_f32_fp8((int)y[j][k], true); const float g = gt[k]; s4.x += g * lo.x; s4.y += g * lo.y; s4.z += g * hi.x; s4.w += g * hi.y; }
            v[j] = v[j] + s4;
            __builtin_nontemporal_store(v[j], xr + 64 * j); }
    }
}

constexpr int NPH = 9;
struct Args { const float* in[16]; float* out; unsigned char* ws; int ph_lo, ph_hi; };
__global__ void __launch_bounds__(NWAVES * 64, 2) fwd(Args args) {
    extern __shared__ __attribute__((aligned(16))) unsigned char lds[];
    Frame F;
    F.lds = (LAS unsigned char*)lds;
    F.MISC = (volatile LAS unsigned*)(F.lds + MISC_OFF);
    F.tid = threadIdx.x; F.lane = F.tid & 63; F.wave = __builtin_amdgcn_readfirstlane(F.tid >> 6);
    F.G = gridDim.x; { const int bx = blockIdx.x; F.vcu = (F.G % 8 == 0) ? (bx % 8) * (F.G / 8) + bx / 8 : bx; }
    F.gw = blockIdx.x * NWAVES + F.wave; F.ngw = F.G * NWAVES;
    F.ws = args.ws; F.ctl = (gu32*)(args.ws + WS_CTL); F.out = args.out;
    F.x = args.in[0]; F.norm1_g = args.in[1]; F.w_in = args.in[2]; F.sb_q_g = args.in[3]; F.sb_k_g = args.in[4]; F.sb_out_g = args.in[5]; F.hg_lb = args.in[6]; F.hg_out_g = args.in[7];
    F.w_out = args.in[8]; F.norm2_g = args.in[9]; F.w_router = args.in[10]; F.b_router = args.in[11]; F.w_gu = args.in[12]; F.b_gu = args.in[13]; F.w_d = args.in[14]; F.b_d = args.in[15];
    for (int u = F.tid; u < (LDS_BYTES - LDSCTL_OFF) / 4; u += NWAVES * 64) ((LAS unsigned*)(F.lds + LDSCTL_OFF))[u] = 0u;
    __syncthreads();
    XcdBarrier bar; bar.bar = (unsigned*)(F.ctl + CW_BAR); bar.x = 0; bar.st = nullptr;
    if (MK_ONE_LAUNCH) bar = xcd_barrier_post((unsigned*)(F.ctl + CW_BAR), F.MISC + 8);
    const int lo = args.ph_lo, hi = args.ph_hi;
#define IN(k) (lo <= (k) && (k) < hi && ((F.lane = lane_id()), (F.tid = F.wave * 64 + F.lane), true))
#define SEAM(k) do { if (IN(k) && IN((k) + 1)) xcd_barrier(bar); } while (0)

    if (IN(0)) { p0_prologue(F); } SEAM(0);
    if (IN(1)) {
        pg8::Gemm g{(const bf16*)(F.ws + WS_XN), (const bf16*)(F.ws + WS_WIN), T, NIN, D}; pg8::StaticOrder S; S.init(T, NIN, F.G, (int)blockIdx.x);
        pg8::EpiInproj E{(bf16*)(F.ws + WS_P), (bf16*)(F.ws + WS_PH), (bf16*)(F.ws + WS_QN), (bf16*)(F.ws + WS_KN), F.sb_q_g, F.sb_k_g, QSCALE, EPS};
        pg8::gemm_phase<pg8::EpiInproj, pg8::StaticOrder, PG8_ALIGN, PG8_SP2>(F.lds + RING_OFF, g, S, E, F.tid);
    } SEAM(1);
    if (IN(2)) { prep_phase(F); __syncthreads(); hgA_phase(F); } SEAM(2);
    if (IN(3)) { attn_phase(F); hgC_phase(F); } SEAM(3);
    if (IN(4)) {
        pg8::Gemm g{(const bf16*)(F.ws + WS_MIX), (const bf16*)(F.ws + WS_WOUT), T, D, D}; pg8::StaticOrder S; S.init(T, D, F.G, (int)blockIdx.x);
        pg8::EpiRes E{F.x, (bf16*)(F.ws + WS_XN), D};
        pg8::gemm_phase<pg8::EpiRes, pg8::StaticOrder, PG8_ALIGN, PG8_SP2>(F.lds + RING_OFF, g, S, E, F.tid);
    } SEAM(4);
    if (IN(5)) { router_phase(F); } SEAM(5);
    if (IN(6)) {
        const int nt = build_moe_tables(F, 8, 1); const LAS int* lt = (const LAS int*)(F.lds + LTAB_OFF);
        pg8::Gemm g{(const bf16*)(F.ws + WS_X8), (const bf16*)(F.ws + WS_WGU), MAXROWS, NE * 2048, D / 2};
        pg8::MoeOrder S{lt, (const LAS unsigned short*)(F.lds + ROWTAB2_OFF), 8, nt * 8, F.G, F.vcu, 1024u, 0};
        pg8::EpiAct<true> E{F.ws + WS_ACT, (const LAS float*)(F.lds + ROWTAB_OFF), A8_SCALE};
        pg8::gemm_phase<pg8::EpiAct<true>, pg8::MoeOrder, PG8_ALIGN, PG8_SP2, true, SC_W8, SC_ONE>(F.lds + RING_OFF, g, S, E, F.tid);
        {
            const int rem = (nt * 8) % F.G, nidle = F.G - rem; const bool few = rem == 0 || nidle < F.G / 4;
            __syncthreads();
            if (few) p0_items(F, P0_NITEMS - P0_NLATE, P0_NITEMS, F.vcu * NWAVES + F.wave, F.G * NWAVES);
            else if (F.vcu >= rem) p0_items(F, P0_NITEMS - P0_NLATE, P0_NITEMS, (F.vcu - rem) * NWAVES + F.wave, nidle * NWAVES);
        }
    } SEAM(6);
    if (IN(7)) {
        const int nt = build_moe_tables(F, 4, 2); const LAS int* lt = (const LAS int*)(F.lds + LTAB_OFF);
        pg8::Gemm g{(const bf16*)(F.ws + WS_ACT), (const bf16*)(F.ws + WS_WD), MAXROWS, NE * 1024, D / 2};
        pg8::MoeOrder S{lt, nullptr, 4, nt * 4, F.G, F.vcu, 1024u, nt};
        pg8::EpiDown E{F.ws + WS_YK, (const LAS int*)(F.lds + ROWTAB_OFF) + ((MAXTILES * 4 + 255) / 256) * 256, (const LAS float*)(F.lds + ROWTAB_OFF), Y8_SCALE};
        pg8::gemm_phase<pg8::EpiDown, pg8::MoeOrder, PG8_ALIGN, PG8_SP2, true, SC_W8Y, SC_A8>(F.lds + RING_OFF, g, S, E, F.tid);
    } SEAM(7);
    if (IN(8)) { combine_phase(F); }
#undef IN
#undef SEAM
}

extern "C" void kernel_launch(void* const* d_in, const int* in_sizes, int n_in, void* d_out, int out_size, void* d_ws, size_t ws_size, hipStream_t stream) {
    static int grid = 0;
    if (grid == 0) {
        if (n_in != 16 || in_sizes[0] != T * D || out_size != T * D || ws_size < WS_END) { fprintf(stderr, "kernel_launch: shape/workspace mismatch (n_in %d, ws %zu, need %zu); nothing launched\n", n_in, ws_size, (size_t)WS_END); grid = -1; return; }
        int dev = 0, cus = 0, per_cu = 0;
        if (hipGetDevice(&dev) != hipSuccess || hipDeviceGetAttribute(&cus, hipDeviceAttributeMultiprocessorCount, dev) != hipSuccess) { grid = -1; return; }
        if (hipFuncSetAttribute((const void*)fwd, hipFuncAttributeMaxDynamicSharedMemorySize, LDS_BYTES) != hipSuccess) { grid = -1; return; }
        if (hipOccupancyMaxActiveBlocksPerMultiprocessor(&per_cu, (const void*)fwd, NWAVES * 64, LDS_BYTES) != hipSuccess || per_cu < 1) { fprintf(stderr, "kernel_launch: occupancy query says %d\n", per_cu); }
        (void)hipGetLastError();
        if ((MAXTILES * 8 + cus - 1) / cus > MAXSLOT || cus < 1) { fprintf(stderr, "kernel_launch: %d CUs: the per-workgroup unit tables are sized for 256\n", cus); grid = -1; return; }
        grid = cus;
    }
    if (grid < 0) return;
    if (hipMemsetAsync((char*)d_ws + WS_CTL, 0, CTL_ZERO_BYTES, stream) != hipSuccess) return;
    Args a{};
    for (int i = 0; i < 16; ++i) a.in[i] = (const float*)d_in[i];
    a.out = (float*)d_out; a.ws = (unsigned char*)d_ws;
#if MK_ONE_LAUNCH
    a.ph_lo = 0; a.ph_hi = NPH;
    hipLaunchKernelGGL(fwd, dim3(grid), dim3(NWAVES * 64), LDS_BYTES, stream, a);
#else
    for (int p = 0; p < NPH; ++p) { a.ph_lo = p; a.ph_hi = p + 1; hipLaunchKernelGGL(fwd, dim3(grid), dim3(NWAVES * 64), LDS_BYTES, stream, a); }
#endif
}
```

```cpp
#include <hip/hip_runtime.h>
#include <cstdio>
#include <cstdint>
namespace pg8 {
#define PG8_LAS __attribute__((address_space(3)))
typedef unsigned short bf16_t;
typedef short bf16x8 __attribute__((ext_vector_type(8)));
typedef float f32x4 __attribute__((ext_vector_type(4)));
typedef unsigned u32x4 __attribute__((ext_vector_type(4)));
typedef int i32x4_t __attribute__((ext_vector_type(4)));
typedef int i32x8_t __attribute__((ext_vector_type(8)));
constexpr int BM = 256, BK = 64, HALF = 128, HTB = HALF * BK * 2  , STAGE_BYTES = 8 * HTB, NXCD = 8, WGM = 8;

__host__ __device__ __forceinline__ int lds_byte(int r, int c) { const int st = (r >> 4) * 2 + (c >> 5), rr = r & 15, cc = c & 31, ob = rr * 64 + cc * 2; return st * 1024 + (ob ^ (((ob >> 9) & 1) << 5)); }
__host__ __device__ __forceinline__ void stage_rc(int b, int& R, int& C) { const int st = b / 1024, sb = b % 1024, swz = sb ^ (((sb >> 9) & 1) << 5); R = (st >> 1) * 16 + swz / 64; C = (st & 1) * 32 + (swz % 64) / 2; }
__host__ __device__ __forceinline__ int perm32(int rho) { const int n = rho >> 4, i = rho & 15; return 8 * (i >> 2) + 4 * n + (i & 3); }

struct Unit { int pm, pn, slot; };
struct Gemm { const bf16_t* A; const bf16_t* Bt; int M, N, K; };

struct StaticOrder {
    int nM, nN, nwg, G, c;
    __host__ __device__ void init(int M, int N, int G_, int c_) { nM = M / BM; nN = N / BM; nwg = nM * nN; G = G_; c = c_; }
    __host__ __device__ bool next(int i, Unit& u) const {
        const long L = (long)i * G + c; if (L >= nwg) return false;
        int wgid = (int)L; { const int q = nwg / NXCD, r = nwg % NXCD, xcd = wgid % NXCD, off = wgid / NXCD; wgid = (xcd < r ? xcd * (q + 1) : r * (q + 1) + (xcd - r) * q) + off; }
        const int nig = WGM * nN, gid = wgid / nig, fm = gid * WGM, gsz = (nM - fm) < WGM ? (nM - fm) : WGM;
        u.pm = fm + ((wgid % nig) % gsz); u.pn = (wgid % nig) / gsz; return true;
    }
    __device__ __forceinline__ void a_ready(const Unit&) const {}
    __device__ __forceinline__ void done(const Unit&) const {}
};

__device__ __forceinline__ unsigned cvt_pk_bf16(float lo, float hi) { unsigned r; asm volatile("v_cvt_pk_bf16_f32 %0, %1, %2" : "=v"(r) : "v"(lo), "v"(hi)); return r; }
typedef float f32x2 __attribute__((ext_vector_type(2)));
__device__ __forceinline__ f32x2 gelu_pk(f32x2 v) {
    const f32x2 av = __builtin_elementwise_abs(v), d = av * 0.2316418882f + 1.0f;
    f32x2 t; t.x = __builtin_amdgcn_rcpf(d.x); t.y = __builtin_amdgcn_rcpf(d.y);
    f32x2 q = t * 0.5307027145f + (-0.7265760135f); q = q * t + 0.7107068705f; q = q * t + (-0.142248368f); q = q * t + 0.127414796f; q = q * t;
    const f32x2 s = (v * v) * (-0.72134752044f);
    f32x2 e; e.x = __builtin_amdgcn_exp2f(s.x); e.y = __builtin_amdgcn_exp2f(s.y);
    const f32x2 m = v * (q * e), r = v - m;
    f32x2 o; o.x = v.x < 0.f ? m.x : r.x; o.y = v.y < 0.f ? m.y : r.y; return o;
}

template <int ACT  > struct EpiBf16 {
    static constexpr bool PERM = true, AFTER_DRAIN = false, HAS_INIT = false, INIT_LOADS = false; static_assert(ACT == 0 || ACT == 1, "EpiBf16: ACT is 0 (none) or 1 (gelu_pk)");
    bf16_t* O; int ldc; const float* bias; int split_cols; size_t split_stride; float scale0;
    __device__ __forceinline__ void operator()(const f32x4 (&acc)[2][2][4][2], const Unit& u, int wr, int wc, int fr, int fq) const {
        const int row0 = u.pm * BM + wr * 64 + fr; int colt = u.pn * BM; bf16_t* base = O;
        float sc = 1.f; if (split_cols) { const int t = colt / split_cols; base += (size_t)t * split_stride; colt -= t * split_cols; if (t == 0) sc = scale0; }
        const int col0 = colt + wc * 32 + 8 * fq, bcol0 = u.pn * BM + wc * 32 + 8 * fq;
        f32x4 bv[2][2];
#pragma unroll
        for (int bj = 0; bj < 2; ++bj)
#pragma unroll
            for (int n = 0; n < 2; ++n) bv[bj][n] = bias ? *(const f32x4*)(bias + bcol0 + bj * HALF + 4 * n) : (f32x4){0.f, 0.f, 0.f, 0.f};
#pragma unroll
        for (int ai = 0; ai < 2; ++ai)
#pragma unroll
            for (int m = 0; m < 4; ++m) { bf16_t* rowp = base + (size_t)(row0 + ai * HALF + m * 16) * ldc + col0;
#pragma unroll
                for (int bj = 0; bj < 2; ++bj) { f32x4 v0 = acc[ai][bj][m][0] + bv[bj][0], v1 = acc[ai][bj][m][1] + bv[bj][1];
                    if (ACT == 1) { f32x2 a = gelu_pk((f32x2){v0[0], v0[1]}), b = gelu_pk((f32x2){v0[2], v0[3]}), c = gelu_pk((f32x2){v1[0], v1[1]}), d = gelu_pk((f32x2){v1[2], v1[3]});
                        v0 = (f32x4){a.x, a.y, b.x, b.y}; v1 = (f32x4){c.x, c.y, d.x, d.y}; }
                    v0 = v0 * sc; v1 = v1 * sc; u32x4 w; w.x = cvt_pk_bf16(v0[0], v0[1]); w.y = cvt_pk_bf16(v0[2], v0[3]); w.z = cvt_pk_bf16(v1[0], v1[1]); w.w = cvt_pk_bf16(v1[2], v1[3]);
                    *(u32x4*)(rowp + bj * HALF) = w; } }
    }
};

__device__ __forceinline__ unsigned pk4_fp8(float a, float b, float c, float d) {
    a = fminf(fmaxf(a, -448.f), 448.f); b = fminf(fmaxf(b, -448.f), 448.f); c = fminf(fmaxf(c, -448.f), 448.f); d = fminf(fmaxf(d, -448.f), 448.f);
    int p = 0; p = __builtin_amdgcn_cvt_pk_fp8_f32(a, b, p, false); p = __builtin_amdgcn_cvt_pk_fp8_f32(c, d, p, true); return (unsigned)p;
}
struct EpiRes {
    static constexpr bool PERM = true, AFTER_DRAIN = false, HAS_INIT = true, INIT_LOADS = true;
    const float* __restrict__ X; bf16_t* __restrict__ XH; int ldc;
    __device__ __forceinline__ void init(f32x4 (&acc)[2][2][4][2], const Unit& u, int wr, int wc, int fr, int fq) const {
        const int row0 = u.pm * BM + wr * 64 + fr, col0 = u.pn * BM + wc * 32 + 8 * fq;
#pragma unroll
        for (int ai = 0; ai < 2; ++ai)
#pragma unroll
            for (int m = 0; m < 4; ++m) { const float* rp = X + (size_t)(row0 + ai * HALF + m * 16) * ldc + col0;
#pragma unroll
                for (int bj = 0; bj < 2; ++bj)
#pragma unroll
                    for (int n = 0; n < 2; ++n) acc[ai][bj][m][n] = __builtin_nontemporal_load((const f32x4*)(rp + bj * HALF + n * 4)); }
    }
    __device__ __forceinline__ void operator()(const f32x4 (&acc)[2][2][4][2], const Unit& u, int wr, int wc, int fr, int fq) const {
        const int row0 = u.pm * BM + wr * 64 + fr, col0 = u.pn * BM + wc * 32 + 8 * fq;
#pragma unroll
        for (int ai = 0; ai < 2; ++ai)
#pragma unroll
            for (int m = 0; m < 4; ++m) { bf16_t* rp = XH + (size_t)(row0 + ai * HALF + m * 16) * ldc + col0;
#pragma unroll
                for (int bj = 0; bj < 2; ++bj) { const f32x4 v0 = acc[ai][bj][m][0], v1 = acc[ai][bj][m][1];
                    u32x4 w; w.x = cvt_pk_bf16(v0[0], v0[1]); w.y = cvt_pk_bf16(v0[2], v0[3]); w.z = cvt_pk_bf16(v1[0], v1[1]); w.w = cvt_pk_bf16(v1[2], v1[3]);
                    *(u32x4*)(rp + bj * HALF) = w; } }
    }
};
struct EpiInproj {
    static constexpr bool PERM = true, AFTER_DRAIN = false, HAS_INIT = false, INIT_LOADS = false;
    bf16_t* PA; bf16_t* PH; bf16_t* QN; bf16_t* KN; const float* gq; const float* gk; float qscale, eps;
    __device__ __forceinline__ void operator()(const f32x4 (&acc)[2][2][4][2], const Unit& u, int wr, int wc, int fr, int fq) const {
        if (u.pn < 4) {
            const int arr = u.pn >> 1, hd = (u.pn & 1) * 4 + wc; const float* g = arr ? gk : gq; const float gs = arr ? 1.f : qscale; bf16_t* dst = arr ? KN : QN;
            f32x4 gv[2][2];
#pragma unroll
            for (int bj = 0; bj < 2; ++bj)
#pragma unroll
                for (int n = 0; n < 2; ++n) gv[bj][n] = *(const f32x4*)(g + 32 * bj + 8 * fq + 4 * n) * gs;
#pragma unroll
            for (int ai = 0; ai < 2; ++ai)
#pragma unroll
                for (int m = 0; m < 4; ++m) { float ss = 0.f;
#pragma unroll
                    for (int bj = 0; bj < 2; ++bj)
#pragma unroll
                        for (int n = 0; n < 2; ++n) { const f32x4 a = acc[ai][bj][m][n]; ss += (a[0] * a[0] + a[1] * a[1]) + (a[2] * a[2] + a[3] * a[3]); }
                    ss += __shfl_xor(ss, 16); ss += __shfl_xor(ss, 32);
                    const float rs = 1.f / sqrtf(ss * (1.f / 64.f) + eps);
                    const int row = u.pm * BM + ai * HALF + wr * 64 + m * 16 + fr, b = row >> 11, s = row & 2047;
                    bf16_t* rp = dst + ((size_t)((b * 8 + hd) * 64 + (s >> 5))) * 2048 + (s & 31) * 8;
#pragma unroll
                    for (int bj = 0; bj < 2; ++bj) { const int c8 = 4 * bj + fq; const f32x4 v0 = acc[ai][bj][m][0] * rs * gv[bj][0], v1 = acc[ai][bj][m][1] * rs * gv[bj][1];
                        u32x4 w; w.x = cvt_pk_bf16(v0[0], v0[1]); w.y = cvt_pk_bf16(v0[2], v0[3]); w.z = cvt_pk_bf16(v1[0], v1[1]); w.w = cvt_pk_bf16(v1[2], v1[3]);
                        *(u32x4*)(rp + (c8 >> 1) * 512 + (c8 & 1) * 256) = w; } }
            return;
        }
#pragma unroll
        for (int bj = 0; bj < 2; ++bj) { const int col = u.pn * BM + bj * HALF + wc * 32 + 8 * fq;
            bf16_t* base; int rowlen;
            if (col < 1536) { const int arr = col >> 9, hd = (col & 511) >> 6, dd = col & 63; base = PA + ((size_t)(arr * 16) * 8 + hd) * 2048 * 64 + dd; rowlen = 64; }
            else { const int c2 = col - 1536, arr = c2 >> 9, hd = (c2 & 511) >> 7, dd = c2 & 127; base = PH + ((size_t)(arr * 16) * 4 + hd) * 2048 * 128 + dd; rowlen = 128; }
            const size_t bstride = (size_t)(rowlen == 64 ? 8 : 4) * 2048 * rowlen;
#pragma unroll
            for (int ai = 0; ai < 2; ++ai)
#pragma unroll
                for (int m = 0; m < 4; ++m) { const int row = u.pm * BM + ai * HALF + wr * 64 + m * 16 + fr, b = row >> 11, s = row & 2047;
                    const f32x4 v0 = acc[ai][bj][m][0], v1 = acc[ai][bj][m][1];
                    u32x4 w; w.x = cvt_pk_bf16(v0[0], v0[1]); w.y = cvt_pk_bf16(v0[2], v0[3]); w.z = cvt_pk_bf16(v1[0], v1[1]); w.w = cvt_pk_bf16(v1[2], v1[3]);
                    *(u32x4*)(base + (size_t)b * bstride + (size_t)s * rowlen) = w; } }
    }
};
struct MoeOrder {
    const PG8_LAS int* tile_e; const PG8_LAS unsigned short* rowtab; int ntn, nunits, G, c; unsigned rowbytes; int rev;
    __device__ __forceinline__ bool next(int i, Unit& u) const {
        const int L = i * G + c; if (L >= nunits) return false;
        const int pm0 = L / ntn, pl = L - pm0 * ntn, pm = rev ? rev - 1 - pm0 : pm0; u.pm = pm; u.pn = tile_e[pm] * ntn + pl; u.slot = i; return true;
    }
    __device__ __forceinline__ unsigned rowoff(const Unit& u, int r) const { return (rowtab ? (unsigned)rowtab[u.slot * 256 + r] : (unsigned)(u.pm * 256 + r)) * rowbytes; }
    __device__ __forceinline__ void a_ready(const Unit&) const {}
    __device__ __forceinline__ void done(const Unit&) const {}
};
template <bool OUT8> struct EpiAct {
    static constexpr bool PERM = true, AFTER_DRAIN = false, HAS_INIT = true, INIT_LOADS = false;
    unsigned char* ACT; const PG8_LAS float* biastab; float oscale;
    __device__ __forceinline__ void init(f32x4 (&acc)[2][2][4][2], const Unit& u, int wr, int wc, int fr, int fq) const {
#pragma unroll
        for (int n = 0; n < 2; ++n) { const f32x4 bg = *(const PG8_LAS f32x4*)(biastab + u.slot * 256 + wc * 32 + 8 * fq + 4 * n), bu = *(const PG8_LAS f32x4*)(biastab + u.slot * 256 + 128 + wc * 32 + 8 * fq + 4 * n);
#pragma unroll
            for (int ai = 0; ai < 2; ++ai)
#pragma unroll
                for (int m = 0; m < 4; ++m) { acc[ai][0][m][n] = bg; acc[ai][1][m][n] = bu; } }
    }
    __device__ __forceinline__ void operator()(const f32x4 (&acc)[2][2][4][2], const Unit& u, int wr, int wc, int fr, int fq) const {
        const int pl = u.pn & 7; const int row0 = u.pm * BM + wr * 64 + fr, acol0 = pl * 128 + wc * 32 + 8 * fq;
#pragma unroll
        for (int ai = 0; ai < 2; ++ai)
#pragma unroll
            for (int m = 0; m < 4; ++m) { unsigned char* rowp = ACT + (size_t)(row0 + ai * HALF + m * 16) * 1024 + acol0; f32x4 a4[2];
#pragma unroll
                for (int n = 0; n < 2; ++n) { const f32x4 g4 = acc[ai][0][m][n], u4 = acc[ai][1][m][n]; f32x4 gl, ul, ex;
#pragma unroll
                    for (int j = 0; j < 4; ++j) { gl[j] = fminf(g4[j], 7.0f); ul[j] = __builtin_amdgcn_fmed3f(u4[j], -7.0f, 7.0f); }
                    const f32x4 t4 = gl * (-1.702f * 1.44269504089f);
#pragma unroll
                    for (int j = 0; j < 4; ++j) ex[j] = __builtin_amdgcn_exp2f(t4[j]);
                    const f32x4 d4 = ex + 1.0f; f32x4 s4;
#pragma unroll
                    for (int j = 0; j < 4; ++j) s4[j] = __builtin_amdgcn_rcpf(d4[j]);
                    a4[n] = (gl * s4) * (ul * oscale + oscale); }
                if constexpr (OUT8) { int p0 = 0, p1 = 0; p0 = __builtin_amdgcn_cvt_pk_fp8_f32(a4[0][0], a4[0][1], p0, false); p0 = __builtin_amdgcn_cvt_pk_fp8_f32(a4[0][2], a4[0][3], p0, true);
                    p1 = __builtin_amdgcn_cvt_pk_fp8_f32(a4[1][0], a4[1][1], p1, false); p1 = __builtin_amdgcn_cvt_pk_fp8_f32(a4[1][2], a4[1][3], p1, true);
                    *(unsigned long long*)rowp = (unsigned long long)(unsigned)p0 | ((unsigned long long)(unsigned)p1 << 32); }
                else { u32x4 w; w.x = cvt_pk_bf16(a4[0][0], a4[0][1]); w.y = cvt_pk_bf16(a4[0][2], a4[0][3]); w.z = cvt_pk_bf16(a4[1][0], a4[1][1]); w.w = cvt_pk_bf16(a4[1][2], a4[1][3]); *(u32x4*)(rowp + (size_t)(row0 + ai * HALF + m * 16) * 1024 + acol0) = w; } }
    }
};
struct EpiDown {
    static constexpr bool PERM = true, AFTER_DRAIN = false, HAS_INIT = true, INIT_LOADS = false;
    unsigned char* YK; const PG8_LAS int* tktab; const PG8_LAS float* biastab; float oscale;
    __device__ __forceinline__ void init(f32x4 (&acc)[2][2][4][2], const Unit& u, int wr, int wc, int fr, int fq) const {
#pragma unroll
        for (int bj = 0; bj < 2; ++bj)
#pragma unroll
            for (int n = 0; n < 2; ++n) { const f32x4 bv = *(const PG8_LAS f32x4*)(biastab + u.slot * 256 + 64 * wc + 16 * fq + 8 * bj + 4 * n) * oscale;
#pragma unroll
                for (int ai = 0; ai < 2; ++ai)
#pragma unroll
                    for (int m = 0; m < 4; ++m) acc[ai][bj][m][n] = bv; }
    }
    __device__ __forceinline__ void operator()(const f32x4 (&acc)[2][2][4][2], const Unit& u, int wr, int wc, int fr, int fq) const {
        const int pl = u.pn & 3; const int col0 = pl * BM + 64 * wc + 16 * fq;
#pragma unroll
        for (int ai = 0; ai < 2; ++ai)
#pragma unroll
            for (int m = 0; m < 4; ++m) { const int tk = tktab[u.slot * 256 + ai * HALF + wr * 64 + m * 16 + fr];
                if (tk >= 0) { unsigned char* rowp = YK + (size_t)tk * 1024 + col0; int p[4];
#pragma unroll
                    for (int bj = 0; bj < 2; ++bj) { f32x4 v0 = acc[ai][bj][m][0], v1 = acc[ai][bj][m][1];
#pragma unroll
                        for (int j = 0; j < 4; ++j) { v0[j] = __builtin_amdgcn_fmed3f(v0[j], -448.f, 448.f); v1[j] = __builtin_amdgcn_fmed3f(v1[j], -448.f, 448.f); }
                        int p0 = 0, p1 = 0; p0 = __builtin_amdgcn_cvt_pk_fp8_f32(v0[0], v0[1], p0, false); p0 = __builtin_amdgcn_cvt_pk_fp8_f32(v0[2], v0[3], p0, true);
                        p1 = __builtin_amdgcn_cvt_pk_fp8_f32(v1[0], v1[1], p1, false); p1 = __builtin_amdgcn_cvt_pk_fp8_f32(v1[2], v1[3], p1, true);
                        p[2 * bj] = p0; p[2 * bj + 1] = p1; }
                    u32x4 w; w.x = (unsigned)p[0]; w.y = (unsigned)p[1]; w.z = (unsigned)p[2]; w.w = (unsigned)p[3];
                    *(u32x4*)rowp = w; } }
    }
};

template <class Epi, class Sched, bool ALIGN_EPI = false, bool SP2 = false, bool GATHER = false, int SCW = 0, int SCX = 0>
__device__ __forceinline__ void gemm_phase(PG8_LAS unsigned char* lds, const Gemm g, const Sched& S, const Epi& E, const int tid) {
    const int wid = __builtin_amdgcn_readfirstlane(tid >> 6), lane = tid & 63, wr = wid >> 2, wc = wid & 3, fr = lane & 15, fq = lane >> 4;
    const int K = g.K, nt = K / BK;
    unsigned voffA[2], voffB[2]; int RA[2]; unsigned CA2[2]; unsigned va0[2] = {0u, 0u}, va1[2] = {0u, 0u};
#pragma unroll
    for (int i = 0; i < 2; ++i) { int R, C; stage_rc(tid * 16 + i * 8192, R, C); const int Rb = Epi::PERM ? ((R & ~31) + perm32(R & 31)) : R;
        voffA[i] = (unsigned)(R * K + C) * 2u; voffB[i] = (unsigned)(Rb * K + C) * 2u; RA[i] = R; CA2[i] = (unsigned)C * 2u; }
    static_assert(!GATHER || SP2, "the gathered-A form exists for the SP2 loop only");
    const char* const gA0 = (const char*)g.A;
#define PG8_VA(u) do { int l_; asm volatile("v_mbcnt_lo_u32_b32 %0, -1, 0\n\tv_mbcnt_hi_u32_b32 %0, -1, %0" : "=v"(l_)); const int t_ = wid * 64 + l_;     \
        _Pragma("unroll") for (int _i = 0; _i < 2; ++_i) { int R_, C_; stage_rc(t_ * 16 + _i * 8192, R_, C_); va0[_i] = S.rowoff((u), R_) + (unsigned)C_ * 2u; va1[_i] = S.rowoff((u), HALF + R_) + (unsigned)C_ * 2u; } } while (0)
#define PG8_STA(bufoff, base_ng, base_g, h) do { if constexpr (GATHER) { if (h) PG8_STAGE(bufoff, base_g, va1); else PG8_STAGE(bufoff, base_g, va0); } else PG8_STAGE(bufoff, base_ng, voffA); } while (0)
    const size_t kstep = (size_t)(BK * 2);
    const size_t hstep = (size_t)HALF * K * 2;
    const size_t tstep = 2 * hstep;
    const unsigned ldsw = (unsigned)wid * 1024u;
    const int aoff = lds_byte(wr * 64 + fr, fq * 8), boff = lds_byte(wc * 32 + fr, fq * 8);
#define PG8_SA(b, h) (((b) * 2 + (h)) * HTB)
#define PG8_SB(b, h) ((4 + (b) * 2 + (h)) * HTB)
#define PG8_STAGE(bufoff, gbase, voff) do { _Pragma("unroll") for (int _i = 0; _i < 2; ++_i) \
        __builtin_amdgcn_global_load_lds((const unsigned*)((const char*)(gbase) + (voff)[_i]), (PG8_LAS unsigned*)(lds + (bufoff) + ldsw + _i * 8192), 16, 0, 0); } while (0)
#define PG8_LDA(dst, b, h) do { if constexpr (SCW != 0) { _Pragma("unroll") for (int m = 0; m < 4; ++m) dst##8[m] = PG8_CAT8(*(const PG8_LAS bf16x8*)(lds + PG8_SA(b, h) + aoff + m * 2048), *(const PG8_LAS bf16x8*)(lds + PG8_SA(b, h) + aoff + m * 2048 + 1024)); } \
        else { _Pragma("unroll") for (int m = 0; m < 4; ++m) _Pragma("unroll") for (int k = 0; k < 2; ++k) dst[m][k] = *(const PG8_LAS bf16x8*)(lds + PG8_SA(b, h) + aoff + m * 2048 + k * 1024); } } while (0)
#define PG8_LDB(dst, b, h) do { if constexpr (SCW != 0) { _Pragma("unroll") for (int n = 0; n < 2; ++n) dst##8[n] = PG8_CAT8(*(const PG8_LAS bf16x8*)(lds + PG8_SB(b, h) + boff + n * 2048), *(const PG8_LAS bf16x8*)(lds + PG8_SB(b, h) + boff + n * 2048 + 1024)); } \
        else { _Pragma("unroll") for (int n = 0; n < 2; ++n) _Pragma("unroll") for (int k = 0; k < 2; ++k) dst[n][k] = *(const PG8_LAS bf16x8*)(lds + PG8_SB(b, h) + boff + n * 2048 + k * 1024); } } while (0)
#define PG8_CAT8(lo, hi) __builtin_shufflevector(__builtin_bit_cast(i32x4_t, (lo)), __builtin_bit_cast(i32x4_t, (hi)), 0, 1, 2, 3, 4, 5, 6, 7)
#define PG8_MMA(ai, bj, At, Bt) do { __builtin_amdgcn_s_setprio(1); _Pragma("unroll") for (int m = 0; m < 4; ++m) _Pragma("unroll") for (int n = 0; n < 2; ++n) { \
        if constexpr (SCW != 0) acc[ai][bj][m][n] = __builtin_amdgcn_mfma_scale_f32_16x16x128_f8f6f4(Bt##8[n], At##8[m], acc[ai][bj][m][n], 0, 0, 0, SCW, 0, SCX); \
        else { _Pragma("unroll") for (int k = 0; k < 2; ++k) acc[ai][bj][m][n] = __builtin_amdgcn_mfma_f32_16x16x32_bf16(Bt[n][k], At[m][k], acc[ai][bj][m][n], 0, 0, 0); } } __builtin_amdgcn_s_setprio(0); } while (0)
#define PG8_WAIT_V(n) asm volatile("s_waitcnt vmcnt(" #n ")" ::: "memory")
#define PG8_WAIT_L(n) asm volatile("s_waitcnt lgkmcnt(" #n ")" ::: "memory")
#define PG8_BAR __builtin_amdgcn_s_barrier()
#define PG8_SCHED __builtin_amdgcn_sched_barrier(0)
    Unit cur, nxt; int ui = 0;
    if (!S.next(0, cur)) return;
    f32x4 acc[2][2][4][2];
    if constexpr (Epi::HAS_INIT) { E.init(acc, cur, wr, wc, fr, fq); if constexpr (Epi::INIT_LOADS) __builtin_amdgcn_s_waitcnt(0x0F70); }
    else {
#pragma unroll
    for (int a = 0; a < 2; ++a)
#pragma unroll
        for (int b = 0; b < 2; ++b)
#pragma unroll
            for (int m = 0; m < 4; ++m)
#pragma unroll
                for (int n = 0; n < 2; ++n) acc[a][b][m][n] = (f32x4){0.f, 0.f, 0.f, 0.f};
    }
    bf16x8 At[4][2], B0[2][2], B1[2][2]; i32x8_t At8[4], B08[2], B18[2];
    const char* cA = (const char*)g.A + (size_t)cur.pm * tstep; const char* cB = (const char*)g.Bt + (size_t)cur.pn * tstep;
    S.a_ready(cur);
    if constexpr (SP2) {
        if constexpr (GATHER) PG8_VA(cur);
        PG8_STAGE(PG8_SB(0, 0), cB, voffB); PG8_STAGE(PG8_SB(0, 1), cB + hstep, voffB); PG8_STA(PG8_SA(0, 0), cA, gA0, 0); PG8_STA(PG8_SA(0, 1), cA + hstep, gA0, 1);
        if (wr == 1) PG8_BAR;
        PG8_WAIT_V(2); PG8_BAR;
        PG8_STAGE(PG8_SB(1, 0), cB + kstep, voffB); PG8_STA(PG8_SA(1, 0), cA + kstep, gA0 + kstep, 0); PG8_STAGE(PG8_SB(1, 1), cB + hstep + kstep, voffB);
        PG8_WAIT_V(6); PG8_BAR;
    } else {
        PG8_STAGE(PG8_SB(0, 0), cB, voffB); PG8_STAGE(PG8_SA(0, 0), cA, voffA); PG8_STAGE(PG8_SB(0, 1), cB + hstep, voffB); PG8_STAGE(PG8_SA(0, 1), cA + hstep, voffA);
        if (wr == 1) PG8_BAR;
        PG8_WAIT_V(4); PG8_BAR;
        PG8_STAGE(PG8_SB(1, 0), cB + kstep, voffB); PG8_STAGE(PG8_SA(1, 0), cA + kstep, voffA); PG8_STAGE(PG8_SB(1, 1), cB + hstep + kstep, voffB);
        PG8_WAIT_V(6); PG8_BAR;
    }
    for (;;) {
        const bool has_next = S.next(ui + 1, nxt);
        const char* nA = has_next ? (const char*)g.A + (size_t)nxt.pm * tstep : cA; const char* nB = has_next ? (const char*)g.Bt + (size_t)nxt.pn * tstep : cB;
        _Pragma("nounroll") for (int t = 0; t < nt; t += 2) {
            const bool last = (t == nt - 2);
            const char* a1 = cA + (size_t)(t + 1) * kstep;
            const char* a2 = last ? nA : cA + (size_t)(t + 2) * kstep; const char* b2 = last ? nB : cB + (size_t)(t + 2) * kstep;
            const char* a3 = a2 + kstep; const char* b3 = b2 + kstep;
            if (last && has_next) S.a_ready(nxt);
            const char* const g1 = gA0 + (size_t)(t + 1) * kstep; const char* const g2 = last ? gA0 : gA0 + (size_t)(t + 2) * kstep; const char* const g3 = g2 + kstep;
            if constexpr (SP2) {
            PG8_LDB(B0, 0, 0); PG8_LDB(B1, 0, 1); PG8_SCHED; PG8_LDA(At, 0, 0); PG8_STA(PG8_SA(1, 1), a1 + hstep, g1, 1);
            PG8_WAIT_V(8); PG8_WAIT_L(0); PG8_BAR; PG8_MMA(0, 0, At, B0); PG8_MMA(0, 1, At, B1); PG8_BAR; PG8_SCHED;
            if constexpr (GATHER) { if (last && has_next) PG8_VA(nxt); }
            PG8_LDA(At, 0, 1); PG8_STAGE(PG8_SB(0, 0), b2, voffB); PG8_STAGE(PG8_SB(0, 1), b2 + hstep, voffB); PG8_STA(PG8_SA(0, 0), a2, g2, 0);
            PG8_WAIT_V(8); PG8_WAIT_L(0); PG8_BAR; PG8_MMA(1, 0, At, B0); PG8_MMA(1, 1, At, B1); PG8_BAR; PG8_SCHED;
            PG8_LDB(B0, 1, 0); PG8_LDB(B1, 1, 1); PG8_SCHED; PG8_LDA(At, 1, 0); PG8_STA(PG8_SA(0, 1), a2 + hstep, g2, 1);
            PG8_WAIT_V(8); PG8_WAIT_L(0); PG8_BAR; PG8_MMA(0, 0, At, B0); PG8_MMA(0, 1, At, B1); PG8_BAR; PG8_SCHED;
            PG8_LDA(At, 1, 1); PG8_STAGE(PG8_SB(1, 0), b3, voffB); PG8_STAGE(PG8_SB(1, 1), b3 + hstep, voffB); PG8_STA(PG8_SA(1, 0), a3, g3, 0);
            PG8_WAIT_V(8); PG8_WAIT_L(0); PG8_BAR; PG8_MMA(1, 0, At, B0); PG8_MMA(1, 1, At, B1); PG8_BAR; PG8_SCHED;
            } else {
            PG8_LDB(B0, 0, 0); PG8_SCHED; PG8_LDA(At, 0, 0); PG8_STAGE(PG8_SA(1, 1), a1 + hstep, voffA);
            PG8_WAIT_L(8); PG8_BAR; PG8_WAIT_L(0); PG8_MMA(0, 0, At, B0); PG8_BAR; PG8_SCHED;
            PG8_LDB(B1, 0, 1); PG8_STAGE(PG8_SB(0, 0), b2, voffB);
            PG8_BAR; PG8_WAIT_L(0); PG8_MMA(0, 1, At, B1); PG8_BAR;
            PG8_LDA(At, 0, 1); PG8_STAGE(PG8_SA(0, 0), a2, voffA);
            PG8_BAR; PG8_WAIT_L(0); PG8_MMA(1, 0, At, B0); PG8_BAR; PG8_SCHED;
            PG8_STAGE(PG8_SB(0, 1), b2 + hstep, voffB);
            PG8_WAIT_V(6); PG8_BAR; PG8_MMA(1, 1, At, B1); PG8_BAR;
            PG8_LDB(B0, 1, 0); PG8_SCHED; PG8_LDA(At, 1, 0); PG8_STAGE(PG8_SA(0, 1), a2 + hstep, voffA);
            PG8_WAIT_L(8); PG8_BAR; PG8_WAIT_L(0); PG8_MMA(0, 0, At, B0); PG8_BAR; PG8_SCHED;
            PG8_LDB(B1, 1, 1); PG8_STAGE(PG8_SB(1, 0), b3, voffB);
            PG8_BAR; PG8_WAIT_L(0); PG8_MMA(0, 1, At, B1); PG8_BAR;
            PG8_LDA(At, 1, 1); PG8_STAGE(PG8_SA(1, 0), a3, voffA);
            PG8_BAR; PG8_WAIT_L(0); PG8_MMA(1, 0, At, B0); PG8_BAR; PG8_SCHED;
            PG8_STAGE(PG8_SB(1, 1), b3 + hstep, voffB);
            PG8_WAIT_V(6); PG8_BAR; PG8_MMA(1, 1, At, B1); PG8_BAR;
            }
        }
        if constexpr (ALIGN_EPI) { if (wr == 0) PG8_BAR; }
        if constexpr (!Epi::AFTER_DRAIN) { int fr_ = fr, fq_ = fq; asm volatile("" : "+v"(fr_), "+v"(fq_));
            E(acc, cur, wr, wc, fr_, fq_); S.done(cur); }
        if (!has_next) break;
        if constexpr (Epi::HAS_INIT) { int fr_ = fr, fq_ = fq; asm volatile("" : "+v"(fr_), "+v"(fq_)); E.init(acc, nxt, wr, wc, fr_, fq_); if constexpr (Epi::INIT_LOADS) __builtin_amdgcn_s_waitcnt(0x0F70); }
        else {
#pragma unroll
        for (int a = 0; a < 2; ++a)
#pragma unroll
            for (int b = 0; b < 2; ++b)
#pragma unroll
                for (int m = 0; m < 4; ++m)
#pragma unroll
                    for (int n = 0; n < 2; ++n) acc[a][b][m][n] = (f32x4){0.f, 0.f, 0.f, 0.f};
        }
        cur = nxt; cA = nA; cB = nB; ++ui;
        if constexpr (ALIGN_EPI) { if (wr == 1) PG8_BAR; }
    }
    PG8_WAIT_V(0);
    if constexpr (!ALIGN_EPI) { if (wr == 0) PG8_BAR; }
    PG8_BAR;
    if constexpr (Epi::AFTER_DRAIN) { E.fused(acc, cur, wr, wc, fr, fq, lds, wid, lane); S.done(cur); }
#undef PG8_SA
#undef PG8_CAT8
#undef PG8_VA
#undef PG8_STA
#undef PG8_SB
#undef PG8_STAGE
#undef PG8_LDA
#undef PG8_LDB
#undef PG8_MMA
#undef PG8_WAIT_V
#undef PG8_WAIT_L
#undef PG8_BAR
#undef PG8_SCHED
}
}

#ifndef PG8_SP2
#define PG8_SP2 true
#endif
#ifndef PG8_ALIGN
#define PG8_ALIGN true
#endif
#define GAS __attribute__((address_space(1)))
#define LAS __attribute__((address_space(3)))
typedef unsigned short bf16;
typedef unsigned v4u __attribute__((ext_vector_type(4)));
typedef float f32x4 __attribute__((ext_vector_type(4)));
typedef short bf16x8 __attribute__((ext_vector_type(8)));
typedef GAS unsigned gu32;
typedef GAS unsigned long long gu64;
#define RLX_AGENT __ATOMIC_RELAXED, __HIP_MEMORY_SCOPE_AGENT
#define LDS_WAIT() asm volatile("s_waitcnt lgkmcnt(0)" ::: "memory")
#define VM_WAIT() asm volatile("s_waitcnt vmcnt(0)" ::: "memory")
__device__ __forceinline__ unsigned long long rt() { return __builtin_amdgcn_s_memrealtime(); }
__device__ __forceinline__ unsigned f2bf(float f) { unsigned u = __builtin_bit_cast(unsigned, f); return (u + 0x7fffu + ((u >> 16) & 1u)) >> 16; }
__device__ __forceinline__ unsigned pk2(float lo, float hi) { return f2bf(lo) | (f2bf(hi) << 16); }

#define XB_TMO      128
#define XB_XCNT(j)  (256  + 64 * (j))
#define XB_XSUB(j)  (1280 + 64 * (j))
#define XB_XGEN(j)  (2304 + 64 * (j))
#define XB_TOP      3328
#define XB_TOPGEN   3392
#define XCD_BAR_WORDS 3456
#define XB_SPIN_CAP (1u << 18)

__device__ __forceinline__ unsigned xb_ld(unsigned* p)              { return __hip_atomic_load(p, __ATOMIC_RELAXED, __HIP_MEMORY_SCOPE_AGENT); }
__device__ __forceinline__ unsigned xb_add(unsigned* p, unsigned v) { return __hip_atomic_fetch_add(p, v, __ATOMIC_RELAXED, __HIP_MEMORY_SCOPE_AGENT); }
__device__ __forceinline__ unsigned xb_xcc_id() { return (unsigned)__builtin_amdgcn_s_getreg((3 << 11) | 20) & 0xFu; }
#define XB_SPIN(cond, bar) do { unsigned _sp = 0; while (cond) { __builtin_amdgcn_s_sleep(1); \
    if ((++_sp & 255u) == 0u) { if (xb_ld(&(bar)[XB_TMO])) break; if (_sp > XB_SPIN_CAP) { atomicAdd(&(bar)[XB_TMO], 1u); break; } } } } while (0)

struct XcdBarrier {
    unsigned* bar; unsigned x;
    volatile LAS unsigned* st;
};

__device__ __forceinline__ XcdBarrier xcd_barrier_post(unsigned* bar, volatile LAS unsigned* st) {
    XcdBarrier b; b.bar = bar; b.x = xb_xcc_id(); b.st = st;
    if (threadIdx.x == 0) (void)xb_add(&bar[XB_XCNT(b.x)], 1u);
    return b;
}
__device__ __forceinline__ void xcd_barrier_complete(unsigned* bar, unsigned x, unsigned& nloc, unsigned& nx) {
    const unsigned G = gridDim.x * gridDim.y * gridDim.z;
    unsigned sum, cnt, mine, sp = 0u;
    for (;;) {
        sum = 0u; cnt = 0u; mine = 0u;
#pragma unroll
        for (unsigned j = 0; j < 16; ++j) { const unsigned c = xb_ld(&bar[XB_XCNT(j)]); sum += c; cnt += (c > 0u) ? 1u : 0u; mine = (j == x) ? c : mine; }
        if (sum == G) break;
        __builtin_amdgcn_s_sleep(1);
        if ((++sp & 255u) == 0u) { if (xb_ld(&bar[XB_TMO])) break; if (sp > XB_SPIN_CAP) { atomicAdd(&bar[XB_TMO], 1u); break; } }
    }
    nloc = mine > 0u ? mine : 1u; nx = cnt > 0u ? cnt : 1u;
}

__device__ __forceinline__ void xcd_barrier(const XcdBarrier& b) {
    asm volatile("s_waitcnt vmcnt(0)" ::: "memory");
    __syncthreads();
    if (threadIdx.x == 0) {
        unsigned* bar = b.bar;
        __builtin_amdgcn_s_waitcnt(0);
        unsigned nloc = b.st[0], nx = b.st[1];
        if (nloc == 0u) { xcd_barrier_complete(bar, b.x, nloc, nx); b.st[0] = nloc; b.st[1] = nx; }
        const unsigned old = xb_add(&bar[XB_XSUB(b.x)], 1u);
        const unsigned gen = old / nloc;
        if (old + 1u == (gen + 1u) * nloc) {
            __builtin_amdgcn_fence(__ATOMIC_RELEASE, "agent");
            asm volatile("s_waitcnt vmcnt(0)" ::: "memory");
            const unsigned og = xb_add(&bar[XB_TOP], 1u);
            const unsigned tg = og / nx;
            if (og + 1u == (tg + 1u) * nx) xb_add(&bar[XB_TOPGEN], 1u);
            else XB_SPIN(xb_ld(&bar[XB_TOPGEN]) == tg, bar);
            __builtin_amdgcn_fence(__ATOMIC_ACQUIRE, "agent");
            xb_add(&bar[XB_XGEN(b.x)], 1u);
            asm volatile("s_waitcnt vmcnt(0)" ::: "memory");
        } else {
            XB_SPIN(xb_ld(&bar[XB_XGEN(b.x)]) == gen, bar);
            __builtin_amdgcn_fence(__ATOMIC_ACQUIRE, "agent");
            asm volatile("s_waitcnt vmcnt(0)" ::: "memory");
        }
    }
    __syncthreads();
}

constexpr int NWAVES = 8;
#ifndef MK_ONE_LAUNCH
#define MK_ONE_LAUNCH 1
#endif

constexpr int BATCH = 16, SEQ = 2048, D = 1024, T = BATCH * SEQ;
constexpr int NIN = 3584;
constexpr int OFF_SQ = 0, OFF_SK = 512, OFF_SV = 1024, OFF_HQ = 1536, OFF_HF = 2048, OFF_HI = 2560, OFF_HG = 3072;
constexpr int NE = 32, TOPK = 4, NASSIGN = T * TOPK;
constexpr int MAXTILES = NASSIGN / 256 + NE;
constexpr int MAXROWS = MAXTILES * 256;
constexpr float EPS = 1e-6f;

constexpr size_t MiB = 1u << 20;
constexpr size_t WS_CTL = 0, CTL_ZERO_BYTES = 1 * MiB;
constexpr size_t WS_WIN = 2 * MiB;
constexpr size_t WS_WOUT = 10 * MiB;
constexpr size_t WS_RT = 12 * MiB;
constexpr size_t WS_WGU = 16 * MiB;
constexpr size_t WS_WD = 144 * MiB;
constexpr size_t WS_XN = 208 * MiB;
constexpr size_t WS_P = 272 * MiB;
constexpr size_t WS_PH = WS_P + 96 * MiB;
constexpr size_t WS_MIX = 496 * MiB;
constexpr size_t WS_ACT = 272 * MiB;
constexpr size_t WS_YK = 560 * MiB;
constexpr size_t WS_QN = 624 * MiB;
constexpr size_t WS_KN = 656 * MiB;
constexpr size_t WS_VT = 688 * MiB;
constexpr size_t WS_KVS = 720 * MiB;
constexpr size_t WS_DEC = 784 * MiB;
constexpr size_t WS_SSEG = 786 * MiB;
constexpr size_t WS_DSEG = 802 * MiB;
constexpr size_t WS_LIST = 816 * MiB;
constexpr size_t WS_TOPG = 825 * MiB;
constexpr size_t WS_X8 = 560 * MiB;
constexpr size_t WS_END = 832 * MiB;
static_assert(WS_ACT + (size_t)MAXROWS * 2048 <= WS_YK && WS_YK + (size_t)T * 4 * 2048 <= WS_LIST && WS_MIX + (size_t)T * 2048 <= WS_YK, "d_ws map");
constexpr int CW_TMO = 0, CW_CODE = 1;
constexpr int CW_CNT = 64;
constexpr int CW_BAR = 4096;

constexpr int RING_OFF = 0, RING_BYTES = 131072;
constexpr int RT_ROW = 2064, RT_WL = 32 * RT_ROW, RT_END = 64 * RT_ROW;
constexpr int LDSCTL_OFF = 133120, MISC_OFF = LDSCTL_OFF + 320;
constexpr int LTAB_OFF = LDSCTL_OFF + 512;
constexpr int LT_TS = MAXTILES, LT_CNT = MAXTILES + 32, LT_MISC = MAXTILES + 64, LT_WORDS = MAXTILES + 192;
constexpr int ROWTAB_OFF = LTAB_OFF + LT_WORDS * 4;
constexpr int MAXSLOT = 17;
constexpr int ROWTAB2_OFF = ROWTAB_OFF + MAXSLOT * 1024;
constexpr int LDS_BYTES = ROWTAB2_OFF + MAXSLOT * 512;
static_assert(RT_END <= LDSCTL_OFF && MISC_OFF + 128 <= LTAB_OFF && LDS_BYTES <= 160 * 1024 && (MAXTILES * 8 + 255) / 256 <= MAXSLOT && 2 * ((MAXTILES * 4 + 255) / 256) * 1024 <= MAXSLOT * 1536 && ROWTAB_OFF % 16 == 0, "LDS map");

struct Frame {
    LAS unsigned char* lds;
    volatile LAS unsigned* MISC;
    gu32* ctl;
    int tid, lane, wave, gw, ngw;
    int vcu, G;
    const float *x, *norm1_g, *w_in, *sb_q_g, *sb_k_g, *sb_out_g, *hg_lb, *hg_out_g, *w_out, *norm2_g, *w_router, *b_router, *w_gu, *b_gu, *w_d, *b_d;
    float* out;
    unsigned char* ws;
};
__device__ __forceinline__ float bf2f(unsigned short b) { return __builtin_bit_cast(float, (unsigned)b << 16); }
__device__ __forceinline__ float bflo(unsigned w) { return __builtin_bit_cast(float, w << 16); }
__device__ __forceinline__ float bfhi(unsigned w) { return __builtin_bit_cast(float, w & 0xffff0000u); }
typedef __bf16 bf16x2n_ __attribute__((ext_vector_type(2)));
typedef float f32x2n_ __attribute__((ext_vector_type(2)));
__device__ __forceinline__ unsigned pkbf(float a, float b) { const bf16x2n_ v = __builtin_convertvector((f32x2n_){a, b}, bf16x2n_); return __builtin_bit_cast(unsigned, v); }
__device__ __forceinline__ int lane_id() { int l; asm volatile("v_mbcnt_lo_u32_b32 %0, -1, 0\n\tv_mbcnt_hi_u32_b32 %0, -1, %0" : "=v"(l)); return l; }
__device__ __forceinline__ int vzero() { int z; asm volatile("v_mov_b32 %0, 0" : "=v"(z)); return z; }
__device__ __forceinline__ float wave_sum(float v) {
#pragma unroll
    for (int o = 1; o < 64; o <<= 1) v += __shfl_xor(v, o);
    return v;
}

constexpr float W8_SCALE = 256.f, A8_SCALE = 4.f, Y8_SCALE = 32.f; static_assert(Y8_SCALE == 32.f, "SC_W8Y below is 2^-8 * 32");
constexpr int SC_ONE = 0x7f7f7f7f, SC_W8 = 0x77777777, SC_A8 = 0x7d7d7d7d, SC_W8Y = 0x7c7c7c7c;
struct P0Item { const float* W; bf16* WT; const float* rowscale; int N, k0, n0, drow0, fp8, perm; };
__device__ __forceinline__ void p0_load(const P0Item& it, f32x4 (&v)[16], int lane) {
    const int kr = lane >> 4, nc = 4 * (lane & 15);
#pragma unroll
    for (int i = 0; i < 16; ++i) v[i] = __builtin_nontemporal_load((const f32x4*)(it.W + (size_t)(it.k0 + 4 * i + kr) * it.N + it.n0 + nc));
}
__device__ __forceinline__ void p0_store(const P0Item& it, const f32x4 (&v)[16], LAS unsigned char* scr, int lane) {
    const int kr = lane >> 4, nc = 4 * (lane & 15);
#pragma unroll
    for (int i = 0; i < 16; ++i) { const float sc = it.rowscale ? it.rowscale[it.k0 + 4 * i + kr] : 1.f;
        *(LAS unsigned long long*)(scr + (4 * i + kr) * 136 + 2 * nc) = (unsigned long long)pkbf(v[i].x * sc, v[i].y * sc) | ((unsigned long long)pkbf(v[i].z * sc, v[i].w * sc) << 32); }
    LDS_WAIT(); asm volatile("" ::: "memory");
    const LAS unsigned short* s16 = (const LAS unsigned short*)scr;
    if (it.fp8) { const int p = lane & 3, nr = lane >> 2;
#pragma unroll
        for (int c = 0; c < 4; ++c) { const int n = 16 * c + nr; unsigned val[16];
#pragma unroll
            for (int kk = 0; kk < 16; ++kk) val[kk] = s16[(16 * p + kk) * 68 + n];
            v4u w4;
            w4.x = pg8::pk4_fp8(bflo(val[0]) * W8_SCALE, bflo(val[1]) * W8_SCALE, bflo(val[2]) * W8_SCALE, bflo(val[3]) * W8_SCALE);
            w4.y = pg8::pk4_fp8(bflo(val[4]) * W8_SCALE, bflo(val[5]) * W8_SCALE, bflo(val[6]) * W8_SCALE, bflo(val[7]) * W8_SCALE);
            w4.z = pg8::pk4_fp8(bflo(val[8]) * W8_SCALE, bflo(val[9]) * W8_SCALE, bflo(val[10]) * W8_SCALE, bflo(val[11]) * W8_SCALE);
            w4.w = pg8::pk4_fp8(bflo(val[12]) * W8_SCALE, bflo(val[13]) * W8_SCALE, bflo(val[14]) * W8_SCALE, bflo(val[15]) * W8_SCALE);
            *(GAS v4u*)((unsigned char*)it.WT + (size_t)(it.drow0 + (it.perm == 2 ? 128 * ((n >> 3) & 1) + 8 * (n >> 4) + (n & 7) : n)) * D + it.k0 + 16 * p) = w4; }
    } else { const int p = lane & 7, nr = lane >> 3;
#pragma unroll
        for (int c = 0; c < 8; ++c) { const int n = 8 * c + nr; unsigned val[8];
#pragma unroll
            for (int kk = 0; kk < 8; ++kk) val[kk] = s16[(8 * p + kk) * 68 + n];
            v4u w4; w4.x = val[0] | (val[1] << 16); w4.y = val[2] | (val[3] << 16); w4.z = val[4] | (val[5] << 16); w4.w = val[6] | (val[7] << 16);
            *(GAS v4u*)(it.WT + (size_t)(it.drow0 + (it.perm ? 128 * (n >> 5) + (n & 31) : n)) * D + it.k0 + 8 * p) = w4; } }
    LDS_WAIT(); asm volatile("" ::: "memory");
}
__device__ __forceinline__ void rms_rows2_to_bf16(const float* xa, const float* xb, bool hasb, const float* g, bf16* oa, bf16* ob, int lane) {
    const GAS f32x4* pa = (const GAS f32x4*)xa + lane; const GAS f32x4* pb = (const GAS f32x4*)(hasb ? xb : xa) + lane; const f32x4* gr = (const f32x4*)g + lane;
    f32x4 va[4], vb[4], gg[4]; float sa = 0.f, sb = 0.f;
#pragma unroll
    for (int j = 0; j < 4; ++j) { va[j] = __builtin_nontemporal_load(pa + 64 * j); vb[j] = __builtin_nontemporal_load(pb + 64 * j); gg[j] = gr[64 * j]; }
#pragma unroll
    for (int j = 0; j < 4; ++j) { sa += (va[j].x * va[j].x + va[j].y * va[j].y) + (va[j].z * va[j].z + va[j].w * va[j].w); sb += (vb[j].x * vb[j].x + vb[j].y * vb[j].y) + (vb[j].z * vb[j].z + vb[j].w * vb[j].w); }
    const float ra = 1.f / sqrtf(wave_sum(sa) * (1.f / D) + EPS), rb = 1.f / sqrtf(wave_sum(sb) * (1.f / D) + EPS);
    GAS unsigned long long* o8a = (GAS unsigned long long*)oa + lane; GAS unsigned long long* o8b = (GAS unsigned long long*)ob + lane;
#pragma unroll
    for (int j = 0; j < 4; ++j) o8a[64 * j] = (unsigned long long)pkbf(va[j].x * ra * gg[j].x, va[j].y * ra * gg[j].y) | ((unsigned long long)pkbf(va[j].z * ra * gg[j].z, va[j].w * ra * gg[j].w) << 32);
    if (hasb) {
#pragma unroll
        for (int j = 0; j < 4; ++j) o8b[64 * j] = (unsigned long long)pkbf(vb[j].x * rb * gg[j].x, vb[j].y * rb * gg[j].y) | ((unsigned long long)pkbf(vb[j].z * rb * gg[j].z, vb[j].w * rb * gg[j].w) << 32); }
}
__device__ __forceinline__ P0Item p0_item(Frame& F, int r) {
    constexpr int I_IN = 16 * (NIN / 64), I_OUT = 16 * 16, I_GU = NE * 16 * 32;
    P0Item it;
    if (r < I_IN) { const int nb = NIN / 64, kb = r / nb, nn = r % nb; const int pq = nn < 16; it = P0Item{F.w_in, (bf16*)(F.ws + WS_WIN), nullptr, NIN, 64 * kb, 64 * nn, pq ? 256 * (nn >> 2) + 32 * (nn & 3) : 64 * nn, 0, pq}; return it; } r -= I_IN;
    if (r < I_OUT) { const int kb = r / 16, nn = r % 16; it = P0Item{F.w_out, (bf16*)(F.ws + WS_WOUT), nullptr, D, 64 * kb, 64 * nn, 64 * nn, 0, 0}; return it; } r -= I_OUT;
    if (r < I_GU) { const int e = r / 512, q = r % 512, kb = q / 32, nn = q % 32;
        const int isup = nn >> 4, a = (nn & 15) * 64;
        it = P0Item{F.w_gu + (size_t)e * D * 2048, (bf16*)(F.ws + WS_WGU + (size_t)e * 2048 * D), F.norm2_g, 2048, 64 * kb, 64 * nn, 256 * (a >> 7) + 128 * isup + (a & 127), 1, 0}; return it; } r -= I_GU;
    { const int e = r / 256, q = r % 256, kb = q / 16, nn = q % 16;
        it = P0Item{F.w_d + (size_t)e * D * D, (bf16*)(F.ws + WS_WD + (size_t)e * D * D), nullptr, D, 64 * kb, 64 * nn, 256 * (nn >> 2) + 32 * (nn & 3), 1, 2}; return it; }
}
constexpr int P0_NITEMS = 16 * (NIN / 64) + 16 * 16 + NE * 16 * 32 + NE * 16 * 16;
constexpr int P0_NLATE = 1024;
__device__ __forceinline__ void p0_items(Frame& F, int lo, int hi, int w, int nw) {
    LAS unsigned char* scr = F.lds + RING_OFF + F.wave * 16384;
    f32x4 va[16], vb[16]; int it = lo + w;
    if (it < hi) { P0Item A = p0_item(F, it); p0_load(A, va, F.lane);
        for (;;) {
            const int itb = it + nw; const bool hb = itb < hi; const P0Item B = p0_item(F, hb ? itb : it); p0_load(B, vb, F.lane); __builtin_amdgcn_sched_barrier(0);
            p0_store(A, va, scr, F.lane);
            if (!hb) break;
            it = itb + nw; const bool ha = it < hi; A = p0_item(F, ha ? it : itb); p0_load(A, va, F.lane); __builtin_amdgcn_sched_barrier(0);
            p0_store(B, vb, scr, F.lane);
            if (!ha) break;
        }
    }
}
__device__ __forceinline__ void p0_prologue(Frame& F) {
    p0_items(F, 0, P0_NITEMS - P0_NLATE, F.gw, F.ngw);
    for (int q = blockIdx.x * (NWAVES * 64) + F.tid; q < 4096; q += F.G * NWAVES * 64) {
        const int e = q & 31, k0 = (q >> 5) * 8; unsigned hi[8], lo[8];
#pragma unroll
        for (int j = 0; j < 8; ++j) { const float w = F.w_router[(k0 + j) * 32 + e] * F.norm2_g[k0 + j]; hi[j] = pkbf(w, 0.f) & 0xffffu; lo[j] = pkbf(w - bflo(hi[j]), 0.f) & 0xffffu; }
        const v4u h4 = {hi[0] | (hi[1] << 16), hi[2] | (hi[3] << 16), hi[4] | (hi[5] << 16), hi[6] | (hi[7] << 16)}, l4 = {lo[0] | (lo[1] << 16), lo[2] | (lo[3] << 16), lo[4] | (lo[5] << 16), lo[6] | (lo[7] << 16)};
        *(GAS v4u*)(F.ws + WS_RT + e * RT_ROW + 2 * k0) = h4; *(GAS v4u*)(F.ws + WS_RT + RT_WL + e * RT_ROW + 2 * k0) = l4; }
    for (int m = F.gw; m < T; m += 2 * F.ngw) rms_rows2_to_bf16(F.x + (size_t)m * D, F.x + (size_t)(m + F.ngw) * D, m + F.ngw < T, F.norm1_g, (bf16*)(F.ws + WS_XN) + (size_t)m * D, (bf16*)(F.ws + WS_XN) + (size_t)(m + F.ngw) * D, F.lane);
}

typedef float f32x16 __attribute__((ext_vector_type(16)));
typedef __bf16 bf16x2n __attribute__((ext_vector_type(2)));
typedef float f32x2n __attribute__((ext_vector_type(2)));
#define MFMA32(a, b, c) __builtin_amdgcn_mfma_f32_32x32x16_bf16((a), (b), (c), 0, 0, 0)
__device__ __forceinline__ bf16x8 pack8(float a0, float a1, float a2, float a3, float a4, float a5, float a6, float a7) { const v4u p = {pkbf(a0, a1), pkbf(a2, a3), pkbf(a4, a5), pkbf(a6, a7)}; return __builtin_bit_cast(bf16x8, p); }
constexpr float QSCALE = 0.125f * 1.44269504089f;
__device__ __forceinline__ void prep_phase(Frame& F) {
    LAS unsigned* tl = (LAS unsigned*)(F.lds + RING_OFF + F.wave * 16384);
    const bf16* P = (const bf16*)(F.ws + WS_P); bf16* Qn = (bf16*)(F.ws + WS_QN); bf16* Kn = (bf16*)(F.ws + WS_KN); bf16* VT = (bf16*)(F.ws + WS_VT);
    const int tr = F.lane >> 3, c8 = F.lane & 7;
    for (int it = F.gw; it < 4096; it += F.ngw) {
        const int bh = it & 127, blk = it >> 7, b = bh >> 3, h = bh & 7;
        const bf16* base = P + ((size_t)b * 8 + h) * SEQ * 64 + (size_t)(blk * 64 + tr) * 64 + 8 * c8;
        v4u rv[8];
#pragma unroll
        for (int i = 0; i < 8; ++i) { const bf16* row = base + (size_t)(8 * i) * 64; rv[i] = *(const GAS v4u*)(row + (size_t)2 * 16 * 8 * SEQ * 64); }
        {
#pragma unroll
            for (int i = 0; i < 8; ++i) { LAS unsigned* q = tl + (8 * i + tr) * 33 + 4 * c8; q[0] = rv[i].x; q[1] = rv[i].y; q[2] = rv[i].z; q[3] = rv[i].w; }
            LDS_WAIT(); asm volatile("" ::: "memory");
            const LAS unsigned short* t16 = (const LAS unsigned short*)tl; const int dr = tr;
#define KAP(pos) (((pos) & ~12) | (((pos) & 4) << 1) | (((pos) & 8) >> 1))
            bf16* const obase = VT + ((size_t)bh * 64 + blk * 2 + (c8 >> 2)) * 2048 + ((c8 >> 1) & 1) * 512 + (c8 & 1) * 256;
#pragma unroll
            for (int j = 0; j < 8; ++j) { unsigned val[8];
#pragma unroll
                for (int p = 0; p < 8; ++p) { const int pos = 8 * c8 + p; val[p] = t16[KAP(pos) * 66 + 8 * j + dr]; }
                v4u w4; w4.x = val[0] | (val[1] << 16); w4.y = val[2] | (val[3] << 16); w4.z = val[4] | (val[5] << 16); w4.w = val[6] | (val[7] << 16);
                *(GAS v4u*)(obase + (j >> 2) * 1024 + ((8 * j + dr) & 31) * 8) = w4; }
#undef KAP
            LDS_WAIT(); asm volatile("" ::: "memory");
        }
    }
}

__device__ __forceinline__ int crow16(int i, int hh) { return (i & 3) + 8 * (i >> 2) + 4 * hh; }
__device__ __forceinline__ void attn_item(Frame& F, int bh, int qb, float thr, const bf16x8 (&Lt)[2]) {
    const int r = F.lane & 31, hh = F.lane >> 5, b = bh >> 3, h = bh & 7, q0 = qb * 32;
    const bf16* Qn = (const bf16*)(F.ws + WS_QN); const bf16* Kn = (const bf16*)(F.ws + WS_KN); const bf16* VT = (const bf16*)(F.ws + WS_VT);
    bf16x8 qf[4];
#pragma unroll
    for (int s = 0; s < 4; ++s) qf[s] = *(const GAS bf16x8*)(Qn + ((size_t)bh * 64 + qb) * 2048 + s * 512 + F.lane * 8);
    f32x4 gout[2][4];
#pragma unroll
    for (int db = 0; db < 2; ++db)
#pragma unroll
        for (int gq = 0; gq < 4; ++gq) gout[db][gq] = *(const f32x4*)(F.sb_out_g + h * 64 + 32 * db + 8 * gq + 4 * hh);
    f32x16 O0, O1;
#pragma unroll
    for (int i = 0; i < 16; ++i) { O0[i] = 0.f; O1[i] = 0.f; }
    float carry = 0.f;
    const bf16* kbase = Kn + (size_t)bh * 64 * 2048 + F.lane * 8; const bf16* vbase = VT + (size_t)bh * 64 * 2048 + F.lane * 8;
#define ATT_LOAD(KF, VF, kb_) do { _Pragma("unroll") for (int s_ = 0; s_ < 4; ++s_) KF[s_] = *(const GAS bf16x8*)(kbase + (size_t)(kb_) * 2048 + 512 * s_); \
        _Pragma("unroll") for (int db_ = 0; db_ < 2; ++db_) _Pragma("unroll") for (int ks_ = 0; ks_ < 2; ++ks_) VF[db_][ks_] = *(const GAS bf16x8*)(vbase + (size_t)(kb_) * 2048 + 1024 * db_ + 512 * ks_); } while (0)
#define ATT_BLOCK(KF, VF, kb_) do { const bool diag = ((kb_) == qb); \
        f32x16 z; _Pragma("unroll") for (int i = 0; i < 16; ++i) z[i] = 0.f; \
        _Pragma("unroll") for (int s_ = 0; s_ < 4; ++s_) z = MFMA32(KF[s_], qf[s_], z); \
        float sp[16]; \
        _Pragma("unroll") for (int i = 0; i < 16; ++i) { const float zz = z[i]; float v = fmaxf(zz, 0.f) + __builtin_amdgcn_logf(1.f + __builtin_amdgcn_exp2f(-fabsf(zz))); if (diag && !(crow16(i, hh) < r)) v = 0.f; sp[i] = v; } \
        const bf16x8 sb0 = pack8(sp[0], sp[1], sp[2], sp[3], sp[4], sp[5], sp[6], sp[7]), sb1 = pack8(sp[8], sp[9], sp[10], sp[11], sp[12], sp[13], sp[14], sp[15]); \
        f32x16 Cc; _Pragma("unroll") for (int i = 0; i < 16; ++i) Cc[i] = carry; \
        Cc = MFMA32(Lt[0], sb0, Cc); Cc = MFMA32(Lt[1], sb1, Cc); \
        float w[16]; \
        _Pragma("unroll") for (int i = 0; i < 16; ++i) { float v = __builtin_amdgcn_exp2f(z[i] - Cc[i]); if (diag && !(crow16(i, hh) < r)) v = 0.f; w[i] = v; } \
        const bf16x8 wb0 = pack8(w[0], w[1], w[2], w[3], w[4], w[5], w[6], w[7]), wb1 = pack8(w[8], w[9], w[10], w[11], w[12], w[13], w[14], w[15]); \
        O0 = MFMA32(VF[0][0], wb0, O0); O0 = MFMA32(VF[0][1], wb1, O0); O1 = MFMA32(VF[1][0], wb0, O1); O1 = MFMA32(VF[1][1], wb1, O1); \
        carry = __shfl(Cc[0], r); } while (0)
    bf16x8 kfA[4], vfA[2][2], kfB[4], vfB[2][2];
    ATT_LOAD(kfA, vfA, qb);
    for (int kb = qb; kb >= 0; kb -= 2) {
        ATT_LOAD(kfB, vfB, kb > 0 ? kb - 1 : 0); __builtin_amdgcn_sched_barrier(0);
        ATT_BLOCK(kfA, vfA, kb);
        if (kb == 0 || __all(carry > thr)) break;
        ATT_LOAD(kfA, vfA, kb > 1 ? kb - 2 : 0); __builtin_amdgcn_sched_barrier(0);
        ATT_BLOCK(kfB, vfB, kb - 1);
        if (__all(carry > thr)) break;
    }
#undef ATT_LOAD
#undef ATT_BLOCK
    float ss = 0.f;
#pragma unroll
    for (int i = 0; i < 16; ++i) ss += O0[i] * O0[i] + O1[i] * O1[i];
    ss += __shfl_xor(ss, 32);
    const float rs = 1.f / sqrtf(ss * (1.f / 64.f) + EPS);
    bf16* orow = (bf16*)(F.ws + WS_MIX) + ((size_t)b * SEQ + q0 + r) * D + h * 64;
#pragma unroll
    for (int db = 0; db < 2; ++db) { unsigned op[4][2];
#pragma unroll
        for (int gq = 0; gq < 4; ++gq) { const f32x4 gg = gout[db][gq];
            const float a0 = (db ? O1[4 * gq + 0] : O0[4 * gq + 0]) * rs * gg.x, a1 = (db ? O1[4 * gq + 1] : O0[4 * gq + 1]) * rs * gg.y, a2 = (db ? O1[4 * gq + 2] : O0[4 * gq + 2]) * rs * gg.z, a3 = (db ? O1[4 * gq + 3] : O0[4 * gq + 3]) * rs * gg.w;
            op[gq][0] = pkbf(a0, a1); op[gq][1] = pkbf(a2, a3); }
#pragma unroll
        for (int gp = 0; gp < 2; ++gp) { const auto s0 = __builtin_amdgcn_permlane32_swap(op[2 * gp][0], op[2 * gp + 1][0], false, false), s1 = __builtin_amdgcn_permlane32_swap(op[2 * gp][1], op[2 * gp + 1][1], false, false);
            *(GAS v4u*)(orow + 32 * db + 8 * (2 * gp + hh)) = (v4u){s0[0], s1[0], s0[1], s1[1]}; } }
}
__device__ __forceinline__ void attn_phase(Frame& F) {
    const int r = F.lane & 31, hh = F.lane >> 5;
    float mq = fabsf(F.sb_q_g[F.lane]), mk = fabsf(F.sb_k_g[F.lane]);
#pragma unroll
    for (int o = 1; o < 64; o <<= 1) { mq = fmaxf(mq, __shfl_xor(mq, o)); mk = fmaxf(mk, __shfl_xor(mk, o)); }
    const float thr = 64.f * QSCALE * mq * mk * 1.02f + 151.f;
    bf16x8 Lt[2];
#pragma unroll
    for (int ks = 0; ks < 2; ++ks) { float e[8];
#pragma unroll
        for (int jj = 0; jj < 8; ++jj) e[jj] = (16 * ks + 8 * (jj >> 2) + 4 * hh + (jj & 3) >= r) ? 1.f : 0.f;
        Lt[ks] = pack8(e[0], e[1], e[2], e[3], e[4], e[5], e[6], e[7]); }
    for (int it = F.gw; it < 2048; it += F.ngw) { const int bh = it & 127, j = it >> 7;
        attn_item(F, bh, 63 - j, thr, Lt); attn_item(F, bh, j, thr, Lt); attn_item(F, bh, 47 - j, thr, Lt); attn_item(F, bh, 16 + j, thr, Lt); }
}

constexpr int HG_PART = 0, HG_SSQ = 2048, HG_QE = 4096, HG_KE = HG_QE + 64 * 272, HG_VT = HG_KE + 64 * 272, HG_KST = HG_VT + 128 * 144, HG_ST = HG_KST + 128 * 144, HG_END = HG_ST + 128 * 272;
static_assert(HG_END <= RING_BYTES, "HGRN2 LDS map");
__device__ __forceinline__ float hg_lbound(Frame& F, int h, int d) { const int c = h * 128 + d; return 1.f / (1.f + __expf(F.hg_lb[512 + c] - F.hg_lb[c])); }
__device__ __forceinline__ void hg_gates(Frame& F, const unsigned short (&ffr)[16], float lb, int d, int tq, float (&bb)[16], float (&kk)[16], float& total) {
    float run = 1.f;
#pragma unroll
    for (int i = 0; i < 16; ++i) { const float ff = bf2f(ffr[i]); const float sg = __builtin_amdgcn_rcpf(1.f + __expf(-ff));
        const float f = lb + (1.f - lb) * sg; kk[i] = (1.f - lb) * (1.f - sg); run *= f; bb[i] = run; }
    LAS float* part = (LAS float*)(F.lds + RING_OFF + HG_PART);
    part[tq * 128 + d] = run;
    __syncthreads();
    const float p0 = part[d], p1 = part[128 + d], p2 = part[256 + d], p3 = part[384 + d];
    const float off = (tq > 0 ? p0 : 1.f) * (tq > 1 ? p1 : 1.f) * (tq > 2 ? p2 : 1.f);
    total = (p0 * p1) * (p2 * p3);
#pragma unroll
    for (int i = 0; i < 16; ++i) bb[i] *= off;
}
#define HG_HV() const bf16* const PHp = (const bf16*)(F.ws + WS_PH); \
    const __amdgpu_buffer_rsrc_t rsrcP = __builtin_amdgcn_make_buffer_rsrc((void*)PHp, 0, (int)((size_t)4 * T * 512 * 2), 0x00020000)
#define HG_SOFF(item_, arr_) ((unsigned)((((arr_) * 16 + (((item_) >> 5) >> 2)) * 4 + (((item_) >> 5) & 3)) * SEQ + ((item_) & 31) * 64) * 256u)
#define HG_ARR(col_) ((col_) == OFF_HQ ? 0 : (col_) == OFF_HF ? 1 : (col_) == OFF_HI ? 2 : 3)
#define HG_LOADT(dst2, item_, arr_) do { const unsigned so_ = (unsigned)__builtin_amdgcn_readfirstlane((int)HG_SOFF(item_, arr_)); _Pragma("unroll") for (int j_ = 0; j_ < 2; ++j_) \
        (dst2)[j_] = __builtin_bit_cast(v4u, __builtin_amdgcn_raw_buffer_load_b128(rsrcP, (unsigned)F.tid * 16u + 8192u * j_, so_, 0)); } while (0)
#define HG_PUT(src2, raw_) do { _Pragma("unroll") for (int j_ = 0; j_ < 2; ++j_) *(LAS v4u*)((raw_) + ((F.tid >> 4) + 32 * j_) * 272 + (F.tid & 15) * 16) = (src2)[j_]; } while (0)
#define HG_COL(dst, raw_) do { _Pragma("unroll") for (int i_ = 0; i_ < 16; ++i_) dst[i_] = *(const LAS unsigned short*)((raw_) + (16 * tq + i_) * 272 + 2 * d); } while (0)
template <bool PERMUTE> __device__ __forceinline__ void st16(LAS unsigned char* dst, const float (&v)[16]) {
    v4u a, b2;
    if (!PERMUTE) { a.x = pkbf(v[0], v[1]); a.y = pkbf(v[2], v[3]); a.z = pkbf(v[4], v[5]); a.w = pkbf(v[6], v[7]); b2.x = pkbf(v[8], v[9]); b2.y = pkbf(v[10], v[11]); b2.z = pkbf(v[12], v[13]); b2.w = pkbf(v[14], v[15]); }
    else { a.x = pkbf(v[0], v[1]); a.y = pkbf(v[2], v[3]); a.z = pkbf(v[8], v[9]); a.w = pkbf(v[10], v[11]); b2.x = pkbf(v[4], v[5]); b2.y = pkbf(v[6], v[7]); b2.z = pkbf(v[12], v[13]); b2.w = pkbf(v[14], v[15]); }
    *(LAS v4u*)dst = a; *(LAS v4u*)(dst + 16) = b2;
}
__device__ __forceinline__ void hgA_phase(Frame& F) {
    const int d = F.tid & 127, tq = F.tid >> 7, r = F.lane & 31, hh = F.lane >> 5;
    const bf16* P = (const bf16*)(F.ws + WS_P); bf16* KVS = (bf16*)(F.ws + WS_KVS); float* DEC = (float*)(F.ws + WS_DEC); float* SSEG = (float*)(F.ws + WS_SSEG); float* DSEG = (float*)(F.ws + WS_DSEG);
    LAS unsigned char* L = F.lds + RING_OFF; LAS float* decl = (LAS float*)(L + HG_SSQ);
    HG_HV();
    v4u rf[2], rv[2];
    LAS unsigned char* const RAWF = F.lds + ROWTAB_OFF; LAS unsigned char* const RAWV = L + HG_ST;
    for (int wg = blockIdx.x; wg < 256; wg += F.G) {
        const int bh = wg >> 2, seg = wg & 3, item0 = bh * 32 + seg * 8, h = bh & 3;
        HG_LOADT(rf, item0, 1); HG_LOADT(rv, item0, 2);
        const float lbv = hg_lbound(F, h, d); float totrun = 1.f;
        const int db = F.wave & 3, eb0 = 2 * (F.wave >> 2);
        f32x16 run0, run1;
#pragma unroll
        for (int i = 0; i < 16; ++i) { run0[i] = 0.f; run1[i] = 0.f; }
      for (int k = 0; k < 8; ++k) {
        const int item = item0 + k;
        HG_PUT(rf, RAWF); HG_PUT(rv, RAWV);
        __syncthreads();
        { const int nit = k < 7 ? item + 1 : item; HG_LOADT(rf, nit, 1); HG_LOADT(rv, nit, 2); __builtin_amdgcn_sched_barrier(0); }
        unsigned short ffr[16], vr[16]; HG_COL(ffr, RAWF); HG_COL(vr, RAWV);
        float bb[16], kk[16], total; hg_gates(F, ffr, lbv, d, tq, bb, kk, total);
        float ks[16], vv[16];
#pragma unroll
        for (int i = 0; i < 16; ++i) { ks[i] = kk[i] * (total * __builtin_amdgcn_rcpf(bb[i])); vv[i] = bf2f(vr[i]); }
        st16<false>(L + HG_KST + d * 144 + tq * 32, ks); st16<false>(L + HG_VT + d * 144 + tq * 32, vv);
        const float dc = total; totrun *= total;
        if (tq == 0) { DEC[(size_t)item * 128 + d] = dc; decl[d] = dc; }
        __syncthreads();
        f32x16 acc0, acc1;
#pragma unroll
        for (int i = 0; i < 16; ++i) { acc0[i] = 0.f; acc1[i] = 0.f; }
#pragma unroll
        for (int s = 0; s < 4; ++s) { const bf16x8 af = *(const LAS bf16x8*)(L + HG_KST + (db * 32 + r) * 144 + 32 * s + 16 * hh);
            const bf16x8 b0 = *(const LAS bf16x8*)(L + HG_VT + (eb0 * 32 + r) * 144 + 32 * s + 16 * hh), b1 = *(const LAS bf16x8*)(L + HG_VT + ((eb0 + 1) * 32 + r) * 144 + 32 * s + 16 * hh);
            acc0 = MFMA32(af, b0, acc0); acc1 = MFMA32(af, b1, acc1); }
#pragma unroll
        for (int g = 0; g < 4; ++g) { const f32x4 dl = *(const LAS f32x4*)(decl + db * 32 + 8 * g + 4 * hh);
#pragma unroll
            for (int ii = 0; ii < 4; ++ii) { run0[4 * g + ii] = dl[ii] * run0[4 * g + ii] + acc0[4 * g + ii]; run1[4 * g + ii] = dl[ii] * run1[4 * g + ii] + acc1[4 * g + ii]; } }
#pragma unroll
        for (int j = 0; j < 2; ++j) { bf16* dst = KVS + ((size_t)item * 128 + (eb0 + j) * 32 + r) * 128 + db * 32;
#pragma unroll
            for (int gp = 0; gp < 2; ++gp) { unsigned pk[2][2];
#pragma unroll
                for (int q = 0; q < 2; ++q) { const int g = 2 * gp + q; const float a0 = j ? acc1[4 * g + 0] : acc0[4 * g + 0], a1 = j ? acc1[4 * g + 1] : acc0[4 * g + 1], a2 = j ? acc1[4 * g + 2] : acc0[4 * g + 2], a3 = j ? acc1[4 * g + 3] : acc0[4 * g + 3];
                    pk[q][0] = pkbf(a0, a1); pk[q][1] = pkbf(a2, a3); }
                const auto s0 = __builtin_amdgcn_permlane32_swap(pk[0][0], pk[1][0], false, false), s1 = __builtin_amdgcn_permlane32_swap(pk[0][1], pk[1][1], false, false);
                const v4u w4 = {s0[0], s1[0], s0[1], s1[1]};
                *(GAS v4u*)(dst + 8 * (2 * gp + hh)) = w4; } }
        __syncthreads();
      }
#pragma unroll
        for (int j = 0; j < 2; ++j) { float* dst = SSEG + ((size_t)wg * 128 + (eb0 + j) * 32 + r) * 128 + db * 32 + 4 * hh;
#pragma unroll
            for (int g = 0; g < 4; ++g) *(GAS f32x4*)(dst + 8 * g) = j ? (f32x4){run1[4 * g + 0], run1[4 * g + 1], run1[4 * g + 2], run1[4 * g + 3]} : (f32x4){run0[4 * g + 0], run0[4 * g + 1], run0[4 * g + 2], run0[4 * g + 3]}; }
        if (tq == 0) DSEG[(size_t)wg * 128 + d] = totrun;
    }
}
constexpr int HG_DECS = HG_END;
static_assert(HG_DECS + 4096 + 64 * 272 <= LDSCTL_OFF && HG_KST + 64 * 272 <= HG_ST && 64 * 272 <= MAXSLOT * 1536, "HGRN2 LDS map (decays, raw tiles)");
__device__ __forceinline__ void hgC_phase(Frame& F) {
    const int d = F.tid & 127, tq = F.tid >> 7, r = F.lane & 31, hh = F.lane >> 5;
    const bf16* P = (const bf16*)(F.ws + WS_P); const bf16* KVS = (const bf16*)(F.ws + WS_KVS); bf16* MIX = (bf16*)(F.ws + WS_MIX); const float* DEC = (const float*)(F.ws + WS_DEC);
    HG_HV();
    LAS unsigned char* L = F.lds + RING_OFF; const LAS float* decs = (const LAS float*)(L + HG_DECS);
    const int se = F.tid >> 2, sq = F.tid & 3;
    v4u rf[2], rq[2], rv[2], st[4];
    LAS unsigned char* const RAWF = L + HG_KST; LAS unsigned char* const RAWQ = F.lds + ROWTAB_OFF; LAS unsigned char* const RAWV = L + HG_DECS + 4096;
    const __amdgpu_buffer_rsrc_t rsrcG = __builtin_amdgcn_make_buffer_rsrc((void*)F.hg_out_g, 0, 512 * 4, 0x00020000), rsrcSS = __builtin_amdgcn_make_buffer_rsrc((void*)(F.ws + WS_SSEG), 0, 256 * 128 * 128 * 4, 0x00020000), rsrcDS = __builtin_amdgcn_make_buffer_rsrc((void*)(F.ws + WS_DSEG), 0, 256 * 128 * 4, 0x00020000);
    const __amdgpu_buffer_rsrc_t rsrcD = __builtin_amdgcn_make_buffer_rsrc((void*)DEC, 0, 64 * 32 * 128 * 4, 0x00020000), rsrcM = __builtin_amdgcn_make_buffer_rsrc((void*)MIX, 0, (int)((size_t)T * D * 2), 0x00020000);
    const __amdgpu_buffer_rsrc_t rsrcK = __builtin_amdgcn_make_buffer_rsrc((void*)KVS, 0, 64 * 32 * 128 * 128 * 2, 0x00020000); const unsigned kvo = (unsigned)((se * 128 + sq * 32) * 2);
#define HG_LOADKV(dst_, item_) do { const unsigned so_ = (unsigned)__builtin_amdgcn_readfirstlane((int)((item_) * (128 * 128 * 2))); _Pragma("unroll") for (int j_ = 0; j_ < 4; ++j_) (dst_)[j_] = __builtin_bit_cast(v4u, __builtin_amdgcn_raw_buffer_load_b128(rsrcK, kvo + 16u * j_, so_, 0)); } while (0)
#define HG_LOADST(item_) HG_LOADKV(st, item_)
#define HG_FOLD(kv_, c_) do { _Pragma("unroll") for (int j_ = 0; j_ < 4; ++j_) { const f32x4 d0_ = *(const LAS f32x4*)(decs + (c_) * 128 + sq * 32 + 8 * j_), d1_ = *(const LAS f32x4*)(decs + (c_) * 128 + sq * 32 + 8 * j_ + 4); const v4u k_ = (kv_)[j_]; \
        S[8 * j_ + 0] = d0_.x * S[8 * j_ + 0] + bflo(k_.x); S[8 * j_ + 1] = d0_.y * S[8 * j_ + 1] + bfhi(k_.x); S[8 * j_ + 2] = d0_.z * S[8 * j_ + 2] + bflo(k_.y); S[8 * j_ + 3] = d0_.w * S[8 * j_ + 3] + bfhi(k_.y); \
        S[8 * j_ + 4] = d1_.x * S[8 * j_ + 4] + bflo(k_.z); S[8 * j_ + 5] = d1_.y * S[8 * j_ + 5] + bfhi(k_.z); S[8 * j_ + 6] = d1_.z * S[8 * j_ + 6] + bflo(k_.w); S[8 * j_ + 7] = d1_.w * S[8 * j_ + 7] + bfhi(k_.w); } } while (0)
    for (int wg = blockIdx.x; wg < 256; wg += F.G) {
        const int bh = wg >> 2, seg = wg & 3, item0 = bh * 32 + seg * 8, b = bh >> 2, h = bh & 3;
        HG_LOADT(rf, item0, 1); HG_LOADT(rq, item0, 0); HG_LOADT(rv, item0, 2); HG_LOADST(item0);
        const unsigned dso0 = (unsigned)__builtin_amdgcn_readfirstlane((bh * 32 + seg * 8) * 128 * 4);
        const f32x4 decv = __builtin_bit_cast(f32x4, __builtin_amdgcn_raw_buffer_load_b128(rsrcD, (unsigned)(F.tid & 255) * 16u, dso0, 0));
        const float lbv = hg_lbound(F, h, d);
        __builtin_amdgcn_sched_barrier(0);
        float S[32];
#pragma unroll
        for (int j = 0; j < 32; ++j) S[j] = 0.f;
        for (int sp = 0; sp < seg; ++sp) {
            const unsigned sso = (unsigned)__builtin_amdgcn_readfirstlane((bh * 4 + sp) * 128 * 128 * 4), dso = (unsigned)__builtin_amdgcn_readfirstlane((bh * 4 + sp) * 128 * 4);
#pragma unroll
            for (int j0 = 0; j0 < 8; j0 += 8) { f32x4 sv[8], dv[8];
#pragma unroll
                for (int j = 0; j < 8; ++j) { sv[j] = __builtin_bit_cast(f32x4, __builtin_amdgcn_raw_buffer_load_b128(rsrcSS, (unsigned)((se * 128 + sq * 32) * 4) + 16u * (j0 + j), sso, 0));
                    dv[j] = __builtin_bit_cast(f32x4, __builtin_amdgcn_raw_buffer_load_b128(rsrcDS, (unsigned)(sq * 32 * 4) + 16u * (j0 + j), dso, 0)); }
#pragma unroll
                for (int j = 0; j < 8; ++j) { const int q = 4 * (j0 + j); S[q + 0] = dv[j].x * S[q + 0] + sv[j].x; S[q + 1] = dv[j].y * S[q + 1] + sv[j].y; S[q + 2] = dv[j].z * S[q + 2] + sv[j].z; S[q + 3] = dv[j].w * S[q + 3] + sv[j].w; } }
        }
        if (F.tid < 256) *((LAS f32x4*)(L + HG_DECS) + F.tid) = decv;
        __syncthreads();
      for (int k = 0; k < 8; ++k) {
        const int item = item0 + k, c = seg * 8 + k;
        const int tb = F.wave & 1, eb = F.wave >> 1;
        const int nit = k < 7 ? item + 1 : item;
        HG_PUT(rf, RAWF); HG_PUT(rq, RAWQ); HG_PUT(rv, RAWV);
        __syncthreads();
        HG_LOADT(rf, nit, 1); HG_LOADT(rq, nit, 0); HG_LOADT(rv, nit, 2); __builtin_amdgcn_sched_barrier(0);
        unsigned short ffr[16], qr[16], vr[16]; HG_COL(ffr, RAWF); HG_COL(qr, RAWQ); HG_COL(vr, RAWV);
        float bb[16], kk[16], total; hg_gates(F, ffr, lbv, d, tq, bb, kk, total);
        float vv[16];
#pragma unroll
        for (int i = 0; i < 16; ++i) { const int t = 16 * tq + i; const float q = bf2f(qr[i]);
            *(LAS unsigned short*)(L + HG_QE + t * 272 + 2 * d) = (unsigned short)pkbf(q * bb[i], 0.f);
            *(LAS unsigned short*)(L + HG_KE + t * 272 + 2 * d) = (unsigned short)pkbf(kk[i] * __builtin_amdgcn_rcpf(bb[i]), 0.f);
            vv[i] = bf2f(vr[i]); }
        st16<true>(L + HG_VT + d * 144 + tq * 32, vv);
#pragma unroll
        for (int j = 0; j < 4; ++j) { v4u w4; w4.x = pkbf(S[8 * j + 0], S[8 * j + 1]); w4.y = pkbf(S[8 * j + 2], S[8 * j + 3]); w4.z = pkbf(S[8 * j + 4], S[8 * j + 5]); w4.w = pkbf(S[8 * j + 6], S[8 * j + 7]);
            *(LAS v4u*)(L + HG_ST + se * 272 + sq * 64 + 16 * j) = w4; }
        HG_FOLD(st, k);
        unsigned long long grv[4];
        { const bf16* grow_ = PHp + (((size_t)(3 * 16 + b) * 4 + h) * SEQ + c * 64 + tb * 32 + r) * 128;
#pragma unroll
            for (int g = 0; g < 4; ++g) grv[g] = *(const GAS unsigned long long*)(grow_ + eb * 32 + 8 * g + 4 * hh); }
        HG_LOADST(nit); __builtin_amdgcn_sched_barrier(0);
        __syncthreads();
        f32x16 acc;
#pragma unroll
        for (int i = 0; i < 16; ++i) acc[i] = 0.f;
#define HG_QF(s_) (*(const LAS bf16x8*)(L + HG_QE + (tb * 32 + r) * 272 + 32 * (s_) + 16 * hh))
#pragma unroll
        for (int s = 0; s < 8; ++s) acc = MFMA32(*(const LAS bf16x8*)(L + HG_ST + (eb * 32 + r) * 272 + 32 * s + 16 * hh), HG_QF(s), acc);
        for (int sb = 0; sb <= tb; ++sb) {
            f32x16 at;
#pragma unroll
            for (int i = 0; i < 16; ++i) at[i] = 0.f;
#pragma unroll
            for (int s = 0; s < 8; ++s) at = MFMA32(*(const LAS bf16x8*)(L + HG_KE + (sb * 32 + r) * 272 + 32 * s + 16 * hh), HG_QF(s), at);
            float a[16];
#pragma unroll
            for (int i = 0; i < 16; ++i) a[i] = (sb < tb || crow16(i, hh) <= r) ? at[i] : 0.f;
            const bf16x8 ab0 = pack8(a[0], a[1], a[2], a[3], a[4], a[5], a[6], a[7]), ab1 = pack8(a[8], a[9], a[10], a[11], a[12], a[13], a[14], a[15]);
            acc = MFMA32(*(const LAS bf16x8*)(L + HG_VT + (eb * 32 + r) * 144 + sb * 64 + 0 + 16 * hh), ab0, acc);
            acc = MFMA32(*(const LAS bf16x8*)(L + HG_VT + (eb * 32 + r) * 144 + sb * 64 + 32 + 16 * hh), ab1, acc);
        }
        float ss = 0.f;
#pragma unroll
        for (int i = 0; i < 16; ++i) ss += acc[i] * acc[i];
        ss += __shfl_xor(ss, 32);
        LAS float* ssq = (LAS float*)(L + HG_SSQ);
        if (hh == 0) ssq[eb * 64 + tb * 32 + r] = ss;
        f32x4 ggv[4];
        { const unsigned so = (unsigned)__builtin_amdgcn_readfirstlane(h * 512);
#pragma unroll
            for (int g = 0; g < 4; ++g) ggv[g] = __builtin_bit_cast(f32x4, __builtin_amdgcn_raw_buffer_load_b128(rsrcG, (unsigned)((eb * 32 + 8 * g + 4 * hh) * 4), so, 0)); }
        __syncthreads();
        const int tl = tb * 32 + r; const float tot = (ssq[tl] + ssq[64 + tl]) + (ssq[128 + tl] + ssq[192 + tl]);
        const float rs = 1.f / sqrtf(tot * (1.f / 128.f) + EPS);
        const unsigned mso = (unsigned)__builtin_amdgcn_readfirstlane((int)((((unsigned)b * SEQ + c * 64) * D + 512 + h * 128) * 2)), mvo = (unsigned)((tl * D + eb * 32) * 2);
        unsigned yp[4][2];
#pragma unroll
        for (int g = 0; g < 4; ++g) { const unsigned long long gr = grv[g]; const f32x4 gg = ggv[g];
            const float g0 = bflo((unsigned)gr), g1 = bfhi((unsigned)gr), g2 = bflo((unsigned)(gr >> 32)), g3 = bfhi((unsigned)(gr >> 32));
            const float y0 = acc[4 * g + 0] * rs * gg.x * (g0 * __builtin_amdgcn_rcpf(1.f + __expf(-g0))), y1 = acc[4 * g + 1] * rs * gg.y * (g1 * __builtin_amdgcn_rcpf(1.f + __expf(-g1)));
            const float y2 = acc[4 * g + 2] * rs * gg.z * (g2 * __builtin_amdgcn_rcpf(1.f + __expf(-g2))), y3 = acc[4 * g + 3] * rs * gg.w * (g3 * __builtin_amdgcn_rcpf(1.f + __expf(-g3)));
            yp[g][0] = pkbf(y0, y1); yp[g][1] = pkbf(y2, y3); }
#pragma unroll
        for (int gp = 0; gp < 2; ++gp) { const auto s0 = __builtin_amdgcn_permlane32_swap(yp[2 * gp][0], yp[2 * gp + 1][0], false, false), s1 = __builtin_amdgcn_permlane32_swap(yp[2 * gp][1], yp[2 * gp + 1][1], false, false);
            __builtin_amdgcn_raw_buffer_store_b128((v4u){s0[0], s1[0], s0[1], s1[1]}, rsrcM, mvo + 16u * (2 * gp + hh), mso, 0); }
        __syncthreads();
      }
    }
#undef HG_LOADST
#undef HG_LOADKV
#undef HG_FOLD
#undef HG_QF
}
#undef HG_LOADT
#undef HG_PUT
#undef HG_COL
#undef HG_ARR
#undef HG_SOFF
#undef HG_HV

__device__ __forceinline__ void router_phase(Frame& F) {
    LAS unsigned char* L = F.lds; const int r = F.lane & 31, hh = F.lane >> 5;
    LAS unsigned* lcnt = (LAS unsigned*)(F.lds + LTAB_OFF) + LT_MISC; LAS unsigned* lbase = lcnt + 32; LAS float* lrstd = (LAS float*)(F.lds + ROWTAB_OFF);
    float* TOPG = (float*)(F.ws + WS_TOPG);
    {
        const GAS v4u* img = (const GAS v4u*)(F.ws + WS_RT) + vzero();
        constexpr int NB = (RT_END / 16 + NWAVES * 64 - 1) / (NWAVES * 64);
        v4u t4[NB];
#pragma unroll
        for (int j = 0; j < NB; ++j) { const int q = F.tid + j * NWAVES * 64; t4[j] = img[q < RT_END / 16 ? q : 0]; }
#pragma unroll
        for (int j = 0; j < NB; ++j) { const int q = F.tid + j * NWAVES * 64; if (q < RT_END / 16) *(LAS v4u*)(L + 16 * q) = t4[j]; }
    }
    const bf16* XH = (const bf16*)(F.ws + WS_XN); int* LIST = (int*)(F.ws + WS_LIST); unsigned* cnt = (unsigned*)(F.ctl + CW_CNT);
    for (int base = blockIdx.x * 4; base < T / 32; base += F.G * 4) {
        const int grp = base + F.wave; const bool active = F.wave < 4 && grp < T / 32;
        if (F.tid < 32) lcnt[F.tid] = 0u;
        __syncthreads();
        float sv[4] = {0.f, 0.f, 0.f, 0.f}; int se[4] = {0, 0, 0, 0}; unsigned lp0 = 0u, lp1 = 0u; float rstd = 0.f; const int tok = grp * 32 + r;
        if (active) {
            const bf16* hrow = XH + (size_t)tok * D + 8 * hh;
            f32x16 acc;
#pragma unroll
            for (int i = 0; i < 16; ++i) acc[i] = 0.f;
            float ssq = 0.f;
#pragma unroll 16
            for (int s = 0; s < 64; ++s) {
                const v4u hu = *(const GAS v4u*)(hrow + 16 * s); const bf16x8 hi = __builtin_bit_cast(bf16x8, hu);
                { const float a0 = bflo(hu.x), a1 = bfhi(hu.x), a2 = bflo(hu.y), a3 = bfhi(hu.y), a4 = bflo(hu.z), a5 = bfhi(hu.z), a6 = bflo(hu.w), a7 = bfhi(hu.w);
                    ssq += (a0 * a0 + a1 * a1) + (a2 * a2 + a3 * a3) + (a4 * a4 + a5 * a5) + (a6 * a6 + a7 * a7); }
                const bf16x8 wh = *(const LAS bf16x8*)(L + r * RT_ROW + 32 * s + 16 * hh), wl = *(const LAS bf16x8*)(L + RT_WL + r * RT_ROW + 32 * s + 16 * hh);
                acc = MFMA32(wh, hi, acc); acc = MFMA32(wl, hi, acc);
            }
            ssq += __shfl_xor(ssq, 32);
            rstd = 1.f / sqrtf(ssq * (1.f / D) + EPS);
            float l[16];
#pragma unroll
            for (int i = 0; i < 16; ++i) l[i] = acc[i] * rstd + F.b_router[crow16(i, hh)];
            float cv[8]; int ce[8];
#pragma unroll
            for (int rnd = 0; rnd < 4; ++rnd) { float bv = l[0]; int bi = 0;
#pragma unroll
                for (int i = 1; i < 16; ++i) if (l[i] > bv) { bv = l[i]; bi = i; }
                cv[rnd] = bv; ce[rnd] = crow16(bi, hh);
#pragma unroll
                for (int i = 0; i < 16; ++i) if (i == bi) l[i] = -__builtin_inff(); }
#pragma unroll
            for (int j = 0; j < 4; ++j) { cv[4 + j] = __shfl_xor(cv[j], 32); ce[4 + j] = __shfl_xor(ce[j], 32); }
#pragma unroll
            for (int rnd = 0; rnd < 4; ++rnd) { float bv = cv[0]; int be = ce[0]; int bj = 0;
#pragma unroll
                for (int j = 1; j < 8; ++j) if (cv[j] > bv || (cv[j] == bv && ce[j] < be)) { bv = cv[j]; be = ce[j]; bj = j; }
                sv[rnd] = bv; se[rnd] = be;
#pragma unroll
                for (int j = 0; j < 8; ++j) if (j == bj) { cv[j] = -__builtin_inff(); ce[j] = 64; } }
            lp0 = __hip_atomic_fetch_add(lcnt + (hh ? se[2] : se[0]), 1u, __ATOMIC_RELAXED, __HIP_MEMORY_SCOPE_WORKGROUP);
            lp1 = __hip_atomic_fetch_add(lcnt + (hh ? se[3] : se[1]), 1u, __ATOMIC_RELAXED, __HIP_MEMORY_SCOPE_WORKGROUP);
        }
        __syncthreads();
        if (F.tid < 32) lbase[F.tid] = __hip_atomic_fetch_add(cnt + F.tid, lcnt[F.tid], __ATOMIC_RELAXED, __HIP_MEMORY_SCOPE_AGENT);
        __syncthreads();
        if (active) {
            const float e1 = __expf(sv[1] - sv[0]), e2 = __expf(sv[2] - sv[0]), e3 = __expf(sv[3] - sv[0]); const float inv = 1.f / (1.f + e1 + e2 + e3);
            const int ea = hh ? se[2] : se[0], eb = hh ? se[3] : se[1]; const float ga = (hh ? e2 : 1.f) * inv, gb = (hh ? e3 : e1) * inv;
            const size_t ia = (size_t)ea * 32768 + lbase[ea] + lp0, ib = (size_t)eb * 32768 + lbase[eb] + lp1;
            LIST[ia] = tok * 4 + 2 * hh; LIST[ib] = tok * 4 + 2 * hh + 1; TOPG[tok * 4 + 2 * hh] = ga; TOPG[tok * 4 + 2 * hh + 1] = gb;
            if (hh == 0) lrstd[F.wave * 32 + r] = rstd;
        }
        __syncthreads();
        {
            unsigned char* X8 = F.ws + WS_X8; const int t0 = base * 32;
#pragma unroll
            for (int q0 = 0; q0 < 16; q0 += 4) { v4u a[4][2];
#pragma unroll
                for (int q = 0; q < 4; ++q) { const int tt = t0 + F.wave * 16 + q0 + q; const GAS v4u* p = (const GAS v4u*)(XH + (size_t)(tt < T ? tt : 0) * D) + 2 * F.lane; a[q][0] = p[0]; a[q][1] = p[1]; }
#pragma unroll
                for (int q = 0; q < 4; ++q) { const int tl = F.wave * 16 + q0 + q, tt = t0 + tl; if (tt < T) { const float rs = lrstd[tl]; v4u o;
                    o.x = pg8::pk4_fp8(bflo(a[q][0].x) * rs, bfhi(a[q][0].x) * rs, bflo(a[q][0].y) * rs, bfhi(a[q][0].y) * rs); o.y = pg8::pk4_fp8(bflo(a[q][0].z) * rs, bfhi(a[q][0].z) * rs, bflo(a[q][0].w) * rs, bfhi(a[q][0].w) * rs);
                    o.z = pg8::pk4_fp8(bflo(a[q][1].x) * rs, bfhi(a[q][1].x) * rs, bflo(a[q][1].y) * rs, bfhi(a[q][1].y) * rs); o.w = pg8::pk4_fp8(bflo(a[q][1].z) * rs, bfhi(a[q][1].z) * rs, bflo(a[q][1].w) * rs, bfhi(a[q][1].w) * rs);
                    *((GAS v4u*)(X8 + (size_t)tt * D) + F.lane) = o; } } }
        }
        __syncthreads();
    }
}
__device__ __forceinline__ int build_moe_tables(Frame& F, int ntn, int mode) {
    LAS int* lt = (LAS int*)(F.lds + LTAB_OFF);
    if (F.wave == 0) {
        const int e = F.lane & 31; const int c = (int)__hip_atomic_load((unsigned*)(F.ctl + CW_CNT) + e, __ATOMIC_RELAXED, __HIP_MEMORY_SCOPE_AGENT);
        const int tl = (c + 255) >> 8; int inc = tl;
#pragma unroll
        for (int off = 1; off < 32; off <<= 1) { const int o = __shfl_up(inc, off, 32); if (e >= off) inc += o; }
        const int tot = __shfl(inc, 31, 32), t0 = inc - tl;
        if (F.lane < 32) { lt[LT_TS + e] = t0; lt[LT_CNT + e] = c; for (int i = 0; i < tl; ++i) lt[t0 + i] = e; }
        if (F.lane == 0) lt[LT_MISC + 64] = tot;
    }
    __syncthreads();
    int nt = lt[LT_MISC + 64]; nt = nt < 0 ? 0 : (nt > MAXTILES ? MAXTILES : nt); nt = __builtin_amdgcn_readfirstlane(nt);
    const int* LIST = (const int*)(F.ws + WS_LIST);
    const int nslot = mode == 1 ? MAXSLOT : (MAXTILES * 4 + 255) / 256;
    for (int q = F.tid; q < nslot * 256; q += NWAVES * 64) { const int i = q >> 8, rr = q & 255; const int Lu = i * F.G + F.vcu;
        int li = -1; float bias = 0.f;
        if (Lu < nt * ntn) { const int pm0 = Lu / ntn, pl = Lu - pm0 * ntn, pm = mode == 2 ? nt - 1 - pm0 : pm0, e = lt[pm], idx = (pm - lt[LT_TS + e]) * 256 + rr; if (idx < lt[LT_CNT + e]) li = LIST[(size_t)e * 32768 + idx];
            bias = mode == 1 ? F.b_gu[(size_t)e * 2048 + (rr >> 7) * 1024 + pl * 128 + (rr & 127)] : F.b_d[(size_t)e * 1024 + pl * 256 + rr]; }
        ((LAS float*)(F.lds + ROWTAB_OFF))[q] = bias;
        if (mode == 1) ((LAS unsigned short*)(F.lds + ROWTAB2_OFF))[q] = (unsigned short)(li < 0 ? 0 : (li >> 2));
        else ((LAS int*)(F.lds + ROWTAB_OFF) + nslot * 256)[q] = li; }
    __syncthreads();
    return nt;
}
__device__ __forceinline__ void combine_phase(Frame& F) {
    const unsigned char* YK = F.ws + WS_YK; const bf16* XH = (const bf16*)(F.ws + WS_XN); const float* TOPG = (const float*)(F.ws + WS_TOPG);
    for (int t = F.gw; t < T; t += F.ngw) {
        GAS f32x4* xr = (GAS f32x4*)(F.out + (size_t)t * D) + F.lane; f32x4 v[4]; unsigned y[4][4]; const f32x4 gt = *((const GAS f32x4*)TOPG + t + vzero()) * (1.0f / Y8_SCALE);
#pragma unroll
        for (int j = 0; j < 4; ++j) { const unsigned long long xh = __builtin_nontemporal_load((const GAS unsigned long long*)(XH + (size_t)t * D) + F.lane + 64 * j);
            v[j] = (f32x4){bflo((unsigned)xh), bfhi((unsigned)xh), bflo((unsigned)(xh >> 32)), bfhi((unsigned)(xh >> 32))};
#pragma unroll
            for (int k = 0; k < 4; ++k) y[j][k] = __builtin_nontemporal_load((const GAS unsigned*)(YK + ((size_t)t * 4 + k) * D) + F.lane + 64 * j); }
#pragma unroll
        for (int j = 0; j < 4; ++j) { f32x4 s4 = {0.f, 0.f, 0.f, 0.f};
#pragma unroll
            for (int k = 0; k < 4; ++k) { const f32x2n_ lo = __builtin_amdgcn_cvt_pk_f32_fp8((int)y[j][k], false), hi = __builtin_amdgcn_cvt_pk_f32_fp8((int)y[j][k], true); const float g = gt[k]; s4.x += g * lo.x; s4.y += g * lo.y; s4.z += g * hi.x; s4.w += g * hi.y; }
            v[j] = v[j] + s4;
            __builtin_nontemporal_store(v[j], xr + 64 * j); }
    }
}

constexpr int NPH = 9;
struct Args { const float* in[16]; float* out; unsigned char* ws; int ph_lo, ph_hi; };
__global__ void __launch_bounds__(NWAVES * 64, 2) fwd(Args args) {
    extern __shared__ __attribute__((aligned(16))) unsigned char lds[];
    Frame F;
    F.lds = (LAS unsigned char*)lds;
    F.MISC = (volatile LAS unsigned*)(F.lds + MISC_OFF);
    F.tid = threadIdx.x; F.lane = F.tid & 63; F.wave = __builtin_amdgcn_readfirstlane(F.tid >> 6);
    F.G = gridDim.x; { const int bx = blockIdx.x; F.vcu = (F.G % 8 == 0) ? (bx % 8) * (F.G / 8) + bx / 8 : bx; }
    F.gw = blockIdx.x * NWAVES + F.wave; F.ngw = F.G * NWAVES;
    F.ws = args.ws; F.ctl = (gu32*)(args.ws + WS_CTL); F.out = args.out;
    F.x = args.in[0]; F.norm1_g = args.in[1]; F.w_in = args.in[2]; F.sb_q_g = args.in[3]; F.sb_k_g = args.in[4]; F.sb_out_g = args.in[5]; F.hg_lb = args.in[6]; F.hg_out_g = args.in[7];
    F.w_out = args.in[8]; F.norm2_g = args.in[9]; F.w_router = args.in[10]; F.b_router = args.in[11]; F.w_gu = args.in[12]; F.b_gu = args.in[13]; F.w_d = args.in[14]; F.b_d = args.in[15];
    for (int u = F.tid; u < (LDS_BYTES - LDSCTL_OFF) / 4; u += NWAVES * 64) ((LAS unsigned*)(F.lds + LDSCTL_OFF))[u] = 0u;
    __syncthreads();
    XcdBarrier bar; bar.bar = (unsigned*)(F.ctl + CW_BAR); bar.x = 0; bar.st = nullptr;
    if (MK_ONE_LAUNCH) bar = xcd_barrier_post((unsigned*)(F.ctl + CW_BAR), F.MISC + 8);
    const int lo = args.ph_lo, hi = args.ph_hi;
#define IN(k) (lo <= (k) && (k) < hi && ((F.lane = lane_id()), (F.tid = F.wave * 64 + F.lane), true))
#define SEAM(k) do { if (IN(k) && IN((k) + 1)) xcd_barrier(bar); } while (0)

    if (IN(0)) { p0_prologue(F); } SEAM(0);
    if (IN(1)) {
        pg8::Gemm g{(const bf16*)(F.ws + WS_XN), (const bf16*)(F.ws + WS_WIN), T, NIN, D}; pg8::StaticOrder S; S.init(T, NIN, F.G, (int)blockIdx.x);
        pg8::EpiInproj E{(bf16*)(F.ws + WS_P), (bf16*)(F.ws + WS_PH), (bf16*)(F.ws + WS_QN), (bf16*)(F.ws + WS_KN), F.sb_q_g, F.sb_k_g, QSCALE, EPS};
        pg8::gemm_phase<pg8::EpiInproj, pg8::StaticOrder, PG8_ALIGN, PG8_SP2>(F.lds + RING_OFF, g, S, E, F.tid);
    } SEAM(1);
    if (IN(2)) { prep_phase(F); __syncthreads(); hgA_phase(F); } SEAM(2);
    if (IN(3)) { attn_phase(F); hgC_phase(F); } SEAM(3);
    if (IN(4)) {
        pg8::Gemm g{(const bf16*)(F.ws + WS_MIX), (const bf16*)(F.ws + WS_WOUT), T, D, D}; pg8::StaticOrder S; S.init(T, D, F.G, (int)blockIdx.x);
        pg8::EpiRes E{F.x, (bf16*)(F.ws + WS_XN), D};
        pg8::gemm_phase<pg8::EpiRes, pg8::StaticOrder, PG8_ALIGN, PG8_SP2>(F.lds + RING_OFF, g, S, E, F.tid);
    } SEAM(4);
    if (IN(5)) { router_phase(F); } SEAM(5);
    if (IN(6)) {
        const int nt = build_moe_tables(F, 8, 1); const LAS int* lt = (const LAS int*)(F.lds + LTAB_OFF);
        pg8::Gemm g{(const bf16*)(F.ws + WS_X8), (const bf16*)(F.ws + WS_WGU), MAXROWS, NE * 2048, D / 2};
        pg8::MoeOrder S{lt, (const LAS unsigned short*)(F.lds + ROWTAB2_OFF), 8, nt * 8, F.G, F.vcu, 1024u, 0};
        pg8::EpiAct<true> E{F.ws + WS_ACT, (const LAS float*)(F.lds + ROWTAB_OFF), A8_SCALE};
        pg8::gemm_phase<pg8::EpiAct<true>, pg8::MoeOrder, PG8_ALIGN, PG8_SP2, true, SC_W8, SC_ONE>(F.lds + RING_OFF, g, S, E, F.tid);
        {
            const int rem = (nt * 8) % F.G, nidle = F.G - rem; const bool few = rem == 0 || nidle < F.G / 4;
            __syncthreads();
            if (few) p0_items(F, P0_NITEMS - P0_NLATE, P0_NITEMS, F.vcu * NWAVES + F.wave, F.G * NWAVES);
            else if (F.vcu >= rem) p0_items(F, P0_NITEMS - P0_NLATE, P0_NITEMS, (F.vcu - rem) * NWAVES + F.wave, nidle * NWAVES);
        }
    } SEAM(6);
    if (IN(7)) {
        const int nt = build_moe_tables(F, 4, 2); const LAS int* lt = (const LAS int*)(F.lds + LTAB_OFF);
        pg8::Gemm g{(const bf16*)(F.ws + WS_ACT), (const bf16*)(F.ws + WS_WD), MAXROWS, NE * 1024, D / 2};
        pg8::MoeOrder S{lt, nullptr, 4, nt * 4, F.G, F.vcu, 1024u, nt};
        pg8::EpiDown E{F.ws + WS_YK, (const LAS int*)(F.lds + ROWTAB_OFF) + ((MAXTILES * 4 + 255) / 256) * 256, (const LAS float*)(F.lds + ROWTAB_OFF), Y8_SCALE};
        pg8::gemm_phase<pg8::EpiDown, pg8::MoeOrder, PG8_ALIGN, PG8_SP2, true, SC_W8Y, SC_A8>(F.lds + RING_OFF, g, S, E, F.tid);
    } SEAM(7);
    if (IN(8)) { combine_phase(F); }
#undef IN
#undef SEAM
}

extern "C" void kernel_launch(void* const* d_in, const int* in_sizes, int n_in, void* d_out, int out_size, void* d_ws, size_t ws_size, hipStream_t stream) {
    static int grid = 0;
    if (grid == 0) {
        if (n_in != 16 || in_sizes[0] != T * D || out_size != T * D || ws_size < WS_END) { fprintf(stderr, "kernel_launch: shape/workspace mismatch (n_in %d, ws %zu, need %zu); nothing launched\n", n_in, ws_size, (size_t)WS_END); grid = -1; return; }
        int dev = 0, cus = 0, per_cu = 0;
        if (hipGetDevice(&dev) != hipSuccess || hipDeviceGetAttribute(&cus, hipDeviceAttributeMultiprocessorCount, dev) != hipSuccess) { grid = -1; return; }
        if (hipFuncSetAttribute((const void*)fwd, hipFuncAttributeMaxDynamicSharedMemorySize, LDS_BYTES) != hipSuccess) { grid = -1; return; }
        if (hipOccupancyMaxActiveBlocksPerMultiprocessor(&per_cu, (const void*)fwd, NWAVES * 64, LDS_BYTES) != hipSuccess || per_cu < 1) { fprintf(stderr, "kernel_launch: occupancy query says %d\n", per_cu); }
        (void)hipGetLastError();
        if ((MAXTILES * 8 + cus - 1) / cus > MAXSLOT || cus < 1) { fprintf(stderr, "kernel_launch: %d CUs: the per-workgroup unit tables are sized for 256\n", cus); grid = -1; return; }
        grid = cus;
    }
    if (grid < 0) return;
    if (hipMemsetAsync((char*)d_ws + WS_CTL, 0, CTL_ZERO_BYTES, stream) != hipSuccess) return;
    Args a{};
    for (int i = 0; i < 16; ++i) a.in[i] = (const float*)d_in[i];
    a.out = (float*)d_out; a.ws = (unsigned char*)d_ws;
#if MK_ONE_LAUNCH
    a.ph_lo = 0; a.ph_hi = NPH;
    hipLaunchKernelGGL(fwd, dim3(grid), dim3(NWAVES * 64), LDS_BYTES, stream, a);
#else
    for (int p = 0; p < NPH; ++p) { a.ph_lo = p; a.ph_hi = p + 1; hipLaunchKernelGGL(fwd, dim3(grid), dim3(NWAVES * 64), LDS_BYTES, stream, a); }
#endif
}
```

```cpp
#include <hip/hip_runtime.h>
#include <cstdio>
#include <cstdint>
namespace pg8 {
#define PG8_LAS __attribute__((address_space(3)))
typedef unsigned short bf16_t;
typedef short bf16x8 __attribute__((ext_vector_type(8)));
typedef float f32x4 __attribute__((ext_vector_type(4)));
typedef unsigned u32x4 __attribute__((ext_vector_type(4)));
typedef int i32x4_t __attribute__((ext_vector_type(4)));
typedef int i32x8_t __attribute__((ext_vector_type(8)));
constexpr int BM = 256, BK = 64, HALF = 128, HTB = HALF * BK * 2  , STAGE_BYTES = 8 * HTB, NXCD = 8, WGM = 8;

__host__ __device__ __forceinline__ int lds_byte(int r, int c) { const int st = (r >> 4) * 2 + (c >> 5), rr = r & 15, cc = c & 31, ob = rr * 64 + cc * 2; return st * 1024 + (ob ^ (((ob >> 9) & 1) << 5)); }
__host__ __device__ __forceinline__ void stage_rc(int b, int& R, int& C) { const int st = b / 1024, sb = b % 1024, swz = sb ^ (((sb >> 9) & 1) << 5); R = (st >> 1) * 16 + swz / 64; C = (st & 1) * 32 + (swz % 64) / 2; }
__host__ __device__ __forceinline__ int perm32(int rho) { const int n = rho >> 4, i = rho & 15; return 8 * (i >> 2) + 4 * n + (i & 3); }

struct Unit { int pm, pn, slot; };
struct Gemm { const bf16_t* A; const bf16_t* Bt; int M, N, K; };

struct StaticOrder {
    int nM, nN, nwg, G, c;
    __host__ __device__ void init(int M, int N, int G_, int c_) { nM = M / BM; nN = N / BM; nwg = nM * nN; G = G_; c = c_; }
    __host__ __device__ bool next(int i, Unit& u) const {
        const long L = (long)i * G + c; if (L >= nwg) return false;
        int wgid = (int)L; { const int q = nwg / NXCD, r = nwg % NXCD, xcd = wgid % NXCD, off = wgid / NXCD; wgid = (xcd < r ? xcd * (q + 1) : r * (q + 1) + (xcd - r) * q) + off; }
        const int nig = WGM * nN, gid = wgid / nig, fm = gid * WGM, gsz = (nM - fm) < WGM ? (nM - fm) : WGM;
        u.pm = fm + ((wgid % nig) % gsz); u.pn = (wgid % nig) / gsz; return true;
    }
    __device__ __forceinline__ void a_ready(const Unit&) const {}
    __device__ __forceinline__ void done(const Unit&) const {}
};

__device__ __forceinline__ unsigned cvt_pk_bf16(float lo, float hi) { unsigned r; asm volatile("v_cvt_pk_bf16_f32 %0, %1, %2" : "=v"(r) : "v"(lo), "v"(hi)); return r; }
typedef float f32x2 __attribute__((ext_vector_type(2)));
__device__ __forceinline__ f32x2 gelu_pk(f32x2 v) {
    const f32x2 av = __builtin_elementwise_abs(v), d = av * 0.2316418882f + 1.0f;
    f32x2 t; t.x = __builtin_amdgcn_rcpf(d.x); t.y = __builtin_amdgcn_rcpf(d.y);
    f32x2 q = t * 0.5307027145f + (-0.7265760135f); q = q * t + 0.7107068705f; q = q * t + (-0.142248368f); q = q * t + 0.127414796f; q = q * t;
    const f32x2 s = (v * v) * (-0.72134752044f);
    f32x2 e; e.x = __builtin_amdgcn_exp2f(s.x); e.y = __builtin_amdgcn_exp2f(s.y);
    const f32x2 m = v * (q * e), r = v - m;
    f32x2 o; o.x = v.x < 0.f ? m.x : r.x; o.y = v.y < 0.f ? m.y : r.y; return o;
}

template <int ACT  > struct EpiBf16 {
    static constexpr bool PERM = true, AFTER_DRAIN = false, HAS_INIT = false, INIT_LOADS = false; static_assert(ACT == 0 || ACT == 1, "EpiBf16: ACT is 0 (none) or 1 (gelu_pk)");
    bf16_t* O; int ldc; const float* bias; int split_cols; size_t split_stride; float scale0;
    __device__ __forceinline__ void operator()(const f32x4 (&acc)[2][2][4][2], const Unit& u, int wr, int wc, int fr, int fq) const {
        const int row0 = u.pm * BM + wr * 64 + fr; int colt = u.pn * BM; bf16_t* base = O;
        float sc = 1.f; if (split_cols) { const int t = colt / split_cols; base += (size_t)t * split_stride; colt -= t * split_cols; if (t == 0) sc = scale0; }
        const int col0 = colt + wc * 32 + 8 * fq, bcol0 = u.pn * BM + wc * 32 + 8 * fq;
        f32x4 bv[2][2];
#pragma unroll
        for (int bj = 0; bj < 2; ++bj)
#pragma unroll
            for (int n = 0; n < 2; ++n) bv[bj][n] = bias ? *(const f32x4*)(bias + bcol0 + bj * HALF + 4 * n) : (f32x4){0.f, 0.f, 0.f, 0.f};
#pragma unroll
        for (int ai = 0; ai < 2; ++ai)
#pragma unroll
            for (int m = 0; m < 4; ++m) { bf16_t* rowp = base + (size_t)(row0 + ai * HALF + m * 16) * ldc + col0;
#pragma unroll
                for (int bj = 0; bj < 2; ++bj) { f32x4 v0 = acc[ai][bj][m][0] + bv[bj][0], v1 = acc[ai][bj][m][1] + bv[bj][1];
                    if (ACT == 1) { f32x2 a = gelu_pk((f32x2){v0[0], v0[1]}), b = gelu_pk((f32x2){v0[2], v0[3]}), c = gelu_pk((f32x2){v1[0], v1[1]}), d = gelu_pk((f32x2){v1[2], v1[3]});
                        v0 = (f32x4){a.x, a.y, b.x, b.y}; v1 = (f32x4){c.x, c.y, d.x, d.y}; }
                    v0 = v0 * sc; v1 = v1 * sc; u32x4 w; w.x = cvt_pk_bf16(v0[0], v0[1]); w.y = cvt_pk_bf16(v0[2], v0[3]); w.z = cvt_pk_bf16(v1[0], v1[1]); w.w = cvt_pk_bf16(v1[2], v1[3]);
                    *(u32x4*)(rowp + bj * HALF) = w; } }
    }
};

__device__ __forceinline__ unsigned pk4_fp8(float a, float b, float c, float d) {
    a = fminf(fmaxf(a, -448.f), 448.f); b = fminf(fmaxf(b, -448.f), 448.f); c = fminf(fmaxf(c, -448.f), 448.f); d = fminf(fmaxf(d, -448.f), 448.f);
    int p = 0; p = __builtin_amdgcn_cvt_pk_fp8_f32(a, b, p, false); p = __builtin_amdgcn_cvt_pk_fp8_f32(c, d, p, true); return (unsigned)p;
}
struct EpiRes {
    static constexpr bool PERM = true, AFTER_DRAIN = false, HAS_INIT = true, INIT_LOADS = true;
    const float* __restrict__ X; bf16_t* __restrict__ XH; int ldc;
    __device__ __forceinline__ void init(f32x4 (&acc)[2][2][4][2], const Unit& u, int wr, int wc, int fr, int fq) const {
        const int row0 = u.pm * BM + wr * 64 + fr, col0 = u.pn * BM + wc * 32 + 8 * fq;
#pragma unroll
        for (int ai = 0; ai < 2; ++ai)
#pragma unroll
            for (int m = 0; m < 4; ++m) { const float* rp = X + (size_t)(row0 + ai * HALF + m * 16) * ldc + col0;
#pragma unroll
                for (int bj = 0; bj < 2; ++bj)
#pragma unroll
                    for (int n = 0; n < 2; ++n) acc[ai][bj][m][n] = __builtin_nontemporal_load((const f32x4*)(rp + bj * HALF + n * 4)); }
    }
    __device__ __forceinline__ void operator()(const f32x4 (&acc)[2][2][4][2], const Unit& u, int wr, int wc, int fr, int fq) const {
        const int row0 = u.pm * BM + wr * 64 + fr, col0 = u.pn * BM + wc * 32 + 8 * fq;
#pragma unroll
        for (int ai = 0; ai < 2; ++ai)
#pragma unroll
            for (int m = 0; m < 4; ++m) { bf16_t* rp = XH + (size_t)(row0 + ai * HALF + m * 16) * ldc + col0;
#pragma unroll
                for (int bj = 0; bj < 2; ++bj) { const f32x4 v0 = acc[ai][bj][m][0], v1 = acc[ai][bj][m][1];
                    u32x4 w; w.x = cvt_pk_bf16(v0[0], v0[1]); w.y = cvt_pk_bf16(v0[2], v0[3]); w.z = cvt_pk_bf16(v1[0], v1[1]); w.w = cvt_pk_bf16(v1[2], v1[3]);
                    *(u32x4*)(rp + bj * HALF) = w; } }
    }
};
struct EpiInproj {
    static constexpr bool PERM = true, AFTER_DRAIN = false, HAS_INIT = false, INIT_LOADS = false;
    bf16_t* PA; bf16_t* PH; bf16_t* QN; bf16_t* KN; const float* gq; const float* gk; float qscale, eps;
    __device__ __forceinline__ void operator()(const f32x4 (&acc)[2][2][4][2], const Unit& u, int wr, int wc, int fr, int fq) const {
        if (u.pn < 4) {
            const int arr = u.pn >> 1, hd = (u.pn & 1) * 4 + wc; const float* g = arr ? gk : gq; const float gs = arr ? 1.f : qscale; bf16_t* dst = arr ? KN : QN;
            f32x4 gv[2][2];
#pragma unroll
            for (int bj = 0; bj < 2; ++bj)
#pragma unroll
                for (int n = 0; n < 2; ++n) gv[bj][n] = *(const f32x4*)(g + 32 * bj + 8 * fq + 4 * n) * gs;
#pragma unroll
            for (int ai = 0; ai < 2; ++ai)
#pragma unroll
                for (int m = 0; m < 4; ++m) { float ss = 0.f;
#pragma unroll
                    for (int bj = 0; bj < 2; ++bj)
#pragma unroll
                        for (int n = 0; n < 2; ++n) { const f32x4 a = acc[ai][bj][m][n]; ss += (a[0] * a[0] + a[1] * a[1]) + (a[2] * a[2] + a[3] * a[3]); }
                    ss += __shfl_xor(ss, 16); ss += __shfl_xor(ss, 32);
                    const float rs = 1.f / sqrtf(ss * (1.f / 64.f) + eps);
                    const int row = u.pm * BM + ai * HALF + wr * 64 + m * 16 + fr, b = row >> 11, s = row & 2047;
                    bf16_t* rp = dst + ((size_t)((b * 8 + hd) * 64 + (s >> 5))) * 2048 + (s & 31) * 8;
#pragma unroll
                    for (int bj = 0; bj < 2; ++bj) { const int c8 = 4 * bj + fq; const f32x4 v0 = acc[ai][bj][m][0] * rs * gv[bj][0], v1 = acc[ai][bj][m][1] * rs * gv[bj][1];
                        u32x4 w; w.x = cvt_pk_bf16(v0[0], v0[1]); w.y = cvt_pk_bf16(v0[2], v0[3]); w.z = cvt_pk_bf16(v1[0], v1[1]); w.w = cvt_pk_bf16(v1[2], v1[3]);
                        *(u32x4*)(rp + (c8 >> 1) * 512 + (c8 & 1) * 256) = w; } }
            return;
        }
#pragma unroll
        for (int bj = 0; bj < 2; ++bj) { const int col = u.pn * BM + bj * HALF + wc * 32 + 8 * fq;
            bf16_t* base; int rowlen;
            if (col < 1536) { const int arr = col >> 9, hd = (col & 511) >> 6, dd = col & 63; base = PA + ((size_t)(arr * 16) * 8 + hd) * 2048 * 64 + dd; rowlen = 64; }
            else { const int c2 = col - 1536, arr = c2 >> 9, hd = (c2 & 511) >> 7, dd = c2 & 127; base = PH + ((size_t)(arr * 16) * 4 + hd) * 2048 * 128 + dd; rowlen = 128; }
            const size_t bstride = (size_t)(rowlen == 64 ? 8 : 4) * 2048 * rowlen;
#pragma unroll
            for (int ai = 0; ai < 2; ++ai)
#pragma unroll
                for (int m = 0; m < 4; ++m) { const int row = u.pm * BM + ai * HALF + wr * 64 + m * 16 + fr, b = row >> 11, s = row & 2047;
                    const f32x4 v0 = acc[ai][bj][m][0], v1 = acc[ai][bj][m][1];
                    u32x4 w; w.x = cvt_pk_bf16(v0[0], v0[1]); w.y = cvt_pk_bf16(v0[2], v0[3]); w.z = cvt_pk_bf16(v1[0], v1[1]); w.w = cvt_pk_bf16(v1[2], v1[3]);
                    *(u32x4*)(base + (size_t)b * bstride + (size_t)s * rowlen) = w; } }
    }
};
struct MoeOrder {
    const PG8_LAS int* tile_e; const PG8_LAS unsigned short* rowtab; int ntn, nunits, G, c; unsigned rowbytes; int rev;
    __device__ __forceinline__ bool next(int i, Unit& u) const {
        const int L = i * G + c; if (L >= nunits) return false;
        const int pm0 = L / ntn, pl = L - pm0 * ntn, pm = rev ? rev - 1 - pm0 : pm0; u.pm = pm; u.pn = tile_e[pm] * ntn + pl; u.slot = i; return true;
    }
    __device__ __forceinline__ unsigned rowoff(const Unit& u, int r) const { return (rowtab ? (unsigned)rowtab[u.slot * 256 + r] : (unsigned)(u.pm * 256 + r)) * rowbytes; }
    __device__ __forceinline__ void a_ready(const Unit&) const {}
    __device__ __forceinline__ void done(const Unit&) const {}
};
template <bool OUT8> struct EpiAct {
    static constexpr bool PERM = true, AFTER_DRAIN = false, HAS_INIT = true, INIT_LOADS = false;
    unsigned char* ACT; const PG8_LAS float* biastab; float oscale;
    __device__ __forceinline__ void init(f32x4 (&acc)[2][2][4][2], const Unit& u, int wr, int wc, int fr, int fq) const {
#pragma unroll
        for (int n = 0; n < 2; ++n) { const f32x4 bg = *(const PG8_LAS f32x4*)(biastab + u.slot * 256 + wc * 32 + 8 * fq + 4 * n), bu = *(const PG8_LAS f32x4*)(biastab + u.slot * 256 + 128 + wc * 32 + 8 * fq + 4 * n);
#pragma unroll
            for (int ai = 0; ai < 2; ++ai)
#pragma unroll
                for (int m = 0; m < 4; ++m) { acc[ai][0][m][n] = bg; acc[ai][1][m][n] = bu; } }
    }
    __device__ __forceinline__ void operator()(const f32x4 (&acc)[2][2][4][2], const Unit& u, int wr, int wc, int fr, int fq) const {
        const int pl = u.pn & 7; const int row0 = u.pm * BM + wr * 64 + fr, acol0 = pl * 128 + wc * 32 + 8 * fq;
#pragma unroll
        for (int ai = 0; ai < 2; ++ai)
#pragma unroll
            for (int m = 0; m < 4; ++m) { unsigned char* rowp = ACT + (size_t)(row0 + ai * HALF + m * 16) * 1024 + acol0; f32x4 a4[2];
#pragma unroll
                for (int n = 0; n < 2; ++n) { const f32x4 g4 = acc[ai][0][m][n], u4 = acc[ai][1][m][n]; f32x4 gl, ul, ex;
#pragma unroll
                    for (int j = 0; j < 4; ++j) { gl[j] = fminf(g4[j], 7.0f); ul[j] = __builtin_amdgcn_fmed3f(u4[j], -7.0f, 7.0f); }
                    const f32x4 t4 = gl * (-1.702f * 1.44269504089f);
#pragma unroll
                    for (int j = 0; j < 4; ++j) ex[j] = __builtin_amdgcn_exp2f(t4[j]);
                    const f32x4 d4 = ex + 1.0f; f32x4 s4;
#pragma unroll
                    for (int j = 0; j < 4; ++j) s4[j] = __builtin_amdgcn_rcpf(d4[j]);
                    a4[n] = (gl * s4) * (ul * oscale + oscale); }
                if constexpr (OUT8) { int p0 = 0, p1 = 0; p0 = __builtin_amdgcn_cvt_pk_fp8_f32(a4[0][0], a4[0][1], p0, false); p0 = __builtin_amdgcn_cvt_pk_fp8_f32(a4[0][2], a4[0][3], p0, true);
                    p1 = __builtin_amdgcn_cvt_pk_fp8_f32(a4[1][0], a4[1][1], p1, false); p1 = __builtin_amdgcn_cvt_pk_fp8_f32(a4[1][2], a4[1][3], p1, true);
                    *(unsigned long long*)rowp = (unsigned long long)(unsigned)p0 | ((unsigned long long)(unsigned)p1 << 32); }
                else { u32x4 w; w.x = cvt_pk_bf16(a4[0][0], a4[0][1]); w.y = cvt_pk_bf16(a4[0][2], a4[0][3]); w.z = cvt_pk_bf16(a4[1][0], a4[1][1]); w.w = cvt_pk_bf16(a4[1][2], a4[1][3]); *(u32x4*)(rowp + (size_t)(row0 + ai * HALF + m * 16) * 1024 + acol0) = w; } }
    }
};
struct EpiDown {
    static constexpr bool PERM = true, AFTER_DRAIN = false, HAS_INIT = true, INIT_LOADS = false;
    unsigned char* YK; const PG8_LAS int* tktab; const PG8_LAS float* biastab; float oscale;
    __device__ __forceinline__ void init(f32x4 (&acc)[2][2][4][2], const Unit& u, int wr, int wc, int fr, int fq) const {
#pragma unroll
        for (int bj = 0; bj < 2; ++bj)
#pragma unroll
            for (int n = 0; n < 2; ++n) { const f32x4 bv = *(const PG8_LAS f32x4*)(biastab + u.slot * 256 + 64 * wc + 16 * fq + 8 * bj + 4 * n) * oscale;
#pragma unroll
                for (int ai = 0; ai < 2; ++ai)
#pragma unroll
                    for (int m = 0; m < 4; ++m) acc[ai][bj][m][n] = bv; }
    }
    __device__ __forceinline__ void operator()(const f32x4 (&acc)[2][2][4][2], const Unit& u, int wr, int wc, int fr, int fq) const {
        const int pl = u.pn & 3; const int col0 = pl * BM + 64 * wc + 16 * fq;
#pragma unroll
        for (int ai = 0; ai < 2; ++ai)
#pragma unroll
            for (int m = 0; m < 4; ++m) { const int tk = tktab[u.slot * 256 + ai * HALF + wr * 64 + m * 16 + fr];
                if (tk >= 0) { unsigned char* rowp = YK + (size_t)tk * 1024 + col0; int p[4];
#pragma unroll
                    for (int bj = 0; bj < 2; ++bj) { f32x4 v0 = acc[ai][bj][m][0], v1 = acc[ai][bj][m][1];
#pragma unroll
                        for (int j = 0; j < 4; ++j) { v0[j] = __builtin_amdgcn_fmed3f(v0[j], -448.f, 448.f); v1[j] = __builtin_amdgcn_fmed3f(v1[j], -448.f, 448.f); }
                        int p0 = 0, p1 = 0; p0 = __builtin_amdgcn_cvt_pk_fp8_f32(v0[0], v0[1], p0, false); p0 = __builtin_amdgcn_cvt_pk_fp8_f32(v0[2], v0[3], p0, true);
                        p1 = __builtin_amdgcn_cvt_pk_fp8_f32(v1[0], v1[1], p1, false); p1 = __builtin_amdgcn_cvt_pk_fp8_f32(v1[2], v1[3], p1, true);
                        p[2 * bj] = p0; p[2 * bj + 1] = p1; }
                    u32x4 w; w.x = (unsigned)p[0]; w.y = (unsigned)p[1]; w.z = (unsigned)p[2]; w.w = (unsigned)p[3];
                    *(u32x4*)rowp = w; } }
    }
};

template <class Epi, class Sched, bool ALIGN_EPI = false, bool SP2 = false, bool GATHER = false, int SCW = 0, int SCX = 0>
__device__ __forceinline__ void gemm_phase(PG8_LAS unsigned char* lds, const Gemm g, const Sched& S, const Epi& E, const int tid) {
    const int wid = __builtin_amdgcn_readfirstlane(tid >> 6), lane = tid & 63, wr = wid >> 2, wc = wid & 3, fr = lane & 15, fq = lane >> 4;
    const int K = g.K, nt = K / BK;
    unsigned voffA[2], voffB[2]; int RA[2]; unsigned CA2[2]; unsigned va0[2] = {0u, 0u}, va1[2] = {0u, 0u};
#pragma unroll
    for (int i = 0; i < 2; ++i) { int R, C; stage_rc(tid * 16 + i * 8192, R, C); const int Rb = Epi::PERM ? ((R & ~31) + perm32(R & 31)) : R;
        voffA[i] = (unsigned)(R * K + C) * 2u; voffB[i] = (unsigned)(Rb * K + C) * 2u; RA[i] = R; CA2[i] = (unsigned)C * 2u; }
    static_assert(!GATHER || SP2, "the gathered-A form exists for the SP2 loop only");
    const char* const gA0 = (const char*)g.A;
#define PG8_VA(u) do { int l_; asm volatile("v_mbcnt_lo_u32_b32 %0, -1, 0\n\tv_mbcnt_hi_u32_b32 %0, -1, %0" : "=v"(l_)); const int t_ = wid * 64 + l_;     \
        _Pragma("unroll") for (int _i = 0; _i < 2; ++_i) { int R_, C_; stage_rc(t_ * 16 + _i * 8192, R_, C_); va0[_i] = S.rowoff((u), R_) + (unsigned)C_ * 2u; va1[_i] = S.rowoff((u), HALF + R_) + (unsigned)C_ * 2u; } } while (0)
#define PG8_STA(bufoff, base_ng, base_g, h) do { if constexpr (GATHER) { if (h) PG8_STAGE(bufoff, base_g, va1); else PG8_STAGE(bufoff, base_g, va0); } else PG8_STAGE(bufoff, base_ng, voffA); } while (0)
    const size_t kstep = (size_t)(BK * 2);
    const size_t hstep = (size_t)HALF * K * 2;
    const size_t tstep = 2 * hstep;
    const unsigned ldsw = (unsigned)wid * 1024u;
    const int aoff = lds_byte(wr * 64 + fr, fq * 8), boff = lds_byte(wc * 32 + fr, fq * 8);
#define PG8_SA(b, h) (((b) * 2 + (h)) * HTB)
#define PG8_SB(b, h) ((4 + (b) * 2 + (h)) * HTB)
#define PG8_STAGE(bufoff, gbase, voff) do { _Pragma("unroll") for (int _i = 0; _i < 2; ++_i) \
        __builtin_amdgcn_global_load_lds((const unsigned*)((const char*)(gbase) + (voff)[_i]), (PG8_LAS unsigned*)(lds + (bufoff) + ldsw + _i * 8192), 16, 0, 0); } while (0)
#define PG8_LDA(dst, b, h) do { if constexpr (SCW != 0) { _Pragma("unroll") for (int m = 0; m < 4; ++m) dst##8[m] = PG8_CAT8(*(const PG8_LAS bf16x8*)(lds + PG8_SA(b, h) + aoff + m * 2048), *(const PG8_LAS bf16x8*)(lds + PG8_SA(b, h) + aoff + m * 2048 + 1024)); } \
        else { _Pragma("unroll") for (int m = 0; m < 4; ++m) _Pragma("unroll") for (int k = 0; k < 2; ++k) dst[m][k] = *(const PG8_LAS bf16x8*)(lds + PG8_SA(b, h) + aoff + m * 2048 + k * 1024); } } while (0)
#define PG8_LDB(dst, b, h) do { if constexpr (SCW != 0) { _Pragma("unroll") for (int n = 0; n < 2; ++n) dst##8[n] = PG8_CAT8(*(const PG8_LAS bf16x8*)(lds + PG8_SB(b, h) + boff + n * 2048), *(const PG8_LAS bf16x8*)(lds + PG8_SB(b, h) + boff + n * 2048 + 1024)); } \
        else { _Pragma("unroll") for (int n = 0; n < 2; ++n) _Pragma("unroll") for (int k = 0; k < 2; ++k) dst[n][k] = *(const PG8_LAS bf16x8*)(lds + PG8_SB(b, h) + boff + n * 2048 + k * 1024); } } while (0)
#define PG8_CAT8(lo, hi) __builtin_shufflevector(__builtin_bit_cast(i32x4_t, (lo)), __builtin_bit_cast(i32x4_t, (hi)), 0, 1, 2, 3, 4, 5, 6, 7)
#define PG8_MMA(ai, bj, At, Bt) do { __builtin_amdgcn_s_setprio(1); _Pragma("unroll") for (int m = 0; m < 4; ++m) _Pragma("unroll") for (int n = 0; n < 2; ++n) { \
        if constexpr (SCW != 0) acc[ai][bj][m][n] = __builtin_amdgcn_mfma_scale_f32_16x16x128_f8f6f4(Bt##8[n], At##8[m], acc[ai][bj][m][n], 0, 0, 0, SCW, 0, SCX); \
        else { _Pragma("unroll") for (int k = 0; k < 2; ++k) acc[ai][bj][m][n] = __builtin_amdgcn_mfma_f32_16x16x32_bf16(Bt[n][k], At[m][k], acc[ai][bj][m][n], 0, 0, 0); } } __builtin_amdgcn_s_setprio(0); } while (0)
#define PG8_WAIT_V(n) asm volatile("s_waitcnt vmcnt(" #n ")" ::: "memory")
#define PG8_WAIT_L(n) asm volatile("s_waitcnt lgkmcnt(" #n ")" ::: "memory")
#define PG8_BAR __builtin_amdgcn_s_barrier()
#define PG8_SCHED __builtin_amdgcn_sched_barrier(0)
    Unit cur, nxt; int ui = 0;
    if (!S.next(0, cur)) return;
    f32x4 acc[2][2][4][2];
    if constexpr (Epi::HAS_INIT) { E.init(acc, cur, wr, wc, fr, fq); if constexpr (Epi::INIT_LOADS) __builtin_amdgcn_s_waitcnt(0x0F70); }
    else {
#pragma unroll
    for (int a = 0; a < 2; ++a)
#pragma unroll
        for (int b = 0; b < 2; ++b)
#pragma unroll
            for (int m = 0; m < 4; ++m)
#pragma unroll
                for (int n = 0; n < 2; ++n) acc[a][b][m][n] = (f32x4){0.f, 0.f, 0.f, 0.f};
    }
    bf16x8 At[4][2], B0[2][2], B1[2][2]; i32x8_t At8[4], B08[2], B18[2];
    const char* cA = (const char*)g.A + (size_t)cur.pm * tstep; const char* cB = (const char*)g.Bt + (size_t)cur.pn * tstep;
    S.a_ready(cur);
    if constexpr (SP2) {
        if constexpr (GATHER) PG8_VA(cur);
        PG8_STAGE(PG8_SB(0, 0), cB, voffB); PG8_STAGE(PG8_SB(0, 1), cB + hstep, voffB); PG8_STA(PG8_SA(0, 0), cA, gA0, 0); PG8_STA(PG8_SA(0, 1), cA + hstep, gA0, 1);
        if (wr == 1) PG8_BAR;
        PG8_WAIT_V(2); PG8_BAR;
        PG8_STAGE(PG8_SB(1, 0), cB + kstep, voffB); PG8_STA(PG8_SA(1, 0), cA + kstep, gA0 + kstep, 0); PG8_STAGE(PG8_SB(1, 1), cB + hstep + kstep, voffB);
        PG8_WAIT_V(6); PG8_BAR;
    } else {
        PG8_STAGE(PG8_SB(0, 0), cB, voffB); PG8_STAGE(PG8_SA(0, 0), cA, voffA); PG8_STAGE(PG8_SB(0, 1), cB + hstep, voffB); PG8_STAGE(PG8_SA(0, 1), cA + hstep, voffA);
        if (wr == 1) PG8_BAR;
        PG8_WAIT_V(4); PG8_BAR;
        PG8_STAGE(PG8_SB(1, 0), cB + kstep, voffB); PG8_STAGE(PG8_SA(1, 0), cA + kstep, voffA); PG8_STAGE(PG8_SB(1, 1), cB + hstep + kstep, voffB);
        PG8_WAIT_V(6); PG8_BAR;
    }
    for (;;) {
        const bool has_next = S.next(ui + 1, nxt);
        const char* nA = has_next ? (const char*)g.A + (size_t)nxt.pm * tstep : cA; const char* nB = has_next ? (const char*)g.Bt + (size_t)nxt.pn * tstep : cB;
        _Pragma("nounroll") for (int t = 0; t < nt; t += 2) {
            const bool last = (t == nt - 2);
            const char* a1 = cA + (size_t)(t + 1) * kstep;
            const char* a2 = last ? nA : cA + (size_t)(t + 2) * kstep; const char* b2 = last ? nB : cB + (size_t)(t + 2) * kstep;
            const char* a3 = a2 + kstep; const char* b3 = b2 + kstep;
            if (last && has_next) S.a_ready(nxt);
            const char* const g1 = gA0 + (size_t)(t + 1) * kstep; const char* const g2 = last ? gA0 : gA0 + (size_t)(t + 2) * kstep; const char* const g3 = g2 + kstep;
            if constexpr (SP2) {
            PG8_LDB(B0, 0, 0); PG8_LDB(B1, 0, 1); PG8_SCHED; PG8_LDA(At, 0, 0); PG8_STA(PG8_SA(1, 1), a1 + hstep, g1, 1);
            PG8_WAIT_V(8); PG8_WAIT_L(0); PG8_BAR; PG8_MMA(0, 0, At, B0); PG8_MMA(0, 1, At, B1); PG8_BAR; PG8_SCHED;
            if constexpr (GATHER) { if (last && has_next) PG8_VA(nxt); }
            PG8_LDA(At, 0, 1); PG8_STAGE(PG8_SB(0, 0), b2, voffB); PG8_STAGE(PG8_SB(0, 1), b2 + hstep, voffB); PG8_STA(PG8_SA(0, 0), a2, g2, 0);
            PG8_WAIT_V(8); PG8_WAIT_L(0); PG8_BAR; PG8_MMA(1, 0, At, B0); PG8_MMA(1, 1, At, B1); PG8_BAR; PG8_SCHED;
            PG8_LDB(B0, 1, 0); PG8_LDB(B1, 1, 1); PG8_SCHED; PG8_LDA(At, 1, 0); PG8_STA(PG8_SA(0, 1), a2 + hstep, g2, 1);
            PG8_WAIT_V(8); PG8_WAIT_L(0); PG8_BAR; PG8_MMA(0, 0, At, B0); PG8_MMA(0, 1, At, B1); PG8_BAR; PG8_SCHED;
            PG8_LDA(At, 1, 1); PG8_STAGE(PG8_SB(1, 0), b3, voffB); PG8_STAGE(PG8_SB(1, 1), b3 + hstep, voffB); PG8_STA(PG8_SA(1, 0), a3, g3, 0);
            PG8_WAIT_V(8); PG8_WAIT_L(0); PG8_BAR; PG8_MMA(1, 0, At, B0); PG8_MMA(1, 1, At, B1); PG8_BAR; PG8_SCHED;
            } else {
            PG8_LDB(B0, 0, 0); PG8_SCHED; PG8_LDA(At, 0, 0); PG8_STAGE(PG8_SA(1, 1), a1 + hstep, voffA);
            PG8_WAIT_L(8); PG8_BAR; PG8_WAIT_L(0); PG8_MMA(0, 0, At, B0); PG8_BAR; PG8_SCHED;
            PG8_LDB(B1, 0, 1); PG8_STAGE(PG8_SB(0, 0), b2, voffB);
            PG8_BAR; PG8_WAIT_L(0); PG8_MMA(0, 1, At, B1); PG8_BAR;
            PG8_LDA(At, 0, 1); PG8_STAGE(PG8_SA(0, 0), a2, voffA);
            PG8_BAR; PG8_WAIT_L(0); PG8_MMA(1, 0, At, B0); PG8_BAR; PG8_SCHED;
            PG8_STAGE(PG8_SB(0, 1), b2 + hstep, voffB);
            PG8_WAIT_V(6); PG8_BAR; PG8_MMA(1, 1, At, B1); PG8_BAR;
            PG8_LDB(B0, 1, 0); PG8_SCHED; PG8_LDA(At, 1, 0); PG8_STAGE(PG8_SA(0, 1), a2 + hstep, voffA);
            PG8_WAIT_L(8); PG8_BAR; PG8_WAIT_L(0); PG8_MMA(0, 0, At, B0); PG8_BAR; PG8_SCHED;
            PG8_LDB(B1, 1, 1); PG8_STAGE(PG8_SB(1, 0), b3, voffB);
            PG8_BAR; PG8_WAIT_L(0); PG8_MMA(0, 1, At, B1); PG8_BAR;
            PG8_LDA(At, 1, 1); PG8_STAGE(PG8_SA(1, 0), a3, voffA);
            PG8_BAR; PG8_WAIT_L(0); PG8_MMA(1, 0, At, B0); PG8_BAR; PG8_SCHED;
            PG8_STAGE(PG8_SB(1, 1), b3 + hstep, voffB);
            PG8_WAIT_V(6); PG8_BAR; PG8_MMA(1, 1, At, B1); PG8_BAR;
            }
        }
        if constexpr (ALIGN_EPI) { if (wr == 0) PG8_BAR; }
        if constexpr (!Epi::AFTER_DRAIN) { int fr_ = fr, fq_ = fq; asm volatile("" : "+v"(fr_), "+v"(fq_));
            E(acc, cur, wr, wc, fr_, fq_); S.done(cur); }
        if (!has_next) break;
        if constexpr (Epi::HAS_INIT) { int fr_ = fr, fq_ = fq; asm volatile("" : "+v"(fr_), "+v"(fq_)); E.init(acc, nxt, wr, wc, fr_, fq_); if constexpr (Epi::INIT_LOADS) __builtin_amdgcn_s_waitcnt(0x0F70); }
        else {
#pragma unroll
        for (int a = 0; a < 2; ++a)
#pragma unroll
            for (int b = 0; b < 2; ++b)
#pragma unroll
                for (int m = 0; m < 4; ++m)
#pragma unroll
                    for (int n = 0; n < 2; ++n) acc[a][b][m][n] = (f32x4){0.f, 0.f, 0.f, 0.f};
        }
        cur = nxt; cA = nA; cB = nB; ++ui;
        if constexpr (ALIGN_EPI) { if (wr == 1) PG8_BAR; }
    }
    PG8_WAIT_V(0);
    if constexpr (!ALIGN_EPI) { if (wr == 0) PG8_BAR; }
    PG8_BAR;
    if constexpr (Epi::AFTER_DRAIN) { E.fused(acc, cur, wr, wc, fr, fq, lds, wid, lane); S.done(cur); }
#undef PG8_SA
#undef PG8_CAT8
#undef PG8_VA
#undef PG8_STA
#undef PG8_SB
#undef PG8_STAGE
#undef PG8_LDA
#undef PG8_LDB
#undef PG8_MMA
#undef PG8_WAIT_V
#undef PG8_WAIT_L
#undef PG8_BAR
#undef PG8_SCHED
}
}

#ifndef PG8_SP2
#define PG8_SP2 true
#endif
#ifndef PG8_ALIGN
#define PG8_ALIGN true
#endif
#define GAS __attribute__((address_space(1)))
#define LAS __attribute__((address_space(3)))
typedef unsigned short bf16;
typedef unsigned v4u __attribute__((ext_vector_type(4)));
typedef float f32x4 __attribute__((ext_vector_type(4)));
typedef short bf16x8 __attribute__((ext_vector_type(8)));
typedef GAS unsigned gu32;
typedef GAS unsigned long long gu64;
#define RLX_AGENT __ATOMIC_RELAXED, __HIP_MEMORY_SCOPE_AGENT
#define LDS_WAIT() asm volatile("s_waitcnt lgkmcnt(0)" ::: "memory")
#define VM_WAIT() asm volatile("s_waitcnt vmcnt(0)" ::: "memory")
__device__ __forceinline__ unsigned long long rt() { return __builtin_amdgcn_s_memrealtime(); }
__device__ __forceinline__ unsigned f2bf(float f) { unsigned u = __builtin_bit_cast(unsigned, f); return (u + 0x7fffu + ((u >> 16) & 1u)) >> 16; }
__device__ __forceinline__ unsigned pk2(float lo, float hi) { return f2bf(lo) | (f2bf(hi) << 16); }

#define XB_TMO      128
#define XB_XCNT(j)  (256  + 64 * (j))
#define XB_XSUB(j)  (1280 + 64 * (j))
#define XB_XGEN(j)  (2304 + 64 * (j))
#define XB_TOP      3328
#define XB_TOPGEN   3392
#define XCD_BAR_WORDS 3456
#define XB_SPIN_CAP (1u << 18)

__device__ __forceinline__ unsigned xb_ld(unsigned* p)              { return __hip_atomic_load(p, __ATOMIC_RELAXED, __HIP_MEMORY_SCOPE_AGENT); }
__device__ __forceinline__ unsigned xb_add(unsigned* p, unsigned v) { return __hip_atomic_fetch_add(p, v, __ATOMIC_RELAXED, __HIP_MEMORY_SCOPE_AGENT); }
__device__ __forceinline__ unsigned xb_xcc_id() { return (unsigned)__builtin_amdgcn_s_getreg((3 << 11) | 20) & 0xFu; }
#define XB_SPIN(cond, bar) do { unsigned _sp = 0; while (cond) { __builtin_amdgcn_s_sleep(1); \
    if ((++_sp & 255u) == 0u) { if (xb_ld(&(bar)[XB_TMO])) break; if (_sp > XB_SPIN_CAP) { atomicAdd(&(bar)[XB_TMO], 1u); break; } } } } while (0)

struct XcdBarrier {
    unsigned* bar; unsigned x;
    volatile LAS unsigned* st;
};

__device__ __forceinline__ XcdBarrier xcd_barrier_post(unsigned* bar, volatile LAS unsigned* st) {
    XcdBarrier b; b.bar = bar; b.x = xb_xcc_id(); b.st = st;
    if (threadIdx.x == 0) (void)xb_add(&bar[XB_XCNT(b.x)], 1u);
    return b;
}
__device__ __forceinline__ void xcd_barrier_complete(unsigned* bar, unsigned x, unsigned& nloc, unsigned& nx) {
    const unsigned G = gridDim.x * gridDim.y * gridDim.z;
    unsigned sum, cnt, mine, sp = 0u;
    for (;;) {
        sum = 0u; cnt = 0u; mine = 0u;
#pragma unroll
        for (unsigned j = 0; j < 16; ++j) { const unsigned c = xb_ld(&bar[XB_XCNT(j)]); sum += c; cnt += (c > 0u) ? 1u : 0u; mine = (j == x) ? c : mine; }
        if (sum == G) break;
        __builtin_amdgcn_s_sleep(1);
        if ((++sp & 255u) == 0u) { if (xb_ld(&bar[XB_TMO])) break; if (sp > XB_SPIN_CAP) { atomicAdd(&bar[XB_TMO], 1u); break; } }
    }
    nloc = mine > 0u ? mine : 1u; nx = cnt > 0u ? cnt : 1u;
}

__device__ __forceinline__ void xcd_barrier(const XcdBarrier& b) {
    asm volatile("s_waitcnt vmcnt(0)" ::: "memory");
    __syncthreads();
    if (threadIdx.x == 0) {
        unsigned* bar = b.bar;
        __builtin_amdgcn_s_waitcnt(0);
        unsigned nloc = b.st[0], nx = b.st[1];
        if (nloc == 0u) { xcd_barrier_complete(bar, b.x, nloc, nx); b.st[0] = nloc; b.st[1] = nx; }
        const unsigned old = xb_add(&bar[XB_XSUB(b.x)], 1u);
        const unsigned gen = old / nloc;
        if (old + 1u == (gen + 1u) * nloc) {
            __builtin_amdgcn_fence(__ATOMIC_RELEASE, "agent");
            asm volatile("s_waitcnt vmcnt(0)" ::: "memory");
            const unsigned og = xb_add(&bar[XB_TOP], 1u);
            const unsigned tg = og / nx;
            if (og + 1u == (tg + 1u) * nx) xb_add(&bar[XB_TOPGEN], 1u);
            else XB_SPIN(xb_ld(&bar[XB_TOPGEN]) == tg, bar);
            __builtin_amdgcn_fence(__ATOMIC_ACQUIRE, "agent");
            xb_add(&bar[XB_XGEN(b.x)], 1u);
            asm volatile("s_waitcnt vmcnt(0)" ::: "memory");
        } else {
            XB_SPIN(xb_ld(&bar[XB_XGEN(b.x)]) == gen, bar);
            __builtin_amdgcn_fence(__ATOMIC_ACQUIRE, "agent");
            asm volatile("s_waitcnt vmcnt(0)" ::: "memory");
        }
    }
    __syncthreads();
}

constexpr int NWAVES = 8;
#ifndef MK_ONE_LAUNCH
#define MK_ONE_LAUNCH 1
#endif

constexpr int BATCH = 16, SEQ = 2048, D = 1024, T = BATCH * SEQ;
constexpr int NIN = 3584;
constexpr int OFF_SQ = 0, OFF_SK = 512, OFF_SV = 1024, OFF_HQ = 1536, OFF_HF = 2048, OFF_HI = 2560, OFF_HG = 3072;
constexpr int NE = 32, TOPK = 4, NASSIGN = T * TOPK;
constexpr int MAXTILES = NASSIGN / 256 + NE;
constexpr int MAXROWS = MAXTILES * 256;
constexpr float EPS = 1e-6f;

constexpr size_t MiB = 1u << 20;
constexpr size_t WS_CTL = 0, CTL_ZERO_BYTES = 1 * MiB;
constexpr size_t WS_WIN = 2 * MiB;
constexpr size_t WS_WOUT = 10 * MiB;
constexpr size_t WS_RT = 12 * MiB;
constexpr size_t WS_WGU = 16 * MiB;
constexpr size_t WS_WD = 144 * MiB;
constexpr size_t WS_XN = 208 * MiB;
constexpr size_t WS_P = 272 * MiB;
constexpr size_t WS_PH = WS_P + 96 * MiB;
constexpr size_t WS_MIX = 496 * MiB;
constexpr size_t WS_ACT = 272 * MiB;
constexpr size_t WS_YK = 560 * MiB;
constexpr size_t WS_QN = 624 * MiB;
constexpr size_t WS_KN = 656 * MiB;
constexpr size_t WS_VT = 688 * MiB;
constexpr size_t WS_KVS = 720 * MiB;
constexpr size_t WS_DEC = 784 * MiB;
constexpr size_t WS_SSEG = 786 * MiB;
constexpr size_t WS_DSEG = 802 * MiB;
constexpr size_t WS_LIST = 816 * MiB;
constexpr size_t WS_TOPG = 825 * MiB;
constexpr size_t WS_X8 = 560 * MiB;
constexpr size_t WS_END = 832 * MiB;
static_assert(WS_ACT + (size_t)MAXROWS * 2048 <= WS_YK && WS_YK + (size_t)T * 4 * 2048 <= WS_LIST && WS_MIX + (size_t)T * 2048 <= WS_YK, "d_ws map");
constexpr int CW_TMO = 0, CW_CODE = 1;
constexpr int CW_CNT = 64;
constexpr int CW_BAR = 4096;

constexpr int RING_OFF = 0, RING_BYTES = 131072;
constexpr int RT_ROW = 2064, RT_WL = 32 * RT_ROW, RT_END = 64 * RT_ROW;
constexpr int LDSCTL_OFF = 133120, MISC_OFF = LDSCTL_OFF + 320;
constexpr int LTAB_OFF = LDSCTL_OFF + 512;
constexpr int LT_TS = MAXTILES, LT_CNT = MAXTILES + 32, LT_MISC = MAXTILES + 64, LT_WORDS = MAXTILES + 192;
constexpr int ROWTAB_OFF = LTAB_OFF + LT_WORDS * 4;
constexpr int MAXSLOT = 17;
constexpr int ROWTAB2_OFF = ROWTAB_OFF + MAXSLOT * 1024;
constexpr int LDS_BYTES = ROWTAB2_OFF + MAXSLOT * 512;
static_assert(RT_END <= LDSCTL_OFF && MISC_OFF + 128 <= LTAB_OFF && LDS_BYTES <= 160 * 1024 && (MAXTILES * 8 + 255) / 256 <= MAXSLOT && 2 * ((MAXTILES * 4 + 255) / 256) * 1024 <= MAXSLOT * 1536 && ROWTAB_OFF % 16 == 0, "LDS map");

struct Frame {
    LAS unsigned char* lds;
    volatile LAS unsigned* MISC;
    gu32* ctl;
    int tid, lane, wave, gw, ngw;
    int vcu, G;
    const float *x, *norm1_g, *w_in, *sb_q_g, *sb_k_g, *sb_out_g, *hg_lb, *hg_out_g, *w_out, *norm2_g, *w_router, *b_router, *w_gu, *b_gu, *w_d, *b_d;
    float* out;
    unsigned char* ws;
};
__device__ __forceinline__ float bf2f(unsigned short b) { return __builtin_bit_cast(float, (unsigned)b << 16); }
__device__ __forceinline__ float bflo(unsigned w) { return __builtin_bit_cast(float, w << 16); }
__device__ __forceinline__ float bfhi(unsigned w) { return __builtin_bit_cast(float, w & 0xffff0000u); }
typedef __bf16 bf16x2n_ __attribute__((ext_vector_type(2)));
typedef float f32x2n_ __attribute__((ext_vector_type(2)));
__device__ __forceinline__ unsigned pkbf(float a, float b) { const bf16x2n_ v = __builtin_convertvector((f32x2n_){a, b}, bf16x2n_); return __builtin_bit_cast(unsigned, v); }
__device__ __forceinline__ int lane_id() { int l; asm volatile("v_mbcnt_lo_u32_b32 %0, -1, 0\n\tv_mbcnt_hi_u32_b32 %0, -1, %0" : "=v"(l)); return l; }
__device__ __forceinline__ int vzero() { int z; asm volatile("v_mov_b32 %0, 0" : "=v"(z)); return z; }
__device__ __forceinline__ float wave_sum(float v) {
#pragma unroll
    for (int o = 1; o < 64; o <<= 1) v += __shfl_xor(v, o);
    return v;
}

constexpr float W8_SCALE = 256.f, A8_SCALE = 4.f, Y8_SCALE = 32.f; static_assert(Y8_SCALE == 32.f, "SC_W8Y below is 2^-8 * 32");
constexpr int SC_ONE = 0x7f7f7f7f, SC_W8 = 0x77777777, SC_A8 = 0x7d7d7d7d, SC_W8Y = 0x7c7c7c7c;
struct P0Item { const float* W; bf16* WT; const float* rowscale; int N, k0, n0, drow0, fp8, perm; };
__device__ __forceinline__ void p0_load(const P0Item& it, f32x4 (&v)[16], int lane) {
    const int kr = lane >> 4, nc = 4 * (lane & 15);
#pragma unroll
    for (int i = 0; i < 16; ++i) v[i] = __builtin_nontemporal_load((const f32x4*)(it.W + (size_t)(it.k0 + 4 * i + kr) * it.N + it.n0 + nc));
}
__device__ __forceinline__ void p0_store(const P0Item& it, const f32x4 (&v)[16], LAS unsigned char* scr, int lane) {
    const int kr = lane >> 4, nc = 4 * (lane & 15);
#pragma unroll
    for (int i = 0; i < 16; ++i) { const float sc = it.rowscale ? it.rowscale[it.k0 + 4 * i + kr] : 1.f;
        *(LAS unsigned long long*)(scr + (4 * i + kr) * 136 + 2 * nc) = (unsigned long long)pkbf(v[i].x * sc, v[i].y * sc) | ((unsigned long long)pkbf(v[i].z * sc, v[i].w * sc) << 32); }
    LDS_WAIT(); asm volatile("" ::: "memory");
    const LAS unsigned short* s16 = (const LAS unsigned short*)scr;
    if (it.fp8) { const int p = lane & 3, nr = lane >> 2;
#pragma unroll
        for (int c = 0; c < 4; ++c) { const int n = 16 * c + nr; unsigned val[16];
#pragma unroll
            for (int kk = 0; kk < 16; ++kk) val[kk] = s16[(16 * p + kk) * 68 + n];
            v4u w4;
            w4.x = pg8::pk4_fp8(bflo(val[0]) * W8_SCALE, bflo(val[1]) * W8_SCALE, bflo(val[2]) * W8_SCALE, bflo(val[3]) * W8_SCALE);
            w4.y = pg8::pk4_fp8(bflo(val[4]) * W8_SCALE, bflo(val[5]) * W8_SCALE, bflo(val[6]) * W8_SCALE, bflo(val[7]) * W8_SCALE);
            w4.z = pg8::pk4_fp8(bflo(val[8]) * W8_SCALE, bflo(val[9]) * W8_SCALE, bflo(val[10]) * W8_SCALE, bflo(val[11]) * W8_SCALE);
            w4.w = pg8::pk4_fp8(bflo(val[12]) * W8_SCALE, bflo(val[13]) * W8_SCALE, bflo(val[14]) * W8_SCALE, bflo(val[15]) * W8_SCALE);
            *(GAS v4u*)((unsigned char*)it.WT + (size_t)(it.drow0 + (it.perm == 2 ? 128 * ((n >> 3) & 1) + 8 * (n >> 4) + (n & 7) : n)) * D + it.k0 + 16 * p) = w4; }
    } else { const int p = lane & 7, nr = lane >> 3;
#pragma unroll
        for (int c = 0; c < 8; ++c) { const int n = 8 * c + nr; unsigned val[8];
#pragma unroll
            for (int kk = 0; kk < 8; ++kk) val[kk] = s16[(8 * p + kk) * 68 + n];
            v4u w4; w4.x = val[0] | (val[1] << 16); w4.y = val[2] | (val[3] << 16); w4.z = val[4] | (val[5] << 16); w4.w = val[6] | (val[7] << 16);
            *(GAS v4u*)(it.WT + (size_t)(it.drow0 + (it.perm ? 128 * (n >> 5) + (n & 31) : n)) * D + it.k0 + 8 * p) = w4; } }
    LDS_WAIT(); asm volatile("" ::: "memory");
}
__device__ __forceinline__ void rms_rows2_to_bf16(const float* xa, const float* xb, bool hasb, const float* g, bf16* oa, bf16* ob, int lane) {
    const GAS f32x4* pa = (const GAS f32x4*)xa + lane; const GAS f32x4* pb = (const GAS f32x4*)(hasb ? xb : xa) + lane; const f32x4* gr = (const f32x4*)g + lane;
    f32x4 va[4], vb[4], gg[4]; float sa = 0.f, sb = 0.f;
#pragma unroll
    for (int j = 0; j < 4; ++j) { va[j] = __builtin_nontemporal_load(pa + 64 * j); vb[j] = __builtin_nontemporal_load(pb + 64 * j); gg[j] = gr[64 * j]; }
#pragma unroll
    for (int j = 0; j < 4; ++j) { sa += (va[j].x * va[j].x + va[j].y * va[j].y) + (va[j].z * va[j].z + va[j].w * va[j].w); sb += (vb[j].x * vb[j].x + vb[j].y * vb[j].y) + (vb[j].z * vb[j].z + vb[j].w * vb[j].w); }
    const float ra = 1.f / sqrtf(wave_sum(sa) * (1.f / D) + EPS), rb = 1.f / sqrtf(wave_sum(sb) * (1.f / D) + EPS);
    GAS unsigned long long* o8a = (GAS unsigned long long*)oa + lane; GAS unsigned long long* o8b = (GAS unsigned long long*)ob + lane;
#pragma unroll
    for (int j = 0; j < 4; ++j) o8a[64 * j] = (unsigned long long)pkbf(va[j].x * ra * gg[j].x, va[j].y * ra * gg[j].y) | ((unsigned long long)pkbf(va[j].z * ra * gg[j].z, va[j].w * ra * gg[j].w) << 32);
    if (hasb) {
#pragma unroll
        for (int j = 0; j < 4; ++j) o8b[64 * j] = (unsigned long long)pkbf(vb[j].x * rb * gg[j].x, vb[j].y * rb * gg[j].y) | ((unsigned long long)pkbf(vb[j].z * rb * gg[j].z, vb[j].w * rb * gg[j].w) << 32); }
}
__device__ __forceinline__ P0Item p0_item(Frame& F, int r) {
    constexpr int I_IN = 16 * (NIN / 64), I_OUT = 16 * 16, I_GU = NE * 16 * 32;
    P0Item it;
    if (r < I_IN) { const int nb = NIN / 64, kb = r / nb, nn = r % nb; const int pq = nn < 16; it = P0Item{F.w_in, (bf16*)(F.ws + WS_WIN), nullptr, NIN, 64 * kb, 64 * nn, pq ? 256 * (nn >> 2) + 32 * (nn & 3) : 64 * nn, 0, pq}; return it; } r -= I_IN;
    if (r < I_OUT) { const int kb = r / 16, nn = r % 16; it = P0Item{F.w_out, (bf16*)(F.ws + WS_WOUT), nullptr, D, 64 * kb, 64 * nn, 64 * nn, 0, 0}; return it; } r -= I_OUT;
    if (r < I_GU) { const int e = r / 512, q = r % 512, kb = q / 32, nn = q % 32;
        const int isup = nn >> 4, a = (nn & 15) * 64;
        it = P0Item{F.w_gu + (size_t)e * D * 2048, (bf16*)(F.ws + WS_WGU + (size_t)e * 2048 * D), F.norm2_g, 2048, 64 * kb, 64 * nn, 256 * (a >> 7) + 128 * isup + (a & 127), 1, 0}; return it; } r -= I_GU;
    { const int e = r / 256, q = r % 256, kb = q / 16, nn = q % 16;
        it = P0Item{F.w_d + (size_t)e * D * D, (bf16*)(F.ws + WS_WD + (size_t)e * D * D), nullptr, D, 64 * kb, 64 * nn, 256 * (nn >> 2) + 32 * (nn & 3), 1, 2}; return it; }
}
constexpr int P0_NITEMS = 16 * (NIN / 64) + 16 * 16 + NE * 16 * 32 + NE * 16 * 16;
constexpr int P0_NLATE = 1024;
__device__ __forceinline__ void p0_items(Frame& F, int lo, int hi, int w, int nw) {
    LAS unsigned char* scr = F.lds + RING_OFF + F.wave * 16384;
    f32x4 va[16], vb[16]; int it = lo + w;
    if (it < hi) { P0Item A = p0_item(F, it); p0_load(A, va, F.lane);
        for (;;) {
            const int itb = it + nw; const bool hb = itb < hi; const P0Item B = p0_item(F, hb ? itb : it); p0_load(B, vb, F.lane); __builtin_amdgcn_sched_barrier(0);
            p0_store(A, va, scr, F.lane);
            if (!hb) break;
            it = itb + nw; const bool ha = it < hi; A = p0_item(F, ha ? it : itb); p0_load(A, va, F.lane); __builtin_amdgcn_sched_barrier(0);
            p0_store(B, vb, scr, F.lane);
            if (!ha) break;
        }
    }
}
__device__ __forceinline__ void p0_prologue(Frame& F) {
    p0_items(F, 0, P0_NITEMS - P0_NLATE, F.gw, F.ngw);
    for (int q = blockIdx.x * (NWAVES * 64) + F.tid; q < 4096; q += F.G * NWAVES * 64) {
        const int e = q & 31, k0 = (q >> 5) * 8; unsigned hi[8], lo[8];
#pragma unroll
        for (int j = 0; j < 8; ++j) { const float w = F.w_router[(k0 + j) * 32 + e] * F.norm2_g[k0 + j]; hi[j] = pkbf(w, 0.f) & 0xffffu; lo[j] = pkbf(w - bflo(hi[j]), 0.f) & 0xffffu; }
        const v4u h4 = {hi[0] | (hi[1] << 16), hi[2] | (hi[3] << 16), hi[4] | (hi[5] << 16), hi[6] | (hi[7] << 16)}, l4 = {lo[0] | (lo[1] << 16), lo[2] | (lo[3] << 16), lo[4] | (lo[5] << 16), lo[6] | (lo[7] << 16)};
        *(GAS v4u*)(F.ws + WS_RT + e * RT_ROW + 2 * k0) = h4; *(GAS v4u*)(F.ws + WS_RT + RT_WL + e * RT_ROW + 2 * k0) = l4; }
    for (int m = F.gw; m < T; m += 2 * F.ngw) rms_rows2_to_bf16(F.x + (size_t)m * D, F.x + (size_t)(m + F.ngw) * D, m + F.ngw < T, F.norm1_g, (bf16*)(F.ws + WS_XN) + (size_t)m * D, (bf16*)(F.ws + WS_XN) + (size_t)(m + F.ngw) * D, F.lane);
}

typedef float f32x16 __attribute__((ext_vector_type(16)));
typedef __bf16 bf16x2n __attribute__((ext_vector_type(2)));
typedef float f32x2n __attribute__((ext_vector_type(2)));
#define MFMA32(a, b, c) __builtin_amdgcn_mfma_f32_32x32x16_bf16((a), (b), (c), 0, 0, 0)
__device__ __forceinline__ bf16x8 pack8(float a0, float a1, float a2, float a3, float a4, float a5, float a6, float a7) { const v4u p = {pkbf(a0, a1), pkbf(a2, a3), pkbf(a4, a5), pkbf(a6, a7)}; return __builtin_bit_cast(bf16x8, p); }
constexpr float QSCALE = 0.125f * 1.44269504089f;
__device__ __forceinline__ void prep_phase(Frame& F) {
    LAS unsigned* tl = (LAS unsigned*)(F.lds + RING_OFF + F.wave * 16384);
    const bf16* P = (const bf16*)(F.ws + WS_P); bf16* Qn = (bf16*)(F.ws + WS_QN); bf16* Kn = (bf16*)(F.ws + WS_KN); bf16* VT = (bf16*)(F.ws + WS_VT);
    const int tr = F.lane >> 3, c8 = F.lane & 7;
    for (int it = F.gw; it < 4096; it += F.ngw) {
        const int bh = it & 127, blk = it >> 7, b = bh >> 3, h = bh & 7;
        const bf16* base = P + ((size_t)b * 8 + h) * SEQ * 64 + (size_t)(blk * 64 + tr) * 64 + 8 * c8;
        v4u rv[8];
#pragma unroll
        for (int i = 0; i < 8; ++i) { const bf16* row = base + (size_t)(8 * i) * 64; rv[i] = *(const GAS v4u*)(row + (size_t)2 * 16 * 8 * SEQ * 64); }
        {
#pragma unroll
            for (int i = 0; i < 8; ++i) { LAS unsigned* q = tl + (8 * i + tr) * 33 + 4 * c8; q[0] = rv[i].x; q[1] = rv[i].y; q[2] = rv[i].z; q[3] = rv[i].w; }
            LDS_WAIT(); asm volatile("" ::: "memory");
            const LAS unsigned short* t16 = (const LAS unsigned short*)tl; const int dr = tr;
#define KAP(pos) (((pos) & ~12) | (((pos) & 4) << 1) | (((pos) & 8) >> 1))
            bf16* const obase = VT + ((size_t)bh * 64 + blk * 2 + (c8 >> 2)) * 2048 + ((c8 >> 1) & 1) * 512 + (c8 & 1) * 256;
#pragma unroll
            for (int j = 0; j < 8; ++j) { unsigned val[8];
#pragma unroll
                for (int p = 0; p < 8; ++p) { const int pos = 8 * c8 + p; val[p] = t16[KAP(pos) * 66 + 8 * j + dr]; }
                v4u w4; w4.x = val[0] | (val[1] << 16); w4.y = val[2] | (val[3] << 16); w4.z = val[4] | (val[5] << 16); w4.w = val[6] | (val[7] << 16);
                *(GAS v4u*)(obase + (j >> 2) * 1024 + ((8 * j + dr) & 31) * 8) = w4; }
#undef KAP
            LDS_WAIT(); asm volatile("" ::: "memory");
        }
    }
}

__device__ __forceinline__ int crow16(int i, int hh) { return (i & 3) + 8 * (i >> 2) + 4 * hh; }
__device__ __forceinline__ void attn_item(Frame& F, int bh, int qb, float thr, const bf16x8 (&Lt)[2]) {
    const int r = F.lane & 31, hh = F.lane >> 5, b = bh >> 3, h = bh & 7, q0 = qb * 32;
    const bf16* Qn = (const bf16*)(F.ws + WS_QN); const bf16* Kn = (const bf16*)(F.ws + WS_KN); const bf16* VT = (const bf16*)(F.ws + WS_VT);
    bf16x8 qf[4];
#pragma unroll
    for (int s = 0; s < 4; ++s) qf[s] = *(const GAS bf16x8*)(Qn + ((size_t)bh * 64 + qb) * 2048 + s * 512 + F.lane * 8);
    f32x4 gout[2][4];
#pragma unroll
    for (int db = 0; db < 2; ++db)
#pragma unroll
        for (int gq = 0; gq < 4; ++gq) gout[db][gq] = *(const f32x4*)(F.sb_out_g + h * 64 + 32 * db + 8 * gq + 4 * hh);
    f32x16 O0, O1;
#pragma unroll
    for (int i = 0; i < 16; ++i) { O0[i] = 0.f; O1[i] = 0.f; }
    float carry = 0.f;
    const bf16* kbase = Kn + (size_t)bh * 64 * 2048 + F.lane * 8; const bf16* vbase = VT + (size_t)bh * 64 * 2048 + F.lane * 8;
#define ATT_LOAD(KF, VF, kb_) do { _Pragma("unroll") for (int s_ = 0; s_ < 4; ++s_) KF[s_] = *(const GAS bf16x8*)(kbase + (size_t)(kb_) * 2048 + 512 * s_); \
        _Pragma("unroll") for (int db_ = 0; db_ < 2; ++db_) _Pragma("unroll") for (int ks_ = 0; ks_ < 2; ++ks_) VF[db_][ks_] = *(const GAS bf16x8*)(vbase + (size_t)(kb_) * 2048 + 1024 * db_ + 512 * ks_); } while (0)
#define ATT_BLOCK(KF, VF, kb_) do { const bool diag = ((kb_) == qb); \
        f32x16 z; _Pragma("unroll") for (int i = 0; i < 16; ++i) z[i] = 0.f; \
        _Pragma("unroll") for (int s_ = 0; s_ < 4; ++s_) z = MFMA32(KF[s_], qf[s_], z); \
        float sp[16]; \
        _Pragma("unroll") for (int i = 0; i < 16; ++i) { const float zz = z[i]; float v = fmaxf(zz, 0.f) + __builtin_amdgcn_logf(1.f + __builtin_amdgcn_exp2f(-fabsf(zz))); if (diag && !(crow16(i, hh) < r)) v = 0.f; sp[i] = v; } \
        const bf16x8 sb0 = pack8(sp[0], sp[1], sp[2], sp[3], sp[4], sp[5], sp[6], sp[7]), sb1 = pack8(sp[8], sp[9], sp[10], sp[11], sp[12], sp[13], sp[14], sp[15]); \
        f32x16 Cc; _Pragma("unroll") for (int i = 0; i < 16; ++i) Cc[i] = carry; \
        Cc = MFMA32(Lt[0], sb0, Cc); Cc = MFMA32(Lt[1], sb1, Cc); \
        float w[16]; \
        _Pragma("unroll") for (int i = 0; i < 16; ++i) { float v = __builtin_amdgcn_exp2f(z[i] - Cc[i]); if (diag && !(crow16(i, hh) < r)) v = 0.f; w[i] = v; } \
        const bf16x8 wb0 = pack8(w[0], w[1], w[2], w[3], w[4], w[5], w[6], w[7]), wb1 = pack8(w[8], w[9], w[10], w[11], w[12], w[13], w[14], w[15]); \
        O0 = MFMA32(VF[0][0], wb0, O0); O0 = MFMA32(VF[0][1], wb1, O0); O1 = MFMA32(VF[1][0], wb0, O1); O1 = MFMA32(VF[1][1], wb1, O1); \
        carry = __shfl(Cc[0], r); } while (0)
    bf16x8 kfA[4], vfA[2][2], kfB[4], vfB[2][2];
    ATT_LOAD(kfA, vfA, qb);
    for (int kb = qb; kb >= 0; kb -= 2) {
        ATT_LOAD(kfB, vfB, kb > 0 ? kb - 1 : 0); __builtin_amdgcn_sched_barrier(0);
        ATT_BLOCK(kfA, vfA, kb);
        if (kb == 0 || __all(carry > thr)) break;
        ATT_LOAD(kfA, vfA, kb > 1 ? kb - 2 : 0); __builtin_amdgcn_sched_barrier(0);
        ATT_BLOCK(kfB, vfB, kb - 1);
        if (__all(carry > thr)) break;
    }
#undef ATT_LOAD
#undef ATT_BLOCK
    float ss = 0.f;
#pragma unroll
    for (int i = 0; i < 16; ++i) ss += O0[i] * O0[i] + O1[i] * O1[i];
    ss += __shfl_xor(ss, 32);
    const float rs = 1.f / sqrtf(ss * (1.f / 64.f) + EPS);
    bf16* orow = (bf16*)(F.ws + WS_MIX) + ((size_t)b * SEQ + q0 + r) * D + h * 64;
#pragma unroll
    for (int db = 0; db < 2; ++db) { unsigned op[4][2];
#pragma unroll
        for (int gq = 0; gq < 4; ++gq) { const f32x4 gg = gout[db][gq];
            const float a0 = (db ? O1[4 * gq + 0] : O0[4 * gq + 0]) * rs * gg.x, a1 = (db ? O1[4 * gq + 1] : O0[4 * gq + 1]) * rs * gg.y, a2 = (db ? O1[4 * gq + 2] : O0[4 * gq + 2]) * rs * gg.z, a3 = (db ? O1[4 * gq + 3] : O0[4 * gq + 3]) * rs * gg.w;
            op[gq][0] = pkbf(a0, a1); op[gq][1] = pkbf(a2, a3); }
#pragma unroll
        for (int gp = 0; gp < 2; ++gp) { const auto s0 = __builtin_amdgcn_permlane32_swap(op[2 * gp][0], op[2 * gp + 1][0], false, false), s1 = __builtin_amdgcn_permlane32_swap(op[2 * gp][1], op[2 * gp + 1][1], false, false);
            *(GAS v4u*)(orow + 32 * db + 8 * (2 * gp + hh)) = (v4u){s0[0], s1[0], s0[1], s1[1]}; } }
}
__device__ __forceinline__ void attn_phase(Frame& F) {
    const int r = F.lane & 31, hh = F.lane >> 5;
    float mq = fabsf(F.sb_q_g[F.lane]), mk = fabsf(F.sb_k_g[F.lane]);
#pragma unroll
    for (int o = 1; o < 64; o <<= 1) { mq = fmaxf(mq, __shfl_xor(mq, o)); mk = fmaxf(mk, __shfl_xor(mk, o)); }
    const float thr = 64.f * QSCALE * mq * mk * 1.02f + 151.f;
    bf16x8 Lt[2];
#pragma unroll
    for (int ks = 0; ks < 2; ++ks) { float e[8];
#pragma unroll
        for (int jj = 0; jj < 8; ++jj) e[jj] = (16 * ks + 8 * (jj >> 2) + 4 * hh + (jj & 3) >= r) ? 1.f : 0.f;
        Lt[ks] = pack8(e[0], e[1], e[2], e[3], e[4], e[5], e[6], e[7]); }
    for (int it = F.gw; it < 2048; it += F.ngw) { const int bh = it & 127, j = it >> 7;
        attn_item(F, bh, 63 - j, thr, Lt); attn_item(F, bh, j, thr, Lt); attn_item(F, bh, 47 - j, thr, Lt); attn_item(F, bh, 16 + j, thr, Lt); }
}

constexpr int HG_PART = 0, HG_SSQ = 2048, HG_QE = 4096, HG_KE = HG_QE + 64 * 272, HG_VT = HG_KE + 64 * 272, HG_KST = HG_VT + 128 * 144, HG_ST = HG_KST + 128 * 144, HG_END = HG_ST + 128 * 272;
static_assert(HG_END <= RING_BYTES, "HGRN2 LDS map");
__device__ __forceinline__ float hg_lbound(Frame& F, int h, int d) { const int c = h * 128 + d; return 1.f / (1.f + __expf(F.hg_lb[512 + c] - F.hg_lb[c])); }
__device__ __forceinline__ void hg_gates(Frame& F, const unsigned short (&ffr)[16], float lb, int d, int tq, float (&bb)[16], float (&kk)[16], float& total) {
    float run = 1.f;
#pragma unroll
    for (int i = 0; i < 16; ++i) { const float ff = bf2f(ffr[i]); const float sg = __builtin_amdgcn_rcpf(1.f + __expf(-ff));
        const float f = lb + (1.f - lb) * sg; kk[i] = (1.f - lb) * (1.f - sg); run *= f; bb[i] = run; }
    LAS float* part = (LAS float*)(F.lds + RING_OFF + HG_PART);
    part[tq * 128 + d] = run;
    __syncthreads();
    const float p0 = part[d], p1 = part[128 + d], p2 = part[256 + d], p3 = part[384 + d];
    const float off = (tq > 0 ? p0 : 1.f) * (tq > 1 ? p1 : 1.f) * (tq > 2 ? p2 : 1.f);
    total = (p0 * p1) * (p2 * p3);
#pragma unroll
    for (int i = 0; i < 16; ++i) bb[i] *= off;
}
#define HG_HV() const bf16* const PHp = (const bf16*)(F.ws + WS_PH); \
    const __amdgpu_buffer_rsrc_t rsrcP = __builtin_amdgcn_make_buffer_rsrc((void*)PHp, 0, (int)((size_t)4 * T * 512 * 2), 0x00020000)
#define HG_SOFF(item_, arr_) ((unsigned)((((arr_) * 16 + (((item_) >> 5) >> 2)) * 4 + (((item_) >> 5) & 3)) * SEQ + ((item_) & 31) * 64) * 256u)
#define HG_ARR(col_) ((col_) == OFF_HQ ? 0 : (col_) == OFF_HF ? 1 : (col_) == OFF_HI ? 2 : 3)
#define HG_LOADT(dst2, item_, arr_) do { const unsigned so_ = (unsigned)__builtin_amdgcn_readfirstlane((int)HG_SOFF(item_, arr_)); _Pragma("unroll") for (int j_ = 0; j_ < 2; ++j_) \
        (dst2)[j_] = __builtin_bit_cast(v4u, __builtin_amdgcn_raw_buffer_load_b128(rsrcP, (unsigned)F.tid * 16u + 8192u * j_, so_, 0)); } while (0)
#define HG_PUT(src2, raw_) do { _Pragma("unroll") for (int j_ = 0; j_ < 2; ++j_) *(LAS v4u*)((raw_) + ((F.tid >> 4) + 32 * j_) * 272 + (F.tid & 15) * 16) = (src2)[j_]; } while (0)
#define HG_COL(dst, raw_) do { _Pragma("unroll") for (int i_ = 0; i_ < 16; ++i_) dst[i_] = *(const LAS unsigned short*)((raw_) + (16 * tq + i_) * 272 + 2 * d); } while (0)
template <bool PERMUTE> __device__ __forceinline__ void st16(LAS unsigned char* dst, const float (&v)[16]) {
    v4u a, b2;
    if (!PERMUTE) { a.x = pkbf(v[0], v[1]); a.y = pkbf(v[2], v[3]); a.z = pkbf(v[4], v[5]); a.w = pkbf(v[6], v[7]); b2.x = pkbf(v[8], v[9]); b2.y = pkbf(v[10], v[11]); b2.z = pkbf(v[12], v[13]); b2.w = pkbf(v[14], v[15]); }
    else { a.x = pkbf(v[0], v[1]); a.y = pkbf(v[2], v[3]); a.z = pkbf(v[8], v[9]); a.w = pkbf(v[10], v[11]); b2.x = pkbf(v[4], v[5]); b2.y = pkbf(v[6], v[7]); b2.z = pkbf(v[12], v[13]); b2.w = pkbf(v[14], v[15]); }
    *(LAS v4u*)dst = a; *(LAS v4u*)(dst + 16) = b2;
}
__device__ __forceinline__ void hgA_phase(Frame& F) {
    const int d = F.tid & 127, tq = F.tid >> 7, r = F.lane & 31, hh = F.lane >> 5;
    const bf16* P = (const bf16*)(F.ws + WS_P); bf16* KVS = (bf16*)(F.ws + WS_KVS); float* DEC = (float*)(F.ws + WS_DEC); float* SSEG = (float*)(F.ws + WS_SSEG); float* DSEG = (float*)(F.ws + WS_DSEG);
    LAS unsigned char* L = F.lds + RING_OFF; LAS float* decl = (LAS float*)(L + HG_SSQ);
    HG_HV();
    v4u rf[2], rv[2];
    LAS unsigned char* const RAWF = F.lds + ROWTAB_OFF; LAS unsigned char* const RAWV = L + HG_ST;
    for (int wg = blockIdx.x; wg < 256; wg += F.G) {
        const int bh = wg >> 2, seg = wg & 3, item0 = bh * 32 + seg * 8, h = bh & 3;
        HG_LOADT(rf, item0, 1); HG_LOADT(rv, item0, 2);
        const float lbv = hg_lbound(F, h, d); float totrun = 1.f;
        const int db = F.wave & 3, eb0 = 2 * (F.wave >> 2);
        f32x16 run0, run1;
#pragma unroll
        for (int i = 0; i < 16; ++i) { run0[i] = 0.f; run1[i] = 0.f; }
      for (int k = 0; k < 8; ++k) {
        const int item = item0 + k;
        HG_PUT(rf, RAWF); HG_PUT(rv, RAWV);
        __syncthreads();
        { const int nit = k < 7 ? item + 1 : item; HG_LOADT(rf, nit, 1); HG_LOADT(rv, nit, 2); __builtin_amdgcn_sched_barrier(0); }
        unsigned short ffr[16], vr[16]; HG_COL(ffr, RAWF); HG_COL(vr, RAWV);
        float bb[16], kk[16], total; hg_gates(F, ffr, lbv, d, tq, bb, kk, total);
        float ks[16], vv[16];
#pragma unroll
        for (int i = 0; i < 16; ++i) { ks[i] = kk[i] * (total * __builtin_amdgcn_rcpf(bb[i])); vv[i] = bf2f(vr[i]); }
        st16<false>(L + HG_KST + d * 144 + tq * 32, ks); st16<false>(L + HG_VT + d * 144 + tq * 32, vv);
        const float dc = total; totrun *= total;
        if (tq == 0) { DEC[(size_t)item * 128 + d] = dc; decl[d] = dc; }
        __syncthreads();
        f32x16 acc0, acc1;
#pragma unroll
        for (int i = 0; i < 16; ++i) { acc0[i] = 0.f; acc1[i] = 0.f; }
#pragma unroll
        for (int s = 0; s < 4; ++s) { const bf16x8 af = *(const LAS bf16x8*)(L + HG_KST + (db * 32 + r) * 144 + 32 * s + 16 * hh);
            const bf16x8 b0 = *(const LAS bf16x8*)(L + HG_VT + (eb0 * 32 + r) * 144 + 32 * s + 16 * hh), b1 = *(const LAS bf16x8*)(L + HG_VT + ((eb0 + 1) * 32 + r) * 144 + 32 * s + 16 * hh);
            acc0 = MFMA32(af, b0, acc0); acc1 = MFMA32(af, b1, acc1); }
#pragma unroll
        for (int g = 0; g < 4; ++g) { const f32x4 dl = *(const LAS f32x4*)(decl + db * 32 + 8 * g + 4 * hh);
#pragma unroll
            for (int ii = 0; ii < 4; ++ii) { run0[4 * g + ii] = dl[ii] * run0[4 * g + ii] + acc0[4 * g + ii]; run1[4 * g + ii] = dl[ii] * run1[4 * g + ii] + acc1[4 * g + ii]; } }
#pragma unroll
        for (int j = 0; j < 2; ++j) { bf16* dst = KVS + ((size_t)item * 128 + (eb0 + j) * 32 + r) * 128 + db * 32;
#pragma unroll
            for (int gp = 0; gp < 2; ++gp) { unsigned pk[2][2];
#pragma unroll
                for (int q = 0; q < 2; ++q) { const int g = 2 * gp + q; const float a0 = j ? acc1[4 * g + 0] : acc0[4 * g + 0], a1 = j ? acc1[4 * g + 1] : acc0[4 * g + 1], a2 = j ? acc1[4 * g + 2] : acc0[4 * g + 2], a3 = j ? acc1[4 * g + 3] : acc0[4 * g + 3];
                    pk[q][0] = pkbf(a0, a1); pk[q][1] = pkbf(a2, a3); }
                const auto s0 = __builtin_amdgcn_permlane32_swap(pk[0][0], pk[1][0], false, false), s1 = __builtin_amdgcn_permlane32_swap(pk[0][1], pk[1][1], false, false);
                const v4u w4 = {s0[0], s1[0], s0[1], s1[1]};
                *(GAS v4u*)(dst + 8 * (2 * gp + hh)) = w4; } }
        __syncthreads();
      }
#pragma unroll
        for (int j = 0; j < 2; ++j) { float* dst = SSEG + ((size_t)wg * 128 + (eb0 + j) * 32 + r) * 128 + db * 32 + 4 * hh;
#pragma unroll
            for (int g = 0; g < 4; ++g) *(GAS f32x4*)(dst + 8 * g) = j ? (f32x4){run1[4 * g + 0], run1[4 * g + 1], run1[4 * g + 2], run1[4 * g + 3]} : (f32x4){run0[4 * g + 0], run0[4 * g + 1], run0[4 * g + 2], run0[4 * g + 3]}; }
        if (tq == 0) DSEG[(size_t)wg * 128 + d] = totrun;
    }
}
constexpr int HG_DECS = HG_END;
static_assert(HG_DECS + 4096 + 64 * 272 <= LDSCTL_OFF && HG_KST + 64 * 272 <= HG_ST && 64 * 272 <= MAXSLOT * 1536, "HGRN2 LDS map (decays, raw tiles)");
__device__ __forceinline__ void hgC_phase(Frame& F) {
    const int d = F.tid & 127, tq = F.tid >> 7, r = F.lane & 31, hh = F.lane >> 5;
    const bf16* P = (const bf16*)(F.ws + WS_P); const bf16* KVS = (const bf16*)(F.ws + WS_KVS); bf16* MIX = (bf16*)(F.ws + WS_MIX); const float* DEC = (const float*)(F.ws + WS_DEC);
    HG_HV();
    LAS unsigned char* L = F.lds + RING_OFF; const LAS float* decs = (const LAS float*)(L + HG_DECS);
    const int srow = (F.tid >> 6) * 16 + ((F.tid & 63) >> 4), sd0 = 8 * (F.tid & 15);
    v4u rf[2], rq[2], rv[2], st[4];
    LAS unsigned char* const RAWF = L + HG_KST; LAS unsigned char* const RAWQ = F.lds + ROWTAB_OFF; LAS unsigned char* const RAWV = L + HG_DECS + 4096;
    const __amdgpu_buffer_rsrc_t rsrcG = __builtin_amdgcn_make_buffer_rsrc((void*)F.hg_out_g, 0, 512 * 4, 0x00020000), rsrcSS = __builtin_amdgcn_make_buffer_rsrc((void*)(F.ws + WS_SSEG), 0, 256 * 128 * 128 * 4, 0x00020000), rsrcDS = __builtin_amdgcn_make_buffer_rsrc((void*)(F.ws + WS_DSEG), 0, 256 * 128 * 4, 0x00020000);
    const __amdgpu_buffer_rsrc_t rsrcD = __builtin_amdgcn_make_buffer_rsrc((void*)DEC, 0, 64 * 32 * 128 * 4, 0x00020000), rsrcM = __builtin_amdgcn_make_buffer_rsrc((void*)MIX, 0, (int)((size_t)T * D * 2), 0x00020000);
    const __amdgpu_buffer_rsrc_t rsrcK = __builtin_amdgcn_make_buffer_rsrc((void*)KVS, 0, 64 * 32 * 128 * 128 * 2, 0x00020000); const unsigned kvo = (unsigned)((srow * 128 + sd0) * 2);
#define HG_LOADKV(dst_, item_) do { const unsigned so_ = (unsigned)__builtin_amdgcn_readfirstlane((int)((item_) * (128 * 128 * 2))); _Pragma("unroll") for (int j_ = 0; j_ < 4; ++j_) (dst_)[j_] = __builtin_bit_cast(v4u, __builtin_amdgcn_raw_buffer_load_b128(rsrcK, kvo + 1024u * j_, so_, 0)); } while (0)
#define HG_LOADST(item_) HG_LOADKV(st, item_)
#define HG_FOLD(kv_, c_) do { const f32x4 d0_ = *(const LAS f32x4*)(decs + (c_) * 128 + sd0), d1_ = *(const LAS f32x4*)(decs + (c_) * 128 + sd0 + 4); _Pragma("unroll") for (int j_ = 0; j_ < 4; ++j_) { const v4u k_ = (kv_)[j_]; \
        S[8 * j_ + 0] = d0_.x * S[8 * j_ + 0] + bflo(k_.x); S[8 * j_ + 1] = d0_.y * S[8 * j_ + 1] + bfhi(k_.x); S[8 * j_ + 2] = d0_.z * S[8 * j_ + 2] + bflo(k_.y); S[8 * j_ + 3] = d0_.w * S[8 * j_ + 3] + bfhi(k_.y); \
        S[8 * j_ + 4] = d1_.x * S[8 * j_ + 4] + bflo(k_.z); S[8 * j_ + 5] = d1_.y * S[8 * j_ + 5] + bfhi(k_.z); S[8 * j_ + 6] = d1_.z * S[8 * j_ + 6] + bflo(k_.w); S[8 * j_ + 7] = d1_.w * S[8 * j_ + 7] + bfhi(k_.w); } } while (0)
    for (int wg = blockIdx.x; wg < 256; wg += F.G) {
        const int bh = wg >> 2, seg = wg & 3, item0 = bh * 32 + seg * 8, b = bh >> 2, h = bh & 3;
        HG_LOADT(rf, item0, 1); HG_LOADT(rq, item0, 0); HG_LOADT(rv, item0, 2); HG_LOADST(item0);
        const unsigned dso0 = (unsigned)__builtin_amdgcn_readfirstlane((bh * 32 + seg * 8) * 128 * 4);
        const f32x4 decv = __builtin_bit_cast(f32x4, __builtin_amdgcn_raw_buffer_load_b128(rsrcD, (unsigned)(F.tid & 255) * 16u, dso0, 0));
        const float lbv = hg_lbound(F, h, d);
        __builtin_amdgcn_sched_barrier(0);
        float S[32];
#pragma unroll
        for (int j = 0; j < 32; ++j) S[j] = 0.f;
        for (int sp = 0; sp < seg; ++sp) {
            const unsigned sso = (unsigned)__builtin_amdgcn_readfirstlane((bh * 4 + sp) * 128 * 128 * 4), dso = (unsigned)__builtin_amdgcn_readfirstlane((bh * 4 + sp) * 128 * 4);
#pragma unroll
            for (int j0 = 0; j0 < 8; j0 += 8) { f32x4 sv[8], dv[8];
#pragma unroll
                for (int j = 0; j < 8; ++j) { sv[j] = __builtin_bit_cast(f32x4, __builtin_amdgcn_raw_buffer_load_b128(rsrcSS, (unsigned)((srow * 128 + sd0) * 4) + 2048u * ((j0 + j) >> 1) + 16u * ((j0 + j) & 1), sso, 0));
                    dv[j] = __builtin_bit_cast(f32x4, __builtin_amdgcn_raw_buffer_load_b128(rsrcDS, (unsigned)(sd0 * 4) + 16u * ((j0 + j) & 1), dso, 0)); }
#pragma unroll
                for (int j = 0; j < 8; ++j) { const int q = 4 * (j0 + j); S[q + 0] = dv[j].x * S[q + 0] + sv[j].x; S[q + 1] = dv[j].y * S[q + 1] + sv[j].y; S[q + 2] = dv[j].z * S[q + 2] + sv[j].z; S[q + 3] = dv[j].w * S[q + 3] + sv[j].w; } }
        }
        if (F.tid < 256) *((LAS f32x4*)(L + HG_DECS) + F.tid) = decv;
        __syncthreads();
      for (int k = 0; k < 8; ++k) {
        const int item = item0 + k, c = seg * 8 + k;
        const int tb = F.wave & 1, eb = F.wave >> 1;
        const int nit = k < 7 ? item + 1 : item;
        HG_PUT(rf, RAWF); HG_PUT(rq, RAWQ); HG_PUT(rv, RAWV);
        __syncthreads();
        HG_LOADT(rf, nit, 1); HG_LOADT(rq, nit, 0); HG_LOADT(rv, nit, 2); __builtin_amdgcn_sched_barrier(0);
        unsigned short ffr[16], qr[16], vr[16]; HG_COL(ffr, RAWF); HG_COL(qr, RAWQ); HG_COL(vr, RAWV);
        float bb[16], kk[16], total; hg_gates(F, ffr, lbv, d, tq, bb, kk, total);
        float vv[16];
#pragma unroll
        for (int i = 0; i < 16; ++i) { const int t = 16 * tq + i; const float q = bf2f(qr[i]);
            *(LAS unsigned short*)(L + HG_QE + t * 272 + 2 * d) = (unsigned short)pkbf(q * bb[i], 0.f);
            *(LAS unsigned short*)(L + HG_KE + t * 272 + 2 * d) = (unsigned short)pkbf(kk[i] * __builtin_amdgcn_rcpf(bb[i]), 0.f);
            vv[i] = bf2f(vr[i]); }
        st16<true>(L + HG_VT + d * 144 + tq * 32, vv);
#pragma unroll
        for (int j = 0; j < 4; ++j) { v4u w4; w4.x = pkbf(S[8 * j + 0], S[8 * j + 1]); w4.y = pkbf(S[8 * j + 2], S[8 * j + 3]); w4.z = pkbf(S[8 * j + 4], S[8 * j + 5]); w4.w = pkbf(S[8 * j + 6], S[8 * j + 7]);
            *(LAS v4u*)(L + HG_ST + (srow + 4 * j) * 272 + sd0 * 2) = w4; }
        HG_FOLD(st, k);
        v4u grw[2];
        { const bf16* grow_ = PHp + (((size_t)(3 * 16 + b) * 4 + h) * SEQ + c * 64 + tb * 32 + r) * 128;
#pragma unroll
            for (int gp = 0; gp < 2; ++gp) grw[gp] = *(const GAS v4u*)(grow_ + eb * 32 + 8 * (2 * gp + hh)); }
        HG_LOADST(nit); __builtin_amdgcn_sched_barrier(0);
        __syncthreads();
        f32x16 acc;
#pragma unroll
        for (int i = 0; i < 16; ++i) acc[i] = 0.f;
#define HG_QF(s_) (*(const LAS bf16x8*)(L + HG_QE + (tb * 32 + r) * 272 + 32 * (s_) + 16 * hh))
#pragma unroll
        for (int s = 0; s < 8; ++s) acc = MFMA32(*(const LAS bf16x8*)(L + HG_ST + (eb * 32 + r) * 272 + 32 * s + 16 * hh), HG_QF(s), acc);
        for (int sb = 0; sb <= tb; ++sb) {
            f32x16 at;
#pragma unroll
            for (int i = 0; i < 16; ++i) at[i] = 0.f;
#pragma unroll
            for (int s = 0; s < 8; ++s) at = MFMA32(*(const LAS bf16x8*)(L + HG_KE + (sb * 32 + r) * 272 + 32 * s + 16 * hh), HG_QF(s), at);
            float a[16];
#pragma unroll
            for (int i = 0; i < 16; ++i) a[i] = (sb < tb || crow16(i, hh) <= r) ? at[i] : 0.f;
            const bf16x8 ab0 = pack8(a[0], a[1], a[2], a[3], a[4], a[5], a[6], a[7]), ab1 = pack8(a[8], a[9], a[10], a[11], a[12], a[13], a[14], a[15]);
            acc = MFMA32(*(const LAS bf16x8*)(L + HG_VT + (eb * 32 + r) * 144 + sb * 64 + 0 + 16 * hh), ab0, acc);
            acc = MFMA32(*(const LAS bf16x8*)(L + HG_VT + (eb * 32 + r) * 144 + sb * 64 + 32 + 16 * hh), ab1, acc);
        }
        float ss = 0.f;
#pragma unroll
        for (int i = 0; i < 16; ++i) ss += acc[i] * acc[i];
        ss += __shfl_xor(ss, 32);
        LAS float* ssq = (LAS float*)(L + HG_SSQ);
        if (hh == 0) ssq[eb * 64 + tb * 32 + r] = ss;
        f32x4 ggv[4];
        { const unsigned so = (unsigned)__builtin_amdgcn_readfirstlane(h * 512);
#pragma unroll
            for (int g = 0; g < 4; ++g) ggv[g] = __builtin_bit_cast(f32x4, __builtin_amdgcn_raw_buffer_load_b128(rsrcG, (unsigned)((eb * 32 + 8 * g + 4 * hh) * 4), so, 0)); }
        __syncthreads();
        const int tl = tb * 32 + r; const float tot = (ssq[tl] + ssq[64 + tl]) + (ssq[128 + tl] + ssq[192 + tl]);
        const float rs = 1.f / sqrtf(tot * (1.f / 128.f) + EPS);
        const unsigned mso = (unsigned)__builtin_amdgcn_readfirstlane((int)((((unsigned)b * SEQ + c * 64) * D + 512 + h * 128) * 2)), mvo = (unsigned)((tl * D + eb * 32) * 2);
        unsigned long long grv[4];
#pragma unroll
        for (int gp = 0; gp < 2; ++gp) { const auto sa = __builtin_amdgcn_permlane32_swap(grw[gp].x, grw[gp].z, false, false), sb = __builtin_amdgcn_permlane32_swap(grw[gp].y, grw[gp].w, false, false);
            grv[2 * gp] = (unsigned long long)sa[0] | ((unsigned long long)sb[0] << 32); grv[2 * gp + 1] = (unsigned long long)sa[1] | ((unsigned long long)sb[1] << 32); }
        unsigned yp[4][2];
#pragma unroll
        for (int g = 0; g < 4; ++g) { const unsigned long long gr = grv[g]; const f32x4 gg = ggv[g];
            const float g0 = bflo((unsigned)gr), g1 = bfhi((unsigned)gr), g2 = bflo((unsigned)(gr >> 32)), g3 = bfhi((unsigned)(gr >> 32));
            const float y0 = acc[4 * g + 0] * rs * gg.x * (g0 * __builtin_amdgcn_rcpf(1.f + __expf(-g0))), y1 = acc[4 * g + 1] * rs * gg.y * (g1 * __builtin_amdgcn_rcpf(1.f + __expf(-g1)));
            const float y2 = acc[4 * g + 2] * rs * gg.z * (g2 * __builtin_amdgcn_rcpf(1.f + __expf(-g2))), y3 = acc[4 * g + 3] * rs * gg.w * (g3 * __builtin_amdgcn_rcpf(1.f + __expf(-g3)));
            yp[g][0] = pkbf(y0, y1); yp[g][1] = pkbf(y2, y3); }
#pragma unroll
        for (int gp = 0; gp < 2; ++gp) { const auto s0 = __builtin_amdgcn_permlane32_swap(yp[2 * gp][0], yp[2 * gp + 1][0], false, false), s1 = __builtin_amdgcn_permlane32_swap(yp[2 * gp][1], yp[2 * gp + 1][1], false, false);
            __builtin_amdgcn_raw_buffer_store_b128((v4u){s0[0], s1[0], s0[1], s1[1]}, rsrcM, mvo + 16u * (2 * gp + hh), mso, 0); }
        __syncthreads();
      }
    }
#undef HG_LOADST
#undef HG_LOADKV
#undef HG_FOLD
#undef HG_QF
}
#undef HG_LOADT
#undef HG_PUT
#undef HG_COL
#undef HG_ARR
#undef HG_SOFF
#undef HG_HV

__device__ __forceinline__ void router_phase(Frame& F) {
    LAS unsigned char* L = F.lds; const int r = F.lane & 31, hh = F.lane >> 5;
    LAS unsigned* lcnt = (LAS unsigned*)(F.lds + LTAB_OFF) + LT_MISC; LAS unsigned* lbase = lcnt + 32; LAS float* lrstd = (LAS float*)(F.lds + ROWTAB_OFF);
    float* TOPG = (float*)(F.ws + WS_TOPG);
    {
        const GAS v4u* img = (const GAS v4u*)(F.ws + WS_RT) + vzero();
        constexpr int NB = (RT_END / 16 + NWAVES * 64 - 1) / (NWAVES * 64);
        v4u t4[NB];
#pragma unroll
        for (int j = 0; j < NB; ++j) { const int q = F.tid + j * NWAVES * 64; t4[j] = img[q < RT_END / 16 ? q : 0]; }
#pragma unroll
        for (int j = 0; j < NB; ++j) { const int q = F.tid + j * NWAVES * 64; if (q < RT_END / 16) *(LAS v4u*)(L + 16 * q) = t4[j]; }
    }
    const bf16* XH = (const bf16*)(F.ws + WS_XN); int* LIST = (int*)(F.ws + WS_LIST); unsigned* cnt = (unsigned*)(F.ctl + CW_CNT);
    for (int base = blockIdx.x * 4; base < T / 32; base += F.G * 4) {
        const int grp = base + F.wave; const bool active = F.wave < 4 && grp < T / 32;
        if (F.tid < 32) lcnt[F.tid] = 0u;
        __syncthreads();
        float sv[4] = {0.f, 0.f, 0.f, 0.f}; int se[4] = {0, 0, 0, 0}; unsigned lp0 = 0u, lp1 = 0u; float rstd = 0.f; const int tok = grp * 32 + r;
        if (active) {
            const bf16* hrow = XH + (size_t)tok * D + 8 * hh;
            f32x16 acc;
#pragma unroll
            for (int i = 0; i < 16; ++i) acc[i] = 0.f;
            float ssq = 0.f;
#pragma unroll 16
            for (int s = 0; s < 64; ++s) {
                const v4u hu = *(const GAS v4u*)(hrow + 16 * s); const bf16x8 hi = __builtin_bit_cast(bf16x8, hu);
                { const float a0 = bflo(hu.x), a1 = bfhi(hu.x), a2 = bflo(hu.y), a3 = bfhi(hu.y), a4 = bflo(hu.z), a5 = bfhi(hu.z), a6 = bflo(hu.w), a7 = bfhi(hu.w);
                    ssq += (a0 * a0 + a1 * a1) + (a2 * a2 + a3 * a3) + (a4 * a4 + a5 * a5) + (a6 * a6 + a7 * a7); }
                const bf16x8 wh = *(const LAS bf16x8*)(L + r * RT_ROW + 32 * s + 16 * hh), wl = *(const LAS bf16x8*)(L + RT_WL + r * RT_ROW + 32 * s + 16 * hh);
                acc = MFMA32(wh, hi, acc); acc = MFMA32(wl, hi, acc);
            }
            ssq += __shfl_xor(ssq, 32);
            rstd = 1.f / sqrtf(ssq * (1.f / D) + EPS);
            float l[16];
#pragma unroll
            for (int i = 0; i < 16; ++i) l[i] = acc[i] * rstd + F.b_router[crow16(i, hh)];
            float cv[8]; int ce[8];
#pragma unroll
            for (int rnd = 0; rnd < 4; ++rnd) { float bv = l[0]; int bi = 0;
#pragma unroll
                for (int i = 1; i < 16; ++i) if (l[i] > bv) { bv = l[i]; bi = i; }
                cv[rnd] = bv; ce[rnd] = crow16(bi, hh);
#pragma unroll
                for (int i = 0; i < 16; ++i) if (i == bi) l[i] = -__builtin_inff(); }
#pragma unroll
            for (int j = 0; j < 4; ++j) { cv[4 + j] = __shfl_xor(cv[j], 32); ce[4 + j] = __shfl_xor(ce[j], 32); }
#pragma unroll
            for (int rnd = 0; rnd < 4; ++rnd) { float bv = cv[0]; int be = ce[0]; int bj = 0;
#pragma unroll
                for (int j = 1; j < 8; ++j) if (cv[j] > bv || (cv[j] == bv && ce[j] < be)) { bv = cv[j]; be = ce[j]; bj = j; }
                sv[rnd] = bv; se[rnd] = be;
#pragma unroll
                for (int j = 0; j < 8; ++j) if (j == bj) { cv[j] = -__builtin_inff(); ce[j] = 64; } }
            lp0 = __hip_atomic_fetch_add(lcnt + (hh ? se[2] : se[0]), 1u, __ATOMIC_RELAXED, __HIP_MEMORY_SCOPE_WORKGROUP);
            lp1 = __hip_atomic_fetch_add(lcnt + (hh ? se[3] : se[1]), 1u, __ATOMIC_RELAXED, __HIP_MEMORY_SCOPE_WORKGROUP);
        }
        __syncthreads();
        if (F.tid < 32) lbase[F.tid] = __hip_atomic_fetch_add(cnt + F.tid, lcnt[F.tid], __ATOMIC_RELAXED, __HIP_MEMORY_SCOPE_AGENT);
        __syncthreads();
        if (active) {
            const float e1 = __expf(sv[1] - sv[0]), e2 = __expf(sv[2] - sv[0]), e3 = __expf(sv[3] - sv[0]); const float inv = 1.f / (1.f + e1 + e2 + e3);
            const int ea = hh ? se[2] : se[0], eb = hh ? se[3] : se[1]; const float ga = (hh ? e2 : 1.f) * inv, gb = (hh ? e3 : e1) * inv;
            const size_t ia = (size_t)ea * 32768 + lbase[ea] + lp0, ib = (size_t)eb * 32768 + lbase[eb] + lp1;
            LIST[ia] = tok * 4 + 2 * hh; LIST[ib] = tok * 4 + 2 * hh + 1; TOPG[tok * 4 + 2 * hh] = ga; TOPG[tok * 4 + 2 * hh + 1] = gb;
            if (hh == 0) lrstd[F.wave * 32 + r] = rstd;
        }
        __syncthreads();
        {
            unsigned char* X8 = F.ws + WS_X8; const int t0 = base * 32;
#pragma unroll
            for (int q0 = 0; q0 < 16; q0 += 4) { v4u a[4][2];
#pragma unroll
                for (int q = 0; q < 4; ++q) { const int tt = t0 + F.wave * 16 + q0 + q; const GAS v4u* p = (const GAS v4u*)(XH + (size_t)(tt < T ? tt : 0) * D) + 2 * F.lane; a[q][0] = p[0]; a[q][1] = p[1]; }
#pragma unroll
                for (int q = 0; q < 4; ++q) { const int tl = F.wave * 16 + q0 + q, tt = t0 + tl; if (tt < T) { const float rs = lrstd[tl]; v4u o;
                    o.x = pg8::pk4_fp8(bflo(a[q][0].x) * rs, bfhi(a[q][0].x) * rs, bflo(a[q][0].y) * rs, bfhi(a[q][0].y) * rs); o.y = pg8::pk4_fp8(bflo(a[q][0].z) * rs, bfhi(a[q][0].z) * rs, bflo(a[q][0].w) * rs, bfhi(a[q][0].w) * rs);
                    o.z = pg8::pk4_fp8(bflo(a[q][1].x) * rs, bfhi(a[q][1].x) * rs, bflo(a[q][1].y) * rs, bfhi(a[q][1].y) * rs); o.w = pg8::pk4_fp8(bflo(a[q][1].z) * rs, bfhi(a[q][1].z) * rs, bflo(a[q][1].w) * rs, bfhi(a[q][1].w) * rs);
                    *((GAS v4u*)(X8 + (size_t)tt * D) + F.lane) = o; } } }
        }
        __syncthreads();
    }
}
__device__ __forceinline__ int build_moe_tables(Frame& F, int ntn, int mode) {
    LAS int* lt = (LAS int*)(F.lds + LTAB_OFF);
    if (F.wave == 0) {
        const int e = F.lane & 31; const int c = (int)__hip_atomic_load((unsigned*)(F.ctl + CW_CNT) + e, __ATOMIC_RELAXED, __HIP_MEMORY_SCOPE_AGENT);
        const int tl = (c + 255) >> 8; int inc = tl;
#pragma unroll
        for (int off = 1; off < 32; off <<= 1) { const int o = __shfl_up(inc, off, 32); if (e >= off) inc += o; }
        const int tot = __shfl(inc, 31, 32), t0 = inc - tl;
        if (F.lane < 32) { lt[LT_TS + e] = t0; lt[LT_CNT + e] = c; for (int i = 0; i < tl; ++i) lt[t0 + i] = e; }
        if (F.lane == 0) lt[LT_MISC + 64] = tot;
    }
    __syncthreads();
    int nt = lt[LT_MISC + 64]; nt = nt < 0 ? 0 : (nt > MAXTILES ? MAXTILES : nt); nt = __builtin_amdgcn_readfirstlane(nt);
    const int* LIST = (const int*)(F.ws + WS_LIST);
    const int nslot = mode == 1 ? MAXSLOT : (MAXTILES * 4 + 255) / 256;
    for (int q = F.tid; q < nslot * 256; q += NWAVES * 64) { const int i = q >> 8, rr = q & 255; const int Lu = i * F.G + F.vcu;
        int li = -1; float bias = 0.f;
        if (Lu < nt * ntn) { const int pm0 = Lu / ntn, pl = Lu - pm0 * ntn, pm = mode == 2 ? nt - 1 - pm0 : pm0, e = lt[pm], idx = (pm - lt[LT_TS + e]) * 256 + rr; if (idx < lt[LT_CNT + e]) li = LIST[(size_t)e * 32768 + idx];
            bias = mode == 1 ? F.b_gu[(size_t)e * 2048 + (rr >> 7) * 1024 + pl * 128 + (rr & 127)] : F.b_d[(size_t)e * 1024 + pl * 256 + rr]; }
        ((LAS float*)(F.lds + ROWTAB_OFF))[q] = bias;
        if (mode == 1) ((LAS unsigned short*)(F.lds + ROWTAB2_OFF))[q] = (unsigned short)(li < 0 ? 0 : (li >> 2));
        else ((LAS int*)(F.lds + ROWTAB_OFF) + nslot * 256)[q] = li; }
    __syncthreads();
    return nt;
}
__device__ __forceinline__ void combine_phase(Frame& F) {
    const unsigned char* YK = F.ws + WS_YK; const bf16* XH = (const bf16*)(F.ws + WS_XN); const float* TOPG = (const float*)(F.ws + WS_TOPG);
    for (int t = F.gw; t < T; t += F.ngw) {
        GAS f32x4* xr = (GAS f32x4*)(F.out + (size_t)t * D) + F.lane; f32x4 v[4]; unsigned y[4][4]; const f32x4 gt = *((const GAS f32x4*)TOPG + t + vzero()) * (1.0f / Y8_SCALE);
#pragma unroll
        for (int j = 0; j < 4; ++j) { const unsigned long long xh = __builtin_nontemporal_load((const GAS unsigned long long*)(XH + (size_t)t * D) + F.lane + 64 * j);
            v[j] = (f32x4){bflo((unsigned)xh), bfhi((unsigned)xh), bflo((unsigned)(xh >> 32)), bfhi((unsigned)(xh >> 32))};
#pragma unroll
            for (int k = 0; k < 4; ++k) y[j][k] = __builtin_nontemporal_load((const GAS unsigned*)(YK + ((size_t)t * 4 + k) * D) + F.lane + 64 * j); }
#pragma unroll
        for (int j = 0; j < 4; ++j) { f32x4 s4 = {0.f, 0.f, 0.f, 0.f};
#pragma unroll
            for (int k = 0; k < 4; ++k) { const f32x2n_ lo = __builtin_amdgcn_cvt_pk_f32_fp8((int)y[j][k], false), hi = __builtin_amdgcn_cvt_pk_f32_fp8((int)y[j][k], true); const float g = gt[k]; s4.x += g * lo.x; s4.y += g * lo.y; s4.z += g * hi.x; s4.w += g * hi.y; }
            v[j] = v[j] + s4;
            __builtin_nontemporal_store(v[j], xr + 64 * j); }
    }
}

constexpr int NPH = 9;
struct Args { const float* in[16]; float* out; unsigned char* ws; int ph_lo, ph_hi; };
__global__ void __launch_bounds__(NWAVES * 64, 2) fwd(Args args) {
    extern __shared__ __attribute__((aligned(16))) unsigned char lds[];
    Frame F;
    F.lds = (LAS unsigned char*)lds;
    F.MISC = (volatile LAS unsigned*)(F.lds + MISC_OFF);
    F.tid = threadIdx.x; F.lane = F.tid & 63; F.wave = __builtin_amdgcn_readfirstlane(F.tid >> 6);
    F.G = gridDim.x; { const int bx = blockIdx.x; F.vcu = (F.G % 8 == 0) ? (bx % 8) * (F.G / 8) + bx / 8 : bx; }
    F.gw = blockIdx.x * NWAVES + F.wave; F.ngw = F.G * NWAVES;
    F.ws = args.ws; F.ctl = (gu32*)(args.ws + WS_CTL); F.out = args.out;
    F.x = args.in[0]; F.norm1_g = args.in[1]; F.w_in = args.in[2]; F.sb_q_g = args.in[3]; F.sb_k_g = args.in[4]; F.sb_out_g = args.in[5]; F.hg_lb = args.in[6]; F.hg_out_g = args.in[7];
    F.w_out = args.in[8]; F.norm2_g = args.in[9]; F.w_router = args.in[10]; F.b_router = args.in[11]; F.w_gu = args.in[12]; F.b_gu = args.in[13]; F.w_d = args.in[14]; F.b_d = args.in[15];
    for (int u = F.tid; u < (LDS_BYTES - LDSCTL_OFF) / 4; u += NWAVES * 64) ((LAS unsigned*)(F.lds + LDSCTL_OFF))[u] = 0u;
    __syncthreads();
    XcdBarrier bar; bar.bar = (unsigned*)(F.ctl + CW_BAR); bar.x = 0; bar.st = nullptr;
    if (MK_ONE_LAUNCH) bar = xcd_barrier_post((unsigned*)(F.ctl + CW_BAR), F.MISC + 8);
    const int lo = args.ph_lo, hi = args.ph_hi;
#define IN(k) (lo <= (k) && (k) < hi && ((F.lane = lane_id()), (F.tid = F.wave * 64 + F.lane), true))
#define SEAM(k) do { if (IN(k) && IN((k) + 1)) xcd_barrier(bar); } while (0)

    if (IN(0)) { p0_prologue(F); } SEAM(0);
    if (IN(1)) {
        pg8::Gemm g{(const bf16*)(F.ws + WS_XN), (const bf16*)(F.ws + WS_WIN), T, NIN, D}; pg8::StaticOrder S; S.init(T, NIN, F.G, (int)blockIdx.x);
        pg8::EpiInproj E{(bf16*)(F.ws + WS_P), (bf16*)(F.ws + WS_PH), (bf16*)(F.ws + WS_QN), (bf16*)(F.ws + WS_KN), F.sb_q_g, F.sb_k_g, QSCALE, EPS};
        pg8::gemm_phase<pg8::EpiInproj, pg8::StaticOrder, PG8_ALIGN, PG8_SP2>(F.lds + RING_OFF, g, S, E, F.tid);
    } SEAM(1);
    if (IN(2)) { prep_phase(F); __syncthreads(); hgA_phase(F); } SEAM(2);
    if (IN(3)) { attn_phase(F); hgC_phase(F); } SEAM(3);
    if (IN(4)) {
        pg8::Gemm g{(const bf16*)(F.ws + WS_MIX), (const bf16*)(F.ws + WS_WOUT), T, D, D}; pg8::StaticOrder S; S.init(T, D, F.G, (int)blockIdx.x);
        pg8::EpiRes E{F.x, (bf16*)(F.ws + WS_XN), D};
        pg8::gemm_phase<pg8::EpiRes, pg8::StaticOrder, PG8_ALIGN, PG8_SP2>(F.lds + RING_OFF, g, S, E, F.tid);
    } SEAM(4);
    if (IN(5)) { router_phase(F); } SEAM(5);
    if (IN(6)) {
        const int nt = build_moe_tables(F, 8, 1); const LAS int* lt = (const LAS int*)(F.lds + LTAB_OFF);
        pg8::Gemm g{(const bf16*)(F.ws + WS_X8), (const bf16*)(F.ws + WS_WGU), MAXROWS, NE * 2048, D / 2};
        pg8::MoeOrder S{lt, (const LAS unsigned short*)(F.lds + ROWTAB2_OFF), 8, nt * 8, F.G, F.vcu, 1024u, 0};
        pg8::EpiAct<true> E{F.ws + WS_ACT, (const LAS float*)(F.lds + ROWTAB_OFF), A8_SCALE};
        pg8::gemm_phase<pg8::EpiAct<true>, pg8::MoeOrder, PG8_ALIGN, PG8_SP2, true, SC_W8, SC_ONE>(F.lds + RING_OFF, g, S, E, F.tid);
        {
            const int rem = (nt * 8) % F.G, nidle = F.G - rem; const bool few = rem == 0 || nidle < F.G / 4;
            __syncthreads();
            if (few) p0_items(F, P0_NITEMS - P0_NLATE, P0_NITEMS, F.vcu * NWAVES + F.wave, F.G * NWAVES);
            else if (F.vcu >= rem) p0_items(F, P0_NITEMS - P0_NLATE, P0_NITEMS, (F.vcu - rem) * NWAVES + F.wave, nidle * NWAVES);
        }
    } SEAM(6);
    if (IN(7)) {
        const int nt = build_moe_tables(F, 4, 2); const LAS int* lt = (const LAS int*)(F.lds + LTAB_OFF);
        pg8::Gemm g{(const bf16*)(F.ws + WS_ACT), (const bf16*)(F.ws + WS_WD), MAXROWS, NE * 1024, D / 2};
        pg8::MoeOrder S{lt, nullptr, 4, nt * 4, F.G, F.vcu, 1024u, nt};
        pg8::EpiDown E{F.ws + WS_YK, (const LAS int*)(F.lds + ROWTAB_OFF) + ((MAXTILES * 4 + 255) / 256) * 256, (const LAS float*)(F.lds + ROWTAB_OFF), Y8_SCALE};
        pg8::gemm_phase<pg8::EpiDown, pg8::MoeOrder, PG8_ALIGN, PG8_SP2, true, SC_W8Y, SC_A8>(F.lds + RING_OFF, g, S, E, F.tid);
    } SEAM(7);
    if (IN(8)) { combine_phase(F); }
#undef IN
#undef SEAM
}

extern "C" void kernel_launch(void* const* d_in, const int* in_sizes, int n_in, void* d_out, int out_size, void* d_ws, size_t ws_size, hipStream_t stream) {
    static int grid = 0;
    if (grid == 0) {
        if (n_in != 16 || in_sizes[0] != T * D || out_size != T * D || ws_size < WS_END) { fprintf(stderr, "kernel_launch: shape/workspace mismatch (n_in %d, ws %zu, need %zu); nothing launched\n", n_in, ws_size, (size_t)WS_END); grid = -1; return; }
        int dev = 0, cus = 0, per_cu = 0;
        if (hipGetDevice(&dev) != hipSuccess || hipDeviceGetAttribute(&cus, hipDeviceAttributeMultiprocessorCount, dev) != hipSuccess) { grid = -1; return; }
        if (hipFuncSetAttribute((const void*)fwd, hipFuncAttributeMaxDynamicSharedMemorySize, LDS_BYTES) != hipSuccess) { grid = -1; return; }
        if (hipOccupancyMaxActiveBlocksPerMultiprocessor(&per_cu, (const void*)fwd, NWAVES * 64, LDS_BYTES) != hipSuccess || per_cu < 1) { fprintf(stderr, "kernel_launch: occupancy query says %d\n", per_cu); }
        (void)hipGetLastError();
        if ((MAXTILES * 8 + cus - 1) / cus > MAXSLOT || cus < 1) { fprintf(stderr, "kernel_launch: %d CUs: the per-workgroup unit tables are sized for 256\n", cus); grid = -1; return; }
        grid = cus;
    }
    if (grid < 0) return;
    if (hipMemsetAsync((char*)d_ws + WS_CTL, 0, CTL_ZERO_BYTES, stream) != hipSuccess) return;
    Args a{};
    for (int i = 0; i < 16; ++i) a.in[i] = (const float*)d_in[i];
    a.out = (float*)d_out; a.ws = (unsigned char*)d_ws;
#if MK_ONE_LAUNCH
    a.ph_lo = 0; a.ph_hi = NPH;
    hipLaunchKernelGGL(fwd, dim3(grid), dim3(NWAVES * 64), LDS_BYTES, stream, a);
#else
    for (int p = 0; p < NPH; ++p) { a.ph_lo = p; a.ph_hi = p + 1; hipLaunchKernelGGL(fwd, dim3(grid), dim3(NWAVES * 64), LDS_BYTES, stream, a); }
#endif
}
```

```cpp
#include <hip/hip_runtime.h>
#include <cstdio>
#include <cstdint>
namespace pg8 {
#define PG8_LAS __attribute__((address_space(3)))
typedef unsigned short bf16_t;
typedef short bf16x8 __attribute__((ext_vector_type(8)));
typedef float f32x4 __attribute__((ext_vector_type(4)));
typedef unsigned u32x4 __attribute__((ext_vector_type(4)));
typedef int i32x4_t __attribute__((ext_vector_type(4)));
typedef int i32x8_t __attribute__((ext_vector_type(8)));
constexpr int BM = 256, BK = 64, HALF = 128, HTB = HALF * BK * 2  , STAGE_BYTES = 8 * HTB, NXCD = 8, WGM = 8;

__host__ __device__ __forceinline__ int lds_byte(int r, int c) { const int st = (r >> 4) * 2 + (c >> 5), rr = r & 15, cc = c & 31, ob = rr * 64 + cc * 2; return st * 1024 + (ob ^ (((ob >> 9) & 1) << 5)); }
__host__ __device__ __forceinline__ void stage_rc(int b, int& R, int& C) { const int st = b / 1024, sb = b % 1024, swz = sb ^ (((sb >> 9) & 1) << 5); R = (st >> 1) * 16 + swz / 64; C = (st & 1) * 32 + (swz % 64) / 2; }
__host__ __device__ __forceinline__ int perm32(int rho) { const int n = rho >> 4, i = rho & 15; return 8 * (i >> 2) + 4 * n + (i & 3); }

struct Unit { int pm, pn, slot; };
struct Gemm { const bf16_t* A; const bf16_t* Bt; int M, N, K; };

struct StaticOrder {
    int nM, nN, nwg, G, c;
    __host__ __device__ void init(int M, int N, int G_, int c_) { nM = M / BM; nN = N / BM; nwg = nM * nN; G = G_; c = c_; }
    __host__ __device__ bool next(int i, Unit& u) const {
        const long L = (long)i * G + c; if (L >= nwg) return false;
        int wgid = (int)L; { const int q = nwg / NXCD, r = nwg % NXCD, xcd = wgid % NXCD, off = wgid / NXCD; wgid = (xcd < r ? xcd * (q + 1) : r * (q + 1) + (xcd - r) * q) + off; }
        const int nig = WGM * nN, gid = wgid / nig, fm = gid * WGM, gsz = (nM - fm) < WGM ? (nM - fm) : WGM;
        u.pm = fm + ((wgid % nig) % gsz); u.pn = (wgid % nig) / gsz; return true;
    }
    __device__ __forceinline__ void a_ready(const Unit&) const {}
    __device__ __forceinline__ void done(const Unit&) const {}
};

__device__ __forceinline__ unsigned cvt_pk_bf16(float lo, float hi) { unsigned r; asm volatile("v_cvt_pk_bf16_f32 %0, %1, %2" : "=v"(r) : "v"(lo), "v"(hi)); return r; }
typedef float f32x2 __attribute__((ext_vector_type(2)));
__device__ __forceinline__ f32x2 gelu_pk(f32x2 v) {
    const f32x2 av = __builtin_elementwise_abs(v), d = av * 0.2316418882f + 1.0f;
    f32x2 t; t.x = __builtin_amdgcn_rcpf(d.x); t.y = __builtin_amdgcn_rcpf(d.y);
    f32x2 q = t * 0.5307027145f + (-0.7265760135f); q = q * t + 0.7107068705f; q = q * t + (-0.142248368f); q = q * t + 0.127414796f; q = q * t;
    const f32x2 s = (v * v) * (-0.72134752044f);
    f32x2 e; e.x = __builtin_amdgcn_exp2f(s.x); e.y = __builtin_amdgcn_exp2f(s.y);
    const f32x2 m = v * (q * e), r = v - m;
    f32x2 o; o.x = v.x < 0.f ? m.x : r.x; o.y = v.y < 0.f ? m.y : r.y; return o;
}

template <int ACT  > struct EpiBf16 {
    static constexpr bool PERM = true, AFTER_DRAIN = false, HAS_INIT = false, INIT_LOADS = false; static_assert(ACT == 0 || ACT == 1, "EpiBf16: ACT is 0 (none) or 1 (gelu_pk)");
    bf16_t* O; int ldc; const float* bias; int split_cols; size_t split_stride; float scale0;
    __device__ __forceinline__ void operator()(const f32x4 (&acc)[2][2][4][2], const Unit& u, int wr, int wc, int fr, int fq) const {
        const int row0 = u.pm * BM + wr * 64 + fr; int colt = u.pn * BM; bf16_t* base = O;
        float sc = 1.f; if (split_cols) { const int t = colt / split_cols; base += (size_t)t * split_stride; colt -= t * split_cols; if (t == 0) sc = scale0; }
        const int col0 = colt + wc * 32 + 8 * fq, bcol0 = u.pn * BM + wc * 32 + 8 * fq;
        f32x4 bv[2][2];
#pragma unroll
        for (int bj = 0; bj < 2; ++bj)
#pragma unroll
            for (int n = 0; n < 2; ++n) bv[bj][n] = bias ? *(const f32x4*)(bias + bcol0 + bj * HALF + 4 * n) : (f32x4){0.f, 0.f, 0.f, 0.f};
#pragma unroll
        for (int ai = 0; ai < 2; ++ai)
#pragma unroll
            for (int m = 0; m < 4; ++m) { bf16_t* rowp = base + (size_t)(row0 + ai * HALF + m * 16) * ldc + col0;
#pragma unroll
                for (int bj = 0; bj < 2; ++bj) { f32x4 v0 = acc[ai][bj][m][0] + bv[bj][0], v1 = acc[ai][bj][m][1] + bv[bj][1];
                    if (ACT == 1) { f32x2 a = gelu_pk((f32x2){v0[0], v0[1]}), b = gelu_pk((f32x2){v0[2], v0[3]}), c = gelu_pk((f32x2){v1[0], v1[1]}), d = gelu_pk((f32x2){v1[2], v1[3]});
                        v0 = (f32x4){a.x, a.y, b.x, b.y}; v1 = (f32x4){c.x, c.y, d.x, d.y}; }
                    v0 = v0 * sc; v1 = v1 * sc; u32x4 w; w.x = cvt_pk_bf16(v0[0], v0[1]); w.y = cvt_pk_bf16(v0[2], v0[3]); w.z = cvt_pk_bf16(v1[0], v1[1]); w.w = cvt_pk_bf16(v1[2], v1[3]);
                    *(u32x4*)(rowp + bj * HALF) = w; } }
    }
};

__device__ __forceinline__ unsigned pk4_fp8(float a, float b, float c, float d) {
    a = fminf(fmaxf(a, -448.f), 448.f); b = fminf(fmaxf(b, -448.f), 448.f); c = fminf(fmaxf(c, -448.f), 448.f); d = fminf(fmaxf(d, -448.f), 448.f);
    int p = 0; p = __builtin_amdgcn_cvt_pk_fp8_f32(a, b, p, false); p = __builtin_amdgcn_cvt_pk_fp8_f32(c, d, p, true); return (unsigned)p;
}
struct EpiRes {
    static constexpr bool PERM = true, AFTER_DRAIN = false, HAS_INIT = true, INIT_LOADS = true;
    const float* __restrict__ X; bf16_t* __restrict__ XH; int ldc;
    __device__ __forceinline__ void init(f32x4 (&acc)[2][2][4][2], const Unit& u, int wr, int wc, int fr, int fq) const {
        const int row0 = u.pm * BM + wr * 64 + fr, col0 = u.pn * BM + wc * 32 + 8 * fq;
#pragma unroll
        for (int ai = 0; ai < 2; ++ai)
#pragma unroll
            for (int m = 0; m < 4; ++m) { const float* rp = X + (size_t)(row0 + ai * HALF + m * 16) * ldc + col0;
#pragma unroll
                for (int bj = 0; bj < 2; ++bj)
#pragma unroll
                    for (int n = 0; n < 2; ++n) acc[ai][bj][m][n] = __builtin_nontemporal_load((const f32x4*)(rp + bj * HALF + n * 4)); }
    }
    __device__ __forceinline__ void operator()(const f32x4 (&acc)[2][2][4][2], const Unit& u, int wr, int wc, int fr, int fq) const {
        const int row0 = u.pm * BM + wr * 64 + fr, col0 = u.pn * BM + wc * 32 + 8 * fq;
#pragma unroll
        for (int ai = 0; ai < 2; ++ai)
#pragma unroll
            for (int m = 0; m < 4; ++m) { bf16_t* rp = XH + (size_t)(row0 + ai * HALF + m * 16) * ldc + col0;
#pragma unroll
                for (int bj = 0; bj < 2; ++bj) { const f32x4 v0 = acc[ai][bj][m][0], v1 = acc[ai][bj][m][1];
                    u32x4 w; w.x = cvt_pk_bf16(v0[0], v0[1]); w.y = cvt_pk_bf16(v0[2], v0[3]); w.z = cvt_pk_bf16(v1[0], v1[1]); w.w = cvt_pk_bf16(v1[2], v1[3]);
                    *(u32x4*)(rp + bj * HALF) = w; } }
    }
};
struct EpiInproj {
    static constexpr bool PERM = true, AFTER_DRAIN = false, HAS_INIT = false, INIT_LOADS = false;
    bf16_t* PA; bf16_t* PH; bf16_t* QN; bf16_t* KN; const float* gq; const float* gk; float qscale, eps;
    __device__ __forceinline__ void operator()(const f32x4 (&acc)[2][2][4][2], const Unit& u, int wr, int wc, int fr, int fq) const {
        if (u.pn < 4) {
            const int arr = u.pn >> 1, hd = (u.pn & 1) * 4 + wc; const float* g = arr ? gk : gq; const float gs = arr ? 1.f : qscale; bf16_t* dst = arr ? KN : QN;
            f32x4 gv[2][2];
#pragma unroll
            for (int bj = 0; bj < 2; ++bj)
#pragma unroll
                for (int n = 0; n < 2; ++n) gv[bj][n] = *(const f32x4*)(g + 32 * bj + 8 * fq + 4 * n) * gs;
#pragma unroll
            for (int ai = 0; ai < 2; ++ai)
#pragma unroll
                for (int m = 0; m < 4; ++m) { float ss = 0.f;
#pragma unroll
                    for (int bj = 0; bj < 2; ++bj)
#pragma unroll
                        for (int n = 0; n < 2; ++n) { const f32x4 a = acc[ai][bj][m][n]; ss += (a[0] * a[0] + a[1] * a[1]) + (a[2] * a[2] + a[3] * a[3]); }
                    ss += __shfl_xor(ss, 16); ss += __shfl_xor(ss, 32);
                    const float rs = 1.f / sqrtf(ss * (1.f / 64.f) + eps);
                    const int row = u.pm * BM + ai * HALF + wr * 64 + m * 16 + fr, b = row >> 11, s = row & 2047;
                    bf16_t* rp = dst + ((size_t)((b * 8 + hd) * 64 + (s >> 5))) * 2048 + (s & 31) * 8;
#pragma unroll
                    for (int bj = 0; bj < 2; ++bj) { const int c8 = 4 * bj + fq; const f32x4 v0 = acc[ai][bj][m][0] * rs * gv[bj][0], v1 = acc[ai][bj][m][1] * rs * gv[bj][1];
                        u32x4 w; w.x = cvt_pk_bf16(v0[0], v0[1]); w.y = cvt_pk_bf16(v0[2], v0[3]); w.z = cvt_pk_bf16(v1[0], v1[1]); w.w = cvt_pk_bf16(v1[2], v1[3]);
                        *(u32x4*)(rp + (c8 >> 1) * 512 + (c8 & 1) * 256) = w; } }
            return;
        }
        const int colw = u.pn * BM + wc * 64; bf16_t* base; int rowlen;
        if (colw < 1536) { const int arr = colw >> 9, hd = (colw & 511) >> 6; base = PA + ((size_t)(arr * 16) * 8 + hd) * 2048 * 64; rowlen = 64; }
        else { const int c2 = colw - 1536, arr = c2 >> 9, hd = (c2 & 511) >> 7, dd = c2 & 127; base = PH + ((size_t)(arr * 16) * 4 + hd) * 2048 * 128 + dd; rowlen = 128; }
        const size_t bstride = (size_t)(rowlen == 64 ? 8 : 4) * 2048 * rowlen;
        const bool odd = fr & 1; base += (odd ? 32 : 0) + 8 * fq;
#pragma unroll
        for (int ai = 0; ai < 2; ++ai)
#pragma unroll
            for (int m = 0; m < 4; ++m) { const int rowE = u.pm * BM + ai * HALF + wr * 64 + m * 16 + (fr & ~1), b = rowE >> 11, s = rowE & 2047;
                u32x4 w[2];
#pragma unroll
                for (int bj = 0; bj < 2; ++bj) { const f32x4 v0 = acc[ai][bj][m][0], v1 = acc[ai][bj][m][1];
                    w[bj].x = cvt_pk_bf16(v0[0], v0[1]); w[bj].y = cvt_pk_bf16(v0[2], v0[3]); w[bj].z = cvt_pk_bf16(v1[0], v1[1]); w[bj].w = cvt_pk_bf16(v1[2], v1[3]); }
                const u32x4 snd = odd ? w[0] : w[1]; u32x4 rcv;
                rcv.x = (unsigned)__builtin_amdgcn_mov_dpp((int)snd.x, 0xB1, 0xF, 0xF, true); rcv.y = (unsigned)__builtin_amdgcn_mov_dpp((int)snd.y, 0xB1, 0xF, 0xF, true);
                rcv.z = (unsigned)__builtin_amdgcn_mov_dpp((int)snd.z, 0xB1, 0xF, 0xF, true); rcv.w = (unsigned)__builtin_amdgcn_mov_dpp((int)snd.w, 0xB1, 0xF, 0xF, true);
                bf16_t* rp = base + (size_t)b * bstride + (size_t)s * rowlen;
                *(u32x4*)rp = odd ? rcv : w[0];
                *(u32x4*)(rp + rowlen) = odd ? w[1] : rcv; }
    }
};
struct MoeOrder {
    const PG8_LAS int* tile_e; const PG8_LAS unsigned short* rowtab; int ntn, nunits, G, c; unsigned rowbytes; int rev;
    __device__ __forceinline__ bool next(int i, Unit& u) const {
        const int L = i * G + c; if (L >= nunits) return false;
        const int pm0 = L / ntn, pl = L - pm0 * ntn, pm = rev ? rev - 1 - pm0 : pm0; u.pm = pm; u.pn = tile_e[pm] * ntn + pl; u.slot = i; return true;
    }
    __device__ __forceinline__ unsigned rowoff(const Unit& u, int r) const { return (rowtab ? (unsigned)rowtab[u.slot * 256 + r] : (unsigned)(u.pm * 256 + r)) * rowbytes; }
    __device__ __forceinline__ void a_ready(const Unit&) const {}
    __device__ __forceinline__ void done(const Unit&) const {}
};
template <bool OUT8> struct EpiAct {
    static constexpr bool PERM = true, AFTER_DRAIN = false, HAS_INIT = true, INIT_LOADS = false;
    unsigned char* ACT; const PG8_LAS float* biastab; float oscale;
    __device__ __forceinline__ void init(f32x4 (&acc)[2][2][4][2], const Unit& u, int wr, int wc, int fr, int fq) const {
#pragma unroll
        for (int n = 0; n < 2; ++n) { const f32x4 bg = *(const PG8_LAS f32x4*)(biastab + u.slot * 256 + wc * 32 + 8 * fq + 4 * n), bu = *(const PG8_LAS f32x4*)(biastab + u.slot * 256 + 128 + wc * 32 + 8 * fq + 4 * n);
#pragma unroll
            for (int ai = 0; ai < 2; ++ai)
#pragma unroll
                for (int m = 0; m < 4; ++m) { acc[ai][0][m][n] = bg; acc[ai][1][m][n] = bu; } }
    }
    __device__ __forceinline__ void operator()(const f32x4 (&acc)[2][2][4][2], const Unit& u, int wr, int wc, int fr, int fq) const {
        const int pl = u.pn & 7; const int row0 = u.pm * BM + wr * 64 + fr, acol0 = pl * 128 + wc * 32 + 8 * fq;
#pragma unroll
        for (int ai = 0; ai < 2; ++ai)
#pragma unroll
            for (int m = 0; m < 4; ++m) { unsigned char* rowp = ACT + (size_t)(row0 + ai * HALF + m * 16) * 1024 + acol0; f32x4 a4[2];
#pragma unroll
                for (int n = 0; n < 2; ++n) { const f32x4 g4 = acc[ai][0][m][n], u4 = acc[ai][1][m][n]; f32x4 gl, ul, ex;
#pragma unroll
                    for (int j = 0; j < 4; ++j) { gl[j] = fminf(g4[j], 7.0f); ul[j] = __builtin_amdgcn_fmed3f(u4[j], -7.0f, 7.0f); }
                    const f32x4 t4 = gl * (-1.702f * 1.44269504089f);
#pragma unroll
                    for (int j = 0; j < 4; ++j) ex[j] = __builtin_amdgcn_exp2f(t4[j]);
                    const f32x4 d4 = ex + 1.0f; f32x4 s4;
#pragma unroll
                    for (int j = 0; j < 4; ++j) s4[j] = __builtin_amdgcn_rcpf(d4[j]);
                    a4[n] = (gl * s4) * (ul * oscale + oscale); }
                if constexpr (OUT8) { int p0 = 0, p1 = 0; p0 = __builtin_amdgcn_cvt_pk_fp8_f32(a4[0][0], a4[0][1], p0, false); p0 = __builtin_amdgcn_cvt_pk_fp8_f32(a4[0][2], a4[0][3], p0, true);
                    p1 = __builtin_amdgcn_cvt_pk_fp8_f32(a4[1][0], a4[1][1], p1, false); p1 = __builtin_amdgcn_cvt_pk_fp8_f32(a4[1][2], a4[1][3], p1, true);
                    *(unsigned long long*)rowp = (unsigned long long)(unsigned)p0 | ((unsigned long long)(unsigned)p1 << 32); }
                else { u32x4 w; w.x = cvt_pk_bf16(a4[0][0], a4[0][1]); w.y = cvt_pk_bf16(a4[0][2], a4[0][3]); w.z = cvt_pk_bf16(a4[1][0], a4[1][1]); w.w = cvt_pk_bf16(a4[1][2], a4[1][3]); *(u32x4*)(rowp + (size_t)(row0 + ai * HALF + m * 16) * 1024 + acol0) = w; } }
    }
};
struct EpiDown {
    static constexpr bool PERM = true, AFTER_DRAIN = false, HAS_INIT = true, INIT_LOADS = false;
    unsigned char* YK; const PG8_LAS int* tktab; const PG8_LAS float* biastab; float oscale;
    __device__ __forceinline__ void init(f32x4 (&acc)[2][2][4][2], const Unit& u, int wr, int wc, int fr, int fq) const {
#pragma unroll
        for (int bj = 0; bj < 2; ++bj)
#pragma unroll
            for (int n = 0; n < 2; ++n) { const f32x4 bv = *(const PG8_LAS f32x4*)(biastab + u.slot * 256 + 64 * wc + 16 * fq + 8 * bj + 4 * n) * oscale;
#pragma unroll
                for (int ai = 0; ai < 2; ++ai)
#pragma unroll
                    for (int m = 0; m < 4; ++m) acc[ai][bj][m][n] = bv; }
    }
    __device__ __forceinline__ void operator()(const f32x4 (&acc)[2][2][4][2], const Unit& u, int wr, int wc, int fr, int fq) const {
        const int pl = u.pn & 3; const int col0 = pl * BM + 64 * wc + 16 * fq;
#pragma unroll
        for (int ai = 0; ai < 2; ++ai)
#pragma unroll
            for (int m = 0; m < 4; ++m) { const int tk = tktab[u.slot * 256 + ai * HALF + wr * 64 + m * 16 + fr];
                if (tk >= 0) { unsigned char* rowp = YK + (size_t)tk * 1024 + col0; int p[4];
#pragma unroll
                    for (int bj = 0; bj < 2; ++bj) { f32x4 v0 = acc[ai][bj][m][0], v1 = acc[ai][bj][m][1];
#pragma unroll
                        for (int j = 0; j < 4; ++j) { v0[j] = __builtin_amdgcn_fmed3f(v0[j], -448.f, 448.f); v1[j] = __builtin_amdgcn_fmed3f(v1[j], -448.f, 448.f); }
                        int p0 = 0, p1 = 0; p0 = __builtin_amdgcn_cvt_pk_fp8_f32(v0[0], v0[1], p0, false); p0 = __builtin_amdgcn_cvt_pk_fp8_f32(v0[2], v0[3], p0, true);
                        p1 = __builtin_amdgcn_cvt_pk_fp8_f32(v1[0], v1[1], p1, false); p1 = __builtin_amdgcn_cvt_pk_fp8_f32(v1[2], v1[3], p1, true);
                        p[2 * bj] = p0; p[2 * bj + 1] = p1; }
                    u32x4 w; w.x = (unsigned)p[0]; w.y = (unsigned)p[1]; w.z = (unsigned)p[2]; w.w = (unsigned)p[3];
                    *(u32x4*)rowp = w; } }
    }
};

template <class Epi, class Sched, bool ALIGN_EPI = false, bool SP2 = false, bool GATHER = false, int SCW = 0, int SCX = 0>
__device__ __forceinline__ void gemm_phase(PG8_LAS unsigned char* lds, const Gemm g, const Sched& S, const Epi& E, const int tid) {
    const int wid = __builtin_amdgcn_readfirstlane(tid >> 6), lane = tid & 63, wr = wid >> 2, wc = wid & 3, fr = lane & 15, fq = lane >> 4;
    const int K = g.K, nt = K / BK;
    unsigned voffA[2], voffB[2]; int RA[2]; unsigned CA2[2]; unsigned va0[2] = {0u, 0u}, va1[2] = {0u, 0u};
#pragma unroll
    for (int i = 0; i < 2; ++i) { int R, C; stage_rc(tid * 16 + i * 8192, R, C); const int Rb = Epi::PERM ? ((R & ~31) + perm32(R & 31)) : R;
        voffA[i] = (unsigned)(R * K + C) * 2u; voffB[i] = (unsigned)(Rb * K + C) * 2u; RA[i] = R; CA2[i] = (unsigned)C * 2u; }
    static_assert(!GATHER || SP2, "the gathered-A form exists for the SP2 loop only");
    const char* const gA0 = (const char*)g.A;
#define PG8_VA(u) do { int l_; asm volatile("v_mbcnt_lo_u32_b32 %0, -1, 0\n\tv_mbcnt_hi_u32_b32 %0, -1, %0" : "=v"(l_)); const int t_ = wid * 64 + l_;     \
        _Pragma("unroll") for (int _i = 0; _i < 2; ++_i) { int R_, C_; stage_rc(t_ * 16 + _i * 8192, R_, C_); va0[_i] = S.rowoff((u), R_) + (unsigned)C_ * 2u; va1[_i] = S.rowoff((u), HALF + R_) + (unsigned)C_ * 2u; } } while (0)
#define PG8_STA(bufoff, base_ng, base_g, h) do { if constexpr (GATHER) { if (h) PG8_STAGE(bufoff, base_g, va1); else PG8_STAGE(bufoff, base_g, va0); } else PG8_STAGE(bufoff, base_ng, voffA); } while (0)
    const size_t kstep = (size_t)(BK * 2);
    const size_t hstep = (size_t)HALF * K * 2;
    const size_t tstep = 2 * hstep;
    const unsigned ldsw = (unsigned)wid * 1024u;
    const int aoff = lds_byte(wr * 64 + fr, fq * 8), boff = lds_byte(wc * 32 + fr, fq * 8);
#define PG8_SA(b, h) (((b) * 2 + (h)) * HTB)
#define PG8_SB(b, h) ((4 + (b) * 2 + (h)) * HTB)
#define PG8_STAGE(bufoff, gbase, voff) do { _Pragma("unroll") for (int _i = 0; _i < 2; ++_i) \
        __builtin_amdgcn_global_load_lds((const unsigned*)((const char*)(gbase) + (voff)[_i]), (PG8_LAS unsigned*)(lds + (bufoff) + ldsw + _i * 8192), 16, 0, 0); } while (0)
#define PG8_LDA(dst, b, h) do { if constexpr (SCW != 0) { _Pragma("unroll") for (int m = 0; m < 4; ++m) dst##8[m] = PG8_CAT8(*(const PG8_LAS bf16x8*)(lds + PG8_SA(b, h) + aoff + m * 2048), *(const PG8_LAS bf16x8*)(lds + PG8_SA(b, h) + aoff + m * 2048 + 1024)); } \
        else { _Pragma("unroll") for (int m = 0; m < 4; ++m) _Pragma("unroll") for (int k = 0; k < 2; ++k) dst[m][k] = *(const PG8_LAS bf16x8*)(lds + PG8_SA(b, h) + aoff + m * 2048 + k * 1024); } } while (0)
#define PG8_LDB(dst, b, h) do { if constexpr (SCW != 0) { _Pragma("unroll") for (int n = 0; n < 2; ++n) dst##8[n] = PG8_CAT8(*(const PG8_LAS bf16x8*)(lds + PG8_SB(b, h) + boff + n * 2048), *(const PG8_LAS bf16x8*)(lds + PG8_SB(b, h) + boff + n * 2048 + 1024)); } \
        else { _Pragma("unroll") for (int n = 0; n < 2; ++n) _Pragma("unroll") for (int k = 0; k < 2; ++k) dst[n][k] = *(const PG8_LAS bf16x8*)(lds + PG8_SB(b, h) + boff + n * 2048 + k * 1024); } } while (0)
#define PG8_CAT8(lo, hi) __builtin_shufflevector(__builtin_bit_cast(i32x4_t, (lo)), __builtin_bit_cast(i32x4_t, (hi)), 0, 1, 2, 3, 4, 5, 6, 7)
#define PG8_MMA(ai, bj, At, Bt) do { __builtin_amdgcn_s_setprio(1); _Pragma("unroll") for (int m = 0; m < 4; ++m) _Pragma("unroll") for (int n = 0; n < 2; ++n) { \
        if constexpr (SCW != 0) acc[ai][bj][m][n] = __builtin_amdgcn_mfma_scale_f32_16x16x128_f8f6f4(Bt##8[n], At##8[m], acc[ai][bj][m][n], 0, 0, 0, SCW, 0, SCX); \
        else { _Pragma("unroll") for (int k = 0; k < 2; ++k) acc[ai][bj][m][n] = __builtin_amdgcn_mfma_f32_16x16x32_bf16(Bt[n][k], At[m][k], acc[ai][bj][m][n], 0, 0, 0); } } __builtin_amdgcn_s_setprio(0); } while (0)
#define PG8_WAIT_V(n) asm volatile("s_waitcnt vmcnt(" #n ")" ::: "memory")
#define PG8_WAIT_L(n) asm volatile("s_waitcnt lgkmcnt(" #n ")" ::: "memory")
#define PG8_BAR __builtin_amdgcn_s_barrier()
#define PG8_SCHED __builtin_amdgcn_sched_barrier(0)
    Unit cur, nxt; int ui = 0;
    if (!S.next(0, cur)) return;
    f32x4 acc[2][2][4][2];
    if constexpr (Epi::HAS_INIT) { E.init(acc, cur, wr, wc, fr, fq); if constexpr (Epi::INIT_LOADS) __builtin_amdgcn_s_waitcnt(0x0F70); }
    else {
#pragma unroll
    for (int a = 0; a < 2; ++a)
#pragma unroll
        for (int b = 0; b < 2; ++b)
#pragma unroll
            for (int m = 0; m < 4; ++m)
#pragma unroll
                for (int n = 0; n < 2; ++n) acc[a][b][m][n] = (f32x4){0.f, 0.f, 0.f, 0.f};
    }
    bf16x8 At[4][2], B0[2][2], B1[2][2]; i32x8_t At8[4], B08[2], B18[2];
    const char* cA = (const char*)g.A + (size_t)cur.pm * tstep; const char* cB = (const char*)g.Bt + (size_t)cur.pn * tstep;
    S.a_ready(cur);
    if constexpr (SP2) {
        if constexpr (GATHER) PG8_VA(cur);
        PG8_STAGE(PG8_SB(0, 0), cB, voffB); PG8_STAGE(PG8_SB(0, 1), cB + hstep, voffB); PG8_STA(PG8_SA(0, 0), cA, gA0, 0); PG8_STA(PG8_SA(0, 1), cA + hstep, gA0, 1);
        if (wr == 1) PG8_BAR;
        PG8_WAIT_V(2); PG8_BAR;
        PG8_STAGE(PG8_SB(1, 0), cB + kstep, voffB); PG8_STA(PG8_SA(1, 0), cA + kstep, gA0 + kstep, 0); PG8_STAGE(PG8_SB(1, 1), cB + hstep + kstep, voffB);
        PG8_WAIT_V(6); PG8_BAR;
    } else {
        PG8_STAGE(PG8_SB(0, 0), cB, voffB); PG8_STAGE(PG8_SA(0, 0), cA, voffA); PG8_STAGE(PG8_SB(0, 1), cB + hstep, voffB); PG8_STAGE(PG8_SA(0, 1), cA + hstep, voffA);
        if (wr == 1) PG8_BAR;
        PG8_WAIT_V(4); PG8_BAR;
        PG8_STAGE(PG8_SB(1, 0), cB + kstep, voffB); PG8_STAGE(PG8_SA(1, 0), cA + kstep, voffA); PG8_STAGE(PG8_SB(1, 1), cB + hstep + kstep, voffB);
        PG8_WAIT_V(6); PG8_BAR;
    }
    for (;;) {
        const bool has_next = S.next(ui + 1, nxt);
        const char* nA = has_next ? (const char*)g.A + (size_t)nxt.pm * tstep : cA; const char* nB = has_next ? (const char*)g.Bt + (size_t)nxt.pn * tstep : cB;
        _Pragma("nounroll") for (int t = 0; t < nt; t += 2) {
            const bool last = (t == nt - 2);
            const char* a1 = cA + (size_t)(t + 1) * kstep;
            const char* a2 = last ? nA : cA + (size_t)(t + 2) * kstep; const char* b2 = last ? nB : cB + (size_t)(t + 2) * kstep;
            const char* a3 = a2 + kstep; const char* b3 = b2 + kstep;
            if (last && has_next) S.a_ready(nxt);
            const char* const g1 = gA0 + (size_t)(t + 1) * kstep; const char* const g2 = last ? gA0 : gA0 + (size_t)(t + 2) * kstep; const char* const g3 = g2 + kstep;
            if constexpr (SP2) {
            PG8_LDB(B0, 0, 0); PG8_LDB(B1, 0, 1); PG8_SCHED; PG8_LDA(At, 0, 0); PG8_STA(PG8_SA(1, 1), a1 + hstep, g1, 1);
            PG8_WAIT_V(8); PG8_WAIT_L(0); PG8_BAR; PG8_MMA(0, 0, At, B0); PG8_MMA(0, 1, At, B1); PG8_BAR; PG8_SCHED;
            if constexpr (GATHER) { if (last && has_next) PG8_VA(nxt); }
            PG8_LDA(At, 0, 1); PG8_STAGE(PG8_SB(0, 0), b2, voffB); PG8_STAGE(PG8_SB(0, 1), b2 + hstep, voffB); PG8_STA(PG8_SA(0, 0), a2, g2, 0);
            PG8_WAIT_V(8); PG8_WAIT_L(0); PG8_BAR; PG8_MMA(1, 0, At, B0); PG8_MMA(1, 1, At, B1); PG8_BAR; PG8_SCHED;
            PG8_LDB(B0, 1, 0); PG8_LDB(B1, 1, 1); PG8_SCHED; PG8_LDA(At, 1, 0); PG8_STA(PG8_SA(0, 1), a2 + hstep, g2, 1);
            PG8_WAIT_V(8); PG8_WAIT_L(0); PG8_BAR; PG8_MMA(0, 0, At, B0); PG8_MMA(0, 1, At, B1); PG8_BAR; PG8_SCHED;
            PG8_LDA(At, 1, 1); PG8_STAGE(PG8_SB(1, 0), b3, voffB); PG8_STAGE(PG8_SB(1, 1), b3 + hstep, voffB); PG8_STA(PG8_SA(1, 0), a3, g3, 0);
            PG8_WAIT_V(8); PG8_WAIT_L(0); PG8_BAR; PG8_MMA(1, 0, At, B0); PG8_MMA(1, 1, At, B1); PG8_BAR; PG8_SCHED;
            } else {
            PG8_LDB(B0, 0, 0); PG8_SCHED; PG8_LDA(At, 0, 0); PG8_STAGE(PG8_SA(1, 1), a1 + hstep, voffA);
            PG8_WAIT_L(8); PG8_BAR; PG8_WAIT_L(0); PG8_MMA(0, 0, At, B0); PG8_BAR; PG8_SCHED;
            PG8_LDB(B1, 0, 1); PG8_STAGE(PG8_SB(0, 0), b2, voffB);
            PG8_BAR; PG8_WAIT_L(0); PG8_MMA(0, 1, At, B1); PG8_BAR;
            PG8_LDA(At, 0, 1); PG8_STAGE(PG8_SA(0, 0), a2, voffA);
            PG8_BAR; PG8_WAIT_L(0); PG8_MMA(1, 0, At, B0); PG8_BAR; PG8_SCHED;
            PG8_STAGE(PG8_SB(0, 1), b2 + hstep, voffB);
            PG8_WAIT_V(6); PG8_BAR; PG8_MMA(1, 1, At, B1); PG8_BAR;
            PG8_LDB(B0, 1, 0); PG8_SCHED; PG8_LDA(At, 1, 0); PG8_STAGE(PG8_SA(0, 1), a2 + hstep, voffA);
            PG8_WAIT_L(8); PG8_BAR; PG8_WAIT_L(0); PG8_MMA(0, 0, At, B0); PG8_BAR; PG8_SCHED;
            PG8_LDB(B1, 1, 1); PG8_STAGE(PG8_SB(1, 0), b3, voffB);
            PG8_BAR; PG8_WAIT_L(0); PG8_MMA(0, 1, At, B1); PG8_BAR;
            PG8_LDA(At, 1, 1); PG8_STAGE(PG8_SA(1, 0), a3, voffA);
            PG8_BAR; PG8_WAIT_L(0); PG8_MMA(1, 0, At, B0); PG8_BAR; PG8_SCHED;
            PG8_STAGE(PG8_SB(1, 1), b3 + hstep, voffB);
            PG8_WAIT_V(6); PG8_BAR; PG8_MMA(1, 1, At, B1); PG8_BAR;
            }
        }
        if constexpr (ALIGN_EPI) { if (wr == 0) PG8_BAR; }
        if constexpr (!Epi::AFTER_DRAIN) { int fr_ = fr, fq_ = fq; asm volatile("" : "+v"(fr_), "+v"(fq_));
            E(acc, cur, wr, wc, fr_, fq_); S.done(cur); }
        if (!has_next) break;
        if constexpr (Epi::HAS_INIT) { int fr_ = fr, fq_ = fq; asm volatile("" : "+v"(fr_), "+v"(fq_)); E.init(acc, nxt, wr, wc, fr_, fq_); if constexpr (Epi::INIT_LOADS) __builtin_amdgcn_s_waitcnt(0x0F70); }
        else {
#pragma unroll
        for (int a = 0; a < 2; ++a)
#pragma unroll
            for (int b = 0; b < 2; ++b)
#pragma unroll
                for (int m = 0; m < 4; ++m)
#pragma unroll
                    for (int n = 0; n < 2; ++n) acc[a][b][m][n] = (f32x4){0.f, 0.f, 0.f, 0.f};
        }
        cur = nxt; cA = nA; cB = nB; ++ui;
        if constexpr (ALIGN_EPI) { if (wr == 1) PG8_BAR; }
    }
    PG8_WAIT_V(0);
    if constexpr (!ALIGN_EPI) { if (wr == 0) PG8_BAR; }
    PG8_BAR;
    if constexpr (Epi::AFTER_DRAIN) { E.fused(acc, cur, wr, wc, fr, fq, lds, wid, lane); S.done(cur); }
#undef PG8_SA
#undef PG8_CAT8
#undef PG8_VA
#undef PG8_STA
#undef PG8_SB
#undef PG8_STAGE
#undef PG8_LDA
#undef PG8_LDB
#undef PG8_MMA
#undef PG8_WAIT_V
#undef PG8_WAIT_L
#undef PG8_BAR
#undef PG8_SCHED
}
}

#ifndef PG8_SP2
#define PG8_SP2 true
#endif
#ifndef PG8_ALIGN
#define PG8_ALIGN true
#endif
#define GAS __attribute__((address_space(1)))
#define LAS __attribute__((address_space(3)))
typedef unsigned short bf16;
typedef unsigned v4u __attribute__((ext_vector_type(4)));
typedef float f32x4 __attribute__((ext_vector_type(4)));
typedef short bf16x8 __attribute__((ext_vector_type(8)));
typedef GAS unsigned gu32;
typedef GAS unsigned long long gu64;
#define RLX_AGENT __ATOMIC_RELAXED, __HIP_MEMORY_SCOPE_AGENT
#define LDS_WAIT() asm volatile("s_waitcnt lgkmcnt(0)" ::: "memory")
#define VM_WAIT() asm volatile("s_waitcnt vmcnt(0)" ::: "memory")
__device__ __forceinline__ unsigned long long rt() { return __builtin_amdgcn_s_memrealtime(); }
__device__ __forceinline__ unsigned f2bf(float f) { unsigned u = __builtin_bit_cast(unsigned, f); return (u + 0x7fffu + ((u >> 16) & 1u)) >> 16; }
__device__ __forceinline__ unsigned pk2(float lo, float hi) { return f2bf(lo) | (f2bf(hi) << 16); }

#define XB_TMO      128
#define XB_XCNT(j)  (256  + 64 * (j))
#define XB_XSUB(j)  (1280 + 64 * (j))
#define XB_XGEN(j)  (2304 + 64 * (j))
#define XB_TOP      3328
#define XB_TOPGEN   3392
#define XCD_BAR_WORDS 3456
#define XB_SPIN_CAP (1u << 18)

__device__ __forceinline__ unsigned xb_ld(unsigned* p)              { return __hip_atomic_load(p, __ATOMIC_RELAXED, __HIP_MEMORY_SCOPE_AGENT); }
__device__ __forceinline__ unsigned xb_add(unsigned* p, unsigned v) { return __hip_atomic_fetch_add(p, v, __ATOMIC_RELAXED, __HIP_MEMORY_SCOPE_AGENT); }
__device__ __forceinline__ unsigned xb_xcc_id() { return (unsigned)__builtin_amdgcn_s_getreg((3 << 11) | 20) & 0xFu; }
#define XB_SPIN(cond, bar) do { unsigned _sp = 0; while (cond) { __builtin_amdgcn_s_sleep(1); \
    if ((++_sp & 255u) == 0u) { if (xb_ld(&(bar)[XB_TMO])) break; if (_sp > XB_SPIN_CAP) { atomicAdd(&(bar)[XB_TMO], 1u); break; } } } } while (0)

struct XcdBarrier {
    unsigned* bar; unsigned x;
    volatile LAS unsigned* st;
};

__device__ __forceinline__ XcdBarrier xcd_barrier_post(unsigned* bar, volatile LAS unsigned* st) {
    XcdBarrier b; b.bar = bar; b.x = xb_xcc_id(); b.st = st;
    if (threadIdx.x == 0) (void)xb_add(&bar[XB_XCNT(b.x)], 1u);
    return b;
}
__device__ __forceinline__ void xcd_barrier_complete(unsigned* bar, unsigned x, unsigned& nloc, unsigned& nx) {
    const unsigned G = gridDim.x * gridDim.y * gridDim.z;
    unsigned sum, cnt, mine, sp = 0u;
    for (;;) {
        sum = 0u; cnt = 0u; mine = 0u;
#pragma unroll
        for (unsigned j = 0; j < 16; ++j) { const unsigned c = xb_ld(&bar[XB_XCNT(j)]); sum += c; cnt += (c > 0u) ? 1u : 0u; mine = (j == x) ? c : mine; }
        if (sum == G) break;
        __builtin_amdgcn_s_sleep(1);
        if ((++sp & 255u) == 0u) { if (xb_ld(&bar[XB_TMO])) break; if (sp > XB_SPIN_CAP) { atomicAdd(&bar[XB_TMO], 1u); break; } }
    }
    nloc = mine > 0u ? mine : 1u; nx = cnt > 0u ? cnt : 1u;
}

__device__ __forceinline__ void xcd_barrier(const XcdBarrier& b) {
    asm volatile("s_waitcnt vmcnt(0)" ::: "memory");
    __syncthreads();
    if (threadIdx.x == 0) {
        unsigned* bar = b.bar;
        __builtin_amdgcn_s_waitcnt(0);
        unsigned nloc = b.st[0], nx = b.st[1];
        if (nloc == 0u) { xcd_barrier_complete(bar, b.x, nloc, nx); b.st[0] = nloc; b.st[1] = nx; }
        const unsigned old = xb_add(&bar[XB_XSUB(b.x)], 1u);
        const unsigned gen = old / nloc;
        if (old + 1u == (gen + 1u) * nloc) {
            __builtin_amdgcn_fence(__ATOMIC_RELEASE, "agent");
            asm volatile("s_waitcnt vmcnt(0)" ::: "memory");
            const unsigned og = xb_add(&bar[XB_TOP], 1u);
            const unsigned tg = og / nx;
            if (og + 1u == (tg + 1u) * nx) xb_add(&bar[XB_TOPGEN], 1u);
            else XB_SPIN(xb_ld(&bar[XB_TOPGEN]) == tg, bar);
            __builtin_amdgcn_fence(__ATOMIC_ACQUIRE, "agent");
            xb_add(&bar[XB_XGEN(b.x)], 1u);
            asm volatile("s_waitcnt vmcnt(0)" ::: "memory");
        } else {
            XB_SPIN(xb_ld(&bar[XB_XGEN(b.x)]) == gen, bar);
            __builtin_amdgcn_fence(__ATOMIC_ACQUIRE, "agent");
            asm volatile("s_waitcnt vmcnt(0)" ::: "memory");
        }
    }
    __syncthreads();
}

constexpr int NWAVES = 8;
#ifndef MK_ONE_LAUNCH
#define MK_ONE_LAUNCH 1
#endif

constexpr int BATCH = 16, SEQ = 2048, D = 1024, T = BATCH * SEQ;
constexpr int NIN = 3584;
constexpr int OFF_SQ = 0, OFF_SK = 512, OFF_SV = 1024, OFF_HQ = 1536, OFF_HF = 2048, OFF_HI = 2560, OFF_HG = 3072;
constexpr int NE = 32, TOPK = 4, NASSIGN = T * TOPK;
constexpr int MAXTILES = NASSIGN / 256 + NE;
constexpr int MAXROWS = MAXTILES * 256;
constexpr float EPS = 1e-6f;

constexpr size_t MiB = 1u << 20;
constexpr size_t WS_CTL = 0, CTL_ZERO_BYTES = 1 * MiB;
constexpr size_t WS_WIN = 2 * MiB;
constexpr size_t WS_WOUT = 10 * MiB;
constexpr size_t WS_RT = 12 * MiB;
constexpr size_t WS_WGU = 16 * MiB;
constexpr size_t WS_WD = 144 * MiB;
constexpr size_t WS_XN = 208 * MiB;
constexpr size_t WS_P = 272 * MiB;
constexpr size_t WS_PH = WS_P + 96 * MiB;
constexpr size_t WS_MIX = 496 * MiB;
constexpr size_t WS_ACT = 272 * MiB;
constexpr size_t WS_YK = 560 * MiB;
constexpr size_t WS_QN = 624 * MiB;
constexpr size_t WS_KN = 656 * MiB;
constexpr size_t WS_VT = 688 * MiB;
constexpr size_t WS_KVS = 720 * MiB;
constexpr size_t WS_DEC = 784 * MiB;
constexpr size_t WS_SSEG = 786 * MiB;
constexpr size_t WS_DSEG = 802 * MiB;
constexpr size_t WS_LIST = 816 * MiB;
constexpr size_t WS_TOPG = 825 * MiB;
constexpr size_t WS_X8 = 560 * MiB;
constexpr size_t WS_END = 832 * MiB;
static_assert(WS_ACT + (size_t)MAXROWS * 2048 <= WS_YK && WS_YK + (size_t)T * 4 * 2048 <= WS_LIST && WS_MIX + (size_t)T * 2048 <= WS_YK, "d_ws map");
constexpr int CW_TMO = 0, CW_CODE = 1;
constexpr int CW_CNT = 64;
constexpr int CW_BAR = 4096;

constexpr int RING_OFF = 0, RING_BYTES = 131072;
constexpr int RT_ROW = 2064, RT_WL = 32 * RT_ROW, RT_END = 64 * RT_ROW;
constexpr int LDSCTL_OFF = 133120, MISC_OFF = LDSCTL_OFF + 320;
constexpr int LTAB_OFF = LDSCTL_OFF + 512;
constexpr int LT_TS = MAXTILES, LT_CNT = MAXTILES + 32, LT_MISC = MAXTILES + 64, LT_WORDS = MAXTILES + 192;
constexpr int ROWTAB_OFF = LTAB_OFF + LT_WORDS * 4;
constexpr int MAXSLOT = 17;
constexpr int ROWTAB2_OFF = ROWTAB_OFF + MAXSLOT * 1024;
constexpr int LDS_BYTES = ROWTAB2_OFF + MAXSLOT * 512;
static_assert(RT_END <= LDSCTL_OFF && MISC_OFF + 128 <= LTAB_OFF && LDS_BYTES <= 160 * 1024 && (MAXTILES * 8 + 255) / 256 <= MAXSLOT && 2 * ((MAXTILES * 4 + 255) / 256) * 1024 <= MAXSLOT * 1536 && ROWTAB_OFF % 16 == 0, "LDS map");

struct Frame {
    LAS unsigned char* lds;
    volatile LAS unsigned* MISC;
    gu32* ctl;
    int tid, lane, wave, gw, ngw;
    int vcu, G;
    const float *x, *norm1_g, *w_in, *sb_q_g, *sb_k_g, *sb_out_g, *hg_lb, *hg_out_g, *w_out, *norm2_g, *w_router, *b_router, *w_gu, *b_gu, *w_d, *b_d;
    float* out;
    unsigned char* ws;
};
__device__ __forceinline__ float bf2f(unsigned short b) { return __builtin_bit_cast(float, (unsigned)b << 16); }
__device__ __forceinline__ float bflo(unsigned w) { return __builtin_bit_cast(float, w << 16); }
__device__ __forceinline__ float bfhi(unsigned w) { return __builtin_bit_cast(float, w & 0xffff0000u); }
typedef __bf16 bf16x2n_ __attribute__((ext_vector_type(2)));
typedef float f32x2n_ __attribute__((ext_vector_type(2)));
__device__ __forceinline__ unsigned pkbf(float a, float b) { const bf16x2n_ v = __builtin_convertvector((f32x2n_){a, b}, bf16x2n_); return __builtin_bit_cast(unsigned, v); }
__device__ __forceinline__ int lane_id() { int l; asm volatile("v_mbcnt_lo_u32_b32 %0, -1, 0\n\tv_mbcnt_hi_u32_b32 %0, -1, %0" : "=v"(l)); return l; }
__device__ __forceinline__ int vzero() { int z; asm volatile("v_mov_b32 %0, 0" : "=v"(z)); return z; }
__device__ __forceinline__ float wave_sum(float v) {
#pragma unroll
    for (int o = 1; o < 64; o <<= 1) v += __shfl_xor(v, o);
    return v;
}

constexpr float W8_SCALE = 256.f, A8_SCALE = 4.f, Y8_SCALE = 32.f; static_assert(Y8_SCALE == 32.f, "SC_W8Y below is 2^-8 * 32");
constexpr int SC_ONE = 0x7f7f7f7f, SC_W8 = 0x77777777, SC_A8 = 0x7d7d7d7d, SC_W8Y = 0x7c7c7c7c;
struct P0Item { const float* W; bf16* WT; const float* rowscale; int N, k0, n0, drow0, fp8, perm; };
__device__ __forceinline__ void p0_load(const P0Item& it, f32x4 (&v)[16], int lane) {
    const int kr = lane >> 4, nc = 4 * (lane & 15);
#pragma unroll
    for (int i = 0; i < 16; ++i) v[i] = __builtin_nontemporal_load((const f32x4*)(it.W + (size_t)(it.k0 + 4 * i + kr) * it.N + it.n0 + nc));
}
__device__ __forceinline__ void p0_store(const P0Item& it, const f32x4 (&v)[16], LAS unsigned char* scr, int lane) {
    const int kr = lane >> 4, nc = 4 * (lane & 15);
#pragma unroll
    for (int i = 0; i < 16; ++i) { const float sc = it.rowscale ? it.rowscale[it.k0 + 4 * i + kr] : 1.f;
        *(LAS unsigned long long*)(scr + (4 * i + kr) * 136 + 2 * nc) = (unsigned long long)pkbf(v[i].x * sc, v[i].y * sc) | ((unsigned long long)pkbf(v[i].z * sc, v[i].w * sc) << 32); }
    LDS_WAIT(); asm volatile("" ::: "memory");
    const LAS unsigned short* s16 = (const LAS unsigned short*)scr;
    if (it.fp8) { const int p = lane & 3, nr = lane >> 2;
#pragma unroll
        for (int c = 0; c < 4; ++c) { const int n = 16 * c + nr; unsigned val[16];
#pragma unroll
            for (int kk = 0; kk < 16; ++kk) val[kk] = s16[(16 * p + kk) * 68 + n];
            v4u w4;
            w4.x = pg8::pk4_fp8(bflo(val[0]) * W8_SCALE, bflo(val[1]) * W8_SCALE, bflo(val[2]) * W8_SCALE, bflo(val[3]) * W8_SCALE);
            w4.y = pg8::pk4_fp8(bflo(val[4]) * W8_SCALE, bflo(val[5]) * W8_SCALE, bflo(val[6]) * W8_SCALE, bflo(val[7]) * W8_SCALE);
            w4.z = pg8::pk4_fp8(bflo(val[8]) * W8_SCALE, bflo(val[9]) * W8_SCALE, bflo(val[10]) * W8_SCALE, bflo(val[11]) * W8_SCALE);
            w4.w = pg8::pk4_fp8(bflo(val[12]) * W8_SCALE, bflo(val[13]) * W8_SCALE, bflo(val[14]) * W8_SCALE, bflo(val[15]) * W8_SCALE);
            *(GAS v4u*)((unsigned char*)it.WT + (size_t)(it.drow0 + (it.perm == 2 ? 128 * ((n >> 3) & 1) + 8 * (n >> 4) + (n & 7) : n)) * D + it.k0 + 16 * p) = w4; }
    } else { const int p = lane & 7, nr = lane >> 3;
#pragma unroll
        for (int c = 0; c < 8; ++c) { const int n = 8 * c + nr; unsigned val[8];
#pragma unroll
            for (int kk = 0; kk < 8; ++kk) val[kk] = s16[(8 * p + kk) * 68 + n];
            v4u w4; w4.x = val[0] | (val[1] << 16); w4.y = val[2] | (val[3] << 16); w4.z = val[4] | (val[5] << 16); w4.w = val[6] | (val[7] << 16);
            *(GAS v4u*)(it.WT + (size_t)(it.drow0 + (it.perm ? 128 * (n >> 5) + (n & 31) : n)) * D + it.k0 + 8 * p) = w4; } }
    LDS_WAIT(); asm volatile("" ::: "memory");
}
__device__ __forceinline__ void rms_rows2_to_bf16(const float* xa, const float* xb, bool hasb, const float* g, bf16* oa, bf16* ob, int lane) {
    const GAS f32x4* pa = (const GAS f32x4*)xa + lane; const GAS f32x4* pb = (const GAS f32x4*)(hasb ? xb : xa) + lane; const f32x4* gr = (const f32x4*)g + lane;
    f32x4 va[4], vb[4], gg[4]; float sa = 0.f, sb = 0.f;
#pragma unroll
    for (int j = 0; j < 4; ++j) { va[j] = __builtin_nontemporal_load(pa + 64 * j); vb[j] = __builtin_nontemporal_load(pb + 64 * j); gg[j] = gr[64 * j]; }
#pragma unroll
    for (int j = 0; j < 4; ++j) { sa += (va[j].x * va[j].x + va[j].y * va[j].y) + (va[j].z * va[j].z + va[j].w * va[j].w); sb += (vb[j].x * vb[j].x + vb[j].y * vb[j].y) + (vb[j].z * vb[j].z + vb[j].w * vb[j].w); }
    const float ra = 1.f / sqrtf(wave_sum(sa) * (1.f / D) + EPS), rb = 1.f / sqrtf(wave_sum(sb) * (1.f / D) + EPS);
    GAS unsigned long long* o8a = (GAS unsigned long long*)oa + lane; GAS unsigned long long* o8b = (GAS unsigned long long*)ob + lane;
#pragma unroll
    for (int j = 0; j < 4; ++j) o8a[64 * j] = (unsigned long long)pkbf(va[j].x * ra * gg[j].x, va[j].y * ra * gg[j].y) | ((unsigned long long)pkbf(va[j].z * ra * gg[j].z, va[j].w * ra * gg[j].w) << 32);
    if (hasb) {
#pragma unroll
        for (int j = 0; j < 4; ++j) o8b[64 * j] = (unsigned long long)pkbf(vb[j].x * rb * gg[j].x, vb[j].y * rb * gg[j].y) | ((unsigned long long)pkbf(vb[j].z * rb * gg[j].z, vb[j].w * rb * gg[j].w) << 32); }
}
__device__ __forceinline__ P0Item p0_item(Frame& F, int r) {
    constexpr int I_IN = 16 * (NIN / 64), I_OUT = 16 * 16, I_GU = NE * 16 * 32;
    P0Item it;
    if (r < I_IN) { const int nb = NIN / 64, kb = r / nb, nn = r % nb; const int pq = 1; it = P0Item{F.w_in, (bf16*)(F.ws + WS_WIN), nullptr, NIN, 64 * kb, 64 * nn, pq ? 256 * (nn >> 2) + 32 * (nn & 3) : 64 * nn, 0, pq}; return it; } r -= I_IN;
    if (r < I_OUT) { const int kb = r / 16, nn = r % 16; it = P0Item{F.w_out, (bf16*)(F.ws + WS_WOUT), nullptr, D, 64 * kb, 64 * nn, 64 * nn, 0, 0}; return it; } r -= I_OUT;
    if (r < I_GU) { const int e = r / 512, q = r % 512, kb = q / 32, nn = q % 32;
        const int isup = nn >> 4, a = (nn & 15) * 64;
        it = P0Item{F.w_gu + (size_t)e * D * 2048, (bf16*)(F.ws + WS_WGU + (size_t)e * 2048 * D), F.norm2_g, 2048, 64 * kb, 64 * nn, 256 * (a >> 7) + 128 * isup + (a & 127), 1, 0}; return it; } r -= I_GU;
    { const int e = r / 256, q = r % 256, kb = q / 16, nn = q % 16;
        it = P0Item{F.w_d + (size_t)e * D * D, (bf16*)(F.ws + WS_WD + (size_t)e * D * D), nullptr, D, 64 * kb, 64 * nn, 256 * (nn >> 2) + 32 * (nn & 3), 1, 2}; return it; }
}
constexpr int P0_NITEMS = 16 * (NIN / 64) + 16 * 16 + NE * 16 * 32 + NE * 16 * 16;
constexpr int P0_NLATE = 1024;
__device__ __forceinline__ void p0_items(Frame& F, int lo, int hi, int w, int nw) {
    LAS unsigned char* scr = F.lds + RING_OFF + F.wave * 16384;
    f32x4 va[16], vb[16]; int it = lo + w;
    if (it < hi) { P0Item A = p0_item(F, it); p0_load(A, va, F.lane);
        for (;;) {
            const int itb = it + nw; const bool hb = itb < hi; const P0Item B = p0_item(F, hb ? itb : it); p0_load(B, vb, F.lane); __builtin_amdgcn_sched_barrier(0);
            p0_store(A, va, scr, F.lane);
            if (!hb) break;
            it = itb + nw; const bool ha = it < hi; A = p0_item(F, ha ? it : itb); p0_load(A, va, F.lane); __builtin_amdgcn_sched_barrier(0);
            p0_store(B, vb, scr, F.lane);
            if (!ha) break;
        }
    }
}
__device__ __forceinline__ void p0_prologue(Frame& F) {
    p0_items(F, 0, P0_NITEMS - P0_NLATE, F.gw, F.ngw);
    for (int q = blockIdx.x * (NWAVES * 64) + F.tid; q < 4096; q += F.G * NWAVES * 64) {
        const int e = q & 31, k0 = (q >> 5) * 8; unsigned hi[8], lo[8];
#pragma unroll
        for (int j = 0; j < 8; ++j) { const float w = F.w_router[(k0 + j) * 32 + e] * F.norm2_g[k0 + j]; hi[j] = pkbf(w, 0.f) & 0xffffu; lo[j] = pkbf(w - bflo(hi[j]), 0.f) & 0xffffu; }
        const v4u h4 = {hi[0] | (hi[1] << 16), hi[2] | (hi[3] << 16), hi[4] | (hi[5] << 16), hi[6] | (hi[7] << 16)}, l4 = {lo[0] | (lo[1] << 16), lo[2] | (lo[3] << 16), lo[4] | (lo[5] << 16), lo[6] | (lo[7] << 16)};
        *(GAS v4u*)(F.ws + WS_RT + e * RT_ROW + 2 * k0) = h4; *(GAS v4u*)(F.ws + WS_RT + RT_WL + e * RT_ROW + 2 * k0) = l4; }
    for (int m = F.gw; m < T; m += 2 * F.ngw) rms_rows2_to_bf16(F.x + (size_t)m * D, F.x + (size_t)(m + F.ngw) * D, m + F.ngw < T, F.norm1_g, (bf16*)(F.ws + WS_XN) + (size_t)m * D, (bf16*)(F.ws + WS_XN) + (size_t)(m + F.ngw) * D, F.lane);
}

typedef float f32x16 __attribute__((ext_vector_type(16)));
typedef __bf16 bf16x2n __attribute__((ext_vector_type(2)));
typedef float f32x2n __attribute__((ext_vector_type(2)));
#define MFMA32(a, b, c) __builtin_amdgcn_mfma_f32_32x32x16_bf16((a), (b), (c), 0, 0, 0)
__device__ __forceinline__ bf16x8 pack8(float a0, float a1, float a2, float a3, float a4, float a5, float a6, float a7) { const v4u p = {pkbf(a0, a1), pkbf(a2, a3), pkbf(a4, a5), pkbf(a6, a7)}; return __builtin_bit_cast(bf16x8, p); }
constexpr float QSCALE = 0.125f * 1.44269504089f;
__device__ __forceinline__ void prep_phase(Frame& F) {
    LAS unsigned* tl = (LAS unsigned*)(F.lds + RING_OFF + F.wave * 16384);
    const bf16* P = (const bf16*)(F.ws + WS_P); bf16* Qn = (bf16*)(F.ws + WS_QN); bf16* Kn = (bf16*)(F.ws + WS_KN); bf16* VT = (bf16*)(F.ws + WS_VT);
    const int tr = F.lane >> 3, c8 = F.lane & 7;
    for (int it = F.gw; it < 4096; it += F.ngw) {
        const int bh = it & 127, blk = it >> 7, b = bh >> 3, h = bh & 7;
        const bf16* base = P + ((size_t)b * 8 + h) * SEQ * 64 + (size_t)(blk * 64 + tr) * 64 + 8 * c8;
        v4u rv[8];
#pragma unroll
        for (int i = 0; i < 8; ++i) { const bf16* row = base + (size_t)(8 * i) * 64; rv[i] = *(const GAS v4u*)(row + (size_t)2 * 16 * 8 * SEQ * 64); }
        {
#pragma unroll
            for (int i = 0; i < 8; ++i) { LAS unsigned* q = tl + (8 * i + tr) * 33 + 4 * c8; q[0] = rv[i].x; q[1] = rv[i].y; q[2] = rv[i].z; q[3] = rv[i].w; }
            LDS_WAIT(); asm volatile("" ::: "memory");
            const LAS unsigned short* t16 = (const LAS unsigned short*)tl; const int dr = tr;
#define KAP(pos) (((pos) & ~12) | (((pos) & 4) << 1) | (((pos) & 8) >> 1))
            bf16* const obase = VT + ((size_t)bh * 64 + blk * 2 + (c8 >> 2)) * 2048 + ((c8 >> 1) & 1) * 512 + (c8 & 1) * 256;
#pragma unroll
            for (int j = 0; j < 8; ++j) { unsigned val[8];
#pragma unroll
                for (int p = 0; p < 8; ++p) { const int pos = 8 * c8 + p; val[p] = t16[KAP(pos) * 66 + 8 * j + dr]; }
                v4u w4; w4.x = val[0] | (val[1] << 16); w4.y = val[2] | (val[3] << 16); w4.z = val[4] | (val[5] << 16); w4.w = val[6] | (val[7] << 16);
                *(GAS v4u*)(obase + (j >> 2) * 1024 + ((8 * j + dr) & 31) * 8) = w4; }
#undef KAP
            LDS_WAIT(); asm volatile("" ::: "memory");
        }
    }
}

__device__ __forceinline__ int crow16(int i, int hh) { return (i & 3) + 8 * (i >> 2) + 4 * hh; }
__device__ __forceinline__ void attn_item(Frame& F, int bh, int qb, float thr, const bf16x8 (&Lt)[2]) {
    const int r = F.lane & 31, hh = F.lane >> 5, b = bh >> 3, h = bh & 7, q0 = qb * 32;
    const bf16* Qn = (const bf16*)(F.ws + WS_QN); const bf16* Kn = (const bf16*)(F.ws + WS_KN); const bf16* VT = (const bf16*)(F.ws + WS_VT);
    bf16x8 qf[4];
#pragma unroll
    for (int s = 0; s < 4; ++s) qf[s] = *(const GAS bf16x8*)(Qn + ((size_t)bh * 64 + qb) * 2048 + s * 512 + F.lane * 8);
    f32x4 gout[2][4];
#pragma unroll
    for (int db = 0; db < 2; ++db)
#pragma unroll
        for (int gq = 0; gq < 4; ++gq) gout[db][gq] = *(const f32x4*)(F.sb_out_g + h * 64 + 32 * db + 8 * gq + 4 * hh);
    f32x16 O0, O1;
#pragma unroll
    for (int i = 0; i < 16; ++i) { O0[i] = 0.f; O1[i] = 0.f; }
    float carry = 0.f;
    const bf16* kbase = Kn + (size_t)bh * 64 * 2048 + F.lane * 8; const bf16* vbase = VT + (size_t)bh * 64 * 2048 + F.lane * 8;
#define ATT_LOAD(KF, VF, kb_) do { _Pragma("unroll") for (int s_ = 0; s_ < 4; ++s_) KF[s_] = *(const GAS bf16x8*)(kbase + (size_t)(kb_) * 2048 + 512 * s_); \
        _Pragma("unroll") for (int db_ = 0; db_ < 2; ++db_) _Pragma("unroll") for (int ks_ = 0; ks_ < 2; ++ks_) VF[db_][ks_] = *(const GAS bf16x8*)(vbase + (size_t)(kb_) * 2048 + 1024 * db_ + 512 * ks_); } while (0)
#define ATT_BLOCK(KF, VF, kb_) do { const bool diag = ((kb_) == qb); \
        f32x16 z; _Pragma("unroll") for (int i = 0; i < 16; ++i) z[i] = 0.f; \
        _Pragma("unroll") for (int s_ = 0; s_ < 4; ++s_) z = MFMA32(KF[s_], qf[s_], z); \
        float sp[16]; \
        _Pragma("unroll") for (int i = 0; i < 16; ++i) { const float zz = z[i]; float v = fmaxf(zz, 0.f) + __builtin_amdgcn_logf(1.f + __builtin_amdgcn_exp2f(-fabsf(zz))); if (diag && !(crow16(i, hh) < r)) v = 0.f; sp[i] = v; } \
        const bf16x8 sb0 = pack8(sp[0], sp[1], sp[2], sp[3], sp[4], sp[5], sp[6], sp[7]), sb1 = pack8(sp[8], sp[9], sp[10], sp[11], sp[12], sp[13], sp[14], sp[15]); \
        f32x16 Cc; _Pragma("unroll") for (int i = 0; i < 16; ++i) Cc[i] = carry; \
        Cc = MFMA32(Lt[0], sb0, Cc); Cc = MFMA32(Lt[1], sb1, Cc); \
        float w[16]; \
        _Pragma("unroll") for (int i = 0; i < 16; ++i) { float v = __builtin_amdgcn_exp2f(z[i] - Cc[i]); if (diag && !(crow16(i, hh) < r)) v = 0.f; w[i] = v; } \
        const bf16x8 wb0 = pack8(w[0], w[1], w[2], w[3], w[4], w[5], w[6], w[7]), wb1 = pack8(w[8], w[9], w[10], w[11], w[12], w[13], w[14], w[15]); \
        O0 = MFMA32(VF[0][0], wb0, O0); O0 = MFMA32(VF[0][1], wb1, O0); O1 = MFMA32(VF[1][0], wb0, O1); O1 = MFMA32(VF[1][1], wb1, O1); \
        carry = __shfl(Cc[0], r); } while (0)
    bf16x8 kfA[4], vfA[2][2], kfB[4], vfB[2][2];
    ATT_LOAD(kfA, vfA, qb);
    for (int kb = qb; kb >= 0; kb -= 2) {
        ATT_LOAD(kfB, vfB, kb > 0 ? kb - 1 : 0); __builtin_amdgcn_sched_barrier(0);
        ATT_BLOCK(kfA, vfA, kb);
        if (kb == 0 || __all(carry > thr)) break;
        ATT_LOAD(kfA, vfA, kb > 1 ? kb - 2 : 0); __builtin_amdgcn_sched_barrier(0);
        ATT_BLOCK(kfB, vfB, kb - 1);
        if (__all(carry > thr)) break;
    }
#undef ATT_LOAD
#undef ATT_BLOCK
    float ss = 0.f;
#pragma unroll
    for (int i = 0; i < 16; ++i) ss += O0[i] * O0[i] + O1[i] * O1[i];
    ss += __shfl_xor(ss, 32);
    const float rs = 1.f / sqrtf(ss * (1.f / 64.f) + EPS);
    bf16* orow = (bf16*)(F.ws + WS_MIX) + ((size_t)b * SEQ + q0 + r) * D + h * 64;
#pragma unroll
    for (int db = 0; db < 2; ++db) { unsigned op[4][2];
#pragma unroll
        for (int gq = 0; gq < 4; ++gq) { const f32x4 gg = gout[db][gq];
            const float a0 = (db ? O1[4 * gq + 0] : O0[4 * gq + 0]) * rs * gg.x, a1 = (db ? O1[4 * gq + 1] : O0[4 * gq + 1]) * rs * gg.y, a2 = (db ? O1[4 * gq + 2] : O0[4 * gq + 2]) * rs * gg.z, a3 = (db ? O1[4 * gq + 3] : O0[4 * gq + 3]) * rs * gg.w;
            op[gq][0] = pkbf(a0, a1); op[gq][1] = pkbf(a2, a3); }
#pragma unroll
        for (int gp = 0; gp < 2; ++gp) { const auto s0 = __builtin_amdgcn_permlane32_swap(op[2 * gp][0], op[2 * gp + 1][0], false, false), s1 = __builtin_amdgcn_permlane32_swap(op[2 * gp][1], op[2 * gp + 1][1], false, false);
            *(GAS v4u*)(orow + 32 * db + 8 * (2 * gp + hh)) = (v4u){s0[0], s1[0], s0[1], s1[1]}; } }
}
__device__ __forceinline__ void attn_phase(Frame& F) {
    const int r = F.lane & 31, hh = F.lane >> 5;
    float mq = fabsf(F.sb_q_g[F.lane]), mk = fabsf(F.sb_k_g[F.lane]);
#pragma unroll
    for (int o = 1; o < 64; o <<= 1) { mq = fmaxf(mq, __shfl_xor(mq, o)); mk = fmaxf(mk, __shfl_xor(mk, o)); }
    const float thr = 64.f * QSCALE * mq * mk * 1.02f + 151.f;
    bf16x8 Lt[2];
#pragma unroll
    for (int ks = 0; ks < 2; ++ks) { float e[8];
#pragma unroll
        for (int jj = 0; jj < 8; ++jj) e[jj] = (16 * ks + 8 * (jj >> 2) + 4 * hh + (jj & 3) >= r) ? 1.f : 0.f;
        Lt[ks] = pack8(e[0], e[1], e[2], e[3], e[4], e[5], e[6], e[7]); }
    for (int it = F.gw; it < 2048; it += F.ngw) { const int bh = it & 127, j = it >> 7;
        attn_item(F, bh, 63 - j, thr, Lt); attn_item(F, bh, j, thr, Lt); attn_item(F, bh, 47 - j, thr, Lt); attn_item(F, bh, 16 + j, thr, Lt); }
}

constexpr int HG_PART = 0, HG_SSQ = 2048, HG_QE = 4096, HG_KE = HG_QE + 64 * 272, HG_VT = HG_KE + 64 * 272, HG_KST = HG_VT + 128 * 144, HG_ST = HG_KST + 128 * 144, HG_END = HG_ST + 128 * 272;
static_assert(HG_END <= RING_BYTES, "HGRN2 LDS map");
__device__ __forceinline__ float hg_lbound(Frame& F, int h, int d) { const int c = h * 128 + d; return 1.f / (1.f + __expf(F.hg_lb[512 + c] - F.hg_lb[c])); }
__device__ __forceinline__ void hg_gates(Frame& F, const unsigned short (&ffr)[16], float lb, int d, int tq, float (&bb)[16], float (&kk)[16], float& total) {
    float run = 1.f;
#pragma unroll
    for (int i = 0; i < 16; ++i) { const float ff = bf2f(ffr[i]); const float sg = __builtin_amdgcn_rcpf(1.f + __expf(-ff));
        const float f = lb + (1.f - lb) * sg; kk[i] = (1.f - lb) * (1.f - sg); run *= f; bb[i] = run; }
    LAS float* part = (LAS float*)(F.lds + RING_OFF + HG_PART);
    part[tq * 128 + d] = run;
    __syncthreads();
    const float p0 = part[d], p1 = part[128 + d], p2 = part[256 + d], p3 = part[384 + d];
    const float off = (tq > 0 ? p0 : 1.f) * (tq > 1 ? p1 : 1.f) * (tq > 2 ? p2 : 1.f);
    total = (p0 * p1) * (p2 * p3);
#pragma unroll
    for (int i = 0; i < 16; ++i) bb[i] *= off;
}
#define HG_HV() const bf16* const PHp = (const bf16*)(F.ws + WS_PH); \
    const __amdgpu_buffer_rsrc_t rsrcP = __builtin_amdgcn_make_buffer_rsrc((void*)PHp, 0, (int)((size_t)4 * T * 512 * 2), 0x00020000)
#define HG_SOFF(item_, arr_) ((unsigned)((((arr_) * 16 + (((item_) >> 5) >> 2)) * 4 + (((item_) >> 5) & 3)) * SEQ + ((item_) & 31) * 64) * 256u)
#define HG_ARR(col_) ((col_) == OFF_HQ ? 0 : (col_) == OFF_HF ? 1 : (col_) == OFF_HI ? 2 : 3)
#define HG_LOADT(dst2, item_, arr_) do { const unsigned so_ = (unsigned)__builtin_amdgcn_readfirstlane((int)HG_SOFF(item_, arr_)); _Pragma("unroll") for (int j_ = 0; j_ < 2; ++j_) \
        (dst2)[j_] = __builtin_bit_cast(v4u, __builtin_amdgcn_raw_buffer_load_b128(rsrcP, (unsigned)F.tid * 16u + 8192u * j_, so_, 0)); } while (0)
#define HG_PUT(src2, raw_) do { _Pragma("unroll") for (int j_ = 0; j_ < 2; ++j_) *(LAS v4u*)((raw_) + ((F.tid >> 4) + 32 * j_) * 272 + (F.tid & 15) * 16) = (src2)[j_]; } while (0)
#define HG_COL(dst, raw_) do { _Pragma("unroll") for (int i_ = 0; i_ < 16; ++i_) dst[i_] = *(const LAS unsigned short*)((raw_) + (16 * tq + i_) * 272 + 2 * d); } while (0)
template <bool PERMUTE> __device__ __forceinline__ void st16(LAS unsigned char* dst, const float (&v)[16]) {
    v4u a, b2;
    if (!PERMUTE) { a.x = pkbf(v[0], v[1]); a.y = pkbf(v[2], v[3]); a.z = pkbf(v[4], v[5]); a.w = pkbf(v[6], v[7]); b2.x = pkbf(v[8], v[9]); b2.y = pkbf(v[10], v[11]); b2.z = pkbf(v[12], v[13]); b2.w = pkbf(v[14], v[15]); }
    else { a.x = pkbf(v[0], v[1]); a.y = pkbf(v[2], v[3]); a.z = pkbf(v[8], v[9]); a.w = pkbf(v[10], v[11]); b2.x = pkbf(v[4], v[5]); b2.y = pkbf(v[6], v[7]); b2.z = pkbf(v[12], v[13]); b2.w = pkbf(v[14], v[15]); }
    *(LAS v4u*)dst = a; *(LAS v4u*)(dst + 16) = b2;
}
__device__ __forceinline__ void hgA_phase(Frame& F) {
    const int d = F.tid & 127, tq = F.tid >> 7, r = F.lane & 31, hh = F.lane >> 5;
    const bf16* P = (const bf16*)(F.ws + WS_P); bf16* KVS = (bf16*)(F.ws + WS_KVS); float* DEC = (float*)(F.ws + WS_DEC); float* SSEG = (float*)(F.ws + WS_SSEG); float* DSEG = (float*)(F.ws + WS_DSEG);
    LAS unsigned char* L = F.lds + RING_OFF; LAS float* decl = (LAS float*)(L + HG_SSQ);
    HG_HV();
    v4u rf[2], rv[2];
    LAS unsigned char* const RAWF = F.lds + ROWTAB_OFF; LAS unsigned char* const RAWV = L + HG_ST;
    for (int wg = blockIdx.x; wg < 256; wg += F.G) {
        const int bh = wg >> 2, seg = wg & 3, item0 = bh * 32 + seg * 8, h = bh & 3;
        HG_LOADT(rf, item0, 1); HG_LOADT(rv, item0, 2);
        const float lbv = hg_lbound(F, h, d); float totrun = 1.f;
        const int db = F.wave & 3, eb0 = 2 * (F.wave >> 2);
        f32x16 run0, run1;
#pragma unroll
        for (int i = 0; i < 16; ++i) { run0[i] = 0.f; run1[i] = 0.f; }
      for (int k = 0; k < 8; ++k) {
        const int item = item0 + k;
        HG_PUT(rf, RAWF); HG_PUT(rv, RAWV);
        __syncthreads();
        { const int nit = k < 7 ? item + 1 : item; HG_LOADT(rf, nit, 1); HG_LOADT(rv, nit, 2); __builtin_amdgcn_sched_barrier(0); }
        unsigned short ffr[16], vr[16]; HG_COL(ffr, RAWF); HG_COL(vr, RAWV);
        float bb[16], kk[16], total; hg_gates(F, ffr, lbv, d, tq, bb, kk, total);
        float ks[16], vv[16];
#pragma unroll
        for (int i = 0; i < 16; ++i) { ks[i] = kk[i] * (total * __builtin_amdgcn_rcpf(bb[i])); vv[i] = bf2f(vr[i]); }
        st16<false>(L + HG_KST + d * 144 + tq * 32, ks); st16<false>(L + HG_VT + d * 144 + tq * 32, vv);
        const float dc = total; totrun *= total;
        if (tq == 0) { DEC[(size_t)item * 128 + d] = dc; decl[d] = dc; }
        __syncthreads();
        f32x16 acc0, acc1;
#pragma unroll
        for (int i = 0; i < 16; ++i) { acc0[i] = 0.f; acc1[i] = 0.f; }
#pragma unroll
        for (int s = 0; s < 4; ++s) { const bf16x8 af = *(const LAS bf16x8*)(L + HG_KST + (db * 32 + r) * 144 + 32 * s + 16 * hh);
            const bf16x8 b0 = *(const LAS bf16x8*)(L + HG_VT + (eb0 * 32 + r) * 144 + 32 * s + 16 * hh), b1 = *(const LAS bf16x8*)(L + HG_VT + ((eb0 + 1) * 32 + r) * 144 + 32 * s + 16 * hh);
            acc0 = MFMA32(af, b0, acc0); acc1 = MFMA32(af, b1, acc1); }
#pragma unroll
        for (int g = 0; g < 4; ++g) { const f32x4 dl = *(const LAS f32x4*)(decl + db * 32 + 8 * g + 4 * hh);
#pragma unroll
            for (int ii = 0; ii < 4; ++ii) { run0[4 * g + ii] = dl[ii] * run0[4 * g + ii] + acc0[4 * g + ii]; run1[4 * g + ii] = dl[ii] * run1[4 * g + ii] + acc1[4 * g + ii]; } }
#pragma unroll
        for (int j = 0; j < 2; ++j) { bf16* dst = KVS + ((size_t)item * 128 + (eb0 + j) * 32 + r) * 128 + db * 32;
#pragma unroll
            for (int gp = 0; gp < 2; ++gp) { unsigned pk[2][2];
#pragma unroll
                for (int q = 0; q < 2; ++q) { const int g = 2 * gp + q; const float a0 = j ? acc1[4 * g + 0] : acc0[4 * g + 0], a1 = j ? acc1[4 * g + 1] : acc0[4 * g + 1], a2 = j ? acc1[4 * g + 2] : acc0[4 * g + 2], a3 = j ? acc1[4 * g + 3] : acc0[4 * g + 3];
                    pk[q][0] = pkbf(a0, a1); pk[q][1] = pkbf(a2, a3); }
                const auto s0 = __builtin_amdgcn_permlane32_swap(pk[0][0], pk[1][0], false, false), s1 = __builtin_amdgcn_permlane32_swap(pk[0][1], pk[1][1], false, false);
                const v4u w4 = {s0[0], s1[0], s0[1], s1[1]};
                *(GAS v4u*)(dst + 8 * (2 * gp + hh)) = w4; } }
        __syncthreads();
      }
#pragma unroll
        for (int j = 0; j < 2; ++j) { float* dst = SSEG + ((size_t)wg * 128 + (eb0 + j) * 32 + r) * 128 + db * 32 + 4 * hh;
#pragma unroll
            for (int g = 0; g < 4; ++g) *(GAS f32x4*)(dst + 8 * g) = j ? (f32x4){run1[4 * g + 0], run1[4 * g + 1], run1[4 * g + 2], run1[4 * g + 3]} : (f32x4){run0[4 * g + 0], run0[4 * g + 1], run0[4 * g + 2], run0[4 * g + 3]}; }
        if (tq == 0) DSEG[(size_t)wg * 128 + d] = totrun;
    }
}
constexpr int HG_DECS = HG_END;
static_assert(HG_DECS + 4096 + 64 * 272 <= LDSCTL_OFF && HG_KST + 64 * 272 <= HG_ST && 64 * 272 <= MAXSLOT * 1536, "HGRN2 LDS map (decays, raw tiles)");
__device__ __forceinline__ void hgC_phase(Frame& F) {
    const int d = F.tid & 127, tq = F.tid >> 7, r = F.lane & 31, hh = F.lane >> 5;
    const bf16* P = (const bf16*)(F.ws + WS_P); const bf16* KVS = (const bf16*)(F.ws + WS_KVS); bf16* MIX = (bf16*)(F.ws + WS_MIX); const float* DEC = (const float*)(F.ws + WS_DEC);
    HG_HV();
    LAS unsigned char* L = F.lds + RING_OFF; const LAS float* decs = (const LAS float*)(L + HG_DECS);
    const int srow = (F.tid >> 6) * 16 + ((F.tid & 63) >> 4), sd0 = 8 * (F.tid & 15);
    v4u rf[2], rq[2], rv[2], st[4];
    LAS unsigned char* const RAWF = L + HG_KST; LAS unsigned char* const RAWQ = F.lds + ROWTAB_OFF; LAS unsigned char* const RAWV = L + HG_DECS + 4096;
    const __amdgpu_buffer_rsrc_t rsrcG = __builtin_amdgcn_make_buffer_rsrc((void*)F.hg_out_g, 0, 512 * 4, 0x00020000), rsrcSS = __builtin_amdgcn_make_buffer_rsrc((void*)(F.ws + WS_SSEG), 0, 256 * 128 * 128 * 4, 0x00020000), rsrcDS = __builtin_amdgcn_make_buffer_rsrc((void*)(F.ws + WS_DSEG), 0, 256 * 128 * 4, 0x00020000);
    const __amdgpu_buffer_rsrc_t rsrcD = __builtin_amdgcn_make_buffer_rsrc((void*)DEC, 0, 64 * 32 * 128 * 4, 0x00020000), rsrcM = __builtin_amdgcn_make_buffer_rsrc((void*)MIX, 0, (int)((size_t)T * D * 2), 0x00020000);
    const __amdgpu_buffer_rsrc_t rsrcK = __builtin_amdgcn_make_buffer_rsrc((void*)KVS, 0, 64 * 32 * 128 * 128 * 2, 0x00020000); const unsigned kvo = (unsigned)((srow * 128 + sd0) * 2);
#define HG_LOADKV(dst_, item_) do { const unsigned so_ = (unsigned)__builtin_amdgcn_readfirstlane((int)((item_) * (128 * 128 * 2))); _Pragma("unroll") for (int j_ = 0; j_ < 4; ++j_) (dst_)[j_] = __builtin_bit_cast(v4u, __builtin_amdgcn_raw_buffer_load_b128(rsrcK, kvo + 1024u * j_, so_, 0)); } while (0)
#define HG_LOADST(item_) HG_LOADKV(st, item_)
#define HG_FOLD(kv_, c_) do { const f32x4 d0_ = *(const LAS f32x4*)(decs + (c_) * 128 + sd0), d1_ = *(const LAS f32x4*)(decs + (c_) * 128 + sd0 + 4); _Pragma("unroll") for (int j_ = 0; j_ < 4; ++j_) { const v4u k_ = (kv_)[j_]; \
        S[8 * j_ + 0] = d0_.x * S[8 * j_ + 0] + bflo(k_.x); S[8 * j_ + 1] = d0_.y * S[8 * j_ + 1] + bfhi(k_.x); S[8 * j_ + 2] = d0_.z * S[8 * j_ + 2] + bflo(k_.y); S[8 * j_ + 3] = d0_.w * S[8 * j_ + 3] + bfhi(k_.y); \
        S[8 * j_ + 4] = d1_.x * S[8 * j_ + 4] + bflo(k_.z); S[8 * j_ + 5] = d1_.y * S[8 * j_ + 5] + bfhi(k_.z); S[8 * j_ + 6] = d1_.z * S[8 * j_ + 6] + bflo(k_.w); S[8 * j_ + 7] = d1_.w * S[8 * j_ + 7] + bfhi(k_.w); } } while (0)
    for (int wg = blockIdx.x; wg < 256; wg += F.G) {
        const int bh = wg >> 2, seg = wg & 3, item0 = bh * 32 + seg * 8, b = bh >> 2, h = bh & 3;
        HG_LOADT(rf, item0, 1); HG_LOADT(rq, item0, 0); HG_LOADT(rv, item0, 2); HG_LOADST(item0);
        const unsigned dso0 = (unsigned)__builtin_amdgcn_readfirstlane((bh * 32 + seg * 8) * 128 * 4);
        const f32x4 decv = __builtin_bit_cast(f32x4, __builtin_amdgcn_raw_buffer_load_b128(rsrcD, (unsigned)(F.tid & 255) * 16u, dso0, 0));
        const float lbv = hg_lbound(F, h, d);
        __builtin_amdgcn_sched_barrier(0);
        float S[32];
#pragma unroll
        for (int j = 0; j < 32; ++j) S[j] = 0.f;
        for (int sp = 0; sp < seg; ++sp) {
            const unsigned sso = (unsigned)__builtin_amdgcn_readfirstlane((bh * 4 + sp) * 128 * 128 * 4), dso = (unsigned)__builtin_amdgcn_readfirstlane((bh * 4 + sp) * 128 * 4);
#pragma unroll
            for (int j0 = 0; j0 < 8; j0 += 8) { f32x4 sv[8], dv[8];
#pragma unroll
                for (int j = 0; j < 8; ++j) { sv[j] = __builtin_bit_cast(f32x4, __builtin_amdgcn_raw_buffer_load_b128(rsrcSS, (unsigned)((srow * 128 + sd0) * 4) + 2048u * ((j0 + j) >> 1) + 16u * ((j0 + j) & 1), sso, 0));
                    dv[j] = __builtin_bit_cast(f32x4, __builtin_amdgcn_raw_buffer_load_b128(rsrcDS, (unsigned)(sd0 * 4) + 16u * ((j0 + j) & 1), dso, 0)); }
#pragma unroll
                for (int j = 0; j < 8; ++j) { const int q = 4 * (j0 + j); S[q + 0] = dv[j].x * S[q + 0] + sv[j].x; S[q + 1] = dv[j].y * S[q + 1] + sv[j].y; S[q + 2] = dv[j].z * S[q + 2] + sv[j].z; S[q + 3] = dv[j].w * S[q + 3] + sv[j].w; } }
        }
        if (F.tid < 256) *((LAS f32x4*)(L + HG_DECS) + F.tid) = decv;
        __syncthreads();
      for (int k = 0; k < 8; ++k) {
        const int item = item0 + k, c = seg * 8 + k;
        const int tb = F.wave & 1, eb = F.wave >> 1;
        const int nit = k < 7 ? item + 1 : item;
        HG_PUT(rf, RAWF); HG_PUT(rq, RAWQ); HG_PUT(rv, RAWV);
        __syncthreads();
        HG_LOADT(rf, nit, 1); HG_LOADT(rq, nit, 0); HG_LOADT(rv, nit, 2); __builtin_amdgcn_sched_barrier(0);
        unsigned short ffr[16], qr[16], vr[16]; HG_COL(ffr, RAWF); HG_COL(qr, RAWQ); HG_COL(vr, RAWV);
        float bb[16], kk[16], total; hg_gates(F, ffr, lbv, d, tq, bb, kk, total);
        float vv[16];
#pragma unroll
        for (int i = 0; i < 16; ++i) { const int t = 16 * tq + i; const float q = bf2f(qr[i]);
            *(LAS unsigned short*)(L + HG_QE + t * 272 + 2 * d) = (unsigned short)pkbf(q * bb[i], 0.f);
            *(LAS unsigned short*)(L + HG_KE + t * 272 + 2 * d) = (unsigned short)pkbf(kk[i] * __builtin_amdgcn_rcpf(bb[i]), 0.f);
            vv[i] = bf2f(vr[i]); }
        st16<true>(L + HG_VT + d * 144 + tq * 32, vv);
#pragma unroll
        for (int j = 0; j < 4; ++j) { v4u w4; w4.x = pkbf(S[8 * j + 0], S[8 * j + 1]); w4.y = pkbf(S[8 * j + 2], S[8 * j + 3]); w4.z = pkbf(S[8 * j + 4], S[8 * j + 5]); w4.w = pkbf(S[8 * j + 6], S[8 * j + 7]);
            *(LAS v4u*)(L + HG_ST + (srow + 4 * j) * 272 + sd0 * 2) = w4; }
        HG_FOLD(st, k);
        v4u grw[2];
        { const bf16* grow_ = PHp + (((size_t)(3 * 16 + b) * 4 + h) * SEQ + c * 64 + tb * 32 + r) * 128;
#pragma unroll
            for (int gp = 0; gp < 2; ++gp) grw[gp] = *(const GAS v4u*)(grow_ + eb * 32 + 8 * (2 * gp + hh)); }
        HG_LOADST(nit); __builtin_amdgcn_sched_barrier(0);
        __syncthreads();
        f32x16 acc;
#pragma unroll
        for (int i = 0; i < 16; ++i) acc[i] = 0.f;
#define HG_QF(s_) (*(const LAS bf16x8*)(L + HG_QE + (tb * 32 + r) * 272 + 32 * (s_) + 16 * hh))
#pragma unroll
        for (int s = 0; s < 8; ++s) acc = MFMA32(*(const LAS bf16x8*)(L + HG_ST + (eb * 32 + r) * 272 + 32 * s + 16 * hh), HG_QF(s), acc);
        for (int sb = 0; sb <= tb; ++sb) {
            f32x16 at;
#pragma unroll
            for (int i = 0; i < 16; ++i) at[i] = 0.f;
#pragma unroll
            for (int s = 0; s < 8; ++s) at = MFMA32(*(const LAS bf16x8*)(L + HG_KE + (sb * 32 + r) * 272 + 32 * s + 16 * hh), HG_QF(s), at);
            float a[16];
#pragma unroll
            for (int i = 0; i < 16; ++i) a[i] = (sb < tb || crow16(i, hh) <= r) ? at[i] : 0.f;
            const bf16x8 ab0 = pack8(a[0], a[1], a[2], a[3], a[4], a[5], a[6], a[7]), ab1 = pack8(a[8], a[9], a[10], a[11], a[12], a[13], a[14], a[15]);
            acc = MFMA32(*(const LAS bf16x8*)(L + HG_VT + (eb * 32 + r) * 144 + sb * 64 + 0 + 16 * hh), ab0, acc);
            acc = MFMA32(*(const LAS bf16x8*)(L + HG_VT + (eb * 32 + r) * 144 + sb * 64 + 32 + 16 * hh), ab1, acc);
        }
        float ss = 0.f;
#pragma unroll
        for (int i = 0; i < 16; ++i) ss += acc[i] * acc[i];
        ss += __shfl_xor(ss, 32);
        LAS float* ssq = (LAS float*)(L + HG_SSQ);
        if (hh == 0) ssq[eb * 64 + tb * 32 + r] = ss;
        f32x4 ggv[4];
        { const unsigned so = (unsigned)__builtin_amdgcn_readfirstlane(h * 512);
#pragma unroll
            for (int g = 0; g < 4; ++g) ggv[g] = __builtin_bit_cast(f32x4, __builtin_amdgcn_raw_buffer_load_b128(rsrcG, (unsigned)((eb * 32 + 8 * g + 4 * hh) * 4), so, 0)); }
        __syncthreads();
        const int tl = tb * 32 + r; const float tot = (ssq[tl] + ssq[64 + tl]) + (ssq[128 + tl] + ssq[192 + tl]);
        const float rs = 1.f / sqrtf(tot * (1.f / 128.f) + EPS);
        const unsigned mso = (unsigned)__builtin_amdgcn_readfirstlane((int)((((unsigned)b * SEQ + c * 64) * D + 512 + h * 128) * 2)), mvo = (unsigned)((tl * D + eb * 32) * 2);
        unsigned long long grv[4];
#pragma unroll
        for (int gp = 0; gp < 2; ++gp) { const auto sa = __builtin_amdgcn_permlane32_swap(grw[gp].x, grw[gp].z, false, false), sb = __builtin_amdgcn_permlane32_swap(grw[gp].y, grw[gp].w, false, false);
            grv[2 * gp] = (unsigned long long)sa[0] | ((unsigned long long)sb[0] << 32); grv[2 * gp + 1] = (unsigned long long)sa[1] | ((unsigned long long)sb[1] << 32); }
        unsigned yp[4][2];
#pragma unroll
        for (int g = 0; g < 4; ++g) { const unsigned long long gr = grv[g]; const f32x4 gg = ggv[g];
            const float g0 = bflo((unsigned)gr), g1 = bfhi((unsigned)gr), g2 = bflo((unsigned)(gr >> 32)), g3 = bfhi((unsigned)(gr >> 32));
            const float y0 = acc[4 * g + 0] * rs * gg.x * (g0 * __builtin_amdgcn_rcpf(1.f + __expf(-g0))), y1 = acc[4 * g + 1] * rs * gg.y * (g1 * __builtin_amdgcn_rcpf(1.f + __expf(-g1)));
            const float y2 = acc[4 * g + 2] * rs * gg.z * (g2 * __builtin_amdgcn_rcpf(1.f + __expf(-g2))), y3 = acc[4 * g + 3] * rs * gg.w * (g3 * __builtin_amdgcn_rcpf(1.f + __expf(-g3)));
            yp[g][0] = pkbf(y0, y1); yp[g][1] = pkbf(y2, y3); }
#pragma unroll
        for (int gp = 0; gp < 2; ++gp) { const auto s0 = __builtin_amdgcn_permlane32_swap(yp[2 * gp][0], yp[2 * gp + 1][0], false, false), s1 = __builtin_amdgcn_permlane32_swap(yp[2 * gp][1], yp[2 * gp + 1][1], false, false);
            __builtin_amdgcn_raw_buffer_store_b128((v4u){s0[0], s1[0], s0[1], s1[1]}, rsrcM, mvo + 16u * (2 * gp + hh), mso, 0); }
        __syncthreads();
      }
    }
#undef HG_LOADST
#undef HG_LOADKV
#undef HG_FOLD
#undef HG_QF
}
#undef HG_LOADT
#undef HG_PUT
#undef HG_COL
#undef HG_ARR
#undef HG_SOFF
#undef HG_HV

__device__ __forceinline__ void router_phase(Frame& F) {
    LAS unsigned char* L = F.lds; const int r = F.lane & 31, hh = F.lane >> 5;
    LAS unsigned* lcnt = (LAS unsigned*)(F.lds + LTAB_OFF) + LT_MISC; LAS unsigned* lbase = lcnt + 32; LAS float* lrstd = (LAS float*)(F.lds + ROWTAB_OFF);
    float* TOPG = (float*)(F.ws + WS_TOPG);
    {
        const GAS v4u* img = (const GAS v4u*)(F.ws + WS_RT) + vzero();
        constexpr int NB = (RT_END / 16 + NWAVES * 64 - 1) / (NWAVES * 64);
        v4u t4[NB];
#pragma unroll
        for (int j = 0; j < NB; ++j) { const int q = F.tid + j * NWAVES * 64; t4[j] = img[q < RT_END / 16 ? q : 0]; }
#pragma unroll
        for (int j = 0; j < NB; ++j) { const int q = F.tid + j * NWAVES * 64; if (q < RT_END / 16) *(LAS v4u*)(L + 16 * q) = t4[j]; }
    }
    const bf16* XH = (const bf16*)(F.ws + WS_XN); int* LIST = (int*)(F.ws + WS_LIST); unsigned* cnt = (unsigned*)(F.ctl + CW_CNT);
    for (int base = blockIdx.x * 4; base < T / 32; base += F.G * 4) {
        const int grp = base + F.wave; const bool active = F.wave < 4 && grp < T / 32;
        if (F.tid < 32) lcnt[F.tid] = 0u;
        __syncthreads();
        float sv[4] = {0.f, 0.f, 0.f, 0.f}; int se[4] = {0, 0, 0, 0}; unsigned lp0 = 0u, lp1 = 0u; float rstd = 0.f; const int tok = grp * 32 + r;
        if (active) {
            const bf16* hrow = XH + (size_t)tok * D + 8 * hh;
            f32x16 acc;
#pragma unroll
            for (int i = 0; i < 16; ++i) acc[i] = 0.f;
            float ssq = 0.f;
#pragma unroll 16
            for (int s = 0; s < 64; ++s) {
                const v4u hu = *(const GAS v4u*)(hrow + 16 * s); const bf16x8 hi = __builtin_bit_cast(bf16x8, hu);
                { const float a0 = bflo(hu.x), a1 = bfhi(hu.x), a2 = bflo(hu.y), a3 = bfhi(hu.y), a4 = bflo(hu.z), a5 = bfhi(hu.z), a6 = bflo(hu.w), a7 = bfhi(hu.w);
                    ssq += (a0 * a0 + a1 * a1) + (a2 * a2 + a3 * a3) + (a4 * a4 + a5 * a5) + (a6 * a6 + a7 * a7); }
                const bf16x8 wh = *(const LAS bf16x8*)(L + r * RT_ROW + 32 * s + 16 * hh), wl = *(const LAS bf16x8*)(L + RT_WL + r * RT_ROW + 32 * s + 16 * hh);
                acc = MFMA32(wh, hi, acc); acc = MFMA32(wl, hi, acc);
            }
            ssq += __shfl_xor(ssq, 32);
            rstd = 1.f / sqrtf(ssq * (1.f / D) + EPS);
            float l[16];
#pragma unroll
            for (int i = 0; i < 16; ++i) l[i] = acc[i] * rstd + F.b_router[crow16(i, hh)];
            float cv[8]; int ce[8];
#pragma unroll
            for (int rnd = 0; rnd < 4; ++rnd) { float bv = l[0]; int bi = 0;
#pragma unroll
                for (int i = 1; i < 16; ++i) if (l[i] > bv) { bv = l[i]; bi = i; }
                cv[rnd] = bv; ce[rnd] = crow16(bi, hh);
#pragma unroll
                for (int i = 0; i < 16; ++i) if (i == bi) l[i] = -__builtin_inff(); }
#pragma unroll
            for (int j = 0; j < 4; ++j) { cv[4 + j] = __shfl_xor(cv[j], 32); ce[4 + j] = __shfl_xor(ce[j], 32); }
#pragma unroll
            for (int rnd = 0; rnd < 4; ++rnd) { float bv = cv[0]; int be = ce[0]; int bj = 0;
#pragma unroll
                for (int j = 1; j < 8; ++j) if (cv[j] > bv || (cv[j] == bv && ce[j] < be)) { bv = cv[j]; be = ce[j]; bj = j; }
                sv[rnd] = bv; se[rnd] = be;
#pragma unroll
                for (int j = 0; j < 8; ++j) if (j == bj) { cv[j] = -__builtin_inff(); ce[j] = 64; } }
            lp0 = __hip_atomic_fetch_add(lcnt + (hh ? se[2] : se[0]), 1u, __ATOMIC_RELAXED, __HIP_MEMORY_SCOPE_WORKGROUP);
            lp1 = __hip_atomic_fetch_add(lcnt + (hh ? se[3] : se[1]), 1u, __ATOMIC_RELAXED, __HIP_MEMORY_SCOPE_WORKGROUP);
        }
        __syncthreads();
        if (F.tid < 32) lbase[F.tid] = __hip_atomic_fetch_add(cnt + F.tid, lcnt[F.tid], __ATOMIC_RELAXED, __HIP_MEMORY_SCOPE_AGENT);
        __syncthreads();
        if (active) {
            const float e1 = __expf(sv[1] - sv[0]), e2 = __expf(sv[2] - sv[0]), e3 = __expf(sv[3] - sv[0]); const float inv = 1.f / (1.f + e1 + e2 + e3);
            const int ea = hh ? se[2] : se[0], eb = hh ? se[3] : se[1]; const float ga = (hh ? e2 : 1.f) * inv, gb = (hh ? e3 : e1) * inv;
            const size_t ia = (size_t)ea * 32768 + lbase[ea] + lp0, ib = (size_t)eb * 32768 + lbase[eb] + lp1;
            LIST[ia] = tok * 4 + 2 * hh; LIST[ib] = tok * 4 + 2 * hh + 1; TOPG[tok * 4 + 2 * hh] = ga; TOPG[tok * 4 + 2 * hh + 1] = gb;
            if (hh == 0) lrstd[F.wave * 32 + r] = rstd;
        }
        __syncthreads();
        {
            unsigned char* X8 = F.ws + WS_X8; const int t0 = base * 32;
#pragma unroll
            for (int q0 = 0; q0 < 16; q0 += 4) { v4u a[4][2];
#pragma unroll
                for (int q = 0; q < 4; ++q) { const int tt = t0 + F.wave * 16 + q0 + q; const GAS v4u* p = (const GAS v4u*)(XH + (size_t)(tt < T ? tt : 0) * D) + 2 * F.lane; a[q][0] = p[0]; a[q][1] = p[1]; }
#pragma unroll
                for (int q = 0; q < 4; ++q) { const int tl = F.wave * 16 + q0 + q, tt = t0 + tl; if (tt < T) { const float rs = lrstd[tl]; v4u o;
                    o.x = pg8::pk4_fp8(bflo(a[q][0].x) * rs, bfhi(a[q][0].x) * rs, bflo(a[q][0].y) * rs, bfhi(a[q][0].y) * rs); o.y = pg8::pk4_fp8(bflo(a[q][0].z) * rs, bfhi(a[q][0].z) * rs, bflo(a[q][0].w) * rs, bfhi(a[q][0].w) * rs);
                    o.z = pg8::pk4_fp8(bflo(a[q][1].x) * rs, bfhi(a[q][1].x) * rs, bflo(a[q][1].y) * rs, bfhi(a[q][1].y) * rs); o.w = pg8::pk4_fp8(bflo(a[q][1].z) * rs, bfhi(a[q][1].z) * rs, bflo(a[q][1].w) * rs, bfhi(a[q][1].w) * rs);
                    *((GAS v4u*)(X8 + (size_t)tt * D) + F.lane) = o; } } }
        }
        __syncthreads();
    }
}
__device__ __forceinline__ int build_moe_tables(Frame& F, int ntn, int mode) {
    LAS int* lt = (LAS int*)(F.lds + LTAB_OFF);
    if (F.wave == 0) {
        const int e = F.lane & 31; const int c = (int)__hip_atomic_load((unsigned*)(F.ctl + CW_CNT) + e, __ATOMIC_RELAXED, __HIP_MEMORY_SCOPE_AGENT);
        const int tl = (c + 255) >> 8; int inc = tl;
#pragma unroll
        for (int off = 1; off < 32; off <<= 1) { const int o = __shfl_up(inc, off, 32); if (e >= off) inc += o; }
        const int tot = __shfl(inc, 31, 32), t0 = inc - tl;
        if (F.lane < 32) { lt[LT_TS + e] = t0; lt[LT_CNT + e] = c; for (int i = 0; i < tl; ++i) lt[t0 + i] = e; }
        if (F.lane == 0) lt[LT_MISC + 64] = tot;
    }
    __syncthreads();
    int nt = lt[LT_MISC + 64]; nt = nt < 0 ? 0 : (nt > MAXTILES ? MAXTILES : nt); nt = __builtin_amdgcn_readfirstlane(nt);
    const int* LIST = (const int*)(F.ws + WS_LIST);
    const int nslot = mode == 1 ? MAXSLOT : (MAXTILES * 4 + 255) / 256;
    for (int q = F.tid; q < nslot * 256; q += NWAVES * 64) { const int i = q >> 8, rr = q & 255; const int Lu = i * F.G + F.vcu;
        int li = -1; float bias = 0.f;
        if (Lu < nt * ntn) { const int pm0 = Lu / ntn, pl = Lu - pm0 * ntn, pm = mode == 2 ? nt - 1 - pm0 : pm0, e = lt[pm], idx = (pm - lt[LT_TS + e]) * 256 + rr; if (idx < lt[LT_CNT + e]) li = LIST[(size_t)e * 32768 + idx];
            bias = mode == 1 ? F.b_gu[(size_t)e * 2048 + (rr >> 7) * 1024 + pl * 128 + (rr & 127)] : F.b_d[(size_t)e * 1024 + pl * 256 + rr]; }
        ((LAS float*)(F.lds + ROWTAB_OFF))[q] = bias;
        if (mode == 1) ((LAS unsigned short*)(F.lds + ROWTAB2_OFF))[q] = (unsigned short)(li < 0 ? 0 : (li >> 2));
        else ((LAS int*)(F.lds + ROWTAB_OFF) + nslot * 256)[q] = li; }
    __syncthreads();
    return nt;
}
__device__ __forceinline__ void combine_phase(Frame& F) {
    const unsigned char* YK = F.ws + WS_YK; const bf16* XH = (const bf16*)(F.ws + WS_XN); const float* TOPG = (const float*)(F.ws + WS_TOPG);
    for (int t = F.gw; t < T; t += F.ngw) {
        GAS f32x4* xr = (GAS f32x4*)(F.out + (size_t)t * D) + F.lane; f32x4 v[4]; unsigned y[4][4]; const f32x4 gt = *((const GAS f32x4*)TOPG + t + vzero()) * (1.0f / Y8_SCALE);
#pragma unroll
        for (int j = 0; j < 4; ++j) { const unsigned long long xh = __builtin_nontemporal_load((const GAS unsigned long long*)(XH + (size_t)t * D) + F.lane + 64 * j);
            v[j] = (f32x4){bflo((unsigned)xh), bfhi((unsigned)xh), bflo((unsigned)(xh >> 32)), bfhi((unsigned)(xh >> 32))};
#pragma unroll
            for (int k = 0; k < 4; ++k) y[j][k] = __builtin_nontemporal_load((const GAS unsigned*)(YK + ((size_t)t * 4 + k) * D) + F.lane + 64 * j); }
#pragma unroll
        for (int j = 0; j < 4; ++j) { f32x4 s4 = {0.f, 0.f, 0.f, 0.f};
#pragma unroll
            for (int k = 0; k < 4; ++k) { const f32x2n_ lo = __builtin_amdgcn_cvt_pk_f32_fp8((int)y[j][k], false), hi = __builtin_amdgcn_cvt_pk_f32_fp8((int)y[j][k], true); const float g = gt[k]; s4.x += g * lo.x; s4.y += g * lo.y; s4.z += g * hi.x; s4.w += g * hi.y; }
            v[j] = v[j] + s4;
            __builtin_nontemporal_store(v[j], xr + 64 * j); }
    }
}

constexpr int NPH = 9;
struct Args { const float* in[16]; float* out; unsigned char* ws; int ph_lo, ph_hi; };
__global__ void __launch_bounds__(NWAVES * 64, 2) fwd(Args args) {
    extern __shared__ __attribute__((aligned(16))) unsigned char lds[];
    Frame F;
    F.lds = (LAS unsigned char*)lds;
    F.MISC = (volatile LAS unsigned*)(F.lds + MISC_OFF);
    F.tid = threadIdx.x; F.lane = F.tid & 63; F.wave = __builtin_amdgcn_readfirstlane(F.tid >> 6);
    F.G = gridDim.x; { const int bx = blockIdx.x; F.vcu = (F.G % 8 == 0) ? (bx % 8) * (F.G / 8) + bx / 8 : bx; }
    F.gw = blockIdx.x * NWAVES + F.wave; F.ngw = F.G * NWAVES;
    F.ws = args.ws; F.ctl = (gu32*)(args.ws + WS_CTL); F.out = args.out;
    F.x = args.in[0]; F.norm1_g = args.in[1]; F.w_in = args.in[2]; F.sb_q_g = args.in[3]; F.sb_k_g = args.in[4]; F.sb_out_g = args.in[5]; F.hg_lb = args.in[6]; F.hg_out_g = args.in[7];
    F.w_out = args.in[8]; F.norm2_g = args.in[9]; F.w_router = args.in[10]; F.b_router = args.in[11]; F.w_gu = args.in[12]; F.b_gu = args.in[13]; F.w_d = args.in[14]; F.b_d = args.in[15];
    for (int u = F.tid; u < (LDS_BYTES - LDSCTL_OFF) / 4; u += NWAVES * 64) ((LAS unsigned*)(F.lds + LDSCTL_OFF))[u] = 0u;
    __syncthreads();
    XcdBarrier bar; bar.bar = (unsigned*)(F.ctl + CW_BAR); bar.x = 0; bar.st = nullptr;
    if (MK_ONE_LAUNCH) bar = xcd_barrier_post((unsigned*)(F.ctl + CW_BAR), F.MISC + 8);
    const int lo = args.ph_lo, hi = args.ph_hi;
#define IN(k) (lo <= (k) && (k) < hi && ((F.lane = lane_id()), (F.tid = F.wave * 64 + F.lane), true))
#define SEAM(k) do { if (IN(k) && IN((k) + 1)) xcd_barrier(bar); } while (0)

    if (IN(0)) { p0_prologue(F); } SEAM(0);
    if (IN(1)) {
        pg8::Gemm g{(const bf16*)(F.ws + WS_XN), (const bf16*)(F.ws + WS_WIN), T, NIN, D}; pg8::StaticOrder S; S.init(T, NIN, F.G, (int)blockIdx.x);
        pg8::EpiInproj E{(bf16*)(F.ws + WS_P), (bf16*)(F.ws + WS_PH), (bf16*)(F.ws + WS_QN), (bf16*)(F.ws + WS_KN), F.sb_q_g, F.sb_k_g, QSCALE, EPS};
        pg8::gemm_phase<pg8::EpiInproj, pg8::StaticOrder, PG8_ALIGN, PG8_SP2>(F.lds + RING_OFF, g, S, E, F.tid);
    } SEAM(1);
    if (IN(2)) { prep_phase(F); __syncthreads(); hgA_phase(F); } SEAM(2);
    if (IN(3)) { attn_phase(F); hgC_phase(F); } SEAM(3);
    if (IN(4)) {
        pg8::Gemm g{(const bf16*)(F.ws + WS_MIX), (const bf16*)(F.ws + WS_WOUT), T, D, D}; pg8::StaticOrder S; S.init(T, D, F.G, (int)blockIdx.x);
        pg8::EpiRes E{F.x, (bf16*)(F.ws + WS_XN), D};
        pg8::gemm_phase<pg8::EpiRes, pg8::StaticOrder, PG8_ALIGN, PG8_SP2>(F.lds + RING_OFF, g, S, E, F.tid);
    } SEAM(4);
    if (IN(5)) { router_phase(F); } SEAM(5);
    if (IN(6)) {
        const int nt = build_moe_tables(F, 8, 1); const LAS int* lt = (const LAS int*)(F.lds + LTAB_OFF);
        pg8::Gemm g{(const bf16*)(F.ws + WS_X8), (const bf16*)(F.ws + WS_WGU), MAXROWS, NE * 2048, D / 2};
        pg8::MoeOrder S{lt, (const LAS unsigned short*)(F.lds + ROWTAB2_OFF), 8, nt * 8, F.G, F.vcu, 1024u, 0};
        pg8::EpiAct<true> E{F.ws + WS_ACT, (const LAS float*)(F.lds + ROWTAB_OFF), A8_SCALE};
        pg8::gemm_phase<pg8::EpiAct<true>, pg8::MoeOrder, PG8_ALIGN, PG8_SP2, true, SC_W8, SC_ONE>(F.lds + RING_OFF, g, S, E, F.tid);
        {
            const int rem = (nt * 8) % F.G, nidle = F.G - rem; const bool few = rem == 0 || nidle < F.G / 4;
            __syncthreads();
            if (few) p0_items(F, P0_NITEMS - P0_NLATE, P0_NITEMS, F.vcu * NWAVES + F.wave, F.G * NWAVES);
            else if (F.vcu >= rem) p0_items(F, P0_NITEMS - P0_NLATE, P0_NITEMS, (F.vcu - rem) * NWAVES + F.wave, nidle * NWAVES);
        }
    } SEAM(6);
    if (IN(7)) {
        const int nt = build_moe_tables(F, 4, 2); const LAS int* lt = (const LAS int*)(F.lds + LTAB_OFF);
        pg8::Gemm g{(const bf16*)(F.ws + WS_ACT), (const bf16*)(F.ws + WS_WD), MAXROWS, NE * 1024, D / 2};
        pg8::MoeOrder S{lt, nullptr, 4, nt * 4, F.G, F.vcu, 1024u, nt};
        pg8::EpiDown E{F.ws + WS_YK, (const LAS int*)(F.lds + ROWTAB_OFF) + ((MAXTILES * 4 + 255) / 256) * 256, (const LAS float*)(F.lds + ROWTAB_OFF), Y8_SCALE};
        pg8::gemm_phase<pg8::EpiDown, pg8::MoeOrder, PG8_ALIGN, PG8_SP2, true, SC_W8Y, SC_A8>(F.lds + RING_OFF, g, S, E, F.tid);
    } SEAM(7);
    if (IN(8)) { combine_phase(F); }
#undef IN
#undef SEAM
}

extern "C" void kernel_launch(void* const* d_in, const int* in_sizes, int n_in, void* d_out, int out_size, void* d_ws, size_t ws_size, hipStream_t stream) {
    static int grid = 0;
    if (grid == 0) {
        if (n_in != 16 || in_sizes[0] != T * D || out_size != T * D || ws_size < WS_END) { fprintf(stderr, "kernel_launch: shape/workspace mismatch (n_in %d, ws %zu, need %zu); nothing launched\n", n_in, ws_size, (size_t)WS_END); grid = -1; return; }
        int dev = 0, cus = 0, per_cu = 0;
        if (hipGetDevice(&dev) != hipSuccess || hipDeviceGetAttribute(&cus, hipDeviceAttributeMultiprocessorCount, dev) != hipSuccess) { grid = -1; return; }
        if (hipFuncSetAttribute((const void*)fwd, hipFuncAttributeMaxDynamicSharedMemorySize, LDS_BYTES) != hipSuccess) { grid = -1; return; }
        if (hipOccupancyMaxActiveBlocksPerMultiprocessor(&per_cu, (const void*)fwd, NWAVES * 64, LDS_BYTES) != hipSuccess || per_cu < 1) { fprintf(stderr, "kernel_launch: occupancy query says %d\n", per_cu); }
        (void)hipGetLastError();
        if ((MAXTILES * 8 + cus - 1) / cus > MAXSLOT || cus < 1) { fprintf(stderr, "kernel_launch: %d CUs: the per-workgroup unit tables are sized for 256\n", cus); grid = -1; return; }
        grid = cus;
    }
    if (grid < 0) return;
    if (hipMemsetAsync((char*)d_ws + WS_CTL, 0, CTL_ZERO_BYTES, stream) != hipSuccess) return;
    Args a{};
    for (int i = 0; i < 16; ++i) a.in[i] = (const float*)d_in[i];
    a.out = (float*)d_out; a.ws = (unsigned char*)d_ws;
#if MK_ONE_LAUNCH
    a.ph_lo = 0; a.ph_hi = NPH;
    hipLaunchKernelGGL(fwd, dim3(grid), dim3(NWAVES * 64), LDS_BYTES, stream, a);
#else
    for (int p = 0; p < NPH; ++p) { a.ph_lo = p; a.ph_hi = p + 1; hipLaunchKernelGGL(fwd, dim3(grid), dim3(NWAVES * 64), LDS_BYTES, stream, a); }
#endif
}
```

```cpp
#include <hip/hip_runtime.h>
#include <cstdio>
#include <cstdint>
namespace pg8 {
#define PG8_LAS __attribute__((address_space(3)))
typedef unsigned short bf16_t;
typedef short bf16x8 __attribute__((ext_vector_type(8)));
typedef float f32x4 __attribute__((ext_vector_type(4)));
typedef unsigned u32x4 __attribute__((ext_vector_type(4)));
typedef int i32x4_t __attribute__((ext_vector_type(4)));
typedef int i32x8_t __attribute__((ext_vector_type(8)));
constexpr int BM = 256, BK = 64, HALF = 128, HTB = HALF * BK * 2  , STAGE_BYTES = 8 * HTB, NXCD = 8, WGM = 8;

__host__ __device__ __forceinline__ int lds_byte(int r, int c) { const int st = (r >> 4) * 2 + (c >> 5), rr = r & 15, cc = c & 31, ob = rr * 64 + cc * 2; return st * 1024 + (ob ^ (((ob >> 9) & 1) << 5)); }
__host__ __device__ __forceinline__ void stage_rc(int b, int& R, int& C) { const int st = b / 1024, sb = b % 1024, swz = sb ^ (((sb >> 9) & 1) << 5); R = (st >> 1) * 16 + swz / 64; C = (st & 1) * 32 + (swz % 64) / 2; }
__host__ __device__ __forceinline__ int perm32(int rho) { const int n = rho >> 4, i = rho & 15; return 8 * (i >> 2) + 4 * n + (i & 3); }

struct Unit { int pm, pn, slot; };
struct Gemm { const bf16_t* A; const bf16_t* Bt; int M, N, K; };

struct StaticOrder {
    int nM, nN, nwg, G, c;
    __host__ __device__ void init(int M, int N, int G_, int c_) { nM = M / BM; nN = N / BM; nwg = nM * nN; G = G_; c = c_; }
    __host__ __device__ bool next(int i, Unit& u) const {
        const long L = (long)i * G + c; if (L >= nwg) return false;
        int wgid = (int)L; { const int q = nwg / NXCD, r = nwg % NXCD, xcd = wgid % NXCD, off = wgid / NXCD; wgid = (xcd < r ? xcd * (q + 1) : r * (q + 1) + (xcd - r) * q) + off; }
        const int nig = WGM * nN, gid = wgid / nig, fm = gid * WGM, gsz = (nM - fm) < WGM ? (nM - fm) : WGM;
        u.pm = fm + ((wgid % nig) % gsz); u.pn = (wgid % nig) / gsz; return true;
    }
    __device__ __forceinline__ void a_ready(const Unit&) const {}
    __device__ __forceinline__ void done(const Unit&) const {}
};

__device__ __forceinline__ unsigned cvt_pk_bf16(float lo, float hi) { unsigned r; asm volatile("v_cvt_pk_bf16_f32 %0, %1, %2" : "=v"(r) : "v"(lo), "v"(hi)); return r; }
typedef float f32x2 __attribute__((ext_vector_type(2)));
__device__ __forceinline__ f32x2 gelu_pk(f32x2 v) {
    const f32x2 av = __builtin_elementwise_abs(v), d = av * 0.2316418882f + 1.0f;
    f32x2 t; t.x = __builtin_amdgcn_rcpf(d.x); t.y = __builtin_amdgcn_rcpf(d.y);
    f32x2 q = t * 0.5307027145f + (-0.7265760135f); q = q * t + 0.7107068705f; q = q * t + (-0.142248368f); q = q * t + 0.127414796f; q = q * t;
    const f32x2 s = (v * v) * (-0.72134752044f);
    f32x2 e; e.x = __builtin_amdgcn_exp2f(s.x); e.y = __builtin_amdgcn_exp2f(s.y);
    const f32x2 m = v * (q * e), r = v - m;
    f32x2 o; o.x = v.x < 0.f ? m.x : r.x; o.y = v.y < 0.f ? m.y : r.y; return o;
}

template <int ACT  > struct EpiBf16 {
    static constexpr bool PERM = true, AFTER_DRAIN = false, HAS_INIT = false, INIT_LOADS = false; static_assert(ACT == 0 || ACT == 1, "EpiBf16: ACT is 0 (none) or 1 (gelu_pk)");
    bf16_t* O; int ldc; const float* bias; int split_cols; size_t split_stride; float scale0;
    __device__ __forceinline__ void operator()(const f32x4 (&acc)[2][2][4][2], const Unit& u, int wr, int wc, int fr, int fq) const {
        const int row0 = u.pm * BM + wr * 64 + fr; int colt = u.pn * BM; bf16_t* base = O;
        float sc = 1.f; if (split_cols) { const int t = colt / split_cols; base += (size_t)t * split_stride; colt -= t * split_cols; if (t == 0) sc = scale0; }
        const int col0 = colt + wc * 32 + 8 * fq, bcol0 = u.pn * BM + wc * 32 + 8 * fq;
        f32x4 bv[2][2];
#pragma unroll
        for (int bj = 0; bj < 2; ++bj)
#pragma unroll
            for (int n = 0; n < 2; ++n) bv[bj][n] = bias ? *(const f32x4*)(bias + bcol0 + bj * HALF + 4 * n) : (f32x4){0.f, 0.f, 0.f, 0.f};
#pragma unroll
        for (int ai = 0; ai < 2; ++ai)
#pragma unroll
            for (int m = 0; m < 4; ++m) { bf16_t* rowp = base + (size_t)(row0 + ai * HALF + m * 16) * ldc + col0;
#pragma unroll
                for (int bj = 0; bj < 2; ++bj) { f32x4 v0 = acc[ai][bj][m][0] + bv[bj][0], v1 = acc[ai][bj][m][1] + bv[bj][1];
                    if (ACT == 1) { f32x2 a = gelu_pk((f32x2){v0[0], v0[1]}), b = gelu_pk((f32x2){v0[2], v0[3]}), c = gelu_pk((f32x2){v1[0], v1[1]}), d = gelu_pk((f32x2){v1[2], v1[3]});
                        v0 = (f32x4){a.x, a.y, b.x, b.y}; v1 = (f32x4){c.x, c.y, d.x, d.y}; }
                    v0 = v0 * sc; v1 = v1 * sc; u32x4 w; w.x = cvt_pk_bf16(v0[0], v0[1]); w.y = cvt_pk_bf16(v0[2], v0[3]); w.z = cvt_pk_bf16(v1[0], v1[1]); w.w = cvt_pk_bf16(v1[2], v1[3]);
                    *(u32x4*)(rowp + bj * HALF) = w; } }
    }
};

__device__ __forceinline__ unsigned pk4_fp8(float a, float b, float c, float d) {
    a = fminf(fmaxf(a, -448.f), 448.f); b = fminf(fmaxf(b, -448.f), 448.f); c = fminf(fmaxf(c, -448.f), 448.f); d = fminf(fmaxf(d, -448.f), 448.f);
    int p = 0; p = __builtin_amdgcn_cvt_pk_fp8_f32(a, b, p, false); p = __builtin_amdgcn_cvt_pk_fp8_f32(c, d, p, true); return (unsigned)p;
}
struct EpiRes {
    static constexpr bool PERM = true, AFTER_DRAIN = false, HAS_INIT = true, INIT_LOADS = true;
    const float* __restrict__ X; bf16_t* __restrict__ XH; int ldc;
    __device__ __forceinline__ void init(f32x4 (&acc)[2][2][4][2], const Unit& u, int wr, int wc, int fr, int fq) const {
        const int row0 = u.pm * BM + wr * 64 + fr, col0 = u.pn * BM + wc * 64 + 8 * fq;
#pragma unroll
        for (int ai = 0; ai < 2; ++ai)
#pragma unroll
            for (int m = 0; m < 4; ++m) { const float* rp = X + (size_t)(row0 + ai * HALF + m * 16) * ldc + col0;
#pragma unroll
                for (int bj = 0; bj < 2; ++bj)
#pragma unroll
                    for (int n = 0; n < 2; ++n) acc[ai][bj][m][n] = __builtin_nontemporal_load((const f32x4*)(rp + bj * 32 + n * 4)); }
    }
    __device__ __forceinline__ void operator()(const f32x4 (&acc)[2][2][4][2], const Unit& u, int wr, int wc, int fr, int fq) const {
        const bool odd = fr & 1; const int rowE0 = u.pm * BM + wr * 64 + (fr & ~1), col0 = u.pn * BM + wc * 64 + 8 * fq + (odd ? 32 : 0);
#pragma unroll
        for (int ai = 0; ai < 2; ++ai)
#pragma unroll
            for (int m = 0; m < 4; ++m) { bf16_t* rp = XH + (size_t)(rowE0 + ai * HALF + m * 16) * ldc + col0; u32x4 w[2];
#pragma unroll
                for (int bj = 0; bj < 2; ++bj) { const f32x4 v0 = acc[ai][bj][m][0], v1 = acc[ai][bj][m][1];
                    w[bj].x = cvt_pk_bf16(v0[0], v0[1]); w[bj].y = cvt_pk_bf16(v0[2], v0[3]); w[bj].z = cvt_pk_bf16(v1[0], v1[1]); w[bj].w = cvt_pk_bf16(v1[2], v1[3]); }
                const u32x4 snd = odd ? w[0] : w[1]; u32x4 rcv;
                rcv.x = (unsigned)__builtin_amdgcn_mov_dpp((int)snd.x, 0xB1, 0xF, 0xF, true); rcv.y = (unsigned)__builtin_amdgcn_mov_dpp((int)snd.y, 0xB1, 0xF, 0xF, true);
                rcv.z = (unsigned)__builtin_amdgcn_mov_dpp((int)snd.z, 0xB1, 0xF, 0xF, true); rcv.w = (unsigned)__builtin_amdgcn_mov_dpp((int)snd.w, 0xB1, 0xF, 0xF, true);
                *(u32x4*)rp = odd ? rcv : w[0];
                *(u32x4*)(rp + ldc) = odd ? w[1] : rcv; }
    }
};
struct EpiInproj {
    static constexpr bool PERM = true, AFTER_DRAIN = false, HAS_INIT = false, INIT_LOADS = false;
    bf16_t* PA; bf16_t* PH; bf16_t* QN; bf16_t* KN; const float* gq; const float* gk; float qscale, eps;
    __device__ __forceinline__ void operator()(const f32x4 (&acc)[2][2][4][2], const Unit& u, int wr, int wc, int fr, int fq) const {
        if (u.pn < 4) {
            const int arr = u.pn >> 1, hd = (u.pn & 1) * 4 + wc; const float* g = arr ? gk : gq; const float gs = arr ? 1.f : qscale; bf16_t* dst = arr ? KN : QN;
            f32x4 gv[2][2];
#pragma unroll
            for (int bj = 0; bj < 2; ++bj)
#pragma unroll
                for (int n = 0; n < 2; ++n) gv[bj][n] = *(const f32x4*)(g + 32 * bj + 8 * fq + 4 * n) * gs;
#pragma unroll
            for (int ai = 0; ai < 2; ++ai)
#pragma unroll
                for (int m = 0; m < 4; ++m) { float ss = 0.f;
#pragma unroll
                    for (int bj = 0; bj < 2; ++bj)
#pragma unroll
                        for (int n = 0; n < 2; ++n) { const f32x4 a = acc[ai][bj][m][n]; ss += (a[0] * a[0] + a[1] * a[1]) + (a[2] * a[2] + a[3] * a[3]); }
                    ss += __shfl_xor(ss, 16); ss += __shfl_xor(ss, 32);
                    const float rs = 1.f / sqrtf(ss * (1.f / 64.f) + eps);
                    const int row = u.pm * BM + ai * HALF + wr * 64 + m * 16 + fr, b = row >> 11, s = row & 2047;
                    bf16_t* rp = dst + ((size_t)((b * 8 + hd) * 64 + (s >> 5))) * 2048 + (s & 31) * 8;
#pragma unroll
                    for (int bj = 0; bj < 2; ++bj) { const int c8 = 4 * bj + fq; const f32x4 v0 = acc[ai][bj][m][0] * rs * gv[bj][0], v1 = acc[ai][bj][m][1] * rs * gv[bj][1];
                        u32x4 w; w.x = cvt_pk_bf16(v0[0], v0[1]); w.y = cvt_pk_bf16(v0[2], v0[3]); w.z = cvt_pk_bf16(v1[0], v1[1]); w.w = cvt_pk_bf16(v1[2], v1[3]);
                        *(u32x4*)(rp + (c8 >> 1) * 512 + (c8 & 1) * 256) = w; } }
            return;
        }
        const int colw = u.pn * BM + wc * 64; bf16_t* base; int rowlen;
        if (colw < 1536) { const int arr = colw >> 9, hd = (colw & 511) >> 6; base = PA + ((size_t)(arr * 16) * 8 + hd) * 2048 * 64; rowlen = 64; }
        else { const int c2 = colw - 1536, arr = c2 >> 9, hd = (c2 & 511) >> 7, dd = c2 & 127; base = PH + ((size_t)(arr * 16) * 4 + hd) * 2048 * 128 + dd; rowlen = 128; }
        const size_t bstride = (size_t)(rowlen == 64 ? 8 : 4) * 2048 * rowlen;
        const bool odd = fr & 1; base += (odd ? 32 : 0) + 8 * fq;
#pragma unroll
        for (int ai = 0; ai < 2; ++ai)
#pragma unroll
            for (int m = 0; m < 4; ++m) { const int rowE = u.pm * BM + ai * HALF + wr * 64 + m * 16 + (fr & ~1), b = rowE >> 11, s = rowE & 2047;
                u32x4 w[2];
#pragma unroll
                for (int bj = 0; bj < 2; ++bj) { const f32x4 v0 = acc[ai][bj][m][0], v1 = acc[ai][bj][m][1];
                    w[bj].x = cvt_pk_bf16(v0[0], v0[1]); w[bj].y = cvt_pk_bf16(v0[2], v0[3]); w[bj].z = cvt_pk_bf16(v1[0], v1[1]); w[bj].w = cvt_pk_bf16(v1[2], v1[3]); }
                const u32x4 snd = odd ? w[0] : w[1]; u32x4 rcv;
                rcv.x = (unsigned)__builtin_amdgcn_mov_dpp((int)snd.x, 0xB1, 0xF, 0xF, true); rcv.y = (unsigned)__builtin_amdgcn_mov_dpp((int)snd.y, 0xB1, 0xF, 0xF, true);
                rcv.z = (unsigned)__builtin_amdgcn_mov_dpp((int)snd.z, 0xB1, 0xF, 0xF, true); rcv.w = (unsigned)__builtin_amdgcn_mov_dpp((int)snd.w, 0xB1, 0xF, 0xF, true);
                bf16_t* rp = base + (size_t)b * bstride + (size_t)s * rowlen;
                *(u32x4*)rp = odd ? rcv : w[0];
                *(u32x4*)(rp + rowlen) = odd ? w[1] : rcv; }
    }
};
struct MoeOrder {
    const PG8_LAS int* tile_e; const PG8_LAS unsigned short* rowtab; int ntn, nunits, G, c; unsigned rowbytes; int rev;
    __device__ __forceinline__ bool next(int i, Unit& u) const {
        const int L = i * G + c; if (L >= nunits) return false;
        const int pm0 = L / ntn, pl = L - pm0 * ntn, pm = rev ? rev - 1 - pm0 : pm0; u.pm = pm; u.pn = tile_e[pm] * ntn + pl; u.slot = i; return true;
    }
    __device__ __forceinline__ unsigned rowoff(const Unit& u, int r) const { return (rowtab ? (unsigned)rowtab[u.slot * 256 + r] : (unsigned)(u.pm * 256 + r)) * rowbytes; }
    __device__ __forceinline__ void a_ready(const Unit&) const {}
    __device__ __forceinline__ void done(const Unit&) const {}
};
template <bool OUT8> struct EpiAct {
    static constexpr bool PERM = true, AFTER_DRAIN = false, HAS_INIT = true, INIT_LOADS = false;
    unsigned char* ACT; const PG8_LAS float* biastab; float oscale;
    __device__ __forceinline__ void init(f32x4 (&acc)[2][2][4][2], const Unit& u, int wr, int wc, int fr, int fq) const {
#pragma unroll
        for (int n = 0; n < 2; ++n) { const f32x4 bg = *(const PG8_LAS f32x4*)(biastab + u.slot * 256 + wc * 32 + 8 * fq + 4 * n), bu = *(const PG8_LAS f32x4*)(biastab + u.slot * 256 + 128 + wc * 32 + 8 * fq + 4 * n);
#pragma unroll
            for (int ai = 0; ai < 2; ++ai)
#pragma unroll
                for (int m = 0; m < 4; ++m) { acc[ai][0][m][n] = bg; acc[ai][1][m][n] = bu; } }
    }
    __device__ __forceinline__ void operator()(const f32x4 (&acc)[2][2][4][2], const Unit& u, int wr, int wc, int fr, int fq) const {
        const int pl = u.pn & 7; const int row0 = u.pm * BM + wr * 64 + fr, acol0 = pl * 128 + wc * 32 + 8 * fq;
#pragma unroll
        for (int ai = 0; ai < 2; ++ai)
#pragma unroll
            for (int m = 0; m < 4; ++m) { unsigned char* rowp = ACT + (size_t)(row0 + ai * HALF + m * 16) * 1024 + acol0; f32x4 a4[2];
#pragma unroll
                for (int n = 0; n < 2; ++n) { const f32x4 g4 = acc[ai][0][m][n], u4 = acc[ai][1][m][n]; f32x4 gl, ul, ex;
#pragma unroll
                    for (int j = 0; j < 4; ++j) { gl[j] = fminf(g4[j], 7.0f); ul[j] = __builtin_amdgcn_fmed3f(u4[j], -7.0f, 7.0f); }
                    const f32x4 t4 = gl * (-1.702f * 1.44269504089f);
#pragma unroll
                    for (int j = 0; j < 4; ++j) ex[j] = __builtin_amdgcn_exp2f(t4[j]);
                    const f32x4 d4 = ex + 1.0f; f32x4 s4;
#pragma unroll
                    for (int j = 0; j < 4; ++j) s4[j] = __builtin_amdgcn_rcpf(d4[j]);
                    a4[n] = (gl * s4) * (ul * oscale + oscale); }
                if constexpr (OUT8) { int p0 = 0, p1 = 0; p0 = __builtin_amdgcn_cvt_pk_fp8_f32(a4[0][0], a4[0][1], p0, false); p0 = __builtin_amdgcn_cvt_pk_fp8_f32(a4[0][2], a4[0][3], p0, true);
                    p1 = __builtin_amdgcn_cvt_pk_fp8_f32(a4[1][0], a4[1][1], p1, false); p1 = __builtin_amdgcn_cvt_pk_fp8_f32(a4[1][2], a4[1][3], p1, true);
                    *(unsigned long long*)rowp = (unsigned long long)(unsigned)p0 | ((unsigned long long)(unsigned)p1 << 32); }
                else { u32x4 w; w.x = cvt_pk_bf16(a4[0][0], a4[0][1]); w.y = cvt_pk_bf16(a4[0][2], a4[0][3]); w.z = cvt_pk_bf16(a4[1][0], a4[1][1]); w.w = cvt_pk_bf16(a4[1][2], a4[1][3]); *(u32x4*)(rowp + (size_t)(row0 + ai * HALF + m * 16) * 1024 + acol0) = w; } }
    }
};
struct EpiDown {
    static constexpr bool PERM = true, AFTER_DRAIN = false, HAS_INIT = true, INIT_LOADS = false;
    unsigned char* YK; const PG8_LAS int* tktab; const PG8_LAS float* biastab; float oscale;
    __device__ __forceinline__ void init(f32x4 (&acc)[2][2][4][2], const Unit& u, int wr, int wc, int fr, int fq) const {
#pragma unroll
        for (int bj = 0; bj < 2; ++bj)
#pragma unroll
            for (int n = 0; n < 2; ++n) { const f32x4 bv = *(const PG8_LAS f32x4*)(biastab + u.slot * 256 + 64 * wc + 16 * fq + 8 * bj + 4 * n) * oscale;
#pragma unroll
                for (int ai = 0; ai < 2; ++ai)
#pragma unroll
                    for (int m = 0; m < 4; ++m) acc[ai][bj][m][n] = bv; }
    }
    __device__ __forceinline__ void operator()(const f32x4 (&acc)[2][2][4][2], const Unit& u, int wr, int wc, int fr, int fq) const {
        const int pl = u.pn & 3; const int col0 = pl * BM + 64 * wc + 16 * fq;
#pragma unroll
        for (int ai = 0; ai < 2; ++ai)
#pragma unroll
            for (int m = 0; m < 4; ++m) { const int tk = tktab[u.slot * 256 + ai * HALF + wr * 64 + m * 16 + fr];
                if (tk >= 0) { unsigned char* rowp = YK + (size_t)tk * 1024 + col0; int p[4];
#pragma unroll
                    for (int bj = 0; bj < 2; ++bj) { f32x4 v0 = acc[ai][bj][m][0], v1 = acc[ai][bj][m][1];
#pragma unroll
                        for (int j = 0; j < 4; ++j) { v0[j] = __builtin_amdgcn_fmed3f(v0[j], -448.f, 448.f); v1[j] = __builtin_amdgcn_fmed3f(v1[j], -448.f, 448.f); }
                        int p0 = 0, p1 = 0; p0 = __builtin_amdgcn_cvt_pk_fp8_f32(v0[0], v0[1], p0, false); p0 = __builtin_amdgcn_cvt_pk_fp8_f32(v0[2], v0[3], p0, true);
                        p1 = __builtin_amdgcn_cvt_pk_fp8_f32(v1[0], v1[1], p1, false); p1 = __builtin_amdgcn_cvt_pk_fp8_f32(v1[2], v1[3], p1, true);
                        p[2 * bj] = p0; p[2 * bj + 1] = p1; }
                    u32x4 w; w.x = (unsigned)p[0]; w.y = (unsigned)p[1]; w.z = (unsigned)p[2]; w.w = (unsigned)p[3];
                    *(u32x4*)rowp = w; } }
    }
};

template <class Epi, class Sched, bool ALIGN_EPI = false, bool SP2 = false, bool GATHER = false, int SCW = 0, int SCX = 0>
__device__ __forceinline__ void gemm_phase(PG8_LAS unsigned char* lds, const Gemm g, const Sched& S, const Epi& E, const int tid) {
    const int wid = __builtin_amdgcn_readfirstlane(tid >> 6), lane = tid & 63, wr = wid >> 2, wc = wid & 3, fr = lane & 15, fq = lane >> 4;
    const int K = g.K, nt = K / BK;
    unsigned voffA[2], voffB[2]; int RA[2]; unsigned CA2[2]; unsigned va0[2] = {0u, 0u}, va1[2] = {0u, 0u};
#pragma unroll
    for (int i = 0; i < 2; ++i) { int R, C; stage_rc(tid * 16 + i * 8192, R, C); const int Rb = Epi::PERM ? ((R & ~31) + perm32(R & 31)) : R;
        voffA[i] = (unsigned)(R * K + C) * 2u; voffB[i] = (unsigned)(Rb * K + C) * 2u; RA[i] = R; CA2[i] = (unsigned)C * 2u; }
    static_assert(!GATHER || SP2, "the gathered-A form exists for the SP2 loop only");
    const char* const gA0 = (const char*)g.A;
#define PG8_VA(u) do { int l_; asm volatile("v_mbcnt_lo_u32_b32 %0, -1, 0\n\tv_mbcnt_hi_u32_b32 %0, -1, %0" : "=v"(l_)); const int t_ = wid * 64 + l_;     \
        _Pragma("unroll") for (int _i = 0; _i < 2; ++_i) { int R_, C_; stage_rc(t_ * 16 + _i * 8192, R_, C_); va0[_i] = S.rowoff((u), R_) + (unsigned)C_ * 2u; va1[_i] = S.rowoff((u), HALF + R_) + (unsigned)C_ * 2u; } } while (0)
#define PG8_STA(bufoff, base_ng, base_g, h) do { if constexpr (GATHER) { if (h) PG8_STAGE(bufoff, base_g, va1); else PG8_STAGE(bufoff, base_g, va0); } else PG8_STAGE(bufoff, base_ng, voffA); } while (0)
    const size_t kstep = (size_t)(BK * 2);
    const size_t hstep = (size_t)HALF * K * 2;
    const size_t tstep = 2 * hstep;
    const unsigned ldsw = (unsigned)wid * 1024u;
    const int aoff = lds_byte(wr * 64 + fr, fq * 8), boff = lds_byte(wc * 32 + fr, fq * 8);
#define PG8_SA(b, h) (((b) * 2 + (h)) * HTB)
#define PG8_SB(b, h) ((4 + (b) * 2 + (h)) * HTB)
#define PG8_STAGE(bufoff, gbase, voff) do { _Pragma("unroll") for (int _i = 0; _i < 2; ++_i) \
        __builtin_amdgcn_global_load_lds((const unsigned*)((const char*)(gbase) + (voff)[_i]), (PG8_LAS unsigned*)(lds + (bufoff) + ldsw + _i * 8192), 16, 0, 0); } while (0)
#define PG8_LDA(dst, b, h) do { if constexpr (SCW != 0) { _Pragma("unroll") for (int m = 0; m < 4; ++m) dst##8[m] = PG8_CAT8(*(const PG8_LAS bf16x8*)(lds + PG8_SA(b, h) + aoff + m * 2048), *(const PG8_LAS bf16x8*)(lds + PG8_SA(b, h) + aoff + m * 2048 + 1024)); } \
        else { _Pragma("unroll") for (int m = 0; m < 4; ++m) _Pragma("unroll") for (int k = 0; k < 2; ++k) dst[m][k] = *(const PG8_LAS bf16x8*)(lds + PG8_SA(b, h) + aoff + m * 2048 + k * 1024); } } while (0)
#define PG8_LDB(dst, b, h) do { if constexpr (SCW != 0) { _Pragma("unroll") for (int n = 0; n < 2; ++n) dst##8[n] = PG8_CAT8(*(const PG8_LAS bf16x8*)(lds + PG8_SB(b, h) + boff + n * 2048), *(const PG8_LAS bf16x8*)(lds + PG8_SB(b, h) + boff + n * 2048 + 1024)); } \
        else { _Pragma("unroll") for (int n = 0; n < 2; ++n) _Pragma("unroll") for (int k = 0; k < 2; ++k) dst[n][k] = *(const PG8_LAS bf16x8*)(lds + PG8_SB(b, h) + boff + n * 2048 + k * 1024); } } while (0)
#define PG8_CAT8(lo, hi) __builtin_shufflevector(__builtin_bit_cast(i32x4_t, (lo)), __builtin_bit_cast(i32x4_t, (hi)), 0, 1, 2, 3, 4, 5, 6, 7)
#define PG8_MMA(ai, bj, At, Bt) do { __builtin_amdgcn_s_setprio(1); _Pragma("unroll") for (int m = 0; m < 4; ++m) _Pragma("unroll") for (int n = 0; n < 2; ++n) { \
        if constexpr (SCW != 0) acc[ai][bj][m][n] = __builtin_amdgcn_mfma_scale_f32_16x16x128_f8f6f4(Bt##8[n], At##8[m], acc[ai][bj][m][n], 0, 0, 0, SCW, 0, SCX); \
        else { _Pragma("unroll") for (int k = 0; k < 2; ++k) acc[ai][bj][m][n] = __builtin_amdgcn_mfma_f32_16x16x32_bf16(Bt[n][k], At[m][k], acc[ai][bj][m][n], 0, 0, 0); } } __builtin_amdgcn_s_setprio(0); } while (0)
#define PG8_WAIT_V(n) asm volatile("s_waitcnt vmcnt(" #n ")" ::: "memory")
#define PG8_WAIT_L(n) asm volatile("s_waitcnt lgkmcnt(" #n ")" ::: "memory")
#define PG8_BAR __builtin_amdgcn_s_barrier()
#define PG8_SCHED __builtin_amdgcn_sched_barrier(0)
    Unit cur, nxt; int ui = 0;
    if (!S.next(0, cur)) return;
    f32x4 acc[2][2][4][2];
    if constexpr (Epi::HAS_INIT) { E.init(acc, cur, wr, wc, fr, fq); if constexpr (Epi::INIT_LOADS) __builtin_amdgcn_s_waitcnt(0x0F70); }
    else {
#pragma unroll
    for (int a = 0; a < 2; ++a)
#pragma unroll
        for (int b = 0; b < 2; ++b)
#pragma unroll
            for (int m = 0; m < 4; ++m)
#pragma unroll
                for (int n = 0; n < 2; ++n) acc[a][b][m][n] = (f32x4){0.f, 0.f, 0.f, 0.f};
    }
    bf16x8 At[4][2], B0[2][2], B1[2][2]; i32x8_t At8[4], B08[2], B18[2];
    const char* cA = (const char*)g.A + (size_t)cur.pm * tstep; const char* cB = (const char*)g.Bt + (size_t)cur.pn * tstep;
    S.a_ready(cur);
    if constexpr (SP2) {
        if constexpr (GATHER) PG8_VA(cur);
        PG8_STAGE(PG8_SB(0, 0), cB, voffB); PG8_STAGE(PG8_SB(0, 1), cB + hstep, voffB); PG8_STA(PG8_SA(0, 0), cA, gA0, 0); PG8_STA(PG8_SA(0, 1), cA + hstep, gA0, 1);
        if (wr == 1) PG8_BAR;
        PG8_WAIT_V(2); PG8_BAR;
        PG8_STAGE(PG8_SB(1, 0), cB + kstep, voffB); PG8_STA(PG8_SA(1, 0), cA + kstep, gA0 + kstep, 0); PG8_STAGE(PG8_SB(1, 1), cB + hstep + kstep, voffB);
        PG8_WAIT_V(6); PG8_BAR;
    } else {
        PG8_STAGE(PG8_SB(0, 0), cB, voffB); PG8_STAGE(PG8_SA(0, 0), cA, voffA); PG8_STAGE(PG8_SB(0, 1), cB + hstep, voffB); PG8_STAGE(PG8_SA(0, 1), cA + hstep, voffA);
        if (wr == 1) PG8_BAR;
        PG8_WAIT_V(4); PG8_BAR;
        PG8_STAGE(PG8_SB(1, 0), cB + kstep, voffB); PG8_STAGE(PG8_SA(1, 0), cA + kstep, voffA); PG8_STAGE(PG8_SB(1, 1), cB + hstep + kstep, voffB);
        PG8_WAIT_V(6); PG8_BAR;
    }
    for (;;) {
        const bool has_next = S.next(ui + 1, nxt);
        const char* nA = has_next ? (const char*)g.A + (size_t)nxt.pm * tstep : cA; const char* nB = has_next ? (const char*)g.Bt + (size_t)nxt.pn * tstep : cB;
        _Pragma("nounroll") for (int t = 0; t < nt; t += 2) {
            const bool last = (t == nt - 2);
            const char* a1 = cA + (size_t)(t + 1) * kstep;
            const char* a2 = last ? nA : cA + (size_t)(t + 2) * kstep; const char* b2 = last ? nB : cB + (size_t)(t + 2) * kstep;
            const char* a3 = a2 + kstep; const char* b3 = b2 + kstep;
            if (last && has_next) S.a_ready(nxt);
            const char* const g1 = gA0 + (size_t)(t + 1) * kstep; const char* const g2 = last ? gA0 : gA0 + (size_t)(t + 2) * kstep; const char* const g3 = g2 + kstep;
            if constexpr (SP2) {
            PG8_LDB(B0, 0, 0); PG8_LDB(B1, 0, 1); PG8_SCHED; PG8_LDA(At, 0, 0); PG8_STA(PG8_SA(1, 1), a1 + hstep, g1, 1);
            PG8_WAIT_V(8); PG8_WAIT_L(0); PG8_BAR; PG8_MMA(0, 0, At, B0); PG8_MMA(0, 1, At, B1); PG8_BAR; PG8_SCHED;
            if constexpr (GATHER) { if (last && has_next) PG8_VA(nxt); }
            PG8_LDA(At, 0, 1); PG8_STAGE(PG8_SB(0, 0), b2, voffB); PG8_STAGE(PG8_SB(0, 1), b2 + hstep, voffB); PG8_STA(PG8_SA(0, 0), a2, g2, 0);
            PG8_WAIT_V(8); PG8_WAIT_L(0); PG8_BAR; PG8_MMA(1, 0, At, B0); PG8_MMA(1, 1, At, B1); PG8_BAR; PG8_SCHED;
            PG8_LDB(B0, 1, 0); PG8_LDB(B1, 1, 1); PG8_SCHED; PG8_LDA(At, 1, 0); PG8_STA(PG8_SA(0, 1), a2 + hstep, g2, 1);
            PG8_WAIT_V(8); PG8_WAIT_L(0); PG8_BAR; PG8_MMA(0, 0, At, B0); PG8_MMA(0, 1, At, B1); PG8_BAR; PG8_SCHED;
            PG8_LDA(At, 1, 1); PG8_STAGE(PG8_SB(1, 0), b3, voffB); PG8_STAGE(PG8_SB(1, 1), b3 + hstep, voffB); PG8_STA(PG8_SA(1, 0), a3, g3, 0);
            PG8_WAIT_V(8); PG8_WAIT_L(0); PG8_BAR; PG8_MMA(1, 0, At, B0); PG8_MMA(1, 1, At, B1); PG8_BAR; PG8_SCHED;
            } else {
            PG8_LDB(B0, 0, 0); PG8_SCHED; PG8_LDA(At, 0, 0); PG8_STAGE(PG8_SA(1, 1), a1 + hstep, voffA);
            PG8_WAIT_L(8); PG8_BAR; PG8_WAIT_L(0); PG8_MMA(0, 0, At, B0); PG8_BAR; PG8_SCHED;
            PG8_LDB(B1, 0, 1); PG8_STAGE(PG8_SB(0, 0), b2, voffB);
            PG8_BAR; PG8_WAIT_L(0); PG8_MMA(0, 1, At, B1); PG8_BAR;
            PG8_LDA(At, 0, 1); PG8_STAGE(PG8_SA(0, 0), a2, voffA);
            PG8_BAR; PG8_WAIT_L(0); PG8_MMA(1, 0, At, B0); PG8_BAR; PG8_SCHED;
            PG8_STAGE(PG8_SB(0, 1), b2 + hstep, voffB);
            PG8_WAIT_V(6); PG8_BAR; PG8_MMA(1, 1, At, B1); PG8_BAR;
            PG8_LDB(B0, 1, 0); PG8_SCHED; PG8_LDA(At, 1, 0); PG8_STAGE(PG8_SA(0, 1), a2 + hstep, voffA);
            PG8_WAIT_L(8); PG8_BAR; PG8_WAIT_L(0); PG8_MMA(0, 0, At, B0); PG8_BAR; PG8_SCHED;
            PG8_LDB(B1, 1, 1); PG8_STAGE(PG8_SB(1, 0), b3, voffB);
            PG8_BAR; PG8_WAIT_L(0); PG8_MMA(0, 1, At, B1); PG8_BAR;
            PG8_LDA(At, 1, 1); PG8_STAGE(PG8_SA(1, 0), a3, voffA);
            PG8_BAR; PG8_WAIT_L(0); PG8_MMA(1, 0, At, B0); PG8_BAR; PG8_SCHED;
            PG8_STAGE(PG8_SB(1, 1), b3 + hstep, voffB);
            PG8_WAIT_V(6); PG8_BAR; PG8_MMA(1, 1, At, B1); PG8_BAR;
            }
        }
        if constexpr (ALIGN_EPI) { if (wr == 0) PG8_BAR; }
        if constexpr (!Epi::AFTER_DRAIN) { int fr_ = fr, fq_ = fq; asm volatile("" : "+v"(fr_), "+v"(fq_));
            E(acc, cur, wr, wc, fr_, fq_); S.done(cur); }
        if (!has_next) break;
        if constexpr (Epi::HAS_INIT) { int fr_ = fr, fq_ = fq; asm volatile("" : "+v"(fr_), "+v"(fq_)); E.init(acc, nxt, wr, wc, fr_, fq_); if constexpr (Epi::INIT_LOADS) __builtin_amdgcn_s_waitcnt(0x0F70); }
        else {
#pragma unroll
        for (int a = 0; a < 2; ++a)
#pragma unroll
            for (int b = 0; b < 2; ++b)
#pragma unroll
                for (int m = 0; m < 4; ++m)
#pragma unroll
                    for (int n = 0; n < 2; ++n) acc[a][b][m][n] = (f32x4){0.f, 0.f, 0.f, 0.f};
        }
        cur = nxt; cA = nA; cB = nB; ++ui;
        if constexpr (ALIGN_EPI) { if (wr == 1) PG8_BAR; }
    }
    PG8_WAIT_V(0);
    if constexpr (!ALIGN_EPI) { if (wr == 0) PG8_BAR; }
    PG8_BAR;
    if constexpr (Epi::AFTER_DRAIN) { E.fused(acc, cur, wr, wc, fr, fq, lds, wid, lane); S.done(cur); }
#undef PG8_SA
#undef PG8_CAT8
#undef PG8_VA
#undef PG8_STA
#undef PG8_SB
#undef PG8_STAGE
#undef PG8_LDA
#undef PG8_LDB
#undef PG8_MMA
#undef PG8_WAIT_V
#undef PG8_WAIT_L
#undef PG8_BAR
#undef PG8_SCHED
}
}

#ifndef PG8_SP2
#define PG8_SP2 true
#endif
#ifndef PG8_ALIGN
#define PG8_ALIGN true
#endif
#define GAS __attribute__((address_space(1)))
#define LAS __attribute__((address_space(3)))
typedef unsigned short bf16;
typedef unsigned v4u __attribute__((ext_vector_type(4)));
typedef float f32x4 __attribute__((ext_vector_type(4)));
typedef short bf16x8 __attribute__((ext_vector_type(8)));
typedef GAS unsigned gu32;
typedef GAS unsigned long long gu64;
#define RLX_AGENT __ATOMIC_RELAXED, __HIP_MEMORY_SCOPE_AGENT
#define LDS_WAIT() asm volatile("s_waitcnt lgkmcnt(0)" ::: "memory")
#define VM_WAIT() asm volatile("s_waitcnt vmcnt(0)" ::: "memory")
__device__ __forceinline__ unsigned long long rt() { return __builtin_amdgcn_s_memrealtime(); }
__device__ __forceinline__ unsigned f2bf(float f) { unsigned u = __builtin_bit_cast(unsigned, f); return (u + 0x7fffu + ((u >> 16) & 1u)) >> 16; }
__device__ __forceinline__ unsigned pk2(float lo, float hi) { return f2bf(lo) | (f2bf(hi) << 16); }

#define XB_TMO      128
#define XB_XCNT(j)  (256  + 64 * (j))
#define XB_XSUB(j)  (1280 + 64 * (j))
#define XB_XGEN(j)  (2304 + 64 * (j))
#define XB_TOP      3328
#define XB_TOPGEN   3392
#define XCD_BAR_WORDS 3456
#define XB_SPIN_CAP (1u << 18)

__device__ __forceinline__ unsigned xb_ld(unsigned* p)              { return __hip_atomic_load(p, __ATOMIC_RELAXED, __HIP_MEMORY_SCOPE_AGENT); }
__device__ __forceinline__ unsigned xb_add(unsigned* p, unsigned v) { return __hip_atomic_fetch_add(p, v, __ATOMIC_RELAXED, __HIP_MEMORY_SCOPE_AGENT); }
__device__ __forceinline__ unsigned xb_xcc_id() { return (unsigned)__builtin_amdgcn_s_getreg((3 << 11) | 20) & 0xFu; }
#define XB_SPIN(cond, bar) do { unsigned _sp = 0; while (cond) { __builtin_amdgcn_s_sleep(1); \
    if ((++_sp & 255u) == 0u) { if (xb_ld(&(bar)[XB_TMO])) break; if (_sp > XB_SPIN_CAP) { atomicAdd(&(bar)[XB_TMO], 1u); break; } } } } while (0)

struct XcdBarrier {
    unsigned* bar; unsigned x;
    volatile LAS unsigned* st;
};

__device__ __forceinline__ XcdBarrier xcd_barrier_post(unsigned* bar, volatile LAS unsigned* st) {
    XcdBarrier b; b.bar = bar; b.x = xb_xcc_id(); b.st = st;
    if (threadIdx.x == 0) (void)xb_add(&bar[XB_XCNT(b.x)], 1u);
    return b;
}
__device__ __forceinline__ void xcd_barrier_complete(unsigned* bar, unsigned x, unsigned& nloc, unsigned& nx) {
    const unsigned G = gridDim.x * gridDim.y * gridDim.z;
    unsigned sum, cnt, mine, sp = 0u;
    for (;;) {
        sum = 0u; cnt = 0u; mine = 0u;
#pragma unroll
        for (unsigned j = 0; j < 16; ++j) { const unsigned c = xb_ld(&bar[XB_XCNT(j)]); sum += c; cnt += (c > 0u) ? 1u : 0u; mine = (j == x) ? c : mine; }
        if (sum == G) break;
        __builtin_amdgcn_s_sleep(1);
        if ((++sp & 255u) == 0u) { if (xb_ld(&bar[XB_TMO])) break; if (sp > XB_SPIN_CAP) { atomicAdd(&bar[XB_TMO], 1u); break; } }
    }
    nloc = mine > 0u ? mine : 1u; nx = cnt > 0u ? cnt : 1u;
}

__device__ __forceinline__ void xcd_barrier(const XcdBarrier& b) {
    asm volatile("s_waitcnt vmcnt(0)" ::: "memory");
    __syncthreads();
    if (threadIdx.x == 0) {
        unsigned* bar = b.bar;
        __builtin_amdgcn_s_waitcnt(0);
        unsigned nloc = b.st[0], nx = b.st[1];
        if (nloc == 0u) { xcd_barrier_complete(bar, b.x, nloc, nx); b.st[0] = nloc; b.st[1] = nx; }
        const unsigned old = xb_add(&bar[XB_XSUB(b.x)], 1u);
        const unsigned gen = old / nloc;
        if (old + 1u == (gen + 1u) * nloc) {
            __builtin_amdgcn_fence(__ATOMIC_RELEASE, "agent");
            asm volatile("s_waitcnt vmcnt(0)" ::: "memory");
            const unsigned og = xb_add(&bar[XB_TOP], 1u);
            const unsigned tg = og / nx;
            if (og + 1u == (tg + 1u) * nx) xb_add(&bar[XB_TOPGEN], 1u);
            else XB_SPIN(xb_ld(&bar[XB_TOPGEN]) == tg, bar);
            __builtin_amdgcn_fence(__ATOMIC_ACQUIRE, "agent");
            xb_add(&bar[XB_XGEN(b.x)], 1u);
            asm volatile("s_waitcnt vmcnt(0)" ::: "memory");
        } else {
            XB_SPIN(xb_ld(&bar[XB_XGEN(b.x)]) == gen, bar);
            __builtin_amdgcn_fence(__ATOMIC_ACQUIRE, "agent");
            asm volatile("s_waitcnt vmcnt(0)" ::: "memory");
        }
    }
    __syncthreads();
}

constexpr int NWAVES = 8;
#ifndef MK_ONE_LAUNCH
#define MK_ONE_LAUNCH 1
#endif

constexpr int BATCH = 16, SEQ = 2048, D = 1024, T = BATCH * SEQ;
constexpr int NIN = 3584;
constexpr int OFF_SQ = 0, OFF_SK = 512, OFF_SV = 1024, OFF_HQ = 1536, OFF_HF = 2048, OFF_HI = 2560, OFF_HG = 3072;
constexpr int NE = 32, TOPK = 4, NASSIGN = T * TOPK;
constexpr int MAXTILES = NASSIGN / 256 + NE;
constexpr int MAXROWS = MAXTILES * 256;
constexpr float EPS = 1e-6f;

constexpr size_t MiB = 1u << 20;
constexpr size_t WS_CTL = 0, CTL_ZERO_BYTES = 1 * MiB;
constexpr size_t WS_WIN = 2 * MiB;
constexpr size_t WS_WOUT = 10 * MiB;
constexpr size_t WS_RT = 12 * MiB;
constexpr size_t WS_WGU = 16 * MiB;
constexpr size_t WS_WD = 144 * MiB;
constexpr size_t WS_XN = 208 * MiB;
constexpr size_t WS_P = 272 * MiB;
constexpr size_t WS_PH = WS_P + 96 * MiB;
constexpr size_t WS_MIX = 496 * MiB;
constexpr size_t WS_ACT = 272 * MiB;
constexpr size_t WS_YK = 560 * MiB;
constexpr size_t WS_QN = 624 * MiB;
constexpr size_t WS_KN = 656 * MiB;
constexpr size_t WS_VT = 688 * MiB;
constexpr size_t WS_KVS = 720 * MiB;
constexpr size_t WS_DEC = 784 * MiB;
constexpr size_t WS_SSEG = 786 * MiB;
constexpr size_t WS_DSEG = 802 * MiB;
constexpr size_t WS_LIST = 816 * MiB;
constexpr size_t WS_TOPG = 825 * MiB;
constexpr size_t WS_X8 = 560 * MiB;
constexpr size_t WS_END = 832 * MiB;
static_assert(WS_ACT + (size_t)MAXROWS * 2048 <= WS_YK && WS_YK + (size_t)T * 4 * 2048 <= WS_LIST && WS_MIX + (size_t)T * 2048 <= WS_YK, "d_ws map");
constexpr int CW_TMO = 0, CW_CODE = 1;
constexpr int CW_CNT = 64;
constexpr int CW_BAR = 4096;

constexpr int RING_OFF = 0, RING_BYTES = 131072;
constexpr int RT_ROW = 2064, RT_WL = 32 * RT_ROW, RT_END = 64 * RT_ROW;
constexpr int LDSCTL_OFF = 133120, MISC_OFF = LDSCTL_OFF + 320;
constexpr int LTAB_OFF = LDSCTL_OFF + 512;
constexpr int LT_TS = MAXTILES, LT_CNT = MAXTILES + 32, LT_MISC = MAXTILES + 64, LT_WORDS = MAXTILES + 192;
constexpr int ROWTAB_OFF = LTAB_OFF + LT_WORDS * 4;
constexpr int MAXSLOT = 17;
constexpr int ROWTAB2_OFF = ROWTAB_OFF + MAXSLOT * 1024;
constexpr int LDS_BYTES = ROWTAB2_OFF + MAXSLOT * 512;
static_assert(RT_END <= LDSCTL_OFF && MISC_OFF + 128 <= LTAB_OFF && LDS_BYTES <= 160 * 1024 && (MAXTILES * 8 + 255) / 256 <= MAXSLOT && 2 * ((MAXTILES * 4 + 255) / 256) * 1024 <= MAXSLOT * 1536 && ROWTAB_OFF % 16 == 0, "LDS map");

struct Frame {
    LAS unsigned char* lds;
    volatile LAS unsigned* MISC;
    gu32* ctl;
    int tid, lane, wave, gw, ngw;
    int vcu, G;
    const float *x, *norm1_g, *w_in, *sb_q_g, *sb_k_g, *sb_out_g, *hg_lb, *hg_out_g, *w_out, *norm2_g, *w_router, *b_router, *w_gu, *b_gu, *w_d, *b_d;
    float* out;
    unsigned char* ws;
};
__device__ __forceinline__ float bf2f(unsigned short b) { return __builtin_bit_cast(float, (unsigned)b << 16); }
__device__ __forceinline__ float bflo(unsigned w) { return __builtin_bit_cast(float, w << 16); }
__device__ __forceinline__ float bfhi(unsigned w) { return __builtin_bit_cast(float, w & 0xffff0000u); }
typedef __bf16 bf16x2n_ __attribute__((ext_vector_type(2)));
typedef float f32x2n_ __attribute__((ext_vector_type(2)));
__device__ __forceinline__ unsigned pkbf(float a, float b) { const bf16x2n_ v = __builtin_convertvector((f32x2n_){a, b}, bf16x2n_); return __builtin_bit_cast(unsigned, v); }
__device__ __forceinline__ int lane_id() { int l; asm volatile("v_mbcnt_lo_u32_b32 %0, -1, 0\n\tv_mbcnt_hi_u32_b32 %0, -1, %0" : "=v"(l)); return l; }
__device__ __forceinline__ int vzero() { int z; asm volatile("v_mov_b32 %0, 0" : "=v"(z)); return z; }
__device__ __forceinline__ float wave_sum(float v) {
#pragma unroll
    for (int o = 1; o < 64; o <<= 1) v += __shfl_xor(v, o);
    return v;
}

constexpr float W8_SCALE = 256.f, A8_SCALE = 4.f, Y8_SCALE = 32.f; static_assert(Y8_SCALE == 32.f, "SC_W8Y below is 2^-8 * 32");
constexpr int SC_ONE = 0x7f7f7f7f, SC_W8 = 0x77777777, SC_A8 = 0x7d7d7d7d, SC_W8Y = 0x7c7c7c7c;
struct P0Item { const float* W; bf16* WT; const float* rowscale; int N, k0, n0, drow0, fp8, perm; };
__device__ __forceinline__ void p0_load(const P0Item& it, f32x4 (&v)[16], int lane) {
    const int kr = lane >> 4, nc = 4 * (lane & 15);
#pragma unroll
    for (int i = 0; i < 16; ++i) v[i] = __builtin_nontemporal_load((const f32x4*)(it.W + (size_t)(it.k0 + 4 * i + kr) * it.N + it.n0 + nc));
}
__device__ __forceinline__ void p0_store(const P0Item& it, const f32x4 (&v)[16], LAS unsigned char* scr, int lane) {
    const int kr = lane >> 4, nc = 4 * (lane & 15);
#pragma unroll
    for (int i = 0; i < 16; ++i) { const float sc = it.rowscale ? it.rowscale[it.k0 + 4 * i + kr] : 1.f;
        *(LAS unsigned long long*)(scr + (4 * i + kr) * 136 + 2 * nc) = (unsigned long long)pkbf(v[i].x * sc, v[i].y * sc) | ((unsigned long long)pkbf(v[i].z * sc, v[i].w * sc) << 32); }
    LDS_WAIT(); asm volatile("" ::: "memory");
    const LAS unsigned short* s16 = (const LAS unsigned short*)scr;
    if (it.fp8) { const int p = lane & 3, nr = lane >> 2;
#pragma unroll
        for (int c = 0; c < 4; ++c) { const int n = 16 * c + nr; unsigned val[16];
#pragma unroll
            for (int kk = 0; kk < 16; ++kk) val[kk] = s16[(16 * p + kk) * 68 + n];
            v4u w4;
            w4.x = pg8::pk4_fp8(bflo(val[0]) * W8_SCALE, bflo(val[1]) * W8_SCALE, bflo(val[2]) * W8_SCALE, bflo(val[3]) * W8_SCALE);
            w4.y = pg8::pk4_fp8(bflo(val[4]) * W8_SCALE, bflo(val[5]) * W8_SCALE, bflo(val[6]) * W8_SCALE, bflo(val[7]) * W8_SCALE);
            w4.z = pg8::pk4_fp8(bflo(val[8]) * W8_SCALE, bflo(val[9]) * W8_SCALE, bflo(val[10]) * W8_SCALE, bflo(val[11]) * W8_SCALE);
            w4.w = pg8::pk4_fp8(bflo(val[12]) * W8_SCALE, bflo(val[13]) * W8_SCALE, bflo(val[14]) * W8_SCALE, bflo(val[15]) * W8_SCALE);
            *(GAS v4u*)((unsigned char*)it.WT + (size_t)(it.drow0 + (it.perm == 2 ? 128 * ((n >> 3) & 1) + 8 * (n >> 4) + (n & 7) : n)) * D + it.k0 + 16 * p) = w4; }
    } else { const int p = lane & 7, nr = lane >> 3;
#pragma unroll
        for (int c = 0; c < 8; ++c) { const int n = 8 * c + nr; unsigned val[8];
#pragma unroll
            for (int kk = 0; kk < 8; ++kk) val[kk] = s16[(8 * p + kk) * 68 + n];
            v4u w4; w4.x = val[0] | (val[1] << 16); w4.y = val[2] | (val[3] << 16); w4.z = val[4] | (val[5] << 16); w4.w = val[6] | (val[7] << 16);
            *(GAS v4u*)(it.WT + (size_t)(it.drow0 + (it.perm ? 128 * (n >> 5) + (n & 31) : n)) * D + it.k0 + 8 * p) = w4; } }
    LDS_WAIT(); asm volatile("" ::: "memory");
}
__device__ __forceinline__ void rms_rows2_to_bf16(const float* xa, const float* xb, bool hasb, const float* g, bf16* oa, bf16* ob, int lane) {
    const GAS f32x4* pa = (const GAS f32x4*)xa + lane; const GAS f32x4* pb = (const GAS f32x4*)(hasb ? xb : xa) + lane; const f32x4* gr = (const f32x4*)g + lane;
    f32x4 va[4], vb[4], gg[4]; float sa = 0.f, sb = 0.f;
#pragma unroll
    for (int j = 0; j < 4; ++j) { va[j] = __builtin_nontemporal_load(pa + 64 * j); vb[j] = __builtin_nontemporal_load(pb + 64 * j); gg[j] = gr[64 * j]; }
#pragma unroll
    for (int j = 0; j < 4; ++j) { sa += (va[j].x * va[j].x + va[j].y * va[j].y) + (va[j].z * va[j].z + va[j].w * va[j].w); sb += (vb[j].x * vb[j].x + vb[j].y * vb[j].y) + (vb[j].z * vb[j].z + vb[j].w * vb[j].w); }
    const float ra = 1.f / sqrtf(wave_sum(sa) * (1.f / D) + EPS), rb = 1.f / sqrtf(wave_sum(sb) * (1.f / D) + EPS);
    GAS unsigned long long* o8a = (GAS unsigned long long*)oa + lane; GAS unsigned long long* o8b = (GAS unsigned long long*)ob + lane;
#pragma unroll
    for (int j = 0; j < 4; ++j) o8a[64 * j] = (unsigned long long)pkbf(va[j].x * ra * gg[j].x, va[j].y * ra * gg[j].y) | ((unsigned long long)pkbf(va[j].z * ra * gg[j].z, va[j].w * ra * gg[j].w) << 32);
    if (hasb) {
#pragma unroll
        for (int j = 0; j < 4; ++j) o8b[64 * j] = (unsigned long long)pkbf(vb[j].x * rb * gg[j].x, vb[j].y * rb * gg[j].y) | ((unsigned long long)pkbf(vb[j].z * rb * gg[j].z, vb[j].w * rb * gg[j].w) << 32); }
}
__device__ __forceinline__ P0Item p0_item(Frame& F, int r) {
    constexpr int I_IN = 16 * (NIN / 64), I_OUT = 16 * 16, I_GU = NE * 16 * 32;
    P0Item it;
    if (r < I_IN) { const int nb = NIN / 64, kb = r / nb, nn = r % nb; const int pq = 1; it = P0Item{F.w_in, (bf16*)(F.ws + WS_WIN), nullptr, NIN, 64 * kb, 64 * nn, pq ? 256 * (nn >> 2) + 32 * (nn & 3) : 64 * nn, 0, pq}; return it; } r -= I_IN;
    if (r < I_OUT) { const int kb = r / 16, nn = r % 16; it = P0Item{F.w_out, (bf16*)(F.ws + WS_WOUT), nullptr, D, 64 * kb, 64 * nn, 256 * (nn >> 2) + 32 * (nn & 3), 0, 1}; return it; }     r -= I_OUT;
    if (r < I_GU) { const int e = r / 512, q = r % 512, kb = q / 32, nn = q % 32;
        const int isup = nn >> 4, a = (nn & 15) * 64;
        it = P0Item{F.w_gu + (size_t)e * D * 2048, (bf16*)(F.ws + WS_WGU + (size_t)e * 2048 * D), F.norm2_g, 2048, 64 * kb, 64 * nn, 256 * (a >> 7) + 128 * isup + (a & 127), 1, 0}; return it; } r -= I_GU;
    { const int e = r / 256, q = r % 256, kb = q / 16, nn = q % 16;
        it = P0Item{F.w_d + (size_t)e * D * D, (bf16*)(F.ws + WS_WD + (size_t)e * D * D), nullptr, D, 64 * kb, 64 * nn, 256 * (nn >> 2) + 32 * (nn & 3), 1, 2}; return it; }
}
constexpr int P0_NITEMS = 16 * (NIN / 64) + 16 * 16 + NE * 16 * 32 + NE * 16 * 16;
constexpr int P0_NLATE = 1024;
__device__ __forceinline__ void p0_items(Frame& F, int lo, int hi, int w, int nw) {
    LAS unsigned char* scr = F.lds + RING_OFF + F.wave * 16384;
    f32x4 va[16], vb[16]; int it = lo + w;
    if (it < hi) { P0Item A = p0_item(F, it); p0_load(A, va, F.lane);
        for (;;) {
            const int itb = it + nw; const bool hb = itb < hi; const P0Item B = p0_item(F, hb ? itb : it); p0_load(B, vb, F.lane); __builtin_amdgcn_sched_barrier(0);
            p0_store(A, va, scr, F.lane);
            if (!hb) break;
            it = itb + nw; const bool ha = it < hi; A = p0_item(F, ha ? it : itb); p0_load(A, va, F.lane); __builtin_amdgcn_sched_barrier(0);
            p0_store(B, vb, scr, F.lane);
            if (!ha) break;
        }
    }
}
__device__ __forceinline__ void p0_prologue(Frame& F) {
    p0_items(F, 0, P0_NITEMS - P0_NLATE, F.gw, F.ngw);
    for (int q = blockIdx.x * (NWAVES * 64) + F.tid; q < 4096; q += F.G * NWAVES * 64) {
        const int e = q & 31, k0 = (q >> 5) * 8; unsigned hi[8], lo[8];
#pragma unroll
        for (int j = 0; j < 8; ++j) { const float w = F.w_router[(k0 + j) * 32 + e] * F.norm2_g[k0 + j]; hi[j] = pkbf(w, 0.f) & 0xffffu; lo[j] = pkbf(w - bflo(hi[j]), 0.f) & 0xffffu; }
        const v4u h4 = {hi[0] | (hi[1] << 16), hi[2] | (hi[3] << 16), hi[4] | (hi[5] << 16), hi[6] | (hi[7] << 16)}, l4 = {lo[0] | (lo[1] << 16), lo[2] | (lo[3] << 16), lo[4] | (lo[5] << 16), lo[6] | (lo[7] << 16)};
        *(GAS v4u*)(F.ws + WS_RT + e * RT_ROW + 2 * k0) = h4; *(GAS v4u*)(F.ws + WS_RT + RT_WL + e * RT_ROW + 2 * k0) = l4; }
    for (int m = F.gw; m < T; m += 2 * F.ngw) rms_rows2_to_bf16(F.x + (size_t)m * D, F.x + (size_t)(m + F.ngw) * D, m + F.ngw < T, F.norm1_g, (bf16*)(F.ws + WS_XN) + (size_t)m * D, (bf16*)(F.ws + WS_XN) + (size_t)(m + F.ngw) * D, F.lane);
}

typedef float f32x16 __attribute__((ext_vector_type(16)));
typedef __bf16 bf16x2n __attribute__((ext_vector_type(2)));
typedef float f32x2n __attribute__((ext_vector_type(2)));
#define MFMA32(a, b, c) __builtin_amdgcn_mfma_f32_32x32x16_bf16((a), (b), (c), 0, 0, 0)
__device__ __forceinline__ bf16x8 pack8(float a0, float a1, float a2, float a3, float a4, float a5, float a6, float a7) { const v4u p = {pkbf(a0, a1), pkbf(a2, a3), pkbf(a4, a5), pkbf(a6, a7)}; return __builtin_bit_cast(bf16x8, p); }
constexpr float QSCALE = 0.125f * 1.44269504089f;
__device__ __forceinline__ void prep_phase(Frame& F) {
    LAS unsigned* tl = (LAS unsigned*)(F.lds + RING_OFF + F.wave * 16384);
    const bf16* P = (const bf16*)(F.ws + WS_P); bf16* Qn = (bf16*)(F.ws + WS_QN); bf16* Kn = (bf16*)(F.ws + WS_KN); bf16* VT = (bf16*)(F.ws + WS_VT);
    const int tr = F.lane >> 3, c8 = F.lane & 7;
    for (int it = F.gw; it < 4096; it += F.ngw) {
        const int bh = it & 127, blk = it >> 7, b = bh >> 3, h = bh & 7;
        const bf16* base = P + ((size_t)b * 8 + h) * SEQ * 64 + (size_t)(blk * 64 + tr) * 64 + 8 * c8;
        v4u rv[8];
#pragma unroll
        for (int i = 0; i < 8; ++i) { const bf16* row = base + (size_t)(8 * i) * 64; rv[i] = *(const GAS v4u*)(row + (size_t)2 * 16 * 8 * SEQ * 64); }
        {
#pragma unroll
            for (int i = 0; i < 8; ++i) { LAS unsigned* q = tl + (8 * i + tr) * 33 + 4 * c8; q[0] = rv[i].x; q[1] = rv[i].y; q[2] = rv[i].z; q[3] = rv[i].w; }
            LDS_WAIT(); asm volatile("" ::: "memory");
            const LAS unsigned short* t16 = (const LAS unsigned short*)tl; const int dr = tr;
#define KAP(pos) (((pos) & ~12) | (((pos) & 4) << 1) | (((pos) & 8) >> 1))
            bf16* const obase = VT + ((size_t)bh * 64 + blk * 2 + (c8 >> 2)) * 2048 + ((c8 >> 1) & 1) * 512 + (c8 & 1) * 256;
#pragma unroll
            for (int j = 0; j < 8; ++j) { unsigned val[8];
#pragma unroll
                for (int p = 0; p < 8; ++p) { const int pos = 8 * c8 + p; val[p] = t16[KAP(pos) * 66 + 8 * j + dr]; }
                v4u w4; w4.x = val[0] | (val[1] << 16); w4.y = val[2] | (val[3] << 16); w4.z = val[4] | (val[5] << 16); w4.w = val[6] | (val[7] << 16);
                *(GAS v4u*)(obase + (j >> 2) * 1024 + ((8 * j + dr) & 31) * 8) = w4; }
#undef KAP
            LDS_WAIT(); asm volatile("" ::: "memory");
        }
    }
}

__device__ __forceinline__ int crow16(int i, int hh) { return (i & 3) + 8 * (i >> 2) + 4 * hh; }
__device__ __forceinline__ void attn_item(Frame& F, int bh, int qb, float thr, const bf16x8 (&Lt)[2]) {
    const int r = F.lane & 31, hh = F.lane >> 5, b = bh >> 3, h = bh & 7, q0 = qb * 32;
    const bf16* Qn = (const bf16*)(F.ws + WS_QN); const bf16* Kn = (const bf16*)(F.ws + WS_KN); const bf16* VT = (const bf16*)(F.ws + WS_VT);
    bf16x8 qf[4];
#pragma unroll
    for (int s = 0; s < 4; ++s) qf[s] = *(const GAS bf16x8*)(Qn + ((size_t)bh * 64 + qb) * 2048 + s * 512 + F.lane * 8);
    f32x4 gout[2][4];
#pragma unroll
    for (int db = 0; db < 2; ++db)
#pragma unroll
        for (int gq = 0; gq < 4; ++gq) gout[db][gq] = *(const f32x4*)(F.sb_out_g + h * 64 + 32 * db + 8 * gq + 4 * hh);
    f32x16 O0, O1;
#pragma unroll
    for (int i = 0; i < 16; ++i) { O0[i] = 0.f; O1[i] = 0.f; }
    float carry = 0.f;
    const bf16* kbase = Kn + (size_t)bh * 64 * 2048 + F.lane * 8; const bf16* vbase = VT + (size_t)bh * 64 * 2048 + F.lane * 8;
#define ATT_LOAD(KF, VF, kb_) do { _Pragma("unroll") for (int s_ = 0; s_ < 4; ++s_) KF[s_] = *(const GAS bf16x8*)(kbase + (size_t)(kb_) * 2048 + 512 * s_); \
        _Pragma("unroll") for (int db_ = 0; db_ < 2; ++db_) _Pragma("unroll") for (int ks_ = 0; ks_ < 2; ++ks_) VF[db_][ks_] = *(const GAS bf16x8*)(vbase + (size_t)(kb_) * 2048 + 1024 * db_ + 512 * ks_); } while (0)
#define ATT_BLOCK(KF, VF, kb_) do { const bool diag = ((kb_) == qb); \
        f32x16 z; _Pragma("unroll") for (int i = 0; i < 16; ++i) z[i] = 0.f; \
        _Pragma("unroll") for (int s_ = 0; s_ < 4; ++s_) z = MFMA32(KF[s_], qf[s_], z); \
        float sp[16]; \
        _Pragma("unroll") for (int i = 0; i < 16; ++i) { const float zz = z[i]; float v = fmaxf(zz, 0.f) + __builtin_amdgcn_logf(1.f + __builtin_amdgcn_exp2f(-fabsf(zz))); if (diag && !(crow16(i, hh) < r)) v = 0.f; sp[i] = v; } \
        const bf16x8 sb0 = pack8(sp[0], sp[1], sp[2], sp[3], sp[4], sp[5], sp[6], sp[7]), sb1 = pack8(sp[8], sp[9], sp[10], sp[11], sp[12], sp[13], sp[14], sp[15]); \
        f32x16 Cc; _Pragma("unroll") for (int i = 0; i < 16; ++i) Cc[i] = carry; \
        Cc = MFMA32(Lt[0], sb0, Cc); Cc = MFMA32(Lt[1], sb1, Cc); \
        float w[16]; \
        _Pragma("unroll") for (int i = 0; i < 16; ++i) { float v = __builtin_amdgcn_exp2f(z[i] - Cc[i]); if (diag && !(crow16(i, hh) < r)) v = 0.f; w[i] = v; } \
        const bf16x8 wb0 = pack8(w[0], w[1], w[2], w[3], w[4], w[5], w[6], w[7]), wb1 = pack8(w[8], w[9], w[10], w[11], w[12], w[13], w[14], w[15]); \
        O0 = MFMA32(VF[0][0], wb0, O0); O0 = MFMA32(VF[0][1], wb1, O0); O1 = MFMA32(VF[1][0], wb0, O1); O1 = MFMA32(VF[1][1], wb1, O1); \
        carry = __shfl(Cc[0], r); } while (0)
    bf16x8 kfA[4], vfA[2][2], kfB[4], vfB[2][2];
    ATT_LOAD(kfA, vfA, qb);
    for (int kb = qb; kb >= 0; kb -= 2) {
        ATT_LOAD(kfB, vfB, kb > 0 ? kb - 1 : 0); __builtin_amdgcn_sched_barrier(0);
        ATT_BLOCK(kfA, vfA, kb);
        if (kb == 0 || __all(carry > thr)) break;
        ATT_LOAD(kfA, vfA, kb > 1 ? kb - 2 : 0); __builtin_amdgcn_sched_barrier(0);
        ATT_BLOCK(kfB, vfB, kb - 1);
        if (__all(carry > thr)) break;
    }
#undef ATT_LOAD
#undef ATT_BLOCK
    float ss = 0.f;
#pragma unroll
    for (int i = 0; i < 16; ++i) ss += O0[i] * O0[i] + O1[i] * O1[i];
    ss += __shfl_xor(ss, 32);
    const float rs = 1.f / sqrtf(ss * (1.f / 64.f) + EPS);
    bf16* orow = (bf16*)(F.ws + WS_MIX) + ((size_t)b * SEQ + q0 + r) * D + h * 64;
#pragma unroll
    for (int db = 0; db < 2; ++db) { unsigned op[4][2];
#pragma unroll
        for (int gq = 0; gq < 4; ++gq) { const f32x4 gg = gout[db][gq];
            const float a0 = (db ? O1[4 * gq + 0] : O0[4 * gq + 0]) * rs * gg.x, a1 = (db ? O1[4 * gq + 1] : O0[4 * gq + 1]) * rs * gg.y, a2 = (db ? O1[4 * gq + 2] : O0[4 * gq + 2]) * rs * gg.z, a3 = (db ? O1[4 * gq + 3] : O0[4 * gq + 3]) * rs * gg.w;
            op[gq][0] = pkbf(a0, a1); op[gq][1] = pkbf(a2, a3); }
#pragma unroll
        for (int gp = 0; gp < 2; ++gp) { const auto s0 = __builtin_amdgcn_permlane32_swap(op[2 * gp][0], op[2 * gp + 1][0], false, false), s1 = __builtin_amdgcn_permlane32_swap(op[2 * gp][1], op[2 * gp + 1][1], false, false);
            *(GAS v4u*)(orow + 32 * db + 8 * (2 * gp + hh)) = (v4u){s0[0], s1[0], s0[1], s1[1]}; } }
}
__device__ __forceinline__ void attn_phase(Frame& F) {
    const int r = F.lane & 31, hh = F.lane >> 5;
    float mq = fabsf(F.sb_q_g[F.lane]), mk = fabsf(F.sb_k_g[F.lane]);
#pragma unroll
    for (int o = 1; o < 64; o <<= 1) { mq = fmaxf(mq, __shfl_xor(mq, o)); mk = fmaxf(mk, __shfl_xor(mk, o)); }
    const float thr = 64.f * QSCALE * mq * mk * 1.02f + 151.f;
    bf16x8 Lt[2];
#pragma unroll
    for (int ks = 0; ks < 2; ++ks) { float e[8];
#pragma unroll
        for (int jj = 0; jj < 8; ++jj) e[jj] = (16 * ks + 8 * (jj >> 2) + 4 * hh + (jj & 3) >= r) ? 1.f : 0.f;
        Lt[ks] = pack8(e[0], e[1], e[2], e[3], e[4], e[5], e[6], e[7]); }
    for (int it = F.gw; it < 2048; it += F.ngw) { const int bh = it & 127, j = it >> 7;
        attn_item(F, bh, 63 - j, thr, Lt); attn_item(F, bh, j, thr, Lt); attn_item(F, bh, 47 - j, thr, Lt); attn_item(F, bh, 16 + j, thr, Lt); }
}

constexpr int HG_PART = 0, HG_SSQ = 2048, HG_QE = 4096, HG_KE = HG_QE + 64 * 272, HG_VT = HG_KE + 64 * 272, HG_KST = HG_VT + 128 * 144, HG_ST = HG_KST + 128 * 144, HG_END = HG_ST + 128 * 272;
static_assert(HG_END <= RING_BYTES, "HGRN2 LDS map");
__device__ __forceinline__ float hg_lbound(Frame& F, int h, int d) { const int c = h * 128 + d; return 1.f / (1.f + __expf(F.hg_lb[512 + c] - F.hg_lb[c])); }
__device__ __forceinline__ void hg_gates(Frame& F, const unsigned short (&ffr)[16], float lb, int d, int tq, float (&bb)[16], float (&kk)[16], float& total) {
    float run = 1.f;
#pragma unroll
    for (int i = 0; i < 16; ++i) { const float ff = bf2f(ffr[i]); const float sg = __builtin_amdgcn_rcpf(1.f + __expf(-ff));
        const float f = lb + (1.f - lb) * sg; kk[i] = (1.f - lb) * (1.f - sg); run *= f; bb[i] = run; }
    LAS float* part = (LAS float*)(F.lds + RING_OFF + HG_PART);
    part[tq * 128 + d] = run;
    __syncthreads();
    const float p0 = part[d], p1 = part[128 + d], p2 = part[256 + d], p3 = part[384 + d];
    const float off = (tq > 0 ? p0 : 1.f) * (tq > 1 ? p1 : 1.f) * (tq > 2 ? p2 : 1.f);
    total = (p0 * p1) * (p2 * p3);
#pragma unroll
    for (int i = 0; i < 16; ++i) bb[i] *= off;
}
#define HG_HV() const bf16* const PHp = (const bf16*)(F.ws + WS_PH); \
    const __amdgpu_buffer_rsrc_t rsrcP = __builtin_amdgcn_make_buffer_rsrc((void*)PHp, 0, (int)((size_t)4 * T * 512 * 2), 0x00020000)
#define HG_SOFF(item_, arr_) ((unsigned)((((arr_) * 16 + (((item_) >> 5) >> 2)) * 4 + (((item_) >> 5) & 3)) * SEQ + ((item_) & 31) * 64) * 256u)
#define HG_ARR(col_) ((col_) == OFF_HQ ? 0 : (col_) == OFF_HF ? 1 : (col_) == OFF_HI ? 2 : 3)
#define HG_LOADT(dst2, item_, arr_) do { const unsigned so_ = (unsigned)__builtin_amdgcn_readfirstlane((int)HG_SOFF(item_, arr_)); _Pragma("unroll") for (int j_ = 0; j_ < 2; ++j_) \
        (dst2)[j_] = __builtin_bit_cast(v4u, __builtin_amdgcn_raw_buffer_load_b128(rsrcP, (unsigned)F.tid * 16u + 8192u * j_, so_, 0)); } while (0)
#define HG_PUT(src2, raw_) do { _Pragma("unroll") for (int j_ = 0; j_ < 2; ++j_) *(LAS v4u*)((raw_) + ((F.tid >> 4) + 32 * j_) * 272 + (F.tid & 15) * 16) = (src2)[j_]; } while (0)
#define HG_COL(dst, raw_) do { _Pragma("unroll") for (int i_ = 0; i_ < 16; ++i_) dst[i_] = *(const LAS unsigned short*)((raw_) + (16 * tq + i_) * 272 + 2 * d); } while (0)
template <bool PERMUTE> __device__ __forceinline__ void st16(LAS unsigned char* dst, const float (&v)[16]) {
    v4u a, b2;
    if (!PERMUTE) { a.x = pkbf(v[0], v[1]); a.y = pkbf(v[2], v[3]); a.z = pkbf(v[4], v[5]); a.w = pkbf(v[6], v[7]); b2.x = pkbf(v[8], v[9]); b2.y = pkbf(v[10], v[11]); b2.z = pkbf(v[12], v[13]); b2.w = pkbf(v[14], v[15]); }
    else { a.x = pkbf(v[0], v[1]); a.y = pkbf(v[2], v[3]); a.z = pkbf(v[8], v[9]); a.w = pkbf(v[10], v[11]); b2.x = pkbf(v[4], v[5]); b2.y = pkbf(v[6], v[7]); b2.z = pkbf(v[12], v[13]); b2.w = pkbf(v[14], v[15]); }
    *(LAS v4u*)dst = a; *(LAS v4u*)(dst + 16) = b2;
}
__device__ __forceinline__ void hgA_phase(Frame& F) {
    const int d = F.tid & 127, tq = F.tid >> 7, r = F.lane & 31, hh = F.lane >> 5;
    const bf16* P = (const bf16*)(F.ws + WS_P); bf16* KVS = (bf16*)(F.ws + WS_KVS); float* DEC = (float*)(F.ws + WS_DEC); float* SSEG = (float*)(F.ws + WS_SSEG); float* DSEG = (float*)(F.ws + WS_DSEG);
    LAS unsigned char* L = F.lds + RING_OFF; LAS float* decl = (LAS float*)(L + HG_SSQ);
    HG_HV();
    v4u rf[2], rv[2];
    LAS unsigned char* const RAWF = F.lds + ROWTAB_OFF; LAS unsigned char* const RAWV = L + HG_ST;
    for (int wg = blockIdx.x; wg < 256; wg += F.G) {
        const int bh = wg >> 2, seg = wg & 3, item0 = bh * 32 + seg * 8, h = bh & 3;
        HG_LOADT(rf, item0, 1); HG_LOADT(rv, item0, 2);
        const float lbv = hg_lbound(F, h, d); float totrun = 1.f;
        const int db = F.wave & 3, eb0 = 2 * (F.wave >> 2);
        f32x16 run0, run1;
#pragma unroll
        for (int i = 0; i < 16; ++i) { run0[i] = 0.f; run1[i] = 0.f; }
      for (int k = 0; k < 8; ++k) {
        const int item = item0 + k;
        HG_PUT(rf, RAWF); HG_PUT(rv, RAWV);
        __syncthreads();
        { const int nit = k < 7 ? item + 1 : item; HG_LOADT(rf, nit, 1); HG_LOADT(rv, nit, 2); __builtin_amdgcn_sched_barrier(0); }
        unsigned short ffr[16], vr[16]; HG_COL(ffr, RAWF); HG_COL(vr, RAWV);
        float bb[16], kk[16], total; hg_gates(F, ffr, lbv, d, tq, bb, kk, total);
        float ks[16], vv[16];
#pragma unroll
        for (int i = 0; i < 16; ++i) { ks[i] = kk[i] * (total * __builtin_amdgcn_rcpf(bb[i])); vv[i] = bf2f(vr[i]); }
        st16<false>(L + HG_KST + d * 144 + tq * 32, ks); st16<false>(L + HG_VT + d * 144 + tq * 32, vv);
        const float dc = total; totrun *= total;
        if (tq == 0) { DEC[(size_t)item * 128 + d] = dc; decl[d] = dc; }
        __syncthreads();
        f32x16 acc0, acc1;
#pragma unroll
        for (int i = 0; i < 16; ++i) { acc0[i] = 0.f; acc1[i] = 0.f; }
#pragma unroll
        for (int s = 0; s < 4; ++s) { const bf16x8 af = *(const LAS bf16x8*)(L + HG_KST + (db * 32 + r) * 144 + 32 * s + 16 * hh);
            const bf16x8 b0 = *(const LAS bf16x8*)(L + HG_VT + (eb0 * 32 + r) * 144 + 32 * s + 16 * hh), b1 = *(const LAS bf16x8*)(L + HG_VT + ((eb0 + 1) * 32 + r) * 144 + 32 * s + 16 * hh);
            acc0 = MFMA32(af, b0, acc0); acc1 = MFMA32(af, b1, acc1); }
#pragma unroll
        for (int g = 0; g < 4; ++g) { const f32x4 dl = *(const LAS f32x4*)(decl + db * 32 + 8 * g + 4 * hh);
#pragma unroll
            for (int ii = 0; ii < 4; ++ii) { run0[4 * g + ii] = dl[ii] * run0[4 * g + ii] + acc0[4 * g + ii]; run1[4 * g + ii] = dl[ii] * run1[4 * g + ii] + acc1[4 * g + ii]; } }
#pragma unroll
        for (int j = 0; j < 2; ++j) { bf16* dst = KVS + ((size_t)item * 128 + (eb0 + j) * 32 + r) * 128 + db * 32;
#pragma unroll
            for (int gp = 0; gp < 2; ++gp) { unsigned pk[2][2];
#pragma unroll
                for (int q = 0; q < 2; ++q) { const int g = 2 * gp + q; const float a0 = j ? acc1[4 * g + 0] : acc0[4 * g + 0], a1 = j ? acc1[4 * g + 1] : acc0[4 * g + 1], a2 = j ? acc1[4 * g + 2] : acc0[4 * g + 2], a3 = j ? acc1[4 * g + 3] : acc0[4 * g + 3];
                    pk[q][0] = pkbf(a0, a1); pk[q][1] = pkbf(a2, a3); }
                const auto s0 = __builtin_amdgcn_permlane32_swap(pk[0][0], pk[1][0], false, false), s1 = __builtin_amdgcn_permlane32_swap(pk[0][1], pk[1][1], false, false);
                const v4u w4 = {s0[0], s1[0], s0[1], s1[1]};
                *(GAS v4u*)(dst + 8 * (2 * gp + hh)) = w4; } }
        __syncthreads();
      }
#pragma unroll
        for (int j = 0; j < 2; ++j) { float* dst = SSEG + ((size_t)wg * 128 + (eb0 + j) * 32 + r) * 128 + db * 32 + 4 * hh;
#pragma unroll
            for (int g = 0; g < 4; ++g) *(GAS f32x4*)(dst + 8 * g) = j ? (f32x4){run1[4 * g + 0], run1[4 * g + 1], run1[4 * g + 2], run1[4 * g + 3]} : (f32x4){run0[4 * g + 0], run0[4 * g + 1], run0[4 * g + 2], run0[4 * g + 3]}; }
        if (tq == 0) DSEG[(size_t)wg * 128 + d] = totrun;
    }
}
constexpr int HG_DECS = HG_END;
static_assert(HG_DECS + 4096 + 64 * 272 <= LDSCTL_OFF && HG_KST + 64 * 272 <= HG_ST && 64 * 272 <= MAXSLOT * 1536, "HGRN2 LDS map (decays, raw tiles)");
__device__ __forceinline__ void hgC_phase(Frame& F) {
    const int d = F.tid & 127, tq = F.tid >> 7, r = F.lane & 31, hh = F.lane >> 5;
    const bf16* P = (const bf16*)(F.ws + WS_P); const bf16* KVS = (const bf16*)(F.ws + WS_KVS); bf16* MIX = (bf16*)(F.ws + WS_MIX); const float* DEC = (const float*)(F.ws + WS_DEC);
    HG_HV();
    LAS unsigned char* L = F.lds + RING_OFF; const LAS float* decs = (const LAS float*)(L + HG_DECS);
    const int srow = (F.tid >> 6) * 16 + ((F.tid & 63) >> 4), sd0 = 8 * (F.tid & 15);
    v4u rf[2], rq[2], rv[2], st[4];
    LAS unsigned char* const RAWF = L + HG_KST; LAS unsigned char* const RAWQ = F.lds + ROWTAB_OFF; LAS unsigned char* const RAWV = L + HG_DECS + 4096;
    const __amdgpu_buffer_rsrc_t rsrcG = __builtin_amdgcn_make_buffer_rsrc((void*)F.hg_out_g, 0, 512 * 4, 0x00020000), rsrcSS = __builtin_amdgcn_make_buffer_rsrc((void*)(F.ws + WS_SSEG), 0, 256 * 128 * 128 * 4, 0x00020000), rsrcDS = __builtin_amdgcn_make_buffer_rsrc((void*)(F.ws + WS_DSEG), 0, 256 * 128 * 4, 0x00020000);
    const __amdgpu_buffer_rsrc_t rsrcD = __builtin_amdgcn_make_buffer_rsrc((void*)DEC, 0, 64 * 32 * 128 * 4, 0x00020000), rsrcM = __builtin_amdgcn_make_buffer_rsrc((void*)MIX, 0, (int)((size_t)T * D * 2), 0x00020000);
    const __amdgpu_buffer_rsrc_t rsrcK = __builtin_amdgcn_make_buffer_rsrc((void*)KVS, 0, 64 * 32 * 128 * 128 * 2, 0x00020000); const unsigned kvo = (unsigned)((srow * 128 + sd0) * 2);
#define HG_LOADKV(dst_, item_) do { const unsigned so_ = (unsigned)__builtin_amdgcn_readfirstlane((int)((item_) * (128 * 128 * 2))); _Pragma("unroll") for (int j_ = 0; j_ < 4; ++j_) (dst_)[j_] = __builtin_bit_cast(v4u, __builtin_amdgcn_raw_buffer_load_b128(rsrcK, kvo + 1024u * j_, so_, 0)); } while (0)
#define HG_LOADST(item_) HG_LOADKV(st, item_)
#define HG_FOLD(kv_, c_) do { const f32x4 d0_ = *(const LAS f32x4*)(decs + (c_) * 128 + sd0), d1_ = *(const LAS f32x4*)(decs + (c_) * 128 + sd0 + 4); _Pragma("unroll") for (int j_ = 0; j_ < 4; ++j_) { const v4u k_ = (kv_)[j_]; \
        S[8 * j_ + 0] = d0_.x * S[8 * j_ + 0] + bflo(k_.x); S[8 * j_ + 1] = d0_.y * S[8 * j_ + 1] + bfhi(k_.x); S[8 * j_ + 2] = d0_.z * S[8 * j_ + 2] + bflo(k_.y); S[8 * j_ + 3] = d0_.w * S[8 * j_ + 3] + bfhi(k_.y); \
        S[8 * j_ + 4] = d1_.x * S[8 * j_ + 4] + bflo(k_.z); S[8 * j_ + 5] = d1_.y * S[8 * j_ + 5] + bfhi(k_.z); S[8 * j_ + 6] = d1_.z * S[8 * j_ + 6] + bflo(k_.w); S[8 * j_ + 7] = d1_.w * S[8 * j_ + 7] + bfhi(k_.w); } } while (0)
    for (int wg = blockIdx.x; wg < 256; wg += F.G) {
        const int bh = wg >> 2, seg = wg & 3, item0 = bh * 32 + seg * 8, b = bh >> 2, h = bh & 3;
        HG_LOADT(rf, item0, 1); HG_LOADT(rq, item0, 0); HG_LOADT(rv, item0, 2); HG_LOADST(item0);
        const unsigned dso0 = (unsigned)__builtin_amdgcn_readfirstlane((bh * 32 + seg * 8) * 128 * 4);
        const f32x4 decv = __builtin_bit_cast(f32x4, __builtin_amdgcn_raw_buffer_load_b128(rsrcD, (unsigned)(F.tid & 255) * 16u, dso0, 0));
        const float lbv = hg_lbound(F, h, d);
        __builtin_amdgcn_sched_barrier(0);
        float S[32];
#pragma unroll
        for (int j = 0; j < 32; ++j) S[j] = 0.f;
        for (int sp = 0; sp < seg; ++sp) {
            const unsigned sso = (unsigned)__builtin_amdgcn_readfirstlane((bh * 4 + sp) * 128 * 128 * 4), dso = (unsigned)__builtin_amdgcn_readfirstlane((bh * 4 + sp) * 128 * 4);
#pragma unroll
            for (int j0 = 0; j0 < 8; j0 += 8) { f32x4 sv[8], dv[8];
#pragma unroll
                for (int j = 0; j < 8; ++j) { sv[j] = __builtin_bit_cast(f32x4, __builtin_amdgcn_raw_buffer_load_b128(rsrcSS, (unsigned)((srow * 128 + sd0) * 4) + 2048u * ((j0 + j) >> 1) + 16u * ((j0 + j) & 1), sso, 0));
                    dv[j] = __builtin_bit_cast(f32x4, __builtin_amdgcn_raw_buffer_load_b128(rsrcDS, (unsigned)(sd0 * 4) + 16u * ((j0 + j) & 1), dso, 0)); }
#pragma unroll
                for (int j = 0; j < 8; ++j) { const int q = 4 * (j0 + j); S[q + 0] = dv[j].x * S[q + 0] + sv[j].x; S[q + 1] = dv[j].y * S[q + 1] + sv[j].y; S[q + 2] = dv[j].z * S[q + 2] + sv[j].z; S[q + 3] = dv[j].w * S[q + 3] + sv[j].w; } }
        }
        if (F.tid < 256) *((LAS f32x4*)(L + HG_DECS) + F.tid) = decv;
        __syncthreads();
      for (int k = 0; k < 8; ++k) {
        const int item = item0 + k, c = seg * 8 + k;
        const int tb = F.wave & 1, eb = F.wave >> 1;
        const int nit = k < 7 ? item + 1 : item;
        HG_PUT(rf, RAWF); HG_PUT(rq, RAWQ); HG_PUT(rv, RAWV);
        __syncthreads();
        HG_LOADT(rf, nit, 1); HG_LOADT(rq, nit, 0); HG_LOADT(rv, nit, 2); __builtin_amdgcn_sched_barrier(0);
        unsigned short ffr[16], qr[16], vr[16]; HG_COL(ffr, RAWF); HG_COL(qr, RAWQ); HG_COL(vr, RAWV);
        float bb[16], kk[16], total; hg_gates(F, ffr, lbv, d, tq, bb, kk, total);
        float vv[16];
#pragma unroll
        for (int i = 0; i < 16; ++i) { const int t = 16 * tq + i; const float q = bf2f(qr[i]);
            *(LAS unsigned short*)(L + HG_QE + t * 272 + 2 * d) = (unsigned short)pkbf(q * bb[i], 0.f);
            *(LAS unsigned short*)(L + HG_KE + t * 272 + 2 * d) = (unsigned short)pkbf(kk[i] * __builtin_amdgcn_rcpf(bb[i]), 0.f);
            vv[i] = bf2f(vr[i]); }
        st16<true>(L + HG_VT + d * 144 + tq * 32, vv);
#pragma unroll
        for (int j = 0; j < 4; ++j) { v4u w4; w4.x = pkbf(S[8 * j + 0], S[8 * j + 1]); w4.y = pkbf(S[8 * j + 2], S[8 * j + 3]); w4.z = pkbf(S[8 * j + 4], S[8 * j + 5]); w4.w = pkbf(S[8 * j + 6], S[8 * j + 7]);
            *(LAS v4u*)(L + HG_ST + (srow + 4 * j) * 272 + sd0 * 2) = w4; }
        HG_FOLD(st, k);
        v4u grw[2];
        { const bf16* grow_ = PHp + (((size_t)(3 * 16 + b) * 4 + h) * SEQ + c * 64 + tb * 32 + r) * 128;
#pragma unroll
            for (int gp = 0; gp < 2; ++gp) grw[gp] = *(const GAS v4u*)(grow_ + eb * 32 + 8 * (2 * gp + hh)); }
        HG_LOADST(nit); __builtin_amdgcn_sched_barrier(0);
        __syncthreads();
        f32x16 acc;
#pragma unroll
        for (int i = 0; i < 16; ++i) acc[i] = 0.f;
#define HG_QF(s_) (*(const LAS bf16x8*)(L + HG_QE + (tb * 32 + r) * 272 + 32 * (s_) + 16 * hh))
#pragma unroll
        for (int s = 0; s < 8; ++s) acc = MFMA32(*(const LAS bf16x8*)(L + HG_ST + (eb * 32 + r) * 272 + 32 * s + 16 * hh), HG_QF(s), acc);
        for (int sb = 0; sb <= tb; ++sb) {
            f32x16 at;
#pragma unroll
            for (int i = 0; i < 16; ++i) at[i] = 0.f;
#pragma unroll
            for (int s = 0; s < 8; ++s) at = MFMA32(*(const LAS bf16x8*)(L + HG_KE + (sb * 32 + r) * 272 + 32 * s + 16 * hh), HG_QF(s), at);
            float a[16];
#pragma unroll
            for (int i = 0; i < 16; ++i) a[i] = (sb < tb || crow16(i, hh) <= r) ? at[i] : 0.f;
            const bf16x8 ab0 = pack8(a[0], a[1], a[2], a[3], a[4], a[5], a[6], a[7]), ab1 = pack8(a[8], a[9], a[10], a[11], a[12], a[13], a[14], a[15]);
            acc = MFMA32(*(const LAS bf16x8*)(L + HG_VT + (eb * 32 + r) * 144 + sb * 64 + 0 + 16 * hh), ab0, acc);
            acc = MFMA32(*(const LAS bf16x8*)(L + HG_VT + (eb * 32 + r) * 144 + sb * 64 + 32 + 16 * hh), ab1, acc);
        }
        float ss = 0.f;
#pragma unroll
        for (int i = 0; i < 16; ++i) ss += acc[i] * acc[i];
        ss += __shfl_xor(ss, 32);
        LAS float* ssq = (LAS float*)(L + HG_SSQ);
        if (hh == 0) ssq[eb * 64 + tb * 32 + r] = ss;
        f32x4 ggv[4];
        { const unsigned so = (unsigned)__builtin_amdgcn_readfirstlane(h * 512);
#pragma unroll
            for (int g = 0; g < 4; ++g) ggv[g] = __builtin_bit_cast(f32x4, __builtin_amdgcn_raw_buffer_load_b128(rsrcG, (unsigned)((eb * 32 + 8 * g + 4 * hh) * 4), so, 0)); }
        __syncthreads();
        const int tl = tb * 32 + r; const float tot = (ssq[tl] + ssq[64 + tl]) + (ssq[128 + tl] + ssq[192 + tl]);
        const float rs = 1.f / sqrtf(tot * (1.f / 128.f) + EPS);
        const unsigned mso = (unsigned)__builtin_amdgcn_readfirstlane((int)((((unsigned)b * SEQ + c * 64) * D + 512 + h * 128) * 2)), mvo = (unsigned)((tl * D + eb * 32) * 2);
        unsigned long long grv[4];
#pragma unroll
        for (int gp = 0; gp < 2; ++gp) { const auto sa = __builtin_amdgcn_permlane32_swap(grw[gp].x, grw[gp].z, false, false), sb = __builtin_amdgcn_permlane32_swap(grw[gp].y, grw[gp].w, false, false);
            grv[2 * gp] = (unsigned long long)sa[0] | ((unsigned long long)sb[0] << 32); grv[2 * gp + 1] = (unsigned long long)sa[1] | ((unsigned long long)sb[1] << 32); }
        unsigned yp[4][2];
#pragma unroll
        for (int g = 0; g < 4; ++g) { const unsigned long long gr = grv[g]; const f32x4 gg = ggv[g];
            const float g0 = bflo((unsigned)gr), g1 = bfhi((unsigned)gr), g2 = bflo((unsigned)(gr >> 32)), g3 = bfhi((unsigned)(gr >> 32));
            const float y0 = acc[4 * g + 0] * rs * gg.x * (g0 * __builtin_amdgcn_rcpf(1.f + __expf(-g0))), y1 = acc[4 * g + 1] * rs * gg.y * (g1 * __builtin_amdgcn_rcpf(1.f + __expf(-g1)));
            const float y2 = acc[4 * g + 2] * rs * gg.z * (g2 * __builtin_amdgcn_rcpf(1.f + __expf(-g2))), y3 = acc[4 * g + 3] * rs * gg.w * (g3 * __builtin_amdgcn_rcpf(1.f + __expf(-g3)));
            yp[g][0] = pkbf(y0, y1); yp[g][1] = pkbf(y2, y3); }
#pragma unroll
        for (int gp = 0; gp < 2; ++gp) { const auto s0 = __builtin_amdgcn_permlane32_swap(yp[2 * gp][0], yp[2 * gp + 1][0], false, false), s1 = __builtin_amdgcn_permlane32_swap(yp[2 * gp][1], yp[2 * gp + 1][1], false, false);
            __builtin_amdgcn_raw_buffer_store_b128((v4u){s0[0], s1[0], s0[1], s1[1]}, rsrcM, mvo + 16u * (2 * gp + hh), mso, 0); }
        __syncthreads();
      }
    }
#undef HG_LOADST
#undef HG_LOADKV
#undef HG_FOLD
#undef HG_QF
}
#undef HG_LOADT
#undef HG_PUT
#undef HG_COL
#undef HG_ARR
#undef HG_SOFF
#undef HG_HV

__device__ __forceinline__ void router_phase(Frame& F) {
    LAS unsigned char* L = F.lds; const int r = F.lane & 31, hh = F.lane >> 5;
    LAS unsigned* lcnt = (LAS unsigned*)(F.lds + LTAB_OFF) + LT_MISC; LAS unsigned* lbase = lcnt + 32; LAS float* lrstd = (LAS float*)(F.lds + ROWTAB_OFF);
    float* TOPG = (float*)(F.ws + WS_TOPG);
    {
        const GAS v4u* img = (const GAS v4u*)(F.ws + WS_RT) + vzero();
        constexpr int NB = (RT_END / 16 + NWAVES * 64 - 1) / (NWAVES * 64);
        v4u t4[NB];
#pragma unroll
        for (int j = 0; j < NB; ++j) { const int q = F.tid + j * NWAVES * 64; t4[j] = img[q < RT_END / 16 ? q : 0]; }
#pragma unroll
        for (int j = 0; j < NB; ++j) { const int q = F.tid + j * NWAVES * 64; if (q < RT_END / 16) *(LAS v4u*)(L + 16 * q) = t4[j]; }
    }
    const bf16* XH = (const bf16*)(F.ws + WS_XN); int* LIST = (int*)(F.ws + WS_LIST); unsigned* cnt = (unsigned*)(F.ctl + CW_CNT);
    for (int base = blockIdx.x * 4; base < T / 32; base += F.G * 4) {
        const int grp = base + F.wave; const bool active = F.wave < 4 && grp < T / 32;
        if (F.tid < 32) lcnt[F.tid] = 0u;
        __syncthreads();
        float sv[4] = {0.f, 0.f, 0.f, 0.f}; int se[4] = {0, 0, 0, 0}; unsigned lp0 = 0u, lp1 = 0u; float rstd = 0.f; const int tok = grp * 32 + r;
        if (active) {
            const bf16* hrow = XH + (size_t)tok * D + 8 * hh;
            f32x16 acc;
#pragma unroll
            for (int i = 0; i < 16; ++i) acc[i] = 0.f;
            float ssq = 0.f;
#pragma unroll 16
            for (int s = 0; s < 64; ++s) {
                const v4u hu = *(const GAS v4u*)(hrow + 16 * s); const bf16x8 hi = __builtin_bit_cast(bf16x8, hu);
                { const float a0 = bflo(hu.x), a1 = bfhi(hu.x), a2 = bflo(hu.y), a3 = bfhi(hu.y), a4 = bflo(hu.z), a5 = bfhi(hu.z), a6 = bflo(hu.w), a7 = bfhi(hu.w);
                    ssq += (a0 * a0 + a1 * a1) + (a2 * a2 + a3 * a3) + (a4 * a4 + a5 * a5) + (a6 * a6 + a7 * a7); }
                const bf16x8 wh = *(const LAS bf16x8*)(L + r * RT_ROW + 32 * s + 16 * hh), wl = *(const LAS bf16x8*)(L + RT_WL + r * RT_ROW + 32 * s + 16 * hh);
                acc = MFMA32(wh, hi, acc); acc = MFMA32(wl, hi, acc);
            }
            ssq += __shfl_xor(ssq, 32);
            rstd = 1.f / sqrtf(ssq * (1.f / D) + EPS);
            float l[16];
#pragma unroll
            for (int i = 0; i < 16; ++i) l[i] = acc[i] * rstd + F.b_router[crow16(i, hh)];
            float cv[8]; int ce[8];
#pragma unroll
            for (int rnd = 0; rnd < 4; ++rnd) { float bv = l[0]; int bi = 0;
#pragma unroll
                for (int i = 1; i < 16; ++i) if (l[i] > bv) { bv = l[i]; bi = i; }
                cv[rnd] = bv; ce[rnd] = crow16(bi, hh);
#pragma unroll
                for (int i = 0; i < 16; ++i) if (i == bi) l[i] = -__builtin_inff(); }
#pragma unroll
            for (int j = 0; j < 4; ++j) { cv[4 + j] = __shfl_xor(cv[j], 32); ce[4 + j] = __shfl_xor(ce[j], 32); }
#pragma unroll
            for (int rnd = 0; rnd < 4; ++rnd) { float bv = cv[0]; int be = ce[0]; int bj = 0;
#pragma unroll
                for (int j = 1; j < 8; ++j) if (cv[j] > bv || (cv[j] == bv && ce[j] < be)) { bv = cv[j]; be = ce[j]; bj = j; }
                sv[rnd] = bv; se[rnd] = be;
#pragma unroll
                for (int j = 0; j < 8; ++j) if (j == bj) { cv[j] = -__builtin_inff(); ce[j] = 64; } }
            lp0 = __hip_atomic_fetch_add(lcnt + (hh ? se[2] : se[0]), 1u, __ATOMIC_RELAXED, __HIP_MEMORY_SCOPE_WORKGROUP);
            lp1 = __hip_atomic_fetch_add(lcnt + (hh ? se[3] : se[1]), 1u, __ATOMIC_RELAXED, __HIP_MEMORY_SCOPE_WORKGROUP);
        }
        __syncthreads();
        if (F.tid < 32) lbase[F.tid] = __hip_atomic_fetch_add(cnt + F.tid, lcnt[F.tid], __ATOMIC_RELAXED, __HIP_MEMORY_SCOPE_AGENT);
        __syncthreads();
        if (active) {
            const float e1 = __expf(sv[1] - sv[0]), e2 = __expf(sv[2] - sv[0]), e3 = __expf(sv[3] - sv[0]); const float inv = 1.f / (1.f + e1 + e2 + e3);
            const int ea = hh ? se[2] : se[0], eb = hh ? se[3] : se[1]; const float ga = (hh ? e2 : 1.f) * inv, gb = (hh ? e3 : e1) * inv;
            const size_t ia = (size_t)ea * 32768 + lbase[ea] + lp0, ib = (size_t)eb * 32768 + lbase[eb] + lp1;
            LIST[ia] = tok * 4 + 2 * hh; LIST[ib] = tok * 4 + 2 * hh + 1; TOPG[tok * 4 + 2 * hh] = ga; TOPG[tok * 4 + 2 * hh + 1] = gb;
            if (hh == 0) lrstd[F.wave * 32 + r] = rstd;
        }
        __syncthreads();
        {
            unsigned char* X8 = F.ws + WS_X8; const int t0 = base * 32;
#pragma unroll
            for (int q0 = 0; q0 < 16; q0 += 4) { v4u a[4][2];
#pragma unroll
                for (int q = 0; q < 4; ++q) { const int tt = t0 + F.wave * 16 + q0 + q; const GAS v4u* p = (const GAS v4u*)(XH + (size_t)(tt < T ? tt : 0) * D) + 2 * F.lane; a[q][0] = p[0]; a[q][1] = p[1]; }
#pragma unroll
                for (int q = 0; q < 4; ++q) { const int tl = F.wave * 16 + q0 + q, tt = t0 + tl; if (tt < T) { const float rs = lrstd[tl]; v4u o;
                    o.x = pg8::pk4_fp8(bflo(a[q][0].x) * rs, bfhi(a[q][0].x) * rs, bflo(a[q][0].y) * rs, bfhi(a[q][0].y) * rs); o.y = pg8::pk4_fp8(bflo(a[q][0].z) * rs, bfhi(a[q][0].z) * rs, bflo(a[q][0].w) * rs, bfhi(a[q][0].w) * rs);
                    o.z = pg8::pk4_fp8(bflo(a[q][1].x) * rs, bfhi(a[q][1].x) * rs, bflo(a[q][1].y) * rs, bfhi(a[q][1].y) * rs); o.w = pg8::pk4_fp8(bflo(a[q][1].z) * rs, bfhi(a[q][1].z) * rs, bflo(a[q][1].w) * rs, bfhi(a[q][1].w) * rs);
                    *((GAS v4u*)(X8 + (size_t)tt * D) + F.lane) = o; } } }
        }
        __syncthreads();
    }
}
__device__ __forceinline__ int build_moe_tables(Frame& F, int ntn, int mode) {
    LAS int* lt = (LAS int*)(F.lds + LTAB_OFF);
    if (F.wave == 0) {
        const int e = F.lane & 31; const int c = (int)__hip_atomic_load((unsigned*)(F.ctl + CW_CNT) + e, __ATOMIC_RELAXED, __HIP_MEMORY_SCOPE_AGENT);
        const int tl = (c + 255) >> 8; int inc = tl;
#pragma unroll
        for (int off = 1; off < 32; off <<= 1) { const int o = __shfl_up(inc, off, 32); if (e >= off) inc += o; }
        const int tot = __shfl(inc, 31, 32), t0 = inc - tl;
        if (F.lane < 32) { lt[LT_TS + e] = t0; lt[LT_CNT + e] = c; for (int i = 0; i < tl; ++i) lt[t0 + i] = e; }
        if (F.lane == 0) lt[LT_MISC + 64] = tot;
    }
    __syncthreads();
    int nt = lt[LT_MISC + 64]; nt = nt < 0 ? 0 : (nt > MAXTILES ? MAXTILES : nt); nt = __builtin_amdgcn_readfirstlane(nt);
    const int* LIST = (const int*)(F.ws + WS_LIST);
    const int nslot = mode == 1 ? MAXSLOT : (MAXTILES * 4 + 255) / 256;
    for (int q = F.tid; q < nslot * 256; q += NWAVES * 64) { const int i = q >> 8, rr = q & 255; const int Lu = i * F.G + F.vcu;
        int li = -1; float bias = 0.f;
        if (Lu < nt * ntn) { const int pm0 = Lu / ntn, pl = Lu - pm0 * ntn, pm = mode == 2 ? nt - 1 - pm0 : pm0, e = lt[pm], idx = (pm - lt[LT_TS + e]) * 256 + rr; if (idx < lt[LT_CNT + e]) li = LIST[(size_t)e * 32768 + idx];
            bias = mode == 1 ? F.b_gu[(size_t)e * 2048 + (rr >> 7) * 1024 + pl * 128 + (rr & 127)] : F.b_d[(size_t)e * 1024 + pl * 256 + rr]; }
        ((LAS float*)(F.lds + ROWTAB_OFF))[q] = bias;
        if (mode == 1) ((LAS unsigned short*)(F.lds + ROWTAB2_OFF))[q] = (unsigned short)(li < 0 ? 0 : (li >> 2));
        else ((LAS int*)(F.lds + ROWTAB_OFF) + nslot * 256)[q] = li; }
    __syncthreads();
    return nt;
}
__device__ __forceinline__ void combine_phase(Frame& F) {
    const unsigned char* YK = F.ws + WS_YK; const bf16* XH = (const bf16*)(F.ws + WS_XN); const float* TOPG = (const float*)(F.ws + WS_TOPG);
    for (int t = F.gw; t < T; t += F.ngw) {
        GAS f32x4* xr = (GAS f32x4*)(F.out + (size_t)t * D) + F.lane; f32x4 v[4]; unsigned y[4][4]; const f32x4 gt = *((const GAS f32x4*)TOPG + t + vzero()) * (1.0f / Y8_SCALE);
#pragma unroll
        for (int j = 0; j < 4; ++j) { const unsigned long long xh = __builtin_nontemporal_load((const GAS unsigned long long*)(XH + (size_t)t * D) + F.lane + 64 * j);
            v[j] = (f32x4){bflo((unsigned)xh), bfhi((unsigned)xh), bflo((unsigned)(xh >> 32)), bfhi((unsigned)(xh >> 32))};
#pragma unroll
            for (int k = 0; k < 4; ++k) y[j][k] = __builtin_nontemporal_load((const GAS unsigned*)(YK + ((size_t)t * 4 + k) * D) + F.lane + 64 * j); }
#pragma unroll
        for (int j = 0; j < 4; ++j) { f32x4 s4 = {0.f, 0.f, 0.f, 0.f};
#pragma unroll
            for (int k = 0; k < 4; ++k) { const f32x2n_ lo = __builtin_amdgcn_cvt_pk_f32_fp8((int)y[j][k], false), hi = __builtin_amdgcn_cvt_pk_f32_fp8((int)y[j][k], true); const float g = gt[k]; s4.x += g * lo.x; s4.y += g * lo.y; s4.z += g * hi.x; s4.w += g * hi.y; }
            v[j] = v[j] + s4;
            __builtin_nontemporal_store(v[j], xr + 64 * j); }
    }
}

constexpr int NPH = 9;
struct Args { const float* in[16]; float* out; unsigned char* ws; int ph_lo, ph_hi; };
__global__ void __launch_bounds__(NWAVES * 64, 2) fwd(Args args) {
    extern __shared__ __attribute__((aligned(16))) unsigned char lds[];
    Frame F;
    F.lds = (LAS unsigned char*)lds;
    F.MISC = (volatile LAS unsigned*)(F.lds + MISC_OFF);
    F.tid = threadIdx.x; F.lane = F.tid & 63; F.wave = __builtin_amdgcn_readfirstlane(F.tid >> 6);
    F.G = gridDim.x; { const int bx = blockIdx.x; F.vcu = (F.G % 8 == 0) ? (bx % 8) * (F.G / 8) + bx / 8 : bx; }
    F.gw = blockIdx.x * NWAVES + F.wave; F.ngw = F.G * NWAVES;
    F.ws = args.ws; F.ctl = (gu32*)(args.ws + WS_CTL); F.out = args.out;
    F.x = args.in[0]; F.norm1_g = args.in[1]; F.w_in = args.in[2]; F.sb_q_g = args.in[3]; F.sb_k_g = args.in[4]; F.sb_out_g = args.in[5]; F.hg_lb = args.in[6]; F.hg_out_g = args.in[7];
    F.w_out = args.in[8]; F.norm2_g = args.in[9]; F.w_router = args.in[10]; F.b_router = args.in[11]; F.w_gu = args.in[12]; F.b_gu = args.in[13]; F.w_d = args.in[14]; F.b_d = args.in[15];
    for (int u = F.tid; u < (LDS_BYTES - LDSCTL_OFF) / 4; u += NWAVES * 64) ((LAS unsigned*)(F.lds + LDSCTL_OFF))[u] = 0u;
    __syncthreads();
    XcdBarrier bar; bar.bar = (unsigned*)(F.ctl + CW_BAR); bar.x = 0; bar.st = nullptr;
    if (MK_ONE_LAUNCH) bar = xcd_barrier_post((unsigned*)(F.ctl + CW_BAR), F.MISC + 8);
    const int lo = args.ph_lo, hi = args.ph_hi;
#define IN(k) (lo <= (k) && (k) < hi && ((F.lane = lane_id()), (F.tid = F.wave * 64 + F.lane), true))
#define SEAM(k) do { if (IN(k) && IN((k) + 1)) xcd_barrier(bar); } while (0)

    if (IN(0)) { p0_prologue(F); } SEAM(0);
    if (IN(1)) {
        pg8::Gemm g{(const bf16*)(F.ws + WS_XN), (const bf16*)(F.ws + WS_WIN), T, NIN, D}; pg8::StaticOrder S; S.init(T, NIN, F.G, (int)blockIdx.x);
        pg8::EpiInproj E{(bf16*)(F.ws + WS_P), (bf16*)(F.ws + WS_PH), (bf16*)(F.ws + WS_QN), (bf16*)(F.ws + WS_KN), F.sb_q_g, F.sb_k_g, QSCALE, EPS};
        pg8::gemm_phase<pg8::EpiInproj, pg8::StaticOrder, PG8_ALIGN, PG8_SP2>(F.lds + RING_OFF, g, S, E, F.tid);
    } SEAM(1);
    if (IN(2)) { prep_phase(F); __syncthreads(); hgA_phase(F); } SEAM(2);
    if (IN(3)) { attn_phase(F); hgC_phase(F); } SEAM(3);
    if (IN(4)) {
        pg8::Gemm g{(const bf16*)(F.ws + WS_MIX), (const bf16*)(F.ws + WS_WOUT), T, D, D}; pg8::StaticOrder S; S.init(T, D, F.G, (int)blockIdx.x);
        pg8::EpiRes E{F.x, (bf16*)(F.ws + WS_XN), D};
        pg8::gemm_phase<pg8::EpiRes, pg8::StaticOrder, PG8_ALIGN, PG8_SP2>(F.lds + RING_OFF, g, S, E, F.tid);
    } SEAM(4);
    if (IN(5)) { router_phase(F); } SEAM(5);
    if (IN(6)) {
        const int nt = build_moe_tables(F, 8, 1); const LAS int* lt = (const LAS int*)(F.lds + LTAB_OFF);
        pg8::Gemm g{(const bf16*)(F.ws + WS_X8), (const bf16*)(F.ws + WS_WGU), MAXROWS, NE * 2048, D / 2};
        pg8::MoeOrder S{lt, (const LAS unsigned short*)(F.lds + ROWTAB2_OFF), 8, nt * 8, F.G, F.vcu, 1024u, 0};
        pg8::EpiAct<true> E{F.ws + WS_ACT, (const LAS float*)(F.lds + ROWTAB_OFF), A8_SCALE};
        pg8::gemm_phase<pg8::EpiAct<true>, pg8::MoeOrder, PG8_ALIGN, PG8_SP2, true, SC_W8, SC_ONE>(F.lds + RING_OFF, g, S, E, F.tid);
        {
            const int rem = (nt * 8) % F.G, nidle = F.G - rem; const bool few = rem == 0 || nidle < F.G / 4;
            __syncthreads();
            if (few) p0_items(F, P0_NITEMS - P0_NLATE, P0_NITEMS, F.vcu * NWAVES + F.wave, F.G * NWAVES);
            else if (F.vcu >= rem) p0_items(F, P0_NITEMS - P0_NLATE, P0_NITEMS, (F.vcu - rem) * NWAVES + F.wave, nidle * NWAVES);
        }
    } SEAM(6);
    if (IN(7)) {
        const int nt = build_moe_tables(F, 4, 2); const LAS int* lt = (const LAS int*)(F.lds + LTAB_OFF);
        pg8::Gemm g{(const bf16*)(F.ws + WS_ACT), (const bf16*)(F.ws + WS_WD), MAXROWS, NE * 1024, D / 2};
        pg8::MoeOrder S{lt, nullptr, 4, nt * 4, F.G, F.vcu, 1024u, nt};
        pg8::EpiDown E{F.ws + WS_YK, (const LAS int*)(F.lds + ROWTAB_OFF) + ((MAXTILES * 4 + 255) / 256) * 256, (const LAS float*)(F.lds + ROWTAB_OFF), Y8_SCALE};
        pg8::gemm_phase<pg8::EpiDown, pg8::MoeOrder, PG8_ALIGN, PG8_SP2, true, SC_W8Y, SC_A8>(F.lds + RING_OFF, g, S, E, F.tid);
    } SEAM(7);
    if (IN(8)) { combine_phase(F); }
#undef IN
#undef SEAM
}

extern "C" void kernel_launch(void* const* d_in, const int* in_sizes, int n_in, void* d_out, int out_size, void* d_ws, size_t ws_size, hipStream_t stream) {
    static int grid = 0;
    if (grid == 0) {
        if (n_in != 16 || in_sizes[0] != T * D || out_size != T * D || ws_size < WS_END) { fprintf(stderr, "kernel_launch: shape/workspace mismatch (n_in %d, ws %zu, need %zu); nothing launched\n", n_in, ws_size, (size_t)WS_END); grid = -1; return; }
        int dev = 0, cus = 0, per_cu = 0;
        if (hipGetDevice(&dev) != hipSuccess || hipDeviceGetAttribute(&cus, hipDeviceAttributeMultiprocessorCount, dev) != hipSuccess) { grid = -1; return; }
        if (hipFuncSetAttribute((const void*)fwd, hipFuncAttributeMaxDynamicSharedMemorySize, LDS_BYTES) != hipSuccess) { grid = -1; return; }
        if (hipOccupancyMaxActiveBlocksPerMultiprocessor(&per_cu, (const void*)fwd, NWAVES * 64, LDS_BYTES) != hipSuccess || per_cu < 1) { fprintf(stderr, "kernel_launch: occupancy query says %d\n", per_cu); }
        (void)hipGetLastError();
        if ((MAXTILES * 8 + cus - 1) / cus > MAXSLOT || cus < 1) { fprintf(stderr, "kernel_launch: %d CUs: the per-workgroup unit tables are sized for 256\n", cus); grid = -1; return; }
        grid = cus;
    }
    if (grid < 0) return;
    if (hipMemsetAsync((char*)d_ws + WS_CTL, 0, CTL_ZERO_BYTES, stream) != hipSuccess) return;
    Args a{};
    for (int i = 0; i < 16; ++i) a.in[i] = (const float*)d_in[i];
    a.out = (float*)d_out; a.ws = (unsigned char*)d_ws;
#if MK_ONE_LAUNCH
    a.ph_lo = 0; a.ph_hi = NPH;
    hipLaunchKernelGGL(fwd, dim3(grid), dim3(NWAVES * 64), LDS_BYTES, stream, a);
#else
    for (int p = 0; p < NPH; ++p) { a.ph_lo = p; a.ph_hi = p + 1; hipLaunchKernelGGL(fwd, dim3(grid), dim3(NWAVES * 64), LDS_BYTES, stream, a); }
#endif
}
```

```cpp
#include <hip/hip_runtime.h>
#include <cstdio>
#include <cstdint>
namespace pg8 {
#define PG8_LAS __attribute__((address_space(3)))
typedef unsigned short bf16_t;
typedef short bf16x8 __attribute__((ext_vector_type(8)));
typedef float f32x4 __attribute__((ext_vector_type(4)));
typedef unsigned u32x4 __attribute__((ext_vector_type(4)));
typedef int i32x4_t __attribute__((ext_vector_type(4)));
typedef int i32x8_t __attribute__((ext_vector_type(8)));
constexpr int BM = 256, BK = 64, HALF = 128, HTB = HALF * BK * 2  , STAGE_BYTES = 8 * HTB, NXCD = 8, WGM = 8;

__host__ __device__ __forceinline__ int lds_byte(int r, int c) { const int st = (r >> 4) * 2 + (c >> 5), rr = r & 15, cc = c & 31, ob = rr * 64 + cc * 2; return st * 1024 + (ob ^ (((ob >> 9) & 1) << 5)); }
__host__ __device__ __forceinline__ void stage_rc(int b, int& R, int& C) { const int st = b / 1024, sb = b % 1024, swz = sb ^ (((sb >> 9) & 1) << 5); R = (st >> 1) * 16 + swz / 64; C = (st & 1) * 32 + (swz % 64) / 2; }
__host__ __device__ __forceinline__ int perm32(int rho) { const int n = rho >> 4, i = rho & 15; return 8 * (i >> 2) + 4 * n + (i & 3); }

struct Unit { int pm, pn, slot; };
struct Gemm { const bf16_t* A; const bf16_t* Bt; int M, N, K; };

struct StaticOrder {
    int nM, nN, nwg, G, c;
    __host__ __device__ void init(int M, int N, int G_, int c_) { nM = M / BM; nN = N / BM; nwg = nM * nN; G = G_; c = c_; }
    __host__ __device__ bool next(int i, Unit& u) const {
        const long L = (long)i * G + c; if (L >= nwg) return false;
        int wgid = (int)L; { const int q = nwg / NXCD, r = nwg % NXCD, xcd = wgid % NXCD, off = wgid / NXCD; wgid = (xcd < r ? xcd * (q + 1) : r * (q + 1) + (xcd - r) * q) + off; }
        const int nig = WGM * nN, gid = wgid / nig, fm = gid * WGM, gsz = (nM - fm) < WGM ? (nM - fm) : WGM;
        u.pm = fm + ((wgid % nig) % gsz); u.pn = (wgid % nig) / gsz; return true;
    }
    __device__ __forceinline__ void a_ready(const Unit&) const {}
    __device__ __forceinline__ void done(const Unit&) const {}
};

__device__ __forceinline__ unsigned cvt_pk_bf16(float lo, float hi) { unsigned r; asm volatile("v_cvt_pk_bf16_f32 %0, %1, %2" : "=v"(r) : "v"(lo), "v"(hi)); return r; }
typedef float f32x2 __attribute__((ext_vector_type(2)));
__device__ __forceinline__ f32x2 gelu_pk(f32x2 v) {
    const f32x2 av = __builtin_elementwise_abs(v), d = av * 0.2316418882f + 1.0f;
    f32x2 t; t.x = __builtin_amdgcn_rcpf(d.x); t.y = __builtin_amdgcn_rcpf(d.y);
    f32x2 q = t * 0.5307027145f + (-0.7265760135f); q = q * t + 0.7107068705f; q = q * t + (-0.142248368f); q = q * t + 0.127414796f; q = q * t;
    const f32x2 s = (v * v) * (-0.72134752044f);
    f32x2 e; e.x = __builtin_amdgcn_exp2f(s.x); e.y = __builtin_amdgcn_exp2f(s.y);
    const f32x2 m = v * (q * e), r = v - m;
    f32x2 o; o.x = v.x < 0.f ? m.x : r.x; o.y = v.y < 0.f ? m.y : r.y; return o;
}

template <int ACT  > struct EpiBf16 {
    static constexpr bool PERM = true, AFTER_DRAIN = false, HAS_INIT = false, INIT_LOADS = false; static_assert(ACT == 0 || ACT == 1, "EpiBf16: ACT is 0 (none) or 1 (gelu_pk)");
    bf16_t* O; int ldc; const float* bias; int split_cols; size_t split_stride; float scale0;
    __device__ __forceinline__ void operator()(const f32x4 (&acc)[2][2][4][2], const Unit& u, int wr, int wc, int fr, int fq) const {
        const int row0 = u.pm * BM + wr * 64 + fr; int colt = u.pn * BM; bf16_t* base = O;
        float sc = 1.f; if (split_cols) { const int t = colt / split_cols; base += (size_t)t * split_stride; colt -= t * split_cols; if (t == 0) sc = scale0; }
        const int col0 = colt + wc * 32 + 8 * fq, bcol0 = u.pn * BM + wc * 32 + 8 * fq;
        f32x4 bv[2][2];
#pragma unroll
        for (int bj = 0; bj < 2; ++bj)
#pragma unroll
            for (int n = 0; n < 2; ++n) bv[bj][n] = bias ? *(const f32x4*)(bias + bcol0 + bj * HALF + 4 * n) : (f32x4){0.f, 0.f, 0.f, 0.f};
#pragma unroll
        for (int ai = 0; ai < 2; ++ai)
#pragma unroll
            for (int m = 0; m < 4; ++m) { bf16_t* rowp = base + (size_t)(row0 + ai * HALF + m * 16) * ldc + col0;
#pragma unroll
                for (int bj = 0; bj < 2; ++bj) { f32x4 v0 = acc[ai][bj][m][0] + bv[bj][0], v1 = acc[ai][bj][m][1] + bv[bj][1];
                    if (ACT == 1) { f32x2 a = gelu_pk((f32x2){v0[0], v0[1]}), b = gelu_pk((f32x2){v0[2], v0[3]}), c = gelu_pk((f32x2){v1[0], v1[1]}), d = gelu_pk((f32x2){v1[2], v1[3]});
                        v0 = (f32x4){a.x, a.y, b.x, b.y}; v1 = (f32x4){c.x, c.y, d.x, d.y}; }
                    v0 = v0 * sc; v1 = v1 * sc; u32x4 w; w.x = cvt_pk_bf16(v0[0], v0[1]); w.y = cvt_pk_bf16(v0[2], v0[3]); w.z = cvt_pk_bf16(v1[0], v1[1]); w.w = cvt_pk_bf16(v1[2], v1[3]);
                    *(u32x4*)(rowp + bj * HALF) = w; } }
    }
};

__device__ __forceinline__ unsigned pk4_fp8(float a, float b, float c, float d) {
    a = fminf(fmaxf(a, -448.f), 448.f); b = fminf(fmaxf(b, -448.f), 448.f); c = fminf(fmaxf(c, -448.f), 448.f); d = fminf(fmaxf(d, -448.f), 448.f);
    int p = 0; p = __builtin_amdgcn_cvt_pk_fp8_f32(a, b, p, false); p = __builtin_amdgcn_cvt_pk_fp8_f32(c, d, p, true); return (unsigned)p;
}
struct EpiRes {
    static constexpr bool PERM = true, AFTER_DRAIN = false, HAS_INIT = true, INIT_LOADS = true;
    const float* __restrict__ X; bf16_t* __restrict__ XH; int ldc;
    __device__ __forceinline__ void init(f32x4 (&acc)[2][2][4][2], const Unit& u, int wr, int wc, int fr, int fq) const {
        const int row0 = u.pm * BM + wr * 64 + fr, col0 = u.pn * BM + wc * 64 + 8 * fq;
#pragma unroll
        for (int ai = 0; ai < 2; ++ai)
#pragma unroll
            for (int m = 0; m < 4; ++m) { const float* rp = X + (size_t)(row0 + ai * HALF + m * 16) * ldc + col0;
#pragma unroll
                for (int bj = 0; bj < 2; ++bj)
#pragma unroll
                    for (int n = 0; n < 2; ++n) acc[ai][bj][m][n] = __builtin_nontemporal_load((const f32x4*)(rp + bj * 32 + n * 4)); }
    }
    __device__ __forceinline__ void operator()(const f32x4 (&acc)[2][2][4][2], const Unit& u, int wr, int wc, int fr, int fq) const {
        const bool odd = fr & 1; const int rowE0 = u.pm * BM + wr * 64 + (fr & ~1), col0 = u.pn * BM + wc * 64 + 8 * fq + (odd ? 32 : 0);
#pragma unroll
        for (int ai = 0; ai < 2; ++ai)
#pragma unroll
            for (int m = 0; m < 4; ++m) { bf16_t* rp = XH + (size_t)(rowE0 + ai * HALF + m * 16) * ldc + col0; u32x4 w[2];
#pragma unroll
                for (int bj = 0; bj < 2; ++bj) { const f32x4 v0 = acc[ai][bj][m][0], v1 = acc[ai][bj][m][1];
                    w[bj].x = cvt_pk_bf16(v0[0], v0[1]); w[bj].y = cvt_pk_bf16(v0[2], v0[3]); w[bj].z = cvt_pk_bf16(v1[0], v1[1]); w[bj].w = cvt_pk_bf16(v1[2], v1[3]); }
                const u32x4 snd = odd ? w[0] : w[1]; u32x4 rcv;
                rcv.x = (unsigned)__builtin_amdgcn_mov_dpp((int)snd.x, 0xB1, 0xF, 0xF, true); rcv.y = (unsigned)__builtin_amdgcn_mov_dpp((int)snd.y, 0xB1, 0xF, 0xF, true);
                rcv.z = (unsigned)__builtin_amdgcn_mov_dpp((int)snd.z, 0xB1, 0xF, 0xF, true); rcv.w = (unsigned)__builtin_amdgcn_mov_dpp((int)snd.w, 0xB1, 0xF, 0xF, true);
                *(u32x4*)rp = odd ? rcv : w[0];
                *(u32x4*)(rp + ldc) = odd ? w[1] : rcv; }
    }
};
struct EpiInproj {
    static constexpr bool PERM = true, AFTER_DRAIN = false, HAS_INIT = false, INIT_LOADS = false;
    bf16_t* PA; bf16_t* PH; bf16_t* QN; bf16_t* KN; const float* gq; const float* gk; float qscale, eps;
    __device__ __forceinline__ void operator()(const f32x4 (&acc)[2][2][4][2], const Unit& u, int wr, int wc, int fr, int fq) const {
        if (u.pn < 4) {
            const int arr = u.pn >> 1, hd = (u.pn & 1) * 4 + wc; const float* g = arr ? gk : gq; const float gs = arr ? 1.f : qscale; bf16_t* dst = arr ? KN : QN;
            f32x4 gv[2][2];
#pragma unroll
            for (int bj = 0; bj < 2; ++bj)
#pragma unroll
                for (int n = 0; n < 2; ++n) gv[bj][n] = *(const f32x4*)(g + 32 * bj + 8 * fq + 4 * n) * gs;
#pragma unroll
            for (int ai = 0; ai < 2; ++ai)
#pragma unroll
                for (int m = 0; m < 4; ++m) { float ss = 0.f;
#pragma unroll
                    for (int bj = 0; bj < 2; ++bj)
#pragma unroll
                        for (int n = 0; n < 2; ++n) { const f32x4 a = acc[ai][bj][m][n]; ss += (a[0] * a[0] + a[1] * a[1]) + (a[2] * a[2] + a[3] * a[3]); }
                    ss += __shfl_xor(ss, 16); ss += __shfl_xor(ss, 32);
                    const float rs = 1.f / sqrtf(ss * (1.f / 64.f) + eps);
                    const int row = u.pm * BM + ai * HALF + wr * 64 + m * 16 + fr, b = row >> 11, s = row & 2047;
                    bf16_t* rp = dst + ((size_t)((b * 8 + hd) * 64 + (s >> 5))) * 2048 + (s & 31) * 8;
#pragma unroll
                    for (int bj = 0; bj < 2; ++bj) { const int c8 = 4 * bj + fq; const f32x4 v0 = acc[ai][bj][m][0] * rs * gv[bj][0], v1 = acc[ai][bj][m][1] * rs * gv[bj][1];
                        u32x4 w; w.x = cvt_pk_bf16(v0[0], v0[1]); w.y = cvt_pk_bf16(v0[2], v0[3]); w.z = cvt_pk_bf16(v1[0], v1[1]); w.w = cvt_pk_bf16(v1[2], v1[3]);
                        *(u32x4*)(rp + (c8 >> 1) * 512 + (c8 & 1) * 256) = w; } }
            return;
        }
        const int colw = u.pn * BM + wc * 64; bf16_t* base; int rowlen;
        if (colw < 1536) { const int arr = colw >> 9, hd = (colw & 511) >> 6; base = PA + ((size_t)(arr * 16) * 8 + hd) * 2048 * 64; rowlen = 64; }
        else { const int c2 = colw - 1536, arr = c2 >> 9, hd = (c2 & 511) >> 7, dd = c2 & 127; base = PH + ((size_t)(arr * 16) * 4 + hd) * 2048 * 128 + dd; rowlen = 128; }
        const size_t bstride = (size_t)(rowlen == 64 ? 8 : 4) * 2048 * rowlen;
        const bool odd = fr & 1; base += (odd ? 32 : 0) + 8 * fq;
#pragma unroll
        for (int ai = 0; ai < 2; ++ai)
#pragma unroll
            for (int m = 0; m < 4; ++m) { const int rowE = u.pm * BM + ai * HALF + wr * 64 + m * 16 + (fr & ~1), b = rowE >> 11, s = rowE & 2047;
                u32x4 w[2];
#pragma unroll
                for (int bj = 0; bj < 2; ++bj) { const f32x4 v0 = acc[ai][bj][m][0], v1 = acc[ai][bj][m][1];
                    w[bj].x = cvt_pk_bf16(v0[0], v0[1]); w[bj].y = cvt_pk_bf16(v0[2], v0[3]); w[bj].z = cvt_pk_bf16(v1[0], v1[1]); w[bj].w = cvt_pk_bf16(v1[2], v1[3]); }
                const u32x4 snd = odd ? w[0] : w[1]; u32x4 rcv;
                rcv.x = (unsigned)__builtin_amdgcn_mov_dpp((int)snd.x, 0xB1, 0xF, 0xF, true); rcv.y = (unsigned)__builtin_amdgcn_mov_dpp((int)snd.y, 0xB1, 0xF, 0xF, true);
                rcv.z = (unsigned)__builtin_amdgcn_mov_dpp((int)snd.z, 0xB1, 0xF, 0xF, true); rcv.w = (unsigned)__builtin_amdgcn_mov_dpp((int)snd.w, 0xB1, 0xF, 0xF, true);
                bf16_t* rp = base + (size_t)b * bstride + (size_t)s * rowlen;
                *(u32x4*)rp = odd ? rcv : w[0];
                *(u32x4*)(rp + rowlen) = odd ? w[1] : rcv; }
    }
};
struct MoeOrder {
    const PG8_LAS int* tile_e; const PG8_LAS unsigned short* rowtab; int ntn, nunits, G, c; unsigned rowbytes; int rev;
    __device__ __forceinline__ bool next(int i, Unit& u) const {
        const int L = i * G + c; if (L >= nunits) return false;
        const int pm0 = L / ntn, pl = L - pm0 * ntn, pm = rev ? rev - 1 - pm0 : pm0; u.pm = pm; u.pn = tile_e[pm] * ntn + pl; u.slot = i; return true;
    }
    __device__ __forceinline__ unsigned rowoff(const Unit& u, int r) const { return (rowtab ? (unsigned)rowtab[u.slot * 256 + r] : (unsigned)(u.pm * 256 + r)) * rowbytes; }
    __device__ __forceinline__ void a_ready(const Unit&) const {}
    __device__ __forceinline__ void done(const Unit&) const {}
};
template <bool OUT8> struct EpiAct {
    static constexpr bool PERM = true, AFTER_DRAIN = false, HAS_INIT = true, INIT_LOADS = false;
    unsigned char* ACT; const PG8_LAS float* biastab; float oscale;
    __device__ __forceinline__ void init(f32x4 (&acc)[2][2][4][2], const Unit& u, int wr, int wc, int fr, int fq) const {
#pragma unroll
        for (int n = 0; n < 2; ++n) { const f32x4 bg = *(const PG8_LAS f32x4*)(biastab + u.slot * 256 + wc * 32 + 8 * fq + 4 * n), bu = *(const PG8_LAS f32x4*)(biastab + u.slot * 256 + 128 + wc * 32 + 8 * fq + 4 * n);
#pragma unroll
            for (int ai = 0; ai < 2; ++ai)
#pragma unroll
                for (int m = 0; m < 4; ++m) { acc[ai][0][m][n] = bg; acc[ai][1][m][n] = bu; } }
    }
    __device__ __forceinline__ void operator()(const f32x4 (&acc)[2][2][4][2], const Unit& u, int wr, int wc, int fr, int fq) const {
        const int pl = u.pn & 7; const int row0 = u.pm * BM + wr * 64 + fr, acol0 = pl * 128 + wc * 32 + 8 * fq;
#pragma unroll
        for (int ai = 0; ai < 2; ++ai)
#pragma unroll
            for (int m = 0; m < 4; ++m) { unsigned char* rowp = ACT + (size_t)(row0 + ai * HALF + m * 16) * 1024 + acol0; f32x4 a4[2];
#pragma unroll
                for (int n = 0; n < 2; ++n) { const f32x4 g4 = acc[ai][0][m][n], u4 = acc[ai][1][m][n]; f32x4 gl, ul, ex;
#pragma unroll
                    for (int j = 0; j < 4; ++j) { gl[j] = fminf(g4[j], 7.0f); ul[j] = __builtin_amdgcn_fmed3f(u4[j], -7.0f, 7.0f); }
                    const f32x4 t4 = gl * (-1.702f * 1.44269504089f);
#pragma unroll
                    for (int j = 0; j < 4; ++j) ex[j] = __builtin_amdgcn_exp2f(t4[j]);
                    const f32x4 d4 = ex + 1.0f; f32x4 s4;
#pragma unroll
                    for (int j = 0; j < 4; ++j) s4[j] = __builtin_amdgcn_rcpf(d4[j]);
                    a4[n] = (gl * s4) * (ul * oscale + oscale); }
                if constexpr (OUT8) { int p0 = 0, p1 = 0; p0 = __builtin_amdgcn_cvt_pk_fp8_f32(a4[0][0], a4[0][1], p0, false); p0 = __builtin_amdgcn_cvt_pk_fp8_f32(a4[0][2], a4[0][3], p0, true);
                    p1 = __builtin_amdgcn_cvt_pk_fp8_f32(a4[1][0], a4[1][1], p1, false); p1 = __builtin_amdgcn_cvt_pk_fp8_f32(a4[1][2], a4[1][3], p1, true);
                    *(unsigned long long*)rowp = (unsigned long long)(unsigned)p0 | ((unsigned long long)(unsigned)p1 << 32); }
                else { u32x4 w; w.x = cvt_pk_bf16(a4[0][0], a4[0][1]); w.y = cvt_pk_bf16(a4[0][2], a4[0][3]); w.z = cvt_pk_bf16(a4[1][0], a4[1][1]); w.w = cvt_pk_bf16(a4[1][2], a4[1][3]); *(u32x4*)(rowp + (size_t)(row0 + ai * HALF + m * 16) * 1024 + acol0) = w; } }
    }
};
struct EpiDown {
    static constexpr bool PERM = true, AFTER_DRAIN = false, HAS_INIT = true, INIT_LOADS = false;
    unsigned char* YK; const PG8_LAS int* tktab; const PG8_LAS float* biastab; float oscale;
    __device__ __forceinline__ void init(f32x4 (&acc)[2][2][4][2], const Unit& u, int wr, int wc, int fr, int fq) const {
#pragma unroll
        for (int bj = 0; bj < 2; ++bj)
#pragma unroll
            for (int n = 0; n < 2; ++n) { const f32x4 bv = *(const PG8_LAS f32x4*)(biastab + u.slot * 256 + 64 * wc + 16 * fq + 8 * bj + 4 * n) * oscale;
#pragma unroll
                for (int ai = 0; ai < 2; ++ai)
#pragma unroll
                    for (int m = 0; m < 4; ++m) acc[ai][bj][m][n] = bv; }
    }
    __device__ __forceinline__ void operator()(const f32x4 (&acc)[2][2][4][2], const Unit& u, int wr, int wc, int fr, int fq) const {
        const int pl = u.pn & 3; const int col0 = pl * BM + 64 * wc + 16 * fq;
#pragma unroll
        for (int ai = 0; ai < 2; ++ai)
#pragma unroll
            for (int m = 0; m < 4; ++m) { const int tk = tktab[u.slot * 256 + ai * HALF + wr * 64 + m * 16 + fr];
                if (tk >= 0) { unsigned char* rowp = YK + (size_t)tk * 1024 + col0; int p[4];
#pragma unroll
                    for (int bj = 0; bj < 2; ++bj) { f32x4 v0 = acc[ai][bj][m][0], v1 = acc[ai][bj][m][1];
#pragma unroll
                        for (int j = 0; j < 4; ++j) { v0[j] = __builtin_amdgcn_fmed3f(v0[j], -448.f, 448.f); v1[j] = __builtin_amdgcn_fmed3f(v1[j], -448.f, 448.f); }
                        int p0 = 0, p1 = 0; p0 = __builtin_amdgcn_cvt_pk_fp8_f32(v0[0], v0[1], p0, false); p0 = __builtin_amdgcn_cvt_pk_fp8_f32(v0[2], v0[3], p0, true);
                        p1 = __builtin_amdgcn_cvt_pk_fp8_f32(v1[0], v1[1], p1, false); p1 = __builtin_amdgcn_cvt_pk_fp8_f32(v1[2], v1[3], p1, true);
                        p[2 * bj] = p0; p[2 * bj + 1] = p1; }
                    u32x4 w; w.x = (unsigned)p[0]; w.y = (unsigned)p[1]; w.z = (unsigned)p[2]; w.w = (unsigned)p[3];
                    *(u32x4*)rowp = w; } }
    }
};

template <class Epi, class Sched, bool ALIGN_EPI = false, bool SP2 = false, bool GATHER = false, int SCW = 0, int SCX = 0>
__device__ __forceinline__ void gemm_phase(PG8_LAS unsigned char* lds, const Gemm g, const Sched& S, const Epi& E, const int tid) {
    const int wid = __builtin_amdgcn_readfirstlane(tid >> 6), lane = tid & 63, wr = wid >> 2, wc = wid & 3, fr = lane & 15, fq = lane >> 4;
    const int K = g.K, nt = K / BK;
    unsigned voffA[2], voffB[2]; int RA[2]; unsigned CA2[2]; unsigned va0[2] = {0u, 0u}, va1[2] = {0u, 0u};
#pragma unroll
    for (int i = 0; i < 2; ++i) { int R, C; stage_rc(tid * 16 + i * 8192, R, C); const int Rb = Epi::PERM ? ((R & ~31) + perm32(R & 31)) : R;
        voffA[i] = (unsigned)(R * K + C) * 2u; voffB[i] = (unsigned)(Rb * K + C) * 2u; RA[i] = R; CA2[i] = (unsigned)C * 2u; }
    static_assert(!GATHER || SP2, "the gathered-A form exists for the SP2 loop only");
    const char* const gA0 = (const char*)g.A;
#define PG8_VA(u) do { int l_; asm volatile("v_mbcnt_lo_u32_b32 %0, -1, 0\n\tv_mbcnt_hi_u32_b32 %0, -1, %0" : "=v"(l_)); const int t_ = wid * 64 + l_;     \
        _Pragma("unroll") for (int _i = 0; _i < 2; ++_i) { int R_, C_; stage_rc(t_ * 16 + _i * 8192, R_, C_); va0[_i] = S.rowoff((u), R_) + (unsigned)C_ * 2u; va1[_i] = S.rowoff((u), HALF + R_) + (unsigned)C_ * 2u; } } while (0)
#define PG8_STA(bufoff, base_ng, base_g, h) do { if constexpr (GATHER) { if (h) PG8_STAGE(bufoff, base_g, va1); else PG8_STAGE(bufoff, base_g, va0); } else PG8_STAGE(bufoff, base_ng, voffA); } while (0)
    const size_t kstep = (size_t)(BK * 2);
    const size_t hstep = (size_t)HALF * K * 2;
    const size_t tstep = 2 * hstep;
    const unsigned ldsw = (unsigned)wid * 1024u;
    const int aoff = lds_byte(wr * 64 + fr, fq * 8), boff = lds_byte(wc * 32 + fr, fq * 8);
#define PG8_SA(b, h) (((b) * 2 + (h)) * HTB)
#define PG8_SB(b, h) ((4 + (b) * 2 + (h)) * HTB)
#define PG8_STAGE(bufoff, gbase, voff) do { _Pragma("unroll") for (int _i = 0; _i < 2; ++_i) \
        __builtin_amdgcn_global_load_lds((const unsigned*)((const char*)(gbase) + (voff)[_i]), (PG8_LAS unsigned*)(lds + (bufoff) + ldsw + _i * 8192), 16, 0, 0); } while (0)
#define PG8_LDA(dst, b, h) do { if constexpr (SCW != 0) { _Pragma("unroll") for (int m = 0; m < 4; ++m) dst##8[m] = PG8_CAT8(*(const PG8_LAS bf16x8*)(lds + PG8_SA(b, h) + aoff + m * 2048), *(const PG8_LAS bf16x8*)(lds + PG8_SA(b, h) + aoff + m * 2048 + 1024)); } \
        else { _Pragma("unroll") for (int m = 0; m < 4; ++m) _Pragma("unroll") for (int k = 0; k < 2; ++k) dst[m][k] = *(const PG8_LAS bf16x8*)(lds + PG8_SA(b, h) + aoff + m * 2048 + k * 1024); } } while (0)
#define PG8_LDB(dst, b, h) do { if constexpr (SCW != 0) { _Pragma("unroll") for (int n = 0; n < 2; ++n) dst##8[n] = PG8_CAT8(*(const PG8_LAS bf16x8*)(lds + PG8_SB(b, h) + boff + n * 2048), *(const PG8_LAS bf16x8*)(lds + PG8_SB(b, h) + boff + n * 2048 + 1024)); } \
        else { _Pragma("unroll") for (int n = 0; n < 2; ++n) _Pragma("unroll") for (int k = 0; k < 2; ++k) dst[n][k] = *(const PG8_LAS bf16x8*)(lds + PG8_SB(b, h) + boff + n * 2048 + k * 1024); } } while (0)
#define PG8_CAT8(lo, hi) __builtin_shufflevector(__builtin_bit_cast(i32x4_t, (lo)), __builtin_bit_cast(i32x4_t, (hi)), 0, 1, 2, 3, 4, 5, 6, 7)
#define PG8_MMA(ai, bj, At, Bt) do { __builtin_amdgcn_s_setprio(1); _Pragma("unroll") for (int m = 0; m < 4; ++m) _Pragma("unroll") for (int n = 0; n < 2; ++n) { \
        if constexpr (SCW != 0) acc[ai][bj][m][n] = __builtin_amdgcn_mfma_scale_f32_16x16x128_f8f6f4(Bt##8[n], At##8[m], acc[ai][bj][m][n], 0, 0, 0, SCW, 0, SCX); \
        else { _Pragma("unroll") for (int k = 0; k < 2; ++k) acc[ai][bj][m][n] = __builtin_amdgcn_mfma_f32_16x16x32_bf16(Bt[n][k], At[m][k], acc[ai][bj][m][n], 0, 0, 0); } } __builtin_amdgcn_s_setprio(0); } while (0)
#define PG8_WAIT_V(n) asm volatile("s_waitcnt vmcnt(" #n ")" ::: "memory")
#define PG8_WAIT_L(n) asm volatile("s_waitcnt lgkmcnt(" #n ")" ::: "memory")
#define PG8_BAR __builtin_amdgcn_s_barrier()
#define PG8_SCHED __builtin_amdgcn_sched_barrier(0)
    Unit cur, nxt; int ui = 0;
    if (!S.next(0, cur)) return;
    f32x4 acc[2][2][4][2];
    if constexpr (Epi::HAS_INIT) { E.init(acc, cur, wr, wc, fr, fq); if constexpr (Epi::INIT_LOADS) __builtin_amdgcn_s_waitcnt(0x0F70); }
    else {
#pragma unroll
    for (int a = 0; a < 2; ++a)
#pragma unroll
        for (int b = 0; b < 2; ++b)
#pragma unroll
            for (int m = 0; m < 4; ++m)
#pragma unroll
                for (int n = 0; n < 2; ++n) acc[a][b][m][n] = (f32x4){0.f, 0.f, 0.f, 0.f};
    }
    bf16x8 At[4][2], B0[2][2], B1[2][2]; i32x8_t At8[4], B08[2], B18[2];
    const char* cA = (const char*)g.A + (size_t)cur.pm * tstep; const char* cB = (const char*)g.Bt + (size_t)cur.pn * tstep;
    S.a_ready(cur);
    if constexpr (SP2) {
        if constexpr (GATHER) PG8_VA(cur);
        PG8_STAGE(PG8_SB(0, 0), cB, voffB); PG8_STAGE(PG8_SB(0, 1), cB + hstep, voffB); PG8_STA(PG8_SA(0, 0), cA, gA0, 0); PG8_STA(PG8_SA(0, 1), cA + hstep, gA0, 1);
        if (wr == 1) PG8_BAR;
        PG8_WAIT_V(2); PG8_BAR;
        PG8_STAGE(PG8_SB(1, 0), cB + kstep, voffB); PG8_STA(PG8_SA(1, 0), cA + kstep, gA0 + kstep, 0); PG8_STAGE(PG8_SB(1, 1), cB + hstep + kstep, voffB);
        PG8_WAIT_V(6); PG8_BAR;
    } else {
        PG8_STAGE(PG8_SB(0, 0), cB, voffB); PG8_STAGE(PG8_SA(0, 0), cA, voffA); PG8_STAGE(PG8_SB(0, 1), cB + hstep, voffB); PG8_STAGE(PG8_SA(0, 1), cA + hstep, voffA);
        if (wr == 1) PG8_BAR;
        PG8_WAIT_V(4); PG8_BAR;
        PG8_STAGE(PG8_SB(1, 0), cB + kstep, voffB); PG8_STAGE(PG8_SA(1, 0), cA + kstep, voffA); PG8_STAGE(PG8_SB(1, 1), cB + hstep + kstep, voffB);
        PG8_WAIT_V(6); PG8_BAR;
    }
    for (;;) {
        const bool has_next = S.next(ui + 1, nxt);
        const char* nA = has_next ? (const char*)g.A + (size_t)nxt.pm * tstep : cA; const char* nB = has_next ? (const char*)g.Bt + (size_t)nxt.pn * tstep : cB;
        _Pragma("nounroll") for (int t = 0; t < nt; t += 2) {
            const bool last = (t == nt - 2);
            const char* a1 = cA + (size_t)(t + 1) * kstep;
            const char* a2 = last ? nA : cA + (size_t)(t + 2) * kstep; const char* b2 = last ? nB : cB + (size_t)(t + 2) * kstep;
            const char* a3 = a2 + kstep; const char* b3 = b2 + kstep;
            if (last && has_next) S.a_ready(nxt);
            const char* const g1 = gA0 + (size_t)(t + 1) * kstep; const char* const g2 = last ? gA0 : gA0 + (size_t)(t + 2) * kstep; const char* const g3 = g2 + kstep;
            if constexpr (SP2) {
            PG8_LDB(B0, 0, 0); PG8_LDB(B1, 0, 1); PG8_SCHED; PG8_LDA(At, 0, 0); PG8_STA(PG8_SA(1, 1), a1 + hstep, g1, 1);
            PG8_WAIT_V(8); PG8_WAIT_L(0); PG8_BAR; PG8_MMA(0, 0, At, B0); PG8_MMA(0, 1, At, B1); PG8_BAR; PG8_SCHED;
            if constexpr (GATHER) { if (last && has_next) PG8_VA(nxt); }
            PG8_LDA(At, 0, 1); PG8_STAGE(PG8_SB(0, 0), b2, voffB); PG8_STAGE(PG8_SB(0, 1), b2 + hstep, voffB); PG8_STA(PG8_SA(0, 0), a2, g2, 0);
            PG8_WAIT_V(8); PG8_WAIT_L(0); PG8_BAR; PG8_MMA(1, 0, At, B0); PG8_MMA(1, 1, At, B1); PG8_BAR; PG8_SCHED;
            PG8_LDB(B0, 1, 0); PG8_LDB(B1, 1, 1); PG8_SCHED; PG8_LDA(At, 1, 0); PG8_STA(PG8_SA(0, 1), a2 + hstep, g2, 1);
            PG8_WAIT_V(8); PG8_WAIT_L(0); PG8_BAR; PG8_MMA(0, 0, At, B0); PG8_MMA(0, 1, At, B1); PG8_BAR; PG8_SCHED;
            PG8_LDA(At, 1, 1); PG8_STAGE(PG8_SB(1, 0), b3, voffB); PG8_STAGE(PG8_SB(1, 1), b3 + hstep, voffB); PG8_STA(PG8_SA(1, 0), a3, g3, 0);
            PG8_WAIT_V(8); PG8_WAIT_L(0); PG8_BAR; PG8_MMA(1, 0, At, B0); PG8_MMA(1, 1, At, B1); PG8_BAR; PG8_SCHED;
            } else {
            PG8_LDB(B0, 0, 0); PG8_SCHED; PG8_LDA(At, 0, 0); PG8_STAGE(PG8_SA(1, 1), a1 + hstep, voffA);
            PG8_WAIT_L(8); PG8_BAR; PG8_WAIT_L(0); PG8_MMA(0, 0, At, B0); PG8_BAR; PG8_SCHED;
            PG8_LDB(B1, 0, 1); PG8_STAGE(PG8_SB(0, 0), b2, voffB);
            PG8_BAR; PG8_WAIT_L(0); PG8_MMA(0, 1, At, B1); PG8_BAR;
            PG8_LDA(At, 0, 1); PG8_STAGE(PG8_SA(0, 0), a2, voffA);
            PG8_BAR; PG8_WAIT_L(0); PG8_MMA(1, 0, At, B0); PG8_BAR; PG8_SCHED;
            PG8_STAGE(PG8_SB(0, 1), b2 + hstep, voffB);
            PG8_WAIT_V(6); PG8_BAR; PG8_MMA(1, 1, At, B1); PG8_BAR;
            PG8_LDB(B0, 1, 0); PG8_SCHED; PG8_LDA(At, 1, 0); PG8_STAGE(PG8_SA(0, 1), a2 + hstep, voffA);
            PG8_WAIT_L(8); PG8_BAR; PG8_WAIT_L(0); PG8_MMA(0, 0, At, B0); PG8_BAR; PG8_SCHED;
            PG8_LDB(B1, 1, 1); PG8_STAGE(PG8_SB(1, 0), b3, voffB);
            PG8_BAR; PG8_WAIT_L(0); PG8_MMA(0, 1, At, B1); PG8_BAR;
            PG8_LDA(At, 1, 1); PG8_STAGE(PG8_SA(1, 0), a3, voffA);
            PG8_BAR; PG8_WAIT_L(0); PG8_MMA(1, 0, At, B0); PG8_BAR; PG8_SCHED;
            PG8_STAGE(PG8_SB(1, 1), b3 + hstep, voffB);
            PG8_WAIT_V(6); PG8_BAR; PG8_MMA(1, 1, At, B1); PG8_BAR;
            }
        }
        if constexpr (ALIGN_EPI) { if (wr == 0) PG8_BAR; }
        if constexpr (!Epi::AFTER_DRAIN) { int fr_ = fr, fq_ = fq; asm volatile("" : "+v"(fr_), "+v"(fq_));
            E(acc, cur, wr, wc, fr_, fq_); S.done(cur); }
        if (!has_next) break;
        if constexpr (Epi::HAS_INIT) { int fr_ = fr, fq_ = fq; asm volatile("" : "+v"(fr_), "+v"(fq_)); E.init(acc, nxt, wr, wc, fr_, fq_); if constexpr (Epi::INIT_LOADS) __builtin_amdgcn_s_waitcnt(0x0F70); }
        else {
#pragma unroll
        for (int a = 0; a < 2; ++a)
#pragma unroll
            for (int b = 0; b < 2; ++b)
#pragma unroll
                for (int m = 0; m < 4; ++m)
#pragma unroll
                    for (int n = 0; n < 2; ++n) acc[a][b][m][n] = (f32x4){0.f, 0.f, 0.f, 0.f};
        }
        cur = nxt; cA = nA; cB = nB; ++ui;
        if constexpr (ALIGN_EPI) { if (wr == 1) PG8_BAR; }
    }
    PG8_WAIT_V(0);
    if constexpr (!ALIGN_EPI) { if (wr == 0) PG8_BAR; }
    PG8_BAR;
    if constexpr (Epi::AFTER_DRAIN) { E.fused(acc, cur, wr, wc, fr, fq, lds, wid, lane); S.done(cur); }
#undef PG8_SA
#undef PG8_CAT8
#undef PG8_VA
#undef PG8_STA
#undef PG8_SB
#undef PG8_STAGE
#undef PG8_LDA
#undef PG8_LDB
#undef PG8_MMA
#undef PG8_WAIT_V
#undef PG8_WAIT_L
#undef PG8_BAR
#undef PG8_SCHED
}
}

#ifndef PG8_SP2
#define PG8_SP2 true
#endif
#ifndef PG8_ALIGN
#define PG8_ALIGN true
#endif
#define GAS __attribute__((address_space(1)))
#define LAS __attribute__((address_space(3)))
typedef unsigned short bf16;
typedef unsigned v4u __attribute__((ext_vector_type(4)));
typedef float f32x4 __attribute__((ext_vector_type(4)));
typedef short bf16x8 __attribute__((ext_vector_type(8)));
typedef GAS unsigned gu32;
typedef GAS unsigned long long gu64;
#define RLX_AGENT __ATOMIC_RELAXED, __HIP_MEMORY_SCOPE_AGENT
#define LDS_WAIT() asm volatile("s_waitcnt lgkmcnt(0)" ::: "memory")
#define VM_WAIT() asm volatile("s_waitcnt vmcnt(0)" ::: "memory")
__device__ __forceinline__ unsigned long long rt() { return __builtin_amdgcn_s_memrealtime(); }
__device__ __forceinline__ unsigned f2bf(float f) { unsigned u = __builtin_bit_cast(unsigned, f); return (u + 0x7fffu + ((u >> 16) & 1u)) >> 16; }
__device__ __forceinline__ unsigned pk2(float lo, float hi) { return f2bf(lo) | (f2bf(hi) << 16); }

#define XB_TMO      128
#define XB_XCNT(j)  (256  + 64 * (j))
#define XB_XSUB(j)  (1280 + 64 * (j))
#define XB_XGEN(j)  (2304 + 64 * (j))
#define XB_TOP      3328
#define XB_TOPGEN   3392
#define XCD_BAR_WORDS 3456
#define XB_SPIN_CAP (1u << 18)

__device__ __forceinline__ unsigned xb_ld(unsigned* p)              { return __hip_atomic_load(p, __ATOMIC_RELAXED, __HIP_MEMORY_SCOPE_AGENT); }
__device__ __forceinline__ unsigned xb_add(unsigned* p, unsigned v) { return __hip_atomic_fetch_add(p, v, __ATOMIC_RELAXED, __HIP_MEMORY_SCOPE_AGENT); }
__device__ __forceinline__ unsigned xb_xcc_id() { return (unsigned)__builtin_amdgcn_s_getreg((3 << 11) | 20) & 0xFu; }
#define XB_SPIN(cond, bar) do { unsigned _sp = 0; while (cond) { __builtin_amdgcn_s_sleep(1); \
    if ((++_sp & 255u) == 0u) { if (xb_ld(&(bar)[XB_TMO])) break; if (_sp > XB_SPIN_CAP) { atomicAdd(&(bar)[XB_TMO], 1u); break; } } } } while (0)

struct XcdBarrier {
    unsigned* bar; unsigned x;
    volatile LAS unsigned* st;
};

__device__ __forceinline__ XcdBarrier xcd_barrier_post(unsigned* bar, volatile LAS unsigned* st) {
    XcdBarrier b; b.bar = bar; b.x = xb_xcc_id(); b.st = st;
    if (threadIdx.x == 0) (void)xb_add(&bar[XB_XCNT(b.x)], 1u);
    return b;
}
__device__ __forceinline__ void xcd_barrier_complete(unsigned* bar, unsigned x, unsigned& nloc, unsigned& nx) {
    const unsigned G = gridDim.x * gridDim.y * gridDim.z;
    unsigned sum, cnt, mine, sp = 0u;
    for (;;) {
        sum = 0u; cnt = 0u; mine = 0u;
#pragma unroll
        for (unsigned j = 0; j < 16; ++j) { const unsigned c = xb_ld(&bar[XB_XCNT(j)]); sum += c; cnt += (c > 0u) ? 1u : 0u; mine = (j == x) ? c : mine; }
        if (sum == G) break;
        __builtin_amdgcn_s_sleep(1);
        if ((++sp & 255u) == 0u) { if (xb_ld(&bar[XB_TMO])) break; if (sp > XB_SPIN_CAP) { atomicAdd(&bar[XB_TMO], 1u); break; } }
    }
    nloc = mine > 0u ? mine : 1u; nx = cnt > 0u ? cnt : 1u;
}

__device__ __forceinline__ void xcd_barrier(const XcdBarrier& b) {
    asm volatile("s_waitcnt vmcnt(0)" ::: "memory");
    __syncthreads();
    if (threadIdx.x == 0) {
        unsigned* bar = b.bar;
        __builtin_amdgcn_s_waitcnt(0);
        unsigned nloc = b.st[0], nx = b.st[1];
        if (nloc == 0u) { xcd_barrier_complete(bar, b.x, nloc, nx); b.st[0] = nloc; b.st[1] = nx; }
        const unsigned old = xb_add(&bar[XB_XSUB(b.x)], 1u);
        const unsigned gen = old / nloc;
        if (old + 1u == (gen + 1u) * nloc) {
            __builtin_amdgcn_fence(__ATOMIC_RELEASE, "agent");
            asm volatile("s_waitcnt vmcnt(0)" ::: "memory");
            const unsigned og = xb_add(&bar[XB_TOP], 1u);
            const unsigned tg = og / nx;
            if (og + 1u == (tg + 1u) * nx) xb_add(&bar[XB_TOPGEN], 1u);
            else XB_SPIN(xb_ld(&bar[XB_TOPGEN]) == tg, bar);
            __builtin_amdgcn_fence(__ATOMIC_ACQUIRE, "agent");
            xb_add(&bar[XB_XGEN(b.x)], 1u);
            asm volatile("s_waitcnt vmcnt(0)" ::: "memory");
        } else {
            XB_SPIN(xb_ld(&bar[XB_XGEN(b.x)]) == gen, bar);
            __builtin_amdgcn_fence(__ATOMIC_ACQUIRE, "agent");
            asm volatile("s_waitcnt vmcnt(0)" ::: "memory");
        }
    }
    __syncthreads();
}

constexpr int NWAVES = 8;
#ifndef MK_ONE_LAUNCH
#define MK_ONE_LAUNCH 1
#endif

constexpr int BATCH = 16, SEQ = 2048, D = 1024, T = BATCH * SEQ;
constexpr int NIN = 3584;
constexpr int OFF_SQ = 0, OFF_SK = 512, OFF_SV = 1024, OFF_HQ = 1536, OFF_HF = 2048, OFF_HI = 2560, OFF_HG = 3072;
constexpr int NE = 32, TOPK = 4, NASSIGN = T * TOPK;
constexpr int MAXTILES = NASSIGN / 256 + NE;
constexpr int MAXROWS = MAXTILES * 256;
constexpr float EPS = 1e-6f;

constexpr size_t MiB = 1u << 20;
constexpr size_t WS_CTL = 0, CTL_ZERO_BYTES = 1 * MiB;
constexpr size_t WS_WIN = 2 * MiB;
constexpr size_t WS_WOUT = 10 * MiB;
constexpr size_t WS_RT = 12 * MiB;
constexpr size_t WS_WGU = 16 * MiB;
constexpr size_t WS_WD = 144 * MiB;
constexpr size_t WS_XN = 208 * MiB;
constexpr size_t WS_P = 272 * MiB;
constexpr size_t WS_PH = WS_P + 96 * MiB;
constexpr size_t WS_MIX = 496 * MiB;
constexpr size_t WS_ACT = 272 * MiB;
constexpr size_t WS_YK = 560 * MiB;
constexpr size_t WS_QN = 624 * MiB;
constexpr size_t WS_KN = 656 * MiB;
constexpr size_t WS_VT = 688 * MiB;
constexpr size_t WS_KVS = 720 * MiB;
constexpr size_t WS_DEC = 784 * MiB;
constexpr size_t WS_SSEG = 786 * MiB;
constexpr size_t WS_DSEG = 802 * MiB;
constexpr size_t WS_LIST = 816 * MiB;
constexpr size_t WS_TOPG = 825 * MiB;
constexpr size_t WS_X8 = 560 * MiB;
constexpr size_t WS_END = 832 * MiB;
static_assert(WS_ACT + (size_t)MAXROWS * 2048 <= WS_YK && WS_YK + (size_t)T * 4 * 2048 <= WS_LIST && WS_MIX + (size_t)T * 2048 <= WS_YK, "d_ws map");
constexpr int CW_TMO = 0, CW_CODE = 1;
constexpr int CW_CNT = 64;
constexpr int CW_BAR = 4096;

constexpr int RING_OFF = 0, RING_BYTES = 131072;
constexpr int RT_ROW = 2064, RT_WL = 32 * RT_ROW, RT_END = 64 * RT_ROW;
constexpr int LDSCTL_OFF = 133120, MISC_OFF = LDSCTL_OFF + 320;
constexpr int LTAB_OFF = LDSCTL_OFF + 512;
constexpr int LT_TS = MAXTILES, LT_CNT = MAXTILES + 32, LT_MISC = MAXTILES + 64, LT_WORDS = MAXTILES + 192;
constexpr int ROWTAB_OFF = LTAB_OFF + LT_WORDS * 4;
constexpr int MAXSLOT = 17;
constexpr int ROWTAB2_OFF = ROWTAB_OFF + MAXSLOT * 1024;
constexpr int LDS_BYTES = ROWTAB2_OFF + MAXSLOT * 512;
static_assert(RT_END <= LDSCTL_OFF && MISC_OFF + 128 <= LTAB_OFF && LDS_BYTES <= 160 * 1024 && (MAXTILES * 8 + 255) / 256 <= MAXSLOT && 2 * ((MAXTILES * 4 + 255) / 256) * 1024 <= MAXSLOT * 1536 && ROWTAB_OFF % 16 == 0, "LDS map");

struct Frame {
    LAS unsigned char* lds;
    volatile LAS unsigned* MISC;
    gu32* ctl;
    int tid, lane, wave, gw, ngw;
    int vcu, G;
    const float *x, *norm1_g, *w_in, *sb_q_g, *sb_k_g, *sb_out_g, *hg_lb, *hg_out_g, *w_out, *norm2_g, *w_router, *b_router, *w_gu, *b_gu, *w_d, *b_d;
    float* out;
    unsigned char* ws;
};
__device__ __forceinline__ float bf2f(unsigned short b) { return __builtin_bit_cast(float, (unsigned)b << 16); }
__device__ __forceinline__ float bflo(unsigned w) { return __builtin_bit_cast(float, w << 16); }
__device__ __forceinline__ float bfhi(unsigned w) { return __builtin_bit_cast(float, w & 0xffff0000u); }
typedef __bf16 bf16x2n_ __attribute__((ext_vector_type(2)));
typedef float f32x2n_ __attribute__((ext_vector_type(2)));
__device__ __forceinline__ unsigned pkbf(float a, float b) { const bf16x2n_ v = __builtin_convertvector((f32x2n_){a, b}, bf16x2n_); return __builtin_bit_cast(unsigned, v); }
__device__ __forceinline__ int lane_id() { int l; asm volatile("v_mbcnt_lo_u32_b32 %0, -1, 0\n\tv_mbcnt_hi_u32_b32 %0, -1, %0" : "=v"(l)); return l; }
__device__ __forceinline__ int vzero() { int z; asm volatile("v_mov_b32 %0, 0" : "=v"(z)); return z; }
__device__ __forceinline__ float wave_sum(float v) {
#pragma unroll
    for (int o = 1; o < 64; o <<= 1) v += __shfl_xor(v, o);
    return v;
}

constexpr float W8_SCALE = 256.f, A8_SCALE = 4.f, Y8_SCALE = 32.f; static_assert(Y8_SCALE == 32.f, "SC_W8Y below is 2^-8 * 32");
constexpr int SC_ONE = 0x7f7f7f7f, SC_W8 = 0x77777777, SC_A8 = 0x7d7d7d7d, SC_W8Y = 0x7c7c7c7c;
struct P0Item { const float* W; bf16* WT; const float* rowscale; int N, k0, n0, drow0, fp8, perm; };
__device__ __forceinline__ void p0_load(const P0Item& it, f32x4 (&v)[16], int lane) {
    const int kr = lane >> 4, nc = 4 * (lane & 15);
#pragma unroll
    for (int i = 0; i < 16; ++i) v[i] = __builtin_nontemporal_load((const f32x4*)(it.W + (size_t)(it.k0 + 4 * i + kr) * it.N + it.n0 + nc));
}
__device__ __forceinline__ void p0_store(const P0Item& it, const f32x4 (&v)[16], LAS unsigned char* scr, int lane) {
    const int kr = lane >> 4, nc = 4 * (lane & 15);
#pragma unroll
    for (int i = 0; i < 16; ++i) { const float sc = it.rowscale ? it.rowscale[it.k0 + 4 * i + kr] : 1.f;
        *(LAS unsigned long long*)(scr + (4 * i + kr) * 136 + 2 * nc) = (unsigned long long)pkbf(v[i].x * sc, v[i].y * sc) | ((unsigned long long)pkbf(v[i].z * sc, v[i].w * sc) << 32); }
    LDS_WAIT(); asm volatile("" ::: "memory");
    const LAS unsigned short* s16 = (const LAS unsigned short*)scr;
    if (it.fp8) { const int p = lane & 3, nr = lane >> 2;
#pragma unroll
        for (int c = 0; c < 4; ++c) { const int n = 16 * c + nr; unsigned val[16];
#pragma unroll
            for (int kk = 0; kk < 16; ++kk) val[kk] = s16[(16 * p + kk) * 68 + n];
            v4u w4;
            w4.x = pg8::pk4_fp8(bflo(val[0]) * W8_SCALE, bflo(val[1]) * W8_SCALE, bflo(val[2]) * W8_SCALE, bflo(val[3]) * W8_SCALE);
            w4.y = pg8::pk4_fp8(bflo(val[4]) * W8_SCALE, bflo(val[5]) * W8_SCALE, bflo(val[6]) * W8_SCALE, bflo(val[7]) * W8_SCALE);
            w4.z = pg8::pk4_fp8(bflo(val[8]) * W8_SCALE, bflo(val[9]) * W8_SCALE, bflo(val[10]) * W8_SCALE, bflo(val[11]) * W8_SCALE);
            w4.w = pg8::pk4_fp8(bflo(val[12]) * W8_SCALE, bflo(val[13]) * W8_SCALE, bflo(val[14]) * W8_SCALE, bflo(val[15]) * W8_SCALE);
            *(GAS v4u*)((unsigned char*)it.WT + (size_t)(it.drow0 + (it.perm == 2 ? 128 * ((n >> 3) & 1) + 8 * (n >> 4) + (n & 7) : n)) * D + it.k0 + 16 * p) = w4; }
    } else { const int p = lane & 7, nr = lane >> 3;
#pragma unroll
        for (int c = 0; c < 8; ++c) { const int n = 8 * c + nr; unsigned val[8];
#pragma unroll
            for (int kk = 0; kk < 8; ++kk) val[kk] = s16[(8 * p + kk) * 68 + n];
            v4u w4; w4.x = val[0] | (val[1] << 16); w4.y = val[2] | (val[3] << 16); w4.z = val[4] | (val[5] << 16); w4.w = val[6] | (val[7] << 16);
            *(GAS v4u*)(it.WT + (size_t)(it.drow0 + (it.perm ? 128 * (n >> 5) + (n & 31) : n)) * D + it.k0 + 8 * p) = w4; } }
    LDS_WAIT(); asm volatile("" ::: "memory");
}
__device__ __forceinline__ void rms_rows2_to_bf16(const float* xa, const float* xb, bool hasb, const float* g, bf16* oa, bf16* ob, int lane) {
    const GAS f32x4* pa = (const GAS f32x4*)xa + lane; const GAS f32x4* pb = (const GAS f32x4*)(hasb ? xb : xa) + lane; const f32x4* gr = (const f32x4*)g + lane;
    f32x4 va[4], vb[4], gg[4]; float sa = 0.f, sb = 0.f;
#pragma unroll
    for (int j = 0; j < 4; ++j) { va[j] = __builtin_nontemporal_load(pa + 64 * j); vb[j] = __builtin_nontemporal_load(pb + 64 * j); gg[j] = gr[64 * j]; }
#pragma unroll
    for (int j = 0; j < 4; ++j) { sa += (va[j].x * va[j].x + va[j].y * va[j].y) + (va[j].z * va[j].z + va[j].w * va[j].w); sb += (vb[j].x * vb[j].x + vb[j].y * vb[j].y) + (vb[j].z * vb[j].z + vb[j].w * vb[j].w); }
    const float ra = 1.f / sqrtf(wave_sum(sa) * (1.f / D) + EPS), rb = 1.f / sqrtf(wave_sum(sb) * (1.f / D) + EPS);
    GAS unsigned long long* o8a = (GAS unsigned long long*)oa + lane; GAS unsigned long long* o8b = (GAS unsigned long long*)ob + lane;
#pragma unroll
    for (int j = 0; j < 4; ++j) o8a[64 * j] = (unsigned long long)pkbf(va[j].x * ra * gg[j].x, va[j].y * ra * gg[j].y) | ((unsigned long long)pkbf(va[j].z * ra * gg[j].z, va[j].w * ra * gg[j].w) << 32);
    if (hasb) {
#pragma unroll
        for (int j = 0; j < 4; ++j) o8b[64 * j] = (unsigned long long)pkbf(vb[j].x * rb * gg[j].x, vb[j].y * rb * gg[j].y) | ((unsigned long long)pkbf(vb[j].z * rb * gg[j].z, vb[j].w * rb * gg[j].w) << 32); }
}
__device__ __forceinline__ P0Item p0_item(Frame& F, int r) {
    constexpr int I_IN = 16 * (NIN / 64), I_OUT = 16 * 16, I_GU = NE * 16 * 32;
    P0Item it;
    if (r < I_IN) { const int nb = NIN / 64, Qp = r >> 1, kb = 2 * (Qp / nb) + (r & 1), nn = Qp % nb; const int pq = 1; it = P0Item{F.w_in, (bf16*)(F.ws + WS_WIN), nullptr, NIN, 64 * kb, 64 * nn, pq ? 256 * (nn >> 2) + 32 * (nn & 3) : 64 * nn, 0, pq}; return it; } r -= I_IN;
    if (r < I_OUT) { const int Qp = r >> 1, kb = 2 * (Qp / 16) + (r & 1), nn = Qp % 16; it = P0Item{F.w_out, (bf16*)(F.ws + WS_WOUT), nullptr, D, 64 * kb, 64 * nn, 256 * (nn >> 2) + 32 * (nn & 3), 0, 1}; return it; }     r -= I_OUT;
    if (r < I_GU) { const int e = r / 512, q = r % 512, Qp = q >> 1, kb = 2 * (Qp / 32) + (q & 1), nn = Qp % 32;
        const int isup = nn >> 4, a = (nn & 15) * 64;
        it = P0Item{F.w_gu + (size_t)e * D * 2048, (bf16*)(F.ws + WS_WGU + (size_t)e * 2048 * D), F.norm2_g, 2048, 64 * kb, 64 * nn, 256 * (a >> 7) + 128 * isup + (a & 127), 1, 0}; return it; } r -= I_GU;
    { const int e = r / 256, q = r % 256, Qp = q >> 1, kb = 2 * (Qp / 16) + (q & 1), nn = Qp % 16;
        it = P0Item{F.w_d + (size_t)e * D * D, (bf16*)(F.ws + WS_WD + (size_t)e * D * D), nullptr, D, 64 * kb, 64 * nn, 256 * (nn >> 2) + 32 * (nn & 3), 1, 2}; return it; }
}
constexpr int P0_NITEMS = 16 * (NIN / 64) + 16 * 16 + NE * 16 * 32 + NE * 16 * 16;
constexpr int P0_NLATE = 1024;
__device__ __forceinline__ void p0_items(Frame& F, int lo, int hi, int w, int nw) {
    LAS unsigned char* scr = F.lds + RING_OFF + F.wave * 16384;
    f32x4 va[16], vb[16]; int it = lo + w;
    if (it < hi) { P0Item A = p0_item(F, it); p0_load(A, va, F.lane);
        for (;;) {
            const int itb = it + nw; const bool hb = itb < hi; const P0Item B = p0_item(F, hb ? itb : it); p0_load(B, vb, F.lane); __builtin_amdgcn_sched_barrier(0);
            p0_store(A, va, scr, F.lane);
            if (!hb) break;
            it = itb + nw; const bool ha = it < hi; A = p0_item(F, ha ? it : itb); p0_load(A, va, F.lane); __builtin_amdgcn_sched_barrier(0);
            p0_store(B, vb, scr, F.lane);
            if (!ha) break;
        }
    }
}
__device__ __forceinline__ void p0_prologue(Frame& F) {
    p0_items(F, 0, P0_NITEMS - P0_NLATE, F.gw, F.ngw);
    for (int q = blockIdx.x * (NWAVES * 64) + F.tid; q < 4096; q += F.G * NWAVES * 64) {
        const int e = q & 31, k0 = (q >> 5) * 8; unsigned hi[8], lo[8];
#pragma unroll
        for (int j = 0; j < 8; ++j) { const float w = F.w_router[(k0 + j) * 32 + e] * F.norm2_g[k0 + j]; hi[j] = pkbf(w, 0.f) & 0xffffu; lo[j] = pkbf(w - bflo(hi[j]), 0.f) & 0xffffu; }
        const v4u h4 = {hi[0] | (hi[1] << 16), hi[2] | (hi[3] << 16), hi[4] | (hi[5] << 16), hi[6] | (hi[7] << 16)}, l4 = {lo[0] | (lo[1] << 16), lo[2] | (lo[3] << 16), lo[4] | (lo[5] << 16), lo[6] | (lo[7] << 16)};
        *(GAS v4u*)(F.ws + WS_RT + e * RT_ROW + 2 * k0) = h4; *(GAS v4u*)(F.ws + WS_RT + RT_WL + e * RT_ROW + 2 * k0) = l4; }
    for (int m = F.gw; m < T; m += 2 * F.ngw) rms_rows2_to_bf16(F.x + (size_t)m * D, F.x + (size_t)(m + F.ngw) * D, m + F.ngw < T, F.norm1_g, (bf16*)(F.ws + WS_XN) + (size_t)m * D, (bf16*)(F.ws + WS_XN) + (size_t)(m + F.ngw) * D, F.lane);
}

__device__ __forceinline__ v4u pair_trade(const v4u& P0, const v4u& P1, bool odd, v4u& storeA, v4u& storeB) {
    const v4u snd = odd ? P0 : P1; v4u rcv;
    rcv.x = (unsigned)__builtin_amdgcn_mov_dpp((int)snd.x, 0xB1, 0xF, 0xF, true); rcv.y = (unsigned)__builtin_amdgcn_mov_dpp((int)snd.y, 0xB1, 0xF, 0xF, true);
    rcv.z = (unsigned)__builtin_amdgcn_mov_dpp((int)snd.z, 0xB1, 0xF, 0xF, true); rcv.w = (unsigned)__builtin_amdgcn_mov_dpp((int)snd.w, 0xB1, 0xF, 0xF, true);
    storeA = odd ? rcv : P0; storeB = odd ? P1 : rcv; return rcv;
}
typedef float f32x16 __attribute__((ext_vector_type(16)));
typedef __bf16 bf16x2n __attribute__((ext_vector_type(2)));
typedef float f32x2n __attribute__((ext_vector_type(2)));
#define MFMA32(a, b, c) __builtin_amdgcn_mfma_f32_32x32x16_bf16((a), (b), (c), 0, 0, 0)
__device__ __forceinline__ bf16x8 pack8(float a0, float a1, float a2, float a3, float a4, float a5, float a6, float a7) { const v4u p = {pkbf(a0, a1), pkbf(a2, a3), pkbf(a4, a5), pkbf(a6, a7)}; return __builtin_bit_cast(bf16x8, p); }
constexpr float QSCALE = 0.125f * 1.44269504089f;
__device__ __forceinline__ void prep_phase(Frame& F) {
    LAS unsigned* tl = (LAS unsigned*)(F.lds + RING_OFF + F.wave * 16384);
    const bf16* P = (const bf16*)(F.ws + WS_P); bf16* Qn = (bf16*)(F.ws + WS_QN); bf16* Kn = (bf16*)(F.ws + WS_KN); bf16* VT = (bf16*)(F.ws + WS_VT);
    const int tr = F.lane >> 3, c8 = F.lane & 7;
    for (int it = F.gw; it < 4096; it += F.ngw) {
        const int bh = it & 127, blk = it >> 7, b = bh >> 3, h = bh & 7;
        const bf16* base = P + ((size_t)b * 8 + h) * SEQ * 64 + (size_t)(blk * 64 + tr) * 64 + 8 * c8;
        v4u rv[8];
#pragma unroll
        for (int i = 0; i < 8; ++i) { const bf16* row = base + (size_t)(8 * i) * 64; rv[i] = *(const GAS v4u*)(row + (size_t)2 * 16 * 8 * SEQ * 64); }
        {
#pragma unroll
            for (int i = 0; i < 8; ++i) { LAS unsigned* q = tl + (8 * i + tr) * 33 + 4 * c8; q[0] = rv[i].x; q[1] = rv[i].y; q[2] = rv[i].z; q[3] = rv[i].w; }
            LDS_WAIT(); asm volatile("" ::: "memory");
            const LAS unsigned short* t16 = (const LAS unsigned short*)tl; const int dr = tr;
#define KAP(pos) (((pos) & ~12) | (((pos) & 4) << 1) | (((pos) & 8) >> 1))
            bf16* const obase = VT + ((size_t)bh * 64 + blk * 2 + (c8 >> 2)) * 2048 + ((c8 >> 1) & 1) * 512 + (c8 & 1) * 256;
#pragma unroll
            for (int j = 0; j < 8; ++j) { unsigned val[8];
#pragma unroll
                for (int p = 0; p < 8; ++p) { const int pos = 8 * c8 + p; val[p] = t16[KAP(pos) * 66 + 8 * j + dr]; }
                v4u w4; w4.x = val[0] | (val[1] << 16); w4.y = val[2] | (val[3] << 16); w4.z = val[4] | (val[5] << 16); w4.w = val[6] | (val[7] << 16);
                *(GAS v4u*)(obase + (j >> 2) * 1024 + ((8 * j + dr) & 31) * 8) = w4; }
#undef KAP
            LDS_WAIT(); asm volatile("" ::: "memory");
        }
    }
}

__device__ __forceinline__ int crow16(int i, int hh) { return (i & 3) + 8 * (i >> 2) + 4 * hh; }
__device__ __forceinline__ void attn_item(Frame& F, int bh, int qb, float thr, const bf16x8 (&Lt)[2]) {
    const int r = F.lane & 31, hh = F.lane >> 5, b = bh >> 3, h = bh & 7, q0 = qb * 32;
    const bf16* Qn = (const bf16*)(F.ws + WS_QN); const bf16* Kn = (const bf16*)(F.ws + WS_KN); const bf16* VT = (const bf16*)(F.ws + WS_VT);
    bf16x8 qf[4];
#pragma unroll
    for (int s = 0; s < 4; ++s) qf[s] = *(const GAS bf16x8*)(Qn + ((size_t)bh * 64 + qb) * 2048 + s * 512 + F.lane * 8);
    f32x4 gout[2][4];
#pragma unroll
    for (int db = 0; db < 2; ++db)
#pragma unroll
        for (int gq = 0; gq < 4; ++gq) gout[db][gq] = *(const f32x4*)(F.sb_out_g + h * 64 + 32 * db + 8 * gq + 4 * hh);
    f32x16 O0, O1;
#pragma unroll
    for (int i = 0; i < 16; ++i) { O0[i] = 0.f; O1[i] = 0.f; }
    float carry = 0.f;
    const bf16* kbase = Kn + (size_t)bh * 64 * 2048 + F.lane * 8; const bf16* vbase = VT + (size_t)bh * 64 * 2048 + F.lane * 8;
#define ATT_LOAD(KF, VF, kb_) do { _Pragma("unroll") for (int s_ = 0; s_ < 4; ++s_) KF[s_] = *(const GAS bf16x8*)(kbase + (size_t)(kb_) * 2048 + 512 * s_); \
        _Pragma("unroll") for (int db_ = 0; db_ < 2; ++db_) _Pragma("unroll") for (int ks_ = 0; ks_ < 2; ++ks_) VF[db_][ks_] = *(const GAS bf16x8*)(vbase + (size_t)(kb_) * 2048 + 1024 * db_ + 512 * ks_); } while (0)
#define ATT_BLOCK(KF, VF, kb_) do { const bool diag = ((kb_) == qb); \
        f32x16 z; _Pragma("unroll") for (int i = 0; i < 16; ++i) z[i] = 0.f; \
        _Pragma("unroll") for (int s_ = 0; s_ < 4; ++s_) z = MFMA32(KF[s_], qf[s_], z); \
        float sp[16]; \
        _Pragma("unroll") for (int i = 0; i < 16; ++i) { const float zz = z[i]; float v = fmaxf(zz, 0.f) + __builtin_amdgcn_logf(1.f + __builtin_amdgcn_exp2f(-fabsf(zz))); if (diag && !(crow16(i, hh) < r)) v = 0.f; sp[i] = v; } \
        const bf16x8 sb0 = pack8(sp[0], sp[1], sp[2], sp[3], sp[4], sp[5], sp[6], sp[7]), sb1 = pack8(sp[8], sp[9], sp[10], sp[11], sp[12], sp[13], sp[14], sp[15]); \
        f32x16 Cc; _Pragma("unroll") for (int i = 0; i < 16; ++i) Cc[i] = carry; \
        Cc = MFMA32(Lt[0], sb0, Cc); Cc = MFMA32(Lt[1], sb1, Cc); \
        float w[16]; \
        _Pragma("unroll") for (int i = 0; i < 16; ++i) { float v = __builtin_amdgcn_exp2f(z[i] - Cc[i]); if (diag && !(crow16(i, hh) < r)) v = 0.f; w[i] = v; } \
        const bf16x8 wb0 = pack8(w[0], w[1], w[2], w[3], w[4], w[5], w[6], w[7]), wb1 = pack8(w[8], w[9], w[10], w[11], w[12], w[13], w[14], w[15]); \
        O0 = MFMA32(VF[0][0], wb0, O0); O0 = MFMA32(VF[0][1], wb1, O0); O1 = MFMA32(VF[1][0], wb0, O1); O1 = MFMA32(VF[1][1], wb1, O1); \
        carry = __shfl(Cc[0], r); } while (0)
    bf16x8 kfA[4], vfA[2][2], kfB[4], vfB[2][2];
    ATT_LOAD(kfA, vfA, qb);
    for (int kb = qb; kb >= 0; kb -= 2) {
        ATT_LOAD(kfB, vfB, kb > 0 ? kb - 1 : 0); __builtin_amdgcn_sched_barrier(0);
        ATT_BLOCK(kfA, vfA, kb);
        if (kb == 0 || __all(carry > thr)) break;
        ATT_LOAD(kfA, vfA, kb > 1 ? kb - 2 : 0); __builtin_amdgcn_sched_barrier(0);
        ATT_BLOCK(kfB, vfB, kb - 1);
        if (__all(carry > thr)) break;
    }
#undef ATT_LOAD
#undef ATT_BLOCK
    float ss = 0.f;
#pragma unroll
    for (int i = 0; i < 16; ++i) ss += O0[i] * O0[i] + O1[i] * O1[i];
    ss += __shfl_xor(ss, 32);
    const float rs = 1.f / sqrtf(ss * (1.f / 64.f) + EPS);
    bf16* orow = (bf16*)(F.ws + WS_MIX) + ((size_t)b * SEQ + q0 + r) * D + h * 64;
#pragma unroll
    for (int db = 0; db < 2; ++db) { unsigned op[4][2];
#pragma unroll
        for (int gq = 0; gq < 4; ++gq) { const f32x4 gg = gout[db][gq];
            const float a0 = (db ? O1[4 * gq + 0] : O0[4 * gq + 0]) * rs * gg.x, a1 = (db ? O1[4 * gq + 1] : O0[4 * gq + 1]) * rs * gg.y, a2 = (db ? O1[4 * gq + 2] : O0[4 * gq + 2]) * rs * gg.z, a3 = (db ? O1[4 * gq + 3] : O0[4 * gq + 3]) * rs * gg.w;
            op[gq][0] = pkbf(a0, a1); op[gq][1] = pkbf(a2, a3); }
        v4u P[2];
#pragma unroll
        for (int gp = 0; gp < 2; ++gp) { const auto s0 = __builtin_amdgcn_permlane32_swap(op[2 * gp][0], op[2 * gp + 1][0], false, false), s1 = __builtin_amdgcn_permlane32_swap(op[2 * gp][1], op[2 * gp + 1][1], false, false);
            P[gp] = (v4u){s0[0], s1[0], s0[1], s1[1]}; }
        const bool odd = r & 1; v4u sA, sB; pair_trade(P[0], P[1], odd, sA, sB);
        bf16* oE = orow - (odd ? D : 0) + 32 * db + 8 * (hh + 2 * (odd ? 1 : 0));
        *(GAS v4u*)oE = sA; *(GAS v4u*)(oE + D) = sB; }
}
__device__ __forceinline__ void attn_phase(Frame& F) {
    const int r = F.lane & 31, hh = F.lane >> 5;
    float mq = fabsf(F.sb_q_g[F.lane]), mk = fabsf(F.sb_k_g[F.lane]);
#pragma unroll
    for (int o = 1; o < 64; o <<= 1) { mq = fmaxf(mq, __shfl_xor(mq, o)); mk = fmaxf(mk, __shfl_xor(mk, o)); }
    const float thr = 64.f * QSCALE * mq * mk * 1.02f + 151.f;
    bf16x8 Lt[2];
#pragma unroll
    for (int ks = 0; ks < 2; ++ks) { float e[8];
#pragma unroll
        for (int jj = 0; jj < 8; ++jj) e[jj] = (16 * ks + 8 * (jj >> 2) + 4 * hh + (jj & 3) >= r) ? 1.f : 0.f;
        Lt[ks] = pack8(e[0], e[1], e[2], e[3], e[4], e[5], e[6], e[7]); }
    for (int it = F.gw; it < 2048; it += F.ngw) { const int bh = it & 127, j = it >> 7;
        attn_item(F, bh, 63 - j, thr, Lt); attn_item(F, bh, j, thr, Lt); attn_item(F, bh, 47 - j, thr, Lt); attn_item(F, bh, 16 + j, thr, Lt); }
}

constexpr int HG_PART = 0, HG_SSQ = 2048, HG_QE = 4096, HG_KE = HG_QE + 64 * 272, HG_VT = HG_KE + 64 * 272, HG_KST = HG_VT + 128 * 144, HG_ST = HG_KST + 128 * 144, HG_END = HG_ST + 128 * 272;
static_assert(HG_END <= RING_BYTES, "HGRN2 LDS map");
__device__ __forceinline__ float hg_lbound(Frame& F, int h, int d) { const int c = h * 128 + d; return 1.f / (1.f + __expf(F.hg_lb[512 + c] - F.hg_lb[c])); }
__device__ __forceinline__ void hg_gates(Frame& F, const unsigned short (&ffr)[16], float lb, int d, int tq, float (&bb)[16], float (&kk)[16], float& total) {
    float run = 1.f;
#pragma unroll
    for (int i = 0; i < 16; ++i) { const float ff = bf2f(ffr[i]); const float sg = __builtin_amdgcn_rcpf(1.f + __expf(-ff));
        const float f = lb + (1.f - lb) * sg; kk[i] = (1.f - lb) * (1.f - sg); run *= f; bb[i] = run; }
    LAS float* part = (LAS float*)(F.lds + RING_OFF + HG_PART);
    part[tq * 128 + d] = run;
    __syncthreads();
    const float p0 = part[d], p1 = part[128 + d], p2 = part[256 + d], p3 = part[384 + d];
    const float off = (tq > 0 ? p0 : 1.f) * (tq > 1 ? p1 : 1.f) * (tq > 2 ? p2 : 1.f);
    total = (p0 * p1) * (p2 * p3);
#pragma unroll
    for (int i = 0; i < 16; ++i) bb[i] *= off;
}
#define HG_HV() const bf16* const PHp = (const bf16*)(F.ws + WS_PH); \
    const __amdgpu_buffer_rsrc_t rsrcP = __builtin_amdgcn_make_buffer_rsrc((void*)PHp, 0, (int)((size_t)4 * T * 512 * 2), 0x00020000)
#define HG_SOFF(item_, arr_) ((unsigned)((((arr_) * 16 + (((item_) >> 5) >> 2)) * 4 + (((item_) >> 5) & 3)) * SEQ + ((item_) & 31) * 64) * 256u)
#define HG_ARR(col_) ((col_) == OFF_HQ ? 0 : (col_) == OFF_HF ? 1 : (col_) == OFF_HI ? 2 : 3)
#define HG_LOADT(dst2, item_, arr_) do { const unsigned so_ = (unsigned)__builtin_amdgcn_readfirstlane((int)HG_SOFF(item_, arr_)); _Pragma("unroll") for (int j_ = 0; j_ < 2; ++j_) \
        (dst2)[j_] = __builtin_bit_cast(v4u, __builtin_amdgcn_raw_buffer_load_b128(rsrcP, (unsigned)F.tid * 16u + 8192u * j_, so_, 0)); } while (0)
#define HG_PUT(src2, raw_) do { _Pragma("unroll") for (int j_ = 0; j_ < 2; ++j_) *(LAS v4u*)((raw_) + ((F.tid >> 4) + 32 * j_) * 272 + (F.tid & 15) * 16) = (src2)[j_]; } while (0)
#define HG_COL(dst, raw_) do { _Pragma("unroll") for (int i_ = 0; i_ < 16; ++i_) dst[i_] = *(const LAS unsigned short*)((raw_) + (16 * tq + i_) * 272 + 2 * d); } while (0)
template <bool PERMUTE> __device__ __forceinline__ void st16(LAS unsigned char* dst, const float (&v)[16]) {
    v4u a, b2;
    if (!PERMUTE) { a.x = pkbf(v[0], v[1]); a.y = pkbf(v[2], v[3]); a.z = pkbf(v[4], v[5]); a.w = pkbf(v[6], v[7]); b2.x = pkbf(v[8], v[9]); b2.y = pkbf(v[10], v[11]); b2.z = pkbf(v[12], v[13]); b2.w = pkbf(v[14], v[15]); }
    else { a.x = pkbf(v[0], v[1]); a.y = pkbf(v[2], v[3]); a.z = pkbf(v[8], v[9]); a.w = pkbf(v[10], v[11]); b2.x = pkbf(v[4], v[5]); b2.y = pkbf(v[6], v[7]); b2.z = pkbf(v[12], v[13]); b2.w = pkbf(v[14], v[15]); }
    *(LAS v4u*)dst = a; *(LAS v4u*)(dst + 16) = b2;
}
__device__ __forceinline__ void hgA_phase(Frame& F) {
    const int d = F.tid & 127, tq = F.tid >> 7, r = F.lane & 31, hh = F.lane >> 5;
    const bf16* P = (const bf16*)(F.ws + WS_P); bf16* KVS = (bf16*)(F.ws + WS_KVS); float* DEC = (float*)(F.ws + WS_DEC); float* SSEG = (float*)(F.ws + WS_SSEG); float* DSEG = (float*)(F.ws + WS_DSEG);
    LAS unsigned char* L = F.lds + RING_OFF; LAS float* decl = (LAS float*)(L + HG_SSQ);
    HG_HV();
    v4u rf[2], rv[2];
    LAS unsigned char* const RAWF = F.lds + ROWTAB_OFF; LAS unsigned char* const RAWV = L + HG_ST;
    for (int wg = blockIdx.x; wg < 256; wg += F.G) {
        const int bh = wg >> 2, seg = wg & 3, item0 = bh * 32 + seg * 8, h = bh & 3;
        HG_LOADT(rf, item0, 1); HG_LOADT(rv, item0, 2);
        const float lbv = hg_lbound(F, h, d); float totrun = 1.f;
        const int db = F.wave & 3, eb0 = 2 * (F.wave >> 2);
        f32x16 run0, run1;
#pragma unroll
        for (int i = 0; i < 16; ++i) { run0[i] = 0.f; run1[i] = 0.f; }
      for (int k = 0; k < 8; ++k) {
        const int item = item0 + k;
        HG_PUT(rf, RAWF); HG_PUT(rv, RAWV);
        __syncthreads();
        { const int nit = k < 7 ? item + 1 : item; HG_LOADT(rf, nit, 1); HG_LOADT(rv, nit, 2); __builtin_amdgcn_sched_barrier(0); }
        unsigned short ffr[16], vr[16]; HG_COL(ffr, RAWF); HG_COL(vr, RAWV);
        float bb[16], kk[16], total; hg_gates(F, ffr, lbv, d, tq, bb, kk, total);
        float ks[16], vv[16];
#pragma unroll
        for (int i = 0; i < 16; ++i) { ks[i] = kk[i] * (total * __builtin_amdgcn_rcpf(bb[i])); vv[i] = bf2f(vr[i]); }
        st16<false>(L + HG_KST + d * 144 + tq * 32, ks); st16<false>(L + HG_VT + d * 144 + tq * 32, vv);
        const float dc = total; totrun *= total;
        if (tq == 0) { DEC[(size_t)item * 128 + d] = dc; decl[d] = dc; }
        __syncthreads();
        f32x16 acc0, acc1;
#pragma unroll
        for (int i = 0; i < 16; ++i) { acc0[i] = 0.f; acc1[i] = 0.f; }
#pragma unroll
        for (int s = 0; s < 4; ++s) { const bf16x8 af = *(const LAS bf16x8*)(L + HG_KST + (db * 32 + r) * 144 + 32 * s + 16 * hh);
            const bf16x8 b0 = *(const LAS bf16x8*)(L + HG_VT + (eb0 * 32 + r) * 144 + 32 * s + 16 * hh), b1 = *(const LAS bf16x8*)(L + HG_VT + ((eb0 + 1) * 32 + r) * 144 + 32 * s + 16 * hh);
            acc0 = MFMA32(af, b0, acc0); acc1 = MFMA32(af, b1, acc1); }
#pragma unroll
        for (int g = 0; g < 4; ++g) { const f32x4 dl = *(const LAS f32x4*)(decl + db * 32 + 8 * g + 4 * hh);
#pragma unroll
            for (int ii = 0; ii < 4; ++ii) { run0[4 * g + ii] = dl[ii] * run0[4 * g + ii] + acc0[4 * g + ii]; run1[4 * g + ii] = dl[ii] * run1[4 * g + ii] + acc1[4 * g + ii]; } }
#pragma unroll
        for (int j = 0; j < 2; ++j) { const bool odd = r & 1; bf16* dst = KVS + ((size_t)item * 128 + (eb0 + j) * 32 + (r & ~1)) * 128 + db * 32 + 8 * (hh + 2 * (odd ? 1 : 0));
            v4u P[2];
#pragma unroll
            for (int gp = 0; gp < 2; ++gp) { unsigned pk[2][2];
#pragma unroll
                for (int q = 0; q < 2; ++q) { const int g = 2 * gp + q; const float a0 = j ? acc1[4 * g + 0] : acc0[4 * g + 0], a1 = j ? acc1[4 * g + 1] : acc0[4 * g + 1], a2 = j ? acc1[4 * g + 2] : acc0[4 * g + 2], a3 = j ? acc1[4 * g + 3] : acc0[4 * g + 3];
                    pk[q][0] = pkbf(a0, a1); pk[q][1] = pkbf(a2, a3); }
                const auto s0 = __builtin_amdgcn_permlane32_swap(pk[0][0], pk[1][0], false, false), s1 = __builtin_amdgcn_permlane32_swap(pk[0][1], pk[1][1], false, false);
                P[gp] = (v4u){s0[0], s1[0], s0[1], s1[1]}; }
            v4u sA, sB; pair_trade(P[0], P[1], odd, sA, sB);
            *(GAS v4u*)dst = sA; *(GAS v4u*)(dst + 128) = sB; }
        __syncthreads();
      }
#pragma unroll
        for (int j = 0; j < 2; ++j) { float* dst = SSEG + ((size_t)wg * 128 + (eb0 + j) * 32 + r) * 128 + db * 32 + 4 * hh;
#pragma unroll
            for (int g = 0; g < 4; ++g) *(GAS f32x4*)(dst + 8 * g) = j ? (f32x4){run1[4 * g + 0], run1[4 * g + 1], run1[4 * g + 2], run1[4 * g + 3]} : (f32x4){run0[4 * g + 0], run0[4 * g + 1], run0[4 * g + 2], run0[4 * g + 3]}; }
        if (tq == 0) DSEG[(size_t)wg * 128 + d] = totrun;
    }
}
constexpr int HG_DECS = HG_END;
static_assert(HG_DECS + 4096 + 64 * 272 <= LDSCTL_OFF && HG_KST + 64 * 272 <= HG_ST && 64 * 272 <= MAXSLOT * 1536, "HGRN2 LDS map (decays, raw tiles)");
__device__ __forceinline__ void hgC_phase(Frame& F) {
    const int d = F.tid & 127, tq = F.tid >> 7, r = F.lane & 31, hh = F.lane >> 5;
    const bf16* P = (const bf16*)(F.ws + WS_P); const bf16* KVS = (const bf16*)(F.ws + WS_KVS); bf16* MIX = (bf16*)(F.ws + WS_MIX); const float* DEC = (const float*)(F.ws + WS_DEC);
    HG_HV();
    LAS unsigned char* L = F.lds + RING_OFF; const LAS float* decs = (const LAS float*)(L + HG_DECS);
    const int srow = (F.tid >> 6) * 16 + ((F.tid & 63) >> 4), sd0 = 8 * (F.tid & 15);
    v4u rf[2], rq[2], rv[2], st[4];
    LAS unsigned char* const RAWF = L + HG_KST; LAS unsigned char* const RAWQ = F.lds + ROWTAB_OFF; LAS unsigned char* const RAWV = L + HG_DECS + 4096;
    const __amdgpu_buffer_rsrc_t rsrcG = __builtin_amdgcn_make_buffer_rsrc((void*)F.hg_out_g, 0, 512 * 4, 0x00020000), rsrcSS = __builtin_amdgcn_make_buffer_rsrc((void*)(F.ws + WS_SSEG), 0, 256 * 128 * 128 * 4, 0x00020000), rsrcDS = __builtin_amdgcn_make_buffer_rsrc((void*)(F.ws + WS_DSEG), 0, 256 * 128 * 4, 0x00020000);
    const __amdgpu_buffer_rsrc_t rsrcD = __builtin_amdgcn_make_buffer_rsrc((void*)DEC, 0, 64 * 32 * 128 * 4, 0x00020000), rsrcM = __builtin_amdgcn_make_buffer_rsrc((void*)MIX, 0, (int)((size_t)T * D * 2), 0x00020000);
    const __amdgpu_buffer_rsrc_t rsrcK = __builtin_amdgcn_make_buffer_rsrc((void*)KVS, 0, 64 * 32 * 128 * 128 * 2, 0x00020000); const unsigned kvo = (unsigned)((srow * 128 + sd0) * 2);
#define HG_LOADKV(dst_, item_) do { const unsigned so_ = (unsigned)__builtin_amdgcn_readfirstlane((int)((item_) * (128 * 128 * 2))); _Pragma("unroll") for (int j_ = 0; j_ < 4; ++j_) (dst_)[j_] = __builtin_bit_cast(v4u, __builtin_amdgcn_raw_buffer_load_b128(rsrcK, kvo + 1024u * j_, so_, 0)); } while (0)
#define HG_LOADST(item_) HG_LOADKV(st, item_)
#define HG_FOLD(kv_, c_) do { const f32x4 d0_ = *(const LAS f32x4*)(decs + (c_) * 128 + sd0), d1_ = *(const LAS f32x4*)(decs + (c_) * 128 + sd0 + 4); _Pragma("unroll") for (int j_ = 0; j_ < 4; ++j_) { const v4u k_ = (kv_)[j_]; \
        S[8 * j_ + 0] = d0_.x * S[8 * j_ + 0] + bflo(k_.x); S[8 * j_ + 1] = d0_.y * S[8 * j_ + 1] + bfhi(k_.x); S[8 * j_ + 2] = d0_.z * S[8 * j_ + 2] + bflo(k_.y); S[8 * j_ + 3] = d0_.w * S[8 * j_ + 3] + bfhi(k_.y); \
        S[8 * j_ + 4] = d1_.x * S[8 * j_ + 4] + bflo(k_.z); S[8 * j_ + 5] = d1_.y * S[8 * j_ + 5] + bfhi(k_.z); S[8 * j_ + 6] = d1_.z * S[8 * j_ + 6] + bflo(k_.w); S[8 * j_ + 7] = d1_.w * S[8 * j_ + 7] + bfhi(k_.w); } } while (0)
    for (int wg = blockIdx.x; wg < 256; wg += F.G) {
        const int bh = wg >> 2, seg = wg & 3, item0 = bh * 32 + seg * 8, b = bh >> 2, h = bh & 3;
        HG_LOADT(rf, item0, 1); HG_LOADT(rq, item0, 0); HG_LOADT(rv, item0, 2); HG_LOADST(item0);
        const unsigned dso0 = (unsigned)__builtin_amdgcn_readfirstlane((bh * 32 + seg * 8) * 128 * 4);
        const f32x4 decv = __builtin_bit_cast(f32x4, __builtin_amdgcn_raw_buffer_load_b128(rsrcD, (unsigned)(F.tid & 255) * 16u, dso0, 0));
        const float lbv = hg_lbound(F, h, d);
        __builtin_amdgcn_sched_barrier(0);
        float S[32];
#pragma unroll
        for (int j = 0; j < 32; ++j) S[j] = 0.f;
        for (int sp = 0; sp < seg; ++sp) {
            const unsigned sso = (unsigned)__builtin_amdgcn_readfirstlane((bh * 4 + sp) * 128 * 128 * 4), dso = (unsigned)__builtin_amdgcn_readfirstlane((bh * 4 + sp) * 128 * 4);
#pragma unroll
            for (int j0 = 0; j0 < 8; j0 += 8) { f32x4 sv[8], dv[8];
#pragma unroll
                for (int j = 0; j < 8; ++j) { sv[j] = __builtin_bit_cast(f32x4, __builtin_amdgcn_raw_buffer_load_b128(rsrcSS, (unsigned)((srow * 128 + sd0) * 4) + 2048u * ((j0 + j) >> 1) + 16u * ((j0 + j) & 1), sso, 0));
                    dv[j] = __builtin_bit_cast(f32x4, __builtin_amdgcn_raw_buffer_load_b128(rsrcDS, (unsigned)(sd0 * 4) + 16u * ((j0 + j) & 1), dso, 0)); }
#pragma unroll
                for (int j = 0; j < 8; ++j) { const int q = 4 * (j0 + j); S[q + 0] = dv[j].x * S[q + 0] + sv[j].x; S[q + 1] = dv[j].y * S[q + 1] + sv[j].y; S[q + 2] = dv[j].z * S[q + 2] + sv[j].z; S[q + 3] = dv[j].w * S[q + 3] + sv[j].w; } }
        }
        if (F.tid < 256) *((LAS f32x4*)(L + HG_DECS) + F.tid) = decv;
        __syncthreads();
      for (int k = 0; k < 8; ++k) {
        const int item = item0 + k, c = seg * 8 + k;
        const int tb = F.wave & 1, eb = F.wave >> 1;
        const int nit = k < 7 ? item + 1 : item;
        HG_PUT(rf, RAWF); HG_PUT(rq, RAWQ); HG_PUT(rv, RAWV);
        __syncthreads();
        HG_LOADT(rf, nit, 1); HG_LOADT(rq, nit, 0); HG_LOADT(rv, nit, 2); __builtin_amdgcn_sched_barrier(0);
        unsigned short ffr[16], qr[16], vr[16]; HG_COL(ffr, RAWF); HG_COL(qr, RAWQ); HG_COL(vr, RAWV);
        float bb[16], kk[16], total; hg_gates(F, ffr, lbv, d, tq, bb, kk, total);
        float vv[16];
#pragma unroll
        for (int i = 0; i < 16; ++i) { const int t = 16 * tq + i; const float q = bf2f(qr[i]);
            *(LAS unsigned short*)(L + HG_QE + t * 272 + 2 * d) = (unsigned short)pkbf(q * bb[i], 0.f);
            *(LAS unsigned short*)(L + HG_KE + t * 272 + 2 * d) = (unsigned short)pkbf(kk[i] * __builtin_amdgcn_rcpf(bb[i]), 0.f);
            vv[i] = bf2f(vr[i]); }
        st16<true>(L + HG_VT + d * 144 + tq * 32, vv);
#pragma unroll
        for (int j = 0; j < 4; ++j) { v4u w4; w4.x = pkbf(S[8 * j + 0], S[8 * j + 1]); w4.y = pkbf(S[8 * j + 2], S[8 * j + 3]); w4.z = pkbf(S[8 * j + 4], S[8 * j + 5]); w4.w = pkbf(S[8 * j + 6], S[8 * j + 7]);
            *(LAS v4u*)(L + HG_ST + (srow + 4 * j) * 272 + sd0 * 2) = w4; }
        HG_FOLD(st, k);
        v4u grw[2];
        { const bf16* grow_ = PHp + (((size_t)(3 * 16 + b) * 4 + h) * SEQ + c * 64 + tb * 32 + r) * 128;
#pragma unroll
            for (int gp = 0; gp < 2; ++gp) grw[gp] = *(const GAS v4u*)(grow_ + eb * 32 + 8 * (2 * gp + hh)); }
        HG_LOADST(nit); __builtin_amdgcn_sched_barrier(0);
        __syncthreads();
        f32x16 acc;
#pragma unroll
        for (int i = 0; i < 16; ++i) acc[i] = 0.f;
#define HG_QF(s_) (*(const LAS bf16x8*)(L + HG_QE + (tb * 32 + r) * 272 + 32 * (s_) + 16 * hh))
#pragma unroll
        for (int s = 0; s < 8; ++s) acc = MFMA32(*(const LAS bf16x8*)(L + HG_ST + (eb * 32 + r) * 272 + 32 * s + 16 * hh), HG_QF(s), acc);
        for (int sb = 0; sb <= tb; ++sb) {
            f32x16 at;
#pragma unroll
            for (int i = 0; i < 16; ++i) at[i] = 0.f;
#pragma unroll
            for (int s = 0; s < 8; ++s) at = MFMA32(*(const LAS bf16x8*)(L + HG_KE + (sb * 32 + r) * 272 + 32 * s + 16 * hh), HG_QF(s), at);
            float a[16];
#pragma unroll
            for (int i = 0; i < 16; ++i) a[i] = (sb < tb || crow16(i, hh) <= r) ? at[i] : 0.f;
            const bf16x8 ab0 = pack8(a[0], a[1], a[2], a[3], a[4], a[5], a[6], a[7]), ab1 = pack8(a[8], a[9], a[10], a[11], a[12], a[13], a[14], a[15]);
            acc = MFMA32(*(const LAS bf16x8*)(L + HG_VT + (eb * 32 + r) * 144 + sb * 64 + 0 + 16 * hh), ab0, acc);
            acc = MFMA32(*(const LAS bf16x8*)(L + HG_VT + (eb * 32 + r) * 144 + sb * 64 + 32 + 16 * hh), ab1, acc);
        }
        float ss = 0.f;
#pragma unroll
        for (int i = 0; i < 16; ++i) ss += acc[i] * acc[i];
        ss += __shfl_xor(ss, 32);
        LAS float* ssq = (LAS float*)(L + HG_SSQ);
        if (hh == 0) ssq[eb * 64 + tb * 32 + r] = ss;
        f32x4 ggv[4];
        { const unsigned so = (unsigned)__builtin_amdgcn_readfirstlane(h * 512);
#pragma unroll
            for (int g = 0; g < 4; ++g) ggv[g] = __builtin_bit_cast(f32x4, __builtin_amdgcn_raw_buffer_load_b128(rsrcG, (unsigned)((eb * 32 + 8 * g + 4 * hh) * 4), so, 0)); }
        __syncthreads();
        const int tl = tb * 32 + r; const float tot = (ssq[tl] + ssq[64 + tl]) + (ssq[128 + tl] + ssq[192 + tl]);
        const float rs = 1.f / sqrtf(tot * (1.f / 128.f) + EPS);
        const unsigned mso = (unsigned)__builtin_amdgcn_readfirstlane((int)((((unsigned)b * SEQ + c * 64) * D + 512 + h * 128) * 2)), mvo = (unsigned)((tl * D + eb * 32) * 2);
        unsigned long long grv[4];
#pragma unroll
        for (int gp = 0; gp < 2; ++gp) { const auto sa = __builtin_amdgcn_permlane32_swap(grw[gp].x, grw[gp].z, false, false), sb = __builtin_amdgcn_permlane32_swap(grw[gp].y, grw[gp].w, false, false);
            grv[2 * gp] = (unsigned long long)sa[0] | ((unsigned long long)sb[0] << 32); grv[2 * gp + 1] = (unsigned long long)sa[1] | ((unsigned long long)sb[1] << 32); }
        unsigned yp[4][2];
#pragma unroll
        for (int g = 0; g < 4; ++g) { const unsigned long long gr = grv[g]; const f32x4 gg = ggv[g];
            const float g0 = bflo((unsigned)gr), g1 = bfhi((unsigned)gr), g2 = bflo((unsigned)(gr >> 32)), g3 = bfhi((unsigned)(gr >> 32));
            const float y0 = acc[4 * g + 0] * rs * gg.x * (g0 * __builtin_amdgcn_rcpf(1.f + __expf(-g0))), y1 = acc[4 * g + 1] * rs * gg.y * (g1 * __builtin_amdgcn_rcpf(1.f + __expf(-g1)));
            const float y2 = acc[4 * g + 2] * rs * gg.z * (g2 * __builtin_amdgcn_rcpf(1.f + __expf(-g2))), y3 = acc[4 * g + 3] * rs * gg.w * (g3 * __builtin_amdgcn_rcpf(1.f + __expf(-g3)));
            yp[g][0] = pkbf(y0, y1); yp[g][1] = pkbf(y2, y3); }
        { v4u P[2];
#pragma unroll
            for (int gp = 0; gp < 2; ++gp) { const auto s0 = __builtin_amdgcn_permlane32_swap(yp[2 * gp][0], yp[2 * gp + 1][0], false, false), s1 = __builtin_amdgcn_permlane32_swap(yp[2 * gp][1], yp[2 * gp + 1][1], false, false);
                P[gp] = (v4u){s0[0], s1[0], s0[1], s1[1]}; }
            const bool odd = r & 1; v4u sA, sB; pair_trade(P[0], P[1], odd, sA, sB);
            const unsigned mvE = (unsigned)((((tb * 32 + (r & ~1)) * D + eb * 32) * 2) + 16 * (hh + 2 * (odd ? 1 : 0)));
            __builtin_amdgcn_raw_buffer_store_b128(sA, rsrcM, mvE, mso, 0); __builtin_amdgcn_raw_buffer_store_b128(sB, rsrcM, mvE + (unsigned)(D * 2), mso, 0); }
        __syncthreads();
      }
    }
#undef HG_LOADST
#undef HG_LOADKV
#undef HG_FOLD
#undef HG_QF
}
#undef HG_LOADT
#undef HG_PUT
#undef HG_COL
#undef HG_ARR
#undef HG_SOFF
#undef HG_HV

__device__ __forceinline__ void router_phase(Frame& F) {
    LAS unsigned char* L = F.lds; const int r = F.lane & 31, hh = F.lane >> 5;
    LAS unsigned* lcnt = (LAS unsigned*)(F.lds + LTAB_OFF) + LT_MISC; LAS unsigned* lbase = lcnt + 32; LAS float* lrstd = (LAS float*)(F.lds + ROWTAB_OFF);
    float* TOPG = (float*)(F.ws + WS_TOPG);
    {
        const GAS v4u* img = (const GAS v4u*)(F.ws + WS_RT) + vzero();
        constexpr int NB = (RT_END / 16 + NWAVES * 64 - 1) / (NWAVES * 64);
        v4u t4[NB];
#pragma unroll
        for (int j = 0; j < NB; ++j) { const int q = F.tid + j * NWAVES * 64; t4[j] = img[q < RT_END / 16 ? q : 0]; }
#pragma unroll
        for (int j = 0; j < NB; ++j) { const int q = F.tid + j * NWAVES * 64; if (q < RT_END / 16) *(LAS v4u*)(L + 16 * q) = t4[j]; }
    }
    const bf16* XH = (const bf16*)(F.ws + WS_XN); int* LIST = (int*)(F.ws + WS_LIST); unsigned* cnt = (unsigned*)(F.ctl + CW_CNT);
    for (int base = blockIdx.x * 4; base < T / 32; base += F.G * 4) {
        const int grp = base + F.wave; const bool active = F.wave < 4 && grp < T / 32;
        if (F.tid < 32) lcnt[F.tid] = 0u;
        __syncthreads();
        float sv[4] = {0.f, 0.f, 0.f, 0.f}; int se[4] = {0, 0, 0, 0}; unsigned lp0 = 0u, lp1 = 0u; float rstd = 0.f; const int tok = grp * 32 + r;
        if (active) {
            const bf16* hrow = XH + (size_t)tok * D + 8 * hh;
            f32x16 acc;
#pragma unroll
            for (int i = 0; i < 16; ++i) acc[i] = 0.f;
            float ssq = 0.f;
#pragma unroll 16
            for (int s = 0; s < 64; ++s) {
                const v4u hu = *(const GAS v4u*)(hrow + 16 * s); const bf16x8 hi = __builtin_bit_cast(bf16x8, hu);
                { const float a0 = bflo(hu.x), a1 = bfhi(hu.x), a2 = bflo(hu.y), a3 = bfhi(hu.y), a4 = bflo(hu.z), a5 = bfhi(hu.z), a6 = bflo(hu.w), a7 = bfhi(hu.w);
                    ssq += (a0 * a0 + a1 * a1) + (a2 * a2 + a3 * a3) + (a4 * a4 + a5 * a5) + (a6 * a6 + a7 * a7); }
                const bf16x8 wh = *(const LAS bf16x8*)(L + r * RT_ROW + 32 * s + 16 * hh), wl = *(const LAS bf16x8*)(L + RT_WL + r * RT_ROW + 32 * s + 16 * hh);
                acc = MFMA32(wh, hi, acc); acc = MFMA32(wl, hi, acc);
            }
            ssq += __shfl_xor(ssq, 32);
            rstd = 1.f / sqrtf(ssq * (1.f / D) + EPS);
            float l[16];
#pragma unroll
            for (int i = 0; i < 16; ++i) l[i] = acc[i] * rstd + F.b_router[crow16(i, hh)];
            float cv[8]; int ce[8];
#pragma unroll
            for (int rnd = 0; rnd < 4; ++rnd) { float bv = l[0]; int bi = 0;
#pragma unroll
                for (int i = 1; i < 16; ++i) if (l[i] > bv) { bv = l[i]; bi = i; }
                cv[rnd] = bv; ce[rnd] = crow16(bi, hh);
#pragma unroll
                for (int i = 0; i < 16; ++i) if (i == bi) l[i] = -__builtin_inff(); }
#pragma unroll
            for (int j = 0; j < 4; ++j) { cv[4 + j] = __shfl_xor(cv[j], 32); ce[4 + j] = __shfl_xor(ce[j], 32); }
#pragma unroll
            for (int rnd = 0; rnd < 4; ++rnd) { float bv = cv[0]; int be = ce[0]; int bj = 0;
#pragma unroll
                for (int j = 1; j < 8; ++j) if (cv[j] > bv || (cv[j] == bv && ce[j] < be)) { bv = cv[j]; be = ce[j]; bj = j; }
                sv[rnd] = bv; se[rnd] = be;
#pragma unroll
                for (int j = 0; j < 8; ++j) if (j == bj) { cv[j] = -__builtin_inff(); ce[j] = 64; } }
            lp0 = __hip_atomic_fetch_add(lcnt + (hh ? se[2] : se[0]), 1u, __ATOMIC_RELAXED, __HIP_MEMORY_SCOPE_WORKGROUP);
            lp1 = __hip_atomic_fetch_add(lcnt + (hh ? se[3] : se[1]), 1u, __ATOMIC_RELAXED, __HIP_MEMORY_SCOPE_WORKGROUP);
        }
        __syncthreads();
        if (F.tid < 32) lbase[F.tid] = __hip_atomic_fetch_add(cnt + F.tid, lcnt[F.tid], __ATOMIC_RELAXED, __HIP_MEMORY_SCOPE_AGENT);
        __syncthreads();
        if (active) {
            const float e1 = __expf(sv[1] - sv[0]), e2 = __expf(sv[2] - sv[0]), e3 = __expf(sv[3] - sv[0]); const float inv = 1.f / (1.f + e1 + e2 + e3);
            const int ea = hh ? se[2] : se[0], eb = hh ? se[3] : se[1]; const float ga = (hh ? e2 : 1.f) * inv, gb = (hh ? e3 : e1) * inv;
            const size_t ia = (size_t)ea * 32768 + lbase[ea] + lp0, ib = (size_t)eb * 32768 + lbase[eb] + lp1;
            LIST[ia] = tok * 4 + 2 * hh; LIST[ib] = tok * 4 + 2 * hh + 1; TOPG[tok * 4 + 2 * hh] = ga; TOPG[tok * 4 + 2 * hh + 1] = gb;
            if (hh == 0) lrstd[F.wave * 32 + r] = rstd;
        }
        __syncthreads();
        {
            unsigned char* X8 = F.ws + WS_X8; const int t0 = base * 32;
#pragma unroll
            for (int q0 = 0; q0 < 16; q0 += 4) { v4u a[4][2];
#pragma unroll
                for (int q = 0; q < 4; ++q) { const int tt = t0 + F.wave * 16 + q0 + q; const GAS v4u* p = (const GAS v4u*)(XH + (size_t)(tt < T ? tt : 0) * D) + 2 * F.lane; a[q][0] = p[0]; a[q][1] = p[1]; }
#pragma unroll
                for (int q = 0; q < 4; ++q) { const int tl = F.wave * 16 + q0 + q, tt = t0 + tl; if (tt < T) { const float rs = lrstd[tl]; v4u o;
                    o.x = pg8::pk4_fp8(bflo(a[q][0].x) * rs, bfhi(a[q][0].x) * rs, bflo(a[q][0].y) * rs, bfhi(a[q][0].y) * rs); o.y = pg8::pk4_fp8(bflo(a[q][0].z) * rs, bfhi(a[q][0].z) * rs, bflo(a[q][0].w) * rs, bfhi(a[q][0].w) * rs);
                    o.z = pg8::pk4_fp8(bflo(a[q][1].x) * rs, bfhi(a[q][1].x) * rs, bflo(a[q][1].y) * rs, bfhi(a[q][1].y) * rs); o.w = pg8::pk4_fp8(bflo(a[q][1].z) * rs, bfhi(a[q][1].z) * rs, bflo(a[q][1].w) * rs, bfhi(a[q][1].w) * rs);
                    *((GAS v4u*)(X8 + (size_t)tt * D) + F.lane) = o; } } }
        }
        __syncthreads();
    }
}
__device__ __forceinline__ int build_moe_tables(Frame& F, int ntn, int mode) {
    LAS int* lt = (LAS int*)(F.lds + LTAB_OFF);
    if (F.wave == 0) {
        const int e = F.lane & 31; const int c = (int)__hip_atomic_load((unsigned*)(F.ctl + CW_CNT) + e, __ATOMIC_RELAXED, __HIP_MEMORY_SCOPE_AGENT);
        const int tl = (c + 255) >> 8; int inc = tl;
#pragma unroll
        for (int off = 1; off < 32; off <<= 1) { const int o = __shfl_up(inc, off, 32); if (e >= off) inc += o; }
        const int tot = __shfl(inc, 31, 32), t0 = inc - tl;
        if (F.lane < 32) { lt[LT_TS + e] = t0; lt[LT_CNT + e] = c; for (int i = 0; i < tl; ++i) lt[t0 + i] = e; }
        if (F.lane == 0) lt[LT_MISC + 64] = tot;
    }
    __syncthreads();
    int nt = lt[LT_MISC + 64]; nt = nt < 0 ? 0 : (nt > MAXTILES ? MAXTILES : nt); nt = __builtin_amdgcn_readfirstlane(nt);
    const int* LIST = (const int*)(F.ws + WS_LIST);
    const int nslot = mode == 1 ? MAXSLOT : (MAXTILES * 4 + 255) / 256;
    for (int q = F.tid; q < nslot * 256; q += NWAVES * 64) { const int i = q >> 8, rr = q & 255; const int Lu = i * F.G + F.vcu;
        int li = -1; float bias = 0.f;
        if (Lu < nt * ntn) { const int pm0 = Lu / ntn, pl = Lu - pm0 * ntn, pm = mode == 2 ? nt - 1 - pm0 : pm0, e = lt[pm], idx = (pm - lt[LT_TS + e]) * 256 + rr; if (idx < lt[LT_CNT + e]) li = LIST[(size_t)e * 32768 + idx];
            bias = mode == 1 ? F.b_gu[(size_t)e * 2048 + (rr >> 7) * 1024 + pl * 128 + (rr & 127)] : F.b_d[(size_t)e * 1024 + pl * 256 + rr]; }
        ((LAS float*)(F.lds + ROWTAB_OFF))[q] = bias;
        if (mode == 1) ((LAS unsigned short*)(F.lds + ROWTAB2_OFF))[q] = (unsigned short)(li < 0 ? 0 : (li >> 2));
        else ((LAS int*)(F.lds + ROWTAB_OFF) + nslot * 256)[q] = li; }
    __syncthreads();
    return nt;
}
__device__ __forceinline__ void combine_phase(Frame& F) {
    const unsigned char* YK = F.ws + WS_YK; const bf16* XH = (const bf16*)(F.ws + WS_XN); const float* TOPG = (const float*)(F.ws + WS_TOPG);
    for (int t = F.gw; t < T; t += F.ngw) {
        GAS f32x4* xr = (GAS f32x4*)(F.out + (size_t)t * D) + F.lane; f32x4 v[4]; unsigned y[4][4]; const f32x4 gt = *((const GAS f32x4*)TOPG + t + vzero()) * (1.0f / Y8_SCALE);
#pragma unroll
        for (int j = 0; j < 4; ++j) { const unsigned long long xh = __builtin_nontemporal_load((const GAS unsigned long long*)(XH + (size_t)t * D) + F.lane + 64 * j);
            v[j] = (f32x4){bflo((unsigned)xh), bfhi((unsigned)xh), bflo((unsigned)(xh >> 32)), bfhi((unsigned)(xh >> 32))};
#pragma unroll
            for (int k = 0; k < 4; ++k) y[j][k] = __builtin_nontemporal_load((const GAS unsigned*)(YK + ((size_t)t * 4 + k) * D) + F.lane + 64 * j); }
#pragma unroll
        for (int j = 0; j < 4; ++j) { f32x4 s4 = {0.f, 0.f, 0.f, 0.f};
#pragma unroll
            for (int k = 0; k < 4; ++k) { const f32x2n_ lo = __builtin_amdgcn_cvt_pk_f32_fp8((int)y[j][k], false), hi = __builtin_amdgcn_cvt_pk_f32_fp8((int)y[j][k], true); const float g = gt[k]; s4.x += g * lo.x; s4.y += g * lo.y; s4.z += g * hi.x; s4.w += g * hi.y; }
            v[j] = v[j] + s4;
            __builtin_nontemporal_store(v[j], xr + 64 * j); }
    }
}

constexpr int NPH = 9;
struct Args { const float* in[16]; float* out; unsigned char* ws; int ph_lo, ph_hi; };
__global__ void __launch_bounds__(NWAVES * 64, 2) fwd(Args args) {
    extern __shared__ __attribute__((aligned(16))) unsigned char lds[];
    Frame F;
    F.lds = (LAS unsigned char*)lds;
    F.MISC = (volatile LAS unsigned*)(F.lds + MISC_OFF);
    F.tid = threadIdx.x; F.lane = F.tid & 63; F.wave = __builtin_amdgcn_readfirstlane(F.tid >> 6);
    F.G = gridDim.x; { const int bx = blockIdx.x; F.vcu = (F.G % 8 == 0) ? (bx % 8) * (F.G / 8) + bx / 8 : bx; }
    F.gw = blockIdx.x * NWAVES + F.wave; F.ngw = F.G * NWAVES;
    F.ws = args.ws; F.ctl = (gu32*)(args.ws + WS_CTL); F.out = args.out;
    F.x = args.in[0]; F.norm1_g = args.in[1]; F.w_in = args.in[2]; F.sb_q_g = args.in[3]; F.sb_k_g = args.in[4]; F.sb_out_g = args.in[5]; F.hg_lb = args.in[6]; F.hg_out_g = args.in[7];
    F.w_out = args.in[8]; F.norm2_g = args.in[9]; F.w_router = args.in[10]; F.b_router = args.in[11]; F.w_gu = args.in[12]; F.b_gu = args.in[13]; F.w_d = args.in[14]; F.b_d = args.in[15];
    for (int u = F.tid; u < (LDS_BYTES - LDSCTL_OFF) / 4; u += NWAVES * 64) ((LAS unsigned*)(F.lds + LDSCTL_OFF))[u] = 0u;
    __syncthreads();
    XcdBarrier bar; bar.bar = (unsigned*)(F.ctl + CW_BAR); bar.x = 0; bar.st = nullptr;
    if (MK_ONE_LAUNCH) bar = xcd_barrier_post((unsigned*)(F.ctl + CW_BAR), F.MISC + 8);
    const int lo = args.ph_lo, hi = args.ph_hi;
#define IN(k) (lo <= (k) && (k) < hi && ((F.lane = lane_id()), (F.tid = F.wave * 64 + F.lane), true))
#define SEAM(k) do { if (IN(k) && IN((k) + 1)) xcd_barrier(bar); } while (0)

    if (IN(0)) { p0_prologue(F); } SEAM(0);
    if (IN(1)) {
        pg8::Gemm g{(const bf16*)(F.ws + WS_XN), (const bf16*)(F.ws + WS_WIN), T, NIN, D}; pg8::StaticOrder S; S.init(T, NIN, F.G, (int)blockIdx.x);
        pg8::EpiInproj E{(bf16*)(F.ws + WS_P), (bf16*)(F.ws + WS_PH), (bf16*)(F.ws + WS_QN), (bf16*)(F.ws + WS_KN), F.sb_q_g, F.sb_k_g, QSCALE, EPS};
        pg8::gemm_phase<pg8::EpiInproj, pg8::StaticOrder, PG8_ALIGN, PG8_SP2>(F.lds + RING_OFF, g, S, E, F.tid);
    } SEAM(1);
    if (IN(2)) { prep_phase(F); __syncthreads(); hgA_phase(F); } SEAM(2);
    if (IN(3)) { attn_phase(F); hgC_phase(F); } SEAM(3);
    if (IN(4)) {
        pg8::Gemm g{(const bf16*)(F.ws + WS_MIX), (const bf16*)(F.ws + WS_WOUT), T, D, D}; pg8::StaticOrder S; S.init(T, D, F.G, (int)blockIdx.x);
        pg8::EpiRes E{F.x, (bf16*)(F.ws + WS_XN), D};
        pg8::gemm_phase<pg8::EpiRes, pg8::StaticOrder, PG8_ALIGN, PG8_SP2>(F.lds + RING_OFF, g, S, E, F.tid);
    } SEAM(4);
    if (IN(5)) { router_phase(F); } SEAM(5);
    if (IN(6)) {
        const int nt = build_moe_tables(F, 8, 1); const LAS int* lt = (const LAS int*)(F.lds + LTAB_OFF);
        pg8::Gemm g{(const bf16*)(F.ws + WS_X8), (const bf16*)(F.ws + WS_WGU), MAXROWS, NE * 2048, D / 2};
        pg8::MoeOrder S{lt, (const LAS unsigned short*)(F.lds + ROWTAB2_OFF), 8, nt * 8, F.G, F.vcu, 1024u, 0};
        pg8::EpiAct<true> E{F.ws + WS_ACT, (const LAS float*)(F.lds + ROWTAB_OFF), A8_SCALE};
        pg8::gemm_phase<pg8::EpiAct<true>, pg8::MoeOrder, PG8_ALIGN, PG8_SP2, true, SC_W8, SC_ONE>(F.lds + RING_OFF, g, S, E, F.tid);
        {
            const int rem = (nt * 8) % F.G, nidle = F.G - rem; const bool few = rem == 0 || nidle < F.G / 4;
            __syncthreads();
            if (few) p0_items(F, P0_NITEMS - P0_NLATE, P0_NITEMS, F.vcu * NWAVES + F.wave, F.G * NWAVES);
            else if (F.vcu >= rem) p0_items(F, P0_NITEMS - P0_NLATE, P0_NITEMS, (F.vcu - rem) * NWAVES + F.wave, nidle * NWAVES);
        }
    } SEAM(6);
    if (IN(7)) {
        const int nt = build_moe_tables(F, 4, 2); const LAS int* lt = (const LAS int*)(F.lds + LTAB_OFF);
        pg8::Gemm g{(const bf16*)(F.ws + WS_ACT), (const bf16*)(F.ws + WS_WD), MAXROWS, NE * 1024, D / 2};
        pg8::MoeOrder S{lt, nullptr, 4, nt * 4, F.G, F.vcu, 1024u, nt};
        pg8::EpiDown E{F.ws + WS_YK, (const LAS int*)(F.lds + ROWTAB_OFF) + ((MAXTILES * 4 + 255) / 256) * 256, (const LAS float*)(F.lds + ROWTAB_OFF), Y8_SCALE};
        pg8::gemm_phase<pg8::EpiDown, pg8::MoeOrder, PG8_ALIGN, PG8_SP2, true, SC_W8Y, SC_A8>(F.lds + RING_OFF, g, S, E, F.tid);
    } SEAM(7);
    if (IN(8)) { combine_phase(F); }
#undef IN
#undef SEAM
}

extern "C" void kernel_launch(void* const* d_in, const int* in_sizes, int n_in, void* d_out, int out_size, void* d_ws, size_t ws_size, hipStream_t stream) {
    static int grid = 0;
    if (grid == 0) {
        if (n_in != 16 || in_sizes[0] != T * D || out_size != T * D || ws_size < WS_END) { fprintf(stderr, "kernel_launch: shape/workspace mismatch (n_in %d, ws %zu, need %zu); nothing launched\n", n_in, ws_size, (size_t)WS_END); grid = -1; return; }
        int dev = 0, cus = 0, per_cu = 0;
        if (hipGetDevice(&dev) != hipSuccess || hipDeviceGetAttribute(&cus, hipDeviceAttributeMultiprocessorCount, dev) != hipSuccess) { grid = -1; return; }
        if (hipFuncSetAttribute((const void*)fwd, hipFuncAttributeMaxDynamicSharedMemorySize, LDS_BYTES) != hipSuccess) { grid = -1; return; }
        if (hipOccupancyMaxActiveBlocksPerMultiprocessor(&per_cu, (const void*)fwd, NWAVES * 64, LDS_BYTES) != hipSuccess || per_cu < 1) { fprintf(stderr, "kernel_launch: occupancy query says %d\n", per_cu); }
        (void)hipGetLastError();
        if ((MAXTILES * 8 + cus - 1) / cus > MAXSLOT || cus < 1) { fprintf(stderr, "kernel_launch: %d CUs: the per-workgroup unit tables are sized for 256\n", cus); grid = -1; return; }
        grid = cus;
    }
    if (grid < 0) return;
    if (hipMemsetAsync((char*)d_ws + WS_CTL, 0, CTL_ZERO_BYTES, stream) != hipSuccess) return;
    Args a{};
    for (int i = 0; i < 16; ++i) a.in[i] = (const float*)d_in[i];
    a.out = (float*)d_out; a.ws = (unsigned char*)d_ws;
#if MK_ONE_LAUNCH
    a.ph_lo = 0; a.ph_hi = NPH;
    hipLaunchKernelGGL(fwd, dim3(grid), dim3(NWAVES * 64), LDS_BYTES, stream, a);
#else
    for (int p = 0; p < NPH; ++p) { a.ph_lo = p; a.ph_hi = p + 1; hipLaunchKernelGGL(fwd, dim3(grid), dim3(NWAVES * 64), LDS_BYTES, stream, a); }
#endif
}
```

```cpp
#include <hip/hip_runtime.h>
#include <cstdio>
#include <cstdint>
namespace pg8 {
#define PG8_LAS __attribute__((address_space(3)))
typedef unsigned short bf16_t;
typedef short bf16x8 __attribute__((ext_vector_type(8)));
typedef float f32x4 __attribute__((ext_vector_type(4)));
typedef unsigned u32x4 __attribute__((ext_vector_type(4)));
typedef int i32x4_t __attribute__((ext_vector_type(4)));
typedef int i32x8_t __attribute__((ext_vector_type(8)));
constexpr int BM = 256, BK = 64, HALF = 128, HTB = HALF * BK * 2  , STAGE_BYTES = 8 * HTB, NXCD = 8, WGM = 8;

__host__ __device__ __forceinline__ int lds_byte(int r, int c) { const int st = (r >> 4) * 2 + (c >> 5), rr = r & 15, cc = c & 31, ob = rr * 64 + cc * 2; return st * 1024 + (ob ^ (((ob >> 9) & 1) << 5)); }
__host__ __device__ __forceinline__ void stage_rc(int b, int& R, int& C) { const int st = b / 1024, sb = b % 1024, swz = sb ^ (((sb >> 9) & 1) << 5); R = (st >> 1) * 16 + swz / 64; C = (st & 1) * 32 + (swz % 64) / 2; }
__host__ __device__ __forceinline__ int perm32(int rho) { const int n = rho >> 4, i = rho & 15; return 8 * (i >> 2) + 4 * n + (i & 3); }

struct Unit { int pm, pn, slot; };
struct Gemm { const bf16_t* A; const bf16_t* Bt; int M, N, K; };

struct StaticOrder {
    int nM, nN, nwg, G, c;
    __host__ __device__ void init(int M, int N, int G_, int c_) { nM = M / BM; nN = N / BM; nwg = nM * nN; G = G_; c = c_; }
    __host__ __device__ bool next(int i, Unit& u) const {
        const long L = (long)i * G + c; if (L >= nwg) return false;
        int wgid = (int)L; { const int q = nwg / NXCD, r = nwg % NXCD, xcd = wgid % NXCD, off = wgid / NXCD; wgid = (xcd < r ? xcd * (q + 1) : r * (q + 1) + (xcd - r) * q) + off; }
        const int nig = WGM * nN, gid = wgid / nig, fm = gid * WGM, gsz = (nM - fm) < WGM ? (nM - fm) : WGM;
        u.pm = fm + ((wgid % nig) % gsz); u.pn = (wgid % nig) / gsz; return true;
    }
    __device__ __forceinline__ void a_ready(const Unit&) const {}
    __device__ __forceinline__ void done(const Unit&) const {}
};

__device__ __forceinline__ unsigned cvt_pk_bf16(float lo, float hi) { unsigned r; asm volatile("v_cvt_pk_bf16_f32 %0, %1, %2" : "=v"(r) : "v"(lo), "v"(hi)); return r; }
typedef float f32x2 __attribute__((ext_vector_type(2)));
__device__ __forceinline__ f32x2 gelu_pk(f32x2 v) {
    const f32x2 av = __builtin_elementwise_abs(v), d = av * 0.2316418882f + 1.0f;
    f32x2 t; t.x = __builtin_amdgcn_rcpf(d.x); t.y = __builtin_amdgcn_rcpf(d.y);
    f32x2 q = t * 0.5307027145f + (-0.7265760135f); q = q * t + 0.7107068705f; q = q * t + (-0.142248368f); q = q * t + 0.127414796f; q = q * t;
    const f32x2 s = (v * v) * (-0.72134752044f);
    f32x2 e; e.x = __builtin_amdgcn_exp2f(s.x); e.y = __builtin_amdgcn_exp2f(s.y);
    const f32x2 m = v * (q * e), r = v - m;
    f32x2 o; o.x = v.x < 0.f ? m.x : r.x; o.y = v.y < 0.f ? m.y : r.y; return o;
}

template <int ACT  > struct EpiBf16 {
    static constexpr bool PERM = true, AFTER_DRAIN = false, HAS_INIT = false, INIT_LOADS = false; static_assert(ACT == 0 || ACT == 1, "EpiBf16: ACT is 0 (none) or 1 (gelu_pk)");
    bf16_t* O; int ldc; const float* bias; int split_cols; size_t split_stride; float scale0;
    __device__ __forceinline__ void operator()(const f32x4 (&acc)[2][2][4][2], const Unit& u, int wr, int wc, int fr, int fq) const {
        const int row0 = u.pm * BM + wr * 64 + fr; int colt = u.pn * BM; bf16_t* base = O;
        float sc = 1.f; if (split_cols) { const int t = colt / split_cols; base += (size_t)t * split_stride; colt -= t * split_cols; if (t == 0) sc = scale0; }
        const int col0 = colt + wc * 32 + 8 * fq, bcol0 = u.pn * BM + wc * 32 + 8 * fq;
        f32x4 bv[2][2];
#pragma unroll
        for (int bj = 0; bj < 2; ++bj)
#pragma unroll
            for (int n = 0; n < 2; ++n) bv[bj][n] = bias ? *(const f32x4*)(bias + bcol0 + bj * HALF + 4 * n) : (f32x4){0.f, 0.f, 0.f, 0.f};
#pragma unroll
        for (int ai = 0; ai < 2; ++ai)
#pragma unroll
            for (int m = 0; m < 4; ++m) { bf16_t* rowp = base + (size_t)(row0 + ai * HALF + m * 16) * ldc + col0;
#pragma unroll
                for (int bj = 0; bj < 2; ++bj) { f32x4 v0 = acc[ai][bj][m][0] + bv[bj][0], v1 = acc[ai][bj][m][1] + bv[bj][1];
                    if (ACT == 1) { f32x2 a = gelu_pk((f32x2){v0[0], v0[1]}), b = gelu_pk((f32x2){v0[2], v0[3]}), c = gelu_pk((f32x2){v1[0], v1[1]}), d = gelu_pk((f32x2){v1[2], v1[3]});
                        v0 = (f32x4){a.x, a.y, b.x, b.y}; v1 = (f32x4){c.x, c.y, d.x, d.y}; }
                    v0 = v0 * sc; v1 = v1 * sc; u32x4 w; w.x = cvt_pk_bf16(v0[0], v0[1]); w.y = cvt_pk_bf16(v0[2], v0[3]); w.z = cvt_pk_bf16(v1[0], v1[1]); w.w = cvt_pk_bf16(v1[2], v1[3]);
                    *(u32x4*)(rowp + bj * HALF) = w; } }
    }
};

__device__ __forceinline__ unsigned pk4_fp8(float a, float b, float c, float d) {
    a = fminf(fmaxf(a, -448.f), 448.f); b = fminf(fmaxf(b, -448.f), 448.f); c = fminf(fmaxf(c, -448.f), 448.f); d = fminf(fmaxf(d, -448.f), 448.f);
    int p = 0; p = __builtin_amdgcn_cvt_pk_fp8_f32(a, b, p, false); p = __builtin_amdgcn_cvt_pk_fp8_f32(c, d, p, true); return (unsigned)p;
}
struct EpiRes {
    static constexpr bool PERM = true, AFTER_DRAIN = false, HAS_INIT = true, INIT_LOADS = true;
    const float* __restrict__ X; bf16_t* __restrict__ XH; int ldc;
    __device__ __forceinline__ void init(f32x4 (&acc)[2][2][4][2], const Unit& u, int wr, int wc, int fr, int fq) const {
        const bool odd = fr & 1; const int rowE0 = u.pm * BM + wr * 64 + (fr & ~1), col0 = u.pn * BM + wc * 64 + 8 * fq + (odd ? 4 : 0);
#pragma unroll
        for (int ai = 0; ai < 2; ++ai)
#pragma unroll
            for (int m = 0; m < 4; ++m) { const float* rp = X + (size_t)(rowE0 + ai * HALF + m * 16) * ldc + col0;
#pragma unroll
                for (int bj = 0; bj < 2; ++bj) { acc[ai][bj][m][0] = __builtin_nontemporal_load((const f32x4*)(rp + bj * 32)); acc[ai][bj][m][1] = __builtin_nontemporal_load((const f32x4*)(rp + ldc + bj * 32)); } }
        __builtin_amdgcn_s_waitcnt(0x0F70);
#pragma unroll
        for (int ai = 0; ai < 2; ++ai)
#pragma unroll
            for (int m = 0; m < 4; ++m)
#pragma unroll
                for (int bj = 0; bj < 2; ++bj) { const u32x4 r0 = __builtin_bit_cast(u32x4, acc[ai][bj][m][0]), r1 = __builtin_bit_cast(u32x4, acc[ai][bj][m][1]);
                    const unsigned s0 = odd ? r0.x : r1.x, s1 = odd ? r0.y : r1.y, s2 = odd ? r0.z : r1.z, s3 = odd ? r0.w : r1.w; u32x4 rcv;
                    rcv.x = (unsigned)__builtin_amdgcn_mov_dpp((int)s0, 0xB1, 0xF, 0xF, true); rcv.y = (unsigned)__builtin_amdgcn_mov_dpp((int)s1, 0xB1, 0xF, 0xF, true);
                    rcv.z = (unsigned)__builtin_amdgcn_mov_dpp((int)s2, 0xB1, 0xF, 0xF, true); rcv.w = (unsigned)__builtin_amdgcn_mov_dpp((int)s3, 0xB1, 0xF, 0xF, true);
                    u32x4 n0, n1; n0.x = odd ? rcv.x : r0.x; n0.y = odd ? rcv.y : r0.y; n0.z = odd ? rcv.z : r0.z; n0.w = odd ? rcv.w : r0.w; n1.x = odd ? r1.x : rcv.x; n1.y = odd ? r1.y : rcv.y; n1.z = odd ? r1.z : rcv.z; n1.w = odd ? r1.w : rcv.w;
                    acc[ai][bj][m][0] = __builtin_bit_cast(f32x4, n0); acc[ai][bj][m][1] = __builtin_bit_cast(f32x4, n1); }
    }
    __device__ __forceinline__ void operator()(const f32x4 (&acc)[2][2][4][2], const Unit& u, int wr, int wc, int fr, int fq) const {
        const bool odd = fr & 1; const int rowE0 = u.pm * BM + wr * 64 + (fr & ~1), col0 = u.pn * BM + wc * 64 + 8 * fq + (odd ? 32 : 0);
#pragma unroll
        for (int ai = 0; ai < 2; ++ai)
#pragma unroll
            for (int m = 0; m < 4; ++m) { bf16_t* rp = XH + (size_t)(rowE0 + ai * HALF + m * 16) * ldc + col0; u32x4 w[2];
#pragma unroll
                for (int bj = 0; bj < 2; ++bj) { const f32x4 v0 = acc[ai][bj][m][0], v1 = acc[ai][bj][m][1];
                    w[bj].x = cvt_pk_bf16(v0[0], v0[1]); w[bj].y = cvt_pk_bf16(v0[2], v0[3]); w[bj].z = cvt_pk_bf16(v1[0], v1[1]); w[bj].w = cvt_pk_bf16(v1[2], v1[3]); }
                const u32x4 snd = odd ? w[0] : w[1]; u32x4 rcv;
                rcv.x = (unsigned)__builtin_amdgcn_mov_dpp((int)snd.x, 0xB1, 0xF, 0xF, true); rcv.y = (unsigned)__builtin_amdgcn_mov_dpp((int)snd.y, 0xB1, 0xF, 0xF, true);
                rcv.z = (unsigned)__builtin_amdgcn_mov_dpp((int)snd.z, 0xB1, 0xF, 0xF, true); rcv.w = (unsigned)__builtin_amdgcn_mov_dpp((int)snd.w, 0xB1, 0xF, 0xF, true);
                *(u32x4*)rp = odd ? rcv : w[0];
                *(u32x4*)(rp + ldc) = odd ? w[1] : rcv; }
    }
};
struct EpiInproj {
    static constexpr bool PERM = true, AFTER_DRAIN = false, HAS_INIT = false, INIT_LOADS = false;
    bf16_t* PA; bf16_t* PH; bf16_t* QN; bf16_t* KN; const float* gq; const float* gk; float qscale, eps;
    __device__ __forceinline__ void operator()(const f32x4 (&acc)[2][2][4][2], const Unit& u, int wr, int wc, int fr, int fq) const {
        if (u.pn < 4) {
            const int arr = u.pn >> 1, hd = (u.pn & 1) * 4 + wc; const float* g = arr ? gk : gq; const float gs = arr ? 1.f : qscale; bf16_t* dst = arr ? KN : QN;
            f32x4 gv[2][2];
#pragma unroll
            for (int bj = 0; bj < 2; ++bj)
#pragma unroll
                for (int n = 0; n < 2; ++n) gv[bj][n] = *(const f32x4*)(g + 32 * bj + 8 * fq + 4 * n) * gs;
#pragma unroll
            for (int ai = 0; ai < 2; ++ai)
#pragma unroll
                for (int m = 0; m < 4; ++m) { float ss = 0.f;
#pragma unroll
                    for (int bj = 0; bj < 2; ++bj)
#pragma unroll
                        for (int n = 0; n < 2; ++n) { const f32x4 a = acc[ai][bj][m][n]; ss += (a[0] * a[0] + a[1] * a[1]) + (a[2] * a[2] + a[3] * a[3]); }
                    ss += __shfl_xor(ss, 16); ss += __shfl_xor(ss, 32);
                    const float rs = 1.f / sqrtf(ss * (1.f / 64.f) + eps);
                    const int row = u.pm * BM + ai * HALF + wr * 64 + m * 16 + fr, b = row >> 11, s = row & 2047;
                    bf16_t* rp = dst + ((size_t)((b * 8 + hd) * 64 + (s >> 5))) * 2048 + (s & 31) * 8;
#pragma unroll
                    for (int bj = 0; bj < 2; ++bj) { const int c8 = 4 * bj + fq; const f32x4 v0 = acc[ai][bj][m][0] * rs * gv[bj][0], v1 = acc[ai][bj][m][1] * rs * gv[bj][1];
                        u32x4 w; w.x = cvt_pk_bf16(v0[0], v0[1]); w.y = cvt_pk_bf16(v0[2], v0[3]); w.z = cvt_pk_bf16(v1[0], v1[1]); w.w = cvt_pk_bf16(v1[2], v1[3]);
                        *(u32x4*)(rp + (c8 >> 1) * 512 + (c8 & 1) * 256) = w; } }
            return;
        }
        const int colw = u.pn * BM + wc * 64; bf16_t* base; int rowlen;
        if (colw < 1536) { const int arr = colw >> 9, hd = (colw & 511) >> 6; base = PA + ((size_t)(arr * 16) * 8 + hd) * 2048 * 64; rowlen = 64; }
        else { const int c2 = colw - 1536, arr = c2 >> 9, hd = (c2 & 511) >> 7, dd = c2 & 127; base = PH + ((size_t)(arr * 16) * 4 + hd) * 2048 * 128 + dd; rowlen = 128; }
        const size_t bstride = (size_t)(rowlen == 64 ? 8 : 4) * 2048 * rowlen;
        const bool odd = fr & 1; base += (odd ? 32 : 0) + 8 * fq;
#pragma unroll
        for (int ai = 0; ai < 2; ++ai)
#pragma unroll
            for (int m = 0; m < 4; ++m) { const int rowE = u.pm * BM + ai * HALF + wr * 64 + m * 16 + (fr & ~1), b = rowE >> 11, s = rowE & 2047;
                u32x4 w[2];
#pragma unroll
                for (int bj = 0; bj < 2; ++bj) { const f32x4 v0 = acc[ai][bj][m][0], v1 = acc[ai][bj][m][1];
                    w[bj].x = cvt_pk_bf16(v0[0], v0[1]); w[bj].y = cvt_pk_bf16(v0[2], v0[3]); w[bj].z = cvt_pk_bf16(v1[0], v1[1]); w[bj].w = cvt_pk_bf16(v1[2], v1[3]); }
                const u32x4 snd = odd ? w[0] : w[1]; u32x4 rcv;
                rcv.x = (unsigned)__builtin_amdgcn_mov_dpp((int)snd.x, 0xB1, 0xF, 0xF, true); rcv.y = (unsigned)__builtin_amdgcn_mov_dpp((int)snd.y, 0xB1, 0xF, 0xF, true);
                rcv.z = (unsigned)__builtin_amdgcn_mov_dpp((int)snd.z, 0xB1, 0xF, 0xF, true); rcv.w = (unsigned)__builtin_amdgcn_mov_dpp((int)snd.w, 0xB1, 0xF, 0xF, true);
                bf16_t* rp = base + (size_t)b * bstride + (size_t)s * rowlen;
                *(u32x4*)rp = odd ? rcv : w[0];
                *(u32x4*)(rp + rowlen) = odd ? w[1] : rcv; }
    }
};
struct MoeOrder {
    const PG8_LAS int* tile_e; const PG8_LAS unsigned short* rowtab; int ntn, nunits, G, c; unsigned rowbytes; int rev;
    __device__ __forceinline__ bool next(int i, Unit& u) const {
        const int L = i * G + c; if (L >= nunits) return false;
        const int pm0 = L / ntn, pl = L - pm0 * ntn, pm = rev ? rev - 1 - pm0 : pm0; u.pm = pm; u.pn = tile_e[pm] * ntn + pl; u.slot = i; return true;
    }
    __device__ __forceinline__ unsigned rowoff(const Unit& u, int r) const { return (rowtab ? (unsigned)rowtab[u.slot * 256 + r] : (unsigned)(u.pm * 256 + r)) * rowbytes; }
    __device__ __forceinline__ void a_ready(const Unit&) const {}
    __device__ __forceinline__ void done(const Unit&) const {}
};
template <bool OUT8> struct EpiAct {
    static constexpr bool PERM = true, AFTER_DRAIN = false, HAS_INIT = true, INIT_LOADS = false;
    unsigned char* ACT; const PG8_LAS float* biastab; float oscale;
    __device__ __forceinline__ void init(f32x4 (&acc)[2][2][4][2], const Unit& u, int wr, int wc, int fr, int fq) const {
#pragma unroll
        for (int n = 0; n < 2; ++n) { const f32x4 bg = *(const PG8_LAS f32x4*)(biastab + u.slot * 256 + wc * 32 + 8 * fq + 4 * n), bu = *(const PG8_LAS f32x4*)(biastab + u.slot * 256 + 128 + wc * 32 + 8 * fq + 4 * n);
#pragma unroll
            for (int ai = 0; ai < 2; ++ai)
#pragma unroll
                for (int m = 0; m < 4; ++m) { acc[ai][0][m][n] = bg; acc[ai][1][m][n] = bu; } }
    }
    __device__ __forceinline__ void operator()(const f32x4 (&acc)[2][2][4][2], const Unit& u, int wr, int wc, int fr, int fq) const {
        const int pl = u.pn & 7; const int row0 = u.pm * BM + wr * 64 + fr, acol0 = pl * 128 + wc * 32 + 8 * fq;
#pragma unroll
        for (int ai = 0; ai < 2; ++ai)
#pragma unroll
            for (int m = 0; m < 4; ++m) { unsigned char* rowp = ACT + (size_t)(row0 + ai * HALF + m * 16) * 1024 + acol0; f32x4 a4[2];
#pragma unroll
                for (int n = 0; n < 2; ++n) { const f32x4 g4 = acc[ai][0][m][n], u4 = acc[ai][1][m][n]; f32x4 gl, ul, ex;
#pragma unroll
                    for (int j = 0; j < 4; ++j) { gl[j] = fminf(g4[j], 7.0f); ul[j] = __builtin_amdgcn_fmed3f(u4[j], -7.0f, 7.0f); }
                    const f32x4 t4 = gl * (-1.702f * 1.44269504089f);
#pragma unroll
                    for (int j = 0; j < 4; ++j) ex[j] = __builtin_amdgcn_exp2f(t4[j]);
                    const f32x4 d4 = ex + 1.0f; f32x4 s4;
#pragma unroll
                    for (int j = 0; j < 4; ++j) s4[j] = __builtin_amdgcn_rcpf(d4[j]);
                    a4[n] = (gl * s4) * (ul * oscale + oscale); }
                if constexpr (OUT8) { int p0 = 0, p1 = 0; p0 = __builtin_amdgcn_cvt_pk_fp8_f32(a4[0][0], a4[0][1], p0, false); p0 = __builtin_amdgcn_cvt_pk_fp8_f32(a4[0][2], a4[0][3], p0, true);
                    p1 = __builtin_amdgcn_cvt_pk_fp8_f32(a4[1][0], a4[1][1], p1, false); p1 = __builtin_amdgcn_cvt_pk_fp8_f32(a4[1][2], a4[1][3], p1, true);
                    *(unsigned long long*)rowp = (unsigned long long)(unsigned)p0 | ((unsigned long long)(unsigned)p1 << 32); }
                else { u32x4 w; w.x = cvt_pk_bf16(a4[0][0], a4[0][1]); w.y = cvt_pk_bf16(a4[0][2], a4[0][3]); w.z = cvt_pk_bf16(a4[1][0], a4[1][1]); w.w = cvt_pk_bf16(a4[1][2], a4[1][3]); *(u32x4*)(rowp + (size_t)(row0 + ai * HALF + m * 16) * 1024 + acol0) = w; } }
    }
};
struct EpiDown {
    static constexpr bool PERM = true, AFTER_DRAIN = false, HAS_INIT = true, INIT_LOADS = false;
    unsigned char* YK; const PG8_LAS int* tktab; const PG8_LAS float* biastab; float oscale;
    __device__ __forceinline__ void init(f32x4 (&acc)[2][2][4][2], const Unit& u, int wr, int wc, int fr, int fq) const {
#pragma unroll
        for (int bj = 0; bj < 2; ++bj)
#pragma unroll
            for (int n = 0; n < 2; ++n) { const f32x4 bv = *(const PG8_LAS f32x4*)(biastab + u.slot * 256 + 64 * wc + 16 * fq + 8 * bj + 4 * n) * oscale;
#pragma unroll
                for (int ai = 0; ai < 2; ++ai)
#pragma unroll
                    for (int m = 0; m < 4; ++m) acc[ai][bj][m][n] = bv; }
    }
    __device__ __forceinline__ void operator()(const f32x4 (&acc)[2][2][4][2], const Unit& u, int wr, int wc, int fr, int fq) const {
        const int pl = u.pn & 3; const int col0 = pl * BM + 64 * wc + 16 * fq;
#pragma unroll
        for (int ai = 0; ai < 2; ++ai)
#pragma unroll
            for (int m = 0; m < 4; ++m) { const int tk = tktab[u.slot * 256 + ai * HALF + wr * 64 + m * 16 + fr];
                if (tk >= 0) { unsigned char* rowp = YK + (size_t)tk * 1024 + col0; int p[4];
#pragma unroll
                    for (int bj = 0; bj < 2; ++bj) { f32x4 v0 = acc[ai][bj][m][0], v1 = acc[ai][bj][m][1];
#pragma unroll
                        for (int j = 0; j < 4; ++j) { v0[j] = __builtin_amdgcn_fmed3f(v0[j], -448.f, 448.f); v1[j] = __builtin_amdgcn_fmed3f(v1[j], -448.f, 448.f); }
                        int p0 = 0, p1 = 0; p0 = __builtin_amdgcn_cvt_pk_fp8_f32(v0[0], v0[1], p0, false); p0 = __builtin_amdgcn_cvt_pk_fp8_f32(v0[2], v0[3], p0, true);
                        p1 = __builtin_amdgcn_cvt_pk_fp8_f32(v1[0], v1[1], p1, false); p1 = __builtin_amdgcn_cvt_pk_fp8_f32(v1[2], v1[3], p1, true);
                        p[2 * bj] = p0; p[2 * bj + 1] = p1; }
                    u32x4 w; w.x = (unsigned)p[0]; w.y = (unsigned)p[1]; w.z = (unsigned)p[2]; w.w = (unsigned)p[3];
                    *(u32x4*)rowp = w; } }
    }
};

template <class Epi, class Sched, bool ALIGN_EPI = false, bool SP2 = false, bool GATHER = false, int SCW = 0, int SCX = 0>
__device__ __forceinline__ void gemm_phase(PG8_LAS unsigned char* lds, const Gemm g, const Sched& S, const Epi& E, const int tid) {
    const int wid = __builtin_amdgcn_readfirstlane(tid >> 6), lane = tid & 63, wr = wid >> 2, wc = wid & 3, fr = lane & 15, fq = lane >> 4;
    const int K = g.K, nt = K / BK;
    unsigned voffA[2], voffB[2]; int RA[2]; unsigned CA2[2]; unsigned va0[2] = {0u, 0u}, va1[2] = {0u, 0u};
#pragma unroll
    for (int i = 0; i < 2; ++i) { int R, C; stage_rc(tid * 16 + i * 8192, R, C); const int Rb = Epi::PERM ? ((R & ~31) + perm32(R & 31)) : R;
        voffA[i] = (unsigned)(R * K + C) * 2u; voffB[i] = (unsigned)(Rb * K + C) * 2u; RA[i] = R; CA2[i] = (unsigned)C * 2u; }
    static_assert(!GATHER || SP2, "the gathered-A form exists for the SP2 loop only");
    const char* const gA0 = (const char*)g.A;
#define PG8_VA(u) do { int l_; asm volatile("v_mbcnt_lo_u32_b32 %0, -1, 0\n\tv_mbcnt_hi_u32_b32 %0, -1, %0" : "=v"(l_)); const int t_ = wid * 64 + l_;     \
        _Pragma("unroll") for (int _i = 0; _i < 2; ++_i) { int R_, C_; stage_rc(t_ * 16 + _i * 8192, R_, C_); va0[_i] = S.rowoff((u), R_) + (unsigned)C_ * 2u; va1[_i] = S.rowoff((u), HALF + R_) + (unsigned)C_ * 2u; } } while (0)
#define PG8_STA(bufoff, base_ng, base_g, h) do { if constexpr (GATHER) { if (h) PG8_STAGE(bufoff, base_g, va1); else PG8_STAGE(bufoff, base_g, va0); } else PG8_STAGE(bufoff, base_ng, voffA); } while (0)
    const size_t kstep = (size_t)(BK * 2);
    const size_t hstep = (size_t)HALF * K * 2;
    const size_t tstep = 2 * hstep;
    const unsigned ldsw = (unsigned)wid * 1024u;
    const int aoff = lds_byte(wr * 64 + fr, fq * 8), boff = lds_byte(wc * 32 + fr, fq * 8);
#define PG8_SA(b, h) (((b) * 2 + (h)) * HTB)
#define PG8_SB(b, h) ((4 + (b) * 2 + (h)) * HTB)
#define PG8_STAGE(bufoff, gbase, voff) do { _Pragma("unroll") for (int _i = 0; _i < 2; ++_i) \
        __builtin_amdgcn_global_load_lds((const unsigned*)((const char*)(gbase) + (voff)[_i]), (PG8_LAS unsigned*)(lds + (bufoff) + ldsw + _i * 8192), 16, 0, 0); } while (0)
#define PG8_LDA(dst, b, h) do { if constexpr (SCW != 0) { _Pragma("unroll") for (int m = 0; m < 4; ++m) dst##8[m] = PG8_CAT8(*(const PG8_LAS bf16x8*)(lds + PG8_SA(b, h) + aoff + m * 2048), *(const PG8_LAS bf16x8*)(lds + PG8_SA(b, h) + aoff + m * 2048 + 1024)); } \
        else { _Pragma("unroll") for (int m = 0; m < 4; ++m) _Pragma("unroll") for (int k = 0; k < 2; ++k) dst[m][k] = *(const PG8_LAS bf16x8*)(lds + PG8_SA(b, h) + aoff + m * 2048 + k * 1024); } } while (0)
#define PG8_LDB(dst, b, h) do { if constexpr (SCW != 0) { _Pragma("unroll") for (int n = 0; n < 2; ++n) dst##8[n] = PG8_CAT8(*(const PG8_LAS bf16x8*)(lds + PG8_SB(b, h) + boff + n * 2048), *(const PG8_LAS bf16x8*)(lds + PG8_SB(b, h) + boff + n * 2048 + 1024)); } \
        else { _Pragma("unroll") for (int n = 0; n < 2; ++n) _Pragma("unroll") for (int k = 0; k < 2; ++k) dst[n][k] = *(const PG8_LAS bf16x8*)(lds + PG8_SB(b, h) + boff + n * 2048 + k * 1024); } } while (0)
#define PG8_CAT8(lo, hi) __builtin_shufflevector(__builtin_bit_cast(i32x4_t, (lo)), __builtin_bit_cast(i32x4_t, (hi)), 0, 1, 2, 3, 4, 5, 6, 7)
#define PG8_MMA(ai, bj, At, Bt) do { __builtin_amdgcn_s_setprio(1); _Pragma("unroll") for (int m = 0; m < 4; ++m) _Pragma("unroll") for (int n = 0; n < 2; ++n) { \
        if constexpr (SCW != 0) acc[ai][bj][m][n] = __builtin_amdgcn_mfma_scale_f32_16x16x128_f8f6f4(Bt##8[n], At##8[m], acc[ai][bj][m][n], 0, 0, 0, SCW, 0, SCX); \
        else { _Pragma("unroll") for (int k = 0; k < 2; ++k) acc[ai][bj][m][n] = __builtin_amdgcn_mfma_f32_16x16x32_bf16(Bt[n][k], At[m][k], acc[ai][bj][m][n], 0, 0, 0); } } __builtin_amdgcn_s_setprio(0); } while (0)
#define PG8_WAIT_V(n) asm volatile("s_waitcnt vmcnt(" #n ")" ::: "memory")
#define PG8_WAIT_L(n) asm volatile("s_waitcnt lgkmcnt(" #n ")" ::: "memory")
#define PG8_BAR __builtin_amdgcn_s_barrier()
#define PG8_SCHED __builtin_amdgcn_sched_barrier(0)
    Unit cur, nxt; int ui = 0;
    if (!S.next(0, cur)) return;
    f32x4 acc[2][2][4][2];
    if constexpr (Epi::HAS_INIT) { E.init(acc, cur, wr, wc, fr, fq); if constexpr (Epi::INIT_LOADS) __builtin_amdgcn_s_waitcnt(0x0F70); }
    else {
#pragma unroll
    for (int a = 0; a < 2; ++a)
#pragma unroll
        for (int b = 0; b < 2; ++b)
#pragma unroll
            for (int m = 0; m < 4; ++m)
#pragma unroll
                for (int n = 0; n < 2; ++n) acc[a][b][m][n] = (f32x4){0.f, 0.f, 0.f, 0.f};
    }
    bf16x8 At[4][2], B0[2][2], B1[2][2]; i32x8_t At8[4], B08[2], B18[2];
    const char* cA = (const char*)g.A + (size_t)cur.pm * tstep; const char* cB = (const char*)g.Bt + (size_t)cur.pn * tstep;
    S.a_ready(cur);
    if constexpr (SP2) {
        if constexpr (GATHER) PG8_VA(cur);
        PG8_STAGE(PG8_SB(0, 0), cB, voffB); PG8_STAGE(PG8_SB(0, 1), cB + hstep, voffB); PG8_STA(PG8_SA(0, 0), cA, gA0, 0); PG8_STA(PG8_SA(0, 1), cA + hstep, gA0, 1);
        if (wr == 1) PG8_BAR;
        PG8_WAIT_V(2); PG8_BAR;
        PG8_STAGE(PG8_SB(1, 0), cB + kstep, voffB); PG8_STA(PG8_SA(1, 0), cA + kstep, gA0 + kstep, 0); PG8_STAGE(PG8_SB(1, 1), cB + hstep + kstep, voffB);
        PG8_WAIT_V(6); PG8_BAR;
    } else {
        PG8_STAGE(PG8_SB(0, 0), cB, voffB); PG8_STAGE(PG8_SA(0, 0), cA, voffA); PG8_STAGE(PG8_SB(0, 1), cB + hstep, voffB); PG8_STAGE(PG8_SA(0, 1), cA + hstep, voffA);
        if (wr == 1) PG8_BAR;
        PG8_WAIT_V(4); PG8_BAR;
        PG8_STAGE(PG8_SB(1, 0), cB + kstep, voffB); PG8_STAGE(PG8_SA(1, 0), cA + kstep, voffA); PG8_STAGE(PG8_SB(1, 1), cB + hstep + kstep, voffB);
        PG8_WAIT_V(6); PG8_BAR;
    }
    for (;;) {
        const bool has_next = S.next(ui + 1, nxt);
        const char* nA = has_next ? (const char*)g.A + (size_t)nxt.pm * tstep : cA; const char* nB = has_next ? (const char*)g.Bt + (size_t)nxt.pn * tstep : cB;
        _Pragma("nounroll") for (int t = 0; t < nt; t += 2) {
            const bool last = (t == nt - 2);
            const char* a1 = cA + (size_t)(t + 1) * kstep;
            const char* a2 = last ? nA : cA + (size_t)(t + 2) * kstep; const char* b2 = last ? nB : cB + (size_t)(t + 2) * kstep;
            const char* a3 = a2 + kstep; const char* b3 = b2 + kstep;
            if (last && has_next) S.a_ready(nxt);
            const char* const g1 = gA0 + (size_t)(t + 1) * kstep; const char* const g2 = last ? gA0 : gA0 + (size_t)(t + 2) * kstep; const char* const g3 = g2 + kstep;
            if constexpr (SP2) {
            PG8_LDB(B0, 0, 0); PG8_LDB(B1, 0, 1); PG8_SCHED; PG8_LDA(At, 0, 0); PG8_STA(PG8_SA(1, 1), a1 + hstep, g1, 1);
            PG8_WAIT_V(8); PG8_WAIT_L(0); PG8_BAR; PG8_MMA(0, 0, At, B0); PG8_MMA(0, 1, At, B1); PG8_BAR; PG8_SCHED;
            if constexpr (GATHER) { if (last && has_next) PG8_VA(nxt); }
            PG8_LDA(At, 0, 1); PG8_STAGE(PG8_SB(0, 0), b2, voffB); PG8_STAGE(PG8_SB(0, 1), b2 + hstep, voffB); PG8_STA(PG8_SA(0, 0), a2, g2, 0);
            PG8_WAIT_V(8); PG8_WAIT_L(0); PG8_BAR; PG8_MMA(1, 0, At, B0); PG8_MMA(1, 1, At, B1); PG8_BAR; PG8_SCHED;
            PG8_LDB(B0, 1, 0); PG8_LDB(B1, 1, 1); PG8_SCHED; PG8_LDA(At, 1, 0); PG8_STA(PG8_SA(0, 1), a2 + hstep, g2, 1);
            PG8_WAIT_V(8); PG8_WAIT_L(0); PG8_BAR; PG8_MMA(0, 0, At, B0); PG8_MMA(0, 1, At, B1); PG8_BAR; PG8_SCHED;
            PG8_LDA(At, 1, 1); PG8_STAGE(PG8_SB(1, 0), b3, voffB); PG8_STAGE(PG8_SB(1, 1), b3 + hstep, voffB); PG8_STA(PG8_SA(1, 0), a3, g3, 0);
            PG8_WAIT_V(8); PG8_WAIT_L(0); PG8_BAR; PG8_MMA(1, 0, At, B0); PG8_MMA(1, 1, At, B1); PG8_BAR; PG8_SCHED;
            } else {
            PG8_LDB(B0, 0, 0); PG8_SCHED; PG8_LDA(At, 0, 0); PG8_STAGE(PG8_SA(1, 1), a1 + hstep, voffA);
            PG8_WAIT_L(8); PG8_BAR; PG8_WAIT_L(0); PG8_MMA(0, 0, At, B0); PG8_BAR; PG8_SCHED;
            PG8_LDB(B1, 0, 1); PG8_STAGE(PG8_SB(0, 0), b2, voffB);
            PG8_BAR; PG8_WAIT_L(0); PG8_MMA(0, 1, At, B1); PG8_BAR;
            PG8_LDA(At, 0, 1); PG8_STAGE(PG8_SA(0, 0), a2, voffA);
            PG8_BAR; PG8_WAIT_L(0); PG8_MMA(1, 0, At, B0); PG8_BAR; PG8_SCHED;
            PG8_STAGE(PG8_SB(0, 1), b2 + hstep, voffB);
            PG8_WAIT_V(6); PG8_BAR; PG8_MMA(1, 1, At, B1); PG8_BAR;
            PG8_LDB(B0, 1, 0); PG8_SCHED; PG8_LDA(At, 1, 0); PG8_STAGE(PG8_SA(0, 1), a2 + hstep, voffA);
            PG8_WAIT_L(8); PG8_BAR; PG8_WAIT_L(0); PG8_MMA(0, 0, At, B0); PG8_BAR; PG8_SCHED;
            PG8_LDB(B1, 1, 1); PG8_STAGE(PG8_SB(1, 0), b3, voffB);
            PG8_BAR; PG8_WAIT_L(0); PG8_MMA(0, 1, At, B1); PG8_BAR;
            PG8_LDA(At, 1, 1); PG8_STAGE(PG8_SA(1, 0), a3, voffA);
            PG8_BAR; PG8_WAIT_L(0); PG8_MMA(1, 0, At, B0); PG8_BAR; PG8_SCHED;
            PG8_STAGE(PG8_SB(1, 1), b3 + hstep, voffB);
            PG8_WAIT_V(6); PG8_BAR; PG8_MMA(1, 1, At, B1); PG8_BAR;
            }
        }
        if constexpr (ALIGN_EPI) { if (wr == 0) PG8_BAR; }
        if constexpr (!Epi::AFTER_DRAIN) { int fr_ = fr, fq_ = fq; asm volatile("" : "+v"(fr_), "+v"(fq_));
            E(acc, cur, wr, wc, fr_, fq_); S.done(cur); }
        if (!has_next) break;
        if constexpr (Epi::HAS_INIT) { int fr_ = fr, fq_ = fq; asm volatile("" : "+v"(fr_), "+v"(fq_)); E.init(acc, nxt, wr, wc, fr_, fq_); if constexpr (Epi::INIT_LOADS) __builtin_amdgcn_s_waitcnt(0x0F70); }
        else {
#pragma unroll
        for (int a = 0; a < 2; ++a)
#pragma unroll
            for (int b = 0; b < 2; ++b)
#pragma unroll
                for (int m = 0; m < 4; ++m)
#pragma unroll
                    for (int n = 0; n < 2; ++n) acc[a][b][m][n] = (f32x4){0.f, 0.f, 0.f, 0.f};
        }
        cur = nxt; cA = nA; cB = nB; ++ui;
        if constexpr (ALIGN_EPI) { if (wr == 1) PG8_BAR; }
    }
    PG8_WAIT_V(0);
    if constexpr (!ALIGN_EPI) { if (wr == 0) PG8_BAR; }
    PG8_BAR;
    if constexpr (Epi::AFTER_DRAIN) { E.fused(acc, cur, wr, wc, fr, fq, lds, wid, lane); S.done(cur); }
#undef PG8_SA
#undef PG8_CAT8
#undef PG8_VA
#undef PG8_STA
#undef PG8_SB
#undef PG8_STAGE
#undef PG8_LDA
#undef PG8_LDB
#undef PG8_MMA
#undef PG8_WAIT_V
#undef PG8_WAIT_L
#undef PG8_BAR
#undef PG8_SCHED
}
}

#ifndef PG8_SP2
#define PG8_SP2 true
#endif
#ifndef PG8_ALIGN
#define PG8_ALIGN true
#endif
#define GAS __attribute__((address_space(1)))
#define LAS __attribute__((address_space(3)))
typedef unsigned short bf16;
typedef unsigned v4u __attribute__((ext_vector_type(4)));
typedef float f32x4 __attribute__((ext_vector_type(4)));
typedef short bf16x8 __attribute__((ext_vector_type(8)));
typedef GAS unsigned gu32;
typedef GAS unsigned long long gu64;
#define RLX_AGENT __ATOMIC_RELAXED, __HIP_MEMORY_SCOPE_AGENT
#define LDS_WAIT() asm volatile("s_waitcnt lgkmcnt(0)" ::: "memory")
#define VM_WAIT() asm volatile("s_waitcnt vmcnt(0)" ::: "memory")
__device__ __forceinline__ unsigned long long rt() { return __builtin_amdgcn_s_memrealtime(); }
__device__ __forceinline__ unsigned f2bf(float f) { unsigned u = __builtin_bit_cast(unsigned, f); return (u + 0x7fffu + ((u >> 16) & 1u)) >> 16; }
__device__ __forceinline__ unsigned pk2(float lo, float hi) { return f2bf(lo) | (f2bf(hi) << 16); }

#define XB_TMO      128
#define XB_XCNT(j)  (256  + 64 * (j))
#define XB_XSUB(j)  (1280 + 64 * (j))
#define XB_XGEN(j)  (2304 + 64 * (j))
#define XB_TOP      3328
#define XB_TOPGEN   3392
#define XCD_BAR_WORDS 3456
#define XB_SPIN_CAP (1u << 18)

__device__ __forceinline__ unsigned xb_ld(unsigned* p)              { return __hip_atomic_load(p, __ATOMIC_RELAXED, __HIP_MEMORY_SCOPE_AGENT); }
__device__ __forceinline__ unsigned xb_add(unsigned* p, unsigned v) { return __hip_atomic_fetch_add(p, v, __ATOMIC_RELAXED, __HIP_MEMORY_SCOPE_AGENT); }
__device__ __forceinline__ unsigned xb_xcc_id() { return (unsigned)__builtin_amdgcn_s_getreg((3 << 11) | 20) & 0xFu; }
#define XB_SPIN(cond, bar) do { unsigned _sp = 0; while (cond) { __builtin_amdgcn_s_sleep(1); \
    if ((++_sp & 255u) == 0u) { if (xb_ld(&(bar)[XB_TMO])) break; if (_sp > XB_SPIN_CAP) { atomicAdd(&(bar)[XB_TMO], 1u); break; } } } } while (0)

struct XcdBarrier {
    unsigned* bar; unsigned x;
    volatile LAS unsigned* st;
};

__device__ __forceinline__ XcdBarrier xcd_barrier_post(unsigned* bar, volatile LAS unsigned* st) {
    XcdBarrier b; b.bar = bar; b.x = xb_xcc_id(); b.st = st;
    if (threadIdx.x == 0) (void)xb_add(&bar[XB_XCNT(b.x)], 1u);
    return b;
}
__device__ __forceinline__ void xcd_barrier_complete(unsigned* bar, unsigned x, unsigned& nloc, unsigned& nx) {
    const unsigned G = gridDim.x * gridDim.y * gridDim.z;
    unsigned sum, cnt, mine, sp = 0u;
    for (;;) {
        sum = 0u; cnt = 0u; mine = 0u;
#pragma unroll
        for (unsigned j = 0; j < 16; ++j) { const unsigned c = xb_ld(&bar[XB_XCNT(j)]); sum += c; cnt += (c > 0u) ? 1u : 0u; mine = (j == x) ? c : mine; }
        if (sum == G) break;
        __builtin_amdgcn_s_sleep(1);
        if ((++sp & 255u) == 0u) { if (xb_ld(&bar[XB_TMO])) break; if (sp > XB_SPIN_CAP) { atomicAdd(&bar[XB_TMO], 1u); break; } }
    }
    nloc = mine > 0u ? mine : 1u; nx = cnt > 0u ? cnt : 1u;
}

__device__ __forceinline__ void xcd_barrier(const XcdBarrier& b) {
    asm volatile("s_waitcnt vmcnt(0)" ::: "memory");
    __syncthreads();
    if (threadIdx.x == 0) {
        unsigned* bar = b.bar;
        __builtin_amdgcn_s_waitcnt(0);
        unsigned nloc = b.st[0], nx = b.st[1];
        if (nloc == 0u) { xcd_barrier_complete(bar, b.x, nloc, nx); b.st[0] = nloc; b.st[1] = nx; }
        const unsigned old = xb_add(&bar[XB_XSUB(b.x)], 1u);
        const unsigned gen = old / nloc;
        if (old + 1u == (gen + 1u) * nloc) {
            __builtin_amdgcn_fence(__ATOMIC_RELEASE, "agent");
            asm volatile("s_waitcnt vmcnt(0)" ::: "memory");
            const unsigned og = xb_add(&bar[XB_TOP], 1u);
            const unsigned tg = og / nx;
            if (og + 1u == (tg + 1u) * nx) xb_add(&bar[XB_TOPGEN], 1u);
            else XB_SPIN(xb_ld(&bar[XB_TOPGEN]) == tg, bar);
            __builtin_amdgcn_fence(__ATOMIC_ACQUIRE, "agent");
            xb_add(&bar[XB_XGEN(b.x)], 1u);
            asm volatile("s_waitcnt vmcnt(0)" ::: "memory");
        } else {
            XB_SPIN(xb_ld(&bar[XB_XGEN(b.x)]) == gen, bar);
            __builtin_amdgcn_fence(__ATOMIC_ACQUIRE, "agent");
            asm volatile("s_waitcnt vmcnt(0)" ::: "memory");
        }
    }
    __syncthreads();
}

constexpr int NWAVES = 8;
#ifndef MK_ONE_LAUNCH
#define MK_ONE_LAUNCH 1
#endif

constexpr int BATCH = 16, SEQ = 2048, D = 1024, T = BATCH * SEQ;
constexpr int NIN = 3584;
constexpr int OFF_SQ = 0, OFF_SK = 512, OFF_SV = 1024, OFF_HQ = 1536, OFF_HF = 2048, OFF_HI = 2560, OFF_HG = 3072;
constexpr int NE = 32, TOPK = 4, NASSIGN = T * TOPK;
constexpr int MAXTILES = NASSIGN / 256 + NE;
constexpr int MAXROWS = MAXTILES * 256;
constexpr float EPS = 1e-6f;

constexpr size_t MiB = 1u << 20;
constexpr size_t WS_CTL = 0, CTL_ZERO_BYTES = 1 * MiB;
constexpr size_t WS_WIN = 2 * MiB;
constexpr size_t WS_WOUT = 10 * MiB;
constexpr size_t WS_RT = 12 * MiB;
constexpr size_t WS_WGU = 16 * MiB;
constexpr size_t WS_WD = 144 * MiB;
constexpr size_t WS_XN = 208 * MiB;
constexpr size_t WS_P = 272 * MiB;
constexpr size_t WS_PH = WS_P + 96 * MiB;
constexpr size_t WS_MIX = 496 * MiB;
constexpr size_t WS_ACT = 272 * MiB;
constexpr size_t WS_YK = 560 * MiB;
constexpr size_t WS_QN = 624 * MiB;
constexpr size_t WS_KN = 656 * MiB;
constexpr size_t WS_VT = 688 * MiB;
constexpr size_t WS_KVS = 720 * MiB;
constexpr size_t WS_DEC = 784 * MiB;
constexpr size_t WS_SSEG = 786 * MiB;
constexpr size_t WS_DSEG = 802 * MiB;
constexpr size_t WS_LIST = 816 * MiB;
constexpr size_t WS_TOPG = 825 * MiB;
constexpr size_t WS_X8 = 560 * MiB;
constexpr size_t WS_END = 832 * MiB;
static_assert(WS_ACT + (size_t)MAXROWS * 2048 <= WS_YK && WS_YK + (size_t)T * 4 * 2048 <= WS_LIST && WS_MIX + (size_t)T * 2048 <= WS_YK, "d_ws map");
constexpr int CW_TMO = 0, CW_CODE = 1;
constexpr int CW_CNT = 64;
constexpr int CW_BAR = 4096;

constexpr int RING_OFF = 0, RING_BYTES = 131072;
constexpr int RT_ROW = 2064, RT_WL = 32 * RT_ROW, RT_END = 64 * RT_ROW;
constexpr int LDSCTL_OFF = 133120, MISC_OFF = LDSCTL_OFF + 320;
constexpr int LTAB_OFF = LDSCTL_OFF + 512;
constexpr int LT_TS = MAXTILES, LT_CNT = MAXTILES + 32, LT_MISC = MAXTILES + 64, LT_WORDS = MAXTILES + 192;
constexpr int ROWTAB_OFF = LTAB_OFF + LT_WORDS * 4;
constexpr int MAXSLOT = 17;
constexpr int ROWTAB2_OFF = ROWTAB_OFF + MAXSLOT * 1024;
constexpr int LDS_BYTES = ROWTAB2_OFF + MAXSLOT * 512;
static_assert(RT_END <= LDSCTL_OFF && MISC_OFF + 128 <= LTAB_OFF && LDS_BYTES <= 160 * 1024 && (MAXTILES * 8 + 255) / 256 <= MAXSLOT && 2 * ((MAXTILES * 4 + 255) / 256) * 1024 <= MAXSLOT * 1536 && ROWTAB_OFF % 16 == 0, "LDS map");

struct Frame {
    LAS unsigned char* lds;
    volatile LAS unsigned* MISC;
    gu32* ctl;
    int tid, lane, wave, gw, ngw;
    int vcu, G;
    const float *x, *norm1_g, *w_in, *sb_q_g, *sb_k_g, *sb_out_g, *hg_lb, *hg_out_g, *w_out, *norm2_g, *w_router, *b_router, *w_gu, *b_gu, *w_d, *b_d;
    float* out;
    unsigned char* ws;
};
__device__ __forceinline__ float bf2f(unsigned short b) { return __builtin_bit_cast(float, (unsigned)b << 16); }
__device__ __forceinline__ float bflo(unsigned w) { return __builtin_bit_cast(float, w << 16); }
__device__ __forceinline__ float bfhi(unsigned w) { return __builtin_bit_cast(float, w & 0xffff0000u); }
typedef __bf16 bf16x2n_ __attribute__((ext_vector_type(2)));
typedef float f32x2n_ __attribute__((ext_vector_type(2)));
__device__ __forceinline__ unsigned pkbf(float a, float b) { const bf16x2n_ v = __builtin_convertvector((f32x2n_){a, b}, bf16x2n_); return __builtin_bit_cast(unsigned, v); }
__device__ __forceinline__ int lane_id() { int l; asm volatile("v_mbcnt_lo_u32_b32 %0, -1, 0\n\tv_mbcnt_hi_u32_b32 %0, -1, %0" : "=v"(l)); return l; }
__device__ __forceinline__ int vzero() { int z; asm volatile("v_mov_b32 %0, 0" : "=v"(z)); return z; }
__device__ __forceinline__ float wave_sum(float v) {
#pragma unroll
    for (int o = 1; o < 64; o <<= 1) v += __shfl_xor(v, o);
    return v;
}

constexpr float W8_SCALE = 256.f, A8_SCALE = 4.f, Y8_SCALE = 32.f; static_assert(Y8_SCALE == 32.f, "SC_W8Y below is 2^-8 * 32");
constexpr int SC_ONE = 0x7f7f7f7f, SC_W8 = 0x77777777, SC_A8 = 0x7d7d7d7d, SC_W8Y = 0x7c7c7c7c;
struct P0Item { const float* W; bf16* WT; const float* rowscale; int N, k0, n0, drow0, fp8, perm; };
__device__ __forceinline__ void p0_load(const P0Item& it, f32x4 (&v)[16], int lane) {
    const int kr = lane >> 4, nc = 4 * (lane & 15);
#pragma unroll
    for (int i = 0; i < 16; ++i) v[i] = __builtin_nontemporal_load((const f32x4*)(it.W + (size_t)(it.k0 + 4 * i + kr) * it.N + it.n0 + nc));
}
__device__ __forceinline__ void p0_store(const P0Item& it, const f32x4 (&v)[16], LAS unsigned char* scr, int lane) {
    const int kr = lane >> 4, nc = 4 * (lane & 15);
#pragma unroll
    for (int i = 0; i < 16; ++i) { const float sc = it.rowscale ? it.rowscale[it.k0 + 4 * i + kr] : 1.f;
        *(LAS unsigned long long*)(scr + (4 * i + kr) * 136 + 2 * nc) = (unsigned long long)pkbf(v[i].x * sc, v[i].y * sc) | ((unsigned long long)pkbf(v[i].z * sc, v[i].w * sc) << 32); }
    LDS_WAIT(); asm volatile("" ::: "memory");
    const LAS unsigned short* s16 = (const LAS unsigned short*)scr;
    if (it.fp8) { const int p = lane & 3, nr = lane >> 2;
#pragma unroll
        for (int c = 0; c < 4; ++c) { const int n = 16 * c + nr; unsigned val[16];
#pragma unroll
            for (int kk = 0; kk < 16; ++kk) val[kk] = s16[(16 * p + kk) * 68 + n];
            v4u w4;
            w4.x = pg8::pk4_fp8(bflo(val[0]) * W8_SCALE, bflo(val[1]) * W8_SCALE, bflo(val[2]) * W8_SCALE, bflo(val[3]) * W8_SCALE);
            w4.y = pg8::pk4_fp8(bflo(val[4]) * W8_SCALE, bflo(val[5]) * W8_SCALE, bflo(val[6]) * W8_SCALE, bflo(val[7]) * W8_SCALE);
            w4.z = pg8::pk4_fp8(bflo(val[8]) * W8_SCALE, bflo(val[9]) * W8_SCALE, bflo(val[10]) * W8_SCALE, bflo(val[11]) * W8_SCALE);
            w4.w = pg8::pk4_fp8(bflo(val[12]) * W8_SCALE, bflo(val[13]) * W8_SCALE, bflo(val[14]) * W8_SCALE, bflo(val[15]) * W8_SCALE);
            *(GAS v4u*)((unsigned char*)it.WT + (size_t)(it.drow0 + (it.perm == 2 ? 128 * ((n >> 3) & 1) + 8 * (n >> 4) + (n & 7) : n)) * D + it.k0 + 16 * p) = w4; }
    } else { const int p = lane & 7, nr = lane >> 3;
#pragma unroll
        for (int c = 0; c < 8; ++c) { const int n = 8 * c + nr; unsigned val[8];
#pragma unroll
            for (int kk = 0; kk < 8; ++kk) val[kk] = s16[(8 * p + kk) * 68 + n];
            v4u w4; w4.x = val[0] | (val[1] << 16); w4.y = val[2] | (val[3] << 16); w4.z = val[4] | (val[5] << 16); w4.w = val[6] | (val[7] << 16);
            *(GAS v4u*)(it.WT + (size_t)(it.drow0 + (it.perm ? 128 * (n >> 5) + (n & 31) : n)) * D + it.k0 + 8 * p) = w4; } }
    LDS_WAIT(); asm volatile("" ::: "memory");
}
__device__ __forceinline__ void rms_rows2_to_bf16(const float* xa, const float* xb, bool hasb, const float* g, bf16* oa, bf16* ob, int lane) {
    const GAS f32x4* pa = (const GAS f32x4*)xa + lane; const GAS f32x4* pb = (const GAS f32x4*)(hasb ? xb : xa) + lane; const f32x4* gr = (const f32x4*)g + lane;
    f32x4 va[4], vb[4], gg[4]; float sa = 0.f, sb = 0.f;
#pragma unroll
    for (int j = 0; j < 4; ++j) { va[j] = __builtin_nontemporal_load(pa + 64 * j); vb[j] = __builtin_nontemporal_load(pb + 64 * j); gg[j] = gr[64 * j]; }
#pragma unroll
    for (int j = 0; j < 4; ++j) { sa += (va[j].x * va[j].x + va[j].y * va[j].y) + (va[j].z * va[j].z + va[j].w * va[j].w); sb += (vb[j].x * vb[j].x + vb[j].y * vb[j].y) + (vb[j].z * vb[j].z + vb[j].w * vb[j].w); }
    const float ra = 1.f / sqrtf(wave_sum(sa) * (1.f / D) + EPS), rb = 1.f / sqrtf(wave_sum(sb) * (1.f / D) + EPS);
    GAS unsigned long long* o8a = (GAS unsigned long long*)oa + lane; GAS unsigned long long* o8b = (GAS unsigned long long*)ob + lane;
#pragma unroll
    for (int j = 0; j < 4; ++j) o8a[64 * j] = (unsigned long long)pkbf(va[j].x * ra * gg[j].x, va[j].y * ra * gg[j].y) | ((unsigned long long)pkbf(va[j].z * ra * gg[j].z, va[j].w * ra * gg[j].w) << 32);
    if (hasb) {
#pragma unroll
        for (int j = 0; j < 4; ++j) o8b[64 * j] = (unsigned long long)pkbf(vb[j].x * rb * gg[j].x, vb[j].y * rb * gg[j].y) | ((unsigned long long)pkbf(vb[j].z * rb * gg[j].z, vb[j].w * rb * gg[j].w) << 32); }
}
__device__ __forceinline__ P0Item p0_item(Frame& F, int r) {
    constexpr int I_IN = 16 * (NIN / 64), I_OUT = 16 * 16, I_GU = NE * 16 * 32;
    P0Item it;
    if (r < I_IN) { const int nb = NIN / 64, Qp = r >> 1, kb = 2 * (Qp / nb) + (r & 1), nn = Qp % nb; const int pq = 1; it = P0Item{F.w_in, (bf16*)(F.ws + WS_WIN), nullptr, NIN, 64 * kb, 64 * nn, pq ? 256 * (nn >> 2) + 32 * (nn & 3) : 64 * nn, 0, pq}; return it; } r -= I_IN;
    if (r < I_OUT) { const int Qp = r >> 1, kb = 2 * (Qp / 16) + (r & 1), nn = Qp % 16; it = P0Item{F.w_out, (bf16*)(F.ws + WS_WOUT), nullptr, D, 64 * kb, 64 * nn, 256 * (nn >> 2) + 32 * (nn & 3), 0, 1}; return it; }     r -= I_OUT;
    if (r < I_GU) { const int e = r / 512, q = r % 512, Qp = q >> 1, kb = 2 * (Qp / 32) + (q & 1), nn = Qp % 32;
        const int isup = nn >> 4, a = (nn & 15) * 64;
        it = P0Item{F.w_gu + (size_t)e * D * 2048, (bf16*)(F.ws + WS_WGU + (size_t)e * 2048 * D), F.norm2_g, 2048, 64 * kb, 64 * nn, 256 * (a >> 7) + 128 * isup + (a & 127), 1, 0}; return it; } r -= I_GU;
    { const int e = r / 256, q = r % 256, Qp = q >> 1, kb = 2 * (Qp / 16) + (q & 1), nn = Qp % 16;
        it = P0Item{F.w_d + (size_t)e * D * D, (bf16*)(F.ws + WS_WD + (size_t)e * D * D), nullptr, D, 64 * kb, 64 * nn, 256 * (nn >> 2) + 32 * (nn & 3), 1, 2}; return it; }
}
constexpr int P0_NITEMS = 16 * (NIN / 64) + 16 * 16 + NE * 16 * 32 + NE * 16 * 16;
constexpr int P0_NLATE = 1024;
__device__ __forceinline__ void p0_items(Frame& F, int lo, int hi, int w, int nw) {
    LAS unsigned char* scr = F.lds + RING_OFF + F.wave * 16384;
    f32x4 va[16], vb[16]; int it = lo + w;
    if (it < hi) { P0Item A = p0_item(F, it); p0_load(A, va, F.lane);
        for (;;) {
            const int itb = it + nw; const bool hb = itb < hi; const P0Item B = p0_item(F, hb ? itb : it); p0_load(B, vb, F.lane); __builtin_amdgcn_sched_barrier(0);
            p0_store(A, va, scr, F.lane);
            if (!hb) break;
            it = itb + nw; const bool ha = it < hi; A = p0_item(F, ha ? it : itb); p0_load(A, va, F.lane); __builtin_amdgcn_sched_barrier(0);
            p0_store(B, vb, scr, F.lane);
            if (!ha) break;
        }
    }
}
__device__ __forceinline__ void p0_prologue(Frame& F) {
    p0_items(F, 0, P0_NITEMS - P0_NLATE, F.gw, F.ngw);
    for (int q = blockIdx.x * (NWAVES * 64) + F.tid; q < 4096; q += F.G * NWAVES * 64) {
        const int e = q & 31, k0 = (q >> 5) * 8; unsigned hi[8], lo[8];
#pragma unroll
        for (int j = 0; j < 8; ++j) { const float w = F.w_router[(k0 + j) * 32 + e] * F.norm2_g[k0 + j]; hi[j] = pkbf(w, 0.f) & 0xffffu; lo[j] = pkbf(w - bflo(hi[j]), 0.f) & 0xffffu; }
        const v4u h4 = {hi[0] | (hi[1] << 16), hi[2] | (hi[3] << 16), hi[4] | (hi[5] << 16), hi[6] | (hi[7] << 16)}, l4 = {lo[0] | (lo[1] << 16), lo[2] | (lo[3] << 16), lo[4] | (lo[5] << 16), lo[6] | (lo[7] << 16)};
        *(GAS v4u*)(F.ws + WS_RT + e * RT_ROW + 2 * k0) = h4; *(GAS v4u*)(F.ws + WS_RT + RT_WL + e * RT_ROW + 2 * k0) = l4; }
    for (int m = F.gw; m < T; m += 2 * F.ngw) rms_rows2_to_bf16(F.x + (size_t)m * D, F.x + (size_t)(m + F.ngw) * D, m + F.ngw < T, F.norm1_g, (bf16*)(F.ws + WS_XN) + (size_t)m * D, (bf16*)(F.ws + WS_XN) + (size_t)(m + F.ngw) * D, F.lane);
}

__device__ __forceinline__ v4u pair_trade(const v4u& P0, const v4u& P1, bool odd, v4u& storeA, v4u& storeB) {
    const v4u snd = odd ? P0 : P1; v4u rcv;
    rcv.x = (unsigned)__builtin_amdgcn_mov_dpp((int)snd.x, 0xB1, 0xF, 0xF, true); rcv.y = (unsigned)__builtin_amdgcn_mov_dpp((int)snd.y, 0xB1, 0xF, 0xF, true);
    rcv.z = (unsigned)__builtin_amdgcn_mov_dpp((int)snd.z, 0xB1, 0xF, 0xF, true); rcv.w = (unsigned)__builtin_amdgcn_mov_dpp((int)snd.w, 0xB1, 0xF, 0xF, true);
    storeA = odd ? rcv : P0; storeB = odd ? P1 : rcv; return rcv;
}
typedef float f32x16 __attribute__((ext_vector_type(16)));
typedef __bf16 bf16x2n __attribute__((ext_vector_type(2)));
typedef float f32x2n __attribute__((ext_vector_type(2)));
#define MFMA32(a, b, c) __builtin_amdgcn_mfma_f32_32x32x16_bf16((a), (b), (c), 0, 0, 0)
__device__ __forceinline__ bf16x8 pack8(float a0, float a1, float a2, float a3, float a4, float a5, float a6, float a7) { const v4u p = {pkbf(a0, a1), pkbf(a2, a3), pkbf(a4, a5), pkbf(a6, a7)}; return __builtin_bit_cast(bf16x8, p); }
constexpr float QSCALE = 0.125f * 1.44269504089f;
__device__ __forceinline__ void prep_phase(Frame& F) {
    LAS unsigned* tl = (LAS unsigned*)(F.lds + RING_OFF + F.wave * 16384);
    const bf16* P = (const bf16*)(F.ws + WS_P); bf16* Qn = (bf16*)(F.ws + WS_QN); bf16* Kn = (bf16*)(F.ws + WS_KN); bf16* VT = (bf16*)(F.ws + WS_VT);
    const int tr = F.lane >> 3, c8 = F.lane & 7;
    for (int it = F.gw; it < 4096; it += F.ngw) {
        const int bh = it & 127, blk = it >> 7, b = bh >> 3, h = bh & 7;
        const bf16* base = P + ((size_t)b * 8 + h) * SEQ * 64 + (size_t)(blk * 64 + tr) * 64 + 8 * c8;
        v4u rv[8];
#pragma unroll
        for (int i = 0; i < 8; ++i) { const bf16* row = base + (size_t)(8 * i) * 64; rv[i] = *(const GAS v4u*)(row + (size_t)2 * 16 * 8 * SEQ * 64); }
        {
#pragma unroll
            for (int i = 0; i < 8; ++i) { LAS unsigned* q = tl + (8 * i + tr) * 33 + 4 * c8; q[0] = rv[i].x; q[1] = rv[i].y; q[2] = rv[i].z; q[3] = rv[i].w; }
            LDS_WAIT(); asm volatile("" ::: "memory");
            const LAS unsigned short* t16 = (const LAS unsigned short*)tl; const int dr = tr;
#define KAP(pos) (((pos) & ~12) | (((pos) & 4) << 1) | (((pos) & 8) >> 1))
            bf16* const obase = VT + ((size_t)bh * 64 + blk * 2 + (c8 >> 2)) * 2048 + ((c8 >> 1) & 1) * 512 + (c8 & 1) * 256;
#pragma unroll
            for (int j = 0; j < 8; ++j) { unsigned val[8];
#pragma unroll
                for (int p = 0; p < 8; ++p) { const int pos = 8 * c8 + p; val[p] = t16[KAP(pos) * 66 + 8 * j + dr]; }
                v4u w4; w4.x = val[0] | (val[1] << 16); w4.y = val[2] | (val[3] << 16); w4.z = val[4] | (val[5] << 16); w4.w = val[6] | (val[7] << 16);
                *(GAS v4u*)(obase + (j >> 2) * 1024 + ((8 * j + dr) & 31) * 8) = w4; }
#undef KAP
            LDS_WAIT(); asm volatile("" ::: "memory");
        }
    }
}

__device__ __forceinline__ int crow16(int i, int hh) { return (i & 3) + 8 * (i >> 2) + 4 * hh; }
__device__ __forceinline__ void attn_item(Frame& F, int bh, int qb, float thr, const bf16x8 (&Lt)[2]) {
    const int r = F.lane & 31, hh = F.lane >> 5, b = bh >> 3, h = bh & 7, q0 = qb * 32;
    const bf16* Qn = (const bf16*)(F.ws + WS_QN); const bf16* Kn = (const bf16*)(F.ws + WS_KN); const bf16* VT = (const bf16*)(F.ws + WS_VT);
    bf16x8 qf[4];
#pragma unroll
    for (int s = 0; s < 4; ++s) qf[s] = *(const GAS bf16x8*)(Qn + ((size_t)bh * 64 + qb) * 2048 + s * 512 + F.lane * 8);
    f32x4 gout[2][4];
#pragma unroll
    for (int db = 0; db < 2; ++db)
#pragma unroll
        for (int gq = 0; gq < 4; ++gq) gout[db][gq] = *(const f32x4*)(F.sb_out_g + h * 64 + 32 * db + 8 * gq + 4 * hh);
    f32x16 O0, O1;
#pragma unroll
    for (int i = 0; i < 16; ++i) { O0[i] = 0.f; O1[i] = 0.f; }
    float carry = 0.f;
    const bf16* kbase = Kn + (size_t)bh * 64 * 2048 + F.lane * 8; const bf16* vbase = VT + (size_t)bh * 64 * 2048 + F.lane * 8;
#define ATT_LOAD(KF, VF, kb_) do { _Pragma("unroll") for (int s_ = 0; s_ < 4; ++s_) KF[s_] = *(const GAS bf16x8*)(kbase + (size_t)(kb_) * 2048 + 512 * s_); \
        _Pragma("unroll") for (int db_ = 0; db_ < 2; ++db_) _Pragma("unroll") for (int ks_ = 0; ks_ < 2; ++ks_) VF[db_][ks_] = *(const GAS bf16x8*)(vbase + (size_t)(kb_) * 2048 + 1024 * db_ + 512 * ks_); } while (0)
#define ATT_BLOCK(KF, VF, kb_) do { const bool diag = ((kb_) == qb); \
        f32x16 z; _Pragma("unroll") for (int i = 0; i < 16; ++i) z[i] = 0.f; \
        _Pragma("unroll") for (int s_ = 0; s_ < 4; ++s_) z = MFMA32(KF[s_], qf[s_], z); \
        float sp[16]; \
        _Pragma("unroll") for (int i = 0; i < 16; ++i) { const float zz = z[i]; float v = fmaxf(zz, 0.f) + __builtin_amdgcn_logf(1.f + __builtin_amdgcn_exp2f(-fabsf(zz))); if (diag && !(crow16(i, hh) < r)) v = 0.f; sp[i] = v; } \
        const bf16x8 sb0 = pack8(sp[0], sp[1], sp[2], sp[3], sp[4], sp[5], sp[6], sp[7]), sb1 = pack8(sp[8], sp[9], sp[10], sp[11], sp[12], sp[13], sp[14], sp[15]); \
        f32x16 Cc; _Pragma("unroll") for (int i = 0; i < 16; ++i) Cc[i] = carry; \
        Cc = MFMA32(Lt[0], sb0, Cc); Cc = MFMA32(Lt[1], sb1, Cc); \
        float w[16]; \
        _Pragma("unroll") for (int i = 0; i < 16; ++i) { float v = __builtin_amdgcn_exp2f(z[i] - Cc[i]); if (diag && !(crow16(i, hh) < r)) v = 0.f; w[i] = v; } \
        const bf16x8 wb0 = pack8(w[0], w[1], w[2], w[3], w[4], w[5], w[6], w[7]), wb1 = pack8(w[8], w[9], w[10], w[11], w[12], w[13], w[14], w[15]); \
        O0 = MFMA32(VF[0][0], wb0, O0); O0 = MFMA32(VF[0][1], wb1, O0); O1 = MFMA32(VF[1][0], wb0, O1); O1 = MFMA32(VF[1][1], wb1, O1); \
        carry = __shfl(Cc[0], r); } while (0)
    bf16x8 kfA[4], vfA[2][2], kfB[4], vfB[2][2];
    ATT_LOAD(kfA, vfA, qb);
    for (int kb = qb; kb >= 0; kb -= 2) {
        ATT_LOAD(kfB, vfB, kb > 0 ? kb - 1 : 0); __builtin_amdgcn_sched_barrier(0);
        ATT_BLOCK(kfA, vfA, kb);
        if (kb == 0 || __all(carry > thr)) break;
        ATT_LOAD(kfA, vfA, kb > 1 ? kb - 2 : 0); __builtin_amdgcn_sched_barrier(0);
        ATT_BLOCK(kfB, vfB, kb - 1);
        if (__all(carry > thr)) break;
    }
#undef ATT_LOAD
#undef ATT_BLOCK
    float ss = 0.f;
#pragma unroll
    for (int i = 0; i < 16; ++i) ss += O0[i] * O0[i] + O1[i] * O1[i];
    ss += __shfl_xor(ss, 32);
    const float rs = 1.f / sqrtf(ss * (1.f / 64.f) + EPS);
    bf16* orow = (bf16*)(F.ws + WS_MIX) + ((size_t)b * SEQ + q0 + r) * D + h * 64;
#pragma unroll
    for (int db = 0; db < 2; ++db) { unsigned op[4][2];
#pragma unroll
        for (int gq = 0; gq < 4; ++gq) { const f32x4 gg = gout[db][gq];
            const float a0 = (db ? O1[4 * gq + 0] : O0[4 * gq + 0]) * rs * gg.x, a1 = (db ? O1[4 * gq + 1] : O0[4 * gq + 1]) * rs * gg.y, a2 = (db ? O1[4 * gq + 2] : O0[4 * gq + 2]) * rs * gg.z, a3 = (db ? O1[4 * gq + 3] : O0[4 * gq + 3]) * rs * gg.w;
            op[gq][0] = pkbf(a0, a1); op[gq][1] = pkbf(a2, a3); }
        v4u P[2];
#pragma unroll
        for (int gp = 0; gp < 2; ++gp) { const auto s0 = __builtin_amdgcn_permlane32_swap(op[2 * gp][0], op[2 * gp + 1][0], false, false), s1 = __builtin_amdgcn_permlane32_swap(op[2 * gp][1], op[2 * gp + 1][1], false, false);
            P[gp] = (v4u){s0[0], s1[0], s0[1], s1[1]}; }
        const bool odd = r & 1; v4u sA, sB; pair_trade(P[0], P[1], odd, sA, sB);
        bf16* oE = orow - (odd ? D : 0) + 32 * db + 8 * (hh + 2 * (odd ? 1 : 0));
        *(GAS v4u*)oE = sA; *(GAS v4u*)(oE + D) = sB; }
}
__device__ __forceinline__ void attn_phase(Frame& F) {
    const int r = F.lane & 31, hh = F.lane >> 5;
    float mq = fabsf(F.sb_q_g[F.lane]), mk = fabsf(F.sb_k_g[F.lane]);
#pragma unroll
    for (int o = 1; o < 64; o <<= 1) { mq = fmaxf(mq, __shfl_xor(mq, o)); mk = fmaxf(mk, __shfl_xor(mk, o)); }
    const float thr = 64.f * QSCALE * mq * mk * 1.02f + 151.f;
    bf16x8 Lt[2];
#pragma unroll
    for (int ks = 0; ks < 2; ++ks) { float e[8];
#pragma unroll
        for (int jj = 0; jj < 8; ++jj) e[jj] = (16 * ks + 8 * (jj >> 2) + 4 * hh + (jj & 3) >= r) ? 1.f : 0.f;
        Lt[ks] = pack8(e[0], e[1], e[2], e[3], e[4], e[5], e[6], e[7]); }
    for (int it = F.gw; it < 2048; it += F.ngw) { const int bh = it & 127, j = it >> 7;
        attn_item(F, bh, 63 - j, thr, Lt); attn_item(F, bh, j, thr, Lt); attn_item(F, bh, 47 - j, thr, Lt); attn_item(F, bh, 16 + j, thr, Lt); }
}

constexpr int HG_PART = 0, HG_SSQ = 2048, HG_QE = 4096, HG_KE = HG_QE + 64 * 272, HG_VT = HG_KE + 64 * 272, HG_KST = HG_VT + 128 * 144, HG_ST = HG_KST + 128 * 144, HG_END = HG_ST + 128 * 272;
static_assert(HG_END <= RING_BYTES, "HGRN2 LDS map");
__device__ __forceinline__ float hg_lbound(Frame& F, int h, int d) { const int c = h * 128 + d; return 1.f / (1.f + __expf(F.hg_lb[512 + c] - F.hg_lb[c])); }
__device__ __forceinline__ void hg_gates(Frame& F, const unsigned short (&ffr)[16], float lb, int d, int tq, float (&bb)[16], float (&kk)[16], float& total) {
    float run = 1.f;
#pragma unroll
    for (int i = 0; i < 16; ++i) { const float ff = bf2f(ffr[i]); const float sg = __builtin_amdgcn_rcpf(1.f + __expf(-ff));
        const float f = lb + (1.f - lb) * sg; kk[i] = (1.f - lb) * (1.f - sg); run *= f; bb[i] = run; }
    LAS float* part = (LAS float*)(F.lds + RING_OFF + HG_PART);
    part[tq * 128 + d] = run;
    __syncthreads();
    const float p0 = part[d], p1 = part[128 + d], p2 = part[256 + d], p3 = part[384 + d];
    const float off = (tq > 0 ? p0 : 1.f) * (tq > 1 ? p1 : 1.f) * (tq > 2 ? p2 : 1.f);
    total = (p0 * p1) * (p2 * p3);
#pragma unroll
    for (int i = 0; i < 16; ++i) bb[i] *= off;
}
#define HG_HV() const bf16* const PHp = (const bf16*)(F.ws + WS_PH); \
    const __amdgpu_buffer_rsrc_t rsrcP = __builtin_amdgcn_make_buffer_rsrc((void*)PHp, 0, (int)((size_t)4 * T * 512 * 2), 0x00020000)
#define HG_SOFF(item_, arr_) ((unsigned)((((arr_) * 16 + (((item_) >> 5) >> 2)) * 4 + (((item_) >> 5) & 3)) * SEQ + ((item_) & 31) * 64) * 256u)
#define HG_ARR(col_) ((col_) == OFF_HQ ? 0 : (col_) == OFF_HF ? 1 : (col_) == OFF_HI ? 2 : 3)
#define HG_LOADT(dst2, item_, arr_) do { const unsigned so_ = (unsigned)__builtin_amdgcn_readfirstlane((int)HG_SOFF(item_, arr_)); _Pragma("unroll") for (int j_ = 0; j_ < 2; ++j_) \
        (dst2)[j_] = __builtin_bit_cast(v4u, __builtin_amdgcn_raw_buffer_load_b128(rsrcP, (unsigned)F.tid * 16u + 8192u * j_, so_, 0)); } while (0)
#define HG_PUT(src2, raw_) do { _Pragma("unroll") for (int j_ = 0; j_ < 2; ++j_) *(LAS v4u*)((raw_) + ((F.tid >> 4) + 32 * j_) * 272 + (F.tid & 15) * 16) = (src2)[j_]; } while (0)
#define HG_COL(dst, raw_) do { _Pragma("unroll") for (int i_ = 0; i_ < 16; ++i_) dst[i_] = *(const LAS unsigned short*)((raw_) + (16 * tq + i_) * 272 + 2 * d); } while (0)
template <bool PERMUTE> __device__ __forceinline__ void st16(LAS unsigned char* dst, const float (&v)[16]) {
    v4u a, b2;
    if (!PERMUTE) { a.x = pkbf(v[0], v[1]); a.y = pkbf(v[2], v[3]); a.z = pkbf(v[4], v[5]); a.w = pkbf(v[6], v[7]); b2.x = pkbf(v[8], v[9]); b2.y = pkbf(v[10], v[11]); b2.z = pkbf(v[12], v[13]); b2.w = pkbf(v[14], v[15]); }
    else { a.x = pkbf(v[0], v[1]); a.y = pkbf(v[2], v[3]); a.z = pkbf(v[8], v[9]); a.w = pkbf(v[10], v[11]); b2.x = pkbf(v[4], v[5]); b2.y = pkbf(v[6], v[7]); b2.z = pkbf(v[12], v[13]); b2.w = pkbf(v[14], v[15]); }
    *(LAS v4u*)dst = a; *(LAS v4u*)(dst + 16) = b2;
}
__device__ __forceinline__ void hgA_phase(Frame& F) {
    const int d = F.tid & 127, tq = F.tid >> 7, r = F.lane & 31, hh = F.lane >> 5;
    const bf16* P = (const bf16*)(F.ws + WS_P); bf16* KVS = (bf16*)(F.ws + WS_KVS); float* DEC = (float*)(F.ws + WS_DEC); float* SSEG = (float*)(F.ws + WS_SSEG); float* DSEG = (float*)(F.ws + WS_DSEG);
    LAS unsigned char* L = F.lds + RING_OFF; LAS float* decl = (LAS float*)(L + HG_SSQ);
    HG_HV();
    v4u rf[2], rv[2];
    LAS unsigned char* const RAWF = F.lds + ROWTAB_OFF; LAS unsigned char* const RAWV = L + HG_ST;
    for (int wg = blockIdx.x; wg < 256; wg += F.G) {
        const int bh = wg >> 2, seg = wg & 3, item0 = bh * 32 + seg * 8, h = bh & 3;
        HG_LOADT(rf, item0, 1); HG_LOADT(rv, item0, 2);
        const float lbv = hg_lbound(F, h, d); float totrun = 1.f;
        const int db = F.wave & 3, eb0 = 2 * (F.wave >> 2);
        f32x16 run0, run1;
#pragma unroll
        for (int i = 0; i < 16; ++i) { run0[i] = 0.f; run1[i] = 0.f; }
      for (int k = 0; k < 8; ++k) {
        const int item = item0 + k;
        HG_PUT(rf, RAWF); HG_PUT(rv, RAWV);
        __syncthreads();
        { const int nit = k < 7 ? item + 1 : item; HG_LOADT(rf, nit, 1); HG_LOADT(rv, nit, 2); __builtin_amdgcn_sched_barrier(0); }
        unsigned short ffr[16], vr[16]; HG_COL(ffr, RAWF); HG_COL(vr, RAWV);
        float bb[16], kk[16], total; hg_gates(F, ffr, lbv, d, tq, bb, kk, total);
        float ks[16], vv[16];
#pragma unroll
        for (int i = 0; i < 16; ++i) { ks[i] = kk[i] * (total * __builtin_amdgcn_rcpf(bb[i])); vv[i] = bf2f(vr[i]); }
        st16<false>(L + HG_KST + d * 144 + tq * 32, ks); st16<false>(L + HG_VT + d * 144 + tq * 32, vv);
        const float dc = total; totrun *= total;
        if (tq == 0) { DEC[(size_t)item * 128 + d] = dc; decl[d] = dc; }
        __syncthreads();
        f32x16 acc0, acc1;
#pragma unroll
        for (int i = 0; i < 16; ++i) { acc0[i] = 0.f; acc1[i] = 0.f; }
#pragma unroll
        for (int s = 0; s < 4; ++s) { const bf16x8 af = *(const LAS bf16x8*)(L + HG_KST + (db * 32 + r) * 144 + 32 * s + 16 * hh);
            const bf16x8 b0 = *(const LAS bf16x8*)(L + HG_VT + (eb0 * 32 + r) * 144 + 32 * s + 16 * hh), b1 = *(const LAS bf16x8*)(L + HG_VT + ((eb0 + 1) * 32 + r) * 144 + 32 * s + 16 * hh);
            acc0 = MFMA32(af, b0, acc0); acc1 = MFMA32(af, b1, acc1); }
#pragma unroll
        for (int g = 0; g < 4; ++g) { const f32x4 dl = *(const LAS f32x4*)(decl + db * 32 + 8 * g + 4 * hh);
#pragma unroll
            for (int ii = 0; ii < 4; ++ii) { run0[4 * g + ii] = dl[ii] * run0[4 * g + ii] + acc0[4 * g + ii]; run1[4 * g + ii] = dl[ii] * run1[4 * g + ii] + acc1[4 * g + ii]; } }
#pragma unroll
        for (int j = 0; j < 2; ++j) { const bool odd = r & 1; bf16* dst = KVS + ((size_t)item * 128 + (eb0 + j) * 32 + (r & ~1)) * 128 + db * 32 + 8 * (hh + 2 * (odd ? 1 : 0));
            v4u P[2];
#pragma unroll
            for (int gp = 0; gp < 2; ++gp) { unsigned pk[2][2];
#pragma unroll
                for (int q = 0; q < 2; ++q) { const int g = 2 * gp + q; const float a0 = j ? acc1[4 * g + 0] : acc0[4 * g + 0], a1 = j ? acc1[4 * g + 1] : acc0[4 * g + 1], a2 = j ? acc1[4 * g + 2] : acc0[4 * g + 2], a3 = j ? acc1[4 * g + 3] : acc0[4 * g + 3];
                    pk[q][0] = pkbf(a0, a1); pk[q][1] = pkbf(a2, a3); }
                const auto s0 = __builtin_amdgcn_permlane32_swap(pk[0][0], pk[1][0], false, false), s1 = __builtin_amdgcn_permlane32_swap(pk[0][1], pk[1][1], false, false);
                P[gp] = (v4u){s0[0], s1[0], s0[1], s1[1]}; }
            v4u sA, sB; pair_trade(P[0], P[1], odd, sA, sB);
            *(GAS v4u*)dst = sA; *(GAS v4u*)(dst + 128) = sB; }
        __syncthreads();
      }
#pragma unroll
        for (int j = 0; j < 2; ++j) { float* dst = SSEG + ((size_t)wg * 128 + (eb0 + j) * 32 + r) * 128 + db * 32 + 4 * hh;
#pragma unroll
            for (int g = 0; g < 4; ++g) *(GAS f32x4*)(dst + 8 * g) = j ? (f32x4){run1[4 * g + 0], run1[4 * g + 1], run1[4 * g + 2], run1[4 * g + 3]} : (f32x4){run0[4 * g + 0], run0[4 * g + 1], run0[4 * g + 2], run0[4 * g + 3]}; }
        if (tq == 0) DSEG[(size_t)wg * 128 + d] = totrun;
    }
}
constexpr int HG_DECS = HG_END;
static_assert(HG_DECS + 4096 + 64 * 272 <= LDSCTL_OFF && HG_KST + 64 * 272 <= HG_ST && 64 * 272 <= MAXSLOT * 1536, "HGRN2 LDS map (decays, raw tiles)");
__device__ __forceinline__ void hgC_phase(Frame& F) {
    const int d = F.tid & 127, tq = F.tid >> 7, r = F.lane & 31, hh = F.lane >> 5;
    const bf16* P = (const bf16*)(F.ws + WS_P); const bf16* KVS = (const bf16*)(F.ws + WS_KVS); bf16* MIX = (bf16*)(F.ws + WS_MIX); const float* DEC = (const float*)(F.ws + WS_DEC);
    HG_HV();
    LAS unsigned char* L = F.lds + RING_OFF; const LAS float* decs = (const LAS float*)(L + HG_DECS);
    const int srow = (F.tid >> 6) * 16 + ((F.tid & 63) >> 4), sd0 = 8 * (F.tid & 15);
    v4u rf[2], rq[2], rv[2], st[4];
    LAS unsigned char* const RAWF = L + HG_KST; LAS unsigned char* const RAWQ = F.lds + ROWTAB_OFF; LAS unsigned char* const RAWV = L + HG_DECS + 4096;
    const __amdgpu_buffer_rsrc_t rsrcG = __builtin_amdgcn_make_buffer_rsrc((void*)F.hg_out_g, 0, 512 * 4, 0x00020000), rsrcSS = __builtin_amdgcn_make_buffer_rsrc((void*)(F.ws + WS_SSEG), 0, 256 * 128 * 128 * 4, 0x00020000), rsrcDS = __builtin_amdgcn_make_buffer_rsrc((void*)(F.ws + WS_DSEG), 0, 256 * 128 * 4, 0x00020000);
    const __amdgpu_buffer_rsrc_t rsrcD = __builtin_amdgcn_make_buffer_rsrc((void*)DEC, 0, 64 * 32 * 128 * 4, 0x00020000), rsrcM = __builtin_amdgcn_make_buffer_rsrc((void*)MIX, 0, (int)((size_t)T * D * 2), 0x00020000);
    const __amdgpu_buffer_rsrc_t rsrcK = __builtin_amdgcn_make_buffer_rsrc((void*)KVS, 0, 64 * 32 * 128 * 128 * 2, 0x00020000); const unsigned kvo = (unsigned)((srow * 128 + sd0) * 2);
#define HG_LOADKV(dst_, item_) do { const unsigned so_ = (unsigned)__builtin_amdgcn_readfirstlane((int)((item_) * (128 * 128 * 2))); _Pragma("unroll") for (int j_ = 0; j_ < 4; ++j_) (dst_)[j_] = __builtin_bit_cast(v4u, __builtin_amdgcn_raw_buffer_load_b128(rsrcK, kvo + 1024u * j_, so_, 0)); } while (0)
#define HG_LOADST(item_) HG_LOADKV(st, item_)
#define HG_FOLD(kv_, c_) do { const f32x4 d0_ = *(const LAS f32x4*)(decs + (c_) * 128 + sd0), d1_ = *(const LAS f32x4*)(decs + (c_) * 128 + sd0 + 4); _Pragma("unroll") for (int j_ = 0; j_ < 4; ++j_) { const v4u k_ = (kv_)[j_]; \
        S[8 * j_ + 0] = d0_.x * S[8 * j_ + 0] + bflo(k_.x); S[8 * j_ + 1] = d0_.y * S[8 * j_ + 1] + bfhi(k_.x); S[8 * j_ + 2] = d0_.z * S[8 * j_ + 2] + bflo(k_.y); S[8 * j_ + 3] = d0_.w * S[8 * j_ + 3] + bfhi(k_.y); \
        S[8 * j_ + 4] = d1_.x * S[8 * j_ + 4] + bflo(k_.z); S[8 * j_ + 5] = d1_.y * S[8 * j_ + 5] + bfhi(k_.z); S[8 * j_ + 6] = d1_.z * S[8 * j_ + 6] + bflo(k_.w); S[8 * j_ + 7] = d1_.w * S[8 * j_ + 7] + bfhi(k_.w); } } while (0)
    for (int wg = blockIdx.x; wg < 256; wg += F.G) {
        const int bh = wg >> 2, seg = wg & 3, item0 = bh * 32 + seg * 8, b = bh >> 2, h = bh & 3;
        HG_LOADT(rf, item0, 1); HG_LOADT(rq, item0, 0); HG_LOADT(rv, item0, 2); HG_LOADST(item0);
        const unsigned dso0 = (unsigned)__builtin_amdgcn_readfirstlane((bh * 32 + seg * 8) * 128 * 4);
        const f32x4 decv = __builtin_bit_cast(f32x4, __builtin_amdgcn_raw_buffer_load_b128(rsrcD, (unsigned)(F.tid & 255) * 16u, dso0, 0));
        const float lbv = hg_lbound(F, h, d);
        __builtin_amdgcn_sched_barrier(0);
        float S[32];
#pragma unroll
        for (int j = 0; j < 32; ++j) S[j] = 0.f;
        for (int sp = 0; sp < seg; ++sp) {
            const unsigned sso = (unsigned)__builtin_amdgcn_readfirstlane((bh * 4 + sp) * 128 * 128 * 4), dso = (unsigned)__builtin_amdgcn_readfirstlane((bh * 4 + sp) * 128 * 4);
#pragma unroll
            for (int j0 = 0; j0 < 8; j0 += 8) { f32x4 sv[8], dv[8];
#pragma unroll
                for (int j = 0; j < 8; ++j) { sv[j] = __builtin_bit_cast(f32x4, __builtin_amdgcn_raw_buffer_load_b128(rsrcSS, (unsigned)((srow * 128 + sd0) * 4) + 2048u * ((j0 + j) >> 1) + 16u * ((j0 + j) & 1), sso, 0));
                    dv[j] = __builtin_bit_cast(f32x4, __builtin_amdgcn_raw_buffer_load_b128(rsrcDS, (unsigned)(sd0 * 4) + 16u * ((j0 + j) & 1), dso, 0)); }
#pragma unroll
                for (int j = 0; j < 8; ++j) { const int q = 4 * (j0 + j); S[q + 0] = dv[j].x * S[q + 0] + sv[j].x; S[q + 1] = dv[j].y * S[q + 1] + sv[j].y; S[q + 2] = dv[j].z * S[q + 2] + sv[j].z; S[q + 3] = dv[j].w * S[q + 3] + sv[j].w; } }
        }
        if (F.tid < 256) *((LAS f32x4*)(L + HG_DECS) + F.tid) = decv;
        __syncthreads();
      for (int k = 0; k < 8; ++k) {
        const int item = item0 + k, c = seg * 8 + k;
        const int tb = F.wave & 1, eb = F.wave >> 1;
        const int nit = k < 7 ? item + 1 : item;
        HG_PUT(rf, RAWF); HG_PUT(rq, RAWQ); HG_PUT(rv, RAWV);
        __syncthreads();
        HG_LOADT(rf, nit, 1); HG_LOADT(rq, nit, 0); HG_LOADT(rv, nit, 2); __builtin_amdgcn_sched_barrier(0);
        unsigned short ffr[16], qr[16], vr[16]; HG_COL(ffr, RAWF); HG_COL(qr, RAWQ); HG_COL(vr, RAWV);
        float bb[16], kk[16], total; hg_gates(F, ffr, lbv, d, tq, bb, kk, total);
        float vv[16];
#pragma unroll
        for (int i = 0; i < 16; ++i) { const int t = 16 * tq + i; const float q = bf2f(qr[i]);
            *(LAS unsigned short*)(L + HG_QE + t * 272 + 2 * d) = (unsigned short)pkbf(q * bb[i], 0.f);
            *(LAS unsigned short*)(L + HG_KE + t * 272 + 2 * d) = (unsigned short)pkbf(kk[i] * __builtin_amdgcn_rcpf(bb[i]), 0.f);
            vv[i] = bf2f(vr[i]); }
        st16<true>(L + HG_VT + d * 144 + tq * 32, vv);
#pragma unroll
        for (int j = 0; j < 4; ++j) { v4u w4; w4.x = pkbf(S[8 * j + 0], S[8 * j + 1]); w4.y = pkbf(S[8 * j + 2], S[8 * j + 3]); w4.z = pkbf(S[8 * j + 4], S[8 * j + 5]); w4.w = pkbf(S[8 * j + 6], S[8 * j + 7]);
            *(LAS v4u*)(L + HG_ST + (srow + 4 * j) * 272 + sd0 * 2) = w4; }
        HG_FOLD(st, k);
        v4u grw[2];
        { const bf16* grow_ = PHp + (((size_t)(3 * 16 + b) * 4 + h) * SEQ + c * 64 + tb * 32 + r) * 128;
#pragma unroll
            for (int gp = 0; gp < 2; ++gp) grw[gp] = *(const GAS v4u*)(grow_ + eb * 32 + 8 * (2 * gp + hh)); }
        HG_LOADST(nit); __builtin_amdgcn_sched_barrier(0);
        __syncthreads();
        f32x16 acc;
#pragma unroll
        for (int i = 0; i < 16; ++i) acc[i] = 0.f;
#define HG_QF(s_) (*(const LAS bf16x8*)(L + HG_QE + (tb * 32 + r) * 272 + 32 * (s_) + 16 * hh))
#pragma unroll
        for (int s = 0; s < 8; ++s) acc = MFMA32(*(const LAS bf16x8*)(L + HG_ST + (eb * 32 + r) * 272 + 32 * s + 16 * hh), HG_QF(s), acc);
        for (int sb = 0; sb <= tb; ++sb) {
            f32x16 at;
#pragma unroll
            for (int i = 0; i < 16; ++i) at[i] = 0.f;
#pragma unroll
            for (int s = 0; s < 8; ++s) at = MFMA32(*(const LAS bf16x8*)(L + HG_KE + (sb * 32 + r) * 272 + 32 * s + 16 * hh), HG_QF(s), at);
            float a[16];
#pragma unroll
            for (int i = 0; i < 16; ++i) a[i] = (sb < tb || crow16(i, hh) <= r) ? at[i] : 0.f;
            const bf16x8 ab0 = pack8(a[0], a[1], a[2], a[3], a[4], a[5], a[6], a[7]), ab1 = pack8(a[8], a[9], a[10], a[11], a[12], a[13], a[14], a[15]);
            acc = MFMA32(*(const LAS bf16x8*)(L + HG_VT + (eb * 32 + r) * 144 + sb * 64 + 0 + 16 * hh), ab0, acc);
            acc = MFMA32(*(const LAS bf16x8*)(L + HG_VT + (eb * 32 + r) * 144 + sb * 64 + 32 + 16 * hh), ab1, acc);
        }
        float ss = 0.f;
#pragma unroll
        for (int i = 0; i < 16; ++i) ss += acc[i] * acc[i];
        ss += __shfl_xor(ss, 32);
        LAS float* ssq = (LAS float*)(L + HG_SSQ);
        if (hh == 0) ssq[eb * 64 + tb * 32 + r] = ss;
        f32x4 ggv[4];
        { const unsigned so = (unsigned)__builtin_amdgcn_readfirstlane(h * 512);
#pragma unroll
            for (int g = 0; g < 4; ++g) ggv[g] = __builtin_bit_cast(f32x4, __builtin_amdgcn_raw_buffer_load_b128(rsrcG, (unsigned)((eb * 32 + 8 * g + 4 * hh) * 4), so, 0)); }
        __syncthreads();
        const int tl = tb * 32 + r; const float tot = (ssq[tl] + ssq[64 + tl]) + (ssq[128 + tl] + ssq[192 + tl]);
        const float rs = 1.f / sqrtf(tot * (1.f / 128.f) + EPS);
        const unsigned mso = (unsigned)__builtin_amdgcn_readfirstlane((int)((((unsigned)b * SEQ + c * 64) * D + 512 + h * 128) * 2)), mvo = (unsigned)((tl * D + eb * 32) * 2);
        unsigned long long grv[4];
#pragma unroll
        for (int gp = 0; gp < 2; ++gp) { const auto sa = __builtin_amdgcn_permlane32_swap(grw[gp].x, grw[gp].z, false, false), sb = __builtin_amdgcn_permlane32_swap(grw[gp].y, grw[gp].w, false, false);
            grv[2 * gp] = (unsigned long long)sa[0] | ((unsigned long long)sb[0] << 32); grv[2 * gp + 1] = (unsigned long long)sa[1] | ((unsigned long long)sb[1] << 32); }
        unsigned yp[4][2];
#pragma unroll
        for (int g = 0; g < 4; ++g) { const unsigned long long gr = grv[g]; const f32x4 gg = ggv[g];
            const float g0 = bflo((unsigned)gr), g1 = bfhi((unsigned)gr), g2 = bflo((unsigned)(gr >> 32)), g3 = bfhi((unsigned)(gr >> 32));
            const float y0 = acc[4 * g + 0] * rs * gg.x * (g0 * __builtin_amdgcn_rcpf(1.f + __expf(-g0))), y1 = acc[4 * g + 1] * rs * gg.y * (g1 * __builtin_amdgcn_rcpf(1.f + __expf(-g1)));
            const float y2 = acc[4 * g + 2] * rs * gg.z * (g2 * __builtin_amdgcn_rcpf(1.f + __expf(-g2))), y3 = acc[4 * g + 3] * rs * gg.w * (g3 * __builtin_amdgcn_rcpf(1.f + __expf(-g3)));
            yp[g][0] = pkbf(y0, y1); yp[g][1] = pkbf(y2, y3); }
        { v4u P[2];
#pragma unroll
            for (int gp = 0; gp < 2; ++gp) { const auto s0 = __builtin_amdgcn_permlane32_swap(yp[2 * gp][0], yp[2 * gp + 1][0], false, false), s1 = __builtin_amdgcn_permlane32_swap(yp[2 * gp][1], yp[2 * gp + 1][1], false, false);
                P[gp] = (v4u){s0[0], s1[0], s0[1], s1[1]}; }
            const bool odd = r & 1; v4u sA, sB; pair_trade(P[0], P[1], odd, sA, sB);
            const unsigned mvE = (unsigned)((((tb * 32 + (r & ~1)) * D + eb * 32) * 2) + 16 * (hh + 2 * (odd ? 1 : 0)));
            __builtin_amdgcn_raw_buffer_store_b128(sA, rsrcM, mvE, mso, 0); __builtin_amdgcn_raw_buffer_store_b128(sB, rsrcM, mvE + (unsigned)(D * 2), mso, 0); }
        __syncthreads();
      }
    }
#undef HG_LOADST
#undef HG_LOADKV
#undef HG_FOLD
#undef HG_QF
}
#undef HG_LOADT
#undef HG_PUT
#undef HG_COL
#undef HG_ARR
#undef HG_SOFF
#undef HG_HV

__device__ __forceinline__ void router_phase(Frame& F) {
    LAS unsigned char* L = F.lds; const int r = F.lane & 31, hh = F.lane >> 5;
    LAS unsigned* lcnt = (LAS unsigned*)(F.lds + LTAB_OFF) + LT_MISC; LAS unsigned* lbase = lcnt + 32; LAS float* lrstd = (LAS float*)(F.lds + ROWTAB_OFF);
    float* TOPG = (float*)(F.ws + WS_TOPG);
    {
        const GAS v4u* img = (const GAS v4u*)(F.ws + WS_RT) + vzero();
        constexpr int NB = (RT_END / 16 + NWAVES * 64 - 1) / (NWAVES * 64);
        v4u t4[NB];
#pragma unroll
        for (int j = 0; j < NB; ++j) { const int q = F.tid + j * NWAVES * 64; t4[j] = img[q < RT_END / 16 ? q : 0]; }
#pragma unroll
        for (int j = 0; j < NB; ++j) { const int q = F.tid + j * NWAVES * 64; if (q < RT_END / 16) *(LAS v4u*)(L + 16 * q) = t4[j]; }
    }
    const bf16* XH = (const bf16*)(F.ws + WS_XN); int* LIST = (int*)(F.ws + WS_LIST); unsigned* cnt = (unsigned*)(F.ctl + CW_CNT);
    for (int base = blockIdx.x * 4; base < T / 32; base += F.G * 4) {
        const int grp = base + F.wave; const bool active = F.wave < 4 && grp < T / 32;
        if (F.tid < 32) lcnt[F.tid] = 0u;
        __syncthreads();
        float sv[4] = {0.f, 0.f, 0.f, 0.f}; int se[4] = {0, 0, 0, 0}; unsigned lp0 = 0u, lp1 = 0u; float rstd = 0.f; const int tok = grp * 32 + r;
        if (active) {
            const bf16* hrow = XH + (size_t)tok * D + 8 * hh;
            f32x16 acc;
#pragma unroll
            for (int i = 0; i < 16; ++i) acc[i] = 0.f;
            float ssq = 0.f;
#pragma unroll 16
            for (int s = 0; s < 64; ++s) {
                const v4u hu = *(const GAS v4u*)(hrow + 16 * s); const bf16x8 hi = __builtin_bit_cast(bf16x8, hu);
                { const float a0 = bflo(hu.x), a1 = bfhi(hu.x), a2 = bflo(hu.y), a3 = bfhi(hu.y), a4 = bflo(hu.z), a5 = bfhi(hu.z), a6 = bflo(hu.w), a7 = bfhi(hu.w);
                    ssq += (a0 * a0 + a1 * a1) + (a2 * a2 + a3 * a3) + (a4 * a4 + a5 * a5) + (a6 * a6 + a7 * a7); }
                const bf16x8 wh = *(const LAS bf16x8*)(L + r * RT_ROW + 32 * s + 16 * hh), wl = *(const LAS bf16x8*)(L + RT_WL + r * RT_ROW + 32 * s + 16 * hh);
                acc = MFMA32(wh, hi, acc); acc = MFMA32(wl, hi, acc);
            }
            ssq += __shfl_xor(ssq, 32);
            rstd = 1.f / sqrtf(ssq * (1.f / D) + EPS);
            float l[16];
#pragma unroll
            for (int i = 0; i < 16; ++i) l[i] = acc[i] * rstd + F.b_router[crow16(i, hh)];
            float cv[8]; int ce[8];
#pragma unroll
            for (int rnd = 0; rnd < 4; ++rnd) { float bv = l[0]; int bi = 0;
#pragma unroll
                for (int i = 1; i < 16; ++i) if (l[i] > bv) { bv = l[i]; bi = i; }
                cv[rnd] = bv; ce[rnd] = crow16(bi, hh);
#pragma unroll
                for (int i = 0; i < 16; ++i) if (i == bi) l[i] = -__builtin_inff(); }
#pragma unroll
            for (int j = 0; j < 4; ++j) { cv[4 + j] = __shfl_xor(cv[j], 32); ce[4 + j] = __shfl_xor(ce[j], 32); }
#pragma unroll
            for (int rnd = 0; rnd < 4; ++rnd) { float bv = cv[0]; int be = ce[0]; int bj = 0;
#pragma unroll
                for (int j = 1; j < 8; ++j) if (cv[j] > bv || (cv[j] == bv && ce[j] < be)) { bv = cv[j]; be = ce[j]; bj = j; }
                sv[rnd] = bv; se[rnd] = be;
#pragma unroll
                for (int j = 0; j < 8; ++j) if (j == bj) { cv[j] = -__builtin_inff(); ce[j] = 64; } }
            lp0 = __hip_atomic_fetch_add(lcnt + (hh ? se[2] : se[0]), 1u, __ATOMIC_RELAXED, __HIP_MEMORY_SCOPE_WORKGROUP);
            lp1 = __hip_atomic_fetch_add(lcnt + (hh ? se[3] : se[1]), 1u, __ATOMIC_RELAXED, __HIP_MEMORY_SCOPE_WORKGROUP);
        }
        __syncthreads();
        if (F.tid < 32) lbase[F.tid] = __hip_atomic_fetch_add(cnt + F.tid, lcnt[F.tid], __ATOMIC_RELAXED, __HIP_MEMORY_SCOPE_AGENT);
        __syncthreads();
        if (active) {
            const float e1 = __expf(sv[1] - sv[0]), e2 = __expf(sv[2] - sv[0]), e3 = __expf(sv[3] - sv[0]); const float inv = 1.f / (1.f + e1 + e2 + e3);
            const int ea = hh ? se[2] : se[0], eb = hh ? se[3] : se[1]; const float ga = (hh ? e2 : 1.f) * inv, gb = (hh ? e3 : e1) * inv;
            const size_t ia = (size_t)ea * 32768 + lbase[ea] + lp0, ib = (size_t)eb * 32768 + lbase[eb] + lp1;
            LIST[ia] = tok * 4 + 2 * hh; LIST[ib] = tok * 4 + 2 * hh + 1; TOPG[tok * 4 + 2 * hh] = ga; TOPG[tok * 4 + 2 * hh + 1] = gb;
            if (hh == 0) lrstd[F.wave * 32 + r] = rstd;
        }
        __syncthreads();
        {
            unsigned char* X8 = F.ws + WS_X8; const int t0 = base * 32;
#pragma unroll
            for (int q0 = 0; q0 < 16; q0 += 4) { v4u a[4][2];
#pragma unroll
                for (int q = 0; q < 4; ++q) { const int tt = t0 + F.wave * 16 + q0 + q; const GAS v4u* p = (const GAS v4u*)(XH + (size_t)(tt < T ? tt : 0) * D) + 2 * F.lane; a[q][0] = p[0]; a[q][1] = p[1]; }
#pragma unroll
                for (int q = 0; q < 4; ++q) { const int tl = F.wave * 16 + q0 + q, tt = t0 + tl; if (tt < T) { const float rs = lrstd[tl]; v4u o;
                    o.x = pg8::pk4_fp8(bflo(a[q][0].x) * rs, bfhi(a[q][0].x) * rs, bflo(a[q][0].y) * rs, bfhi(a[q][0].y) * rs); o.y = pg8::pk4_fp8(bflo(a[q][0].z) * rs, bfhi(a[q][0].z) * rs, bflo(a[q][0].w) * rs, bfhi(a[q][0].w) * rs);
                    o.z = pg8::pk4_fp8(bflo(a[q][1].x) * rs, bfhi(a[q][1].x) * rs, bflo(a[q][1].y) * rs, bfhi(a[q][1].y) * rs); o.w = pg8::pk4_fp8(bflo(a[q][1].z) * rs, bfhi(a[q][1].z) * rs, bflo(a[q][1].w) * rs, bfhi(a[q][1].w) * rs);
                    *((GAS v4u*)(X8 + (size_t)tt * D) + F.lane) = o; } } }
        }
        __syncthreads();
    }
}
__device__ __forceinline__ int build_moe_tables(Frame& F, int ntn, int mode) {
    LAS int* lt = (LAS int*)(F.lds + LTAB_OFF);
    if (F.wave == 0) {
        const int e = F.lane & 31; const int c = (int)__hip_atomic_load((unsigned*)(F.ctl + CW_CNT) + e, __ATOMIC_RELAXED, __HIP_MEMORY_SCOPE_AGENT);
        const int tl = (c + 255) >> 8; int inc = tl;
#pragma unroll
        for (int off = 1; off < 32; off <<= 1) { const int o = __shfl_up(inc, off, 32); if (e >= off) inc += o; }
        const int tot = __shfl(inc, 31, 32), t0 = inc - tl;
        if (F.lane < 32) { lt[LT_TS + e] = t0; lt[LT_CNT + e] = c; for (int i = 0; i < tl; ++i) lt[t0 + i] = e; }
        if (F.lane == 0) lt[LT_MISC + 64] = tot;
    }
    __syncthreads();
    int nt = lt[LT_MISC + 64]; nt = nt < 0 ? 0 : (nt > MAXTILES ? MAXTILES : nt); nt = __builtin_amdgcn_readfirstlane(nt);
    const int* LIST = (const int*)(F.ws + WS_LIST);
    const int nslot = mode == 1 ? MAXSLOT : (MAXTILES * 4 + 255) / 256;
    for (int q = F.tid; q < nslot * 256; q += NWAVES * 64) { const int i = q >> 8, rr = q & 255; const int Lu = i * F.G + F.vcu;
        int li = -1; float bias = 0.f;
        if (Lu < nt * ntn) { const int pm0 = Lu / ntn, pl = Lu - pm0 * ntn, pm = mode == 2 ? nt - 1 - pm0 : pm0, e = lt[pm], idx = (pm - lt[LT_TS + e]) * 256 + rr; if (idx < lt[LT_CNT + e]) li = LIST[(size_t)e * 32768 + idx];
            bias = mode == 1 ? F.b_gu[(size_t)e * 2048 + (rr >> 7) * 1024 + pl * 128 + (rr & 127)] : F.b_d[(size_t)e * 1024 + pl * 256 + rr]; }
        ((LAS float*)(F.lds + ROWTAB_OFF))[q] = bias;
        if (mode == 1) ((LAS unsigned short*)(F.lds + ROWTAB2_OFF))[q] = (unsigned short)(li < 0 ? 0 : (li >> 2));
        else ((LAS int*)(F.lds + ROWTAB_OFF) + nslot * 256)[q] = li; }
    __syncthreads();
    return nt;
}
__device__ __forceinline__ void combine_phase(Frame& F) {
    const unsigned char* YK = F.ws + WS_YK; const bf16* XH = (const bf16*)(F.ws + WS_XN); const float* TOPG = (const float*)(F.ws + WS_TOPG);
    for (int t = F.gw; t < T; t += F.ngw) {
        GAS f32x4* xr = (GAS f32x4*)(F.out + (size_t)t * D) + F.lane; f32x4 v[4]; unsigned y[4][4]; const f32x4 gt = *((const GAS f32x4*)TOPG + t + vzero()) * (1.0f / Y8_SCALE);
#pragma unroll
        for (int j = 0; j < 4; ++j) { const unsigned long long xh = __builtin_nontemporal_load((const GAS unsigned long long*)(XH + (size_t)t * D) + F.lane + 64 * j);
            v[j] = (f32x4){bflo((unsigned)xh), bfhi((unsigned)xh), bflo((unsigned)(xh >> 32)), bfhi((unsigned)(xh >> 32))};
#pragma unroll
            for (int k = 0; k < 4; ++k) y[j][k] = __builtin_nontemporal_load((const GAS unsigned*)(YK + ((size_t)t * 4 + k) * D) + F.lane + 64 * j); }
#pragma unroll
        for (int j = 0; j < 4; ++j) { f32x4 s4 = {0.f, 0.f, 0.f, 0.f};
#pragma unroll
            for (int k = 0; k < 4; ++k) { const f32x2n_ lo = __builtin_amdgcn_cvt_pk_f32_fp8((int)y[j][k], false), hi = __builtin_amdgcn_cvt_pk_f32_fp8((int)y[j][k], true); const float g = gt[k]; s4.x += g * lo.x; s4.y += g * lo.y; s4.z += g * hi.x; s4.w += g * hi.y; }
            v[j] = v[j] + s4;
            __builtin_nontemporal_store(v[j], xr + 64 * j); }
    }
}

constexpr int NPH = 9;
struct Args { const float* in[16]; float* out; unsigned char* ws; int ph_lo, ph_hi; };
__global__ void __launch_bounds__(NWAVES * 64, 2) fwd(Args args) {
    extern __shared__ __attribute__((aligned(16))) unsigned char lds[];
    Frame F;
    F.lds = (LAS unsigned char*)lds;
    F.MISC = (volatile LAS unsigned*)(F.lds + MISC_OFF);
    F.tid = threadIdx.x; F.lane = F.tid & 63; F.wave = __builtin_amdgcn_readfirstlane(F.tid >> 6);
    F.G = gridDim.x; { const int bx = blockIdx.x; F.vcu = (F.G % 8 == 0) ? (bx % 8) * (F.G / 8) + bx / 8 : bx; }
    F.gw = blockIdx.x * NWAVES + F.wave; F.ngw = F.G * NWAVES;
    F.ws = args.ws; F.ctl = (gu32*)(args.ws + WS_CTL); F.out = args.out;
    F.x = args.in[0]; F.norm1_g = args.in[1]; F.w_in = args.in[2]; F.sb_q_g = args.in[3]; F.sb_k_g = args.in[4]; F.sb_out_g = args.in[5]; F.hg_lb = args.in[6]; F.hg_out_g = args.in[7];
    F.w_out = args.in[8]; F.norm2_g = args.in[9]; F.w_router = args.in[10]; F.b_router = args.in[11]; F.w_gu = args.in[12]; F.b_gu = args.in[13]; F.w_d = args.in[14]; F.b_d = args.in[15];
    for (int u = F.tid; u < (LDS_BYTES - LDSCTL_OFF) / 4; u += NWAVES * 64) ((LAS unsigned*)(F.lds + LDSCTL_OFF))[u] = 0u;
    __syncthreads();
    XcdBarrier bar; bar.bar = (unsigned*)(F.ctl + CW_BAR); bar.x = 0; bar.st = nullptr;
    if (MK_ONE_LAUNCH) bar = xcd_barrier_post((unsigned*)(F.ctl + CW_BAR), F.MISC + 8);
    const int lo = args.ph_lo, hi = args.ph_hi;
#define IN(k) (lo <= (k) && (k) < hi && ((F.lane = lane_id()), (F.tid = F.wave * 64 + F.lane), true))
#define SEAM(k) do { if (IN(k) && IN((k) + 1)) xcd_barrier(bar); } while (0)

    if (IN(0)) { p0_prologue(F); } SEAM(0);
    if (IN(1)) {
        pg8::Gemm g{(const bf16*)(F.ws + WS_XN), (const bf16*)(F.ws + WS_WIN), T, NIN, D}; pg8::StaticOrder S; S.init(T, NIN, F.G, (int)blockIdx.x);
        pg8::EpiInproj E{(bf16*)(F.ws + WS_P), (bf16*)(F.ws + WS_PH), (bf16*)(F.ws + WS_QN), (bf16*)(F.ws + WS_KN), F.sb_q_g, F.sb_k_g, QSCALE, EPS};
        pg8::gemm_phase<pg8::EpiInproj, pg8::StaticOrder, PG8_ALIGN, PG8_SP2>(F.lds + RING_OFF, g, S, E, F.tid);
    } SEAM(1);
    if (IN(2)) { prep_phase(F); __syncthreads(); hgA_phase(F); } SEAM(2);
    if (IN(3)) { attn_phase(F); hgC_phase(F); } SEAM(3);
    if (IN(4)) {
        pg8::Gemm g{(const bf16*)(F.ws + WS_MIX), (const bf16*)(F.ws + WS_WOUT), T, D, D}; pg8::StaticOrder S; S.init(T, D, F.G, (int)blockIdx.x);
        pg8::EpiRes E{F.x, (bf16*)(F.ws + WS_XN), D};
        pg8::gemm_phase<pg8::EpiRes, pg8::StaticOrder, PG8_ALIGN, PG8_SP2>(F.lds + RING_OFF, g, S, E, F.tid);
    } SEAM(4);
    if (IN(5)) { router_phase(F); } SEAM(5);
    if (IN(6)) {
        const int nt = build_moe_tables(F, 8, 1); const LAS int* lt = (const LAS int*)(F.lds + LTAB_OFF);
        pg8::Gemm g{(const bf16*)(F.ws + WS_X8), (const bf16*)(F.ws + WS_WGU), MAXROWS, NE * 2048, D / 2};
        pg8::MoeOrder S{lt, (const LAS unsigned short*)(F.lds + ROWTAB2_OFF), 8, nt * 8, F.G, F.vcu, 1024u, 0};
        pg8::EpiAct<true> E{F.ws + WS_ACT, (const LAS float*)(F.lds + ROWTAB_OFF), A8_SCALE};
        pg8::gemm_phase<pg8::EpiAct<true>, pg8::MoeOrder, PG8_ALIGN, PG8_SP2, true, SC_W8, SC_ONE>(F.lds + RING_OFF, g, S, E, F.tid);
        {
            const int rem = (nt * 8) % F.G, nidle = F.G - rem; const bool few = rem == 0 || nidle < F.G / 4;
            __syncthreads();
            if (few) p0_items(F, P0_NITEMS - P0_NLATE, P0_NITEMS, F.vcu * NWAVES + F.wave, F.G * NWAVES);
            else if (F.vcu >= rem) p0_items(F, P0_NITEMS - P0_NLATE, P0_NITEMS, (F.vcu - rem) * NWAVES + F.wave, nidle * NWAVES);
        }
    } SEAM(6);
    if (IN(7)) {
        const int nt = build_moe_tables(F, 4, 2); const LAS int* lt = (const LAS int*)(F.lds + LTAB_OFF);
        pg8::Gemm g{(const bf16*)(F.ws + WS_ACT), (const bf16*)(F.ws + WS_WD), MAXROWS, NE * 1024, D / 2};
        pg8::MoeOrder S{lt, nullptr, 4, nt * 4, F.G, F.vcu, 1024u, nt};
        pg8::EpiDown E{F.ws + WS_YK, (const LAS int*)(F.lds + ROWTAB_OFF) + ((MAXTILES * 4 + 255) / 256) * 256, (const LAS float*)(F.lds + ROWTAB_OFF), Y8_SCALE};
        pg8::gemm_phase<pg8::EpiDown, pg8::MoeOrder, PG8_ALIGN, PG8_SP2, true, SC_W8Y, SC_A8>(F.lds + RING_OFF, g, S, E, F.tid);
    } SEAM(7);
    if (IN(8)) { combine_phase(F); }
#undef IN
#undef SEAM
}

extern "C" void kernel_launch(void* const* d_in, const int* in_sizes, int n_in, void* d_out, int out_size, void* d_ws, size_t ws_size, hipStream_t stream) {
    static int grid = 0;
    if (grid == 0) {
        if (n_in != 16 || in_sizes[0] != T * D || out_size != T * D || ws_size < WS_END) { fprintf(stderr, "kernel_launch: shape/workspace mismatch (n_in %d, ws %zu, need %zu); nothing launched\n", n_in, ws_size, (size_t)WS_END); grid = -1; return; }
        int dev = 0, cus = 0, per_cu = 0;
        if (hipGetDevice(&dev) != hipSuccess || hipDeviceGetAttribute(&cus, hipDeviceAttributeMultiprocessorCount, dev) != hipSuccess) { grid = -1; return; }
        if (hipFuncSetAttribute((const void*)fwd, hipFuncAttributeMaxDynamicSharedMemorySize, LDS_BYTES) != hipSuccess) { grid = -1; return; }
        if (hipOccupancyMaxActiveBlocksPerMultiprocessor(&per_cu, (const void*)fwd, NWAVES * 64, LDS_BYTES) != hipSuccess || per_cu < 1) { fprintf(stderr, "kernel_launch: occupancy query says %d\n", per_cu); }
        (void)hipGetLastError();
        if ((MAXTILES * 8 + cus - 1) / cus > MAXSLOT || cus < 1) { fprintf(stderr, "kernel_launch: %d CUs: the per-workgroup unit tables are sized for 256\n", cus); grid = -1; return; }
        grid = cus;
    }
    if (grid < 0) return;
    if (hipMemsetAsync((char*)d_ws + WS_CTL, 0, CTL_ZERO_BYTES, stream) != hipSuccess) return;
    Args a{};
    for (int i = 0; i < 16; ++i) a.in[i] = (const float*)d_in[i];
    a.out = (float*)d_out; a.ws = (unsigned char*)d_ws;
#if MK_ONE_LAUNCH
    a.ph_lo = 0; a.ph_hi = NPH;
    hipLaunchKernelGGL(fwd, dim3(grid), dim3(NWAVES * 64), LDS_BYTES, stream, a);
#else
    for (int p = 0; p < NPH; ++p) { a.ph_lo = p; a.ph_hi = p + 1; hipLaunchKernelGGL(fwd, dim3(grid), dim3(NWAVES * 64), LDS_BYTES, stream, a); }
#endif
}
```

```cpp
#include <hip/hip_runtime.h>
#include <cstdio>
#include <cstdint>
namespace pg8 {
#define PG8_LAS __attribute__((address_space(3)))
typedef unsigned short bf16_t;
typedef short bf16x8 __attribute__((ext_vector_type(8)));
typedef float f32x4 __attribute__((ext_vector_type(4)));
typedef unsigned u32x4 __attribute__((ext_vector_type(4)));
typedef int i32x4_t __attribute__((ext_vector_type(4)));
typedef int i32x8_t __attribute__((ext_vector_type(8)));
constexpr int BM = 256, BK = 64, HALF = 128, HTB = HALF * BK * 2  , STAGE_BYTES = 8 * HTB, NXCD = 8, WGM = 8;

__host__ __device__ __forceinline__ int lds_byte(int r, int c) { const int st = (r >> 4) * 2 + (c >> 5), rr = r & 15, cc = c & 31, ob = rr * 64 + cc * 2; return st * 1024 + (ob ^ (((ob >> 9) & 1) << 5)); }
__host__ __device__ __forceinline__ void stage_rc(int b, int& R, int& C) { const int st = b / 1024, sb = b % 1024, swz = sb ^ (((sb >> 9) & 1) << 5); R = (st >> 1) * 16 + swz / 64; C = (st & 1) * 32 + (swz % 64) / 2; }
__host__ __device__ __forceinline__ int perm32(int rho) { const int n = rho >> 4, i = rho & 15; return 8 * (i >> 2) + 4 * n + (i & 3); }

struct Unit { int pm, pn, slot; };
struct Gemm { const bf16_t* A; const bf16_t* Bt; int M, N, K; };

struct StaticOrder {
    int nM, nN, nwg, G, c;
    __host__ __device__ void init(int M, int N, int G_, int c_) { nM = M / BM; nN = N / BM; nwg = nM * nN; G = G_; c = c_; }
    __host__ __device__ bool next(int i, Unit& u) const {
        const long L = (long)i * G + c; if (L >= nwg) return false;
        int wgid = (int)L; { const int q = nwg / NXCD, r = nwg % NXCD, xcd = wgid % NXCD, off = wgid / NXCD; wgid = (xcd < r ? xcd * (q + 1) : r * (q + 1) + (xcd - r) * q) + off; }
        const int nig = WGM * nN, gid = wgid / nig, fm = gid * WGM, gsz = (nM - fm) < WGM ? (nM - fm) : WGM;
        u.pm = fm + ((wgid % nig) % gsz); u.pn = (wgid % nig) / gsz; u.slot = i; return true;
    }
    __device__ __forceinline__ void a_ready(const Unit&) const {}
    __device__ __forceinline__ void done(const Unit&) const {}
};

__device__ __forceinline__ unsigned cvt_pk_bf16(float lo, float hi) { unsigned r; asm volatile("v_cvt_pk_bf16_f32 %0, %1, %2" : "=v"(r) : "v"(lo), "v"(hi)); return r; }
typedef float f32x2 __attribute__((ext_vector_type(2)));
__device__ __forceinline__ f32x2 gelu_pk(f32x2 v) {
    const f32x2 av = __builtin_elementwise_abs(v), d = av * 0.2316418882f + 1.0f;
    f32x2 t; t.x = __builtin_amdgcn_rcpf(d.x); t.y = __builtin_amdgcn_rcpf(d.y);
    f32x2 q = t * 0.5307027145f + (-0.7265760135f); q = q * t + 0.7107068705f; q = q * t + (-0.142248368f); q = q * t + 0.127414796f; q = q * t;
    const f32x2 s = (v * v) * (-0.72134752044f);
    f32x2 e; e.x = __builtin_amdgcn_exp2f(s.x); e.y = __builtin_amdgcn_exp2f(s.y);
    const f32x2 m = v * (q * e), r = v - m;
    f32x2 o; o.x = v.x < 0.f ? m.x : r.x; o.y = v.y < 0.f ? m.y : r.y; return o;
}

template <int ACT  > struct EpiBf16 {
    static constexpr bool PERM = true, AFTER_DRAIN = false, HAS_INIT = false, INIT_LOADS = false; static_assert(ACT == 0 || ACT == 1, "EpiBf16: ACT is 0 (none) or 1 (gelu_pk)");
    bf16_t* O; int ldc; const float* bias; int split_cols; size_t split_stride; float scale0;
    __device__ __forceinline__ void operator()(const f32x4 (&acc)[2][2][4][2], const Unit& u, int wr, int wc, int fr, int fq) const {
        const int row0 = u.pm * BM + wr * 64 + fr; int colt = u.pn * BM; bf16_t* base = O;
        float sc = 1.f; if (split_cols) { const int t = colt / split_cols; base += (size_t)t * split_stride; colt -= t * split_cols; if (t == 0) sc = scale0; }
        const int col0 = colt + wc * 32 + 8 * fq, bcol0 = u.pn * BM + wc * 32 + 8 * fq;
        f32x4 bv[2][2];
#pragma unroll
        for (int bj = 0; bj < 2; ++bj)
#pragma unroll
            for (int n = 0; n < 2; ++n) bv[bj][n] = bias ? *(const f32x4*)(bias + bcol0 + bj * HALF + 4 * n) : (f32x4){0.f, 0.f, 0.f, 0.f};
#pragma unroll
        for (int ai = 0; ai < 2; ++ai)
#pragma unroll
            for (int m = 0; m < 4; ++m) { bf16_t* rowp = base + (size_t)(row0 + ai * HALF + m * 16) * ldc + col0;
#pragma unroll
                for (int bj = 0; bj < 2; ++bj) { f32x4 v0 = acc[ai][bj][m][0] + bv[bj][0], v1 = acc[ai][bj][m][1] + bv[bj][1];
                    if (ACT == 1) { f32x2 a = gelu_pk((f32x2){v0[0], v0[1]}), b = gelu_pk((f32x2){v0[2], v0[3]}), c = gelu_pk((f32x2){v1[0], v1[1]}), d = gelu_pk((f32x2){v1[2], v1[3]});
                        v0 = (f32x4){a.x, a.y, b.x, b.y}; v1 = (f32x4){c.x, c.y, d.x, d.y}; }
                    v0 = v0 * sc; v1 = v1 * sc; u32x4 w; w.x = cvt_pk_bf16(v0[0], v0[1]); w.y = cvt_pk_bf16(v0[2], v0[3]); w.z = cvt_pk_bf16(v1[0], v1[1]); w.w = cvt_pk_bf16(v1[2], v1[3]);
                    *(u32x4*)(rowp + bj * HALF) = w; } }
    }
};

__device__ __forceinline__ unsigned pk4_fp8(float a, float b, float c, float d) {
    a = fminf(fmaxf(a, -448.f), 448.f); b = fminf(fmaxf(b, -448.f), 448.f); c = fminf(fmaxf(c, -448.f), 448.f); d = fminf(fmaxf(d, -448.f), 448.f);
    int p = 0; p = __builtin_amdgcn_cvt_pk_fp8_f32(a, b, p, false); p = __builtin_amdgcn_cvt_pk_fp8_f32(c, d, p, true); return (unsigned)p;
}
struct EpiRes {
    static constexpr bool PERM = true, AFTER_DRAIN = false, HAS_INIT = true, INIT_LOADS = true;
    const float* __restrict__ X; bf16_t* __restrict__ XH; int ldc; float* PSSQ;
    __device__ __forceinline__ void init(f32x4 (&acc)[2][2][4][2], const Unit& u, int wr, int wc, int fr, int fq) const {
        const bool odd = fr & 1; const int rowE0 = u.pm * BM + wr * 64 + (fr & ~1), col0 = u.pn * BM + wc * 64 + 8 * fq + (odd ? 32 : 0);
        u32x4 l0[2][4], l1[2][4];
#pragma unroll
        for (int ai = 0; ai < 2; ++ai)
#pragma unroll
            for (int m = 0; m < 4; ++m) { const bf16_t* rp = XH + (size_t)(rowE0 + ai * HALF + m * 16) * ldc + col0;
                l0[ai][m] = __builtin_nontemporal_load((const u32x4*)rp); l1[ai][m] = __builtin_nontemporal_load((const u32x4*)(rp + ldc)); }
        __builtin_amdgcn_s_waitcnt(0x0F70);
#pragma unroll
        for (int ai = 0; ai < 2; ++ai)
#pragma unroll
            for (int m = 0; m < 4; ++m) { const u32x4 a = l0[ai][m], b = l1[ai][m];
                const unsigned s0 = odd ? a.x : b.x, s1 = odd ? a.y : b.y, s2 = odd ? a.z : b.z, s3 = odd ? a.w : b.w; u32x4 rcv;
                rcv.x = (unsigned)__builtin_amdgcn_mov_dpp((int)s0, 0xB1, 0xF, 0xF, true); rcv.y = (unsigned)__builtin_amdgcn_mov_dpp((int)s1, 0xB1, 0xF, 0xF, true);
                rcv.z = (unsigned)__builtin_amdgcn_mov_dpp((int)s2, 0xB1, 0xF, 0xF, true); rcv.w = (unsigned)__builtin_amdgcn_mov_dpp((int)s3, 0xB1, 0xF, 0xF, true);
                u32x4 q[2];
                q[0].x = odd ? rcv.x : a.x; q[0].y = odd ? rcv.y : a.y; q[0].z = odd ? rcv.z : a.z; q[0].w = odd ? rcv.w : a.w;
                q[1].x = odd ? b.x : rcv.x; q[1].y = odd ? b.y : rcv.y; q[1].z = odd ? b.z : rcv.z; q[1].w = odd ? b.w : rcv.w;
#pragma unroll
                for (int bj = 0; bj < 2; ++bj) {
                    acc[ai][bj][m][0] = (f32x4){__builtin_bit_cast(float, q[bj].x << 16), __builtin_bit_cast(float, q[bj].x & 0xffff0000u), __builtin_bit_cast(float, q[bj].y << 16), __builtin_bit_cast(float, q[bj].y & 0xffff0000u)};
                    acc[ai][bj][m][1] = (f32x4){__builtin_bit_cast(float, q[bj].z << 16), __builtin_bit_cast(float, q[bj].z & 0xffff0000u), __builtin_bit_cast(float, q[bj].w << 16), __builtin_bit_cast(float, q[bj].w & 0xffff0000u)}; } }
    }
    __device__ __forceinline__ void operator()(const f32x4 (&acc)[2][2][4][2], const Unit& u, int wr, int wc, int fr, int fq) const {
        const bool odd = fr & 1; const int rowE0 = u.pm * BM + wr * 64 + (fr & ~1), col0 = u.pn * BM + wc * 64 + 8 * fq + (odd ? 32 : 0);
#pragma unroll
        for (int ai = 0; ai < 2; ++ai)
#pragma unroll
            for (int m = 0; m < 4; ++m) { bf16_t* rp = XH + (size_t)(rowE0 + ai * HALF + m * 16) * ldc + col0; u32x4 w[2];
                { float ss = 0.f;
#pragma unroll
                    for (int bj = 0; bj < 2; ++bj)
#pragma unroll
                        for (int n = 0; n < 2; ++n) { const f32x4 a = acc[ai][bj][m][n]; ss += (a[0] * a[0] + a[1] * a[1]) + (a[2] * a[2] + a[3] * a[3]); }
                    ss += __shfl_xor(ss, 16); ss += __shfl_xor(ss, 32);
                    if (fq == 0) PSSQ[(size_t)(u.pn * 4 + wc) * 32768 + (u.pm * BM + wr * 64 + ai * HALF + m * 16 + fr)] = ss; }
#pragma unroll
                for (int bj = 0; bj < 2; ++bj) { const f32x4 v0 = acc[ai][bj][m][0], v1 = acc[ai][bj][m][1];
                    w[bj].x = cvt_pk_bf16(v0[0], v0[1]); w[bj].y = cvt_pk_bf16(v0[2], v0[3]); w[bj].z = cvt_pk_bf16(v1[0], v1[1]); w[bj].w = cvt_pk_bf16(v1[2], v1[3]); }
                const u32x4 snd = odd ? w[0] : w[1]; u32x4 rcv;
                rcv.x = (unsigned)__builtin_amdgcn_mov_dpp((int)snd.x, 0xB1, 0xF, 0xF, true); rcv.y = (unsigned)__builtin_amdgcn_mov_dpp((int)snd.y, 0xB1, 0xF, 0xF, true);
                rcv.z = (unsigned)__builtin_amdgcn_mov_dpp((int)snd.z, 0xB1, 0xF, 0xF, true); rcv.w = (unsigned)__builtin_amdgcn_mov_dpp((int)snd.w, 0xB1, 0xF, 0xF, true);
                *(u32x4*)rp = odd ? rcv : w[0];
                *(u32x4*)(rp + ldc) = odd ? w[1] : rcv; }
    }
};
struct EpiInproj {
    static constexpr bool PERM = true, AFTER_DRAIN = false, HAS_INIT = false, INIT_LOADS = false;
    bf16_t* PA; bf16_t* PH; bf16_t* QN; bf16_t* KN; const float* gq; const float* gk; float qscale, eps; const PG8_LAS float* rs1;
    __device__ __forceinline__ void operator()(const f32x4 (&acc)[2][2][4][2], const Unit& u, int wr, int wc, int fr, int fq) const {
        float rsr[2][4];
#pragma unroll
        for (int ai = 0; ai < 2; ++ai)
#pragma unroll
            for (int m = 0; m < 4; ++m) rsr[ai][m] = rs1[u.slot * 256 + ai * HALF + wr * 64 + m * 16 + fr];
        if (u.pn < 4) {
            const int arr = u.pn >> 1, hd = (u.pn & 1) * 4 + wc; const float* g = arr ? gk : gq; const float gs = arr ? 1.f : qscale; bf16_t* dst = arr ? KN : QN;
            f32x4 gv[2][2];
#pragma unroll
            for (int bj = 0; bj < 2; ++bj)
#pragma unroll
                for (int n = 0; n < 2; ++n) gv[bj][n] = *(const f32x4*)(g + 32 * bj + 8 * fq + 4 * n) * gs;
#pragma unroll
            for (int ai = 0; ai < 2; ++ai)
#pragma unroll
                for (int m = 0; m < 4; ++m) { float ss = 0.f;
#pragma unroll
                    for (int bj = 0; bj < 2; ++bj)
#pragma unroll
                        for (int n = 0; n < 2; ++n) { const f32x4 a = acc[ai][bj][m][n] * rsr[ai][m]; ss += (a[0] * a[0] + a[1] * a[1]) + (a[2] * a[2] + a[3] * a[3]); }
                    ss += __shfl_xor(ss, 16); ss += __shfl_xor(ss, 32);
                    const float rs = rsr[ai][m] / sqrtf(ss * (1.f / 64.f) + eps);
                    const int row = u.pm * BM + ai * HALF + wr * 64 + m * 16 + fr, b = row >> 11, s = row & 2047;
                    bf16_t* rp = dst + ((size_t)((b * 8 + hd) * 64 + (s >> 5))) * 2048 + (s & 31) * 8;
#pragma unroll
                    for (int bj = 0; bj < 2; ++bj) { const int c8 = 4 * bj + fq; const f32x4 v0 = acc[ai][bj][m][0] * rs * gv[bj][0], v1 = acc[ai][bj][m][1] * rs * gv[bj][1];
                        u32x4 w; w.x = cvt_pk_bf16(v0[0], v0[1]); w.y = cvt_pk_bf16(v0[2], v0[3]); w.z = cvt_pk_bf16(v1[0], v1[1]); w.w = cvt_pk_bf16(v1[2], v1[3]);
                        *(u32x4*)(rp + (c8 >> 1) * 512 + (c8 & 1) * 256) = w; } }
            return;
        }
        const int colw = u.pn * BM + wc * 64; bf16_t* base; int rowlen;
        if (colw < 1536) { const int arr = colw >> 9, hd = (colw & 511) >> 6; base = PA + ((size_t)(arr * 16) * 8 + hd) * 2048 * 64; rowlen = 64; }
        else { const int c2 = colw - 1536, arr = c2 >> 9, hd = (c2 & 511) >> 7, dd = c2 & 127; base = PH + ((size_t)(arr * 16) * 4 + hd) * 2048 * 128 + dd; rowlen = 128; }
        const size_t bstride = (size_t)(rowlen == 64 ? 8 : 4) * 2048 * rowlen;
        const bool odd = fr & 1; base += (odd ? 32 : 0) + 8 * fq;
#pragma unroll
        for (int ai = 0; ai < 2; ++ai)
#pragma unroll
            for (int m = 0; m < 4; ++m) { const int rowE = u.pm * BM + ai * HALF + wr * 64 + m * 16 + (fr & ~1), b = rowE >> 11, s = rowE & 2047;
                u32x4 w[2];
#pragma unroll
                for (int bj = 0; bj < 2; ++bj) { const f32x4 v0 = acc[ai][bj][m][0] * rsr[ai][m], v1 = acc[ai][bj][m][1] * rsr[ai][m];
                    w[bj].x = cvt_pk_bf16(v0[0], v0[1]); w[bj].y = cvt_pk_bf16(v0[2], v0[3]); w[bj].z = cvt_pk_bf16(v1[0], v1[1]); w[bj].w = cvt_pk_bf16(v1[2], v1[3]); }
                const u32x4 snd = odd ? w[0] : w[1]; u32x4 rcv;
                rcv.x = (unsigned)__builtin_amdgcn_mov_dpp((int)snd.x, 0xB1, 0xF, 0xF, true); rcv.y = (unsigned)__builtin_amdgcn_mov_dpp((int)snd.y, 0xB1, 0xF, 0xF, true);
                rcv.z = (unsigned)__builtin_amdgcn_mov_dpp((int)snd.z, 0xB1, 0xF, 0xF, true); rcv.w = (unsigned)__builtin_amdgcn_mov_dpp((int)snd.w, 0xB1, 0xF, 0xF, true);
                bf16_t* rp = base + (size_t)b * bstride + (size_t)s * rowlen;
                *(u32x4*)rp = odd ? rcv : w[0];
                *(u32x4*)(rp + rowlen) = odd ? w[1] : rcv; }
    }
};
struct MoeOrder {
    const PG8_LAS int* tile_e; const PG8_LAS unsigned short* rowtab; int ntn, nunits, G, c; unsigned rowbytes; int L0, rev, mt0;
    unsigned* ready; int early_mt;
    __device__ __forceinline__ bool next(int i, Unit& u) const {
        const int L = L0 + i * G + c; if (L >= nunits) return false;
        const int pm0 = L / ntn, pl = L - pm0 * ntn, pm = rev ? rev - 1 - (pm0 - mt0) : pm0; u.pm = pm; u.pn = tile_e[pm] * ntn + pl; u.slot = i; return true;
    }
    __device__ __forceinline__ unsigned rowoff(const Unit& u, int r) const { return (rowtab ? (unsigned)rowtab[u.slot * 256 + r] : (unsigned)(u.pm * 256 + r)) * rowbytes; }
    __device__ __forceinline__ void a_ready(const Unit&) const {}
    __device__ __forceinline__ void done(const Unit& u) const {
        if (ready != nullptr && u.pm < early_mt) { asm volatile("s_waitcnt vmcnt(0)" ::: "memory");
            if (__builtin_amdgcn_mbcnt_hi(~0u, __builtin_amdgcn_mbcnt_lo(~0u, 0u)) == 0u) (void)__hip_atomic_fetch_add(ready + 64 * u.pm, 1u, __ATOMIC_RELAXED, __HIP_MEMORY_SCOPE_AGENT); }
    }
};
template <bool OUT8> struct EpiAct {
    static constexpr bool PERM = true, AFTER_DRAIN = false, HAS_INIT = true, INIT_LOADS = false;
    unsigned char* ACT; const PG8_LAS float* biastab; float oscale; int early_mt;
    __device__ __forceinline__ void init(f32x4 (&acc)[2][2][4][2], const Unit& u, int wr, int wc, int fr, int fq) const {
#pragma unroll
        for (int n = 0; n < 2; ++n) { const f32x4 bg = *(const PG8_LAS f32x4*)(biastab + u.slot * 256 + wc * 32 + 8 * fq + 4 * n), bu = *(const PG8_LAS f32x4*)(biastab + u.slot * 256 + 128 + wc * 32 + 8 * fq + 4 * n);
#pragma unroll
            for (int ai = 0; ai < 2; ++ai)
#pragma unroll
                for (int m = 0; m < 4; ++m) { acc[ai][0][m][n] = bg; acc[ai][1][m][n] = bu; } }
    }
    __device__ __forceinline__ void operator()(const f32x4 (&acc)[2][2][4][2], const Unit& u, int wr, int wc, int fr, int fq) const {
        if (__builtin_amdgcn_readfirstlane(u.pm) < early_mt) body<true>(acc, u, wr, wc, fr, fq); else body<false>(acc, u, wr, wc, fr, fq);
    }
    template <bool WT> __device__ __forceinline__ void body(const f32x4 (&acc)[2][2][4][2], const Unit& u, int wr, int wc, int fr, int fq) const {
        const int pl = u.pn & 7; const int row0 = u.pm * BM + wr * 64 + fr, acol0 = pl * 128 + wc * 32 + 8 * fq;
#pragma unroll
        for (int ai = 0; ai < 2; ++ai)
#pragma unroll
            for (int m = 0; m < 4; ++m) { unsigned char* rowp = ACT + (size_t)(row0 + ai * HALF + m * 16) * 1024 + acol0; f32x4 a4[2];
#pragma unroll
                for (int n = 0; n < 2; ++n) { const f32x4 g4 = acc[ai][0][m][n], u4 = acc[ai][1][m][n]; f32x4 gl, ul, ex;
#pragma unroll
                    for (int j = 0; j < 4; ++j) { gl[j] = fminf(g4[j], 7.0f); ul[j] = __builtin_amdgcn_fmed3f(u4[j], -7.0f, 7.0f); }
                    const f32x4 t4 = gl * (-1.702f * 1.44269504089f);
#pragma unroll
                    for (int j = 0; j < 4; ++j) ex[j] = __builtin_amdgcn_exp2f(t4[j]);
                    const f32x4 d4 = ex + 1.0f; f32x4 s4;
#pragma unroll
                    for (int j = 0; j < 4; ++j) s4[j] = __builtin_amdgcn_rcpf(d4[j]);
                    a4[n] = (gl * s4) * (ul * oscale + oscale); }
                if constexpr (OUT8) { int p0 = 0, p1 = 0; p0 = __builtin_amdgcn_cvt_pk_fp8_f32(a4[0][0], a4[0][1], p0, false); p0 = __builtin_amdgcn_cvt_pk_fp8_f32(a4[0][2], a4[0][3], p0, true);
                    p1 = __builtin_amdgcn_cvt_pk_fp8_f32(a4[1][0], a4[1][1], p1, false); p1 = __builtin_amdgcn_cvt_pk_fp8_f32(a4[1][2], a4[1][3], p1, true);
                    const unsigned long long pv = (unsigned long long)(unsigned)p0 | ((unsigned long long)(unsigned)p1 << 32);
                    if constexpr (WT) __hip_atomic_store((unsigned long long*)rowp, pv, __ATOMIC_RELAXED, __HIP_MEMORY_SCOPE_AGENT); else *(unsigned long long*)rowp = pv; }
                else { u32x4 w; w.x = cvt_pk_bf16(a4[0][0], a4[0][1]); w.y = cvt_pk_bf16(a4[0][2], a4[0][3]); w.z = cvt_pk_bf16(a4[1][0], a4[1][1]); w.w = cvt_pk_bf16(a4[1][2], a4[1][3]); *(u32x4*)(rowp + (size_t)(row0 + ai * HALF + m * 16) * 1024 + acol0) = w; } }
    }
};
struct EpiDown {
    static constexpr bool PERM = true, AFTER_DRAIN = false, HAS_INIT = true, INIT_LOADS = false;
    unsigned char* YK; const PG8_LAS int* tktab; const PG8_LAS float* biastab; float oscale;
    __device__ __forceinline__ void init(f32x4 (&acc)[2][2][4][2], const Unit& u, int wr, int wc, int fr, int fq) const {
#pragma unroll
        for (int bj = 0; bj < 2; ++bj)
#pragma unroll
            for (int n = 0; n < 2; ++n) { const f32x4 bv = *(const PG8_LAS f32x4*)(biastab + u.slot * 256 + 64 * wc + 16 * fq + 8 * bj + 4 * n) * oscale;
#pragma unroll
                for (int ai = 0; ai < 2; ++ai)
#pragma unroll
                    for (int m = 0; m < 4; ++m) acc[ai][bj][m][n] = bv; }
    }
    __device__ __forceinline__ void operator()(const f32x4 (&acc)[2][2][4][2], const Unit& u, int wr, int wc, int fr, int fq) const {
        const int pl = u.pn & 3; const int col0 = pl * BM + 64 * wc + 16 * fq;
#pragma unroll
        for (int ai = 0; ai < 2; ++ai)
#pragma unroll
            for (int m = 0; m < 4; ++m) { const int tk = tktab[u.slot * 256 + ai * HALF + wr * 64 + m * 16 + fr];
                if (tk >= 0) { unsigned char* rowp = YK + (size_t)tk * 1024 + col0; int p[4];
#pragma unroll
                    for (int bj = 0; bj < 2; ++bj) { f32x4 v0 = acc[ai][bj][m][0], v1 = acc[ai][bj][m][1];
#pragma unroll
                        for (int j = 0; j < 4; ++j) { v0[j] = __builtin_amdgcn_fmed3f(v0[j], -448.f, 448.f); v1[j] = __builtin_amdgcn_fmed3f(v1[j], -448.f, 448.f); }
                        int p0 = 0, p1 = 0; p0 = __builtin_amdgcn_cvt_pk_fp8_f32(v0[0], v0[1], p0, false); p0 = __builtin_amdgcn_cvt_pk_fp8_f32(v0[2], v0[3], p0, true);
                        p1 = __builtin_amdgcn_cvt_pk_fp8_f32(v1[0], v1[1], p1, false); p1 = __builtin_amdgcn_cvt_pk_fp8_f32(v1[2], v1[3], p1, true);
                        p[2 * bj] = p0; p[2 * bj + 1] = p1; }
                    u32x4 w; w.x = (unsigned)p[0]; w.y = (unsigned)p[1]; w.z = (unsigned)p[2]; w.w = (unsigned)p[3];
                    *(u32x4*)rowp = w; } }
    }
};

template <class Epi, class Sched, bool ALIGN_EPI = false, bool SP2 = false, bool GATHER = false, int SCW = 0, int SCX = 0>
__device__ __forceinline__ void gemm_phase(PG8_LAS unsigned char* lds, const Gemm g, const Sched& S, const Epi& E, const int tid) {
    const int wid = __builtin_amdgcn_readfirstlane(tid >> 6), lane = tid & 63, wr = wid >> 2, wc = wid & 3, fr = lane & 15, fq = lane >> 4;
    const int K = g.K, nt = K / BK;
    unsigned voffA[2], voffB[2]; int RA[2]; unsigned CA2[2]; unsigned va0[2] = {0u, 0u}, va1[2] = {0u, 0u};
#pragma unroll
    for (int i = 0; i < 2; ++i) { int R, C; stage_rc(tid * 16 + i * 8192, R, C); const int Rb = Epi::PERM ? ((R & ~31) + perm32(R & 31)) : R;
        voffA[i] = (unsigned)(R * K + C) * 2u; voffB[i] = (unsigned)(Rb * K + C) * 2u; RA[i] = R; CA2[i] = (unsigned)C * 2u; }
    static_assert(!GATHER || SP2, "the gathered-A form exists for the SP2 loop only");
    const char* const gA0 = (const char*)g.A;
#define PG8_VA(u) do { int l_; asm volatile("v_mbcnt_lo_u32_b32 %0, -1, 0\n\tv_mbcnt_hi_u32_b32 %0, -1, %0" : "=v"(l_)); const int t_ = wid * 64 + l_;     \
        _Pragma("unroll") for (int _i = 0; _i < 2; ++_i) { int R_, C_; stage_rc(t_ * 16 + _i * 8192, R_, C_); va0[_i] = S.rowoff((u), R_) + (unsigned)C_ * 2u; va1[_i] = S.rowoff((u), HALF + R_) + (unsigned)C_ * 2u; } } while (0)
#define PG8_STA(bufoff, base_ng, base_g, h) do { if constexpr (GATHER) { if (h) PG8_STAGE(bufoff, base_g, va1); else PG8_STAGE(bufoff, base_g, va0); } else PG8_STAGE(bufoff, base_ng, voffA); } while (0)
    const size_t kstep = (size_t)(BK * 2);
    const size_t hstep = (size_t)HALF * K * 2;
    const size_t tstep = 2 * hstep;
    const unsigned ldsw = (unsigned)wid * 1024u;
    const int aoff = lds_byte(wr * 64 + fr, fq * 8), boff = lds_byte(wc * 32 + fr, fq * 8);
#define PG8_SA(b, h) (((b) * 2 + (h)) * HTB)
#define PG8_SB(b, h) ((4 + (b) * 2 + (h)) * HTB)
#define PG8_STAGE(bufoff, gbase, voff) do { _Pragma("unroll") for (int _i = 0; _i < 2; ++_i) \
        __builtin_amdgcn_global_load_lds((const unsigned*)((const char*)(gbase) + (voff)[_i]), (PG8_LAS unsigned*)(lds + (bufoff) + ldsw + _i * 8192), 16, 0, 0); } while (0)
#define PG8_LDA(dst, b, h) do { if constexpr (SCW != 0) { _Pragma("unroll") for (int m = 0; m < 4; ++m) dst##8[m] = PG8_CAT8(*(const PG8_LAS bf16x8*)(lds + PG8_SA(b, h) + aoff + m * 2048), *(const PG8_LAS bf16x8*)(lds + PG8_SA(b, h) + aoff + m * 2048 + 1024)); } \
        else { _Pragma("unroll") for (int m = 0; m < 4; ++m) _Pragma("unroll") for (int k = 0; k < 2; ++k) dst[m][k] = *(const PG8_LAS bf16x8*)(lds + PG8_SA(b, h) + aoff + m * 2048 + k * 1024); } } while (0)
#define PG8_LDB(dst, b, h) do { if constexpr (SCW != 0) { _Pragma("unroll") for (int n = 0; n < 2; ++n) dst##8[n] = PG8_CAT8(*(const PG8_LAS bf16x8*)(lds + PG8_SB(b, h) + boff + n * 2048), *(const PG8_LAS bf16x8*)(lds + PG8_SB(b, h) + boff + n * 2048 + 1024)); } \
        else { _Pragma("unroll") for (int n = 0; n < 2; ++n) _Pragma("unroll") for (int k = 0; k < 2; ++k) dst[n][k] = *(const PG8_LAS bf16x8*)(lds + PG8_SB(b, h) + boff + n * 2048 + k * 1024); } } while (0)
#define PG8_CAT8(lo, hi) __builtin_shufflevector(__builtin_bit_cast(i32x4_t, (lo)), __builtin_bit_cast(i32x4_t, (hi)), 0, 1, 2, 3, 4, 5, 6, 7)
#define PG8_MMA(ai, bj, At, Bt) do { __builtin_amdgcn_s_setprio(1); _Pragma("unroll") for (int m = 0; m < 4; ++m) _Pragma("unroll") for (int n = 0; n < 2; ++n) { \
        if constexpr (SCW != 0) acc[ai][bj][m][n] = __builtin_amdgcn_mfma_scale_f32_16x16x128_f8f6f4(Bt##8[n], At##8[m], acc[ai][bj][m][n], 0, 0, 0, SCW, 0, SCX); \
        else { _Pragma("unroll") for (int k = 0; k < 2; ++k) acc[ai][bj][m][n] = __builtin_amdgcn_mfma_f32_16x16x32_bf16(Bt[n][k], At[m][k], acc[ai][bj][m][n], 0, 0, 0); } } __builtin_amdgcn_s_setprio(0); } while (0)
#define PG8_WAIT_V(n) asm volatile("s_waitcnt vmcnt(" #n ")" ::: "memory")
#define PG8_WAIT_L(n) asm volatile("s_waitcnt lgkmcnt(" #n ")" ::: "memory")
#define PG8_BAR __builtin_amdgcn_s_barrier()
#define PG8_SCHED __builtin_amdgcn_sched_barrier(0)
    Unit cur, nxt; int ui = 0;
    if (!S.next(0, cur)) return;
    f32x4 acc[2][2][4][2];
    if constexpr (Epi::HAS_INIT) { E.init(acc, cur, wr, wc, fr, fq); if constexpr (Epi::INIT_LOADS) __builtin_amdgcn_s_waitcnt(0x0F70); }
    else {
#pragma unroll
    for (int a = 0; a < 2; ++a)
#pragma unroll
        for (int b = 0; b < 2; ++b)
#pragma unroll
            for (int m = 0; m < 4; ++m)
#pragma unroll
                for (int n = 0; n < 2; ++n) acc[a][b][m][n] = (f32x4){0.f, 0.f, 0.f, 0.f};
    }
    bf16x8 At[4][2], B0[2][2], B1[2][2]; i32x8_t At8[4], B08[2], B18[2];
    const char* cA = (const char*)g.A + (size_t)cur.pm * tstep; const char* cB = (const char*)g.Bt + (size_t)cur.pn * tstep;
    S.a_ready(cur);
    if constexpr (SP2) {
        if constexpr (GATHER) PG8_VA(cur);
        PG8_STAGE(PG8_SB(0, 0), cB, voffB); PG8_STAGE(PG8_SB(0, 1), cB + hstep, voffB); PG8_STA(PG8_SA(0, 0), cA, gA0, 0); PG8_STA(PG8_SA(0, 1), cA + hstep, gA0, 1);
        if (wr == 1) PG8_BAR;
        PG8_WAIT_V(2); PG8_BAR;
        PG8_STAGE(PG8_SB(1, 0), cB + kstep, voffB); PG8_STA(PG8_SA(1, 0), cA + kstep, gA0 + kstep, 0); PG8_STAGE(PG8_SB(1, 1), cB + hstep + kstep, voffB);
        PG8_WAIT_V(6); PG8_BAR;
    } else {
        PG8_STAGE(PG8_SB(0, 0), cB, voffB); PG8_STAGE(PG8_SA(0, 0), cA, voffA); PG8_STAGE(PG8_SB(0, 1), cB + hstep, voffB); PG8_STAGE(PG8_SA(0, 1), cA + hstep, voffA);
        if (wr == 1) PG8_BAR;
        PG8_WAIT_V(4); PG8_BAR;
        PG8_STAGE(PG8_SB(1, 0), cB + kstep, voffB); PG8_STAGE(PG8_SA(1, 0), cA + kstep, voffA); PG8_STAGE(PG8_SB(1, 1), cB + hstep + kstep, voffB);
        PG8_WAIT_V(6); PG8_BAR;
    }
    for (;;) {
        const bool has_next = S.next(ui + 1, nxt);
        const char* nA = has_next ? (const char*)g.A + (size_t)nxt.pm * tstep : cA; const char* nB = has_next ? (const char*)g.Bt + (size_t)nxt.pn * tstep : cB;
        _Pragma("nounroll") for (int t = 0; t < nt; t += 2) {
            const bool last = (t == nt - 2);
            const char* a1 = cA + (size_t)(t + 1) * kstep;
            const char* a2 = last ? nA : cA + (size_t)(t + 2) * kstep; const char* b2 = last ? nB : cB + (size_t)(t + 2) * kstep;
            const char* a3 = a2 + kstep; const char* b3 = b2 + kstep;
            if (last && has_next) S.a_ready(nxt);
            const char* const g1 = gA0 + (size_t)(t + 1) * kstep; const char* const g2 = last ? gA0 : gA0 + (size_t)(t + 2) * kstep; const char* const g3 = g2 + kstep;
            if constexpr (SP2) {
            PG8_LDB(B0, 0, 0); PG8_LDB(B1, 0, 1); PG8_SCHED; PG8_LDA(At, 0, 0); PG8_STA(PG8_SA(1, 1), a1 + hstep, g1, 1);
            PG8_WAIT_V(8); PG8_WAIT_L(0); PG8_BAR; PG8_MMA(0, 0, At, B0); PG8_MMA(0, 1, At, B1); PG8_BAR; PG8_SCHED;
            if constexpr (GATHER) { if (last && has_next) PG8_VA(nxt); }
            PG8_LDA(At, 0, 1); PG8_STAGE(PG8_SB(0, 0), b2, voffB); PG8_STAGE(PG8_SB(0, 1), b2 + hstep, voffB); PG8_STA(PG8_SA(0, 0), a2, g2, 0);
            PG8_WAIT_V(8); PG8_WAIT_L(0); PG8_BAR; PG8_MMA(1, 0, At, B0); PG8_MMA(1, 1, At, B1); PG8_BAR; PG8_SCHED;
            PG8_LDB(B0, 1, 0); PG8_LDB(B1, 1, 1); PG8_SCHED; PG8_LDA(At, 1, 0); PG8_STA(PG8_SA(0, 1), a2 + hstep, g2, 1);
            PG8_WAIT_V(8); PG8_WAIT_L(0); PG8_BAR; PG8_MMA(0, 0, At, B0); PG8_MMA(0, 1, At, B1); PG8_BAR; PG8_SCHED;
            PG8_LDA(At, 1, 1); PG8_STAGE(PG8_SB(1, 0), b3, voffB); PG8_STAGE(PG8_SB(1, 1), b3 + hstep, voffB); PG8_STA(PG8_SA(1, 0), a3, g3, 0);
            PG8_WAIT_V(8); PG8_WAIT_L(0); PG8_BAR; PG8_MMA(1, 0, At, B0); PG8_MMA(1, 1, At, B1); PG8_BAR; PG8_SCHED;
            } else {
            PG8_LDB(B0, 0, 0); PG8_SCHED; PG8_LDA(At, 0, 0); PG8_STAGE(PG8_SA(1, 1), a1 + hstep, voffA);
            PG8_WAIT_L(8); PG8_BAR; PG8_WAIT_L(0); PG8_MMA(0, 0, At, B0); PG8_BAR; PG8_SCHED;
            PG8_LDB(B1, 0, 1); PG8_STAGE(PG8_SB(0, 0), b2, voffB);
            PG8_BAR; PG8_WAIT_L(0); PG8_MMA(0, 1, At, B1); PG8_BAR;
            PG8_LDA(At, 0, 1); PG8_STAGE(PG8_SA(0, 0), a2, voffA);
            PG8_BAR; PG8_WAIT_L(0); PG8_MMA(1, 0, At, B0); PG8_BAR; PG8_SCHED;
            PG8_STAGE(PG8_SB(0, 1), b2 + hstep, voffB);
            PG8_WAIT_V(6); PG8_BAR; PG8_MMA(1, 1, At, B1); PG8_BAR;
            PG8_LDB(B0, 1, 0); PG8_SCHED; PG8_LDA(At, 1, 0); PG8_STAGE(PG8_SA(0, 1), a2 + hstep, voffA);
            PG8_WAIT_L(8); PG8_BAR; PG8_WAIT_L(0); PG8_MMA(0, 0, At, B0); PG8_BAR; PG8_SCHED;
            PG8_LDB(B1, 1, 1); PG8_STAGE(PG8_SB(1, 0), b3, voffB);
            PG8_BAR; PG8_WAIT_L(0); PG8_MMA(0, 1, At, B1); PG8_BAR;
            PG8_LDA(At, 1, 1); PG8_STAGE(PG8_SA(1, 0), a3, voffA);
            PG8_BAR; PG8_WAIT_L(0); PG8_MMA(1, 0, At, B0); PG8_BAR; PG8_SCHED;
            PG8_STAGE(PG8_SB(1, 1), b3 + hstep, voffB);
            PG8_WAIT_V(6); PG8_BAR; PG8_MMA(1, 1, At, B1); PG8_BAR;
            }
        }
        if constexpr (ALIGN_EPI) { if (wr == 0) PG8_BAR; }
        if constexpr (!Epi::AFTER_DRAIN) { int fr_ = fr, fq_ = fq; asm volatile("" : "+v"(fr_), "+v"(fq_));
            E(acc, cur, wr, wc, fr_, fq_); S.done(cur); }
        if (!has_next) break;
        if constexpr (Epi::HAS_INIT) { int fr_ = fr, fq_ = fq; asm volatile("" : "+v"(fr_), "+v"(fq_)); E.init(acc, nxt, wr, wc, fr_, fq_); if constexpr (Epi::INIT_LOADS) __builtin_amdgcn_s_waitcnt(0x0F70); }
        else {
#pragma unroll
        for (int a = 0; a < 2; ++a)
#pragma unroll
            for (int b = 0; b < 2; ++b)
#pragma unroll
                for (int m = 0; m < 4; ++m)
#pragma unroll
                    for (int n = 0; n < 2; ++n) acc[a][b][m][n] = (f32x4){0.f, 0.f, 0.f, 0.f};
        }
        cur = nxt; cA = nA; cB = nB; ++ui;
        if constexpr (ALIGN_EPI) { if (wr == 1) PG8_BAR; }
    }
    PG8_WAIT_V(0);
    if constexpr (!ALIGN_EPI) { if (wr == 0) PG8_BAR; }
    PG8_BAR;
    if constexpr (Epi::AFTER_DRAIN) { E.fused(acc, cur, wr, wc, fr, fq, lds, wid, lane); S.done(cur); }
#undef PG8_SA
#undef PG8_CAT8
#undef PG8_VA
#undef PG8_STA
#undef PG8_SB
#undef PG8_STAGE
#undef PG8_LDA
#undef PG8_LDB
#undef PG8_MMA
#undef PG8_WAIT_V
#undef PG8_WAIT_L
#undef PG8_BAR
#undef PG8_SCHED
}
}

#ifndef PG8_SP2
#define PG8_SP2 true
#endif
#ifndef PG8_ALIGN
#define PG8_ALIGN true
#endif
#define GAS __attribute__((address_space(1)))
#define LAS __attribute__((address_space(3)))
typedef unsigned short bf16;
typedef unsigned v4u __attribute__((ext_vector_type(4)));
typedef float f32x4 __attribute__((ext_vector_type(4)));
typedef short bf16x8 __attribute__((ext_vector_type(8)));
typedef GAS unsigned gu32;
typedef GAS unsigned long long gu64;
#define RLX_AGENT __ATOMIC_RELAXED, __HIP_MEMORY_SCOPE_AGENT
#define LDS_WAIT() asm volatile("s_waitcnt lgkmcnt(0)" ::: "memory")
#define VM_WAIT() asm volatile("s_waitcnt vmcnt(0)" ::: "memory")
__device__ __forceinline__ unsigned long long rt() { return __builtin_amdgcn_s_memrealtime(); }
__device__ __forceinline__ unsigned f2bf(float f) { unsigned u = __builtin_bit_cast(unsigned, f); return (u + 0x7fffu + ((u >> 16) & 1u)) >> 16; }
__device__ __forceinline__ unsigned pk2(float lo, float hi) { return f2bf(lo) | (f2bf(hi) << 16); }

#define XB_TMO      128
#define XB_XCNT(j)  (256  + 64 * (j))
#define XB_XSUB(j)  (1280 + 64 * (j))
#define XB_XGEN(j)  (2304 + 64 * (j))
#define XB_TOP      3328
#define XB_TOPGEN   3392
#define XCD_BAR_WORDS 3456
#define XB_SPIN_CAP (1u << 18)

__device__ __forceinline__ unsigned xb_ld(unsigned* p)              { return __hip_atomic_load(p, __ATOMIC_RELAXED, __HIP_MEMORY_SCOPE_AGENT); }
__device__ __forceinline__ unsigned xb_add(unsigned* p, unsigned v) { return __hip_atomic_fetch_add(p, v, __ATOMIC_RELAXED, __HIP_MEMORY_SCOPE_AGENT); }
__device__ __forceinline__ unsigned xb_xcc_id() { return (unsigned)__builtin_amdgcn_s_getreg((3 << 11) | 20) & 0xFu; }
#define XB_SPIN(cond, bar) do { unsigned _sp = 0; while (cond) { __builtin_amdgcn_s_sleep(1); \
    if ((++_sp & 255u) == 0u) { if (xb_ld(&(bar)[XB_TMO])) break; if (_sp > XB_SPIN_CAP) { atomicAdd(&(bar)[XB_TMO], 1u); break; } } } } while (0)

struct XcdBarrier {
    unsigned* bar; unsigned x;
    volatile LAS unsigned* st;
};

__device__ __forceinline__ XcdBarrier xcd_barrier_post(unsigned* bar, volatile LAS unsigned* st) {
    XcdBarrier b; b.bar = bar; b.x = xb_xcc_id(); b.st = st;
    if (threadIdx.x == 0) (void)xb_add(&bar[XB_XCNT(b.x)], 1u);
    return b;
}
__device__ __forceinline__ void xcd_barrier_complete(unsigned* bar, unsigned x, unsigned& nloc, unsigned& nx) {
    const unsigned G = gridDim.x * gridDim.y * gridDim.z;
    unsigned sum, cnt, mine, sp = 0u;
    for (;;) {
        sum = 0u; cnt = 0u; mine = 0u;
#pragma unroll
        for (unsigned j = 0; j < 16; ++j) { const unsigned c = xb_ld(&bar[XB_XCNT(j)]); sum += c; cnt += (c > 0u) ? 1u : 0u; mine = (j == x) ? c : mine; }
        if (sum == G) break;
        __builtin_amdgcn_s_sleep(1);
        if ((++sp & 255u) == 0u) { if (xb_ld(&bar[XB_TMO])) break; if (sp > XB_SPIN_CAP) { atomicAdd(&bar[XB_TMO], 1u); break; } }
    }
    nloc = mine > 0u ? mine : 1u; nx = cnt > 0u ? cnt : 1u;
}

__device__ __forceinline__ void xcd_barrier(const XcdBarrier& b) {
    asm volatile("s_waitcnt vmcnt(0)" ::: "memory");
    __syncthreads();
    if (threadIdx.x == 0) {
        unsigned* bar = b.bar;
        __builtin_amdgcn_s_waitcnt(0);
        unsigned nloc = b.st[0], nx = b.st[1];
        if (nloc == 0u) { xcd_barrier_complete(bar, b.x, nloc, nx); b.st[0] = nloc; b.st[1] = nx; }
        const unsigned old = xb_add(&bar[XB_XSUB(b.x)], 1u);
        const unsigned gen = old / nloc;
        if (old + 1u == (gen + 1u) * nloc) {
            __builtin_amdgcn_fence(__ATOMIC_RELEASE, "agent");
            asm volatile("s_waitcnt vmcnt(0)" ::: "memory");
            const unsigned og = xb_add(&bar[XB_TOP], 1u);
            const unsigned tg = og / nx;
            if (og + 1u == (tg + 1u) * nx) xb_add(&bar[XB_TOPGEN], 1u);
            else XB_SPIN(xb_ld(&bar[XB_TOPGEN]) == tg, bar);
            __builtin_amdgcn_fence(__ATOMIC_ACQUIRE, "agent");
            xb_add(&bar[XB_XGEN(b.x)], 1u);
            asm volatile("s_waitcnt vmcnt(0)" ::: "memory");
        } else {
            XB_SPIN(xb_ld(&bar[XB_XGEN(b.x)]) == gen, bar);
            __builtin_amdgcn_fence(__ATOMIC_ACQUIRE, "agent");
            asm volatile("s_waitcnt vmcnt(0)" ::: "memory");
        }
    }
    __syncthreads();
}

constexpr int NWAVES = 8;
#ifndef MK_ONE_LAUNCH
#define MK_ONE_LAUNCH 1
#endif

constexpr int BATCH = 16, SEQ = 2048, D = 1024, T = BATCH * SEQ;
constexpr int NIN = 3584;
constexpr int OFF_SQ = 0, OFF_SK = 512, OFF_SV = 1024, OFF_HQ = 1536, OFF_HF = 2048, OFF_HI = 2560, OFF_HG = 3072;
constexpr int NE = 32, TOPK = 4, NASSIGN = T * TOPK;
constexpr int MAXTILES = NASSIGN / 256 + NE;
constexpr int MAXROWS = MAXTILES * 256;
constexpr float EPS = 1e-6f;

constexpr size_t MiB = 1u << 20;
constexpr size_t WS_CTL = 0, CTL_ZERO_BYTES = 1 * MiB;
constexpr size_t WS_WIN = 2 * MiB;
constexpr size_t WS_WOUT = 10 * MiB;
constexpr size_t WS_RT = 12 * MiB;
constexpr size_t WS_PSSQ = 13 * MiB;
constexpr size_t WS_RS1 = 15 * MiB;
constexpr size_t WS_WGU = 16 * MiB;
constexpr size_t WS_WD = 144 * MiB;
constexpr size_t WS_XN = 208 * MiB;
constexpr size_t WS_P = 272 * MiB;
constexpr size_t WS_PH = WS_P + 96 * MiB;
constexpr size_t WS_MIX = 496 * MiB;
constexpr size_t WS_ACT = 272 * MiB;
constexpr size_t WS_YK = 560 * MiB;
constexpr size_t WS_QN = 624 * MiB;
constexpr size_t WS_KN = 656 * MiB;
constexpr size_t WS_VT = 688 * MiB;
constexpr size_t WS_KVS = 720 * MiB;
constexpr size_t WS_DEC = 784 * MiB;
constexpr size_t WS_SSEG = 786 * MiB;
constexpr size_t WS_DSEG = 802 * MiB;
constexpr size_t WS_LIST = 816 * MiB;
constexpr size_t WS_TOPG = 825 * MiB;
constexpr size_t WS_X8 = 560 * MiB;
constexpr size_t WS_END = 832 * MiB;
static_assert(WS_ACT + (size_t)MAXROWS * 2048 <= WS_YK && WS_YK + (size_t)T * 4 * 2048 <= WS_LIST && WS_MIX + (size_t)T * 2048 <= WS_YK, "d_ws map");
constexpr int CW_TMO = 0, CW_CODE = 1;
constexpr int CW_CNT = 64;
constexpr int CW_BAR = 4096;

constexpr int RING_OFF = 0, RING_BYTES = 131072;
constexpr int RT_ROW = 2064, RT_WL = 32 * RT_ROW, RT_END = 64 * RT_ROW;
constexpr int LDSCTL_OFF = 133120, MISC_OFF = LDSCTL_OFF + 320;
constexpr int LTAB_OFF = LDSCTL_OFF + 512;
constexpr int LT_TS = MAXTILES, LT_CNT = MAXTILES + 32, LT_MISC = MAXTILES + 64, LT_WORDS = MAXTILES + 192;
constexpr int ROWTAB_OFF = LTAB_OFF + LT_WORDS * 4;
constexpr int MAXSLOT = 17;
constexpr int ROWTAB2_OFF = ROWTAB_OFF + MAXSLOT * 1024;
constexpr int LDS_BYTES = ROWTAB2_OFF + MAXSLOT * 512;
static_assert(RT_END <= LDSCTL_OFF && MISC_OFF + 128 <= LTAB_OFF && LDS_BYTES <= 160 * 1024 && (MAXTILES * 8 + 255) / 256 <= MAXSLOT && 2 * ((MAXTILES * 4 + 255) / 256) * 1024 <= MAXSLOT * 1536 && ROWTAB_OFF % 16 == 0, "LDS map");

struct Frame {
    LAS unsigned char* lds;
    volatile LAS unsigned* MISC;
    gu32* ctl;
    int tid, lane, wave, gw, ngw;
    int vcu, G;
    const float *x, *norm1_g, *w_in, *sb_q_g, *sb_k_g, *sb_out_g, *hg_lb, *hg_out_g, *w_out, *norm2_g, *w_router, *b_router, *w_gu, *b_gu, *w_d, *b_d;
    float* out;
    unsigned char* ws;
};
__device__ __forceinline__ float bf2f(unsigned short b) { return __builtin_bit_cast(float, (unsigned)b << 16); }
__device__ __forceinline__ float bflo(unsigned w) { return __builtin_bit_cast(float, w << 16); }
__device__ __forceinline__ float bfhi(unsigned w) { return __builtin_bit_cast(float, w & 0xffff0000u); }
typedef __bf16 bf16x2n_ __attribute__((ext_vector_type(2)));
typedef float f32x2n_ __attribute__((ext_vector_type(2)));
__device__ __forceinline__ unsigned pkbf(float a, float b) { const bf16x2n_ v = __builtin_convertvector((f32x2n_){a, b}, bf16x2n_); return __builtin_bit_cast(unsigned, v); }
__device__ __forceinline__ int lane_id() { int l; asm volatile("v_mbcnt_lo_u32_b32 %0, -1, 0\n\tv_mbcnt_hi_u32_b32 %0, -1, %0" : "=v"(l)); return l; }
__device__ __forceinline__ int vzero() { int z; asm volatile("v_mov_b32 %0, 0" : "=v"(z)); return z; }
__device__ __forceinline__ float wave_sum(float v) {
#pragma unroll
    for (int o = 1; o < 64; o <<= 1) v += __shfl_xor(v, o);
    return v;
}

constexpr float W8_SCALE = 256.f, A8_SCALE = 4.f, Y8_SCALE = 32.f; static_assert(Y8_SCALE == 32.f, "SC_W8Y below is 2^-8 * 32");
constexpr int SC_ONE = 0x7f7f7f7f, SC_W8 = 0x77777777, SC_A8 = 0x7d7d7d7d, SC_W8Y = 0x7c7c7c7c;
struct P0Item { const float* W; bf16* WT; const float* rowscale; int N, k0, n0, drow0, fp8, perm; const float* gshuf; };
__device__ __forceinline__ void p0_load(const P0Item& it, f32x4 (&v)[16], float& g, int lane) {
    const int kr = lane >> 4, nc = 4 * (lane & 15);
    g = (it.gshuf ? it.gshuf + it.k0 : it.W)[lane];
#pragma unroll
    for (int i = 0; i < 16; ++i) v[i] = __builtin_nontemporal_load((const f32x4*)(it.W + (size_t)(it.k0 + 4 * i + kr) * it.N + it.n0 + nc));
}
__device__ __forceinline__ void p0_store(const P0Item& it, const f32x4 (&v)[16], float g, LAS unsigned char* scr, int lane) {
    const int kr = lane >> 4, nc = 4 * (lane & 15);
    const float gs = it.gshuf ? g : 1.f;
#pragma unroll
    for (int i = 0; i < 16; ++i) { const float sc = (it.rowscale ? it.rowscale[it.k0 + 4 * i + kr] : 1.f) * __shfl(gs, 4 * i + kr);
        *(LAS unsigned long long*)(scr + (4 * i + kr) * 136 + 2 * nc) = (unsigned long long)pkbf(v[i].x * sc, v[i].y * sc) | ((unsigned long long)pkbf(v[i].z * sc, v[i].w * sc) << 32); }
    LDS_WAIT(); asm volatile("" ::: "memory");
    const LAS unsigned short* s16 = (const LAS unsigned short*)scr;
    if (it.fp8) { const int p = lane & 3, nr = lane >> 2;
#pragma unroll
        for (int c = 0; c < 4; ++c) { const int n = 16 * c + nr; unsigned val[16];
#pragma unroll
            for (int kk = 0; kk < 16; ++kk) val[kk] = s16[(16 * p + kk) * 68 + n];
            v4u w4;
            w4.x = pg8::pk4_fp8(bflo(val[0]) * W8_SCALE, bflo(val[1]) * W8_SCALE, bflo(val[2]) * W8_SCALE, bflo(val[3]) * W8_SCALE);
            w4.y = pg8::pk4_fp8(bflo(val[4]) * W8_SCALE, bflo(val[5]) * W8_SCALE, bflo(val[6]) * W8_SCALE, bflo(val[7]) * W8_SCALE);
            w4.z = pg8::pk4_fp8(bflo(val[8]) * W8_SCALE, bflo(val[9]) * W8_SCALE, bflo(val[10]) * W8_SCALE, bflo(val[11]) * W8_SCALE);
            w4.w = pg8::pk4_fp8(bflo(val[12]) * W8_SCALE, bflo(val[13]) * W8_SCALE, bflo(val[14]) * W8_SCALE, bflo(val[15]) * W8_SCALE);
            *(GAS v4u*)((unsigned char*)it.WT + (size_t)(it.drow0 + (it.perm == 2 ? 128 * ((n >> 3) & 1) + 8 * (n >> 4) + (n & 7) : n)) * D + it.k0 + 16 * p) = w4; }
    } else { const int p = lane & 7, nr = lane >> 3;
#pragma unroll
        for (int c = 0; c < 8; ++c) { const int n = 8 * c + nr; unsigned val[8];
#pragma unroll
            for (int kk = 0; kk < 8; ++kk) val[kk] = s16[(8 * p + kk) * 68 + n];
            v4u w4; w4.x = val[0] | (val[1] << 16); w4.y = val[2] | (val[3] << 16); w4.z = val[4] | (val[5] << 16); w4.w = val[6] | (val[7] << 16);
            *(GAS v4u*)(it.WT + (size_t)(it.drow0 + (it.perm ? 128 * (n >> 5) + (n & 31) : n)) * D + it.k0 + 8 * p) = w4; } }
    LDS_WAIT(); asm volatile("" ::: "memory");
}
__device__ __forceinline__ void rms_rows2_to_bf16(const float* xa, const float* xb, bool hasb, float* rsa, float* rsb, bf16* oa, bf16* ob, int lane) {
    const GAS f32x4* pa = (const GAS f32x4*)xa + lane; const GAS f32x4* pb = (const GAS f32x4*)(hasb ? xb : xa) + lane;
    f32x4 va[4], vb[4]; float sa = 0.f, sb = 0.f;
#pragma unroll
    for (int j = 0; j < 4; ++j) { va[j] = __builtin_nontemporal_load(pa + 64 * j); vb[j] = __builtin_nontemporal_load(pb + 64 * j); }
#pragma unroll
    for (int j = 0; j < 4; ++j) { sa += (va[j].x * va[j].x + va[j].y * va[j].y) + (va[j].z * va[j].z + va[j].w * va[j].w); sb += (vb[j].x * vb[j].x + vb[j].y * vb[j].y) + (vb[j].z * vb[j].z + vb[j].w * vb[j].w); }
    const float ra = 1.f / sqrtf(wave_sum(sa) * (1.f / D) + EPS), rb = 1.f / sqrtf(wave_sum(sb) * (1.f / D) + EPS);
    GAS unsigned long long* o8a = (GAS unsigned long long*)oa + lane; GAS unsigned long long* o8b = (GAS unsigned long long*)ob + lane;
#pragma unroll
    for (int j = 0; j < 4; ++j) o8a[64 * j] = (unsigned long long)pkbf(va[j].x, va[j].y) | ((unsigned long long)pkbf(va[j].z, va[j].w) << 32);
    if (lane == 0) *rsa = ra;
    if (hasb) {
#pragma unroll
        for (int j = 0; j < 4; ++j) o8b[64 * j] = (unsigned long long)pkbf(vb[j].x, vb[j].y) | ((unsigned long long)pkbf(vb[j].z, vb[j].w) << 32);
        if (lane == 0) *rsb = rb; }
}
__device__ __forceinline__ P0Item p0_item(Frame& F, int r) {
    constexpr int I_IN = 16 * (NIN / 64), I_OUT = 16 * 16, I_GU = NE * 16 * 32;
    P0Item it;
    if (r < I_IN) { const int nb = NIN / 64, Qp = r >> 1, kb = 2 * (Qp / nb) + (r & 1), nn = Qp % nb; const int pq = 1; it = P0Item{F.w_in, (bf16*)(F.ws + WS_WIN), nullptr, NIN, 64 * kb, 64 * nn, pq ? 256 * (nn >> 2) + 32 * (nn & 3) : 64 * nn, 0, pq, F.norm1_g}; return it; } r -= I_IN;
    if (r < I_OUT) { const int Qp = r >> 1, kb = 2 * (Qp / 16) + (r & 1), nn = Qp % 16; it = P0Item{F.w_out, (bf16*)(F.ws + WS_WOUT), nullptr, D, 64 * kb, 64 * nn, 256 * (nn >> 2) + 32 * (nn & 3), 0, 1}; return it; }     r -= I_OUT;
    if (r < I_GU) { const int e = r / 512, q = r % 512, Qp = q >> 1, kb = 2 * (Qp / 32) + (q & 1), nn = Qp % 32;
        const int isup = nn >> 4, a = (nn & 15) * 64;
        it = P0Item{F.w_gu + (size_t)e * D * 2048, (bf16*)(F.ws + WS_WGU + (size_t)e * 2048 * D), F.norm2_g, 2048, 64 * kb, 64 * nn, 256 * (a >> 7) + 128 * isup + (a & 127), 1, 0}; return it; } r -= I_GU;
    { const int e = r / 256, q = r % 256, Qp = q >> 1, kb = 2 * (Qp / 16) + (q & 1), nn = Qp % 16;
        it = P0Item{F.w_d + (size_t)e * D * D, (bf16*)(F.ws + WS_WD + (size_t)e * D * D), nullptr, D, 64 * kb, 64 * nn, 256 * (nn >> 2) + 32 * (nn & 3), 1, 2}; return it; }
}
constexpr int P0_NITEMS = 16 * (NIN / 64) + 16 * 16 + NE * 16 * 32 + NE * 16 * 16;
constexpr int P0_NLATE = 1024;
__device__ __forceinline__ void p0_items(Frame& F, int lo, int hi, int w, int nw) {
    LAS unsigned char* scr = F.lds + RING_OFF + F.wave * 16384;
    f32x4 va[16], vb[16]; float ga, gb; int it = lo + w;
    if (it < hi) { P0Item A = p0_item(F, it); p0_load(A, va, ga, F.lane);
        for (;;) {
            const int itb = it + nw; const bool hb = itb < hi; const P0Item B = p0_item(F, hb ? itb : it); p0_load(B, vb, gb, F.lane); __builtin_amdgcn_sched_barrier(0);
            p0_store(A, va, ga, scr, F.lane);
            if (!hb) break;
            it = itb + nw; const bool ha = it < hi; A = p0_item(F, ha ? it : itb); p0_load(A, va, ga, F.lane); __builtin_amdgcn_sched_barrier(0);
            p0_store(B, vb, gb, scr, F.lane);
            if (!ha) break;
        }
    }
}
__device__ __forceinline__ void p0_prologue(Frame& F) {
    p0_items(F, 0, P0_NITEMS - P0_NLATE, F.gw, F.ngw);
    for (int q = blockIdx.x * (NWAVES * 64) + F.tid; q < 4096; q += F.G * NWAVES * 64) {
        const int e = q & 31, k0 = (q >> 5) * 8; unsigned hi[8], lo[8];
#pragma unroll
        for (int j = 0; j < 8; ++j) { const float w = F.w_router[(k0 + j) * 32 + e] * F.norm2_g[k0 + j]; hi[j] = pkbf(w, 0.f) & 0xffffu; lo[j] = pkbf(w - bflo(hi[j]), 0.f) & 0xffffu; }
        const v4u h4 = {hi[0] | (hi[1] << 16), hi[2] | (hi[3] << 16), hi[4] | (hi[5] << 16), hi[6] | (hi[7] << 16)}, l4 = {lo[0] | (lo[1] << 16), lo[2] | (lo[3] << 16), lo[4] | (lo[5] << 16), lo[6] | (lo[7] << 16)};
        *(GAS v4u*)(F.ws + WS_RT + e * RT_ROW + 2 * k0) = h4; *(GAS v4u*)(F.ws + WS_RT + RT_WL + e * RT_ROW + 2 * k0) = l4; }
    for (int m = F.gw; m < T; m += 2 * F.ngw) rms_rows2_to_bf16(F.x + (size_t)m * D, F.x + (size_t)(m + F.ngw) * D, m + F.ngw < T, (float*)(F.ws + WS_RS1) + m, (float*)(F.ws + WS_RS1) + (m + F.ngw < T ? m + F.ngw : m), (bf16*)(F.ws + WS_XN) + (size_t)m * D, (bf16*)(F.ws + WS_XN) + (size_t)(m + F.ngw) * D, F.lane);
}

__device__ __forceinline__ v4u pair_trade(const v4u& P0, const v4u& P1, bool odd, v4u& storeA, v4u& storeB) {
    const v4u snd = odd ? P0 : P1; v4u rcv;
    rcv.x = (unsigned)__builtin_amdgcn_mov_dpp((int)snd.x, 0xB1, 0xF, 0xF, true); rcv.y = (unsigned)__builtin_amdgcn_mov_dpp((int)snd.y, 0xB1, 0xF, 0xF, true);
    rcv.z = (unsigned)__builtin_amdgcn_mov_dpp((int)snd.z, 0xB1, 0xF, 0xF, true); rcv.w = (unsigned)__builtin_amdgcn_mov_dpp((int)snd.w, 0xB1, 0xF, 0xF, true);
    storeA = odd ? rcv : P0; storeB = odd ? P1 : rcv; return rcv;
}
typedef float f32x16 __attribute__((ext_vector_type(16)));
typedef __bf16 bf16x2n __attribute__((ext_vector_type(2)));
typedef float f32x2n __attribute__((ext_vector_type(2)));
#define MFMA32(a, b, c) __builtin_amdgcn_mfma_f32_32x32x16_bf16((a), (b), (c), 0, 0, 0)
__device__ __forceinline__ bf16x8 pack8(float a0, float a1, float a2, float a3, float a4, float a5, float a6, float a7) { const v4u p = {pkbf(a0, a1), pkbf(a2, a3), pkbf(a4, a5), pkbf(a6, a7)}; return __builtin_bit_cast(bf16x8, p); }
constexpr float QSCALE = 0.125f * 1.44269504089f;
__device__ __forceinline__ void prep_phase(Frame& F) {
    LAS unsigned* tl = (LAS unsigned*)(F.lds + RING_OFF + F.wave * 16384);
    const bf16* P = (const bf16*)(F.ws + WS_P); bf16* Qn = (bf16*)(F.ws + WS_QN); bf16* Kn = (bf16*)(F.ws + WS_KN); bf16* VT = (bf16*)(F.ws + WS_VT);
    const int tr = F.lane >> 3, c8 = F.lane & 7;
    for (int it = F.gw; it < 4096; it += F.ngw) {
        const int bh = it & 127, blk = it >> 7, b = bh >> 3, h = bh & 7;
        const bf16* base = P + ((size_t)b * 8 + h) * SEQ * 64 + (size_t)(blk * 64 + tr) * 64 + 8 * c8;
        v4u rv[8];
#pragma unroll
        for (int i = 0; i < 8; ++i) { const bf16* row = base + (size_t)(8 * i) * 64; rv[i] = *(const GAS v4u*)(row + (size_t)2 * 16 * 8 * SEQ * 64); }
        {
#pragma unroll
            for (int i = 0; i < 8; ++i) { LAS unsigned* q = tl + (8 * i + tr) * 33 + 4 * c8; q[0] = rv[i].x; q[1] = rv[i].y; q[2] = rv[i].z; q[3] = rv[i].w; }
            LDS_WAIT(); asm volatile("" ::: "memory");
            const LAS unsigned short* t16 = (const LAS unsigned short*)tl; const int dr = tr;
#define KAP(pos) (((pos) & ~12) | (((pos) & 4) << 1) | (((pos) & 8) >> 1))
            bf16* const obase = VT + ((size_t)bh * 64 + blk * 2 + (c8 >> 2)) * 2048 + ((c8 >> 1) & 1) * 512 + (c8 & 1) * 256;
#pragma unroll
            for (int j = 0; j < 8; ++j) { unsigned val[8];
#pragma unroll
                for (int p = 0; p < 8; ++p) { const int pos = 8 * c8 + p; val[p] = t16[KAP(pos) * 66 + 8 * j + dr]; }
                v4u w4; w4.x = val[0] | (val[1] << 16); w4.y = val[2] | (val[3] << 16); w4.z = val[4] | (val[5] << 16); w4.w = val[6] | (val[7] << 16);
                *(GAS v4u*)(obase + (j >> 2) * 1024 + ((8 * j + dr) & 31) * 8) = w4; }
#undef KAP
            LDS_WAIT(); asm volatile("" ::: "memory");
        }
    }
}

__device__ __forceinline__ int crow16(int i, int hh) { return (i & 3) + 8 * (i >> 2) + 4 * hh; }
__device__ __forceinline__ void attn_item(Frame& F, int bh, int qb, float thr, const bf16x8 (&Lt)[2]) {
    const int r = F.lane & 31, hh = F.lane >> 5, b = bh >> 3, h = bh & 7, q0 = qb * 32;
    const bf16* Qn = (const bf16*)(F.ws + WS_QN); const bf16* Kn = (const bf16*)(F.ws + WS_KN); const bf16* VT = (const bf16*)(F.ws + WS_VT);
    bf16x8 qf[4];
#pragma unroll
    for (int s = 0; s < 4; ++s) qf[s] = *(const GAS bf16x8*)(Qn + ((size_t)bh * 64 + qb) * 2048 + s * 512 + F.lane * 8);
    f32x4 gout[2][4];
#pragma unroll
    for (int db = 0; db < 2; ++db)
#pragma unroll
        for (int gq = 0; gq < 4; ++gq) gout[db][gq] = *(const f32x4*)(F.sb_out_g + h * 64 + 32 * db + 8 * gq + 4 * hh);
    f32x16 O0, O1;
#pragma unroll
    for (int i = 0; i < 16; ++i) { O0[i] = 0.f; O1[i] = 0.f; }
    float carry = 0.f;
    const bf16* kbase = Kn + (size_t)bh * 64 * 2048 + F.lane * 8;
    const bf16* vbase = (const bf16*)(F.ws + WS_P) + (size_t)2 * 16 * 8 * SEQ * 64 + (size_t)bh * SEQ * 64 + F.lane * 8;
    LAS unsigned char* const vtile = F.lds + RING_OFF + F.wave * 16384;
    const unsigned vwr = (unsigned)(size_t)(vtile) + (unsigned)((F.lane >> 3) * 192 + (F.lane & 7) * 16);
    const unsigned vrd = (unsigned)(size_t)(vtile) + (unsigned)((4 * hh + ((F.lane & 15) >> 2)) * 192 + (16 * ((F.lane >> 4) & 1) + 4 * (F.lane & 3)) * 2);
typedef short s16x4 __attribute__((ext_vector_type(4)));
#define VCAT(lo_, hi_) __builtin_shufflevector((lo_), (hi_), 0, 1, 2, 3, 4, 5, 6, 7)
#define ATT_LOAD(KF, VF, kb_) do { _Pragma("unroll") for (int s_ = 0; s_ < 4; ++s_) KF[s_] = *(const GAS bf16x8*)(kbase + (size_t)(kb_) * 2048 + 512 * s_); \
        _Pragma("unroll") for (int j_ = 0; j_ < 4; ++j_) VF[j_] = *(const GAS v4u*)(vbase + (size_t)(kb_) * 2048 + 512 * j_); } while (0)
#define ATT_BLOCK(KF, VF, kb_) do { const bool diag = ((kb_) == qb); \
        _Pragma("unroll") for (int j_ = 0; j_ < 4; ++j_) *(LAS v4u*)(size_t)(vwr + 1536u * j_) = VF[j_]; \
        f32x16 z; _Pragma("unroll") for (int i = 0; i < 16; ++i) z[i] = 0.f; \
        _Pragma("unroll") for (int s_ = 0; s_ < 4; ++s_) z = MFMA32(KF[s_], qf[s_], z); \
        float sp[16]; \
        _Pragma("unroll") for (int i = 0; i < 16; ++i) { const float zz = z[i]; float v = fmaxf(zz, 0.f) + __builtin_amdgcn_logf(1.f + __builtin_amdgcn_exp2f(-fabsf(zz))); if (diag && !(crow16(i, hh) < r)) v = 0.f; sp[i] = v; } \
        const bf16x8 sb0 = pack8(sp[0], sp[1], sp[2], sp[3], sp[4], sp[5], sp[6], sp[7]), sb1 = pack8(sp[8], sp[9], sp[10], sp[11], sp[12], sp[13], sp[14], sp[15]); \
        f32x16 Cc; _Pragma("unroll") for (int i = 0; i < 16; ++i) Cc[i] = carry; \
        Cc = MFMA32(Lt[0], sb0, Cc); Cc = MFMA32(Lt[1], sb1, Cc); \
        s16x4 t0_, t1_, t2_, t3_, t4_, t5_, t6_, t7_;     \
        asm volatile("ds_read_b64_tr_b16 %0, %8 offset:0\n\tds_read_b64_tr_b16 %1, %8 offset:1536\n\tds_read_b64_tr_b16 %2, %8 offset:3072\n\tds_read_b64_tr_b16 %3, %8 offset:4608\n\t" \
                     "ds_read_b64_tr_b16 %4, %8 offset:64\n\tds_read_b64_tr_b16 %5, %8 offset:1600\n\tds_read_b64_tr_b16 %6, %8 offset:3136\n\tds_read_b64_tr_b16 %7, %8 offset:4672" \
                     : "=&v"(t0_), "=&v"(t1_), "=&v"(t2_), "=&v"(t3_), "=&v"(t4_), "=&v"(t5_), "=&v"(t6_), "=&v"(t7_) : "v"(vrd) : "memory"); \
        float w[16]; \
        _Pragma("unroll") for (int i = 0; i < 16; ++i) { float v = __builtin_amdgcn_exp2f(z[i] - Cc[i]); if (diag && !(crow16(i, hh) < r)) v = 0.f; w[i] = v; } \
        const bf16x8 wb0 = pack8(w[0], w[1], w[2], w[3], w[4], w[5], w[6], w[7]), wb1 = pack8(w[8], w[9], w[10], w[11], w[12], w[13], w[14], w[15]); \
        asm volatile("s_waitcnt lgkmcnt(0)" : "+v"(t0_), "+v"(t1_), "+v"(t2_), "+v"(t3_), "+v"(t4_), "+v"(t5_), "+v"(t6_), "+v"(t7_) :: "memory");     \
        O0 = MFMA32(VCAT(t0_, t1_), wb0, O0); O0 = MFMA32(VCAT(t2_, t3_), wb1, O0); O1 = MFMA32(VCAT(t4_, t5_), wb0, O1); O1 = MFMA32(VCAT(t6_, t7_), wb1, O1); \
        carry = __shfl(Cc[0], r); } while (0)
    bf16x8 kfA[4], kfB[4]; v4u vfA[4], vfB[4];
    ATT_LOAD(kfA, vfA, qb);
    for (int kb = qb; kb >= 0; kb -= 2) {
        ATT_LOAD(kfB, vfB, kb > 0 ? kb - 1 : 0); __builtin_amdgcn_sched_barrier(0);
        ATT_BLOCK(kfA, vfA, kb);
        if (kb == 0 || __all(carry > thr)) break;
        ATT_LOAD(kfA, vfA, kb > 1 ? kb - 2 : 0); __builtin_amdgcn_sched_barrier(0);
        ATT_BLOCK(kfB, vfB, kb - 1);
        if (__all(carry > thr)) break;
    }
#undef ATT_LOAD
#undef ATT_BLOCK
#undef VCAT
    float ss = 0.f;
#pragma unroll
    for (int i = 0; i < 16; ++i) ss += O0[i] * O0[i] + O1[i] * O1[i];
    ss += __shfl_xor(ss, 32);
    const float rs = 1.f / sqrtf(ss * (1.f / 64.f) + EPS);
    bf16* orow = (bf16*)(F.ws + WS_MIX) + ((size_t)b * SEQ + q0 + r) * D + h * 64;
#pragma unroll
    for (int db = 0; db < 2; ++db) { unsigned op[4][2];
#pragma unroll
        for (int gq = 0; gq < 4; ++gq) { const f32x4 gg = gout[db][gq];
            const float a0 = (db ? O1[4 * gq + 0] : O0[4 * gq + 0]) * rs * gg.x, a1 = (db ? O1[4 * gq + 1] : O0[4 * gq + 1]) * rs * gg.y, a2 = (db ? O1[4 * gq + 2] : O0[4 * gq + 2]) * rs * gg.z, a3 = (db ? O1[4 * gq + 3] : O0[4 * gq + 3]) * rs * gg.w;
            op[gq][0] = pkbf(a0, a1); op[gq][1] = pkbf(a2, a3); }
        v4u P[2];
#pragma unroll
        for (int gp = 0; gp < 2; ++gp) { const auto s0 = __builtin_amdgcn_permlane32_swap(op[2 * gp][0], op[2 * gp + 1][0], false, false), s1 = __builtin_amdgcn_permlane32_swap(op[2 * gp][1], op[2 * gp + 1][1], false, false);
            P[gp] = (v4u){s0[0], s1[0], s0[1], s1[1]}; }
        const bool odd = r & 1; v4u sA, sB; pair_trade(P[0], P[1], odd, sA, sB);
        bf16* oE = orow - (odd ? D : 0) + 32 * db + 8 * (hh + 2 * (odd ? 1 : 0));
        *(GAS v4u*)oE = sA; *(GAS v4u*)(oE + D) = sB; }
}
__device__ __forceinline__ void attn_phase(Frame& F) {
    const int r = F.lane & 31, hh = F.lane >> 5;
    float mq = fabsf(F.sb_q_g[F.lane]), mk = fabsf(F.sb_k_g[F.lane]);
#pragma unroll
    for (int o = 1; o < 64; o <<= 1) { mq = fmaxf(mq, __shfl_xor(mq, o)); mk = fmaxf(mk, __shfl_xor(mk, o)); }
    const float thr = 64.f * QSCALE * mq * mk * 1.02f + 151.f;
    bf16x8 Lt[2];
#pragma unroll
    for (int ks = 0; ks < 2; ++ks) { float e[8];
#pragma unroll
        for (int jj = 0; jj < 8; ++jj) e[jj] = (16 * ks + 8 * (jj >> 2) + 4 * hh + (jj & 3) >= r) ? 1.f : 0.f;
        Lt[ks] = pack8(e[0], e[1], e[2], e[3], e[4], e[5], e[6], e[7]); }
    for (int it = F.gw; it < 2048; it += F.ngw) { const int bh = it & 127, j = it >> 7;
        attn_item(F, bh, 63 - j, thr, Lt); attn_item(F, bh, j, thr, Lt); attn_item(F, bh, 47 - j, thr, Lt); attn_item(F, bh, 16 + j, thr, Lt); }
}

constexpr int HG_PART = 0, HG_SSQ = 2048, HG_QE = 4096, HG_KE = HG_QE + 64 * 272, HG_VT = HG_KE + 64 * 272, HG_KST = HG_VT + 128 * 144, HG_ST = HG_KST + 128 * 144, HG_END = HG_ST + 128 * 272;
static_assert(HG_END <= RING_BYTES, "HGRN2 LDS map");
__device__ __forceinline__ float hg_lbound(Frame& F, int h, int d) { const int c = h * 128 + d; return 1.f / (1.f + __expf(F.hg_lb[512 + c] - F.hg_lb[c])); }
__device__ __forceinline__ void hg_gates(Frame& F, const unsigned short (&ffr)[16], float lb, int d, int tq, float (&bb)[16], float (&kk)[16], float& total) {
    float run = 1.f;
#pragma unroll
    for (int i = 0; i < 16; ++i) { const float ff = bf2f(ffr[i]); const float sg = __builtin_amdgcn_rcpf(1.f + __expf(-ff));
        const float f = lb + (1.f - lb) * sg; kk[i] = (1.f - lb) * (1.f - sg); run *= f; bb[i] = run; }
    LAS float* part = (LAS float*)(F.lds + RING_OFF + HG_PART);
    part[tq * 128 + d] = run;
    __syncthreads();
    const float p0 = part[d], p1 = part[128 + d], p2 = part[256 + d], p3 = part[384 + d];
    const float off = (tq > 0 ? p0 : 1.f) * (tq > 1 ? p1 : 1.f) * (tq > 2 ? p2 : 1.f);
    total = (p0 * p1) * (p2 * p3);
#pragma unroll
    for (int i = 0; i < 16; ++i) bb[i] *= off;
}
#define HG_HV() const bf16* const PHp = (const bf16*)(F.ws + WS_PH); \
    const __amdgpu_buffer_rsrc_t rsrcP = __builtin_amdgcn_make_buffer_rsrc((void*)PHp, 0, (int)((size_t)4 * T * 512 * 2), 0x00020000)
#define HG_SOFF(item_, arr_) ((unsigned)((((arr_) * 16 + (((item_) >> 5) >> 2)) * 4 + (((item_) >> 5) & 3)) * SEQ + ((item_) & 31) * 64) * 256u)
#define HG_ARR(col_) ((col_) == OFF_HQ ? 0 : (col_) == OFF_HF ? 1 : (col_) == OFF_HI ? 2 : 3)
#define HG_LOADT(dst2, item_, arr_) do { const unsigned so_ = (unsigned)__builtin_amdgcn_readfirstlane((int)HG_SOFF(item_, arr_)); _Pragma("unroll") for (int j_ = 0; j_ < 2; ++j_) \
        (dst2)[j_] = __builtin_bit_cast(v4u, __builtin_amdgcn_raw_buffer_load_b128(rsrcP, (unsigned)F.tid * 16u + 8192u * j_, so_, 0)); } while (0)
#define HG_PUT(src2, raw_) do { _Pragma("unroll") for (int j_ = 0; j_ < 2; ++j_) *(LAS v4u*)((raw_) + ((F.tid >> 4) + 32 * j_) * 272 + (F.tid & 15) * 16) = (src2)[j_]; } while (0)
#define HG_COL(dst, raw_) do { _Pragma("unroll") for (int i_ = 0; i_ < 16; ++i_) dst[i_] = *(const LAS unsigned short*)((raw_) + (16 * tq + i_) * 272 + 2 * d); } while (0)
template <bool PERMUTE> __device__ __forceinline__ void st16(LAS unsigned char* dst, const float (&v)[16]) {
    v4u a, b2;
    if (!PERMUTE) { a.x = pkbf(v[0], v[1]); a.y = pkbf(v[2], v[3]); a.z = pkbf(v[4], v[5]); a.w = pkbf(v[6], v[7]); b2.x = pkbf(v[8], v[9]); b2.y = pkbf(v[10], v[11]); b2.z = pkbf(v[12], v[13]); b2.w = pkbf(v[14], v[15]); }
    else { a.x = pkbf(v[0], v[1]); a.y = pkbf(v[2], v[3]); a.z = pkbf(v[8], v[9]); a.w = pkbf(v[10], v[11]); b2.x = pkbf(v[4], v[5]); b2.y = pkbf(v[6], v[7]); b2.z = pkbf(v[12], v[13]); b2.w = pkbf(v[14], v[15]); }
    *(LAS v4u*)dst = a; *(LAS v4u*)(dst + 16) = b2;
}
__device__ __forceinline__ void hgA_phase(Frame& F) {
    const int d = F.tid & 127, tq = F.tid >> 7, r = F.lane & 31, hh = F.lane >> 5;
    const bf16* P = (const bf16*)(F.ws + WS_P); bf16* KVS = (bf16*)(F.ws + WS_KVS); float* DEC = (float*)(F.ws + WS_DEC); float* SSEG = (float*)(F.ws + WS_SSEG); float* DSEG = (float*)(F.ws + WS_DSEG);
    LAS unsigned char* L = F.lds + RING_OFF; LAS float* decl = (LAS float*)(L + HG_SSQ);
    HG_HV();
    v4u rf[2], rv[2];
    LAS unsigned char* const RAWF = F.lds + ROWTAB_OFF; LAS unsigned char* const RAWV = L + HG_ST;
    for (int wg = blockIdx.x; wg < 256; wg += F.G) {
        const int bh = wg >> 2, seg = wg & 3, item0 = bh * 32 + seg * 8, h = bh & 3;
        HG_LOADT(rf, item0, 1); HG_LOADT(rv, item0, 2);
        const float lbv = hg_lbound(F, h, d); float totrun = 1.f;
        const int db = F.wave & 3, eb0 = 2 * (F.wave >> 2);
        f32x16 run0, run1;
#pragma unroll
        for (int i = 0; i < 16; ++i) { run0[i] = 0.f; run1[i] = 0.f; }
      for (int k = 0; k < 8; ++k) {
        const int item = item0 + k;
        HG_PUT(rf, RAWF); HG_PUT(rv, RAWV);
        __syncthreads();
        { const int nit = k < 7 ? item + 1 : item; HG_LOADT(rf, nit, 1); HG_LOADT(rv, nit, 2); __builtin_amdgcn_sched_barrier(0); }
        unsigned short ffr[16], vr[16]; HG_COL(ffr, RAWF); HG_COL(vr, RAWV);
        float bb[16], kk[16], total; hg_gates(F, ffr, lbv, d, tq, bb, kk, total);
        float ks[16], vv[16];
#pragma unroll
        for (int i = 0; i < 16; ++i) { ks[i] = kk[i] * (total * __builtin_amdgcn_rcpf(bb[i])); vv[i] = bf2f(vr[i]); }
        st16<false>(L + HG_KST + d * 144 + tq * 32, ks); st16<false>(L + HG_VT + d * 144 + tq * 32, vv);
        const float dc = total; totrun *= total;
        if (tq == 0) { DEC[(size_t)item * 128 + d] = dc; decl[d] = dc; }
        __syncthreads();
        f32x16 acc0, acc1;
#pragma unroll
        for (int i = 0; i < 16; ++i) { acc0[i] = 0.f; acc1[i] = 0.f; }
#pragma unroll
        for (int s = 0; s < 4; ++s) { const bf16x8 af = *(const LAS bf16x8*)(L + HG_KST + (db * 32 + r) * 144 + 32 * s + 16 * hh);
            const bf16x8 b0 = *(const LAS bf16x8*)(L + HG_VT + (eb0 * 32 + r) * 144 + 32 * s + 16 * hh), b1 = *(const LAS bf16x8*)(L + HG_VT + ((eb0 + 1) * 32 + r) * 144 + 32 * s + 16 * hh);
            acc0 = MFMA32(af, b0, acc0); acc1 = MFMA32(af, b1, acc1); }
#pragma unroll
        for (int g = 0; g < 4; ++g) { const f32x4 dl = *(const LAS f32x4*)(decl + db * 32 + 8 * g + 4 * hh);
#pragma unroll
            for (int ii = 0; ii < 4; ++ii) { run0[4 * g + ii] = dl[ii] * run0[4 * g + ii] + acc0[4 * g + ii]; run1[4 * g + ii] = dl[ii] * run1[4 * g + ii] + acc1[4 * g + ii]; } }
#pragma unroll
        for (int j = 0; j < 2; ++j) { const bool odd = r & 1; bf16* dst = KVS + ((size_t)item * 128 + (eb0 + j) * 32 + (r & ~1)) * 128 + db * 32 + 8 * (hh + 2 * (odd ? 1 : 0));
            v4u P[2];
#pragma unroll
            for (int gp = 0; gp < 2; ++gp) { unsigned pk[2][2];
#pragma unroll
                for (int q = 0; q < 2; ++q) { const int g = 2 * gp + q; const float a0 = j ? acc1[4 * g + 0] : acc0[4 * g + 0], a1 = j ? acc1[4 * g + 1] : acc0[4 * g + 1], a2 = j ? acc1[4 * g + 2] : acc0[4 * g + 2], a3 = j ? acc1[4 * g + 3] : acc0[4 * g + 3];
                    pk[q][0] = pkbf(a0, a1); pk[q][1] = pkbf(a2, a3); }
                const auto s0 = __builtin_amdgcn_permlane32_swap(pk[0][0], pk[1][0], false, false), s1 = __builtin_amdgcn_permlane32_swap(pk[0][1], pk[1][1], false, false);
                P[gp] = (v4u){s0[0], s1[0], s0[1], s1[1]}; }
            v4u sA, sB; pair_trade(P[0], P[1], odd, sA, sB);
            *(GAS v4u*)dst = sA; *(GAS v4u*)(dst + 128) = sB; }
        __syncthreads();
      }
#pragma unroll
        for (int j = 0; j < 2; ++j) { float* dst = SSEG + ((size_t)wg * 128 + (eb0 + j) * 32 + r) * 128 + db * 32 + 4 * hh;
#pragma unroll
            for (int g = 0; g < 4; ++g) *(GAS f32x4*)(dst + 8 * g) = j ? (f32x4){run1[4 * g + 0], run1[4 * g + 1], run1[4 * g + 2], run1[4 * g + 3]} : (f32x4){run0[4 * g + 0], run0[4 * g + 1], run0[4 * g + 2], run0[4 * g + 3]}; }
        if (tq == 0) DSEG[(size_t)wg * 128 + d] = totrun;
    }
}
constexpr int HG_DECS = HG_END;
static_assert(HG_DECS + 4096 + 64 * 272 <= LDSCTL_OFF && HG_KST + 64 * 272 <= HG_ST && 64 * 272 <= MAXSLOT * 1536, "HGRN2 LDS map (decays, raw tiles)");
__device__ __forceinline__ void hgC_phase(Frame& F) {
    const int d = F.tid & 127, tq = F.tid >> 7, r = F.lane & 31, hh = F.lane >> 5;
    const bf16* P = (const bf16*)(F.ws + WS_P); const bf16* KVS = (const bf16*)(F.ws + WS_KVS); bf16* MIX = (bf16*)(F.ws + WS_MIX); const float* DEC = (const float*)(F.ws + WS_DEC);
    HG_HV();
    LAS unsigned char* L = F.lds + RING_OFF; const LAS float* decs = (const LAS float*)(L + HG_DECS);
    const int srow = (F.tid >> 6) * 16 + ((F.tid & 63) >> 4), sd0 = 8 * (F.tid & 15);
    v4u rf[2], rq[2], rv[2], st[4];
    LAS unsigned char* const RAWF = L + HG_KST; LAS unsigned char* const RAWQ = F.lds + ROWTAB_OFF; LAS unsigned char* const RAWV = L + HG_DECS + 4096;
    const __amdgpu_buffer_rsrc_t rsrcG = __builtin_amdgcn_make_buffer_rsrc((void*)F.hg_out_g, 0, 512 * 4, 0x00020000), rsrcSS = __builtin_amdgcn_make_buffer_rsrc((void*)(F.ws + WS_SSEG), 0, 256 * 128 * 128 * 4, 0x00020000), rsrcDS = __builtin_amdgcn_make_buffer_rsrc((void*)(F.ws + WS_DSEG), 0, 256 * 128 * 4, 0x00020000);
    const __amdgpu_buffer_rsrc_t rsrcD = __builtin_amdgcn_make_buffer_rsrc((void*)DEC, 0, 64 * 32 * 128 * 4, 0x00020000), rsrcM = __builtin_amdgcn_make_buffer_rsrc((void*)MIX, 0, (int)((size_t)T * D * 2), 0x00020000);
    const __amdgpu_buffer_rsrc_t rsrcK = __builtin_amdgcn_make_buffer_rsrc((void*)KVS, 0, 64 * 32 * 128 * 128 * 2, 0x00020000); const unsigned kvo = (unsigned)((srow * 128 + sd0) * 2);
#define HG_LOADKV(dst_, item_) do { const unsigned so_ = (unsigned)__builtin_amdgcn_readfirstlane((int)((item_) * (128 * 128 * 2))); _Pragma("unroll") for (int j_ = 0; j_ < 4; ++j_) (dst_)[j_] = __builtin_bit_cast(v4u, __builtin_amdgcn_raw_buffer_load_b128(rsrcK, kvo + 1024u * j_, so_, 0)); } while (0)
#define HG_LOADST(item_) HG_LOADKV(st, item_)
#define HG_FOLD(kv_, c_) do { const f32x4 d0_ = *(const LAS f32x4*)(decs + (c_) * 128 + sd0), d1_ = *(const LAS f32x4*)(decs + (c_) * 128 + sd0 + 4); _Pragma("unroll") for (int j_ = 0; j_ < 4; ++j_) { const v4u k_ = (kv_)[j_]; \
        S[8 * j_ + 0] = d0_.x * S[8 * j_ + 0] + bflo(k_.x); S[8 * j_ + 1] = d0_.y * S[8 * j_ + 1] + bfhi(k_.x); S[8 * j_ + 2] = d0_.z * S[8 * j_ + 2] + bflo(k_.y); S[8 * j_ + 3] = d0_.w * S[8 * j_ + 3] + bfhi(k_.y); \
        S[8 * j_ + 4] = d1_.x * S[8 * j_ + 4] + bflo(k_.z); S[8 * j_ + 5] = d1_.y * S[8 * j_ + 5] + bfhi(k_.z); S[8 * j_ + 6] = d1_.z * S[8 * j_ + 6] + bflo(k_.w); S[8 * j_ + 7] = d1_.w * S[8 * j_ + 7] + bfhi(k_.w); } } while (0)
    for (int wg = blockIdx.x; wg < 256; wg += F.G) {
        const int bh = wg >> 2, seg = wg & 3, item0 = bh * 32 + seg * 8, b = bh >> 2, h = bh & 3;
        HG_LOADT(rf, item0, 1); HG_LOADT(rq, item0, 0); HG_LOADT(rv, item0, 2); HG_LOADST(item0);
        const unsigned dso0 = (unsigned)__builtin_amdgcn_readfirstlane((bh * 32 + seg * 8) * 128 * 4);
        const f32x4 decv = __builtin_bit_cast(f32x4, __builtin_amdgcn_raw_buffer_load_b128(rsrcD, (unsigned)(F.tid & 255) * 16u, dso0, 0));
        const float lbv = hg_lbound(F, h, d);
        __builtin_amdgcn_sched_barrier(0);
        float S[32];
#pragma unroll
        for (int j = 0; j < 32; ++j) S[j] = 0.f;
        for (int sp = 0; sp < seg; ++sp) {
            const unsigned sso = (unsigned)__builtin_amdgcn_readfirstlane((bh * 4 + sp) * 128 * 128 * 4), dso = (unsigned)__builtin_amdgcn_readfirstlane((bh * 4 + sp) * 128 * 4);
#pragma unroll
            for (int j0 = 0; j0 < 8; j0 += 8) { f32x4 sv[8], dv[8];
#pragma unroll
                for (int j = 0; j < 8; ++j) { sv[j] = __builtin_bit_cast(f32x4, __builtin_amdgcn_raw_buffer_load_b128(rsrcSS, (unsigned)((srow * 128 + sd0) * 4) + 2048u * ((j0 + j) >> 1) + 16u * ((j0 + j) & 1), sso, 0));
                    dv[j] = __builtin_bit_cast(f32x4, __builtin_amdgcn_raw_buffer_load_b128(rsrcDS, (unsigned)(sd0 * 4) + 16u * ((j0 + j) & 1), dso, 0)); }
#pragma unroll
                for (int j = 0; j < 8; ++j) { const int q = 4 * (j0 + j); S[q + 0] = dv[j].x * S[q + 0] + sv[j].x; S[q + 1] = dv[j].y * S[q + 1] + sv[j].y; S[q + 2] = dv[j].z * S[q + 2] + sv[j].z; S[q + 3] = dv[j].w * S[q + 3] + sv[j].w; } }
        }
        if (F.tid < 256) *((LAS f32x4*)(L + HG_DECS) + F.tid) = decv;
        __syncthreads();
      for (int k = 0; k < 8; ++k) {
        const int item = item0 + k, c = seg * 8 + k;
        const int tb = F.wave & 1, eb = F.wave >> 1;
        const int nit = k < 7 ? item + 1 : item;
        HG_PUT(rf, RAWF); HG_PUT(rq, RAWQ); HG_PUT(rv, RAWV);
        __syncthreads();
        HG_LOADT(rf, nit, 1); HG_LOADT(rq, nit, 0); HG_LOADT(rv, nit, 2); __builtin_amdgcn_sched_barrier(0);
        unsigned short ffr[16], qr[16], vr[16]; HG_COL(ffr, RAWF); HG_COL(qr, RAWQ); HG_COL(vr, RAWV);
        float bb[16], kk[16], total; hg_gates(F, ffr, lbv, d, tq, bb, kk, total);
        float vv[16];
#pragma unroll
        for (int i = 0; i < 16; ++i) { const int t = 16 * tq + i; const float q = bf2f(qr[i]);
            *(LAS unsigned short*)(L + HG_QE + t * 272 + 2 * d) = (unsigned short)pkbf(q * bb[i], 0.f);
            *(LAS unsigned short*)(L + HG_KE + t * 272 + 2 * d) = (unsigned short)pkbf(kk[i] * __builtin_amdgcn_rcpf(bb[i]), 0.f);
            vv[i] = bf2f(vr[i]); }
        st16<true>(L + HG_VT + d * 144 + tq * 32, vv);
#pragma unroll
        for (int j = 0; j < 4; ++j) { v4u w4; w4.x = pkbf(S[8 * j + 0], S[8 * j + 1]); w4.y = pkbf(S[8 * j + 2], S[8 * j + 3]); w4.z = pkbf(S[8 * j + 4], S[8 * j + 5]); w4.w = pkbf(S[8 * j + 6], S[8 * j + 7]);
            *(LAS v4u*)(L + HG_ST + (srow + 4 * j) * 272 + sd0 * 2) = w4; }
        HG_FOLD(st, k);
        v4u grw[2];
        { const bf16* grow_ = PHp + (((size_t)(3 * 16 + b) * 4 + h) * SEQ + c * 64 + tb * 32 + r) * 128;
#pragma unroll
            for (int gp = 0; gp < 2; ++gp) grw[gp] = *(const GAS v4u*)(grow_ + eb * 32 + 8 * (2 * gp + hh)); }
        HG_LOADST(nit); __builtin_amdgcn_sched_barrier(0);
        __syncthreads();
        f32x16 acc;
#pragma unroll
        for (int i = 0; i < 16; ++i) acc[i] = 0.f;
#define HG_QF(s_) (*(const LAS bf16x8*)(L + HG_QE + (tb * 32 + r) * 272 + 32 * (s_) + 16 * hh))
#pragma unroll
        for (int s = 0; s < 8; ++s) acc = MFMA32(*(const LAS bf16x8*)(L + HG_ST + (eb * 32 + r) * 272 + 32 * s + 16 * hh), HG_QF(s), acc);
        for (int sb = 0; sb <= tb; ++sb) {
            f32x16 at;
#pragma unroll
            for (int i = 0; i < 16; ++i) at[i] = 0.f;
#pragma unroll
            for (int s = 0; s < 8; ++s) at = MFMA32(*(const LAS bf16x8*)(L + HG_KE + (sb * 32 + r) * 272 + 32 * s + 16 * hh), HG_QF(s), at);
            float a[16];
#pragma unroll
            for (int i = 0; i < 16; ++i) a[i] = (sb < tb || crow16(i, hh) <= r) ? at[i] : 0.f;
            const bf16x8 ab0 = pack8(a[0], a[1], a[2], a[3], a[4], a[5], a[6], a[7]), ab1 = pack8(a[8], a[9], a[10], a[11], a[12], a[13], a[14], a[15]);
            acc = MFMA32(*(const LAS bf16x8*)(L + HG_VT + (eb * 32 + r) * 144 + sb * 64 + 0 + 16 * hh), ab0, acc);
            acc = MFMA32(*(const LAS bf16x8*)(L + HG_VT + (eb * 32 + r) * 144 + sb * 64 + 32 + 16 * hh), ab1, acc);
        }
        float ss = 0.f;
#pragma unroll
        for (int i = 0; i < 16; ++i) ss += acc[i] * acc[i];
        ss += __shfl_xor(ss, 32);
        LAS float* ssq = (LAS float*)(L + HG_SSQ);
        if (hh == 0) ssq[eb * 64 + tb * 32 + r] = ss;
        f32x4 ggv[4];
        { const unsigned so = (unsigned)__builtin_amdgcn_readfirstlane(h * 512);
#pragma unroll
            for (int g = 0; g < 4; ++g) ggv[g] = __builtin_bit_cast(f32x4, __builtin_amdgcn_raw_buffer_load_b128(rsrcG, (unsigned)((eb * 32 + 8 * g + 4 * hh) * 4), so, 0)); }
        __syncthreads();
        const int tl = tb * 32 + r; const float tot = (ssq[tl] + ssq[64 + tl]) + (ssq[128 + tl] + ssq[192 + tl]);
        const float rs = 1.f / sqrtf(tot * (1.f / 128.f) + EPS);
        const unsigned mso = (unsigned)__builtin_amdgcn_readfirstlane((int)((((unsigned)b * SEQ + c * 64) * D + 512 + h * 128) * 2)), mvo = (unsigned)((tl * D + eb * 32) * 2);
        unsigned long long grv[4];
#pragma unroll
        for (int gp = 0; gp < 2; ++gp) { const auto sa = __builtin_amdgcn_permlane32_swap(grw[gp].x, grw[gp].z, false, false), sb = __builtin_amdgcn_permlane32_swap(grw[gp].y, grw[gp].w, false, false);
            grv[2 * gp] = (unsigned long long)sa[0] | ((unsigned long long)sb[0] << 32); grv[2 * gp + 1] = (unsigned long long)sa[1] | ((unsigned long long)sb[1] << 32); }
        unsigned yp[4][2];
#pragma unroll
        for (int g = 0; g < 4; ++g) { const unsigned long long gr = grv[g]; const f32x4 gg = ggv[g];
            const float g0 = bflo((unsigned)gr), g1 = bfhi((unsigned)gr), g2 = bflo((unsigned)(gr >> 32)), g3 = bfhi((unsigned)(gr >> 32));
            const float y0 = acc[4 * g + 0] * rs * gg.x * (g0 * __builtin_amdgcn_rcpf(1.f + __expf(-g0))), y1 = acc[4 * g + 1] * rs * gg.y * (g1 * __builtin_amdgcn_rcpf(1.f + __expf(-g1)));
            const float y2 = acc[4 * g + 2] * rs * gg.z * (g2 * __builtin_amdgcn_rcpf(1.f + __expf(-g2))), y3 = acc[4 * g + 3] * rs * gg.w * (g3 * __builtin_amdgcn_rcpf(1.f + __expf(-g3)));
            yp[g][0] = pkbf(y0, y1); yp[g][1] = pkbf(y2, y3); }
        { v4u P[2];
#pragma unroll
            for (int gp = 0; gp < 2; ++gp) { const auto s0 = __builtin_amdgcn_permlane32_swap(yp[2 * gp][0], yp[2 * gp + 1][0], false, false), s1 = __builtin_amdgcn_permlane32_swap(yp[2 * gp][1], yp[2 * gp + 1][1], false, false);
                P[gp] = (v4u){s0[0], s1[0], s0[1], s1[1]}; }
            const bool odd = r & 1; v4u sA, sB; pair_trade(P[0], P[1], odd, sA, sB);
            const unsigned mvE = (unsigned)((((tb * 32 + (r & ~1)) * D + eb * 32) * 2) + 16 * (hh + 2 * (odd ? 1 : 0)));
            __builtin_amdgcn_raw_buffer_store_b128(sA, rsrcM, mvE, mso, 0); __builtin_amdgcn_raw_buffer_store_b128(sB, rsrcM, mvE + (unsigned)(D * 2), mso, 0); }
        __syncthreads();
      }
    }
#undef HG_LOADST
#undef HG_LOADKV
#undef HG_FOLD
#undef HG_QF
}
#undef HG_LOADT
#undef HG_PUT
#undef HG_COL
#undef HG_ARR
#undef HG_SOFF
#undef HG_HV

__device__ __forceinline__ void router_phase(Frame& F) {
    LAS unsigned char* L = F.lds; const int r = F.lane & 31, hh = F.lane >> 5;
    LAS unsigned* lcnt = (LAS unsigned*)(F.lds + LTAB_OFF) + LT_MISC; LAS unsigned* lbase = lcnt + 32; LAS float* lrstd = (LAS float*)(F.lds + ROWTAB_OFF);
    float* TOPG = (float*)(F.ws + WS_TOPG);
    {
        const GAS v4u* img = (const GAS v4u*)(F.ws + WS_RT) + vzero();
        constexpr int NB = (RT_END / 16 + NWAVES * 64 - 1) / (NWAVES * 64);
        v4u t4[NB];
#pragma unroll
        for (int j = 0; j < NB; ++j) { const int q = F.tid + j * NWAVES * 64; t4[j] = img[q < RT_END / 16 ? q : 0]; }
#pragma unroll
        for (int j = 0; j < NB; ++j) { const int q = F.tid + j * NWAVES * 64; if (q < RT_END / 16) *(LAS v4u*)(L + 16 * q) = t4[j]; }
    }
    const bf16* XH = (const bf16*)(F.ws + WS_XN); int* LIST = (int*)(F.ws + WS_LIST); unsigned* cnt = (unsigned*)(F.ctl + CW_CNT);
    for (int base = blockIdx.x * 4; base < T / 32; base += F.G * 4) {
        const int grp = base + F.wave; const bool active = F.wave < 4 && grp < T / 32;
        if (F.tid < 32) lcnt[F.tid] = 0u;
        __syncthreads();
        float sv[4] = {0.f, 0.f, 0.f, 0.f}; int se[4] = {0, 0, 0, 0}; unsigned lp0 = 0u, lp1 = 0u; const int tok = grp * 32 + r;
        if (active) {
            const float* ps = (const float*)(F.ws + WS_PSSQ) + tok + vzero(); float ssq = 0.f;
#pragma unroll
            for (int k = 0; k < 16; ++k) ssq += ps[(size_t)k * T];
            const float rstd = 1.f / sqrtf(ssq * (1.f / D) + EPS);
            const bf16* hrow = XH + (size_t)tok * D + 8 * hh;
            LAS unsigned char* const xt = F.lds + ROWTAB_OFF + 1024 + F.wave * 4608;
            unsigned char* const xout = F.ws + WS_X8 + (size_t)(grp * 32 + (F.lane >> 3)) * D + 16 * (F.lane & 7);
            f32x16 acc;
#pragma unroll
            for (int i = 0; i < 16; ++i) acc[i] = 0.f;
            for (int s0 = 0; s0 < 64; s0 += 16) { v4u hu16[16];
#pragma unroll
                for (int k = 0; k < 16; ++k) hu16[k] = *(const GAS v4u*)(hrow + 16 * (s0 + k));
#pragma unroll
                for (int k = 0; k < 16; ++k) { const int s = s0 + k; const v4u hu = hu16[k]; const bf16x8 hi = __builtin_bit_cast(bf16x8, hu);
                    const bf16x8 wh = *(const LAS bf16x8*)(L + r * RT_ROW + 32 * s + 16 * hh), wl = *(const LAS bf16x8*)(L + RT_WL + r * RT_ROW + 32 * s + 16 * hh);
                    acc = MFMA32(wh, hi, acc); acc = MFMA32(wl, hi, acc);
                    const unsigned o0 = pg8::pk4_fp8(bflo(hu.x) * rstd, bfhi(hu.x) * rstd, bflo(hu.y) * rstd, bfhi(hu.y) * rstd), o1 = pg8::pk4_fp8(bflo(hu.z) * rstd, bfhi(hu.z) * rstd, bflo(hu.w) * rstd, bfhi(hu.w) * rstd);
                    *(LAS unsigned long long*)(xt + r * 144 + 16 * (k & 7) + 8 * hh) = (unsigned long long)o0 | ((unsigned long long)o1 << 32);
                    if ((k & 7) == 7) { asm volatile("" ::: "memory"); v4u ln[4];
#pragma unroll
                        for (int j = 0; j < 4; ++j) ln[j] = *(const LAS v4u*)(xt + ((F.lane >> 3) + 8 * j) * 144 + 16 * (F.lane & 7));
#pragma unroll
                        for (int j = 0; j < 4; ++j) *(GAS v4u*)(xout + (size_t)(8 * j) * D + 128 * ((s0 + k) >> 3)) = ln[j];
                        asm volatile("" ::: "memory"); } } }
            float l[16];
#pragma unroll
            for (int i = 0; i < 16; ++i) l[i] = acc[i] * rstd + F.b_router[crow16(i, hh)];
            float cv[8]; int ce[8];
#pragma unroll
            for (int rnd = 0; rnd < 4; ++rnd) { float bv = l[0]; int bi = 0;
#pragma unroll
                for (int i = 1; i < 16; ++i) if (l[i] > bv) { bv = l[i]; bi = i; }
                cv[rnd] = bv; ce[rnd] = crow16(bi, hh);
#pragma unroll
                for (int i = 0; i < 16; ++i) if (i == bi) l[i] = -__builtin_inff(); }
#pragma unroll
            for (int j = 0; j < 4; ++j) { cv[4 + j] = __shfl_xor(cv[j], 32); ce[4 + j] = __shfl_xor(ce[j], 32); }
#pragma unroll
            for (int rnd = 0; rnd < 4; ++rnd) { float bv = cv[0]; int be = ce[0]; int bj = 0;
#pragma unroll
                for (int j = 1; j < 8; ++j) if (cv[j] > bv || (cv[j] == bv && ce[j] < be)) { bv = cv[j]; be = ce[j]; bj = j; }
                sv[rnd] = bv; se[rnd] = be;
#pragma unroll
                for (int j = 0; j < 8; ++j) if (j == bj) { cv[j] = -__builtin_inff(); ce[j] = 64; } }
            lp0 = __hip_atomic_fetch_add(lcnt + (hh ? se[2] : se[0]), 1u, __ATOMIC_RELAXED, __HIP_MEMORY_SCOPE_WORKGROUP);
            lp1 = __hip_atomic_fetch_add(lcnt + (hh ? se[3] : se[1]), 1u, __ATOMIC_RELAXED, __HIP_MEMORY_SCOPE_WORKGROUP);
        }
        __syncthreads();
        if (F.tid < 32) lbase[F.tid] = __hip_atomic_fetch_add(cnt + F.tid, lcnt[F.tid], __ATOMIC_RELAXED, __HIP_MEMORY_SCOPE_AGENT);
        __syncthreads();
        if (active) {
            const float e1 = __expf(sv[1] - sv[0]), e2 = __expf(sv[2] - sv[0]), e3 = __expf(sv[3] - sv[0]); const float inv = 1.f / (1.f + e1 + e2 + e3);
            const int ea = hh ? se[2] : se[0], eb = hh ? se[3] : se[1]; const float ga = (hh ? e2 : 1.f) * inv, gb = (hh ? e3 : e1) * inv;
            const size_t ia = (size_t)ea * 32768 + lbase[ea] + lp0, ib = (size_t)eb * 32768 + lbase[eb] + lp1;
            LIST[ia] = tok * 4 + 2 * hh; LIST[ib] = tok * 4 + 2 * hh + 1; TOPG[tok * 4 + 2 * hh] = ga; TOPG[tok * 4 + 2 * hh + 1] = gb;
        }
        __syncthreads();
    }
}
__device__ __forceinline__ int build_moe_tables(Frame& F, int ntn, int mode) {
    LAS int* lt = (LAS int*)(F.lds + LTAB_OFF);
    if (F.wave == 0) {
        const int e = F.lane & 31; const int c = (int)__hip_atomic_load((unsigned*)(F.ctl + CW_CNT) + e, __ATOMIC_RELAXED, __HIP_MEMORY_SCOPE_AGENT);
        const int tl = (c + 255) >> 8; int inc = tl;
#pragma unroll
        for (int off = 1; off < 32; off <<= 1) { const int o = __shfl_up(inc, off, 32); if (e >= off) inc += o; }
        const int tot = __shfl(inc, 31, 32), t0 = inc - tl;
        if (F.lane < 32) { lt[LT_TS + e] = t0; lt[LT_CNT + e] = c; for (int i = 0; i < tl; ++i) lt[t0 + i] = e; }
        if (F.lane == 0) lt[LT_MISC + 64] = tot;
    }
    __syncthreads();
    int nt = lt[LT_MISC + 64]; nt = nt < 0 ? 0 : (nt > MAXTILES ? MAXTILES : nt); nt = __builtin_amdgcn_readfirstlane(nt);
    const int* LIST = (const int*)(F.ws + WS_LIST);
    const int nslot = mode == 1 ? MAXSLOT : (MAXTILES * 4 + 255) / 256;
    for (int q = F.tid; q < nslot * 256; q += NWAVES * 64) { const int i = q >> 8, rr = q & 255; const int Lu = i * F.G + F.vcu;
        int li = -1; float bias = 0.f;
        if (Lu < nt * ntn) { const int pm0 = Lu / ntn, pl = Lu - pm0 * ntn, pm = mode == 2 ? nt - 1 - pm0 : pm0, e = lt[pm], idx = (pm - lt[LT_TS + e]) * 256 + rr; if (idx < lt[LT_CNT + e]) li = LIST[(size_t)e * 32768 + idx];
            bias = mode == 1 ? F.b_gu[(size_t)e * 2048 + (rr >> 7) * 1024 + pl * 128 + (rr & 127)] : F.b_d[(size_t)e * 1024 + pl * 256 + rr]; }
        ((LAS float*)(F.lds + ROWTAB_OFF))[q] = bias;
        if (mode == 1) ((LAS unsigned short*)(F.lds + ROWTAB2_OFF))[q] = (unsigned short)(li < 0 ? 0 : (li >> 2));
        else ((LAS int*)(F.lds + ROWTAB_OFF) + nslot * 256)[q] = li; }
    __syncthreads();
    return nt;
}
__device__ __forceinline__ void combine_phase(Frame& F) {
    const unsigned char* YK = F.ws + WS_YK; const bf16* XH = (const bf16*)(F.ws + WS_XN); const float* TOPG = (const float*)(F.ws + WS_TOPG);
    for (int t = F.gw; t < T; t += F.ngw) {
        GAS f32x4* xr = (GAS f32x4*)(F.out + (size_t)t * D) + F.lane; const f32x4 gt = *((const GAS f32x4*)TOPG + t + vzero()) * (1.0f / Y8_SCALE);
#pragma unroll
        for (int jh = 0; jh < 4; jh += 2) {
            f32x4 v[2]; unsigned y[2][4];
#pragma unroll
            for (int jj = 0; jj < 2; ++jj) { const int j = jh + jj; const unsigned long long xh = __builtin_nontemporal_load((const GAS unsigned long long*)(XH + (size_t)t * D) + F.lane + 64 * j);
                v[jj] = (f32x4){bflo((unsigned)xh), bfhi((unsigned)xh), bflo((unsigned)(xh >> 32)), bfhi((unsigned)(xh >> 32))};
#pragma unroll
                for (int k = 0; k < 4; ++k) y[jj][k] = __builtin_nontemporal_load((const GAS unsigned*)(YK + ((size_t)t * 4 + k) * D) + F.lane + 64 * j); }
#pragma unroll
            for (int jj = 0; jj < 2; ++jj) { const int j = jh + jj; f32x4 s4 = {0.f, 0.f, 0.f, 0.f};
#pragma unroll
                for (int k = 0; k < 4; ++k) { const f32x2n_ lo = __builtin_amdgcn_cvt_pk_f32_fp8((int)y[jj][k], false), hi = __builtin_amdgcn_cvt_pk_f32_fp8((int)y[jj][k], true); const float g = gt[k]; s4.x += g * lo.x; s4.y += g * lo.y; s4.z += g * hi.x; s4.w += g * hi.y; }
                v[jj] = v[jj] + s4;
                __builtin_nontemporal_store(v[jj], xr + 64 * j); }
        }
    }
}

constexpr int NPH = 9;
struct Args { const float* in[16]; float* out; unsigned char* ws; int ph_lo, ph_hi; };
__global__ void __launch_bounds__(NWAVES * 64, 2) fwd(Args args) {
    extern __shared__ __attribute__((aligned(16))) unsigned char lds[];
    Frame F;
    F.lds = (LAS unsigned char*)lds;
    F.MISC = (volatile LAS unsigned*)(F.lds + MISC_OFF);
    F.tid = threadIdx.x; F.lane = F.tid & 63; F.wave = __builtin_amdgcn_readfirstlane(F.tid >> 6);
    F.G = gridDim.x; { const int bx = blockIdx.x; F.vcu = (F.G % 8 == 0) ? (bx % 8) * (F.G / 8) + bx / 8 : bx; }
    F.gw = blockIdx.x * NWAVES + F.wave; F.ngw = F.G * NWAVES;
    F.ws = args.ws; F.ctl = (gu32*)(args.ws + WS_CTL); F.out = args.out;
    F.x = args.in[0]; F.norm1_g = args.in[1]; F.w_in = args.in[2]; F.sb_q_g = args.in[3]; F.sb_k_g = args.in[4]; F.sb_out_g = args.in[5]; F.hg_lb = args.in[6]; F.hg_out_g = args.in[7];
    F.w_out = args.in[8]; F.norm2_g = args.in[9]; F.w_router = args.in[10]; F.b_router = args.in[11]; F.w_gu = args.in[12]; F.b_gu = args.in[13]; F.w_d = args.in[14]; F.b_d = args.in[15];
    for (int u = F.tid; u < (LDS_BYTES - LDSCTL_OFF) / 4; u += NWAVES * 64) ((LAS unsigned*)(F.lds + LDSCTL_OFF))[u] = 0u;
    __syncthreads();
    XcdBarrier bar; bar.bar = (unsigned*)(F.ctl + CW_BAR); bar.x = 0; bar.st = nullptr;
    if (MK_ONE_LAUNCH) bar = xcd_barrier_post((unsigned*)(F.ctl + CW_BAR), F.MISC + 8);
    const int lo = args.ph_lo, hi = args.ph_hi;
#define IN(k) (lo <= (k) && (k) < hi && ((F.lane = lane_id()), (F.tid = F.wave * 64 + F.lane), true))
#define SEAM(k) do { if (IN(k) && IN((k) + 1)) xcd_barrier(bar); } while (0)

    if (IN(0)) { p0_prologue(F); } SEAM(0);
    if (IN(1)) {
        pg8::Gemm g{(const bf16*)(F.ws + WS_XN), (const bf16*)(F.ws + WS_WIN), T, NIN, D}; pg8::StaticOrder S; S.init(T, NIN, F.G, (int)blockIdx.x);
        {
            LAS float* rt = (LAS float*)(F.lds + ROWTAB_OFF); const float* rs1 = (const float*)(F.ws + WS_RS1) + vzero();
            constexpr int NU = (T / 256) * (NIN / 256) / 256 + 1; static_assert(NU * 1024 <= MAXSLOT * 1536, "row-factor table");
            float tv[(NU * 256 + NWAVES * 64 - 1) / (NWAVES * 64)];
#pragma unroll
            for (int j = 0; j < (NU * 256 + NWAVES * 64 - 1) / (NWAVES * 64); ++j) { const int q = F.tid + j * NWAVES * 64; pg8::Unit uu; const bool ok = q < NU * 256 && S.next(q >> 8, uu); tv[j] = rs1[ok ? uu.pm * 256 + (q & 255) : 0]; }
#pragma unroll
            for (int j = 0; j < (NU * 256 + NWAVES * 64 - 1) / (NWAVES * 64); ++j) { const int q = F.tid + j * NWAVES * 64; if (q < NU * 256) rt[q] = tv[j]; }
            __syncthreads(); }
        pg8::EpiInproj E{(bf16*)(F.ws + WS_P), (bf16*)(F.ws + WS_PH), (bf16*)(F.ws + WS_QN), (bf16*)(F.ws + WS_KN), F.sb_q_g, F.sb_k_g, QSCALE, EPS, (const LAS float*)(F.lds + ROWTAB_OFF)};
        pg8::gemm_phase<pg8::EpiInproj, pg8::StaticOrder, PG8_ALIGN, PG8_SP2>(F.lds + RING_OFF, g, S, E, F.tid);
    } SEAM(1);
    if (IN(2)) { hgA_phase(F); } SEAM(2);
    if (IN(3)) { attn_phase(F); __syncthreads(); hgC_phase(F); } SEAM(3);
    if (IN(4)) {
        pg8::Gemm g{(const bf16*)(F.ws + WS_MIX), (const bf16*)(F.ws + WS_WOUT), T, D, D}; pg8::StaticOrder S; S.init(T, D, F.G, (int)blockIdx.x);
        pg8::EpiRes E{F.x, (bf16*)(F.ws + WS_XN), D, (float*)(F.ws + WS_PSSQ)};
        pg8::gemm_phase<pg8::EpiRes, pg8::StaticOrder, PG8_ALIGN, PG8_SP2>(F.lds + RING_OFF, g, S, E, F.tid);
    } SEAM(4);
    if (IN(5)) { router_phase(F); } SEAM(5);
    if (IN(6)) {
        const int nt = build_moe_tables(F, 8, 1); const LAS int* lt = (const LAS int*)(F.lds + LTAB_OFF);
        pg8::Gemm g{(const bf16*)(F.ws + WS_X8), (const bf16*)(F.ws + WS_WGU), MAXROWS, NE * 2048, D / 2};
        pg8::MoeOrder S{lt, (const LAS unsigned short*)(F.lds + ROWTAB2_OFF), 8, nt * 8, F.G, F.vcu, 1024u, 0, 0, 0, nullptr, 0};
        pg8::EpiAct<true> E{F.ws + WS_ACT, (const LAS float*)(F.lds + ROWTAB_OFF), A8_SCALE, 0};
        pg8::gemm_phase<pg8::EpiAct<true>, pg8::MoeOrder, PG8_ALIGN, PG8_SP2, true, SC_W8, SC_ONE>(F.lds + RING_OFF, g, S, E, F.tid);
        {
            const int rem = (nt * 8) % F.G, nidle = F.G - rem; const bool few = rem == 0 || nidle < F.G / 4;
            __syncthreads();
            if (few) p0_items(F, P0_NITEMS - P0_NLATE, P0_NITEMS, F.vcu * NWAVES + F.wave, F.G * NWAVES);
            else if (F.vcu >= rem) p0_items(F, P0_NITEMS - P0_NLATE, P0_NITEMS, (F.vcu - rem) * NWAVES + F.wave, nidle * NWAVES);
        }
    } SEAM(6);
    if (IN(7)) {
        const int nt = build_moe_tables(F, 4, 2); const LAS int* lt = (const LAS int*)(F.lds + LTAB_OFF);
        pg8::Gemm g{(const bf16*)(F.ws + WS_ACT), (const bf16*)(F.ws + WS_WD), MAXROWS, NE * 1024, D / 2};
        pg8::MoeOrder S{lt, nullptr, 4, nt * 4, F.G, F.vcu, 1024u, 0, nt, 0, nullptr, 0};
        pg8::EpiDown E{F.ws + WS_YK, (const LAS int*)(F.lds + ROWTAB_OFF) + ((MAXTILES * 4 + 255) / 256) * 256, (const LAS float*)(F.lds + ROWTAB_OFF), Y8_SCALE};
        pg8::gemm_phase<pg8::EpiDown, pg8::MoeOrder, PG8_ALIGN, PG8_SP2, true, SC_W8Y, SC_A8>(F.lds + RING_OFF, g, S, E, F.tid);
    } SEAM(7);
    if (IN(8)) { combine_phase(F); }
#undef IN
#undef SEAM
}

extern "C" void kernel_launch(void* const* d_in, const int* in_sizes, int n_in, void* d_out, int out_size, void* d_ws, size_t ws_size, hipStream_t stream) {
    static int grid = 0;
    if (grid == 0) {
        if (n_in != 16 || in_sizes[0] != T * D || out_size != T * D || ws_size < WS_END) { fprintf(stderr, "kernel_launch: shape/workspace mismatch (n_in %d, ws %zu, need %zu); nothing launched\n", n_in, ws_size, (size_t)WS_END); grid = -1; return; }
        int dev = 0, cus = 0, per_cu = 0;
        if (hipGetDevice(&dev) != hipSuccess || hipDeviceGetAttribute(&cus, hipDeviceAttributeMultiprocessorCount, dev) != hipSuccess) { grid = -1; return; }
        if (hipFuncSetAttribute((const void*)fwd, hipFuncAttributeMaxDynamicSharedMemorySize, LDS_BYTES) != hipSuccess) { grid = -1; return; }
        if (hipOccupancyMaxActiveBlocksPerMultiprocessor(&per_cu, (const void*)fwd, NWAVES * 64, LDS_BYTES) != hipSuccess || per_cu < 1) { fprintf(stderr, "kernel_launch: occupancy query says %d\n", per_cu); }
        (void)hipGetLastError();
        if ((MAXTILES * 8 + cus - 1) / cus > MAXSLOT || cus < 1) { fprintf(stderr, "kernel_launch: %d CUs: the per-workgroup unit tables are sized for 256\n", cus); grid = -1; return; }
        grid = cus;
    }
    if (grid < 0) return;
    if (hipMemsetAsync((char*)d_ws + WS_CTL, 0, CTL_ZERO_BYTES, stream) != hipSuccess) return;
    Args a{};
    for (int i = 0; i < 16; ++i) a.in[i] = (const float*)d_in[i];
    a.out = (float*)d_out; a.ws = (unsigned char*)d_ws;
#if MK_ONE_LAUNCH
    a.ph_lo = 0; a.ph_hi = NPH;
    hipLaunchKernelGGL(fwd, dim3(grid), dim3(NWAVES * 64), LDS_BYTES, stream, a);
#else
    for (int p = 0; p < NPH; ++p) { a.ph_lo = p; a.ph_hi = p + 1; hipLaunchKernelGGL(fwd, dim3(grid), dim3(NWAVES * 64), LDS_BYTES, stream, a); }
#endif
}
```
